# Optimizing an MI355X kernel written in HIP

```python
import math
import jax
import jax.numpy as jnp
from jax import lax
import numpy as np

D_MODEL = 1024
BATCH = 16
SEQ = 4096
DEPTH = 4

GRID_W = 64
CTX_LEN = 256
MIX_WIDTH = D_MODEL
GROUP_WIDTH = MIX_WIDTH // 4
Q_BLOCK = 128
ROPE_BASE = 10000.0
EPS = 1e-6

MLA_HEADS = 4
MLA_NOPE = 64
MLA_ROPE = 32
MLA_V = GROUP_WIDTH // MLA_HEADS
MLA_Q_RANK = 192
MLA_KV_RANK = 128
GQA_HEADS = 4
GQA_KV_HEADS = 2
GQA_HEAD_DIM = GROUP_WIDTH // GQA_HEADS
SSM_GROUP = 16
SSM_GROUPS = GROUP_WIDTH // SSM_GROUP
SSM_STATE = 64
HY_WIDTH = GROUP_WIDTH
HY_ORDER = 2
HY_EMB = 33
HY_BANDS = (HY_EMB - 1) // 2
HY_HIDDEN = 64
HY_CONV = 3
HY_FAST_DECAY = 0.3
HY_SLOW_DECAY = 1.5
HY_DECAY_TARGET = 1e-2

MLA_COLS = MLA_Q_RANK + MLA_KV_RANK + MLA_ROPE + GROUP_WIDTH
GQA_COLS = (GQA_HEADS + 2 * GQA_KV_HEADS) * GQA_HEAD_DIM + GROUP_WIDTH
SSM_COLS = 2 * GROUP_WIDTH
HY_COLS = (HY_ORDER + 1) * HY_WIDTH + GROUP_WIDTH
IN_COLS = MLA_COLS + GQA_COLS + SSM_COLS + HY_COLS

kernel_name = 'hybrid_parallel_group_dit_block'


def rms_norm(x, g):
    xf = x.astype(jnp.float32)
    y = xf * lax.rsqrt(jnp.mean(xf * xf, axis=-1, keepdims=True) + EPS)
    return (y * g.astype(jnp.float32)).astype(x.dtype)


def grid_positions(n_rows):
    row = jnp.repeat(jnp.arange(n_rows, dtype=jnp.float32), GRID_W)
    col = jnp.tile(jnp.arange(GRID_W, dtype=jnp.float32), n_rows)
    return row, col


def _rotate(x, pos):
    h = x.shape[-1]
    inv = ROPE_BASE ** (-jnp.arange(0, h, 2, dtype=jnp.float32) / h)
    ang = pos[:, None] * inv[None, :]
    cos = jnp.cos(ang)[None, :, None, :].astype(x.dtype)
    sin = jnp.sin(ang)[None, :, None, :].astype(x.dtype)
    x1, x2 = x[..., :h // 2], x[..., h // 2:]
    return jnp.concatenate([x1 * cos - x2 * sin, x1 * sin + x2 * cos], axis=-1)


def axial_rope(x, row, col):
    half = x.shape[-1] // 2
    return jnp.concatenate([_rotate(x[..., :half], row), _rotate(x[..., half:], col)], axis=-1)


def block_attention(q, k, v, scale):
    b, n, h, dk = q.shape
    hk = k.shape[2]
    dv = v.shape[-1]
    nb = n // Q_BLOCK
    qb = q.reshape(b, nb, Q_BLOCK, hk, h // hk, dk).transpose(1, 0, 2, 3, 4, 5)

    def attend(qblk):
        s = jnp.einsum('bqhgd,bkhd->bhgqk', qblk, k, preferred_element_type=jnp.float32) * scale
        p = jax.nn.softmax(s, axis=-1).astype(v.dtype)
        return jnp.einsum('bhgqk,bkhd->bqhgd', p, v)

    o = lax.map(attend, qb)
    return o.transpose(1, 0, 2, 3, 4, 5).reshape(b, n, h, dv)


def mla_mixer(p_lat, p_ctx, g_cq, w_uq, g_ckv, w_ukv, row, col, need_ctx):
    r1 = MLA_Q_RANK
    r2 = r1 + MLA_KV_RANK
    r3 = r2 + MLA_ROPE
    scale = (MLA_NOPE + MLA_ROPE) ** -0.5

    def keys(p, rotary):
        b, n, _ = p.shape
        kv = (rms_norm(p[..., r1:r2], g_ckv) @ w_ukv).reshape(b, n, MLA_HEADS, MLA_NOPE + MLA_V)
        k_rope = p[..., r2:r3][:, :, None, :]
        if rotary:
            k_rope = axial_rope(k_rope, row, col)
        k = jnp.concatenate([kv[..., :MLA_NOPE], jnp.broadcast_to(k_rope, (b, n, MLA_HEADS, MLA_ROPE))], axis=-1)
        return k, kv[..., MLA_NOPE:]

    def attend(p, k, v, rotary):
        b, n, _ = p.shape
        q = (rms_norm(p[..., :r1], g_cq) @ w_uq).reshape(b, n, MLA_HEADS, MLA_NOPE + MLA_ROPE)
        q_rope = q[..., MLA_NOPE:]
        if rotary:
            q_rope = axial_rope(q_rope, row, col)
        q = jnp.concatenate([q[..., :MLA_NOPE], q_rope], axis=-1)
        o = block_attention(q, k, v, scale).reshape(b, n, GROUP_WIDTH)
        return o * jax.nn.silu(p[..., r3:])

    k_c, v_c = keys(p_ctx, False)
    k_l, v_l = keys(p_lat, True)
    o_l = attend(p_lat, jnp.concatenate([k_l, k_c], axis=1), jnp.concatenate([v_l, v_c], axis=1), True)
    o_c = attend(p_ctx, k_c, v_c, False) if need_ctx else None
    return o_l, o_c


def gqa_mixer(p_lat, p_ctx, g_q, g_k, row, col, need_ctx):
    qd = GQA_HEADS * GQA_HEAD_DIM
    kd = GQA_KV_HEADS * GQA_HEAD_DIM
    scale = GQA_HEAD_DIM ** -0.5

    def keys(p, rotary):
        b, n, _ = p.shape
        k = rms_norm(p[..., qd:qd + kd].reshape(b, n, GQA_KV_HEADS, GQA_HEAD_DIM), g_k)
        v = p[..., qd + kd:qd + 2 * kd].reshape(b, n, GQA_KV_HEADS, GQA_HEAD_DIM)
        if rotary:
            k = axial_rope(k, row, col)
        return k, v

    def attend(p, k, v, rotary):
        b, n, _ = p.shape
        q = rms_norm(p[..., :qd].reshape(b, n, GQA_HEADS, GQA_HEAD_DIM), g_q)
        if rotary:
            q = axial_rope(q, row, col)
        o = block_attention(q, k, v, scale).reshape(b, n, GROUP_WIDTH)
        return o * jax.nn.silu(p[..., qd + 2 * kd:])

    k_c, v_c = keys(p_ctx, False)
    k_l, v_l = keys(p_lat, True)
    o_l = attend(p_lat, jnp.concatenate([k_l, k_c], axis=1), jnp.concatenate([v_l, v_c], axis=1), True)
    o_c = attend(p_ctx, k_c, v_c, False) if need_ctx else None
    return o_l, o_c


def ssm_discretise(lam_re, lam_im, log_step, b_re, b_im):
    lam = lax.complex(lam_re.astype(jnp.float32), lam_im.astype(jnp.float32))
    step = jnp.exp(log_step.astype(jnp.float32))[:, None]
    a_bar = jnp.exp(lam * step)
    b_mat = lax.complex(b_re.astype(jnp.float32), b_im.astype(jnp.float32))
    b_bar = ((a_bar - 1.0) / lam)[..., None] * b_mat
    return a_bar, b_bar


def linear_scan(a_bar, bu, s0, reverse):
    a = jnp.broadcast_to(a_bar, bu.shape)

    def combine(e1, e2):
        return e1[0] * e2[0], e2[0] * e1[1] + e2[1]

    a_cum, h = lax.associative_scan(combine, (a, bu), axis=1, reverse=reverse)
    if s0 is not None:
        h = h + a_cum * s0[:, None]
    return h


def ssm_mixer(p_lat, p_ctx, lam_re, lam_im, log_step, b_re, b_im, c_re, c_im, d_skip, glu_w, glu_b, need_ctx):
    w = GROUP_WIDTH

    def drive(p, b_bar):
        b, n, _ = p.shape
        u = p[..., :w].astype(jnp.float32).reshape(b, n, SSM_GROUPS, SSM_GROUP)
        return jnp.einsum('bngh,gph->bngp', u.astype(jnp.complex64), b_bar)

    def readout(states, c_mat):
        return jnp.einsum('bngp,ghp->bngh', states, c_mat).real

    def finish(p, y):
        b, n, _ = p.shape
        u = p[..., :w].astype(jnp.float32)
        y = y.reshape(b, n, w) + d_skip.astype(jnp.float32) * u
        z = jax.nn.gelu(y)
        z = z * jax.nn.sigmoid(z @ glu_w.astype(jnp.float32) + glu_b.astype(jnp.float32))
        return z.astype(p.dtype) * jax.nn.silu(p[..., w:])

    y_lat = []
    y_ctx = []
    for direction, reverse in ((0, False), (1, True)):
        a_bar, b_bar = ssm_discretise(lam_re[direction], lam_im[direction], log_step[direction],
                                      b_re[direction], b_im[direction])
        c_mat = lax.complex(c_re[direction].astype(jnp.float32), c_im[direction].astype(jnp.float32))
        s_ctx = linear_scan(a_bar, drive(p_ctx, b_bar), None, reverse)
        s_end = s_ctx[:, 0] if reverse else s_ctx[:, -1]
        s_lat = linear_scan(a_bar, drive(p_lat, b_bar), s_end, reverse)
        y_lat.append(readout(s_lat, c_mat))
        if need_ctx:
            y_ctx.append(readout(s_ctx, c_mat))
    o_l = finish(p_lat, y_lat[0] + y_lat[1])
    o_c = finish(p_ctx, y_ctx[0] + y_ctx[1]) if need_ctx else None
    return o_l, o_c


def short_conv(x, w, b):
    n = x.shape[1]
    xp = jnp.pad(x, ((0, 0), (1, 1), (0, 0)))
    return xp[:, :n] * w[0] + xp[:, 1:n + 1] * w[1] + xp[:, 2:] * w[2] + b


def hyena_kernel_freq(n, w1, b1, fr1, w2, b2, fr2, w3):
    f32 = jnp.float32
    t = jnp.linspace(0.0, 1.0, n, dtype=f32)[:, None]
    omega = 2.0 * math.pi * jnp.arange(n, dtype=f32)[:, None] / n
    bands = jnp.linspace(1e-4, HY_BANDS - 1, HY_BANDS, dtype=f32)[None, :]
    z = jnp.concatenate([t, jnp.cos(bands * omega), -jnp.sin(bands * omega)], axis=-1)
    h = jnp.sin(fr1.astype(f32) * (z @ w1.astype(f32) + b1.astype(f32)))
    h = jnp.sin(fr2.astype(f32) * (h @ w2.astype(f32) + b2.astype(f32)))
    h = (h @ w3.astype(f32)).reshape(n, HY_ORDER, 2, HY_WIDTH)
    max_decay = math.log(HY_DECAY_TARGET) / HY_FAST_DECAY
    min_decay = math.log(HY_DECAY_TARGET) / HY_SLOW_DECAY
    deltas = jnp.linspace(min_decay, max_decay, HY_WIDTH, dtype=f32)
    h = h * jnp.exp(-t[:, :, None, None] * jnp.abs(deltas))
    h = h * lax.rsqrt(jnp.sum(h * h, axis=(0, 2), keepdims=True) + EPS)
    fwd, bwd = h[:, :, 0], h[:, :, 1]
    zero = jnp.zeros((1, HY_ORDER, HY_WIDTH), f32)
    k_circ = jnp.concatenate([fwd, zero, bwd[1:][::-1]], axis=0)
    return jnp.fft.rfft(k_circ, axis=0)


def long_conv(u, k_f, bias):
    n = u.shape[1]
    uf = jnp.fft.rfft(u, n=2 * n, axis=1)
    y = jnp.fft.irfft(uf * k_f[None], n=2 * n, axis=1)[:, :n]
    return y + u * bias.astype(jnp.float32)


def hyena_mixer(p_lat, p_ctx, conv_w, conv_b, w1, b1, fr1, w2, b2, fr2, w3, bias, need_ctx):
    w = HY_WIDTH

    def run(p):
        n = p.shape[1]
        proj = short_conv(p[..., :(HY_ORDER + 1) * w], conv_w, conv_b)
        v = proj[..., :w].astype(jnp.float32)
        x1 = proj[..., w:2 * w].astype(jnp.float32)
        x2 = proj[..., 2 * w:3 * w].astype(jnp.float32)
        k_f = hyena_kernel_freq(n, w1, b1, fr1, w2, b2, fr2, w3)
        z = x1 * long_conv(v, k_f[:, 0], bias[0])
        z = x2 * long_conv(z, k_f[:, 1], bias[1])
        return z.astype(p.dtype) * jax.nn.silu(p[..., (HY_ORDER + 1) * w:])

    o_l = run(p_lat)
    o_c = run(p_ctx) if need_ctx else None
    return o_l, o_c


def modulation(cvec, w_mod, b_mod):
    m = jax.nn.silu(cvec) @ w_mod + b_mod
    return jnp.split(m, 3, axis=-1)


def setup_inputs(seed: int = 0) -> dict:
    key = jax.random.key(seed)
    keys = iter(jax.random.split(key, 48))
    f32 = jnp.float32

    def normal(shape, scale):
        return jax.random.normal(next(keys), shape, f32) * scale

    def gain(shape):
        return 1.0 + normal(shape, 0.02)

    w = GROUP_WIDTH
    ssm_shape = (DEPTH, 2, SSM_GROUPS, SSM_STATE)
    x = normal((BATCH, SEQ, D_MODEL), 1.0)
    c = normal((BATCH, D_MODEL), 1.0)
    ctx = normal((BATCH, CTX_LEN, D_MODEL), 1.0)
    c_ctx = normal((D_MODEL,), 1.0)
    w_mod = normal((DEPTH, D_MODEL, 3 * D_MODEL), D_MODEL ** -0.5)
    b_mod = normal((DEPTH, 3 * D_MODEL), 0.02)
    g_pre = gain((DEPTH, D_MODEL))
    g_post = gain((DEPTH, D_MODEL))
    w_in = normal((DEPTH, D_MODEL, IN_COLS), D_MODEL ** -0.5)
    w_out = normal((DEPTH, MIX_WIDTH, D_MODEL), MIX_WIDTH ** -0.5)
    mla_g_cq = gain((DEPTH, MLA_Q_RANK))
    mla_w_uq = normal((DEPTH, MLA_Q_RANK, MLA_HEADS * (MLA_NOPE + MLA_ROPE)), MLA_Q_RANK ** -0.5)
    mla_g_ckv = gain((DEPTH, MLA_KV_RANK))
    mla_w_ukv = normal((DEPTH, MLA_KV_RANK, MLA_HEADS * (MLA_NOPE + MLA_V)), MLA_KV_RANK ** -0.5)
    gqa_g_q = gain((DEPTH, GQA_HEAD_DIM))
    gqa_g_k = gain((DEPTH, GQA_HEAD_DIM))
    ssm_lambda_re = -0.5 * jnp.exp(normal(ssm_shape, 0.05))
    ssm_lambda_im = math.pi * jnp.arange(SSM_STATE, dtype=f32) + normal(ssm_shape, 0.01)
    ssm_log_step = jax.random.uniform(next(keys), (DEPTH, 2, SSM_GROUPS), f32, math.log(1e-3), math.log(1e-1))
    ssm_b_re = normal((DEPTH, 2, SSM_GROUPS, SSM_STATE, SSM_GROUP), (2 * SSM_GROUP) ** -0.5)
    ssm_b_im = normal((DEPTH, 2, SSM_GROUPS, SSM_STATE, SSM_GROUP), (2 * SSM_GROUP) ** -0.5)
    ssm_c_re = normal((DEPTH, 2, SSM_GROUPS, SSM_GROUP, SSM_STATE), SSM_STATE ** -0.5)
    ssm_c_im = normal((DEPTH, 2, SSM_GROUPS, SSM_GROUP, SSM_STATE), SSM_STATE ** -0.5)
    ssm_d = normal((DEPTH, w), 1.0)
    ssm_glu_w = normal((DEPTH, w, w), w ** -0.5)
    ssm_glu_b = normal((DEPTH, w), 0.02)
    hy_conv_w = normal((DEPTH, HY_CONV, (HY_ORDER + 1) * HY_WIDTH), HY_CONV ** -0.5)
    hy_conv_b = normal((DEPTH, (HY_ORDER + 1) * HY_WIDTH), 0.02)
    hy_f_w1 = normal((DEPTH, HY_EMB, HY_HIDDEN), HY_EMB ** -0.5)
    hy_f_b1 = normal((DEPTH, HY_HIDDEN), 0.02)
    hy_f_freq1 = gain((DEPTH, HY_HIDDEN))
    hy_f_w2 = normal((DEPTH, HY_HIDDEN, HY_HIDDEN), HY_HIDDEN ** -0.5)
    hy_f_b2 = normal((DEPTH, HY_HIDDEN), 0.02)
    hy_f_freq2 = gain((DEPTH, HY_HIDDEN))
    hy_f_w3 = normal((DEPTH, HY_HIDDEN, HY_ORDER * 2 * HY_WIDTH), HY_HIDDEN ** -0.5)
    hy_bias = normal((DEPTH, HY_ORDER, HY_WIDTH), 0.5)
    return {'x': x, 'c': c, 'ctx': ctx, 'c_ctx': c_ctx, 'w_mod': w_mod, 'b_mod': b_mod,
            'g_pre': g_pre, 'g_post': g_post, 'w_in': w_in, 'w_out': w_out,
            'mla_g_cq': mla_g_cq, 'mla_w_uq': mla_w_uq, 'mla_g_ckv': mla_g_ckv, 'mla_w_ukv': mla_w_ukv,
            'gqa_g_q': gqa_g_q, 'gqa_g_k': gqa_g_k,
            'ssm_lambda_re': ssm_lambda_re, 'ssm_lambda_im': ssm_lambda_im, 'ssm_log_step': ssm_log_step,
            'ssm_b_re': ssm_b_re, 'ssm_b_im': ssm_b_im, 'ssm_c_re': ssm_c_re, 'ssm_c_im': ssm_c_im,
            'ssm_d': ssm_d, 'ssm_glu_w': ssm_glu_w, 'ssm_glu_b': ssm_glu_b,
            'hy_conv_w': hy_conv_w, 'hy_conv_b': hy_conv_b, 'hy_f_w1': hy_f_w1, 'hy_f_b1': hy_f_b1,
            'hy_f_freq1': hy_f_freq1, 'hy_f_w2': hy_f_w2, 'hy_f_b2': hy_f_b2, 'hy_f_freq2': hy_f_freq2,
            'hy_f_w3': hy_f_w3, 'hy_bias': hy_bias}


def reference(x, c, ctx, c_ctx, w_mod, b_mod, g_pre, g_post, w_in, w_out,
              mla_g_cq, mla_w_uq, mla_g_ckv, mla_w_ukv, gqa_g_q, gqa_g_k,
              ssm_lambda_re, ssm_lambda_im, ssm_log_step, ssm_b_re, ssm_b_im, ssm_c_re, ssm_c_im,
              ssm_d, ssm_glu_w, ssm_glu_b,
              hy_conv_w, hy_conv_b, hy_f_w1, hy_f_b1, hy_f_freq1, hy_f_w2, hy_f_b2, hy_f_freq2,
              hy_f_w3, hy_bias):
    n_rows = x.shape[1] // GRID_W
    row, col = grid_positions(n_rows)
    o1 = MLA_COLS
    o2 = o1 + GQA_COLS
    o3 = o2 + SSM_COLS
    for l in range(DEPTH):
        need_ctx = l < DEPTH - 1
        sh_l, sc_l, gt_l = [m[:, None, :] for m in modulation(c, w_mod[l], b_mod[l])]
        sh_c, sc_c, gt_c = modulation(c_ctx, w_mod[l], b_mod[l])
        h_l = rms_norm(x, g_pre[l]) * (1 + sc_l) + sh_l
        h_c = rms_norm(ctx, g_pre[l]) * (1 + sc_c) + sh_c
        p_l = h_l @ w_in[l]
        p_c = h_c @ w_in[l]
        a_l, a_c = mla_mixer(p_l[..., :o1], p_c[..., :o1], mla_g_cq[l], mla_w_uq[l],
                             mla_g_ckv[l], mla_w_ukv[l], row, col, need_ctx)
        g_l, g_c = gqa_mixer(p_l[..., o1:o2], p_c[..., o1:o2], gqa_g_q[l], gqa_g_k[l], row, col, need_ctx)
        s_l, s_c = ssm_mixer(p_l[..., o2:o3], p_c[..., o2:o3], ssm_lambda_re[l], ssm_lambda_im[l],
                             ssm_log_step[l], ssm_b_re[l], ssm_b_im[l], ssm_c_re[l], ssm_c_im[l],
                             ssm_d[l], ssm_glu_w[l], ssm_glu_b[l], need_ctx)
        y_l, y_c = hyena_mixer(p_l[..., o3:], p_c[..., o3:], hy_conv_w[l], hy_conv_b[l],
                               hy_f_w1[l], hy_f_b1[l], hy_f_freq1[l], hy_f_w2[l], hy_f_b2[l],
                               hy_f_freq2[l], hy_f_w3[l], hy_bias[l], need_ctx)
        out_l = jnp.concatenate([a_l, g_l, s_l, y_l], axis=-1) @ w_out[l]
        x = x + gt_l * rms_norm(out_l, g_post[l])
        if need_ctx:
            out_c = jnp.concatenate([a_c, g_c, s_c, y_c], axis=-1) @ w_out[l]
            ctx = ctx + gt_c * rms_norm(out_c, g_post[l])
    return x
```

```cpp
#include <hip/hip_runtime.h>
#include <cstdio>
#include <cstdint>

#ifndef MK_ONE_LAUNCH
#define MK_ONE_LAUNCH 0
#endif

#define LAS __attribute__((address_space(3)))
typedef unsigned short bf16_t;
typedef short bf16x8 __attribute__((ext_vector_type(8)));
typedef short bf16x4 __attribute__((ext_vector_type(4)));
typedef float f32x4 __attribute__((ext_vector_type(4)));
typedef float f32x16 __attribute__((ext_vector_type(16)));
typedef unsigned u32x4 __attribute__((ext_vector_type(4)));
typedef unsigned u32x2 __attribute__((ext_vector_type(2)));

constexpr int NB = 16, SEQL = 4096, CTXL = 256, NTOK = SEQL + CTXL  , MROWS = NB * NTOK  ;
constexpr int DM = 1024, DEPTH = 4, INC = 2912, INP = 3072;
constexpr int NCHB = NTOK / 16  , NCHUNK = MROWS / 16  ;
constexpr float EPS = 1e-6f;
constexpr float LOG2E = 1.4426950408889634f;

constexpr size_t al256(size_t x) { return (x + 255) & ~(size_t)255; }
constexpr size_t WS_CTL = 0;
constexpr size_t CTL_BYTES = 32768;
constexpr size_t WS_MODV = WS_CTL + CTL_BYTES;
constexpr size_t WS_ROPEG = WS_MODV + al256((size_t)4 * 17 * 3072 * 4);
constexpr size_t WS_ROPEM = WS_ROPEG + 64 * 16 * 2 * 4;
constexpr size_t WS_WIN = WS_ROPEM + 64 * 8 * 2 * 4;
constexpr size_t WS_WOUT = WS_WIN + (size_t)4 * 3072 * 1024 * 2;
constexpr size_t WS_WUQ = WS_WOUT + (size_t)4 * 1024 * 1024 * 2;
constexpr size_t WS_WUK = WS_WUQ + (size_t)4 * 512 * 256 * 2;
constexpr size_t WS_WUV = WS_WUK + (size_t)4 * 256 * 256 * 2;
constexpr size_t WS_WGLU = WS_WUV + (size_t)4 * 256 * 256 * 2;
constexpr size_t WS_WE = WS_WGLU + (size_t)4 * 256 * 256 * 2;
constexpr size_t WS_WKC = WS_WE + (size_t)4 * 16 * 256 * 256 * 2;
constexpr size_t WS_A16 = WS_WKC + (size_t)4 * 16 * 256 * 512 * 2;
constexpr size_t WS_GR = WS_A16 + (size_t)4 * 2 * 16 * 64 * 2 * 4;
constexpr size_t WS_GRC = WS_GR + (size_t)4 * 2 * 256 * 8192 * 2;
constexpr size_t WS_CTXR = WS_GRC + (size_t)4 * 2 * 256 * 512 * 2;
constexpr size_t WS_HCAT = WS_CTXR + (size_t)NB * CTXL * DM * 4;
constexpr size_t BLKE = (size_t)MROWS * 256;
constexpr size_t WS_PB = WS_HCAT + (size_t)MROWS * DM * 2;
constexpr size_t WS_KR = WS_PB + 12 * BLKE * 2;
constexpr size_t WS_KG = WS_KR + (size_t)MROWS * 32 * 2;
constexpr size_t WS_VTG = WS_KG + (size_t)32 * NTOK * 64 * 2;
constexpr size_t WS_UG = WS_VTG + (size_t)32 * NTOK * 64 * 2;
constexpr size_t WS_US = WS_UG + BLKE * 2;
constexpr size_t WS_HYV = WS_US + (size_t)16 * NCHUNK * 512 * 2;
constexpr size_t WS_HYX1 = WS_HYV + BLKE * 2;
constexpr size_t WS_HYX2 = WS_HYX1 + BLKE * 2;
constexpr size_t WS_HYG = WS_HYX2 + BLKE * 2;
constexpr size_t WS_END = WS_HYG + BLKE * 2;
static_assert(WS_END <= (size_t)1 << 30, "workspace map exceeds 1 GiB");
constexpr size_t WS_QM = WS_PB + 8 * BLKE * 2;
constexpr size_t WS_KM = WS_QM + (size_t)MROWS * 384 * 2;
constexpr size_t WS_VTM = WS_KM + (size_t)MROWS * 384 * 2;
constexpr size_t WS_E = WS_PB + 4 * BLKE * 2;
constexpr size_t WS_ZS = WS_PB + 6 * BLKE * 2;
constexpr size_t WS_OUTB = WS_PB + 8 * BLKE * 2;
constexpr size_t WS_HT = WS_PB;
static_assert(WS_VTM + BLKE * 2 == WS_PB + 12 * BLKE * 2, "alias map");

constexpr int CW_BAR = 0;
constexpr int CW_Q = 4096;
constexpr int CW_TMO = 4096 + 64 * 8;

__device__ __forceinline__ float bf2f(bf16_t v) { return __uint_as_float(((unsigned)v) << 16); }
__device__ __forceinline__ bf16_t f2bf(float f) { unsigned u = __float_as_uint(f); u += 0x7FFFu + ((u >> 16) & 1u); return (bf16_t)(u >> 16); }
__device__ __forceinline__ unsigned cvt_pk_bf16(float lo, float hi) { unsigned r; asm volatile("v_cvt_pk_bf16_f32 %0, %1, %2" : "=v"(r) : "v"(lo), "v"(hi)); return r; }
__device__ __forceinline__ float lo_bf(unsigned w) { return __uint_as_float(w << 16); }
__device__ __forceinline__ float hi_bf(unsigned w) { return __uint_as_float(w & 0xFFFF0000u); }
__device__ __forceinline__ float sigmf(float x) { float one = 1.f; asm volatile("" : "+v"(one)); return __builtin_amdgcn_rcpf(one + __builtin_amdgcn_exp2f(-1.4426950408889634f * x)); }
__device__ __forceinline__ float siluf(float x) { return x * sigmf(x); }
__device__ __forceinline__ float gelu_tanh(float x) { const float u = 0.7978845608028654f * (x + 0.044715f * x * x * x); return x * sigmf(2.f * u); }
__device__ __forceinline__ int opaque(int x) { asm volatile("" : "+v"(x)); return x; }
__device__ __forceinline__ float wave_sum(float v) {
#pragma unroll
    for (int o = 32; o > 0; o >>= 1) v += __shfl_xor(v, o);
    return v;
}

#define XB_TMO      128
#define XB_XCNT(j)  (256  + 64 * (j))
#define XB_XSUB(j)  (1280 + 64 * (j))
#define XB_XGEN(j)  (2304 + 64 * (j))
#define XB_TOP      3328
#define XB_TOPGEN   3392
#define XCD_BAR_WORDS 3456
#define XB_SPIN_CAP (1u << 22)
__device__ __forceinline__ unsigned xb_ld(unsigned* p)              { return __hip_atomic_load(p, __ATOMIC_RELAXED, __HIP_MEMORY_SCOPE_AGENT); }
__device__ __forceinline__ unsigned xb_add(unsigned* p, unsigned v) { return __hip_atomic_fetch_add(p, v, __ATOMIC_RELAXED, __HIP_MEMORY_SCOPE_AGENT); }
__device__ __forceinline__ unsigned xb_xcc_id() { return (unsigned)__builtin_amdgcn_s_getreg((3 << 11) | 20) & 0xFu; }
#define XB_SPIN(cond, bar) do { unsigned _sp = 0; while (cond) { __builtin_amdgcn_s_sleep(1); \
    if ((++_sp & 255u) == 0u) { if (xb_ld(&(bar)[XB_TMO])) break; if (_sp > XB_SPIN_CAP) { atomicAdd(&(bar)[XB_TMO], 1u); break; } } } } while (0)
struct XcdBarrier { unsigned* bar; unsigned x; volatile LAS unsigned* st; };
__device__ __forceinline__ XcdBarrier xcd_barrier_post(unsigned* bar, volatile LAS unsigned* st) {
    XcdBarrier b; b.bar = bar; b.x = xb_xcc_id(); b.st = st;
    if (threadIdx.x == 0) (void)xb_add(&bar[XB_XCNT(b.x)], 1u);
    return b;
}
__device__ __forceinline__ void xcd_barrier_complete(unsigned* bar, unsigned x, unsigned& nloc, unsigned& nx) {
    const unsigned G = gridDim.x * gridDim.y * gridDim.z;
    unsigned sum, cnt, mine, sp = 0u;
    for (;;) {
        sum = 0u; cnt = 0u; mine = 0u;
#pragma unroll
        for (unsigned j = 0; j < 16; ++j) { const unsigned c = xb_ld(&bar[XB_XCNT(j)]); sum += c; cnt += (c > 0u) ? 1u : 0u; }
        mine = xb_ld(&bar[XB_XCNT(x)]);
        if (sum == G) break;
        __builtin_amdgcn_s_sleep(1);
        if ((++sp & 255u) == 0u) { if (xb_ld(&bar[XB_TMO])) break; if (sp > XB_SPIN_CAP) { atomicAdd(&bar[XB_TMO], 1u); break; } }
    }
    nloc = mine > 0u ? mine : 1u; nx = cnt > 0u ? cnt : 1u;
}
__device__ __forceinline__ void xcd_barrier(const XcdBarrier& b) {
    asm volatile("s_waitcnt vmcnt(0)" ::: "memory");
    __syncthreads();
    if (threadIdx.x == 0) {
        unsigned* bar = b.bar;
        __builtin_amdgcn_s_waitcnt(0);
        unsigned nloc = b.st[0], nx = b.st[1];
        if (nloc == 0u) { xcd_barrier_complete(bar, b.x, nloc, nx); b.st[0] = nloc; b.st[1] = nx; }
        const unsigned old = xb_add(&bar[XB_XSUB(b.x)], 1u);
        const unsigned gen = old / nloc;
        if (old + 1u == (gen + 1u) * nloc) {
            __builtin_amdgcn_fence(__ATOMIC_RELEASE, "agent");
            asm volatile("s_waitcnt vmcnt(0)" ::: "memory");
            const unsigned og = xb_add(&bar[XB_TOP], 1u);
            const unsigned tg = og / nx;
            if (og + 1u == (tg + 1u) * nx) xb_add(&bar[XB_TOPGEN], 1u);
            else XB_SPIN(xb_ld(&bar[XB_TOPGEN]) == tg, bar);
            __builtin_amdgcn_fence(__ATOMIC_ACQUIRE, "agent");
            xb_add(&bar[XB_XGEN(b.x)], 1u);
            asm volatile("s_waitcnt vmcnt(0)" ::: "memory");
        } else {
            XB_SPIN(xb_ld(&bar[XB_XGEN(b.x)]) == gen, bar);
            __builtin_amdgcn_fence(__ATOMIC_ACQUIRE, "agent");
            asm volatile("s_waitcnt vmcnt(0)" ::: "memory");
        }
    }
    __syncthreads();
}

namespace pg8 {
constexpr int BM = 256, BK = 64, HALF = 128, HTB = HALF * BK * 2, STAGE_BYTES = 8 * HTB, NXCD = 8, WGM = 8;
__host__ __device__ __forceinline__ int lds_byte(int r, int c) { const int st = (r >> 4) * 2 + (c >> 5), rr = r & 15, cc = c & 31, ob = rr * 64 + cc * 2; return st * 1024 + (ob ^ (((ob >> 9) & 1) << 5)); }
__host__ __device__ __forceinline__ void stage_rc(int b, int& R, int& C) { const int st = b / 1024, sb = b % 1024, swz = sb ^ (((sb >> 9) & 1) << 5); R = (st >> 1) * 16 + swz / 64; C = (st & 1) * 32 + (swz % 64) / 2; }
__host__ __device__ __forceinline__ int perm32(int rho) { const int n = rho >> 4, i = rho & 15; return 8 * (i >> 2) + 4 * n + (i & 3); }
struct Unit { int pm, pn; };
struct Gemm { const bf16_t* A; const bf16_t* Bt; int M, N, K; };
struct StaticOrder {
    int nM, nN, nwg, G, c;
    __host__ __device__ void init(int M, int N, int G_, int c_) { nM = M / BM; nN = N / BM; nwg = nM * nN; G = G_; c = c_; }
    __host__ __device__ bool next(int i, Unit& u) const {
        const long L = (long)i * G + c; if (L >= nwg) return false;
        int wgid = (int)L; { const int q = nwg / NXCD, r = nwg % NXCD, xcd = wgid % NXCD, off = wgid / NXCD; wgid = (xcd < r ? xcd * (q + 1) : r * (q + 1) + (xcd - r) * q) + off; }
        const int nig = WGM * nN, gid = wgid / nig, fm = gid * WGM, gsz = (nM - fm) < WGM ? (nM - fm) : WGM;
        u.pm = fm + ((wgid % nig) % gsz); u.pn = (wgid % nig) / gsz; return true;
    }
    __device__ __forceinline__ void a_ready(const Unit&) const {}
    __device__ __forceinline__ void done(const Unit&) const {}
};
struct BatchedOrder {
    int nwg, G, c, tpg;
    __host__ __device__ void init(int ng, int tpg_, int G_, int c_) { nwg = ng * tpg_; tpg = tpg_; G = G_; c = c_; }
    __host__ __device__ bool next(int i, Unit& u) const { const int L = i * G + c; if (L >= nwg) return false; u.pm = L; u.pn = L / tpg; return true; }
    __device__ __forceinline__ void a_ready(const Unit&) const {}
    __device__ __forceinline__ void done(const Unit&) const {}
};

template <class Epi, class Sched>
__device__ __forceinline__ void gemm_phase(LAS unsigned char* lds, const Gemm g, const Sched& S, const Epi& E, int tid_in) {
    const int tid = tid_in, wid = __builtin_amdgcn_readfirstlane(tid >> 6), lane = tid & 63, wr = wid >> 2, wc = wid & 3, fr = lane & 15, fq = lane >> 4;
    const int K = g.K, nt = K / BK;
    unsigned voffA[2], voffB[2];
#pragma unroll
    for (int i = 0; i < 2; ++i) { int R, C; stage_rc(tid * 16 + i * 8192, R, C); const int Rb = Epi::PERM ? ((R & ~31) + perm32(R & 31)) : R;
        voffA[i] = (unsigned)(R * K + C) * 2u; voffB[i] = (unsigned)(Rb * K + C) * 2u; }
    const size_t kstep = (size_t)(BK * 2);
    const size_t hstep = (size_t)HALF * K * 2;
    const size_t tstep = 2 * hstep;
    const unsigned ldsw = (unsigned)wid * 1024u;
    const int aoff = lds_byte(wr * 64 + fr, fq * 8), boff = lds_byte(wc * 32 + fr, fq * 8);
#define PG8_SA(b, h) (((b) * 2 + (h)) * HTB)
#define PG8_SB(b, h) ((4 + (b) * 2 + (h)) * HTB)
#define PG8_STAGE(bufoff, gbase, voff) do { _Pragma("unroll") for (int _i = 0; _i < 2; ++_i) \
        __builtin_amdgcn_global_load_lds((const unsigned*)((const char*)(gbase) + (voff)[_i]), (LAS unsigned*)(lds + (bufoff) + ldsw + _i * 8192), 16, 0, 0); } while (0)
#define PG8_LDA(dst, b, h) do { _Pragma("unroll") for (int m = 0; m < 4; ++m) _Pragma("unroll") for (int k = 0; k < 2; ++k) dst[m][k] = *(const LAS bf16x8*)(lds + PG8_SA(b, h) + aoff + m * 2048 + k * 1024); } while (0)
#define PG8_LDB(dst, b, h) do { _Pragma("unroll") for (int n = 0; n < 2; ++n) _Pragma("unroll") for (int k = 0; k < 2; ++k) dst[n][k] = *(const LAS bf16x8*)(lds + PG8_SB(b, h) + boff + n * 2048 + k * 1024); } while (0)
#define PG8_MMA(ai, bj, At, Bt) do { __builtin_amdgcn_s_setprio(1); _Pragma("unroll") for (int m = 0; m < 4; ++m) _Pragma("unroll") for (int n = 0; n < 2; ++n) _Pragma("unroll") for (int k = 0; k < 2; ++k) \
        acc[ai][bj][m][n] = __builtin_amdgcn_mfma_f32_16x16x32_bf16(Bt[n][k], At[m][k], acc[ai][bj][m][n], 0, 0, 0); __builtin_amdgcn_s_setprio(0); } while (0)
#define PG8_WAIT_V(n) asm volatile("s_waitcnt vmcnt(" #n ")" ::: "memory")
#define PG8_WAIT_L(n) asm volatile("s_waitcnt lgkmcnt(" #n ")" ::: "memory")
#define PG8_BAR __builtin_amdgcn_s_barrier()
#define PG8_SCHED __builtin_amdgcn_sched_barrier(0)
    Unit cur, nxt; int ui = 0;
    if (!S.next(0, cur)) return;
    f32x4 acc[2][2][4][2];
#pragma unroll
    for (int a = 0; a < 2; ++a)
#pragma unroll
        for (int b = 0; b < 2; ++b)
#pragma unroll
            for (int m = 0; m < 4; ++m)
#pragma unroll
                for (int n = 0; n < 2; ++n) acc[a][b][m][n] = (f32x4){0.f, 0.f, 0.f, 0.f};
    bf16x8 At[4][2], B0[2][2], B1[2][2];
    const char* cA = (const char*)g.A + (size_t)cur.pm * tstep; const char* cB = (const char*)g.Bt + (size_t)cur.pn * tstep;
    S.a_ready(cur);
    PG8_STAGE(PG8_SB(0, 0), cB, voffB); PG8_STAGE(PG8_SA(0, 0), cA, voffA); PG8_STAGE(PG8_SB(0, 1), cB + hstep, voffB); PG8_STAGE(PG8_SA(0, 1), cA + hstep, voffA);
    if (wr == 1) PG8_BAR;
    PG8_WAIT_V(4); PG8_BAR;
    PG8_STAGE(PG8_SB(1, 0), cB + kstep, voffB); PG8_STAGE(PG8_SA(1, 0), cA + kstep, voffA); PG8_STAGE(PG8_SB(1, 1), cB + hstep + kstep, voffB);
    PG8_WAIT_V(6); PG8_BAR;
    for (;;) {
        const bool has_next = S.next(ui + 1, nxt);
        const char* nA = has_next ? (const char*)g.A + (size_t)nxt.pm * tstep : cA; const char* nB = has_next ? (const char*)g.Bt + (size_t)nxt.pn * tstep : cB;
        for (int t = 0; t < nt; t += 2) {
            const bool last = (t == nt - 2);
            const char* a1 = cA + (size_t)(t + 1) * kstep;
            const char* a2 = last ? nA : cA + (size_t)(t + 2) * kstep; const char* b2 = last ? nB : cB + (size_t)(t + 2) * kstep;
            const char* a3 = a2 + kstep; const char* b3 = b2 + kstep;
            if (last && has_next) S.a_ready(nxt);
            PG8_LDB(B0, 0, 0); PG8_SCHED; PG8_LDA(At, 0, 0); PG8_STAGE(PG8_SA(1, 1), a1 + hstep, voffA);
            PG8_WAIT_L(8); PG8_BAR; PG8_WAIT_L(0); PG8_MMA(0, 0, At, B0); PG8_BAR; PG8_SCHED;
            PG8_LDB(B1, 0, 1); PG8_STAGE(PG8_SB(0, 0), b2, voffB);
            PG8_BAR; PG8_WAIT_L(0); PG8_MMA(0, 1, At, B1); PG8_BAR;
            PG8_LDA(At, 0, 1); PG8_STAGE(PG8_SA(0, 0), a2, voffA);
            PG8_BAR; PG8_WAIT_L(0); PG8_MMA(1, 0, At, B0); PG8_BAR; PG8_SCHED;
            PG8_STAGE(PG8_SB(0, 1), b2 + hstep, voffB);
            PG8_WAIT_V(6); PG8_BAR; PG8_MMA(1, 1, At, B1); PG8_BAR;
            PG8_LDB(B0, 1, 0); PG8_SCHED; PG8_LDA(At, 1, 0); PG8_STAGE(PG8_SA(0, 1), a2 + hstep, voffA);
            PG8_WAIT_L(8); PG8_BAR; PG8_WAIT_L(0); PG8_MMA(0, 0, At, B0); PG8_BAR; PG8_SCHED;
            PG8_LDB(B1, 1, 1); PG8_STAGE(PG8_SB(1, 0), b3, voffB);
            PG8_BAR; PG8_WAIT_L(0); PG8_MMA(0, 1, At, B1); PG8_BAR;
            PG8_LDA(At, 1, 1); PG8_STAGE(PG8_SA(1, 0), a3, voffA);
            PG8_BAR; PG8_WAIT_L(0); PG8_MMA(1, 0, At, B0); PG8_BAR; PG8_SCHED;
            PG8_STAGE(PG8_SB(1, 1), b3 + hstep, voffB);
            PG8_WAIT_V(6); PG8_BAR; PG8_MMA(1, 1, At, B1); PG8_BAR;
        }
        { const int l2 = opaque((int)__builtin_amdgcn_mbcnt_hi(~0u, __builtin_amdgcn_mbcnt_lo(~0u, 0u))); E(acc, cur, wr, wc, l2 & 15, l2 >> 4); } S.done(cur);
        if (!has_next) break;
#pragma unroll
        for (int a = 0; a < 2; ++a)
#pragma unroll
            for (int b = 0; b < 2; ++b)
#pragma unroll
                for (int m = 0; m < 4; ++m)
#pragma unroll
                    for (int n = 0; n < 2; ++n) acc[a][b][m][n] = (f32x4){0.f, 0.f, 0.f, 0.f};
        cur = nxt; cA = nA; cB = nB; ++ui;
    }
    PG8_WAIT_V(0);
    if (wr == 0) PG8_BAR;
    PG8_BAR;
#undef PG8_SA
#undef PG8_SB
#undef PG8_STAGE
#undef PG8_LDA
#undef PG8_LDB
#undef PG8_MMA
#undef PG8_WAIT_V
#undef PG8_WAIT_L
#undef PG8_BAR
#undef PG8_SCHED
}

template <class F> struct EpiWalk {
    static constexpr bool PERM = true, AFTER_DRAIN = false;
    F f;
    __device__ __forceinline__ void operator()(const f32x4 (&acc)[2][2][4][2], const Unit& u, int wr, int wc, int fr, int fq) const {
#pragma unroll
        for (int ai = 0; ai < 2; ++ai)
#pragma unroll
            for (int m = 0; m < 4; ++m) {
                const int row = u.pm * BM + ai * HALF + wr * 64 + m * 16 + fr;
#pragma unroll
                for (int bj = 0; bj < 2; ++bj) { const int col = u.pn * BM + bj * HALF + wc * 32 + 8 * fq; f.put(row, col, acc[ai][bj][m][0], acc[ai][bj][m][1]); asm volatile("" ::: "memory"); }
            }
    }
};
}

__device__ __forceinline__ u32x4 pack8(const f32x4& a, const f32x4& b) {
    u32x4 w; w.x = cvt_pk_bf16(a[0], a[1]); w.y = cvt_pk_bf16(a[2], a[3]); w.z = cvt_pk_bf16(b[0], b[1]); w.w = cvt_pk_bf16(b[2], b[3]); return w;
}
__device__ __forceinline__ void unpack8(const u32x4 w, float (&o)[8]) {
    o[0] = lo_bf(w.x); o[1] = hi_bf(w.x); o[2] = lo_bf(w.y); o[3] = hi_bf(w.y); o[4] = lo_bf(w.z); o[5] = hi_bf(w.z); o[6] = lo_bf(w.w); o[7] = hi_bf(w.w);
}

struct PutSplit {
    bf16_t* pb;
    __device__ __forceinline__ void put(int row, int col, const f32x4& a, const f32x4& b) const { *(u32x4*)(pb + (size_t)(col >> 8) * BLKE + (size_t)row * 256 + (col & 255)) = pack8(a, b); }
};
struct PutPlain {
    bf16_t* dst; int ldc, ncols;
    __device__ __forceinline__ void put(int row, int col, const f32x4& a, const f32x4& b) const { if (col < ncols) *(u32x4*)(dst + (size_t)row * ldc + col) = pack8(a, b); }
};
struct PutKm {
    bf16_t* km; const bf16_t* kr;
    __device__ __forceinline__ void put(int row, int col, const f32x4& a, const f32x4& b) const {
        const int hd = col >> 6, d = col & 63, bb = row / NTOK, key = row - bb * NTOK;
        bf16_t* dst = km + ((size_t)(bb * 4 + hd) * NTOK + key) * 96;
        *(u32x4*)(dst + d) = pack8(a, b);
        if (d < 32) *(u32x4*)(dst + 64 + d) = *(const u32x4*)(kr + (size_t)row * 32 + d);
    }
};
struct PutVt {
    bf16_t* vt;
    __device__ __forceinline__ void put(int row, int col, const f32x4& a, const f32x4& b) const {
        const int bb = col / NTOK, key = col - bb * NTOK;
        *(u32x4*)(vt + ((size_t)(bb * 4 + (row >> 6)) * 64 + (row & 63)) * NTOK + key) = pack8(a, b);
    }
};
struct PutE {
    bf16_t* e;
    __device__ __forceinline__ void put(int row, int col, const f32x4& a, const f32x4& b) const { *(u32x4*)(e + (size_t)row * 256 + (col & 255)) = pack8(a, b); }
};
struct PutSsmY {
    bf16_t* zs; const bf16_t* ug; const float* dskip;
    __device__ __forceinline__ void put(int row, int col, const f32x4& a, const f32x4& b) const {
        const int g = row / NCHUNK, n = row - g * NCHUNK, c = col & 255, tok = n * 16 + (c >> 4), ho = c & 15, ch = g * 16 + ho;
        float u[8]; unpack8(*(const u32x4*)(ug + ((size_t)g * MROWS + tok) * 16 + ho), u);
        const f32x4 d0 = *(const f32x4*)(dskip + ch), d1 = *(const f32x4*)(dskip + ch + 4);
        f32x4 y0, y1;
#pragma unroll
        for (int i = 0; i < 4; ++i) { y0[i] = gelu_tanh(a[i] + d0[i] * u[i]); y1[i] = gelu_tanh(b[i] + d1[i] * u[4 + i]); }
        *(u32x4*)(zs + (size_t)tok * 256 + ch) = pack8(y0, y1);
    }
};
struct PutGlu {
    bf16_t* cat; const bf16_t* zs; const bf16_t* gate; const float* gb;
    __device__ __forceinline__ void put(int row, int col, const f32x4& a, const f32x4& b) const {
        float z[8], gt[8]; unpack8(*(const u32x4*)(zs + (size_t)row * 256 + col), z); unpack8(*(const u32x4*)(gate + (size_t)row * 256 + col), gt);
        const f32x4 b0 = *(const f32x4*)(gb + col), b1 = *(const f32x4*)(gb + col + 4);
        f32x4 y0, y1;
#pragma unroll
        for (int i = 0; i < 4; ++i) { y0[i] = z[i] * sigmf(a[i] + b0[i]) * siluf(gt[i]); y1[i] = z[4 + i] * sigmf(b[i] + b1[i]) * siluf(gt[4 + i]); }
        *(u32x4*)(cat + (size_t)row * DM + 512 + col) = pack8(y0, y1);
    }
};

struct Params {
    const float* in[36];
    float* out;
    unsigned char* ws;
    int ph_lo, ph_hi;
};
enum { I_X = 0, I_C, I_CTX, I_CCTX, I_WMOD, I_BMOD, I_GPRE, I_GPOST, I_WIN, I_WOUT, I_GCQ, I_WUQ, I_GCKV, I_WUKV, I_GQ, I_GK,
       I_LRE, I_LIM, I_LSTEP, I_BRE, I_BIM, I_CRE, I_CIM, I_SSMD, I_GLUW, I_GLUB, I_HCW, I_HCB, I_HW1, I_HB1, I_HF1, I_HW2, I_HB2, I_HF2, I_HW3, I_HBIAS };

typedef __attribute__((address_space(4))) const unsigned long long* kargp_t;
struct Ctx {
    LAS unsigned char* lds;
    kargp_t ka;
    unsigned char* ws;
    int tid, lane, wave, G, bid;
};
#define GAS __attribute__((address_space(1)))
#define KIN(i) ((const float*)(GAS const float*)c.ka[(i)])
#define KOUT() ((float*)(GAS float*)c.ka[36])
template <class T> __device__ __forceinline__ T* wsp(const Ctx& c, size_t off) { return (T*)(c.ws + off); }

__device__ __forceinline__ int wmap(int kind, int n) {
    if (kind == 0) { if (n < 192) return n; if (n < 224) return 320 + (n - 192); if (n < 256) return -1; if (n < 384) return 192 + (n - 256); if (n < 512) return -1; return n - 160; }
    if (kind == 2) return (n >> 6) * 128 + (n & 63);
    if (kind == 3) return (n >> 6) * 128 + 64 + (n & 63);
    return n;
}
__device__ __forceinline__ void wconv_tile(const Ctx& c, const float* src, int Ks, int Ns, int Nlim, bf16_t* dst, int Kp, int kind, int nt, int kt) {
    LAS float* T = (LAS float*)c.lds;
    const int n0 = nt * 64, k0 = kt * 64;
    for (int e = c.tid; e < 4096; e += 512) { const int kk = e >> 6, nn = e & 63, k = k0 + kk, n = n0 + nn; const int sc = (n < Nlim) ? wmap(kind, n) : -1;
        T[kk * 65 + nn] = (k < Ks && sc >= 0) ? src[(size_t)k * Ns + sc] : 0.f; }
    __syncthreads();
    for (int e = c.tid; e < 4096; e += 512) { const int nn = e >> 6, kk = e & 63; dst[(size_t)(n0 + nn) * Kp + k0 + kk] = f2bf(T[kk * 65 + nn]); }
    __syncthreads();
}

__device__ __forceinline__ void modv_job(const Ctx& c, int job) {
    const int l = job / 48, j0 = (job % 48) * 64;
    LAS float* sc = (LAS float*)c.lds;
    LAS float* red = sc + 17 * 1024;
    const float* cv = KIN(I_C); const float* cc = KIN(I_CCTX);
    for (int e = c.tid; e < 17 * 1024; e += 512) { const int r = e >> 10, k = e & 1023; const float v = (r < 16) ? cv[r * 1024 + k] : cc[k]; sc[e] = siluf(v); }
    __syncthreads();
    const int col = c.tid & 63, ks = c.tid >> 6;
    const float* w = KIN(I_WMOD) + (size_t)l * 1024 * 3072 + j0 + col;
    float acc[17];
#pragma unroll
    for (int r = 0; r < 17; ++r) acc[r] = 0.f;
    for (int k = ks * 128; k < ks * 128 + 128; ++k) { const float wv = w[(size_t)k * 3072];
#pragma unroll
        for (int r = 0; r < 17; ++r) acc[r] += sc[r * 1024 + k] * wv; }
#pragma unroll
    for (int r = 0; r < 17; ++r) red[(ks * 17 + r) * 64 + col] = acc[r];
    __syncthreads();
    float* mv = wsp<float>(c, WS_MODV);
    for (int e = c.tid; e < 17 * 64; e += 512) { const int r = e >> 6, cl = e & 63; float s = KIN(I_BMOD)[l * 3072 + j0 + cl];
#pragma unroll
        for (int q = 0; q < 8; ++q) s += red[(q * 17 + r) * 64 + cl];
        mv[((size_t)l * 17 + r) * 3072 + j0 + cl] = s; }
    __syncthreads();
}

__device__ __forceinline__ void rope_job(const Ctx& c) {
    float* rg = wsp<float>(c, WS_ROPEG); float* rm = wsp<float>(c, WS_ROPEM);
    for (int e = c.tid; e < 64 * 16; e += 512) { const int pos = e >> 4, f = e & 15; const float inv = powf(10000.f, -(float)(2 * f) / 32.f); const float a = (float)pos * inv; rg[e * 2] = cosf(a); rg[e * 2 + 1] = sinf(a); }
    for (int e = c.tid; e < 64 * 8; e += 512) { const int pos = e >> 3, f = e & 7; const float inv = powf(10000.f, -(float)(2 * f) / 16.f); const float a = (float)pos * inv; rm[e * 2] = cosf(a); rm[e * 2 + 1] = sinf(a); }
}

typedef float cpx __attribute__((ext_vector_type(2)));
#define CPX(a, b) ((cpx){(a), (b)})
__device__ __forceinline__ cpx cmul(cpx a, cpx b) { return CPX(a.x * b.x - a.y * b.y, a.x * b.y + a.y * b.x); }
__device__ __forceinline__ void ssm_tables_job(const Ctx& c, int job) {
    const int l = job >> 4, g = job & 15;
    LAS cpx* apow = (LAS cpx*)c.lds;
    LAS cpx* bbar = apow + 2 * 17 * 64;
    LAS cpx* cm = bbar + 2 * 64 * 16;
    LAS float* Kc = (LAS float*)(cm + 2 * 16 * 64);
    for (int e = c.tid; e < 2 * 64; e += 512) {
        const int d = e >> 6, p = e & 63; const size_t ix = (((size_t)l * 2 + d) * 16 + g) * 64 + p;
        const float lr = KIN(I_LRE)[ix], li = KIN(I_LIM)[ix], st = expf(KIN(I_LSTEP)[((size_t)l * 2 + d) * 16 + g]);
        for (int k = 0; k <= 16; ++k) { const float m = expf(lr * st * (float)k), an = li * st * (float)k; apow[(d * 17 + k) * 64 + p] = CPX(m * cosf(an), m * sinf(an)); }
    }
    __syncthreads();
    for (int e = c.tid; e < 2 * 64 * 16; e += 512) {
        const int d = e >> 10, p = (e >> 4) & 63, h = e & 15; const size_t ix = (((size_t)l * 2 + d) * 16 + g) * 64 + p;
        const float lr = KIN(I_LRE)[ix], li = KIN(I_LIM)[ix];
        const cpx a = apow[(d * 17 + 1) * 64 + p]; const cpx am1 = CPX(a.x - 1.f, a.y);
        const float den = lr * lr + li * li; const cpx q = CPX((am1.x * lr + am1.y * li) / den, (am1.y * lr - am1.x * li) / den);
        const cpx b = CPX(KIN(I_BRE)[ix * 16 + h], KIN(I_BIM)[ix * 16 + h]);
        bbar[e] = cmul(q, b);
        const size_t cx = ((((size_t)l * 2 + d) * 16 + g) * 16 + h) * 64 + p;
        cm[(d * 16 + h) * 64 + p] = CPX(KIN(I_CRE)[cx], KIN(I_CIM)[cx]);
    }
    __syncthreads();
    for (int e = c.tid; e < 2 * 16 * 256; e += 512) {
        const int d = e >> 12, dd = (e >> 8) & 15, ho = (e >> 4) & 15, hi = e & 15; float s = 0.f;
        for (int p = 0; p < 64; ++p) { const cpx w = cmul(cm[(d * 16 + ho) * 64 + p], apow[(d * 17 + dd) * 64 + p]); const cpx b = bbar[(d * 64 + p) * 16 + hi]; s += w.x * b.x - w.y * b.y; }
        Kc[e] = s;
    }
    __syncthreads();
    bf16_t* wkc = wsp<bf16_t>(c, WS_WKC) + ((size_t)l * 16 + g) * 256 * 512;
    for (int e = c.tid; e < 256 * 512; e += 512) {
        const int r = e >> 9, q = e & 511, i = r >> 4, ho = r & 15; float v;
        if (q < 256) { const int j = q >> 4, hi = q & 15; v = 0.f; if (j <= i) v += Kc[((0 * 16 + (i - j)) * 16 + ho) * 16 + hi]; if (j >= i) v += Kc[((1 * 16 + (j - i)) * 16 + ho) * 16 + hi]; }
        else { const int qq = q - 256, dq = qq >> 7, comp = (qq >> 6) & 1, p = qq & 63, k = dq == 0 ? i + 1 : 16 - i; const cpx w = cmul(cm[(dq * 16 + ho) * 64 + p], apow[(dq * 17 + k) * 64 + p]); v = comp == 0 ? w.x : -w.y; }
        wkc[e] = f2bf(v);
    }
    bf16_t* we = wsp<bf16_t>(c, WS_WE) + ((size_t)l * 16 + g) * 256 * 256;
    for (int e = c.tid; e < 256 * 256; e += 512) {
        const int qq = e >> 8, cidx = e & 255, j = cidx >> 4, hi = cidx & 15, dq = qq >> 7, comp = (qq >> 6) & 1, p = qq & 63, k = dq == 0 ? 15 - j : j;
        const cpx w = cmul(apow[(dq * 17 + k) * 64 + p], bbar[(dq * 64 + p) * 16 + hi]);
        we[e] = f2bf(comp == 0 ? w.x : w.y);
    }
    float* a16 = wsp<float>(c, WS_A16);
    for (int e = c.tid; e < 128; e += 512) { const int d = e >> 6, p = e & 63; const cpx a = apow[(d * 17 + 16) * 64 + p]; const size_t ix = ((((size_t)l * 2 + d) * 16 + g) * 64 + p) * 2; a16[ix] = a.x; a16[ix + 1] = a.y; }
    __syncthreads();
}

__device__ __forceinline__ void hyena_mlp_job(const Ctx& c, int job) {
    const int l = job / 136, tt = job % 136;
    const bool isctx = tt >= 128; const int n = isctx ? CTXL : SEQL; const int t0 = isctx ? (tt - 128) * 32 : tt * 32;
    LAS float* z = (LAS float*)c.lds;
    LAS float* h1 = z + 32 * 36;
    LAS float* h2 = h1 + 32 * 64;
    for (int e = c.tid; e < 32 * 33; e += 512) {
        const int ti = e / 33, f = e % 33, t = t0 + ti; float v;
        if (f == 0) v = (float)t / (float)(n - 1);
        else { const int k = (f - 1) & 15; const float band = 1e-4f + (float)k * ((15.f - 1e-4f) / 15.f); const float om = 6.283185307179586f * (float)t / (float)n; v = (f <= 16) ? cosf(band * om) : -sinf(band * om); }
        z[ti * 36 + f] = v;
    }
    __syncthreads();
    for (int e = c.tid; e < 32 * 64; e += 512) {
        const int ti = e >> 6, j = e & 63; float s = KIN(I_HB1)[l * 64 + j];
        for (int f = 0; f < 33; ++f) s += z[ti * 36 + f] * KIN(I_HW1)[((size_t)l * 33 + f) * 64 + j];
        h1[e] = sinf(KIN(I_HF1)[l * 64 + j] * s);
    }
    __syncthreads();
    for (int e = c.tid; e < 32 * 64; e += 512) {
        const int ti = e >> 6, j = e & 63; float s = KIN(I_HB2)[l * 64 + j];
        for (int f = 0; f < 64; ++f) s += h1[ti * 64 + f] * KIN(I_HW2)[((size_t)l * 64 + f) * 64 + j];
        h2[e] = sinf(KIN(I_HF2)[l * 64 + j] * s);
    }
    __syncthreads();
    float* hT = wsp<float>(c, WS_HT) + (size_t)l * 1024 * NTOK;
    const float mind = -3.070113457325394f, maxd = -15.35056728662697f;
#pragma unroll
    for (int cc = 0; cc < 2; ++cc) {
        const int col = c.tid + cc * 512;
        float acc[32];
#pragma unroll
        for (int ti = 0; ti < 32; ++ti) acc[ti] = 0.f;
        for (int f = 0; f < 64; ++f) { const float w = KIN(I_HW3)[((size_t)l * 64 + f) * 1024 + col];
#pragma unroll
            for (int ti = 0; ti < 32; ++ti) acc[ti] += h2[ti * 64 + f] * w; }
        const int ch = col & 255; const float delta = fabsf(mind + (maxd - mind) * (float)ch / 255.f);
        float* dst = hT + (size_t)col * NTOK + (isctx ? SEQL : 0) + t0;
#pragma unroll
        for (int ti = 0; ti < 32; ++ti) { const float tn = (float)(t0 + ti) / (float)(n - 1); dst[ti] = acc[ti] * expf(-tn * delta); }
    }
    __syncthreads();
}

__device__ __forceinline__ void hyena_pack_job(const Ctx& c, int job) {
    const int l = job >> 9, o = (job >> 8) & 1, ch = job & 255;
    const float* hT = wsp<float>(c, WS_HT) + (size_t)l * 1024 * NTOK;
    const float* fw = hT + (size_t)(o * 512 + ch) * NTOK; const float* bw = hT + (size_t)(o * 512 + 256 + ch) * NTOK;
    LAS float* red = (LAS float*)c.lds;
    float s0 = 0.f, s1 = 0.f;
    for (int t = c.tid; t < SEQL; t += 512) { const float a = fw[t], b = bw[t]; s0 += a * a + b * b; }
    if (c.tid < CTXL) { const float a = fw[SEQL + c.tid], b = bw[SEQL + c.tid]; s1 = a * a + b * b; }
    s0 = wave_sum(s0); s1 = wave_sum(s1);
    if (c.lane == 0) { red[c.wave] = s0; red[8 + c.wave] = s1; }
    __syncthreads();
    float t0 = 0.f, t1 = 0.f;
#pragma unroll
    for (int w = 0; w < 8; ++w) { t0 += red[w]; t1 += red[8 + w]; }
    const float r0 = rsqrtf(t0 + EPS), r1 = rsqrtf(t1 + EPS);
    bf16_t* gr = wsp<bf16_t>(c, WS_GR) + (((size_t)l * 2 + o) * 256 + ch) * 8192;
    for (int e = c.tid; e < 8192; e += 512) { float v; if (e <= 4095) v = fw[4095 - e]; else if (e < 8191) v = bw[e - 4095]; else v = 0.f; gr[e] = f2bf(v * r0); }
    bf16_t* grc = wsp<bf16_t>(c, WS_GRC) + (((size_t)l * 2 + o) * 256 + ch) * 512;
    { const int e = c.tid; float v; if (e <= 255) v = fw[SEQL + 255 - e]; else if (e < 511) v = bw[SEQL + e - 255]; else v = 0.f; grc[e] = f2bf(v * r1); }
    __syncthreads();
}

__device__ __forceinline__ void norm_rows(const Ctx& c, int l  , int next  ) {
    const float* mvl = wsp<float>(c, WS_MODV) + (size_t)(l < 0 ? 0 : l) * 17 * 3072;
    const float* mvn = wsp<float>(c, WS_MODV) + (size_t)(next < 0 ? 0 : next) * 17 * 3072;
    const bf16_t* outb = wsp<bf16_t>(c, WS_OUTB);
    bf16_t* hb = wsp<bf16_t>(c, WS_HCAT);
    float* ctxr = wsp<float>(c, WS_CTXR);
    const int nw = c.G * 8;
    for (int row = c.bid * 8 + c.wave; row < MROWS; row += nw) {
        const int b = row / NTOK, j = row - b * NTOK; const bool isctx = j >= SEQL;
        if (next < 0 && isctx) continue;
        const int mr = isctx ? 16 : b;
        const float* xin; float* xout;
        if (isctx) { xout = ctxr + ((size_t)b * CTXL + (j - SEQL)) * DM; xin = (l < 0) ? KIN(I_CTX) + ((size_t)b * CTXL + (j - SEQL)) * DM : xout; }
        else { xout = KOUT() + ((size_t)b * SEQL + j) * DM; xin = (l <= 0) ? KIN(I_X) + ((size_t)b * SEQL + j) * DM : xout; }
        f32x4 xv[4];
#pragma unroll
        for (int q = 0; q < 4; ++q) xv[q] = *(const f32x4*)(xin + q * 256 + c.lane * 4);
        if (l >= 0) {
            float ov[16]; float ss = 0.f;
#pragma unroll
            for (int q = 0; q < 4; ++q) { const u32x2 w = *(const u32x2*)(outb + (size_t)row * DM + q * 256 + c.lane * 4); ov[q * 4] = lo_bf(w.x); ov[q * 4 + 1] = hi_bf(w.x); ov[q * 4 + 2] = lo_bf(w.y); ov[q * 4 + 3] = hi_bf(w.y); }
#pragma unroll
            for (int i = 0; i < 16; ++i) ss += ov[i] * ov[i];
            ss = wave_sum(ss); const float rs = rsqrtf(ss * (1.f / DM) + EPS);
#pragma unroll
            for (int q = 0; q < 4; ++q) { const int col = q * 256 + c.lane * 4; const f32x4 gp = *(const f32x4*)(KIN(I_GPOST) + l * DM + col); const f32x4 gt = *(const f32x4*)(mvl + mr * 3072 + 2048 + col);
#pragma unroll
                for (int i = 0; i < 4; ++i) xv[q][i] += gt[i] * (ov[q * 4 + i] * rs * gp[i]); }
        }
        if (l >= 0 || isctx) {
#pragma unroll
            for (int q = 0; q < 4; ++q) *(f32x4*)(xout + q * 256 + c.lane * 4) = xv[q];
        }
        if (next >= 0) {
            float ss = 0.f;
#pragma unroll
            for (int q = 0; q < 4; ++q)
#pragma unroll
                for (int i = 0; i < 4; ++i) ss += xv[q][i] * xv[q][i];
            ss = wave_sum(ss); const float rs = rsqrtf(ss * (1.f / DM) + EPS);
#pragma unroll
            for (int q = 0; q < 4; ++q) { const int col = q * 256 + c.lane * 4; const f32x4 gp = *(const f32x4*)(KIN(I_GPRE) + next * DM + col);
                const f32x4 sh = *(const f32x4*)(mvn + mr * 3072 + col), sc = *(const f32x4*)(mvn + mr * 3072 + 1024 + col);
                float hv[4];
#pragma unroll
                for (int i = 0; i < 4; ++i) hv[i] = xv[q][i] * rs * gp[i] * (1.f + sc[i]) + sh[i];
                u32x2 w; w.x = cvt_pk_bf16(hv[0], hv[1]); w.y = cvt_pk_bf16(hv[2], hv[3]); *(u32x2*)(hb + (size_t)row * DM + col) = w; }
        }
    }
}

__device__ __forceinline__ void p2_rows(const Ctx& c, int l) {
    bf16_t* pb = wsp<bf16_t>(c, WS_PB);
    bf16_t* B0 = pb; bf16_t* B1 = pb + BLKE; bf16_t* B3 = pb + 3 * BLKE; const bf16_t* B4 = pb + 4 * BLKE; const bf16_t* B6 = pb + 6 * BLKE;
    bf16_t* kr = wsp<bf16_t>(c, WS_KR); bf16_t* kg = wsp<bf16_t>(c, WS_KG); bf16_t* ug = wsp<bf16_t>(c, WS_UG); bf16_t* us = wsp<bf16_t>(c, WS_US);
    const float* ropeG = wsp<float>(c, WS_ROPEG); const float* ropeM = wsp<float>(c, WS_ROPEM);
    const int lane = c.lane;
    for (int row = c.bid * 8 + c.wave; row < MROWS; row += c.G * 8) {
        const int b = row / NTOK, j = row - b * NTOK; const bool islat = j < SEQL; const int rowpos = (j >> 6) & 63, colpos = j & 63;
        const size_t ro = (size_t)row * 256 + lane * 4;
        {
            const u32x2 w = *(const u32x2*)(B0 + ro); float x[4] = {lo_bf(w.x), hi_bf(w.x), lo_bf(w.y), hi_bf(w.y)};
            float ss = (lane < 48) ? (x[0] * x[0] + x[1] * x[1] + x[2] * x[2] + x[3] * x[3]) : 0.f; ss = wave_sum(ss);
            const float rs = rsqrtf(ss * (1.f / 192.f) + EPS);
            float xp[4];
#pragma unroll
            for (int i = 0; i < 4; ++i) xp[i] = __shfl_xor(x[i], 2);
            u32x2 o; o.x = 0u; o.y = 0u;
            if (lane < 48) { const f32x4 g = *(const f32x4*)(KIN(I_GCQ) + l * 192 + lane * 4); o.x = cvt_pk_bf16(x[0] * rs * g[0], x[1] * rs * g[1]); o.y = cvt_pk_bf16(x[2] * rs * g[2], x[3] * rs * g[3]); }
            else if (lane < 56) {
                const int t = lane - 48; float y[4];
                if (islat) { const int pos = (t & 4) ? colpos : rowpos; const bool isx2 = (t & 2) != 0;
#pragma unroll
                    for (int i = 0; i < 4; ++i) { const int f = 4 * (t & 1) + i; const float cs = ropeM[(pos * 8 + f) * 2], sn = ropeM[(pos * 8 + f) * 2 + 1]; y[i] = isx2 ? (xp[i] * sn + x[i] * cs) : (x[i] * cs - xp[i] * sn); } }
                else {
#pragma unroll
                    for (int i = 0; i < 4; ++i) y[i] = x[i]; }
                u32x2 kk; kk.x = cvt_pk_bf16(y[0], y[1]); kk.y = cvt_pk_bf16(y[2], y[3]); *(u32x2*)(kr + (size_t)row * 32 + t * 4) = kk;
            }
            *(u32x2*)(B0 + ro) = o;
        }
        {
            const u32x2 w = *(const u32x2*)(B1 + ro); float x[4] = {lo_bf(w.x), hi_bf(w.x), lo_bf(w.y), hi_bf(w.y)};
            float ss = (lane < 32) ? (x[0] * x[0] + x[1] * x[1] + x[2] * x[2] + x[3] * x[3]) : 0.f; ss = wave_sum(ss);
            const float rs = rsqrtf(ss * (1.f / 128.f) + EPS);
            u32x2 o; o.x = 0u; o.y = 0u;
            if (lane < 32) { const f32x4 g = *(const f32x4*)(KIN(I_GCKV) + l * 128 + lane * 4); o.x = cvt_pk_bf16(x[0] * rs * g[0], x[1] * rs * g[1]); o.y = cvt_pk_bf16(x[2] * rs * g[2], x[3] * rs * g[3]); }
            *(u32x2*)(B1 + ro) = o;
        }
#pragma unroll
        for (int which = 0; which < 2; ++which) {
            const bf16_t* src = which == 0 ? B3 : B4;
            const u32x2 w = *(const u32x2*)(src + ro); float x[4] = {lo_bf(w.x), hi_bf(w.x), lo_bf(w.y), hi_bf(w.y)};
            float ss = x[0] * x[0] + x[1] * x[1] + x[2] * x[2] + x[3] * x[3];
            ss += __shfl_xor(ss, 1); ss += __shfl_xor(ss, 2); ss += __shfl_xor(ss, 4); ss += __shfl_xor(ss, 8);
            const float rs = rsqrtf(ss * (1.f / 64.f) + EPS);
            const int t = lane & 15; const f32x4 g = *(const f32x4*)(KIN(which == 0 ? I_GQ : I_GK) + l * 64 + t * 4);
#pragma unroll
            for (int i = 0; i < 4; ++i) x[i] = x[i] * rs * g[i];
            float xp[4];
#pragma unroll
            for (int i = 0; i < 4; ++i) xp[i] = __shfl_xor(x[i], 4);
            if (islat) { const int pos = (t & 8) ? colpos : rowpos; const bool isx2 = (t & 4) != 0;
#pragma unroll
                for (int i = 0; i < 4; ++i) { const int f = 4 * (t & 3) + i; const float cs = ropeG[(pos * 16 + f) * 2], sn = ropeG[(pos * 16 + f) * 2 + 1]; x[i] = isx2 ? (xp[i] * sn + x[i] * cs) : (x[i] * cs - xp[i] * sn); } }
            if (which == 0) { const float qs = 0.125f * LOG2E; u32x2 o; o.x = cvt_pk_bf16(x[0] * qs, x[1] * qs); o.y = cvt_pk_bf16(x[2] * qs, x[3] * qs); *(u32x2*)(B3 + ro) = o; }
            else if (lane < 32) { u32x2 o; o.x = cvt_pk_bf16(x[0], x[1]); o.y = cvt_pk_bf16(x[2], x[3]); *(u32x2*)(kg + ((size_t)(b * 2 + (lane >> 4)) * NTOK + j) * 64 + t * 4) = o; }
        }
        {
            const u32x2 w = *(const u32x2*)(B6 + ro); const int g = lane >> 2, hi0 = (lane & 3) * 4;
            *(u32x2*)(ug + ((size_t)g * MROWS + row) * 16 + hi0) = w;
            *(u32x2*)(us + ((size_t)g * NCHUNK + (row >> 4)) * 512 + (row & 15) * 16 + hi0) = w;
        }
    }
}
__device__ __forceinline__ void p2_tiles(const Ctx& c, int l) {
    const bf16_t* pb = wsp<bf16_t>(c, WS_PB);
    bf16_t* vtg = wsp<bf16_t>(c, WS_VTG);
    LAS bf16_t* T = (LAS bf16_t*)c.lds;
    LAS unsigned* T32 = (LAS unsigned*)c.lds;
    const int piece = c.tid & 7, chl = c.tid >> 3;
    for (int tl = c.bid; tl < NB * 68; tl += c.G) {
        const int b = tl / 68, jt = tl - b * 68, j0 = jt * 64; const int lo = jt < 64 ? 0 : SEQL, hi = jt < 64 ? SEQL : NTOK;
        const size_t rbase = (size_t)b * NTOK;
        for (int e = c.tid; e < 64 * 16; e += 512) { const int r = e >> 4, pc = e & 15; const u32x4 w = *(const u32x4*)(pb + 4 * BLKE + (rbase + j0 + r) * 256 + 128 + pc * 8);
            LAS unsigned* d = T32 + (r * 516 + pc * 16) / 4; d[0] = w.x; d[1] = w.y; d[2] = w.z; d[3] = w.w; }
        __syncthreads();
#pragma unroll
        for (int ps = 0; ps < 2; ++ps) { const int dvf = chl + ps * 64; float v[8];
#pragma unroll
            for (int i = 0; i < 8; ++i) v[i] = bf2f(T[(piece * 8 + i) * 258 + dvf]);
            u32x4 w; w.x = cvt_pk_bf16(v[0], v[1]); w.y = cvt_pk_bf16(v[2], v[3]); w.z = cvt_pk_bf16(v[4], v[5]); w.w = cvt_pk_bf16(v[6], v[7]);
            *(u32x4*)(vtg + ((size_t)(b * 2 + (dvf >> 6)) * 64 + (dvf & 63)) * NTOK + j0 + piece * 8) = w; }
        __syncthreads();
        for (int blk = 8; blk < 12; ++blk) {
            for (int e = c.tid; e < 66 * 32; e += 512) { const int r = e >> 5, pc = e & 31, j = j0 - 1 + r; u32x4 w = {0u, 0u, 0u, 0u};
                if (j >= lo && j < hi) w = *(const u32x4*)(pb + (size_t)blk * BLKE + (rbase + j) * 256 + pc * 8);
                LAS unsigned* d = T32 + (r * 516 + pc * 16) / 4; d[0] = w.x; d[1] = w.y; d[2] = w.z; d[3] = w.w; }
            __syncthreads();
            bf16_t* dst = wsp<bf16_t>(c, blk == 8 ? WS_HYV : blk == 9 ? WS_HYX1 : blk == 10 ? WS_HYX2 : WS_HYG);
#pragma unroll
            for (int ps = 0; ps < 4; ++ps) { const int ch = chl + ps * 64; float v[8];
                if (blk < 11) { const int cc = (blk - 8) * 256 + ch; const float w0 = KIN(I_HCW)[((size_t)l * 3 + 0) * 768 + cc], w1 = KIN(I_HCW)[((size_t)l * 3 + 1) * 768 + cc], w2 = KIN(I_HCW)[((size_t)l * 3 + 2) * 768 + cc], bs = KIN(I_HCB)[l * 768 + cc];
                    float xm = bf2f(T[(piece * 8) * 258 + ch]), x0 = bf2f(T[(piece * 8 + 1) * 258 + ch]);
#pragma unroll
                    for (int i = 0; i < 8; ++i) { const float x1 = bf2f(T[(piece * 8 + i + 2) * 258 + ch]); v[i] = w0 * xm + w1 * x0 + w2 * x1 + bs; xm = x0; x0 = x1; } }
                else {
#pragma unroll
                    for (int i = 0; i < 8; ++i) v[i] = siluf(bf2f(T[(piece * 8 + i + 1) * 258 + ch])); }
                u32x4 w; w.x = cvt_pk_bf16(v[0], v[1]); w.y = cvt_pk_bf16(v[2], v[3]); w.z = cvt_pk_bf16(v[4], v[5]); w.w = cvt_pk_bf16(v[6], v[7]);
                *(u32x4*)(dst + ((size_t)ch * 16 + b) * NTOK + j0 + piece * 8) = w; }
            __syncthreads();
        }
    }
}

template <int DK>
__device__ __forceinline__ void attn_unit(const Ctx& c, const bf16_t* Qp, int qpitch, const bf16_t* Kp, const bf16_t* Vtp, int kt0, int nkt,
                                          const bf16_t* gatep, bf16_t* outp, bool rope, int j0, float qscale, const float* ropeM) {
    constexpr int KS = DK / 16, KPC = DK / 8, KPITCH = DK * 2 + 16, KB = 64 * KPITCH, VPITCH = 136, VB = 64 * VPITCH, BUFB = KB + VB;
    static_assert(BUFB % 16 == 0, "attention LDS buffer alignment");
    const int tid = c.tid, lane = c.lane, q = lane & 31, h = lane >> 5, wave = c.wave;
    LAS unsigned char* lds = c.lds;
    bf16x8 qf[KS];
    {
        const bf16_t* qrow = Qp + (size_t)(wave * 32 + q) * qpitch + 8 * h;
#pragma unroll
        for (int ks = 0; ks < KS; ++ks) qf[ks] = *(const bf16x8*)(qrow + 16 * ks);
        if (DK == 96) {
            const int jj = j0 + wave * 32 + q;
#pragma unroll
            for (int ks = 0; ks < KS; ++ks) {
                float x[8]; unpack8(__builtin_bit_cast(u32x4, qf[ks]), x);
                if (ks >= 4) {
                    const int pos = (ks == 4) ? ((jj >> 6) & 63) : (jj & 63);
#pragma unroll
                    for (int e = 0; e < 8; ++e) { const float xp = __shfl_xor(x[e], 32); const float cs = ropeM[(pos * 8 + e) * 2], sn = ropeM[(pos * 8 + e) * 2 + 1];
                        const float r = h ? (xp * sn + x[e] * cs) : (x[e] * cs - xp * sn); x[e] = rope ? r : x[e]; }
                }
                u32x4 w; w.x = cvt_pk_bf16(x[0] * qscale, x[1] * qscale); w.y = cvt_pk_bf16(x[2] * qscale, x[3] * qscale); w.z = cvt_pk_bf16(x[4] * qscale, x[5] * qscale); w.w = cvt_pk_bf16(x[6] * qscale, x[7] * qscale);
                qf[ks] = __builtin_bit_cast(bf16x8, w);
            }
        }
    }
    f32x16 o0, o1;
#pragma unroll
    for (int i = 0; i < 16; ++i) { o0[i] = 0.f; o1[i] = 0.f; }
    float mrun = -1e30f, lrun = 0.f;
    const int kr0 = tid / KPC, kp0 = tid % KPC, kr1 = (tid + 512) / KPC, kp1 = (tid + 512) % KPC; const bool has2 = (DK == 96) && tid < 256;
    const int vdv = tid >> 3, vpc = tid & 7;
    u32x4 kreg0, kreg1 = {0u, 0u, 0u, 0u}, vreg;
#define AT_GLOAD(kt) do { const size_t key0 = (size_t)(kt) * 64; kreg0 = *(const u32x4*)(Kp + (key0 + kr0) * DK + kp0 * 8); if (has2) kreg1 = *(const u32x4*)(Kp + (key0 + kr1) * DK + kp1 * 8); \
        vreg = *(const u32x4*)(Vtp + (size_t)vdv * NTOK + key0 + vpc * 8); } while (0)
#define AT_LWRITE(bi) do { LAS unsigned char* bb = lds + (bi) * BUFB; *(LAS u32x4*)(bb + kr0 * KPITCH + kp0 * 16) = kreg0; if (has2) *(LAS u32x4*)(bb + kr1 * KPITCH + kp1 * 16) = kreg1; \
        LAS u32x2* vd = (LAS u32x2*)(bb + KB + vdv * VPITCH + vpc * 16); vd[0] = (u32x2){vreg.x, vreg.y}; vd[1] = (u32x2){vreg.z, vreg.w}; } while (0)
    AT_GLOAD(kt0); AT_LWRITE(0);
    __syncthreads();
    for (int t = 0; t < nkt; ++t) {
        const bool more = (t + 1 < nkt);
        if (more) AT_GLOAD(kt0 + t + 1);
        const LAS unsigned char* kb = lds + (t & 1) * BUFB;
        f32x16 s0, s1;
#pragma unroll
        for (int i = 0; i < 16; ++i) { s0[i] = 0.f; s1[i] = 0.f; }
#pragma unroll
        for (int ks = 0; ks < KS; ++ks) {
            const bf16x8 a0 = *(const LAS bf16x8*)(kb + q * KPITCH + (16 * ks + 8 * h) * 2);
            const bf16x8 a1 = *(const LAS bf16x8*)(kb + (32 + q) * KPITCH + (16 * ks + 8 * h) * 2);
            s0 = __builtin_amdgcn_mfma_f32_32x32x16_bf16(a0, qf[ks], s0, 0, 0, 0);
            s1 = __builtin_amdgcn_mfma_f32_32x32x16_bf16(a1, qf[ks], s1, 0, 0, 0);
        }
        float mx = fmaxf(s0[0], s1[0]);
#pragma unroll
        for (int i = 1; i < 16; ++i) mx = fmaxf(mx, fmaxf(s0[i], s1[i]));
        mx = fmaxf(mx, __shfl_xor(mx, 32));
        const float mnew = fmaxf(mrun, mx), alpha = __builtin_amdgcn_exp2f(mrun - mnew); mrun = mnew;
        float ps = 0.f;
#pragma unroll
        for (int i = 0; i < 16; ++i) { s0[i] = __builtin_amdgcn_exp2f(s0[i] - mnew); s1[i] = __builtin_amdgcn_exp2f(s1[i] - mnew); ps += s0[i] + s1[i]; }
        lrun = lrun * alpha + ps;
#pragma unroll
        for (int i = 0; i < 16; ++i) { o0[i] *= alpha; o1[i] *= alpha; }
        bf16x8 pk[4];
#pragma unroll
        for (int st = 0; st < 4; ++st) { u32x4 w;
            if (st < 2) { w.x = cvt_pk_bf16(s0[8 * st], s0[8 * st + 1]); w.y = cvt_pk_bf16(s0[8 * st + 2], s0[8 * st + 3]); w.z = cvt_pk_bf16(s0[8 * st + 4], s0[8 * st + 5]); w.w = cvt_pk_bf16(s0[8 * st + 6], s0[8 * st + 7]); }
            else { const int b8 = 8 * (st - 2); w.x = cvt_pk_bf16(s1[b8], s1[b8 + 1]); w.y = cvt_pk_bf16(s1[b8 + 2], s1[b8 + 3]); w.z = cvt_pk_bf16(s1[b8 + 4], s1[b8 + 5]); w.w = cvt_pk_bf16(s1[b8 + 6], s1[b8 + 7]); }
            pk[st] = __builtin_bit_cast(bf16x8, w); }
        const LAS unsigned char* vb = kb + KB;
#pragma unroll
        for (int st = 0; st < 4; ++st) {
            const LAS unsigned char* a0p = vb + q * VPITCH + (16 * st + 4 * h) * 2;
            const LAS unsigned char* a1p = vb + (32 + q) * VPITCH + (16 * st + 4 * h) * 2;
            const u32x2 l0 = *(const LAS u32x2*)a0p, h0 = *(const LAS u32x2*)(a0p + 16), l1 = *(const LAS u32x2*)a1p, h1 = *(const LAS u32x2*)(a1p + 16);
            const bf16x8 va0 = __builtin_bit_cast(bf16x8, (u32x4){l0.x, l0.y, h0.x, h0.y}), va1 = __builtin_bit_cast(bf16x8, (u32x4){l1.x, l1.y, h1.x, h1.y});
            o0 = __builtin_amdgcn_mfma_f32_32x32x16_bf16(va0, pk[st], o0, 0, 0, 0);
            o1 = __builtin_amdgcn_mfma_f32_32x32x16_bf16(va1, pk[st], o1, 0, 0, 0);
        }
        if (more) AT_LWRITE((t + 1) & 1);
        __syncthreads();
    }
#undef AT_GLOAD
#undef AT_LWRITE
    const float lt = lrun + __shfl_xor(lrun, 32), inv = 1.f / lt;
    const size_t row = (size_t)(wave * 32 + q);
#pragma unroll
    for (int dt = 0; dt < 2; ++dt)
#pragma unroll
        for (int g4 = 0; g4 < 4; ++g4) {
            const int dv0 = dt * 32 + 8 * g4 + 4 * h;
            const u32x2 gw = *(const u32x2*)(gatep + row * 256 + dv0);
            const float g0 = siluf(lo_bf(gw.x)), g1 = siluf(hi_bf(gw.x)), g2 = siluf(lo_bf(gw.y)), g3 = siluf(hi_bf(gw.y));
            const f32x16& o = dt ? o1 : o0;
            u32x2 w; w.x = cvt_pk_bf16(o[4 * g4] * inv * g0, o[4 * g4 + 1] * inv * g1); w.y = cvt_pk_bf16(o[4 * g4 + 2] * inv * g2, o[4 * g4 + 3] * inv * g3);
            *(u32x2*)(outp + row * DM + dv0) = w;
        }
}

template <int N>
__device__ __forceinline__ void hyena_conv(const Ctx& c, LAS unsigned char* ub, LAS unsigned char* gb, int pass, const bf16_t* xmul  , float bias,
                                           bf16_t* zdst  , const bf16_t* gmul, bf16_t* cat  ) {
    constexpr int UP = N * 2 + 16, NTT = N / 128, OFF8 = N - 8;
    const int lane = c.lane, i16 = lane & 15, kq = lane >> 4;
    for (int tt = c.wave; tt < NTT; tt += 8) {
        const int t0 = tt * 128;
        f32x4 acc[8];
#pragma unroll
        for (int m = 0; m < 8; ++m) acc[m] = (f32x4){0.f, 0.f, 0.f, 0.f};
        const LAS unsigned char* up = ub + i16 * UP + kq * 16;
        const LAS unsigned char* gp = gb + (OFF8 - t0 - 8 * i16 + 8 * kq) * 2;
#pragma unroll 2
        for (int s0 = 0; s0 < N; s0 += 32) {
            const bf16x8 bfr = *(const LAS bf16x8*)(up + s0 * 2);
            const u32x4 wa = *(const LAS u32x4*)(gp + s0 * 2), wb = *(const LAS u32x4*)(gp + s0 * 2 + 16);
            const unsigned w[8] = {wa.x, wa.y, wa.z, wa.w, wb.x, wb.y, wb.z, wb.w};
            unsigned sh[7];
#pragma unroll
            for (int k = 0; k < 7; ++k) sh[k] = __builtin_amdgcn_alignbit(w[k + 1], w[k], 16);
#pragma unroll
            for (int m = 0; m < 8; ++m) {
                u32x4 a;
                if (m & 1) { const int d0 = (7 - m) >> 1; a = (u32x4){w[d0], w[d0 + 1], w[d0 + 2], w[d0 + 3]}; }
                else { const int d0 = (6 - m) >> 1; a = (u32x4){sh[d0], sh[d0 + 1], sh[d0 + 2], sh[d0 + 3]}; }
                acc[m] = __builtin_amdgcn_mfma_f32_16x16x32_bf16(__builtin_bit_cast(bf16x8, a), bfr, acc[m], 0, 0, 0);
            }
        }
#pragma unroll
        for (int r = 0; r < 4; ++r) {
            const int t8 = t0 + 32 * kq + 8 * r;
            float uu[8], xm[8]; unpack8(*(const LAS u32x4*)(ub + i16 * UP + t8 * 2), uu); unpack8(*(const u32x4*)(xmul + (size_t)i16 * NTOK + t8), xm);
            float y[8];
#pragma unroll
            for (int m = 0; m < 8; ++m) y[m] = xm[m] * (acc[m][r] + bias * uu[m]);
            if (pass == 0) { u32x4 o; o.x = cvt_pk_bf16(y[0], y[1]); o.y = cvt_pk_bf16(y[2], y[3]); o.z = cvt_pk_bf16(y[4], y[5]); o.w = cvt_pk_bf16(y[6], y[7]); *(u32x4*)(zdst + (size_t)i16 * NTOK + t8) = o; }
            else { float gg[8]; unpack8(*(const u32x4*)(gmul + (size_t)i16 * NTOK + t8), gg);
#pragma unroll
                for (int m = 0; m < 8; ++m) cat[((size_t)i16 * NTOK + t8 + m) * DM] = f2bf(y[m] * gg[m]); }
        }
    }
}
template <int N>
__device__ __forceinline__ void hyena_seq(const Ctx& c, int l, int ch, int toff) {
    constexpr int UP = N * 2 + 16;
    LAS unsigned char* ub = c.lds; LAS unsigned char* gb = c.lds + 16 * UP;
    bf16_t* vz = wsp<bf16_t>(c, WS_HYV) + (size_t)ch * 16 * NTOK + toff;
    const bf16_t* x1 = wsp<bf16_t>(c, WS_HYX1) + (size_t)ch * 16 * NTOK + toff;
    const bf16_t* x2 = wsp<bf16_t>(c, WS_HYX2) + (size_t)ch * 16 * NTOK + toff;
    const bf16_t* gm = wsp<bf16_t>(c, WS_HYG) + (size_t)ch * 16 * NTOK + toff;
    bf16_t* cat = wsp<bf16_t>(c, WS_HCAT) + (size_t)toff * DM + 768 + ch;
    for (int pass = 0; pass < 2; ++pass) {
        const bf16_t* gr = (N == SEQL) ? wsp<bf16_t>(c, WS_GR) + (((size_t)l * 2 + pass) * 256 + ch) * 8192 : wsp<bf16_t>(c, WS_GRC) + (((size_t)l * 2 + pass) * 256 + ch) * 512;
        for (int e = c.tid; e < 2 * N / 8; e += 512) *(LAS u32x4*)(gb + e * 16) = *(const u32x4*)(gr + e * 8);
        for (int e = c.tid; e < 16 * N / 8; e += 512) { const int b = e / (N / 8), pc = e % (N / 8); *(LAS u32x4*)(ub + b * UP + pc * 16) = *(const u32x4*)(vz + (size_t)b * NTOK + pc * 8); }
        __syncthreads();
        const float bias = KIN(I_HBIAS)[((size_t)l * 2 + pass) * 256 + ch];
        hyena_conv<N>(c, ub, gb, pass, pass == 0 ? x1 : x2, bias, vz, gm, cat);
        asm volatile("s_waitcnt vmcnt(0)" ::: "memory");
        __syncthreads();
    }
}

__device__ __forceinline__ void ssm_scan_item(const Ctx& c, int l, int item) {
    const int b = item >> 2, g = (item & 3) * 4 + (c.tid >> 7), dq = (c.tid >> 6) & 1, p = c.tid & 63;
    const float* a16 = wsp<float>(c, WS_A16) + ((((size_t)l * 2 + dq) * 16 + g) * 64 + p) * 2;
    const float ar = a16[0], ai = a16[1];
    const bf16_t* E = wsp<bf16_t>(c, WS_E); bf16_t* US = wsp<bf16_t>(c, WS_US);
    float sr = 0.f, si = 0.f;
    for (int st0 = 0; st0 < NCHB; st0 += 8) {
        float er[8], ei[8]; size_t ro[8];
#pragma unroll
        for (int k = 0; k < 8; ++k) { const int st = st0 + k; const int cc = dq == 0 ? (st < 16 ? 256 + st : st - 16) : (st < 16 ? 271 - st : 255 - (st - 16));
            ro[k] = (size_t)g * NCHUNK + (size_t)b * NCHB + cc; er[k] = bf2f(E[ro[k] * 256 + dq * 128 + p]); ei[k] = bf2f(E[ro[k] * 256 + dq * 128 + 64 + p]); }
#pragma unroll
        for (int k = 0; k < 8; ++k) {
            US[ro[k] * 512 + 256 + dq * 128 + p] = f2bf(sr); US[ro[k] * 512 + 256 + dq * 128 + 64 + p] = f2bf(si);
            const float nr = ar * sr - ai * si + er[k], ni = ar * si + ai * sr + ei[k]; sr = nr; si = ni;
        }
    }
}

constexpr int LDS_BYTES = 155648;
constexpr int LDS_MISC = LDS_BYTES - 256;
constexpr int NPRO = 2, NPH = 8, NPHASES = NPRO + DEPTH * NPH;
constexpr int QI_HY = 256, QI_SCAN = 64, QI_ATT = NB * 8 * 17;
constexpr int QI_TOTAL = QI_HY + QI_SCAN + QI_ATT;

__global__ void __launch_bounds__(512, 2) mk_fwd(Params prm) {
    extern __shared__ __attribute__((aligned(16))) unsigned char lds_raw[];
    Ctx c; c.lds = (LAS unsigned char*)lds_raw; c.ka = (kargp_t)__builtin_amdgcn_kernarg_segment_ptr(); c.ws = prm.ws; c.tid = threadIdx.x; c.lane = c.tid & 63; c.wave = __builtin_amdgcn_readfirstlane(c.tid >> 6); c.G = gridDim.x; c.bid = blockIdx.x;
    const int wave0 = c.wave;
    volatile LAS unsigned* misc = (volatile LAS unsigned*)(c.lds + LDS_MISC);
    if (c.tid < 16) misc[c.tid] = 0u;
    __syncthreads();
    unsigned* ctl = wsp<unsigned>(c, WS_CTL);
    const int lo = prm.ph_lo, hi = prm.ph_hi;
    const bool fused = (hi - lo) > 1;
    XcdBarrier bar; bar.bar = ctl + CW_BAR; bar.x = 0; bar.st = misc;
    if (fused) bar = xcd_barrier_post(ctl + CW_BAR, misc);
#ifndef SITE_MASK
#define SITE_MASK 0x3ff
#endif
#define SITE(n) (((SITE_MASK) >> (n)) & 1)
#define IN(k) (lo <= (k) && (k) < hi)
#define FRESH() do { { kargp_t _k = (kargp_t)__builtin_amdgcn_kernarg_segment_ptr(); asm volatile("" : "+s"(_k)); c.ka = _k; c.ws = (unsigned char*)(GAS unsigned char*)_k[37]; } { int _w = wave0; asm volatile("" : "+s"(_w)); c.wave = _w; c.lane = opaque((int)__builtin_amdgcn_mbcnt_hi(~0u, __builtin_amdgcn_mbcnt_lo(~0u, 0u))); c.tid = c.wave * 64 + c.lane; } } while (0)
#define SEAM(k) do { if (IN((k) + 1)) xcd_barrier(bar); } while (0)

    if (SITE(0) && IN(0)) {
        FRESH();
        constexpr int J_SSM = 64, J_HY = 544, J_MOD = 192, J_WIN = 4 * 48 * 16, J_WOUT = 4 * 16 * 16, J_WUQ = 4 * 8 * 4, J_W256 = 4 * 4 * 4;
        constexpr int J0 = J_SSM, J1 = J0 + J_HY, J2 = J1 + J_MOD, J3 = J2 + J_WIN, J4 = J3 + J_WOUT, J5 = J4 + J_WUQ, J6 = J5 + J_W256, J7 = J6 + J_W256, J8 = J7 + J_W256, J9 = J8 + 1;
        for (int job = c.bid; job < J9; job += c.G) {
            if (job < J0) ssm_tables_job(c, job);
            else if (job < J1) hyena_mlp_job(c, job - J0);
            else if (job < J2) modv_job(c, job - J1);
            else if (job < J3) { const int r = job - J2, l = r / 768, q = r % 768; wconv_tile(c, KIN(I_WIN) + (size_t)l * DM * INC, DM, INC, INP, wsp<bf16_t>(c, WS_WIN) + (size_t)l * INP * DM, DM, 0, q / 16, q % 16); }
            else if (job < J4) { const int r = job - J3, l = r / 256, q = r % 256; wconv_tile(c, KIN(I_WOUT) + (size_t)l * DM * DM, DM, DM, DM, wsp<bf16_t>(c, WS_WOUT) + (size_t)l * DM * DM, DM, 1, q / 16, q % 16); }
            else if (job < J5) { const int r = job - J4, l = r / 32, q = r % 32; wconv_tile(c, KIN(I_WUQ) + (size_t)l * 192 * 384, 192, 384, 384, wsp<bf16_t>(c, WS_WUQ) + (size_t)l * 512 * 256, 256, 1, q / 4, q % 4); }
            else if (job < J6) { const int r = job - J5, l = r / 16, q = r % 16; wconv_tile(c, KIN(I_WUKV) + (size_t)l * 128 * 512, 128, 512, 256, wsp<bf16_t>(c, WS_WUK) + (size_t)l * 256 * 256, 256, 2, q / 4, q % 4); }
            else if (job < J7) { const int r = job - J6, l = r / 16, q = r % 16; wconv_tile(c, KIN(I_WUKV) + (size_t)l * 128 * 512, 128, 512, 256, wsp<bf16_t>(c, WS_WUV) + (size_t)l * 256 * 256, 256, 3, q / 4, q % 4); }
            else if (job < J8) { const int r = job - J7, l = r / 16, q = r % 16; wconv_tile(c, KIN(I_GLUW) + (size_t)l * 256 * 256, 256, 256, 256, wsp<bf16_t>(c, WS_WGLU) + (size_t)l * 256 * 256, 256, 1, q / 4, q % 4); }
            else rope_job(c);
        }
        SEAM(0);
    }
    if (SITE(1) && IN(1)) {
        FRESH();
        for (int job = c.bid; job < 4 * 2 * 256; job += c.G) hyena_pack_job(c, job);
        norm_rows(c, -1, 0);
        SEAM(1);
    }
    for (int l = 0; l < DEPTH; ++l) {
        const int pbase = NPRO + l * NPH;
        if (SITE(2) && IN(pbase + 0)) {
            FRESH();
            pg8::Gemm g{wsp<bf16_t>(c, WS_HCAT), wsp<bf16_t>(c, WS_WIN) + (size_t)l * INP * DM, MROWS, INP, DM};
            pg8::StaticOrder S; S.init(MROWS, INP, c.G, c.bid);
            pg8::EpiWalk<PutSplit> E{{wsp<bf16_t>(c, WS_PB)}};
            pg8::gemm_phase(c.lds, g, S, E, c.tid);
            SEAM(pbase + 0);
        }
        if (SITE(3) && IN(pbase + 1)) { FRESH(); p2_rows(c, l); FRESH(); p2_tiles(c, l); SEAM(pbase + 1); }
        if (SITE(4) && IN(pbase + 2)) {
            FRESH();
            { pg8::Gemm g{wsp<bf16_t>(c, WS_PB), wsp<bf16_t>(c, WS_WUQ) + (size_t)l * 512 * 256, MROWS, 512, 256}; pg8::StaticOrder S; S.init(MROWS, 512, c.G, c.bid);
              pg8::EpiWalk<PutPlain> E{{wsp<bf16_t>(c, WS_QM), 384, 384}}; pg8::gemm_phase(c.lds, g, S, E, c.tid); }
            FRESH();
            { pg8::Gemm g{wsp<bf16_t>(c, WS_PB) + BLKE, wsp<bf16_t>(c, WS_WUK) + (size_t)l * 256 * 256, MROWS, 256, 256}; pg8::StaticOrder S; S.init(MROWS, 256, c.G, c.bid);
              pg8::EpiWalk<PutKm> E{{wsp<bf16_t>(c, WS_KM), wsp<bf16_t>(c, WS_KR)}}; pg8::gemm_phase(c.lds, g, S, E, c.tid); }
            FRESH();
            { pg8::Gemm g{wsp<bf16_t>(c, WS_WUV) + (size_t)l * 256 * 256, wsp<bf16_t>(c, WS_PB) + BLKE, 256, MROWS, 256}; pg8::StaticOrder S; S.init(256, MROWS, c.G, c.bid);
              pg8::EpiWalk<PutVt> E{{wsp<bf16_t>(c, WS_VTM)}}; pg8::gemm_phase(c.lds, g, S, E, c.tid); }
            FRESH();
            { pg8::Gemm g{wsp<bf16_t>(c, WS_UG), wsp<bf16_t>(c, WS_WE) + (size_t)l * 16 * 256 * 256, 16 * NCHUNK, 16 * 256, 256}; pg8::BatchedOrder S; S.init(16, NCHUNK / 256, c.G, c.bid);
              pg8::EpiWalk<PutE> E{{wsp<bf16_t>(c, WS_E)}}; pg8::gemm_phase(c.lds, g, S, E, c.tid); }
            SEAM(pbase + 2);
        }
        if (SITE(5) && IN(pbase + 3)) {
            FRESH();
            unsigned* qh = ctl + CW_Q + 64 * l;
            const float* ropeM = wsp<float>(c, WS_ROPEM);
            for (;;) {
                __syncthreads();
                if (c.tid == 0) misc[4] = __hip_atomic_fetch_add(qh, 1u, __ATOMIC_RELAXED, __HIP_MEMORY_SCOPE_AGENT);
                __syncthreads();
                const int it = (int)misc[4];
                if (it >= QI_TOTAL) break;
                FRESH();
                if (it < QI_HY) { hyena_seq<SEQL>(c, l, it, 0); hyena_seq<CTXL>(c, l, it, SEQL); }
                else if (it < QI_HY + QI_SCAN) ssm_scan_item(c, l, it - QI_HY);
                else {
                    const int a = it - QI_HY - QI_SCAN; const int kind = a & 1  , r = a >> 1, head = r & 3, r2 = r >> 2, b = r2 / 17, qb = 16 - (r2 % 17)  ;
                    const size_t row0 = (size_t)b * NTOK + (size_t)qb * 256; const int kt0 = qb == 16 ? 64 : 0, nkt = qb == 16 ? 4 : 68;
                    if (kind == 0) attn_unit<96>(c, wsp<bf16_t>(c, WS_QM) + row0 * 384 + head * 96, 384, wsp<bf16_t>(c, WS_KM) + (size_t)(b * 4 + head) * NTOK * 96, wsp<bf16_t>(c, WS_VTM) + (size_t)(b * 4 + head) * 64 * NTOK,
                                                 kt0, nkt, wsp<bf16_t>(c, WS_PB) + 2 * BLKE + row0 * 256 + head * 64, wsp<bf16_t>(c, WS_HCAT) + row0 * DM + head * 64, qb < 16, qb * 256, 0.10206207261596577f * LOG2E, ropeM);
                    else attn_unit<64>(c, wsp<bf16_t>(c, WS_PB) + 3 * BLKE + row0 * 256 + head * 64, 256, wsp<bf16_t>(c, WS_KG) + (size_t)(b * 2 + (head >> 1)) * NTOK * 64, wsp<bf16_t>(c, WS_VTG) + (size_t)(b * 2 + (head >> 1)) * 64 * NTOK,
                                       kt0, nkt, wsp<bf16_t>(c, WS_PB) + 5 * BLKE + row0 * 256 + head * 64, wsp<bf16_t>(c, WS_HCAT) + row0 * DM + 256 + head * 64, false, 0, 1.f, ropeM);
                }
            }
            SEAM(pbase + 3);
        }
        if (SITE(6) && IN(pbase + 4)) {
            FRESH();
            pg8::Gemm g{wsp<bf16_t>(c, WS_US), wsp<bf16_t>(c, WS_WKC) + (size_t)l * 16 * 256 * 512, 16 * NCHUNK, 16 * 256, 512}; pg8::BatchedOrder S; S.init(16, NCHUNK / 256, c.G, c.bid);
            pg8::EpiWalk<PutSsmY> E{{wsp<bf16_t>(c, WS_ZS), wsp<bf16_t>(c, WS_UG), KIN(I_SSMD) + l * 256}}; pg8::gemm_phase(c.lds, g, S, E, c.tid);
            SEAM(pbase + 4);
        }
        if (SITE(7) && IN(pbase + 5)) {
            FRESH();
            pg8::Gemm g{wsp<bf16_t>(c, WS_ZS), wsp<bf16_t>(c, WS_WGLU) + (size_t)l * 256 * 256, MROWS, 256, 256}; pg8::StaticOrder S; S.init(MROWS, 256, c.G, c.bid);
            pg8::EpiWalk<PutGlu> E{{wsp<bf16_t>(c, WS_HCAT), wsp<bf16_t>(c, WS_ZS), wsp<bf16_t>(c, WS_PB) + 7 * BLKE, KIN(I_GLUB) + l * 256}}; pg8::gemm_phase(c.lds, g, S, E, c.tid);
            SEAM(pbase + 5);
        }
        if (SITE(8) && IN(pbase + 6)) {
            FRESH();
            pg8::Gemm g{wsp<bf16_t>(c, WS_HCAT), wsp<bf16_t>(c, WS_WOUT) + (size_t)l * DM * DM, MROWS, DM, DM}; pg8::StaticOrder S; S.init(MROWS, DM, c.G, c.bid);
            pg8::EpiWalk<PutPlain> E{{wsp<bf16_t>(c, WS_OUTB), DM, DM}}; pg8::gemm_phase(c.lds, g, S, E, c.tid);
            SEAM(pbase + 6);
        }
        if (SITE(9) && IN(pbase + 7)) { FRESH(); norm_rows(c, l, l + 1 < DEPTH ? l + 1 : -1); if (l + 1 < DEPTH) SEAM(pbase + 7); }
    }
#undef IN
#undef SEAM
}

extern "C" void kernel_launch(void* const* d_in, const int* in_sizes, int n_in, void* d_out, int out_size, void* d_ws, size_t ws_size, hipStream_t stream) {
    static int grid = 0;
    if (grid == 0) {
        if (n_in != 36 || out_size != NB * SEQL * DM || ws_size < WS_END) { fprintf(stderr, "kernel_launch: unexpected shapes: n_in %d out %d ws %zu (need %zu)\n", n_in, out_size, ws_size, (size_t)WS_END); grid = -1; return; }
        int dev = 0, cus = 0, per_cu = 0;
        if (hipGetDevice(&dev) != hipSuccess || hipDeviceGetAttribute(&cus, hipDeviceAttributeMultiprocessorCount, dev) != hipSuccess) { grid = -1; return; }
        if (hipFuncSetAttribute((const void*)mk_fwd, hipFuncAttributeMaxDynamicSharedMemorySize, LDS_BYTES) != hipSuccess) { fprintf(stderr, "kernel_launch: hipFuncSetAttribute failed\n"); grid = -1; return; }
        if (hipOccupancyMaxActiveBlocksPerMultiprocessor(&per_cu, (const void*)mk_fwd, 512, LDS_BYTES) != hipSuccess || per_cu < 1) { fprintf(stderr, "kernel_launch: occupancy query says %d blocks per CU\n", per_cu); per_cu = 1; }
        (void)hipGetLastError();
        grid = cus;
    }
    if (grid < 0) return;
    (void)hipMemsetAsync((char*)d_ws + WS_CTL, 0, CTL_BYTES, stream);
    Params p{};
    for (int i = 0; i < 36; ++i) p.in[i] = (const float*)d_in[i];
    p.out = (float*)d_out; p.ws = (unsigned char*)d_ws;
#if MK_ONE_LAUNCH
    p.ph_lo = 0; p.ph_hi = NPHASES;
    hipLaunchKernelGGL(mk_fwd, dim3(grid), dim3(512), LDS_BYTES, stream, p);
#else
    for (int k = 0; k < NPHASES; ++k) { p.ph_lo = k; p.ph_hi = k + 1; hipLaunchKernelGGL(mk_fwd, dim3(grid), dim3(512), LDS_BYTES, stream, p); }
#endif
}
```

```cpp
#include <hip/hip_runtime.h>
#include <cstdio>
#include <cstdint>

#ifndef MK_ONE_LAUNCH
#define MK_ONE_LAUNCH 1
#endif

#define LAS __attribute__((address_space(3)))
typedef unsigned short bf16_t;
typedef short bf16x8 __attribute__((ext_vector_type(8)));
typedef short bf16x4 __attribute__((ext_vector_type(4)));
typedef float f32x4 __attribute__((ext_vector_type(4)));
typedef float f32x16 __attribute__((ext_vector_type(16)));
typedef unsigned u32x4 __attribute__((ext_vector_type(4)));
typedef unsigned u32x2 __attribute__((ext_vector_type(2)));

constexpr int NB = 16, SEQL = 4096, CTXL = 256, NTOK = SEQL + CTXL  , MROWS = NB * NTOK  ;
constexpr int DM = 1024, DEPTH = 4, INC = 2912, INP = 3072;
constexpr int NCHB = NTOK / 16  , NCHUNK = MROWS / 16  ;
constexpr float EPS = 1e-6f;
constexpr float LOG2E = 1.4426950408889634f;

constexpr size_t al256(size_t x) { return (x + 255) & ~(size_t)255; }
constexpr size_t WS_CTL = 0;
constexpr size_t CTL_BYTES = 32768;
constexpr size_t WS_MODV = WS_CTL + CTL_BYTES;
constexpr size_t WS_ROPEG = WS_MODV + al256((size_t)4 * 17 * 3072 * 4);
constexpr size_t WS_ROPEM = WS_ROPEG + 64 * 16 * 2 * 4;
constexpr size_t WS_WIN = WS_ROPEM + 64 * 8 * 2 * 4;
constexpr size_t WS_WOUT = WS_WIN + (size_t)4 * 3072 * 1024 * 2;
constexpr size_t WS_WUQ = WS_WOUT + (size_t)4 * 1024 * 1024 * 2;
constexpr size_t WS_WUK = WS_WUQ + (size_t)4 * 512 * 256 * 2;
constexpr size_t WS_WUV = WS_WUK + (size_t)4 * 256 * 256 * 2;
constexpr size_t WS_WGLU = WS_WUV + (size_t)4 * 256 * 256 * 2;
constexpr size_t WS_WE = WS_WGLU + (size_t)4 * 256 * 256 * 2;
constexpr size_t WS_WKC = WS_WE + (size_t)4 * 16 * 256 * 256 * 2;
constexpr size_t WS_A16 = WS_WKC + (size_t)4 * 16 * 256 * 512 * 2;
constexpr size_t WS_GR = WS_A16 + (size_t)4 * 2 * 16 * 64 * 2 * 4;
constexpr size_t WS_GRC = WS_GR + (size_t)4 * 2 * 256 * 8192 * 2;
constexpr size_t WS_CTXR = WS_GRC + (size_t)4 * 2 * 256 * 512 * 2;
constexpr size_t WS_HCAT = WS_CTXR + (size_t)NB * CTXL * DM * 4;
constexpr size_t BLKE = (size_t)MROWS * 256;
constexpr size_t WS_PB = WS_HCAT + (size_t)MROWS * DM * 2;
constexpr size_t WS_KR = WS_PB + 12 * BLKE * 2;
constexpr size_t WS_KG = WS_KR + (size_t)MROWS * 32 * 2;
constexpr size_t WS_VTG = WS_KG + (size_t)32 * NTOK * 64 * 2;
constexpr size_t WS_UG = WS_VTG + (size_t)32 * NTOK * 64 * 2;
constexpr size_t WS_US = WS_UG + BLKE * 2;
constexpr size_t WS_HYV = WS_US + (size_t)16 * NCHUNK * 512 * 2;
constexpr size_t WS_HYX1 = WS_HYV + BLKE * 2;
constexpr size_t WS_HYX2 = WS_HYX1 + BLKE * 2;
constexpr size_t WS_HYG = WS_HYX2 + BLKE * 2;
constexpr size_t WS_END = WS_HYG + BLKE * 2;
static_assert(WS_END <= (size_t)1 << 30, "workspace map exceeds 1 GiB");
constexpr size_t WS_QM = WS_PB + 8 * BLKE * 2;
constexpr size_t WS_KM = WS_QM + (size_t)MROWS * 384 * 2;
constexpr size_t WS_VTM = WS_KM + (size_t)MROWS * 384 * 2;
constexpr size_t WS_E = WS_PB + 4 * BLKE * 2;
constexpr size_t WS_ZS = WS_PB + 6 * BLKE * 2;
constexpr size_t WS_OUTB = WS_PB + 8 * BLKE * 2;
constexpr size_t WS_HT = WS_PB;
static_assert(WS_VTM + BLKE * 2 == WS_PB + 12 * BLKE * 2, "alias map");

constexpr int CW_BAR = 0;
constexpr int CW_Q = 4096;
constexpr int CW_TMO = 4096 + 64 * 8;

__device__ __forceinline__ float bf2f(bf16_t v) { return __uint_as_float(((unsigned)v) << 16); }
__device__ __forceinline__ bf16_t f2bf(float f) { unsigned u = __float_as_uint(f); u += 0x7FFFu + ((u >> 16) & 1u); return (bf16_t)(u >> 16); }
__device__ __forceinline__ unsigned cvt_pk_bf16(float lo, float hi) { unsigned r; asm volatile("v_cvt_pk_bf16_f32 %0, %1, %2" : "=v"(r) : "v"(lo), "v"(hi)); return r; }
__device__ __forceinline__ float lo_bf(unsigned w) { return __uint_as_float(w << 16); }
__device__ __forceinline__ float hi_bf(unsigned w) { return __uint_as_float(w & 0xFFFF0000u); }
__device__ __forceinline__ float sigmf(float x) { float one = 1.f; asm volatile("" : "+v"(one)); return __builtin_amdgcn_rcpf(one + __builtin_amdgcn_exp2f(-1.4426950408889634f * x)); }
__device__ __forceinline__ float siluf(float x) { return x * sigmf(x); }
__device__ __forceinline__ float gelu_tanh(float x) { const float u = 0.7978845608028654f * (x + 0.044715f * x * x * x); return x * sigmf(2.f * u); }
__device__ __forceinline__ int opaque(int x) { asm volatile("" : "+v"(x)); return x; }
__device__ __forceinline__ float wave_sum(float v) {
#pragma unroll
    for (int o = 32; o > 0; o >>= 1) v += __shfl_xor(v, o);
    return v;
}

#define XB_TMO      128
#define XB_XCNT(j)  (256  + 64 * (j))
#define XB_XSUB(j)  (1280 + 64 * (j))
#define XB_XGEN(j)  (2304 + 64 * (j))
#define XB_TOP      3328
#define XB_TOPGEN   3392
#define XCD_BAR_WORDS 3456
#define XB_SPIN_CAP (1u << 22)
__device__ __forceinline__ unsigned xb_ld(unsigned* p)              { return __hip_atomic_load(p, __ATOMIC_RELAXED, __HIP_MEMORY_SCOPE_AGENT); }
__device__ __forceinline__ unsigned xb_add(unsigned* p, unsigned v) { return __hip_atomic_fetch_add(p, v, __ATOMIC_RELAXED, __HIP_MEMORY_SCOPE_AGENT); }
__device__ __forceinline__ unsigned xb_xcc_id() { return (unsigned)__builtin_amdgcn_s_getreg((3 << 11) | 20) & 0xFu; }
#define XB_SPIN(cond, bar) do { unsigned _sp = 0; while (cond) { __builtin_amdgcn_s_sleep(1); \
    if ((++_sp & 255u) == 0u) { if (xb_ld(&(bar)[XB_TMO])) break; if (_sp > XB_SPIN_CAP) { atomicAdd(&(bar)[XB_TMO], 1u); break; } } } } while (0)
struct XcdBarrier { unsigned* bar; unsigned x; volatile LAS unsigned* st; };
__device__ __forceinline__ XcdBarrier xcd_barrier_post(unsigned* bar, volatile LAS unsigned* st) {
    XcdBarrier b; b.bar = bar; b.x = xb_xcc_id(); b.st = st;
    if (threadIdx.x == 0) (void)xb_add(&bar[XB_XCNT(b.x)], 1u);
    return b;
}
__device__ __forceinline__ void xcd_barrier_complete(unsigned* bar, unsigned x, unsigned& nloc, unsigned& nx) {
    const unsigned G = gridDim.x * gridDim.y * gridDim.z;
    unsigned sum, cnt, mine, sp = 0u;
    for (;;) {
        sum = 0u; cnt = 0u; mine = 0u;
#pragma unroll
        for (unsigned j = 0; j < 16; ++j) { const unsigned c = xb_ld(&bar[XB_XCNT(j)]); sum += c; cnt += (c > 0u) ? 1u : 0u; }
        mine = xb_ld(&bar[XB_XCNT(x)]);
        if (sum == G) break;
        __builtin_amdgcn_s_sleep(1);
        if ((++sp & 255u) == 0u) { if (xb_ld(&bar[XB_TMO])) break; if (sp > XB_SPIN_CAP) { atomicAdd(&bar[XB_TMO], 1u); break; } }
    }
    nloc = mine > 0u ? mine : 1u; nx = cnt > 0u ? cnt : 1u;
}
__device__ __forceinline__ void xcd_barrier(const XcdBarrier& b) {
    asm volatile("s_waitcnt vmcnt(0)" ::: "memory");
    __syncthreads();
    if (threadIdx.x == 0) {
        unsigned* bar = b.bar;
        __builtin_amdgcn_s_waitcnt(0);
        unsigned nloc = b.st[0], nx = b.st[1];
        if (nloc == 0u) { xcd_barrier_complete(bar, b.x, nloc, nx); b.st[0] = nloc; b.st[1] = nx; }
        const unsigned old = xb_add(&bar[XB_XSUB(b.x)], 1u);
        const unsigned gen = old / nloc;
        if (old + 1u == (gen + 1u) * nloc) {
            __builtin_amdgcn_fence(__ATOMIC_RELEASE, "agent");
            asm volatile("s_waitcnt vmcnt(0)" ::: "memory");
            const unsigned og = xb_add(&bar[XB_TOP], 1u);
            const unsigned tg = og / nx;
            if (og + 1u == (tg + 1u) * nx) xb_add(&bar[XB_TOPGEN], 1u);
            else XB_SPIN(xb_ld(&bar[XB_TOPGEN]) == tg, bar);
            __builtin_amdgcn_fence(__ATOMIC_ACQUIRE, "agent");
            xb_add(&bar[XB_XGEN(b.x)], 1u);
            asm volatile("s_waitcnt vmcnt(0)" ::: "memory");
        } else {
            XB_SPIN(xb_ld(&bar[XB_XGEN(b.x)]) == gen, bar);
            __builtin_amdgcn_fence(__ATOMIC_ACQUIRE, "agent");
            asm volatile("s_waitcnt vmcnt(0)" ::: "memory");
        }
    }
    __syncthreads();
}

namespace pg8 {
constexpr int BM = 256, BK = 64, HALF = 128, HTB = HALF * BK * 2, STAGE_BYTES = 8 * HTB, NXCD = 8, WGM = 8;
__host__ __device__ __forceinline__ int lds_byte(int r, int c) { const int st = (r >> 4) * 2 + (c >> 5), rr = r & 15, cc = c & 31, ob = rr * 64 + cc * 2; return st * 1024 + (ob ^ (((ob >> 9) & 1) << 5)); }
__host__ __device__ __forceinline__ void stage_rc(int b, int& R, int& C) { const int st = b / 1024, sb = b % 1024, swz = sb ^ (((sb >> 9) & 1) << 5); R = (st >> 1) * 16 + swz / 64; C = (st & 1) * 32 + (swz % 64) / 2; }
__host__ __device__ __forceinline__ int perm32(int rho) { const int n = rho >> 4, i = rho & 15; return 8 * (i >> 2) + 4 * n + (i & 3); }
struct Unit { int pm, pn; };
struct Gemm { const bf16_t* A; const bf16_t* Bt; int M, N, K; };
struct StaticOrder {
    int nM, nN, nwg, G, c;
    __host__ __device__ void init(int M, int N, int G_, int c_) { nM = M / BM; nN = N / BM; nwg = nM * nN; G = G_; c = c_; }
    __host__ __device__ bool next(int i, Unit& u) const {
        const long L = (long)i * G + c; if (L >= nwg) return false;
        int wgid = (int)L; { const int q = nwg / NXCD, r = nwg % NXCD, xcd = wgid % NXCD, off = wgid / NXCD; wgid = (xcd < r ? xcd * (q + 1) : r * (q + 1) + (xcd - r) * q) + off; }
        const int nig = WGM * nN, gid = wgid / nig, fm = gid * WGM, gsz = (nM - fm) < WGM ? (nM - fm) : WGM;
        u.pm = fm + ((wgid % nig) % gsz); u.pn = (wgid % nig) / gsz; return true;
    }
    __device__ __forceinline__ void a_ready(const Unit&) const {}
    __device__ __forceinline__ void done(const Unit&) const {}
};
struct BatchedOrder {
    int nwg, G, c, tpg;
    __host__ __device__ void init(int ng, int tpg_, int G_, int c_) { nwg = ng * tpg_; tpg = tpg_; G = G_; c = c_; }
    __host__ __device__ bool next(int i, Unit& u) const { const int L = i * G + c; if (L >= nwg) return false; u.pm = L; u.pn = L / tpg; return true; }
    __device__ __forceinline__ void a_ready(const Unit&) const {}
    __device__ __forceinline__ void done(const Unit&) const {}
};

template <class Epi, class Sched>
__device__ __forceinline__ void gemm_phase(LAS unsigned char* lds, const Gemm g, const Sched& S, const Epi& E, int tid_in) {
    const int tid = tid_in, wid = __builtin_amdgcn_readfirstlane(tid >> 6), lane = tid & 63, wr = wid >> 2, wc = wid & 3, fr = lane & 15, fq = lane >> 4;
    const int K = g.K, nt = K / BK;
    unsigned voffA[2], voffB[2];
#pragma unroll
    for (int i = 0; i < 2; ++i) { int R, C; stage_rc(tid * 16 + i * 8192, R, C); const int Rb = Epi::PERM ? ((R & ~31) + perm32(R & 31)) : R;
        voffA[i] = (unsigned)(R * K + C) * 2u; voffB[i] = (unsigned)(Rb * K + C) * 2u; }
    const size_t kstep = (size_t)(BK * 2);
    const size_t hstep = (size_t)HALF * K * 2;
    const size_t tstep = 2 * hstep;
    const unsigned ldsw = (unsigned)wid * 1024u;
    const int aoff = lds_byte(wr * 64 + fr, fq * 8), boff = lds_byte(wc * 32 + fr, fq * 8);
#define PG8_SA(b, h) (((b) * 2 + (h)) * HTB)
#define PG8_SB(b, h) ((4 + (b) * 2 + (h)) * HTB)
#define PG8_STAGE(bufoff, gbase, voff) do { _Pragma("unroll") for (int _i = 0; _i < 2; ++_i) \
        __builtin_amdgcn_global_load_lds((const unsigned*)((const char*)(gbase) + (voff)[_i]), (LAS unsigned*)(lds + (bufoff) + ldsw + _i * 8192), 16, 0, 0); } while (0)
#define PG8_LDA(dst, b, h) do { _Pragma("unroll") for (int m = 0; m < 4; ++m) _Pragma("unroll") for (int k = 0; k < 2; ++k) dst[m][k] = *(const LAS bf16x8*)(lds + PG8_SA(b, h) + aoff + m * 2048 + k * 1024); } while (0)
#define PG8_LDB(dst, b, h) do { _Pragma("unroll") for (int n = 0; n < 2; ++n) _Pragma("unroll") for (int k = 0; k < 2; ++k) dst[n][k] = *(const LAS bf16x8*)(lds + PG8_SB(b, h) + boff + n * 2048 + k * 1024); } while (0)
#define PG8_MMA(ai, bj, At, Bt) do { __builtin_amdgcn_s_setprio(1); _Pragma("unroll") for (int m = 0; m < 4; ++m) _Pragma("unroll") for (int n = 0; n < 2; ++n) _Pragma("unroll") for (int k = 0; k < 2; ++k) \
        acc[ai][bj][m][n] = __builtin_amdgcn_mfma_f32_16x16x32_bf16(Bt[n][k], At[m][k], acc[ai][bj][m][n], 0, 0, 0); __builtin_amdgcn_s_setprio(0); } while (0)
#define PG8_WAIT_V(n) asm volatile("s_waitcnt vmcnt(" #n ")" ::: "memory")
#define PG8_WAIT_L(n) asm volatile("s_waitcnt lgkmcnt(" #n ")" ::: "memory")
#define PG8_BAR __builtin_amdgcn_s_barrier()
#define PG8_SCHED __builtin_amdgcn_sched_barrier(0)
    Unit cur, nxt; int ui = 0;
    if (!S.next(0, cur)) return;
    f32x4 acc[2][2][4][2];
#pragma unroll
    for (int a = 0; a < 2; ++a)
#pragma unroll
        for (int b = 0; b < 2; ++b)
#pragma unroll
            for (int m = 0; m < 4; ++m)
#pragma unroll
                for (int n = 0; n < 2; ++n) acc[a][b][m][n] = (f32x4){0.f, 0.f, 0.f, 0.f};
    bf16x8 At[4][2], B0[2][2], B1[2][2];
    const char* cA = (const char*)g.A + (size_t)cur.pm * tstep; const char* cB = (const char*)g.Bt + (size_t)cur.pn * tstep;
    S.a_ready(cur);
    PG8_STAGE(PG8_SB(0, 0), cB, voffB); PG8_STAGE(PG8_SA(0, 0), cA, voffA); PG8_STAGE(PG8_SB(0, 1), cB + hstep, voffB); PG8_STAGE(PG8_SA(0, 1), cA + hstep, voffA);
    if (wr == 1) PG8_BAR;
    PG8_WAIT_V(4); PG8_BAR;
    PG8_STAGE(PG8_SB(1, 0), cB + kstep, voffB); PG8_STAGE(PG8_SA(1, 0), cA + kstep, voffA); PG8_STAGE(PG8_SB(1, 1), cB + hstep + kstep, voffB);
    PG8_WAIT_V(6); PG8_BAR;
    for (;;) {
        const bool has_next = S.next(ui + 1, nxt);
        const char* nA = has_next ? (const char*)g.A + (size_t)nxt.pm * tstep : cA; const char* nB = has_next ? (const char*)g.Bt + (size_t)nxt.pn * tstep : cB;
        for (int t = 0; t < nt; t += 2) {
            const bool last = (t == nt - 2);
            const char* a1 = cA + (size_t)(t + 1) * kstep;
            const char* a2 = last ? nA : cA + (size_t)(t + 2) * kstep; const char* b2 = last ? nB : cB + (size_t)(t + 2) * kstep;
            const char* a3 = a2 + kstep; const char* b3 = b2 + kstep;
            if (last && has_next) S.a_ready(nxt);
            PG8_LDB(B0, 0, 0); PG8_SCHED; PG8_LDA(At, 0, 0); PG8_STAGE(PG8_SA(1, 1), a1 + hstep, voffA);
            PG8_WAIT_L(8); PG8_BAR; PG8_WAIT_L(0); PG8_MMA(0, 0, At, B0); PG8_BAR; PG8_SCHED;
            PG8_LDB(B1, 0, 1); PG8_STAGE(PG8_SB(0, 0), b2, voffB);
            PG8_BAR; PG8_WAIT_L(0); PG8_MMA(0, 1, At, B1); PG8_BAR;
            PG8_LDA(At, 0, 1); PG8_STAGE(PG8_SA(0, 0), a2, voffA);
            PG8_BAR; PG8_WAIT_L(0); PG8_MMA(1, 0, At, B0); PG8_BAR; PG8_SCHED;
            PG8_STAGE(PG8_SB(0, 1), b2 + hstep, voffB);
            PG8_WAIT_V(6); PG8_BAR; PG8_MMA(1, 1, At, B1); PG8_BAR;
            PG8_LDB(B0, 1, 0); PG8_SCHED; PG8_LDA(At, 1, 0); PG8_STAGE(PG8_SA(0, 1), a2 + hstep, voffA);
            PG8_WAIT_L(8); PG8_BAR; PG8_WAIT_L(0); PG8_MMA(0, 0, At, B0); PG8_BAR; PG8_SCHED;
            PG8_LDB(B1, 1, 1); PG8_STAGE(PG8_SB(1, 0), b3, voffB);
            PG8_BAR; PG8_WAIT_L(0); PG8_MMA(0, 1, At, B1); PG8_BAR;
            PG8_LDA(At, 1, 1); PG8_STAGE(PG8_SA(1, 0), a3, voffA);
            PG8_BAR; PG8_WAIT_L(0); PG8_MMA(1, 0, At, B0); PG8_BAR; PG8_SCHED;
            PG8_STAGE(PG8_SB(1, 1), b3 + hstep, voffB);
            PG8_WAIT_V(6); PG8_BAR; PG8_MMA(1, 1, At, B1); PG8_BAR;
        }
        { const int l2 = opaque((int)__builtin_amdgcn_mbcnt_hi(~0u, __builtin_amdgcn_mbcnt_lo(~0u, 0u))); E(acc, cur, wr, wc, l2 & 15, l2 >> 4); } S.done(cur);
        if (!has_next) break;
#pragma unroll
        for (int a = 0; a < 2; ++a)
#pragma unroll
            for (int b = 0; b < 2; ++b)
#pragma unroll
                for (int m = 0; m < 4; ++m)
#pragma unroll
                    for (int n = 0; n < 2; ++n) acc[a][b][m][n] = (f32x4){0.f, 0.f, 0.f, 0.f};
        cur = nxt; cA = nA; cB = nB; ++ui;
    }
    PG8_WAIT_V(0);
    if (wr == 0) PG8_BAR;
    PG8_BAR;
#undef PG8_SA
#undef PG8_SB
#undef PG8_STAGE
#undef PG8_LDA
#undef PG8_LDB
#undef PG8_MMA
#undef PG8_WAIT_V
#undef PG8_WAIT_L
#undef PG8_BAR
#undef PG8_SCHED
}

template <class F> struct EpiWalk {
    static constexpr bool PERM = true, AFTER_DRAIN = false;
    F f;
    __device__ __forceinline__ void operator()(const f32x4 (&acc)[2][2][4][2], const Unit& u, int wr, int wc, int fr, int fq) const {
#pragma unroll
        for (int ai = 0; ai < 2; ++ai)
#pragma unroll
            for (int m = 0; m < 4; ++m) {
                const int row = u.pm * BM + ai * HALF + wr * 64 + m * 16 + fr;
#pragma unroll
                for (int bj = 0; bj < 2; ++bj) { const int col = u.pn * BM + bj * HALF + wc * 32 + 8 * fq; f.put(row, col, acc[ai][bj][m][0], acc[ai][bj][m][1]); asm volatile("" ::: "memory"); }
            }
    }
};
}

__device__ __forceinline__ u32x4 pack8(const f32x4& a, const f32x4& b) {
    u32x4 w; w.x = cvt_pk_bf16(a[0], a[1]); w.y = cvt_pk_bf16(a[2], a[3]); w.z = cvt_pk_bf16(b[0], b[1]); w.w = cvt_pk_bf16(b[2], b[3]); return w;
}
__device__ __forceinline__ void unpack8(const u32x4 w, float (&o)[8]) {
    o[0] = lo_bf(w.x); o[1] = hi_bf(w.x); o[2] = lo_bf(w.y); o[3] = hi_bf(w.y); o[4] = lo_bf(w.z); o[5] = hi_bf(w.z); o[6] = lo_bf(w.w); o[7] = hi_bf(w.w);
}

struct PutSplit {
    bf16_t* pb;
    __device__ __forceinline__ void put(int row, int col, const f32x4& a, const f32x4& b) const { *(u32x4*)(pb + (size_t)(col >> 8) * BLKE + (size_t)row * 256 + (col & 255)) = pack8(a, b); }
};
struct PutPlain {
    bf16_t* dst; int ldc, ncols;
    __device__ __forceinline__ void put(int row, int col, const f32x4& a, const f32x4& b) const { if (col < ncols) *(u32x4*)(dst + (size_t)row * ldc + col) = pack8(a, b); }
};
struct PutKm {
    bf16_t* km; const bf16_t* kr;
    __device__ __forceinline__ void put(int row, int col, const f32x4& a, const f32x4& b) const {
        const int hd = col >> 6, d = col & 63, bb = row / NTOK, key = row - bb * NTOK;
        bf16_t* dst = km + ((size_t)(bb * 4 + hd) * NTOK + key) * 96;
        *(u32x4*)(dst + d) = pack8(a, b);
        if (d < 32) *(u32x4*)(dst + 64 + d) = *(const u32x4*)(kr + (size_t)row * 32 + d);
    }
};
struct PutVt {
    bf16_t* vt;
    __device__ __forceinline__ void put(int row, int col, const f32x4& a, const f32x4& b) const {
        const int bb = col / NTOK, key = col - bb * NTOK;
        *(u32x4*)(vt + ((size_t)(bb * 4 + (row >> 6)) * 64 + (row & 63)) * NTOK + key) = pack8(a, b);
    }
};
struct PutE {
    bf16_t* e;
    __device__ __forceinline__ void put(int row, int col, const f32x4& a, const f32x4& b) const { *(u32x4*)(e + (size_t)row * 256 + (col & 255)) = pack8(a, b); }
};
struct PutSsmY {
    bf16_t* zs; const bf16_t* ug; const float* dskip;
    __device__ __forceinline__ void put(int row, int col, const f32x4& a, const f32x4& b) const {
        const int g = row / NCHUNK, n = row - g * NCHUNK, c = col & 255, tok = n * 16 + (c >> 4), ho = c & 15, ch = g * 16 + ho;
        float u[8]; unpack8(*(const u32x4*)(ug + ((size_t)g * MROWS + tok) * 16 + ho), u);
        const f32x4 d0 = *(const f32x4*)(dskip + ch), d1 = *(const f32x4*)(dskip + ch + 4);
        f32x4 y0, y1;
#pragma unroll
        for (int i = 0; i < 4; ++i) { y0[i] = gelu_tanh(a[i] + d0[i] * u[i]); y1[i] = gelu_tanh(b[i] + d1[i] * u[4 + i]); }
        *(u32x4*)(zs + (size_t)tok * 256 + ch) = pack8(y0, y1);
    }
};
struct PutGlu {
    bf16_t* cat; const bf16_t* zs; const bf16_t* gate; const float* gb;
    __device__ __forceinline__ void put(int row, int col, const f32x4& a, const f32x4& b) const {
        float z[8], gt[8]; unpack8(*(const u32x4*)(zs + (size_t)row * 256 + col), z); unpack8(*(const u32x4*)(gate + (size_t)row * 256 + col), gt);
        const f32x4 b0 = *(const f32x4*)(gb + col), b1 = *(const f32x4*)(gb + col + 4);
        f32x4 y0, y1;
#pragma unroll
        for (int i = 0; i < 4; ++i) { y0[i] = z[i] * sigmf(a[i] + b0[i]) * siluf(gt[i]); y1[i] = z[4 + i] * sigmf(b[i] + b1[i]) * siluf(gt[4 + i]); }
        *(u32x4*)(cat + (size_t)row * DM + 512 + col) = pack8(y0, y1);
    }
};

struct Params {
    const float* in[36];
    float* out;
    unsigned char* ws;
    int ph_lo, ph_hi;
};
enum { I_X = 0, I_C, I_CTX, I_CCTX, I_WMOD, I_BMOD, I_GPRE, I_GPOST, I_WIN, I_WOUT, I_GCQ, I_WUQ, I_GCKV, I_WUKV, I_GQ, I_GK,
       I_LRE, I_LIM, I_LSTEP, I_BRE, I_BIM, I_CRE, I_CIM, I_SSMD, I_GLUW, I_GLUB, I_HCW, I_HCB, I_HW1, I_HB1, I_HF1, I_HW2, I_HB2, I_HF2, I_HW3, I_HBIAS };

typedef __attribute__((address_space(4))) const unsigned long long* kargp_t;
struct Ctx {
    LAS unsigned char* lds;
    kargp_t ka;
    unsigned char* ws;
    int tid, lane, wave, G, bid;
};
#define GAS __attribute__((address_space(1)))
#define KIN(i) ((const float*)(GAS const float*)c.ka[(i)])
#define KOUT() ((float*)(GAS float*)c.ka[36])
template <class T> __device__ __forceinline__ T* wsp(const Ctx& c, size_t off) { return (T*)(c.ws + off); }

__device__ __forceinline__ int wmap(int kind, int n) {
    if (kind == 0) { if (n < 192) return n; if (n < 224) return 320 + (n - 192); if (n < 256) return -1; if (n < 384) return 192 + (n - 256); if (n < 512) return -1; return n - 160; }
    if (kind == 2) return (n >> 6) * 128 + (n & 63);
    if (kind == 3) return (n >> 6) * 128 + 64 + (n & 63);
    return n;
}
__device__ __forceinline__ void wconv_tile(const Ctx& c, const float* src, int Ks, int Ns, int Nlim, bf16_t* dst, int Kp, int kind, int nt, int kt) {
    LAS float* T = (LAS float*)c.lds;
    const int n0 = nt * 64, k0 = kt * 64;
    for (int e = c.tid; e < 4096; e += 512) { const int kk = e >> 6, nn = e & 63, k = k0 + kk, n = n0 + nn; const int sc = (n < Nlim) ? wmap(kind, n) : -1;
        T[kk * 65 + nn] = (k < Ks && sc >= 0) ? src[(size_t)k * Ns + sc] : 0.f; }
    __syncthreads();
    for (int e = c.tid; e < 4096; e += 512) { const int nn = e >> 6, kk = e & 63; dst[(size_t)(n0 + nn) * Kp + k0 + kk] = f2bf(T[kk * 65 + nn]); }
    __syncthreads();
}

__device__ __forceinline__ void modv_job(const Ctx& c, int job) {
    const int l = job / 48, j0 = (job % 48) * 64;
    LAS float* sc = (LAS float*)c.lds;
    LAS float* red = sc + 17 * 1024;
    const float* cv = KIN(I_C); const float* cc = KIN(I_CCTX);
    for (int e = c.tid; e < 17 * 1024; e += 512) { const int r = e >> 10, k = e & 1023; const float v = (r < 16) ? cv[r * 1024 + k] : cc[k]; sc[e] = siluf(v); }
    __syncthreads();
    const int col = c.tid & 63, ks = c.tid >> 6;
    const float* w = KIN(I_WMOD) + (size_t)l * 1024 * 3072 + j0 + col;
    float acc[17];
#pragma unroll
    for (int r = 0; r < 17; ++r) acc[r] = 0.f;
    for (int k = ks * 128; k < ks * 128 + 128; ++k) { const float wv = w[(size_t)k * 3072];
#pragma unroll
        for (int r = 0; r < 17; ++r) acc[r] += sc[r * 1024 + k] * wv; }
#pragma unroll
    for (int r = 0; r < 17; ++r) red[(ks * 17 + r) * 64 + col] = acc[r];
    __syncthreads();
    float* mv = wsp<float>(c, WS_MODV);
    for (int e = c.tid; e < 17 * 64; e += 512) { const int r = e >> 6, cl = e & 63; float s = KIN(I_BMOD)[l * 3072 + j0 + cl];
#pragma unroll
        for (int q = 0; q < 8; ++q) s += red[(q * 17 + r) * 64 + cl];
        mv[((size_t)l * 17 + r) * 3072 + j0 + cl] = s; }
    __syncthreads();
}

__device__ __forceinline__ void rope_job(const Ctx& c) {
    float* rg = wsp<float>(c, WS_ROPEG); float* rm = wsp<float>(c, WS_ROPEM);
    for (int e = c.tid; e < 64 * 16; e += 512) { const int pos = e >> 4, f = e & 15; const float inv = powf(10000.f, -(float)(2 * f) / 32.f); const float a = (float)pos * inv; rg[e * 2] = cosf(a); rg[e * 2 + 1] = sinf(a); }
    for (int e = c.tid; e < 64 * 8; e += 512) { const int pos = e >> 3, f = e & 7; const float inv = powf(10000.f, -(float)(2 * f) / 16.f); const float a = (float)pos * inv; rm[e * 2] = cosf(a); rm[e * 2 + 1] = sinf(a); }
}

typedef float cpx __attribute__((ext_vector_type(2)));
#define CPX(a, b) ((cpx){(a), (b)})
__device__ __forceinline__ cpx cmul(cpx a, cpx b) { return CPX(a.x * b.x - a.y * b.y, a.x * b.y + a.y * b.x); }
__device__ __forceinline__ void ssm_tables_job(const Ctx& c, int job) {
    const int l = job >> 4, g = job & 15;
    LAS cpx* apow = (LAS cpx*)c.lds;
    LAS cpx* bbar = apow + 2 * 17 * 64;
    LAS cpx* cm = bbar + 2 * 64 * 16;
    LAS float* Kc = (LAS float*)(cm + 2 * 16 * 64);
    for (int e = c.tid; e < 2 * 64; e += 512) {
        const int d = e >> 6, p = e & 63; const size_t ix = (((size_t)l * 2 + d) * 16 + g) * 64 + p;
        const float lr = KIN(I_LRE)[ix], li = KIN(I_LIM)[ix], st = expf(KIN(I_LSTEP)[((size_t)l * 2 + d) * 16 + g]);
        for (int k = 0; k <= 16; ++k) { const float m = expf(lr * st * (float)k), an = li * st * (float)k; apow[(d * 17 + k) * 64 + p] = CPX(m * cosf(an), m * sinf(an)); }
    }
    __syncthreads();
    for (int e = c.tid; e < 2 * 64 * 16; e += 512) {
        const int d = e >> 10, p = (e >> 4) & 63, h = e & 15; const size_t ix = (((size_t)l * 2 + d) * 16 + g) * 64 + p;
        const float lr = KIN(I_LRE)[ix], li = KIN(I_LIM)[ix];
        const cpx a = apow[(d * 17 + 1) * 64 + p]; const cpx am1 = CPX(a.x - 1.f, a.y);
        const float den = lr * lr + li * li; const cpx q = CPX((am1.x * lr + am1.y * li) / den, (am1.y * lr - am1.x * li) / den);
        const cpx b = CPX(KIN(I_BRE)[ix * 16 + h], KIN(I_BIM)[ix * 16 + h]);
        bbar[e] = cmul(q, b);
        const size_t cx = ((((size_t)l * 2 + d) * 16 + g) * 16 + h) * 64 + p;
        cm[(d * 16 + h) * 64 + p] = CPX(KIN(I_CRE)[cx], KIN(I_CIM)[cx]);
    }
    __syncthreads();
    for (int e = c.tid; e < 2 * 16 * 256; e += 512) {
        const int d = e >> 12, dd = (e >> 8) & 15, ho = (e >> 4) & 15, hi = e & 15; float s = 0.f;
        for (int p = 0; p < 64; ++p) { const cpx w = cmul(cm[(d * 16 + ho) * 64 + p], apow[(d * 17 + dd) * 64 + p]); const cpx b = bbar[(d * 64 + p) * 16 + hi]; s += w.x * b.x - w.y * b.y; }
        Kc[e] = s;
    }
    __syncthreads();
    bf16_t* wkc = wsp<bf16_t>(c, WS_WKC) + ((size_t)l * 16 + g) * 256 * 512;
    for (int e = c.tid; e < 256 * 512; e += 512) {
        const int r = e >> 9, q = e & 511, i = r >> 4, ho = r & 15; float v;
        if (q < 256) { const int j = q >> 4, hi = q & 15; v = 0.f; if (j <= i) v += Kc[((0 * 16 + (i - j)) * 16 + ho) * 16 + hi]; if (j >= i) v += Kc[((1 * 16 + (j - i)) * 16 + ho) * 16 + hi]; }
        else { const int qq = q - 256, dq = qq >> 7, comp = (qq >> 6) & 1, p = qq & 63, k = dq == 0 ? i + 1 : 16 - i; const cpx w = cmul(cm[(dq * 16 + ho) * 64 + p], apow[(dq * 17 + k) * 64 + p]); v = comp == 0 ? w.x : -w.y; }
        wkc[e] = f2bf(v);
    }
    bf16_t* we = wsp<bf16_t>(c, WS_WE) + ((size_t)l * 16 + g) * 256 * 256;
    for (int e = c.tid; e < 256 * 256; e += 512) {
        const int qq = e >> 8, cidx = e & 255, j = cidx >> 4, hi = cidx & 15, dq = qq >> 7, comp = (qq >> 6) & 1, p = qq & 63, k = dq == 0 ? 15 - j : j;
        const cpx w = cmul(apow[(dq * 17 + k) * 64 + p], bbar[(dq * 64 + p) * 16 + hi]);
        we[e] = f2bf(comp == 0 ? w.x : w.y);
    }
    float* a16 = wsp<float>(c, WS_A16);
    for (int e = c.tid; e < 128; e += 512) { const int d = e >> 6, p = e & 63; const cpx a = apow[(d * 17 + 16) * 64 + p]; const size_t ix = ((((size_t)l * 2 + d) * 16 + g) * 64 + p) * 2; a16[ix] = a.x; a16[ix + 1] = a.y; }
    __syncthreads();
}

__device__ __forceinline__ void hyena_mlp_job(const Ctx& c, int job) {
    const int l = job / 136, tt = job % 136;
    const bool isctx = tt >= 128; const int n = isctx ? CTXL : SEQL; const int t0 = isctx ? (tt - 128) * 32 : tt * 32;
    LAS float* z = (LAS float*)c.lds;
    LAS float* h1 = z + 32 * 36;
    LAS float* h2 = h1 + 32 * 64;
    for (int e = c.tid; e < 32 * 33; e += 512) {
        const int ti = e / 33, f = e % 33, t = t0 + ti; float v;
        if (f == 0) v = (float)t / (float)(n - 1);
        else { const int k = (f - 1) & 15; const float band = 1e-4f + (float)k * ((15.f - 1e-4f) / 15.f); const float om = 6.283185307179586f * (float)t / (float)n; v = (f <= 16) ? cosf(band * om) : -sinf(band * om); }
        z[ti * 36 + f] = v;
    }
    __syncthreads();
    for (int e = c.tid; e < 32 * 64; e += 512) {
        const int ti = e >> 6, j = e & 63; float s = KIN(I_HB1)[l * 64 + j];
        for (int f = 0; f < 33; ++f) s += z[ti * 36 + f] * KIN(I_HW1)[((size_t)l * 33 + f) * 64 + j];
        h1[e] = sinf(KIN(I_HF1)[l * 64 + j] * s);
    }
    __syncthreads();
    for (int e = c.tid; e < 32 * 64; e += 512) {
        const int ti = e >> 6, j = e & 63; float s = KIN(I_HB2)[l * 64 + j];
        for (int f = 0; f < 64; ++f) s += h1[ti * 64 + f] * KIN(I_HW2)[((size_t)l * 64 + f) * 64 + j];
        h2[e] = sinf(KIN(I_HF2)[l * 64 + j] * s);
    }
    __syncthreads();
    float* hT = wsp<float>(c, WS_HT) + (size_t)l * 1024 * NTOK;
    const float mind = -3.070113457325394f, maxd = -15.35056728662697f;
#pragma unroll
    for (int cc = 0; cc < 2; ++cc) {
        const int col = c.tid + cc * 512;
        float acc[32];
#pragma unroll
        for (int ti = 0; ti < 32; ++ti) acc[ti] = 0.f;
        for (int f = 0; f < 64; ++f) { const float w = KIN(I_HW3)[((size_t)l * 64 + f) * 1024 + col];
#pragma unroll
            for (int ti = 0; ti < 32; ++ti) acc[ti] += h2[ti * 64 + f] * w; }
        const int ch = col & 255; const float delta = fabsf(mind + (maxd - mind) * (float)ch / 255.f);
        float* dst = hT + (size_t)col * NTOK + (isctx ? SEQL : 0) + t0;
#pragma unroll
        for (int ti = 0; ti < 32; ++ti) { const float tn = (float)(t0 + ti) / (float)(n - 1); dst[ti] = acc[ti] * expf(-tn * delta); }
    }
    __syncthreads();
}

__device__ __forceinline__ void hyena_pack_job(const Ctx& c, int job) {
    const int l = job >> 9, o = (job >> 8) & 1, ch = job & 255;
    const float* hT = wsp<float>(c, WS_HT) + (size_t)l * 1024 * NTOK;
    const float* fw = hT + (size_t)(o * 512 + ch) * NTOK; const float* bw = hT + (size_t)(o * 512 + 256 + ch) * NTOK;
    LAS float* red = (LAS float*)c.lds;
    float s0 = 0.f, s1 = 0.f;
    for (int t = c.tid; t < SEQL; t += 512) { const float a = fw[t], b = bw[t]; s0 += a * a + b * b; }
    if (c.tid < CTXL) { const float a = fw[SEQL + c.tid], b = bw[SEQL + c.tid]; s1 = a * a + b * b; }
    s0 = wave_sum(s0); s1 = wave_sum(s1);
    if (c.lane == 0) { red[c.wave] = s0; red[8 + c.wave] = s1; }
    __syncthreads();
    float t0 = 0.f, t1 = 0.f;
#pragma unroll
    for (int w = 0; w < 8; ++w) { t0 += red[w]; t1 += red[8 + w]; }
    const float r0 = rsqrtf(t0 + EPS), r1 = rsqrtf(t1 + EPS);
    bf16_t* gr = wsp<bf16_t>(c, WS_GR) + (((size_t)l * 2 + o) * 256 + ch) * 8192;
    for (int e = c.tid; e < 8192; e += 512) { float v; if (e <= 4095) v = fw[4095 - e]; else if (e < 8191) v = bw[e - 4095]; else v = 0.f; gr[e] = f2bf(v * r0); }
    bf16_t* grc = wsp<bf16_t>(c, WS_GRC) + (((size_t)l * 2 + o) * 256 + ch) * 512;
    { const int e = c.tid; float v; if (e <= 255) v = fw[SEQL + 255 - e]; else if (e < 511) v = bw[SEQL + e - 255]; else v = 0.f; grc[e] = f2bf(v * r1); }
    __syncthreads();
}

__device__ __forceinline__ void norm_rows(const Ctx& c, int l  , int next  ) {
    const float* mvl = wsp<float>(c, WS_MODV) + (size_t)(l < 0 ? 0 : l) * 17 * 3072;
    const float* mvn = wsp<float>(c, WS_MODV) + (size_t)(next < 0 ? 0 : next) * 17 * 3072;
    const bf16_t* outb = wsp<bf16_t>(c, WS_OUTB);
    bf16_t* hb = wsp<bf16_t>(c, WS_HCAT);
    float* ctxr = wsp<float>(c, WS_CTXR);
    const int nw = c.G * 8;
    for (int row = c.bid * 8 + c.wave; row < MROWS; row += nw) {
        const int b = row / NTOK, j = row - b * NTOK; const bool isctx = j >= SEQL;
        if (next < 0 && isctx) continue;
        const int mr = isctx ? 16 : b;
        const float* xin; float* xout;
        if (isctx) { xout = ctxr + ((size_t)b * CTXL + (j - SEQL)) * DM; xin = (l < 0) ? KIN(I_CTX) + ((size_t)b * CTXL + (j - SEQL)) * DM : xout; }
        else { xout = KOUT() + ((size_t)b * SEQL + j) * DM; xin = (l <= 0) ? KIN(I_X) + ((size_t)b * SEQL + j) * DM : xout; }
        f32x4 xv[4];
#pragma unroll
        for (int q = 0; q < 4; ++q) xv[q] = *(const f32x4*)(xin + q * 256 + c.lane * 4);
        if (l >= 0) {
            float ov[16]; float ss = 0.f;
#pragma unroll
            for (int q = 0; q < 4; ++q) { const u32x2 w = *(const u32x2*)(outb + (size_t)row * DM + q * 256 + c.lane * 4); ov[q * 4] = lo_bf(w.x); ov[q * 4 + 1] = hi_bf(w.x); ov[q * 4 + 2] = lo_bf(w.y); ov[q * 4 + 3] = hi_bf(w.y); }
#pragma unroll
            for (int i = 0; i < 16; ++i) ss += ov[i] * ov[i];
            ss = wave_sum(ss); const float rs = rsqrtf(ss * (1.f / DM) + EPS);
#pragma unroll
            for (int q = 0; q < 4; ++q) { const int col = q * 256 + c.lane * 4; const f32x4 gp = *(const f32x4*)(KIN(I_GPOST) + l * DM + col); const f32x4 gt = *(const f32x4*)(mvl + mr * 3072 + 2048 + col);
#pragma unroll
                for (int i = 0; i < 4; ++i) xv[q][i] += gt[i] * (ov[q * 4 + i] * rs * gp[i]); }
        }
        if (l >= 0 || isctx) {
#pragma unroll
            for (int q = 0; q < 4; ++q) *(f32x4*)(xout + q * 256 + c.lane * 4) = xv[q];
        }
        if (next >= 0) {
            float ss = 0.f;
#pragma unroll
            for (int q = 0; q < 4; ++q)
#pragma unroll
                for (int i = 0; i < 4; ++i) ss += xv[q][i] * xv[q][i];
            ss = wave_sum(ss); const float rs = rsqrtf(ss * (1.f / DM) + EPS);
#pragma unroll
            for (int q = 0; q < 4; ++q) { const int col = q * 256 + c.lane * 4; const f32x4 gp = *(const f32x4*)(KIN(I_GPRE) + next * DM + col);
                const f32x4 sh = *(const f32x4*)(mvn + mr * 3072 + col), sc = *(const f32x4*)(mvn + mr * 3072 + 1024 + col);
                float hv[4];
#pragma unroll
                for (int i = 0; i < 4; ++i) hv[i] = xv[q][i] * rs * gp[i] * (1.f + sc[i]) + sh[i];
                u32x2 w; w.x = cvt_pk_bf16(hv[0], hv[1]); w.y = cvt_pk_bf16(hv[2], hv[3]); *(u32x2*)(hb + (size_t)row * DM + col) = w; }
        }
    }
}

__device__ __forceinline__ void p2_rows(const Ctx& c, int l) {
    bf16_t* pb = wsp<bf16_t>(c, WS_PB);
    bf16_t* B0 = pb; bf16_t* B1 = pb + BLKE; bf16_t* B3 = pb + 3 * BLKE; const bf16_t* B4 = pb + 4 * BLKE; const bf16_t* B6 = pb + 6 * BLKE;
    bf16_t* kr = wsp<bf16_t>(c, WS_KR); bf16_t* kg = wsp<bf16_t>(c, WS_KG); bf16_t* ug = wsp<bf16_t>(c, WS_UG); bf16_t* us = wsp<bf16_t>(c, WS_US);
    const float* ropeG = wsp<float>(c, WS_ROPEG); const float* ropeM = wsp<float>(c, WS_ROPEM);
    const int lane = c.lane;
    for (int row = c.bid * 8 + c.wave; row < MROWS; row += c.G * 8) {
        const int b = row / NTOK, j = row - b * NTOK; const bool islat = j < SEQL; const int rowpos = (j >> 6) & 63, colpos = j & 63;
        const size_t ro = (size_t)row * 256 + lane * 4;
        {
            const u32x2 w = *(const u32x2*)(B0 + ro); float x[4] = {lo_bf(w.x), hi_bf(w.x), lo_bf(w.y), hi_bf(w.y)};
            float ss = (lane < 48) ? (x[0] * x[0] + x[1] * x[1] + x[2] * x[2] + x[3] * x[3]) : 0.f; ss = wave_sum(ss);
            const float rs = rsqrtf(ss * (1.f / 192.f) + EPS);
            float xp[4];
#pragma unroll
            for (int i = 0; i < 4; ++i) xp[i] = __shfl_xor(x[i], 2);
            u32x2 o; o.x = 0u; o.y = 0u;
            if (lane < 48) { const f32x4 g = *(const f32x4*)(KIN(I_GCQ) + l * 192 + lane * 4); o.x = cvt_pk_bf16(x[0] * rs * g[0], x[1] * rs * g[1]); o.y = cvt_pk_bf16(x[2] * rs * g[2], x[3] * rs * g[3]); }
            else if (lane < 56) {
                const int t = lane - 48; float y[4];
                if (islat) { const int pos = (t & 4) ? colpos : rowpos; const bool isx2 = (t & 2) != 0;
#pragma unroll
                    for (int i = 0; i < 4; ++i) { const int f = 4 * (t & 1) + i; const float cs = ropeM[(pos * 8 + f) * 2], sn = ropeM[(pos * 8 + f) * 2 + 1]; y[i] = isx2 ? (xp[i] * sn + x[i] * cs) : (x[i] * cs - xp[i] * sn); } }
                else {
#pragma unroll
                    for (int i = 0; i < 4; ++i) y[i] = x[i]; }
                u32x2 kk; kk.x = cvt_pk_bf16(y[0], y[1]); kk.y = cvt_pk_bf16(y[2], y[3]); *(u32x2*)(kr + (size_t)row * 32 + t * 4) = kk;
            }
            *(u32x2*)(B0 + ro) = o;
        }
        {
            const u32x2 w = *(const u32x2*)(B1 + ro); float x[4] = {lo_bf(w.x), hi_bf(w.x), lo_bf(w.y), hi_bf(w.y)};
            float ss = (lane < 32) ? (x[0] * x[0] + x[1] * x[1] + x[2] * x[2] + x[3] * x[3]) : 0.f; ss = wave_sum(ss);
            const float rs = rsqrtf(ss * (1.f / 128.f) + EPS);
            u32x2 o; o.x = 0u; o.y = 0u;
            if (lane < 32) { const f32x4 g = *(const f32x4*)(KIN(I_GCKV) + l * 128 + lane * 4); o.x = cvt_pk_bf16(x[0] * rs * g[0], x[1] * rs * g[1]); o.y = cvt_pk_bf16(x[2] * rs * g[2], x[3] * rs * g[3]); }
            *(u32x2*)(B1 + ro) = o;
        }
#pragma unroll
        for (int which = 0; which < 2; ++which) {
            const bf16_t* src = which == 0 ? B3 : B4;
            const u32x2 w = *(const u32x2*)(src + ro); float x[4] = {lo_bf(w.x), hi_bf(w.x), lo_bf(w.y), hi_bf(w.y)};
            float ss = x[0] * x[0] + x[1] * x[1] + x[2] * x[2] + x[3] * x[3];
            ss += __shfl_xor(ss, 1); ss += __shfl_xor(ss, 2); ss += __shfl_xor(ss, 4); ss += __shfl_xor(ss, 8);
            const float rs = rsqrtf(ss * (1.f / 64.f) + EPS);
            const int t = lane & 15; const f32x4 g = *(const f32x4*)(KIN(which == 0 ? I_GQ : I_GK) + l * 64 + t * 4);
#pragma unroll
            for (int i = 0; i < 4; ++i) x[i] = x[i] * rs * g[i];
            float xp[4];
#pragma unroll
            for (int i = 0; i < 4; ++i) xp[i] = __shfl_xor(x[i], 4);
            if (islat) { const int pos = (t & 8) ? colpos : rowpos; const bool isx2 = (t & 4) != 0;
#pragma unroll
                for (int i = 0; i < 4; ++i) { const int f = 4 * (t & 3) + i; const float cs = ropeG[(pos * 16 + f) * 2], sn = ropeG[(pos * 16 + f) * 2 + 1]; x[i] = isx2 ? (xp[i] * sn + x[i] * cs) : (x[i] * cs - xp[i] * sn); } }
            if (which == 0) { const float qs = 0.125f * LOG2E; u32x2 o; o.x = cvt_pk_bf16(x[0] * qs, x[1] * qs); o.y = cvt_pk_bf16(x[2] * qs, x[3] * qs); *(u32x2*)(B3 + ro) = o; }
            else if (lane < 32) { u32x2 o; o.x = cvt_pk_bf16(x[0], x[1]); o.y = cvt_pk_bf16(x[2], x[3]); *(u32x2*)(kg + ((size_t)(b * 2 + (lane >> 4)) * NTOK + j) * 64 + t * 4) = o; }
        }
        {
            const u32x2 w = *(const u32x2*)(B6 + ro); const int g = lane >> 2, hi0 = (lane & 3) * 4;
            *(u32x2*)(ug + ((size_t)g * MROWS + row) * 16 + hi0) = w;
            *(u32x2*)(us + ((size_t)g * NCHUNK + (row >> 4)) * 512 + (row & 15) * 16 + hi0) = w;
        }
    }
}
__device__ __forceinline__ void p2_tiles(const Ctx& c, int l) {
    const bf16_t* pb = wsp<bf16_t>(c, WS_PB);
    bf16_t* vtg = wsp<bf16_t>(c, WS_VTG);
    LAS bf16_t* T = (LAS bf16_t*)c.lds;
    LAS unsigned* T32 = (LAS unsigned*)c.lds;
    const int piece = c.tid & 7, chl = c.tid >> 3;
    for (int tl = c.bid; tl < NB * 68; tl += c.G) {
        const int b = tl / 68, jt = tl - b * 68, j0 = jt * 64; const int lo = jt < 64 ? 0 : SEQL, hi = jt < 64 ? SEQL : NTOK;
        const size_t rbase = (size_t)b * NTOK;
        for (int e = c.tid; e < 64 * 16; e += 512) { const int r = e >> 4, pc = e & 15; const u32x4 w = *(const u32x4*)(pb + 4 * BLKE + (rbase + j0 + r) * 256 + 128 + pc * 8);
            LAS unsigned* d = T32 + (r * 516 + pc * 16) / 4; d[0] = w.x; d[1] = w.y; d[2] = w.z; d[3] = w.w; }
        __syncthreads();
#pragma unroll
        for (int ps = 0; ps < 2; ++ps) { const int dvf = chl + ps * 64; float v[8];
#pragma unroll
            for (int i = 0; i < 8; ++i) v[i] = bf2f(T[(piece * 8 + i) * 258 + dvf]);
            u32x4 w; w.x = cvt_pk_bf16(v[0], v[1]); w.y = cvt_pk_bf16(v[2], v[3]); w.z = cvt_pk_bf16(v[4], v[5]); w.w = cvt_pk_bf16(v[6], v[7]);
            *(u32x4*)(vtg + ((size_t)(b * 2 + (dvf >> 6)) * 64 + (dvf & 63)) * NTOK + j0 + piece * 8) = w; }
        __syncthreads();
        for (int blk = 8; blk < 12; ++blk) {
            for (int e = c.tid; e < 66 * 32; e += 512) { const int r = e >> 5, pc = e & 31, j = j0 - 1 + r; u32x4 w = {0u, 0u, 0u, 0u};
                if (j >= lo && j < hi) w = *(const u32x4*)(pb + (size_t)blk * BLKE + (rbase + j) * 256 + pc * 8);
                LAS unsigned* d = T32 + (r * 516 + pc * 16) / 4; d[0] = w.x; d[1] = w.y; d[2] = w.z; d[3] = w.w; }
            __syncthreads();
            bf16_t* dst = wsp<bf16_t>(c, blk == 8 ? WS_HYV : blk == 9 ? WS_HYX1 : blk == 10 ? WS_HYX2 : WS_HYG);
#pragma unroll
            for (int ps = 0; ps < 4; ++ps) { const int ch = chl + ps * 64; float v[8];
                if (blk < 11) { const int cc = (blk - 8) * 256 + ch; const float w0 = KIN(I_HCW)[((size_t)l * 3 + 0) * 768 + cc], w1 = KIN(I_HCW)[((size_t)l * 3 + 1) * 768 + cc], w2 = KIN(I_HCW)[((size_t)l * 3 + 2) * 768 + cc], bs = KIN(I_HCB)[l * 768 + cc];
                    float xm = bf2f(T[(piece * 8) * 258 + ch]), x0 = bf2f(T[(piece * 8 + 1) * 258 + ch]);
#pragma unroll
                    for (int i = 0; i < 8; ++i) { const float x1 = bf2f(T[(piece * 8 + i + 2) * 258 + ch]); v[i] = w0 * xm + w1 * x0 + w2 * x1 + bs; xm = x0; x0 = x1; } }
                else {
#pragma unroll
                    for (int i = 0; i < 8; ++i) v[i] = siluf(bf2f(T[(piece * 8 + i + 1) * 258 + ch])); }
                u32x4 w; w.x = cvt_pk_bf16(v[0], v[1]); w.y = cvt_pk_bf16(v[2], v[3]); w.z = cvt_pk_bf16(v[4], v[5]); w.w = cvt_pk_bf16(v[6], v[7]);
                *(u32x4*)(dst + ((size_t)ch * 16 + b) * NTOK + j0 + piece * 8) = w; }
            __syncthreads();
        }
    }
}

template <int DK>
__device__ __forceinline__ void attn_unit(const Ctx& c, const bf16_t* Qp, int qpitch, const bf16_t* Kp, const bf16_t* Vtp, int kt0, int nkt,
                                          const bf16_t* gatep, bf16_t* outp, bool rope, int j0, float qscale, const float* ropeM) {
    constexpr int KS = DK / 16, KPC = DK / 8, KPITCH = DK * 2 + 16, KB = 64 * KPITCH, VPITCH = 136, VB = 64 * VPITCH, BUFB = KB + VB;
    static_assert(BUFB % 16 == 0, "attention LDS buffer alignment");
    const int tid = c.tid, lane = c.lane, q = lane & 31, h = lane >> 5, wave = c.wave;
    LAS unsigned char* lds = c.lds;
    bf16x8 qf[KS];
    {
        const bf16_t* qrow = Qp + (size_t)(wave * 32 + q) * qpitch + 8 * h;
#pragma unroll
        for (int ks = 0; ks < KS; ++ks) qf[ks] = *(const bf16x8*)(qrow + 16 * ks);
        if (DK == 96) {
            const int jj = j0 + wave * 32 + q;
#pragma unroll
            for (int ks = 0; ks < KS; ++ks) {
                float x[8]; unpack8(__builtin_bit_cast(u32x4, qf[ks]), x);
                if (ks >= 4) {
                    const int pos = (ks == 4) ? ((jj >> 6) & 63) : (jj & 63);
#pragma unroll
                    for (int e = 0; e < 8; ++e) { const float xp = __shfl_xor(x[e], 32); const float cs = ropeM[(pos * 8 + e) * 2], sn = ropeM[(pos * 8 + e) * 2 + 1];
                        const float r = h ? (xp * sn + x[e] * cs) : (x[e] * cs - xp * sn); x[e] = rope ? r : x[e]; }
                }
                u32x4 w; w.x = cvt_pk_bf16(x[0] * qscale, x[1] * qscale); w.y = cvt_pk_bf16(x[2] * qscale, x[3] * qscale); w.z = cvt_pk_bf16(x[4] * qscale, x[5] * qscale); w.w = cvt_pk_bf16(x[6] * qscale, x[7] * qscale);
                qf[ks] = __builtin_bit_cast(bf16x8, w);
            }
        }
    }
    f32x16 o0, o1;
#pragma unroll
    for (int i = 0; i < 16; ++i) { o0[i] = 0.f; o1[i] = 0.f; }
    float mrun = -1e30f, lrun = 0.f;
    const int kr0 = tid / KPC, kp0 = tid % KPC, kr1 = (tid + 512) / KPC, kp1 = (tid + 512) % KPC; const bool has2 = (DK == 96) && tid < 256;
    const int vdv = tid >> 3, vpc = tid & 7;
    u32x4 kreg0, kreg1 = {0u, 0u, 0u, 0u}, vreg;
#define AT_GLOAD(kt) do { const size_t key0 = (size_t)(kt) * 64; kreg0 = *(const u32x4*)(Kp + (key0 + kr0) * DK + kp0 * 8); if (has2) kreg1 = *(const u32x4*)(Kp + (key0 + kr1) * DK + kp1 * 8); \
        vreg = *(const u32x4*)(Vtp + (size_t)vdv * NTOK + key0 + vpc * 8); } while (0)
#define AT_LWRITE(bi) do { LAS unsigned char* bb = lds + (bi) * BUFB; *(LAS u32x4*)(bb + kr0 * KPITCH + kp0 * 16) = kreg0; if (has2) *(LAS u32x4*)(bb + kr1 * KPITCH + kp1 * 16) = kreg1; \
        LAS u32x2* vd = (LAS u32x2*)(bb + KB + vdv * VPITCH + vpc * 16); vd[0] = (u32x2){vreg.x, vreg.y}; vd[1] = (u32x2){vreg.z, vreg.w}; } while (0)
    AT_GLOAD(kt0); AT_LWRITE(0);
    __syncthreads();
    for (int t = 0; t < nkt; ++t) {
        const bool more = (t + 1 < nkt);
        if (more) AT_GLOAD(kt0 + t + 1);
        const LAS unsigned char* kb = lds + (t & 1) * BUFB;
        f32x16 s0, s1;
#pragma unroll
        for (int i = 0; i < 16; ++i) { s0[i] = 0.f; s1[i] = 0.f; }
#pragma unroll
        for (int ks = 0; ks < KS; ++ks) {
            const bf16x8 a0 = *(const LAS bf16x8*)(kb + q * KPITCH + (16 * ks + 8 * h) * 2);
            const bf16x8 a1 = *(const LAS bf16x8*)(kb + (32 + q) * KPITCH + (16 * ks + 8 * h) * 2);
            s0 = __builtin_amdgcn_mfma_f32_32x32x16_bf16(a0, qf[ks], s0, 0, 0, 0);
            s1 = __builtin_amdgcn_mfma_f32_32x32x16_bf16(a1, qf[ks], s1, 0, 0, 0);
        }
        float mx = fmaxf(s0[0], s1[0]);
#pragma unroll
        for (int i = 1; i < 16; ++i) mx = fmaxf(mx, fmaxf(s0[i], s1[i]));
        mx = fmaxf(mx, __shfl_xor(mx, 32));
        const float mnew = fmaxf(mrun, mx), alpha = __builtin_amdgcn_exp2f(mrun - mnew); mrun = mnew;
        float ps = 0.f;
#pragma unroll
        for (int i = 0; i < 16; ++i) { s0[i] = __builtin_amdgcn_exp2f(s0[i] - mnew); s1[i] = __builtin_amdgcn_exp2f(s1[i] - mnew); ps += s0[i] + s1[i]; }
        lrun = lrun * alpha + ps;
#pragma unroll
        for (int i = 0; i < 16; ++i) { o0[i] *= alpha; o1[i] *= alpha; }
        bf16x8 pk[4];
#pragma unroll
        for (int st = 0; st < 4; ++st) { u32x4 w;
            if (st < 2) { w.x = cvt_pk_bf16(s0[8 * st], s0[8 * st + 1]); w.y = cvt_pk_bf16(s0[8 * st + 2], s0[8 * st + 3]); w.z = cvt_pk_bf16(s0[8 * st + 4], s0[8 * st + 5]); w.w = cvt_pk_bf16(s0[8 * st + 6], s0[8 * st + 7]); }
            else { const int b8 = 8 * (st - 2); w.x = cvt_pk_bf16(s1[b8], s1[b8 + 1]); w.y = cvt_pk_bf16(s1[b8 + 2], s1[b8 + 3]); w.z = cvt_pk_bf16(s1[b8 + 4], s1[b8 + 5]); w.w = cvt_pk_bf16(s1[b8 + 6], s1[b8 + 7]); }
            pk[st] = __builtin_bit_cast(bf16x8, w); }
        const LAS unsigned char* vb = kb + KB;
#pragma unroll
        for (int st = 0; st < 4; ++st) {
            const LAS unsigned char* a0p = vb + q * VPITCH + (16 * st + 4 * h) * 2;
            const LAS unsigned char* a1p = vb + (32 + q) * VPITCH + (16 * st + 4 * h) * 2;
            const u32x2 l0 = *(const LAS u32x2*)a0p, h0 = *(const LAS u32x2*)(a0p + 16), l1 = *(const LAS u32x2*)a1p, h1 = *(const LAS u32x2*)(a1p + 16);
            const bf16x8 va0 = __builtin_bit_cast(bf16x8, (u32x4){l0.x, l0.y, h0.x, h0.y}), va1 = __builtin_bit_cast(bf16x8, (u32x4){l1.x, l1.y, h1.x, h1.y});
            o0 = __builtin_amdgcn_mfma_f32_32x32x16_bf16(va0, pk[st], o0, 0, 0, 0);
            o1 = __builtin_amdgcn_mfma_f32_32x32x16_bf16(va1, pk[st], o1, 0, 0, 0);
        }
        if (more) AT_LWRITE((t + 1) & 1);
        __syncthreads();
    }
#undef AT_GLOAD
#undef AT_LWRITE
    const float lt = lrun + __shfl_xor(lrun, 32), inv = 1.f / lt;
    const size_t row = (size_t)(wave * 32 + q);
#pragma unroll
    for (int dt = 0; dt < 2; ++dt)
#pragma unroll
        for (int g4 = 0; g4 < 4; ++g4) {
            const int dv0 = dt * 32 + 8 * g4 + 4 * h;
            const u32x2 gw = *(const u32x2*)(gatep + row * 256 + dv0);
            const float g0 = siluf(lo_bf(gw.x)), g1 = siluf(hi_bf(gw.x)), g2 = siluf(lo_bf(gw.y)), g3 = siluf(hi_bf(gw.y));
            const f32x16& o = dt ? o1 : o0;
            u32x2 w; w.x = cvt_pk_bf16(o[4 * g4] * inv * g0, o[4 * g4 + 1] * inv * g1); w.y = cvt_pk_bf16(o[4 * g4 + 2] * inv * g2, o[4 * g4 + 3] * inv * g3);
            *(u32x2*)(outp + row * DM + dv0) = w;
        }
}

template <int N>
__device__ __forceinline__ void hyena_conv(const Ctx& c, LAS unsigned char* ub, LAS unsigned char* gb, int pass, const bf16_t* xmul  , float bias,
                                           bf16_t* zdst  , const bf16_t* gmul, bf16_t* cat  ) {
    constexpr int UP = N * 2 + 16, NTT = N / 128, OFF8 = N - 8;
    const int lane = c.lane, i16 = lane & 15, kq = lane >> 4;
    for (int tt = c.wave; tt < NTT; tt += 8) {
        const int t0 = tt * 128;
        f32x4 acc[8];
#pragma unroll
        for (int m = 0; m < 8; ++m) acc[m] = (f32x4){0.f, 0.f, 0.f, 0.f};
        const LAS unsigned char* up = ub + i16 * UP + kq * 16;
        const LAS unsigned char* gp = gb + (OFF8 - t0 - 8 * i16 + 8 * kq) * 2;
#pragma unroll 2
        for (int s0 = 0; s0 < N; s0 += 32) {
            const bf16x8 bfr = *(const LAS bf16x8*)(up + s0 * 2);
            const u32x4 wa = *(const LAS u32x4*)(gp + s0 * 2), wb = *(const LAS u32x4*)(gp + s0 * 2 + 16);
            const unsigned w[8] = {wa.x, wa.y, wa.z, wa.w, wb.x, wb.y, wb.z, wb.w};
            unsigned sh[7];
#pragma unroll
            for (int k = 0; k < 7; ++k) sh[k] = __builtin_amdgcn_alignbit(w[k + 1], w[k], 16);
#pragma unroll
            for (int m = 0; m < 8; ++m) {
                u32x4 a;
                if (m & 1) { const int d0 = (7 - m) >> 1; a = (u32x4){w[d0], w[d0 + 1], w[d0 + 2], w[d0 + 3]}; }
                else { const int d0 = (6 - m) >> 1; a = (u32x4){sh[d0], sh[d0 + 1], sh[d0 + 2], sh[d0 + 3]}; }
                acc[m] = __builtin_amdgcn_mfma_f32_16x16x32_bf16(__builtin_bit_cast(bf16x8, a), bfr, acc[m], 0, 0, 0);
            }
        }
#pragma unroll
        for (int r = 0; r < 4; ++r) {
            const int t8 = t0 + 32 * kq + 8 * r;
            float uu[8], xm[8]; unpack8(*(const LAS u32x4*)(ub + i16 * UP + t8 * 2), uu); unpack8(*(const u32x4*)(xmul + (size_t)i16 * NTOK + t8), xm);
            float y[8];
#pragma unroll
            for (int m = 0; m < 8; ++m) y[m] = xm[m] * (acc[m][r] + bias * uu[m]);
            if (pass == 0) { u32x4 o; o.x = cvt_pk_bf16(y[0], y[1]); o.y = cvt_pk_bf16(y[2], y[3]); o.z = cvt_pk_bf16(y[4], y[5]); o.w = cvt_pk_bf16(y[6], y[7]); *(u32x4*)(zdst + (size_t)i16 * NTOK + t8) = o; }
            else { float gg[8]; unpack8(*(const u32x4*)(gmul + (size_t)i16 * NTOK + t8), gg);
#pragma unroll
                for (int m = 0; m < 8; ++m) cat[((size_t)i16 * NTOK + t8 + m) * DM] = f2bf(y[m] * gg[m]); }
        }
    }
}
template <int N>
__device__ __forceinline__ void hyena_seq(const Ctx& c, int l, int ch, int toff) {
    constexpr int UP = N * 2 + 16;
    LAS unsigned char* ub = c.lds; LAS unsigned char* gb = c.lds + 16 * UP;
    bf16_t* vz = wsp<bf16_t>(c, WS_HYV) + (size_t)ch * 16 * NTOK + toff;
    const bf16_t* x1 = wsp<bf16_t>(c, WS_HYX1) + (size_t)ch * 16 * NTOK + toff;
    const bf16_t* x2 = wsp<bf16_t>(c, WS_HYX2) + (size_t)ch * 16 * NTOK + toff;
    const bf16_t* gm = wsp<bf16_t>(c, WS_HYG) + (size_t)ch * 16 * NTOK + toff;
    bf16_t* cat = wsp<bf16_t>(c, WS_HCAT) + (size_t)toff * DM + 768 + ch;
    for (int pass = 0; pass < 2; ++pass) {
        const bf16_t* gr = (N == SEQL) ? wsp<bf16_t>(c, WS_GR) + (((size_t)l * 2 + pass) * 256 + ch) * 8192 : wsp<bf16_t>(c, WS_GRC) + (((size_t)l * 2 + pass) * 256 + ch) * 512;
        for (int e = c.tid; e < 2 * N / 8; e += 512) *(LAS u32x4*)(gb + e * 16) = *(const u32x4*)(gr + e * 8);
        for (int e = c.tid; e < 16 * N / 8; e += 512) { const int b = e / (N / 8), pc = e % (N / 8); *(LAS u32x4*)(ub + b * UP + pc * 16) = *(const u32x4*)(vz + (size_t)b * NTOK + pc * 8); }
        __syncthreads();
        const float bias = KIN(I_HBIAS)[((size_t)l * 2 + pass) * 256 + ch];
        hyena_conv<N>(c, ub, gb, pass, pass == 0 ? x1 : x2, bias, vz, gm, cat);
        asm volatile("s_waitcnt vmcnt(0)" ::: "memory");
        __syncthreads();
    }
}

__device__ __forceinline__ void ssm_scan_item(const Ctx& c, int l, int item) {
    const int b = item >> 2, g = (item & 3) * 4 + (c.tid >> 7), dq = (c.tid >> 6) & 1, p = c.tid & 63;
    const float* a16 = wsp<float>(c, WS_A16) + ((((size_t)l * 2 + dq) * 16 + g) * 64 + p) * 2;
    const float ar = a16[0], ai = a16[1];
    const bf16_t* E = wsp<bf16_t>(c, WS_E); bf16_t* US = wsp<bf16_t>(c, WS_US);
    float sr = 0.f, si = 0.f;
    for (int st0 = 0; st0 < NCHB; st0 += 8) {
        float er[8], ei[8]; size_t ro[8];
#pragma unroll
        for (int k = 0; k < 8; ++k) { const int st = st0 + k; const int cc = dq == 0 ? (st < 16 ? 256 + st : st - 16) : (st < 16 ? 271 - st : 255 - (st - 16));
            ro[k] = (size_t)g * NCHUNK + (size_t)b * NCHB + cc; er[k] = bf2f(E[ro[k] * 256 + dq * 128 + p]); ei[k] = bf2f(E[ro[k] * 256 + dq * 128 + 64 + p]); }
#pragma unroll
        for (int k = 0; k < 8; ++k) {
            US[ro[k] * 512 + 256 + dq * 128 + p] = f2bf(sr); US[ro[k] * 512 + 256 + dq * 128 + 64 + p] = f2bf(si);
            const float nr = ar * sr - ai * si + er[k], ni = ar * si + ai * sr + ei[k]; sr = nr; si = ni;
        }
    }
}

constexpr int LDS_BYTES = 155648;
constexpr int LDS_MISC = LDS_BYTES - 256;
constexpr int NPRO = 2, NPH = 8, NPHASES = NPRO + DEPTH * NPH;
constexpr int QI_HY = 256, QI_SCAN = 64, QI_ATT = NB * 8 * 17;
constexpr int QI_TOTAL = QI_HY + QI_SCAN + QI_ATT;

__global__ void __launch_bounds__(512, 2) mk_fwd(Params prm) {
    extern __shared__ __attribute__((aligned(16))) unsigned char lds_raw[];
    Ctx c; c.lds = (LAS unsigned char*)lds_raw; c.ka = (kargp_t)__builtin_amdgcn_kernarg_segment_ptr(); c.ws = prm.ws; c.tid = threadIdx.x; c.lane = c.tid & 63; c.wave = __builtin_amdgcn_readfirstlane(c.tid >> 6); c.G = gridDim.x; c.bid = blockIdx.x;
    const int wave0 = c.wave;
    volatile LAS unsigned* misc = (volatile LAS unsigned*)(c.lds + LDS_MISC);
    if (c.tid < 16) misc[c.tid] = 0u;
    __syncthreads();
    unsigned* ctl = wsp<unsigned>(c, WS_CTL);
    const int lo = prm.ph_lo, hi = prm.ph_hi;
    const bool fused = (hi - lo) > 1;
    XcdBarrier bar; bar.bar = ctl + CW_BAR; bar.x = 0; bar.st = misc;
    if (fused) bar = xcd_barrier_post(ctl + CW_BAR, misc);
#ifndef SITE_MASK
#define SITE_MASK 0x3ff
#endif
#define SITE(n) (((SITE_MASK) >> (n)) & 1)
#define IN(k) (lo <= (k) && (k) < hi)
#define FRESH() do { { kargp_t _k = (kargp_t)__builtin_amdgcn_kernarg_segment_ptr(); asm volatile("" : "+s"(_k)); c.ka = _k; c.ws = (unsigned char*)(GAS unsigned char*)_k[37]; } { int _w = wave0; asm volatile("" : "+s"(_w)); c.wave = _w; c.lane = opaque((int)__builtin_amdgcn_mbcnt_hi(~0u, __builtin_amdgcn_mbcnt_lo(~0u, 0u))); c.tid = c.wave * 64 + c.lane; } } while (0)
#define SEAM(k) do { if (IN((k) + 1)) xcd_barrier(bar); } while (0)

    if (SITE(0) && IN(0)) {
        FRESH();
        constexpr int J_SSM = 64, J_HY = 544, J_MOD = 192, J_WIN = 4 * 48 * 16, J_WOUT = 4 * 16 * 16, J_WUQ = 4 * 8 * 4, J_W256 = 4 * 4 * 4;
        constexpr int J0 = J_SSM, J1 = J0 + J_HY, J2 = J1 + J_MOD, J3 = J2 + J_WIN, J4 = J3 + J_WOUT, J5 = J4 + J_WUQ, J6 = J5 + J_W256, J7 = J6 + J_W256, J8 = J7 + J_W256, J9 = J8 + 1;
        for (int job = c.bid; job < J9; job += c.G) {
            if (job < J0) ssm_tables_job(c, job);
            else if (job < J1) hyena_mlp_job(c, job - J0);
            else if (job < J2) modv_job(c, job - J1);
            else if (job < J3) { const int r = job - J2, l = r / 768, q = r % 768; wconv_tile(c, KIN(I_WIN) + (size_t)l * DM * INC, DM, INC, INP, wsp<bf16_t>(c, WS_WIN) + (size_t)l * INP * DM, DM, 0, q / 16, q % 16); }
            else if (job < J4) { const int r = job - J3, l = r / 256, q = r % 256; wconv_tile(c, KIN(I_WOUT) + (size_t)l * DM * DM, DM, DM, DM, wsp<bf16_t>(c, WS_WOUT) + (size_t)l * DM * DM, DM, 1, q / 16, q % 16); }
            else if (job < J5) { const int r = job - J4, l = r / 32, q = r % 32; wconv_tile(c, KIN(I_WUQ) + (size_t)l * 192 * 384, 192, 384, 384, wsp<bf16_t>(c, WS_WUQ) + (size_t)l * 512 * 256, 256, 1, q / 4, q % 4); }
            else if (job < J6) { const int r = job - J5, l = r / 16, q = r % 16; wconv_tile(c, KIN(I_WUKV) + (size_t)l * 128 * 512, 128, 512, 256, wsp<bf16_t>(c, WS_WUK) + (size_t)l * 256 * 256, 256, 2, q / 4, q % 4); }
            else if (job < J7) { const int r = job - J6, l = r / 16, q = r % 16; wconv_tile(c, KIN(I_WUKV) + (size_t)l * 128 * 512, 128, 512, 256, wsp<bf16_t>(c, WS_WUV) + (size_t)l * 256 * 256, 256, 3, q / 4, q % 4); }
            else if (job < J8) { const int r = job - J7, l = r / 16, q = r % 16; wconv_tile(c, KIN(I_GLUW) + (size_t)l * 256 * 256, 256, 256, 256, wsp<bf16_t>(c, WS_WGLU) + (size_t)l * 256 * 256, 256, 1, q / 4, q % 4); }
            else rope_job(c);
        }
        SEAM(0);
    }
    if (SITE(1) && IN(1)) {
        FRESH();
        for (int job = c.bid; job < 4 * 2 * 256; job += c.G) hyena_pack_job(c, job);
        norm_rows(c, -1, 0);
        SEAM(1);
    }
    for (int l = 0; l < DEPTH; ++l) {
        const int pbase = NPRO + l * NPH;
        if (SITE(2) && IN(pbase + 0)) {
            FRESH();
            pg8::Gemm g{wsp<bf16_t>(c, WS_HCAT), wsp<bf16_t>(c, WS_WIN) + (size_t)l * INP * DM, MROWS, INP, DM};
            pg8::StaticOrder S; S.init(MROWS, INP, c.G, c.bid);
            pg8::EpiWalk<PutSplit> E{{wsp<bf16_t>(c, WS_PB)}};
            pg8::gemm_phase(c.lds, g, S, E, c.tid);
            SEAM(pbase + 0);
        }
        if (SITE(3) && IN(pbase + 1)) { FRESH(); p2_rows(c, l); FRESH(); p2_tiles(c, l); SEAM(pbase + 1); }
        if (SITE(4) && IN(pbase + 2)) {
            FRESH();
            { pg8::Gemm g{wsp<bf16_t>(c, WS_PB), wsp<bf16_t>(c, WS_WUQ) + (size_t)l * 512 * 256, MROWS, 512, 256}; pg8::StaticOrder S; S.init(MROWS, 512, c.G, c.bid);
              pg8::EpiWalk<PutPlain> E{{wsp<bf16_t>(c, WS_QM), 384, 384}}; pg8::gemm_phase(c.lds, g, S, E, c.tid); }
            FRESH();
            { pg8::Gemm g{wsp<bf16_t>(c, WS_PB) + BLKE, wsp<bf16_t>(c, WS_WUK) + (size_t)l * 256 * 256, MROWS, 256, 256}; pg8::StaticOrder S; S.init(MROWS, 256, c.G, c.bid);
              pg8::EpiWalk<PutKm> E{{wsp<bf16_t>(c, WS_KM), wsp<bf16_t>(c, WS_KR)}}; pg8::gemm_phase(c.lds, g, S, E, c.tid); }
            FRESH();
            { pg8::Gemm g{wsp<bf16_t>(c, WS_WUV) + (size_t)l * 256 * 256, wsp<bf16_t>(c, WS_PB) + BLKE, 256, MROWS, 256}; pg8::StaticOrder S; S.init(256, MROWS, c.G, c.bid);
              pg8::EpiWalk<PutVt> E{{wsp<bf16_t>(c, WS_VTM)}}; pg8::gemm_phase(c.lds, g, S, E, c.tid); }
            FRESH();
            { pg8::Gemm g{wsp<bf16_t>(c, WS_UG), wsp<bf16_t>(c, WS_WE) + (size_t)l * 16 * 256 * 256, 16 * NCHUNK, 16 * 256, 256}; pg8::BatchedOrder S; S.init(16, NCHUNK / 256, c.G, c.bid);
              pg8::EpiWalk<PutE> E{{wsp<bf16_t>(c, WS_E)}}; pg8::gemm_phase(c.lds, g, S, E, c.tid); }
            SEAM(pbase + 2);
        }
        if (SITE(5) && IN(pbase + 3)) {
            FRESH();
            unsigned* qh = ctl + CW_Q + 64 * l;
            const float* ropeM = wsp<float>(c, WS_ROPEM);
            for (;;) {
                __syncthreads();
                if (c.tid == 0) misc[4] = __hip_atomic_fetch_add(qh, 1u, __ATOMIC_RELAXED, __HIP_MEMORY_SCOPE_AGENT);
                __syncthreads();
                const int it = (int)misc[4];
                if (it >= QI_TOTAL) break;
                FRESH();
                if (it < QI_HY) { hyena_seq<SEQL>(c, l, it, 0); hyena_seq<CTXL>(c, l, it, SEQL); }
                else if (it < QI_HY + QI_SCAN) ssm_scan_item(c, l, it - QI_HY);
                else {
                    const int a = it - QI_HY - QI_SCAN; const int kind = a & 1  , r = a >> 1, head = r & 3, r2 = r >> 2, b = r2 / 17, qb = 16 - (r2 % 17)  ;
                    const size_t row0 = (size_t)b * NTOK + (size_t)qb * 256; const int kt0 = qb == 16 ? 64 : 0, nkt = qb == 16 ? 4 : 68;
                    if (kind == 0) attn_unit<96>(c, wsp<bf16_t>(c, WS_QM) + row0 * 384 + head * 96, 384, wsp<bf16_t>(c, WS_KM) + (size_t)(b * 4 + head) * NTOK * 96, wsp<bf16_t>(c, WS_VTM) + (size_t)(b * 4 + head) * 64 * NTOK,
                                                 kt0, nkt, wsp<bf16_t>(c, WS_PB) + 2 * BLKE + row0 * 256 + head * 64, wsp<bf16_t>(c, WS_HCAT) + row0 * DM + head * 64, qb < 16, qb * 256, 0.10206207261596577f * LOG2E, ropeM);
                    else attn_unit<64>(c, wsp<bf16_t>(c, WS_PB) + 3 * BLKE + row0 * 256 + head * 64, 256, wsp<bf16_t>(c, WS_KG) + (size_t)(b * 2 + (head >> 1)) * NTOK * 64, wsp<bf16_t>(c, WS_VTG) + (size_t)(b * 2 + (head >> 1)) * 64 * NTOK,
                                       kt0, nkt, wsp<bf16_t>(c, WS_PB) + 5 * BLKE + row0 * 256 + head * 64, wsp<bf16_t>(c, WS_HCAT) + row0 * DM + 256 + head * 64, false, 0, 1.f, ropeM);
                }
            }
            SEAM(pbase + 3);
        }
        if (SITE(6) && IN(pbase + 4)) {
            FRESH();
            pg8::Gemm g{wsp<bf16_t>(c, WS_US), wsp<bf16_t>(c, WS_WKC) + (size_t)l * 16 * 256 * 512, 16 * NCHUNK, 16 * 256, 512}; pg8::BatchedOrder S; S.init(16, NCHUNK / 256, c.G, c.bid);
            pg8::EpiWalk<PutSsmY> E{{wsp<bf16_t>(c, WS_ZS), wsp<bf16_t>(c, WS_UG), KIN(I_SSMD) + l * 256}}; pg8::gemm_phase(c.lds, g, S, E, c.tid);
            SEAM(pbase + 4);
        }
        if (SITE(7) && IN(pbase + 5)) {
            FRESH();
            pg8::Gemm g{wsp<bf16_t>(c, WS_ZS), wsp<bf16_t>(c, WS_WGLU) + (size_t)l * 256 * 256, MROWS, 256, 256}; pg8::StaticOrder S; S.init(MROWS, 256, c.G, c.bid);
            pg8::EpiWalk<PutGlu> E{{wsp<bf16_t>(c, WS_HCAT), wsp<bf16_t>(c, WS_ZS), wsp<bf16_t>(c, WS_PB) + 7 * BLKE, KIN(I_GLUB) + l * 256}}; pg8::gemm_phase(c.lds, g, S, E, c.tid);
            SEAM(pbase + 5);
        }
        if (SITE(8) && IN(pbase + 6)) {
            FRESH();
            pg8::Gemm g{wsp<bf16_t>(c, WS_HCAT), wsp<bf16_t>(c, WS_WOUT) + (size_t)l * DM * DM, MROWS, DM, DM}; pg8::StaticOrder S; S.init(MROWS, DM, c.G, c.bid);
            pg8::EpiWalk<PutPlain> E{{wsp<bf16_t>(c, WS_OUTB), DM, DM}}; pg8::gemm_phase(c.lds, g, S, E, c.tid);
            SEAM(pbase + 6);
        }
        if (SITE(9) && IN(pbase + 7)) { FRESH(); norm_rows(c, l, l + 1 < DEPTH ? l + 1 : -1); if (l + 1 < DEPTH) SEAM(pbase + 7); }
    }
#undef IN
#undef SEAM
}

extern "C" void kernel_launch(void* const* d_in, const int* in_sizes, int n_in, void* d_out, int out_size, void* d_ws, size_t ws_size, hipStream_t stream) {
    static int grid = 0;
    if (grid == 0) {
        if (n_in != 36 || out_size != NB * SEQL * DM || ws_size < WS_END) { fprintf(stderr, "kernel_launch: unexpected shapes: n_in %d out %d ws %zu (need %zu)\n", n_in, out_size, ws_size, (size_t)WS_END); grid = -1; return; }
        int dev = 0, cus = 0, per_cu = 0;
        if (hipGetDevice(&dev) != hipSuccess || hipDeviceGetAttribute(&cus, hipDeviceAttributeMultiprocessorCount, dev) != hipSuccess) { grid = -1; return; }
        if (hipFuncSetAttribute((const void*)mk_fwd, hipFuncAttributeMaxDynamicSharedMemorySize, LDS_BYTES) != hipSuccess) { fprintf(stderr, "kernel_launch: hipFuncSetAttribute failed\n"); grid = -1; return; }
        if (hipOccupancyMaxActiveBlocksPerMultiprocessor(&per_cu, (const void*)mk_fwd, 512, LDS_BYTES) != hipSuccess || per_cu < 1) { fprintf(stderr, "kernel_launch: occupancy query says %d blocks per CU\n", per_cu); per_cu = 1; }
        (void)hipGetLastError();
        grid = cus;
    }
    if (grid < 0) return;
    (void)hipMemsetAsync((char*)d_ws + WS_CTL, 0, CTL_BYTES, stream);
    Params p{};
    for (int i = 0; i < 36; ++i) p.in[i] = (const float*)d_in[i];
    p.out = (float*)d_out; p.ws = (unsigned char*)d_ws;
#if MK_ONE_LAUNCH
    p.ph_lo = 0; p.ph_hi = NPHASES;
    hipLaunchKernelGGL(mk_fwd, dim3(grid), dim3(512), LDS_BYTES, stream, p);
#else
    for (int k = 0; k < NPHASES; ++k) { p.ph_lo = k; p.ph_hi = k + 1; hipLaunchKernelGGL(mk_fwd, dim3(grid), dim3(512), LDS_BYTES, stream, p); }
#endif
}
```

```cpp
#include <hip/hip_runtime.h>
#include <cstdio>
#include <cstdint>

#ifndef MK_ONE_LAUNCH
#define MK_ONE_LAUNCH 1
#endif

#define LAS __attribute__((address_space(3)))
typedef unsigned short bf16_t;
typedef short bf16x8 __attribute__((ext_vector_type(8)));
typedef short bf16x4 __attribute__((ext_vector_type(4)));
typedef float f32x4 __attribute__((ext_vector_type(4)));
typedef float f32x16 __attribute__((ext_vector_type(16)));
typedef unsigned u32x4 __attribute__((ext_vector_type(4)));
typedef unsigned u32x2 __attribute__((ext_vector_type(2)));

constexpr int NB = 16, SEQL = 4096, CTXL = 256, NTOK = SEQL + CTXL  , MROWS = NB * NTOK  ;
constexpr int DM = 1024, DEPTH = 4, INC = 2912, INP = 3072;
constexpr int NCHB = NTOK / 16  , NCHUNK = MROWS / 16  ;
constexpr float EPS = 1e-6f;
constexpr float LOG2E = 1.4426950408889634f;
constexpr int LDS_MISC_OFF = 163840 - 256;

constexpr size_t al256(size_t x) { return (x + 255) & ~(size_t)255; }
constexpr size_t WS_CTL = 0;
constexpr size_t CTL_BYTES = 32768;
constexpr size_t WS_MODV = WS_CTL + CTL_BYTES;
constexpr size_t WS_ROPEG = WS_MODV + al256((size_t)4 * 17 * 3072 * 4);
constexpr size_t WS_ROPEM = WS_ROPEG + 64 * 16 * 2 * 4;
constexpr size_t WS_WIN = WS_ROPEM + 64 * 8 * 2 * 4;
constexpr size_t WS_WOUT = WS_WIN + (size_t)4 * 3072 * 1024 * 2;
constexpr size_t WS_WUQ = WS_WOUT + (size_t)4 * 1024 * 1024 * 2;
constexpr size_t WS_WUK = WS_WUQ + (size_t)4 * 512 * 256 * 2;
constexpr size_t WS_WUV = WS_WUK + (size_t)4 * 256 * 256 * 2;
constexpr size_t WS_WGLU = WS_WUV + (size_t)4 * 256 * 256 * 2;
constexpr size_t WS_WE = WS_WGLU + (size_t)4 * 256 * 256 * 2;
constexpr size_t WS_WKC = WS_WE + (size_t)4 * 16 * 256 * 256 * 2;
constexpr size_t WS_A16 = WS_WKC + (size_t)4 * 16 * 256 * 512 * 2;
constexpr size_t WS_GR = WS_A16 + (size_t)4 * 2 * 16 * 64 * 2 * 4;
constexpr size_t WS_GRC = WS_GR + (size_t)4 * 2 * 256 * 8192 * 2;
constexpr size_t WS_CTXR = WS_GRC + (size_t)4 * 2 * 256 * 512 * 2;
constexpr size_t WS_HCAT = WS_CTXR + (size_t)NB * CTXL * DM * 4;
constexpr size_t BLKE = (size_t)MROWS * 256;
constexpr size_t WS_PB = WS_HCAT + (size_t)MROWS * DM * 2;
constexpr size_t WS_KR = WS_PB + 12 * BLKE * 2;
constexpr size_t WS_KG = WS_KR + (size_t)MROWS * 32 * 2;
constexpr size_t WS_VTG = WS_KG + (size_t)32 * NTOK * 64 * 2;
constexpr size_t WS_UG = WS_VTG + (size_t)32 * NTOK * 64 * 2;
constexpr size_t WS_US = WS_UG + BLKE * 2;
constexpr size_t WS_HYV = WS_US + (size_t)16 * NCHUNK * 512 * 2;
constexpr size_t WS_HYX1 = WS_HYV + BLKE * 2;
constexpr size_t WS_HYX2 = WS_HYX1 + BLKE * 2;
constexpr size_t WS_HYG = WS_HYX2 + BLKE * 2;
constexpr size_t WS_HYZ = WS_HYG + BLKE * 2;
constexpr size_t WS_HYY = WS_HYZ + BLKE * 2;
constexpr size_t WS_END = WS_HYY + BLKE * 2;
static_assert(WS_END <= (size_t)1 << 30, "workspace map exceeds 1 GiB");
constexpr size_t WS_QM = WS_PB + 8 * BLKE * 2;
constexpr size_t WS_KM = WS_QM + (size_t)MROWS * 384 * 2;
constexpr size_t WS_VTM = WS_KM + (size_t)MROWS * 384 * 2;
constexpr size_t WS_E = WS_PB + 4 * BLKE * 2;
constexpr size_t WS_ZS = WS_PB + 6 * BLKE * 2;
constexpr size_t WS_OUTB = WS_PB + 8 * BLKE * 2;
constexpr size_t WS_HT = WS_PB;
static_assert(WS_VTM + BLKE * 2 == WS_PB + 12 * BLKE * 2, "alias map");

constexpr int CW_BAR = 0;
constexpr int CW_Q = 4096;
constexpr int CW_TMO = 4096 + 64 * 8;

__device__ __forceinline__ float bf2f(bf16_t v) { return __uint_as_float(((unsigned)v) << 16); }
__device__ __forceinline__ bf16_t f2bf(float f) { unsigned u = __float_as_uint(f); u += 0x7FFFu + ((u >> 16) & 1u); return (bf16_t)(u >> 16); }
__device__ __forceinline__ unsigned cvt_pk_bf16(float lo, float hi) { unsigned r; asm volatile("v_cvt_pk_bf16_f32 %0, %1, %2" : "=v"(r) : "v"(lo), "v"(hi)); return r; }
__device__ __forceinline__ float lo_bf(unsigned w) { return __uint_as_float(w << 16); }
__device__ __forceinline__ float hi_bf(unsigned w) { return __uint_as_float(w & 0xFFFF0000u); }
__device__ __forceinline__ float sigmf(float x) { float one = 1.f; asm volatile("" : "+v"(one)); return __builtin_amdgcn_rcpf(one + __builtin_amdgcn_exp2f(-1.4426950408889634f * x)); }
__device__ __forceinline__ float siluf(float x) { return x * sigmf(x); }
__device__ __forceinline__ float gelu_tanh(float x) { const float u = 0.7978845608028654f * (x + 0.044715f * x * x * x); return x * sigmf(2.f * u); }
__device__ __forceinline__ int opaque(int x) { asm volatile("" : "+v"(x)); return x; }
__device__ __forceinline__ int lane_id_fresh() { int x; asm volatile("v_mbcnt_lo_u32_b32 %0, -1, 0\n\tv_mbcnt_hi_u32_b32 %0, -1, %0" : "=v"(x)); return x; }
template <int M> __device__ __forceinline__ float swz_xor(float v) { return __int_as_float(__builtin_amdgcn_ds_swizzle(__float_as_int(v), 0x1F | (M << 10))); }
__device__ __forceinline__ float half_sum(float v) { auto r = __builtin_amdgcn_permlane32_swap(__float_as_uint(v), __float_as_uint(v), false, false); return __uint_as_float(r[0]) + __uint_as_float(r[1]); }
__device__ __forceinline__ float half_max(float v) { auto r = __builtin_amdgcn_permlane32_swap(__float_as_uint(v), __float_as_uint(v), false, false); return fmaxf(__uint_as_float(r[0]), __uint_as_float(r[1])); }
__device__ __forceinline__ float half_other(float v, int h) { auto r = __builtin_amdgcn_permlane32_swap(__float_as_uint(v), __float_as_uint(v), false, false); return __uint_as_float(h ? r[0] : r[1]); }
__device__ __forceinline__ float wave_sum(float v) {
    v += swz_xor<16>(v); v += swz_xor<8>(v); v += swz_xor<4>(v); v += swz_xor<2>(v); v += swz_xor<1>(v);
    return half_sum(v);
}

#define XB_TMO      128
#define XB_XCNT(j)  (256  + 64 * (j))
#define XB_XSUB(j)  (1280 + 64 * (j))
#define XB_XGEN(j)  (2304 + 64 * (j))
#define XB_TOP      3328
#define XB_TOPGEN   3392
#define XCD_BAR_WORDS 3456
#define XB_SPIN_CAP (1u << 22)
__device__ __forceinline__ unsigned xb_ld(unsigned* p)              { return __hip_atomic_load(p, __ATOMIC_RELAXED, __HIP_MEMORY_SCOPE_AGENT); }
__device__ __forceinline__ unsigned xb_add(unsigned* p, unsigned v) { return __hip_atomic_fetch_add(p, v, __ATOMIC_RELAXED, __HIP_MEMORY_SCOPE_AGENT); }
__device__ __forceinline__ unsigned xb_xcc_id() { return (unsigned)__builtin_amdgcn_s_getreg((3 << 11) | 20) & 0xFu; }
#define XB_SPIN(cond, bar) do { unsigned _sp = 0; while (cond) { __builtin_amdgcn_s_sleep(1); \
    if ((++_sp & 255u) == 0u) { if (xb_ld(&(bar)[XB_TMO])) break; if (_sp > XB_SPIN_CAP) { atomicAdd(&(bar)[XB_TMO], 1u); break; } } } } while (0)
struct XcdBarrier { unsigned* bar; unsigned x; volatile LAS unsigned* st; };
__device__ __forceinline__ XcdBarrier xcd_barrier_post(unsigned* bar, volatile LAS unsigned* st) {
    XcdBarrier b; b.bar = bar; b.x = xb_xcc_id(); b.st = st;
    if (threadIdx.x == 0) (void)xb_add(&bar[XB_XCNT(b.x)], 1u);
    return b;
}
__device__ __forceinline__ void xcd_barrier_complete(unsigned* bar, unsigned x, unsigned& nloc, unsigned& nx) {
    const unsigned G = gridDim.x * gridDim.y * gridDim.z;
    unsigned sum, cnt, mine, sp = 0u;
    for (;;) {
        sum = 0u; cnt = 0u; mine = 0u;
#pragma unroll
        for (unsigned j = 0; j < 16; ++j) { const unsigned c = xb_ld(&bar[XB_XCNT(j)]); sum += c; cnt += (c > 0u) ? 1u : 0u; }
        mine = xb_ld(&bar[XB_XCNT(x)]);
        if (sum == G) break;
        __builtin_amdgcn_s_sleep(1);
        if ((++sp & 255u) == 0u) { if (xb_ld(&bar[XB_TMO])) break; if (sp > XB_SPIN_CAP) { atomicAdd(&bar[XB_TMO], 1u); break; } }
    }
    nloc = mine > 0u ? mine : 1u; nx = cnt > 0u ? cnt : 1u;
}
__device__ __forceinline__ void xcd_barrier(const XcdBarrier& b) {
    asm volatile("s_waitcnt vmcnt(0)" ::: "memory");
    __syncthreads();
    if (threadIdx.x == 0) {
        unsigned* bar = b.bar;
        __builtin_amdgcn_s_waitcnt(0);
        unsigned nloc = b.st[0], nx = b.st[1];
        if (nloc == 0u) { xcd_barrier_complete(bar, b.x, nloc, nx); b.st[0] = nloc; b.st[1] = nx; }
        const unsigned old = xb_add(&bar[XB_XSUB(b.x)], 1u);
        const unsigned gen = old / nloc;
        if (old + 1u == (gen + 1u) * nloc) {
            __builtin_amdgcn_fence(__ATOMIC_RELEASE, "agent");
            asm volatile("s_waitcnt vmcnt(0)" ::: "memory");
            const unsigned og = xb_add(&bar[XB_TOP], 1u);
            const unsigned tg = og / nx;
            if (og + 1u == (tg + 1u) * nx) xb_add(&bar[XB_TOPGEN], 1u);
            else XB_SPIN(xb_ld(&bar[XB_TOPGEN]) == tg, bar);
            __builtin_amdgcn_fence(__ATOMIC_ACQUIRE, "agent");
            xb_add(&bar[XB_XGEN(b.x)], 1u);
            asm volatile("s_waitcnt vmcnt(0)" ::: "memory");
        } else {
            XB_SPIN(xb_ld(&bar[XB_XGEN(b.x)]) == gen, bar);
            __builtin_amdgcn_fence(__ATOMIC_ACQUIRE, "agent");
            asm volatile("s_waitcnt vmcnt(0)" ::: "memory");
        }
    }
    __syncthreads();
}

namespace pg8 {
constexpr int BM = 256, BK = 64, HALF = 128, HTB = HALF * BK * 2, STAGE_BYTES = 8 * HTB, NXCD = 8, WGM = 8;
__host__ __device__ __forceinline__ int lds_byte(int r, int c) { const int st = (r >> 4) * 2 + (c >> 5), rr = r & 15, cc = c & 31, ob = rr * 64 + cc * 2; return st * 1024 + (ob ^ (((ob >> 9) & 1) << 5)); }
__host__ __device__ __forceinline__ void stage_rc(int b, int& R, int& C) { const int st = b / 1024, sb = b % 1024, swz = sb ^ (((sb >> 9) & 1) << 5); R = (st >> 1) * 16 + swz / 64; C = (st & 1) * 32 + (swz % 64) / 2; }
__host__ __device__ __forceinline__ int perm32(int rho) { const int n = rho >> 4, i = rho & 15; return 8 * (i >> 2) + 4 * n + (i & 3); }
struct Unit { int pm, pn; };
struct Gemm { const bf16_t* A; const bf16_t* Bt; int M, N, K; };
struct StaticOrder {
    int nM, nN, nwg, G, c;
    __host__ __device__ void init(int M, int N, int G_, int c_) { nM = M / BM; nN = N / BM; nwg = nM * nN; G = G_; c = c_; }
    __host__ __device__ bool next(int i, Unit& u) const {
        const long L = (long)i * G + c; if (L >= nwg) return false;
        int wgid = (int)L; { const int q = nwg / NXCD, r = nwg % NXCD, xcd = wgid % NXCD, off = wgid / NXCD; wgid = (xcd < r ? xcd * (q + 1) : r * (q + 1) + (xcd - r) * q) + off; }
        const int nig = WGM * nN, gid = wgid / nig, fm = gid * WGM, gsz = (nM - fm) < WGM ? (nM - fm) : WGM;
        u.pm = fm + ((wgid % nig) % gsz); u.pn = (wgid % nig) / gsz; return true;
    }
    __device__ __forceinline__ void a_ready(const Unit&) const {}
    __device__ __forceinline__ void done(const Unit&) const {}
};
struct BatchedOrder {
    int nwg, G, c, tpg;
    __host__ __device__ void init(int ng, int tpg_, int G_, int c_) { nwg = ng * tpg_; tpg = tpg_; G = G_; c = c_; }
    __host__ __device__ bool next(int i, Unit& u) const { const int L = i * G + c; if (L >= nwg) return false; u.pm = L; u.pn = L / tpg; return true; }
    __device__ __forceinline__ void a_ready(const Unit&) const {}
    __device__ __forceinline__ void done(const Unit&) const {}
};

template <class Epi, class Sched>
__device__ __forceinline__ void gemm_phase(LAS unsigned char* lds, const Gemm g, const Sched& S, const Epi& E, int tid_in) {
    const int tid = tid_in, wid = __builtin_amdgcn_readfirstlane(tid >> 6), lane = tid & 63, wr = wid >> 2, wc = wid & 3, fr = lane & 15, fq = lane >> 4;
    const int K = g.K, nt = K / BK;
    unsigned voffA[2], voffB[2];
#pragma unroll
    for (int i = 0; i < 2; ++i) { int R, C; stage_rc(tid * 16 + i * 8192, R, C); const int Rb = Epi::PERM ? ((R & ~31) + perm32(R & 31)) : R;
        voffA[i] = (unsigned)(R * K + C) * 2u; voffB[i] = (unsigned)(Rb * K + C) * 2u; }
    const size_t kstep = (size_t)(BK * 2);
    const size_t hstep = (size_t)HALF * K * 2;
    const size_t tstep = 2 * hstep;
    const unsigned ldsw = (unsigned)wid * 1024u;
    const int aoff = lds_byte(wr * 64 + fr, fq * 8), boff = lds_byte(wc * 32 + fr, fq * 8);
#define PG8_SA(b, h) (((b) * 2 + (h)) * HTB)
#define PG8_SB(b, h) ((4 + (b) * 2 + (h)) * HTB)
#define PG8_STAGE(bufoff, gbase, voff) do { _Pragma("unroll") for (int _i = 0; _i < 2; ++_i) \
        __builtin_amdgcn_global_load_lds((const unsigned*)((const char*)(gbase) + (voff)[_i]), (LAS unsigned*)(lds + (bufoff) + ldsw + _i * 8192), 16, 0, 0); } while (0)
#define PG8_LDA(dst, b, h) do { _Pragma("unroll") for (int m = 0; m < 4; ++m) _Pragma("unroll") for (int k = 0; k < 2; ++k) dst[m][k] = *(const LAS bf16x8*)(lds + PG8_SA(b, h) + aoff + m * 2048 + k * 1024); } while (0)
#define PG8_LDB(dst, b, h) do { _Pragma("unroll") for (int n = 0; n < 2; ++n) _Pragma("unroll") for (int k = 0; k < 2; ++k) dst[n][k] = *(const LAS bf16x8*)(lds + PG8_SB(b, h) + boff + n * 2048 + k * 1024); } while (0)
#define PG8_MMA(ai, bj, At, Bt) do { __builtin_amdgcn_s_setprio(1); _Pragma("unroll") for (int m = 0; m < 4; ++m) _Pragma("unroll") for (int n = 0; n < 2; ++n) _Pragma("unroll") for (int k = 0; k < 2; ++k) \
        acc[ai][bj][m][n] = __builtin_amdgcn_mfma_f32_16x16x32_bf16(Bt[n][k], At[m][k], acc[ai][bj][m][n], 0, 0, 0); __builtin_amdgcn_s_setprio(0); } while (0)
#define PG8_WAIT_V(n) asm volatile("s_waitcnt vmcnt(" #n ")" ::: "memory")
#define PG8_WAIT_L(n) asm volatile("s_waitcnt lgkmcnt(" #n ")" ::: "memory")
#define PG8_BAR __builtin_amdgcn_s_barrier()
#define PG8_SCHED __builtin_amdgcn_sched_barrier(0)
    Unit cur, nxt; int ui = 0;
    if (!S.next(0, cur)) return;
    f32x4 acc[2][2][4][2];
#pragma unroll
    for (int a = 0; a < 2; ++a)
#pragma unroll
        for (int b = 0; b < 2; ++b)
#pragma unroll
            for (int m = 0; m < 4; ++m)
#pragma unroll
                for (int n = 0; n < 2; ++n) acc[a][b][m][n] = (f32x4){0.f, 0.f, 0.f, 0.f};
    bf16x8 At[4][2], B0[2][2], B1[2][2];
    const char* cA = (const char*)g.A + (size_t)cur.pm * tstep; const char* cB = (const char*)g.Bt + (size_t)cur.pn * tstep;
    S.a_ready(cur);
    PG8_STAGE(PG8_SB(0, 0), cB, voffB); PG8_STAGE(PG8_SA(0, 0), cA, voffA); PG8_STAGE(PG8_SB(0, 1), cB + hstep, voffB); PG8_STAGE(PG8_SA(0, 1), cA + hstep, voffA);
    if (wr == 1) PG8_BAR;
    PG8_WAIT_V(4); PG8_BAR;
    PG8_STAGE(PG8_SB(1, 0), cB + kstep, voffB); PG8_STAGE(PG8_SA(1, 0), cA + kstep, voffA); PG8_STAGE(PG8_SB(1, 1), cB + hstep + kstep, voffB);
    PG8_WAIT_V(6); PG8_BAR;
    for (;;) {
        const bool has_next = S.next(ui + 1, nxt);
        const char* nA = has_next ? (const char*)g.A + (size_t)nxt.pm * tstep : cA; const char* nB = has_next ? (const char*)g.Bt + (size_t)nxt.pn * tstep : cB;
        for (int t = 0; t < nt; t += 2) {
            const bool last = (t == nt - 2);
            const char* a1 = cA + (size_t)(t + 1) * kstep;
            const char* a2 = last ? nA : cA + (size_t)(t + 2) * kstep; const char* b2 = last ? nB : cB + (size_t)(t + 2) * kstep;
            const char* a3 = a2 + kstep; const char* b3 = b2 + kstep;
            if (last && has_next) S.a_ready(nxt);
            PG8_LDB(B0, 0, 0); PG8_SCHED; PG8_LDA(At, 0, 0); PG8_STAGE(PG8_SA(1, 1), a1 + hstep, voffA);
            PG8_WAIT_L(8); PG8_BAR; PG8_WAIT_L(0); PG8_MMA(0, 0, At, B0); PG8_BAR; PG8_SCHED;
            PG8_LDB(B1, 0, 1); PG8_STAGE(PG8_SB(0, 0), b2, voffB);
            PG8_BAR; PG8_WAIT_L(0); PG8_MMA(0, 1, At, B1); PG8_BAR;
            PG8_LDA(At, 0, 1); PG8_STAGE(PG8_SA(0, 0), a2, voffA);
            PG8_BAR; PG8_WAIT_L(0); PG8_MMA(1, 0, At, B0); PG8_BAR; PG8_SCHED;
            PG8_STAGE(PG8_SB(0, 1), b2 + hstep, voffB);
            PG8_WAIT_V(6); PG8_BAR; PG8_MMA(1, 1, At, B1); PG8_BAR;
            PG8_LDB(B0, 1, 0); PG8_SCHED; PG8_LDA(At, 1, 0); PG8_STAGE(PG8_SA(0, 1), a2 + hstep, voffA);
            PG8_WAIT_L(8); PG8_BAR; PG8_WAIT_L(0); PG8_MMA(0, 0, At, B0); PG8_BAR; PG8_SCHED;
            PG8_LDB(B1, 1, 1); PG8_STAGE(PG8_SB(1, 0), b3, voffB);
            PG8_BAR; PG8_WAIT_L(0); PG8_MMA(0, 1, At, B1); PG8_BAR;
            PG8_LDA(At, 1, 1); PG8_STAGE(PG8_SA(1, 0), a3, voffA);
            PG8_BAR; PG8_WAIT_L(0); PG8_MMA(1, 0, At, B0); PG8_BAR; PG8_SCHED;
            PG8_STAGE(PG8_SB(1, 1), b3 + hstep, voffB);
            PG8_WAIT_V(6); PG8_BAR; PG8_MMA(1, 1, At, B1); PG8_BAR;
        }
        { const int l2 = lane_id_fresh(); E(acc, cur, wr, wc, l2 & 15, l2 >> 4); } S.done(cur);
        if (!has_next) break;
#pragma unroll
        for (int a = 0; a < 2; ++a)
#pragma unroll
            for (int b = 0; b < 2; ++b)
#pragma unroll
                for (int m = 0; m < 4; ++m)
#pragma unroll
                    for (int n = 0; n < 2; ++n) acc[a][b][m][n] = (f32x4){0.f, 0.f, 0.f, 0.f};
        cur = nxt; cA = nA; cB = nB; ++ui;
    }
    PG8_WAIT_V(0);
    if (wr == 0) PG8_BAR;
    PG8_BAR;
#undef PG8_SA
#undef PG8_SB
#undef PG8_STAGE
#undef PG8_LDA
#undef PG8_LDB
#undef PG8_MMA
#undef PG8_WAIT_V
#undef PG8_WAIT_L
#undef PG8_BAR
#undef PG8_SCHED
}

template <class F> struct EpiWalk {
    static constexpr bool PERM = true, AFTER_DRAIN = false;
    F f;
    __device__ __forceinline__ void operator()(const f32x4 (&acc)[2][2][4][2], const Unit& u, int wr, int wc, int fr, int fq) const {
#pragma unroll
        for (int ai = 0; ai < 2; ++ai)
#pragma unroll
            for (int m = 0; m < 4; ++m) {
                const int rin = ai * HALF + wr * 64 + m * 16 + fr;
#pragma unroll
                for (int bj = 0; bj < 2; ++bj) { const int cin = bj * HALF + wc * 32 + 8 * fq; f.put(u.pm, u.pn, rin, cin, acc[ai][bj][m][0], acc[ai][bj][m][1]); asm volatile("" ::: "memory"); }
            }
    }
};
}

__device__ __forceinline__ u32x4 pack8(const f32x4& a, const f32x4& b) {
    u32x4 w; w.x = cvt_pk_bf16(a[0], a[1]); w.y = cvt_pk_bf16(a[2], a[3]); w.z = cvt_pk_bf16(b[0], b[1]); w.w = cvt_pk_bf16(b[2], b[3]); return w;
}
__device__ __forceinline__ void unpack8(const u32x4 w, float (&o)[8]) {
    o[0] = lo_bf(w.x); o[1] = hi_bf(w.x); o[2] = lo_bf(w.y); o[3] = hi_bf(w.y); o[4] = lo_bf(w.z); o[5] = hi_bf(w.z); o[6] = lo_bf(w.w); o[7] = hi_bf(w.w);
}

struct PutSplit {
    bf16_t* pb;
    __device__ __forceinline__ void put(int pm, int pn, int rin, int cin, const f32x4& a, const f32x4& b) const { *(u32x4*)(pb + (size_t)pn * BLKE + ((size_t)pm * 256 + rin) * 256 + cin) = pack8(a, b); }
};
struct PutPlain {
    bf16_t* dst; int ldc, ncols;
    __device__ __forceinline__ void put(int pm, int pn, int rin, int cin, const f32x4& a, const f32x4& b) const { const int col = pn * 256 + cin; if (col < ncols) *(u32x4*)(dst + ((size_t)pm * 256 + rin) * ldc + col) = pack8(a, b); }
};
struct PutKm {
    bf16_t* km; const bf16_t* kr;
    __device__ __forceinline__ void put(int pm, int pn, int rin, int cin, const f32x4& a, const f32x4& b) const {
        const int bb = pm / 17, key = (pm - bb * 17) * 256 + rin, hd = cin >> 6, d = cin & 63;
        bf16_t* dst = km + ((size_t)(bb * 4 + hd) * NTOK + key) * 96;
        *(u32x4*)(dst + d) = pack8(a, b);
        if (d < 32) *(u32x4*)(dst + 64 + d) = *(const u32x4*)(kr + ((size_t)pm * 256 + rin) * 32 + d);
    }
};
struct PutVt {
    bf16_t* vt;
    __device__ __forceinline__ void put(int pm, int pn, int rin, int cin, const f32x4& a, const f32x4& b) const {
        const int bb = pn / 17, key = (pn - bb * 17) * 256 + cin;
        *(u32x4*)(vt + ((size_t)(bb * 4 + (rin >> 6)) * 64 + (rin & 63)) * NTOK + key) = pack8(a, b);
    }
};
struct PutE {
    bf16_t* e;
    __device__ __forceinline__ void put(int pm, int pn, int rin, int cin, const f32x4& a, const f32x4& b) const { *(u32x4*)(e + ((size_t)pm * 256 + rin) * 256 + cin) = pack8(a, b); }
};
struct PutSsmY {
    bf16_t* zs; const bf16_t* ug; const float* dskip;
    __device__ __forceinline__ void put(int pm, int pn, int rin, int cin, const f32x4& a, const f32x4& b) const {
        const int g = pn, n = (pm - g * 17) * 256 + rin, tok = n * 16 + (cin >> 4), ho = cin & 15, ch = g * 16 + ho;
        float u[8]; unpack8(*(const u32x4*)(ug + ((size_t)g * MROWS + tok) * 16 + ho), u);
        const f32x4 d0 = *(const f32x4*)(dskip + ch), d1 = *(const f32x4*)(dskip + ch + 4);
        f32x4 y0, y1;
#pragma unroll
        for (int i = 0; i < 4; ++i) { y0[i] = gelu_tanh(a[i] + d0[i] * u[i]); y1[i] = gelu_tanh(b[i] + d1[i] * u[4 + i]); }
        *(u32x4*)(zs + (size_t)tok * 256 + ch) = pack8(y0, y1);
    }
};
struct PutGlu {
    bf16_t* cat; const bf16_t* zs; const bf16_t* gate; const float* gb;
    __device__ __forceinline__ void put(int pm, int pn, int rin, int cin, const f32x4& a, const f32x4& b) const {
        const size_t row = (size_t)pm * 256 + rin; const int col = cin;
        float z[8], gt[8]; unpack8(*(const u32x4*)(zs + row * 256 + col), z); unpack8(*(const u32x4*)(gate + row * 256 + col), gt);
        const f32x4 b0 = *(const f32x4*)(gb + col), b1 = *(const f32x4*)(gb + col + 4);
        f32x4 y0, y1;
#pragma unroll
        for (int i = 0; i < 4; ++i) { y0[i] = z[i] * sigmf(a[i] + b0[i]) * siluf(gt[i]); y1[i] = z[4 + i] * sigmf(b[i] + b1[i]) * siluf(gt[4 + i]); }
        *(u32x4*)(cat + row * DM + 512 + col) = pack8(y0, y1);
    }
};

struct Params {
    const float* in[36];
    float* out;
    unsigned char* ws;
    int ph_lo, ph_hi, dry, pad;
};
enum { I_X = 0, I_C, I_CTX, I_CCTX, I_WMOD, I_BMOD, I_GPRE, I_GPOST, I_WIN, I_WOUT, I_GCQ, I_WUQ, I_GCKV, I_WUKV, I_GQ, I_GK,
       I_LRE, I_LIM, I_LSTEP, I_BRE, I_BIM, I_CRE, I_CIM, I_SSMD, I_GLUW, I_GLUB, I_HCW, I_HCB, I_HW1, I_HB1, I_HF1, I_HW2, I_HB2, I_HF2, I_HW3, I_HBIAS };

typedef __attribute__((address_space(4))) const unsigned long long* kargp_t;
struct Ctx {
    LAS unsigned char* lds;
    kargp_t ka;
    unsigned char* ws;
    int tid, lane, wave, G, bid, dry;
};
#define GAS __attribute__((address_space(1)))
#define KIN(i) ((const float*)(GAS const float*)c.ka[(i)])
#define KOUT() ((float*)(GAS float*)c.ka[36])
template <class T> __device__ __forceinline__ T* wsp(const Ctx& c, size_t off) { return (T*)(c.ws + off); }

__device__ __forceinline__ int wmap(int kind, int n) {
    if (kind == 0) { if (n < 192) return n; if (n < 224) return 320 + (n - 192); if (n < 256) return -1; if (n < 384) return 192 + (n - 256); if (n < 512) return -1; return n - 160; }
    if (kind == 2) return (n >> 6) * 128 + (n & 63);
    if (kind == 3) return (n >> 6) * 128 + 64 + (n & 63);
    return n;
}
__device__ __forceinline__ void wconv_tile(const Ctx& c, const float* src, int Ks, int Ns, int Nlim, bf16_t* dst, int Kp, int kind, int nt, int kt) {
    LAS float* T = (LAS float*)c.lds;
    const int n0 = nt * 64, k0 = kt * 64;
    for (int e = c.tid; e < 4096; e += 512) { const int kk = e >> 6, nn = e & 63, k = k0 + kk, n = n0 + nn; const int sc = (n < Nlim) ? wmap(kind, n) : -1;
        T[kk * 65 + nn] = (k < Ks && sc >= 0) ? src[(size_t)k * Ns + sc] : 0.f; }
    __syncthreads();
    for (int e = c.tid; e < 4096; e += 512) { const int nn = e >> 6, kk = e & 63; dst[(size_t)(n0 + nn) * Kp + k0 + kk] = f2bf(T[kk * 65 + nn]); }
    __syncthreads();
}

__device__ __forceinline__ void modv_job(const Ctx& c, int job) {
    const int l = job / 48, j0 = (job % 48) * 64;
    LAS float* sc = (LAS float*)c.lds;
    LAS float* red = sc + 17 * 1024;
    const float* cv = KIN(I_C); const float* cc = KIN(I_CCTX);
    for (int e = c.tid; e < 17 * 1024; e += 512) { const int r = e >> 10, k = e & 1023; const float v = (r < 16) ? cv[r * 1024 + k] : cc[k]; sc[e] = siluf(v); }
    __syncthreads();
    const int col = c.tid & 63, ks = c.tid >> 6;
    const float* w = KIN(I_WMOD) + (size_t)l * 1024 * 3072 + j0 + col;
    float acc[17];
#pragma unroll
    for (int r = 0; r < 17; ++r) acc[r] = 0.f;
    for (int k = ks * 128; k < ks * 128 + 128; ++k) { const float wv = w[(size_t)k * 3072];
#pragma unroll
        for (int r = 0; r < 17; ++r) acc[r] += sc[r * 1024 + k] * wv; }
#pragma unroll
    for (int r = 0; r < 17; ++r) red[(ks * 17 + r) * 64 + col] = acc[r];
    __syncthreads();
    float* mv = wsp<float>(c, WS_MODV);
    for (int e = c.tid; e < 17 * 64; e += 512) { const int r = e >> 6, cl = e & 63; float s = KIN(I_BMOD)[l * 3072 + j0 + cl];
#pragma unroll
        for (int q = 0; q < 8; ++q) s += red[(q * 17 + r) * 64 + cl];
        mv[((size_t)l * 17 + r) * 3072 + j0 + cl] = s; }
    __syncthreads();
}

__device__ __forceinline__ void rope_job(const Ctx& c) {
    float* rg = wsp<float>(c, WS_ROPEG); float* rm = wsp<float>(c, WS_ROPEM);
    for (int e = c.tid; e < 64 * 16; e += 512) { const int pos = e >> 4, f = e & 15; const float inv = powf(10000.f, -(float)(2 * f) / 32.f); const float a = (float)pos * inv; rg[e * 2] = cosf(a); rg[e * 2 + 1] = sinf(a); }
    for (int e = c.tid; e < 64 * 8; e += 512) { const int pos = e >> 3, f = e & 7; const float inv = powf(10000.f, -(float)(2 * f) / 16.f); const float a = (float)pos * inv; rm[e * 2] = cosf(a); rm[e * 2 + 1] = sinf(a); }
}

typedef float cpx __attribute__((ext_vector_type(2)));
#define CPX(a, b) ((cpx){(a), (b)})
__device__ __forceinline__ cpx cmul(cpx a, cpx b) { return CPX(a.x * b.x - a.y * b.y, a.x * b.y + a.y * b.x); }
__device__ __forceinline__ void ssm_tables_job(const Ctx& c, int job) {
    const int l = job >> 4, g = job & 15;
    LAS cpx* apow = (LAS cpx*)c.lds;
    LAS cpx* bbar = apow + 2 * 17 * 64;
    LAS cpx* cm = bbar + 2 * 64 * 16;
    LAS float* Kc = (LAS float*)(cm + 2 * 16 * 64);
    for (int e = c.tid; e < 2 * 64; e += 512) {
        const int d = e >> 6, p = e & 63; const size_t ix = (((size_t)l * 2 + d) * 16 + g) * 64 + p;
        const float lr = KIN(I_LRE)[ix], li = KIN(I_LIM)[ix], st = expf(KIN(I_LSTEP)[((size_t)l * 2 + d) * 16 + g]);
        for (int k = 0; k <= 16; ++k) { const float m = expf(lr * st * (float)k), an = li * st * (float)k; apow[(d * 17 + k) * 64 + p] = CPX(m * cosf(an), m * sinf(an)); }
    }
    __syncthreads();
    for (int e = c.tid; e < 2 * 64 * 16; e += 512) {
        const int d = e >> 10, p = (e >> 4) & 63, h = e & 15; const size_t ix = (((size_t)l * 2 + d) * 16 + g) * 64 + p;
        const float lr = KIN(I_LRE)[ix], li = KIN(I_LIM)[ix];
        const cpx a = apow[(d * 17 + 1) * 64 + p]; const cpx am1 = CPX(a.x - 1.f, a.y);
        const float den = lr * lr + li * li; const cpx q = CPX((am1.x * lr + am1.y * li) / den, (am1.y * lr - am1.x * li) / den);
        const cpx b = CPX(KIN(I_BRE)[ix * 16 + h], KIN(I_BIM)[ix * 16 + h]);
        bbar[e] = cmul(q, b);
        const size_t cx = ((((size_t)l * 2 + d) * 16 + g) * 16 + h) * 64 + p;
        cm[(d * 16 + h) * 64 + p] = CPX(KIN(I_CRE)[cx], KIN(I_CIM)[cx]);
    }
    __syncthreads();
    for (int e = c.tid; e < 2 * 16 * 256; e += 512) {
        const int d = e >> 12, dd = (e >> 8) & 15, ho = (e >> 4) & 15, hi = e & 15; float s = 0.f;
        for (int p = 0; p < 64; ++p) { const cpx w = cmul(cm[(d * 16 + ho) * 64 + p], apow[(d * 17 + dd) * 64 + p]); const cpx b = bbar[(d * 64 + p) * 16 + hi]; s += w.x * b.x - w.y * b.y; }
        Kc[e] = s;
    }
    __syncthreads();
    bf16_t* wkc = wsp<bf16_t>(c, WS_WKC) + ((size_t)l * 16 + g) * 256 * 512;
    for (int e = c.tid; e < 256 * 512; e += 512) {
        const int r = e >> 9, q = e & 511, i = r >> 4, ho = r & 15; float v;
        if (q < 256) { const int j = q >> 4, hi = q & 15; v = 0.f; if (j <= i) v += Kc[((0 * 16 + (i - j)) * 16 + ho) * 16 + hi]; if (j >= i) v += Kc[((1 * 16 + (j - i)) * 16 + ho) * 16 + hi]; }
        else { const int qq = q - 256, dq = qq >> 7, comp = (qq >> 6) & 1, p = qq & 63, k = dq == 0 ? i + 1 : 16 - i; const cpx w = cmul(cm[(dq * 16 + ho) * 64 + p], apow[(dq * 17 + k) * 64 + p]); v = comp == 0 ? w.x : -w.y; }
        wkc[e] = f2bf(v);
    }
    bf16_t* we = wsp<bf16_t>(c, WS_WE) + ((size_t)l * 16 + g) * 256 * 256;
    for (int e = c.tid; e < 256 * 256; e += 512) {
        const int qq = e >> 8, cidx = e & 255, j = cidx >> 4, hi = cidx & 15, dq = qq >> 7, comp = (qq >> 6) & 1, p = qq & 63, k = dq == 0 ? 15 - j : j;
        const cpx w = cmul(apow[(dq * 17 + k) * 64 + p], bbar[(dq * 64 + p) * 16 + hi]);
        we[e] = f2bf(comp == 0 ? w.x : w.y);
    }
    float* a16 = wsp<float>(c, WS_A16);
    for (int e = c.tid; e < 128; e += 512) { const int d = e >> 6, p = e & 63; const cpx a = apow[(d * 17 + 16) * 64 + p]; const size_t ix = ((((size_t)l * 2 + d) * 16 + g) * 64 + p) * 2; a16[ix] = a.x; a16[ix + 1] = a.y; }
    __syncthreads();
}

__device__ __forceinline__ void hyena_mlp_job(const Ctx& c, int job) {
    const int l = job / 136, tt = job % 136;
    const bool isctx = tt >= 128; const int n = isctx ? CTXL : SEQL; const int t0 = isctx ? (tt - 128) * 32 : tt * 32;
    LAS float* z = (LAS float*)c.lds;
    LAS float* h1 = z + 32 * 36;
    LAS float* h2 = h1 + 32 * 64;
    for (int e = c.tid; e < 32 * 33; e += 512) {
        const int ti = e / 33, f = e % 33, t = t0 + ti; float v;
        if (f == 0) v = (float)t / (float)(n - 1);
        else { const int k = (f - 1) & 15; const float band = 1e-4f + (float)k * ((15.f - 1e-4f) / 15.f); const float om = 6.283185307179586f * (float)t / (float)n; v = (f <= 16) ? cosf(band * om) : -sinf(band * om); }
        z[ti * 36 + f] = v;
    }
    __syncthreads();
    for (int e = c.tid; e < 32 * 64; e += 512) {
        const int ti = e >> 6, j = e & 63; float s = KIN(I_HB1)[l * 64 + j];
        for (int f = 0; f < 33; ++f) s += z[ti * 36 + f] * KIN(I_HW1)[((size_t)l * 33 + f) * 64 + j];
        h1[e] = sinf(KIN(I_HF1)[l * 64 + j] * s);
    }
    __syncthreads();
    for (int e = c.tid; e < 32 * 64; e += 512) {
        const int ti = e >> 6, j = e & 63; float s = KIN(I_HB2)[l * 64 + j];
        for (int f = 0; f < 64; ++f) s += h1[ti * 64 + f] * KIN(I_HW2)[((size_t)l * 64 + f) * 64 + j];
        h2[e] = sinf(KIN(I_HF2)[l * 64 + j] * s);
    }
    __syncthreads();
    float* hT = wsp<float>(c, WS_HT) + (size_t)l * 1024 * NTOK;
    const float mind = -3.070113457325394f, maxd = -15.35056728662697f;
#pragma unroll
    for (int cc = 0; cc < 2; ++cc) {
        const int col = c.tid + cc * 512;
        float acc[32];
#pragma unroll
        for (int ti = 0; ti < 32; ++ti) acc[ti] = 0.f;
        for (int f = 0; f < 64; ++f) { const float w = KIN(I_HW3)[((size_t)l * 64 + f) * 1024 + col];
#pragma unroll
            for (int ti = 0; ti < 32; ++ti) acc[ti] += h2[ti * 64 + f] * w; }
        const int ch = col & 255; const float delta = fabsf(mind + (maxd - mind) * (float)ch / 255.f);
        float* dst = hT + (size_t)col * NTOK + (isctx ? SEQL : 0) + t0;
#pragma unroll
        for (int ti = 0; ti < 32; ++ti) { const float tn = (float)(t0 + ti) / (float)(n - 1); dst[ti] = acc[ti] * expf(-tn * delta); }
    }
    __syncthreads();
}

__device__ __forceinline__ void hyena_pack_job(const Ctx& c, int job) {
    const int l = job >> 9, o = (job >> 8) & 1, ch = job & 255;
    const float* hT = wsp<float>(c, WS_HT) + (size_t)l * 1024 * NTOK;
    const float* fw = hT + (size_t)(o * 512 + ch) * NTOK; const float* bw = hT + (size_t)(o * 512 + 256 + ch) * NTOK;
    LAS float* red = (LAS float*)c.lds;
    float s0 = 0.f, s1 = 0.f;
    for (int t = c.tid; t < SEQL; t += 512) { const float a = fw[t], b = bw[t]; s0 += a * a + b * b; }
    if (c.tid < CTXL) { const float a = fw[SEQL + c.tid], b = bw[SEQL + c.tid]; s1 = a * a + b * b; }
    s0 = wave_sum(s0); s1 = wave_sum(s1);
    if (c.lane == 0) { red[c.wave] = s0; red[8 + c.wave] = s1; }
    __syncthreads();
    float t0 = 0.f, t1 = 0.f;
#pragma unroll
    for (int w = 0; w < 8; ++w) { t0 += red[w]; t1 += red[8 + w]; }
    const float r0 = rsqrtf(t0 + EPS), r1 = rsqrtf(t1 + EPS);
    bf16_t* gr = wsp<bf16_t>(c, WS_GR) + (((size_t)l * 2 + o) * 256 + ch) * 8192;
    for (int e = c.tid; e < 8192; e += 512) { float v; if (e <= 4095) v = fw[4095 - e]; else if (e < 8191) v = bw[e - 4095]; else v = 0.f; gr[e] = f2bf(v * r0); }
    bf16_t* grc = wsp<bf16_t>(c, WS_GRC) + (((size_t)l * 2 + o) * 256 + ch) * 512;
    { const int e = c.tid; float v; if (e <= 255) v = fw[SEQL + 255 - e]; else if (e < 511) v = bw[SEQL + e - 255]; else v = 0.f; grc[e] = f2bf(v * r1); }
    __syncthreads();
}

__device__ __forceinline__ void norm_rows(const Ctx& c, int l  , int next  ) {
    const float* mvl = wsp<float>(c, WS_MODV) + (size_t)(l < 0 ? 0 : l) * 17 * 3072;
    const float* mvn = wsp<float>(c, WS_MODV) + (size_t)(next < 0 ? 0 : next) * 17 * 3072;
    const bf16_t* outb = wsp<bf16_t>(c, WS_OUTB);
    bf16_t* hb = wsp<bf16_t>(c, WS_HCAT);
    float* ctxr = wsp<float>(c, WS_CTXR);
    const float* xin0 = KIN(I_X); const float* cin0 = KIN(I_CTX); float* outp = KOUT();
    const float* gpost = KIN(I_GPOST) + (l < 0 ? 0 : l) * DM; const float* gpre = KIN(I_GPRE) + (next < 0 ? 0 : next) * DM;
    const int nw = c.G * 8, lane4 = c.lane * 4;
    for (int rowb = (c.bid * 8 + c.wave) * 2; rowb < MROWS; rowb += nw * 2) {
        f32x4 xv[2][4]; u32x2 ow[2][4]; const float* xin[2]; float* xout[2]; int mr[2]; bool live[2], isc[2];
#pragma unroll
        for (int rr = 0; rr < 2; ++rr) {
            const int row = rowb + rr, b = row / NTOK, j = row - b * NTOK; isc[rr] = j >= SEQL; live[rr] = !(next < 0 && isc[rr]); mr[rr] = isc[rr] ? 16 : b;
            if (isc[rr]) { xout[rr] = ctxr + ((size_t)b * CTXL + (j - SEQL)) * DM; xin[rr] = (l < 0) ? cin0 + ((size_t)b * CTXL + (j - SEQL)) * DM : xout[rr]; }
            else { xout[rr] = outp + ((size_t)b * SEQL + j) * DM; xin[rr] = (l <= 0) ? xin0 + ((size_t)b * SEQL + j) * DM : xout[rr]; }
#pragma unroll
            for (int q = 0; q < 4; ++q) { xv[rr][q] = *(const f32x4*)(xin[rr] + q * 256 + lane4); if (l >= 0) ow[rr][q] = *(const u32x2*)(outb + (size_t)row * DM + q * 256 + lane4); }
        }
#pragma unroll
        for (int rr = 0; rr < 2; ++rr) {
            if (!live[rr]) continue;
            const int row = rowb + rr;
            if (l >= 0) {
                float ov[16]; float ss = 0.f;
#pragma unroll
                for (int q = 0; q < 4; ++q) { ov[q * 4] = lo_bf(ow[rr][q].x); ov[q * 4 + 1] = hi_bf(ow[rr][q].x); ov[q * 4 + 2] = lo_bf(ow[rr][q].y); ov[q * 4 + 3] = hi_bf(ow[rr][q].y); }
#pragma unroll
                for (int i = 0; i < 16; ++i) ss += ov[i] * ov[i];
                ss = wave_sum(ss); const float rs = rsqrtf(ss * (1.f / DM) + EPS);
#pragma unroll
                for (int q = 0; q < 4; ++q) { const int col = q * 256 + lane4; const f32x4 gp = *(const f32x4*)(gpost + col); const f32x4 gt = *(const f32x4*)(mvl + mr[rr] * 3072 + 2048 + col);
#pragma unroll
                    for (int i = 0; i < 4; ++i) xv[rr][q][i] += gt[i] * (ov[q * 4 + i] * rs * gp[i]); }
            }
            if ((l >= 0 || isc[rr]) && !c.dry) {
#pragma unroll
                for (int q = 0; q < 4; ++q) *(f32x4*)(xout[rr] + q * 256 + lane4) = xv[rr][q];
            }
            if (next >= 0) {
                float ss = 0.f;
#pragma unroll
                for (int q = 0; q < 4; ++q)
#pragma unroll
                    for (int i = 0; i < 4; ++i) ss += xv[rr][q][i] * xv[rr][q][i];
                ss = wave_sum(ss); const float rs = rsqrtf(ss * (1.f / DM) + EPS);
#pragma unroll
                for (int q = 0; q < 4; ++q) { const int col = q * 256 + lane4; const f32x4 gp = *(const f32x4*)(gpre + col);
                    const f32x4 sh = *(const f32x4*)(mvn + mr[rr] * 3072 + col), sc = *(const f32x4*)(mvn + mr[rr] * 3072 + 1024 + col);
                    float hv[4];
#pragma unroll
                    for (int i = 0; i < 4; ++i) hv[i] = xv[rr][q][i] * rs * gp[i] * (1.f + sc[i]) + sh[i];
                    u32x2 w; w.x = cvt_pk_bf16(hv[0], hv[1]); w.y = cvt_pk_bf16(hv[2], hv[3]); *(u32x2*)(hb + (size_t)row * DM + col) = w; }
            }
        }
    }
}

__device__ __forceinline__ void p2_rows(const Ctx& c, int l) {
    bf16_t* pb = wsp<bf16_t>(c, WS_PB);
    bf16_t* B0 = pb; bf16_t* B1 = pb + BLKE; bf16_t* B3 = pb + 3 * BLKE; const bf16_t* B4 = pb + 4 * BLKE; const bf16_t* B6 = pb + 6 * BLKE;
    bf16_t* kr = wsp<bf16_t>(c, WS_KR); bf16_t* kg = wsp<bf16_t>(c, WS_KG); bf16_t* ug = wsp<bf16_t>(c, WS_UG); bf16_t* us = wsp<bf16_t>(c, WS_US);
    const float* ropeG = wsp<float>(c, WS_ROPEG); const float* ropeM = wsp<float>(c, WS_ROPEM);
    const int lane = c.lane;
    const f32x4 gcq = (lane < 48) ? *(const f32x4*)(KIN(I_GCQ) + l * 192 + lane * 4) : (f32x4){0.f, 0.f, 0.f, 0.f};
    const f32x4 gckv = (lane < 32) ? *(const f32x4*)(KIN(I_GCKV) + l * 128 + lane * 4) : (f32x4){0.f, 0.f, 0.f, 0.f};
    const f32x4 gq = *(const f32x4*)(KIN(I_GQ) + l * 64 + (lane & 15) * 4), gk = *(const f32x4*)(KIN(I_GK) + l * 64 + (lane & 15) * 4);
    for (int rowb = (c.bid * 8 + c.wave) * 4; rowb < MROWS; rowb += c.G * 8 * 4) {
        u32x2 w0[4], w1[4], w3[4], w4[4], w6[4];
#pragma unroll
        for (int rr = 0; rr < 4; ++rr) { const size_t ro = (size_t)(rowb + rr) * 256 + lane * 4;
            w0[rr] = *(const u32x2*)(B0 + ro); w1[rr] = *(const u32x2*)(B1 + ro); w3[rr] = *(const u32x2*)(B3 + ro); w4[rr] = *(const u32x2*)(B4 + ro); w6[rr] = *(const u32x2*)(B6 + ro); }
#pragma unroll
        for (int rr = 0; rr < 4; ++rr) {
            const int row = rowb + rr;
            const int b = row / NTOK, j = row - b * NTOK; const bool islat = j < SEQL; const int rowpos = (j >> 6) & 63, colpos = j & 63;
            const size_t ro = (size_t)row * 256 + lane * 4;
            {
                const u32x2 w = w0[rr]; float x[4] = {lo_bf(w.x), hi_bf(w.x), lo_bf(w.y), hi_bf(w.y)};
                float ss = (lane < 48) ? (x[0] * x[0] + x[1] * x[1] + x[2] * x[2] + x[3] * x[3]) : 0.f; ss = wave_sum(ss);
                const float rs = rsqrtf(ss * (1.f / 192.f) + EPS);
                float xp[4];
#pragma unroll
                for (int i = 0; i < 4; ++i) xp[i] = swz_xor<2>(x[i]);
                u32x2 o; o.x = 0u; o.y = 0u;
                if (lane < 48) { o.x = cvt_pk_bf16(x[0] * rs * gcq[0], x[1] * rs * gcq[1]); o.y = cvt_pk_bf16(x[2] * rs * gcq[2], x[3] * rs * gcq[3]); }
                else if (lane < 56) {
                    const int t = lane - 48; float y[4];
                    if (islat) { const int pos = (t & 4) ? colpos : rowpos; const bool isx2 = (t & 2) != 0;
#pragma unroll
                        for (int i = 0; i < 4; ++i) { const int f = 4 * (t & 1) + i; const float cs = ropeM[(pos * 8 + f) * 2], sn = ropeM[(pos * 8 + f) * 2 + 1]; y[i] = isx2 ? (xp[i] * sn + x[i] * cs) : (x[i] * cs - xp[i] * sn); } }
                    else {
#pragma unroll
                        for (int i = 0; i < 4; ++i) y[i] = x[i]; }
                    u32x2 kk; kk.x = cvt_pk_bf16(y[0], y[1]); kk.y = cvt_pk_bf16(y[2], y[3]); *(u32x2*)(kr + (size_t)row * 32 + t * 4) = kk;
                }
                if (!c.dry) *(u32x2*)(B0 + ro) = o;
            }
            {
                const u32x2 w = w1[rr]; float x[4] = {lo_bf(w.x), hi_bf(w.x), lo_bf(w.y), hi_bf(w.y)};
                float ss = (lane < 32) ? (x[0] * x[0] + x[1] * x[1] + x[2] * x[2] + x[3] * x[3]) : 0.f; ss = wave_sum(ss);
                const float rs = rsqrtf(ss * (1.f / 128.f) + EPS);
                u32x2 o; o.x = 0u; o.y = 0u;
                if (lane < 32) { o.x = cvt_pk_bf16(x[0] * rs * gckv[0], x[1] * rs * gckv[1]); o.y = cvt_pk_bf16(x[2] * rs * gckv[2], x[3] * rs * gckv[3]); }
                if (!c.dry) *(u32x2*)(B1 + ro) = o;
            }
#pragma unroll
            for (int which = 0; which < 2; ++which) {
                const u32x2 w = which == 0 ? w3[rr] : w4[rr]; float x[4] = {lo_bf(w.x), hi_bf(w.x), lo_bf(w.y), hi_bf(w.y)};
                float ss = x[0] * x[0] + x[1] * x[1] + x[2] * x[2] + x[3] * x[3];
                ss += swz_xor<1>(ss); ss += swz_xor<2>(ss); ss += swz_xor<4>(ss); ss += swz_xor<8>(ss);
                const float rs = rsqrtf(ss * (1.f / 64.f) + EPS);
                const int t = lane & 15; const f32x4 g = which == 0 ? gq : gk;
#pragma unroll
                for (int i = 0; i < 4; ++i) x[i] = x[i] * rs * g[i];
                float xp[4];
#pragma unroll
                for (int i = 0; i < 4; ++i) xp[i] = swz_xor<4>(x[i]);
                if (islat) { const int pos = (t & 8) ? colpos : rowpos; const bool isx2 = (t & 4) != 0;
#pragma unroll
                    for (int i = 0; i < 4; ++i) { const int f = 4 * (t & 3) + i; const float cs = ropeG[(pos * 16 + f) * 2], sn = ropeG[(pos * 16 + f) * 2 + 1]; x[i] = isx2 ? (xp[i] * sn + x[i] * cs) : (x[i] * cs - xp[i] * sn); } }
                if (which == 0) { const float qs = 0.125f * LOG2E; u32x2 o; o.x = cvt_pk_bf16(x[0] * qs, x[1] * qs); o.y = cvt_pk_bf16(x[2] * qs, x[3] * qs); if (!c.dry) *(u32x2*)(B3 + ro) = o; }
                else if (lane < 32) { u32x2 o; o.x = cvt_pk_bf16(x[0], x[1]); o.y = cvt_pk_bf16(x[2], x[3]); *(u32x2*)(kg + ((size_t)(b * 2 + (lane >> 4)) * NTOK + j) * 64 + t * 4) = o; }
            }
            {
                const u32x2 w = w6[rr]; const int g = lane >> 2, hi0 = (lane & 3) * 4;
                *(u32x2*)(ug + ((size_t)g * MROWS + row) * 16 + hi0) = w;
                *(u32x2*)(us + ((size_t)g * NCHUNK + (row >> 4)) * 512 + (row & 15) * 16 + hi0) = w;
            }
        }
    }
}
__device__ __forceinline__ void p2_tiles(const Ctx& c, int l) {
    const bf16_t* pb = wsp<bf16_t>(c, WS_PB);
    bf16_t* vtg = wsp<bf16_t>(c, WS_VTG);
    LAS bf16_t* T = (LAS bf16_t*)c.lds;
    LAS unsigned* T32 = (LAS unsigned*)c.lds;
    const int piece = c.tid & 7, chl = c.tid >> 3;
    const float* hcw = KIN(I_HCW) + (size_t)l * 3 * 768; const float* hcb = KIN(I_HCB) + l * 768;
    u32x4 pre[5];
#define P2T_LOAD(tl_, s_) do { const int b_ = (tl_) / 68, jt_ = (tl_) - b_ * 68, j0_ = jt_ * 64; const int lo_ = jt_ < 64 ? 0 : SEQL, hi_ = jt_ < 64 ? SEQL : NTOK; const size_t rb_ = (size_t)b_ * NTOK; \
        _Pragma("unroll") for (int k_ = 0; k_ < 5; ++k_) { const int e_ = c.tid + k_ * 512; pre[k_] = (u32x4){0u, 0u, 0u, 0u}; \
            if ((s_) == 0) { if (e_ < 64 * 16) { const int r_ = e_ >> 4, pc_ = e_ & 15; pre[k_] = *(const u32x4*)(pb + 4 * BLKE + (rb_ + j0_ + r_) * 256 + 128 + pc_ * 8); } } \
            else if (e_ < 66 * 32) { const int r_ = e_ >> 5, pc_ = e_ & 31, j_ = j0_ - 1 + r_; if (j_ >= lo_ && j_ < hi_) pre[k_] = *(const u32x4*)(pb + (size_t)(7 + (s_)) * BLKE + (rb_ + j_) * 256 + pc_ * 8); } } } while (0)
    int tl = c.bid, st = 0;
    if (tl < NB * 68) P2T_LOAD(tl, 0);
    while (tl < NB * 68) {
        const int b = tl / 68, jt = tl - b * 68, j0 = jt * 64;
#pragma unroll
        for (int k = 0; k < 5; ++k) { const int e = c.tid + k * 512;
            if (st == 0) { if (e < 64 * 16) { const int r = e >> 4, pc = e & 15; LAS unsigned* d = T32 + (r * 516 + pc * 16) / 4; d[0] = pre[k].x; d[1] = pre[k].y; d[2] = pre[k].z; d[3] = pre[k].w; } }
            else if (e < 66 * 32) { const int r = e >> 5, pc = e & 31; LAS unsigned* d = T32 + (r * 516 + pc * 16) / 4; d[0] = pre[k].x; d[1] = pre[k].y; d[2] = pre[k].z; d[3] = pre[k].w; } }
        __syncthreads();
        int ntl = tl, nst = st + 1; if (nst == 5) { nst = 0; ntl = tl + c.G; }
        if (ntl < NB * 68) { if (nst == 0) P2T_LOAD(ntl, 0); else P2T_LOAD(ntl, nst); }
        if (st == 0) {
#pragma unroll
            for (int ps = 0; ps < 2; ++ps) { const int dvf = chl + ps * 64; float v[8];
#pragma unroll
                for (int i = 0; i < 8; ++i) v[i] = bf2f(T[(piece * 8 + i) * 258 + dvf]);
                u32x4 w; w.x = cvt_pk_bf16(v[0], v[1]); w.y = cvt_pk_bf16(v[2], v[3]); w.z = cvt_pk_bf16(v[4], v[5]); w.w = cvt_pk_bf16(v[6], v[7]);
                *(u32x4*)(vtg + ((size_t)(b * 2 + (dvf >> 6)) * 64 + (dvf & 63)) * NTOK + j0 + piece * 8) = w; }
        } else {
            const int blk = 7 + st;
            bf16_t* dst = wsp<bf16_t>(c, blk == 8 ? WS_HYV : blk == 9 ? WS_HYX1 : blk == 10 ? WS_HYX2 : WS_HYG);
#pragma unroll
            for (int ps = 0; ps < 4; ++ps) { const int ch = chl + ps * 64; float v[8];
                if (blk < 11) { const int cc = (blk - 8) * 256 + ch; const float w0 = hcw[cc], w1 = hcw[768 + cc], w2 = hcw[1536 + cc], bs = hcb[cc];
                    float xm = bf2f(T[(piece * 8) * 258 + ch]), x0 = bf2f(T[(piece * 8 + 1) * 258 + ch]);
#pragma unroll
                    for (int i = 0; i < 8; ++i) { const float x1 = bf2f(T[(piece * 8 + i + 2) * 258 + ch]); v[i] = w0 * xm + w1 * x0 + w2 * x1 + bs; xm = x0; x0 = x1; } }
                else {
#pragma unroll
                    for (int i = 0; i < 8; ++i) v[i] = siluf(bf2f(T[(piece * 8 + i + 1) * 258 + ch])); }
                u32x4 w; w.x = cvt_pk_bf16(v[0], v[1]); w.y = cvt_pk_bf16(v[2], v[3]); w.z = cvt_pk_bf16(v[4], v[5]); w.w = cvt_pk_bf16(v[6], v[7]);
                *(u32x4*)(dst + ((size_t)ch * 16 + b) * NTOK + j0 + piece * 8) = w; }
        }
        __syncthreads();
        tl = ntl; st = nst;
    }
#undef P2T_LOAD
}

template <int DK, bool SUB>
__device__ __forceinline__ bool attn_unit(float (&rowmax)[2], const Ctx& c, const bf16_t* Qp, int qpitch, const bf16_t* Kp, const bf16_t* Vtp, int kt0, int nkt, int nrows,
                                          const bf16_t* gatep, bf16_t* outp, bool rope, int j0, float qscale, const float* ropeM) {
    constexpr int KS = DK / 16, KPC = DK / 8, KPITCH = DK * 2 + 16, KB = 64 * KPITCH, VPITCH = 136, VB = 64 * VPITCH;
    constexpr int KOFF = 0, VOFF = 3 * KB;
    constexpr float LIM = 60.f;
    static_assert(KB % 16 == 0 && VB % 16 == 0, "attention LDS buffer alignment");
    const int tid = c.tid, lane = c.lane, wave = c.wave;
    const int lq_ = opaque(lane), q = lq_ & 31, h = lq_ >> 5;
    LAS unsigned char* lds = c.lds;
    const int rbase = (wave * 64 < nrows) ? wave * 64 : wave * 64 - 256;
    const bool live = wave * 64 < nrows;
    bf16x8 qf[2][KS];
#pragma unroll
    for (int qt = 0; qt < 2; ++qt) {
        const bf16_t* qrow = Qp + (size_t)(rbase + qt * 32 + q) * qpitch + 8 * h;
#pragma unroll
        for (int ks = 0; ks < KS; ++ks) qf[qt][ks] = *(const bf16x8*)(qrow + 16 * ks);
        if (DK == 96) {
            const int jj = j0 + rbase + qt * 32 + q;
#pragma unroll
            for (int ks = 0; ks < KS; ++ks) {
                float x[8]; unpack8(__builtin_bit_cast(u32x4, qf[qt][ks]), x);
                if (ks >= 4) {
                    const int pos = (ks == 4) ? ((jj >> 6) & 63) : (jj & 63);
#pragma unroll
                    for (int e = 0; e < 8; ++e) { const float xp = half_other(x[e], h); const float cs = ropeM[(pos * 8 + e) * 2], sn = ropeM[(pos * 8 + e) * 2 + 1];
                        const float r = h ? (xp * sn + x[e] * cs) : (x[e] * cs - xp * sn); x[e] = rope ? r : x[e]; }
                }
                u32x4 w; w.x = cvt_pk_bf16(x[0] * qscale, x[1] * qscale); w.y = cvt_pk_bf16(x[2] * qscale, x[3] * qscale); w.z = cvt_pk_bf16(x[4] * qscale, x[5] * qscale); w.w = cvt_pk_bf16(x[6] * qscale, x[7] * qscale);
                qf[qt][ks] = __builtin_bit_cast(bf16x8, w);
            }
        }
    }
    f32x16 o00, o01, o10, o11;
#pragma unroll
    for (int i = 0; i < 16; ++i) { o00[i] = 0.f; o01[i] = 0.f; o10[i] = 0.f; o11[i] = 0.f; }
    const float m0 = SUB ? rowmax[0] : 0.f, m1 = SUB ? rowmax[1] : 0.f; float l0 = 0.f, l1 = 0.f;
    float rmax0 = -1e30f, rmax1 = -1e30f;
    u32x4 kreg0, kreg1 = {0u, 0u, 0u, 0u}, vreg;
#define AT_GLOADK(kt) do { const int tq_ = opaque(tid); const int kr0 = tq_ / KPC, kp0 = tq_ % KPC, kr1 = (tq_ + 512) / KPC, kp1 = (tq_ + 512) % KPC; const size_t key0 = (size_t)(kt) * 64; \
        kreg0 = *(const u32x4*)(Kp + (key0 + kr0) * DK + kp0 * 8); if (DK == 96 && tq_ < 256) kreg1 = *(const u32x4*)(Kp + (key0 + kr1) * DK + kp1 * 8); } while (0)
#define AT_GLOADV(kt) do { const int tq_ = opaque(tid); const int vdv = tq_ >> 3, vpc = tq_ & 7; vreg = *(const u32x4*)(Vtp + (size_t)vdv * NTOK + (size_t)(kt) * 64 + vpc * 8); } while (0)
#define AT_WRITEK(bi) do { const int tq_ = opaque(tid); const int kr0 = tq_ / KPC, kp0 = tq_ % KPC, kr1 = (tq_ + 512) / KPC, kp1 = (tq_ + 512) % KPC; LAS unsigned char* bb = lds + KOFF + (bi) * KB; \
        *(LAS u32x4*)(bb + kr0 * KPITCH + kp0 * 16) = kreg0; if (DK == 96 && tq_ < 256) *(LAS u32x4*)(bb + kr1 * KPITCH + kp1 * 16) = kreg1; } while (0)
#define AT_WRITEV(bi) do { const int tq_ = opaque(tid); const int vdv = tq_ >> 3, vpc = tq_ & 7; LAS u32x2* vd = (LAS u32x2*)(lds + VOFF + (bi) * VB + vdv * VPITCH + vpc * 16); vd[0] = (u32x2){vreg.x, vreg.y}; vd[1] = (u32x2){vreg.z, vreg.w}; } while (0)
#define AT_QK(S0, S1, bi, jh) do { const int ln_ = opaque(lane), q_ = ln_ & 31, h_ = ln_ >> 5; const LAS unsigned char* kb = lds + KOFF + (bi) * KB + ((jh) * 32 + q_) * KPITCH + 16 * h_; \
        _Pragma("unroll") for (int i = 0; i < 16; ++i) { S0[i] = 0.f; S1[i] = 0.f; } \
        _Pragma("unroll") for (int ks = 0; ks < KS; ++ks) { \
            const bf16x8 a0 = *(const LAS bf16x8*)(kb + 32 * ks); \
            S0 = __builtin_amdgcn_mfma_f32_32x32x16_bf16(a0, qf[0][ks], S0, 0, 0, 0); \
            S1 = __builtin_amdgcn_mfma_f32_32x32x16_bf16(a0, qf[1][ks], S1, 0, 0, 0); } } while (0)
#define AT_MAX(S, RM) do { if (!SUB) { _Pragma("unroll") for (int i = 0; i < 16; i += 2) RM = __builtin_fmaxf(RM, __builtin_fmaxf(S[i], S[i + 1])); } } while (0)
#define AT_EXP(S, M, L, PK0, PK1) do { float ps = 0.f; \
        _Pragma("unroll") for (int i = 0; i < 16; ++i) { S[i] = __builtin_amdgcn_exp2f(SUB ? S[i] - M : S[i]); ps += S[i]; } \
        L += ps; u32x4 w; \
        w.x = cvt_pk_bf16(S[0], S[1]); w.y = cvt_pk_bf16(S[2], S[3]); w.z = cvt_pk_bf16(S[4], S[5]); w.w = cvt_pk_bf16(S[6], S[7]); PK0 = __builtin_bit_cast(bf16x8, w); \
        w.x = cvt_pk_bf16(S[8], S[9]); w.y = cvt_pk_bf16(S[10], S[11]); w.z = cvt_pk_bf16(S[12], S[13]); w.w = cvt_pk_bf16(S[14], S[15]); PK1 = __builtin_bit_cast(bf16x8, w); } while (0)
#define AT_SUB(SC0, SC1, SN0, SN1, vbi, jh, nbi, njh) do { \
        AT_MAX(SC0, rmax0); AT_MAX(SC1, rmax1); __builtin_amdgcn_sched_barrier(0); \
        AT_QK(SN0, SN1, nbi, njh); \
        bf16x8 p00, p01, p10, p11; \
        AT_EXP(SC0, m0, l0, p00, p01); AT_EXP(SC1, m1, l1, p10, p11); __builtin_amdgcn_sched_barrier(0); \
        const int lv_ = opaque(lane), qv_ = lv_ & 31, hv_ = lv_ >> 5; const LAS unsigned char* vb = lds + VOFF + (vbi) * VB + qv_ * VPITCH + ((jh) * 32 + 4 * hv_) * 2; \
        _Pragma("unroll") for (int st = 0; st < 2; ++st) { \
            const u32x2 la = *(const LAS u32x2*)(vb + 32 * st), ha = *(const LAS u32x2*)(vb + 32 * st + 16), lb = *(const LAS u32x2*)(vb + 32 * VPITCH + 32 * st), hb = *(const LAS u32x2*)(vb + 32 * VPITCH + 32 * st + 16); \
            const bf16x8 va0 = __builtin_bit_cast(bf16x8, (u32x4){la.x, la.y, ha.x, ha.y}), va1 = __builtin_bit_cast(bf16x8, (u32x4){lb.x, lb.y, hb.x, hb.y}); \
            o00 = __builtin_amdgcn_mfma_f32_32x32x16_bf16(va0, st ? p01 : p00, o00, 0, 0, 0); \
            o01 = __builtin_amdgcn_mfma_f32_32x32x16_bf16(va1, st ? p01 : p00, o01, 0, 0, 0); \
            o10 = __builtin_amdgcn_mfma_f32_32x32x16_bf16(va0, st ? p11 : p10, o10, 0, 0, 0); \
            o11 = __builtin_amdgcn_mfma_f32_32x32x16_bf16(va1, st ? p11 : p10, o11, 0, 0, 0); } \
        __builtin_amdgcn_sched_barrier(0); } while (0)
    if (!SUB && tid == 0) *(volatile LAS unsigned*)(lds + LDS_MISC_OFF + 24) = 0u;
    AT_GLOADK(kt0); AT_GLOADV(kt0); AT_WRITEK(0); AT_WRITEV(0);
    AT_GLOADK(kt0 + 1); AT_WRITEK(1);
    __syncthreads();
    f32x16 sa0, sa1, sb0, sb1;
    AT_QK(sa0, sa1, 0, 0);
    int kb0 = 0, kb1 = 1, kb2 = 2;
    for (int t = 0; t < nkt; ++t) {
        const int tk = (t + 2 < nkt) ? t + 2 : nkt - 1, tv = (t + 1 < nkt) ? t + 1 : nkt - 1;
        AT_GLOADK(kt0 + tk);
        AT_SUB(sa0, sa1, sb0, sb1, t & 1, 0, kb0, 1);
        AT_WRITEK(kb2);
        AT_GLOADV(kt0 + tv);
        AT_SUB(sb0, sb1, sa0, sa1, t & 1, 1, kb1, 0);
        AT_WRITEV((t + 1) & 1);
        __syncthreads();
        const int tmp = kb0; kb0 = kb1; kb1 = kb2; kb2 = tmp;
    }
#undef AT_GLOADK
#undef AT_GLOADV
#undef AT_WRITEK
#undef AT_WRITEV
#undef AT_QK
#undef AT_MAX
#undef AT_EXP
#undef AT_SUB
    bool bad = false;
    if (!SUB) { const float r0 = half_max(rmax0), r1 = half_max(rmax1); rowmax[0] = r0; rowmax[1] = r1; const bool b_ = live && !(r0 < LIM && r0 > -LIM && r1 < LIM && r1 > -LIM); volatile LAS unsigned* flg = (volatile LAS unsigned*)(lds + LDS_MISC_OFF + 24); if (__any(b_ ? 1 : 0) && opaque(lane) == 0) *flg = 1u; __syncthreads(); bad = *flg != 0u; __syncthreads(); }
    if (live && !bad) {
        const int le_ = opaque(lane), q = le_ & 31, h = le_ >> 5;
#pragma unroll
        for (int qt = 0; qt < 2; ++qt) {
            const float lr = qt ? l1 : l0; const float lt = half_sum(lr), inv = 1.f / lt;
            const size_t row = (size_t)(rbase + qt * 32 + q);
#pragma unroll
            for (int dt = 0; dt < 2; ++dt)
#pragma unroll
                for (int g4 = 0; g4 < 4; ++g4) {
                    const int dv0 = dt * 32 + 8 * g4 + 4 * h;
                    const u32x2 gw = *(const u32x2*)(gatep + row * 256 + dv0);
                    const float g0 = siluf(lo_bf(gw.x)), g1 = siluf(hi_bf(gw.x)), g2 = siluf(lo_bf(gw.y)), g3 = siluf(hi_bf(gw.y));
                    const f32x16& o = qt ? (dt ? o11 : o10) : (dt ? o01 : o00);
                    u32x2 w; w.x = cvt_pk_bf16(o[4 * g4] * inv * g0, o[4 * g4 + 1] * inv * g1); w.y = cvt_pk_bf16(o[4 * g4 + 2] * inv * g2, o[4 * g4 + 3] * inv * g3);
                    *(u32x2*)(outp + row * DM + dv0) = w;
                }
        }
    }
    return bad;
}

template <int N>
__device__ __forceinline__ void hyena_conv(const Ctx& c, LAS unsigned char* ub, LAS unsigned char* gb, int pass, const bf16_t* xmul  , float bias,
                                           bf16_t* zdst  , const bf16_t* gmul, bf16_t* cat  ) {
    constexpr int UP = (N + 256) * 2 + 16, NPAIR = N / 256, OFF8 = N - 8;
    const int lane = c.lane, i16 = lane & 15, kq = lane >> 4;
    for (int pr = c.wave; pr < NPAIR; pr += 8) {
        const int t0 = pr * 256;
        f32x4 acc[2][8];
#pragma unroll
        for (int m = 0; m < 8; ++m) { acc[0][m] = (f32x4){0.f, 0.f, 0.f, 0.f}; acc[1][m] = (f32x4){0.f, 0.f, 0.f, 0.f}; }
        const LAS unsigned char* up = ub + i16 * UP + 256 + kq * 16;
        const LAS unsigned char* gp = gb + (OFF8 - t0 - 8 * i16 + 8 * kq) * 2;
        bf16x8 bfa = *(const LAS bf16x8*)(up - 256), bfb = *(const LAS bf16x8*)(up);
        u32x4 wa = *(const LAS u32x4*)(gp - 256), wb = *(const LAS u32x4*)(gp - 256 + 16);
        for (int s0 = -128; s0 < N; s0 += 32) {
            const int sn = (s0 + 32 < N) ? s0 + 32 : s0;
            const bf16x8 bfan = *(const LAS bf16x8*)(up + sn * 2), bfbn = *(const LAS bf16x8*)(up + sn * 2 + 256);
            const u32x4 wan = *(const LAS u32x4*)(gp + sn * 2), wbn = *(const LAS u32x4*)(gp + sn * 2 + 16);
            const unsigned w[8] = {wa.x, wa.y, wa.z, wa.w, wb.x, wb.y, wb.z, wb.w};
            unsigned sh[7];
#pragma unroll
            for (int k = 0; k < 7; ++k) sh[k] = __builtin_amdgcn_alignbit(w[k + 1], w[k], 16);
#pragma unroll
            for (int m = 0; m < 8; ++m) {
                u32x4 a;
                if (m & 1) { const int d0 = (7 - m) >> 1; a = (u32x4){w[d0], w[d0 + 1], w[d0 + 2], w[d0 + 3]}; }
                else { const int d0 = (6 - m) >> 1; a = (u32x4){sh[d0], sh[d0 + 1], sh[d0 + 2], sh[d0 + 3]}; }
                acc[0][m] = __builtin_amdgcn_mfma_f32_16x16x32_bf16(__builtin_bit_cast(bf16x8, a), bfa, acc[0][m], 0, 0, 0);
                acc[1][m] = __builtin_amdgcn_mfma_f32_16x16x32_bf16(__builtin_bit_cast(bf16x8, a), bfb, acc[1][m], 0, 0, 0);
            }
            bfa = bfan; bfb = bfbn; wa = wan; wb = wbn;
        }
#pragma unroll
        for (int half = 0; half < 2; ++half)
#pragma unroll
            for (int r = 0; r < 4; ++r) {
                const int t8 = t0 + half * 128 + 32 * kq + 8 * r;
                float uu[8], xm[8]; unpack8(*(const LAS u32x4*)(ub + i16 * UP + 256 + t8 * 2), uu); unpack8(*(const u32x4*)(xmul + (size_t)i16 * NTOK + t8), xm);
                float y[8];
#pragma unroll
                for (int m = 0; m < 8; ++m) y[m] = xm[m] * (acc[half][m][r] + bias * uu[m]);
                if (pass == 0) { u32x4 o; o.x = cvt_pk_bf16(y[0], y[1]); o.y = cvt_pk_bf16(y[2], y[3]); o.z = cvt_pk_bf16(y[4], y[5]); o.w = cvt_pk_bf16(y[6], y[7]); *(u32x4*)(zdst + (size_t)i16 * NTOK + t8) = o; }
                else { float gg[8]; unpack8(*(const u32x4*)(gmul + (size_t)i16 * NTOK + t8), gg);
                    u32x4 o; o.x = cvt_pk_bf16(y[0] * gg[0], y[1] * gg[1]); o.y = cvt_pk_bf16(y[2] * gg[2], y[3] * gg[3]); o.z = cvt_pk_bf16(y[4] * gg[4], y[5] * gg[5]); o.w = cvt_pk_bf16(y[6] * gg[6], y[7] * gg[7]);
                    *(u32x4*)(cat + (size_t)i16 * NTOK + t8) = o; }
            }
    }
}
template <int N>
__device__ __forceinline__ void hyena_seq(const Ctx& c, int l, int ch, int toff) {
    constexpr int UP = (N + 256) * 2 + 16;
    LAS unsigned char* ub = c.lds; LAS unsigned char* gb = c.lds + 16 * UP;
    const bf16_t* vv = wsp<bf16_t>(c, WS_HYV) + (size_t)ch * 16 * NTOK + toff;
    bf16_t* vz = wsp<bf16_t>(c, WS_HYZ) + (size_t)ch * 16 * NTOK + toff;
    const bf16_t* x1 = wsp<bf16_t>(c, WS_HYX1) + (size_t)ch * 16 * NTOK + toff;
    const bf16_t* x2 = wsp<bf16_t>(c, WS_HYX2) + (size_t)ch * 16 * NTOK + toff;
    const bf16_t* gm = wsp<bf16_t>(c, WS_HYG) + (size_t)ch * 16 * NTOK + toff;
    bf16_t* cat = wsp<bf16_t>(c, WS_HYY) + (size_t)ch * 16 * NTOK + toff;
    { const int e = c.tid, b = e >> 5, side = (e >> 4) & 1, pc = e & 15; unsigned z = 0u; asm volatile("" : "+v"(z)); *(LAS u32x4*)(ub + b * UP + side * (256 + N * 2) + pc * 16) = (u32x4){z, z, z, z}; }
    for (int pass = 0; pass < 2; ++pass) {
        const bf16_t* gr = (N == SEQL) ? wsp<bf16_t>(c, WS_GR) + (((size_t)l * 2 + pass) * 256 + ch) * 8192 : wsp<bf16_t>(c, WS_GRC) + (((size_t)l * 2 + pass) * 256 + ch) * 512;
        const bf16_t* usrc = pass == 0 ? vv : vz;
        constexpr int NG = (2 * N / 8 + 511) / 512;
        {
            u32x4 t[NG];
#pragma unroll
            for (int k = 0; k < NG; ++k) { const int e = c.tid + k * 512; t[k] = (e < 2 * N / 8) ? *(const u32x4*)(gr + e * 8) : (u32x4){0u, 0u, 0u, 0u}; }
#pragma unroll
            for (int k = 0; k < NG; ++k) { const int e = c.tid + k * 512; if (e < 2 * N / 8) *(LAS u32x4*)(gb + e * 16) = t[k]; }
        }
        if constexpr (N == SEQL) {
#pragma unroll
            for (int k0 = 0; k0 < 16; k0 += 8) {
                u32x4 t[8];
#pragma unroll
                for (int k = 0; k < 8; ++k) t[k] = *(const u32x4*)(usrc + (size_t)(k0 + k) * NTOK + c.tid * 8);
#pragma unroll
                for (int k = 0; k < 8; ++k) *(LAS u32x4*)(ub + (k0 + k) * UP + 256 + c.tid * 16) = t[k];
            }
        } else {
            const int b = c.tid >> 5, pc = c.tid & 31;
            *(LAS u32x4*)(ub + b * UP + 256 + pc * 16) = *(const u32x4*)(usrc + (size_t)b * NTOK + pc * 8);
        }
        __syncthreads();
        const float bias = KIN(I_HBIAS)[((size_t)l * 2 + pass) * 256 + ch];
        hyena_conv<N>(c, ub, gb, pass, pass == 0 ? x1 : x2, bias, vz, gm, cat);
        asm volatile("s_waitcnt vmcnt(0)" ::: "memory");
        __syncthreads();
    }
}

__device__ __forceinline__ void hyena_untranspose(const Ctx& c) {
    const bf16_t* yT = wsp<bf16_t>(c, WS_HYY); bf16_t* cat = wsp<bf16_t>(c, WS_HCAT);
    LAS bf16_t* T = (LAS bf16_t*)c.lds;
    LAS unsigned* T32 = (LAS unsigned*)c.lds;
    for (int tl = c.bid; tl < NB * 68; tl += c.G) {
        const int b = tl / 68, j0 = (tl - b * 68) * 64;
        u32x4 pre[4];
#pragma unroll
        for (int k = 0; k < 4; ++k) { const int e = c.tid + k * 512, ch = e >> 3, pc = e & 7; pre[k] = *(const u32x4*)(yT + ((size_t)ch * 16 + b) * NTOK + j0 + pc * 8); }
#pragma unroll
        for (int k = 0; k < 4; ++k) { const int e = c.tid + k * 512, ch = e >> 3, pc = e & 7; LAS unsigned* d = T32 + (ch * 132 + pc * 16) / 4; d[0] = pre[k].x; d[1] = pre[k].y; d[2] = pre[k].z; d[3] = pre[k].w; }
        __syncthreads();
#pragma unroll
        for (int k = 0; k < 4; ++k) { const int e = c.tid + k * 512, t = e >> 5, c0 = (e & 31) * 8; float v[8];
#pragma unroll
            for (int i = 0; i < 8; ++i) v[i] = bf2f(T[(c0 + i) * 66 + t]);
            u32x4 w; w.x = cvt_pk_bf16(v[0], v[1]); w.y = cvt_pk_bf16(v[2], v[3]); w.z = cvt_pk_bf16(v[4], v[5]); w.w = cvt_pk_bf16(v[6], v[7]);
            *(u32x4*)(cat + ((size_t)b * NTOK + j0 + t) * DM + 768 + c0) = w; }
        __syncthreads();
    }
}

__device__ __forceinline__ void ssm_scan_item(const Ctx& c, int l, int item) {
    const int b = item >> 2, g = (item & 3) * 4 + (c.tid >> 7), dq = (c.tid >> 6) & 1, p = c.tid & 63;
    const float* a16 = wsp<float>(c, WS_A16) + ((((size_t)l * 2 + dq) * 16 + g) * 64 + p) * 2;
    const float ar = a16[0], ai = a16[1];
    const bf16_t* E = wsp<bf16_t>(c, WS_E); bf16_t* US = wsp<bf16_t>(c, WS_US);
    float sr = 0.f, si = 0.f;
    for (int st0 = 0; st0 < NCHB; st0 += 8) {
        float er[8], ei[8]; size_t ro[8];
#pragma unroll
        for (int k = 0; k < 8; ++k) { const int st = st0 + k; const int cc = dq == 0 ? (st < 16 ? 256 + st : st - 16) : (st < 16 ? 271 - st : 255 - (st - 16));
            ro[k] = (size_t)g * NCHUNK + (size_t)b * NCHB + cc; er[k] = bf2f(E[ro[k] * 256 + dq * 128 + p]); ei[k] = bf2f(E[ro[k] * 256 + dq * 128 + 64 + p]); }
#pragma unroll
        for (int k = 0; k < 8; ++k) {
            US[ro[k] * 512 + 256 + dq * 128 + p] = f2bf(sr); US[ro[k] * 512 + 256 + dq * 128 + 64 + p] = f2bf(si);
            const float nr = ar * sr - ai * si + er[k], ni = ar * si + ai * sr + ei[k]; sr = nr; si = ni;
        }
    }
}

constexpr int LDS_BYTES = 163840;
constexpr int LDS_MISC = LDS_MISC_OFF;
static_assert(LDS_MISC_OFF == LDS_BYTES - 256, "LDS map");
constexpr int NPRO = 2, NPH = 8, NPHASES = NPRO + DEPTH * NPH;
constexpr int QI_HY = 256, QI_SCAN = 64, QI_ATT = NB * 8 * 9;
#ifndef PROBE_DUP_MASK
#define PROBE_DUP_MASK 0
#endif
#ifndef PROBE_ATT2
#define PROBE_ATT2 0
#endif
#ifndef PROBE_HY2
#define PROBE_HY2 0
#endif
#ifndef PROBE_GEMM2
#define PROBE_GEMM2 0
#endif
constexpr int QI_TOTAL = QI_HY + QI_SCAN + QI_ATT + (PROBE_ATT2 ? QI_ATT : 0) + (PROBE_HY2 ? QI_HY : 0);

__global__ void __launch_bounds__(512, 2) mk_fwd(Params prm) {
    extern __shared__ __attribute__((aligned(16))) unsigned char lds_raw[];
    Ctx c; c.lds = (LAS unsigned char*)lds_raw; c.ka = (kargp_t)__builtin_amdgcn_kernarg_segment_ptr(); c.ws = prm.ws; c.tid = threadIdx.x; c.lane = c.tid & 63; c.wave = __builtin_amdgcn_readfirstlane(c.tid >> 6); c.G = gridDim.x; c.bid = blockIdx.x; c.dry = prm.dry;
    const int wave0 = c.wave;
    volatile LAS unsigned* misc = (volatile LAS unsigned*)(c.lds + LDS_MISC);
    if (c.tid < 16) misc[c.tid] = 0u;
    __syncthreads();
    unsigned* ctl = wsp<unsigned>(c, WS_CTL);
    const int lo = prm.ph_lo, hi = prm.ph_hi;
    const bool fused = (hi - lo) > 1;
    XcdBarrier bar; bar.bar = ctl + CW_BAR; bar.x = 0; bar.st = misc;
    if (fused) bar = xcd_barrier_post(ctl + CW_BAR, misc);
#ifndef SITE_MASK
#define SITE_MASK 0x3ff
#endif
#define SITE(n) (((SITE_MASK) >> (n)) & 1)
#define IN(k) (lo <= (k) && (k) < hi)
#define FRESH() do { { kargp_t _k = (kargp_t)__builtin_amdgcn_kernarg_segment_ptr(); asm volatile("" : "+s"(_k)); c.ka = _k; c.ws = (unsigned char*)(GAS unsigned char*)_k[37]; } { int _w = wave0; asm volatile("" : "+s"(_w)); c.wave = _w; c.lane = lane_id_fresh(); c.tid = c.wave * 64 + c.lane; } } while (0)
#define SEAM(k) do { if (IN((k) + 1)) xcd_barrier(bar); } while (0)

    if (SITE(0) && IN(0)) {
        FRESH();
        constexpr int J_SSM = 64, J_HY = 544, J_MOD = 192, J_WIN = 4 * 48 * 16, J_WOUT = 4 * 16 * 16, J_WUQ = 4 * 8 * 4, J_W256 = 4 * 4 * 4;
        constexpr int J0 = J_SSM, J1 = J0 + J_HY, J2 = J1 + J_MOD, J3 = J2 + J_WIN, J4 = J3 + J_WOUT, J5 = J4 + J_WUQ, J6 = J5 + J_W256, J7 = J6 + J_W256, J8 = J7 + J_W256, J9 = J8 + 1;
        for (int job = c.bid; job < J9; job += c.G) {
            if (job < J0) ssm_tables_job(c, job);
            else if (job < J1) hyena_mlp_job(c, job - J0);
            else if (job < J2) modv_job(c, job - J1);
            else if (job < J3) { const int r = job - J2, l = r / 768, q = r % 768; wconv_tile(c, KIN(I_WIN) + (size_t)l * DM * INC, DM, INC, INP, wsp<bf16_t>(c, WS_WIN) + (size_t)l * INP * DM, DM, 0, q / 16, q % 16); }
            else if (job < J4) { const int r = job - J3, l = r / 256, q = r % 256; wconv_tile(c, KIN(I_WOUT) + (size_t)l * DM * DM, DM, DM, DM, wsp<bf16_t>(c, WS_WOUT) + (size_t)l * DM * DM, DM, 1, q / 16, q % 16); }
            else if (job < J5) { const int r = job - J4, l = r / 32, q = r % 32; wconv_tile(c, KIN(I_WUQ) + (size_t)l * 192 * 384, 192, 384, 384, wsp<bf16_t>(c, WS_WUQ) + (size_t)l * 512 * 256, 256, 1, q / 4, q % 4); }
            else if (job < J6) { const int r = job - J5, l = r / 16, q = r % 16; wconv_tile(c, KIN(I_WUKV) + (size_t)l * 128 * 512, 128, 512, 256, wsp<bf16_t>(c, WS_WUK) + (size_t)l * 256 * 256, 256, 2, q / 4, q % 4); }
            else if (job < J7) { const int r = job - J6, l = r / 16, q = r % 16; wconv_tile(c, KIN(I_WUKV) + (size_t)l * 128 * 512, 128, 512, 256, wsp<bf16_t>(c, WS_WUV) + (size_t)l * 256 * 256, 256, 3, q / 4, q % 4); }
            else if (job < J8) { const int r = job - J7, l = r / 16, q = r % 16; wconv_tile(c, KIN(I_GLUW) + (size_t)l * 256 * 256, 256, 256, 256, wsp<bf16_t>(c, WS_WGLU) + (size_t)l * 256 * 256, 256, 1, q / 4, q % 4); }
            else rope_job(c);
        }
        SEAM(0);
    }
    if (SITE(1) && IN(1)) {
        FRESH();
        for (int job = c.bid; job < 4 * 2 * 256; job += c.G) hyena_pack_job(c, job);
        norm_rows(c, -1, 0);
        SEAM(1);
    }
    for (int l = 0; l < DEPTH; ++l) {
        const int pbase = NPRO + l * NPH;
        if (SITE(2) && IN(pbase + 0)) {
            FRESH();
            pg8::Gemm g{wsp<bf16_t>(c, WS_HCAT), wsp<bf16_t>(c, WS_WIN) + (size_t)l * INP * DM, MROWS, INP, DM};
            pg8::StaticOrder S; S.init(MROWS, INP, c.G, c.bid);
            pg8::EpiWalk<PutSplit> E{{wsp<bf16_t>(c, WS_PB)}};
            pg8::gemm_phase(c.lds, g, S, E, c.tid); if (PROBE_GEMM2) { FRESH(); pg8::gemm_phase(c.lds, g, S, E, c.tid); }
            SEAM(pbase + 0);
        }
        if (SITE(3) && IN(pbase + 1)) { FRESH(); p2_rows(c, l); FRESH(); p2_tiles(c, l); SEAM(pbase + 1); }
        if (SITE(4) && IN(pbase + 2)) {
            FRESH();
            { pg8::Gemm g{wsp<bf16_t>(c, WS_PB), wsp<bf16_t>(c, WS_WUQ) + (size_t)l * 512 * 256, MROWS, 512, 256}; pg8::StaticOrder S; S.init(MROWS, 512, c.G, c.bid);
              pg8::EpiWalk<PutPlain> E{{wsp<bf16_t>(c, WS_QM), 384, 384}}; pg8::gemm_phase(c.lds, g, S, E, c.tid); if (PROBE_GEMM2) { FRESH(); pg8::gemm_phase(c.lds, g, S, E, c.tid); } }
            FRESH();
            { pg8::Gemm g{wsp<bf16_t>(c, WS_PB) + BLKE, wsp<bf16_t>(c, WS_WUK) + (size_t)l * 256 * 256, MROWS, 256, 256}; pg8::StaticOrder S; S.init(MROWS, 256, c.G, c.bid);
              pg8::EpiWalk<PutKm> E{{wsp<bf16_t>(c, WS_KM), wsp<bf16_t>(c, WS_KR)}}; pg8::gemm_phase(c.lds, g, S, E, c.tid); if (PROBE_GEMM2) { FRESH(); pg8::gemm_phase(c.lds, g, S, E, c.tid); } }
            FRESH();
            { pg8::Gemm g{wsp<bf16_t>(c, WS_WUV) + (size_t)l * 256 * 256, wsp<bf16_t>(c, WS_PB) + BLKE, 256, MROWS, 256}; pg8::StaticOrder S; S.init(256, MROWS, c.G, c.bid);
              pg8::EpiWalk<PutVt> E{{wsp<bf16_t>(c, WS_VTM)}}; pg8::gemm_phase(c.lds, g, S, E, c.tid); if (PROBE_GEMM2) { FRESH(); pg8::gemm_phase(c.lds, g, S, E, c.tid); } }
            FRESH();
            { pg8::Gemm g{wsp<bf16_t>(c, WS_UG), wsp<bf16_t>(c, WS_WE) + (size_t)l * 16 * 256 * 256, 16 * NCHUNK, 16 * 256, 256}; pg8::BatchedOrder S; S.init(16, NCHUNK / 256, c.G, c.bid);
              pg8::EpiWalk<PutE> E{{wsp<bf16_t>(c, WS_E)}}; pg8::gemm_phase(c.lds, g, S, E, c.tid); if (PROBE_GEMM2) { FRESH(); pg8::gemm_phase(c.lds, g, S, E, c.tid); } }
            SEAM(pbase + 2);
        }
        if (SITE(5) && IN(pbase + 3)) {
            FRESH();
            unsigned* qh = ctl + CW_Q + 64 * (l + 4 * c.dry);
            const float* ropeM = wsp<float>(c, WS_ROPEM);
#define ATT_CALL(DKV, ...) do { float rowmax_[2] = {0.f, 0.f}; if (attn_unit<DKV, false>(rowmax_, __VA_ARGS__)) { (void)attn_unit<DKV, true>(rowmax_, __VA_ARGS__); } } while (0)
            for (;;) {
                __syncthreads();
                if (c.tid == 0) misc[4] = __hip_atomic_fetch_add(qh, 1u, __ATOMIC_RELAXED, __HIP_MEMORY_SCOPE_AGENT);
                __syncthreads();
                int it = (int)misc[4];
                if (it >= QI_TOTAL) break;
                if (PROBE_ATT2 && it >= QI_HY + QI_SCAN + QI_ATT && it < QI_HY + QI_SCAN + 2 * QI_ATT) it -= QI_ATT;
                if (PROBE_HY2 && it >= QI_TOTAL - QI_HY) it -= QI_TOTAL - QI_HY;
                FRESH();
                if (it < QI_HY) { hyena_seq<SEQL>(c, l, it, 0); hyena_seq<CTXL>(c, l, it, SEQL); }
                else if (it < QI_HY + QI_SCAN) ssm_scan_item(c, l, it - QI_HY);
                else {
                    const int a = it - QI_HY - QI_SCAN; const int blk = a / (NB * 8)  , r = a % (NB * 8), kind = r & 1  , head = (r >> 1) & 3, b = r >> 3;
                    const bool isctx = blk == 8;
                    const size_t row0 = (size_t)b * NTOK + (isctx ? SEQL : blk * 512); const int kt0 = isctx ? 64 : 0, nkt = isctx ? 4 : 68, nrows = isctx ? 256 : 512;
                    if (kind == 0) { ATT_CALL(96, c, wsp<bf16_t>(c, WS_QM) + row0 * 384 + head * 96, 384, wsp<bf16_t>(c, WS_KM) + (size_t)(b * 4 + head) * NTOK * 96, wsp<bf16_t>(c, WS_VTM) + (size_t)(b * 4 + head) * 64 * NTOK,
                                                 kt0, nkt, nrows, wsp<bf16_t>(c, WS_PB) + 2 * BLKE + row0 * 256 + head * 64, wsp<bf16_t>(c, WS_HCAT) + row0 * DM + head * 64, !isctx, blk * 512, 0.10206207261596577f * LOG2E, ropeM); }
                    else { ATT_CALL(64, c, wsp<bf16_t>(c, WS_PB) + 3 * BLKE + row0 * 256 + head * 64, 256, wsp<bf16_t>(c, WS_KG) + (size_t)(b * 2 + (head >> 1)) * NTOK * 64, wsp<bf16_t>(c, WS_VTG) + (size_t)(b * 2 + (head >> 1)) * 64 * NTOK,
                                       kt0, nkt, nrows, wsp<bf16_t>(c, WS_PB) + 5 * BLKE + row0 * 256 + head * 64, wsp<bf16_t>(c, WS_HCAT) + row0 * DM + 256 + head * 64, false, 0, 1.f, ropeM); }
                }
            }
            SEAM(pbase + 3);
        }
        if (SITE(6) && IN(pbase + 4)) {
            FRESH();
            hyena_untranspose(c);
            FRESH();
            pg8::Gemm g{wsp<bf16_t>(c, WS_US), wsp<bf16_t>(c, WS_WKC) + (size_t)l * 16 * 256 * 512, 16 * NCHUNK, 16 * 256, 512}; pg8::BatchedOrder S; S.init(16, NCHUNK / 256, c.G, c.bid);
            pg8::EpiWalk<PutSsmY> E{{wsp<bf16_t>(c, WS_ZS), wsp<bf16_t>(c, WS_UG), KIN(I_SSMD) + l * 256}}; pg8::gemm_phase(c.lds, g, S, E, c.tid); if (PROBE_GEMM2) { FRESH(); pg8::gemm_phase(c.lds, g, S, E, c.tid); }
            SEAM(pbase + 4);
        }
        if (SITE(7) && IN(pbase + 5)) {
            FRESH();
            pg8::Gemm g{wsp<bf16_t>(c, WS_ZS), wsp<bf16_t>(c, WS_WGLU) + (size_t)l * 256 * 256, MROWS, 256, 256}; pg8::StaticOrder S; S.init(MROWS, 256, c.G, c.bid);
            pg8::EpiWalk<PutGlu> E{{wsp<bf16_t>(c, WS_HCAT), wsp<bf16_t>(c, WS_ZS), wsp<bf16_t>(c, WS_PB) + 7 * BLKE, KIN(I_GLUB) + l * 256}}; pg8::gemm_phase(c.lds, g, S, E, c.tid); if (PROBE_GEMM2) { FRESH(); pg8::gemm_phase(c.lds, g, S, E, c.tid); }
            SEAM(pbase + 5);
        }
        if (SITE(8) && IN(pbase + 6)) {
            FRESH();
            pg8::Gemm g{wsp<bf16_t>(c, WS_HCAT), wsp<bf16_t>(c, WS_WOUT) + (size_t)l * DM * DM, MROWS, DM, DM}; pg8::StaticOrder S; S.init(MROWS, DM, c.G, c.bid);
            pg8::EpiWalk<PutPlain> E{{wsp<bf16_t>(c, WS_OUTB), DM, DM}}; pg8::gemm_phase(c.lds, g, S, E, c.tid); if (PROBE_GEMM2) { FRESH(); pg8::gemm_phase(c.lds, g, S, E, c.tid); }
            SEAM(pbase + 6);
        }
        if (SITE(9) && IN(pbase + 7)) { FRESH(); norm_rows(c, l, l + 1 < DEPTH ? l + 1 : -1); if (l + 1 < DEPTH) SEAM(pbase + 7); }
    }
#undef IN
#undef SEAM
}

extern "C" void kernel_launch(void* const* d_in, const int* in_sizes, int n_in, void* d_out, int out_size, void* d_ws, size_t ws_size, hipStream_t stream) {
    static int grid = 0;
    if (grid == 0) {
        if (n_in != 36 || out_size != NB * SEQL * DM || ws_size < WS_END) { fprintf(stderr, "kernel_launch: unexpected shapes: n_in %d out %d ws %zu (need %zu)\n", n_in, out_size, ws_size, (size_t)WS_END); grid = -1; return; }
        int dev = 0, cus = 0, per_cu = 0;
        if (hipGetDevice(&dev) != hipSuccess || hipDeviceGetAttribute(&cus, hipDeviceAttributeMultiprocessorCount, dev) != hipSuccess) { grid = -1; return; }
        if (hipFuncSetAttribute((const void*)mk_fwd, hipFuncAttributeMaxDynamicSharedMemorySize, LDS_BYTES) != hipSuccess) { fprintf(stderr, "kernel_launch: hipFuncSetAttribute failed\n"); grid = -1; return; }
        if (hipOccupancyMaxActiveBlocksPerMultiprocessor(&per_cu, (const void*)mk_fwd, 512, LDS_BYTES) != hipSuccess || per_cu < 1) { fprintf(stderr, "kernel_launch: occupancy query says %d blocks per CU\n", per_cu); per_cu = 1; }
        (void)hipGetLastError();
        grid = cus;
    }
    if (grid < 0) return;
    (void)hipMemsetAsync((char*)d_ws + WS_CTL, 0, CTL_BYTES, stream);
    Params p{};
    for (int i = 0; i < 36; ++i) p.in[i] = (const float*)d_in[i];
    p.out = (float*)d_out; p.ws = (unsigned char*)d_ws;
#if MK_ONE_LAUNCH
    p.ph_lo = 0; p.ph_hi = NPHASES;
    hipLaunchKernelGGL(mk_fwd, dim3(grid), dim3(512), LDS_BYTES, stream, p);
#else
    for (int k = 0; k < NPHASES; ++k) { p.ph_lo = k; p.ph_hi = k + 1; const int site = k < NPRO ? k : NPRO + (k - NPRO) % NPH;
        if ((PROBE_DUP_MASK >> site) & 1) { p.dry = 1; hipLaunchKernelGGL(mk_fwd, dim3(grid), dim3(512), LDS_BYTES, stream, p); p.dry = 0; }
        hipLaunchKernelGGL(mk_fwd, dim3(grid), dim3(512), LDS_BYTES, stream, p); }
#endif
}
```

```cpp
#include <hip/hip_runtime.h>
#include <cstdio>
#include <cstdint>

#ifndef MK_ONE_LAUNCH
#define MK_ONE_LAUNCH 1
#endif

#define LAS __attribute__((address_space(3)))
typedef unsigned short bf16_t;
typedef short bf16x8 __attribute__((ext_vector_type(8)));
typedef short bf16x4 __attribute__((ext_vector_type(4)));
typedef float f32x4 __attribute__((ext_vector_type(4)));
typedef float f32x16 __attribute__((ext_vector_type(16)));
typedef unsigned u32x4 __attribute__((ext_vector_type(4)));
typedef unsigned u32x2 __attribute__((ext_vector_type(2)));

constexpr int NB = 16, SEQL = 4096, CTXL = 256, NTOK = SEQL + CTXL  , MROWS = NB * NTOK  ;
constexpr int DM = 1024, DEPTH = 4, INC = 2912, INP = 3072;
constexpr int NCHB = NTOK / 16  , NCHUNK = MROWS / 16  ;
constexpr float EPS = 1e-6f;
constexpr float LOG2E = 1.4426950408889634f;
constexpr int LDS_MISC_OFF = 163840 - 256;

constexpr size_t al256(size_t x) { return (x + 255) & ~(size_t)255; }
constexpr size_t WS_CTL = 0;
constexpr size_t CTL_BYTES = 65536;
constexpr size_t WS_MODV = WS_CTL + CTL_BYTES;
constexpr size_t WS_ROPEG = WS_MODV + al256((size_t)4 * 17 * 3072 * 4);
constexpr size_t WS_ROPEM = WS_ROPEG + 64 * 16 * 2 * 4;
constexpr size_t WS_WIN = WS_ROPEM + 64 * 8 * 2 * 4;
constexpr size_t WS_WOUT = WS_WIN + (size_t)4 * 3072 * 1024 * 2;
constexpr size_t WS_WUQ = WS_WOUT + (size_t)4 * 1024 * 1024 * 2;
constexpr size_t WS_WUK = WS_WUQ + (size_t)4 * 512 * 256 * 2;
constexpr size_t WS_WUV = WS_WUK + (size_t)4 * 256 * 256 * 2;
constexpr size_t WS_WGLU = WS_WUV + (size_t)4 * 256 * 256 * 2;
constexpr size_t WS_WE = WS_WGLU + (size_t)4 * 256 * 256 * 2;
constexpr size_t WS_WKC = WS_WE + (size_t)4 * 16 * 256 * 256 * 2;
constexpr size_t WS_A16 = WS_WKC + (size_t)4 * 16 * 256 * 512 * 2;
constexpr size_t WS_GR = WS_A16 + (size_t)4 * 2 * 16 * 64 * 2 * 4;
constexpr size_t WS_GRC = WS_GR + (size_t)4 * 2 * 256 * 8192 * 2;
constexpr size_t WS_CTXR = WS_GRC + (size_t)4 * 2 * 256 * 512 * 2;
constexpr size_t WS_HCAT = WS_CTXR + (size_t)NB * CTXL * DM * 4;
constexpr size_t BLKE = (size_t)MROWS * 256;
constexpr size_t WS_PB = WS_HCAT + (size_t)MROWS * DM * 2;
constexpr size_t WS_KR = WS_PB + 12 * BLKE * 2;
constexpr size_t WS_KG = WS_KR + (size_t)MROWS * 32 * 2;
constexpr size_t WS_VTG = WS_KG + (size_t)32 * NTOK * 64 * 2;
constexpr size_t WS_UG = WS_VTG + (size_t)32 * NTOK * 64 * 2;
constexpr size_t WS_US = WS_UG + BLKE * 2;
constexpr size_t WS_HYV = WS_US + (size_t)16 * NCHUNK * 512 * 2;
constexpr size_t WS_HYX1 = WS_HYV + BLKE * 2;
constexpr size_t WS_HYX2 = WS_HYX1 + BLKE * 2;
constexpr size_t WS_HYG = WS_HYX2 + BLKE * 2;
constexpr size_t WS_HYZ = WS_HYG + BLKE * 2;
constexpr size_t WS_HYY = WS_HYZ + BLKE * 2;
constexpr size_t WS_END = WS_HYY + BLKE * 2;
static_assert(WS_END <= (size_t)1 << 30, "workspace map exceeds 1 GiB");
constexpr size_t WS_QM = WS_PB + 8 * BLKE * 2;
constexpr size_t WS_KM = WS_QM + (size_t)MROWS * 384 * 2;
constexpr size_t WS_VTM = WS_KM + (size_t)MROWS * 384 * 2;
constexpr size_t WS_E = WS_PB + 4 * BLKE * 2;
constexpr size_t WS_ZS = WS_PB + 6 * BLKE * 2;
constexpr size_t WS_OUTB = WS_PB + 8 * BLKE * 2;
constexpr size_t WS_HT = WS_PB;
static_assert(WS_VTM + BLKE * 2 == WS_PB + 12 * BLKE * 2, "alias map");

constexpr int CW_BAR = 0;
constexpr int CW_Q = 4096;
constexpr int CW_TMO = 4096 + 64 * 8;
constexpr int CW_DEP = 5120;
constexpr int DEP_SET = 20 * 64;

__device__ __forceinline__ float bf2f(bf16_t v) { return __uint_as_float(((unsigned)v) << 16); }
__device__ __forceinline__ bf16_t f2bf(float f) { unsigned u = __float_as_uint(f); u += 0x7FFFu + ((u >> 16) & 1u); return (bf16_t)(u >> 16); }
__device__ __forceinline__ unsigned cvt_pk_bf16(float lo, float hi) { unsigned r; asm volatile("v_cvt_pk_bf16_f32 %0, %1, %2" : "=v"(r) : "v"(lo), "v"(hi)); return r; }
__device__ __forceinline__ float lo_bf(unsigned w) { return __uint_as_float(w << 16); }
__device__ __forceinline__ float hi_bf(unsigned w) { return __uint_as_float(w & 0xFFFF0000u); }
__device__ __forceinline__ float sigmf(float x) { float one = 1.f; asm volatile("" : "+v"(one)); return __builtin_amdgcn_rcpf(one + __builtin_amdgcn_exp2f(-1.4426950408889634f * x)); }
__device__ __forceinline__ float siluf(float x) { return x * sigmf(x); }
__device__ __forceinline__ float gelu_tanh(float x) { const float u = 0.7978845608028654f * (x + 0.044715f * x * x * x); return x * sigmf(2.f * u); }
__device__ __forceinline__ int opaque(int x) { asm volatile("" : "+v"(x)); return x; }
__device__ __forceinline__ int lane_id_fresh() { int x; asm volatile("v_mbcnt_lo_u32_b32 %0, -1, 0\n\tv_mbcnt_hi_u32_b32 %0, -1, %0" : "=v"(x)); return x; }
__device__ __forceinline__ float max3_raw(float a, float b, float c) { float r; asm("v_max3_f32 %0, %1, %2, %3" : "=v"(r) : "v"(a), "v"(b), "v"(c)); return r; }
template <int M> __device__ __forceinline__ float swz_xor(float v) { return __int_as_float(__builtin_amdgcn_ds_swizzle(__float_as_int(v), 0x1F | (M << 10))); }
__device__ __forceinline__ float half_sum(float v) { auto r = __builtin_amdgcn_permlane32_swap(__float_as_uint(v), __float_as_uint(v), false, false); return __uint_as_float(r[0]) + __uint_as_float(r[1]); }
__device__ __forceinline__ float half_max(float v) { auto r = __builtin_amdgcn_permlane32_swap(__float_as_uint(v), __float_as_uint(v), false, false); return fmaxf(__uint_as_float(r[0]), __uint_as_float(r[1])); }
__device__ __forceinline__ float half_other(float v, int h) { auto r = __builtin_amdgcn_permlane32_swap(__float_as_uint(v), __float_as_uint(v), false, false); return __uint_as_float(h ? r[0] : r[1]); }
__device__ __forceinline__ float wave_sum(float v) {
    v += swz_xor<16>(v); v += swz_xor<8>(v); v += swz_xor<4>(v); v += swz_xor<2>(v); v += swz_xor<1>(v);
    return half_sum(v);
}

#define XB_TMO      128
#define XB_XCNT(j)  (256  + 64 * (j))
#define XB_XSUB(j)  (1280 + 64 * (j))
#define XB_XGEN(j)  (2304 + 64 * (j))
#define XB_TOP      3328
#define XB_TOPGEN   3392
#define XCD_BAR_WORDS 3456
#define XB_SPIN_CAP (1u << 22)
__device__ __forceinline__ unsigned xb_ld(unsigned* p)              { return __hip_atomic_load(p, __ATOMIC_RELAXED, __HIP_MEMORY_SCOPE_AGENT); }
__device__ __forceinline__ unsigned xb_add(unsigned* p, unsigned v) { return __hip_atomic_fetch_add(p, v, __ATOMIC_RELAXED, __HIP_MEMORY_SCOPE_AGENT); }
__device__ __forceinline__ unsigned xb_xcc_id() { return (unsigned)__builtin_amdgcn_s_getreg((3 << 11) | 20) & 0xFu; }
#define XB_SPIN(cond, bar) do { unsigned _sp = 0; while (cond) { __builtin_amdgcn_s_sleep(1); \
    if ((++_sp & 255u) == 0u) { if (xb_ld(&(bar)[XB_TMO])) break; if (_sp > XB_SPIN_CAP) { atomicAdd(&(bar)[XB_TMO], 1u); break; } } } } while (0)
struct XcdBarrier { unsigned* bar; unsigned x; volatile LAS unsigned* st; };
__device__ __forceinline__ XcdBarrier xcd_barrier_post(unsigned* bar, volatile LAS unsigned* st) {
    XcdBarrier b; b.bar = bar; b.x = xb_xcc_id(); b.st = st;
    if (threadIdx.x == 0) (void)xb_add(&bar[XB_XCNT(b.x)], 1u);
    return b;
}
__device__ __forceinline__ void xcd_barrier_complete(unsigned* bar, unsigned x, unsigned& nloc, unsigned& nx) {
    const unsigned G = gridDim.x * gridDim.y * gridDim.z;
    unsigned sum, cnt, mine, sp = 0u;
    for (;;) {
        sum = 0u; cnt = 0u; mine = 0u;
#pragma unroll
        for (unsigned j = 0; j < 16; ++j) { const unsigned c = xb_ld(&bar[XB_XCNT(j)]); sum += c; cnt += (c > 0u) ? 1u : 0u; }
        mine = xb_ld(&bar[XB_XCNT(x)]);
        if (sum == G) break;
        __builtin_amdgcn_s_sleep(1);
        if ((++sp & 255u) == 0u) { if (xb_ld(&bar[XB_TMO])) break; if (sp > XB_SPIN_CAP) { atomicAdd(&bar[XB_TMO], 1u); break; } }
    }
    nloc = mine > 0u ? mine : 1u; nx = cnt > 0u ? cnt : 1u;
}
__device__ __forceinline__ void xcd_barrier(const XcdBarrier& b) {
    asm volatile("s_waitcnt vmcnt(0)" ::: "memory");
    __syncthreads();
    if (threadIdx.x == 0) {
        unsigned* bar = b.bar;
        __builtin_amdgcn_s_waitcnt(0);
        unsigned nloc = b.st[0], nx = b.st[1];
        if (nloc == 0u) { xcd_barrier_complete(bar, b.x, nloc, nx); b.st[0] = nloc; b.st[1] = nx; }
        const unsigned old = xb_add(&bar[XB_XSUB(b.x)], 1u);
        const unsigned gen = old / nloc;
        if (old + 1u == (gen + 1u) * nloc) {
            __builtin_amdgcn_fence(__ATOMIC_RELEASE, "agent");
            asm volatile("s_waitcnt vmcnt(0)" ::: "memory");
            const unsigned og = xb_add(&bar[XB_TOP], 1u);
            const unsigned tg = og / nx;
            if (og + 1u == (tg + 1u) * nx) xb_add(&bar[XB_TOPGEN], 1u);
            else XB_SPIN(xb_ld(&bar[XB_TOPGEN]) == tg, bar);
            __builtin_amdgcn_fence(__ATOMIC_ACQUIRE, "agent");
            xb_add(&bar[XB_XGEN(b.x)], 1u);
            asm volatile("s_waitcnt vmcnt(0)" ::: "memory");
        } else {
            XB_SPIN(xb_ld(&bar[XB_XGEN(b.x)]) == gen, bar);
            __builtin_amdgcn_fence(__ATOMIC_ACQUIRE, "agent");
            asm volatile("s_waitcnt vmcnt(0)" ::: "memory");
        }
    }
    __syncthreads();
}

namespace pg8 {
constexpr int BM = 256, BK = 64, HALF = 128, HTB = HALF * BK * 2, STAGE_BYTES = 8 * HTB, NXCD = 8, WGM = 8;
__host__ __device__ __forceinline__ int lds_byte(int r, int c) { const int st = (r >> 4) * 2 + (c >> 5), rr = r & 15, cc = c & 31, ob = rr * 64 + cc * 2; return st * 1024 + (ob ^ (((ob >> 9) & 1) << 5)); }
__host__ __device__ __forceinline__ void stage_rc(int b, int& R, int& C) { const int st = b / 1024, sb = b % 1024, swz = sb ^ (((sb >> 9) & 1) << 5); R = (st >> 1) * 16 + swz / 64; C = (st & 1) * 32 + (swz % 64) / 2; }
__host__ __device__ __forceinline__ int perm32(int rho) { const int n = rho >> 4, i = rho & 15; return 8 * (i >> 2) + 4 * n + (i & 3); }
struct Unit { int pm, pn, kd; };
struct Gemm { const bf16_t* A; const bf16_t* Bt; int M, N, K; };
struct StaticOrder {
    int nM, nN, nwg, G, c;
    __host__ __device__ void init(int M, int N, int G_, int c_) { nM = M / BM; nN = N / BM; nwg = nM * nN; G = G_; c = c_; }
    __host__ __device__ bool next(int i, Unit& u) const {
        const long L = (long)i * G + c; if (L >= nwg) return false;
        int wgid = (int)L; { const int q = nwg / NXCD, r = nwg % NXCD, xcd = wgid % NXCD, off = wgid / NXCD; wgid = (xcd < r ? xcd * (q + 1) : r * (q + 1) + (xcd - r) * q) + off; }
        const int nig = WGM * nN, gid = wgid / nig, fm = gid * WGM, gsz = (nM - fm) < WGM ? (nM - fm) : WGM;
        u.pm = fm + ((wgid % nig) % gsz); u.pn = (wgid % nig) / gsz; u.kd = 0; return true;
    }
    __device__ __forceinline__ void a_ready(const Unit&) const {}
    __device__ __forceinline__ void done(const Unit&) const {}
    __device__ __forceinline__ const char* abase(const Gemm& g, const Unit& u, size_t tstep) const { return (const char*)g.A + (size_t)u.pm * tstep; }
    __device__ __forceinline__ const char* bbase(const Gemm& g, const Unit& u, size_t tstep) const { return (const char*)g.Bt + (size_t)u.pn * tstep; }
};
struct BatchedOrder {
    int nwg, G, c, tpg;
    __host__ __device__ void init(int ng, int tpg_, int G_, int c_) { nwg = ng * tpg_; tpg = tpg_; G = G_; c = c_; }
    __host__ __device__ bool next(int i, Unit& u) const { const int L = i * G + c; if (L >= nwg) return false; u.pm = L; u.pn = L / tpg; u.kd = 0; return true; }
    __device__ __forceinline__ void a_ready(const Unit&) const {}
    __device__ __forceinline__ void done(const Unit&) const {}
    __device__ __forceinline__ const char* abase(const Gemm& g, const Unit& u, size_t tstep) const { return (const char*)g.A + (size_t)u.pm * tstep; }
    __device__ __forceinline__ const char* bbase(const Gemm& g, const Unit& u, size_t tstep) const { return (const char*)g.Bt + (size_t)u.pn * tstep; }
};
struct P3Order {
    const bf16_t *b0, *b1, *wuq, *wuk, *wuv, *ug, *we; int G, c;
    __host__ __device__ bool next(int i, Unit& u) const {
        const int L = i * G + c; if (L >= 1360) return false;
        if (L < 544) { u.kd = 0; u.pm = L >> 1; u.pn = L & 1; } else if (L < 816) { u.kd = 1; u.pm = L - 544; u.pn = 0; } else if (L < 1088) { u.kd = 2; u.pm = 0; u.pn = L - 816; } else { u.kd = 3; u.pm = L - 1088; u.pn = (L - 1088) / 17; }
        return true;
    }
    __device__ __forceinline__ void a_ready(const Unit&) const {}
    __device__ __forceinline__ void done(const Unit&) const {}
    __device__ __forceinline__ const char* abase(const Gemm&, const Unit& u, size_t tstep) const { const bf16_t* p = u.kd == 0 ? b0 : u.kd == 1 ? b1 : u.kd == 2 ? wuv : ug; return (const char*)p + (size_t)u.pm * tstep; }
    __device__ __forceinline__ const char* bbase(const Gemm&, const Unit& u, size_t tstep) const { const bf16_t* p = u.kd == 0 ? wuq : u.kd == 1 ? wuk : u.kd == 2 ? b1 : we; return (const char*)p + (size_t)u.pn * tstep; }
};

struct OneUnit {
    int pm, pn;
    __host__ __device__ bool next(int i, Unit& u) const { if (i) return false; u.pm = pm; u.pn = pn; u.kd = 0; return true; }
    __device__ __forceinline__ void a_ready(const Unit&) const {}
    __device__ __forceinline__ void done(const Unit&) const {}
    __device__ __forceinline__ const char* abase(const Gemm& g, const Unit& u, size_t tstep) const { return (const char*)g.A + (size_t)u.pm * tstep; }
    __device__ __forceinline__ const char* bbase(const Gemm& g, const Unit& u, size_t tstep) const { return (const char*)g.Bt + (size_t)u.pn * tstep; }
};
template <class Epi, class Sched>
__device__ __forceinline__ void gemm_phase(LAS unsigned char* lds, const Gemm g, const Sched& S, const Epi& E, int tid_in) {
    const int tid = tid_in, wid = __builtin_amdgcn_readfirstlane(tid >> 6), lane = tid & 63, wr = wid >> 2, wc = wid & 3, fr = lane & 15, fq = lane >> 4;
    const int K = g.K, nt = K / BK;
    unsigned voffA[2], voffB[2];
#pragma unroll
    for (int i = 0; i < 2; ++i) { int R, C; stage_rc(tid * 16 + i * 8192, R, C); const int Rb = Epi::PERM ? ((R & ~31) + perm32(R & 31)) : R;
        voffA[i] = (unsigned)(R * K + C) * 2u; voffB[i] = (unsigned)(Rb * K + C) * 2u; }
    const size_t kstep = (size_t)(BK * 2);
    const size_t hstep = (size_t)HALF * K * 2;
    const size_t tstep = 2 * hstep;
    const unsigned ldsw = (unsigned)wid * 1024u;
    const int aoff = lds_byte(wr * 64 + fr, fq * 8), boff = lds_byte(wc * 32 + fr, fq * 8);
#define PG8_SA(b, h) (((b) * 2 + (h)) * HTB)
#define PG8_SB(b, h) ((4 + (b) * 2 + (h)) * HTB)
#define PG8_STAGE(bufoff, gbase, voff) do { _Pragma("unroll") for (int _i = 0; _i < 2; ++_i) \
        __builtin_amdgcn_global_load_lds((const unsigned*)((const char*)(gbase) + (voff)[_i]), (LAS unsigned*)(lds + (bufoff) + ldsw + _i * 8192), 16, 0, 0); } while (0)
#define PG8_LDA(dst, b, h) do { _Pragma("unroll") for (int m = 0; m < 4; ++m) _Pragma("unroll") for (int k = 0; k < 2; ++k) dst[m][k] = *(const LAS bf16x8*)(lds + PG8_SA(b, h) + aoff + m * 2048 + k * 1024); } while (0)
#define PG8_LDB(dst, b, h) do { _Pragma("unroll") for (int n = 0; n < 2; ++n) _Pragma("unroll") for (int k = 0; k < 2; ++k) dst[n][k] = *(const LAS bf16x8*)(lds + PG8_SB(b, h) + boff + n * 2048 + k * 1024); } while (0)
#define PG8_MMA(ai, bj, At, Bt) do { __builtin_amdgcn_s_setprio(1); _Pragma("unroll") for (int m = 0; m < 4; ++m) _Pragma("unroll") for (int n = 0; n < 2; ++n) _Pragma("unroll") for (int k = 0; k < 2; ++k) \
        acc[ai][bj][m][n] = __builtin_amdgcn_mfma_f32_16x16x32_bf16(Bt[n][k], At[m][k], acc[ai][bj][m][n], 0, 0, 0); __builtin_amdgcn_s_setprio(0); } while (0)
#define PG8_WAIT_V(n) asm volatile("s_waitcnt vmcnt(" #n ")" ::: "memory")
#define PG8_WAIT_L(n) asm volatile("s_waitcnt lgkmcnt(" #n ")" ::: "memory")
#define PG8_BAR __builtin_amdgcn_s_barrier()
#define PG8_SCHED __builtin_amdgcn_sched_barrier(0)
    Unit cur, nxt; int ui = 0;
    if (!S.next(0, cur)) return;
    f32x4 acc[2][2][4][2];
#pragma unroll
    for (int a = 0; a < 2; ++a)
#pragma unroll
        for (int b = 0; b < 2; ++b)
#pragma unroll
            for (int m = 0; m < 4; ++m)
#pragma unroll
                for (int n = 0; n < 2; ++n) acc[a][b][m][n] = (f32x4){0.f, 0.f, 0.f, 0.f};
    bf16x8 At[4][2], B0[2][2], B1[2][2];
    const char* cA = S.abase(g, cur, tstep); const char* cB = S.bbase(g, cur, tstep);
    S.a_ready(cur);
    PG8_STAGE(PG8_SB(0, 0), cB, voffB); PG8_STAGE(PG8_SA(0, 0), cA, voffA); PG8_STAGE(PG8_SB(0, 1), cB + hstep, voffB); PG8_STAGE(PG8_SA(0, 1), cA + hstep, voffA);
    if (wr == 1) PG8_BAR;
    PG8_WAIT_V(4); PG8_BAR;
    PG8_STAGE(PG8_SB(1, 0), cB + kstep, voffB); PG8_STAGE(PG8_SA(1, 0), cA + kstep, voffA); PG8_STAGE(PG8_SB(1, 1), cB + hstep + kstep, voffB);
    PG8_WAIT_V(6); PG8_BAR;
    for (;;) {
        const bool has_next = S.next(ui + 1, nxt);
        const char* nA = has_next ? S.abase(g, nxt, tstep) : cA; const char* nB = has_next ? S.bbase(g, nxt, tstep) : cB;
        for (int t = 0; t < nt; t += 2) {
            const bool last = (t == nt - 2);
            const char* a1 = cA + (size_t)(t + 1) * kstep;
            const char* a2 = last ? nA : cA + (size_t)(t + 2) * kstep; const char* b2 = last ? nB : cB + (size_t)(t + 2) * kstep;
            const char* a3 = a2 + kstep; const char* b3 = b2 + kstep;
            if (last && has_next) S.a_ready(nxt);
            PG8_LDB(B0, 0, 0); PG8_SCHED; PG8_LDA(At, 0, 0); PG8_STAGE(PG8_SA(1, 1), a1 + hstep, voffA);
            PG8_WAIT_L(8); PG8_BAR; PG8_WAIT_L(0); PG8_MMA(0, 0, At, B0); PG8_BAR; PG8_SCHED;
            PG8_LDB(B1, 0, 1); PG8_STAGE(PG8_SB(0, 0), b2, voffB);
            PG8_BAR; PG8_WAIT_L(0); PG8_MMA(0, 1, At, B1); PG8_BAR;
            PG8_LDA(At, 0, 1); PG8_STAGE(PG8_SA(0, 0), a2, voffA);
            PG8_BAR; PG8_WAIT_L(0); PG8_MMA(1, 0, At, B0); PG8_BAR; PG8_SCHED;
            PG8_STAGE(PG8_SB(0, 1), b2 + hstep, voffB);
            PG8_WAIT_V(6); PG8_BAR; PG8_MMA(1, 1, At, B1); PG8_BAR;
            PG8_LDB(B0, 1, 0); PG8_SCHED; PG8_LDA(At, 1, 0); PG8_STAGE(PG8_SA(0, 1), a2 + hstep, voffA);
            PG8_WAIT_L(8); PG8_BAR; PG8_WAIT_L(0); PG8_MMA(0, 0, At, B0); PG8_BAR; PG8_SCHED;
            PG8_LDB(B1, 1, 1); PG8_STAGE(PG8_SB(1, 0), b3, voffB);
            PG8_BAR; PG8_WAIT_L(0); PG8_MMA(0, 1, At, B1); PG8_BAR;
            PG8_LDA(At, 1, 1); PG8_STAGE(PG8_SA(1, 0), a3, voffA);
            PG8_BAR; PG8_WAIT_L(0); PG8_MMA(1, 0, At, B0); PG8_BAR; PG8_SCHED;
            PG8_STAGE(PG8_SB(1, 1), b3 + hstep, voffB);
            PG8_WAIT_V(6); PG8_BAR; PG8_MMA(1, 1, At, B1); PG8_BAR;
        }
        { const int l2 = lane_id_fresh(); E(acc, cur, wr, wc, l2 & 15, l2 >> 4); } S.done(cur);
        if (!has_next) break;
#pragma unroll
        for (int a = 0; a < 2; ++a)
#pragma unroll
            for (int b = 0; b < 2; ++b)
#pragma unroll
                for (int m = 0; m < 4; ++m)
#pragma unroll
                    for (int n = 0; n < 2; ++n) acc[a][b][m][n] = (f32x4){0.f, 0.f, 0.f, 0.f};
        cur = nxt; cA = nA; cB = nB; ++ui;
    }
    PG8_WAIT_V(0);
    if (wr == 0) PG8_BAR;
    PG8_BAR;
#undef PG8_SA
#undef PG8_SB
#undef PG8_STAGE
#undef PG8_LDA
#undef PG8_LDB
#undef PG8_MMA
#undef PG8_WAIT_V
#undef PG8_WAIT_L
#undef PG8_BAR
#undef PG8_SCHED
}

template <class F> struct EpiWalk {
    static constexpr bool PERM = true, AFTER_DRAIN = false;
    F f;
    __device__ __forceinline__ void operator()(const f32x4 (&acc)[2][2][4][2], const Unit& u, int wr, int wc, int fr, int fq) const {
#pragma unroll
        for (int ai = 0; ai < 2; ++ai)
#pragma unroll
            for (int m = 0; m < 4; ++m) {
                const int rin = ai * HALF + wr * 64 + m * 16 + fr;
#pragma unroll
                for (int bj = 0; bj < 2; ++bj) { const int cin = bj * HALF + wc * 32 + 8 * fq; f.put(u.pm, u.pn, rin, cin, acc[ai][bj][m][0], acc[ai][bj][m][1]); asm volatile("" ::: "memory"); }
            }
    }
};
}

__device__ __forceinline__ u32x4 pack8(const f32x4& a, const f32x4& b) {
    u32x4 w; w.x = cvt_pk_bf16(a[0], a[1]); w.y = cvt_pk_bf16(a[2], a[3]); w.z = cvt_pk_bf16(b[0], b[1]); w.w = cvt_pk_bf16(b[2], b[3]); return w;
}
__device__ __forceinline__ void unpack8(const u32x4 w, float (&o)[8]) {
    o[0] = lo_bf(w.x); o[1] = hi_bf(w.x); o[2] = lo_bf(w.y); o[3] = hi_bf(w.y); o[4] = lo_bf(w.z); o[5] = hi_bf(w.z); o[6] = lo_bf(w.w); o[7] = hi_bf(w.w);
}

struct PutSplit {
    bf16_t* pb;
    __device__ __forceinline__ void put(int pm, int pn, int rin, int cin, const f32x4& a, const f32x4& b) const { *(u32x4*)(pb + (size_t)pn * BLKE + ((size_t)pm * 256 + rin) * 256 + cin) = pack8(a, b); }
};
struct PutPlain {
    bf16_t* dst; int ldc, ncols;
    __device__ __forceinline__ void put(int pm, int pn, int rin, int cin, const f32x4& a, const f32x4& b) const { const int col = pn * 256 + cin; if (col < ncols) *(u32x4*)(dst + ((size_t)pm * 256 + rin) * ldc + col) = pack8(a, b); }
};
struct PutKm {
    bf16_t* km; const bf16_t* kr;
    __device__ __forceinline__ void put(int pm, int pn, int rin, int cin, const f32x4& a, const f32x4& b) const {
        const int bb = pm / 17, key = (pm - bb * 17) * 256 + rin, hd = cin >> 6, d = cin & 63;
        bf16_t* dst = km + ((size_t)(bb * 4 + hd) * NTOK + key) * 96;
        *(u32x4*)(dst + d) = pack8(a, b);
        if (d < 32) *(u32x4*)(dst + 64 + d) = *(const u32x4*)(kr + ((size_t)pm * 256 + rin) * 32 + d);
    }
};
struct PutVt {
    bf16_t* vt;
    __device__ __forceinline__ void put(int pm, int pn, int rin, int cin, const f32x4& a, const f32x4& b) const {
        const int bb = pn / 17, key = (pn - bb * 17) * 256 + cin;
        *(u32x4*)(vt + ((size_t)(bb * 4 + (rin >> 6)) * 64 + (rin & 63)) * NTOK + key) = pack8(a, b);
    }
};
struct PutE {
    bf16_t* e;
    __device__ __forceinline__ void put(int pm, int pn, int rin, int cin, const f32x4& a, const f32x4& b) const { *(u32x4*)(e + ((size_t)pm * 256 + rin) * 256 + cin) = pack8(a, b); }
};
struct PutSsmY {
    bf16_t* zs; const bf16_t* ug; const float* dskip;
    __device__ __forceinline__ void put(int pm, int pn, int rin, int cin, const f32x4& a, const f32x4& b) const {
        const int g = pn, n = (pm - g * 17) * 256 + rin, tok = n * 16 + (cin >> 4), ho = cin & 15, ch = g * 16 + ho;
        float u[8]; unpack8(*(const u32x4*)(ug + ((size_t)g * MROWS + tok) * 16 + ho), u);
        const f32x4 d0 = *(const f32x4*)(dskip + ch), d1 = *(const f32x4*)(dskip + ch + 4);
        f32x4 y0, y1;
#pragma unroll
        for (int i = 0; i < 4; ++i) { y0[i] = gelu_tanh(a[i] + d0[i] * u[i]); y1[i] = gelu_tanh(b[i] + d1[i] * u[4 + i]); }
        *(u32x4*)(zs + (size_t)tok * 256 + ch) = pack8(y0, y1);
    }
};
struct PutGlu {
    bf16_t* cat; const bf16_t* zs; const bf16_t* gate; const float* gb;
    __device__ __forceinline__ void put(int pm, int pn, int rin, int cin, const f32x4& a, const f32x4& b) const {
        const size_t row = (size_t)pm * 256 + rin; const int col = cin;
        float z[8], gt[8]; unpack8(*(const u32x4*)(zs + row * 256 + col), z); unpack8(*(const u32x4*)(gate + row * 256 + col), gt);
        const f32x4 b0 = *(const f32x4*)(gb + col), b1 = *(const f32x4*)(gb + col + 4);
        f32x4 y0, y1;
#pragma unroll
        for (int i = 0; i < 4; ++i) { y0[i] = z[i] * sigmf(a[i] + b0[i]) * siluf(gt[i]); y1[i] = z[4 + i] * sigmf(b[i] + b1[i]) * siluf(gt[4 + i]); }
        *(u32x4*)(cat + row * DM + 512 + col) = pack8(y0, y1);
    }
};

struct EpiP3 {
    static constexpr bool PERM = true, AFTER_DRAIN = false;
    PutPlain q; PutKm k; PutVt v; PutE e;
    __device__ __forceinline__ void operator()(const f32x4 (&acc)[2][2][4][2], const pg8::Unit& u, int wr, int wc, int fr, int fq) const {
#pragma unroll
        for (int ai = 0; ai < 2; ++ai)
#pragma unroll
            for (int m = 0; m < 4; ++m) {
                const int rin = ai * pg8::HALF + wr * 64 + m * 16 + fr;
#pragma unroll
                for (int bj = 0; bj < 2; ++bj) { const int cin = bj * pg8::HALF + wc * 32 + 8 * fq;
                    if (u.kd == 0) q.put(u.pm, u.pn, rin, cin, acc[ai][bj][m][0], acc[ai][bj][m][1]);
                    else if (u.kd == 1) k.put(u.pm, u.pn, rin, cin, acc[ai][bj][m][0], acc[ai][bj][m][1]);
                    else if (u.kd == 2) v.put(u.pm, u.pn, rin, cin, acc[ai][bj][m][0], acc[ai][bj][m][1]);
                    else e.put(u.pm, u.pn, rin, cin, acc[ai][bj][m][0], acc[ai][bj][m][1]);
                    asm volatile("" ::: "memory"); }
            }
    }
};

struct Params {
    const float* in[36];
    float* out;
    unsigned char* ws;
    int ph_lo, ph_hi, dry, pad;
};
enum { I_X = 0, I_C, I_CTX, I_CCTX, I_WMOD, I_BMOD, I_GPRE, I_GPOST, I_WIN, I_WOUT, I_GCQ, I_WUQ, I_GCKV, I_WUKV, I_GQ, I_GK,
       I_LRE, I_LIM, I_LSTEP, I_BRE, I_BIM, I_CRE, I_CIM, I_SSMD, I_GLUW, I_GLUB, I_HCW, I_HCB, I_HW1, I_HB1, I_HF1, I_HW2, I_HB2, I_HF2, I_HW3, I_HBIAS };

typedef __attribute__((address_space(4))) const unsigned long long* kargp_t;
struct Ctx {
    LAS unsigned char* lds;
    kargp_t ka;
    unsigned char* ws;
    int tid, lane, wave, G, bid, dry;
};
#define GAS __attribute__((address_space(1)))
#define KIN(i) ((const float*)(GAS const float*)c.ka[(i)])
#define KOUT() ((float*)(GAS float*)c.ka[36])
template <class T> __device__ __forceinline__ T* wsp(const Ctx& c, size_t off) { return (T*)(c.ws + off); }

__device__ __forceinline__ int wmap(int kind, int n) {
    if (kind == 0) { if (n < 192) return n; if (n < 224) return 320 + (n - 192); if (n < 256) return -1; if (n < 384) return 192 + (n - 256); if (n < 512) return -1; return n - 160; }
    if (kind == 2) return (n >> 6) * 128 + (n & 63);
    if (kind == 3) return (n >> 6) * 128 + 64 + (n & 63);
    return n;
}
__device__ __forceinline__ void wconv_tile(const Ctx& c, const float* src, int Ks, int Ns, int Nlim, bf16_t* dst, int Kp, int kind, int nt, int kt) {
    LAS float* T = (LAS float*)c.lds;
    const int n0 = nt * 64, k0 = kt * 128;
    const int nn = c.tid & 63, kk0 = c.tid >> 6; const int n = n0 + nn; const int sc = (n < Nlim) ? wmap(kind, n) : -1;
    float v[16];
#pragma unroll
    for (int i = 0; i < 16; ++i) { const int k = k0 + kk0 + 8 * i; v[i] = (k < Ks && sc >= 0) ? src[(size_t)k * Ns + sc] : 0.f; }
#pragma unroll
    for (int i = 0; i < 16; ++i) T[(kk0 + 8 * i) * 65 + nn] = v[i];
    __syncthreads();
#pragma unroll
    for (int i = 0; i < 2; ++i) { const int e = c.tid + i * 512, row = e >> 4, pc = e & 15; float x[8];
#pragma unroll
        for (int j = 0; j < 8; ++j) x[j] = T[(pc * 8 + j) * 65 + row];
        u32x4 w; w.x = cvt_pk_bf16(x[0], x[1]); w.y = cvt_pk_bf16(x[2], x[3]); w.z = cvt_pk_bf16(x[4], x[5]); w.w = cvt_pk_bf16(x[6], x[7]);
        *(u32x4*)(dst + (size_t)(n0 + row) * Kp + k0 + pc * 8) = w; }
    __syncthreads();
}

__device__ __forceinline__ void modv_job(const Ctx& c, int job) {
    const int l = job / 48, j0 = (job % 48) * 64;
    LAS float* sc = (LAS float*)c.lds;
    LAS float* red = sc + 17 * 1024;
    const float* cv = KIN(I_C); const float* cc = KIN(I_CCTX);
    for (int e = c.tid; e < 17 * 1024; e += 512) { const int r = e >> 10, k = e & 1023; const float v = (r < 16) ? cv[r * 1024 + k] : cc[k]; sc[e] = siluf(v); }
    __syncthreads();
    const int col = c.tid & 63, ks = c.tid >> 6;
    const float* w = KIN(I_WMOD) + (size_t)l * 1024 * 3072 + j0 + col;
    float acc[17];
#pragma unroll
    for (int r = 0; r < 17; ++r) acc[r] = 0.f;
    for (int k = ks * 128; k < ks * 128 + 128; ++k) { const float wv = w[(size_t)k * 3072];
#pragma unroll
        for (int r = 0; r < 17; ++r) acc[r] += sc[r * 1024 + k] * wv; }
#pragma unroll
    for (int r = 0; r < 17; ++r) red[(ks * 17 + r) * 64 + col] = acc[r];
    __syncthreads();
    float* mv = wsp<float>(c, WS_MODV);
    for (int e = c.tid; e < 17 * 64; e += 512) { const int r = e >> 6, cl = e & 63; float s = KIN(I_BMOD)[l * 3072 + j0 + cl];
#pragma unroll
        for (int q = 0; q < 8; ++q) s += red[(q * 17 + r) * 64 + cl];
        mv[((size_t)l * 17 + r) * 3072 + j0 + cl] = s; }
    __syncthreads();
}

__device__ __forceinline__ void rope_job(const Ctx& c) {
    float* rg = wsp<float>(c, WS_ROPEG); float* rm = wsp<float>(c, WS_ROPEM);
    for (int e = c.tid; e < 64 * 16; e += 512) { const int pos = e >> 4, f = e & 15; const float inv = powf(10000.f, -(float)(2 * f) / 32.f); const float a = (float)pos * inv; rg[e * 2] = cosf(a); rg[e * 2 + 1] = sinf(a); }
    for (int e = c.tid; e < 64 * 8; e += 512) { const int pos = e >> 3, f = e & 7; const float inv = powf(10000.f, -(float)(2 * f) / 16.f); const float a = (float)pos * inv; rm[e * 2] = cosf(a); rm[e * 2 + 1] = sinf(a); }
}

typedef float cpx __attribute__((ext_vector_type(2)));
#define CPX(a, b) ((cpx){(a), (b)})
__device__ __forceinline__ cpx cmul(cpx a, cpx b) { return CPX(a.x * b.x - a.y * b.y, a.x * b.y + a.y * b.x); }
__device__ __forceinline__ void ssm_tables_job(const Ctx& c, int job) {
    const int l = job >> 4, g = job & 15;
    LAS cpx* apow = (LAS cpx*)c.lds;
    LAS cpx* bbar = apow + 2 * 17 * 64;
    LAS cpx* cm = bbar + 2 * 64 * 16;
    LAS float* Kc = (LAS float*)(cm + 2 * 16 * 64);
    for (int e = c.tid; e < 2 * 64; e += 512) {
        const int d = e >> 6, p = e & 63; const size_t ix = (((size_t)l * 2 + d) * 16 + g) * 64 + p;
        const float lr = KIN(I_LRE)[ix], li = KIN(I_LIM)[ix], st = expf(KIN(I_LSTEP)[((size_t)l * 2 + d) * 16 + g]);
        for (int k = 0; k <= 16; ++k) { const float m = expf(lr * st * (float)k), an = li * st * (float)k; apow[(d * 17 + k) * 64 + p] = CPX(m * cosf(an), m * sinf(an)); }
    }
    __syncthreads();
    for (int e = c.tid; e < 2 * 64 * 16; e += 512) {
        const int d = e >> 10, p = (e >> 4) & 63, h = e & 15; const size_t ix = (((size_t)l * 2 + d) * 16 + g) * 64 + p;
        const float lr = KIN(I_LRE)[ix], li = KIN(I_LIM)[ix];
        const cpx a = apow[(d * 17 + 1) * 64 + p]; const cpx am1 = CPX(a.x - 1.f, a.y);
        const float den = lr * lr + li * li; const cpx q = CPX((am1.x * lr + am1.y * li) / den, (am1.y * lr - am1.x * li) / den);
        const cpx b = CPX(KIN(I_BRE)[ix * 16 + h], KIN(I_BIM)[ix * 16 + h]);
        bbar[e] = cmul(q, b);
        const size_t cx = ((((size_t)l * 2 + d) * 16 + g) * 16 + h) * 64 + p;
        cm[(d * 16 + h) * 64 + p] = CPX(KIN(I_CRE)[cx], KIN(I_CIM)[cx]);
    }
    __syncthreads();
    for (int e = c.tid; e < 2 * 16 * 256; e += 512) {
        const int d = e >> 12, dd = (e >> 8) & 15, ho = (e >> 4) & 15, hi = e & 15; float s = 0.f;
        for (int p = 0; p < 64; ++p) { const cpx w = cmul(cm[(d * 16 + ho) * 64 + p], apow[(d * 17 + dd) * 64 + p]); const cpx b = bbar[(d * 64 + p) * 16 + hi]; s += w.x * b.x - w.y * b.y; }
        Kc[e] = s;
    }
    __syncthreads();
    bf16_t* wkc = wsp<bf16_t>(c, WS_WKC) + ((size_t)l * 16 + g) * 256 * 512;
    for (int e = c.tid; e < 256 * 512; e += 512) {
        const int r = e >> 9, q = e & 511, i = r >> 4, ho = r & 15; float v;
        if (q < 256) { const int j = q >> 4, hi = q & 15; v = 0.f; if (j <= i) v += Kc[((0 * 16 + (i - j)) * 16 + ho) * 16 + hi]; if (j >= i) v += Kc[((1 * 16 + (j - i)) * 16 + ho) * 16 + hi]; }
        else { const int qq = q - 256, dq = qq >> 7, comp = (qq >> 6) & 1, p = qq & 63, k = dq == 0 ? i + 1 : 16 - i; const cpx w = cmul(cm[(dq * 16 + ho) * 64 + p], apow[(dq * 17 + k) * 64 + p]); v = comp == 0 ? w.x : -w.y; }
        wkc[e] = f2bf(v);
    }
    bf16_t* we = wsp<bf16_t>(c, WS_WE) + ((size_t)l * 16 + g) * 256 * 256;
    for (int e = c.tid; e < 256 * 256; e += 512) {
        const int qq = e >> 8, cidx = e & 255, j = cidx >> 4, hi = cidx & 15, dq = qq >> 7, comp = (qq >> 6) & 1, p = qq & 63, k = dq == 0 ? 15 - j : j;
        const cpx w = cmul(apow[(dq * 17 + k) * 64 + p], bbar[(dq * 64 + p) * 16 + hi]);
        we[e] = f2bf(comp == 0 ? w.x : w.y);
    }
    float* a16 = wsp<float>(c, WS_A16);
    for (int e = c.tid; e < 128; e += 512) { const int d = e >> 6, p = e & 63; const cpx a = apow[(d * 17 + 16) * 64 + p]; const size_t ix = ((((size_t)l * 2 + d) * 16 + g) * 64 + p) * 2; a16[ix] = a.x; a16[ix + 1] = a.y; }
    __syncthreads();
}

__device__ __forceinline__ void hyena_mlp_job(const Ctx& c, int job) {
    const int l = job / 136, tt = job % 136;
    const bool isctx = tt >= 128; const int n = isctx ? CTXL : SEQL; const int t0 = isctx ? (tt - 128) * 32 : tt * 32;
    LAS float* z = (LAS float*)c.lds;
    LAS float* h1 = z + 32 * 36;
    LAS float* h2 = h1 + 32 * 64;
    for (int e = c.tid; e < 32 * 33; e += 512) {
        const int ti = e / 33, f = e % 33, t = t0 + ti; float v;
        if (f == 0) v = (float)t / (float)(n - 1);
        else { const int k = (f - 1) & 15; const float band = 1e-4f + (float)k * ((15.f - 1e-4f) / 15.f); const float om = 6.283185307179586f * (float)t / (float)n; v = (f <= 16) ? cosf(band * om) : -sinf(band * om); }
        z[ti * 36 + f] = v;
    }
    __syncthreads();
    for (int e = c.tid; e < 32 * 64; e += 512) {
        const int ti = e >> 6, j = e & 63; float s = KIN(I_HB1)[l * 64 + j];
        for (int f = 0; f < 33; ++f) s += z[ti * 36 + f] * KIN(I_HW1)[((size_t)l * 33 + f) * 64 + j];
        h1[e] = sinf(KIN(I_HF1)[l * 64 + j] * s);
    }
    __syncthreads();
    for (int e = c.tid; e < 32 * 64; e += 512) {
        const int ti = e >> 6, j = e & 63; float s = KIN(I_HB2)[l * 64 + j];
        for (int f = 0; f < 64; ++f) s += h1[ti * 64 + f] * KIN(I_HW2)[((size_t)l * 64 + f) * 64 + j];
        h2[e] = sinf(KIN(I_HF2)[l * 64 + j] * s);
    }
    __syncthreads();
    float* hT = wsp<float>(c, WS_HT) + (size_t)l * 1024 * NTOK;
    const float mind = -3.070113457325394f, maxd = -15.35056728662697f;
#pragma unroll
    for (int cc = 0; cc < 2; ++cc) {
        const int col = c.tid + cc * 512;
        float acc[32];
#pragma unroll
        for (int ti = 0; ti < 32; ++ti) acc[ti] = 0.f;
        for (int f = 0; f < 64; ++f) { const float w = KIN(I_HW3)[((size_t)l * 64 + f) * 1024 + col];
#pragma unroll
            for (int ti = 0; ti < 32; ++ti) acc[ti] += h2[ti * 64 + f] * w; }
        const int ch = col & 255; const float delta = fabsf(mind + (maxd - mind) * (float)ch / 255.f);
        float* dst = hT + (size_t)col * NTOK + (isctx ? SEQL : 0) + t0;
#pragma unroll
        for (int ti = 0; ti < 32; ++ti) { const float tn = (float)(t0 + ti) / (float)(n - 1); dst[ti] = acc[ti] * expf(-tn * delta); }
    }
    __syncthreads();
}

__device__ __forceinline__ void hyena_pack_job(const Ctx& c, int job) {
    const int l = job >> 9, o = (job >> 8) & 1, ch = job & 255;
    const float* hT = wsp<float>(c, WS_HT) + (size_t)l * 1024 * NTOK;
    const float* fw = hT + (size_t)(o * 512 + ch) * NTOK; const float* bw = hT + (size_t)(o * 512 + 256 + ch) * NTOK;
    LAS float* red = (LAS float*)c.lds;
    float s0 = 0.f, s1 = 0.f;
    for (int t = c.tid; t < SEQL; t += 512) { const float a = fw[t], b = bw[t]; s0 += a * a + b * b; }
    if (c.tid < CTXL) { const float a = fw[SEQL + c.tid], b = bw[SEQL + c.tid]; s1 = a * a + b * b; }
    s0 = wave_sum(s0); s1 = wave_sum(s1);
    if (c.lane == 0) { red[c.wave] = s0; red[8 + c.wave] = s1; }
    __syncthreads();
    float t0 = 0.f, t1 = 0.f;
#pragma unroll
    for (int w = 0; w < 8; ++w) { t0 += red[w]; t1 += red[8 + w]; }
    const float r0 = rsqrtf(t0 + EPS), r1 = rsqrtf(t1 + EPS);
    bf16_t* gr = wsp<bf16_t>(c, WS_GR) + (((size_t)l * 2 + o) * 256 + ch) * 8192;
    for (int e = c.tid; e < 8192; e += 512) { float v; if (e <= 4095) v = fw[4095 - e]; else if (e < 8191) v = bw[e - 4095]; else v = 0.f; gr[e] = f2bf(v * r0); }
    bf16_t* grc = wsp<bf16_t>(c, WS_GRC) + (((size_t)l * 2 + o) * 256 + ch) * 512;
    { const int e = c.tid; float v; if (e <= 255) v = fw[SEQL + 255 - e]; else if (e < 511) v = bw[SEQL + e - 255]; else v = 0.f; grc[e] = f2bf(v * r1); }
    __syncthreads();
}

__device__ __forceinline__ void norm_rows(const Ctx& c, int l  , int next  ) {
    const float* mvl = wsp<float>(c, WS_MODV) + (size_t)(l < 0 ? 0 : l) * 17 * 3072;
    const float* mvn = wsp<float>(c, WS_MODV) + (size_t)(next < 0 ? 0 : next) * 17 * 3072;
    const bf16_t* outb = wsp<bf16_t>(c, WS_OUTB);
    bf16_t* hb = wsp<bf16_t>(c, WS_HCAT);
    float* ctxr = wsp<float>(c, WS_CTXR);
    const float* xin0 = KIN(I_X); const float* cin0 = KIN(I_CTX); float* outp = KOUT();
    const float* gpost = KIN(I_GPOST) + (l < 0 ? 0 : l) * DM; const float* gpre = KIN(I_GPRE) + (next < 0 ? 0 : next) * DM;
    const int nw = c.G * 8, lane4 = c.lane * 4;
    for (int rowb = (c.bid * 8 + c.wave) * 2; rowb < MROWS; rowb += nw * 2) {
        f32x4 xv[2][4]; u32x2 ow[2][4]; const float* xin[2]; float* xout[2]; int mr[2]; bool live[2], isc[2];
#pragma unroll
        for (int rr = 0; rr < 2; ++rr) {
            const int row = rowb + rr, b = row / NTOK, j = row - b * NTOK; isc[rr] = j >= SEQL; live[rr] = !(next < 0 && isc[rr]); mr[rr] = isc[rr] ? 16 : b;
            if (isc[rr]) { xout[rr] = ctxr + ((size_t)b * CTXL + (j - SEQL)) * DM; xin[rr] = (l < 0) ? cin0 + ((size_t)b * CTXL + (j - SEQL)) * DM : xout[rr]; }
            else { xout[rr] = outp + ((size_t)b * SEQL + j) * DM; xin[rr] = (l <= 0) ? xin0 + ((size_t)b * SEQL + j) * DM : xout[rr]; }
#pragma unroll
            for (int q = 0; q < 4; ++q) { xv[rr][q] = *(const f32x4*)(xin[rr] + q * 256 + lane4); if (l >= 0) ow[rr][q] = *(const u32x2*)(outb + (size_t)row * DM + q * 256 + lane4); }
        }
#pragma unroll
        for (int rr = 0; rr < 2; ++rr) {
            if (!live[rr]) continue;
            const int row = rowb + rr;
            if (l >= 0) {
                float ov[16]; float ss = 0.f;
#pragma unroll
                for (int q = 0; q < 4; ++q) { ov[q * 4] = lo_bf(ow[rr][q].x); ov[q * 4 + 1] = hi_bf(ow[rr][q].x); ov[q * 4 + 2] = lo_bf(ow[rr][q].y); ov[q * 4 + 3] = hi_bf(ow[rr][q].y); }
#pragma unroll
                for (int i = 0; i < 16; ++i) ss += ov[i] * ov[i];
                ss = wave_sum(ss); const float rs = rsqrtf(ss * (1.f / DM) + EPS);
#pragma unroll
                for (int q = 0; q < 4; ++q) { const int col = q * 256 + lane4; const f32x4 gp = *(const f32x4*)(gpost + col); const f32x4 gt = *(const f32x4*)(mvl + mr[rr] * 3072 + 2048 + col);
#pragma unroll
                    for (int i = 0; i < 4; ++i) xv[rr][q][i] += gt[i] * (ov[q * 4 + i] * rs * gp[i]); }
            }
            if ((l >= 0 || isc[rr]) && !c.dry) {
#pragma unroll
                for (int q = 0; q < 4; ++q) *(f32x4*)(xout[rr] + q * 256 + lane4) = xv[rr][q];
            }
            if (next >= 0) {
                float ss = 0.f;
#pragma unroll
                for (int q = 0; q < 4; ++q)
#pragma unroll
                    for (int i = 0; i < 4; ++i) ss += xv[rr][q][i] * xv[rr][q][i];
                ss = wave_sum(ss); const float rs = rsqrtf(ss * (1.f / DM) + EPS);
#pragma unroll
                for (int q = 0; q < 4; ++q) { const int col = q * 256 + lane4; const f32x4 gp = *(const f32x4*)(gpre + col);
                    const f32x4 sh = *(const f32x4*)(mvn + mr[rr] * 3072 + col), sc = *(const f32x4*)(mvn + mr[rr] * 3072 + 1024 + col);
                    float hv[4];
#pragma unroll
                    for (int i = 0; i < 4; ++i) hv[i] = xv[rr][q][i] * rs * gp[i] * (1.f + sc[i]) + sh[i];
                    u32x2 w; w.x = cvt_pk_bf16(hv[0], hv[1]); w.y = cvt_pk_bf16(hv[2], hv[3]); *(u32x2*)(hb + (size_t)row * DM + col) = w; }
            }
        }
    }
}

__device__ __forceinline__ void p2_rows(const Ctx& c, int l) {
    bf16_t* pb = wsp<bf16_t>(c, WS_PB);
    bf16_t* B0 = pb; bf16_t* B1 = pb + BLKE; bf16_t* B3 = pb + 3 * BLKE; const bf16_t* B4 = pb + 4 * BLKE; const bf16_t* B6 = pb + 6 * BLKE;
    bf16_t* kr = wsp<bf16_t>(c, WS_KR); bf16_t* kg = wsp<bf16_t>(c, WS_KG); bf16_t* ug = wsp<bf16_t>(c, WS_UG); bf16_t* us = wsp<bf16_t>(c, WS_US);
    const float* ropeG = wsp<float>(c, WS_ROPEG); const float* ropeM = wsp<float>(c, WS_ROPEM);
    const int lane = c.lane;
    const f32x4 gcq = (lane < 48) ? *(const f32x4*)(KIN(I_GCQ) + l * 192 + lane * 4) : (f32x4){0.f, 0.f, 0.f, 0.f};
    const f32x4 gckv = (lane < 32) ? *(const f32x4*)(KIN(I_GCKV) + l * 128 + lane * 4) : (f32x4){0.f, 0.f, 0.f, 0.f};
    const f32x4 gq = *(const f32x4*)(KIN(I_GQ) + l * 64 + (lane & 15) * 4), gk = *(const f32x4*)(KIN(I_GK) + l * 64 + (lane & 15) * 4);
    for (int rowb = (c.bid * 8 + c.wave) * 4; rowb < MROWS; rowb += c.G * 8 * 4) {
        u32x2 w0[4], w1[4], w3[4], w4[4], w6[4];
#pragma unroll
        for (int rr = 0; rr < 4; ++rr) { const size_t ro = (size_t)(rowb + rr) * 256 + lane * 4;
            w0[rr] = *(const u32x2*)(B0 + ro); w1[rr] = *(const u32x2*)(B1 + ro); w3[rr] = *(const u32x2*)(B3 + ro); w4[rr] = *(const u32x2*)(B4 + ro); w6[rr] = *(const u32x2*)(B6 + ro); }
#pragma unroll
        for (int rr = 0; rr < 4; ++rr) {
            const int row = rowb + rr;
            const int b = row / NTOK, j = row - b * NTOK; const bool islat = j < SEQL; const int rowpos = (j >> 6) & 63, colpos = j & 63;
            const size_t ro = (size_t)row * 256 + lane * 4;
            {
                const u32x2 w = w0[rr]; float x[4] = {lo_bf(w.x), hi_bf(w.x), lo_bf(w.y), hi_bf(w.y)};
                float ss = (lane < 48) ? (x[0] * x[0] + x[1] * x[1] + x[2] * x[2] + x[3] * x[3]) : 0.f; ss = wave_sum(ss);
                const float rs = rsqrtf(ss * (1.f / 192.f) + EPS);
                float xp[4];
#pragma unroll
                for (int i = 0; i < 4; ++i) xp[i] = swz_xor<2>(x[i]);
                u32x2 o; o.x = 0u; o.y = 0u;
                if (lane < 48) { o.x = cvt_pk_bf16(x[0] * rs * gcq[0], x[1] * rs * gcq[1]); o.y = cvt_pk_bf16(x[2] * rs * gcq[2], x[3] * rs * gcq[3]); }
                else if (lane < 56) {
                    const int t = lane - 48; float y[4];
                    if (islat) { const int pos = (t & 4) ? colpos : rowpos; const bool isx2 = (t & 2) != 0;
#pragma unroll
                        for (int i = 0; i < 4; ++i) { const int f = 4 * (t & 1) + i; const float cs = ropeM[(pos * 8 + f) * 2], sn = ropeM[(pos * 8 + f) * 2 + 1]; y[i] = isx2 ? (xp[i] * sn + x[i] * cs) : (x[i] * cs - xp[i] * sn); } }
                    else {
#pragma unroll
                        for (int i = 0; i < 4; ++i) y[i] = x[i]; }
                    u32x2 kk; kk.x = cvt_pk_bf16(y[0], y[1]); kk.y = cvt_pk_bf16(y[2], y[3]); *(u32x2*)(kr + (size_t)row * 32 + t * 4) = kk;
                }
                if (!c.dry) *(u32x2*)(B0 + ro) = o;
            }
            {
                const u32x2 w = w1[rr]; float x[4] = {lo_bf(w.x), hi_bf(w.x), lo_bf(w.y), hi_bf(w.y)};
                float ss = (lane < 32) ? (x[0] * x[0] + x[1] * x[1] + x[2] * x[2] + x[3] * x[3]) : 0.f; ss = wave_sum(ss);
                const float rs = rsqrtf(ss * (1.f / 128.f) + EPS);
                u32x2 o; o.x = 0u; o.y = 0u;
                if (lane < 32) { o.x = cvt_pk_bf16(x[0] * rs * gckv[0], x[1] * rs * gckv[1]); o.y = cvt_pk_bf16(x[2] * rs * gckv[2], x[3] * rs * gckv[3]); }
                if (!c.dry) *(u32x2*)(B1 + ro) = o;
            }
#pragma unroll
            for (int which = 0; which < 2; ++which) {
                const u32x2 w = which == 0 ? w3[rr] : w4[rr]; float x[4] = {lo_bf(w.x), hi_bf(w.x), lo_bf(w.y), hi_bf(w.y)};
                float ss = x[0] * x[0] + x[1] * x[1] + x[2] * x[2] + x[3] * x[3];
                ss += swz_xor<1>(ss); ss += swz_xor<2>(ss); ss += swz_xor<4>(ss); ss += swz_xor<8>(ss);
                const float rs = rsqrtf(ss * (1.f / 64.f) + EPS);
                const int t = lane & 15; const f32x4 g = which == 0 ? gq : gk;
#pragma unroll
                for (int i = 0; i < 4; ++i) x[i] = x[i] * rs * g[i];
                float xp[4];
#pragma unroll
                for (int i = 0; i < 4; ++i) xp[i] = swz_xor<4>(x[i]);
                if (islat) { const int pos = (t & 8) ? colpos : rowpos; const bool isx2 = (t & 4) != 0;
#pragma unroll
                    for (int i = 0; i < 4; ++i) { const int f = 4 * (t & 3) + i; const float cs = ropeG[(pos * 16 + f) * 2], sn = ropeG[(pos * 16 + f) * 2 + 1]; x[i] = isx2 ? (xp[i] * sn + x[i] * cs) : (x[i] * cs - xp[i] * sn); } }
                if (which == 0) { const float qs = 0.125f * LOG2E; u32x2 o; o.x = cvt_pk_bf16(x[0] * qs, x[1] * qs); o.y = cvt_pk_bf16(x[2] * qs, x[3] * qs); if (!c.dry) *(u32x2*)(B3 + ro) = o; }
                else if (lane < 32) { u32x2 o; o.x = cvt_pk_bf16(x[0], x[1]); o.y = cvt_pk_bf16(x[2], x[3]); *(u32x2*)(kg + ((size_t)(b * 2 + (lane >> 4)) * NTOK + j) * 64 + t * 4) = o; }
            }
            {
                const u32x2 w = w6[rr]; const int g = lane >> 2, hi0 = (lane & 3) * 4;
                *(u32x2*)(ug + ((size_t)g * MROWS + row) * 16 + hi0) = w;
                *(u32x2*)(us + ((size_t)g * NCHUNK + (row >> 4)) * 512 + (row & 15) * 16 + hi0) = w;
            }
        }
    }
}
__device__ __forceinline__ void p2_tiles(const Ctx& c, int l) {
    const bf16_t* pb = wsp<bf16_t>(c, WS_PB);
    bf16_t* vtg = wsp<bf16_t>(c, WS_VTG);
    LAS bf16_t* T = (LAS bf16_t*)c.lds;
    LAS unsigned* T32 = (LAS unsigned*)c.lds;
    const int piece = c.tid & 7, chl = c.tid >> 3;
    const float* hcw = KIN(I_HCW) + (size_t)l * 3 * 768; const float* hcb = KIN(I_HCB) + l * 768;
    u32x4 pre[5];
#define P2T_LOAD(tl_, s_) do { const int b_ = (tl_) / 68, jt_ = (tl_) - b_ * 68, j0_ = jt_ * 64; const int lo_ = jt_ < 64 ? 0 : SEQL, hi_ = jt_ < 64 ? SEQL : NTOK; const size_t rb_ = (size_t)b_ * NTOK; \
        _Pragma("unroll") for (int k_ = 0; k_ < 5; ++k_) { const int e_ = c.tid + k_ * 512; pre[k_] = (u32x4){0u, 0u, 0u, 0u}; \
            if ((s_) == 0) { if (e_ < 64 * 16) { const int r_ = e_ >> 4, pc_ = e_ & 15; pre[k_] = *(const u32x4*)(pb + 4 * BLKE + (rb_ + j0_ + r_) * 256 + 128 + pc_ * 8); } } \
            else if (e_ < 66 * 32) { const int r_ = e_ >> 5, pc_ = e_ & 31, j_ = j0_ - 1 + r_; if (j_ >= lo_ && j_ < hi_) pre[k_] = *(const u32x4*)(pb + (size_t)(7 + (s_)) * BLKE + (rb_ + j_) * 256 + pc_ * 8); } } } while (0)
    int tl = c.bid, st = 0;
    if (tl < NB * 68) P2T_LOAD(tl, 0);
    while (tl < NB * 68) {
        const int b = tl / 68, jt = tl - b * 68, j0 = jt * 64;
#pragma unroll
        for (int k = 0; k < 5; ++k) { const int e = c.tid + k * 512;
            if (st == 0) { if (e < 64 * 16) { const int r = e >> 4, pc = e & 15; LAS unsigned* d = T32 + (r * 516 + pc * 16) / 4; d[0] = pre[k].x; d[1] = pre[k].y; d[2] = pre[k].z; d[3] = pre[k].w; } }
            else if (e < 66 * 32) { const int r = e >> 5, pc = e & 31; LAS unsigned* d = T32 + (r * 516 + pc * 16) / 4; d[0] = pre[k].x; d[1] = pre[k].y; d[2] = pre[k].z; d[3] = pre[k].w; } }
        __syncthreads();
        int ntl = tl, nst = st + 1; if (nst == 5) { nst = 0; ntl = tl + c.G; }
        if (ntl < NB * 68) { if (nst == 0) P2T_LOAD(ntl, 0); else P2T_LOAD(ntl, nst); }
        if (st == 0) {
#pragma unroll
            for (int ps = 0; ps < 2; ++ps) { const int dvf = chl + ps * 64; float v[8];
#pragma unroll
                for (int i = 0; i < 8; ++i) v[i] = bf2f(T[(piece * 8 + i) * 258 + dvf]);
                u32x4 w; w.x = cvt_pk_bf16(v[0], v[1]); w.y = cvt_pk_bf16(v[2], v[3]); w.z = cvt_pk_bf16(v[4], v[5]); w.w = cvt_pk_bf16(v[6], v[7]);
                *(u32x4*)(vtg + ((size_t)(b * 2 + (dvf >> 6)) * 64 + (dvf & 63)) * NTOK + j0 + piece * 8) = w; }
        } else {
            const int blk = 7 + st;
            bf16_t* dst = wsp<bf16_t>(c, blk == 8 ? WS_HYV : blk == 9 ? WS_HYX1 : blk == 10 ? WS_HYX2 : WS_HYG);
#pragma unroll
            for (int ps = 0; ps < 4; ++ps) { const int ch = chl + ps * 64; float v[8];
                if (blk < 11) { const int cc = (blk - 8) * 256 + ch; const float w0 = hcw[cc], w1 = hcw[768 + cc], w2 = hcw[1536 + cc], bs = hcb[cc];
                    float xm = bf2f(T[(piece * 8) * 258 + ch]), x0 = bf2f(T[(piece * 8 + 1) * 258 + ch]);
#pragma unroll
                    for (int i = 0; i < 8; ++i) { const float x1 = bf2f(T[(piece * 8 + i + 2) * 258 + ch]); v[i] = w0 * xm + w1 * x0 + w2 * x1 + bs; xm = x0; x0 = x1; } }
                else {
#pragma unroll
                    for (int i = 0; i < 8; ++i) v[i] = siluf(bf2f(T[(piece * 8 + i + 1) * 258 + ch])); }
                u32x4 w; w.x = cvt_pk_bf16(v[0], v[1]); w.y = cvt_pk_bf16(v[2], v[3]); w.z = cvt_pk_bf16(v[4], v[5]); w.w = cvt_pk_bf16(v[6], v[7]);
                *(u32x4*)(dst + ((size_t)ch * 16 + b) * NTOK + j0 + piece * 8) = w; }
        }
        __syncthreads();
        tl = ntl; st = nst;
    }
#undef P2T_LOAD
}

template <int DK, bool SUB>
__device__ __forceinline__ bool attn_unit(float (&rowmax)[2], const Ctx& c, const bf16_t* Qp, int qpitch, const bf16_t* Kp, const bf16_t* Vtp, int kt0, int nkt, int nrows,
                                          const bf16_t* gatep, bf16_t* outp, bool rope, int j0, float qscale, const float* ropeM) {
    constexpr int KS = DK / 16, KPC = DK / 8, KPITCH = DK * 2 + 16, KB = 64 * KPITCH, VPITCH = 136, VB = 64 * VPITCH;
    constexpr int KOFF = 0, VOFF = 3 * KB;
    constexpr float LIM = 60.f;
    static_assert(KB % 16 == 0 && VB % 16 == 0, "attention LDS buffer alignment");
    const int tid = c.tid, lane = c.lane, wave = c.wave;
    const int lq_ = opaque(lane), q = lq_ & 31, h = lq_ >> 5;
    LAS unsigned char* lds = c.lds;
    const int rbase = (wave * 64 < nrows) ? wave * 64 : wave * 64 - 256;
    const bool live = wave * 64 < nrows;
    bf16x8 qf[2][KS];
#pragma unroll
    for (int qt = 0; qt < 2; ++qt) {
        const bf16_t* qrow = Qp + (size_t)(rbase + qt * 32 + q) * qpitch + 8 * h;
#pragma unroll
        for (int ks = 0; ks < KS; ++ks) qf[qt][ks] = *(const bf16x8*)(qrow + 16 * ks);
        if (DK == 96) {
            const int jj = j0 + rbase + qt * 32 + q;
#pragma unroll
            for (int ks = 0; ks < KS; ++ks) {
                float x[8]; unpack8(__builtin_bit_cast(u32x4, qf[qt][ks]), x);
                if (ks >= 4) {
                    const int pos = (ks == 4) ? ((jj >> 6) & 63) : (jj & 63);
#pragma unroll
                    for (int e = 0; e < 8; ++e) { const float xp = half_other(x[e], h); const float cs = ropeM[(pos * 8 + e) * 2], sn = ropeM[(pos * 8 + e) * 2 + 1];
                        const float r = h ? (xp * sn + x[e] * cs) : (x[e] * cs - xp * sn); x[e] = rope ? r : x[e]; }
                }
                u32x4 w; w.x = cvt_pk_bf16(x[0] * qscale, x[1] * qscale); w.y = cvt_pk_bf16(x[2] * qscale, x[3] * qscale); w.z = cvt_pk_bf16(x[4] * qscale, x[5] * qscale); w.w = cvt_pk_bf16(x[6] * qscale, x[7] * qscale);
                qf[qt][ks] = __builtin_bit_cast(bf16x8, w);
            }
        }
    }
    f32x16 o00, o01, o10, o11;
#pragma unroll
    for (int i = 0; i < 16; ++i) { o00[i] = 0.f; o01[i] = 0.f; o10[i] = 0.f; o11[i] = 0.f; }
    const float m0 = SUB ? rowmax[0] : 0.f, m1 = SUB ? rowmax[1] : 0.f; float l0 = 0.f, l1 = 0.f;
    float rmax0 = -1e30f, rmax1 = -1e30f;
    const int tq_ = opaque(tid);
    const int kst0 = (tq_ / KPC) * KPITCH + (tq_ % KPC) * 16, kst1 = ((tq_ + 512) / KPC) * KPITCH + ((tq_ + 512) % KPC) * 16;
    const int kgl0 = ((tq_ / KPC) * DK + (tq_ % KPC) * 8) * 2, kgl1 = (((tq_ + 512) / KPC) * DK + ((tq_ + 512) % KPC) * 8) * 2;
    const int vst = (tq_ >> 3) * VPITCH + (tq_ & 7) * 16, vgl = ((tq_ >> 3) * NTOK + (tq_ & 7) * 8) * 2;
    const bool has2 = (DK == 96) && tq_ < 256;
    const int kfo = q * KPITCH + 16 * h, vfo = q * VPITCH + 8 * h;
    const char* Kc = (const char*)Kp; const char* Vc = (const char*)Vtp;
    u32x4 kreg0, kreg1 = {0u, 0u, 0u, 0u}, vreg;
#define AT_GLOADK(kt) do { const char* kb_ = Kc + (size_t)(kt) * (64 * DK * 2); kreg0 = *(const u32x4*)(kb_ + kgl0); if (has2) kreg1 = *(const u32x4*)(kb_ + kgl1); } while (0)
#define AT_GLOADV(kt) do { vreg = *(const u32x4*)(Vc + (size_t)(kt) * 128 + vgl); } while (0)
#define AT_WRITEK(bi) do { LAS unsigned char* bb = lds + KOFF + (bi) * KB; *(LAS u32x4*)(bb + kst0) = kreg0; if (has2) *(LAS u32x4*)(bb + kst1) = kreg1; } while (0)
#define AT_WRITEV(bi) do { LAS u32x2* vd = (LAS u32x2*)(lds + VOFF + (bi) * VB + vst); vd[0] = (u32x2){vreg.x, vreg.y}; vd[1] = (u32x2){vreg.z, vreg.w}; } while (0)
#define AT_QK(S0, S1, bi, jh) do { const LAS unsigned char* kb = lds + KOFF + (bi) * KB + (jh) * 32 * KPITCH + kfo; \
        _Pragma("unroll") for (int i = 0; i < 16; ++i) { S0[i] = 0.f; S1[i] = 0.f; } \
        _Pragma("unroll") for (int ks = 0; ks < KS; ++ks) { \
            const bf16x8 a0 = *(const LAS bf16x8*)(kb + 32 * ks); \
            S0 = __builtin_amdgcn_mfma_f32_32x32x16_bf16(a0, qf[0][ks], S0, 0, 0, 0); \
            S1 = __builtin_amdgcn_mfma_f32_32x32x16_bf16(a0, qf[1][ks], S1, 0, 0, 0); } } while (0)
#define AT_MAX(S, RM) do { if (!SUB) { _Pragma("unroll") for (int i = 0; i < 16; i += 2) RM = max3_raw(RM, S[i], S[i + 1]); } } while (0)
#define AT_EXP(S, M, L, PK0, PK1) do { float ps = 0.f; \
        _Pragma("unroll") for (int i = 0; i < 16; ++i) { S[i] = __builtin_amdgcn_exp2f(SUB ? S[i] - M : S[i]); ps += S[i]; } \
        L += ps; u32x4 w; \
        w.x = cvt_pk_bf16(S[0], S[1]); w.y = cvt_pk_bf16(S[2], S[3]); w.z = cvt_pk_bf16(S[4], S[5]); w.w = cvt_pk_bf16(S[6], S[7]); PK0 = __builtin_bit_cast(bf16x8, w); \
        w.x = cvt_pk_bf16(S[8], S[9]); w.y = cvt_pk_bf16(S[10], S[11]); w.z = cvt_pk_bf16(S[12], S[13]); w.w = cvt_pk_bf16(S[14], S[15]); PK1 = __builtin_bit_cast(bf16x8, w); } while (0)
#define AT_SUB(SC0, SC1, SN0, SN1, vbi, jh, nbi, njh) do { \
        AT_MAX(SC0, rmax0); AT_MAX(SC1, rmax1); __builtin_amdgcn_sched_barrier(0); \
        AT_QK(SN0, SN1, nbi, njh); \
        bf16x8 p00, p01, p10, p11; \
        AT_EXP(SC0, m0, l0, p00, p01); AT_EXP(SC1, m1, l1, p10, p11); __builtin_amdgcn_sched_barrier(0); \
        const LAS unsigned char* vb = lds + VOFF + (vbi) * VB + (jh) * 64 + vfo; \
        _Pragma("unroll") for (int st = 0; st < 2; ++st) { \
            const u32x2 la = *(const LAS u32x2*)(vb + 32 * st), ha = *(const LAS u32x2*)(vb + 32 * st + 16), lb = *(const LAS u32x2*)(vb + 32 * VPITCH + 32 * st), hb = *(const LAS u32x2*)(vb + 32 * VPITCH + 32 * st + 16); \
            const bf16x8 va0 = __builtin_bit_cast(bf16x8, (u32x4){la.x, la.y, ha.x, ha.y}), va1 = __builtin_bit_cast(bf16x8, (u32x4){lb.x, lb.y, hb.x, hb.y}); \
            o00 = __builtin_amdgcn_mfma_f32_32x32x16_bf16(va0, st ? p01 : p00, o00, 0, 0, 0); \
            o01 = __builtin_amdgcn_mfma_f32_32x32x16_bf16(va1, st ? p01 : p00, o01, 0, 0, 0); \
            o10 = __builtin_amdgcn_mfma_f32_32x32x16_bf16(va0, st ? p11 : p10, o10, 0, 0, 0); \
            o11 = __builtin_amdgcn_mfma_f32_32x32x16_bf16(va1, st ? p11 : p10, o11, 0, 0, 0); } \
        __builtin_amdgcn_sched_barrier(0); } while (0)
    if (!SUB && tid == 0) *(volatile LAS unsigned*)(lds + LDS_MISC_OFF + 24) = 0u;
    AT_GLOADK(kt0); AT_GLOADV(kt0); AT_WRITEK(0); AT_WRITEV(0);
    AT_GLOADK(kt0 + 1); AT_WRITEK(1);
    __syncthreads();
    f32x16 sa0, sa1, sb0, sb1;
    AT_QK(sa0, sa1, 0, 0);
    int kb0 = 0, kb1 = 1, kb2 = 2;
    for (int t = 0; t < nkt; ++t) {
        const int tk = (t + 2 < nkt) ? t + 2 : nkt - 1, tv = (t + 1 < nkt) ? t + 1 : nkt - 1;
        AT_GLOADK(kt0 + tk);
        AT_SUB(sa0, sa1, sb0, sb1, t & 1, 0, kb0, 1);
        AT_WRITEK(kb2);
        AT_GLOADV(kt0 + tv);
        AT_SUB(sb0, sb1, sa0, sa1, t & 1, 1, kb1, 0);
        AT_WRITEV((t + 1) & 1);
        __syncthreads();
        const int tmp = kb0; kb0 = kb1; kb1 = kb2; kb2 = tmp;
    }
#undef AT_GLOADK
#undef AT_GLOADV
#undef AT_WRITEK
#undef AT_WRITEV
#undef AT_QK
#undef AT_MAX
#undef AT_EXP
#undef AT_SUB
    bool bad = false;
    if (!SUB) { const float r0 = half_max(rmax0), r1 = half_max(rmax1); rowmax[0] = r0; rowmax[1] = r1; const bool b_ = live && !(r0 < LIM && r0 > -LIM && r1 < LIM && r1 > -LIM); volatile LAS unsigned* flg = (volatile LAS unsigned*)(lds + LDS_MISC_OFF + 24); if (__any(b_ ? 1 : 0) && opaque(lane) == 0) *flg = 1u; __syncthreads(); bad = *flg != 0u; __syncthreads(); }
    if (live && !bad) {
        const int le_ = opaque(lane), q = le_ & 31, h = le_ >> 5;
#pragma unroll
        for (int qt = 0; qt < 2; ++qt) {
            const float lr = qt ? l1 : l0; const float lt = half_sum(lr), inv = 1.f / lt;
            const size_t row = (size_t)(rbase + qt * 32 + q);
#pragma unroll
            for (int dt = 0; dt < 2; ++dt)
#pragma unroll
                for (int g4 = 0; g4 < 4; ++g4) {
                    const int dv0 = dt * 32 + 8 * g4 + 4 * h;
                    const u32x2 gw = *(const u32x2*)(gatep + row * 256 + dv0);
                    const float g0 = siluf(lo_bf(gw.x)), g1 = siluf(hi_bf(gw.x)), g2 = siluf(lo_bf(gw.y)), g3 = siluf(hi_bf(gw.y));
                    const f32x16& o = qt ? (dt ? o11 : o10) : (dt ? o01 : o00);
                    u32x2 w; w.x = cvt_pk_bf16(o[4 * g4] * inv * g0, o[4 * g4 + 1] * inv * g1); w.y = cvt_pk_bf16(o[4 * g4 + 2] * inv * g2, o[4 * g4 + 3] * inv * g3);
                    *(u32x2*)(outp + row * DM + dv0) = w;
                }
        }
    }
    return bad;
}

template <int N>
__device__ __forceinline__ void hyena_conv(const Ctx& c, LAS unsigned char* ub, LAS unsigned char* gb, int pass, const bf16_t* xmul  , float bias,
                                           bf16_t* zdst  , const bf16_t* gmul, bf16_t* cat  ) {
    constexpr int UP = (N + 256) * 2 + 16, NPAIR = N / 256, OFF8 = N - 8;
    const int lane = c.lane, i16 = lane & 15, kq = lane >> 4;
    for (int pr = c.wave; pr < NPAIR; pr += 8) {
        const int t0 = pr * 256;
        f32x4 acc[2][8];
#pragma unroll
        for (int m = 0; m < 8; ++m) { acc[0][m] = (f32x4){0.f, 0.f, 0.f, 0.f}; acc[1][m] = (f32x4){0.f, 0.f, 0.f, 0.f}; }
        const LAS unsigned char* up = ub + i16 * UP + 256 + kq * 16;
        const LAS unsigned char* gp = gb + (OFF8 - t0 - 8 * i16 + 8 * kq) * 2;
        bf16x8 bfa = *(const LAS bf16x8*)(up - 256), bfb = *(const LAS bf16x8*)(up);
        u32x4 wa = *(const LAS u32x4*)(gp - 256), wb = *(const LAS u32x4*)(gp - 256 + 16);
        for (int s0 = -128; s0 < N; s0 += 32) {
            const int sn = (s0 + 32 < N) ? s0 + 32 : s0;
            const bf16x8 bfan = *(const LAS bf16x8*)(up + sn * 2), bfbn = *(const LAS bf16x8*)(up + sn * 2 + 256);
            const u32x4 wan = *(const LAS u32x4*)(gp + sn * 2), wbn = *(const LAS u32x4*)(gp + sn * 2 + 16);
            const unsigned w[8] = {wa.x, wa.y, wa.z, wa.w, wb.x, wb.y, wb.z, wb.w};
            unsigned sh[7];
#pragma unroll
            for (int k = 0; k < 7; ++k) sh[k] = __builtin_amdgcn_alignbit(w[k + 1], w[k], 16);
#pragma unroll
            for (int m = 0; m < 8; ++m) {
                u32x4 a;
                if (m & 1) { const int d0 = (7 - m) >> 1; a = (u32x4){w[d0], w[d0 + 1], w[d0 + 2], w[d0 + 3]}; }
                else { const int d0 = (6 - m) >> 1; a = (u32x4){sh[d0], sh[d0 + 1], sh[d0 + 2], sh[d0 + 3]}; }
                acc[0][m] = __builtin_amdgcn_mfma_f32_16x16x32_bf16(__builtin_bit_cast(bf16x8, a), bfa, acc[0][m], 0, 0, 0);
                acc[1][m] = __builtin_amdgcn_mfma_f32_16x16x32_bf16(__builtin_bit_cast(bf16x8, a), bfb, acc[1][m], 0, 0, 0);
            }
            bfa = bfan; bfb = bfbn; wa = wan; wb = wbn;
        }
#pragma unroll
        for (int half = 0; half < 2; ++half)
#pragma unroll
            for (int r = 0; r < 4; ++r) {
                const int t8 = t0 + half * 128 + 32 * kq + 8 * r;
                float uu[8], xm[8]; unpack8(*(const LAS u32x4*)(ub + i16 * UP + 256 + t8 * 2), uu); unpack8(*(const u32x4*)(xmul + (size_t)i16 * NTOK + t8), xm);
                float y[8];
#pragma unroll
                for (int m = 0; m < 8; ++m) y[m] = xm[m] * (acc[half][m][r] + bias * uu[m]);
                if (pass == 0) { u32x4 o; o.x = cvt_pk_bf16(y[0], y[1]); o.y = cvt_pk_bf16(y[2], y[3]); o.z = cvt_pk_bf16(y[4], y[5]); o.w = cvt_pk_bf16(y[6], y[7]); *(u32x4*)(zdst + (size_t)i16 * NTOK + t8) = o; }
                else { float gg[8]; unpack8(*(const u32x4*)(gmul + (size_t)i16 * NTOK + t8), gg);
                    u32x4 o; o.x = cvt_pk_bf16(y[0] * gg[0], y[1] * gg[1]); o.y = cvt_pk_bf16(y[2] * gg[2], y[3] * gg[3]); o.z = cvt_pk_bf16(y[4] * gg[4], y[5] * gg[5]); o.w = cvt_pk_bf16(y[6] * gg[6], y[7] * gg[7]);
                    *(u32x4*)(cat + (size_t)i16 * NTOK + t8) = o; }
            }
    }
}
template <int N>
__device__ __forceinline__ void hyena_seq(const Ctx& c, int l, int ch, int toff) {
    constexpr int UP = (N + 256) * 2 + 16;
    LAS unsigned char* ub = c.lds; LAS unsigned char* gb = c.lds + 16 * UP;
    const bf16_t* vv = wsp<bf16_t>(c, WS_HYV) + (size_t)ch * 16 * NTOK + toff;
    bf16_t* vz = wsp<bf16_t>(c, WS_HYZ) + (size_t)ch * 16 * NTOK + toff;
    const bf16_t* x1 = wsp<bf16_t>(c, WS_HYX1) + (size_t)ch * 16 * NTOK + toff;
    const bf16_t* x2 = wsp<bf16_t>(c, WS_HYX2) + (size_t)ch * 16 * NTOK + toff;
    const bf16_t* gm = wsp<bf16_t>(c, WS_HYG) + (size_t)ch * 16 * NTOK + toff;
    bf16_t* cat = wsp<bf16_t>(c, WS_HYY) + (size_t)ch * 16 * NTOK + toff;
    { const int e = c.tid, b = e >> 5, side = (e >> 4) & 1, pc = e & 15; unsigned z = 0u; asm volatile("" : "+v"(z)); *(LAS u32x4*)(ub + b * UP + side * (256 + N * 2) + pc * 16) = (u32x4){z, z, z, z}; }
    for (int pass = 0; pass < 2; ++pass) {
        const bf16_t* gr = (N == SEQL) ? wsp<bf16_t>(c, WS_GR) + (((size_t)l * 2 + pass) * 256 + ch) * 8192 : wsp<bf16_t>(c, WS_GRC) + (((size_t)l * 2 + pass) * 256 + ch) * 512;
        const bf16_t* usrc = pass == 0 ? vv : vz;
        constexpr int NG = (2 * N / 8 + 511) / 512;
        {
            u32x4 t[NG];
#pragma unroll
            for (int k = 0; k < NG; ++k) { const int e = c.tid + k * 512; t[k] = (e < 2 * N / 8) ? *(const u32x4*)(gr + e * 8) : (u32x4){0u, 0u, 0u, 0u}; }
#pragma unroll
            for (int k = 0; k < NG; ++k) { const int e = c.tid + k * 512; if (e < 2 * N / 8) *(LAS u32x4*)(gb + e * 16) = t[k]; }
        }
        if constexpr (N == SEQL) {
#pragma unroll
            for (int k0 = 0; k0 < 16; k0 += 8) {
                u32x4 t[8];
#pragma unroll
                for (int k = 0; k < 8; ++k) t[k] = *(const u32x4*)(usrc + (size_t)(k0 + k) * NTOK + c.tid * 8);
#pragma unroll
                for (int k = 0; k < 8; ++k) *(LAS u32x4*)(ub + (k0 + k) * UP + 256 + c.tid * 16) = t[k];
            }
        } else {
            const int b = c.tid >> 5, pc = c.tid & 31;
            *(LAS u32x4*)(ub + b * UP + 256 + pc * 16) = *(const u32x4*)(usrc + (size_t)b * NTOK + pc * 8);
        }
        __syncthreads();
        const float bias = KIN(I_HBIAS)[((size_t)l * 2 + pass) * 256 + ch];
        hyena_conv<N>(c, ub, gb, pass, pass == 0 ? x1 : x2, bias, vz, gm, cat);
        asm volatile("s_waitcnt vmcnt(0)" ::: "memory");
        __syncthreads();
    }
}

__device__ __forceinline__ void hyena_untranspose(const Ctx& c, int tl0, int tl1) {
    const bf16_t* yT = wsp<bf16_t>(c, WS_HYY); bf16_t* cat = wsp<bf16_t>(c, WS_HCAT);
    LAS bf16_t* T = (LAS bf16_t*)c.lds;
    LAS unsigned* T32 = (LAS unsigned*)c.lds;
    for (int tl = tl0; tl < tl1; ++tl) {
        const int b = tl / 68, j0 = (tl - b * 68) * 64;
        u32x4 pre[4];
#pragma unroll
        for (int k = 0; k < 4; ++k) { const int e = c.tid + k * 512, ch = e >> 3, pc = e & 7; pre[k] = *(const u32x4*)(yT + ((size_t)ch * 16 + b) * NTOK + j0 + pc * 8); }
#pragma unroll
        for (int k = 0; k < 4; ++k) { const int e = c.tid + k * 512, ch = e >> 3, pc = e & 7; LAS unsigned* d = T32 + (ch * 132 + pc * 16) / 4; d[0] = pre[k].x; d[1] = pre[k].y; d[2] = pre[k].z; d[3] = pre[k].w; }
        __syncthreads();
#pragma unroll
        for (int k = 0; k < 4; ++k) { const int e = c.tid + k * 512, t = e >> 5, c0 = (e & 31) * 8; float v[8];
#pragma unroll
            for (int i = 0; i < 8; ++i) v[i] = bf2f(T[(c0 + i) * 66 + t]);
            u32x4 w; w.x = cvt_pk_bf16(v[0], v[1]); w.y = cvt_pk_bf16(v[2], v[3]); w.z = cvt_pk_bf16(v[4], v[5]); w.w = cvt_pk_bf16(v[6], v[7]);
            *(u32x4*)(cat + ((size_t)b * NTOK + j0 + t) * DM + 768 + c0) = w; }
        __syncthreads();
    }
}

__device__ __forceinline__ void ssm_scan_item(const Ctx& c, int l, int item) {
    const int b = item >> 2, g = (item & 3) * 4 + (c.tid >> 7), dq = (c.tid >> 6) & 1, p = c.tid & 63;
    const float* a16 = wsp<float>(c, WS_A16) + ((((size_t)l * 2 + dq) * 16 + g) * 64 + p) * 2;
    const float ar = a16[0], ai = a16[1];
    const bf16_t* E = wsp<bf16_t>(c, WS_E); bf16_t* US = wsp<bf16_t>(c, WS_US);
    float sr = 0.f, si = 0.f;
    for (int st0 = 0; st0 < NCHB; st0 += 8) {
        float er[8], ei[8]; size_t ro[8];
#pragma unroll
        for (int k = 0; k < 8; ++k) { const int st = st0 + k; const int cc = dq == 0 ? (st < 16 ? 256 + st : st - 16) : (st < 16 ? 271 - st : 255 - (st - 16));
            ro[k] = (size_t)g * NCHUNK + (size_t)b * NCHB + cc; er[k] = bf2f(E[ro[k] * 256 + dq * 128 + p]); ei[k] = bf2f(E[ro[k] * 256 + dq * 128 + 64 + p]); }
#pragma unroll
        for (int k = 0; k < 8; ++k) {
            US[ro[k] * 512 + 256 + dq * 128 + p] = f2bf(sr); US[ro[k] * 512 + 256 + dq * 128 + 64 + p] = f2bf(si);
            const float nr = ar * sr - ai * si + er[k], ni = ar * si + ai * sr + ei[k]; sr = nr; si = ni;
        }
    }
}

constexpr int LDS_BYTES = 163840;
constexpr int LDS_MISC = LDS_MISC_OFF;
static_assert(LDS_MISC_OFF == LDS_BYTES - 256, "LDS map");
constexpr int NPRO = 2, NPH = 6, NPHASES = NPRO + DEPTH * NPH;
constexpr int QI_HY = 256, QI_SCAN = 64, QI_ATTL = NB * 8 * 8, QI_SSM2 = 16 * 17, QI_UNT = 272, QI_ATTC = NB * 8, QI_GLU = MROWS / 256;
constexpr int QO_SCAN = QI_HY, QO_ATTL = QO_SCAN + QI_SCAN, QO_SSM2 = QO_ATTL + QI_ATTL, QO_UNT = QO_SSM2 + QI_SSM2, QO_ATTC = QO_UNT + QI_UNT, QO_GLU = QO_ATTC + QI_ATTC, QI_TOTAL = QO_GLU + QI_GLU;
#ifndef PROBE_DUP_MASK
#define PROBE_DUP_MASK 0
#endif
__device__ __forceinline__ void dep_signal(const Ctx& c, unsigned* cnt) {
    asm volatile("s_waitcnt vmcnt(0)" ::: "memory");
    __syncthreads();
    if (c.tid == 0) { __builtin_amdgcn_fence(__ATOMIC_RELEASE, "agent"); asm volatile("s_waitcnt vmcnt(0)" ::: "memory"); (void)xb_add(cnt, 1u); }
}
__device__ __forceinline__ void dep_wait(const Ctx& c, unsigned* cnt, unsigned need, unsigned* tmo) {
    if (c.tid == 0) {
        unsigned sp = 0;
        while (xb_ld(cnt) < need) { __builtin_amdgcn_s_sleep(2); if ((++sp & 255u) == 0u) { if (xb_ld(tmo)) break; if (sp > XB_SPIN_CAP) { atomicAdd(tmo, 1u); break; } } }
        __builtin_amdgcn_fence(__ATOMIC_ACQUIRE, "agent");
        asm volatile("s_waitcnt vmcnt(0)" ::: "memory");
    }
    __syncthreads();
}

__global__ void __launch_bounds__(512, 2) mk_fwd(Params prm) {
    extern __shared__ __attribute__((aligned(16))) unsigned char lds_raw[];
    Ctx c; c.lds = (LAS unsigned char*)lds_raw; c.ka = (kargp_t)__builtin_amdgcn_kernarg_segment_ptr(); c.ws = prm.ws; c.tid = threadIdx.x; c.lane = c.tid & 63; c.wave = __builtin_amdgcn_readfirstlane(c.tid >> 6); c.G = gridDim.x; c.bid = blockIdx.x; c.dry = prm.dry;
    const int wave0 = c.wave;
    volatile LAS unsigned* misc = (volatile LAS unsigned*)(c.lds + LDS_MISC);
    if (c.tid < 16) misc[c.tid] = 0u;
    __syncthreads();
    unsigned* ctl = wsp<unsigned>(c, WS_CTL);
    const int lo = prm.ph_lo, hi = prm.ph_hi;
    const bool fused = (hi - lo) > 1;
    XcdBarrier bar; bar.bar = ctl + CW_BAR; bar.x = 0; bar.st = misc;
    if (fused) bar = xcd_barrier_post(ctl + CW_BAR, misc);
#ifndef SITE_MASK
#define SITE_MASK 0x3ff
#endif
#define SITE(n) (((SITE_MASK) >> (n)) & 1)
#define IN(k) (lo <= (k) && (k) < hi)
#define FRESH() do { { kargp_t _k = (kargp_t)__builtin_amdgcn_kernarg_segment_ptr(); asm volatile("" : "+s"(_k)); c.ka = _k; c.ws = (unsigned char*)(GAS unsigned char*)_k[37]; } { int _w = wave0; asm volatile("" : "+s"(_w)); c.wave = _w; c.lane = lane_id_fresh(); c.tid = c.wave * 64 + c.lane; } } while (0)
#define SEAM(k) do { if (IN((k) + 1)) xcd_barrier(bar); } while (0)

    if (SITE(0) && IN(0)) {
        FRESH();
        constexpr int J_SSM = 64, J_HY = 544, J_MOD = 192, J_WIN = 4 * 48 * 8, J_WOUT = 4 * 16 * 8, J_WUQ = 4 * 8 * 2, J_W256 = 4 * 4 * 2;
        constexpr int J0 = J_SSM, J1 = J0 + J_HY, J2 = J1 + J_MOD, J3 = J2 + J_WIN, J4 = J3 + J_WOUT, J5 = J4 + J_WUQ, J6 = J5 + J_W256, J7 = J6 + J_W256, J8 = J7 + J_W256, J9 = J8 + 1;
        for (int job = c.bid; job < J9; job += c.G) {
            if (job < J0) ssm_tables_job(c, job);
            else if (job < J1) hyena_mlp_job(c, job - J0);
            else if (job < J2) modv_job(c, job - J1);
            else if (job < J3) { const int r = job - J2, l = r / 384, q = r % 384; wconv_tile(c, KIN(I_WIN) + (size_t)l * DM * INC, DM, INC, INP, wsp<bf16_t>(c, WS_WIN) + (size_t)l * INP * DM, DM, 0, q / 8, q % 8); }
            else if (job < J4) { const int r = job - J3, l = r / 128, q = r % 128; wconv_tile(c, KIN(I_WOUT) + (size_t)l * DM * DM, DM, DM, DM, wsp<bf16_t>(c, WS_WOUT) + (size_t)l * DM * DM, DM, 1, q / 8, q % 8); }
            else if (job < J5) { const int r = job - J4, l = r / 16, q = r % 16; wconv_tile(c, KIN(I_WUQ) + (size_t)l * 192 * 384, 192, 384, 384, wsp<bf16_t>(c, WS_WUQ) + (size_t)l * 512 * 256, 256, 1, q / 2, q % 2); }
            else if (job < J6) { const int r = job - J5, l = r / 8, q = r % 8; wconv_tile(c, KIN(I_WUKV) + (size_t)l * 128 * 512, 128, 512, 256, wsp<bf16_t>(c, WS_WUK) + (size_t)l * 256 * 256, 256, 2, q / 2, q % 2); }
            else if (job < J7) { const int r = job - J6, l = r / 8, q = r % 8; wconv_tile(c, KIN(I_WUKV) + (size_t)l * 128 * 512, 128, 512, 256, wsp<bf16_t>(c, WS_WUV) + (size_t)l * 256 * 256, 256, 3, q / 2, q % 2); }
            else if (job < J8) { const int r = job - J7, l = r / 8, q = r % 8; wconv_tile(c, KIN(I_GLUW) + (size_t)l * 256 * 256, 256, 256, 256, wsp<bf16_t>(c, WS_WGLU) + (size_t)l * 256 * 256, 256, 1, q / 2, q % 2); }
            else rope_job(c);
        }
        SEAM(0);
    }
    if (SITE(1) && IN(1)) {
        FRESH();
        for (int job = c.bid; job < 4 * 2 * 256; job += c.G) hyena_pack_job(c, job);
        norm_rows(c, -1, 0);
        SEAM(1);
    }
    for (int l = 0; l < DEPTH; ++l) {
        const int pbase = NPRO + l * NPH;
        if (SITE(2) && IN(pbase + 0)) {
            FRESH();
            pg8::Gemm g{wsp<bf16_t>(c, WS_HCAT), wsp<bf16_t>(c, WS_WIN) + (size_t)l * INP * DM, MROWS, INP, DM};
            pg8::StaticOrder S; S.init(MROWS, INP, c.G, c.bid);
            pg8::EpiWalk<PutSplit> E{{wsp<bf16_t>(c, WS_PB)}};
            pg8::gemm_phase(c.lds, g, S, E, c.tid);
            SEAM(pbase + 0);
        }
        if (SITE(3) && IN(pbase + 1)) { FRESH(); p2_rows(c, l); FRESH(); p2_tiles(c, l); SEAM(pbase + 1); }
        if (SITE(4) && IN(pbase + 2)) {
            FRESH();
            pg8::Gemm g{wsp<bf16_t>(c, WS_PB), wsp<bf16_t>(c, WS_WUQ), MROWS, 512, 256};
            pg8::P3Order S{wsp<bf16_t>(c, WS_PB), wsp<bf16_t>(c, WS_PB) + BLKE, wsp<bf16_t>(c, WS_WUQ) + (size_t)l * 512 * 256, wsp<bf16_t>(c, WS_WUK) + (size_t)l * 256 * 256, wsp<bf16_t>(c, WS_WUV) + (size_t)l * 256 * 256,
                           wsp<bf16_t>(c, WS_UG), wsp<bf16_t>(c, WS_WE) + (size_t)l * 16 * 256 * 256, c.G, c.bid};
            EpiP3 E{{wsp<bf16_t>(c, WS_QM), 384, 384}, {wsp<bf16_t>(c, WS_KM), wsp<bf16_t>(c, WS_KR)}, {wsp<bf16_t>(c, WS_VTM)}, {wsp<bf16_t>(c, WS_E)}};
            pg8::gemm_phase(c.lds, g, S, E, c.tid);
            SEAM(pbase + 2);
        }
        if (SITE(5) && IN(pbase + 3)) {
            FRESH();
            unsigned* qh = ctl + CW_Q + 64 * (l + 4 * c.dry);
            unsigned* dep = ctl + CW_DEP + DEP_SET * (l + 4 * c.dry);
            unsigned* tmo = ctl + CW_BAR + XB_TMO;
            const float* ropeM = wsp<float>(c, WS_ROPEM);
#define ATT_CALL(DKV, ...) do { float rowmax_[2] = {0.f, 0.f}; if (attn_unit<DKV, false>(rowmax_, __VA_ARGS__)) { (void)attn_unit<DKV, true>(rowmax_, __VA_ARGS__); } } while (0)
            for (;;) {
                __syncthreads();
                if (c.tid == 0) misc[4] = __hip_atomic_fetch_add(qh, 1u, __ATOMIC_RELAXED, __HIP_MEMORY_SCOPE_AGENT);
                __syncthreads();
                const int it = (int)misc[4];
                if (it >= QI_TOTAL) break;
                FRESH();
                if (it < QO_SCAN) { hyena_seq<SEQL>(c, l, it, 0); hyena_seq<CTXL>(c, l, it, SEQL); dep_signal(c, dep); }
                else if (it < QO_ATTL) { ssm_scan_item(c, l, it - QO_SCAN); dep_signal(c, dep + 64); }
                else if (it < QO_SSM2 || (it >= QO_ATTC && it < QO_GLU)) {
                    const bool isctx = it >= QO_ATTC; const int r = isctx ? it - QO_ATTC : (it - QO_ATTL) % (NB * 8), blk = isctx ? 8 : (it - QO_ATTL) / (NB * 8)  ;
                    const int kind = r & 1  , head = (r >> 1) & 3, b = r >> 3;
                    const size_t row0 = (size_t)b * NTOK + (isctx ? SEQL : blk * 512); const int kt0 = isctx ? 64 : 0, nkt = isctx ? 4 : 68, nrows = isctx ? 256 : 512;
                    if (kind == 0) { ATT_CALL(96, c, wsp<bf16_t>(c, WS_QM) + row0 * 384 + head * 96, 384, wsp<bf16_t>(c, WS_KM) + (size_t)(b * 4 + head) * NTOK * 96, wsp<bf16_t>(c, WS_VTM) + (size_t)(b * 4 + head) * 64 * NTOK,
                                                 kt0, nkt, nrows, wsp<bf16_t>(c, WS_PB) + 2 * BLKE + row0 * 256 + head * 64, wsp<bf16_t>(c, WS_HCAT) + row0 * DM + head * 64, !isctx, blk * 512, 0.10206207261596577f * LOG2E, ropeM); }
                    else { ATT_CALL(64, c, wsp<bf16_t>(c, WS_PB) + 3 * BLKE + row0 * 256 + head * 64, 256, wsp<bf16_t>(c, WS_KG) + (size_t)(b * 2 + (head >> 1)) * NTOK * 64, wsp<bf16_t>(c, WS_VTG) + (size_t)(b * 2 + (head >> 1)) * 64 * NTOK,
                                       kt0, nkt, nrows, wsp<bf16_t>(c, WS_PB) + 5 * BLKE + row0 * 256 + head * 64, wsp<bf16_t>(c, WS_HCAT) + row0 * DM + 256 + head * 64, false, 0, 1.f, ropeM); }
                }
                else if (it < QO_UNT) {
                    const int L = it - QO_SSM2, i = L >> 4, g = L & 15;
                    dep_wait(c, dep + 64, QI_SCAN, tmo);
                    pg8::Gemm gm{wsp<bf16_t>(c, WS_US), wsp<bf16_t>(c, WS_WKC) + (size_t)l * 16 * 256 * 512, 16 * NCHUNK, 16 * 256, 512}; pg8::OneUnit S{g * 17 + i, g};
                    pg8::EpiWalk<PutSsmY> E{{wsp<bf16_t>(c, WS_ZS), wsp<bf16_t>(c, WS_UG), KIN(I_SSMD) + l * 256}}; pg8::gemm_phase(c.lds, gm, S, E, c.tid);
                    dep_signal(c, dep + 64 * (2 + i));
                }
                else if (it < QO_ATTC) {
                    dep_wait(c, dep, QI_HY, tmo);
                    const int j = it - QO_UNT; hyena_untranspose(c, 4 * j, 4 * j + 4);
                }
                else {
                    const int pm = it - QO_GLU;
                    dep_wait(c, dep + 64 * (2 + (pm >> 4)), 16u, tmo);
                    pg8::Gemm gm{wsp<bf16_t>(c, WS_ZS), wsp<bf16_t>(c, WS_WGLU) + (size_t)l * 256 * 256, MROWS, 256, 256}; pg8::OneUnit S{pm, 0};
                    pg8::EpiWalk<PutGlu> E{{wsp<bf16_t>(c, WS_HCAT), wsp<bf16_t>(c, WS_ZS), wsp<bf16_t>(c, WS_PB) + 7 * BLKE, KIN(I_GLUB) + l * 256}}; pg8::gemm_phase(c.lds, gm, S, E, c.tid);
                }
            }
            SEAM(pbase + 3);
        }
        if (SITE(6) && IN(pbase + 4)) {
            FRESH();
            pg8::Gemm g{wsp<bf16_t>(c, WS_HCAT), wsp<bf16_t>(c, WS_WOUT) + (size_t)l * DM * DM, MROWS, DM, DM}; pg8::StaticOrder S; S.init(MROWS, DM, c.G, c.bid);
            pg8::EpiWalk<PutPlain> E{{wsp<bf16_t>(c, WS_OUTB), DM, DM}}; pg8::gemm_phase(c.lds, g, S, E, c.tid);
            SEAM(pbase + 4);
        }
        if (SITE(7) && IN(pbase + 5)) { FRESH(); norm_rows(c, l, l + 1 < DEPTH ? l + 1 : -1); if (l + 1 < DEPTH) SEAM(pbase + 5); }
    }
#undef IN
#undef SEAM
}

extern "C" void kernel_launch(void* const* d_in, const int* in_sizes, int n_in, void* d_out, int out_size, void* d_ws, size_t ws_size, hipStream_t stream) {
    static int grid = 0;
    if (grid == 0) {
        if (n_in != 36 || out_size != NB * SEQL * DM || ws_size < WS_END) { fprintf(stderr, "kernel_launch: unexpected shapes: n_in %d out %d ws %zu (need %zu)\n", n_in, out_size, ws_size, (size_t)WS_END); grid = -1; return; }
        int dev = 0, cus = 0, per_cu = 0;
        if (hipGetDevice(&dev) != hipSuccess || hipDeviceGetAttribute(&cus, hipDeviceAttributeMultiprocessorCount, dev) != hipSuccess) { grid = -1; return; }
        if (hipFuncSetAttribute((const void*)mk_fwd, hipFuncAttributeMaxDynamicSharedMemorySize, LDS_BYTES) != hipSuccess) { fprintf(stderr, "kernel_launch: hipFuncSetAttribute failed\n"); grid = -1; return; }
        if (hipOccupancyMaxActiveBlocksPerMultiprocessor(&per_cu, (const void*)mk_fwd, 512, LDS_BYTES) != hipSuccess || per_cu < 1) { fprintf(stderr, "kernel_launch: occupancy query says %d blocks per CU\n", per_cu); per_cu = 1; }
        (void)hipGetLastError();
        grid = cus;
    }
    if (grid < 0) return;
    (void)hipMemsetAsync((char*)d_ws + WS_CTL, 0, CTL_BYTES, stream);
    Params p{};
    for (int i = 0; i < 36; ++i) p.in[i] = (const float*)d_in[i];
    p.out = (float*)d_out; p.ws = (unsigned char*)d_ws;
#if MK_ONE_LAUNCH
    p.ph_lo = 0; p.ph_hi = NPHASES;
    hipLaunchKernelGGL(mk_fwd, dim3(grid), dim3(512), LDS_BYTES, stream, p);
#else
    for (int k = 0; k < NPHASES; ++k) { p.ph_lo = k; p.ph_hi = k + 1; const int site = k < NPRO ? k : NPRO + (k - NPRO) % NPH;
        if ((PROBE_DUP_MASK >> site) & 1) { p.dry = 1; hipLaunchKernelGGL(mk_fwd, dim3(grid), dim3(512), LDS_BYTES, stream, p); p.dry = 0; }
        hipLaunchKernelGGL(mk_fwd, dim3(grid), dim3(512), LDS_BYTES, stream, p); }
#endif
}
```

```cpp
#include <hip/hip_runtime.h>
#include <cstdio>
#include <cstdint>

#ifndef MK_ONE_LAUNCH
#define MK_ONE_LAUNCH 1
#endif

#define LAS __attribute__((address_space(3)))
typedef unsigned short bf16_t;
typedef short bf16x8 __attribute__((ext_vector_type(8)));
typedef short bf16x4 __attribute__((ext_vector_type(4)));
typedef float f32x4 __attribute__((ext_vector_type(4)));
typedef float f32x16 __attribute__((ext_vector_type(16)));
typedef unsigned u32x4 __attribute__((ext_vector_type(4)));
typedef unsigned u32x2 __attribute__((ext_vector_type(2)));

constexpr int NB = 16, SEQL = 4096, CTXL = 256, NTOK = SEQL + CTXL  , MROWS = NB * NTOK  ;
constexpr int DM = 1024, DEPTH = 4, INC = 2912, INP = 3072;
constexpr int NCHB = NTOK / 16  , NCHUNK = MROWS / 16  ;
constexpr float EPS = 1e-6f;
constexpr float LOG2E = 1.4426950408889634f;
constexpr int LDS_MISC_OFF = 163840 - 256;

constexpr size_t al256(size_t x) { return (x + 255) & ~(size_t)255; }
constexpr size_t WS_CTL = 0;
constexpr size_t CTL_BYTES = 65536;
constexpr size_t WS_MODV = WS_CTL + CTL_BYTES;
constexpr size_t WS_ROPEG = WS_MODV + al256((size_t)4 * 17 * 3072 * 4);
constexpr size_t WS_ROPEM = WS_ROPEG + 64 * 16 * 2 * 4;
constexpr size_t WS_WIN = WS_ROPEM + 64 * 8 * 2 * 4;
constexpr size_t WS_WOUT = WS_WIN + (size_t)4 * 3072 * 1024 * 2;
constexpr size_t WS_WUQ = WS_WOUT + (size_t)4 * 1024 * 1024 * 2;
constexpr size_t WS_WUK = WS_WUQ + (size_t)4 * 512 * 256 * 2;
constexpr size_t WS_WUV = WS_WUK + (size_t)4 * 256 * 256 * 2;
constexpr size_t WS_WGLU = WS_WUV + (size_t)4 * 256 * 256 * 2;
constexpr size_t WS_WE = WS_WGLU + (size_t)4 * 256 * 256 * 2;
constexpr size_t WS_WKC = WS_WE + (size_t)4 * 16 * 256 * 256 * 2;
constexpr size_t WS_A16 = WS_WKC + (size_t)4 * 16 * 256 * 512 * 2;
constexpr size_t WS_GR = WS_A16 + (size_t)4 * 2 * 16 * 64 * 2 * 4;
constexpr size_t WS_GRC = WS_GR + (size_t)4 * 2 * 256 * 8192 * 2;
constexpr size_t WS_CTXR = WS_GRC + (size_t)4 * 2 * 256 * 512 * 2;
constexpr size_t WS_HCAT = WS_CTXR + (size_t)NB * CTXL * DM * 4;
constexpr size_t BLKE = (size_t)MROWS * 256;
constexpr size_t WS_PB = WS_HCAT + (size_t)MROWS * DM * 2;
constexpr size_t WS_KR = WS_PB + 12 * BLKE * 2;
constexpr size_t WS_KG = WS_KR + (size_t)MROWS * 32 * 2;
constexpr size_t WS_VTG = WS_KG + (size_t)32 * NTOK * 64 * 2;
constexpr size_t WS_UG = WS_VTG + (size_t)32 * NTOK * 64 * 2;
constexpr size_t WS_US = WS_UG + BLKE * 2;
constexpr size_t WS_HYV = WS_US + (size_t)16 * NCHUNK * 512 * 2;
constexpr size_t WS_HYX1 = WS_HYV + BLKE * 2;
constexpr size_t WS_HYX2 = WS_HYX1 + BLKE * 2;
constexpr size_t WS_HYG = WS_HYX2 + BLKE * 2;
constexpr size_t WS_HYZ = WS_HYG + BLKE * 2;
constexpr size_t WS_HYY = WS_HYZ + BLKE * 2;
constexpr size_t WS_END = WS_HYY + BLKE * 2;
static_assert(WS_END <= (size_t)1 << 30, "workspace map exceeds 1 GiB");
constexpr size_t WS_QM = WS_PB + 8 * BLKE * 2;
constexpr size_t WS_KM = WS_QM + (size_t)MROWS * 384 * 2;
constexpr size_t WS_VTM = WS_KM + (size_t)MROWS * 384 * 2;
constexpr size_t WS_E = WS_PB + 4 * BLKE * 2;
constexpr size_t WS_ZS = WS_PB + 6 * BLKE * 2;
constexpr size_t WS_OUTB = WS_PB + 8 * BLKE * 2;
constexpr size_t WS_HT = WS_PB;
static_assert(WS_VTM + BLKE * 2 == WS_PB + 12 * BLKE * 2, "alias map");

constexpr int CW_BAR = 0;
constexpr int CW_Q = 4096;
constexpr int CW_TMO = 4096 + 64 * 8;
constexpr int CW_DEP = 5120;
constexpr int DEP_SET = 20 * 64;

__device__ __forceinline__ float bf2f(bf16_t v) { return __uint_as_float(((unsigned)v) << 16); }
__device__ __forceinline__ bf16_t f2bf(float f) { unsigned u = __float_as_uint(f); u += 0x7FFFu + ((u >> 16) & 1u); return (bf16_t)(u >> 16); }
__device__ __forceinline__ unsigned cvt_pk_bf16(float lo, float hi) { unsigned r; asm volatile("v_cvt_pk_bf16_f32 %0, %1, %2" : "=v"(r) : "v"(lo), "v"(hi)); return r; }
__device__ __forceinline__ float lo_bf(unsigned w) { return __uint_as_float(w << 16); }
__device__ __forceinline__ float hi_bf(unsigned w) { return __uint_as_float(w & 0xFFFF0000u); }
__device__ __forceinline__ float sigmf(float x) { float one = 1.f; asm volatile("" : "+v"(one)); return __builtin_amdgcn_rcpf(one + __builtin_amdgcn_exp2f(-1.4426950408889634f * x)); }
__device__ __forceinline__ float siluf(float x) { return x * sigmf(x); }
__device__ __forceinline__ float gelu_tanh(float x) { const float u = 0.7978845608028654f * (x + 0.044715f * x * x * x); return x * sigmf(2.f * u); }
__device__ __forceinline__ int opaque(int x) { asm volatile("" : "+v"(x)); return x; }
__device__ __forceinline__ int lane_id_fresh() { int x; asm volatile("v_mbcnt_lo_u32_b32 %0, -1, 0\n\tv_mbcnt_hi_u32_b32 %0, -1, %0" : "=v"(x)); return x; }
__device__ __forceinline__ float max3_raw(float a, float b, float c) { float r; asm("v_max3_f32 %0, %1, %2, %3" : "=v"(r) : "v"(a), "v"(b), "v"(c)); return r; }
template <int M> __device__ __forceinline__ float swz_xor(float v) { return __int_as_float(__builtin_amdgcn_ds_swizzle(__float_as_int(v), 0x1F | (M << 10))); }
__device__ __forceinline__ float half_sum(float v) { auto r = __builtin_amdgcn_permlane32_swap(__float_as_uint(v), __float_as_uint(v), false, false); return __uint_as_float(r[0]) + __uint_as_float(r[1]); }
__device__ __forceinline__ float half_max(float v) { auto r = __builtin_amdgcn_permlane32_swap(__float_as_uint(v), __float_as_uint(v), false, false); return fmaxf(__uint_as_float(r[0]), __uint_as_float(r[1])); }
__device__ __forceinline__ float half_other(float v, int h) { auto r = __builtin_amdgcn_permlane32_swap(__float_as_uint(v), __float_as_uint(v), false, false); return __uint_as_float(h ? r[0] : r[1]); }
__device__ __forceinline__ float wave_sum(float v) {
    v += swz_xor<16>(v); v += swz_xor<8>(v); v += swz_xor<4>(v); v += swz_xor<2>(v); v += swz_xor<1>(v);
    return half_sum(v);
}

#define XB_TMO      128
#define XB_XCNT(j)  (256  + 64 * (j))
#define XB_XSUB(j)  (1280 + 64 * (j))
#define XB_XGEN(j)  (2304 + 64 * (j))
#define XB_TOP      3328
#define XB_TOPGEN   3392
#define XCD_BAR_WORDS 3456
#define XB_SPIN_CAP (1u << 22)
__device__ __forceinline__ unsigned xb_ld(unsigned* p)              { return __hip_atomic_load(p, __ATOMIC_RELAXED, __HIP_MEMORY_SCOPE_AGENT); }
__device__ __forceinline__ unsigned xb_add(unsigned* p, unsigned v) { return __hip_atomic_fetch_add(p, v, __ATOMIC_RELAXED, __HIP_MEMORY_SCOPE_AGENT); }
__device__ __forceinline__ unsigned xb_xcc_id() { return (unsigned)__builtin_amdgcn_s_getreg((3 << 11) | 20) & 0xFu; }
#define XB_SPIN(cond, bar) do { unsigned _sp = 0; while (cond) { __builtin_amdgcn_s_sleep(1); \
    if ((++_sp & 255u) == 0u) { if (xb_ld(&(bar)[XB_TMO])) break; if (_sp > XB_SPIN_CAP) { atomicAdd(&(bar)[XB_TMO], 1u); break; } } } } while (0)
struct XcdBarrier { unsigned* bar; unsigned x; volatile LAS unsigned* st; };
__device__ __forceinline__ XcdBarrier xcd_barrier_post(unsigned* bar, volatile LAS unsigned* st) {
    XcdBarrier b; b.bar = bar; b.x = xb_xcc_id(); b.st = st;
    if (threadIdx.x == 0) (void)xb_add(&bar[XB_XCNT(b.x)], 1u);
    return b;
}
__device__ __forceinline__ void xcd_barrier_complete(unsigned* bar, unsigned x, unsigned& nloc, unsigned& nx) {
    const unsigned G = gridDim.x * gridDim.y * gridDim.z;
    unsigned sum, cnt, mine, sp = 0u;
    for (;;) {
        sum = 0u; cnt = 0u; mine = 0u;
#pragma unroll
        for (unsigned j = 0; j < 16; ++j) { const unsigned c = xb_ld(&bar[XB_XCNT(j)]); sum += c; cnt += (c > 0u) ? 1u : 0u; }
        mine = xb_ld(&bar[XB_XCNT(x)]);
        if (sum == G) break;
        __builtin_amdgcn_s_sleep(1);
        if ((++sp & 255u) == 0u) { if (xb_ld(&bar[XB_TMO])) break; if (sp > XB_SPIN_CAP) { atomicAdd(&bar[XB_TMO], 1u); break; } }
    }
    nloc = mine > 0u ? mine : 1u; nx = cnt > 0u ? cnt : 1u;
}
__device__ __forceinline__ void xcd_barrier(const XcdBarrier& b) {
    asm volatile("s_waitcnt vmcnt(0)" ::: "memory");
    __syncthreads();
    if (threadIdx.x == 0) {
        unsigned* bar = b.bar;
        __builtin_amdgcn_s_waitcnt(0);
        unsigned nloc = b.st[0], nx = b.st[1];
        if (nloc == 0u) { xcd_barrier_complete(bar, b.x, nloc, nx); b.st[0] = nloc; b.st[1] = nx; }
        const unsigned old = xb_add(&bar[XB_XSUB(b.x)], 1u);
        const unsigned gen = old / nloc;
        if (old + 1u == (gen + 1u) * nloc) {
            __builtin_amdgcn_fence(__ATOMIC_RELEASE, "agent");
            asm volatile("s_waitcnt vmcnt(0)" ::: "memory");
            const unsigned og = xb_add(&bar[XB_TOP], 1u);
            const unsigned tg = og / nx;
            if (og + 1u == (tg + 1u) * nx) xb_add(&bar[XB_TOPGEN], 1u);
            else XB_SPIN(xb_ld(&bar[XB_TOPGEN]) == tg, bar);
            __builtin_amdgcn_fence(__ATOMIC_ACQUIRE, "agent");
            xb_add(&bar[XB_XGEN(b.x)], 1u);
            asm volatile("s_waitcnt vmcnt(0)" ::: "memory");
        } else {
            XB_SPIN(xb_ld(&bar[XB_XGEN(b.x)]) == gen, bar);
            __builtin_amdgcn_fence(__ATOMIC_ACQUIRE, "agent");
            asm volatile("s_waitcnt vmcnt(0)" ::: "memory");
        }
    }
    __syncthreads();
}

namespace pg8 {
constexpr int BM = 256, BK = 64, HALF = 128, HTB = HALF * BK * 2, STAGE_BYTES = 8 * HTB, NXCD = 8, WGM = 8;
__host__ __device__ __forceinline__ int lds_byte(int r, int c) { const int st = (r >> 4) * 2 + (c >> 5), rr = r & 15, cc = c & 31, ob = rr * 64 + cc * 2; return st * 1024 + (ob ^ (((ob >> 9) & 1) << 5)); }
__host__ __device__ __forceinline__ void stage_rc(int b, int& R, int& C) { const int st = b / 1024, sb = b % 1024, swz = sb ^ (((sb >> 9) & 1) << 5); R = (st >> 1) * 16 + swz / 64; C = (st & 1) * 32 + (swz % 64) / 2; }
__host__ __device__ __forceinline__ int perm32(int rho) { const int n = rho >> 4, i = rho & 15; return 8 * (i >> 2) + 4 * n + (i & 3); }
struct Unit { int pm, pn, kd; };
struct Gemm { const bf16_t* A; const bf16_t* Bt; int M, N, K; };
struct StaticOrder {
    int nM, nN, nwg, G, c;
    __host__ __device__ void init(int M, int N, int G_, int c_) { nM = M / BM; nN = N / BM; nwg = nM * nN; G = G_; c = c_; }
    __host__ __device__ bool next(int i, Unit& u) const {
        const long L = (long)i * G + c; if (L >= nwg) return false;
        int wgid = (int)L; { const int q = nwg / NXCD, r = nwg % NXCD, xcd = wgid % NXCD, off = wgid / NXCD; wgid = (xcd < r ? xcd * (q + 1) : r * (q + 1) + (xcd - r) * q) + off; }
        const int nig = WGM * nN, gid = wgid / nig, fm = gid * WGM, gsz = (nM - fm) < WGM ? (nM - fm) : WGM;
        u.pm = fm + ((wgid % nig) % gsz); u.pn = (wgid % nig) / gsz; u.kd = 0; return true;
    }
    __device__ __forceinline__ void a_ready(const Unit&) const {}
    __device__ __forceinline__ void done(const Unit&) const {}
    __device__ __forceinline__ const char* abase(const Gemm& g, const Unit& u, size_t tstep) const { return (const char*)g.A + (size_t)u.pm * tstep; }
    __device__ __forceinline__ const char* bbase(const Gemm& g, const Unit& u, size_t tstep) const { return (const char*)g.Bt + (size_t)u.pn * tstep; }
};
struct LiveRowsOrder : StaticOrder {
    bool skip;
    __host__ __device__ void init2(int N, int G_, int c_, bool skip_) { skip = skip_; init(skip_ ? NB * SEQL : MROWS, N, G_, c_); }
    __host__ __device__ bool next(int i, Unit& u) const { if (!StaticOrder::next(i, u)) return false; if (skip) u.pm = (u.pm >> 4) * 17 + (u.pm & 15); return true; }
};
struct BatchedOrder {
    int nwg, G, c, tpg;
    __host__ __device__ void init(int ng, int tpg_, int G_, int c_) { nwg = ng * tpg_; tpg = tpg_; G = G_; c = c_; }
    __host__ __device__ bool next(int i, Unit& u) const { const int L = i * G + c; if (L >= nwg) return false; u.pm = L; u.pn = L / tpg; u.kd = 0; return true; }
    __device__ __forceinline__ void a_ready(const Unit&) const {}
    __device__ __forceinline__ void done(const Unit&) const {}
    __device__ __forceinline__ const char* abase(const Gemm& g, const Unit& u, size_t tstep) const { return (const char*)g.A + (size_t)u.pm * tstep; }
    __device__ __forceinline__ const char* bbase(const Gemm& g, const Unit& u, size_t tstep) const { return (const char*)g.Bt + (size_t)u.pn * tstep; }
};
struct P3Order {
    const bf16_t *b0, *b1, *wuq, *wuk, *wuv, *ug, *we; int G, c;
    __host__ __device__ bool next(int i, Unit& u) const {
        const int L = i * G + c; if (L >= 1360) return false;
        if (L < 544) { u.kd = 0; u.pm = L >> 1; u.pn = L & 1; } else if (L < 816) { u.kd = 1; u.pm = L - 544; u.pn = 0; } else if (L < 1088) { u.kd = 2; u.pm = 0; u.pn = L - 816; } else { u.kd = 3; u.pm = L - 1088; u.pn = (L - 1088) / 17; }
        return true;
    }
    __device__ __forceinline__ void a_ready(const Unit&) const {}
    __device__ __forceinline__ void done(const Unit&) const {}
    __device__ __forceinline__ const char* abase(const Gemm&, const Unit& u, size_t tstep) const { const bf16_t* p = u.kd == 0 ? b0 : u.kd == 1 ? b1 : u.kd == 2 ? wuv : ug; return (const char*)p + (size_t)u.pm * tstep; }
    __device__ __forceinline__ const char* bbase(const Gemm&, const Unit& u, size_t tstep) const { const bf16_t* p = u.kd == 0 ? wuq : u.kd == 1 ? wuk : u.kd == 2 ? b1 : we; return (const char*)p + (size_t)u.pn * tstep; }
};

struct OneUnit {
    int pm, pn;
    __host__ __device__ bool next(int i, Unit& u) const { if (i) return false; u.pm = pm; u.pn = pn; u.kd = 0; return true; }
    __device__ __forceinline__ void a_ready(const Unit&) const {}
    __device__ __forceinline__ void done(const Unit&) const {}
    __device__ __forceinline__ const char* abase(const Gemm& g, const Unit& u, size_t tstep) const { return (const char*)g.A + (size_t)u.pm * tstep; }
    __device__ __forceinline__ const char* bbase(const Gemm& g, const Unit& u, size_t tstep) const { return (const char*)g.Bt + (size_t)u.pn * tstep; }
};
template <class Epi, class Sched>
__device__ __forceinline__ void gemm_phase(LAS unsigned char* lds, const Gemm g, const Sched& S, const Epi& E, int tid_in) {
    const int tid = tid_in, wid = __builtin_amdgcn_readfirstlane(tid >> 6), lane = tid & 63, wr = wid >> 2, wc = wid & 3, fr = lane & 15, fq = lane >> 4;
    const int K = g.K, nt = K / BK;
    unsigned voffA[2], voffB[2];
#pragma unroll
    for (int i = 0; i < 2; ++i) { int R, C; stage_rc(tid * 16 + i * 8192, R, C); const int Rb = Epi::PERM ? ((R & ~31) + perm32(R & 31)) : R;
        voffA[i] = (unsigned)(R * K + C) * 2u; voffB[i] = (unsigned)(Rb * K + C) * 2u; }
    const size_t kstep = (size_t)(BK * 2);
    const size_t hstep = (size_t)HALF * K * 2;
    const size_t tstep = 2 * hstep;
    const unsigned ldsw = (unsigned)wid * 1024u;
    const int aoff = lds_byte(wr * 64 + fr, fq * 8), boff = lds_byte(wc * 32 + fr, fq * 8);
#define PG8_SA(b, h) (((b) * 2 + (h)) * HTB)
#define PG8_SB(b, h) ((4 + (b) * 2 + (h)) * HTB)
#define PG8_STAGE(bufoff, gbase, voff) do { _Pragma("unroll") for (int _i = 0; _i < 2; ++_i) \
        __builtin_amdgcn_global_load_lds((const unsigned*)((const char*)(gbase) + (voff)[_i]), (LAS unsigned*)(lds + (bufoff) + ldsw + _i * 8192), 16, 0, 0); } while (0)
#define PG8_LDA(dst, b, h) do { _Pragma("unroll") for (int m = 0; m < 4; ++m) _Pragma("unroll") for (int k = 0; k < 2; ++k) dst[m][k] = *(const LAS bf16x8*)(lds + PG8_SA(b, h) + aoff + m * 2048 + k * 1024); } while (0)
#define PG8_LDB(dst, b, h) do { _Pragma("unroll") for (int n = 0; n < 2; ++n) _Pragma("unroll") for (int k = 0; k < 2; ++k) dst[n][k] = *(const LAS bf16x8*)(lds + PG8_SB(b, h) + boff + n * 2048 + k * 1024); } while (0)
#define PG8_MMA(ai, bj, At, Bt) do { __builtin_amdgcn_s_setprio(1); _Pragma("unroll") for (int m = 0; m < 4; ++m) _Pragma("unroll") for (int n = 0; n < 2; ++n) _Pragma("unroll") for (int k = 0; k < 2; ++k) \
        acc[ai][bj][m][n] = __builtin_amdgcn_mfma_f32_16x16x32_bf16(Bt[n][k], At[m][k], acc[ai][bj][m][n], 0, 0, 0); __builtin_amdgcn_s_setprio(0); } while (0)
#define PG8_WAIT_V(n) asm volatile("s_waitcnt vmcnt(" #n ")" ::: "memory")
#define PG8_WAIT_L(n) asm volatile("s_waitcnt lgkmcnt(" #n ")" ::: "memory")
#define PG8_BAR __builtin_amdgcn_s_barrier()
#define PG8_SCHED __builtin_amdgcn_sched_barrier(0)
    Unit cur, nxt; int ui = 0;
    if (!S.next(0, cur)) return;
    f32x4 acc[2][2][4][2];
#pragma unroll
    for (int a = 0; a < 2; ++a)
#pragma unroll
        for (int b = 0; b < 2; ++b)
#pragma unroll
            for (int m = 0; m < 4; ++m)
#pragma unroll
                for (int n = 0; n < 2; ++n) acc[a][b][m][n] = (f32x4){0.f, 0.f, 0.f, 0.f};
    bf16x8 At[4][2], B0[2][2], B1[2][2];
    const char* cA = S.abase(g, cur, tstep); const char* cB = S.bbase(g, cur, tstep);
    S.a_ready(cur);
    PG8_STAGE(PG8_SB(0, 0), cB, voffB); PG8_STAGE(PG8_SA(0, 0), cA, voffA); PG8_STAGE(PG8_SB(0, 1), cB + hstep, voffB); PG8_STAGE(PG8_SA(0, 1), cA + hstep, voffA);
    if (wr == 1) PG8_BAR;
    PG8_WAIT_V(4); PG8_BAR;
    PG8_STAGE(PG8_SB(1, 0), cB + kstep, voffB); PG8_STAGE(PG8_SA(1, 0), cA + kstep, voffA); PG8_STAGE(PG8_SB(1, 1), cB + hstep + kstep, voffB);
    PG8_WAIT_V(6); PG8_BAR;
    for (;;) {
        const bool has_next = S.next(ui + 1, nxt);
        const char* nA = has_next ? S.abase(g, nxt, tstep) : cA; const char* nB = has_next ? S.bbase(g, nxt, tstep) : cB;
        for (int t = 0; t < nt; t += 2) {
            const bool last = (t == nt - 2);
            const char* a1 = cA + (size_t)(t + 1) * kstep;
            const char* a2 = last ? nA : cA + (size_t)(t + 2) * kstep; const char* b2 = last ? nB : cB + (size_t)(t + 2) * kstep;
            const char* a3 = a2 + kstep; const char* b3 = b2 + kstep;
            if (last && has_next) S.a_ready(nxt);
            PG8_LDB(B0, 0, 0); PG8_SCHED; PG8_LDA(At, 0, 0); PG8_STAGE(PG8_SA(1, 1), a1 + hstep, voffA);
            PG8_WAIT_L(8); PG8_BAR; PG8_WAIT_L(0); PG8_MMA(0, 0, At, B0); PG8_BAR; PG8_SCHED;
            PG8_LDB(B1, 0, 1); PG8_STAGE(PG8_SB(0, 0), b2, voffB);
            PG8_BAR; PG8_WAIT_L(0); PG8_MMA(0, 1, At, B1); PG8_BAR;
            PG8_LDA(At, 0, 1); PG8_STAGE(PG8_SA(0, 0), a2, voffA);
            PG8_BAR; PG8_WAIT_L(0); PG8_MMA(1, 0, At, B0); PG8_BAR; PG8_SCHED;
            PG8_STAGE(PG8_SB(0, 1), b2 + hstep, voffB);
            PG8_WAIT_V(6); PG8_BAR; PG8_MMA(1, 1, At, B1); PG8_BAR;
            PG8_LDB(B0, 1, 0); PG8_SCHED; PG8_LDA(At, 1, 0); PG8_STAGE(PG8_SA(0, 1), a2 + hstep, voffA);
            PG8_WAIT_L(8); PG8_BAR; PG8_WAIT_L(0); PG8_MMA(0, 0, At, B0); PG8_BAR; PG8_SCHED;
            PG8_LDB(B1, 1, 1); PG8_STAGE(PG8_SB(1, 0), b3, voffB);
            PG8_BAR; PG8_WAIT_L(0); PG8_MMA(0, 1, At, B1); PG8_BAR;
            PG8_LDA(At, 1, 1); PG8_STAGE(PG8_SA(1, 0), a3, voffA);
            PG8_BAR; PG8_WAIT_L(0); PG8_MMA(1, 0, At, B0); PG8_BAR; PG8_SCHED;
            PG8_STAGE(PG8_SB(1, 1), b3 + hstep, voffB);
            PG8_WAIT_V(6); PG8_BAR; PG8_MMA(1, 1, At, B1); PG8_BAR;
        }
        { const int l2 = lane_id_fresh(); E(acc, cur, wr, wc, l2 & 15, l2 >> 4); } S.done(cur);
        if (!has_next) break;
#pragma unroll
        for (int a = 0; a < 2; ++a)
#pragma unroll
            for (int b = 0; b < 2; ++b)
#pragma unroll
                for (int m = 0; m < 4; ++m)
#pragma unroll
                    for (int n = 0; n < 2; ++n) acc[a][b][m][n] = (f32x4){0.f, 0.f, 0.f, 0.f};
        cur = nxt; cA = nA; cB = nB; ++ui;
    }
    PG8_WAIT_V(0);
    if (wr == 0) PG8_BAR;
    PG8_BAR;
#undef PG8_SA
#undef PG8_SB
#undef PG8_STAGE
#undef PG8_LDA
#undef PG8_LDB
#undef PG8_MMA
#undef PG8_WAIT_V
#undef PG8_WAIT_L
#undef PG8_BAR
#undef PG8_SCHED
}

template <class F> struct EpiWalk {
    static constexpr bool PERM = true, AFTER_DRAIN = false;
    F f;
    __device__ __forceinline__ void operator()(const f32x4 (&acc)[2][2][4][2], const Unit& u, int wr, int wc, int fr, int fq) const {
#pragma unroll
        for (int ai = 0; ai < 2; ++ai)
#pragma unroll
            for (int m = 0; m < 4; ++m) {
                const int rin = ai * HALF + wr * 64 + m * 16 + fr;
#pragma unroll
                for (int bj = 0; bj < 2; ++bj) { const int cin = bj * HALF + wc * 32 + 8 * fq; f.put(u.pm, u.pn, rin, cin, acc[ai][bj][m][0], acc[ai][bj][m][1]); asm volatile("" ::: "memory"); }
            }
    }
};
}

__device__ __forceinline__ u32x4 pack8(const f32x4& a, const f32x4& b) {
    u32x4 w; w.x = cvt_pk_bf16(a[0], a[1]); w.y = cvt_pk_bf16(a[2], a[3]); w.z = cvt_pk_bf16(b[0], b[1]); w.w = cvt_pk_bf16(b[2], b[3]); return w;
}
__device__ __forceinline__ void unpack8(const u32x4 w, float (&o)[8]) {
    o[0] = lo_bf(w.x); o[1] = hi_bf(w.x); o[2] = lo_bf(w.y); o[3] = hi_bf(w.y); o[4] = lo_bf(w.z); o[5] = hi_bf(w.z); o[6] = lo_bf(w.w); o[7] = hi_bf(w.w);
}

struct PutSplit {
    bf16_t* pb;
    __device__ __forceinline__ void put(int pm, int pn, int rin, int cin, const f32x4& a, const f32x4& b) const { *(u32x4*)(pb + (size_t)pn * BLKE + ((size_t)pm * 256 + rin) * 256 + cin) = pack8(a, b); }
};
struct PutPlain {
    bf16_t* dst; int ldc, ncols;
    __device__ __forceinline__ void put(int pm, int pn, int rin, int cin, const f32x4& a, const f32x4& b) const { const int col = pn * 256 + cin; if (col < ncols) *(u32x4*)(dst + ((size_t)pm * 256 + rin) * ldc + col) = pack8(a, b); }
};
struct PutKm {
    bf16_t* km; const bf16_t* kr;
    __device__ __forceinline__ void put(int pm, int pn, int rin, int cin, const f32x4& a, const f32x4& b) const {
        const int bb = pm / 17, key = (pm - bb * 17) * 256 + rin, hd = cin >> 6, d = cin & 63;
        bf16_t* dst = km + ((size_t)(bb * 4 + hd) * NTOK + key) * 96;
        *(u32x4*)(dst + d) = pack8(a, b);
        if (d < 32) *(u32x4*)(dst + 64 + d) = *(const u32x4*)(kr + ((size_t)pm * 256 + rin) * 32 + d);
    }
};
struct PutVt {
    bf16_t* vt;
    __device__ __forceinline__ void put(int pm, int pn, int rin, int cin, const f32x4& a, const f32x4& b) const {
        const int bb = pn / 17, key = (pn - bb * 17) * 256 + cin;
        *(u32x4*)(vt + ((size_t)(bb * 4 + (rin >> 6)) * 64 + (rin & 63)) * NTOK + key) = pack8(a, b);
    }
};
struct PutE {
    bf16_t* e;
    __device__ __forceinline__ void put(int pm, int pn, int rin, int cin, const f32x4& a, const f32x4& b) const { *(u32x4*)(e + ((size_t)pm * 256 + rin) * 256 + cin) = pack8(a, b); }
};
struct PutSsmY {
    bf16_t* zs; const bf16_t* ug; const float* dskip;
    __device__ __forceinline__ void put(int pm, int pn, int rin, int cin, const f32x4& a, const f32x4& b) const {
        const int g = pn, n = (pm - g * 17) * 256 + rin, tok = n * 16 + (cin >> 4), ho = cin & 15, ch = g * 16 + ho;
        float u[8]; unpack8(*(const u32x4*)(ug + ((size_t)g * MROWS + tok) * 16 + ho), u);
        const f32x4 d0 = *(const f32x4*)(dskip + ch), d1 = *(const f32x4*)(dskip + ch + 4);
        f32x4 y0, y1;
#pragma unroll
        for (int i = 0; i < 4; ++i) { y0[i] = gelu_tanh(a[i] + d0[i] * u[i]); y1[i] = gelu_tanh(b[i] + d1[i] * u[4 + i]); }
        *(u32x4*)(zs + (size_t)tok * 256 + ch) = pack8(y0, y1);
    }
};
struct PutGlu {
    bf16_t* cat; const bf16_t* zs; const bf16_t* gate; const float* gb;
    __device__ __forceinline__ void put(int pm, int pn, int rin, int cin, const f32x4& a, const f32x4& b) const {
        const size_t row = (size_t)pm * 256 + rin; const int col = cin;
        float z[8], gt[8]; unpack8(*(const u32x4*)(zs + row * 256 + col), z); unpack8(*(const u32x4*)(gate + row * 256 + col), gt);
        const f32x4 b0 = *(const f32x4*)(gb + col), b1 = *(const f32x4*)(gb + col + 4);
        f32x4 y0, y1;
#pragma unroll
        for (int i = 0; i < 4; ++i) { y0[i] = z[i] * sigmf(a[i] + b0[i]) * siluf(gt[i]); y1[i] = z[4 + i] * sigmf(b[i] + b1[i]) * siluf(gt[4 + i]); }
        *(u32x4*)(cat + row * DM + 512 + col) = pack8(y0, y1);
    }
};

struct EpiInProj {
    static constexpr bool PERM = true, AFTER_DRAIN = false;
    bf16_t *pb, *ug, *us, *vtg, *hy0;
    LAS unsigned char* scratch;
    __device__ __forceinline__ void operator()(const f32x4 (&acc)[2][2][4][2], const pg8::Unit& u, int wr, int wc, int fr, int fq) const {
        const int pn = u.pn, pm = u.pm;
        const int bb = pm / 17, jt = (pm - bb * 17) * 256;
        LAS unsigned char* sw = scratch + (wr * 4 + wc) * 1280;
        const int ln = fq * 16 + fr, tch = ln >> 1, thalf = ln & 1;
#pragma unroll
        for (int ai = 0; ai < 2; ++ai)
#pragma unroll
            for (int m = 0; m < 4; ++m) {
                const int rin = ai * pg8::HALF + wr * 64 + m * 16 + fr;
#pragma unroll
                for (int bj = 0; bj < 2; ++bj) {
                    const int cin = bj * pg8::HALF + wc * 32 + 8 * fq;
                    const u32x4 w = pack8(acc[ai][bj][m][0], acc[ai][bj][m][1]);
                    const bool plain = pn < 4 || pn == 5 || pn == 7 || (pn == 4 && bj == 0);
                    if (plain) { *(u32x4*)(pb + (size_t)pn * BLKE + ((size_t)pm * 256 + rin) * 256 + cin) = w; }
                    else if (pn == 6) { const size_t row = (size_t)pm * 256 + rin; const int g = cin >> 4, hi0 = cin & 15;
                        *(u32x4*)(ug + ((size_t)g * MROWS + row) * 16 + hi0) = w;
                        *(u32x4*)(us + ((size_t)g * NCHUNK + (row >> 4)) * 512 + (row & 15) * 16 + hi0) = w; }
                    else {
                        *(LAS u32x4*)(sw + fr * 80 + fq * 16) = w;
                        asm volatile("" ::: "memory");
                        unsigned short e[8];
#pragma unroll
                        for (int i = 0; i < 8; ++i) e[i] = *(const LAS unsigned short*)(sw + (thalf * 8 + i) * 80 + tch * 2);
                        asm volatile("" ::: "memory");
                        u32x4 t; t.x = e[0] | ((unsigned)e[1] << 16); t.y = e[2] | ((unsigned)e[3] << 16); t.z = e[4] | ((unsigned)e[5] << 16); t.w = e[6] | ((unsigned)e[7] << 16);
                        const int chn = bj * pg8::HALF + wc * 32 + tch;
                        const int tok = jt + ai * pg8::HALF + wr * 64 + m * 16 + thalf * 8;
                        bf16_t* dst = (pn == 4) ? vtg + ((size_t)(bb * 2 + ((chn - 128) >> 6)) * 64 + ((chn - 128) & 63)) * NTOK + tok
                                                : hy0 + (size_t)(pn - 8) * BLKE + ((size_t)chn * 16 + bb) * NTOK + tok;
                        *(u32x4*)dst = t;
                    }
                    asm volatile("" ::: "memory");
                }
            }
    }
};

struct EpiP3 {
    static constexpr bool PERM = true, AFTER_DRAIN = false;
    PutPlain q; PutKm k; PutVt v; PutE e;
    __device__ __forceinline__ void operator()(const f32x4 (&acc)[2][2][4][2], const pg8::Unit& u, int wr, int wc, int fr, int fq) const {
#pragma unroll
        for (int ai = 0; ai < 2; ++ai)
#pragma unroll
            for (int m = 0; m < 4; ++m) {
                const int rin = ai * pg8::HALF + wr * 64 + m * 16 + fr;
#pragma unroll
                for (int bj = 0; bj < 2; ++bj) { const int cin = bj * pg8::HALF + wc * 32 + 8 * fq;
                    if (u.kd == 0) q.put(u.pm, u.pn, rin, cin, acc[ai][bj][m][0], acc[ai][bj][m][1]);
                    else if (u.kd == 1) k.put(u.pm, u.pn, rin, cin, acc[ai][bj][m][0], acc[ai][bj][m][1]);
                    else if (u.kd == 2) v.put(u.pm, u.pn, rin, cin, acc[ai][bj][m][0], acc[ai][bj][m][1]);
                    else e.put(u.pm, u.pn, rin, cin, acc[ai][bj][m][0], acc[ai][bj][m][1]);
                    asm volatile("" ::: "memory"); }
            }
    }
};

struct Params {
    const float* in[36];
    float* out;
    unsigned char* ws;
    int ph_lo, ph_hi, dry, pad;
};
enum { I_X = 0, I_C, I_CTX, I_CCTX, I_WMOD, I_BMOD, I_GPRE, I_GPOST, I_WIN, I_WOUT, I_GCQ, I_WUQ, I_GCKV, I_WUKV, I_GQ, I_GK,
       I_LRE, I_LIM, I_LSTEP, I_BRE, I_BIM, I_CRE, I_CIM, I_SSMD, I_GLUW, I_GLUB, I_HCW, I_HCB, I_HW1, I_HB1, I_HF1, I_HW2, I_HB2, I_HF2, I_HW3, I_HBIAS };

typedef __attribute__((address_space(4))) const unsigned long long* kargp_t;
struct Ctx {
    LAS unsigned char* lds;
    kargp_t ka;
    unsigned char* ws;
    int tid, lane, wave, G, bid, dry;
};
#define GAS __attribute__((address_space(1)))
#define KIN(i) ((const float*)(GAS const float*)c.ka[(i)])
#define KOUT() ((float*)(GAS float*)c.ka[36])
template <class T> __device__ __forceinline__ T* wsp(const Ctx& c, size_t off) { return (T*)(c.ws + off); }

__device__ __forceinline__ int wmap(int kind, int n) {
    if (kind == 0) { if (n < 192) return n; if (n < 224) return 320 + (n - 192); if (n < 256) return -1; if (n < 384) return 192 + (n - 256); if (n < 512) return -1; return n - 160; }
    if (kind == 2) return (n >> 6) * 128 + (n & 63);
    if (kind == 3) return (n >> 6) * 128 + 64 + (n & 63);
    return n;
}
__device__ __forceinline__ void wconv_tile(const Ctx& c, const float* src, int Ks, int Ns, int Nlim, bf16_t* dst, int Kp, int kind, int nt, int kt) {
    LAS float* T = (LAS float*)c.lds;
    const int n0 = nt * 64, k0 = kt * 128;
    const int nn = c.tid & 63, kk0 = c.tid >> 6; const int n = n0 + nn; const int sc = (n < Nlim) ? wmap(kind, n) : -1;
    float v[16];
#pragma unroll
    for (int i = 0; i < 16; ++i) { const int k = k0 + kk0 + 8 * i; v[i] = (k < Ks && sc >= 0) ? src[(size_t)k * Ns + sc] : 0.f; }
#pragma unroll
    for (int i = 0; i < 16; ++i) T[(kk0 + 8 * i) * 65 + nn] = v[i];
    __syncthreads();
#pragma unroll
    for (int i = 0; i < 2; ++i) { const int e = c.tid + i * 512, row = e >> 4, pc = e & 15; float x[8];
#pragma unroll
        for (int j = 0; j < 8; ++j) x[j] = T[(pc * 8 + j) * 65 + row];
        u32x4 w; w.x = cvt_pk_bf16(x[0], x[1]); w.y = cvt_pk_bf16(x[2], x[3]); w.z = cvt_pk_bf16(x[4], x[5]); w.w = cvt_pk_bf16(x[6], x[7]);
        *(u32x4*)(dst + (size_t)(n0 + row) * Kp + k0 + pc * 8) = w; }
    __syncthreads();
}

__device__ __forceinline__ void modv_job(const Ctx& c, int job) {
    const int l = job / 48, j0 = (job % 48) * 64;
    LAS float* sc = (LAS float*)c.lds;
    LAS float* red = sc + 17 * 1024;
    const float* cv = KIN(I_C); const float* cc = KIN(I_CCTX);
    for (int e = c.tid; e < 17 * 1024; e += 512) { const int r = e >> 10, k = e & 1023; const float v = (r < 16) ? cv[r * 1024 + k] : cc[k]; sc[e] = siluf(v); }
    __syncthreads();
    const int col = c.tid & 63, ks = c.tid >> 6;
    const float* w = KIN(I_WMOD) + (size_t)l * 1024 * 3072 + j0 + col;
    float acc[17];
#pragma unroll
    for (int r = 0; r < 17; ++r) acc[r] = 0.f;
    for (int k = ks * 128; k < ks * 128 + 128; ++k) { const float wv = w[(size_t)k * 3072];
#pragma unroll
        for (int r = 0; r < 17; ++r) acc[r] += sc[r * 1024 + k] * wv; }
#pragma unroll
    for (int r = 0; r < 17; ++r) red[(ks * 17 + r) * 64 + col] = acc[r];
    __syncthreads();
    float* mv = wsp<float>(c, WS_MODV);
    for (int e = c.tid; e < 17 * 64; e += 512) { const int r = e >> 6, cl = e & 63; float s = KIN(I_BMOD)[l * 3072 + j0 + cl];
#pragma unroll
        for (int q = 0; q < 8; ++q) s += red[(q * 17 + r) * 64 + cl];
        mv[((size_t)l * 17 + r) * 3072 + j0 + cl] = s; }
    __syncthreads();
}

__device__ __forceinline__ void rope_job(const Ctx& c) {
    float* rg = wsp<float>(c, WS_ROPEG); float* rm = wsp<float>(c, WS_ROPEM);
    for (int e = c.tid; e < 64 * 16; e += 512) { const int pos = e >> 4, f = e & 15; const float inv = powf(10000.f, -(float)(2 * f) / 32.f); const float a = (float)pos * inv; rg[e * 2] = cosf(a); rg[e * 2 + 1] = sinf(a); }
    for (int e = c.tid; e < 64 * 8; e += 512) { const int pos = e >> 3, f = e & 7; const float inv = powf(10000.f, -(float)(2 * f) / 16.f); const float a = (float)pos * inv; rm[e * 2] = cosf(a); rm[e * 2 + 1] = sinf(a); }
}

typedef float cpx __attribute__((ext_vector_type(2)));
#define CPX(a, b) ((cpx){(a), (b)})
__device__ __forceinline__ cpx cmul(cpx a, cpx b) { return CPX(a.x * b.x - a.y * b.y, a.x * b.y + a.y * b.x); }
__device__ __forceinline__ void ssm_tables_job(const Ctx& c, int job) {
    const int l = job >> 4, g = job & 15;
    LAS cpx* apow = (LAS cpx*)c.lds;
    LAS cpx* bbar = apow + 2 * 17 * 64;
    LAS cpx* cm = bbar + 2 * 64 * 16;
    LAS float* Kc = (LAS float*)(cm + 2 * 16 * 64);
    for (int e = c.tid; e < 2 * 64; e += 512) {
        const int d = e >> 6, p = e & 63; const size_t ix = (((size_t)l * 2 + d) * 16 + g) * 64 + p;
        const float lr = KIN(I_LRE)[ix], li = KIN(I_LIM)[ix], st = expf(KIN(I_LSTEP)[((size_t)l * 2 + d) * 16 + g]);
        for (int k = 0; k <= 16; ++k) { const float m = expf(lr * st * (float)k), an = li * st * (float)k; apow[(d * 17 + k) * 64 + p] = CPX(m * cosf(an), m * sinf(an)); }
    }
    __syncthreads();
    for (int e = c.tid; e < 2 * 64 * 16; e += 512) {
        const int d = e >> 10, p = (e >> 4) & 63, h = e & 15; const size_t ix = (((size_t)l * 2 + d) * 16 + g) * 64 + p;
        const float lr = KIN(I_LRE)[ix], li = KIN(I_LIM)[ix];
        const cpx a = apow[(d * 17 + 1) * 64 + p]; const cpx am1 = CPX(a.x - 1.f, a.y);
        const float den = lr * lr + li * li; const cpx q = CPX((am1.x * lr + am1.y * li) / den, (am1.y * lr - am1.x * li) / den);
        const cpx b = CPX(KIN(I_BRE)[ix * 16 + h], KIN(I_BIM)[ix * 16 + h]);
        bbar[e] = cmul(q, b);
        const size_t cx = ((((size_t)l * 2 + d) * 16 + g) * 16 + h) * 64 + p;
        cm[(d * 16 + h) * 64 + p] = CPX(KIN(I_CRE)[cx], KIN(I_CIM)[cx]);
    }
    __syncthreads();
    for (int e = c.tid; e < 2 * 16 * 256; e += 512) {
        const int d = e >> 12, dd = (e >> 8) & 15, ho = (e >> 4) & 15, hi = e & 15; float s = 0.f;
        for (int p = 0; p < 64; ++p) { const cpx w = cmul(cm[(d * 16 + ho) * 64 + p], apow[(d * 17 + dd) * 64 + p]); const cpx b = bbar[(d * 64 + p) * 16 + hi]; s += w.x * b.x - w.y * b.y; }
        Kc[e] = s;
    }
    __syncthreads();
    bf16_t* wkc = wsp<bf16_t>(c, WS_WKC) + ((size_t)l * 16 + g) * 256 * 512;
    for (int e = c.tid; e < 256 * 512; e += 512) {
        const int r = e >> 9, q = e & 511, i = r >> 4, ho = r & 15; float v;
        if (q < 256) { const int j = q >> 4, hi = q & 15; v = 0.f; if (j <= i) v += Kc[((0 * 16 + (i - j)) * 16 + ho) * 16 + hi]; if (j >= i) v += Kc[((1 * 16 + (j - i)) * 16 + ho) * 16 + hi]; }
        else { const int qq = q - 256, dq = qq >> 7, comp = (qq >> 6) & 1, p = qq & 63, k = dq == 0 ? i + 1 : 16 - i; const cpx w = cmul(cm[(dq * 16 + ho) * 64 + p], apow[(dq * 17 + k) * 64 + p]); v = comp == 0 ? w.x : -w.y; }
        wkc[e] = f2bf(v);
    }
    bf16_t* we = wsp<bf16_t>(c, WS_WE) + ((size_t)l * 16 + g) * 256 * 256;
    for (int e = c.tid; e < 256 * 256; e += 512) {
        const int qq = e >> 8, cidx = e & 255, j = cidx >> 4, hi = cidx & 15, dq = qq >> 7, comp = (qq >> 6) & 1, p = qq & 63, k = dq == 0 ? 15 - j : j;
        const cpx w = cmul(apow[(dq * 17 + k) * 64 + p], bbar[(dq * 64 + p) * 16 + hi]);
        we[e] = f2bf(comp == 0 ? w.x : w.y);
    }
    float* a16 = wsp<float>(c, WS_A16);
    for (int e = c.tid; e < 128; e += 512) { const int d = e >> 6, p = e & 63; const cpx a = apow[(d * 17 + 16) * 64 + p]; const size_t ix = ((((size_t)l * 2 + d) * 16 + g) * 64 + p) * 2; a16[ix] = a.x; a16[ix + 1] = a.y; }
    __syncthreads();
}

__device__ __forceinline__ void hyena_mlp_job(const Ctx& c, int job) {
    const int l = job / 136, tt = job % 136;
    const bool isctx = tt >= 128; const int n = isctx ? CTXL : SEQL; const int t0 = isctx ? (tt - 128) * 32 : tt * 32;
    LAS float* z = (LAS float*)c.lds;
    LAS float* h1 = z + 32 * 36;
    LAS float* h2 = h1 + 32 * 64;
    for (int e = c.tid; e < 32 * 33; e += 512) {
        const int ti = e / 33, f = e % 33, t = t0 + ti; float v;
        if (f == 0) v = (float)t / (float)(n - 1);
        else { const int k = (f - 1) & 15; const float band = 1e-4f + (float)k * ((15.f - 1e-4f) / 15.f); const float om = 6.283185307179586f * (float)t / (float)n; v = (f <= 16) ? cosf(band * om) : -sinf(band * om); }
        z[ti * 36 + f] = v;
    }
    __syncthreads();
    for (int e = c.tid; e < 32 * 64; e += 512) {
        const int ti = e >> 6, j = e & 63; float s = KIN(I_HB1)[l * 64 + j];
        for (int f = 0; f < 33; ++f) s += z[ti * 36 + f] * KIN(I_HW1)[((size_t)l * 33 + f) * 64 + j];
        h1[e] = sinf(KIN(I_HF1)[l * 64 + j] * s);
    }
    __syncthreads();
    for (int e = c.tid; e < 32 * 64; e += 512) {
        const int ti = e >> 6, j = e & 63; float s = KIN(I_HB2)[l * 64 + j];
        for (int f = 0; f < 64; ++f) s += h1[ti * 64 + f] * KIN(I_HW2)[((size_t)l * 64 + f) * 64 + j];
        h2[e] = sinf(KIN(I_HF2)[l * 64 + j] * s);
    }
    __syncthreads();
    float* hT = wsp<float>(c, WS_HT) + (size_t)l * 1024 * NTOK;
    const float mind = -3.070113457325394f, maxd = -15.35056728662697f;
#pragma unroll
    for (int cc = 0; cc < 2; ++cc) {
        const int col = c.tid + cc * 512;
        float acc[32];
#pragma unroll
        for (int ti = 0; ti < 32; ++ti) acc[ti] = 0.f;
        for (int f = 0; f < 64; ++f) { const float w = KIN(I_HW3)[((size_t)l * 64 + f) * 1024 + col];
#pragma unroll
            for (int ti = 0; ti < 32; ++ti) acc[ti] += h2[ti * 64 + f] * w; }
        const int ch = col & 255; const float delta = fabsf(mind + (maxd - mind) * (float)ch / 255.f);
        float* dst = hT + (size_t)col * NTOK + (isctx ? SEQL : 0) + t0;
#pragma unroll
        for (int ti = 0; ti < 32; ++ti) { const float tn = (float)(t0 + ti) / (float)(n - 1); dst[ti] = acc[ti] * expf(-tn * delta); }
    }
    __syncthreads();
}

__device__ __forceinline__ void hyena_pack_job(const Ctx& c, int job) {
    const int l = job >> 9, o = (job >> 8) & 1, ch = job & 255;
    const float* hT = wsp<float>(c, WS_HT) + (size_t)l * 1024 * NTOK;
    const float* fw = hT + (size_t)(o * 512 + ch) * NTOK; const float* bw = hT + (size_t)(o * 512 + 256 + ch) * NTOK;
    LAS float* red = (LAS float*)c.lds;
    float s0 = 0.f, s1 = 0.f;
    for (int t = c.tid; t < SEQL; t += 512) { const float a = fw[t], b = bw[t]; s0 += a * a + b * b; }
    if (c.tid < CTXL) { const float a = fw[SEQL + c.tid], b = bw[SEQL + c.tid]; s1 = a * a + b * b; }
    s0 = wave_sum(s0); s1 = wave_sum(s1);
    if (c.lane == 0) { red[c.wave] = s0; red[8 + c.wave] = s1; }
    __syncthreads();
    float t0 = 0.f, t1 = 0.f;
#pragma unroll
    for (int w = 0; w < 8; ++w) { t0 += red[w]; t1 += red[8 + w]; }
    const float r0 = rsqrtf(t0 + EPS), r1 = rsqrtf(t1 + EPS);
    bf16_t* gr = wsp<bf16_t>(c, WS_GR) + (((size_t)l * 2 + o) * 256 + ch) * 8192;
    for (int e = c.tid; e < 8192; e += 512) { float v; if (e <= 4095) v = fw[4095 - e]; else if (e < 8191) v = bw[e - 4095]; else v = 0.f; gr[e] = f2bf(v * r0); }
    bf16_t* grc = wsp<bf16_t>(c, WS_GRC) + (((size_t)l * 2 + o) * 256 + ch) * 512;
    { const int e = c.tid; float v; if (e <= 255) v = fw[SEQL + 255 - e]; else if (e < 511) v = bw[SEQL + e - 255]; else v = 0.f; grc[e] = f2bf(v * r1); }
    __syncthreads();
}

__device__ __forceinline__ void norm_rows(const Ctx& c, int l  , int next  ) {
    const float* mvl = wsp<float>(c, WS_MODV) + (size_t)(l < 0 ? 0 : l) * 17 * 3072;
    const float* mvn = wsp<float>(c, WS_MODV) + (size_t)(next < 0 ? 0 : next) * 17 * 3072;
    const bf16_t* outb = wsp<bf16_t>(c, WS_OUTB);
    bf16_t* hb = wsp<bf16_t>(c, WS_HCAT);
    float* ctxr = wsp<float>(c, WS_CTXR);
    const float* xin0 = KIN(I_X); const float* cin0 = KIN(I_CTX); float* outp = KOUT();
    const float* gpost = KIN(I_GPOST) + (l < 0 ? 0 : l) * DM; const float* gpre = KIN(I_GPRE) + (next < 0 ? 0 : next) * DM;
    const int nw = c.G * 8, lane4 = c.lane * 4;
    for (int rowb = (c.bid * 8 + c.wave) * 2; rowb < MROWS; rowb += nw * 2) {
        f32x4 xv[2][4]; u32x2 ow[2][4]; const float* xin[2]; float* xout[2]; int mr[2]; bool live[2], isc[2];
#pragma unroll
        for (int rr = 0; rr < 2; ++rr) {
            const int row = rowb + rr, b = row / NTOK, j = row - b * NTOK; isc[rr] = j >= SEQL; live[rr] = !(next < 0 && isc[rr]); mr[rr] = isc[rr] ? 16 : b;
            if (isc[rr]) { xout[rr] = ctxr + ((size_t)b * CTXL + (j - SEQL)) * DM; xin[rr] = (l < 0) ? cin0 + ((size_t)b * CTXL + (j - SEQL)) * DM : xout[rr]; }
            else { xout[rr] = outp + ((size_t)b * SEQL + j) * DM; xin[rr] = (l <= 0) ? xin0 + ((size_t)b * SEQL + j) * DM : xout[rr]; }
#pragma unroll
            for (int q = 0; q < 4; ++q) { xv[rr][q] = __builtin_nontemporal_load((const f32x4*)(xin[rr] + q * 256 + lane4)); if (l >= 0) ow[rr][q] = *(const u32x2*)(outb + (size_t)row * DM + q * 256 + lane4); }
        }
#pragma unroll
        for (int rr = 0; rr < 2; ++rr) {
            if (!live[rr]) continue;
            const int row = rowb + rr;
            if (l >= 0) {
                float ov[16]; float ss = 0.f;
#pragma unroll
                for (int q = 0; q < 4; ++q) { ov[q * 4] = lo_bf(ow[rr][q].x); ov[q * 4 + 1] = hi_bf(ow[rr][q].x); ov[q * 4 + 2] = lo_bf(ow[rr][q].y); ov[q * 4 + 3] = hi_bf(ow[rr][q].y); }
#pragma unroll
                for (int i = 0; i < 16; ++i) ss += ov[i] * ov[i];
                ss = wave_sum(ss); const float rs = rsqrtf(ss * (1.f / DM) + EPS);
#pragma unroll
                for (int q = 0; q < 4; ++q) { const int col = q * 256 + lane4; const f32x4 gp = *(const f32x4*)(gpost + col); const f32x4 gt = *(const f32x4*)(mvl + mr[rr] * 3072 + 2048 + col);
#pragma unroll
                    for (int i = 0; i < 4; ++i) xv[rr][q][i] += gt[i] * (ov[q * 4 + i] * rs * gp[i]); }
            }
            if ((l >= 0 || isc[rr]) && !c.dry) {
#pragma unroll
                for (int q = 0; q < 4; ++q) __builtin_nontemporal_store(xv[rr][q], (f32x4*)(xout[rr] + q * 256 + lane4));
            }
            if (next >= 0) {
                float ss = 0.f;
#pragma unroll
                for (int q = 0; q < 4; ++q)
#pragma unroll
                    for (int i = 0; i < 4; ++i) ss += xv[rr][q][i] * xv[rr][q][i];
                ss = wave_sum(ss); const float rs = rsqrtf(ss * (1.f / DM) + EPS);
#pragma unroll
                for (int q = 0; q < 4; ++q) { const int col = q * 256 + lane4; const f32x4 gp = *(const f32x4*)(gpre + col);
                    const f32x4 sh = *(const f32x4*)(mvn + mr[rr] * 3072 + col), sc = *(const f32x4*)(mvn + mr[rr] * 3072 + 1024 + col);
                    float hv[4];
#pragma unroll
                    for (int i = 0; i < 4; ++i) hv[i] = xv[rr][q][i] * rs * gp[i] * (1.f + sc[i]) + sh[i];
                    u32x2 w; w.x = cvt_pk_bf16(hv[0], hv[1]); w.y = cvt_pk_bf16(hv[2], hv[3]); *(u32x2*)(hb + (size_t)row * DM + col) = w; }
            }
        }
    }
}

__device__ __forceinline__ void p2_rows(const Ctx& c, int l) {
    bf16_t* pb = wsp<bf16_t>(c, WS_PB);
    bf16_t* B0 = pb; bf16_t* B1 = pb + BLKE; bf16_t* B3 = pb + 3 * BLKE; const bf16_t* B4 = pb + 4 * BLKE; const bf16_t* B6 = pb + 6 * BLKE;
    bf16_t* kr = wsp<bf16_t>(c, WS_KR); bf16_t* kg = wsp<bf16_t>(c, WS_KG); bf16_t* ug = wsp<bf16_t>(c, WS_UG); bf16_t* us = wsp<bf16_t>(c, WS_US);
    const float* ropeG = wsp<float>(c, WS_ROPEG); const float* ropeM = wsp<float>(c, WS_ROPEM);
    const int lane = c.lane;
    const f32x4 gcq = (lane < 48) ? *(const f32x4*)(KIN(I_GCQ) + l * 192 + lane * 4) : (f32x4){0.f, 0.f, 0.f, 0.f};
    const f32x4 gckv = (lane < 32) ? *(const f32x4*)(KIN(I_GCKV) + l * 128 + lane * 4) : (f32x4){0.f, 0.f, 0.f, 0.f};
    const f32x4 gq = *(const f32x4*)(KIN(I_GQ) + l * 64 + (lane & 15) * 4), gk = *(const f32x4*)(KIN(I_GK) + l * 64 + (lane & 15) * 4);
    for (int rowb = (c.bid * 8 + c.wave) * 4; rowb < MROWS; rowb += c.G * 8 * 4) {
        u32x2 w0[4], w1[4], w3[4], w4[4];
#pragma unroll
        for (int rr = 0; rr < 4; ++rr) { const size_t ro = (size_t)(rowb + rr) * 256 + lane * 4;
            w0[rr] = *(const u32x2*)(B0 + ro); w1[rr] = *(const u32x2*)(B1 + ro); w3[rr] = *(const u32x2*)(B3 + ro); w4[rr] = *(const u32x2*)(B4 + ro); }
#pragma unroll
        for (int rr = 0; rr < 4; ++rr) {
            const int row = rowb + rr;
            const int b = row / NTOK, j = row - b * NTOK; const bool islat = j < SEQL; const int rowpos = (j >> 6) & 63, colpos = j & 63;
            const size_t ro = (size_t)row * 256 + lane * 4;
            {
                const u32x2 w = w0[rr]; float x[4] = {lo_bf(w.x), hi_bf(w.x), lo_bf(w.y), hi_bf(w.y)};
                float ss = (lane < 48) ? (x[0] * x[0] + x[1] * x[1] + x[2] * x[2] + x[3] * x[3]) : 0.f; ss = wave_sum(ss);
                const float rs = rsqrtf(ss * (1.f / 192.f) + EPS);
                float xp[4];
#pragma unroll
                for (int i = 0; i < 4; ++i) xp[i] = swz_xor<2>(x[i]);
                u32x2 o; o.x = 0u; o.y = 0u;
                if (lane < 48) { o.x = cvt_pk_bf16(x[0] * rs * gcq[0], x[1] * rs * gcq[1]); o.y = cvt_pk_bf16(x[2] * rs * gcq[2], x[3] * rs * gcq[3]); }
                else if (lane < 56) {
                    const int t = lane - 48; float y[4];
                    if (islat) { const int pos = (t & 4) ? colpos : rowpos; const bool isx2 = (t & 2) != 0;
#pragma unroll
                        for (int i = 0; i < 4; ++i) { const int f = 4 * (t & 1) + i; const float cs = ropeM[(pos * 8 + f) * 2], sn = ropeM[(pos * 8 + f) * 2 + 1]; y[i] = isx2 ? (xp[i] * sn + x[i] * cs) : (x[i] * cs - xp[i] * sn); } }
                    else {
#pragma unroll
                        for (int i = 0; i < 4; ++i) y[i] = x[i]; }
                    u32x2 kk; kk.x = cvt_pk_bf16(y[0], y[1]); kk.y = cvt_pk_bf16(y[2], y[3]); *(u32x2*)(kr + (size_t)row * 32 + t * 4) = kk;
                }
                if (!c.dry) *(u32x2*)(B0 + ro) = o;
            }
            {
                const u32x2 w = w1[rr]; float x[4] = {lo_bf(w.x), hi_bf(w.x), lo_bf(w.y), hi_bf(w.y)};
                float ss = (lane < 32) ? (x[0] * x[0] + x[1] * x[1] + x[2] * x[2] + x[3] * x[3]) : 0.f; ss = wave_sum(ss);
                const float rs = rsqrtf(ss * (1.f / 128.f) + EPS);
                u32x2 o; o.x = 0u; o.y = 0u;
                if (lane < 32) { o.x = cvt_pk_bf16(x[0] * rs * gckv[0], x[1] * rs * gckv[1]); o.y = cvt_pk_bf16(x[2] * rs * gckv[2], x[3] * rs * gckv[3]); }
                if (!c.dry) *(u32x2*)(B1 + ro) = o;
            }
#pragma unroll
            for (int which = 0; which < 2; ++which) {
                const u32x2 w = which == 0 ? w3[rr] : w4[rr]; float x[4] = {lo_bf(w.x), hi_bf(w.x), lo_bf(w.y), hi_bf(w.y)};
                float ss = x[0] * x[0] + x[1] * x[1] + x[2] * x[2] + x[3] * x[3];
                ss += swz_xor<1>(ss); ss += swz_xor<2>(ss); ss += swz_xor<4>(ss); ss += swz_xor<8>(ss);
                const float rs = rsqrtf(ss * (1.f / 64.f) + EPS);
                const int t = lane & 15; const f32x4 g = which == 0 ? gq : gk;
#pragma unroll
                for (int i = 0; i < 4; ++i) x[i] = x[i] * rs * g[i];
                float xp[4];
#pragma unroll
                for (int i = 0; i < 4; ++i) xp[i] = swz_xor<4>(x[i]);
                if (islat) { const int pos = (t & 8) ? colpos : rowpos; const bool isx2 = (t & 4) != 0;
#pragma unroll
                    for (int i = 0; i < 4; ++i) { const int f = 4 * (t & 3) + i; const float cs = ropeG[(pos * 16 + f) * 2], sn = ropeG[(pos * 16 + f) * 2 + 1]; x[i] = isx2 ? (xp[i] * sn + x[i] * cs) : (x[i] * cs - xp[i] * sn); } }
                if (which == 0) { const float qs = 0.125f * LOG2E; u32x2 o; o.x = cvt_pk_bf16(x[0] * qs, x[1] * qs); o.y = cvt_pk_bf16(x[2] * qs, x[3] * qs); if (!c.dry) *(u32x2*)(B3 + ro) = o; }
                else if (lane < 32) { u32x2 o; o.x = cvt_pk_bf16(x[0], x[1]); o.y = cvt_pk_bf16(x[2], x[3]); *(u32x2*)(kg + ((size_t)(b * 2 + (lane >> 4)) * NTOK + j) * 64 + t * 4) = o; }
            }
        }
    }
}
__device__ __forceinline__ void p2_tiles(const Ctx& c, int l) {
    const bf16_t* pb = wsp<bf16_t>(c, WS_PB);
    bf16_t* vtg = wsp<bf16_t>(c, WS_VTG);
    LAS bf16_t* T = (LAS bf16_t*)c.lds;
    LAS unsigned* T32 = (LAS unsigned*)c.lds;
    const int piece = c.tid & 7, chl = c.tid >> 3;
    const float* hcw = KIN(I_HCW) + (size_t)l * 3 * 768; const float* hcb = KIN(I_HCB) + l * 768;
    u32x4 pre[5];
#define P2T_LOAD(tl_, s_) do { const int b_ = (tl_) / 68, jt_ = (tl_) - b_ * 68, j0_ = jt_ * 64; const int lo_ = jt_ < 64 ? 0 : SEQL, hi_ = jt_ < 64 ? SEQL : NTOK; const size_t rb_ = (size_t)b_ * NTOK; \
        _Pragma("unroll") for (int k_ = 0; k_ < 5; ++k_) { const int e_ = c.tid + k_ * 512; pre[k_] = (u32x4){0u, 0u, 0u, 0u}; \
            if ((s_) == 0) { if (e_ < 64 * 16) { const int r_ = e_ >> 4, pc_ = e_ & 15; pre[k_] = *(const u32x4*)(pb + 4 * BLKE + (rb_ + j0_ + r_) * 256 + 128 + pc_ * 8); } } \
            else if (e_ < 66 * 32) { const int r_ = e_ >> 5, pc_ = e_ & 31, j_ = j0_ - 1 + r_; if (j_ >= lo_ && j_ < hi_) pre[k_] = *(const u32x4*)(pb + (size_t)(7 + (s_)) * BLKE + (rb_ + j_) * 256 + pc_ * 8); } } } while (0)
    int tl = c.bid, st = 0;
    if (tl < NB * 68) P2T_LOAD(tl, 0);
    while (tl < NB * 68) {
        const int b = tl / 68, jt = tl - b * 68, j0 = jt * 64;
#pragma unroll
        for (int k = 0; k < 5; ++k) { const int e = c.tid + k * 512;
            if (st == 0) { if (e < 64 * 16) { const int r = e >> 4, pc = e & 15; LAS unsigned* d = T32 + (r * 516 + pc * 16) / 4; d[0] = pre[k].x; d[1] = pre[k].y; d[2] = pre[k].z; d[3] = pre[k].w; } }
            else if (e < 66 * 32) { const int r = e >> 5, pc = e & 31; LAS unsigned* d = T32 + (r * 516 + pc * 16) / 4; d[0] = pre[k].x; d[1] = pre[k].y; d[2] = pre[k].z; d[3] = pre[k].w; } }
        __syncthreads();
        int ntl = tl, nst = st + 1; if (nst == 5) { nst = 0; ntl = tl + c.G; }
        if (ntl < NB * 68) { if (nst == 0) P2T_LOAD(ntl, 0); else P2T_LOAD(ntl, nst); }
        if (st == 0) {
#pragma unroll
            for (int ps = 0; ps < 2; ++ps) { const int dvf = chl + ps * 64; float v[8];
#pragma unroll
                for (int i = 0; i < 8; ++i) v[i] = bf2f(T[(piece * 8 + i) * 258 + dvf]);
                u32x4 w; w.x = cvt_pk_bf16(v[0], v[1]); w.y = cvt_pk_bf16(v[2], v[3]); w.z = cvt_pk_bf16(v[4], v[5]); w.w = cvt_pk_bf16(v[6], v[7]);
                *(u32x4*)(vtg + ((size_t)(b * 2 + (dvf >> 6)) * 64 + (dvf & 63)) * NTOK + j0 + piece * 8) = w; }
        } else {
            const int blk = 7 + st;
            bf16_t* dst = wsp<bf16_t>(c, blk == 8 ? WS_HYV : blk == 9 ? WS_HYX1 : blk == 10 ? WS_HYX2 : WS_HYG);
#pragma unroll
            for (int ps = 0; ps < 4; ++ps) { const int ch = chl + ps * 64; float v[8];
                if (blk < 11) { const int cc = (blk - 8) * 256 + ch; const float w0 = hcw[cc], w1 = hcw[768 + cc], w2 = hcw[1536 + cc], bs = hcb[cc];
                    float xm = bf2f(T[(piece * 8) * 258 + ch]), x0 = bf2f(T[(piece * 8 + 1) * 258 + ch]);
#pragma unroll
                    for (int i = 0; i < 8; ++i) { const float x1 = bf2f(T[(piece * 8 + i + 2) * 258 + ch]); v[i] = w0 * xm + w1 * x0 + w2 * x1 + bs; xm = x0; x0 = x1; } }
                else {
#pragma unroll
                    for (int i = 0; i < 8; ++i) v[i] = siluf(bf2f(T[(piece * 8 + i + 1) * 258 + ch])); }
                u32x4 w; w.x = cvt_pk_bf16(v[0], v[1]); w.y = cvt_pk_bf16(v[2], v[3]); w.z = cvt_pk_bf16(v[4], v[5]); w.w = cvt_pk_bf16(v[6], v[7]);
                *(u32x4*)(dst + ((size_t)ch * 16 + b) * NTOK + j0 + piece * 8) = w; }
        }
        __syncthreads();
        tl = ntl; st = nst;
    }
#undef P2T_LOAD
}

template <int DK, bool SUB>
__device__ __forceinline__ bool attn_unit(float (&rowmax)[2], const Ctx& c, const bf16_t* Qp, int qpitch, const bf16_t* Kp, const bf16_t* Vtp, int kt0, int nkt, int nrows,
                                          const bf16_t* gatep, bf16_t* outp, bool rope, int j0, float qscale, const float* ropeM) {
    constexpr int KS = DK / 16, KPC = DK / 8, KPITCH = DK * 2 + 16, KB = 64 * KPITCH, VPITCH = 136, VB = 64 * VPITCH;
    constexpr int KOFF = 0, VOFF = 3 * KB;
    constexpr float LIM = 60.f;
    static_assert(KB % 16 == 0 && VB % 16 == 0, "attention LDS buffer alignment");
    const int tid = c.tid, lane = c.lane, wave = c.wave;
    const int lq_ = opaque(lane), q = lq_ & 31, h = lq_ >> 5;
    LAS unsigned char* lds = c.lds;
    const int rbase = (wave * 64 < nrows) ? wave * 64 : wave * 64 - 256;
    const bool live = wave * 64 < nrows;
    bf16x8 qf[2][KS];
#pragma unroll
    for (int qt = 0; qt < 2; ++qt) {
        const bf16_t* qrow = Qp + (size_t)(rbase + qt * 32 + q) * qpitch + 8 * h;
#pragma unroll
        for (int ks = 0; ks < KS; ++ks) qf[qt][ks] = *(const bf16x8*)(qrow + 16 * ks);
        if (DK == 96) {
            const int jj = j0 + rbase + qt * 32 + q;
#pragma unroll
            for (int ks = 0; ks < KS; ++ks) {
                float x[8]; unpack8(__builtin_bit_cast(u32x4, qf[qt][ks]), x);
                if (ks >= 4) {
                    const int pos = (ks == 4) ? ((jj >> 6) & 63) : (jj & 63);
#pragma unroll
                    for (int e = 0; e < 8; ++e) { const float xp = half_other(x[e], h); const float cs = ropeM[(pos * 8 + e) * 2], sn = ropeM[(pos * 8 + e) * 2 + 1];
                        const float r = h ? (xp * sn + x[e] * cs) : (x[e] * cs - xp * sn); x[e] = rope ? r : x[e]; }
                }
                u32x4 w; w.x = cvt_pk_bf16(x[0] * qscale, x[1] * qscale); w.y = cvt_pk_bf16(x[2] * qscale, x[3] * qscale); w.z = cvt_pk_bf16(x[4] * qscale, x[5] * qscale); w.w = cvt_pk_bf16(x[6] * qscale, x[7] * qscale);
                qf[qt][ks] = __builtin_bit_cast(bf16x8, w);
            }
        }
    }
    f32x16 o00, o01, o10, o11;
#pragma unroll
    for (int i = 0; i < 16; ++i) { o00[i] = 0.f; o01[i] = 0.f; o10[i] = 0.f; o11[i] = 0.f; }
    const float m0 = SUB ? rowmax[0] : 0.f, m1 = SUB ? rowmax[1] : 0.f; float l0 = 0.f, l1 = 0.f;
    float rmax0 = -1e30f, rmax1 = -1e30f;
    const int tq_ = opaque(tid);
    const int kst0 = (tq_ / KPC) * KPITCH + (tq_ % KPC) * 16, kst1 = ((tq_ + 512) / KPC) * KPITCH + ((tq_ + 512) % KPC) * 16;
    const int kgl0 = ((tq_ / KPC) * DK + (tq_ % KPC) * 8) * 2, kgl1 = (((tq_ + 512) / KPC) * DK + ((tq_ + 512) % KPC) * 8) * 2;
    const int vst = (tq_ >> 3) * VPITCH + (tq_ & 7) * 16, vgl = ((tq_ >> 3) * NTOK + (tq_ & 7) * 8) * 2;
    const bool has2 = (DK == 96) && tq_ < 256;
    const int kfo = q * KPITCH + 16 * h, vfo = q * VPITCH + 8 * h;
    const char* Kc = (const char*)Kp; const char* Vc = (const char*)Vtp;
    u32x4 kreg0, kreg1 = {0u, 0u, 0u, 0u}, vreg;
#define AT_GLOADK(kt) do { const char* kb_ = Kc + (size_t)(kt) * (64 * DK * 2); kreg0 = *(const u32x4*)(kb_ + kgl0); if (has2) kreg1 = *(const u32x4*)(kb_ + kgl1); } while (0)
#define AT_GLOADV(kt) do { vreg = *(const u32x4*)(Vc + (size_t)(kt) * 128 + vgl); } while (0)
#define AT_WRITEK(bi) do { LAS unsigned char* bb = lds + KOFF + (bi) * KB; *(LAS u32x4*)(bb + kst0) = kreg0; if (has2) *(LAS u32x4*)(bb + kst1) = kreg1; } while (0)
#define AT_WRITEV(bi) do { LAS u32x2* vd = (LAS u32x2*)(lds + VOFF + (bi) * VB + vst); vd[0] = (u32x2){vreg.x, vreg.y}; vd[1] = (u32x2){vreg.z, vreg.w}; } while (0)
#define AT_QK(S0, S1, bi, jh) do { const LAS unsigned char* kb = lds + KOFF + (bi) * KB + (jh) * 32 * KPITCH + kfo; \
        _Pragma("unroll") for (int i = 0; i < 16; ++i) { S0[i] = 0.f; S1[i] = 0.f; } \
        _Pragma("unroll") for (int ks = 0; ks < KS; ++ks) { \
            const bf16x8 a0 = *(const LAS bf16x8*)(kb + 32 * ks); \
            S0 = __builtin_amdgcn_mfma_f32_32x32x16_bf16(a0, qf[0][ks], S0, 0, 0, 0); \
            S1 = __builtin_amdgcn_mfma_f32_32x32x16_bf16(a0, qf[1][ks], S1, 0, 0, 0); } } while (0)
#define AT_MAX(S, RM) do { if (!SUB) { _Pragma("unroll") for (int i = 0; i < 16; i += 2) RM = max3_raw(RM, S[i], S[i + 1]); } } while (0)
#define AT_EXP(S, M, L, PK0, PK1) do { float ps = 0.f; \
        _Pragma("unroll") for (int i = 0; i < 16; ++i) { S[i] = __builtin_amdgcn_exp2f(SUB ? S[i] - M : S[i]); ps += S[i]; } \
        L += ps; u32x4 w; \
        w.x = cvt_pk_bf16(S[0], S[1]); w.y = cvt_pk_bf16(S[2], S[3]); w.z = cvt_pk_bf16(S[4], S[5]); w.w = cvt_pk_bf16(S[6], S[7]); PK0 = __builtin_bit_cast(bf16x8, w); \
        w.x = cvt_pk_bf16(S[8], S[9]); w.y = cvt_pk_bf16(S[10], S[11]); w.z = cvt_pk_bf16(S[12], S[13]); w.w = cvt_pk_bf16(S[14], S[15]); PK1 = __builtin_bit_cast(bf16x8, w); } while (0)
#define AT_SUB(SC0, SC1, SN0, SN1, vbi, jh, nbi, njh) do { \
        AT_MAX(SC0, rmax0); AT_MAX(SC1, rmax1); __builtin_amdgcn_sched_barrier(0); \
        AT_QK(SN0, SN1, nbi, njh); \
        bf16x8 p00, p01, p10, p11; \
        AT_EXP(SC0, m0, l0, p00, p01); AT_EXP(SC1, m1, l1, p10, p11); __builtin_amdgcn_sched_barrier(0); \
        const LAS unsigned char* vb = lds + VOFF + (vbi) * VB + (jh) * 64 + vfo; \
        _Pragma("unroll") for (int st = 0; st < 2; ++st) { \
            const u32x2 la = *(const LAS u32x2*)(vb + 32 * st), ha = *(const LAS u32x2*)(vb + 32 * st + 16), lb = *(const LAS u32x2*)(vb + 32 * VPITCH + 32 * st), hb = *(const LAS u32x2*)(vb + 32 * VPITCH + 32 * st + 16); \
            const bf16x8 va0 = __builtin_bit_cast(bf16x8, (u32x4){la.x, la.y, ha.x, ha.y}), va1 = __builtin_bit_cast(bf16x8, (u32x4){lb.x, lb.y, hb.x, hb.y}); \
            o00 = __builtin_amdgcn_mfma_f32_32x32x16_bf16(va0, st ? p01 : p00, o00, 0, 0, 0); \
            o01 = __builtin_amdgcn_mfma_f32_32x32x16_bf16(va1, st ? p01 : p00, o01, 0, 0, 0); \
            o10 = __builtin_amdgcn_mfma_f32_32x32x16_bf16(va0, st ? p11 : p10, o10, 0, 0, 0); \
            o11 = __builtin_amdgcn_mfma_f32_32x32x16_bf16(va1, st ? p11 : p10, o11, 0, 0, 0); } \
        __builtin_amdgcn_sched_barrier(0); } while (0)
    if (!SUB && tid == 0) *(volatile LAS unsigned*)(lds + LDS_MISC_OFF + 24) = 0u;
    AT_GLOADK(kt0); AT_GLOADV(kt0); AT_WRITEK(0); AT_WRITEV(0);
    AT_GLOADK(kt0 + 1); AT_WRITEK(1);
    __syncthreads();
    f32x16 sa0, sa1, sb0, sb1;
    AT_QK(sa0, sa1, 0, 0);
    int kb0 = 0, kb1 = 1, kb2 = 2;
    for (int t = 0; t < nkt; ++t) {
        const int tk = (t + 2 < nkt) ? t + 2 : nkt - 1, tv = (t + 1 < nkt) ? t + 1 : nkt - 1;
        AT_GLOADK(kt0 + tk);
        AT_SUB(sa0, sa1, sb0, sb1, t & 1, 0, kb0, 1);
        AT_WRITEK(kb2);
        AT_GLOADV(kt0 + tv);
        AT_SUB(sb0, sb1, sa0, sa1, t & 1, 1, kb1, 0);
        AT_WRITEV((t + 1) & 1);
        __syncthreads();
        const int tmp = kb0; kb0 = kb1; kb1 = kb2; kb2 = tmp;
    }
#undef AT_GLOADK
#undef AT_GLOADV
#undef AT_WRITEK
#undef AT_WRITEV
#undef AT_QK
#undef AT_MAX
#undef AT_EXP
#undef AT_SUB
    bool bad = false;
    if (!SUB) { const float r0 = half_max(rmax0), r1 = half_max(rmax1); rowmax[0] = r0; rowmax[1] = r1; const bool b_ = live && !(r0 < LIM && r0 > -LIM && r1 < LIM && r1 > -LIM); volatile LAS unsigned* flg = (volatile LAS unsigned*)(lds + LDS_MISC_OFF + 24); if (__any(b_ ? 1 : 0) && opaque(lane) == 0) *flg = 1u; __syncthreads(); bad = *flg != 0u; __syncthreads(); }
    if (live && !bad) {
        const int le_ = opaque(lane), q = le_ & 31, h = le_ >> 5;
#pragma unroll
        for (int qt = 0; qt < 2; ++qt) {
            const float lr = qt ? l1 : l0; const float lt = half_sum(lr), inv = 1.f / lt;
            const size_t row = (size_t)(rbase + qt * 32 + q);
#pragma unroll
            for (int dt = 0; dt < 2; ++dt)
#pragma unroll
                for (int g4 = 0; g4 < 4; ++g4) {
                    const int dv0 = dt * 32 + 8 * g4 + 4 * h;
                    const u32x2 gw = *(const u32x2*)(gatep + row * 256 + dv0);
                    const float g0 = siluf(lo_bf(gw.x)), g1 = siluf(hi_bf(gw.x)), g2 = siluf(lo_bf(gw.y)), g3 = siluf(hi_bf(gw.y));
                    const f32x16& o = qt ? (dt ? o11 : o10) : (dt ? o01 : o00);
                    u32x2 w; w.x = cvt_pk_bf16(o[4 * g4] * inv * g0, o[4 * g4 + 1] * inv * g1); w.y = cvt_pk_bf16(o[4 * g4 + 2] * inv * g2, o[4 * g4 + 3] * inv * g3);
                    *(u32x2*)(outp + row * DM + dv0) = w;
                }
        }
    }
    return bad;
}

template <int N>
__device__ __forceinline__ void hyena_conv(const Ctx& c, LAS unsigned char* ub, LAS unsigned char* gb, int pass, const bf16_t* xmul  , float bias,
                                           bf16_t* zdst  , const bf16_t* gmul, bf16_t* cat  , float cw0, float cw1, float cw2, float cb  ) {
    constexpr int UP = (N + 256) * 2 + 16, NPAIR = N / 256, OFF8 = N - 8;
    const int lane = c.lane, i16 = lane & 15, kq = lane >> 4;
    for (int pr = c.wave; pr < NPAIR; pr += 8) {
        const int t0 = pr * 256;
        u32x4 xq[2][4], gq[2][4]; bf16_t xl[2][4], xr[2][4];
#pragma unroll
        for (int half = 0; half < 2; ++half)
#pragma unroll
            for (int r = 0; r < 4; ++r) { const int t8 = t0 + half * 128 + 32 * kq + 8 * r; const bf16_t* xp_ = xmul + (size_t)i16 * NTOK + t8; xq[half][r] = *(const u32x4*)xp_;
                xl[half][r] = (t8 > 0) ? xp_[-1] : (bf16_t)0; xr[half][r] = (t8 + 8 < N) ? xp_[8] : (bf16_t)0;
                gq[half][r] = (pass == 1) ? *(const u32x4*)(gmul + (size_t)i16 * NTOK + t8) : (u32x4){0u, 0u, 0u, 0u}; }
        f32x4 acc[2][8];
#pragma unroll
        for (int m = 0; m < 8; ++m) { acc[0][m] = (f32x4){0.f, 0.f, 0.f, 0.f}; acc[1][m] = (f32x4){0.f, 0.f, 0.f, 0.f}; }
        const LAS unsigned char* up = ub + i16 * UP + 256 + kq * 16;
        const LAS unsigned char* gp = gb + (OFF8 - t0 - 8 * i16 + 8 * kq) * 2;
        bf16x8 bfa = *(const LAS bf16x8*)(up - 256), bfb = *(const LAS bf16x8*)(up);
        u32x4 wa = *(const LAS u32x4*)(gp - 256), wb = *(const LAS u32x4*)(gp - 256 + 16);
        for (int s0 = -128; s0 < N; s0 += 32) {
            const int sn = (s0 + 32 < N) ? s0 + 32 : s0;
            const bf16x8 bfan = *(const LAS bf16x8*)(up + sn * 2), bfbn = *(const LAS bf16x8*)(up + sn * 2 + 256);
            const u32x4 wan = *(const LAS u32x4*)(gp + sn * 2), wbn = *(const LAS u32x4*)(gp + sn * 2 + 16);
            const unsigned w[8] = {wa.x, wa.y, wa.z, wa.w, wb.x, wb.y, wb.z, wb.w};
            unsigned sh[7];
#pragma unroll
            for (int k = 0; k < 7; ++k) sh[k] = __builtin_amdgcn_alignbit(w[k + 1], w[k], 16);
#pragma unroll
            for (int m = 0; m < 8; ++m) {
                u32x4 a;
                if (m & 1) { const int d0 = (7 - m) >> 1; a = (u32x4){w[d0], w[d0 + 1], w[d0 + 2], w[d0 + 3]}; }
                else { const int d0 = (6 - m) >> 1; a = (u32x4){sh[d0], sh[d0 + 1], sh[d0 + 2], sh[d0 + 3]}; }
                acc[0][m] = __builtin_amdgcn_mfma_f32_16x16x32_bf16(__builtin_bit_cast(bf16x8, a), bfa, acc[0][m], 0, 0, 0);
                acc[1][m] = __builtin_amdgcn_mfma_f32_16x16x32_bf16(__builtin_bit_cast(bf16x8, a), bfb, acc[1][m], 0, 0, 0);
            }
            bfa = bfan; bfb = bfbn; wa = wan; wb = wbn;
        }
#pragma unroll
        for (int half = 0; half < 2; ++half)
#pragma unroll
            for (int r = 0; r < 4; ++r) {
                const int t8 = t0 + half * 128 + 32 * kq + 8 * r;
                float uu[8], xr8[8], xm[8]; unpack8(*(const LAS u32x4*)(ub + i16 * UP + 256 + t8 * 2), uu); unpack8(xq[half][r], xr8);
                {   float pv = bf2f(xl[half][r]);
#pragma unroll
                    for (int m = 0; m < 8; ++m) { const float nx = (m < 7) ? xr8[m + 1] : bf2f(xr[half][r]); xm[m] = bf2f(f2bf(cw0 * pv + cw1 * xr8[m] + cw2 * nx + cb)); pv = xr8[m]; } }
                float y[8];
#pragma unroll
                for (int m = 0; m < 8; ++m) y[m] = xm[m] * (acc[half][m][r] + bias * uu[m]);
                if (pass == 0) { u32x4 o; o.x = cvt_pk_bf16(y[0], y[1]); o.y = cvt_pk_bf16(y[2], y[3]); o.z = cvt_pk_bf16(y[4], y[5]); o.w = cvt_pk_bf16(y[6], y[7]); *(u32x4*)(zdst + (size_t)i16 * NTOK + t8) = o; }
                else { float gg[8]; unpack8(gq[half][r], gg);
#pragma unroll
                    for (int m = 0; m < 8; ++m) gg[m] = bf2f(f2bf(siluf(gg[m])));
                    u32x4 o; o.x = cvt_pk_bf16(y[0] * gg[0], y[1] * gg[1]); o.y = cvt_pk_bf16(y[2] * gg[2], y[3] * gg[3]); o.z = cvt_pk_bf16(y[4] * gg[4], y[5] * gg[5]); o.w = cvt_pk_bf16(y[6] * gg[6], y[7] * gg[7]);
                    *(u32x4*)(cat + (size_t)i16 * NTOK + t8) = o; }
            }
    }
}
template <int N>
__device__ __forceinline__ void hyena_seq(const Ctx& c, int l, int ch, int toff) {
    constexpr int UP = (N + 256) * 2 + 16;
    LAS unsigned char* ub = c.lds; LAS unsigned char* gb = c.lds + 16 * UP;
    const bf16_t* vv = wsp<bf16_t>(c, WS_HYV) + (size_t)ch * 16 * NTOK + toff;
    bf16_t* vz = wsp<bf16_t>(c, WS_HYZ) + (size_t)ch * 16 * NTOK + toff;
    const bf16_t* x1 = wsp<bf16_t>(c, WS_HYX1) + (size_t)ch * 16 * NTOK + toff;
    const bf16_t* x2 = wsp<bf16_t>(c, WS_HYX2) + (size_t)ch * 16 * NTOK + toff;
    const bf16_t* gm = wsp<bf16_t>(c, WS_HYG) + (size_t)ch * 16 * NTOK + toff;
    bf16_t* cat = wsp<bf16_t>(c, WS_HYY) + (size_t)ch * 16 * NTOK + toff;
    { const int e = c.tid, b = e >> 5, side = (e >> 4) & 1, pc = e & 15; unsigned z = 0u; asm volatile("" : "+v"(z)); *(LAS u32x4*)(ub + b * UP + side * (256 + N * 2) + pc * 16) = (u32x4){z, z, z, z}; }
    for (int pass = 0; pass < 2; ++pass) {
        const bf16_t* gr = (N == SEQL) ? wsp<bf16_t>(c, WS_GR) + (((size_t)l * 2 + pass) * 256 + ch) * 8192 : wsp<bf16_t>(c, WS_GRC) + (((size_t)l * 2 + pass) * 256 + ch) * 512;
        const bf16_t* usrc = pass == 0 ? vv : vz;
        constexpr int NG = (2 * N / 8 + 511) / 512;
        {
            u32x4 t[NG];
#pragma unroll
            for (int k = 0; k < NG; ++k) { const int e = c.tid + k * 512; t[k] = (e < 2 * N / 8) ? *(const u32x4*)(gr + e * 8) : (u32x4){0u, 0u, 0u, 0u}; }
#pragma unroll
            for (int k = 0; k < NG; ++k) { const int e = c.tid + k * 512; if (e < 2 * N / 8) *(LAS u32x4*)(gb + e * 16) = t[k]; }
        }
        if constexpr (N == SEQL) {
#pragma unroll
            for (int k0 = 0; k0 < 16; k0 += 8) {
                u32x4 t[8];
#pragma unroll
                for (int k = 0; k < 8; ++k) t[k] = *(const u32x4*)(usrc + (size_t)(k0 + k) * NTOK + c.tid * 8);
#pragma unroll
                for (int k = 0; k < 8; ++k) *(LAS u32x4*)(ub + (k0 + k) * UP + 256 + c.tid * 16) = t[k];
            }
        } else {
            const int b = c.tid >> 5, pc = c.tid & 31;
            *(LAS u32x4*)(ub + b * UP + 256 + pc * 16) = *(const u32x4*)(usrc + (size_t)b * NTOK + pc * 8);
        }
        __syncthreads();
        const float* hcw = KIN(I_HCW) + (size_t)l * 3 * 768; const float* hcb = KIN(I_HCB) + l * 768;
        if (pass == 0) {
            const float w0 = hcw[ch], w1 = hcw[768 + ch], w2 = hcw[1536 + ch], bs = hcb[ch];
            constexpr int PPT = (N == SEQL) ? 16 : 1;
            u32x4 o[PPT];
#pragma unroll
            for (int k = 0; k < PPT; ++k) { const int b = (N == SEQL) ? k : (c.tid >> 5), pc = (N == SEQL) ? c.tid : (c.tid & 31); const LAS unsigned char* p = ub + b * UP + 256 + pc * 16;
                float x[8]; unpack8(*(const LAS u32x4*)p, x); float pv = bf2f(*(const LAS bf16_t*)(p - 2)); const float nx8 = bf2f(*(const LAS bf16_t*)(p + 16)); float y[8];
#pragma unroll
                for (int m = 0; m < 8; ++m) { const float nx = (m < 7) ? x[m + 1] : nx8; y[m] = w0 * pv + w1 * x[m] + w2 * nx + bs; pv = x[m]; }
                o[k].x = cvt_pk_bf16(y[0], y[1]); o[k].y = cvt_pk_bf16(y[2], y[3]); o[k].z = cvt_pk_bf16(y[4], y[5]); o[k].w = cvt_pk_bf16(y[6], y[7]); }
            __syncthreads();
#pragma unroll
            for (int k = 0; k < PPT; ++k) { const int b = (N == SEQL) ? k : (c.tid >> 5), pc = (N == SEQL) ? c.tid : (c.tid & 31); *(LAS u32x4*)(ub + b * UP + 256 + pc * 16) = o[k]; }
            __syncthreads();
        }
        const float bias = KIN(I_HBIAS)[((size_t)l * 2 + pass) * 256 + ch];
        const int cc = (pass + 1) * 256 + ch;
        hyena_conv<N>(c, ub, gb, pass, pass == 0 ? x1 : x2, bias, vz, gm, cat, hcw[cc], hcw[768 + cc], hcw[1536 + cc], hcb[cc]);
        asm volatile("s_waitcnt vmcnt(0)" ::: "memory");
        __syncthreads();
    }
}

__device__ __forceinline__ void hyena_untranspose(const Ctx& c, int tl0, int tl1) {
    const bf16_t* yT = wsp<bf16_t>(c, WS_HYY); bf16_t* cat = wsp<bf16_t>(c, WS_HCAT);
    LAS bf16_t* T = (LAS bf16_t*)c.lds;
    LAS unsigned* T32 = (LAS unsigned*)c.lds;
    for (int tl = tl0; tl < tl1; ++tl) {
        const int b = tl / 68, j0 = (tl - b * 68) * 64;
        u32x4 pre[4];
#pragma unroll
        for (int k = 0; k < 4; ++k) { const int e = c.tid + k * 512, ch = e >> 3, pc = e & 7; pre[k] = *(const u32x4*)(yT + ((size_t)ch * 16 + b) * NTOK + j0 + pc * 8); }
#pragma unroll
        for (int k = 0; k < 4; ++k) { const int e = c.tid + k * 512, ch = e >> 3, pc = e & 7; LAS unsigned* d = T32 + (ch * 132 + pc * 16) / 4; d[0] = pre[k].x; d[1] = pre[k].y; d[2] = pre[k].z; d[3] = pre[k].w; }
        __syncthreads();
#pragma unroll
        for (int k = 0; k < 4; ++k) { const int e = c.tid + k * 512, t = e >> 5, c0 = (e & 31) * 8; float v[8];
#pragma unroll
            for (int i = 0; i < 8; ++i) v[i] = bf2f(T[(c0 + i) * 66 + t]);
            u32x4 w; w.x = cvt_pk_bf16(v[0], v[1]); w.y = cvt_pk_bf16(v[2], v[3]); w.z = cvt_pk_bf16(v[4], v[5]); w.w = cvt_pk_bf16(v[6], v[7]);
            *(u32x4*)(cat + ((size_t)b * NTOK + j0 + t) * DM + 768 + c0) = w; }
        __syncthreads();
    }
}

__device__ __forceinline__ void ssm_scan_item(const Ctx& c, int l, int item) {
    const int b = item >> 2, g = (item & 3) * 4 + (c.tid >> 7), dq = (c.tid >> 6) & 1, p = c.tid & 63;
    const float* a16 = wsp<float>(c, WS_A16) + ((((size_t)l * 2 + dq) * 16 + g) * 64 + p) * 2;
    const float ar = a16[0], ai = a16[1];
    const bf16_t* E = wsp<bf16_t>(c, WS_E); bf16_t* US = wsp<bf16_t>(c, WS_US);
    float sr = 0.f, si = 0.f;
    for (int st0 = 0; st0 < NCHB; st0 += 8) {
        float er[8], ei[8]; size_t ro[8];
#pragma unroll
        for (int k = 0; k < 8; ++k) { const int st = st0 + k; const int cc = dq == 0 ? (st < 16 ? 256 + st : st - 16) : (st < 16 ? 271 - st : 255 - (st - 16));
            ro[k] = (size_t)g * NCHUNK + (size_t)b * NCHB + cc; er[k] = bf2f(E[ro[k] * 256 + dq * 128 + p]); ei[k] = bf2f(E[ro[k] * 256 + dq * 128 + 64 + p]); }
#pragma unroll
        for (int k = 0; k < 8; ++k) {
            US[ro[k] * 512 + 256 + dq * 128 + p] = f2bf(sr); US[ro[k] * 512 + 256 + dq * 128 + 64 + p] = f2bf(si);
            const float nr = ar * sr - ai * si + er[k], ni = ar * si + ai * sr + ei[k]; sr = nr; si = ni;
        }
    }
}

constexpr int LDS_BYTES = 163840;
constexpr int LDS_MISC = LDS_MISC_OFF;
static_assert(LDS_MISC_OFF == LDS_BYTES - 256, "LDS map");
constexpr int NPRO = 2, NPH = 6, NPHASES = NPRO + DEPTH * NPH;
constexpr int QI_HY = 256, QI_SCAN = 64, QI_ATTL = NB * 8 * 8, QI_SSM2 = 16 * 17, QI_UNT = 272, QI_ATTC = NB * 8, QI_GLU = MROWS / 256;
constexpr int QO_SCAN = QI_HY, QO_ATTL = QO_SCAN + QI_SCAN, QO_SSM2 = QO_ATTL + QI_ATTL, QO_UNT = QO_SSM2 + QI_SSM2, QO_ATTC = QO_UNT + QI_UNT, QO_GLU = QO_ATTC + QI_ATTC, QI_TOTAL = QO_GLU + QI_GLU;
#ifndef PROBE_DUP_MASK
#define PROBE_DUP_MASK 0
#endif
#ifndef PROBE_P4KINDS
#define PROBE_P4KINDS 0x7f
#endif
__device__ __forceinline__ void dep_signal(const Ctx& c, unsigned* cnt) {
    asm volatile("s_waitcnt vmcnt(0)" ::: "memory");
    __syncthreads();
    if (c.tid == 0) { __builtin_amdgcn_fence(__ATOMIC_RELEASE, "agent"); asm volatile("s_waitcnt vmcnt(0)" ::: "memory"); (void)xb_add(cnt, 1u); }
}
__device__ __forceinline__ void dep_wait(const Ctx& c, unsigned* cnt, unsigned need, unsigned* tmo) {
    if (c.dry) return;
    if (c.tid == 0) {
        unsigned sp = 0;
        while (xb_ld(cnt) < need) { __builtin_amdgcn_s_sleep(2); if ((++sp & 255u) == 0u) { if (xb_ld(tmo)) break; if (sp > XB_SPIN_CAP) { atomicAdd(tmo, 1u); break; } } }
        __builtin_amdgcn_fence(__ATOMIC_ACQUIRE, "agent");
        asm volatile("s_waitcnt vmcnt(0)" ::: "memory");
    }
    __syncthreads();
}

__global__ void __launch_bounds__(512, 2) mk_fwd(Params prm) {
    extern __shared__ __attribute__((aligned(16))) unsigned char lds_raw[];
    Ctx c; c.lds = (LAS unsigned char*)lds_raw; c.ka = (kargp_t)__builtin_amdgcn_kernarg_segment_ptr(); c.ws = prm.ws; c.tid = threadIdx.x; c.lane = c.tid & 63; c.wave = __builtin_amdgcn_readfirstlane(c.tid >> 6); c.G = gridDim.x; c.bid = blockIdx.x; c.dry = prm.dry;
    const int wave0 = c.wave;
    volatile LAS unsigned* misc = (volatile LAS unsigned*)(c.lds + LDS_MISC);
    if (c.tid < 16) misc[c.tid] = 0u;
    __syncthreads();
    unsigned* ctl = wsp<unsigned>(c, WS_CTL);
    const int lo = prm.ph_lo, hi = prm.ph_hi;
    const bool fused = (hi - lo) > 1;
    XcdBarrier bar; bar.bar = ctl + CW_BAR; bar.x = 0; bar.st = misc;
    if (fused) bar = xcd_barrier_post(ctl + CW_BAR, misc);
#ifndef SITE_MASK
#define SITE_MASK 0x3ff
#endif
#define SITE(n) (((SITE_MASK) >> (n)) & 1)
#define IN(k) (lo <= (k) && (k) < hi)
#define FRESH() do { { kargp_t _k = (kargp_t)__builtin_amdgcn_kernarg_segment_ptr(); asm volatile("" : "+s"(_k)); c.ka = _k; c.ws = (unsigned char*)(GAS unsigned char*)_k[37]; } { int _w = wave0; asm volatile("" : "+s"(_w)); c.wave = _w; c.lane = lane_id_fresh(); c.tid = c.wave * 64 + c.lane; } } while (0)
#define SEAM(k) do { if (IN((k) + 1)) xcd_barrier(bar); } while (0)

    if (SITE(0) && IN(0)) {
        FRESH();
        constexpr int J_SSM = 64, J_HY = 544, J_MOD = 192, J_WIN = 4 * 48 * 8, J_WOUT = 4 * 16 * 8, J_WUQ = 4 * 8 * 2, J_W256 = 4 * 4 * 2;
        constexpr int J0 = J_SSM, J1 = J0 + J_HY, J2 = J1 + J_MOD, J3 = J2 + J_WIN, J4 = J3 + J_WOUT, J5 = J4 + J_WUQ, J6 = J5 + J_W256, J7 = J6 + J_W256, J8 = J7 + J_W256, J9 = J8 + 1;
        for (int job = c.bid; job < J9; job += c.G) {
            if (job < J0) ssm_tables_job(c, job);
            else if (job < J1) hyena_mlp_job(c, job - J0);
            else if (job < J2) modv_job(c, job - J1);
            else if (job < J3) { const int r = job - J2, l = r / 384, q = r % 384; wconv_tile(c, KIN(I_WIN) + (size_t)l * DM * INC, DM, INC, INP, wsp<bf16_t>(c, WS_WIN) + (size_t)l * INP * DM, DM, 0, q / 8, q % 8); }
            else if (job < J4) { const int r = job - J3, l = r / 128, q = r % 128; wconv_tile(c, KIN(I_WOUT) + (size_t)l * DM * DM, DM, DM, DM, wsp<bf16_t>(c, WS_WOUT) + (size_t)l * DM * DM, DM, 1, q / 8, q % 8); }
            else if (job < J5) { const int r = job - J4, l = r / 16, q = r % 16; wconv_tile(c, KIN(I_WUQ) + (size_t)l * 192 * 384, 192, 384, 384, wsp<bf16_t>(c, WS_WUQ) + (size_t)l * 512 * 256, 256, 1, q / 2, q % 2); }
            else if (job < J6) { const int r = job - J5, l = r / 8, q = r % 8; wconv_tile(c, KIN(I_WUKV) + (size_t)l * 128 * 512, 128, 512, 256, wsp<bf16_t>(c, WS_WUK) + (size_t)l * 256 * 256, 256, 2, q / 2, q % 2); }
            else if (job < J7) { const int r = job - J6, l = r / 8, q = r % 8; wconv_tile(c, KIN(I_WUKV) + (size_t)l * 128 * 512, 128, 512, 256, wsp<bf16_t>(c, WS_WUV) + (size_t)l * 256 * 256, 256, 3, q / 2, q % 2); }
            else if (job < J8) { const int r = job - J7, l = r / 8, q = r % 8; wconv_tile(c, KIN(I_GLUW) + (size_t)l * 256 * 256, 256, 256, 256, wsp<bf16_t>(c, WS_WGLU) + (size_t)l * 256 * 256, 256, 1, q / 2, q % 2); }
            else rope_job(c);
        }
        SEAM(0);
    }
    if (SITE(1) && IN(1)) {
        FRESH();
        for (int job = c.bid; job < 4 * 2 * 256; job += c.G) hyena_pack_job(c, job);
        norm_rows(c, -1, 0);
        SEAM(1);
    }
    for (int l = 0; l < DEPTH; ++l) {
        const int pbase = NPRO + l * NPH;
        if (SITE(2) && IN(pbase + 0)) {
            FRESH();
            pg8::Gemm g{wsp<bf16_t>(c, WS_HCAT), wsp<bf16_t>(c, WS_WIN) + (size_t)l * INP * DM, MROWS, INP, DM};
            pg8::StaticOrder S; S.init(MROWS, INP, c.G, c.bid);
            EpiInProj E{wsp<bf16_t>(c, WS_PB), wsp<bf16_t>(c, WS_UG), wsp<bf16_t>(c, WS_US), wsp<bf16_t>(c, WS_VTG), wsp<bf16_t>(c, WS_HYV), c.lds + pg8::STAGE_BYTES};
            pg8::gemm_phase(c.lds, g, S, E, c.tid);
            SEAM(pbase + 0);
        }
        if (SITE(3) && IN(pbase + 1)) { FRESH(); p2_rows(c, l); SEAM(pbase + 1); }
        if (SITE(4) && IN(pbase + 2)) {
            FRESH();
            pg8::Gemm g{wsp<bf16_t>(c, WS_PB), wsp<bf16_t>(c, WS_WUQ), MROWS, 512, 256};
            pg8::P3Order S{wsp<bf16_t>(c, WS_PB), wsp<bf16_t>(c, WS_PB) + BLKE, wsp<bf16_t>(c, WS_WUQ) + (size_t)l * 512 * 256, wsp<bf16_t>(c, WS_WUK) + (size_t)l * 256 * 256, wsp<bf16_t>(c, WS_WUV) + (size_t)l * 256 * 256,
                           wsp<bf16_t>(c, WS_UG), wsp<bf16_t>(c, WS_WE) + (size_t)l * 16 * 256 * 256, c.G, c.bid};
            EpiP3 E{{wsp<bf16_t>(c, WS_QM), 384, 384}, {wsp<bf16_t>(c, WS_KM), wsp<bf16_t>(c, WS_KR)}, {wsp<bf16_t>(c, WS_VTM)}, {wsp<bf16_t>(c, WS_E)}};
            pg8::gemm_phase(c.lds, g, S, E, c.tid);
            SEAM(pbase + 2);
        }
        if (SITE(5) && IN(pbase + 3)) {
            FRESH();
            unsigned* qh = ctl + CW_Q + 64 * (l + 4 * c.dry);
            unsigned* dep = ctl + CW_DEP + DEP_SET * (l + 4 * c.dry);
            unsigned* tmo = ctl + CW_BAR + XB_TMO;
            const float* ropeM = wsp<float>(c, WS_ROPEM);
#define ATT_CALL(DKV, ...) do { float rowmax_[2] = {0.f, 0.f}; if (attn_unit<DKV, false>(rowmax_, __VA_ARGS__)) { (void)attn_unit<DKV, true>(rowmax_, __VA_ARGS__); } } while (0)
            for (;;) {
                __syncthreads();
                if (c.tid == 0) misc[4] = __hip_atomic_fetch_add(qh, 1u, __ATOMIC_RELAXED, __HIP_MEMORY_SCOPE_AGENT);
                __syncthreads();
                const int it = (int)misc[4];
                if (it >= QI_TOTAL) break;
                FRESH();
                if (c.dry) { const int kd_ = it < QO_SCAN ? 0 : it < QO_ATTL ? 1 : it < QO_SSM2 ? 2 : it < QO_UNT ? 3 : it < QO_ATTC ? 4 : it < QO_GLU ? 5 : 6; if (!((c.dry >> (1 + kd_)) & 1)) continue; }
                if (it < QO_SCAN) { hyena_seq<SEQL>(c, l, it, 0); if (l + 1 < DEPTH) hyena_seq<CTXL>(c, l, it, SEQL); dep_signal(c, dep); }
                else if (it < QO_ATTL) { ssm_scan_item(c, l, it - QO_SCAN); dep_signal(c, dep + 64); }
                else if (it >= QO_ATTC && it < QO_GLU && l + 1 == DEPTH) {   }
                else if (it < QO_SSM2 || (it >= QO_ATTC && it < QO_GLU)) {
                    const bool isctx = it >= QO_ATTC; const int r = isctx ? it - QO_ATTC : (it - QO_ATTL) % (NB * 8), blk = isctx ? 8 : (it - QO_ATTL) / (NB * 8)  ;
                    const int kind = r & 1  , head = (r >> 1) & 3, b = r >> 3;
                    const size_t row0 = (size_t)b * NTOK + (isctx ? SEQL : blk * 512); const int kt0 = isctx ? 64 : 0, nkt = isctx ? 4 : 68, nrows = isctx ? 256 : 512;
                    if (kind == 0) { ATT_CALL(96, c, wsp<bf16_t>(c, WS_QM) + row0 * 384 + head * 96, 384, wsp<bf16_t>(c, WS_KM) + (size_t)(b * 4 + head) * NTOK * 96, wsp<bf16_t>(c, WS_VTM) + (size_t)(b * 4 + head) * 64 * NTOK,
                                                 kt0, nkt, nrows, wsp<bf16_t>(c, WS_PB) + 2 * BLKE + row0 * 256 + head * 64, wsp<bf16_t>(c, WS_HCAT) + row0 * DM + head * 64, !isctx, blk * 512, 0.10206207261596577f * LOG2E, ropeM); }
                    else { ATT_CALL(64, c, wsp<bf16_t>(c, WS_PB) + 3 * BLKE + row0 * 256 + head * 64, 256, wsp<bf16_t>(c, WS_KG) + (size_t)(b * 2 + (head >> 1)) * NTOK * 64, wsp<bf16_t>(c, WS_VTG) + (size_t)(b * 2 + (head >> 1)) * 64 * NTOK,
                                       kt0, nkt, nrows, wsp<bf16_t>(c, WS_PB) + 5 * BLKE + row0 * 256 + head * 64, wsp<bf16_t>(c, WS_HCAT) + row0 * DM + 256 + head * 64, false, 0, 1.f, ropeM); }
                }
                else if (it < QO_UNT) {
                    const int L = it - QO_SSM2, i = L >> 4, g = L & 15;
                    dep_wait(c, dep + 64, QI_SCAN, tmo);
                    pg8::Gemm gm{wsp<bf16_t>(c, WS_US), wsp<bf16_t>(c, WS_WKC) + (size_t)l * 16 * 256 * 512, 16 * NCHUNK, 16 * 256, 512}; pg8::OneUnit S{g * 17 + i, g};
                    pg8::EpiWalk<PutSsmY> E{{wsp<bf16_t>(c, WS_ZS), wsp<bf16_t>(c, WS_UG), KIN(I_SSMD) + l * 256}}; pg8::gemm_phase(c.lds, gm, S, E, c.tid);
                    dep_signal(c, dep + 64 * (2 + i));
                }
                else if (it < QO_ATTC) {
                    dep_wait(c, dep, QI_HY, tmo);
                    const int j = it - QO_UNT; hyena_untranspose(c, 4 * j, 4 * j + 4);
                }
                else {
                    const int pm = it - QO_GLU;
                    dep_wait(c, dep + 64 * (2 + (pm >> 4)), 16u, tmo);
                    pg8::Gemm gm{wsp<bf16_t>(c, WS_ZS), wsp<bf16_t>(c, WS_WGLU) + (size_t)l * 256 * 256, MROWS, 256, 256}; pg8::OneUnit S{pm, 0};
                    pg8::EpiWalk<PutGlu> E{{wsp<bf16_t>(c, WS_HCAT), wsp<bf16_t>(c, WS_ZS), wsp<bf16_t>(c, WS_PB) + 7 * BLKE, KIN(I_GLUB) + l * 256}}; pg8::gemm_phase(c.lds, gm, S, E, c.tid);
                }
            }
            SEAM(pbase + 3);
        }
        if (SITE(6) && IN(pbase + 4)) {
            FRESH();
            pg8::Gemm g{wsp<bf16_t>(c, WS_HCAT), wsp<bf16_t>(c, WS_WOUT) + (size_t)l * DM * DM, MROWS, DM, DM}; pg8::LiveRowsOrder S; S.init2(DM, c.G, c.bid, l + 1 == DEPTH);
            pg8::EpiWalk<PutPlain> E{{wsp<bf16_t>(c, WS_OUTB), DM, DM}}; pg8::gemm_phase(c.lds, g, S, E, c.tid);
            SEAM(pbase + 4);
        }
        if (SITE(7) && IN(pbase + 5)) { FRESH(); norm_rows(c, l, l + 1 < DEPTH ? l + 1 : -1); if (l + 1 < DEPTH) SEAM(pbase + 5); }
    }
#undef IN
#undef SEAM
}

extern "C" void kernel_launch(void* const* d_in, const int* in_sizes, int n_in, void* d_out, int out_size, void* d_ws, size_t ws_size, hipStream_t stream) {
    static int grid = 0;
    if (grid == 0) {
        if (n_in != 36 || out_size != NB * SEQL * DM || ws_size < WS_END) { fprintf(stderr, "kernel_launch: unexpected shapes: n_in %d out %d ws %zu (need %zu)\n", n_in, out_size, ws_size, (size_t)WS_END); grid = -1; return; }
        int dev = 0, cus = 0, per_cu = 0;
        if (hipGetDevice(&dev) != hipSuccess || hipDeviceGetAttribute(&cus, hipDeviceAttributeMultiprocessorCount, dev) != hipSuccess) { grid = -1; return; }
        if (hipFuncSetAttribute((const void*)mk_fwd, hipFuncAttributeMaxDynamicSharedMemorySize, LDS_BYTES) != hipSuccess) { fprintf(stderr, "kernel_launch: hipFuncSetAttribute failed\n"); grid = -1; return; }
        if (hipOccupancyMaxActiveBlocksPerMultiprocessor(&per_cu, (const void*)mk_fwd, 512, LDS_BYTES) != hipSuccess || per_cu < 1) { fprintf(stderr, "kernel_launch: occupancy query says %d blocks per CU\n", per_cu); per_cu = 1; }
        (void)hipGetLastError();
        grid = cus;
    }
    if (grid < 0) return;
    (void)hipMemsetAsync((char*)d_ws + WS_CTL, 0, CTL_BYTES, stream);
    Params p{};
    for (int i = 0; i < 36; ++i) p.in[i] = (const float*)d_in[i];
    p.out = (float*)d_out; p.ws = (unsigned char*)d_ws;
#if MK_ONE_LAUNCH
    p.ph_lo = 0; p.ph_hi = NPHASES;
    hipLaunchKernelGGL(mk_fwd, dim3(grid), dim3(512), LDS_BYTES, stream, p);
#else
    for (int k = 0; k < NPHASES; ++k) { p.ph_lo = k; p.ph_hi = k + 1; const int site = k < NPRO ? k : NPRO + (k - NPRO) % NPH;
        if ((PROBE_DUP_MASK >> site) & 1) { p.dry = 1 | (PROBE_P4KINDS << 1); hipLaunchKernelGGL(mk_fwd, dim3(grid), dim3(512), LDS_BYTES, stream, p); p.dry = 0; }
        hipLaunchKernelGGL(mk_fwd, dim3(grid), dim3(512), LDS_BYTES, stream, p); }
#endif
}
```

```cpp
#include <hip/hip_runtime.h>
#include <cstdio>
#include <cstdint>

#ifndef MK_ONE_LAUNCH
#define MK_ONE_LAUNCH 1
#endif

#define LAS __attribute__((address_space(3)))
typedef unsigned short bf16_t;
typedef short bf16x8 __attribute__((ext_vector_type(8)));
typedef short bf16x4 __attribute__((ext_vector_type(4)));
typedef float f32x4 __attribute__((ext_vector_type(4)));
typedef float f32x16 __attribute__((ext_vector_type(16)));
typedef unsigned u32x4 __attribute__((ext_vector_type(4)));
typedef unsigned u32x2 __attribute__((ext_vector_type(2)));

constexpr int NB = 16, SEQL = 4096, CTXL = 256, NTOK = SEQL + CTXL  , MROWS = NB * NTOK  ;
constexpr int DM = 1024, DEPTH = 4, INC = 2912, INP = 3072;
constexpr int NCHB = NTOK / 16  , NCHUNK = MROWS / 16  ;
constexpr float EPS = 1e-6f;
constexpr float LOG2E = 1.4426950408889634f;
constexpr int LDS_MISC_OFF = 163840 - 256;

constexpr size_t al256(size_t x) { return (x + 255) & ~(size_t)255; }
constexpr size_t WS_CTL = 0;
constexpr size_t CTL_BYTES = 65536;
constexpr size_t WS_MODV = WS_CTL + CTL_BYTES;
constexpr size_t WS_ROPEG = WS_MODV + al256((size_t)4 * 17 * 3072 * 4);
constexpr size_t WS_ROPEM = WS_ROPEG + 64 * 16 * 2 * 4;
constexpr size_t WS_WIN = WS_ROPEM + 64 * 8 * 2 * 4;
constexpr size_t WS_WOUT = WS_WIN + (size_t)4 * 3072 * 1024 * 2;
constexpr size_t WS_WUQ = WS_WOUT + (size_t)4 * 1024 * 1024 * 2;
constexpr size_t WS_WUK = WS_WUQ + (size_t)4 * 512 * 256 * 2;
constexpr size_t WS_WUV = WS_WUK + (size_t)4 * 256 * 256 * 2;
constexpr size_t WS_WGLU = WS_WUV + (size_t)4 * 256 * 256 * 2;
constexpr size_t WS_WE = WS_WGLU + (size_t)4 * 256 * 256 * 2;
constexpr size_t WS_WKC = WS_WE + (size_t)4 * 16 * 256 * 256 * 2;
constexpr size_t WS_A16 = WS_WKC + (size_t)4 * 16 * 256 * 512 * 2;
constexpr size_t WS_GR = WS_A16 + (size_t)4 * 2 * 16 * 64 * 2 * 4;
constexpr size_t WS_GRC = WS_GR + (size_t)4 * 2 * 256 * 8192 * 2;
constexpr size_t WS_CTXR = WS_GRC + (size_t)4 * 2 * 256 * 512 * 2;
constexpr size_t WS_HCAT = WS_CTXR + (size_t)NB * CTXL * DM * 4;
constexpr size_t BLKE = (size_t)MROWS * 256;
constexpr size_t WS_PB = WS_HCAT + (size_t)MROWS * DM * 2;
constexpr size_t WS_KR = WS_PB + 12 * BLKE * 2;
constexpr size_t WS_KG = WS_KR + (size_t)MROWS * 32 * 2;
constexpr size_t WS_VTG = WS_KG + (size_t)32 * NTOK * 64 * 2;
constexpr size_t WS_UG = WS_VTG + (size_t)32 * NTOK * 64 * 2;
constexpr size_t WS_US = WS_UG + BLKE * 2;
constexpr size_t WS_HYV = WS_US + (size_t)16 * NCHUNK * 512 * 2;
constexpr size_t WS_HYX1 = WS_HYV + BLKE * 2;
constexpr size_t WS_HYX2 = WS_HYX1 + BLKE * 2;
constexpr size_t WS_HYG = WS_HYX2 + BLKE * 2;
constexpr size_t WS_HYZ = WS_HYG + BLKE * 2;
constexpr size_t WS_HYY = WS_HYZ + BLKE * 2;
constexpr size_t WS_END = WS_HYY + BLKE * 2;
static_assert(WS_END <= (size_t)1 << 30, "workspace map exceeds 1 GiB");
constexpr size_t WS_QM = WS_PB + 8 * BLKE * 2;
constexpr size_t WS_KM = WS_QM + (size_t)MROWS * 384 * 2;
constexpr size_t WS_VTM = WS_KM + (size_t)MROWS * 384 * 2;
constexpr size_t WS_E = WS_PB + 4 * BLKE * 2;
constexpr size_t WS_ZS = WS_PB + 6 * BLKE * 2;
constexpr size_t WS_OUTB = WS_PB + 8 * BLKE * 2;
constexpr size_t WS_HT = WS_PB;
static_assert(WS_VTM + BLKE * 2 == WS_PB + 12 * BLKE * 2, "alias map");

constexpr int CW_BAR = 0;
constexpr int CW_Q = 4096;
constexpr int CW_TMO = 4096 + 64 * 8;
constexpr int CW_DEP = 5120;
constexpr int DEP_SET = 20 * 64;

__device__ __forceinline__ float bf2f(bf16_t v) { return __uint_as_float(((unsigned)v) << 16); }
__device__ __forceinline__ bf16_t f2bf(float f) { unsigned u = __float_as_uint(f); u += 0x7FFFu + ((u >> 16) & 1u); return (bf16_t)(u >> 16); }
__device__ __forceinline__ unsigned cvt_pk_bf16(float lo, float hi) { unsigned r; asm volatile("v_cvt_pk_bf16_f32 %0, %1, %2" : "=v"(r) : "v"(lo), "v"(hi)); return r; }
__device__ __forceinline__ float lo_bf(unsigned w) { return __uint_as_float(w << 16); }
__device__ __forceinline__ float hi_bf(unsigned w) { return __uint_as_float(w & 0xFFFF0000u); }
__device__ __forceinline__ float sigmf(float x) { float one = 1.f; asm volatile("" : "+v"(one)); return __builtin_amdgcn_rcpf(one + __builtin_amdgcn_exp2f(-1.4426950408889634f * x)); }
__device__ __forceinline__ float siluf(float x) { return x * sigmf(x); }
__device__ __forceinline__ float gelu_tanh(float x) { const float u = 0.7978845608028654f * (x + 0.044715f * x * x * x); return x * sigmf(2.f * u); }
__device__ __forceinline__ int opaque(int x) { asm volatile("" : "+v"(x)); return x; }
__device__ __forceinline__ int lane_id_fresh() { int x; asm volatile("v_mbcnt_lo_u32_b32 %0, -1, 0\n\tv_mbcnt_hi_u32_b32 %0, -1, %0" : "=v"(x)); return x; }
__device__ __forceinline__ float max3_raw(float a, float b, float c) { float r; asm("v_max3_f32 %0, %1, %2, %3" : "=v"(r) : "v"(a), "v"(b), "v"(c)); return r; }
template <int M> __device__ __forceinline__ float swz_xor(float v) { return __int_as_float(__builtin_amdgcn_ds_swizzle(__float_as_int(v), 0x1F | (M << 10))); }
__device__ __forceinline__ float half_sum(float v) { auto r = __builtin_amdgcn_permlane32_swap(__float_as_uint(v), __float_as_uint(v), false, false); return __uint_as_float(r[0]) + __uint_as_float(r[1]); }
__device__ __forceinline__ float half_max(float v) { auto r = __builtin_amdgcn_permlane32_swap(__float_as_uint(v), __float_as_uint(v), false, false); return fmaxf(__uint_as_float(r[0]), __uint_as_float(r[1])); }
__device__ __forceinline__ float half_other(float v, int h) { auto r = __builtin_amdgcn_permlane32_swap(__float_as_uint(v), __float_as_uint(v), false, false); return __uint_as_float(h ? r[0] : r[1]); }
__device__ __forceinline__ float wave_sum(float v) {
    v += swz_xor<16>(v); v += swz_xor<8>(v); v += swz_xor<4>(v); v += swz_xor<2>(v); v += swz_xor<1>(v);
    return half_sum(v);
}

#define XB_TMO      128
#define XB_XCNT(j)  (256  + 64 * (j))
#define XB_XSUB(j)  (1280 + 64 * (j))
#define XB_XGEN(j)  (2304 + 64 * (j))
#define XB_TOP      3328
#define XB_TOPGEN   3392
#define XCD_BAR_WORDS 3456
#define XB_SPIN_CAP (1u << 22)
__device__ __forceinline__ unsigned xb_ld(unsigned* p)              { return __hip_atomic_load(p, __ATOMIC_RELAXED, __HIP_MEMORY_SCOPE_AGENT); }
__device__ __forceinline__ unsigned xb_add(unsigned* p, unsigned v) { return __hip_atomic_fetch_add(p, v, __ATOMIC_RELAXED, __HIP_MEMORY_SCOPE_AGENT); }
__device__ __forceinline__ unsigned xb_xcc_id() { return (unsigned)__builtin_amdgcn_s_getreg((3 << 11) | 20) & 0xFu; }
#define XB_SPIN(cond, bar) do { unsigned _sp = 0; while (cond) { __builtin_amdgcn_s_sleep(1); \
    if ((++_sp & 255u) == 0u) { if (xb_ld(&(bar)[XB_TMO])) break; if (_sp > XB_SPIN_CAP) { atomicAdd(&(bar)[XB_TMO], 1u); break; } } } } while (0)
struct XcdBarrier { unsigned* bar; unsigned x; volatile LAS unsigned* st; };
__device__ __forceinline__ XcdBarrier xcd_barrier_post(unsigned* bar, volatile LAS unsigned* st) {
    XcdBarrier b; b.bar = bar; b.x = xb_xcc_id(); b.st = st;
    if (threadIdx.x == 0) (void)xb_add(&bar[XB_XCNT(b.x)], 1u);
    return b;
}
__device__ __forceinline__ void xcd_barrier_complete(unsigned* bar, unsigned x, unsigned& nloc, unsigned& nx) {
    const unsigned G = gridDim.x * gridDim.y * gridDim.z;
    unsigned sum, cnt, mine, sp = 0u;
    for (;;) {
        sum = 0u; cnt = 0u; mine = 0u;
#pragma unroll
        for (unsigned j = 0; j < 16; ++j) { const unsigned c = xb_ld(&bar[XB_XCNT(j)]); sum += c; cnt += (c > 0u) ? 1u : 0u; }
        mine = xb_ld(&bar[XB_XCNT(x)]);
        if (sum == G) break;
        __builtin_amdgcn_s_sleep(1);
        if ((++sp & 255u) == 0u) { if (xb_ld(&bar[XB_TMO])) break; if (sp > XB_SPIN_CAP) { atomicAdd(&bar[XB_TMO], 1u); break; } }
    }
    nloc = mine > 0u ? mine : 1u; nx = cnt > 0u ? cnt : 1u;
}
__device__ __forceinline__ void xcd_barrier(const XcdBarrier& b) {
    asm volatile("s_waitcnt vmcnt(0)" ::: "memory");
    __syncthreads();
    if (threadIdx.x == 0) {
        unsigned* bar = b.bar;
        __builtin_amdgcn_s_waitcnt(0);
        unsigned nloc = b.st[0], nx = b.st[1];
        if (nloc == 0u) { xcd_barrier_complete(bar, b.x, nloc, nx); b.st[0] = nloc; b.st[1] = nx; }
        const unsigned old = xb_add(&bar[XB_XSUB(b.x)], 1u);
        const unsigned gen = old / nloc;
        if (old + 1u == (gen + 1u) * nloc) {
            __builtin_amdgcn_fence(__ATOMIC_RELEASE, "agent");
            asm volatile("s_waitcnt vmcnt(0)" ::: "memory");
            const unsigned og = xb_add(&bar[XB_TOP], 1u);
            const unsigned tg = og / nx;
            if (og + 1u == (tg + 1u) * nx) xb_add(&bar[XB_TOPGEN], 1u);
            else XB_SPIN(xb_ld(&bar[XB_TOPGEN]) == tg, bar);
            __builtin_amdgcn_fence(__ATOMIC_ACQUIRE, "agent");
            xb_add(&bar[XB_XGEN(b.x)], 1u);
            asm volatile("s_waitcnt vmcnt(0)" ::: "memory");
        } else {
            XB_SPIN(xb_ld(&bar[XB_XGEN(b.x)]) == gen, bar);
            __builtin_amdgcn_fence(__ATOMIC_ACQUIRE, "agent");
            asm volatile("s_waitcnt vmcnt(0)" ::: "memory");
        }
    }
    __syncthreads();
}

namespace pg8 {
constexpr int BM = 256, BK = 64, HALF = 128, HTB = HALF * BK * 2, STAGE_BYTES = 8 * HTB, NXCD = 8, WGM = 8;
__host__ __device__ __forceinline__ int lds_byte(int r, int c) { const int st = (r >> 4) * 2 + (c >> 5), rr = r & 15, cc = c & 31, ob = rr * 64 + cc * 2; return st * 1024 + (ob ^ (((ob >> 9) & 1) << 5)); }
__host__ __device__ __forceinline__ void stage_rc(int b, int& R, int& C) { const int st = b / 1024, sb = b % 1024, swz = sb ^ (((sb >> 9) & 1) << 5); R = (st >> 1) * 16 + swz / 64; C = (st & 1) * 32 + (swz % 64) / 2; }
__host__ __device__ __forceinline__ int perm32(int rho) { const int n = rho >> 4, i = rho & 15; return 8 * (i >> 2) + 4 * n + (i & 3); }
struct Unit { int pm, pn, kd; };
struct Gemm { const bf16_t* A; const bf16_t* Bt; int M, N, K; };
struct StaticOrder {
    int nM, nN, nwg, G, c;
    __host__ __device__ void init(int M, int N, int G_, int c_) { nM = M / BM; nN = N / BM; nwg = nM * nN; G = G_; c = c_; }
    __host__ __device__ bool next(int i, Unit& u) const {
        const long L = (long)i * G + c; if (L >= nwg) return false;
        int wgid = (int)L; { const int q = nwg / NXCD, r = nwg % NXCD, xcd = wgid % NXCD, off = wgid / NXCD; wgid = (xcd < r ? xcd * (q + 1) : r * (q + 1) + (xcd - r) * q) + off; }
        const int nig = WGM * nN, gid = wgid / nig, fm = gid * WGM, gsz = (nM - fm) < WGM ? (nM - fm) : WGM;
        u.pm = fm + ((wgid % nig) % gsz); u.pn = (wgid % nig) / gsz; u.kd = 0; return true;
    }
    __device__ __forceinline__ void a_ready(const Unit&) const {}
    __device__ __forceinline__ void done(const Unit&) const {}
    __device__ __forceinline__ const char* abase(const Gemm& g, const Unit& u, size_t tstep) const { return (const char*)g.A + (size_t)u.pm * tstep; }
    __device__ __forceinline__ const char* bbase(const Gemm& g, const Unit& u, size_t tstep) const { return (const char*)g.Bt + (size_t)u.pn * tstep; }
};
struct LiveRowsOrder : StaticOrder {
    bool skip;
    __host__ __device__ void init2(int N, int G_, int c_, bool skip_) { skip = skip_; init(skip_ ? NB * SEQL : MROWS, N, G_, c_); }
    __host__ __device__ bool next(int i, Unit& u) const { if (!StaticOrder::next(i, u)) return false; if (skip) u.pm = (u.pm >> 4) * 17 + (u.pm & 15); return true; }
};
struct BatchedOrder {
    int nwg, G, c, tpg;
    __host__ __device__ void init(int ng, int tpg_, int G_, int c_) { nwg = ng * tpg_; tpg = tpg_; G = G_; c = c_; }
    __host__ __device__ bool next(int i, Unit& u) const { const int L = i * G + c; if (L >= nwg) return false; u.pm = L; u.pn = L / tpg; u.kd = 0; return true; }
    __device__ __forceinline__ void a_ready(const Unit&) const {}
    __device__ __forceinline__ void done(const Unit&) const {}
    __device__ __forceinline__ const char* abase(const Gemm& g, const Unit& u, size_t tstep) const { return (const char*)g.A + (size_t)u.pm * tstep; }
    __device__ __forceinline__ const char* bbase(const Gemm& g, const Unit& u, size_t tstep) const { return (const char*)g.Bt + (size_t)u.pn * tstep; }
};
struct P3Order {
    const bf16_t *b0, *b1, *wuq, *wuk, *wuv, *ug, *we; int G, c;
    __host__ __device__ bool next(int i, Unit& u) const {
        const int L = i * G + c; if (L >= 1360) return false;
        if (L < 544) { u.kd = 0; u.pm = L >> 1; u.pn = L & 1; } else if (L < 816) { u.kd = 1; u.pm = L - 544; u.pn = 0; } else if (L < 1088) { u.kd = 2; u.pm = 0; u.pn = L - 816; } else { u.kd = 3; u.pm = L - 1088; u.pn = (L - 1088) / 17; }
        return true;
    }
    __device__ __forceinline__ void a_ready(const Unit&) const {}
    __device__ __forceinline__ void done(const Unit&) const {}
    __device__ __forceinline__ const char* abase(const Gemm&, const Unit& u, size_t tstep) const { const bf16_t* p = u.kd == 0 ? b0 : u.kd == 1 ? b1 : u.kd == 2 ? wuv : ug; return (const char*)p + (size_t)u.pm * tstep; }
    __device__ __forceinline__ const char* bbase(const Gemm&, const Unit& u, size_t tstep) const { const bf16_t* p = u.kd == 0 ? wuq : u.kd == 1 ? wuk : u.kd == 2 ? b1 : we; return (const char*)p + (size_t)u.pn * tstep; }
};

struct OneUnit {
    int pm, pn;
    __host__ __device__ bool next(int i, Unit& u) const { if (i) return false; u.pm = pm; u.pn = pn; u.kd = 0; return true; }
    __device__ __forceinline__ void a_ready(const Unit&) const {}
    __device__ __forceinline__ void done(const Unit&) const {}
    __device__ __forceinline__ const char* abase(const Gemm& g, const Unit& u, size_t tstep) const { return (const char*)g.A + (size_t)u.pm * tstep; }
    __device__ __forceinline__ const char* bbase(const Gemm& g, const Unit& u, size_t tstep) const { return (const char*)g.Bt + (size_t)u.pn * tstep; }
};
template <class Epi, class Sched>
__device__ __forceinline__ void gemm_phase(LAS unsigned char* lds, const Gemm g, const Sched& S, const Epi& E, int tid_in) {
    const int tid = tid_in, wid = __builtin_amdgcn_readfirstlane(tid >> 6), lane = tid & 63, wr = wid >> 2, wc = wid & 3, fr = lane & 15, fq = lane >> 4;
    const int K = g.K, nt = K / BK;
    unsigned voffA[2], voffB[2];
#pragma unroll
    for (int i = 0; i < 2; ++i) { int R, C; stage_rc(tid * 16 + i * 8192, R, C); const int Rb = Epi::PERM ? ((R & ~31) + perm32(R & 31)) : R;
        voffA[i] = (unsigned)(R * K + C) * 2u; voffB[i] = (unsigned)(Rb * K + C) * 2u; }
    const size_t kstep = (size_t)(BK * 2);
    const size_t hstep = (size_t)HALF * K * 2;
    const size_t tstep = 2 * hstep;
    const unsigned ldsw = (unsigned)wid * 1024u;
    const int aoff = lds_byte(wr * 64 + fr, fq * 8), boff = lds_byte(wc * 32 + fr, fq * 8);
#define PG8_SA(b, h) (((b) * 2 + (h)) * HTB)
#define PG8_SB(b, h) ((4 + (b) * 2 + (h)) * HTB)
#define PG8_STAGE(bufoff, gbase, voff) do { _Pragma("unroll") for (int _i = 0; _i < 2; ++_i) \
        __builtin_amdgcn_global_load_lds((const unsigned*)((const char*)(gbase) + (voff)[_i]), (LAS unsigned*)(lds + (bufoff) + ldsw + _i * 8192), 16, 0, 0); } while (0)
#define PG8_LDA(dst, b, h) do { _Pragma("unroll") for (int m = 0; m < 4; ++m) _Pragma("unroll") for (int k = 0; k < 2; ++k) dst[m][k] = *(const LAS bf16x8*)(lds + PG8_SA(b, h) + aoff + m * 2048 + k * 1024); } while (0)
#define PG8_LDB(dst, b, h) do { _Pragma("unroll") for (int n = 0; n < 2; ++n) _Pragma("unroll") for (int k = 0; k < 2; ++k) dst[n][k] = *(const LAS bf16x8*)(lds + PG8_SB(b, h) + boff + n * 2048 + k * 1024); } while (0)
#define PG8_MMA(ai, bj, At, Bt) do { __builtin_amdgcn_s_setprio(1); _Pragma("unroll") for (int m = 0; m < 4; ++m) _Pragma("unroll") for (int n = 0; n < 2; ++n) _Pragma("unroll") for (int k = 0; k < 2; ++k) \
        acc[ai][bj][m][n] = __builtin_amdgcn_mfma_f32_16x16x32_bf16(Bt[n][k], At[m][k], acc[ai][bj][m][n], 0, 0, 0); __builtin_amdgcn_s_setprio(0); } while (0)
#define PG8_WAIT_V(n) asm volatile("s_waitcnt vmcnt(" #n ")" ::: "memory")
#define PG8_WAIT_L(n) asm volatile("s_waitcnt lgkmcnt(" #n ")" ::: "memory")
#define PG8_BAR __builtin_amdgcn_s_barrier()
#define PG8_SCHED __builtin_amdgcn_sched_barrier(0)
    Unit cur, nxt; int ui = 0;
    if (!S.next(0, cur)) return;
    f32x4 acc[2][2][4][2];
#pragma unroll
    for (int a = 0; a < 2; ++a)
#pragma unroll
        for (int b = 0; b < 2; ++b)
#pragma unroll
            for (int m = 0; m < 4; ++m)
#pragma unroll
                for (int n = 0; n < 2; ++n) acc[a][b][m][n] = (f32x4){0.f, 0.f, 0.f, 0.f};
    bf16x8 At[4][2], B0[2][2], B1[2][2];
    const char* cA = S.abase(g, cur, tstep); const char* cB = S.bbase(g, cur, tstep);
    S.a_ready(cur);
    PG8_STAGE(PG8_SB(0, 0), cB, voffB); PG8_STAGE(PG8_SA(0, 0), cA, voffA); PG8_STAGE(PG8_SB(0, 1), cB + hstep, voffB); PG8_STAGE(PG8_SA(0, 1), cA + hstep, voffA);
    if (wr == 1) PG8_BAR;
    PG8_WAIT_V(4); PG8_BAR;
    PG8_STAGE(PG8_SB(1, 0), cB + kstep, voffB); PG8_STAGE(PG8_SA(1, 0), cA + kstep, voffA); PG8_STAGE(PG8_SB(1, 1), cB + hstep + kstep, voffB);
    PG8_WAIT_V(6); PG8_BAR;
    for (;;) {
        const bool has_next = S.next(ui + 1, nxt);
        const char* nA = has_next ? S.abase(g, nxt, tstep) : cA; const char* nB = has_next ? S.bbase(g, nxt, tstep) : cB;
        for (int t = 0; t < nt; t += 2) {
            const bool last = (t == nt - 2);
            const char* a1 = cA + (size_t)(t + 1) * kstep;
            const char* a2 = last ? nA : cA + (size_t)(t + 2) * kstep; const char* b2 = last ? nB : cB + (size_t)(t + 2) * kstep;
            const char* a3 = a2 + kstep; const char* b3 = b2 + kstep;
            if (last && has_next) S.a_ready(nxt);
            PG8_LDB(B0, 0, 0); PG8_SCHED; PG8_LDA(At, 0, 0); PG8_STAGE(PG8_SA(1, 1), a1 + hstep, voffA);
            PG8_WAIT_L(8); PG8_BAR; PG8_WAIT_L(0); PG8_MMA(0, 0, At, B0); PG8_BAR; PG8_SCHED;
            PG8_LDB(B1, 0, 1); PG8_STAGE(PG8_SB(0, 0), b2, voffB);
            PG8_BAR; PG8_WAIT_L(0); PG8_MMA(0, 1, At, B1); PG8_BAR;
            PG8_LDA(At, 0, 1); PG8_STAGE(PG8_SA(0, 0), a2, voffA);
            PG8_BAR; PG8_WAIT_L(0); PG8_MMA(1, 0, At, B0); PG8_BAR; PG8_SCHED;
            PG8_STAGE(PG8_SB(0, 1), b2 + hstep, voffB);
            PG8_WAIT_V(6); PG8_BAR; PG8_MMA(1, 1, At, B1); PG8_BAR;
            PG8_LDB(B0, 1, 0); PG8_SCHED; PG8_LDA(At, 1, 0); PG8_STAGE(PG8_SA(0, 1), a2 + hstep, voffA);
            PG8_WAIT_L(8); PG8_BAR; PG8_WAIT_L(0); PG8_MMA(0, 0, At, B0); PG8_BAR; PG8_SCHED;
            PG8_LDB(B1, 1, 1); PG8_STAGE(PG8_SB(1, 0), b3, voffB);
            PG8_BAR; PG8_WAIT_L(0); PG8_MMA(0, 1, At, B1); PG8_BAR;
            PG8_LDA(At, 1, 1); PG8_STAGE(PG8_SA(1, 0), a3, voffA);
            PG8_BAR; PG8_WAIT_L(0); PG8_MMA(1, 0, At, B0); PG8_BAR; PG8_SCHED;
            PG8_STAGE(PG8_SB(1, 1), b3 + hstep, voffB);
            PG8_WAIT_V(6); PG8_BAR; PG8_MMA(1, 1, At, B1); PG8_BAR;
        }
        { const int l2 = lane_id_fresh(); E(acc, cur, wr, wc, l2 & 15, l2 >> 4); } S.done(cur);
        if (!has_next) break;
#pragma unroll
        for (int a = 0; a < 2; ++a)
#pragma unroll
            for (int b = 0; b < 2; ++b)
#pragma unroll
                for (int m = 0; m < 4; ++m)
#pragma unroll
                    for (int n = 0; n < 2; ++n) acc[a][b][m][n] = (f32x4){0.f, 0.f, 0.f, 0.f};
        cur = nxt; cA = nA; cB = nB; ++ui;
    }
    PG8_WAIT_V(0);
    if (wr == 0) PG8_BAR;
    PG8_BAR;
#undef PG8_SA
#undef PG8_SB
#undef PG8_STAGE
#undef PG8_LDA
#undef PG8_LDB
#undef PG8_MMA
#undef PG8_WAIT_V
#undef PG8_WAIT_L
#undef PG8_BAR
#undef PG8_SCHED
}

template <class F> struct EpiWalk {
    static constexpr bool PERM = true, AFTER_DRAIN = false;
    F f;
    __device__ __forceinline__ void operator()(const f32x4 (&acc)[2][2][4][2], const Unit& u, int wr, int wc, int fr, int fq) const {
#pragma unroll
        for (int ai = 0; ai < 2; ++ai)
#pragma unroll
            for (int m = 0; m < 4; ++m) {
                const int rin = ai * HALF + wr * 64 + m * 16 + fr;
#pragma unroll
                for (int bj = 0; bj < 2; ++bj) { const int cin = bj * HALF + wc * 32 + 8 * fq; f.put(u.pm, u.pn, rin, cin, acc[ai][bj][m][0], acc[ai][bj][m][1]); asm volatile("" ::: "memory"); }
            }
    }
};
}

__device__ __forceinline__ u32x4 pack8(const f32x4& a, const f32x4& b) {
    u32x4 w; w.x = cvt_pk_bf16(a[0], a[1]); w.y = cvt_pk_bf16(a[2], a[3]); w.z = cvt_pk_bf16(b[0], b[1]); w.w = cvt_pk_bf16(b[2], b[3]); return w;
}
__device__ __forceinline__ void unpack8(const u32x4 w, float (&o)[8]) {
    o[0] = lo_bf(w.x); o[1] = hi_bf(w.x); o[2] = lo_bf(w.y); o[3] = hi_bf(w.y); o[4] = lo_bf(w.z); o[5] = hi_bf(w.z); o[6] = lo_bf(w.w); o[7] = hi_bf(w.w);
}

struct PutPlain {
    bf16_t* dst; int ldc, ncols;
    __device__ __forceinline__ void put(int pm, int pn, int rin, int cin, const f32x4& a, const f32x4& b) const { const int col = pn * 256 + cin; if (col < ncols) *(u32x4*)(dst + ((size_t)pm * 256 + rin) * ldc + col) = pack8(a, b); }
};
struct PutKm {
    bf16_t* km; const bf16_t* kr;
    __device__ __forceinline__ void put(int pm, int pn, int rin, int cin, const f32x4& a, const f32x4& b) const {
        const int bb = pm / 17, key = (pm - bb * 17) * 256 + rin, hd = cin >> 6, d = cin & 63;
        bf16_t* dst = km + ((size_t)(bb * 4 + hd) * NTOK + key) * 96;
        *(u32x4*)(dst + d) = pack8(a, b);
        if (d < 32) *(u32x4*)(dst + 64 + d) = *(const u32x4*)(kr + ((size_t)pm * 256 + rin) * 32 + d);
    }
};
struct PutVt {
    bf16_t* vt;
    __device__ __forceinline__ void put(int pm, int pn, int rin, int cin, const f32x4& a, const f32x4& b) const {
        const int bb = pn / 17, key = (pn - bb * 17) * 256 + cin;
        *(u32x4*)(vt + ((size_t)(bb * 4 + (rin >> 6)) * 64 + (rin & 63)) * NTOK + key) = pack8(a, b);
    }
};
struct PutE {
    bf16_t* e;
    __device__ __forceinline__ void put(int pm, int pn, int rin, int cin, const f32x4& a, const f32x4& b) const { *(u32x4*)(e + ((size_t)pm * 256 + rin) * 256 + cin) = pack8(a, b); }
};
struct PutSsmY {
    bf16_t* zs; const bf16_t* ug; const float* dskip;
    __device__ __forceinline__ void put(int pm, int pn, int rin, int cin, const f32x4& a, const f32x4& b) const {
        const int g = pn, n = (pm - g * 17) * 256 + rin, tok = n * 16 + (cin >> 4), ho = cin & 15, ch = g * 16 + ho;
        float u[8]; unpack8(*(const u32x4*)(ug + ((size_t)g * MROWS + tok) * 16 + ho), u);
        const f32x4 d0 = *(const f32x4*)(dskip + ch), d1 = *(const f32x4*)(dskip + ch + 4);
        f32x4 y0, y1;
#pragma unroll
        for (int i = 0; i < 4; ++i) { y0[i] = gelu_tanh(a[i] + d0[i] * u[i]); y1[i] = gelu_tanh(b[i] + d1[i] * u[4 + i]); }
        *(u32x4*)(zs + (size_t)tok * 256 + ch) = pack8(y0, y1);
    }
};
struct PutGlu {
    bf16_t* cat; const bf16_t* zs; const bf16_t* gate; const float* gb;
    __device__ __forceinline__ void put(int pm, int pn, int rin, int cin, const f32x4& a, const f32x4& b) const {
        const size_t row = (size_t)pm * 256 + rin; const int col = cin;
        float z[8], gt[8]; unpack8(*(const u32x4*)(zs + row * 256 + col), z); unpack8(*(const u32x4*)(gate + row * 256 + col), gt);
        const f32x4 b0 = *(const f32x4*)(gb + col), b1 = *(const f32x4*)(gb + col + 4);
        f32x4 y0, y1;
#pragma unroll
        for (int i = 0; i < 4; ++i) { y0[i] = z[i] * sigmf(a[i] + b0[i]) * siluf(gt[i]); y1[i] = z[4 + i] * sigmf(b[i] + b1[i]) * siluf(gt[4 + i]); }
        *(u32x4*)(cat + row * DM + 512 + col) = pack8(y0, y1);
    }
};

struct EpiInProj {
    static constexpr bool PERM = true, AFTER_DRAIN = false;
    bf16_t *pb, *ug, *us, *vtg, *hy0;
    LAS unsigned char* scratch;
    __device__ __forceinline__ void operator()(const f32x4 (&acc)[2][2][4][2], const pg8::Unit& u, int wr, int wc, int fr, int fq) const {
        const int pn = u.pn, pm = u.pm;
        const int bb = pm / 17, jt = (pm - bb * 17) * 256;
        LAS unsigned char* sw = scratch + (wr * 4 + wc) * 1280;
        const int ln = fq * 16 + fr, tch = ln >> 1, thalf = ln & 1;
#pragma unroll
        for (int ai = 0; ai < 2; ++ai)
#pragma unroll
            for (int m = 0; m < 4; ++m) {
                const int rin = ai * pg8::HALF + wr * 64 + m * 16 + fr;
#pragma unroll
                for (int bj = 0; bj < 2; ++bj) {
                    const int cin = bj * pg8::HALF + wc * 32 + 8 * fq;
                    const u32x4 w = pack8(acc[ai][bj][m][0], acc[ai][bj][m][1]);
                    const bool plain = pn < 4 || pn == 5 || pn == 7 || (pn == 4 && bj == 0);
                    if (plain) { *(u32x4*)(pb + (size_t)pn * BLKE + ((size_t)pm * 256 + rin) * 256 + cin) = w; }
                    else if (pn == 6) { const size_t row = (size_t)pm * 256 + rin; const int g = cin >> 4, hi0 = cin & 15;
                        *(u32x4*)(ug + ((size_t)g * MROWS + row) * 16 + hi0) = w;
                        *(u32x4*)(us + ((size_t)g * NCHUNK + (row >> 4)) * 512 + (row & 15) * 16 + hi0) = w; }
                    else {
                        *(LAS u32x4*)(sw + fr * 80 + fq * 16) = w;
                        asm volatile("" ::: "memory");
                        unsigned short e[8];
#pragma unroll
                        for (int i = 0; i < 8; ++i) e[i] = *(const LAS unsigned short*)(sw + (thalf * 8 + i) * 80 + tch * 2);
                        asm volatile("" ::: "memory");
                        u32x4 t; t.x = e[0] | ((unsigned)e[1] << 16); t.y = e[2] | ((unsigned)e[3] << 16); t.z = e[4] | ((unsigned)e[5] << 16); t.w = e[6] | ((unsigned)e[7] << 16);
                        const int chn = bj * pg8::HALF + wc * 32 + tch;
                        const int tok = jt + ai * pg8::HALF + wr * 64 + m * 16 + thalf * 8;
                        bf16_t* dst = (pn == 4) ? vtg + ((size_t)(bb * 2 + ((chn - 128) >> 6)) * 64 + ((chn - 128) & 63)) * NTOK + tok
                                                : hy0 + (size_t)(pn - 8) * BLKE + ((size_t)chn * 16 + bb) * NTOK + tok;
                        *(u32x4*)dst = t;
                    }
                    asm volatile("" ::: "memory");
                }
            }
    }
};

struct EpiP3 {
    static constexpr bool PERM = true, AFTER_DRAIN = false;
    PutPlain q; PutKm k; PutVt v; PutE e;
    __device__ __forceinline__ void operator()(const f32x4 (&acc)[2][2][4][2], const pg8::Unit& u, int wr, int wc, int fr, int fq) const {
#pragma unroll
        for (int ai = 0; ai < 2; ++ai)
#pragma unroll
            for (int m = 0; m < 4; ++m) {
                const int rin = ai * pg8::HALF + wr * 64 + m * 16 + fr;
#pragma unroll
                for (int bj = 0; bj < 2; ++bj) { const int cin = bj * pg8::HALF + wc * 32 + 8 * fq;
                    if (u.kd == 0) q.put(u.pm, u.pn, rin, cin, acc[ai][bj][m][0], acc[ai][bj][m][1]);
                    else if (u.kd == 1) k.put(u.pm, u.pn, rin, cin, acc[ai][bj][m][0], acc[ai][bj][m][1]);
                    else if (u.kd == 2) v.put(u.pm, u.pn, rin, cin, acc[ai][bj][m][0], acc[ai][bj][m][1]);
                    else e.put(u.pm, u.pn, rin, cin, acc[ai][bj][m][0], acc[ai][bj][m][1]);
                    asm volatile("" ::: "memory"); }
            }
    }
};

struct Params {
    const float* in[36];
    float* out;
    unsigned char* ws;
    int ph_lo, ph_hi, dry, pad;
};
enum { I_X = 0, I_C, I_CTX, I_CCTX, I_WMOD, I_BMOD, I_GPRE, I_GPOST, I_WIN, I_WOUT, I_GCQ, I_WUQ, I_GCKV, I_WUKV, I_GQ, I_GK,
       I_LRE, I_LIM, I_LSTEP, I_BRE, I_BIM, I_CRE, I_CIM, I_SSMD, I_GLUW, I_GLUB, I_HCW, I_HCB, I_HW1, I_HB1, I_HF1, I_HW2, I_HB2, I_HF2, I_HW3, I_HBIAS };

typedef __attribute__((address_space(4))) const unsigned long long* kargp_t;
struct Ctx {
    LAS unsigned char* lds;
    kargp_t ka;
    unsigned char* ws;
    int tid, lane, wave, G, bid, dry;
};
#define GAS __attribute__((address_space(1)))
#define KIN(i) ((const float*)(GAS const float*)c.ka[(i)])
#define KOUT() ((float*)(GAS float*)c.ka[36])
template <class T> __device__ __forceinline__ T* wsp(const Ctx& c, size_t off) { return (T*)(c.ws + off); }

__device__ __forceinline__ int wmap(int kind, int n) {
    if (kind == 0) { if (n < 192) return n; if (n < 224) return 320 + (n - 192); if (n < 256) return -1; if (n < 384) return 192 + (n - 256); if (n < 512) return -1; return n - 160; }
    if (kind == 2) return (n >> 6) * 128 + (n & 63);
    if (kind == 3) return (n >> 6) * 128 + 64 + (n & 63);
    return n;
}
__device__ __forceinline__ void wconv_tile(const Ctx& c, const float* src, int Ks, int Ns, int Nlim, bf16_t* dst, int Kp, int kind, int nt, int kt) {
    LAS float* T = (LAS float*)c.lds;
    const int n0 = nt * 64, k0 = kt * 128;
    const int nn = c.tid & 63, kk0 = c.tid >> 6; const int n = n0 + nn; const int sc = (n < Nlim) ? wmap(kind, n) : -1;
    float v[16];
#pragma unroll
    for (int i = 0; i < 16; ++i) { const int k = k0 + kk0 + 8 * i; v[i] = (k < Ks && sc >= 0) ? src[(size_t)k * Ns + sc] : 0.f; }
#pragma unroll
    for (int i = 0; i < 16; ++i) T[(kk0 + 8 * i) * 65 + nn] = v[i];
    __syncthreads();
#pragma unroll
    for (int i = 0; i < 2; ++i) { const int e = c.tid + i * 512, row = e >> 4, pc = e & 15; float x[8];
#pragma unroll
        for (int j = 0; j < 8; ++j) x[j] = T[(pc * 8 + j) * 65 + row];
        u32x4 w; w.x = cvt_pk_bf16(x[0], x[1]); w.y = cvt_pk_bf16(x[2], x[3]); w.z = cvt_pk_bf16(x[4], x[5]); w.w = cvt_pk_bf16(x[6], x[7]);
        *(u32x4*)(dst + (size_t)(n0 + row) * Kp + k0 + pc * 8) = w; }
    __syncthreads();
}

__device__ __forceinline__ void modv_job(const Ctx& c, int job) {
    const int l = job / 48, j0 = (job % 48) * 64;
    LAS float* sc = (LAS float*)c.lds;
    LAS float* red = sc + 17 * 1024;
    const float* cv = KIN(I_C); const float* cc = KIN(I_CCTX);
    for (int e = c.tid; e < 17 * 1024; e += 512) { const int r = e >> 10, k = e & 1023; const float v = (r < 16) ? cv[r * 1024 + k] : cc[k]; sc[e] = siluf(v); }
    __syncthreads();
    const int col = c.tid & 63, ks = c.tid >> 6;
    const float* w = KIN(I_WMOD) + (size_t)l * 1024 * 3072 + j0 + col;
    float acc[17];
#pragma unroll
    for (int r = 0; r < 17; ++r) acc[r] = 0.f;
    for (int k = ks * 128; k < ks * 128 + 128; ++k) { const float wv = w[(size_t)k * 3072];
#pragma unroll
        for (int r = 0; r < 17; ++r) acc[r] += sc[r * 1024 + k] * wv; }
#pragma unroll
    for (int r = 0; r < 17; ++r) red[(ks * 17 + r) * 64 + col] = acc[r];
    __syncthreads();
    float* mv = wsp<float>(c, WS_MODV);
    for (int e = c.tid; e < 17 * 64; e += 512) { const int r = e >> 6, cl = e & 63; float s = KIN(I_BMOD)[l * 3072 + j0 + cl];
#pragma unroll
        for (int q = 0; q < 8; ++q) s += red[(q * 17 + r) * 64 + cl];
        mv[((size_t)l * 17 + r) * 3072 + j0 + cl] = s; }
    __syncthreads();
}

__device__ __forceinline__ void rope_job(const Ctx& c) {
    float* rg = wsp<float>(c, WS_ROPEG); float* rm = wsp<float>(c, WS_ROPEM);
    for (int e = c.tid; e < 64 * 16; e += 512) { const int pos = e >> 4, f = e & 15; const float inv = powf(10000.f, -(float)(2 * f) / 32.f); const float a = (float)pos * inv; rg[e * 2] = cosf(a); rg[e * 2 + 1] = sinf(a); }
    for (int e = c.tid; e < 64 * 8; e += 512) { const int pos = e >> 3, f = e & 7; const float inv = powf(10000.f, -(float)(2 * f) / 16.f); const float a = (float)pos * inv; rm[e * 2] = cosf(a); rm[e * 2 + 1] = sinf(a); }
}

typedef float cpx __attribute__((ext_vector_type(2)));
#define CPX(a, b) ((cpx){(a), (b)})
__device__ __forceinline__ cpx cmul(cpx a, cpx b) { return CPX(a.x * b.x - a.y * b.y, a.x * b.y + a.y * b.x); }
__device__ __forceinline__ void ssm_tables_job(const Ctx& c, int job) {
    const int l = job >> 4, g = job & 15;
    LAS cpx* apow = (LAS cpx*)c.lds;
    LAS cpx* bbar = apow + 2 * 17 * 64;
    LAS cpx* cm = bbar + 2 * 64 * 16;
    LAS float* Kc = (LAS float*)(cm + 2 * 16 * 64);
    for (int e = c.tid; e < 2 * 64; e += 512) {
        const int d = e >> 6, p = e & 63; const size_t ix = (((size_t)l * 2 + d) * 16 + g) * 64 + p;
        const float lr = KIN(I_LRE)[ix], li = KIN(I_LIM)[ix], st = expf(KIN(I_LSTEP)[((size_t)l * 2 + d) * 16 + g]);
        for (int k = 0; k <= 16; ++k) { const float m = expf(lr * st * (float)k), an = li * st * (float)k; apow[(d * 17 + k) * 64 + p] = CPX(m * cosf(an), m * sinf(an)); }
    }
    __syncthreads();
    for (int e = c.tid; e < 2 * 64 * 16; e += 512) {
        const int d = e >> 10, p = (e >> 4) & 63, h = e & 15; const size_t ix = (((size_t)l * 2 + d) * 16 + g) * 64 + p;
        const float lr = KIN(I_LRE)[ix], li = KIN(I_LIM)[ix];
        const cpx a = apow[(d * 17 + 1) * 64 + p]; const cpx am1 = CPX(a.x - 1.f, a.y);
        const float den = lr * lr + li * li; const cpx q = CPX((am1.x * lr + am1.y * li) / den, (am1.y * lr - am1.x * li) / den);
        const cpx b = CPX(KIN(I_BRE)[ix * 16 + h], KIN(I_BIM)[ix * 16 + h]);
        bbar[e] = cmul(q, b);
        const size_t cx = ((((size_t)l * 2 + d) * 16 + g) * 16 + h) * 64 + p;
        cm[(d * 16 + h) * 64 + p] = CPX(KIN(I_CRE)[cx], KIN(I_CIM)[cx]);
    }
    __syncthreads();
    for (int e = c.tid; e < 2 * 16 * 256; e += 512) {
        const int d = e >> 12, dd = (e >> 8) & 15, ho = (e >> 4) & 15, hi = e & 15; float s = 0.f;
        for (int p = 0; p < 64; ++p) { const cpx w = cmul(cm[(d * 16 + ho) * 64 + p], apow[(d * 17 + dd) * 64 + p]); const cpx b = bbar[(d * 64 + p) * 16 + hi]; s += w.x * b.x - w.y * b.y; }
        Kc[e] = s;
    }
    __syncthreads();
    bf16_t* wkc = wsp<bf16_t>(c, WS_WKC) + ((size_t)l * 16 + g) * 256 * 512;
    for (int e = c.tid; e < 256 * 512; e += 512) {
        const int r = e >> 9, q = e & 511, i = r >> 4, ho = r & 15; float v;
        if (q < 256) { const int j = q >> 4, hi = q & 15; v = 0.f; if (j <= i) v += Kc[((0 * 16 + (i - j)) * 16 + ho) * 16 + hi]; if (j >= i) v += Kc[((1 * 16 + (j - i)) * 16 + ho) * 16 + hi]; }
        else { const int qq = q - 256, dq = qq >> 7, comp = (qq >> 6) & 1, p = qq & 63, k = dq == 0 ? i + 1 : 16 - i; const cpx w = cmul(cm[(dq * 16 + ho) * 64 + p], apow[(dq * 17 + k) * 64 + p]); v = comp == 0 ? w.x : -w.y; }
        wkc[e] = f2bf(v);
    }
    bf16_t* we = wsp<bf16_t>(c, WS_WE) + ((size_t)l * 16 + g) * 256 * 256;
    for (int e = c.tid; e < 256 * 256; e += 512) {
        const int qq = e >> 8, cidx = e & 255, j = cidx >> 4, hi = cidx & 15, dq = qq >> 7, comp = (qq >> 6) & 1, p = qq & 63, k = dq == 0 ? 15 - j : j;
        const cpx w = cmul(apow[(dq * 17 + k) * 64 + p], bbar[(dq * 64 + p) * 16 + hi]);
        we[e] = f2bf(comp == 0 ? w.x : w.y);
    }
    float* a16 = wsp<float>(c, WS_A16);
    for (int e = c.tid; e < 128; e += 512) { const int d = e >> 6, p = e & 63; const cpx a = apow[(d * 17 + 16) * 64 + p]; const size_t ix = ((((size_t)l * 2 + d) * 16 + g) * 64 + p) * 2; a16[ix] = a.x; a16[ix + 1] = a.y; }
    __syncthreads();
}

__device__ __forceinline__ void hyena_mlp_job(const Ctx& c, int job) {
    const int l = job / 136, tt = job % 136;
    const bool isctx = tt >= 128; const int n = isctx ? CTXL : SEQL; const int t0 = isctx ? (tt - 128) * 32 : tt * 32;
    LAS float* z = (LAS float*)c.lds;
    LAS float* h1 = z + 32 * 36;
    LAS float* h2 = h1 + 32 * 64;
    for (int e = c.tid; e < 32 * 33; e += 512) {
        const int ti = e / 33, f = e % 33, t = t0 + ti; float v;
        if (f == 0) v = (float)t / (float)(n - 1);
        else { const int k = (f - 1) & 15; const float band = 1e-4f + (float)k * ((15.f - 1e-4f) / 15.f); const float om = 6.283185307179586f * (float)t / (float)n; v = (f <= 16) ? cosf(band * om) : -sinf(band * om); }
        z[ti * 36 + f] = v;
    }
    __syncthreads();
    for (int e = c.tid; e < 32 * 64; e += 512) {
        const int ti = e >> 6, j = e & 63; float s = KIN(I_HB1)[l * 64 + j];
        for (int f = 0; f < 33; ++f) s += z[ti * 36 + f] * KIN(I_HW1)[((size_t)l * 33 + f) * 64 + j];
        h1[e] = sinf(KIN(I_HF1)[l * 64 + j] * s);
    }
    __syncthreads();
    for (int e = c.tid; e < 32 * 64; e += 512) {
        const int ti = e >> 6, j = e & 63; float s = KIN(I_HB2)[l * 64 + j];
        for (int f = 0; f < 64; ++f) s += h1[ti * 64 + f] * KIN(I_HW2)[((size_t)l * 64 + f) * 64 + j];
        h2[e] = sinf(KIN(I_HF2)[l * 64 + j] * s);
    }
    __syncthreads();
    float* hT = wsp<float>(c, WS_HT) + (size_t)l * 1024 * NTOK;
    const float mind = -3.070113457325394f, maxd = -15.35056728662697f;
#pragma unroll
    for (int cc = 0; cc < 2; ++cc) {
        const int col = c.tid + cc * 512;
        float acc[32];
#pragma unroll
        for (int ti = 0; ti < 32; ++ti) acc[ti] = 0.f;
        for (int f = 0; f < 64; ++f) { const float w = KIN(I_HW3)[((size_t)l * 64 + f) * 1024 + col];
#pragma unroll
            for (int ti = 0; ti < 32; ++ti) acc[ti] += h2[ti * 64 + f] * w; }
        const int ch = col & 255; const float delta = fabsf(mind + (maxd - mind) * (float)ch / 255.f);
        float* dst = hT + (size_t)col * NTOK + (isctx ? SEQL : 0) + t0;
#pragma unroll
        for (int ti = 0; ti < 32; ++ti) { const float tn = (float)(t0 + ti) / (float)(n - 1); dst[ti] = acc[ti] * expf(-tn * delta); }
    }
    __syncthreads();
}

__device__ __forceinline__ void hyena_pack_job(const Ctx& c, int job) {
    const int l = job >> 9, o = (job >> 8) & 1, ch = job & 255;
    const float* hT = wsp<float>(c, WS_HT) + (size_t)l * 1024 * NTOK;
    const float* fw = hT + (size_t)(o * 512 + ch) * NTOK; const float* bw = hT + (size_t)(o * 512 + 256 + ch) * NTOK;
    LAS float* red = (LAS float*)c.lds;
    float s0 = 0.f, s1 = 0.f;
    for (int t = c.tid; t < SEQL; t += 512) { const float a = fw[t], b = bw[t]; s0 += a * a + b * b; }
    if (c.tid < CTXL) { const float a = fw[SEQL + c.tid], b = bw[SEQL + c.tid]; s1 = a * a + b * b; }
    s0 = wave_sum(s0); s1 = wave_sum(s1);
    if (c.lane == 0) { red[c.wave] = s0; red[8 + c.wave] = s1; }
    __syncthreads();
    float t0 = 0.f, t1 = 0.f;
#pragma unroll
    for (int w = 0; w < 8; ++w) { t0 += red[w]; t1 += red[8 + w]; }
    const float r0 = rsqrtf(t0 + EPS), r1 = rsqrtf(t1 + EPS);
    bf16_t* gr = wsp<bf16_t>(c, WS_GR) + (((size_t)l * 2 + o) * 256 + ch) * 8192;
    for (int e = c.tid; e < 8192; e += 512) { float v; if (e <= 4095) v = fw[4095 - e]; else if (e < 8191) v = bw[e - 4095]; else v = 0.f; gr[e] = f2bf(v * r0); }
    bf16_t* grc = wsp<bf16_t>(c, WS_GRC) + (((size_t)l * 2 + o) * 256 + ch) * 512;
    { const int e = c.tid; float v; if (e <= 255) v = fw[SEQL + 255 - e]; else if (e < 511) v = bw[SEQL + e - 255]; else v = 0.f; grc[e] = f2bf(v * r1); }
    __syncthreads();
}

__device__ __forceinline__ void norm_rows(const Ctx& c, int l  , int next  , int r0 = -1  , int r1 = 0) {
    const float* mvl = wsp<float>(c, WS_MODV) + (size_t)(l < 0 ? 0 : l) * 17 * 3072;
    const float* mvn = wsp<float>(c, WS_MODV) + (size_t)(next < 0 ? 0 : next) * 17 * 3072;
    const bf16_t* outb = wsp<bf16_t>(c, WS_OUTB);
    bf16_t* hb = wsp<bf16_t>(c, WS_HCAT);
    float* ctxr = wsp<float>(c, WS_CTXR);
    const float* xin0 = KIN(I_X); const float* cin0 = KIN(I_CTX); float* outp = KOUT();
    const float* gpost = KIN(I_GPOST) + (l < 0 ? 0 : l) * DM; const float* gpre = KIN(I_GPRE) + (next < 0 ? 0 : next) * DM;
    const int nw = c.G * 8, lane4 = c.lane * 4;
    const int rb0 = r0 >= 0 ? r0 + c.wave * 2 : (c.bid * 8 + c.wave) * 2, rbe = r0 >= 0 ? r1 : MROWS, rbs = r0 >= 0 ? 16 : nw * 2;
    for (int rowb = rb0; rowb < rbe; rowb += rbs) {
        f32x4 xv[2][4]; u32x2 ow[2][4]; const float* xin[2]; float* xout[2]; int mr[2]; bool live[2], isc[2];
#pragma unroll
        for (int rr = 0; rr < 2; ++rr) {
            const int row = rowb + rr, b = row / NTOK, j = row - b * NTOK; isc[rr] = j >= SEQL; live[rr] = !(next < 0 && isc[rr]); mr[rr] = isc[rr] ? 16 : b;
            if (isc[rr]) { xout[rr] = ctxr + ((size_t)b * CTXL + (j - SEQL)) * DM; xin[rr] = (l < 0) ? cin0 + ((size_t)b * CTXL + (j - SEQL)) * DM : xout[rr]; }
            else { xout[rr] = outp + ((size_t)b * SEQL + j) * DM; xin[rr] = (l <= 0) ? xin0 + ((size_t)b * SEQL + j) * DM : xout[rr]; }
#pragma unroll
            for (int q = 0; q < 4; ++q) { xv[rr][q] = __builtin_nontemporal_load((const f32x4*)(xin[rr] + q * 256 + lane4)); if (l >= 0) ow[rr][q] = *(const u32x2*)(outb + (size_t)row * DM + q * 256 + lane4); }
        }
#pragma unroll
        for (int rr = 0; rr < 2; ++rr) {
            if (!live[rr]) continue;
            const int row = rowb + rr;
            if (l >= 0) {
                float ov[16]; float ss = 0.f;
#pragma unroll
                for (int q = 0; q < 4; ++q) { ov[q * 4] = lo_bf(ow[rr][q].x); ov[q * 4 + 1] = hi_bf(ow[rr][q].x); ov[q * 4 + 2] = lo_bf(ow[rr][q].y); ov[q * 4 + 3] = hi_bf(ow[rr][q].y); }
#pragma unroll
                for (int i = 0; i < 16; ++i) ss += ov[i] * ov[i];
                ss = wave_sum(ss); const float rs = rsqrtf(ss * (1.f / DM) + EPS);
#pragma unroll
                for (int q = 0; q < 4; ++q) { const int col = q * 256 + lane4; const f32x4 gp = *(const f32x4*)(gpost + col); const f32x4 gt = *(const f32x4*)(mvl + mr[rr] * 3072 + 2048 + col);
#pragma unroll
                    for (int i = 0; i < 4; ++i) xv[rr][q][i] += gt[i] * (ov[q * 4 + i] * rs * gp[i]); }
            }
            if ((l >= 0 || isc[rr]) && !c.dry) {
#pragma unroll
                for (int q = 0; q < 4; ++q) __builtin_nontemporal_store(xv[rr][q], (f32x4*)(xout[rr] + q * 256 + lane4));
            }
            if (next >= 0) {
                float ss = 0.f;
#pragma unroll
                for (int q = 0; q < 4; ++q)
#pragma unroll
                    for (int i = 0; i < 4; ++i) ss += xv[rr][q][i] * xv[rr][q][i];
                ss = wave_sum(ss); const float rs = rsqrtf(ss * (1.f / DM) + EPS);
#pragma unroll
                for (int q = 0; q < 4; ++q) { const int col = q * 256 + lane4; const f32x4 gp = *(const f32x4*)(gpre + col);
                    const f32x4 sh = *(const f32x4*)(mvn + mr[rr] * 3072 + col), sc = *(const f32x4*)(mvn + mr[rr] * 3072 + 1024 + col);
                    float hv[4];
#pragma unroll
                    for (int i = 0; i < 4; ++i) hv[i] = xv[rr][q][i] * rs * gp[i] * (1.f + sc[i]) + sh[i];
                    u32x2 w; w.x = cvt_pk_bf16(hv[0], hv[1]); w.y = cvt_pk_bf16(hv[2], hv[3]); *(u32x2*)(hb + (size_t)row * DM + col) = w; }
            }
        }
    }
}

__device__ __forceinline__ void p2_rows(const Ctx& c, int l) {
    bf16_t* pb = wsp<bf16_t>(c, WS_PB);
    bf16_t* B0 = pb; bf16_t* B1 = pb + BLKE; bf16_t* B3 = pb + 3 * BLKE; const bf16_t* B4 = pb + 4 * BLKE;
    bf16_t* kr = wsp<bf16_t>(c, WS_KR); bf16_t* kg = wsp<bf16_t>(c, WS_KG); bf16_t* ug = wsp<bf16_t>(c, WS_UG); bf16_t* us = wsp<bf16_t>(c, WS_US);
    const float* ropeG = wsp<float>(c, WS_ROPEG); const float* ropeM = wsp<float>(c, WS_ROPEM);
    const int lane = c.lane;
    const f32x4 gcq = (lane < 48) ? *(const f32x4*)(KIN(I_GCQ) + l * 192 + lane * 4) : (f32x4){0.f, 0.f, 0.f, 0.f};
    const f32x4 gckv = (lane < 32) ? *(const f32x4*)(KIN(I_GCKV) + l * 128 + lane * 4) : (f32x4){0.f, 0.f, 0.f, 0.f};
    const f32x4 gq = *(const f32x4*)(KIN(I_GQ) + l * 64 + (lane & 15) * 4), gk = *(const f32x4*)(KIN(I_GK) + l * 64 + (lane & 15) * 4);
    for (int rowb = (c.bid * 8 + c.wave) * 4; rowb < MROWS; rowb += c.G * 8 * 4) {
        u32x2 w0[4], w1[4], w3[4], w4[4];
#pragma unroll
        for (int rr = 0; rr < 4; ++rr) { const size_t ro = (size_t)(rowb + rr) * 256 + lane * 4;
            w0[rr] = *(const u32x2*)(B0 + ro); w1[rr] = *(const u32x2*)(B1 + ro); w3[rr] = *(const u32x2*)(B3 + ro); w4[rr] = *(const u32x2*)(B4 + ro); }
#pragma unroll
        for (int rr = 0; rr < 4; ++rr) {
            const int row = rowb + rr;
            const int b = row / NTOK, j = row - b * NTOK; const bool islat = j < SEQL; const int rowpos = (j >> 6) & 63, colpos = j & 63;
            const size_t ro = (size_t)row * 256 + lane * 4;
            {
                const u32x2 w = w0[rr]; float x[4] = {lo_bf(w.x), hi_bf(w.x), lo_bf(w.y), hi_bf(w.y)};
                float ss = (lane < 48) ? (x[0] * x[0] + x[1] * x[1] + x[2] * x[2] + x[3] * x[3]) : 0.f; ss = wave_sum(ss);
                const float rs = rsqrtf(ss * (1.f / 192.f) + EPS);
                float xp[4];
#pragma unroll
                for (int i = 0; i < 4; ++i) xp[i] = swz_xor<2>(x[i]);
                u32x2 o; o.x = 0u; o.y = 0u;
                if (lane < 48) { o.x = cvt_pk_bf16(x[0] * rs * gcq[0], x[1] * rs * gcq[1]); o.y = cvt_pk_bf16(x[2] * rs * gcq[2], x[3] * rs * gcq[3]); }
                else if (lane < 56) {
                    const int t = lane - 48; float y[4];
                    if (islat) { const int pos = (t & 4) ? colpos : rowpos; const bool isx2 = (t & 2) != 0;
#pragma unroll
                        for (int i = 0; i < 4; ++i) { const int f = 4 * (t & 1) + i; const float cs = ropeM[(pos * 8 + f) * 2], sn = ropeM[(pos * 8 + f) * 2 + 1]; y[i] = isx2 ? (xp[i] * sn + x[i] * cs) : (x[i] * cs - xp[i] * sn); } }
                    else {
#pragma unroll
                        for (int i = 0; i < 4; ++i) y[i] = x[i]; }
                    u32x2 kk; kk.x = cvt_pk_bf16(y[0], y[1]); kk.y = cvt_pk_bf16(y[2], y[3]); *(u32x2*)(kr + (size_t)row * 32 + t * 4) = kk;
                }
                if (!c.dry) *(u32x2*)(B0 + ro) = o;
            }
            {
                const u32x2 w = w1[rr]; float x[4] = {lo_bf(w.x), hi_bf(w.x), lo_bf(w.y), hi_bf(w.y)};
                float ss = (lane < 32) ? (x[0] * x[0] + x[1] * x[1] + x[2] * x[2] + x[3] * x[3]) : 0.f; ss = wave_sum(ss);
                const float rs = rsqrtf(ss * (1.f / 128.f) + EPS);
                u32x2 o; o.x = 0u; o.y = 0u;
                if (lane < 32) { o.x = cvt_pk_bf16(x[0] * rs * gckv[0], x[1] * rs * gckv[1]); o.y = cvt_pk_bf16(x[2] * rs * gckv[2], x[3] * rs * gckv[3]); }
                if (!c.dry) *(u32x2*)(B1 + ro) = o;
            }
#pragma unroll
            for (int which = 0; which < 2; ++which) {
                const u32x2 w = which == 0 ? w3[rr] : w4[rr]; float x[4] = {lo_bf(w.x), hi_bf(w.x), lo_bf(w.y), hi_bf(w.y)};
                float ss = x[0] * x[0] + x[1] * x[1] + x[2] * x[2] + x[3] * x[3];
                ss += swz_xor<1>(ss); ss += swz_xor<2>(ss); ss += swz_xor<4>(ss); ss += swz_xor<8>(ss);
                const float rs = rsqrtf(ss * (1.f / 64.f) + EPS);
                const int t = lane & 15; const f32x4 g = which == 0 ? gq : gk;
#pragma unroll
                for (int i = 0; i < 4; ++i) x[i] = x[i] * rs * g[i];
                float xp[4];
#pragma unroll
                for (int i = 0; i < 4; ++i) xp[i] = swz_xor<4>(x[i]);
                if (islat) { const int pos = (t & 8) ? colpos : rowpos; const bool isx2 = (t & 4) != 0;
#pragma unroll
                    for (int i = 0; i < 4; ++i) { const int f = 4 * (t & 3) + i; const float cs = ropeG[(pos * 16 + f) * 2], sn = ropeG[(pos * 16 + f) * 2 + 1]; x[i] = isx2 ? (xp[i] * sn + x[i] * cs) : (x[i] * cs - xp[i] * sn); } }
                if (which == 0) { const float qs = 0.125f * LOG2E; u32x2 o; o.x = cvt_pk_bf16(x[0] * qs, x[1] * qs); o.y = cvt_pk_bf16(x[2] * qs, x[3] * qs); if (!c.dry) *(u32x2*)(B3 + ro) = o; }
                else if (lane < 32) { u32x2 o; o.x = cvt_pk_bf16(x[0], x[1]); o.y = cvt_pk_bf16(x[2], x[3]); *(u32x2*)(kg + ((size_t)(b * 2 + (lane >> 4)) * NTOK + j) * 64 + t * 4) = o; }
            }
        }
    }
}
template <int DK, bool SUB, bool NOMAX = false>
__device__ __forceinline__ bool attn_unit(float (&rowmax)[2], const Ctx& c, const bf16_t* Qp, int qpitch, const bf16_t* Kp, const bf16_t* Vtp, int kt0, int nkt, int nrows,
                                          const bf16_t* gatep, bf16_t* outp, bool rope, int j0, float qscale, const float* ropeM) {
    constexpr int KS = DK / 16, KPC = DK / 8, KPITCH = DK * 2 + 16, KB = 64 * KPITCH, VPITCH = 136, VB = 64 * VPITCH;
    constexpr int KOFF = 0, VOFF = 3 * KB;
    constexpr float LIM = 60.f;
    static_assert(KB % 16 == 0 && VB % 16 == 0, "attention LDS buffer alignment");
    const int tid = c.tid, lane = c.lane, wave = c.wave;
    const int lq_ = opaque(lane), q = lq_ & 31, h = lq_ >> 5;
    LAS unsigned char* lds = c.lds;
    const int rbase = (wave * 64 < nrows) ? wave * 64 : wave * 64 - 256;
    const bool live = wave * 64 < nrows;
    bf16x8 qf[2][KS];
#pragma unroll
    for (int qt = 0; qt < 2; ++qt) {
        const bf16_t* qrow = Qp + (size_t)(rbase + qt * 32 + q) * qpitch + 8 * h;
#pragma unroll
        for (int ks = 0; ks < KS; ++ks) qf[qt][ks] = *(const bf16x8*)(qrow + 16 * ks);
        if (DK == 96) {
            const int jj = j0 + rbase + qt * 32 + q;
#pragma unroll
            for (int ks = 0; ks < KS; ++ks) {
                float x[8]; unpack8(__builtin_bit_cast(u32x4, qf[qt][ks]), x);
                if (ks >= 4) {
                    const int pos = (ks == 4) ? ((jj >> 6) & 63) : (jj & 63);
#pragma unroll
                    for (int e = 0; e < 8; ++e) { const float xp = half_other(x[e], h); const float cs = ropeM[(pos * 8 + e) * 2], sn = ropeM[(pos * 8 + e) * 2 + 1];
                        const float r = h ? (xp * sn + x[e] * cs) : (x[e] * cs - xp * sn); x[e] = rope ? r : x[e]; }
                }
                u32x4 w; w.x = cvt_pk_bf16(x[0] * qscale, x[1] * qscale); w.y = cvt_pk_bf16(x[2] * qscale, x[3] * qscale); w.z = cvt_pk_bf16(x[4] * qscale, x[5] * qscale); w.w = cvt_pk_bf16(x[6] * qscale, x[7] * qscale);
                qf[qt][ks] = __builtin_bit_cast(bf16x8, w);
            }
        }
    }
    f32x16 o00, o01, o10, o11;
#pragma unroll
    for (int i = 0; i < 16; ++i) { o00[i] = 0.f; o01[i] = 0.f; o10[i] = 0.f; o11[i] = 0.f; }
    const float m0 = SUB ? rowmax[0] : 0.f, m1 = SUB ? rowmax[1] : 0.f; float l0 = 0.f, l1 = 0.f;
    float rmax0 = -1e30f, rmax1 = -1e30f;
    const int tq_ = opaque(tid);
    const int kst0 = (tq_ / KPC) * KPITCH + (tq_ % KPC) * 16, kst1 = ((tq_ + 512) / KPC) * KPITCH + ((tq_ + 512) % KPC) * 16;
    const int kgl0 = ((tq_ / KPC) * DK + (tq_ % KPC) * 8) * 2, kgl1 = (((tq_ + 512) / KPC) * DK + ((tq_ + 512) % KPC) * 8) * 2;
    const int vst = (tq_ >> 3) * VPITCH + (tq_ & 7) * 16, vgl = ((tq_ >> 3) * NTOK + (tq_ & 7) * 8) * 2;
    const bool has2 = (DK == 96) && tq_ < 256;
    const int kfo = q * KPITCH + 16 * h, vfo = q * VPITCH + 8 * h;
    const char* Kc = (const char*)Kp; const char* Vc = (const char*)Vtp;
    u32x4 kreg0, kreg1 = {0u, 0u, 0u, 0u}, vreg;
#define AT_GLOADK(kt) do { const char* kb_ = Kc + (size_t)(kt) * (64 * DK * 2); kreg0 = *(const u32x4*)(kb_ + kgl0); if (has2) kreg1 = *(const u32x4*)(kb_ + kgl1); } while (0)
#define AT_GLOADV(kt) do { vreg = *(const u32x4*)(Vc + (size_t)(kt) * 128 + vgl); } while (0)
#define AT_WRITEK(bi) do { LAS unsigned char* bb = lds + KOFF + (bi) * KB; *(LAS u32x4*)(bb + kst0) = kreg0; if (has2) *(LAS u32x4*)(bb + kst1) = kreg1; } while (0)
#define AT_WRITEV(bi) do { LAS u32x2* vd = (LAS u32x2*)(lds + VOFF + (bi) * VB + vst); vd[0] = (u32x2){vreg.x, vreg.y}; vd[1] = (u32x2){vreg.z, vreg.w}; } while (0)
#define AT_QK(S0, S1, bi, jh) do { const LAS unsigned char* kb = lds + KOFF + (bi) * KB + (jh) * 32 * KPITCH + kfo; \
        _Pragma("unroll") for (int i = 0; i < 16; ++i) { S0[i] = 0.f; S1[i] = 0.f; } \
        _Pragma("unroll") for (int ks = 0; ks < KS; ++ks) { \
            const bf16x8 a0 = *(const LAS bf16x8*)(kb + 32 * ks); \
            S0 = __builtin_amdgcn_mfma_f32_32x32x16_bf16(a0, qf[0][ks], S0, 0, 0, 0); \
            S1 = __builtin_amdgcn_mfma_f32_32x32x16_bf16(a0, qf[1][ks], S1, 0, 0, 0); } } while (0)
#define AT_MAX(S, RM) do { if (!SUB && !NOMAX) { _Pragma("unroll") for (int i = 0; i < 16; i += 2) RM = max3_raw(RM, S[i], S[i + 1]); } } while (0)
#define AT_EXP(S, M, L, PK0, PK1) do { float ps = 0.f; \
        _Pragma("unroll") for (int i = 0; i < 16; ++i) { S[i] = __builtin_amdgcn_exp2f(SUB ? S[i] - M : S[i]); ps += S[i]; } \
        L += ps; u32x4 w; \
        w.x = cvt_pk_bf16(S[0], S[1]); w.y = cvt_pk_bf16(S[2], S[3]); w.z = cvt_pk_bf16(S[4], S[5]); w.w = cvt_pk_bf16(S[6], S[7]); PK0 = __builtin_bit_cast(bf16x8, w); \
        w.x = cvt_pk_bf16(S[8], S[9]); w.y = cvt_pk_bf16(S[10], S[11]); w.z = cvt_pk_bf16(S[12], S[13]); w.w = cvt_pk_bf16(S[14], S[15]); PK1 = __builtin_bit_cast(bf16x8, w); } while (0)
#define AT_SUB(SC0, SC1, SN0, SN1, vbi, jh, nbi, njh) do { \
        AT_MAX(SC0, rmax0); AT_MAX(SC1, rmax1); __builtin_amdgcn_sched_barrier(0); \
        AT_QK(SN0, SN1, nbi, njh); \
        bf16x8 p00, p01, p10, p11; \
        AT_EXP(SC0, m0, l0, p00, p01); AT_EXP(SC1, m1, l1, p10, p11); __builtin_amdgcn_sched_barrier(0); \
        const LAS unsigned char* vb = lds + VOFF + (vbi) * VB + (jh) * 64 + vfo; \
        _Pragma("unroll") for (int st = 0; st < 2; ++st) { \
            const u32x2 la = *(const LAS u32x2*)(vb + 32 * st), ha = *(const LAS u32x2*)(vb + 32 * st + 16), lb = *(const LAS u32x2*)(vb + 32 * VPITCH + 32 * st), hb = *(const LAS u32x2*)(vb + 32 * VPITCH + 32 * st + 16); \
            const bf16x8 va0 = __builtin_bit_cast(bf16x8, (u32x4){la.x, la.y, ha.x, ha.y}), va1 = __builtin_bit_cast(bf16x8, (u32x4){lb.x, lb.y, hb.x, hb.y}); \
            o00 = __builtin_amdgcn_mfma_f32_32x32x16_bf16(va0, st ? p01 : p00, o00, 0, 0, 0); \
            o01 = __builtin_amdgcn_mfma_f32_32x32x16_bf16(va1, st ? p01 : p00, o01, 0, 0, 0); \
            o10 = __builtin_amdgcn_mfma_f32_32x32x16_bf16(va0, st ? p11 : p10, o10, 0, 0, 0); \
            o11 = __builtin_amdgcn_mfma_f32_32x32x16_bf16(va1, st ? p11 : p10, o11, 0, 0, 0); } \
        __builtin_amdgcn_sched_barrier(0); } while (0)
    if (!SUB && !NOMAX && tid == 0) *(volatile LAS unsigned*)(lds + LDS_MISC_OFF + 24) = 0u;
    AT_GLOADK(kt0); AT_GLOADV(kt0); AT_WRITEK(0); AT_WRITEV(0);
    AT_GLOADK(kt0 + 1); AT_WRITEK(1);
    __syncthreads();
    f32x16 sa0, sa1, sb0, sb1;
    AT_QK(sa0, sa1, 0, 0);
    int kb0 = 0, kb1 = 1, kb2 = 2;
    for (int t = 0; t < nkt; ++t) {
        const int tk = (t + 2 < nkt) ? t + 2 : nkt - 1, tv = (t + 1 < nkt) ? t + 1 : nkt - 1;
        AT_GLOADK(kt0 + tk);
        AT_SUB(sa0, sa1, sb0, sb1, t & 1, 0, kb0, 1);
        AT_WRITEK(kb2);
        AT_GLOADV(kt0 + tv);
        AT_SUB(sb0, sb1, sa0, sa1, t & 1, 1, kb1, 0);
        AT_WRITEV((t + 1) & 1);
        __syncthreads();
        const int tmp = kb0; kb0 = kb1; kb1 = kb2; kb2 = tmp;
    }
#undef AT_GLOADK
#undef AT_GLOADV
#undef AT_WRITEK
#undef AT_WRITEV
#undef AT_QK
#undef AT_MAX
#undef AT_EXP
#undef AT_SUB
    bool bad = false;
    if (!SUB && !NOMAX) { const float r0 = half_max(rmax0), r1 = half_max(rmax1); rowmax[0] = r0; rowmax[1] = r1; const bool b_ = live && !(r0 < LIM && r0 > -LIM && r1 < LIM && r1 > -LIM); volatile LAS unsigned* flg = (volatile LAS unsigned*)(lds + LDS_MISC_OFF + 24); if (__any(b_ ? 1 : 0) && opaque(lane) == 0) *flg = 1u; __syncthreads(); bad = *flg != 0u; __syncthreads(); }
    if (live && !bad) {
        const int le_ = opaque(lane), q = le_ & 31, h = le_ >> 5;
#pragma unroll
        for (int qt = 0; qt < 2; ++qt) {
            const float lr = qt ? l1 : l0; const float lt = half_sum(lr), inv = 1.f / lt;
            const size_t row = (size_t)(rbase + qt * 32 + q);
#pragma unroll
            for (int dt = 0; dt < 2; ++dt)
#pragma unroll
                for (int g4 = 0; g4 < 4; ++g4) {
                    const int dv0 = dt * 32 + 8 * g4 + 4 * h;
                    const u32x2 gw = *(const u32x2*)(gatep + row * 256 + dv0);
                    const float g0 = siluf(lo_bf(gw.x)), g1 = siluf(hi_bf(gw.x)), g2 = siluf(lo_bf(gw.y)), g3 = siluf(hi_bf(gw.y));
                    const f32x16& o = qt ? (dt ? o11 : o10) : (dt ? o01 : o00);
                    u32x2 w; w.x = cvt_pk_bf16(o[4 * g4] * inv * g0, o[4 * g4 + 1] * inv * g1); w.y = cvt_pk_bf16(o[4 * g4 + 2] * inv * g2, o[4 * g4 + 3] * inv * g3);
                    *(u32x2*)(outp + row * DM + dv0) = w;
                }
        }
    }
    return bad;
}

template <int N>
__device__ __forceinline__ void hyena_conv(const Ctx& c, LAS unsigned char* ub, LAS unsigned char* gb, int pass, const bf16_t* xmul  , float bias,
                                           bf16_t* zdst  , const bf16_t* gmul, bf16_t* cat  , float cw0, float cw1, float cw2, float cb  ) {
    constexpr int UP = (N + 256) * 2 + 16, NPAIR = N / 256, OFF8 = N - 8;
    const int lane = c.lane, i16 = lane & 15, kq = lane >> 4;
    for (int pr = c.wave; pr < NPAIR; pr += 8) {
        const int t0 = pr * 256;
        u32x4 xq[2][4], gq[2][4]; bf16_t xl[2][4], xr[2][4];
#pragma unroll
        for (int half = 0; half < 2; ++half)
#pragma unroll
            for (int r = 0; r < 4; ++r) { const int t8 = t0 + half * 128 + 32 * kq + 8 * r; const bf16_t* xp_ = xmul + (size_t)i16 * NTOK + t8; xq[half][r] = *(const u32x4*)xp_;
                xl[half][r] = (t8 > 0) ? xp_[-1] : (bf16_t)0; xr[half][r] = (t8 + 8 < N) ? xp_[8] : (bf16_t)0;
                gq[half][r] = (pass == 1) ? *(const u32x4*)(gmul + (size_t)i16 * NTOK + t8) : (u32x4){0u, 0u, 0u, 0u}; }
        f32x4 acc[2][8];
#pragma unroll
        for (int m = 0; m < 8; ++m) { acc[0][m] = (f32x4){0.f, 0.f, 0.f, 0.f}; acc[1][m] = (f32x4){0.f, 0.f, 0.f, 0.f}; }
        const LAS unsigned char* up = ub + i16 * UP + 256 + kq * 16;
        const LAS unsigned char* gp = gb + (OFF8 - t0 - 8 * i16 + 8 * kq) * 2;
        bf16x8 bfa = *(const LAS bf16x8*)(up - 256), bfb = *(const LAS bf16x8*)(up);
        u32x4 wa = *(const LAS u32x4*)(gp - 256), wb = *(const LAS u32x4*)(gp - 256 + 16);
        for (int s0 = -128; s0 < N; s0 += 32) {
            const int sn = (s0 + 32 < N) ? s0 + 32 : s0;
            const bf16x8 bfan = *(const LAS bf16x8*)(up + sn * 2), bfbn = *(const LAS bf16x8*)(up + sn * 2 + 256);
            const u32x4 wan = *(const LAS u32x4*)(gp + sn * 2), wbn = *(const LAS u32x4*)(gp + sn * 2 + 16);
            const unsigned w[8] = {wa.x, wa.y, wa.z, wa.w, wb.x, wb.y, wb.z, wb.w};
            unsigned sh[7];
#pragma unroll
            for (int k = 0; k < 7; ++k) sh[k] = __builtin_amdgcn_alignbit(w[k + 1], w[k], 16);
#pragma unroll
            for (int m = 0; m < 8; ++m) {
                u32x4 a;
                if (m & 1) { const int d0 = (7 - m) >> 1; a = (u32x4){w[d0], w[d0 + 1], w[d0 + 2], w[d0 + 3]}; }
                else { const int d0 = (6 - m) >> 1; a = (u32x4){sh[d0], sh[d0 + 1], sh[d0 + 2], sh[d0 + 3]}; }
                acc[0][m] = __builtin_amdgcn_mfma_f32_16x16x32_bf16(__builtin_bit_cast(bf16x8, a), bfa, acc[0][m], 0, 0, 0);
                acc[1][m] = __builtin_amdgcn_mfma_f32_16x16x32_bf16(__builtin_bit_cast(bf16x8, a), bfb, acc[1][m], 0, 0, 0);
            }
            bfa = bfan; bfb = bfbn; wa = wan; wb = wbn;
        }
#pragma unroll
        for (int half = 0; half < 2; ++half)
#pragma unroll
            for (int r = 0; r < 4; ++r) {
                const int t8 = t0 + half * 128 + 32 * kq + 8 * r;
                float uu[8], xr8[8], xm[8]; unpack8(*(const LAS u32x4*)(ub + i16 * UP + 256 + t8 * 2), uu); unpack8(xq[half][r], xr8);
                {   float pv = bf2f(xl[half][r]);
#pragma unroll
                    for (int m = 0; m < 8; ++m) { const float nx = (m < 7) ? xr8[m + 1] : bf2f(xr[half][r]); xm[m] = bf2f(f2bf(cw0 * pv + cw1 * xr8[m] + cw2 * nx + cb)); pv = xr8[m]; } }
                float y[8];
#pragma unroll
                for (int m = 0; m < 8; ++m) y[m] = xm[m] * (acc[half][m][r] + bias * uu[m]);
                if (pass == 0) { u32x4 o; o.x = cvt_pk_bf16(y[0], y[1]); o.y = cvt_pk_bf16(y[2], y[3]); o.z = cvt_pk_bf16(y[4], y[5]); o.w = cvt_pk_bf16(y[6], y[7]); *(u32x4*)(zdst + (size_t)i16 * NTOK + t8) = o; }
                else { float gg[8]; unpack8(gq[half][r], gg);
#pragma unroll
                    for (int m = 0; m < 8; ++m) gg[m] = bf2f(f2bf(siluf(gg[m])));
                    u32x4 o; o.x = cvt_pk_bf16(y[0] * gg[0], y[1] * gg[1]); o.y = cvt_pk_bf16(y[2] * gg[2], y[3] * gg[3]); o.z = cvt_pk_bf16(y[4] * gg[4], y[5] * gg[5]); o.w = cvt_pk_bf16(y[6] * gg[6], y[7] * gg[7]);
                    *(u32x4*)(cat + (size_t)i16 * NTOK + t8) = o; }
            }
    }
}
template <int N>
__device__ __forceinline__ void hyena_seq(const Ctx& c, int l, int ch, int toff) {
    constexpr int UP = (N + 256) * 2 + 16;
    LAS unsigned char* ub = c.lds; LAS unsigned char* gb = c.lds + 16 * UP;
    const bf16_t* vv = wsp<bf16_t>(c, WS_HYV) + (size_t)ch * 16 * NTOK + toff;
    bf16_t* vz = wsp<bf16_t>(c, WS_HYZ) + (size_t)ch * 16 * NTOK + toff;
    const bf16_t* x1 = wsp<bf16_t>(c, WS_HYX1) + (size_t)ch * 16 * NTOK + toff;
    const bf16_t* x2 = wsp<bf16_t>(c, WS_HYX2) + (size_t)ch * 16 * NTOK + toff;
    const bf16_t* gm = wsp<bf16_t>(c, WS_HYG) + (size_t)ch * 16 * NTOK + toff;
    bf16_t* cat = wsp<bf16_t>(c, WS_HYY) + (size_t)ch * 16 * NTOK + toff;
    { const int e = c.tid, b = e >> 5, side = (e >> 4) & 1, pc = e & 15; unsigned z = 0u; asm volatile("" : "+v"(z)); *(LAS u32x4*)(ub + b * UP + side * (256 + N * 2) + pc * 16) = (u32x4){z, z, z, z}; }
    for (int pass = 0; pass < 2; ++pass) {
        const bf16_t* gr = (N == SEQL) ? wsp<bf16_t>(c, WS_GR) + (((size_t)l * 2 + pass) * 256 + ch) * 8192 : wsp<bf16_t>(c, WS_GRC) + (((size_t)l * 2 + pass) * 256 + ch) * 512;
        const bf16_t* usrc = pass == 0 ? vv : vz;
        constexpr int NG = (2 * N / 8 + 511) / 512;
        {
            u32x4 t[NG];
#pragma unroll
            for (int k = 0; k < NG; ++k) { const int e = c.tid + k * 512; t[k] = (e < 2 * N / 8) ? *(const u32x4*)(gr + e * 8) : (u32x4){0u, 0u, 0u, 0u}; }
#pragma unroll
            for (int k = 0; k < NG; ++k) { const int e = c.tid + k * 512; if (e < 2 * N / 8) *(LAS u32x4*)(gb + e * 16) = t[k]; }
        }
        if constexpr (N == SEQL) {
#pragma unroll
            for (int k0 = 0; k0 < 16; k0 += 8) {
                u32x4 t[8];
#pragma unroll
                for (int k = 0; k < 8; ++k) t[k] = *(const u32x4*)(usrc + (size_t)(k0 + k) * NTOK + c.tid * 8);
#pragma unroll
                for (int k = 0; k < 8; ++k) *(LAS u32x4*)(ub + (k0 + k) * UP + 256 + c.tid * 16) = t[k];
            }
        } else {
            const int b = c.tid >> 5, pc = c.tid & 31;
            *(LAS u32x4*)(ub + b * UP + 256 + pc * 16) = *(const u32x4*)(usrc + (size_t)b * NTOK + pc * 8);
        }
        __syncthreads();
        const float* hcw = KIN(I_HCW) + (size_t)l * 3 * 768; const float* hcb = KIN(I_HCB) + l * 768;
        if (pass == 0) {
            const float w0 = hcw[ch], w1 = hcw[768 + ch], w2 = hcw[1536 + ch], bs = hcb[ch];
            constexpr int PPT = (N == SEQL) ? 16 : 1;
            u32x4 o[PPT];
#pragma unroll
            for (int k = 0; k < PPT; ++k) { const int b = (N == SEQL) ? k : (c.tid >> 5), pc = (N == SEQL) ? c.tid : (c.tid & 31); const LAS unsigned char* p = ub + b * UP + 256 + pc * 16;
                float x[8]; unpack8(*(const LAS u32x4*)p, x); float pv = bf2f(*(const LAS bf16_t*)(p - 2)); const float nx8 = bf2f(*(const LAS bf16_t*)(p + 16)); float y[8];
#pragma unroll
                for (int m = 0; m < 8; ++m) { const float nx = (m < 7) ? x[m + 1] : nx8; y[m] = w0 * pv + w1 * x[m] + w2 * nx + bs; pv = x[m]; }
                o[k].x = cvt_pk_bf16(y[0], y[1]); o[k].y = cvt_pk_bf16(y[2], y[3]); o[k].z = cvt_pk_bf16(y[4], y[5]); o[k].w = cvt_pk_bf16(y[6], y[7]); }
            __syncthreads();
#pragma unroll
            for (int k = 0; k < PPT; ++k) { const int b = (N == SEQL) ? k : (c.tid >> 5), pc = (N == SEQL) ? c.tid : (c.tid & 31); *(LAS u32x4*)(ub + b * UP + 256 + pc * 16) = o[k]; }
            __syncthreads();
        }
        const float bias = KIN(I_HBIAS)[((size_t)l * 2 + pass) * 256 + ch];
        const int cc = (pass + 1) * 256 + ch;
        hyena_conv<N>(c, ub, gb, pass, pass == 0 ? x1 : x2, bias, vz, gm, cat, hcw[cc], hcw[768 + cc], hcw[1536 + cc], hcb[cc]);
        asm volatile("s_waitcnt vmcnt(0)" ::: "memory");
        __syncthreads();
    }
}

__device__ __forceinline__ void hyena_untranspose(const Ctx& c, int tl0, int tl1) {
    const bf16_t* yT = wsp<bf16_t>(c, WS_HYY); bf16_t* cat = wsp<bf16_t>(c, WS_HCAT);
    LAS bf16_t* T = (LAS bf16_t*)c.lds;
    LAS unsigned* T32 = (LAS unsigned*)c.lds;
    for (int tl = tl0; tl < tl1; ++tl) {
        const int b = tl / 68, j0 = (tl - b * 68) * 64;
        u32x4 pre[4];
#pragma unroll
        for (int k = 0; k < 4; ++k) { const int e = c.tid + k * 512, ch = e >> 3, pc = e & 7; pre[k] = *(const u32x4*)(yT + ((size_t)ch * 16 + b) * NTOK + j0 + pc * 8); }
#pragma unroll
        for (int k = 0; k < 4; ++k) { const int e = c.tid + k * 512, ch = e >> 3, pc = e & 7; LAS unsigned* d = T32 + (ch * 132 + pc * 16) / 4; d[0] = pre[k].x; d[1] = pre[k].y; d[2] = pre[k].z; d[3] = pre[k].w; }
        __syncthreads();
#pragma unroll
        for (int k = 0; k < 4; ++k) { const int e = c.tid + k * 512, t = e >> 5, c0 = (e & 31) * 8; float v[8];
#pragma unroll
            for (int i = 0; i < 8; ++i) v[i] = bf2f(T[(c0 + i) * 66 + t]);
            u32x4 w; w.x = cvt_pk_bf16(v[0], v[1]); w.y = cvt_pk_bf16(v[2], v[3]); w.z = cvt_pk_bf16(v[4], v[5]); w.w = cvt_pk_bf16(v[6], v[7]);
            *(u32x4*)(cat + ((size_t)b * NTOK + j0 + t) * DM + 768 + c0) = w; }
        __syncthreads();
    }
}

__device__ __forceinline__ void ssm_scan_item(const Ctx& c, int l, int item) {
    const int b = item >> 2, g = (item & 3) * 4 + (c.tid >> 7), dq = (c.tid >> 6) & 1, p = c.tid & 63;
    const float* a16 = wsp<float>(c, WS_A16) + ((((size_t)l * 2 + dq) * 16 + g) * 64 + p) * 2;
    const float ar = a16[0], ai = a16[1];
    const bf16_t* E = wsp<bf16_t>(c, WS_E); bf16_t* US = wsp<bf16_t>(c, WS_US);
    float sr = 0.f, si = 0.f;
    for (int st0 = 0; st0 < NCHB; st0 += 8) {
        float er[8], ei[8]; size_t ro[8];
#pragma unroll
        for (int k = 0; k < 8; ++k) { const int st = st0 + k; const int cc = dq == 0 ? (st < 16 ? 256 + st : st - 16) : (st < 16 ? 271 - st : 255 - (st - 16));
            ro[k] = (size_t)g * NCHUNK + (size_t)b * NCHB + cc; er[k] = bf2f(E[ro[k] * 256 + dq * 128 + p]); ei[k] = bf2f(E[ro[k] * 256 + dq * 128 + 64 + p]); }
#pragma unroll
        for (int k = 0; k < 8; ++k) {
            US[ro[k] * 512 + 256 + dq * 128 + p] = f2bf(sr); US[ro[k] * 512 + 256 + dq * 128 + 64 + p] = f2bf(si);
            const float nr = ar * sr - ai * si + er[k], ni = ar * si + ai * sr + ei[k]; sr = nr; si = ni;
        }
    }
}

constexpr int LDS_BYTES = 163840;
constexpr int LDS_MISC = LDS_MISC_OFF;
static_assert(LDS_MISC_OFF == LDS_BYTES - 256, "LDS map");
constexpr int NPRO = 1, NPH = 6, NPHASES = NPRO + DEPTH * NPH;
constexpr int QI_HY = 256, QI_SCAN = 64, QI_ATTL = NB * 8 * 8, QI_SSM2 = 16 * 17, QI_UNT = 272, QI_ATTC = NB * 8, QI_GLU = MROWS / 256;
constexpr int QO_SCAN = QI_HY, QO_ATTL = QO_SCAN + QI_SCAN, QO_SSM2 = QO_ATTL + QI_ATTL, QO_UNT = QO_SSM2 + QI_SSM2, QO_ATTC = QO_UNT + QI_UNT, QO_GLU = QO_ATTC + QI_ATTC, QI_TOTAL = QO_GLU + QI_GLU;
#ifndef PROBE_DUP_MASK
#define PROBE_DUP_MASK 0
#endif
#ifndef PROBE_P4KINDS
#define PROBE_P4KINDS 0x7f
#endif
__device__ __forceinline__ void dep_signal(const Ctx& c, unsigned* cnt) {
    asm volatile("s_waitcnt vmcnt(0)" ::: "memory");
    __syncthreads();
    if (c.tid == 0) { __builtin_amdgcn_fence(__ATOMIC_RELEASE, "agent"); asm volatile("s_waitcnt vmcnt(0)" ::: "memory"); (void)xb_add(cnt, 1u); }
}
__device__ __forceinline__ void dep_wait(const Ctx& c, unsigned* cnt, unsigned need, unsigned* tmo) {
    if (c.dry) return;
    if (c.tid == 0) {
        unsigned sp = 0;
        while (xb_ld(cnt) < need) { __builtin_amdgcn_s_sleep(2); if ((++sp & 255u) == 0u) { if (xb_ld(tmo)) break; if (sp > XB_SPIN_CAP) { atomicAdd(tmo, 1u); break; } } }
        __builtin_amdgcn_fence(__ATOMIC_ACQUIRE, "agent");
        asm volatile("s_waitcnt vmcnt(0)" ::: "memory");
    }
    __syncthreads();
}

__global__ void __launch_bounds__(512, 2) mk_fwd(Params prm) {
    extern __shared__ __attribute__((aligned(16))) unsigned char lds_raw[];
    Ctx c; c.lds = (LAS unsigned char*)lds_raw; c.ka = (kargp_t)__builtin_amdgcn_kernarg_segment_ptr(); c.ws = prm.ws; c.tid = threadIdx.x; c.lane = c.tid & 63; c.wave = __builtin_amdgcn_readfirstlane(c.tid >> 6); c.G = gridDim.x; c.bid = blockIdx.x; c.dry = prm.dry;
    const int wave0 = c.wave;
    volatile LAS unsigned* misc = (volatile LAS unsigned*)(c.lds + LDS_MISC);
    if (c.tid < 16) misc[c.tid] = 0u;
    __syncthreads();
    unsigned* ctl = wsp<unsigned>(c, WS_CTL);
    const int lo = prm.ph_lo, hi = prm.ph_hi;
    const bool fused = (hi - lo) > 1;
    XcdBarrier bar; bar.bar = ctl + CW_BAR; bar.x = 0; bar.st = misc;
    if (fused) bar = xcd_barrier_post(ctl + CW_BAR, misc);
#ifndef SITE_MASK
#define SITE_MASK 0x3ff
#endif
#define SITE(n) (((SITE_MASK) >> (n)) & 1)
#define IN(k) (lo <= (k) && (k) < hi)
#define FRESH() do { { kargp_t _k = (kargp_t)__builtin_amdgcn_kernarg_segment_ptr(); asm volatile("" : "+s"(_k)); c.ka = _k; c.ws = (unsigned char*)(GAS unsigned char*)_k[37]; } { int _w = wave0; asm volatile("" : "+s"(_w)); c.wave = _w; c.lane = lane_id_fresh(); c.tid = c.wave * 64 + c.lane; } } while (0)
#define SEAM(k) do { if (IN((k) + 1)) xcd_barrier(bar); } while (0)

    if (SITE(0) && IN(0)) {
        FRESH();
        constexpr int J_MOD = 192, J_HY = 544, J_SSM = 64, J_WIN = 4 * 48 * 8, J_WOUT = 4 * 16 * 8, J_WUQ = 4 * 8 * 2, J_W256 = 4 * 4 * 2, J_NORM = MROWS / 256, J_PACK = 4 * 2 * 256;
        constexpr int J0 = J_MOD, J1 = J0 + J_HY, J2 = J1 + J_SSM, J3 = J2 + J_WIN, J4 = J3 + J_WOUT, J5 = J4 + J_WUQ, J6 = J5 + J_W256, J7 = J6 + J_W256, J8 = J7 + J_W256, J9 = J8 + 1, J10 = J9 + J_NORM, J11 = J10 + J_PACK;
        unsigned* dep = ctl + CW_DEP + DEP_SET * 8;
        unsigned* tmo = ctl + CW_BAR + XB_TMO;
        for (int job = c.bid; job < J11; job += c.G) {
            FRESH();
            if (job < J0) { modv_job(c, job); dep_signal(c, dep); }
            else if (job < J1) { hyena_mlp_job(c, job - J0); dep_signal(c, dep + 64); }
            else if (job < J2) ssm_tables_job(c, job - J1);
            else if (job < J3) { const int r = job - J2, l = r / 384, q = r % 384; wconv_tile(c, KIN(I_WIN) + (size_t)l * DM * INC, DM, INC, INP, wsp<bf16_t>(c, WS_WIN) + (size_t)l * INP * DM, DM, 0, q / 8, q % 8); }
            else if (job < J4) { const int r = job - J3, l = r / 128, q = r % 128; wconv_tile(c, KIN(I_WOUT) + (size_t)l * DM * DM, DM, DM, DM, wsp<bf16_t>(c, WS_WOUT) + (size_t)l * DM * DM, DM, 1, q / 8, q % 8); }
            else if (job < J5) { const int r = job - J4, l = r / 16, q = r % 16; wconv_tile(c, KIN(I_WUQ) + (size_t)l * 192 * 384, 192, 384, 384, wsp<bf16_t>(c, WS_WUQ) + (size_t)l * 512 * 256, 256, 1, q / 2, q % 2); }
            else if (job < J6) { const int r = job - J5, l = r / 8, q = r % 8; wconv_tile(c, KIN(I_WUKV) + (size_t)l * 128 * 512, 128, 512, 256, wsp<bf16_t>(c, WS_WUK) + (size_t)l * 256 * 256, 256, 2, q / 2, q % 2); }
            else if (job < J7) { const int r = job - J6, l = r / 8, q = r % 8; wconv_tile(c, KIN(I_WUKV) + (size_t)l * 128 * 512, 128, 512, 256, wsp<bf16_t>(c, WS_WUV) + (size_t)l * 256 * 256, 256, 3, q / 2, q % 2); }
            else if (job < J8) { const int r = job - J7, l = r / 8, q = r % 8; wconv_tile(c, KIN(I_GLUW) + (size_t)l * 256 * 256, 256, 256, 256, wsp<bf16_t>(c, WS_WGLU) + (size_t)l * 256 * 256, 256, 1, q / 2, q % 2); }
            else if (job < J9) rope_job(c);
            else if (job < J10) { dep_wait(c, dep, J_MOD, tmo); FRESH(); const int t = job - J9; norm_rows(c, -1, 0, t * 256, t * 256 + 256); }
            else { dep_wait(c, dep + 64, J_HY, tmo); FRESH(); hyena_pack_job(c, job - J10); }
        }
        SEAM(0);
    }
    for (int l = 0; l < DEPTH; ++l) {
        const int pbase = NPRO + l * NPH;
        if (SITE(2) && IN(pbase + 0)) {
            FRESH();
            pg8::Gemm g{wsp<bf16_t>(c, WS_HCAT), wsp<bf16_t>(c, WS_WIN) + (size_t)l * INP * DM, MROWS, INP, DM};
            pg8::StaticOrder S; S.init(MROWS, INP, c.G, c.bid);
            EpiInProj E{wsp<bf16_t>(c, WS_PB), wsp<bf16_t>(c, WS_UG), wsp<bf16_t>(c, WS_US), wsp<bf16_t>(c, WS_VTG), wsp<bf16_t>(c, WS_HYV), c.lds + pg8::STAGE_BYTES};
            pg8::gemm_phase(c.lds, g, S, E, c.tid);
            SEAM(pbase + 0);
        }
        if (SITE(3) && IN(pbase + 1)) { FRESH(); p2_rows(c, l); SEAM(pbase + 1); }
        if (SITE(4) && IN(pbase + 2)) {
            FRESH();
            pg8::Gemm g{wsp<bf16_t>(c, WS_PB), wsp<bf16_t>(c, WS_WUQ), MROWS, 512, 256};
            pg8::P3Order S{wsp<bf16_t>(c, WS_PB), wsp<bf16_t>(c, WS_PB) + BLKE, wsp<bf16_t>(c, WS_WUQ) + (size_t)l * 512 * 256, wsp<bf16_t>(c, WS_WUK) + (size_t)l * 256 * 256, wsp<bf16_t>(c, WS_WUV) + (size_t)l * 256 * 256,
                           wsp<bf16_t>(c, WS_UG), wsp<bf16_t>(c, WS_WE) + (size_t)l * 16 * 256 * 256, c.G, c.bid};
            EpiP3 E{{wsp<bf16_t>(c, WS_QM), 384, 384}, {wsp<bf16_t>(c, WS_KM), wsp<bf16_t>(c, WS_KR)}, {wsp<bf16_t>(c, WS_VTM)}, {wsp<bf16_t>(c, WS_E)}};
            pg8::gemm_phase(c.lds, g, S, E, c.tid);
            SEAM(pbase + 2);
        }
        if (SITE(5) && IN(pbase + 3)) {
            FRESH();
            unsigned* qh = ctl + CW_Q + 64 * (l + 4 * c.dry);
            unsigned* dep = ctl + CW_DEP + DEP_SET * (l + 4 * c.dry);
            unsigned* tmo = ctl + CW_BAR + XB_TMO;
            const float* ropeM = wsp<float>(c, WS_ROPEM);
            bool gqa_nomax;
            { float gq_ = fabsf(KIN(I_GQ)[l * 64 + c.lane]), gk_ = fabsf(KIN(I_GK)[l * 64 + c.lane]);
              gq_ = fmaxf(gq_, swz_xor<16>(gq_)); gq_ = fmaxf(gq_, swz_xor<8>(gq_)); gq_ = fmaxf(gq_, swz_xor<4>(gq_)); gq_ = fmaxf(gq_, swz_xor<2>(gq_)); gq_ = fmaxf(gq_, swz_xor<1>(gq_)); gq_ = half_max(gq_);
              gk_ = fmaxf(gk_, swz_xor<16>(gk_)); gk_ = fmaxf(gk_, swz_xor<8>(gk_)); gk_ = fmaxf(gk_, swz_xor<4>(gk_)); gk_ = fmaxf(gk_, swz_xor<2>(gk_)); gk_ = fmaxf(gk_, swz_xor<1>(gk_)); gk_ = half_max(gk_);
              const float bound = 64.f * gq_ * gk_ * 0.125f * LOG2E * 1.01f; gqa_nomax = __builtin_amdgcn_readfirstlane(bound < 50.f ? 1 : 0) != 0; }
#define ATT_CALL(DKV, ...) do { float rowmax_[2] = {0.f, 0.f}; if (attn_unit<DKV, false>(rowmax_, __VA_ARGS__)) { (void)attn_unit<DKV, true>(rowmax_, __VA_ARGS__); } } while (0)
            for (;;) {
                __syncthreads();
                if (c.tid == 0) misc[4] = __hip_atomic_fetch_add(qh, 1u, __ATOMIC_RELAXED, __HIP_MEMORY_SCOPE_AGENT);
                __syncthreads();
                const int it = (int)misc[4];
                if (it >= QI_TOTAL) break;
                FRESH();
                if (c.dry) { const int kd_ = it < QO_SCAN ? 0 : it < QO_ATTL ? 1 : it < QO_SSM2 ? 2 : it < QO_UNT ? 3 : it < QO_ATTC ? 4 : it < QO_GLU ? 5 : 6; if (!((c.dry >> (1 + kd_)) & 1)) continue; }
                if (it < QO_SCAN) { hyena_seq<SEQL>(c, l, it, 0); if (l + 1 < DEPTH) hyena_seq<CTXL>(c, l, it, SEQL); dep_signal(c, dep); }
                else if (it < QO_ATTL) { ssm_scan_item(c, l, it - QO_SCAN); dep_signal(c, dep + 64); }
                else if (it >= QO_ATTC && it < QO_GLU && l + 1 == DEPTH) {   }
                else if (it < QO_SSM2 || (it >= QO_ATTC && it < QO_GLU)) {
                    const bool isctx = it >= QO_ATTC; const int r = isctx ? it - QO_ATTC : (it - QO_ATTL) % (NB * 8), blk = isctx ? 8 : (it - QO_ATTL) / (NB * 8)  ;
                    const int kind = r & 1  , head = (r >> 1) & 3, b = r >> 3;
                    const size_t row0 = (size_t)b * NTOK + (isctx ? SEQL : blk * 512); const int kt0 = isctx ? 64 : 0, nkt = isctx ? 4 : 68, nrows = isctx ? 256 : 512;
                    if (kind == 0) { ATT_CALL(96, c, wsp<bf16_t>(c, WS_QM) + row0 * 384 + head * 96, 384, wsp<bf16_t>(c, WS_KM) + (size_t)(b * 4 + head) * NTOK * 96, wsp<bf16_t>(c, WS_VTM) + (size_t)(b * 4 + head) * 64 * NTOK,
                                                 kt0, nkt, nrows, wsp<bf16_t>(c, WS_PB) + 2 * BLKE + row0 * 256 + head * 64, wsp<bf16_t>(c, WS_HCAT) + row0 * DM + head * 64, !isctx, blk * 512, 0.10206207261596577f * LOG2E, ropeM); }
                    else if (gqa_nomax) { float rm_[2] = {0.f, 0.f}; (void)attn_unit<64, false, true>(rm_, c, wsp<bf16_t>(c, WS_PB) + 3 * BLKE + row0 * 256 + head * 64, 256, wsp<bf16_t>(c, WS_KG) + (size_t)(b * 2 + (head >> 1)) * NTOK * 64, wsp<bf16_t>(c, WS_VTG) + (size_t)(b * 2 + (head >> 1)) * 64 * NTOK,
                                       kt0, nkt, nrows, wsp<bf16_t>(c, WS_PB) + 5 * BLKE + row0 * 256 + head * 64, wsp<bf16_t>(c, WS_HCAT) + row0 * DM + 256 + head * 64, false, 0, 1.f, ropeM); }
                    else { ATT_CALL(64, c, wsp<bf16_t>(c, WS_PB) + 3 * BLKE + row0 * 256 + head * 64, 256, wsp<bf16_t>(c, WS_KG) + (size_t)(b * 2 + (head >> 1)) * NTOK * 64, wsp<bf16_t>(c, WS_VTG) + (size_t)(b * 2 + (head >> 1)) * 64 * NTOK,
                                       kt0, nkt, nrows, wsp<bf16_t>(c, WS_PB) + 5 * BLKE + row0 * 256 + head * 64, wsp<bf16_t>(c, WS_HCAT) + row0 * DM + 256 + head * 64, false, 0, 1.f, ropeM); }
                }
                else if (it < QO_UNT) {
                    const int L = it - QO_SSM2, i = L >> 4, g = L & 15;
                    dep_wait(c, dep + 64, QI_SCAN, tmo);
                    pg8::Gemm gm{wsp<bf16_t>(c, WS_US), wsp<bf16_t>(c, WS_WKC) + (size_t)l * 16 * 256 * 512, 16 * NCHUNK, 16 * 256, 512}; pg8::OneUnit S{g * 17 + i, g};
                    pg8::EpiWalk<PutSsmY> E{{wsp<bf16_t>(c, WS_ZS), wsp<bf16_t>(c, WS_UG), KIN(I_SSMD) + l * 256}}; pg8::gemm_phase(c.lds, gm, S, E, c.tid);
                    dep_signal(c, dep + 64 * (2 + i));
                }
                else if (it < QO_ATTC) {
                    dep_wait(c, dep, QI_HY, tmo);
                    const int j = it - QO_UNT; hyena_untranspose(c, 4 * j, 4 * j + 4);
                }
                else {
                    const int pm = it - QO_GLU;
                    dep_wait(c, dep + 64 * (2 + (pm >> 4)), 16u, tmo);
                    pg8::Gemm gm{wsp<bf16_t>(c, WS_ZS), wsp<bf16_t>(c, WS_WGLU) + (size_t)l * 256 * 256, MROWS, 256, 256}; pg8::OneUnit S{pm, 0};
                    pg8::EpiWalk<PutGlu> E{{wsp<bf16_t>(c, WS_HCAT), wsp<bf16_t>(c, WS_ZS), wsp<bf16_t>(c, WS_PB) + 7 * BLKE, KIN(I_GLUB) + l * 256}}; pg8::gemm_phase(c.lds, gm, S, E, c.tid);
                }
            }
            SEAM(pbase + 3);
        }
        if (SITE(6) && IN(pbase + 4)) {
            FRESH();
            pg8::Gemm g{wsp<bf16_t>(c, WS_HCAT), wsp<bf16_t>(c, WS_WOUT) + (size_t)l * DM * DM, MROWS, DM, DM}; pg8::LiveRowsOrder S; S.init2(DM, c.G, c.bid, l + 1 == DEPTH);
            pg8::EpiWalk<PutPlain> E{{wsp<bf16_t>(c, WS_OUTB), DM, DM}}; pg8::gemm_phase(c.lds, g, S, E, c.tid);
            SEAM(pbase + 4);
        }
        if (SITE(7) && IN(pbase + 5)) { FRESH(); norm_rows(c, l, l + 1 < DEPTH ? l + 1 : -1); if (l + 1 < DEPTH) SEAM(pbase + 5); }
    }
#undef IN
#undef SEAM
}

extern "C" void kernel_launch(void* const* d_in, const int* in_sizes, int n_in, void* d_out, int out_size, void* d_ws, size_t ws_size, hipStream_t stream) {
    static int grid = 0;
    if (grid == 0) {
        if (n_in != 36 || out_size != NB * SEQL * DM || ws_size < WS_END) { fprintf(stderr, "kernel_launch: unexpected shapes: n_in %d out %d ws %zu (need %zu)\n", n_in, out_size, ws_size, (size_t)WS_END); grid = -1; return; }
        int dev = 0, cus = 0, per_cu = 0;
        if (hipGetDevice(&dev) != hipSuccess || hipDeviceGetAttribute(&cus, hipDeviceAttributeMultiprocessorCount, dev) != hipSuccess) { grid = -1; return; }
        if (hipFuncSetAttribute((const void*)mk_fwd, hipFuncAttributeMaxDynamicSharedMemorySize, LDS_BYTES) != hipSuccess) { fprintf(stderr, "kernel_launch: hipFuncSetAttribute failed\n"); grid = -1; return; }
        if (hipOccupancyMaxActiveBlocksPerMultiprocessor(&per_cu, (const void*)mk_fwd, 512, LDS_BYTES) != hipSuccess || per_cu < 1) { fprintf(stderr, "kernel_launch: occupancy query says %d blocks per CU\n", per_cu); per_cu = 1; }
        (void)hipGetLastError();
        grid = cus;
    }
    if (grid < 0) return;
    (void)hipMemsetAsync((char*)d_ws + WS_CTL, 0, CTL_BYTES, stream);
    Params p{};
    for (int i = 0; i < 36; ++i) p.in[i] = (const float*)d_in[i];
    p.out = (float*)d_out; p.ws = (unsigned char*)d_ws;
#if MK_ONE_LAUNCH
    p.ph_lo = 0; p.ph_hi = NPHASES;
    hipLaunchKernelGGL(mk_fwd, dim3(grid), dim3(512), LDS_BYTES, stream, p);
#else
    for (int k = 0; k < NPHASES; ++k) { p.ph_lo = k; p.ph_hi = k + 1; const int site = k < NPRO ? k : NPRO + (k - NPRO) % NPH;
        if ((PROBE_DUP_MASK >> site) & 1) { p.dry = 1 | (PROBE_P4KINDS << 1); hipLaunchKernelGGL(mk_fwd, dim3(grid), dim3(512), LDS_BYTES, stream, p); p.dry = 0; }
        hipLaunchKernelGGL(mk_fwd, dim3(grid), dim3(512), LDS_BYTES, stream, p); }
#endif
}
```

```cpp
#include <hip/hip_runtime.h>
#include <cstdio>
#include <cstdint>

#ifndef MK_ONE_LAUNCH
#define MK_ONE_LAUNCH 1
#endif

#define LAS __attribute__((address_space(3)))
typedef unsigned short bf16_t;
typedef short bf16x8 __attribute__((ext_vector_type(8)));
typedef short bf16x4 __attribute__((ext_vector_type(4)));
typedef float f32x4 __attribute__((ext_vector_type(4)));
typedef float f32x16 __attribute__((ext_vector_type(16)));
typedef unsigned u32x4 __attribute__((ext_vector_type(4)));
typedef unsigned u32x2 __attribute__((ext_vector_type(2)));

constexpr int NB = 16, SEQL = 4096, CTXL = 256, NTOK = SEQL + CTXL  , MROWS = NB * NTOK  ;
constexpr int DM = 1024, DEPTH = 4, INC = 2912, INP = 3072;
constexpr int NCHB = NTOK / 16  , NCHUNK = MROWS / 16  ;
constexpr float EPS = 1e-6f;
constexpr float LOG2E = 1.4426950408889634f;
constexpr int LDS_MISC_OFF = 163840 - 256;

constexpr size_t al256(size_t x) { return (x + 255) & ~(size_t)255; }
constexpr size_t WS_CTL = 0;
constexpr size_t CTL_BYTES = 65536;
constexpr size_t WS_MODV = WS_CTL + CTL_BYTES;
constexpr size_t WS_ROPEG = WS_MODV + al256((size_t)4 * 17 * 3072 * 4);
constexpr size_t WS_ROPEM = WS_ROPEG + 64 * 16 * 2 * 4;
constexpr size_t WS_WIN = WS_ROPEM + 64 * 8 * 2 * 4;
constexpr size_t WS_WOUT = WS_WIN + (size_t)4 * 3072 * 1024 * 2;
constexpr size_t WS_WUQ = WS_WOUT + (size_t)4 * 1024 * 1024 * 2;
constexpr size_t WS_WUK = WS_WUQ + (size_t)4 * 512 * 256 * 2;
constexpr size_t WS_WUV = WS_WUK + (size_t)4 * 256 * 256 * 2;
constexpr size_t WS_WGLU = WS_WUV + (size_t)4 * 256 * 256 * 2;
constexpr size_t WS_WE = WS_WGLU + (size_t)4 * 256 * 256 * 2;
constexpr size_t WS_WKC = WS_WE + (size_t)4 * 16 * 256 * 256 * 2;
constexpr size_t WS_A16 = WS_WKC + (size_t)4 * 16 * 256 * 512 * 2;
constexpr size_t WS_GR = WS_A16 + (size_t)4 * 2 * 16 * 64 * 2 * 4;
constexpr size_t WS_GRC = WS_GR + (size_t)4 * 2 * 256 * 8192 * 2;
constexpr size_t WS_CTXR = WS_GRC + (size_t)4 * 2 * 256 * 512 * 2;
constexpr size_t WS_HCAT = WS_CTXR + (size_t)NB * CTXL * DM * 4;
constexpr size_t BLKE = (size_t)MROWS * 256;
constexpr size_t WS_PB = WS_HCAT + (size_t)MROWS * DM * 2;
constexpr size_t WS_KR = WS_PB + 12 * BLKE * 2;
constexpr size_t WS_KG = WS_KR + (size_t)MROWS * 32 * 2;
constexpr size_t WS_VTG = WS_KG + (size_t)32 * NTOK * 64 * 2;
constexpr size_t WS_UG = WS_VTG + (size_t)32 * NTOK * 64 * 2;
constexpr size_t WS_US = WS_UG + BLKE * 2;
constexpr size_t WS_HYV = WS_US + (size_t)16 * NCHUNK * 512 * 2;
constexpr size_t WS_HYX1 = WS_HYV + BLKE * 2;
constexpr size_t WS_HYX2 = WS_HYX1 + BLKE * 2;
constexpr size_t WS_HYG = WS_HYX2 + BLKE * 2;
constexpr size_t WS_HYZ = WS_HYG + BLKE * 2;
constexpr size_t WS_HYY = WS_HYZ + BLKE * 2;
constexpr size_t WS_END = WS_HYY + BLKE * 2;
static_assert(WS_END <= (size_t)1 << 30, "workspace map exceeds 1 GiB");
constexpr size_t WS_QM = WS_PB + 8 * BLKE * 2;
constexpr size_t WS_KM = WS_QM + (size_t)MROWS * 384 * 2;
constexpr size_t WS_VTM = WS_KM + (size_t)MROWS * 384 * 2;
constexpr size_t WS_E = WS_PB + 4 * BLKE * 2;
constexpr size_t WS_ZS = WS_PB + 6 * BLKE * 2;
constexpr size_t WS_OUTB = WS_PB + 8 * BLKE * 2;
constexpr size_t WS_HT = WS_PB;
static_assert(WS_VTM + BLKE * 2 == WS_PB + 12 * BLKE * 2, "alias map");

constexpr int CW_BAR = 0;
constexpr int CW_Q = 4096;
constexpr int CW_TMO = 4096 + 64 * 8;
constexpr int CW_DEP = 5120;
constexpr int DEP_SET = 20 * 64;

__device__ __forceinline__ float bf2f(bf16_t v) { return __uint_as_float(((unsigned)v) << 16); }
__device__ __forceinline__ bf16_t f2bf(float f) { unsigned u = __float_as_uint(f); u += 0x7FFFu + ((u >> 16) & 1u); return (bf16_t)(u >> 16); }
__device__ __forceinline__ unsigned cvt_pk_bf16(float lo, float hi) { unsigned r; asm volatile("v_cvt_pk_bf16_f32 %0, %1, %2" : "=v"(r) : "v"(lo), "v"(hi)); return r; }
__device__ __forceinline__ float lo_bf(unsigned w) { return __uint_as_float(w << 16); }
__device__ __forceinline__ float hi_bf(unsigned w) { return __uint_as_float(w & 0xFFFF0000u); }
__device__ __forceinline__ float sigmf(float x) { float one = 1.f; asm volatile("" : "+v"(one)); return __builtin_amdgcn_rcpf(one + __builtin_amdgcn_exp2f(-1.4426950408889634f * x)); }
__device__ __forceinline__ float siluf(float x) { return x * sigmf(x); }
__device__ __forceinline__ float gelu_tanh(float x) { const float u = 0.7978845608028654f * (x + 0.044715f * x * x * x); return x * sigmf(2.f * u); }
__device__ __forceinline__ int opaque(int x) { asm volatile("" : "+v"(x)); return x; }
__device__ __forceinline__ int lane_id_fresh() { int x; asm volatile("v_mbcnt_lo_u32_b32 %0, -1, 0\n\tv_mbcnt_hi_u32_b32 %0, -1, %0" : "=v"(x)); return x; }
__device__ __forceinline__ float max3_raw(float a, float b, float c) { float r; asm("v_max3_f32 %0, %1, %2, %3" : "=v"(r) : "v"(a), "v"(b), "v"(c)); return r; }
template <int M> __device__ __forceinline__ float swz_xor(float v) { return __int_as_float(__builtin_amdgcn_ds_swizzle(__float_as_int(v), 0x1F | (M << 10))); }
__device__ __forceinline__ float half_sum(float v) { auto r = __builtin_amdgcn_permlane32_swap(__float_as_uint(v), __float_as_uint(v), false, false); return __uint_as_float(r[0]) + __uint_as_float(r[1]); }
__device__ __forceinline__ float half_max(float v) { auto r = __builtin_amdgcn_permlane32_swap(__float_as_uint(v), __float_as_uint(v), false, false); return fmaxf(__uint_as_float(r[0]), __uint_as_float(r[1])); }
__device__ __forceinline__ float half_other(float v, int h) { auto r = __builtin_amdgcn_permlane32_swap(__float_as_uint(v), __float_as_uint(v), false, false); return __uint_as_float(h ? r[0] : r[1]); }
__device__ __forceinline__ float wave_sum(float v) {
    v += swz_xor<16>(v); v += swz_xor<8>(v); v += swz_xor<4>(v); v += swz_xor<2>(v); v += swz_xor<1>(v);
    return half_sum(v);
}

#define XB_TMO      128
#define XB_XCNT(j)  (256  + 64 * (j))
#define XB_XSUB(j)  (1280 + 64 * (j))
#define XB_XGEN(j)  (2304 + 64 * (j))
#define XB_TOP      3328
#define XB_TOPGEN   3392
#define XCD_BAR_WORDS 3456
#define XB_SPIN_CAP (1u << 22)
__device__ __forceinline__ unsigned xb_ld(unsigned* p)              { return __hip_atomic_load(p, __ATOMIC_RELAXED, __HIP_MEMORY_SCOPE_AGENT); }
__device__ __forceinline__ unsigned xb_add(unsigned* p, unsigned v) { return __hip_atomic_fetch_add(p, v, __ATOMIC_RELAXED, __HIP_MEMORY_SCOPE_AGENT); }
__device__ __forceinline__ unsigned xb_xcc_id() { return (unsigned)__builtin_amdgcn_s_getreg((3 << 11) | 20) & 0xFu; }
#define XB_SPIN(cond, bar) do { unsigned _sp = 0; while (cond) { __builtin_amdgcn_s_sleep(1); \
    if ((++_sp & 255u) == 0u) { if (xb_ld(&(bar)[XB_TMO])) break; if (_sp > XB_SPIN_CAP) { atomicAdd(&(bar)[XB_TMO], 1u); break; } } } } while (0)
struct XcdBarrier { unsigned* bar; unsigned x; volatile LAS unsigned* st; };
__device__ __forceinline__ XcdBarrier xcd_barrier_post(unsigned* bar, volatile LAS unsigned* st) {
    XcdBarrier b; b.bar = bar; b.x = xb_xcc_id(); b.st = st;
    if (threadIdx.x == 0) (void)xb_add(&bar[XB_XCNT(b.x)], 1u);
    return b;
}
__device__ __forceinline__ void xcd_barrier_complete(unsigned* bar, unsigned x, unsigned& nloc, unsigned& nx) {
    const unsigned G = gridDim.x * gridDim.y * gridDim.z;
    unsigned sum, cnt, mine, sp = 0u;
    for (;;) {
        sum = 0u; cnt = 0u; mine = 0u;
#pragma unroll
        for (unsigned j = 0; j < 16; ++j) { const unsigned c = xb_ld(&bar[XB_XCNT(j)]); sum += c; cnt += (c > 0u) ? 1u : 0u; }
        mine = xb_ld(&bar[XB_XCNT(x)]);
        if (sum == G) break;
        __builtin_amdgcn_s_sleep(1);
        if ((++sp & 255u) == 0u) { if (xb_ld(&bar[XB_TMO])) break; if (sp > XB_SPIN_CAP) { atomicAdd(&bar[XB_TMO], 1u); break; } }
    }
    nloc = mine > 0u ? mine : 1u; nx = cnt > 0u ? cnt : 1u;
}
__device__ __forceinline__ void xcd_barrier(const XcdBarrier& b) {
    asm volatile("s_waitcnt vmcnt(0)" ::: "memory");
    __syncthreads();
    if (threadIdx.x == 0) {
        unsigned* bar = b.bar;
        __builtin_amdgcn_s_waitcnt(0);
        unsigned nloc = b.st[0], nx = b.st[1];
        if (nloc == 0u) { xcd_barrier_complete(bar, b.x, nloc, nx); b.st[0] = nloc; b.st[1] = nx; }
        const unsigned old = xb_add(&bar[XB_XSUB(b.x)], 1u);
        const unsigned gen = old / nloc;
        if (old + 1u == (gen + 1u) * nloc) {
            __builtin_amdgcn_fence(__ATOMIC_RELEASE, "agent");
            asm volatile("s_waitcnt vmcnt(0)" ::: "memory");
            const unsigned og = xb_add(&bar[XB_TOP], 1u);
            const unsigned tg = og / nx;
            if (og + 1u == (tg + 1u) * nx) xb_add(&bar[XB_TOPGEN], 1u);
            else XB_SPIN(xb_ld(&bar[XB_TOPGEN]) == tg, bar);
            __builtin_amdgcn_fence(__ATOMIC_ACQUIRE, "agent");
            xb_add(&bar[XB_XGEN(b.x)], 1u);
            asm volatile("s_waitcnt vmcnt(0)" ::: "memory");
        } else {
            XB_SPIN(xb_ld(&bar[XB_XGEN(b.x)]) == gen, bar);
            __builtin_amdgcn_fence(__ATOMIC_ACQUIRE, "agent");
            asm volatile("s_waitcnt vmcnt(0)" ::: "memory");
        }
    }
    __syncthreads();
}

namespace pg8 {
constexpr int BM = 256, BK = 64, HALF = 128, HTB = HALF * BK * 2, STAGE_BYTES = 8 * HTB, NXCD = 8, WGM = 8;
__host__ __device__ __forceinline__ int lds_byte(int r, int c) { const int st = (r >> 4) * 2 + (c >> 5), rr = r & 15, cc = c & 31, ob = rr * 64 + cc * 2; return st * 1024 + (ob ^ (((ob >> 9) & 1) << 5)); }
__host__ __device__ __forceinline__ void stage_rc(int b, int& R, int& C) { const int st = b / 1024, sb = b % 1024, swz = sb ^ (((sb >> 9) & 1) << 5); R = (st >> 1) * 16 + swz / 64; C = (st & 1) * 32 + (swz % 64) / 2; }
__host__ __device__ __forceinline__ int perm32(int rho) { const int n = rho >> 4, i = rho & 15; return 8 * (i >> 2) + 4 * n + (i & 3); }
struct Unit { int pm, pn, kd; };
struct Gemm { const bf16_t* A; const bf16_t* Bt; int M, N, K; };
struct StaticOrder {
    int nM, nN, nwg, G, c;
    __host__ __device__ void init(int M, int N, int G_, int c_) { nM = M / BM; nN = N / BM; nwg = nM * nN; G = G_; c = c_; }
    __host__ __device__ bool next(int i, Unit& u) const {
        const long L = (long)i * G + c; if (L >= nwg) return false;
        int wgid = (int)L; { const int q = nwg / NXCD, r = nwg % NXCD, xcd = wgid % NXCD, off = wgid / NXCD; wgid = (xcd < r ? xcd * (q + 1) : r * (q + 1) + (xcd - r) * q) + off; }
        const int nig = WGM * nN, gid = wgid / nig, fm = gid * WGM, gsz = (nM - fm) < WGM ? (nM - fm) : WGM;
        u.pm = fm + ((wgid % nig) % gsz); u.pn = (wgid % nig) / gsz; u.kd = 0; return true;
    }
    __device__ __forceinline__ void a_ready(const Unit&) const {}
    __device__ __forceinline__ void done(const Unit&) const {}
    __device__ __forceinline__ const char* abase(const Gemm& g, const Unit& u, size_t tstep) const { return (const char*)g.A + (size_t)u.pm * tstep; }
    __device__ __forceinline__ const char* bbase(const Gemm& g, const Unit& u, size_t tstep) const { return (const char*)g.Bt + (size_t)u.pn * tstep; }
};
struct LiveRowsOrder : StaticOrder {
    bool skip;
    __host__ __device__ void init2(int N, int G_, int c_, bool skip_) { skip = skip_; init(skip_ ? NB * SEQL : MROWS, N, G_, c_); }
    __host__ __device__ bool next(int i, Unit& u) const { if (!StaticOrder::next(i, u)) return false; if (skip) u.pm = (u.pm >> 4) * 17 + (u.pm & 15); return true; }
};
struct BatchedOrder {
    int nwg, G, c, tpg;
    __host__ __device__ void init(int ng, int tpg_, int G_, int c_) { nwg = ng * tpg_; tpg = tpg_; G = G_; c = c_; }
    __host__ __device__ bool next(int i, Unit& u) const { const int L = i * G + c; if (L >= nwg) return false; u.pm = L; u.pn = L / tpg; u.kd = 0; return true; }
    __device__ __forceinline__ void a_ready(const Unit&) const {}
    __device__ __forceinline__ void done(const Unit&) const {}
    __device__ __forceinline__ const char* abase(const Gemm& g, const Unit& u, size_t tstep) const { return (const char*)g.A + (size_t)u.pm * tstep; }
    __device__ __forceinline__ const char* bbase(const Gemm& g, const Unit& u, size_t tstep) const { return (const char*)g.Bt + (size_t)u.pn * tstep; }
};
struct P3Order {
    const bf16_t *b0, *b1, *wuq, *wuk, *wuv, *ug, *we; int G, c;
    __host__ __device__ bool next(int i, Unit& u) const {
        const int L = i * G + c; if (L >= 1360) return false;
        if (L < 544) { u.kd = 0; u.pm = L >> 1; u.pn = L & 1; } else if (L < 816) { u.kd = 1; u.pm = L - 544; u.pn = 0; } else if (L < 1088) { u.kd = 2; u.pm = 0; u.pn = L - 816; } else { u.kd = 3; u.pm = L - 1088; u.pn = (L - 1088) / 17; }
        return true;
    }
    __device__ __forceinline__ void a_ready(const Unit&) const {}
    __device__ __forceinline__ void done(const Unit&) const {}
    __device__ __forceinline__ const char* abase(const Gemm&, const Unit& u, size_t tstep) const { const bf16_t* p = u.kd == 0 ? b0 : u.kd == 1 ? b1 : u.kd == 2 ? wuv : ug; return (const char*)p + (size_t)u.pm * tstep; }
    __device__ __forceinline__ const char* bbase(const Gemm&, const Unit& u, size_t tstep) const { const bf16_t* p = u.kd == 0 ? wuq : u.kd == 1 ? wuk : u.kd == 2 ? b1 : we; return (const char*)p + (size_t)u.pn * tstep; }
};

struct OneUnit {
    int pm, pn;
    __host__ __device__ bool next(int i, Unit& u) const { if (i) return false; u.pm = pm; u.pn = pn; u.kd = 0; return true; }
    __device__ __forceinline__ void a_ready(const Unit&) const {}
    __device__ __forceinline__ void done(const Unit&) const {}
    __device__ __forceinline__ const char* abase(const Gemm& g, const Unit& u, size_t tstep) const { return (const char*)g.A + (size_t)u.pm * tstep; }
    __device__ __forceinline__ const char* bbase(const Gemm& g, const Unit& u, size_t tstep) const { return (const char*)g.Bt + (size_t)u.pn * tstep; }
};
template <class Epi, class Sched>
__device__ __forceinline__ void gemm_phase(LAS unsigned char* lds, const Gemm g, const Sched& S, const Epi& E, int tid_in) {
    const int tid = tid_in, wid = __builtin_amdgcn_readfirstlane(tid >> 6), lane = tid & 63, wr = wid >> 2, wc = wid & 3, fr = lane & 15, fq = lane >> 4;
    const int K = g.K, nt = K / BK;
    unsigned voffA[2], voffB[2];
#pragma unroll
    for (int i = 0; i < 2; ++i) { int R, C; stage_rc(tid * 16 + i * 8192, R, C); const int Rb = Epi::PERM ? ((R & ~31) + perm32(R & 31)) : R;
        voffA[i] = (unsigned)(R * K + C) * 2u; voffB[i] = (unsigned)(Rb * K + C) * 2u; }
    const size_t kstep = (size_t)(BK * 2);
    const size_t hstep = (size_t)HALF * K * 2;
    const size_t tstep = 2 * hstep;
    const unsigned ldsw = (unsigned)wid * 1024u;
    const int aoff = lds_byte(wr * 64 + fr, fq * 8), boff = lds_byte(wc * 32 + fr, fq * 8);
#define PG8_SA(b, h) (((b) * 2 + (h)) * HTB)
#define PG8_SB(b, h) ((4 + (b) * 2 + (h)) * HTB)
#define PG8_STAGE(bufoff, gbase, voff) do { _Pragma("unroll") for (int _i = 0; _i < 2; ++_i) \
        __builtin_amdgcn_global_load_lds((const unsigned*)((const char*)(gbase) + (voff)[_i]), (LAS unsigned*)(lds + (bufoff) + ldsw + _i * 8192), 16, 0, 0); } while (0)
#define PG8_LDA(dst, b, h) do { _Pragma("unroll") for (int m = 0; m < 4; ++m) _Pragma("unroll") for (int k = 0; k < 2; ++k) dst[m][k] = *(const LAS bf16x8*)(lds + PG8_SA(b, h) + aoff + m * 2048 + k * 1024); } while (0)
#define PG8_LDB(dst, b, h) do { _Pragma("unroll") for (int n = 0; n < 2; ++n) _Pragma("unroll") for (int k = 0; k < 2; ++k) dst[n][k] = *(const LAS bf16x8*)(lds + PG8_SB(b, h) + boff + n * 2048 + k * 1024); } while (0)
#define PG8_MMA(ai, bj, At, Bt) do { __builtin_amdgcn_s_setprio(1); _Pragma("unroll") for (int m = 0; m < 4; ++m) _Pragma("unroll") for (int n = 0; n < 2; ++n) _Pragma("unroll") for (int k = 0; k < 2; ++k) \
        acc[ai][bj][m][n] = __builtin_amdgcn_mfma_f32_16x16x32_bf16(Bt[n][k], At[m][k], acc[ai][bj][m][n], 0, 0, 0); __builtin_amdgcn_s_setprio(0); } while (0)
#define PG8_WAIT_V(n) asm volatile("s_waitcnt vmcnt(" #n ")" ::: "memory")
#define PG8_WAIT_L(n) asm volatile("s_waitcnt lgkmcnt(" #n ")" ::: "memory")
#define PG8_BAR __builtin_amdgcn_s_barrier()
#define PG8_SCHED __builtin_amdgcn_sched_barrier(0)
    Unit cur, nxt; int ui = 0;
    if (!S.next(0, cur)) return;
    f32x4 acc[2][2][4][2];
#pragma unroll
    for (int a = 0; a < 2; ++a)
#pragma unroll
        for (int b = 0; b < 2; ++b)
#pragma unroll
            for (int m = 0; m < 4; ++m)
#pragma unroll
                for (int n = 0; n < 2; ++n) acc[a][b][m][n] = (f32x4){0.f, 0.f, 0.f, 0.f};
    bf16x8 At[4][2], B0[2][2], B1[2][2];
    const char* cA = S.abase(g, cur, tstep); const char* cB = S.bbase(g, cur, tstep);
    S.a_ready(cur);
    PG8_STAGE(PG8_SB(0, 0), cB, voffB); PG8_STAGE(PG8_SA(0, 0), cA, voffA); PG8_STAGE(PG8_SB(0, 1), cB + hstep, voffB); PG8_STAGE(PG8_SA(0, 1), cA + hstep, voffA);
    if (wr == 1) PG8_BAR;
    PG8_WAIT_V(4); PG8_BAR;
    PG8_STAGE(PG8_SB(1, 0), cB + kstep, voffB); PG8_STAGE(PG8_SA(1, 0), cA + kstep, voffA); PG8_STAGE(PG8_SB(1, 1), cB + hstep + kstep, voffB);
    PG8_WAIT_V(6); PG8_BAR;
    for (;;) {
        const bool has_next = S.next(ui + 1, nxt);
        const char* nA = has_next ? S.abase(g, nxt, tstep) : cA; const char* nB = has_next ? S.bbase(g, nxt, tstep) : cB;
        for (int t = 0; t < nt; t += 2) {
            const bool last = (t == nt - 2);
            const char* a1 = cA + (size_t)(t + 1) * kstep;
            const char* a2 = last ? nA : cA + (size_t)(t + 2) * kstep; const char* b2 = last ? nB : cB + (size_t)(t + 2) * kstep;
            const char* a3 = a2 + kstep; const char* b3 = b2 + kstep;
            if (last && has_next) S.a_ready(nxt);
            PG8_LDB(B0, 0, 0); PG8_SCHED; PG8_LDA(At, 0, 0); PG8_STAGE(PG8_SA(1, 1), a1 + hstep, voffA);
            PG8_WAIT_L(8); PG8_BAR; PG8_WAIT_L(0); PG8_MMA(0, 0, At, B0); PG8_BAR; PG8_SCHED;
            PG8_LDB(B1, 0, 1); PG8_STAGE(PG8_SB(0, 0), b2, voffB);
            PG8_BAR; PG8_WAIT_L(0); PG8_MMA(0, 1, At, B1); PG8_BAR;
            PG8_LDA(At, 0, 1); PG8_STAGE(PG8_SA(0, 0), a2, voffA);
            PG8_BAR; PG8_WAIT_L(0); PG8_MMA(1, 0, At, B0); PG8_BAR; PG8_SCHED;
            PG8_STAGE(PG8_SB(0, 1), b2 + hstep, voffB);
            PG8_WAIT_V(6); PG8_BAR; PG8_MMA(1, 1, At, B1); PG8_BAR;
            PG8_LDB(B0, 1, 0); PG8_SCHED; PG8_LDA(At, 1, 0); PG8_STAGE(PG8_SA(0, 1), a2 + hstep, voffA);
            PG8_WAIT_L(8); PG8_BAR; PG8_WAIT_L(0); PG8_MMA(0, 0, At, B0); PG8_BAR; PG8_SCHED;
            PG8_LDB(B1, 1, 1); PG8_STAGE(PG8_SB(1, 0), b3, voffB);
            PG8_BAR; PG8_WAIT_L(0); PG8_MMA(0, 1, At, B1); PG8_BAR;
            PG8_LDA(At, 1, 1); PG8_STAGE(PG8_SA(1, 0), a3, voffA);
            PG8_BAR; PG8_WAIT_L(0); PG8_MMA(1, 0, At, B0); PG8_BAR; PG8_SCHED;
            PG8_STAGE(PG8_SB(1, 1), b3 + hstep, voffB);
            PG8_WAIT_V(6); PG8_BAR; PG8_MMA(1, 1, At, B1); PG8_BAR;
        }
        { const int l2 = lane_id_fresh(); E(acc, cur, wr, wc, l2 & 15, l2 >> 4); } S.done(cur);
        if (!has_next) break;
#pragma unroll
        for (int a = 0; a < 2; ++a)
#pragma unroll
            for (int b = 0; b < 2; ++b)
#pragma unroll
                for (int m = 0; m < 4; ++m)
#pragma unroll
                    for (int n = 0; n < 2; ++n) acc[a][b][m][n] = (f32x4){0.f, 0.f, 0.f, 0.f};
        cur = nxt; cA = nA; cB = nB; ++ui;
    }
    PG8_WAIT_V(0);
    if (wr == 0) PG8_BAR;
    PG8_BAR;
#undef PG8_SA
#undef PG8_SB
#undef PG8_STAGE
#undef PG8_LDA
#undef PG8_LDB
#undef PG8_MMA
#undef PG8_WAIT_V
#undef PG8_WAIT_L
#undef PG8_BAR
#undef PG8_SCHED
}

template <class F> struct EpiWalk {
    static constexpr bool PERM = true, AFTER_DRAIN = false;
    F f;
    __device__ __forceinline__ void operator()(const f32x4 (&acc)[2][2][4][2], const Unit& u, int wr, int wc, int fr, int fq) const {
#pragma unroll
        for (int ai = 0; ai < 2; ++ai)
#pragma unroll
            for (int m = 0; m < 4; ++m) {
                const int rin = ai * HALF + wr * 64 + m * 16 + fr;
#pragma unroll
                for (int bj = 0; bj < 2; ++bj) { const int cin = bj * HALF + wc * 32 + 8 * fq; f.put(u.pm, u.pn, rin, cin, acc[ai][bj][m][0], acc[ai][bj][m][1]); asm volatile("" ::: "memory"); }
            }
    }
};
}

__device__ __forceinline__ u32x4 pack8(const f32x4& a, const f32x4& b) {
    u32x4 w; w.x = cvt_pk_bf16(a[0], a[1]); w.y = cvt_pk_bf16(a[2], a[3]); w.z = cvt_pk_bf16(b[0], b[1]); w.w = cvt_pk_bf16(b[2], b[3]); return w;
}
__device__ __forceinline__ void unpack8(const u32x4 w, float (&o)[8]) {
    o[0] = lo_bf(w.x); o[1] = hi_bf(w.x); o[2] = lo_bf(w.y); o[3] = hi_bf(w.y); o[4] = lo_bf(w.z); o[5] = hi_bf(w.z); o[6] = lo_bf(w.w); o[7] = hi_bf(w.w);
}

struct PutPlain {
    bf16_t* dst; int ldc, ncols;
    __device__ __forceinline__ void put(int pm, int pn, int rin, int cin, const f32x4& a, const f32x4& b) const { const int col = pn * 256 + cin; if (col < ncols) *(u32x4*)(dst + ((size_t)pm * 256 + rin) * ldc + col) = pack8(a, b); }
};
struct PutKm {
    bf16_t* km; const bf16_t* kr;
    __device__ __forceinline__ void put(int pm, int pn, int rin, int cin, const f32x4& a, const f32x4& b) const {
        const int bb = pm / 17, key = (pm - bb * 17) * 256 + rin, hd = cin >> 6, d = cin & 63;
        bf16_t* dst = km + ((size_t)(bb * 4 + hd) * NTOK + key) * 96;
        *(u32x4*)(dst + d) = pack8(a, b);
        if (d < 32) *(u32x4*)(dst + 64 + d) = *(const u32x4*)(kr + ((size_t)pm * 256 + rin) * 32 + d);
    }
};
struct PutVt {
    bf16_t* vt;
    __device__ __forceinline__ void put(int pm, int pn, int rin, int cin, const f32x4& a, const f32x4& b) const {
        const int bb = pn / 17, key = (pn - bb * 17) * 256 + cin;
        *(u32x4*)(vt + ((size_t)(bb * 4 + (rin >> 6)) * 64 + (rin & 63)) * NTOK + key) = pack8(a, b);
    }
};
struct PutE {
    bf16_t* e;
    __device__ __forceinline__ void put(int pm, int pn, int rin, int cin, const f32x4& a, const f32x4& b) const { *(u32x4*)(e + ((size_t)pm * 256 + rin) * 256 + cin) = pack8(a, b); }
};
struct PutSsmY {
    bf16_t* zs; const bf16_t* ug; const float* dskip;
    __device__ __forceinline__ void put(int pm, int pn, int rin, int cin, const f32x4& a, const f32x4& b) const {
        const int g = pn, n = (pm - g * 17) * 256 + rin, tok = n * 16 + (cin >> 4), ho = cin & 15, ch = g * 16 + ho;
        float u[8]; unpack8(*(const u32x4*)(ug + ((size_t)g * MROWS + tok) * 16 + ho), u);
        const f32x4 d0 = *(const f32x4*)(dskip + ch), d1 = *(const f32x4*)(dskip + ch + 4);
        f32x4 y0, y1;
#pragma unroll
        for (int i = 0; i < 4; ++i) { y0[i] = gelu_tanh(a[i] + d0[i] * u[i]); y1[i] = gelu_tanh(b[i] + d1[i] * u[4 + i]); }
        *(u32x4*)(zs + (size_t)tok * 256 + ch) = pack8(y0, y1);
    }
};
struct PutGlu {
    bf16_t* cat; const bf16_t* zs; const bf16_t* gate; const float* gb;
    __device__ __forceinline__ void put(int pm, int pn, int rin, int cin, const f32x4& a, const f32x4& b) const {
        const size_t row = (size_t)pm * 256 + rin; const int col = cin;
        float z[8], gt[8]; unpack8(*(const u32x4*)(zs + row * 256 + col), z); unpack8(*(const u32x4*)(gate + row * 256 + col), gt);
        const f32x4 b0 = *(const f32x4*)(gb + col), b1 = *(const f32x4*)(gb + col + 4);
        f32x4 y0, y1;
#pragma unroll
        for (int i = 0; i < 4; ++i) { y0[i] = z[i] * sigmf(a[i] + b0[i]) * siluf(gt[i]); y1[i] = z[4 + i] * sigmf(b[i] + b1[i]) * siluf(gt[4 + i]); }
        *(u32x4*)(cat + row * DM + 512 + col) = pack8(y0, y1);
    }
};

struct EpiInProj {
    static constexpr bool PERM = true, AFTER_DRAIN = false;
    bf16_t *pb, *ug, *us, *vtg, *hy0;
    LAS unsigned char* scratch;
    __device__ __forceinline__ void operator()(const f32x4 (&acc)[2][2][4][2], const pg8::Unit& u, int wr, int wc, int fr, int fq) const {
        const int pn = u.pn, pm = u.pm;
        const int bb = pm / 17, jt = (pm - bb * 17) * 256;
        LAS unsigned char* sw = scratch + (wr * 4 + wc) * 1280;
        const int ln = fq * 16 + fr, tch = ln >> 1, thalf = ln & 1;
#pragma unroll
        for (int ai = 0; ai < 2; ++ai)
#pragma unroll
            for (int m = 0; m < 4; ++m) {
                const int rin = ai * pg8::HALF + wr * 64 + m * 16 + fr;
#pragma unroll
                for (int bj = 0; bj < 2; ++bj) {
                    const int cin = bj * pg8::HALF + wc * 32 + 8 * fq;
                    const u32x4 w = pack8(acc[ai][bj][m][0], acc[ai][bj][m][1]);
                    const bool plain = pn < 4 || pn == 5 || pn == 7 || (pn == 4 && bj == 0);
                    if (plain) { *(u32x4*)(pb + (size_t)pn * BLKE + ((size_t)pm * 256 + rin) * 256 + cin) = w; }
                    else if (pn == 6) { const size_t row = (size_t)pm * 256 + rin; const int g = cin >> 4, hi0 = cin & 15;
                        *(u32x4*)(ug + ((size_t)g * MROWS + row) * 16 + hi0) = w;
                        *(u32x4*)(us + ((size_t)g * NCHUNK + (row >> 4)) * 512 + (row & 15) * 16 + hi0) = w; }
                    else {
                        *(LAS u32x4*)(sw + fr * 80 + fq * 16) = w;
                        asm volatile("" ::: "memory");
                        unsigned short e[8];
#pragma unroll
                        for (int i = 0; i < 8; ++i) e[i] = *(const LAS unsigned short*)(sw + (thalf * 8 + i) * 80 + tch * 2);
                        asm volatile("" ::: "memory");
                        u32x4 t; t.x = e[0] | ((unsigned)e[1] << 16); t.y = e[2] | ((unsigned)e[3] << 16); t.z = e[4] | ((unsigned)e[5] << 16); t.w = e[6] | ((unsigned)e[7] << 16);
                        const int chn = bj * pg8::HALF + wc * 32 + tch;
                        const int tok = jt + ai * pg8::HALF + wr * 64 + m * 16 + thalf * 8;
                        bf16_t* dst = (pn == 4) ? vtg + ((size_t)(bb * 2 + ((chn - 128) >> 6)) * 64 + ((chn - 128) & 63)) * NTOK + tok
                                                : hy0 + (size_t)(pn - 8) * BLKE + ((size_t)chn * 16 + bb) * NTOK + tok;
                        *(u32x4*)dst = t;
                    }
                    asm volatile("" ::: "memory");
                }
            }
    }
};

struct EpiP3 {
    static constexpr bool PERM = true, AFTER_DRAIN = false;
    PutPlain q; PutKm k; PutVt v; PutE e;
    __device__ __forceinline__ void operator()(const f32x4 (&acc)[2][2][4][2], const pg8::Unit& u, int wr, int wc, int fr, int fq) const {
#pragma unroll
        for (int ai = 0; ai < 2; ++ai)
#pragma unroll
            for (int m = 0; m < 4; ++m) {
                const int rin = ai * pg8::HALF + wr * 64 + m * 16 + fr;
#pragma unroll
                for (int bj = 0; bj < 2; ++bj) { const int cin = bj * pg8::HALF + wc * 32 + 8 * fq;
                    if (u.kd == 0) q.put(u.pm, u.pn, rin, cin, acc[ai][bj][m][0], acc[ai][bj][m][1]);
                    else if (u.kd == 1) k.put(u.pm, u.pn, rin, cin, acc[ai][bj][m][0], acc[ai][bj][m][1]);
                    else if (u.kd == 2) v.put(u.pm, u.pn, rin, cin, acc[ai][bj][m][0], acc[ai][bj][m][1]);
                    else e.put(u.pm, u.pn, rin, cin, acc[ai][bj][m][0], acc[ai][bj][m][1]);
                    asm volatile("" ::: "memory"); }
            }
    }
};

struct Params {
    const float* in[36];
    float* out;
    unsigned char* ws;
    int ph_lo, ph_hi, dry, pad;
};
enum { I_X = 0, I_C, I_CTX, I_CCTX, I_WMOD, I_BMOD, I_GPRE, I_GPOST, I_WIN, I_WOUT, I_GCQ, I_WUQ, I_GCKV, I_WUKV, I_GQ, I_GK,
       I_LRE, I_LIM, I_LSTEP, I_BRE, I_BIM, I_CRE, I_CIM, I_SSMD, I_GLUW, I_GLUB, I_HCW, I_HCB, I_HW1, I_HB1, I_HF1, I_HW2, I_HB2, I_HF2, I_HW3, I_HBIAS };

typedef __attribute__((address_space(4))) const unsigned long long* kargp_t;
struct Ctx {
    LAS unsigned char* lds;
    kargp_t ka;
    unsigned char* ws;
    int tid, lane, wave, G, bid, dry;
};
#define GAS __attribute__((address_space(1)))
#define KIN(i) ((const float*)(GAS const float*)c.ka[(i)])
#define KOUT() ((float*)(GAS float*)c.ka[36])
template <class T> __device__ __forceinline__ T* wsp(const Ctx& c, size_t off) { return (T*)(c.ws + off); }

__device__ __forceinline__ int wmap(int kind, int n) {
    if (kind == 0) { if (n < 192) return n; if (n < 224) return 320 + (n - 192); if (n < 256) return -1; if (n < 384) return 192 + (n - 256); if (n < 512) return -1; return n - 160; }
    if (kind == 2) return (n >> 6) * 128 + (n & 63);
    if (kind == 3) return (n >> 6) * 128 + 64 + (n & 63);
    return n;
}
__device__ __forceinline__ void wconv_tile(const Ctx& c, const float* src, int Ks, int Ns, int Nlim, bf16_t* dst, int Kp, int kind, int nt, int kt) {
    LAS float* T = (LAS float*)c.lds;
    const int n0 = nt * 64, k0 = kt * 128;
    const int nn = c.tid & 63, kk0 = c.tid >> 6; const int n = n0 + nn; const int sc = (n < Nlim) ? wmap(kind, n) : -1;
    float v[16];
#pragma unroll
    for (int i = 0; i < 16; ++i) { const int k = k0 + kk0 + 8 * i; v[i] = (k < Ks && sc >= 0) ? src[(size_t)k * Ns + sc] : 0.f; }
#pragma unroll
    for (int i = 0; i < 16; ++i) T[(kk0 + 8 * i) * 65 + nn] = v[i];
    __syncthreads();
#pragma unroll
    for (int i = 0; i < 2; ++i) { const int e = c.tid + i * 512, row = e >> 4, pc = e & 15; float x[8];
#pragma unroll
        for (int j = 0; j < 8; ++j) x[j] = T[(pc * 8 + j) * 65 + row];
        u32x4 w; w.x = cvt_pk_bf16(x[0], x[1]); w.y = cvt_pk_bf16(x[2], x[3]); w.z = cvt_pk_bf16(x[4], x[5]); w.w = cvt_pk_bf16(x[6], x[7]);
        *(u32x4*)(dst + (size_t)(n0 + row) * Kp + k0 + pc * 8) = w; }
    __syncthreads();
}

__device__ __forceinline__ void modv_job(const Ctx& c, int job) {
    const int l = job / 48, j0 = (job % 48) * 64;
    LAS float* sc = (LAS float*)c.lds;
    LAS float* red = sc + 17 * 1024;
    const float* cv = KIN(I_C); const float* cc = KIN(I_CCTX);
    for (int e = c.tid; e < 17 * 1024; e += 512) { const int r = e >> 10, k = e & 1023; const float v = (r < 16) ? cv[r * 1024 + k] : cc[k]; sc[e] = siluf(v); }
    __syncthreads();
    const int col = c.tid & 63, ks = c.tid >> 6;
    const float* w = KIN(I_WMOD) + (size_t)l * 1024 * 3072 + j0 + col;
    float acc[17];
#pragma unroll
    for (int r = 0; r < 17; ++r) acc[r] = 0.f;
    for (int k = ks * 128; k < ks * 128 + 128; ++k) { const float wv = w[(size_t)k * 3072];
#pragma unroll
        for (int r = 0; r < 17; ++r) acc[r] += sc[r * 1024 + k] * wv; }
#pragma unroll
    for (int r = 0; r < 17; ++r) red[(ks * 17 + r) * 64 + col] = acc[r];
    __syncthreads();
    float* mv = wsp<float>(c, WS_MODV);
    for (int e = c.tid; e < 17 * 64; e += 512) { const int r = e >> 6, cl = e & 63; float s = KIN(I_BMOD)[l * 3072 + j0 + cl];
#pragma unroll
        for (int q = 0; q < 8; ++q) s += red[(q * 17 + r) * 64 + cl];
        mv[((size_t)l * 17 + r) * 3072 + j0 + cl] = s; }
    __syncthreads();
}

__device__ __forceinline__ void rope_job(const Ctx& c) {
    float* rg = wsp<float>(c, WS_ROPEG); float* rm = wsp<float>(c, WS_ROPEM);
    for (int e = c.tid; e < 64 * 16; e += 512) { const int pos = e >> 4, f = e & 15; const float inv = powf(10000.f, -(float)(2 * f) / 32.f); const float a = (float)pos * inv; rg[e * 2] = cosf(a); rg[e * 2 + 1] = sinf(a); }
    for (int e = c.tid; e < 64 * 8; e += 512) { const int pos = e >> 3, f = e & 7; const float inv = powf(10000.f, -(float)(2 * f) / 16.f); const float a = (float)pos * inv; rm[e * 2] = cosf(a); rm[e * 2 + 1] = sinf(a); }
}

typedef float cpx __attribute__((ext_vector_type(2)));
#define CPX(a, b) ((cpx){(a), (b)})
__device__ __forceinline__ cpx cmul(cpx a, cpx b) { return CPX(a.x * b.x - a.y * b.y, a.x * b.y + a.y * b.x); }
__device__ __forceinline__ void ssm_tables_job(const Ctx& c, int job) {
    const int l = job >> 4, g = job & 15;
    LAS cpx* apow = (LAS cpx*)c.lds;
    LAS cpx* bbar = apow + 2 * 17 * 64;
    LAS cpx* cm = bbar + 2 * 64 * 16;
    LAS float* Kc = (LAS float*)(cm + 2 * 16 * 64);
    for (int e = c.tid; e < 2 * 64; e += 512) {
        const int d = e >> 6, p = e & 63; const size_t ix = (((size_t)l * 2 + d) * 16 + g) * 64 + p;
        const float lr = KIN(I_LRE)[ix], li = KIN(I_LIM)[ix], st = expf(KIN(I_LSTEP)[((size_t)l * 2 + d) * 16 + g]);
        for (int k = 0; k <= 16; ++k) { const float m = expf(lr * st * (float)k), an = li * st * (float)k; apow[(d * 17 + k) * 64 + p] = CPX(m * cosf(an), m * sinf(an)); }
    }
    __syncthreads();
    for (int e = c.tid; e < 2 * 64 * 16; e += 512) {
        const int d = e >> 10, p = (e >> 4) & 63, h = e & 15; const size_t ix = (((size_t)l * 2 + d) * 16 + g) * 64 + p;
        const float lr = KIN(I_LRE)[ix], li = KIN(I_LIM)[ix];
        const cpx a = apow[(d * 17 + 1) * 64 + p]; const cpx am1 = CPX(a.x - 1.f, a.y);
        const float den = lr * lr + li * li; const cpx q = CPX((am1.x * lr + am1.y * li) / den, (am1.y * lr - am1.x * li) / den);
        const cpx b = CPX(KIN(I_BRE)[ix * 16 + h], KIN(I_BIM)[ix * 16 + h]);
        bbar[e] = cmul(q, b);
        const size_t cx = ((((size_t)l * 2 + d) * 16 + g) * 16 + h) * 64 + p;
        cm[(d * 16 + h) * 64 + p] = CPX(KIN(I_CRE)[cx], KIN(I_CIM)[cx]);
    }
    __syncthreads();
    for (int e = c.tid; e < 2 * 16 * 256; e += 512) {
        const int d = e >> 12, dd = (e >> 8) & 15, ho = (e >> 4) & 15, hi = e & 15; float s = 0.f;
        for (int p = 0; p < 64; ++p) { const cpx w = cmul(cm[(d * 16 + ho) * 64 + p], apow[(d * 17 + dd) * 64 + p]); const cpx b = bbar[(d * 64 + p) * 16 + hi]; s += w.x * b.x - w.y * b.y; }
        Kc[e] = s;
    }
    __syncthreads();
    bf16_t* wkc = wsp<bf16_t>(c, WS_WKC) + ((size_t)l * 16 + g) * 256 * 512;
    for (int e = c.tid; e < 256 * 512; e += 512) {
        const int r = e >> 9, q = e & 511, i = r >> 4, ho = r & 15; float v;
        if (q < 256) { const int j = q >> 4, hi = q & 15; v = 0.f; if (j <= i) v += Kc[((0 * 16 + (i - j)) * 16 + ho) * 16 + hi]; if (j >= i) v += Kc[((1 * 16 + (j - i)) * 16 + ho) * 16 + hi]; }
        else { const int qq = q - 256, dq = qq >> 7, comp = (qq >> 6) & 1, p = qq & 63, k = dq == 0 ? i + 1 : 16 - i; const cpx w = cmul(cm[(dq * 16 + ho) * 64 + p], apow[(dq * 17 + k) * 64 + p]); v = comp == 0 ? w.x : -w.y; }
        wkc[e] = f2bf(v);
    }
    bf16_t* we = wsp<bf16_t>(c, WS_WE) + ((size_t)l * 16 + g) * 256 * 256;
    for (int e = c.tid; e < 256 * 256; e += 512) {
        const int qq = e >> 8, cidx = e & 255, j = cidx >> 4, hi = cidx & 15, dq = qq >> 7, comp = (qq >> 6) & 1, p = qq & 63, k = dq == 0 ? 15 - j : j;
        const cpx w = cmul(apow[(dq * 17 + k) * 64 + p], bbar[(dq * 64 + p) * 16 + hi]);
        we[e] = f2bf(comp == 0 ? w.x : w.y);
    }
    float* a16 = wsp<float>(c, WS_A16);
    for (int e = c.tid; e < 128; e += 512) { const int d = e >> 6, p = e & 63; const cpx a = apow[(d * 17 + 16) * 64 + p]; const size_t ix = ((((size_t)l * 2 + d) * 16 + g) * 64 + p) * 2; a16[ix] = a.x; a16[ix + 1] = a.y; }
    __syncthreads();
}

__device__ __forceinline__ void hyena_mlp_job(const Ctx& c, int job) {
    const int l = job / 136, tt = job % 136;
    const bool isctx = tt >= 128; const int n = isctx ? CTXL : SEQL; const int t0 = isctx ? (tt - 128) * 32 : tt * 32;
    LAS float* z = (LAS float*)c.lds;
    LAS float* h1 = z + 32 * 36;
    LAS float* h2 = h1 + 32 * 64;
    for (int e = c.tid; e < 32 * 33; e += 512) {
        const int ti = e / 33, f = e % 33, t = t0 + ti; float v;
        if (f == 0) v = (float)t / (float)(n - 1);
        else { const int k = (f - 1) & 15; const float band = 1e-4f + (float)k * ((15.f - 1e-4f) / 15.f); const float om = 6.283185307179586f * (float)t / (float)n; v = (f <= 16) ? cosf(band * om) : -sinf(band * om); }
        z[ti * 36 + f] = v;
    }
    __syncthreads();
    for (int e = c.tid; e < 32 * 64; e += 512) {
        const int ti = e >> 6, j = e & 63; float s = KIN(I_HB1)[l * 64 + j];
        for (int f = 0; f < 33; ++f) s += z[ti * 36 + f] * KIN(I_HW1)[((size_t)l * 33 + f) * 64 + j];
        h1[e] = sinf(KIN(I_HF1)[l * 64 + j] * s);
    }
    __syncthreads();
    for (int e = c.tid; e < 32 * 64; e += 512) {
        const int ti = e >> 6, j = e & 63; float s = KIN(I_HB2)[l * 64 + j];
        for (int f = 0; f < 64; ++f) s += h1[ti * 64 + f] * KIN(I_HW2)[((size_t)l * 64 + f) * 64 + j];
        h2[e] = sinf(KIN(I_HF2)[l * 64 + j] * s);
    }
    __syncthreads();
    float* hT = wsp<float>(c, WS_HT) + (size_t)l * 1024 * NTOK;
    const float mind = -3.070113457325394f, maxd = -15.35056728662697f;
#pragma unroll
    for (int cc = 0; cc < 2; ++cc) {
        const int col = c.tid + cc * 512;
        float acc[32];
#pragma unroll
        for (int ti = 0; ti < 32; ++ti) acc[ti] = 0.f;
        for (int f = 0; f < 64; ++f) { const float w = KIN(I_HW3)[((size_t)l * 64 + f) * 1024 + col];
#pragma unroll
            for (int ti = 0; ti < 32; ++ti) acc[ti] += h2[ti * 64 + f] * w; }
        const int ch = col & 255; const float delta = fabsf(mind + (maxd - mind) * (float)ch / 255.f);
        float* dst = hT + (size_t)col * NTOK + (isctx ? SEQL : 0) + t0;
#pragma unroll
        for (int ti = 0; ti < 32; ++ti) { const float tn = (float)(t0 + ti) / (float)(n - 1); dst[ti] = acc[ti] * expf(-tn * delta); }
    }
    __syncthreads();
}

__device__ __forceinline__ void hyena_pack_job(const Ctx& c, int job) {
    const int l = job >> 9, o = (job >> 8) & 1, ch = job & 255;
    const float* hT = wsp<float>(c, WS_HT) + (size_t)l * 1024 * NTOK;
    const float* fw = hT + (size_t)(o * 512 + ch) * NTOK; const float* bw = hT + (size_t)(o * 512 + 256 + ch) * NTOK;
    LAS float* red = (LAS float*)c.lds;
    float s0 = 0.f, s1 = 0.f;
    for (int t = c.tid; t < SEQL; t += 512) { const float a = fw[t], b = bw[t]; s0 += a * a + b * b; }
    if (c.tid < CTXL) { const float a = fw[SEQL + c.tid], b = bw[SEQL + c.tid]; s1 = a * a + b * b; }
    s0 = wave_sum(s0); s1 = wave_sum(s1);
    if (c.lane == 0) { red[c.wave] = s0; red[8 + c.wave] = s1; }
    __syncthreads();
    float t0 = 0.f, t1 = 0.f;
#pragma unroll
    for (int w = 0; w < 8; ++w) { t0 += red[w]; t1 += red[8 + w]; }
    const float r0 = rsqrtf(t0 + EPS), r1 = rsqrtf(t1 + EPS);
    bf16_t* gr = wsp<bf16_t>(c, WS_GR) + (((size_t)l * 2 + o) * 256 + ch) * 8192;
    for (int e = c.tid; e < 8192; e += 512) { float v; if (e <= 4095) v = fw[4095 - e]; else if (e < 8191) v = bw[e - 4095]; else v = 0.f; gr[e] = f2bf(v * r0); }
    bf16_t* grc = wsp<bf16_t>(c, WS_GRC) + (((size_t)l * 2 + o) * 256 + ch) * 512;
    { const int e = c.tid; float v; if (e <= 255) v = fw[SEQL + 255 - e]; else if (e < 511) v = bw[SEQL + e - 255]; else v = 0.f; grc[e] = f2bf(v * r1); }
    __syncthreads();
}

__device__ __forceinline__ void norm_rows(const Ctx& c, int l  , int next  , int r0 = -1  , int r1 = 0) {
    const float* mvl = wsp<float>(c, WS_MODV) + (size_t)(l < 0 ? 0 : l) * 17 * 3072;
    const float* mvn = wsp<float>(c, WS_MODV) + (size_t)(next < 0 ? 0 : next) * 17 * 3072;
    const bf16_t* outb = wsp<bf16_t>(c, WS_OUTB);
    bf16_t* hb = wsp<bf16_t>(c, WS_HCAT);
    float* ctxr = wsp<float>(c, WS_CTXR);
    const float* xin0 = KIN(I_X); const float* cin0 = KIN(I_CTX); float* outp = KOUT();
    const float* gpost = KIN(I_GPOST) + (l < 0 ? 0 : l) * DM; const float* gpre = KIN(I_GPRE) + (next < 0 ? 0 : next) * DM;
    const int nw = c.G * 8, lane4 = c.lane * 4;
    const int rb0 = r0 >= 0 ? r0 + c.wave * 2 : (c.bid * 8 + c.wave) * 2, rbe = r0 >= 0 ? r1 : MROWS, rbs = r0 >= 0 ? 16 : nw * 2;
    for (int rowb = rb0; rowb < rbe; rowb += rbs) {
        f32x4 xv[2][4]; u32x2 ow[2][4]; const float* xin[2]; float* xout[2]; int mr[2]; bool live[2], isc[2];
#pragma unroll
        for (int rr = 0; rr < 2; ++rr) {
            const int row = rowb + rr, b = row / NTOK, j = row - b * NTOK; isc[rr] = j >= SEQL; live[rr] = !(next < 0 && isc[rr]); mr[rr] = isc[rr] ? 16 : b;
            if (isc[rr]) { xout[rr] = ctxr + ((size_t)b * CTXL + (j - SEQL)) * DM; xin[rr] = (l < 0) ? cin0 + ((size_t)b * CTXL + (j - SEQL)) * DM : xout[rr]; }
            else { xout[rr] = outp + ((size_t)b * SEQL + j) * DM; xin[rr] = (l <= 0) ? xin0 + ((size_t)b * SEQL + j) * DM : xout[rr]; }
#pragma unroll
            for (int q = 0; q < 4; ++q) { xv[rr][q] = __builtin_nontemporal_load((const f32x4*)(xin[rr] + q * 256 + lane4)); if (l >= 0) ow[rr][q] = *(const u32x2*)(outb + (size_t)row * DM + q * 256 + lane4); }
        }
#pragma unroll
        for (int rr = 0; rr < 2; ++rr) {
            if (!live[rr]) continue;
            const int row = rowb + rr;
            if (l >= 0) {
                float ov[16]; float ss = 0.f;
#pragma unroll
                for (int q = 0; q < 4; ++q) { ov[q * 4] = lo_bf(ow[rr][q].x); ov[q * 4 + 1] = hi_bf(ow[rr][q].x); ov[q * 4 + 2] = lo_bf(ow[rr][q].y); ov[q * 4 + 3] = hi_bf(ow[rr][q].y); }
#pragma unroll
                for (int i = 0; i < 16; ++i) ss += ov[i] * ov[i];
                ss = wave_sum(ss); const float rs = rsqrtf(ss * (1.f / DM) + EPS);
#pragma unroll
                for (int q = 0; q < 4; ++q) { const int col = q * 256 + lane4; const f32x4 gp = *(const f32x4*)(gpost + col); const f32x4 gt = *(const f32x4*)(mvl + mr[rr] * 3072 + 2048 + col);
#pragma unroll
                    for (int i = 0; i < 4; ++i) xv[rr][q][i] += gt[i] * (ov[q * 4 + i] * rs * gp[i]); }
            }
            if ((l >= 0 || isc[rr]) && !c.dry) {
#pragma unroll
                for (int q = 0; q < 4; ++q) __builtin_nontemporal_store(xv[rr][q], (f32x4*)(xout[rr] + q * 256 + lane4));
            }
            if (next >= 0) {
                float ss = 0.f;
#pragma unroll
                for (int q = 0; q < 4; ++q)
#pragma unroll
                    for (int i = 0; i < 4; ++i) ss += xv[rr][q][i] * xv[rr][q][i];
                ss = wave_sum(ss); const float rs = rsqrtf(ss * (1.f / DM) + EPS);
#pragma unroll
                for (int q = 0; q < 4; ++q) { const int col = q * 256 + lane4; const f32x4 gp = *(const f32x4*)(gpre + col);
                    const f32x4 sh = *(const f32x4*)(mvn + mr[rr] * 3072 + col), sc = *(const f32x4*)(mvn + mr[rr] * 3072 + 1024 + col);
                    float hv[4];
#pragma unroll
                    for (int i = 0; i < 4; ++i) hv[i] = xv[rr][q][i] * rs * gp[i] * (1.f + sc[i]) + sh[i];
                    u32x2 w; w.x = cvt_pk_bf16(hv[0], hv[1]); w.y = cvt_pk_bf16(hv[2], hv[3]); *(u32x2*)(hb + (size_t)row * DM + col) = w; }
            }
        }
    }
}

__device__ __forceinline__ void p2_rows(const Ctx& c, int l) {
    bf16_t* pb = wsp<bf16_t>(c, WS_PB);
    bf16_t* B0 = pb; bf16_t* B1 = pb + BLKE; bf16_t* B3 = pb + 3 * BLKE; const bf16_t* B4 = pb + 4 * BLKE;
    bf16_t* kr = wsp<bf16_t>(c, WS_KR); bf16_t* kg = wsp<bf16_t>(c, WS_KG); bf16_t* ug = wsp<bf16_t>(c, WS_UG); bf16_t* us = wsp<bf16_t>(c, WS_US);
    const float* ropeG = wsp<float>(c, WS_ROPEG); const float* ropeM = wsp<float>(c, WS_ROPEM);
    const int lane = c.lane;
    const f32x4 gcq = (lane < 48) ? *(const f32x4*)(KIN(I_GCQ) + l * 192 + lane * 4) : (f32x4){0.f, 0.f, 0.f, 0.f};
    const f32x4 gckv = (lane < 32) ? *(const f32x4*)(KIN(I_GCKV) + l * 128 + lane * 4) : (f32x4){0.f, 0.f, 0.f, 0.f};
    const f32x4 gq = *(const f32x4*)(KIN(I_GQ) + l * 64 + (lane & 15) * 4), gk = *(const f32x4*)(KIN(I_GK) + l * 64 + (lane & 15) * 4);
    for (int rowb = (c.bid * 8 + c.wave) * 4; rowb < MROWS; rowb += c.G * 8 * 4) {
        u32x2 w0[4], w1[4], w3[4], w4[4];
#pragma unroll
        for (int rr = 0; rr < 4; ++rr) { const size_t ro = (size_t)(rowb + rr) * 256 + lane * 4;
            w0[rr] = *(const u32x2*)(B0 + ro); w1[rr] = *(const u32x2*)(B1 + ro); w3[rr] = *(const u32x2*)(B3 + ro); w4[rr] = *(const u32x2*)(B4 + ro); }
#pragma unroll
        for (int rr = 0; rr < 4; ++rr) {
            const int row = rowb + rr;
            const int b = row / NTOK, j = row - b * NTOK; const bool islat = j < SEQL; const int rowpos = (j >> 6) & 63, colpos = j & 63;
            const size_t ro = (size_t)row * 256 + lane * 4;
            {
                const u32x2 w = w0[rr]; float x[4] = {lo_bf(w.x), hi_bf(w.x), lo_bf(w.y), hi_bf(w.y)};
                float ss = (lane < 48) ? (x[0] * x[0] + x[1] * x[1] + x[2] * x[2] + x[3] * x[3]) : 0.f; ss = wave_sum(ss);
                const float rs = rsqrtf(ss * (1.f / 192.f) + EPS);
                float xp[4];
#pragma unroll
                for (int i = 0; i < 4; ++i) xp[i] = swz_xor<2>(x[i]);
                u32x2 o; o.x = 0u; o.y = 0u;
                if (lane < 48) { o.x = cvt_pk_bf16(x[0] * rs * gcq[0], x[1] * rs * gcq[1]); o.y = cvt_pk_bf16(x[2] * rs * gcq[2], x[3] * rs * gcq[3]); }
                else if (lane < 56) {
                    const int t = lane - 48; float y[4];
                    if (islat) { const int pos = (t & 4) ? colpos : rowpos; const bool isx2 = (t & 2) != 0;
#pragma unroll
                        for (int i = 0; i < 4; ++i) { const int f = 4 * (t & 1) + i; const float cs = ropeM[(pos * 8 + f) * 2], sn = ropeM[(pos * 8 + f) * 2 + 1]; y[i] = isx2 ? (xp[i] * sn + x[i] * cs) : (x[i] * cs - xp[i] * sn); } }
                    else {
#pragma unroll
                        for (int i = 0; i < 4; ++i) y[i] = x[i]; }
                    u32x2 kk; kk.x = cvt_pk_bf16(y[0], y[1]); kk.y = cvt_pk_bf16(y[2], y[3]); *(u32x2*)(kr + (size_t)row * 32 + t * 4) = kk;
                }
                if (!c.dry) *(u32x2*)(B0 + ro) = o;
            }
            {
                const u32x2 w = w1[rr]; float x[4] = {lo_bf(w.x), hi_bf(w.x), lo_bf(w.y), hi_bf(w.y)};
                float ss = (lane < 32) ? (x[0] * x[0] + x[1] * x[1] + x[2] * x[2] + x[3] * x[3]) : 0.f; ss = wave_sum(ss);
                const float rs = rsqrtf(ss * (1.f / 128.f) + EPS);
                u32x2 o; o.x = 0u; o.y = 0u;
                if (lane < 32) { o.x = cvt_pk_bf16(x[0] * rs * gckv[0], x[1] * rs * gckv[1]); o.y = cvt_pk_bf16(x[2] * rs * gckv[2], x[3] * rs * gckv[3]); }
                if (!c.dry) *(u32x2*)(B1 + ro) = o;
            }
#pragma unroll
            for (int which = 0; which < 2; ++which) {
                const u32x2 w = which == 0 ? w3[rr] : w4[rr]; float x[4] = {lo_bf(w.x), hi_bf(w.x), lo_bf(w.y), hi_bf(w.y)};
                float ss = x[0] * x[0] + x[1] * x[1] + x[2] * x[2] + x[3] * x[3];
                ss += swz_xor<1>(ss); ss += swz_xor<2>(ss); ss += swz_xor<4>(ss); ss += swz_xor<8>(ss);
                const float rs = rsqrtf(ss * (1.f / 64.f) + EPS);
                const int t = lane & 15; const f32x4 g = which == 0 ? gq : gk;
#pragma unroll
                for (int i = 0; i < 4; ++i) x[i] = x[i] * rs * g[i];
                float xp[4];
#pragma unroll
                for (int i = 0; i < 4; ++i) xp[i] = swz_xor<4>(x[i]);
                if (islat) { const int pos = (t & 8) ? colpos : rowpos; const bool isx2 = (t & 4) != 0;
#pragma unroll
                    for (int i = 0; i < 4; ++i) { const int f = 4 * (t & 3) + i; const float cs = ropeG[(pos * 16 + f) * 2], sn = ropeG[(pos * 16 + f) * 2 + 1]; x[i] = isx2 ? (xp[i] * sn + x[i] * cs) : (x[i] * cs - xp[i] * sn); } }
                if (which == 0) { const float qs = 0.125f * LOG2E; u32x2 o; o.x = cvt_pk_bf16(x[0] * qs, x[1] * qs); o.y = cvt_pk_bf16(x[2] * qs, x[3] * qs); if (!c.dry) *(u32x2*)(B3 + ro) = o; }
                else if (lane < 32) { u32x2 o; o.x = cvt_pk_bf16(x[0], x[1]); o.y = cvt_pk_bf16(x[2], x[3]); *(u32x2*)(kg + ((size_t)(b * 2 + (lane >> 4)) * NTOK + j) * 64 + t * 4) = o; }
            }
        }
    }
}
#ifndef PROBE_ABL
#define PROBE_ABL 0
#endif
#ifndef PROBE_GQAONLY
#define PROBE_GQAONLY 0
#endif
template <int DK, bool SUB, bool NOMAX = false, int ABL = 0>
__device__ __forceinline__ bool attn_unit(float (&rowmax)[2], const Ctx& c, const bf16_t* Qp, int qpitch, const bf16_t* Kp, const bf16_t* Vtp, int kt0, int nkt, int nrows,
                                          const bf16_t* gatep, bf16_t* outp, bool rope, int j0, float qscale, const float* ropeM) {
    constexpr int KS = DK / 16, KPC = DK / 8, KPITCH = DK * 2 + 16, KB = 64 * KPITCH, VPITCH = 136, VB = 64 * VPITCH;
    constexpr int KOFF = 0, VOFF = 3 * KB;
    constexpr float LIM = 60.f;
    static_assert(KB % 16 == 0 && VB % 16 == 0, "attention LDS buffer alignment");
    const int tid = c.tid, lane = c.lane, wave = c.wave;
    const int lq_ = opaque(lane), q = lq_ & 31, h = lq_ >> 5;
    LAS unsigned char* lds = c.lds;
    const int rbase = (wave * 64 < nrows) ? wave * 64 : wave * 64 - 256;
    const bool live = wave * 64 < nrows;
    bf16x8 qf[2][KS];
#pragma unroll
    for (int qt = 0; qt < 2; ++qt) {
        const bf16_t* qrow = Qp + (size_t)(rbase + qt * 32 + q) * qpitch + 8 * h;
#pragma unroll
        for (int ks = 0; ks < KS; ++ks) qf[qt][ks] = *(const bf16x8*)(qrow + 16 * ks);
        if (DK == 96) {
            const int jj = j0 + rbase + qt * 32 + q;
#pragma unroll
            for (int ks = 0; ks < KS; ++ks) {
                float x[8]; unpack8(__builtin_bit_cast(u32x4, qf[qt][ks]), x);
                if (ks >= 4) {
                    const int pos = (ks == 4) ? ((jj >> 6) & 63) : (jj & 63);
#pragma unroll
                    for (int e = 0; e < 8; ++e) { const float xp = half_other(x[e], h); const float cs = ropeM[(pos * 8 + e) * 2], sn = ropeM[(pos * 8 + e) * 2 + 1];
                        const float r = h ? (xp * sn + x[e] * cs) : (x[e] * cs - xp * sn); x[e] = rope ? r : x[e]; }
                }
                u32x4 w; w.x = cvt_pk_bf16(x[0] * qscale, x[1] * qscale); w.y = cvt_pk_bf16(x[2] * qscale, x[3] * qscale); w.z = cvt_pk_bf16(x[4] * qscale, x[5] * qscale); w.w = cvt_pk_bf16(x[6] * qscale, x[7] * qscale);
                qf[qt][ks] = __builtin_bit_cast(bf16x8, w);
            }
        }
    }
    f32x16 o00, o01, o10, o11;
#pragma unroll
    for (int i = 0; i < 16; ++i) { o00[i] = 0.f; o01[i] = 0.f; o10[i] = 0.f; o11[i] = 0.f; }
    const float m0 = SUB ? rowmax[0] : 0.f, m1 = SUB ? rowmax[1] : 0.f; float l0 = 0.f, l1 = 0.f;
    float rmax0 = -1e30f, rmax1 = -1e30f;
    const int tq_ = opaque(tid);
    const int kst0 = (tq_ / KPC) * KPITCH + (tq_ % KPC) * 16, kst1 = ((tq_ + 512) / KPC) * KPITCH + ((tq_ + 512) % KPC) * 16;
    const int kgl0 = ((tq_ / KPC) * DK + (tq_ % KPC) * 8) * 2, kgl1 = (((tq_ + 512) / KPC) * DK + ((tq_ + 512) % KPC) * 8) * 2;
    const int vst = (tq_ >> 3) * VPITCH + (tq_ & 7) * 16, vgl = ((tq_ >> 3) * NTOK + (tq_ & 7) * 8) * 2;
    const bool has2 = (DK == 96) && tq_ < 256;
    const int kfo = q * KPITCH + 16 * h, vfo = q * VPITCH + 8 * h;
    const char* Kc = (const char*)Kp; const char* Vc = (const char*)Vtp;
    u32x4 kreg0, kreg1 = {0u, 0u, 0u, 0u}, vreg;
#define AT_GLOADK(kt) do { if (ABL & 1) break; const char* kb_ = Kc + (size_t)(kt) * (64 * DK * 2); kreg0 = *(const u32x4*)(kb_ + kgl0); if (has2) kreg1 = *(const u32x4*)(kb_ + kgl1); } while (0)
#define AT_GLOADV(kt) do { if (ABL & 1) break; vreg = *(const u32x4*)(Vc + (size_t)(kt) * 128 + vgl); } while (0)
#define AT_WRITEK(bi) do { if (ABL & 1) break; LAS unsigned char* bb = lds + KOFF + (bi) * KB; *(LAS u32x4*)(bb + kst0) = kreg0; if (has2) *(LAS u32x4*)(bb + kst1) = kreg1; } while (0)
#define AT_WRITEV(bi) do { if (ABL & 1) break; LAS u32x2* vd = (LAS u32x2*)(lds + VOFF + (bi) * VB + vst); vd[0] = (u32x2){vreg.x, vreg.y}; vd[1] = (u32x2){vreg.z, vreg.w}; } while (0)
#define AT_QK(S0, S1, bi, jh) do { const LAS unsigned char* kb = lds + KOFF + (bi) * KB + (jh) * 32 * KPITCH + kfo; \
        _Pragma("unroll") for (int i = 0; i < 16; ++i) { S0[i] = 0.f; S1[i] = 0.f; } \
        if (!(ABL & 8)) _Pragma("unroll") for (int ks = 0; ks < KS; ++ks) { \
            const bf16x8 a0 = *(const LAS bf16x8*)(kb + 32 * ks); \
            S0 = __builtin_amdgcn_mfma_f32_32x32x16_bf16(a0, qf[0][ks], S0, 0, 0, 0); \
            S1 = __builtin_amdgcn_mfma_f32_32x32x16_bf16(a0, qf[1][ks], S1, 0, 0, 0); } } while (0)
#define AT_MAX(S, RM) do { if (!SUB && !NOMAX) { _Pragma("unroll") for (int i = 0; i < 16; i += 2) RM = max3_raw(RM, S[i], S[i + 1]); } } while (0)
#define AT_EXP(S, M, L, PK0, PK1) do { float ps = 0.f; \
        _Pragma("unroll") for (int i = 0; i < 16; ++i) { S[i] = (ABL & 2) ? S[i] * 0.001f : __builtin_amdgcn_exp2f(SUB ? S[i] - M : S[i]); ps += S[i]; } \
        L += ps; u32x4 w; \
        w.x = cvt_pk_bf16(S[0], S[1]); w.y = cvt_pk_bf16(S[2], S[3]); w.z = cvt_pk_bf16(S[4], S[5]); w.w = cvt_pk_bf16(S[6], S[7]); PK0 = __builtin_bit_cast(bf16x8, w); \
        w.x = cvt_pk_bf16(S[8], S[9]); w.y = cvt_pk_bf16(S[10], S[11]); w.z = cvt_pk_bf16(S[12], S[13]); w.w = cvt_pk_bf16(S[14], S[15]); PK1 = __builtin_bit_cast(bf16x8, w); } while (0)
#define AT_VLOAD() do { la0 = *(const LAS u32x2*)(vb); ha0 = *(const LAS u32x2*)(vb + 16); lb0 = *(const LAS u32x2*)(vb + 32 * VPITCH); hb0 = *(const LAS u32x2*)(vb + 32 * VPITCH + 16); \
        la1 = *(const LAS u32x2*)(vb + 32); ha1 = *(const LAS u32x2*)(vb + 48); lb1 = *(const LAS u32x2*)(vb + 32 * VPITCH + 32); hb1 = *(const LAS u32x2*)(vb + 32 * VPITCH + 48); } while (0)
#define AT_SUB(SC0, SC1, SN0, SN1, vbi, jh, nbi, njh) do { \
          \
        const LAS unsigned char* vb = lds + VOFF + (vbi) * VB + (jh) * 64 + vfo; \
        u32x2 la0, ha0, lb0, hb0, la1, ha1, lb1, hb1; \
        if (DK == 64) { AT_VLOAD(); }        \
        AT_MAX(SC0, rmax0); AT_MAX(SC1, rmax1); \
        AT_QK(SN0, SN1, nbi, njh); \
        bf16x8 p00, p01, p10, p11; \
        AT_EXP(SC0, m0, l0, p00, p01); AT_EXP(SC1, m1, l1, p10, p11); \
        if (DK != 64) { AT_VLOAD(); } \
        if (!(ABL & 4)) { \
            const bf16x8 va00 = __builtin_bit_cast(bf16x8, (u32x4){la0.x, la0.y, ha0.x, ha0.y}), va10 = __builtin_bit_cast(bf16x8, (u32x4){lb0.x, lb0.y, hb0.x, hb0.y}); \
            const bf16x8 va01 = __builtin_bit_cast(bf16x8, (u32x4){la1.x, la1.y, ha1.x, ha1.y}), va11 = __builtin_bit_cast(bf16x8, (u32x4){lb1.x, lb1.y, hb1.x, hb1.y}); \
            o00 = __builtin_amdgcn_mfma_f32_32x32x16_bf16(va00, p00, o00, 0, 0, 0); \
            o01 = __builtin_amdgcn_mfma_f32_32x32x16_bf16(va10, p00, o01, 0, 0, 0); \
            o10 = __builtin_amdgcn_mfma_f32_32x32x16_bf16(va00, p10, o10, 0, 0, 0); \
            o11 = __builtin_amdgcn_mfma_f32_32x32x16_bf16(va10, p10, o11, 0, 0, 0); \
            o00 = __builtin_amdgcn_mfma_f32_32x32x16_bf16(va01, p01, o00, 0, 0, 0); \
            o01 = __builtin_amdgcn_mfma_f32_32x32x16_bf16(va11, p01, o01, 0, 0, 0); \
            o10 = __builtin_amdgcn_mfma_f32_32x32x16_bf16(va01, p11, o10, 0, 0, 0); \
            o11 = __builtin_amdgcn_mfma_f32_32x32x16_bf16(va11, p11, o11, 0, 0, 0); } \
        if (ABL & 4) { asm volatile("" :: "v"(p00), "v"(p01), "v"(p10), "v"(p11), "v"(la0), "v"(ha0), "v"(lb0), "v"(hb0), "v"(la1), "v"(ha1), "v"(lb1), "v"(hb1)); } \
        } while (0)
    if (!SUB && !NOMAX && tid == 0) *(volatile LAS unsigned*)(lds + LDS_MISC_OFF + 24) = 0u;
    AT_GLOADK(kt0); AT_GLOADV(kt0); AT_WRITEK(0); AT_WRITEV(0);
    AT_GLOADK(kt0 + 1); AT_WRITEK(1);
    __syncthreads();
    f32x16 sa0, sa1, sb0, sb1;
    AT_QK(sa0, sa1, 0, 0);
    int kb0 = 0, kb1 = 1, kb2 = 2;
    for (int t = 0; t < nkt; ++t) {
        const int tk = (t + 2 < nkt) ? t + 2 : nkt - 1, tv = (t + 1 < nkt) ? t + 1 : nkt - 1;
        AT_GLOADK(kt0 + tk);
        AT_SUB(sa0, sa1, sb0, sb1, t & 1, 0, kb0, 1);
        AT_WRITEK(kb2);
        AT_GLOADV(kt0 + tv);
        AT_SUB(sb0, sb1, sa0, sa1, t & 1, 1, kb1, 0);
        AT_WRITEV((t + 1) & 1);
        if (!(ABL & 16)) __syncthreads();
        const int tmp = kb0; kb0 = kb1; kb1 = kb2; kb2 = tmp;
    }
#undef AT_GLOADK
#undef AT_GLOADV
#undef AT_WRITEK
#undef AT_WRITEV
#undef AT_QK
#undef AT_MAX
#undef AT_EXP
#undef AT_SUB
#undef AT_VLOAD
    bool bad = false;
    if (!SUB && !NOMAX) { const float r0 = half_max(rmax0), r1 = half_max(rmax1); rowmax[0] = r0; rowmax[1] = r1; const bool b_ = live && !(r0 < LIM && r0 > -LIM && r1 < LIM && r1 > -LIM); volatile LAS unsigned* flg = (volatile LAS unsigned*)(lds + LDS_MISC_OFF + 24); if (__any(b_ ? 1 : 0) && opaque(lane) == 0) *flg = 1u; __syncthreads(); bad = *flg != 0u; __syncthreads(); }
    if (live && !bad) {
        const int le_ = opaque(lane), q = le_ & 31, h = le_ >> 5;
#pragma unroll
        for (int qt = 0; qt < 2; ++qt) {
            const float lr = qt ? l1 : l0; const float lt = half_sum(lr), inv = 1.f / lt;
            const size_t row = (size_t)(rbase + qt * 32 + q);
#pragma unroll
            for (int dt = 0; dt < 2; ++dt)
#pragma unroll
                for (int g4 = 0; g4 < 4; ++g4) {
                    const int dv0 = dt * 32 + 8 * g4 + 4 * h;
                    const u32x2 gw = *(const u32x2*)(gatep + row * 256 + dv0);
                    const float g0 = siluf(lo_bf(gw.x)), g1 = siluf(hi_bf(gw.x)), g2 = siluf(lo_bf(gw.y)), g3 = siluf(hi_bf(gw.y));
                    const f32x16& o = qt ? (dt ? o11 : o10) : (dt ? o01 : o00);
                    u32x2 w; w.x = cvt_pk_bf16(o[4 * g4] * inv * g0, o[4 * g4 + 1] * inv * g1); w.y = cvt_pk_bf16(o[4 * g4 + 2] * inv * g2, o[4 * g4 + 3] * inv * g3);
                    *(u32x2*)(outp + row * DM + dv0) = w;
                }
        }
    }
    return bad;
}

template <int N>
__device__ __forceinline__ void hyena_conv(const Ctx& c, LAS unsigned char* ub, LAS unsigned char* gb, int pass, const bf16_t* xmul  , float bias,
                                           bf16_t* zdst  , const bf16_t* gmul, bf16_t* cat  , float cw0, float cw1, float cw2, float cb  ) {
    constexpr int UP = (N + 256) * 2 + 16, NPAIR = N / 256, OFF8 = N - 8;
    const int lane = c.lane, i16 = lane & 15, kq = lane >> 4;
    for (int pr = c.wave; pr < NPAIR; pr += 8) {
        const int t0 = pr * 256;
        u32x4 xq[2][4], gq[2][4]; bf16_t xl[2][4], xr[2][4];
#pragma unroll
        for (int half = 0; half < 2; ++half)
#pragma unroll
            for (int r = 0; r < 4; ++r) { const int t8 = t0 + half * 128 + 32 * kq + 8 * r; const bf16_t* xp_ = xmul + (size_t)i16 * NTOK + t8; xq[half][r] = *(const u32x4*)xp_;
                xl[half][r] = (t8 > 0) ? xp_[-1] : (bf16_t)0; xr[half][r] = (t8 + 8 < N) ? xp_[8] : (bf16_t)0;
                gq[half][r] = (pass == 1) ? *(const u32x4*)(gmul + (size_t)i16 * NTOK + t8) : (u32x4){0u, 0u, 0u, 0u}; }
        f32x4 acc[2][8];
#pragma unroll
        for (int m = 0; m < 8; ++m) { acc[0][m] = (f32x4){0.f, 0.f, 0.f, 0.f}; acc[1][m] = (f32x4){0.f, 0.f, 0.f, 0.f}; }
        const LAS unsigned char* up = ub + i16 * UP + 256 + kq * 16;
        const LAS unsigned char* gp = gb + (OFF8 - t0 - 8 * i16 + 8 * kq) * 2;
        bf16x8 bfa = *(const LAS bf16x8*)(up - 256), bfb = *(const LAS bf16x8*)(up);
        u32x4 wa = *(const LAS u32x4*)(gp - 256), wb = *(const LAS u32x4*)(gp - 256 + 16);
        for (int s0 = -128; s0 < N; s0 += 32) {
            const int sn = (s0 + 32 < N) ? s0 + 32 : s0;
            const bf16x8 bfan = *(const LAS bf16x8*)(up + sn * 2), bfbn = *(const LAS bf16x8*)(up + sn * 2 + 256);
            const u32x4 wan = *(const LAS u32x4*)(gp + sn * 2), wbn = *(const LAS u32x4*)(gp + sn * 2 + 16);
            const unsigned w[8] = {wa.x, wa.y, wa.z, wa.w, wb.x, wb.y, wb.z, wb.w};
            unsigned sh[7];
#pragma unroll
            for (int k = 0; k < 7; ++k) sh[k] = __builtin_amdgcn_alignbit(w[k + 1], w[k], 16);
#pragma unroll
            for (int m = 0; m < 8; ++m) {
                u32x4 a;
                if (m & 1) { const int d0 = (7 - m) >> 1; a = (u32x4){w[d0], w[d0 + 1], w[d0 + 2], w[d0 + 3]}; }
                else { const int d0 = (6 - m) >> 1; a = (u32x4){sh[d0], sh[d0 + 1], sh[d0 + 2], sh[d0 + 3]}; }
                acc[0][m] = __builtin_amdgcn_mfma_f32_16x16x32_bf16(__builtin_bit_cast(bf16x8, a), bfa, acc[0][m], 0, 0, 0);
                acc[1][m] = __builtin_amdgcn_mfma_f32_16x16x32_bf16(__builtin_bit_cast(bf16x8, a), bfb, acc[1][m], 0, 0, 0);
            }
            bfa = bfan; bfb = bfbn; wa = wan; wb = wbn;
        }
#pragma unroll
        for (int half = 0; half < 2; ++half)
#pragma unroll
            for (int r = 0; r < 4; ++r) {
                const int t8 = t0 + half * 128 + 32 * kq + 8 * r;
                float uu[8], xr8[8], xm[8]; unpack8(*(const LAS u32x4*)(ub + i16 * UP + 256 + t8 * 2), uu); unpack8(xq[half][r], xr8);
                {   float pv = bf2f(xl[half][r]);
#pragma unroll
                    for (int m = 0; m < 8; ++m) { const float nx = (m < 7) ? xr8[m + 1] : bf2f(xr[half][r]); xm[m] = bf2f(f2bf(cw0 * pv + cw1 * xr8[m] + cw2 * nx + cb)); pv = xr8[m]; } }
                float y[8];
#pragma unroll
                for (int m = 0; m < 8; ++m) y[m] = xm[m] * (acc[half][m][r] + bias * uu[m]);
                if (pass == 0) { u32x4 o; o.x = cvt_pk_bf16(y[0], y[1]); o.y = cvt_pk_bf16(y[2], y[3]); o.z = cvt_pk_bf16(y[4], y[5]); o.w = cvt_pk_bf16(y[6], y[7]); *(u32x4*)(zdst + (size_t)i16 * NTOK + t8) = o; }
                else { float gg[8]; unpack8(gq[half][r], gg);
#pragma unroll
                    for (int m = 0; m < 8; ++m) gg[m] = bf2f(f2bf(siluf(gg[m])));
                    u32x4 o; o.x = cvt_pk_bf16(y[0] * gg[0], y[1] * gg[1]); o.y = cvt_pk_bf16(y[2] * gg[2], y[3] * gg[3]); o.z = cvt_pk_bf16(y[4] * gg[4], y[5] * gg[5]); o.w = cvt_pk_bf16(y[6] * gg[6], y[7] * gg[7]);
                    *(u32x4*)(cat + (size_t)i16 * NTOK + t8) = o; }
            }
    }
}
template <int N>
__device__ __forceinline__ void hyena_seq(const Ctx& c, int l, int ch, int toff) {
    constexpr int UP = (N + 256) * 2 + 16;
    LAS unsigned char* ub = c.lds; LAS unsigned char* gb = c.lds + 16 * UP;
    const bf16_t* vv = wsp<bf16_t>(c, WS_HYV) + (size_t)ch * 16 * NTOK + toff;
    bf16_t* vz = wsp<bf16_t>(c, WS_HYZ) + (size_t)ch * 16 * NTOK + toff;
    const bf16_t* x1 = wsp<bf16_t>(c, WS_HYX1) + (size_t)ch * 16 * NTOK + toff;
    const bf16_t* x2 = wsp<bf16_t>(c, WS_HYX2) + (size_t)ch * 16 * NTOK + toff;
    const bf16_t* gm = wsp<bf16_t>(c, WS_HYG) + (size_t)ch * 16 * NTOK + toff;
    bf16_t* cat = wsp<bf16_t>(c, WS_HYY) + (size_t)ch * 16 * NTOK + toff;
    { const int e = c.tid, b = e >> 5, side = (e >> 4) & 1, pc = e & 15; unsigned z = 0u; asm volatile("" : "+v"(z)); *(LAS u32x4*)(ub + b * UP + side * (256 + N * 2) + pc * 16) = (u32x4){z, z, z, z}; }
    for (int pass = 0; pass < 2; ++pass) {
        const bf16_t* gr = (N == SEQL) ? wsp<bf16_t>(c, WS_GR) + (((size_t)l * 2 + pass) * 256 + ch) * 8192 : wsp<bf16_t>(c, WS_GRC) + (((size_t)l * 2 + pass) * 256 + ch) * 512;
        const bf16_t* usrc = pass == 0 ? vv : vz;
        constexpr int NG = (2 * N / 8 + 511) / 512;
        {
            u32x4 t[NG];
#pragma unroll
            for (int k = 0; k < NG; ++k) { const int e = c.tid + k * 512; t[k] = (e < 2 * N / 8) ? *(const u32x4*)(gr + e * 8) : (u32x4){0u, 0u, 0u, 0u}; }
#pragma unroll
            for (int k = 0; k < NG; ++k) { const int e = c.tid + k * 512; if (e < 2 * N / 8) *(LAS u32x4*)(gb + e * 16) = t[k]; }
        }
        if constexpr (N == SEQL) {
#pragma unroll
            for (int k0 = 0; k0 < 16; k0 += 8) {
                u32x4 t[8];
#pragma unroll
                for (int k = 0; k < 8; ++k) t[k] = *(const u32x4*)(usrc + (size_t)(k0 + k) * NTOK + c.tid * 8);
#pragma unroll
                for (int k = 0; k < 8; ++k) *(LAS u32x4*)(ub + (k0 + k) * UP + 256 + c.tid * 16) = t[k];
            }
        } else {
            const int b = c.tid >> 5, pc = c.tid & 31;
            *(LAS u32x4*)(ub + b * UP + 256 + pc * 16) = *(const u32x4*)(usrc + (size_t)b * NTOK + pc * 8);
        }
        __syncthreads();
        const float* hcw = KIN(I_HCW) + (size_t)l * 3 * 768; const float* hcb = KIN(I_HCB) + l * 768;
        if (pass == 0) {
            const float w0 = hcw[ch], w1 = hcw[768 + ch], w2 = hcw[1536 + ch], bs = hcb[ch];
            constexpr int PPT = (N == SEQL) ? 16 : 1;
            u32x4 o[PPT];
#pragma unroll
            for (int k = 0; k < PPT; ++k) { const int b = (N == SEQL) ? k : (c.tid >> 5), pc = (N == SEQL) ? c.tid : (c.tid & 31); const LAS unsigned char* p = ub + b * UP + 256 + pc * 16;
                float x[8]; unpack8(*(const LAS u32x4*)p, x); float pv = bf2f(*(const LAS bf16_t*)(p - 2)); const float nx8 = bf2f(*(const LAS bf16_t*)(p + 16)); float y[8];
#pragma unroll
                for (int m = 0; m < 8; ++m) { const float nx = (m < 7) ? x[m + 1] : nx8; y[m] = w0 * pv + w1 * x[m] + w2 * nx + bs; pv = x[m]; }
                o[k].x = cvt_pk_bf16(y[0], y[1]); o[k].y = cvt_pk_bf16(y[2], y[3]); o[k].z = cvt_pk_bf16(y[4], y[5]); o[k].w = cvt_pk_bf16(y[6], y[7]); }
            __syncthreads();
#pragma unroll
            for (int k = 0; k < PPT; ++k) { const int b = (N == SEQL) ? k : (c.tid >> 5), pc = (N == SEQL) ? c.tid : (c.tid & 31); *(LAS u32x4*)(ub + b * UP + 256 + pc * 16) = o[k]; }
            __syncthreads();
        }
        const float bias = KIN(I_HBIAS)[((size_t)l * 2 + pass) * 256 + ch];
        const int cc = (pass + 1) * 256 + ch;
        hyena_conv<N>(c, ub, gb, pass, pass == 0 ? x1 : x2, bias, vz, gm, cat, hcw[cc], hcw[768 + cc], hcw[1536 + cc], hcb[cc]);
        asm volatile("s_waitcnt vmcnt(0)" ::: "memory");
        __syncthreads();
    }
}

__device__ __forceinline__ void hyena_untranspose(const Ctx& c, int tl0, int tl1) {
    const bf16_t* yT = wsp<bf16_t>(c, WS_HYY); bf16_t* cat = wsp<bf16_t>(c, WS_HCAT);
    LAS bf16_t* T = (LAS bf16_t*)c.lds;
    LAS unsigned* T32 = (LAS unsigned*)c.lds;
    for (int tl = tl0; tl < tl1; ++tl) {
        const int b = tl / 68, j0 = (tl - b * 68) * 64;
        u32x4 pre[4];
#pragma unroll
        for (int k = 0; k < 4; ++k) { const int e = c.tid + k * 512, ch = e >> 3, pc = e & 7; pre[k] = *(const u32x4*)(yT + ((size_t)ch * 16 + b) * NTOK + j0 + pc * 8); }
#pragma unroll
        for (int k = 0; k < 4; ++k) { const int e = c.tid + k * 512, ch = e >> 3, pc = e & 7; LAS unsigned* d = T32 + (ch * 132 + pc * 16) / 4; d[0] = pre[k].x; d[1] = pre[k].y; d[2] = pre[k].z; d[3] = pre[k].w; }
        __syncthreads();
#pragma unroll
        for (int k = 0; k < 4; ++k) { const int e = c.tid + k * 512, t = e >> 5, c0 = (e & 31) * 8; float v[8];
#pragma unroll
            for (int i = 0; i < 8; ++i) v[i] = bf2f(T[(c0 + i) * 66 + t]);
            u32x4 w; w.x = cvt_pk_bf16(v[0], v[1]); w.y = cvt_pk_bf16(v[2], v[3]); w.z = cvt_pk_bf16(v[4], v[5]); w.w = cvt_pk_bf16(v[6], v[7]);
            *(u32x4*)(cat + ((size_t)b * NTOK + j0 + t) * DM + 768 + c0) = w; }
        __syncthreads();
    }
}

__device__ __forceinline__ void ssm_scan_item(const Ctx& c, int l, int item) {
    const int b = item >> 2, g = (item & 3) * 4 + (c.tid >> 7), dq = (c.tid >> 6) & 1, p = c.tid & 63;
    const float* a16 = wsp<float>(c, WS_A16) + ((((size_t)l * 2 + dq) * 16 + g) * 64 + p) * 2;
    const float ar = a16[0], ai = a16[1];
    const bf16_t* E = wsp<bf16_t>(c, WS_E); bf16_t* US = wsp<bf16_t>(c, WS_US);
    float sr = 0.f, si = 0.f;
    for (int st0 = 0; st0 < NCHB; st0 += 8) {
        float er[8], ei[8]; size_t ro[8];
#pragma unroll
        for (int k = 0; k < 8; ++k) { const int st = st0 + k; const int cc = dq == 0 ? (st < 16 ? 256 + st : st - 16) : (st < 16 ? 271 - st : 255 - (st - 16));
            ro[k] = (size_t)g * NCHUNK + (size_t)b * NCHB + cc; er[k] = bf2f(E[ro[k] * 256 + dq * 128 + p]); ei[k] = bf2f(E[ro[k] * 256 + dq * 128 + 64 + p]); }
#pragma unroll
        for (int k = 0; k < 8; ++k) {
            US[ro[k] * 512 + 256 + dq * 128 + p] = f2bf(sr); US[ro[k] * 512 + 256 + dq * 128 + 64 + p] = f2bf(si);
            const float nr = ar * sr - ai * si + er[k], ni = ar * si + ai * sr + ei[k]; sr = nr; si = ni;
        }
    }
}

constexpr int LDS_BYTES = 163840;
constexpr int LDS_MISC = LDS_MISC_OFF;
static_assert(LDS_MISC_OFF == LDS_BYTES - 256, "LDS map");
constexpr int NPRO = 1, NPH = 6, NPHASES = NPRO + DEPTH * NPH;
constexpr int QI_HY = 256, QI_SCAN = 64, QI_ATTL = NB * 8 * 8, QI_SSM2 = 16 * 17, QI_UNT = 272, QI_ATTC = NB * 8, QI_GLU = MROWS / 256;
constexpr int QO_SCAN = QI_HY, QO_ATTL = QO_SCAN + QI_SCAN, QO_SSM2 = QO_ATTL + QI_ATTL, QO_UNT = QO_SSM2 + QI_SSM2, QO_ATTC = QO_UNT + QI_UNT, QO_GLU = QO_ATTC + QI_ATTC, QI_TOTAL = QO_GLU + QI_GLU;
#ifndef PROBE_DUP_MASK
#define PROBE_DUP_MASK 0
#endif
#ifndef PROBE_P4KINDS
#define PROBE_P4KINDS 0x7f
#endif
__device__ __forceinline__ void dep_signal(const Ctx& c, unsigned* cnt) {
    asm volatile("s_waitcnt vmcnt(0)" ::: "memory");
    __syncthreads();
    if (c.tid == 0) { __builtin_amdgcn_fence(__ATOMIC_RELEASE, "agent"); asm volatile("s_waitcnt vmcnt(0)" ::: "memory"); (void)xb_add(cnt, 1u); }
}
__device__ __forceinline__ void dep_wait(const Ctx& c, unsigned* cnt, unsigned need, unsigned* tmo) {
    if (c.dry) return;
    if (c.tid == 0) {
        unsigned sp = 0;
        while (xb_ld(cnt) < need) { __builtin_amdgcn_s_sleep(2); if ((++sp & 255u) == 0u) { if (xb_ld(tmo)) break; if (sp > XB_SPIN_CAP) { atomicAdd(tmo, 1u); break; } } }
        __builtin_amdgcn_fence(__ATOMIC_ACQUIRE, "agent");
        asm volatile("s_waitcnt vmcnt(0)" ::: "memory");
    }
    __syncthreads();
}

__global__ void __launch_bounds__(512, 2) mk_fwd(Params prm) {
    extern __shared__ __attribute__((aligned(16))) unsigned char lds_raw[];
    Ctx c; c.lds = (LAS unsigned char*)lds_raw; c.ka = (kargp_t)__builtin_amdgcn_kernarg_segment_ptr(); c.ws = prm.ws; c.tid = threadIdx.x; c.lane = c.tid & 63; c.wave = __builtin_amdgcn_readfirstlane(c.tid >> 6); c.G = gridDim.x; c.bid = blockIdx.x; c.dry = prm.dry;
    const int wave0 = c.wave;
    volatile LAS unsigned* misc = (volatile LAS unsigned*)(c.lds + LDS_MISC);
    if (c.tid < 16) misc[c.tid] = 0u;
    __syncthreads();
    unsigned* ctl = wsp<unsigned>(c, WS_CTL);
    const int lo = prm.ph_lo, hi = prm.ph_hi;
    const bool fused = (hi - lo) > 1;
    XcdBarrier bar; bar.bar = ctl + CW_BAR; bar.x = 0; bar.st = misc;
    if (fused) bar = xcd_barrier_post(ctl + CW_BAR, misc);
#ifndef SITE_MASK
#define SITE_MASK 0x3ff
#endif
#define SITE(n) (((SITE_MASK) >> (n)) & 1)
#define IN(k) (lo <= (k) && (k) < hi)
#define FRESH() do { { kargp_t _k = (kargp_t)__builtin_amdgcn_kernarg_segment_ptr(); asm volatile("" : "+s"(_k)); c.ka = _k; c.ws = (unsigned char*)(GAS unsigned char*)_k[37]; } { int _w = wave0; asm volatile("" : "+s"(_w)); c.wave = _w; c.lane = lane_id_fresh(); c.tid = c.wave * 64 + c.lane; } } while (0)
#define SEAM(k) do { if (IN((k) + 1)) xcd_barrier(bar); } while (0)

    if (SITE(0) && IN(0)) {
        FRESH();
        constexpr int J_MOD = 192, J_HY = 544, J_SSM = 64, J_WIN = 4 * 48 * 8, J_WOUT = 4 * 16 * 8, J_WUQ = 4 * 8 * 2, J_W256 = 4 * 4 * 2, J_NORM = MROWS / 256, J_PACK = 4 * 2 * 256;
        constexpr int J0 = J_MOD, J1 = J0 + J_HY, J2 = J1 + J_SSM, J3 = J2 + J_WIN, J4 = J3 + J_WOUT, J5 = J4 + J_WUQ, J6 = J5 + J_W256, J7 = J6 + J_W256, J8 = J7 + J_W256, J9 = J8 + 1, J10 = J9 + J_NORM, J11 = J10 + J_PACK;
        unsigned* dep = ctl + CW_DEP + DEP_SET * 8;
        unsigned* tmo = ctl + CW_BAR + XB_TMO;
        for (int job = c.bid; job < J11; job += c.G) {
            FRESH();
            if (job < J0) { modv_job(c, job); dep_signal(c, dep); }
            else if (job < J1) { hyena_mlp_job(c, job - J0); dep_signal(c, dep + 64); }
            else if (job < J2) ssm_tables_job(c, job - J1);
            else if (job < J3) { const int r = job - J2, l = r / 384, q = r % 384; wconv_tile(c, KIN(I_WIN) + (size_t)l * DM * INC, DM, INC, INP, wsp<bf16_t>(c, WS_WIN) + (size_t)l * INP * DM, DM, 0, q / 8, q % 8); }
            else if (job < J4) { const int r = job - J3, l = r / 128, q = r % 128; wconv_tile(c, KIN(I_WOUT) + (size_t)l * DM * DM, DM, DM, DM, wsp<bf16_t>(c, WS_WOUT) + (size_t)l * DM * DM, DM, 1, q / 8, q % 8); }
            else if (job < J5) { const int r = job - J4, l = r / 16, q = r % 16; wconv_tile(c, KIN(I_WUQ) + (size_t)l * 192 * 384, 192, 384, 384, wsp<bf16_t>(c, WS_WUQ) + (size_t)l * 512 * 256, 256, 1, q / 2, q % 2); }
            else if (job < J6) { const int r = job - J5, l = r / 8, q = r % 8; wconv_tile(c, KIN(I_WUKV) + (size_t)l * 128 * 512, 128, 512, 256, wsp<bf16_t>(c, WS_WUK) + (size_t)l * 256 * 256, 256, 2, q / 2, q % 2); }
            else if (job < J7) { const int r = job - J6, l = r / 8, q = r % 8; wconv_tile(c, KIN(I_WUKV) + (size_t)l * 128 * 512, 128, 512, 256, wsp<bf16_t>(c, WS_WUV) + (size_t)l * 256 * 256, 256, 3, q / 2, q % 2); }
            else if (job < J8) { const int r = job - J7, l = r / 8, q = r % 8; wconv_tile(c, KIN(I_GLUW) + (size_t)l * 256 * 256, 256, 256, 256, wsp<bf16_t>(c, WS_WGLU) + (size_t)l * 256 * 256, 256, 1, q / 2, q % 2); }
            else if (job < J9) rope_job(c);
            else if (job < J10) { dep_wait(c, dep, J_MOD, tmo); FRESH(); const int t = job - J9; norm_rows(c, -1, 0, t * 256, t * 256 + 256); }
            else { dep_wait(c, dep + 64, J_HY, tmo); FRESH(); hyena_pack_job(c, job - J10); }
        }
        SEAM(0);
    }
    for (int l = 0; l < DEPTH; ++l) {
        const int pbase = NPRO + l * NPH;
        if (SITE(2) && IN(pbase + 0)) {
            FRESH();
            pg8::Gemm g{wsp<bf16_t>(c, WS_HCAT), wsp<bf16_t>(c, WS_WIN) + (size_t)l * INP * DM, MROWS, INP, DM};
            pg8::StaticOrder S; S.init(MROWS, INP, c.G, c.bid);
            EpiInProj E{wsp<bf16_t>(c, WS_PB), wsp<bf16_t>(c, WS_UG), wsp<bf16_t>(c, WS_US), wsp<bf16_t>(c, WS_VTG), wsp<bf16_t>(c, WS_HYV), c.lds + pg8::STAGE_BYTES};
            pg8::gemm_phase(c.lds, g, S, E, c.tid);
            SEAM(pbase + 0);
        }
        if (SITE(3) && IN(pbase + 1)) { FRESH(); p2_rows(c, l); SEAM(pbase + 1); }
        if (SITE(4) && IN(pbase + 2)) {
            FRESH();
            pg8::Gemm g{wsp<bf16_t>(c, WS_PB), wsp<bf16_t>(c, WS_WUQ), MROWS, 512, 256};
            pg8::P3Order S{wsp<bf16_t>(c, WS_PB), wsp<bf16_t>(c, WS_PB) + BLKE, wsp<bf16_t>(c, WS_WUQ) + (size_t)l * 512 * 256, wsp<bf16_t>(c, WS_WUK) + (size_t)l * 256 * 256, wsp<bf16_t>(c, WS_WUV) + (size_t)l * 256 * 256,
                           wsp<bf16_t>(c, WS_UG), wsp<bf16_t>(c, WS_WE) + (size_t)l * 16 * 256 * 256, c.G, c.bid};
            EpiP3 E{{wsp<bf16_t>(c, WS_QM), 384, 384}, {wsp<bf16_t>(c, WS_KM), wsp<bf16_t>(c, WS_KR)}, {wsp<bf16_t>(c, WS_VTM)}, {wsp<bf16_t>(c, WS_E)}};
            pg8::gemm_phase(c.lds, g, S, E, c.tid);
            SEAM(pbase + 2);
        }
        if (SITE(5) && IN(pbase + 3)) {
            FRESH();
            unsigned* qh = ctl + CW_Q + 64 * (l + 4 * (c.dry ? 1 : 0));
            unsigned* dep = ctl + CW_DEP + DEP_SET * (l + 4 * (c.dry ? 1 : 0));
            unsigned* tmo = ctl + CW_BAR + XB_TMO;
            const float* ropeM = wsp<float>(c, WS_ROPEM);
            bool gqa_nomax;
            { float gq_ = fabsf(KIN(I_GQ)[l * 64 + c.lane]), gk_ = fabsf(KIN(I_GK)[l * 64 + c.lane]);
              gq_ = fmaxf(gq_, swz_xor<16>(gq_)); gq_ = fmaxf(gq_, swz_xor<8>(gq_)); gq_ = fmaxf(gq_, swz_xor<4>(gq_)); gq_ = fmaxf(gq_, swz_xor<2>(gq_)); gq_ = fmaxf(gq_, swz_xor<1>(gq_)); gq_ = half_max(gq_);
              gk_ = fmaxf(gk_, swz_xor<16>(gk_)); gk_ = fmaxf(gk_, swz_xor<8>(gk_)); gk_ = fmaxf(gk_, swz_xor<4>(gk_)); gk_ = fmaxf(gk_, swz_xor<2>(gk_)); gk_ = fmaxf(gk_, swz_xor<1>(gk_)); gk_ = half_max(gk_);
              const float bound = 64.f * gq_ * gk_ * 0.125f * LOG2E * 1.01f; gqa_nomax = __builtin_amdgcn_readfirstlane(bound < 50.f ? 1 : 0) != 0; }
#define ATT_CALL(DKV, ...) do { float rowmax_[2] = {0.f, 0.f}; if (attn_unit<DKV, false>(rowmax_, __VA_ARGS__)) { (void)attn_unit<DKV, true>(rowmax_, __VA_ARGS__); } } while (0)
            for (;;) {
                __syncthreads();
                if (c.tid == 0) misc[4] = __hip_atomic_fetch_add(qh, 1u, __ATOMIC_RELAXED, __HIP_MEMORY_SCOPE_AGENT);
                __syncthreads();
                const int it = (int)misc[4];
                if (it >= QI_TOTAL) break;
                FRESH();
                if (c.dry) { const int kd_ = it < QO_SCAN ? 0 : it < QO_ATTL ? 1 : it < QO_SSM2 ? 2 : it < QO_UNT ? 3 : it < QO_ATTC ? 4 : it < QO_GLU ? 5 : 6; if (!((c.dry >> (1 + kd_)) & 1)) continue; }
                if (it < QO_SCAN) { hyena_seq<SEQL>(c, l, it, 0); if (l + 1 < DEPTH) hyena_seq<CTXL>(c, l, it, SEQL); dep_signal(c, dep); }
                else if (it < QO_ATTL) { ssm_scan_item(c, l, it - QO_SCAN); dep_signal(c, dep + 64); }
                else if (it >= QO_ATTC && it < QO_GLU && l + 1 == DEPTH) {   }
                else if (it < QO_SSM2 || (it >= QO_ATTC && it < QO_GLU)) {
                    const bool isctx = it >= QO_ATTC; const int r = isctx ? it - QO_ATTC : (it - QO_ATTL) % (NB * 8), blk = isctx ? 8 : (it - QO_ATTL) / (NB * 8)  ;
                    const int kind = r & 1  , head = (r >> 1) & 3, b = r >> 3;
                    const size_t row0 = (size_t)b * NTOK + (isctx ? SEQL : blk * 512); const int kt0 = isctx ? 64 : 0, nkt = isctx ? 4 : 68, nrows = isctx ? 256 : 512;
                    if (kind == 0) { if (c.dry && PROBE_GQAONLY == 1) continue; ATT_CALL(96, c, wsp<bf16_t>(c, WS_QM) + row0 * 384 + head * 96, 384, wsp<bf16_t>(c, WS_KM) + (size_t)(b * 4 + head) * NTOK * 96, wsp<bf16_t>(c, WS_VTM) + (size_t)(b * 4 + head) * 64 * NTOK,
                                                 kt0, nkt, nrows, wsp<bf16_t>(c, WS_PB) + 2 * BLKE + row0 * 256 + head * 64, wsp<bf16_t>(c, WS_HCAT) + row0 * DM + head * 64, !isctx, blk * 512, 0.10206207261596577f * LOG2E, ropeM); }
                    else if (c.dry && PROBE_GQAONLY == 2) { continue; }
                    else if (c.dry && PROBE_ABL) { float rm_[2] = {0.f, 0.f}; (void)attn_unit<64, false, true, PROBE_ABL>(rm_, c, wsp<bf16_t>(c, WS_PB) + 3 * BLKE + row0 * 256 + head * 64, 256, wsp<bf16_t>(c, WS_KG) + (size_t)(b * 2 + (head >> 1)) * NTOK * 64, wsp<bf16_t>(c, WS_VTG) + (size_t)(b * 2 + (head >> 1)) * 64 * NTOK,
                                       kt0, nkt, nrows, wsp<bf16_t>(c, WS_PB) + 5 * BLKE + row0 * 256 + head * 64, wsp<bf16_t>(c, WS_HCAT) + row0 * DM + 256 + head * 64, false, 0, 1.f, ropeM); }
                    else if (gqa_nomax) { float rm_[2] = {0.f, 0.f}; (void)attn_unit<64, false, true>(rm_, c, wsp<bf16_t>(c, WS_PB) + 3 * BLKE + row0 * 256 + head * 64, 256, wsp<bf16_t>(c, WS_KG) + (size_t)(b * 2 + (head >> 1)) * NTOK * 64, wsp<bf16_t>(c, WS_VTG) + (size_t)(b * 2 + (head >> 1)) * 64 * NTOK,
                                       kt0, nkt, nrows, wsp<bf16_t>(c, WS_PB) + 5 * BLKE + row0 * 256 + head * 64, wsp<bf16_t>(c, WS_HCAT) + row0 * DM + 256 + head * 64, false, 0, 1.f, ropeM); }
                    else { ATT_CALL(64, c, wsp<bf16_t>(c, WS_PB) + 3 * BLKE + row0 * 256 + head * 64, 256, wsp<bf16_t>(c, WS_KG) + (size_t)(b * 2 + (head >> 1)) * NTOK * 64, wsp<bf16_t>(c, WS_VTG) + (size_t)(b * 2 + (head >> 1)) * 64 * NTOK,
                                       kt0, nkt, nrows, wsp<bf16_t>(c, WS_PB) + 5 * BLKE + row0 * 256 + head * 64, wsp<bf16_t>(c, WS_HCAT) + row0 * DM + 256 + head * 64, false, 0, 1.f, ropeM); }
                }
                else if (it < QO_UNT) {
                    const int L = it - QO_SSM2, i = L >> 4, g = L & 15;
                    dep_wait(c, dep + 64, QI_SCAN, tmo);
                    pg8::Gemm gm{wsp<bf16_t>(c, WS_US), wsp<bf16_t>(c, WS_WKC) + (size_t)l * 16 * 256 * 512, 16 * NCHUNK, 16 * 256, 512}; pg8::OneUnit S{g * 17 + i, g};
                    pg8::EpiWalk<PutSsmY> E{{wsp<bf16_t>(c, WS_ZS), wsp<bf16_t>(c, WS_UG), KIN(I_SSMD) + l * 256}}; pg8::gemm_phase(c.lds, gm, S, E, c.tid);
                    dep_signal(c, dep + 64 * (2 + i));
                }
                else if (it < QO_ATTC) {
                    dep_wait(c, dep, QI_HY, tmo);
                    const int j = it - QO_UNT; hyena_untranspose(c, 4 * j, 4 * j + 4);
                }
                else {
                    const int pm = it - QO_GLU;
                    dep_wait(c, dep + 64 * (2 + (pm >> 4)), 16u, tmo);
                    pg8::Gemm gm{wsp<bf16_t>(c, WS_ZS), wsp<bf16_t>(c, WS_WGLU) + (size_t)l * 256 * 256, MROWS, 256, 256}; pg8::OneUnit S{pm, 0};
                    pg8::EpiWalk<PutGlu> E{{wsp<bf16_t>(c, WS_HCAT), wsp<bf16_t>(c, WS_ZS), wsp<bf16_t>(c, WS_PB) + 7 * BLKE, KIN(I_GLUB) + l * 256}}; pg8::gemm_phase(c.lds, gm, S, E, c.tid);
                }
            }
            SEAM(pbase + 3);
        }
        if (SITE(6) && IN(pbase + 4)) {
            FRESH();
            pg8::Gemm g{wsp<bf16_t>(c, WS_HCAT), wsp<bf16_t>(c, WS_WOUT) + (size_t)l * DM * DM, MROWS, DM, DM}; pg8::LiveRowsOrder S; S.init2(DM, c.G, c.bid, l + 1 == DEPTH);
            pg8::EpiWalk<PutPlain> E{{wsp<bf16_t>(c, WS_OUTB), DM, DM}}; pg8::gemm_phase(c.lds, g, S, E, c.tid);
            SEAM(pbase + 4);
        }
        if (SITE(7) && IN(pbase + 5)) { FRESH(); norm_rows(c, l, l + 1 < DEPTH ? l + 1 : -1); if (l + 1 < DEPTH) SEAM(pbase + 5); }
    }
#undef IN
#undef SEAM
}

extern "C" void kernel_launch(void* const* d_in, const int* in_sizes, int n_in, void* d_out, int out_size, void* d_ws, size_t ws_size, hipStream_t stream) {
    static int grid = 0;
    if (grid == 0) {
        if (n_in != 36 || out_size != NB * SEQL * DM || ws_size < WS_END) { fprintf(stderr, "kernel_launch: unexpected shapes: n_in %d out %d ws %zu (need %zu)\n", n_in, out_size, ws_size, (size_t)WS_END); grid = -1; return; }
        int dev = 0, cus = 0, per_cu = 0;
        if (hipGetDevice(&dev) != hipSuccess || hipDeviceGetAttribute(&cus, hipDeviceAttributeMultiprocessorCount, dev) != hipSuccess) { grid = -1; return; }
        if (hipFuncSetAttribute((const void*)mk_fwd, hipFuncAttributeMaxDynamicSharedMemorySize, LDS_BYTES) != hipSuccess) { fprintf(stderr, "kernel_launch: hipFuncSetAttribute failed\n"); grid = -1; return; }
        if (hipOccupancyMaxActiveBlocksPerMultiprocessor(&per_cu, (const void*)mk_fwd, 512, LDS_BYTES) != hipSuccess || per_cu < 1) { fprintf(stderr, "kernel_launch: occupancy query says %d blocks per CU\n", per_cu); per_cu = 1; }
        (void)hipGetLastError();
        grid = cus;
    }
    if (grid < 0) return;
    (void)hipMemsetAsync((char*)d_ws + WS_CTL, 0, CTL_BYTES, stream);
    Params p{};
    for (int i = 0; i < 36; ++i) p.in[i] = (const float*)d_in[i];
    p.out = (float*)d_out; p.ws = (unsigned char*)d_ws;
#if MK_ONE_LAUNCH
    p.ph_lo = 0; p.ph_hi = NPHASES;
    hipLaunchKernelGGL(mk_fwd, dim3(grid), dim3(512), LDS_BYTES, stream, p);
#else
    for (int k = 0; k < NPHASES; ++k) { p.ph_lo = k; p.ph_hi = k + 1; const int site = k < NPRO ? k : NPRO + (k - NPRO) % NPH;
        if ((PROBE_DUP_MASK >> site) & 1) { p.dry = 1 | (PROBE_P4KINDS << 1); hipLaunchKernelGGL(mk_fwd, dim3(grid), dim3(512), LDS_BYTES, stream, p); p.dry = 0; }
        hipLaunchKernelGGL(mk_fwd, dim3(grid), dim3(512), LDS_BYTES, stream, p); }
#endif
}
```

```cpp
#include <hip/hip_runtime.h>
#include <cstdio>
#include <cstdint>

#ifndef MK_ONE_LAUNCH
#define MK_ONE_LAUNCH 1
#endif

#define LAS __attribute__((address_space(3)))
typedef unsigned short bf16_t;
typedef short bf16x8 __attribute__((ext_vector_type(8)));
typedef short bf16x4 __attribute__((ext_vector_type(4)));
typedef float f32x4 __attribute__((ext_vector_type(4)));
typedef float f32x16 __attribute__((ext_vector_type(16)));
typedef unsigned u32x4 __attribute__((ext_vector_type(4)));
typedef unsigned u32x2 __attribute__((ext_vector_type(2)));

constexpr int NB = 16, SEQL = 4096, CTXL = 256, NTOK = SEQL + CTXL  , MROWS = NB * NTOK  ;
constexpr int DM = 1024, DEPTH = 4, INC = 2912, INP = 3072;
constexpr int NCHB = NTOK / 16  , NCHUNK = MROWS / 16  ;
constexpr float EPS = 1e-6f;
constexpr float LOG2E = 1.4426950408889634f;
constexpr int LDS_MISC_OFF = 163840 - 256;

constexpr size_t al256(size_t x) { return (x + 255) & ~(size_t)255; }
constexpr size_t WS_CTL = 0;
constexpr size_t CTL_BYTES = 65536;
constexpr size_t WS_MODV = WS_CTL + CTL_BYTES;
constexpr size_t WS_ROPEG = WS_MODV + al256((size_t)4 * 17 * 3072 * 4);
constexpr size_t WS_ROPEM = WS_ROPEG + 64 * 16 * 2 * 4;
constexpr size_t WS_WIN = WS_ROPEM + 64 * 8 * 2 * 4;
constexpr size_t WS_WOUT = WS_WIN + (size_t)4 * 3072 * 1024 * 2;
constexpr size_t WS_WUQ = WS_WOUT + (size_t)4 * 1024 * 1024 * 2;
constexpr size_t WS_WUK = WS_WUQ + (size_t)4 * 512 * 256 * 2;
constexpr size_t WS_WUV = WS_WUK + (size_t)4 * 256 * 256 * 2;
constexpr size_t WS_WGLU = WS_WUV + (size_t)4 * 256 * 256 * 2;
constexpr size_t WS_WE = WS_WGLU + (size_t)4 * 256 * 256 * 2;
constexpr size_t WS_WKC = WS_WE + (size_t)4 * 16 * 256 * 256 * 2;
constexpr size_t WS_A16 = WS_WKC + (size_t)4 * 16 * 256 * 512 * 2;
constexpr size_t WS_GR = WS_A16 + (size_t)4 * 2 * 16 * 64 * 2 * 4;
constexpr size_t WS_GRC = WS_GR + (size_t)4 * 2 * 256 * 8192 * 2;
constexpr size_t WS_CTXR = WS_GRC + (size_t)4 * 2 * 256 * 512 * 2;
constexpr size_t WS_HCAT = WS_CTXR + (size_t)NB * CTXL * DM * 4;
constexpr size_t BLKE = (size_t)MROWS * 256;
constexpr size_t WS_PB = WS_HCAT + (size_t)MROWS * DM * 2;
constexpr size_t WS_KR = WS_PB + 12 * BLKE * 2;
constexpr size_t WS_KG = WS_KR + (size_t)MROWS * 32 * 2;
constexpr size_t WS_VTG = WS_KG + (size_t)32 * NTOK * 64 * 2;
constexpr size_t WS_UG = WS_VTG + (size_t)32 * NTOK * 64 * 2;
constexpr size_t WS_US = WS_UG + BLKE * 2;
constexpr size_t WS_HYV = WS_US + (size_t)16 * NCHUNK * 512 * 2;
constexpr size_t WS_HYX1 = WS_HYV + BLKE * 2;
constexpr size_t WS_HYX2 = WS_HYX1 + BLKE * 2;
constexpr size_t WS_HYG = WS_HYX2 + BLKE * 2;
constexpr size_t WS_HYZ = WS_HYG + BLKE * 2;
constexpr size_t WS_HYY = WS_HYZ + BLKE * 2;
constexpr size_t WS_END = WS_HYY + BLKE * 2;
static_assert(WS_END <= (size_t)1 << 30, "workspace map exceeds 1 GiB");
constexpr size_t WS_QM = WS_PB + 8 * BLKE * 2;
constexpr size_t WS_KM = WS_QM + (size_t)MROWS * 384 * 2;
constexpr size_t WS_VTM = WS_KM + (size_t)MROWS * 384 * 2;
constexpr size_t WS_E = WS_PB + 4 * BLKE * 2;
constexpr size_t WS_ZS = WS_PB + 6 * BLKE * 2;
constexpr size_t WS_OUTB = WS_PB + 8 * BLKE * 2;
constexpr size_t WS_HT = WS_PB;
static_assert(WS_VTM + BLKE * 2 == WS_PB + 12 * BLKE * 2, "alias map");

constexpr int CW_BAR = 0;
constexpr int CW_Q = 4096;
constexpr int CW_TMO = 4096 + 64 * 8;
constexpr int CW_DEP = 5120;
constexpr int DEP_SET = 20 * 64;

__device__ __forceinline__ float bf2f(bf16_t v) { return __uint_as_float(((unsigned)v) << 16); }
__device__ __forceinline__ bf16_t f2bf(float f) { unsigned u = __float_as_uint(f); u += 0x7FFFu + ((u >> 16) & 1u); return (bf16_t)(u >> 16); }
__device__ __forceinline__ unsigned cvt_pk_bf16(float lo, float hi) { unsigned r; asm volatile("v_cvt_pk_bf16_f32 %0, %1, %2" : "=v"(r) : "v"(lo), "v"(hi)); return r; }
__device__ __forceinline__ float lo_bf(unsigned w) { return __uint_as_float(w << 16); }
__device__ __forceinline__ float hi_bf(unsigned w) { return __uint_as_float(w & 0xFFFF0000u); }
__device__ __forceinline__ float sigmf(float x) { float one = 1.f; asm volatile("" : "+v"(one)); return __builtin_amdgcn_rcpf(one + __builtin_amdgcn_exp2f(-1.4426950408889634f * x)); }
__device__ __forceinline__ float siluf(float x) { return x * sigmf(x); }
__device__ __forceinline__ float gelu_tanh(float x) { const float u = 0.7978845608028654f * (x + 0.044715f * x * x * x); return x * sigmf(2.f * u); }
__device__ __forceinline__ int opaque(int x) { asm volatile("" : "+v"(x)); return x; }
__device__ __forceinline__ int lane_id_fresh() { int x; asm volatile("v_mbcnt_lo_u32_b32 %0, -1, 0\n\tv_mbcnt_hi_u32_b32 %0, -1, %0" : "=v"(x)); return x; }
__device__ __forceinline__ float max3_raw(float a, float b, float c) { float r; asm("v_max3_f32 %0, %1, %2, %3" : "=v"(r) : "v"(a), "v"(b), "v"(c)); return r; }
template <int M> __device__ __forceinline__ float swz_xor(float v) { return __int_as_float(__builtin_amdgcn_ds_swizzle(__float_as_int(v), 0x1F | (M << 10))); }
__device__ __forceinline__ float half_sum(float v) { auto r = __builtin_amdgcn_permlane32_swap(__float_as_uint(v), __float_as_uint(v), false, false); return __uint_as_float(r[0]) + __uint_as_float(r[1]); }
__device__ __forceinline__ float half_max(float v) { auto r = __builtin_amdgcn_permlane32_swap(__float_as_uint(v), __float_as_uint(v), false, false); return fmaxf(__uint_as_float(r[0]), __uint_as_float(r[1])); }
__device__ __forceinline__ float half_other(float v, int h) { auto r = __builtin_amdgcn_permlane32_swap(__float_as_uint(v), __float_as_uint(v), false, false); return __uint_as_float(h ? r[0] : r[1]); }
__device__ __forceinline__ float wave_sum(float v) {
    v += swz_xor<16>(v); v += swz_xor<8>(v); v += swz_xor<4>(v); v += swz_xor<2>(v); v += swz_xor<1>(v);
    return half_sum(v);
}

#define XB_TMO      128
#define XB_XCNT(j)  (256  + 64 * (j))
#define XB_XSUB(j)  (1280 + 64 * (j))
#define XB_XGEN(j)  (2304 + 64 * (j))
#define XB_TOP      3328
#define XB_TOPGEN   3392
#define XCD_BAR_WORDS 3456
#define XB_SPIN_CAP (1u << 22)
__device__ __forceinline__ unsigned xb_ld(unsigned* p)              { return __hip_atomic_load(p, __ATOMIC_RELAXED, __HIP_MEMORY_SCOPE_AGENT); }
__device__ __forceinline__ unsigned xb_add(unsigned* p, unsigned v) { return __hip_atomic_fetch_add(p, v, __ATOMIC_RELAXED, __HIP_MEMORY_SCOPE_AGENT); }
__device__ __forceinline__ unsigned xb_xcc_id() { return (unsigned)__builtin_amdgcn_s_getreg((3 << 11) | 20) & 0xFu; }
#define XB_SPIN(cond, bar) do { unsigned _sp = 0; while (cond) { __builtin_amdgcn_s_sleep(1); \
    if ((++_sp & 255u) == 0u) { if (xb_ld(&(bar)[XB_TMO])) break; if (_sp > XB_SPIN_CAP) { atomicAdd(&(bar)[XB_TMO], 1u); break; } } } } while (0)
struct XcdBarrier { unsigned* bar; unsigned x; volatile LAS unsigned* st; };
__device__ __forceinline__ XcdBarrier xcd_barrier_post(unsigned* bar, volatile LAS unsigned* st) {
    XcdBarrier b; b.bar = bar; b.x = xb_xcc_id(); b.st = st;
    if (threadIdx.x == 0) (void)xb_add(&bar[XB_XCNT(b.x)], 1u);
    return b;
}
__device__ __forceinline__ void xcd_barrier_complete(unsigned* bar, unsigned x, unsigned& nloc, unsigned& nx) {
    const unsigned G = gridDim.x * gridDim.y * gridDim.z;
    unsigned sum, cnt, mine, sp = 0u;
    for (;;) {
        sum = 0u; cnt = 0u; mine = 0u;
#pragma unroll
        for (unsigned j = 0; j < 16; ++j) { const unsigned c = xb_ld(&bar[XB_XCNT(j)]); sum += c; cnt += (c > 0u) ? 1u : 0u; }
        mine = xb_ld(&bar[XB_XCNT(x)]);
        if (sum == G) break;
        __builtin_amdgcn_s_sleep(1);
        if ((++sp & 255u) == 0u) { if (xb_ld(&bar[XB_TMO])) break; if (sp > XB_SPIN_CAP) { atomicAdd(&bar[XB_TMO], 1u); break; } }
    }
    nloc = mine > 0u ? mine : 1u; nx = cnt > 0u ? cnt : 1u;
}
__device__ __forceinline__ void xcd_barrier(const XcdBarrier& b) {
    asm volatile("s_waitcnt vmcnt(0)" ::: "memory");
    __syncthreads();
    if (threadIdx.x == 0) {
        unsigned* bar = b.bar;
        __builtin_amdgcn_s_waitcnt(0);
        unsigned nloc = b.st[0], nx = b.st[1];
        if (nloc == 0u) { xcd_barrier_complete(bar, b.x, nloc, nx); b.st[0] = nloc; b.st[1] = nx; }
        const unsigned old = xb_add(&bar[XB_XSUB(b.x)], 1u);
        const unsigned gen = old / nloc;
        if (old + 1u == (gen + 1u) * nloc) {
            __builtin_amdgcn_fence(__ATOMIC_RELEASE, "agent");
            asm volatile("s_waitcnt vmcnt(0)" ::: "memory");
            const unsigned og = xb_add(&bar[XB_TOP], 1u);
            const unsigned tg = og / nx;
            if (og + 1u == (tg + 1u) * nx) xb_add(&bar[XB_TOPGEN], 1u);
            else XB_SPIN(xb_ld(&bar[XB_TOPGEN]) == tg, bar);
            __builtin_amdgcn_fence(__ATOMIC_ACQUIRE, "agent");
            xb_add(&bar[XB_XGEN(b.x)], 1u);
            asm volatile("s_waitcnt vmcnt(0)" ::: "memory");
        } else {
            XB_SPIN(xb_ld(&bar[XB_XGEN(b.x)]) == gen, bar);
            __builtin_amdgcn_fence(__ATOMIC_ACQUIRE, "agent");
            asm volatile("s_waitcnt vmcnt(0)" ::: "memory");
        }
    }
    __syncthreads();
}

namespace pg8 {
constexpr int BM = 256, BK = 64, HALF = 128, HTB = HALF * BK * 2, STAGE_BYTES = 8 * HTB, NXCD = 8, WGM = 8;
__host__ __device__ __forceinline__ int lds_byte(int r, int c) { const int st = (r >> 4) * 2 + (c >> 5), rr = r & 15, cc = c & 31, ob = rr * 64 + cc * 2; return st * 1024 + (ob ^ (((ob >> 9) & 1) << 5)); }
__host__ __device__ __forceinline__ void stage_rc(int b, int& R, int& C) { const int st = b / 1024, sb = b % 1024, swz = sb ^ (((sb >> 9) & 1) << 5); R = (st >> 1) * 16 + swz / 64; C = (st & 1) * 32 + (swz % 64) / 2; }
__host__ __device__ __forceinline__ int perm32(int rho) { const int n = rho >> 4, i = rho & 15; return 8 * (i >> 2) + 4 * n + (i & 3); }
struct Unit { int pm, pn, kd; };
struct Gemm { const bf16_t* A; const bf16_t* Bt; int M, N, K; };
struct StaticOrder {
    int nM, nN, nwg, G, c;
    __host__ __device__ void init(int M, int N, int G_, int c_) { nM = M / BM; nN = N / BM; nwg = nM * nN; G = G_; c = c_; }
    __host__ __device__ bool next(int i, Unit& u) const {
        const long L = (long)i * G + c; if (L >= nwg) return false;
        int wgid = (int)L; { const int q = nwg / NXCD, r = nwg % NXCD, xcd = wgid % NXCD, off = wgid / NXCD; wgid = (xcd < r ? xcd * (q + 1) : r * (q + 1) + (xcd - r) * q) + off; }
        const int nig = WGM * nN, gid = wgid / nig, fm = gid * WGM, gsz = (nM - fm) < WGM ? (nM - fm) : WGM;
        u.pm = fm + ((wgid % nig) % gsz); u.pn = (wgid % nig) / gsz; u.kd = 0; return true;
    }
    __device__ __forceinline__ void a_ready(const Unit&) const {}
    __device__ __forceinline__ void done(const Unit&) const {}
    __device__ __forceinline__ const char* abase(const Gemm& g, const Unit& u, size_t tstep) const { return (const char*)g.A + (size_t)u.pm * tstep; }
    __device__ __forceinline__ const char* bbase(const Gemm& g, const Unit& u, size_t tstep) const { return (const char*)g.Bt + (size_t)u.pn * tstep; }
};
struct LiveRowsOrder : StaticOrder {
    bool skip;
    __host__ __device__ void init2(int N, int G_, int c_, bool skip_) { skip = skip_; init(skip_ ? NB * SEQL : MROWS, N, G_, c_); }
    __host__ __device__ bool next(int i, Unit& u) const { if (!StaticOrder::next(i, u)) return false; if (skip) u.pm = (u.pm >> 4) * 17 + (u.pm & 15); return true; }
};
struct BatchedOrder {
    int nwg, G, c, tpg;
    __host__ __device__ void init(int ng, int tpg_, int G_, int c_) { nwg = ng * tpg_; tpg = tpg_; G = G_; c = c_; }
    __host__ __device__ bool next(int i, Unit& u) const { const int L = i * G + c; if (L >= nwg) return false; u.pm = L; u.pn = L / tpg; u.kd = 0; return true; }
    __device__ __forceinline__ void a_ready(const Unit&) const {}
    __device__ __forceinline__ void done(const Unit&) const {}
    __device__ __forceinline__ const char* abase(const Gemm& g, const Unit& u, size_t tstep) const { return (const char*)g.A + (size_t)u.pm * tstep; }
    __device__ __forceinline__ const char* bbase(const Gemm& g, const Unit& u, size_t tstep) const { return (const char*)g.Bt + (size_t)u.pn * tstep; }
};
struct P3Order {
    const bf16_t *b0, *b1, *wuq, *wuk, *wuv, *ug, *we; int G, c;
    __host__ __device__ bool next(int i, Unit& u) const {
        const int L = i * G + c; if (L >= 1360) return false;
        if (L < 544) { u.kd = 0; u.pm = L >> 1; u.pn = L & 1; } else if (L < 816) { u.kd = 1; u.pm = L - 544; u.pn = 0; } else if (L < 1088) { u.kd = 2; u.pm = 0; u.pn = L - 816; } else { u.kd = 3; u.pm = L - 1088; u.pn = (L - 1088) / 17; }
        return true;
    }
    __device__ __forceinline__ void a_ready(const Unit&) const {}
    __device__ __forceinline__ void done(const Unit&) const {}
    __device__ __forceinline__ const char* abase(const Gemm&, const Unit& u, size_t tstep) const { const bf16_t* p = u.kd == 0 ? b0 : u.kd == 1 ? b1 : u.kd == 2 ? wuv : ug; return (const char*)p + (size_t)u.pm * tstep; }
    __device__ __forceinline__ const char* bbase(const Gemm&, const Unit& u, size_t tstep) const { const bf16_t* p = u.kd == 0 ? wuq : u.kd == 1 ? wuk : u.kd == 2 ? b1 : we; return (const char*)p + (size_t)u.pn * tstep; }
};

struct OneUnit {
    int pm, pn;
    __host__ __device__ bool next(int i, Unit& u) const { if (i) return false; u.pm = pm; u.pn = pn; u.kd = 0; return true; }
    __device__ __forceinline__ void a_ready(const Unit&) const {}
    __device__ __forceinline__ void done(const Unit&) const {}
    __device__ __forceinline__ const char* abase(const Gemm& g, const Unit& u, size_t tstep) const { return (const char*)g.A + (size_t)u.pm * tstep; }
    __device__ __forceinline__ const char* bbase(const Gemm& g, const Unit& u, size_t tstep) const { return (const char*)g.Bt + (size_t)u.pn * tstep; }
};
template <class Epi, class Sched>
__device__ __forceinline__ void gemm_phase(LAS unsigned char* lds, const Gemm g, const Sched& S, const Epi& E, int tid_in) {
    const int tid = tid_in, wid = __builtin_amdgcn_readfirstlane(tid >> 6), lane = tid & 63, wr = wid >> 2, wc = wid & 3, fr = lane & 15, fq = lane >> 4;
    const int K = g.K, nt = K / BK;
    unsigned voffA[2], voffB[2];
#pragma unroll
    for (int i = 0; i < 2; ++i) { int R, C; stage_rc(tid * 16 + i * 8192, R, C); const int Rb = Epi::PERM ? ((R & ~31) + perm32(R & 31)) : R;
        voffA[i] = (unsigned)(R * K + C) * 2u; voffB[i] = (unsigned)(Rb * K + C) * 2u; }
    const size_t kstep = (size_t)(BK * 2);
    const size_t hstep = (size_t)HALF * K * 2;
    const size_t tstep = 2 * hstep;
    const unsigned ldsw = (unsigned)wid * 1024u;
    const int aoff = lds_byte(wr * 64 + fr, fq * 8), boff = lds_byte(wc * 32 + fr, fq * 8);
#define PG8_SA(b, h) (((b) * 2 + (h)) * HTB)
#define PG8_SB(b, h) ((4 + (b) * 2 + (h)) * HTB)
#define PG8_STAGE(bufoff, gbase, voff) do { _Pragma("unroll") for (int _i = 0; _i < 2; ++_i) \
        __builtin_amdgcn_global_load_lds((const unsigned*)((const char*)(gbase) + (voff)[_i]), (LAS unsigned*)(lds + (bufoff) + ldsw + _i * 8192), 16, 0, 0); } while (0)
#define PG8_LDA(dst, b, h) do { _Pragma("unroll") for (int m = 0; m < 4; ++m) _Pragma("unroll") for (int k = 0; k < 2; ++k) dst[m][k] = *(const LAS bf16x8*)(lds + PG8_SA(b, h) + aoff + m * 2048 + k * 1024); } while (0)
#define PG8_LDB(dst, b, h) do { _Pragma("unroll") for (int n = 0; n < 2; ++n) _Pragma("unroll") for (int k = 0; k < 2; ++k) dst[n][k] = *(const LAS bf16x8*)(lds + PG8_SB(b, h) + boff + n * 2048 + k * 1024); } while (0)
#define PG8_MMA(ai, bj, At, Bt) do { __builtin_amdgcn_s_setprio(1); _Pragma("unroll") for (int m = 0; m < 4; ++m) _Pragma("unroll") for (int n = 0; n < 2; ++n) _Pragma("unroll") for (int k = 0; k < 2; ++k) \
        acc[ai][bj][m][n] = __builtin_amdgcn_mfma_f32_16x16x32_bf16(Bt[n][k], At[m][k], acc[ai][bj][m][n], 0, 0, 0); __builtin_amdgcn_s_setprio(0); } while (0)
#define PG8_WAIT_V(n) asm volatile("s_waitcnt vmcnt(" #n ")" ::: "memory")
#define PG8_WAIT_L(n) asm volatile("s_waitcnt lgkmcnt(" #n ")" ::: "memory")
#define PG8_BAR __builtin_amdgcn_s_barrier()
#define PG8_SCHED __builtin_amdgcn_sched_barrier(0)
    Unit cur, nxt; int ui = 0;
    if (!S.next(0, cur)) return;
    f32x4 acc[2][2][4][2];
#pragma unroll
    for (int a = 0; a < 2; ++a)
#pragma unroll
        for (int b = 0; b < 2; ++b)
#pragma unroll
            for (int m = 0; m < 4; ++m)
#pragma unroll
                for (int n = 0; n < 2; ++n) acc[a][b][m][n] = (f32x4){0.f, 0.f, 0.f, 0.f};
    bf16x8 At[4][2], B0[2][2], B1[2][2];
    const char* cA = S.abase(g, cur, tstep); const char* cB = S.bbase(g, cur, tstep);
    S.a_ready(cur);
    PG8_STAGE(PG8_SB(0, 0), cB, voffB); PG8_STAGE(PG8_SA(0, 0), cA, voffA); PG8_STAGE(PG8_SB(0, 1), cB + hstep, voffB); PG8_STAGE(PG8_SA(0, 1), cA + hstep, voffA);
    if (wr == 1) PG8_BAR;
    PG8_WAIT_V(4); PG8_BAR;
    PG8_STAGE(PG8_SB(1, 0), cB + kstep, voffB); PG8_STAGE(PG8_SA(1, 0), cA + kstep, voffA); PG8_STAGE(PG8_SB(1, 1), cB + hstep + kstep, voffB);
    PG8_WAIT_V(6); PG8_BAR;
    for (;;) {
        const bool has_next = S.next(ui + 1, nxt);
        const char* nA = has_next ? S.abase(g, nxt, tstep) : cA; const char* nB = has_next ? S.bbase(g, nxt, tstep) : cB;
        for (int t = 0; t < nt; t += 2) {
            const bool last = (t == nt - 2);
            const char* a1 = cA + (size_t)(t + 1) * kstep;
            const char* a2 = last ? nA : cA + (size_t)(t + 2) * kstep; const char* b2 = last ? nB : cB + (size_t)(t + 2) * kstep;
            const char* a3 = a2 + kstep; const char* b3 = b2 + kstep;
            if (last && has_next) S.a_ready(nxt);
            PG8_LDB(B0, 0, 0); PG8_SCHED; PG8_LDA(At, 0, 0); PG8_STAGE(PG8_SA(1, 1), a1 + hstep, voffA);
            PG8_WAIT_L(8); PG8_BAR; PG8_WAIT_L(0); PG8_MMA(0, 0, At, B0); PG8_BAR; PG8_SCHED;
            PG8_LDB(B1, 0, 1); PG8_STAGE(PG8_SB(0, 0), b2, voffB);
            PG8_BAR; PG8_WAIT_L(0); PG8_MMA(0, 1, At, B1); PG8_BAR;
            PG8_LDA(At, 0, 1); PG8_STAGE(PG8_SA(0, 0), a2, voffA);
            PG8_BAR; PG8_WAIT_L(0); PG8_MMA(1, 0, At, B0); PG8_BAR; PG8_SCHED;
            PG8_STAGE(PG8_SB(0, 1), b2 + hstep, voffB);
            PG8_WAIT_V(6); PG8_BAR; PG8_MMA(1, 1, At, B1); PG8_BAR;
            PG8_LDB(B0, 1, 0); PG8_SCHED; PG8_LDA(At, 1, 0); PG8_STAGE(PG8_SA(0, 1), a2 + hstep, voffA);
            PG8_WAIT_L(8); PG8_BAR; PG8_WAIT_L(0); PG8_MMA(0, 0, At, B0); PG8_BAR; PG8_SCHED;
            PG8_LDB(B1, 1, 1); PG8_STAGE(PG8_SB(1, 0), b3, voffB);
            PG8_BAR; PG8_WAIT_L(0); PG8_MMA(0, 1, At, B1); PG8_BAR;
            PG8_LDA(At, 1, 1); PG8_STAGE(PG8_SA(1, 0), a3, voffA);
            PG8_BAR; PG8_WAIT_L(0); PG8_MMA(1, 0, At, B0); PG8_BAR; PG8_SCHED;
            PG8_STAGE(PG8_SB(1, 1), b3 + hstep, voffB);
            PG8_WAIT_V(6); PG8_BAR; PG8_MMA(1, 1, At, B1); PG8_BAR;
        }
        { const int l2 = lane_id_fresh(); E(acc, cur, wr, wc, l2 & 15, l2 >> 4); } S.done(cur);
        if (!has_next) break;
#pragma unroll
        for (int a = 0; a < 2; ++a)
#pragma unroll
            for (int b = 0; b < 2; ++b)
#pragma unroll
                for (int m = 0; m < 4; ++m)
#pragma unroll
                    for (int n = 0; n < 2; ++n) acc[a][b][m][n] = (f32x4){0.f, 0.f, 0.f, 0.f};
        cur = nxt; cA = nA; cB = nB; ++ui;
    }
    PG8_WAIT_V(0);
    if (wr == 0) PG8_BAR;
    PG8_BAR;
#undef PG8_SA
#undef PG8_SB
#undef PG8_STAGE
#undef PG8_LDA
#undef PG8_LDB
#undef PG8_MMA
#undef PG8_WAIT_V
#undef PG8_WAIT_L
#undef PG8_BAR
#undef PG8_SCHED
}

template <class F> struct EpiWalk {
    static constexpr bool PERM = true, AFTER_DRAIN = false;
    F f;
    __device__ __forceinline__ void operator()(const f32x4 (&acc)[2][2][4][2], const Unit& u, int wr, int wc, int fr, int fq) const {
#pragma unroll
        for (int ai = 0; ai < 2; ++ai)
#pragma unroll
            for (int m = 0; m < 4; ++m) {
                const int rin = ai * HALF + wr * 64 + m * 16 + fr;
#pragma unroll
                for (int bj = 0; bj < 2; ++bj) { const int cin = bj * HALF + wc * 32 + 8 * fq; f.put(u.pm, u.pn, rin, cin, acc[ai][bj][m][0], acc[ai][bj][m][1]); asm volatile("" ::: "memory"); }
            }
    }
};
}

__device__ __forceinline__ u32x4 pack8(const f32x4& a, const f32x4& b) {
    u32x4 w; w.x = cvt_pk_bf16(a[0], a[1]); w.y = cvt_pk_bf16(a[2], a[3]); w.z = cvt_pk_bf16(b[0], b[1]); w.w = cvt_pk_bf16(b[2], b[3]); return w;
}
__device__ __forceinline__ void unpack8(const u32x4 w, float (&o)[8]) {
    o[0] = lo_bf(w.x); o[1] = hi_bf(w.x); o[2] = lo_bf(w.y); o[3] = hi_bf(w.y); o[4] = lo_bf(w.z); o[5] = hi_bf(w.z); o[6] = lo_bf(w.w); o[7] = hi_bf(w.w);
}

struct PutPlain {
    bf16_t* dst; int ldc, ncols;
    __device__ __forceinline__ void put(int pm, int pn, int rin, int cin, const f32x4& a, const f32x4& b) const { const int col = pn * 256 + cin; if (col < ncols) *(u32x4*)(dst + ((size_t)pm * 256 + rin) * ldc + col) = pack8(a, b); }
};
struct PutKm {
    bf16_t* km; const bf16_t* kr;
    __device__ __forceinline__ void put(int pm, int pn, int rin, int cin, const f32x4& a, const f32x4& b) const {
        const int bb = pm / 17, key = (pm - bb * 17) * 256 + rin, hd = cin >> 6, d = cin & 63;
        bf16_t* dst = km + ((size_t)(bb * 4 + hd) * NTOK + key) * 96;
        *(u32x4*)(dst + d) = pack8(a, b);
        if (d < 32) *(u32x4*)(dst + 64 + d) = *(const u32x4*)(kr + ((size_t)pm * 256 + rin) * 32 + d);
    }
};
struct PutVt {
    bf16_t* vt;
    __device__ __forceinline__ void put(int pm, int pn, int rin, int cin, const f32x4& a, const f32x4& b) const {
        const int bb = pn / 17, key = (pn - bb * 17) * 256 + cin;
        *(u32x4*)(vt + ((size_t)(bb * 4 + (rin >> 6)) * 64 + (rin & 63)) * NTOK + key) = pack8(a, b);
    }
};
struct PutE {
    bf16_t* e;
    __device__ __forceinline__ void put(int pm, int pn, int rin, int cin, const f32x4& a, const f32x4& b) const { *(u32x4*)(e + ((size_t)pm * 256 + rin) * 256 + cin) = pack8(a, b); }
};
struct PutSsmY {
    bf16_t* zs; const bf16_t* ug; const float* dskip;
    __device__ __forceinline__ void put(int pm, int pn, int rin, int cin, const f32x4& a, const f32x4& b) const {
        const int g = pn, n = (pm - g * 17) * 256 + rin, tok = n * 16 + (cin >> 4), ho = cin & 15, ch = g * 16 + ho;
        float u[8]; unpack8(*(const u32x4*)(ug + ((size_t)g * MROWS + tok) * 16 + ho), u);
        const f32x4 d0 = *(const f32x4*)(dskip + ch), d1 = *(const f32x4*)(dskip + ch + 4);
        f32x4 y0, y1;
#pragma unroll
        for (int i = 0; i < 4; ++i) { y0[i] = gelu_tanh(a[i] + d0[i] * u[i]); y1[i] = gelu_tanh(b[i] + d1[i] * u[4 + i]); }
        *(u32x4*)(zs + (size_t)tok * 256 + ch) = pack8(y0, y1);
    }
};
struct PutGlu {
    bf16_t* cat; const bf16_t* zs; const bf16_t* gate; const float* gb;
    __device__ __forceinline__ void put(int pm, int pn, int rin, int cin, const f32x4& a, const f32x4& b) const {
        const size_t row = (size_t)pm * 256 + rin; const int col = cin;
        float z[8], gt[8]; unpack8(*(const u32x4*)(zs + row * 256 + col), z); unpack8(*(const u32x4*)(gate + row * 256 + col), gt);
        const f32x4 b0 = *(const f32x4*)(gb + col), b1 = *(const f32x4*)(gb + col + 4);
        f32x4 y0, y1;
#pragma unroll
        for (int i = 0; i < 4; ++i) { y0[i] = z[i] * sigmf(a[i] + b0[i]) * siluf(gt[i]); y1[i] = z[4 + i] * sigmf(b[i] + b1[i]) * siluf(gt[4 + i]); }
        *(u32x4*)(cat + row * DM + 512 + col) = pack8(y0, y1);
    }
};

struct EpiInProj {
    static constexpr bool PERM = true, AFTER_DRAIN = false;
    bf16_t *pb, *ug, *us, *vtg, *hy0;
    LAS unsigned char* scratch;
    __device__ __forceinline__ void operator()(const f32x4 (&acc)[2][2][4][2], const pg8::Unit& u, int wr, int wc, int fr, int fq) const {
        const int pn = u.pn, pm = u.pm;
        const int bb = pm / 17, jt = (pm - bb * 17) * 256;
        LAS unsigned char* sw = scratch + (wr * 4 + wc) * 1280;
        const int ln = fq * 16 + fr, tch = ln >> 1, thalf = ln & 1;
#pragma unroll
        for (int ai = 0; ai < 2; ++ai)
#pragma unroll
            for (int m = 0; m < 4; ++m) {
                const int rin = ai * pg8::HALF + wr * 64 + m * 16 + fr;
#pragma unroll
                for (int bj = 0; bj < 2; ++bj) {
                    const int cin = bj * pg8::HALF + wc * 32 + 8 * fq;
                    const u32x4 w = pack8(acc[ai][bj][m][0], acc[ai][bj][m][1]);
                    const bool plain = pn < 4 || pn == 5 || pn == 7 || (pn == 4 && bj == 0);
                    if (plain) { *(u32x4*)(pb + (size_t)pn * BLKE + ((size_t)pm * 256 + rin) * 256 + cin) = w; }
                    else if (pn == 6) { const size_t row = (size_t)pm * 256 + rin; const int g = cin >> 4, hi0 = cin & 15;
                        *(u32x4*)(ug + ((size_t)g * MROWS + row) * 16 + hi0) = w;
                        *(u32x4*)(us + ((size_t)g * NCHUNK + (row >> 4)) * 512 + (row & 15) * 16 + hi0) = w; }
                    else {
                        *(LAS u32x4*)(sw + fr * 80 + fq * 16) = w;
                        asm volatile("" ::: "memory");
                        unsigned short e[8];
#pragma unroll
                        for (int i = 0; i < 8; ++i) e[i] = *(const LAS unsigned short*)(sw + (thalf * 8 + i) * 80 + tch * 2);
                        asm volatile("" ::: "memory");
                        u32x4 t; t.x = e[0] | ((unsigned)e[1] << 16); t.y = e[2] | ((unsigned)e[3] << 16); t.z = e[4] | ((unsigned)e[5] << 16); t.w = e[6] | ((unsigned)e[7] << 16);
                        const int chn = bj * pg8::HALF + wc * 32 + tch;
                        const int tok = jt + ai * pg8::HALF + wr * 64 + m * 16 + thalf * 8;
                        bf16_t* dst = (pn == 4) ? vtg + ((size_t)(bb * 2 + ((chn - 128) >> 6)) * 64 + ((chn - 128) & 63)) * NTOK + tok
                                                : hy0 + (size_t)(pn - 8) * BLKE + ((size_t)chn * 16 + bb) * NTOK + tok;
                        *(u32x4*)dst = t;
                    }
                    asm volatile("" ::: "memory");
                }
            }
    }
};

struct EpiP3 {
    static constexpr bool PERM = true, AFTER_DRAIN = false;
    PutPlain q; PutKm k; PutVt v; PutE e;
    __device__ __forceinline__ void operator()(const f32x4 (&acc)[2][2][4][2], const pg8::Unit& u, int wr, int wc, int fr, int fq) const {
#pragma unroll
        for (int ai = 0; ai < 2; ++ai)
#pragma unroll
            for (int m = 0; m < 4; ++m) {
                const int rin = ai * pg8::HALF + wr * 64 + m * 16 + fr;
#pragma unroll
                for (int bj = 0; bj < 2; ++bj) { const int cin = bj * pg8::HALF + wc * 32 + 8 * fq;
                    if (u.kd == 0) q.put(u.pm, u.pn, rin, cin, acc[ai][bj][m][0], acc[ai][bj][m][1]);
                    else if (u.kd == 1) k.put(u.pm, u.pn, rin, cin, acc[ai][bj][m][0], acc[ai][bj][m][1]);
                    else if (u.kd == 2) v.put(u.pm, u.pn, rin, cin, acc[ai][bj][m][0], acc[ai][bj][m][1]);
                    else e.put(u.pm, u.pn, rin, cin, acc[ai][bj][m][0], acc[ai][bj][m][1]);
                    asm volatile("" ::: "memory"); }
            }
    }
};

struct Params {
    const float* in[36];
    float* out;
    unsigned char* ws;
    int ph_lo, ph_hi, dry, pad;
};
enum { I_X = 0, I_C, I_CTX, I_CCTX, I_WMOD, I_BMOD, I_GPRE, I_GPOST, I_WIN, I_WOUT, I_GCQ, I_WUQ, I_GCKV, I_WUKV, I_GQ, I_GK,
       I_LRE, I_LIM, I_LSTEP, I_BRE, I_BIM, I_CRE, I_CIM, I_SSMD, I_GLUW, I_GLUB, I_HCW, I_HCB, I_HW1, I_HB1, I_HF1, I_HW2, I_HB2, I_HF2, I_HW3, I_HBIAS };

typedef __attribute__((address_space(4))) const unsigned long long* kargp_t;
struct Ctx {
    LAS unsigned char* lds;
    kargp_t ka;
    unsigned char* ws;
    int tid, lane, wave, G, bid, dry;
};
#define GAS __attribute__((address_space(1)))
#define KIN(i) ((const float*)(GAS const float*)c.ka[(i)])
#define KOUT() ((float*)(GAS float*)c.ka[36])
template <class T> __device__ __forceinline__ T* wsp(const Ctx& c, size_t off) { return (T*)(c.ws + off); }

__device__ __forceinline__ int wmap(int kind, int n) {
    if (kind == 0) { if (n < 192) return n; if (n < 224) return 320 + (n - 192); if (n < 256) return -1; if (n < 384) return 192 + (n - 256); if (n < 512) return -1; return n - 160; }
    if (kind == 2) return (n >> 6) * 128 + (n & 63);
    if (kind == 3) return (n >> 6) * 128 + 64 + (n & 63);
    return n;
}
__device__ __forceinline__ void wconv_tile(const Ctx& c, const float* src, int Ks, int Ns, int Nlim, bf16_t* dst, int Kp, int kind, int nt, int kt) {
    LAS float* T = (LAS float*)c.lds;
    const int n0 = nt * 64, k0 = kt * 128;
    const int nn = c.tid & 63, kk0 = c.tid >> 6; const int n = n0 + nn; const int sc = (n < Nlim) ? wmap(kind, n) : -1;
    float v[16];
#pragma unroll
    for (int i = 0; i < 16; ++i) { const int k = k0 + kk0 + 8 * i; v[i] = (k < Ks && sc >= 0) ? src[(size_t)k * Ns + sc] : 0.f; }
#pragma unroll
    for (int i = 0; i < 16; ++i) T[(kk0 + 8 * i) * 65 + nn] = v[i];
    __syncthreads();
#pragma unroll
    for (int i = 0; i < 2; ++i) { const int e = c.tid + i * 512, row = e >> 4, pc = e & 15; float x[8];
#pragma unroll
        for (int j = 0; j < 8; ++j) x[j] = T[(pc * 8 + j) * 65 + row];
        u32x4 w; w.x = cvt_pk_bf16(x[0], x[1]); w.y = cvt_pk_bf16(x[2], x[3]); w.z = cvt_pk_bf16(x[4], x[5]); w.w = cvt_pk_bf16(x[6], x[7]);
        *(u32x4*)(dst + (size_t)(n0 + row) * Kp + k0 + pc * 8) = w; }
    __syncthreads();
}

__device__ __forceinline__ void modv_job(const Ctx& c, int job) {
    const int l = job / 48, j0 = (job % 48) * 64;
    LAS float* sc = (LAS float*)c.lds;
    LAS float* red = sc + 17 * 1024;
    const float* cv = KIN(I_C); const float* cc = KIN(I_CCTX);
    for (int e = c.tid; e < 17 * 1024; e += 512) { const int r = e >> 10, k = e & 1023; const float v = (r < 16) ? cv[r * 1024 + k] : cc[k]; sc[e] = siluf(v); }
    __syncthreads();
    const int col = c.tid & 63, ks = c.tid >> 6;
    const float* w = KIN(I_WMOD) + (size_t)l * 1024 * 3072 + j0 + col;
    float acc[17];
#pragma unroll
    for (int r = 0; r < 17; ++r) acc[r] = 0.f;
    for (int k = ks * 128; k < ks * 128 + 128; ++k) { const float wv = w[(size_t)k * 3072];
#pragma unroll
        for (int r = 0; r < 17; ++r) acc[r] += sc[r * 1024 + k] * wv; }
#pragma unroll
    for (int r = 0; r < 17; ++r) red[(ks * 17 + r) * 64 + col] = acc[r];
    __syncthreads();
    float* mv = wsp<float>(c, WS_MODV);
    for (int e = c.tid; e < 17 * 64; e += 512) { const int r = e >> 6, cl = e & 63; float s = KIN(I_BMOD)[l * 3072 + j0 + cl];
#pragma unroll
        for (int q = 0; q < 8; ++q) s += red[(q * 17 + r) * 64 + cl];
        mv[((size_t)l * 17 + r) * 3072 + j0 + cl] = s; }
    __syncthreads();
}

__device__ __forceinline__ void rope_job(const Ctx& c) {
    float* rg = wsp<float>(c, WS_ROPEG); float* rm = wsp<float>(c, WS_ROPEM);
    for (int e = c.tid; e < 64 * 16; e += 512) { const int pos = e >> 4, f = e & 15; const float inv = powf(10000.f, -(float)(2 * f) / 32.f); const float a = (float)pos * inv; rg[e * 2] = cosf(a); rg[e * 2 + 1] = sinf(a); }
    for (int e = c.tid; e < 64 * 8; e += 512) { const int pos = e >> 3, f = e & 7; const float inv = powf(10000.f, -(float)(2 * f) / 16.f); const float a = (float)pos * inv; rm[e * 2] = cosf(a); rm[e * 2 + 1] = sinf(a); }
}

typedef float cpx __attribute__((ext_vector_type(2)));
#define CPX(a, b) ((cpx){(a), (b)})
__device__ __forceinline__ cpx cmul(cpx a, cpx b) { return CPX(a.x * b.x - a.y * b.y, a.x * b.y + a.y * b.x); }
__device__ __forceinline__ void ssm_tables_job(const Ctx& c, int job) {
    const int l = job >> 4, g = job & 15;
    LAS cpx* apow = (LAS cpx*)c.lds;
    LAS cpx* bbar = apow + 2 * 17 * 64;
    LAS cpx* cm = bbar + 2 * 64 * 16;
    LAS float* Kc = (LAS float*)(cm + 2 * 16 * 64);
    for (int e = c.tid; e < 2 * 64; e += 512) {
        const int d = e >> 6, p = e & 63; const size_t ix = (((size_t)l * 2 + d) * 16 + g) * 64 + p;
        const float lr = KIN(I_LRE)[ix], li = KIN(I_LIM)[ix], st = expf(KIN(I_LSTEP)[((size_t)l * 2 + d) * 16 + g]);
        for (int k = 0; k <= 16; ++k) { const float m = expf(lr * st * (float)k), an = li * st * (float)k; apow[(d * 17 + k) * 64 + p] = CPX(m * cosf(an), m * sinf(an)); }
    }
    __syncthreads();
    for (int e = c.tid; e < 2 * 64 * 16; e += 512) {
        const int d = e >> 10, p = (e >> 4) & 63, h = e & 15; const size_t ix = (((size_t)l * 2 + d) * 16 + g) * 64 + p;
        const float lr = KIN(I_LRE)[ix], li = KIN(I_LIM)[ix];
        const cpx a = apow[(d * 17 + 1) * 64 + p]; const cpx am1 = CPX(a.x - 1.f, a.y);
        const float den = lr * lr + li * li; const cpx q = CPX((am1.x * lr + am1.y * li) / den, (am1.y * lr - am1.x * li) / den);
        const cpx b = CPX(KIN(I_BRE)[ix * 16 + h], KIN(I_BIM)[ix * 16 + h]);
        bbar[e] = cmul(q, b);
        const size_t cx = ((((size_t)l * 2 + d) * 16 + g) * 16 + h) * 64 + p;
        cm[(d * 16 + h) * 64 + p] = CPX(KIN(I_CRE)[cx], KIN(I_CIM)[cx]);
    }
    __syncthreads();
    for (int e = c.tid; e < 2 * 16 * 256; e += 512) {
        const int d = e >> 12, dd = (e >> 8) & 15, ho = (e >> 4) & 15, hi = e & 15; float s = 0.f;
        for (int p = 0; p < 64; ++p) { const cpx w = cmul(cm[(d * 16 + ho) * 64 + p], apow[(d * 17 + dd) * 64 + p]); const cpx b = bbar[(d * 64 + p) * 16 + hi]; s += w.x * b.x - w.y * b.y; }
        Kc[e] = s;
    }
    __syncthreads();
    bf16_t* wkc = wsp<bf16_t>(c, WS_WKC) + ((size_t)l * 16 + g) * 256 * 512;
    for (int e = c.tid; e < 256 * 512; e += 512) {
        const int r = e >> 9, q = e & 511, i = r >> 4, ho = r & 15; float v;
        if (q < 256) { const int j = q >> 4, hi = q & 15; v = 0.f; if (j <= i) v += Kc[((0 * 16 + (i - j)) * 16 + ho) * 16 + hi]; if (j >= i) v += Kc[((1 * 16 + (j - i)) * 16 + ho) * 16 + hi]; }
        else { const int qq = q - 256, dq = qq >> 7, comp = (qq >> 6) & 1, p = qq & 63, k = dq == 0 ? i + 1 : 16 - i; const cpx w = cmul(cm[(dq * 16 + ho) * 64 + p], apow[(dq * 17 + k) * 64 + p]); v = comp == 0 ? w.x : -w.y; }
        wkc[e] = f2bf(v);
    }
    bf16_t* we = wsp<bf16_t>(c, WS_WE) + ((size_t)l * 16 + g) * 256 * 256;
    for (int e = c.tid; e < 256 * 256; e += 512) {
        const int qq = e >> 8, cidx = e & 255, j = cidx >> 4, hi = cidx & 15, dq = qq >> 7, comp = (qq >> 6) & 1, p = qq & 63, k = dq == 0 ? 15 - j : j;
        const cpx w = cmul(apow[(dq * 17 + k) * 64 + p], bbar[(dq * 64 + p) * 16 + hi]);
        we[e] = f2bf(comp == 0 ? w.x : w.y);
    }
    float* a16 = wsp<float>(c, WS_A16);
    for (int e = c.tid; e < 128; e += 512) { const int d = e >> 6, p = e & 63; const cpx a = apow[(d * 17 + 16) * 64 + p]; const size_t ix = ((((size_t)l * 2 + d) * 16 + g) * 64 + p) * 2; a16[ix] = a.x; a16[ix + 1] = a.y; }
    __syncthreads();
}

__device__ __forceinline__ void hyena_mlp_job(const Ctx& c, int job) {
    const int l = job / 136, tt = job % 136;
    const bool isctx = tt >= 128; const int n = isctx ? CTXL : SEQL; const int t0 = isctx ? (tt - 128) * 32 : tt * 32;
    LAS float* z = (LAS float*)c.lds;
    LAS float* h1 = z + 32 * 36;
    LAS float* h2 = h1 + 32 * 64;
    for (int e = c.tid; e < 32 * 33; e += 512) {
        const int ti = e / 33, f = e % 33, t = t0 + ti; float v;
        if (f == 0) v = (float)t / (float)(n - 1);
        else { const int k = (f - 1) & 15; const float band = 1e-4f + (float)k * ((15.f - 1e-4f) / 15.f); const float om = 6.283185307179586f * (float)t / (float)n; v = (f <= 16) ? cosf(band * om) : -sinf(band * om); }
        z[ti * 36 + f] = v;
    }
    __syncthreads();
    for (int e = c.tid; e < 32 * 64; e += 512) {
        const int ti = e >> 6, j = e & 63; float s = KIN(I_HB1)[l * 64 + j];
        for (int f = 0; f < 33; ++f) s += z[ti * 36 + f] * KIN(I_HW1)[((size_t)l * 33 + f) * 64 + j];
        h1[e] = sinf(KIN(I_HF1)[l * 64 + j] * s);
    }
    __syncthreads();
    for (int e = c.tid; e < 32 * 64; e += 512) {
        const int ti = e >> 6, j = e & 63; float s = KIN(I_HB2)[l * 64 + j];
        for (int f = 0; f < 64; ++f) s += h1[ti * 64 + f] * KIN(I_HW2)[((size_t)l * 64 + f) * 64 + j];
        h2[e] = sinf(KIN(I_HF2)[l * 64 + j] * s);
    }
    __syncthreads();
    float* hT = wsp<float>(c, WS_HT) + (size_t)l * 1024 * NTOK;
    const float mind = -3.070113457325394f, maxd = -15.35056728662697f;
#pragma unroll
    for (int cc = 0; cc < 2; ++cc) {
        const int col = c.tid + cc * 512;
        float acc[32];
#pragma unroll
        for (int ti = 0; ti < 32; ++ti) acc[ti] = 0.f;
        for (int f = 0; f < 64; ++f) { const float w = KIN(I_HW3)[((size_t)l * 64 + f) * 1024 + col];
#pragma unroll
            for (int ti = 0; ti < 32; ++ti) acc[ti] += h2[ti * 64 + f] * w; }
        const int ch = col & 255; const float delta = fabsf(mind + (maxd - mind) * (float)ch / 255.f);
        float* dst = hT + (size_t)col * NTOK + (isctx ? SEQL : 0) + t0;
#pragma unroll
        for (int ti = 0; ti < 32; ++ti) { const float tn = (float)(t0 + ti) / (float)(n - 1); dst[ti] = acc[ti] * expf(-tn * delta); }
    }
    __syncthreads();
}

__device__ __forceinline__ void hyena_pack_job(const Ctx& c, int job) {
    const int l = job >> 9, o = (job >> 8) & 1, ch = job & 255;
    const float* hT = wsp<float>(c, WS_HT) + (size_t)l * 1024 * NTOK;
    const float* fw = hT + (size_t)(o * 512 + ch) * NTOK; const float* bw = hT + (size_t)(o * 512 + 256 + ch) * NTOK;
    LAS float* red = (LAS float*)c.lds;
    float fa[8], ba[8];
#pragma unroll
    for (int k = 0; k < 8; ++k) { fa[k] = fw[c.tid + 512 * k]; ba[k] = bw[c.tid + 512 * k]; }
    const float fc = (c.tid < CTXL) ? fw[SEQL + c.tid] : 0.f, bc = (c.tid < CTXL) ? bw[SEQL + c.tid] : 0.f;
    float s0 = 0.f, s1 = fc * fc + bc * bc;
#pragma unroll
    for (int k = 0; k < 8; ++k) s0 += fa[k] * fa[k] + ba[k] * ba[k];
    s0 = wave_sum(s0); s1 = wave_sum(s1);
    if (c.lane == 0) { red[c.wave] = s0; red[8 + c.wave] = s1; }
    __syncthreads();
    float t0 = 0.f, t1 = 0.f;
#pragma unroll
    for (int w = 0; w < 8; ++w) { t0 += red[w]; t1 += red[8 + w]; }
    const float r0 = rsqrtf(t0 + EPS), r1 = rsqrtf(t1 + EPS);
    bf16_t* gr = wsp<bf16_t>(c, WS_GR) + (((size_t)l * 2 + o) * 256 + ch) * 8192;
#pragma unroll
    for (int k = 0; k < 8; ++k) { const int d = c.tid + 512 * k; gr[4095 - d] = f2bf(fa[k] * r0); if (d >= 1) gr[4095 + d] = f2bf(ba[k] * r0); }
    if (c.tid == 0) gr[8191] = 0;
    bf16_t* grc = wsp<bf16_t>(c, WS_GRC) + (((size_t)l * 2 + o) * 256 + ch) * 512;
    if (c.tid < CTXL) { const int d = c.tid; grc[255 - d] = f2bf(fc * r1); if (d >= 1) grc[255 + d] = f2bf(bc * r1); }
    if (c.tid == 0) grc[511] = 0;
    __syncthreads();
}

__device__ __forceinline__ void norm_rows(const Ctx& c, int l  , int next  , int r0 = -1  , int r1 = 0) {
    const float* mvl = wsp<float>(c, WS_MODV) + (size_t)(l < 0 ? 0 : l) * 17 * 3072;
    const float* mvn = wsp<float>(c, WS_MODV) + (size_t)(next < 0 ? 0 : next) * 17 * 3072;
    const bf16_t* outb = wsp<bf16_t>(c, WS_OUTB);
    bf16_t* hb = wsp<bf16_t>(c, WS_HCAT);
    float* ctxr = wsp<float>(c, WS_CTXR);
    const float* xin0 = KIN(I_X); const float* cin0 = KIN(I_CTX); float* outp = KOUT();
    const float* gpost = KIN(I_GPOST) + (l < 0 ? 0 : l) * DM; const float* gpre = KIN(I_GPRE) + (next < 0 ? 0 : next) * DM;
    const int nw = c.G * 8, lane4 = c.lane * 4;
    const int rb0 = r0 >= 0 ? r0 + c.wave * 2 : (c.bid * 8 + c.wave) * 2, rbe = r0 >= 0 ? r1 : MROWS, rbs = r0 >= 0 ? 16 : nw * 2;
    for (int rowb = rb0; rowb < rbe; rowb += rbs) {
        f32x4 xv[2][4]; u32x2 ow[2][4]; const float* xin[2]; float* xout[2]; int mr[2]; bool live[2], isc[2];
#pragma unroll
        for (int rr = 0; rr < 2; ++rr) {
            const int row = rowb + rr, b = row / NTOK, j = row - b * NTOK; isc[rr] = j >= SEQL; live[rr] = !(next < 0 && isc[rr]); mr[rr] = isc[rr] ? 16 : b;
            if (isc[rr]) { xout[rr] = ctxr + ((size_t)b * CTXL + (j - SEQL)) * DM; xin[rr] = (l < 0) ? cin0 + ((size_t)b * CTXL + (j - SEQL)) * DM : xout[rr]; }
            else { xout[rr] = outp + ((size_t)b * SEQL + j) * DM; xin[rr] = (l <= 0) ? xin0 + ((size_t)b * SEQL + j) * DM : xout[rr]; }
#pragma unroll
            for (int q = 0; q < 4; ++q) { xv[rr][q] = __builtin_nontemporal_load((const f32x4*)(xin[rr] + q * 256 + lane4)); if (l >= 0) ow[rr][q] = *(const u32x2*)(outb + (size_t)row * DM + q * 256 + lane4); }
        }
#pragma unroll
        for (int rr = 0; rr < 2; ++rr) {
            if (!live[rr]) continue;
            const int row = rowb + rr;
            if (l >= 0) {
                float ov[16]; float ss = 0.f;
#pragma unroll
                for (int q = 0; q < 4; ++q) { ov[q * 4] = lo_bf(ow[rr][q].x); ov[q * 4 + 1] = hi_bf(ow[rr][q].x); ov[q * 4 + 2] = lo_bf(ow[rr][q].y); ov[q * 4 + 3] = hi_bf(ow[rr][q].y); }
#pragma unroll
                for (int i = 0; i < 16; ++i) ss += ov[i] * ov[i];
                ss = wave_sum(ss); const float rs = rsqrtf(ss * (1.f / DM) + EPS);
#pragma unroll
                for (int q = 0; q < 4; ++q) { const int col = q * 256 + lane4; const f32x4 gp = *(const f32x4*)(gpost + col); const f32x4 gt = *(const f32x4*)(mvl + mr[rr] * 3072 + 2048 + col);
#pragma unroll
                    for (int i = 0; i < 4; ++i) xv[rr][q][i] += gt[i] * (ov[q * 4 + i] * rs * gp[i]); }
            }
            if ((l >= 0 || isc[rr]) && !c.dry) {
#pragma unroll
                for (int q = 0; q < 4; ++q) __builtin_nontemporal_store(xv[rr][q], (f32x4*)(xout[rr] + q * 256 + lane4));
            }
            if (next >= 0) {
                float ss = 0.f;
#pragma unroll
                for (int q = 0; q < 4; ++q)
#pragma unroll
                    for (int i = 0; i < 4; ++i) ss += xv[rr][q][i] * xv[rr][q][i];
                ss = wave_sum(ss); const float rs = rsqrtf(ss * (1.f / DM) + EPS);
#pragma unroll
                for (int q = 0; q < 4; ++q) { const int col = q * 256 + lane4; const f32x4 gp = *(const f32x4*)(gpre + col);
                    const f32x4 sh = *(const f32x4*)(mvn + mr[rr] * 3072 + col), sc = *(const f32x4*)(mvn + mr[rr] * 3072 + 1024 + col);
                    float hv[4];
#pragma unroll
                    for (int i = 0; i < 4; ++i) hv[i] = xv[rr][q][i] * rs * gp[i] * (1.f + sc[i]) + sh[i];
                    u32x2 w; w.x = cvt_pk_bf16(hv[0], hv[1]); w.y = cvt_pk_bf16(hv[2], hv[3]); *(u32x2*)(hb + (size_t)row * DM + col) = w; }
            }
        }
    }
}

__device__ __forceinline__ void p2_rows(const Ctx& c, int l) {
    bf16_t* pb = wsp<bf16_t>(c, WS_PB);
    bf16_t* B0 = pb; bf16_t* B1 = pb + BLKE; bf16_t* B3 = pb + 3 * BLKE; const bf16_t* B4 = pb + 4 * BLKE;
    bf16_t* kr = wsp<bf16_t>(c, WS_KR); bf16_t* kg = wsp<bf16_t>(c, WS_KG); bf16_t* ug = wsp<bf16_t>(c, WS_UG); bf16_t* us = wsp<bf16_t>(c, WS_US);
    const float* ropeG = wsp<float>(c, WS_ROPEG); const float* ropeM = wsp<float>(c, WS_ROPEM);
    const int lane = c.lane;
    const f32x4 gcq = (lane < 48) ? *(const f32x4*)(KIN(I_GCQ) + l * 192 + lane * 4) : (f32x4){0.f, 0.f, 0.f, 0.f};
    const f32x4 gckv = (lane < 32) ? *(const f32x4*)(KIN(I_GCKV) + l * 128 + lane * 4) : (f32x4){0.f, 0.f, 0.f, 0.f};
    const f32x4 gq = *(const f32x4*)(KIN(I_GQ) + l * 64 + (lane & 15) * 4), gk = *(const f32x4*)(KIN(I_GK) + l * 64 + (lane & 15) * 4);
    for (int rowb = (c.bid * 8 + c.wave) * 4; rowb < MROWS; rowb += c.G * 8 * 4) {
        u32x2 w0[4], w1[4], w3[4], w4[4];
#pragma unroll
        for (int rr = 0; rr < 4; ++rr) { const size_t ro = (size_t)(rowb + rr) * 256 + lane * 4;
            w0[rr] = *(const u32x2*)(B0 + ro); w1[rr] = *(const u32x2*)(B1 + ro); w3[rr] = *(const u32x2*)(B3 + ro); w4[rr] = *(const u32x2*)(B4 + ro); }
#pragma unroll
        for (int rr = 0; rr < 4; ++rr) {
            const int row = rowb + rr;
            const int b = row / NTOK, j = row - b * NTOK; const bool islat = j < SEQL; const int rowpos = (j >> 6) & 63, colpos = j & 63;
            const size_t ro = (size_t)row * 256 + lane * 4;
            {
                const u32x2 w = w0[rr]; float x[4] = {lo_bf(w.x), hi_bf(w.x), lo_bf(w.y), hi_bf(w.y)};
                float ss = (lane < 48) ? (x[0] * x[0] + x[1] * x[1] + x[2] * x[2] + x[3] * x[3]) : 0.f; ss = wave_sum(ss);
                const float rs = rsqrtf(ss * (1.f / 192.f) + EPS);
                float xp[4];
#pragma unroll
                for (int i = 0; i < 4; ++i) xp[i] = swz_xor<2>(x[i]);
                u32x2 o; o.x = 0u; o.y = 0u;
                if (lane < 48) { o.x = cvt_pk_bf16(x[0] * rs * gcq[0], x[1] * rs * gcq[1]); o.y = cvt_pk_bf16(x[2] * rs * gcq[2], x[3] * rs * gcq[3]); }
                else if (lane < 56) {
                    const int t = lane - 48; float y[4];
                    if (islat) { const int pos = (t & 4) ? colpos : rowpos; const bool isx2 = (t & 2) != 0;
#pragma unroll
                        for (int i = 0; i < 4; ++i) { const int f = 4 * (t & 1) + i; const float cs = ropeM[(pos * 8 + f) * 2], sn = ropeM[(pos * 8 + f) * 2 + 1]; y[i] = isx2 ? (xp[i] * sn + x[i] * cs) : (x[i] * cs - xp[i] * sn); } }
                    else {
#pragma unroll
                        for (int i = 0; i < 4; ++i) y[i] = x[i]; }
                    u32x2 kk; kk.x = cvt_pk_bf16(y[0], y[1]); kk.y = cvt_pk_bf16(y[2], y[3]); *(u32x2*)(kr + (size_t)row * 32 + t * 4) = kk;
                }
                if (!c.dry) *(u32x2*)(B0 + ro) = o;
            }
            {
                const u32x2 w = w1[rr]; float x[4] = {lo_bf(w.x), hi_bf(w.x), lo_bf(w.y), hi_bf(w.y)};
                float ss = (lane < 32) ? (x[0] * x[0] + x[1] * x[1] + x[2] * x[2] + x[3] * x[3]) : 0.f; ss = wave_sum(ss);
                const float rs = rsqrtf(ss * (1.f / 128.f) + EPS);
                u32x2 o; o.x = 0u; o.y = 0u;
                if (lane < 32) { o.x = cvt_pk_bf16(x[0] * rs * gckv[0], x[1] * rs * gckv[1]); o.y = cvt_pk_bf16(x[2] * rs * gckv[2], x[3] * rs * gckv[3]); }
                if (!c.dry) *(u32x2*)(B1 + ro) = o;
            }
#pragma unroll
            for (int which = 0; which < 2; ++which) {
                const u32x2 w = which == 0 ? w3[rr] : w4[rr]; float x[4] = {lo_bf(w.x), hi_bf(w.x), lo_bf(w.y), hi_bf(w.y)};
                float ss = x[0] * x[0] + x[1] * x[1] + x[2] * x[2] + x[3] * x[3];
                ss += swz_xor<1>(ss); ss += swz_xor<2>(ss); ss += swz_xor<4>(ss); ss += swz_xor<8>(ss);
                const float rs = rsqrtf(ss * (1.f / 64.f) + EPS);
                const int t = lane & 15; const f32x4 g = which == 0 ? gq : gk;
#pragma unroll
                for (int i = 0; i < 4; ++i) x[i] = x[i] * rs * g[i];
                float xp[4];
#pragma unroll
                for (int i = 0; i < 4; ++i) xp[i] = swz_xor<4>(x[i]);
                if (islat) { const int pos = (t & 8) ? colpos : rowpos; const bool isx2 = (t & 4) != 0;
#pragma unroll
                    for (int i = 0; i < 4; ++i) { const int f = 4 * (t & 3) + i; const float cs = ropeG[(pos * 16 + f) * 2], sn = ropeG[(pos * 16 + f) * 2 + 1]; x[i] = isx2 ? (xp[i] * sn + x[i] * cs) : (x[i] * cs - xp[i] * sn); } }
                if (which == 0) { const float qs = 0.125f * LOG2E; u32x2 o; o.x = cvt_pk_bf16(x[0] * qs, x[1] * qs); o.y = cvt_pk_bf16(x[2] * qs, x[3] * qs); if (!c.dry) *(u32x2*)(B3 + ro) = o; }
                else if (lane < 32) { u32x2 o; o.x = cvt_pk_bf16(x[0], x[1]); o.y = cvt_pk_bf16(x[2], x[3]); *(u32x2*)(kg + ((size_t)(b * 2 + (lane >> 4)) * NTOK + j) * 64 + t * 4) = o; }
            }
        }
    }
}
#ifndef PROBE_ABL
#define PROBE_ABL 0
#endif
#ifndef PROBE_GQAONLY
#define PROBE_GQAONLY 0
#endif
template <int DK, bool SUB, bool NOMAX = false, int ABL = 0>
__device__ __forceinline__ bool attn_unit(float (&rowmax)[2], const Ctx& c, const bf16_t* Qp, int qpitch, const bf16_t* Kp, const bf16_t* Vtp, int kt0, int nkt, int nrows,
                                          const bf16_t* gatep, bf16_t* outp, bool rope, int j0, float qscale, const float* ropeM) {
    constexpr int KS = DK / 16, KPC = DK / 8, KPITCH = DK * 2 + 16, KB = 64 * KPITCH, VPITCH = 136, VB = 64 * VPITCH;
    constexpr int KOFF = 0, VOFF = 3 * KB;
    constexpr float LIM = 60.f;
    static_assert(KB % 16 == 0 && VB % 16 == 0, "attention LDS buffer alignment");
    const int tid = c.tid, lane = c.lane, wave = c.wave;
    const int lq_ = opaque(lane), q = lq_ & 31, h = lq_ >> 5;
    LAS unsigned char* lds = c.lds;
    const int rbase = (wave * 64 < nrows) ? wave * 64 : wave * 64 - 256;
    const bool live = wave * 64 < nrows;
    bf16x8 qf[2][KS];
#pragma unroll
    for (int qt = 0; qt < 2; ++qt) {
        const bf16_t* qrow = Qp + (size_t)(rbase + qt * 32 + q) * qpitch + 8 * h;
#pragma unroll
        for (int ks = 0; ks < KS; ++ks) qf[qt][ks] = *(const bf16x8*)(qrow + 16 * ks);
        if (DK == 96) {
            const int jj = j0 + rbase + qt * 32 + q;
#pragma unroll
            for (int ks = 0; ks < KS; ++ks) {
                float x[8]; unpack8(__builtin_bit_cast(u32x4, qf[qt][ks]), x);
                if (ks >= 4) {
                    const int pos = (ks == 4) ? ((jj >> 6) & 63) : (jj & 63);
#pragma unroll
                    for (int e = 0; e < 8; ++e) { const float xp = half_other(x[e], h); const float cs = ropeM[(pos * 8 + e) * 2], sn = ropeM[(pos * 8 + e) * 2 + 1];
                        const float r = h ? (xp * sn + x[e] * cs) : (x[e] * cs - xp * sn); x[e] = rope ? r : x[e]; }
                }
                u32x4 w; w.x = cvt_pk_bf16(x[0] * qscale, x[1] * qscale); w.y = cvt_pk_bf16(x[2] * qscale, x[3] * qscale); w.z = cvt_pk_bf16(x[4] * qscale, x[5] * qscale); w.w = cvt_pk_bf16(x[6] * qscale, x[7] * qscale);
                qf[qt][ks] = __builtin_bit_cast(bf16x8, w);
            }
        }
    }
    f32x16 o00, o01, o10, o11;
#pragma unroll
    for (int i = 0; i < 16; ++i) { o00[i] = 0.f; o01[i] = 0.f; o10[i] = 0.f; o11[i] = 0.f; }
    const float m0 = SUB ? rowmax[0] : 0.f, m1 = SUB ? rowmax[1] : 0.f; float l0 = 0.f, l1 = 0.f;
    float rmax0 = -1e30f, rmax1 = -1e30f;
    const int tq_ = opaque(tid);
    const int kst0 = (tq_ / KPC) * KPITCH + (tq_ % KPC) * 16, kst1 = ((tq_ + 512) / KPC) * KPITCH + ((tq_ + 512) % KPC) * 16;
    const int kgl0 = ((tq_ / KPC) * DK + (tq_ % KPC) * 8) * 2, kgl1 = (((tq_ + 512) / KPC) * DK + ((tq_ + 512) % KPC) * 8) * 2;
    const int vst = (tq_ >> 3) * VPITCH + (tq_ & 7) * 16, vgl = ((tq_ >> 3) * NTOK + (tq_ & 7) * 8) * 2;
    const bool has2 = (DK == 96) && tq_ < 256;
    const int kfo = q * KPITCH + 16 * h, vfo = q * VPITCH + 8 * h;
    const char* Kc = (const char*)Kp; const char* Vc = (const char*)Vtp;
    u32x4 kreg0, kreg1 = {0u, 0u, 0u, 0u}, vreg;
#define AT_GLOADK(kt) do { if (ABL & 1) break; const char* kb_ = Kc + (size_t)(kt) * (64 * DK * 2); kreg0 = *(const u32x4*)(kb_ + kgl0); if (has2) kreg1 = *(const u32x4*)(kb_ + kgl1); } while (0)
#define AT_GLOADV(kt) do { if (ABL & 1) break; vreg = *(const u32x4*)(Vc + (size_t)(kt) * 128 + vgl); } while (0)
#define AT_WRITEK(bi) do { if (ABL & 1) break; LAS unsigned char* bb = lds + KOFF + (bi) * KB; *(LAS u32x4*)(bb + kst0) = kreg0; if (has2) *(LAS u32x4*)(bb + kst1) = kreg1; } while (0)
#define AT_WRITEV(bi) do { if (ABL & 1) break; LAS u32x2* vd = (LAS u32x2*)(lds + VOFF + (bi) * VB + vst); vd[0] = (u32x2){vreg.x, vreg.y}; vd[1] = (u32x2){vreg.z, vreg.w}; } while (0)
#define AT_QK(S0, S1, bi, jh) do { const LAS unsigned char* kb = lds + KOFF + (bi) * KB + (jh) * 32 * KPITCH + kfo; \
        _Pragma("unroll") for (int i = 0; i < 16; ++i) { S0[i] = 0.f; S1[i] = 0.f; } \
        if (!(ABL & 8)) _Pragma("unroll") for (int ks = 0; ks < KS; ++ks) { \
            const bf16x8 a0 = *(const LAS bf16x8*)(kb + 32 * ks); \
            S0 = __builtin_amdgcn_mfma_f32_32x32x16_bf16(a0, qf[0][ks], S0, 0, 0, 0); \
            S1 = __builtin_amdgcn_mfma_f32_32x32x16_bf16(a0, qf[1][ks], S1, 0, 0, 0); } } while (0)
#define AT_MAX(S, RM) do { if (!SUB && !NOMAX) { _Pragma("unroll") for (int i = 0; i < 16; i += 2) RM = max3_raw(RM, S[i], S[i + 1]); } } while (0)
#define AT_EXP(S, M, L, PK0, PK1) do { float ps = 0.f; \
        _Pragma("unroll") for (int i = 0; i < 16; ++i) { S[i] = (ABL & 2) ? S[i] * 0.001f : __builtin_amdgcn_exp2f(SUB ? S[i] - M : S[i]); ps += S[i]; } \
        L += ps; u32x4 w; \
        w.x = cvt_pk_bf16(S[0], S[1]); w.y = cvt_pk_bf16(S[2], S[3]); w.z = cvt_pk_bf16(S[4], S[5]); w.w = cvt_pk_bf16(S[6], S[7]); PK0 = __builtin_bit_cast(bf16x8, w); \
        w.x = cvt_pk_bf16(S[8], S[9]); w.y = cvt_pk_bf16(S[10], S[11]); w.z = cvt_pk_bf16(S[12], S[13]); w.w = cvt_pk_bf16(S[14], S[15]); PK1 = __builtin_bit_cast(bf16x8, w); } while (0)
#define AT_VLOAD() do { la0 = *(const LAS u32x2*)(vb); ha0 = *(const LAS u32x2*)(vb + 16); lb0 = *(const LAS u32x2*)(vb + 32 * VPITCH); hb0 = *(const LAS u32x2*)(vb + 32 * VPITCH + 16); \
        la1 = *(const LAS u32x2*)(vb + 32); ha1 = *(const LAS u32x2*)(vb + 48); lb1 = *(const LAS u32x2*)(vb + 32 * VPITCH + 32); hb1 = *(const LAS u32x2*)(vb + 32 * VPITCH + 48); } while (0)
#define AT_SUB(SC0, SC1, SN0, SN1, vbi, jh, nbi, njh) do { \
          \
        const LAS unsigned char* vb = lds + VOFF + (vbi) * VB + (jh) * 64 + vfo; \
        u32x2 la0, ha0, lb0, hb0, la1, ha1, lb1, hb1; \
        if (DK == 64) { AT_VLOAD(); }        \
        AT_MAX(SC0, rmax0); AT_MAX(SC1, rmax1); \
        AT_QK(SN0, SN1, nbi, njh); \
        bf16x8 p00, p01, p10, p11; \
        AT_EXP(SC0, m0, l0, p00, p01); AT_EXP(SC1, m1, l1, p10, p11); \
        if (DK != 64) { AT_VLOAD(); } \
        if (!(ABL & 4)) { \
            const bf16x8 va00 = __builtin_bit_cast(bf16x8, (u32x4){la0.x, la0.y, ha0.x, ha0.y}), va10 = __builtin_bit_cast(bf16x8, (u32x4){lb0.x, lb0.y, hb0.x, hb0.y}); \
            const bf16x8 va01 = __builtin_bit_cast(bf16x8, (u32x4){la1.x, la1.y, ha1.x, ha1.y}), va11 = __builtin_bit_cast(bf16x8, (u32x4){lb1.x, lb1.y, hb1.x, hb1.y}); \
            o00 = __builtin_amdgcn_mfma_f32_32x32x16_bf16(va00, p00, o00, 0, 0, 0); \
            o01 = __builtin_amdgcn_mfma_f32_32x32x16_bf16(va10, p00, o01, 0, 0, 0); \
            o10 = __builtin_amdgcn_mfma_f32_32x32x16_bf16(va00, p10, o10, 0, 0, 0); \
            o11 = __builtin_amdgcn_mfma_f32_32x32x16_bf16(va10, p10, o11, 0, 0, 0); \
            o00 = __builtin_amdgcn_mfma_f32_32x32x16_bf16(va01, p01, o00, 0, 0, 0); \
            o01 = __builtin_amdgcn_mfma_f32_32x32x16_bf16(va11, p01, o01, 0, 0, 0); \
            o10 = __builtin_amdgcn_mfma_f32_32x32x16_bf16(va01, p11, o10, 0, 0, 0); \
            o11 = __builtin_amdgcn_mfma_f32_32x32x16_bf16(va11, p11, o11, 0, 0, 0); } \
        if (ABL & 4) { asm volatile("" :: "v"(p00), "v"(p01), "v"(p10), "v"(p11), "v"(la0), "v"(ha0), "v"(lb0), "v"(hb0), "v"(la1), "v"(ha1), "v"(lb1), "v"(hb1)); } \
        } while (0)
    if (!SUB && !NOMAX && tid == 0) *(volatile LAS unsigned*)(lds + LDS_MISC_OFF + 24) = 0u;
    AT_GLOADK(kt0); AT_GLOADV(kt0); AT_WRITEK(0); AT_WRITEV(0);
    AT_GLOADK(kt0 + 1); AT_WRITEK(1);
    __syncthreads();
    f32x16 sa0, sa1, sb0, sb1;
    AT_QK(sa0, sa1, 0, 0);
    int kb0 = 0, kb1 = 1, kb2 = 2;
    for (int t = 0; t < nkt; ++t) {
        const int tk = (t + 2 < nkt) ? t + 2 : nkt - 1, tv = (t + 1 < nkt) ? t + 1 : nkt - 1;
        AT_GLOADK(kt0 + tk);
        AT_SUB(sa0, sa1, sb0, sb1, t & 1, 0, kb0, 1);
        AT_WRITEK(kb2);
        AT_GLOADV(kt0 + tv);
        AT_SUB(sb0, sb1, sa0, sa1, t & 1, 1, kb1, 0);
        AT_WRITEV((t + 1) & 1);
        if (!(ABL & 16)) __syncthreads();
        const int tmp = kb0; kb0 = kb1; kb1 = kb2; kb2 = tmp;
    }
#undef AT_GLOADK
#undef AT_GLOADV
#undef AT_WRITEK
#undef AT_WRITEV
#undef AT_QK
#undef AT_MAX
#undef AT_EXP
#undef AT_SUB
#undef AT_VLOAD
    bool bad = false;
    if (!SUB && !NOMAX) { const float r0 = half_max(rmax0), r1 = half_max(rmax1); rowmax[0] = r0; rowmax[1] = r1; const bool b_ = live && !(r0 < LIM && r0 > -LIM && r1 < LIM && r1 > -LIM); volatile LAS unsigned* flg = (volatile LAS unsigned*)(lds + LDS_MISC_OFF + 24); if (__any(b_ ? 1 : 0) && opaque(lane) == 0) *flg = 1u; __syncthreads(); bad = *flg != 0u; __syncthreads(); }
    if (live && !bad) {
        const int le_ = opaque(lane), q = le_ & 31, h = le_ >> 5;
#pragma unroll
        for (int qt = 0; qt < 2; ++qt) {
            const float lr = qt ? l1 : l0; const float lt = half_sum(lr), inv = 1.f / lt;
            const size_t row = (size_t)(rbase + qt * 32 + q);
#pragma unroll
            for (int dt = 0; dt < 2; ++dt)
#pragma unroll
                for (int g4 = 0; g4 < 4; ++g4) {
                    const int dv0 = dt * 32 + 8 * g4 + 4 * h;
                    const u32x2 gw = *(const u32x2*)(gatep + row * 256 + dv0);
                    const float g0 = siluf(lo_bf(gw.x)), g1 = siluf(hi_bf(gw.x)), g2 = siluf(lo_bf(gw.y)), g3 = siluf(hi_bf(gw.y));
                    const f32x16& o = qt ? (dt ? o11 : o10) : (dt ? o01 : o00);
                    u32x2 w; w.x = cvt_pk_bf16(o[4 * g4] * inv * g0, o[4 * g4 + 1] * inv * g1); w.y = cvt_pk_bf16(o[4 * g4 + 2] * inv * g2, o[4 * g4 + 3] * inv * g3);
                    *(u32x2*)(outp + row * DM + dv0) = w;
                }
        }
    }
    return bad;
}

template <int N>
__device__ __forceinline__ void hyena_conv(const Ctx& c, LAS unsigned char* ub, LAS unsigned char* gb, int pass, const bf16_t* xmul  , float bias,
                                           bf16_t* zdst  , const bf16_t* gmul, bf16_t* cat  , float cw0, float cw1, float cw2, float cb  ) {
    constexpr int UP = (N + 256) * 2 + 16, NPAIR = N / 256, OFF8 = N - 8;
    const int lane = c.lane, i16 = lane & 15, kq = lane >> 4;
    for (int pr = c.wave; pr < NPAIR; pr += 8) {
        const int t0 = pr * 256;
        u32x4 xq[2][4], gq[2][4]; bf16_t xl[2][4], xr[2][4];
#pragma unroll
        for (int half = 0; half < 2; ++half)
#pragma unroll
            for (int r = 0; r < 4; ++r) { const int t8 = t0 + half * 128 + 32 * kq + 8 * r; const bf16_t* xp_ = xmul + (size_t)i16 * NTOK + t8; xq[half][r] = *(const u32x4*)xp_;
                xl[half][r] = (t8 > 0) ? xp_[-1] : (bf16_t)0; xr[half][r] = (t8 + 8 < N) ? xp_[8] : (bf16_t)0;
                gq[half][r] = (pass == 1) ? *(const u32x4*)(gmul + (size_t)i16 * NTOK + t8) : (u32x4){0u, 0u, 0u, 0u}; }
        f32x4 acc[2][8];
#pragma unroll
        for (int m = 0; m < 8; ++m) { acc[0][m] = (f32x4){0.f, 0.f, 0.f, 0.f}; acc[1][m] = (f32x4){0.f, 0.f, 0.f, 0.f}; }
        const LAS unsigned char* up = ub + i16 * UP + 256 + kq * 16;
        const LAS unsigned char* gp = gb + (OFF8 - t0 - 8 * i16 + 8 * kq) * 2;
        bf16x8 bfa = *(const LAS bf16x8*)(up - 256), bfb = *(const LAS bf16x8*)(up);
        u32x4 wa = *(const LAS u32x4*)(gp - 256), wb = *(const LAS u32x4*)(gp - 256 + 16);
        for (int s0 = -128; s0 < N; s0 += 32) {
            const int sn = (s0 + 32 < N) ? s0 + 32 : s0;
            const bf16x8 bfan = *(const LAS bf16x8*)(up + sn * 2), bfbn = *(const LAS bf16x8*)(up + sn * 2 + 256);
            const u32x4 wan = *(const LAS u32x4*)(gp + sn * 2), wbn = *(const LAS u32x4*)(gp + sn * 2 + 16);
            const unsigned w[8] = {wa.x, wa.y, wa.z, wa.w, wb.x, wb.y, wb.z, wb.w};
            unsigned sh[7];
#pragma unroll
            for (int k = 0; k < 7; ++k) sh[k] = __builtin_amdgcn_alignbit(w[k + 1], w[k], 16);
#pragma unroll
            for (int m = 0; m < 8; ++m) {
                u32x4 a;
                if (m & 1) { const int d0 = (7 - m) >> 1; a = (u32x4){w[d0], w[d0 + 1], w[d0 + 2], w[d0 + 3]}; }
                else { const int d0 = (6 - m) >> 1; a = (u32x4){sh[d0], sh[d0 + 1], sh[d0 + 2], sh[d0 + 3]}; }
                acc[0][m] = __builtin_amdgcn_mfma_f32_16x16x32_bf16(__builtin_bit_cast(bf16x8, a), bfa, acc[0][m], 0, 0, 0);
                acc[1][m] = __builtin_amdgcn_mfma_f32_16x16x32_bf16(__builtin_bit_cast(bf16x8, a), bfb, acc[1][m], 0, 0, 0);
            }
            bfa = bfan; bfb = bfbn; wa = wan; wb = wbn;
        }
#pragma unroll
        for (int half = 0; half < 2; ++half)
#pragma unroll
            for (int r = 0; r < 4; ++r) {
                const int t8 = t0 + half * 128 + 32 * kq + 8 * r;
                float uu[8], xr8[8], xm[8]; unpack8(*(const LAS u32x4*)(ub + i16 * UP + 256 + t8 * 2), uu); unpack8(xq[half][r], xr8);
                {   float pv = bf2f(xl[half][r]);
#pragma unroll
                    for (int m = 0; m < 8; ++m) { const float nx = (m < 7) ? xr8[m + 1] : bf2f(xr[half][r]); xm[m] = bf2f(f2bf(cw0 * pv + cw1 * xr8[m] + cw2 * nx + cb)); pv = xr8[m]; } }
                float y[8];
#pragma unroll
                for (int m = 0; m < 8; ++m) y[m] = xm[m] * (acc[half][m][r] + bias * uu[m]);
                if (pass == 0) { u32x4 o; o.x = cvt_pk_bf16(y[0], y[1]); o.y = cvt_pk_bf16(y[2], y[3]); o.z = cvt_pk_bf16(y[4], y[5]); o.w = cvt_pk_bf16(y[6], y[7]); *(u32x4*)(zdst + (size_t)i16 * NTOK + t8) = o; }
                else { float gg[8]; unpack8(gq[half][r], gg);
#pragma unroll
                    for (int m = 0; m < 8; ++m) gg[m] = bf2f(f2bf(siluf(gg[m])));
                    u32x4 o; o.x = cvt_pk_bf16(y[0] * gg[0], y[1] * gg[1]); o.y = cvt_pk_bf16(y[2] * gg[2], y[3] * gg[3]); o.z = cvt_pk_bf16(y[4] * gg[4], y[5] * gg[5]); o.w = cvt_pk_bf16(y[6] * gg[6], y[7] * gg[7]);
                    *(u32x4*)(cat + (size_t)i16 * NTOK + t8) = o; }
            }
    }
}
template <int N>
__device__ __forceinline__ void hyena_seq(const Ctx& c, int l, int ch, int toff) {
    constexpr int UP = (N + 256) * 2 + 16;
    LAS unsigned char* ub = c.lds; LAS unsigned char* gb = c.lds + 16 * UP;
    const bf16_t* vv = wsp<bf16_t>(c, WS_HYV) + (size_t)ch * 16 * NTOK + toff;
    bf16_t* vz = wsp<bf16_t>(c, WS_HYZ) + (size_t)ch * 16 * NTOK + toff;
    const bf16_t* x1 = wsp<bf16_t>(c, WS_HYX1) + (size_t)ch * 16 * NTOK + toff;
    const bf16_t* x2 = wsp<bf16_t>(c, WS_HYX2) + (size_t)ch * 16 * NTOK + toff;
    const bf16_t* gm = wsp<bf16_t>(c, WS_HYG) + (size_t)ch * 16 * NTOK + toff;
    bf16_t* cat = wsp<bf16_t>(c, WS_HYY) + (size_t)ch * 16 * NTOK + toff;
    { const int e = c.tid, b = e >> 5, side = (e >> 4) & 1, pc = e & 15; unsigned z = 0u; asm volatile("" : "+v"(z)); *(LAS u32x4*)(ub + b * UP + side * (256 + N * 2) + pc * 16) = (u32x4){z, z, z, z}; }
    for (int pass = 0; pass < 2; ++pass) {
        const bf16_t* gr = (N == SEQL) ? wsp<bf16_t>(c, WS_GR) + (((size_t)l * 2 + pass) * 256 + ch) * 8192 : wsp<bf16_t>(c, WS_GRC) + (((size_t)l * 2 + pass) * 256 + ch) * 512;
        const bf16_t* usrc = pass == 0 ? vv : vz;
        constexpr int NG = (2 * N / 8 + 511) / 512;
        {
            u32x4 t[NG];
#pragma unroll
            for (int k = 0; k < NG; ++k) { const int e = c.tid + k * 512; t[k] = (e < 2 * N / 8) ? *(const u32x4*)(gr + e * 8) : (u32x4){0u, 0u, 0u, 0u}; }
#pragma unroll
            for (int k = 0; k < NG; ++k) { const int e = c.tid + k * 512; if (e < 2 * N / 8) *(LAS u32x4*)(gb + e * 16) = t[k]; }
        }
        if constexpr (N == SEQL) {
#pragma unroll
            for (int k0 = 0; k0 < 16; k0 += 8) {
                u32x4 t[8];
#pragma unroll
                for (int k = 0; k < 8; ++k) t[k] = *(const u32x4*)(usrc + (size_t)(k0 + k) * NTOK + c.tid * 8);
#pragma unroll
                for (int k = 0; k < 8; ++k) *(LAS u32x4*)(ub + (k0 + k) * UP + 256 + c.tid * 16) = t[k];
            }
        } else {
            const int b = c.tid >> 5, pc = c.tid & 31;
            *(LAS u32x4*)(ub + b * UP + 256 + pc * 16) = *(const u32x4*)(usrc + (size_t)b * NTOK + pc * 8);
        }
        __syncthreads();
        const float* hcw = KIN(I_HCW) + (size_t)l * 3 * 768; const float* hcb = KIN(I_HCB) + l * 768;
        if (pass == 0) {
            const float w0 = hcw[ch], w1 = hcw[768 + ch], w2 = hcw[1536 + ch], bs = hcb[ch];
            constexpr int PPT = (N == SEQL) ? 16 : 1;
            u32x4 o[PPT];
#pragma unroll
            for (int k = 0; k < PPT; ++k) { const int b = (N == SEQL) ? k : (c.tid >> 5), pc = (N == SEQL) ? c.tid : (c.tid & 31); const LAS unsigned char* p = ub + b * UP + 256 + pc * 16;
                float x[8]; unpack8(*(const LAS u32x4*)p, x); float pv = bf2f(*(const LAS bf16_t*)(p - 2)); const float nx8 = bf2f(*(const LAS bf16_t*)(p + 16)); float y[8];
#pragma unroll
                for (int m = 0; m < 8; ++m) { const float nx = (m < 7) ? x[m + 1] : nx8; y[m] = w0 * pv + w1 * x[m] + w2 * nx + bs; pv = x[m]; }
                o[k].x = cvt_pk_bf16(y[0], y[1]); o[k].y = cvt_pk_bf16(y[2], y[3]); o[k].z = cvt_pk_bf16(y[4], y[5]); o[k].w = cvt_pk_bf16(y[6], y[7]); }
            __syncthreads();
#pragma unroll
            for (int k = 0; k < PPT; ++k) { const int b = (N == SEQL) ? k : (c.tid >> 5), pc = (N == SEQL) ? c.tid : (c.tid & 31); *(LAS u32x4*)(ub + b * UP + 256 + pc * 16) = o[k]; }
            __syncthreads();
        }
        const float bias = KIN(I_HBIAS)[((size_t)l * 2 + pass) * 256 + ch];
        const int cc = (pass + 1) * 256 + ch;
        hyena_conv<N>(c, ub, gb, pass, pass == 0 ? x1 : x2, bias, vz, gm, cat, hcw[cc], hcw[768 + cc], hcw[1536 + cc], hcb[cc]);
        asm volatile("s_waitcnt vmcnt(0)" ::: "memory");
        __syncthreads();
    }
}

__device__ __forceinline__ void hyena_untranspose(const Ctx& c, int tl0, int tl1) {
    const bf16_t* yT = wsp<bf16_t>(c, WS_HYY); bf16_t* cat = wsp<bf16_t>(c, WS_HCAT);
    LAS bf16_t* T = (LAS bf16_t*)c.lds;
    LAS unsigned* T32 = (LAS unsigned*)c.lds;
    for (int tl = tl0; tl < tl1; ++tl) {
        const int b = tl / 68, j0 = (tl - b * 68) * 64;
        u32x4 pre[4];
#pragma unroll
        for (int k = 0; k < 4; ++k) { const int e = c.tid + k * 512, ch = e >> 3, pc = e & 7; pre[k] = *(const u32x4*)(yT + ((size_t)ch * 16 + b) * NTOK + j0 + pc * 8); }
#pragma unroll
        for (int k = 0; k < 4; ++k) { const int e = c.tid + k * 512, ch = e >> 3, pc = e & 7; LAS unsigned* d = T32 + (ch * 132 + pc * 16) / 4; d[0] = pre[k].x; d[1] = pre[k].y; d[2] = pre[k].z; d[3] = pre[k].w; }
        __syncthreads();
#pragma unroll
        for (int k = 0; k < 4; ++k) { const int e = c.tid + k * 512, t = e >> 5, c0 = (e & 31) * 8; float v[8];
#pragma unroll
            for (int i = 0; i < 8; ++i) v[i] = bf2f(T[(c0 + i) * 66 + t]);
            u32x4 w; w.x = cvt_pk_bf16(v[0], v[1]); w.y = cvt_pk_bf16(v[2], v[3]); w.z = cvt_pk_bf16(v[4], v[5]); w.w = cvt_pk_bf16(v[6], v[7]);
            *(u32x4*)(cat + ((size_t)b * NTOK + j0 + t) * DM + 768 + c0) = w; }
        __syncthreads();
    }
}

__device__ __forceinline__ void ssm_scan_item(const Ctx& c, int l, int item) {
    const int b = item >> 2, g = (item & 3) * 4 + (c.tid >> 7), dq = (c.tid >> 6) & 1, p = c.tid & 63;
    const float* a16 = wsp<float>(c, WS_A16) + ((((size_t)l * 2 + dq) * 16 + g) * 64 + p) * 2;
    const float ar = a16[0], ai = a16[1];
    const bf16_t* E = wsp<bf16_t>(c, WS_E); bf16_t* US = wsp<bf16_t>(c, WS_US);
    float sr = 0.f, si = 0.f;
    for (int st0 = 0; st0 < NCHB; st0 += 8) {
        float er[8], ei[8]; size_t ro[8];
#pragma unroll
        for (int k = 0; k < 8; ++k) { const int st = st0 + k; const int cc = dq == 0 ? (st < 16 ? 256 + st : st - 16) : (st < 16 ? 271 - st : 255 - (st - 16));
            ro[k] = (size_t)g * NCHUNK + (size_t)b * NCHB + cc; er[k] = bf2f(E[ro[k] * 256 + dq * 128 + p]); ei[k] = bf2f(E[ro[k] * 256 + dq * 128 + 64 + p]); }
#pragma unroll
        for (int k = 0; k < 8; ++k) {
            US[ro[k] * 512 + 256 + dq * 128 + p] = f2bf(sr); US[ro[k] * 512 + 256 + dq * 128 + 64 + p] = f2bf(si);
            const float nr = ar * sr - ai * si + er[k], ni = ar * si + ai * sr + ei[k]; sr = nr; si = ni;
        }
    }
}

constexpr int LDS_BYTES = 163840;
constexpr int LDS_MISC = LDS_MISC_OFF;
static_assert(LDS_MISC_OFF == LDS_BYTES - 256, "LDS map");
constexpr int NPRO = 1, NPH = 6, NPHASES = NPRO + DEPTH * NPH;
constexpr int QI_HY = 256, QI_SCAN = 64, QI_ATTL = NB * 8 * 8, QI_SSM2 = 16 * 17, QI_UNT = 272, QI_ATTC = NB * 8, QI_GLU = MROWS / 256;
constexpr int QO_SCAN = QI_HY, QO_ATTL = QO_SCAN + QI_SCAN, QO_SSM2 = QO_ATTL + QI_ATTL, QO_UNT = QO_SSM2 + QI_SSM2, QO_ATTC = QO_UNT + QI_UNT, QO_GLU = QO_ATTC + QI_ATTC, QI_TOTAL = QO_GLU + QI_GLU;
#ifndef PROBE_DUP_MASK
#define PROBE_DUP_MASK 0
#endif
#ifndef PROBE_P4KINDS
#define PROBE_P4KINDS 0x7f
#endif
__device__ __forceinline__ void dep_signal(const Ctx& c, unsigned* cnt) {
    asm volatile("s_waitcnt vmcnt(0)" ::: "memory");
    __syncthreads();
    if (c.tid == 0) { __builtin_amdgcn_fence(__ATOMIC_RELEASE, "agent"); asm volatile("s_waitcnt vmcnt(0)" ::: "memory"); (void)xb_add(cnt, 1u); }
}
__device__ __forceinline__ void dep_wait(const Ctx& c, unsigned* cnt, unsigned need, unsigned* tmo) {
    if (c.dry) return;
    if (c.tid == 0) {
        unsigned sp = 0;
        while (xb_ld(cnt) < need) { __builtin_amdgcn_s_sleep(2); if ((++sp & 255u) == 0u) { if (xb_ld(tmo)) break; if (sp > XB_SPIN_CAP) { atomicAdd(tmo, 1u); break; } } }
        __builtin_amdgcn_fence(__ATOMIC_ACQUIRE, "agent");
        asm volatile("s_waitcnt vmcnt(0)" ::: "memory");
    }
    __syncthreads();
}

__global__ void __launch_bounds__(512, 2) mk_fwd(Params prm) {
    extern __shared__ __attribute__((aligned(16))) unsigned char lds_raw[];
    Ctx c; c.lds = (LAS unsigned char*)lds_raw; c.ka = (kargp_t)__builtin_amdgcn_kernarg_segment_ptr(); c.ws = prm.ws; c.tid = threadIdx.x; c.lane = c.tid & 63; c.wave = __builtin_amdgcn_readfirstlane(c.tid >> 6); c.G = gridDim.x; c.bid = blockIdx.x; c.dry = prm.dry;
    const int wave0 = c.wave;
    volatile LAS unsigned* misc = (volatile LAS unsigned*)(c.lds + LDS_MISC);
    if (c.tid < 16) misc[c.tid] = 0u;
    __syncthreads();
    unsigned* ctl = wsp<unsigned>(c, WS_CTL);
    const int lo = prm.ph_lo, hi = prm.ph_hi;
    const bool fused = (hi - lo) > 1;
    XcdBarrier bar; bar.bar = ctl + CW_BAR; bar.x = 0; bar.st = misc;
    if (fused) bar = xcd_barrier_post(ctl + CW_BAR, misc);
#ifndef SITE_MASK
#define SITE_MASK 0x3ff
#endif
#define SITE(n) (((SITE_MASK) >> (n)) & 1)
#define IN(k) (lo <= (k) && (k) < hi)
#define FRESH() do { { kargp_t _k = (kargp_t)__builtin_amdgcn_kernarg_segment_ptr(); asm volatile("" : "+s"(_k)); c.ka = _k; c.ws = (unsigned char*)(GAS unsigned char*)_k[37]; } { int _w = wave0; asm volatile("" : "+s"(_w)); c.wave = _w; c.lane = lane_id_fresh(); c.tid = c.wave * 64 + c.lane; } } while (0)
#define SEAM(k) do { if (IN((k) + 1)) xcd_barrier(bar); } while (0)

    if (SITE(0) && IN(0)) {
        FRESH();
        constexpr int J_MOD = 192, J_HY = 544, J_SSM = 64, J_WIN = 4 * 48 * 8, J_WOUT = 4 * 16 * 8, J_WUQ = 4 * 8 * 2, J_W256 = 4 * 4 * 2, J_NORM = MROWS / 256, J_PACK = 4 * 2 * 256;
        constexpr int J0 = J_MOD, J1 = J0 + J_HY, J2 = J1 + J_SSM, J3 = J2 + J_WIN, J4 = J3 + J_WOUT, J5 = J4 + J_WUQ, J6 = J5 + J_W256, J7 = J6 + J_W256, J8 = J7 + J_W256, J9 = J8 + 1, J10 = J9 + J_NORM, J11 = J10 + J_PACK;
        unsigned* dep = ctl + CW_DEP + DEP_SET * 8;
        unsigned* tmo = ctl + CW_BAR + XB_TMO;
        for (int job = c.bid; job < J11; job += c.G) {
            FRESH();
            if (job < J0) { modv_job(c, job); dep_signal(c, dep); }
            else if (job < J1) { hyena_mlp_job(c, job - J0); dep_signal(c, dep + 64); }
            else if (job < J2) ssm_tables_job(c, job - J1);
            else if (job < J3) { const int r = job - J2, l = r / 384, q = r % 384; wconv_tile(c, KIN(I_WIN) + (size_t)l * DM * INC, DM, INC, INP, wsp<bf16_t>(c, WS_WIN) + (size_t)l * INP * DM, DM, 0, q / 8, q % 8); }
            else if (job < J4) { const int r = job - J3, l = r / 128, q = r % 128; wconv_tile(c, KIN(I_WOUT) + (size_t)l * DM * DM, DM, DM, DM, wsp<bf16_t>(c, WS_WOUT) + (size_t)l * DM * DM, DM, 1, q / 8, q % 8); }
            else if (job < J5) { const int r = job - J4, l = r / 16, q = r % 16; wconv_tile(c, KIN(I_WUQ) + (size_t)l * 192 * 384, 192, 384, 384, wsp<bf16_t>(c, WS_WUQ) + (size_t)l * 512 * 256, 256, 1, q / 2, q % 2); }
            else if (job < J6) { const int r = job - J5, l = r / 8, q = r % 8; wconv_tile(c, KIN(I_WUKV) + (size_t)l * 128 * 512, 128, 512, 256, wsp<bf16_t>(c, WS_WUK) + (size_t)l * 256 * 256, 256, 2, q / 2, q % 2); }
            else if (job < J7) { const int r = job - J6, l = r / 8, q = r % 8; wconv_tile(c, KIN(I_WUKV) + (size_t)l * 128 * 512, 128, 512, 256, wsp<bf16_t>(c, WS_WUV) + (size_t)l * 256 * 256, 256, 3, q / 2, q % 2); }
            else if (job < J8) { const int r = job - J7, l = r / 8, q = r % 8; wconv_tile(c, KIN(I_GLUW) + (size_t)l * 256 * 256, 256, 256, 256, wsp<bf16_t>(c, WS_WGLU) + (size_t)l * 256 * 256, 256, 1, q / 2, q % 2); }
            else if (job < J9) rope_job(c);
            else if (job < J10) { dep_wait(c, dep, J_MOD, tmo); FRESH(); const int t = job - J9; norm_rows(c, -1, 0, t * 256, t * 256 + 256); }
            else { dep_wait(c, dep + 64, J_HY, tmo); FRESH(); hyena_pack_job(c, job - J10); }
        }
        SEAM(0);
    }
    for (int l = 0; l < DEPTH; ++l) {
        const int pbase = NPRO + l * NPH;
        if (SITE(2) && IN(pbase + 0)) {
            FRESH();
            pg8::Gemm g{wsp<bf16_t>(c, WS_HCAT), wsp<bf16_t>(c, WS_WIN) + (size_t)l * INP * DM, MROWS, INP, DM};
            pg8::StaticOrder S; S.init(MROWS, INP, c.G, c.bid);
            EpiInProj E{wsp<bf16_t>(c, WS_PB), wsp<bf16_t>(c, WS_UG), wsp<bf16_t>(c, WS_US), wsp<bf16_t>(c, WS_VTG), wsp<bf16_t>(c, WS_HYV), c.lds + pg8::STAGE_BYTES};
            pg8::gemm_phase(c.lds, g, S, E, c.tid);
            SEAM(pbase + 0);
        }
        if (SITE(3) && IN(pbase + 1)) { FRESH(); p2_rows(c, l); SEAM(pbase + 1); }
        if (SITE(4) && IN(pbase + 2)) {
            FRESH();
            pg8::Gemm g{wsp<bf16_t>(c, WS_PB), wsp<bf16_t>(c, WS_WUQ), MROWS, 512, 256};
            pg8::P3Order S{wsp<bf16_t>(c, WS_PB), wsp<bf16_t>(c, WS_PB) + BLKE, wsp<bf16_t>(c, WS_WUQ) + (size_t)l * 512 * 256, wsp<bf16_t>(c, WS_WUK) + (size_t)l * 256 * 256, wsp<bf16_t>(c, WS_WUV) + (size_t)l * 256 * 256,
                           wsp<bf16_t>(c, WS_UG), wsp<bf16_t>(c, WS_WE) + (size_t)l * 16 * 256 * 256, c.G, c.bid};
            EpiP3 E{{wsp<bf16_t>(c, WS_QM), 384, 384}, {wsp<bf16_t>(c, WS_KM), wsp<bf16_t>(c, WS_KR)}, {wsp<bf16_t>(c, WS_VTM)}, {wsp<bf16_t>(c, WS_E)}};
            pg8::gemm_phase(c.lds, g, S, E, c.tid);
            SEAM(pbase + 2);
        }
        if (SITE(5) && IN(pbase + 3)) {
            FRESH();
            unsigned* qh = ctl + CW_Q + 64 * (l + 4 * (c.dry ? 1 : 0));
            unsigned* dep = ctl + CW_DEP + DEP_SET * (l + 4 * (c.dry ? 1 : 0));
            unsigned* tmo = ctl + CW_BAR + XB_TMO;
            const float* ropeM = wsp<float>(c, WS_ROPEM);
            bool gqa_nomax;
            { float gq_ = fabsf(KIN(I_GQ)[l * 64 + c.lane]), gk_ = fabsf(KIN(I_GK)[l * 64 + c.lane]);
              gq_ = fmaxf(gq_, swz_xor<16>(gq_)); gq_ = fmaxf(gq_, swz_xor<8>(gq_)); gq_ = fmaxf(gq_, swz_xor<4>(gq_)); gq_ = fmaxf(gq_, swz_xor<2>(gq_)); gq_ = fmaxf(gq_, swz_xor<1>(gq_)); gq_ = half_max(gq_);
              gk_ = fmaxf(gk_, swz_xor<16>(gk_)); gk_ = fmaxf(gk_, swz_xor<8>(gk_)); gk_ = fmaxf(gk_, swz_xor<4>(gk_)); gk_ = fmaxf(gk_, swz_xor<2>(gk_)); gk_ = fmaxf(gk_, swz_xor<1>(gk_)); gk_ = half_max(gk_);
              const float bound = 64.f * gq_ * gk_ * 0.125f * LOG2E * 1.01f; gqa_nomax = __builtin_amdgcn_readfirstlane(bound < 50.f ? 1 : 0) != 0; }
#define ATT_CALL(DKV, ...) do { float rowmax_[2] = {0.f, 0.f}; if (attn_unit<DKV, false>(rowmax_, __VA_ARGS__)) { (void)attn_unit<DKV, true>(rowmax_, __VA_ARGS__); } } while (0)
            for (;;) {
                __syncthreads();
                if (c.tid == 0) misc[4] = __hip_atomic_fetch_add(qh, 1u, __ATOMIC_RELAXED, __HIP_MEMORY_SCOPE_AGENT);
                __syncthreads();
                const int it = (int)misc[4];
                if (it >= QI_TOTAL) break;
                FRESH();
                if (c.dry) { const int kd_ = it < QO_SCAN ? 0 : it < QO_ATTL ? 1 : it < QO_SSM2 ? 2 : it < QO_UNT ? 3 : it < QO_ATTC ? 4 : it < QO_GLU ? 5 : 6; if (!((c.dry >> (1 + kd_)) & 1)) continue; }
                if (it < QO_SCAN) { hyena_seq<SEQL>(c, l, it, 0); if (l + 1 < DEPTH) hyena_seq<CTXL>(c, l, it, SEQL); dep_signal(c, dep); }
                else if (it < QO_ATTL) { ssm_scan_item(c, l, it - QO_SCAN); dep_signal(c, dep + 64); }
                else if (it >= QO_ATTC && it < QO_GLU && l + 1 == DEPTH) {   }
                else if (it < QO_SSM2 || (it >= QO_ATTC && it < QO_GLU)) {
                    const bool isctx = it >= QO_ATTC; const int r = isctx ? it - QO_ATTC : (it - QO_ATTL) % (NB * 8), blk = isctx ? 8 : (it - QO_ATTL) / (NB * 8)  ;
                    const int kind = r & 1  , head = (r >> 1) & 3, b = r >> 3;
                    const size_t row0 = (size_t)b * NTOK + (isctx ? SEQL : blk * 512); const int kt0 = isctx ? 64 : 0, nkt = isctx ? 4 : 68, nrows = isctx ? 256 : 512;
                    if (kind == 0) { if (c.dry && PROBE_GQAONLY == 1) continue; ATT_CALL(96, c, wsp<bf16_t>(c, WS_QM) + row0 * 384 + head * 96, 384, wsp<bf16_t>(c, WS_KM) + (size_t)(b * 4 + head) * NTOK * 96, wsp<bf16_t>(c, WS_VTM) + (size_t)(b * 4 + head) * 64 * NTOK,
                                                 kt0, nkt, nrows, wsp<bf16_t>(c, WS_PB) + 2 * BLKE + row0 * 256 + head * 64, wsp<bf16_t>(c, WS_HCAT) + row0 * DM + head * 64, !isctx, blk * 512, 0.10206207261596577f * LOG2E, ropeM); }
                    else if (c.dry && PROBE_GQAONLY == 2) { continue; }
                    else if (c.dry && PROBE_ABL) { float rm_[2] = {0.f, 0.f}; (void)attn_unit<64, false, true, PROBE_ABL>(rm_, c, wsp<bf16_t>(c, WS_PB) + 3 * BLKE + row0 * 256 + head * 64, 256, wsp<bf16_t>(c, WS_KG) + (size_t)(b * 2 + (head >> 1)) * NTOK * 64, wsp<bf16_t>(c, WS_VTG) + (size_t)(b * 2 + (head >> 1)) * 64 * NTOK,
                                       kt0, nkt, nrows, wsp<bf16_t>(c, WS_PB) + 5 * BLKE + row0 * 256 + head * 64, wsp<bf16_t>(c, WS_HCAT) + row0 * DM + 256 + head * 64, false, 0, 1.f, ropeM); }
                    else if (gqa_nomax) { float rm_[2] = {0.f, 0.f}; (void)attn_unit<64, false, true>(rm_, c, wsp<bf16_t>(c, WS_PB) + 3 * BLKE + row0 * 256 + head * 64, 256, wsp<bf16_t>(c, WS_KG) + (size_t)(b * 2 + (head >> 1)) * NTOK * 64, wsp<bf16_t>(c, WS_VTG) + (size_t)(b * 2 + (head >> 1)) * 64 * NTOK,
                                       kt0, nkt, nrows, wsp<bf16_t>(c, WS_PB) + 5 * BLKE + row0 * 256 + head * 64, wsp<bf16_t>(c, WS_HCAT) + row0 * DM + 256 + head * 64, false, 0, 1.f, ropeM); }
                    else { ATT_CALL(64, c, wsp<bf16_t>(c, WS_PB) + 3 * BLKE + row0 * 256 + head * 64, 256, wsp<bf16_t>(c, WS_KG) + (size_t)(b * 2 + (head >> 1)) * NTOK * 64, wsp<bf16_t>(c, WS_VTG) + (size_t)(b * 2 + (head >> 1)) * 64 * NTOK,
                                       kt0, nkt, nrows, wsp<bf16_t>(c, WS_PB) + 5 * BLKE + row0 * 256 + head * 64, wsp<bf16_t>(c, WS_HCAT) + row0 * DM + 256 + head * 64, false, 0, 1.f, ropeM); }
                }
                else if (it < QO_UNT) {
                    const int L = it - QO_SSM2, i = L >> 4, g = L & 15;
                    dep_wait(c, dep + 64, QI_SCAN, tmo);
                    pg8::Gemm gm{wsp<bf16_t>(c, WS_US), wsp<bf16_t>(c, WS_WKC) + (size_t)l * 16 * 256 * 512, 16 * NCHUNK, 16 * 256, 512}; pg8::OneUnit S{g * 17 + i, g};
                    pg8::EpiWalk<PutSsmY> E{{wsp<bf16_t>(c, WS_ZS), wsp<bf16_t>(c, WS_UG), KIN(I_SSMD) + l * 256}}; pg8::gemm_phase(c.lds, gm, S, E, c.tid);
                    dep_signal(c, dep + 64 * (2 + i));
                }
                else if (it < QO_ATTC) {
                    dep_wait(c, dep, QI_HY, tmo);
                    const int j = it - QO_UNT; hyena_untranspose(c, 4 * j, 4 * j + 4);
                }
                else {
                    const int pm = it - QO_GLU;
                    dep_wait(c, dep + 64 * (2 + (pm >> 4)), 16u, tmo);
                    pg8::Gemm gm{wsp<bf16_t>(c, WS_ZS), wsp<bf16_t>(c, WS_WGLU) + (size_t)l * 256 * 256, MROWS, 256, 256}; pg8::OneUnit S{pm, 0};
                    pg8::EpiWalk<PutGlu> E{{wsp<bf16_t>(c, WS_HCAT), wsp<bf16_t>(c, WS_ZS), wsp<bf16_t>(c, WS_PB) + 7 * BLKE, KIN(I_GLUB) + l * 256}}; pg8::gemm_phase(c.lds, gm, S, E, c.tid);
                }
            }
            SEAM(pbase + 3);
        }
        if (SITE(6) && IN(pbase + 4)) {
            FRESH();
            pg8::Gemm g{wsp<bf16_t>(c, WS_HCAT), wsp<bf16_t>(c, WS_WOUT) + (size_t)l * DM * DM, MROWS, DM, DM}; pg8::LiveRowsOrder S; S.init2(DM, c.G, c.bid, l + 1 == DEPTH);
            pg8::EpiWalk<PutPlain> E{{wsp<bf16_t>(c, WS_OUTB), DM, DM}}; pg8::gemm_phase(c.lds, g, S, E, c.tid);
            SEAM(pbase + 4);
        }
        if (SITE(7) && IN(pbase + 5)) { FRESH(); norm_rows(c, l, l + 1 < DEPTH ? l + 1 : -1); if (l + 1 < DEPTH) SEAM(pbase + 5); }
    }
#undef IN
#undef SEAM
}

extern "C" void kernel_launch(void* const* d_in, const int* in_sizes, int n_in, void* d_out, int out_size, void* d_ws, size_t ws_size, hipStream_t stream) {
    static int grid = 0;
    if (grid == 0) {
        if (n_in != 36 || out_size != NB * SEQL * DM || ws_size < WS_END) { fprintf(stderr, "kernel_launch: unexpected shapes: n_in %d out %d ws %zu (need %zu)\n", n_in, out_size, ws_size, (size_t)WS_END); grid = -1; return; }
        int dev = 0, cus = 0, per_cu = 0;
        if (hipGetDevice(&dev) != hipSuccess || hipDeviceGetAttribute(&cus, hipDeviceAttributeMultiprocessorCount, dev) != hipSuccess) { grid = -1; return; }
        if (hipFuncSetAttribute((const void*)mk_fwd, hipFuncAttributeMaxDynamicSharedMemorySize, LDS_BYTES) != hipSuccess) { fprintf(stderr, "kernel_launch: hipFuncSetAttribute failed\n"); grid = -1; return; }
        if (hipOccupancyMaxActiveBlocksPerMultiprocessor(&per_cu, (const void*)mk_fwd, 512, LDS_BYTES) != hipSuccess || per_cu < 1) { fprintf(stderr, "kernel_launch: occupancy query says %d blocks per CU\n", per_cu); per_cu = 1; }
        (void)hipGetLastError();
        grid = cus;
    }
    if (grid < 0) return;
    (void)hipMemsetAsync((char*)d_ws + WS_CTL, 0, CTL_BYTES, stream);
    Params p{};
    for (int i = 0; i < 36; ++i) p.in[i] = (const float*)d_in[i];
    p.out = (float*)d_out; p.ws = (unsigned char*)d_ws;
#if MK_ONE_LAUNCH
    p.ph_lo = 0; p.ph_hi = NPHASES;
    hipLaunchKernelGGL(mk_fwd, dim3(grid), dim3(512), LDS_BYTES, stream, p);
#else
    for (int k = 0; k < NPHASES; ++k) { p.ph_lo = k; p.ph_hi = k + 1; const int site = k < NPRO ? k : NPRO + (k - NPRO) % NPH;
        if ((PROBE_DUP_MASK >> site) & 1) { p.dry = 1 | (PROBE_P4KINDS << 1); hipLaunchKernelGGL(mk_fwd, dim3(grid), dim3(512), LDS_BYTES, stream, p); p.dry = 0; }
        hipLaunchKernelGGL(mk_fwd, dim3(grid), dim3(512), LDS_BYTES, stream, p); }
#endif
}
```

```cpp
#include <hip/hip_runtime.h>
#include <cstdio>
#include <cstdint>

#ifndef MK_ONE_LAUNCH
#define MK_ONE_LAUNCH 1
#endif

#define LAS __attribute__((address_space(3)))
typedef unsigned short bf16_t;
typedef short bf16x8 __attribute__((ext_vector_type(8)));
typedef short bf16x4 __attribute__((ext_vector_type(4)));
typedef float f32x4 __attribute__((ext_vector_type(4)));
typedef float f32x16 __attribute__((ext_vector_type(16)));
typedef unsigned u32x4 __attribute__((ext_vector_type(4)));
typedef unsigned u32x2 __attribute__((ext_vector_type(2)));

constexpr int NB = 16, SEQL = 4096, CTXL = 256, NTOK = SEQL + CTXL  , MROWS = NB * NTOK  ;
constexpr int DM = 1024, DEPTH = 4, INC = 2912, INP = 3072;
constexpr int NCHB = NTOK / 16  , NCHUNK = MROWS / 16  ;
constexpr float EPS = 1e-6f;
constexpr float LOG2E = 1.4426950408889634f;
constexpr int LDS_MISC_OFF = 163840 - 256;

constexpr size_t al256(size_t x) { return (x + 255) & ~(size_t)255; }
constexpr size_t WS_CTL = 0;
constexpr size_t CTL_BYTES = 65536;
constexpr size_t WS_MODV = WS_CTL + CTL_BYTES;
constexpr size_t WS_ROPEG = WS_MODV + al256((size_t)4 * 17 * 3072 * 4);
constexpr size_t WS_ROPEM = WS_ROPEG + 64 * 16 * 2 * 4;
constexpr size_t WS_WIN = WS_ROPEM + 64 * 8 * 2 * 4;
constexpr size_t WS_WOUT = WS_WIN + (size_t)4 * 3072 * 1024 * 2;
constexpr size_t WS_WUQ = WS_WOUT + (size_t)4 * 1024 * 1024 * 2;
constexpr size_t WS_WUK = WS_WUQ + (size_t)4 * 512 * 256 * 2;
constexpr size_t WS_WUV = WS_WUK + (size_t)4 * 256 * 256 * 2;
constexpr size_t WS_WGLU = WS_WUV + (size_t)4 * 256 * 256 * 2;
constexpr size_t WS_WE = WS_WGLU + (size_t)4 * 256 * 256 * 2;
constexpr size_t WS_WKC = WS_WE + (size_t)4 * 16 * 256 * 256 * 2;
constexpr size_t WS_A16 = WS_WKC + (size_t)4 * 16 * 256 * 512 * 2;
constexpr size_t WS_GR = WS_A16 + (size_t)4 * 2 * 16 * 64 * 2 * 4;
constexpr size_t WS_GRC = WS_GR + (size_t)4 * 2 * 256 * 8192 * 2;
constexpr size_t WS_CTXR = WS_GRC + (size_t)4 * 2 * 256 * 512 * 2;
constexpr size_t WS_HCAT = WS_CTXR + (size_t)NB * CTXL * DM * 4;
constexpr size_t BLKE = (size_t)MROWS * 256;
constexpr size_t WS_PB = WS_HCAT + (size_t)MROWS * DM * 2;
constexpr size_t WS_KR = WS_PB + 12 * BLKE * 2;
constexpr size_t WS_KG = WS_KR + (size_t)MROWS * 32 * 2;
constexpr size_t WS_VTG = WS_KG + (size_t)32 * NTOK * 64 * 2;
constexpr size_t WS_UG = WS_VTG + (size_t)32 * NTOK * 64 * 2;
constexpr size_t WS_US = WS_UG + BLKE * 2;
constexpr size_t WS_HYV = WS_US + (size_t)16 * NCHUNK * 512 * 2;
constexpr size_t WS_HYX1 = WS_HYV + BLKE * 2;
constexpr size_t WS_HYX2 = WS_HYX1 + BLKE * 2;
constexpr size_t WS_HYG = WS_HYX2 + BLKE * 2;
constexpr size_t WS_HYZ = WS_HYG + BLKE * 2;
constexpr size_t WS_HYY = WS_HYZ + BLKE * 2;
constexpr size_t WS_END = WS_HYY + BLKE * 2;
static_assert(WS_END <= (size_t)1 << 30, "workspace map exceeds 1 GiB");
constexpr size_t WS_QM = WS_PB + 8 * BLKE * 2;
constexpr size_t WS_KM = WS_QM + (size_t)MROWS * 384 * 2;
constexpr size_t WS_VTM = WS_KM + (size_t)MROWS * 384 * 2;
constexpr size_t WS_E = WS_PB + 4 * BLKE * 2;
constexpr size_t WS_ZS = WS_PB + 6 * BLKE * 2;
constexpr size_t WS_OUTB = WS_PB + 8 * BLKE * 2;
constexpr size_t WS_HT = WS_PB;
static_assert(WS_VTM + BLKE * 2 == WS_PB + 12 * BLKE * 2, "alias map");

constexpr int CW_BAR = 0;
constexpr int CW_Q = 4096;
constexpr int CW_TMO = 4096 + 64 * 8;
constexpr int CW_DEP = 5120;
constexpr int DEP_SET = 20 * 64;

__device__ __forceinline__ float bf2f(bf16_t v) { return __uint_as_float(((unsigned)v) << 16); }
__device__ __forceinline__ bf16_t f2bf(float f) { unsigned u = __float_as_uint(f); u += 0x7FFFu + ((u >> 16) & 1u); return (bf16_t)(u >> 16); }
__device__ __forceinline__ unsigned cvt_pk_bf16(float lo, float hi) { unsigned r; asm volatile("v_cvt_pk_bf16_f32 %0, %1, %2" : "=v"(r) : "v"(lo), "v"(hi)); return r; }
__device__ __forceinline__ float lo_bf(unsigned w) { return __uint_as_float(w << 16); }
__device__ __forceinline__ float hi_bf(unsigned w) { return __uint_as_float(w & 0xFFFF0000u); }
__device__ __forceinline__ float sigmf(float x) { float one = 1.f; asm volatile("" : "+v"(one)); return __builtin_amdgcn_rcpf(one + __builtin_amdgcn_exp2f(-1.4426950408889634f * x)); }
__device__ __forceinline__ float siluf(float x) { return x * sigmf(x); }
__device__ __forceinline__ float gelu_tanh(float x) { const float u = 0.7978845608028654f * (x + 0.044715f * x * x * x); return x * sigmf(2.f * u); }
__device__ __forceinline__ int opaque(int x) { asm volatile("" : "+v"(x)); return x; }
__device__ __forceinline__ int lane_id_fresh() { int x; asm volatile("v_mbcnt_lo_u32_b32 %0, -1, 0\n\tv_mbcnt_hi_u32_b32 %0, -1, %0" : "=v"(x)); return x; }
__device__ __forceinline__ float max3_raw(float a, float b, float c) { float r; asm("v_max3_f32 %0, %1, %2, %3" : "=v"(r) : "v"(a), "v"(b), "v"(c)); return r; }
template <int M> __device__ __forceinline__ float swz_xor(float v) { return __int_as_float(__builtin_amdgcn_ds_swizzle(__float_as_int(v), 0x1F | (M << 10))); }
__device__ __forceinline__ float half_sum(float v) { auto r = __builtin_amdgcn_permlane32_swap(__float_as_uint(v), __float_as_uint(v), false, false); return __uint_as_float(r[0]) + __uint_as_float(r[1]); }
__device__ __forceinline__ float half_max(float v) { auto r = __builtin_amdgcn_permlane32_swap(__float_as_uint(v), __float_as_uint(v), false, false); return fmaxf(__uint_as_float(r[0]), __uint_as_float(r[1])); }
__device__ __forceinline__ float half_other(float v, int h) { auto r = __builtin_amdgcn_permlane32_swap(__float_as_uint(v), __float_as_uint(v), false, false); return __uint_as_float(h ? r[0] : r[1]); }
__device__ __forceinline__ float wave_sum(float v) {
    v += swz_xor<16>(v); v += swz_xor<8>(v); v += swz_xor<4>(v); v += swz_xor<2>(v); v += swz_xor<1>(v);
    return half_sum(v);
}

#define XB_TMO      128
#define XB_XCNT(j)  (256  + 64 * (j))
#define XB_XSUB(j)  (1280 + 64 * (j))
#define XB_XGEN(j)  (2304 + 64 * (j))
#define XB_TOP      3328
#define XB_TOPGEN   3392
#define XCD_BAR_WORDS 3456
#define XB_SPIN_CAP (1u << 22)
__device__ __forceinline__ unsigned xb_ld(unsigned* p)              { return __hip_atomic_load(p, __ATOMIC_RELAXED, __HIP_MEMORY_SCOPE_AGENT); }
__device__ __forceinline__ unsigned xb_add(unsigned* p, unsigned v) { return __hip_atomic_fetch_add(p, v, __ATOMIC_RELAXED, __HIP_MEMORY_SCOPE_AGENT); }
__device__ __forceinline__ unsigned xb_xcc_id() { return (unsigned)__builtin_amdgcn_s_getreg((3 << 11) | 20) & 0xFu; }
#define XB_SPIN(cond, bar) do { unsigned _sp = 0; while (cond) { __builtin_amdgcn_s_sleep(1); \
    if ((++_sp & 255u) == 0u) { if (xb_ld(&(bar)[XB_TMO])) break; if (_sp > XB_SPIN_CAP) { atomicAdd(&(bar)[XB_TMO], 1u); break; } } } } while (0)
struct XcdBarrier { unsigned* bar; unsigned x; volatile LAS unsigned* st; };
__device__ __forceinline__ XcdBarrier xcd_barrier_post(unsigned* bar, volatile LAS unsigned* st) {
    XcdBarrier b; b.bar = bar; b.x = xb_xcc_id(); b.st = st;
    if (threadIdx.x == 0) (void)xb_add(&bar[XB_XCNT(b.x)], 1u);
    return b;
}
__device__ __forceinline__ void xcd_barrier_complete(unsigned* bar, unsigned x, unsigned& nloc, unsigned& nx) {
    const unsigned G = gridDim.x * gridDim.y * gridDim.z;
    unsigned sum, cnt, mine, sp = 0u;
    for (;;) {
        sum = 0u; cnt = 0u; mine = 0u;
#pragma unroll
        for (unsigned j = 0; j < 16; ++j) { const unsigned c = xb_ld(&bar[XB_XCNT(j)]); sum += c; cnt += (c > 0u) ? 1u : 0u; }
        mine = xb_ld(&bar[XB_XCNT(x)]);
        if (sum == G) break;
        __builtin_amdgcn_s_sleep(1);
        if ((++sp & 255u) == 0u) { if (xb_ld(&bar[XB_TMO])) break; if (sp > XB_SPIN_CAP) { atomicAdd(&bar[XB_TMO], 1u); break; } }
    }
    nloc = mine > 0u ? mine : 1u; nx = cnt > 0u ? cnt : 1u;
}
__device__ __forceinline__ void xcd_barrier(const XcdBarrier& b) {
    asm volatile("s_waitcnt vmcnt(0)" ::: "memory");
    __syncthreads();
    if (threadIdx.x == 0) {
        unsigned* bar = b.bar;
        __builtin_amdgcn_s_waitcnt(0);
        unsigned nloc = b.st[0], nx = b.st[1];
        if (nloc == 0u) { xcd_barrier_complete(bar, b.x, nloc, nx); b.st[0] = nloc; b.st[1] = nx; }
        const unsigned old = xb_add(&bar[XB_XSUB(b.x)], 1u);
        const unsigned gen = old / nloc;
        if (old + 1u == (gen + 1u) * nloc) {
            __builtin_amdgcn_fence(__ATOMIC_RELEASE, "agent");
            asm volatile("s_waitcnt vmcnt(0)" ::: "memory");
            const unsigned og = xb_add(&bar[XB_TOP], 1u);
            const unsigned tg = og / nx;
            if (og + 1u == (tg + 1u) * nx) xb_add(&bar[XB_TOPGEN], 1u);
            else XB_SPIN(xb_ld(&bar[XB_TOPGEN]) == tg, bar);
            __builtin_amdgcn_fence(__ATOMIC_ACQUIRE, "agent");
            xb_add(&bar[XB_XGEN(b.x)], 1u);
            asm volatile("s_waitcnt vmcnt(0)" ::: "memory");
        } else {
            XB_SPIN(xb_ld(&bar[XB_XGEN(b.x)]) == gen, bar);
            __builtin_amdgcn_fence(__ATOMIC_ACQUIRE, "agent");
            asm volatile("s_waitcnt vmcnt(0)" ::: "memory");
        }
    }
    __syncthreads();
}

namespace pg8 {
constexpr int BM = 256, BK = 64, HALF = 128, HTB = HALF * BK * 2, STAGE_BYTES = 8 * HTB, NXCD = 8, WGM = 8;
__host__ __device__ __forceinline__ int lds_byte(int r, int c) { const int st = (r >> 4) * 2 + (c >> 5), rr = r & 15, cc = c & 31, ob = rr * 64 + cc * 2; return st * 1024 + (ob ^ (((ob >> 9) & 1) << 5)); }
__host__ __device__ __forceinline__ void stage_rc(int b, int& R, int& C) { const int st = b / 1024, sb = b % 1024, swz = sb ^ (((sb >> 9) & 1) << 5); R = (st >> 1) * 16 + swz / 64; C = (st & 1) * 32 + (swz % 64) / 2; }
__host__ __device__ __forceinline__ int perm32(int rho) { const int n = rho >> 4, i = rho & 15; return 8 * (i >> 2) + 4 * n + (i & 3); }
struct Unit { int pm, pn, kd; };
struct Gemm { const bf16_t* A; const bf16_t* Bt; int M, N, K; };
struct StaticOrder {
    int nM, nN, nwg, G, c;
    __host__ __device__ void init(int M, int N, int G_, int c_) { nM = M / BM; nN = N / BM; nwg = nM * nN; G = G_; c = c_; }
    __host__ __device__ bool next(int i, Unit& u) const {
        const long L = (long)i * G + c; if (L >= nwg) return false;
        int wgid = (int)L; { const int q = nwg / NXCD, r = nwg % NXCD, xcd = wgid % NXCD, off = wgid / NXCD; wgid = (xcd < r ? xcd * (q + 1) : r * (q + 1) + (xcd - r) * q) + off; }
        const int nig = WGM * nN, gid = wgid / nig, fm = gid * WGM, gsz = (nM - fm) < WGM ? (nM - fm) : WGM;
        u.pm = fm + ((wgid % nig) % gsz); u.pn = (wgid % nig) / gsz; u.kd = 0; return true;
    }
    __device__ __forceinline__ void a_ready(const Unit&) const {}
    __device__ __forceinline__ void done(const Unit&) const {}
    __device__ __forceinline__ const char* abase(const Gemm& g, const Unit& u, size_t tstep) const { return (const char*)g.A + (size_t)u.pm * tstep; }
    __device__ __forceinline__ const char* bbase(const Gemm& g, const Unit& u, size_t tstep) const { return (const char*)g.Bt + (size_t)u.pn * tstep; }
};
struct LiveRowsOrder : StaticOrder {
    bool skip;
    __host__ __device__ void init2(int N, int G_, int c_, bool skip_) { skip = skip_; init(skip_ ? NB * SEQL : MROWS, N, G_, c_); }
    __host__ __device__ bool next(int i, Unit& u) const { if (!StaticOrder::next(i, u)) return false; if (skip) u.pm = (u.pm >> 4) * 17 + (u.pm & 15); return true; }
};
struct BatchedOrder {
    int nwg, G, c, tpg;
    __host__ __device__ void init(int ng, int tpg_, int G_, int c_) { nwg = ng * tpg_; tpg = tpg_; G = G_; c = c_; }
    __host__ __device__ bool next(int i, Unit& u) const { const int L = i * G + c; if (L >= nwg) return false; u.pm = L; u.pn = L / tpg; u.kd = 0; return true; }
    __device__ __forceinline__ void a_ready(const Unit&) const {}
    __device__ __forceinline__ void done(const Unit&) const {}
    __device__ __forceinline__ const char* abase(const Gemm& g, const Unit& u, size_t tstep) const { return (const char*)g.A + (size_t)u.pm * tstep; }
    __device__ __forceinline__ const char* bbase(const Gemm& g, const Unit& u, size_t tstep) const { return (const char*)g.Bt + (size_t)u.pn * tstep; }
};
struct P3Order {
    const bf16_t *b0, *b1, *wuq, *wuk, *wuv, *ug, *we; int G, c;
    __host__ __device__ bool next(int i, Unit& u) const {
        const int L = i * G + c; if (L >= 1360) return false;
        if (L < 544) { u.kd = 0; u.pm = L >> 1; u.pn = L & 1; } else if (L < 816) { u.kd = 1; u.pm = L - 544; u.pn = 0; } else if (L < 1088) { u.kd = 2; u.pm = 0; u.pn = L - 816; } else { u.kd = 3; u.pm = L - 1088; u.pn = (L - 1088) / 17; }
        return true;
    }
    __device__ __forceinline__ void a_ready(const Unit&) const {}
    __device__ __forceinline__ void done(const Unit&) const {}
    __device__ __forceinline__ const char* abase(const Gemm&, const Unit& u, size_t tstep) const { const bf16_t* p = u.kd == 0 ? b0 : u.kd == 1 ? b1 : u.kd == 2 ? wuv : ug; return (const char*)p + (size_t)u.pm * tstep; }
    __device__ __forceinline__ const char* bbase(const Gemm&, const Unit& u, size_t tstep) const { const bf16_t* p = u.kd == 0 ? wuq : u.kd == 1 ? wuk : u.kd == 2 ? b1 : we; return (const char*)p + (size_t)u.pn * tstep; }
};

struct OneUnit {
    int pm, pn;
    __host__ __device__ bool next(int i, Unit& u) const { if (i) return false; u.pm = pm; u.pn = pn; u.kd = 0; return true; }
    __device__ __forceinline__ void a_ready(const Unit&) const {}
    __device__ __forceinline__ void done(const Unit&) const {}
    __device__ __forceinline__ const char* abase(const Gemm& g, const Unit& u, size_t tstep) const { return (const char*)g.A + (size_t)u.pm * tstep; }
    __device__ __forceinline__ const char* bbase(const Gemm& g, const Unit& u, size_t tstep) const { return (const char*)g.Bt + (size_t)u.pn * tstep; }
};
template <class Epi, class Sched>
__device__ __forceinline__ void gemm_phase(LAS unsigned char* lds, const Gemm g, const Sched& S, const Epi& E, int tid_in) {
    const int tid = tid_in, wid = __builtin_amdgcn_readfirstlane(tid >> 6), lane = tid & 63, wr = wid >> 2, wc = wid & 3, fr = lane & 15, fq = lane >> 4;
    const int K = g.K, nt = K / BK;
    unsigned voffA[2], voffB[2];
#pragma unroll
    for (int i = 0; i < 2; ++i) { int R, C; stage_rc(tid * 16 + i * 8192, R, C); const int Rb = Epi::PERM ? ((R & ~31) + perm32(R & 31)) : R;
        voffA[i] = (unsigned)(R * K + C) * 2u; voffB[i] = (unsigned)(Rb * K + C) * 2u; }
    const size_t kstep = (size_t)(BK * 2);
    const size_t hstep = (size_t)HALF * K * 2;
    const size_t tstep = 2 * hstep;
    const unsigned ldsw = (unsigned)wid * 1024u;
    const int aoff = lds_byte(wr * 64 + fr, fq * 8), boff = lds_byte(wc * 32 + fr, fq * 8);
#define PG8_SA(b, h) (((b) * 2 + (h)) * HTB)
#define PG8_SB(b, h) ((4 + (b) * 2 + (h)) * HTB)
#define PG8_STAGE(bufoff, gbase, voff) do { _Pragma("unroll") for (int _i = 0; _i < 2; ++_i) \
        __builtin_amdgcn_global_load_lds((const unsigned*)((const char*)(gbase) + (voff)[_i]), (LAS unsigned*)(lds + (bufoff) + ldsw + _i * 8192), 16, 0, 0); } while (0)
#define PG8_LDA(dst, b, h) do { _Pragma("unroll") for (int m = 0; m < 4; ++m) _Pragma("unroll") for (int k = 0; k < 2; ++k) dst[m][k] = *(const LAS bf16x8*)(lds + PG8_SA(b, h) + aoff + m * 2048 + k * 1024); } while (0)
#define PG8_LDB(dst, b, h) do { _Pragma("unroll") for (int n = 0; n < 2; ++n) _Pragma("unroll") for (int k = 0; k < 2; ++k) dst[n][k] = *(const LAS bf16x8*)(lds + PG8_SB(b, h) + boff + n * 2048 + k * 1024); } while (0)
#define PG8_MMA(ai, bj, At, Bt) do { __builtin_amdgcn_s_setprio(1); _Pragma("unroll") for (int m = 0; m < 4; ++m) _Pragma("unroll") for (int n = 0; n < 2; ++n) _Pragma("unroll") for (int k = 0; k < 2; ++k) \
        acc[ai][bj][m][n] = __builtin_amdgcn_mfma_f32_16x16x32_bf16(Bt[n][k], At[m][k], acc[ai][bj][m][n], 0, 0, 0); __builtin_amdgcn_s_setprio(0); } while (0)
#define PG8_WAIT_V(n) asm volatile("s_waitcnt vmcnt(" #n ")" ::: "memory")
#define PG8_WAIT_L(n) asm volatile("s_waitcnt lgkmcnt(" #n ")" ::: "memory")
#define PG8_BAR __builtin_amdgcn_s_barrier()
#define PG8_SCHED __builtin_amdgcn_sched_barrier(0)
    Unit cur, nxt; int ui = 0;
    if (!S.next(0, cur)) return;
    f32x4 acc[2][2][4][2];
#pragma unroll
    for (int a = 0; a < 2; ++a)
#pragma unroll
        for (int b = 0; b < 2; ++b)
#pragma unroll
            for (int m = 0; m < 4; ++m)
#pragma unroll
                for (int n = 0; n < 2; ++n) acc[a][b][m][n] = (f32x4){0.f, 0.f, 0.f, 0.f};
    bf16x8 At[4][2], B0[2][2], B1[2][2];
    const char* cA = S.abase(g, cur, tstep); const char* cB = S.bbase(g, cur, tstep);
    S.a_ready(cur);
    PG8_STAGE(PG8_SB(0, 0), cB, voffB); PG8_STAGE(PG8_SA(0, 0), cA, voffA); PG8_STAGE(PG8_SB(0, 1), cB + hstep, voffB); PG8_STAGE(PG8_SA(0, 1), cA + hstep, voffA);
    if (wr == 1) PG8_BAR;
    PG8_WAIT_V(4); PG8_BAR;
    PG8_STAGE(PG8_SB(1, 0), cB + kstep, voffB); PG8_STAGE(PG8_SA(1, 0), cA + kstep, voffA); PG8_STAGE(PG8_SB(1, 1), cB + hstep + kstep, voffB);
    PG8_WAIT_V(6); PG8_BAR;
    for (;;) {
        const bool has_next = S.next(ui + 1, nxt);
        const char* nA = has_next ? S.abase(g, nxt, tstep) : cA; const char* nB = has_next ? S.bbase(g, nxt, tstep) : cB;
        for (int t = 0; t < nt; t += 2) {
            const bool last = (t == nt - 2);
            const char* a1 = cA + (size_t)(t + 1) * kstep;
            const char* a2 = last ? nA : cA + (size_t)(t + 2) * kstep; const char* b2 = last ? nB : cB + (size_t)(t + 2) * kstep;
            const char* a3 = a2 + kstep; const char* b3 = b2 + kstep;
            if (last && has_next) S.a_ready(nxt);
            PG8_LDB(B0, 0, 0); PG8_SCHED; PG8_LDA(At, 0, 0); PG8_STAGE(PG8_SA(1, 1), a1 + hstep, voffA);
            PG8_WAIT_L(8); PG8_BAR; PG8_WAIT_L(0); PG8_MMA(0, 0, At, B0); PG8_BAR; PG8_SCHED;
            PG8_LDB(B1, 0, 1); PG8_STAGE(PG8_SB(0, 0), b2, voffB);
            PG8_BAR; PG8_WAIT_L(0); PG8_MMA(0, 1, At, B1); PG8_BAR;
            PG8_LDA(At, 0, 1); PG8_STAGE(PG8_SA(0, 0), a2, voffA);
            PG8_BAR; PG8_WAIT_L(0); PG8_MMA(1, 0, At, B0); PG8_BAR; PG8_SCHED;
            PG8_STAGE(PG8_SB(0, 1), b2 + hstep, voffB);
            PG8_WAIT_V(6); PG8_BAR; PG8_MMA(1, 1, At, B1); PG8_BAR;
            PG8_LDB(B0, 1, 0); PG8_SCHED; PG8_LDA(At, 1, 0); PG8_STAGE(PG8_SA(0, 1), a2 + hstep, voffA);
            PG8_WAIT_L(8); PG8_BAR; PG8_WAIT_L(0); PG8_MMA(0, 0, At, B0); PG8_BAR; PG8_SCHED;
            PG8_LDB(B1, 1, 1); PG8_STAGE(PG8_SB(1, 0), b3, voffB);
            PG8_BAR; PG8_WAIT_L(0); PG8_MMA(0, 1, At, B1); PG8_BAR;
            PG8_LDA(At, 1, 1); PG8_STAGE(PG8_SA(1, 0), a3, voffA);
            PG8_BAR; PG8_WAIT_L(0); PG8_MMA(1, 0, At, B0); PG8_BAR; PG8_SCHED;
            PG8_STAGE(PG8_SB(1, 1), b3 + hstep, voffB);
            PG8_WAIT_V(6); PG8_BAR; PG8_MMA(1, 1, At, B1); PG8_BAR;
        }
        { const int l2 = lane_id_fresh(); E(acc, cur, wr, wc, l2 & 15, l2 >> 4); } S.done(cur);
        if (!has_next) break;
#pragma unroll
        for (int a = 0; a < 2; ++a)
#pragma unroll
            for (int b = 0; b < 2; ++b)
#pragma unroll
                for (int m = 0; m < 4; ++m)
#pragma unroll
                    for (int n = 0; n < 2; ++n) acc[a][b][m][n] = (f32x4){0.f, 0.f, 0.f, 0.f};
        cur = nxt; cA = nA; cB = nB; ++ui;
    }
    PG8_WAIT_V(0);
    if (wr == 0) PG8_BAR;
    PG8_BAR;
#undef PG8_SA
#undef PG8_SB
#undef PG8_STAGE
#undef PG8_LDA
#undef PG8_LDB
#undef PG8_MMA
#undef PG8_WAIT_V
#undef PG8_WAIT_L
#undef PG8_BAR
#undef PG8_SCHED
}

template <class F> struct EpiWalk {
    static constexpr bool PERM = true, AFTER_DRAIN = false;
    F f;
    __device__ __forceinline__ void operator()(const f32x4 (&acc)[2][2][4][2], const Unit& u, int wr, int wc, int fr, int fq) const {
#pragma unroll
        for (int ai = 0; ai < 2; ++ai)
#pragma unroll
            for (int m = 0; m < 4; ++m) {
                const int rin = ai * HALF + wr * 64 + m * 16 + fr;
#pragma unroll
                for (int bj = 0; bj < 2; ++bj) { const int cin = bj * HALF + wc * 32 + 8 * fq; f.put(u.pm, u.pn, rin, cin, acc[ai][bj][m][0], acc[ai][bj][m][1]); asm volatile("" ::: "memory"); }
            }
    }
};
}

__device__ __forceinline__ u32x4 pack8(const f32x4& a, const f32x4& b) {
    u32x4 w; w.x = cvt_pk_bf16(a[0], a[1]); w.y = cvt_pk_bf16(a[2], a[3]); w.z = cvt_pk_bf16(b[0], b[1]); w.w = cvt_pk_bf16(b[2], b[3]); return w;
}
__device__ __forceinline__ void unpack8(const u32x4 w, float (&o)[8]) {
    o[0] = lo_bf(w.x); o[1] = hi_bf(w.x); o[2] = lo_bf(w.y); o[3] = hi_bf(w.y); o[4] = lo_bf(w.z); o[5] = hi_bf(w.z); o[6] = lo_bf(w.w); o[7] = hi_bf(w.w);
}

struct PutPlain {
    bf16_t* dst; int ldc, ncols;
    __device__ __forceinline__ void put(int pm, int pn, int rin, int cin, const f32x4& a, const f32x4& b) const { const int col = pn * 256 + cin; if (col < ncols) *(u32x4*)(dst + ((size_t)pm * 256 + rin) * ldc + col) = pack8(a, b); }
};
struct PutKm {
    bf16_t* km; const bf16_t* kr;
    __device__ __forceinline__ void put(int pm, int pn, int rin, int cin, const f32x4& a, const f32x4& b) const {
        const int bb = pm / 17, key = (pm - bb * 17) * 256 + rin, hd = cin >> 6, d = cin & 63;
        bf16_t* dst = km + ((size_t)(bb * 4 + hd) * NTOK + key) * 96;
        *(u32x4*)(dst + d) = pack8(a, b);
        if (d < 32) *(u32x4*)(dst + 64 + d) = *(const u32x4*)(kr + ((size_t)pm * 256 + rin) * 32 + d);
    }
};
struct PutVt {
    bf16_t* vt;
    __device__ __forceinline__ void put(int pm, int pn, int rin, int cin, const f32x4& a, const f32x4& b) const {
        const int bb = pn / 17, key = (pn - bb * 17) * 256 + cin;
        *(u32x4*)(vt + ((size_t)(bb * 4 + (rin >> 6)) * 64 + (rin & 63)) * NTOK + key) = pack8(a, b);
    }
};
struct PutE {
    bf16_t* e;
    __device__ __forceinline__ void put(int pm, int pn, int rin, int cin, const f32x4& a, const f32x4& b) const { *(u32x4*)(e + ((size_t)pm * 256 + rin) * 256 + cin) = pack8(a, b); }
};
struct PutSsmY {
    bf16_t* zs; const bf16_t* ug; const float* dskip;
    __device__ __forceinline__ void put(int pm, int pn, int rin, int cin, const f32x4& a, const f32x4& b) const {
        const int g = pn, n = (pm - g * 17) * 256 + rin, tok = n * 16 + (cin >> 4), ho = cin & 15, ch = g * 16 + ho;
        float u[8]; unpack8(*(const u32x4*)(ug + ((size_t)g * MROWS + tok) * 16 + ho), u);
        const f32x4 d0 = *(const f32x4*)(dskip + ch), d1 = *(const f32x4*)(dskip + ch + 4);
        f32x4 y0, y1;
#pragma unroll
        for (int i = 0; i < 4; ++i) { y0[i] = gelu_tanh(a[i] + d0[i] * u[i]); y1[i] = gelu_tanh(b[i] + d1[i] * u[4 + i]); }
        *(u32x4*)(zs + (size_t)tok * 256 + ch) = pack8(y0, y1);
    }
};
struct PutGlu {
    bf16_t* cat; const bf16_t* zs; const bf16_t* gate; const float* gb;
    __device__ __forceinline__ void put(int pm, int pn, int rin, int cin, const f32x4& a, const f32x4& b) const {
        const size_t row = (size_t)pm * 256 + rin; const int col = cin;
        float z[8], gt[8]; unpack8(*(const u32x4*)(zs + row * 256 + col), z); unpack8(*(const u32x4*)(gate + row * 256 + col), gt);
        const f32x4 b0 = *(const f32x4*)(gb + col), b1 = *(const f32x4*)(gb + col + 4);
        f32x4 y0, y1;
#pragma unroll
        for (int i = 0; i < 4; ++i) { y0[i] = z[i] * sigmf(a[i] + b0[i]) * siluf(gt[i]); y1[i] = z[4 + i] * sigmf(b[i] + b1[i]) * siluf(gt[4 + i]); }
        *(u32x4*)(cat + row * DM + 512 + col) = pack8(y0, y1);
    }
};

struct EpiInProj {
    static constexpr bool PERM = true, AFTER_DRAIN = false;
    bf16_t *pb, *ug, *us, *vtg, *hy0;
    LAS unsigned char* scratch;
    __device__ __forceinline__ void operator()(const f32x4 (&acc)[2][2][4][2], const pg8::Unit& u, int wr, int wc, int fr, int fq) const {
        const int pn = u.pn, pm = u.pm;
        const int bb = pm / 17, jt = (pm - bb * 17) * 256;
        LAS unsigned char* sw = scratch + (wr * 4 + wc) * 1280;
        const int ln = fq * 16 + fr, tch = ln >> 1, thalf = ln & 1;
#pragma unroll
        for (int ai = 0; ai < 2; ++ai)
#pragma unroll
            for (int m = 0; m < 4; ++m) {
                const int rin = ai * pg8::HALF + wr * 64 + m * 16 + fr;
#pragma unroll
                for (int bj = 0; bj < 2; ++bj) {
                    const int cin = bj * pg8::HALF + wc * 32 + 8 * fq;
                    const u32x4 w = pack8(acc[ai][bj][m][0], acc[ai][bj][m][1]);
                    const bool plain = pn < 4 || pn == 5 || pn == 7 || (pn == 4 && bj == 0);
                    if (plain) { *(u32x4*)(pb + (size_t)pn * BLKE + ((size_t)pm * 256 + rin) * 256 + cin) = w; }
                    else if (pn == 6) { const size_t row = (size_t)pm * 256 + rin; const int g = cin >> 4, hi0 = cin & 15;
                        *(u32x4*)(ug + ((size_t)g * MROWS + row) * 16 + hi0) = w;
                        *(u32x4*)(us + ((size_t)g * NCHUNK + (row >> 4)) * 512 + (row & 15) * 16 + hi0) = w; }
                    else {
                        *(LAS u32x4*)(sw + fr * 80 + fq * 16) = w;
                        asm volatile("" ::: "memory");
                        unsigned short e[8];
#pragma unroll
                        for (int i = 0; i < 8; ++i) e[i] = *(const LAS unsigned short*)(sw + (thalf * 8 + i) * 80 + tch * 2);
                        asm volatile("" ::: "memory");
                        u32x4 t; t.x = e[0] | ((unsigned)e[1] << 16); t.y = e[2] | ((unsigned)e[3] << 16); t.z = e[4] | ((unsigned)e[5] << 16); t.w = e[6] | ((unsigned)e[7] << 16);
                        const int chn = bj * pg8::HALF + wc * 32 + tch;
                        const int tok = jt + ai * pg8::HALF + wr * 64 + m * 16 + thalf * 8;
                        bf16_t* dst = (pn == 4) ? vtg + ((size_t)(bb * 2 + ((chn - 128) >> 6)) * 64 + ((chn - 128) & 63)) * NTOK + tok
                                                : hy0 + (size_t)(pn - 8) * BLKE + ((size_t)chn * 16 + bb) * NTOK + tok;
                        *(u32x4*)dst = t;
                    }
                    asm volatile("" ::: "memory");
                }
            }
    }
};

struct EpiP3 {
    static constexpr bool PERM = true, AFTER_DRAIN = false;
    PutPlain q; PutKm k; PutVt v; PutE e;
    __device__ __forceinline__ void operator()(const f32x4 (&acc)[2][2][4][2], const pg8::Unit& u, int wr, int wc, int fr, int fq) const {
#pragma unroll
        for (int ai = 0; ai < 2; ++ai)
#pragma unroll
            for (int m = 0; m < 4; ++m) {
                const int rin = ai * pg8::HALF + wr * 64 + m * 16 + fr;
#pragma unroll
                for (int bj = 0; bj < 2; ++bj) { const int cin = bj * pg8::HALF + wc * 32 + 8 * fq;
                    if (u.kd == 0) q.put(u.pm, u.pn, rin, cin, acc[ai][bj][m][0], acc[ai][bj][m][1]);
                    else if (u.kd == 1) k.put(u.pm, u.pn, rin, cin, acc[ai][bj][m][0], acc[ai][bj][m][1]);
                    else if (u.kd == 2) v.put(u.pm, u.pn, rin, cin, acc[ai][bj][m][0], acc[ai][bj][m][1]);
                    else e.put(u.pm, u.pn, rin, cin, acc[ai][bj][m][0], acc[ai][bj][m][1]);
                    asm volatile("" ::: "memory"); }
            }
    }
};

struct Params {
    const float* in[36];
    float* out;
    unsigned char* ws;
    int ph_lo, ph_hi, dry, pad;
};
enum { I_X = 0, I_C, I_CTX, I_CCTX, I_WMOD, I_BMOD, I_GPRE, I_GPOST, I_WIN, I_WOUT, I_GCQ, I_WUQ, I_GCKV, I_WUKV, I_GQ, I_GK,
       I_LRE, I_LIM, I_LSTEP, I_BRE, I_BIM, I_CRE, I_CIM, I_SSMD, I_GLUW, I_GLUB, I_HCW, I_HCB, I_HW1, I_HB1, I_HF1, I_HW2, I_HB2, I_HF2, I_HW3, I_HBIAS };

typedef __attribute__((address_space(4))) const unsigned long long* kargp_t;
struct Ctx {
    LAS unsigned char* lds;
    kargp_t ka;
    unsigned char* ws;
    int tid, lane, wave, G, bid, dry;
};
#define GAS __attribute__((address_space(1)))
#define KIN(i) ((const float*)(GAS const float*)c.ka[(i)])
#define KOUT() ((float*)(GAS float*)c.ka[36])
template <class T> __device__ __forceinline__ T* wsp(const Ctx& c, size_t off) { return (T*)(c.ws + off); }

__device__ __forceinline__ int wmap(int kind, int n) {
    if (kind == 0) { if (n < 192) return n; if (n < 224) return 320 + (n - 192); if (n < 256) return -1; if (n < 384) return 192 + (n - 256); if (n < 512) return -1; return n - 160; }
    if (kind == 2) return (n >> 6) * 128 + (n & 63);
    if (kind == 3) return (n >> 6) * 128 + 64 + (n & 63);
    return n;
}
__device__ __forceinline__ void wconv_tile(const Ctx& c, const float* src, int Ks, int Ns, int Nlim, bf16_t* dst, int Kp, int kind, int nt, int kt) {
    LAS float* T = (LAS float*)c.lds;
    const int n0 = nt * 64, k0 = kt * 128;
    const int nn = c.tid & 63, kk0 = c.tid >> 6; const int n = n0 + nn; const int sc = (n < Nlim) ? wmap(kind, n) : -1;
    float v[16];
#pragma unroll
    for (int i = 0; i < 16; ++i) { const int k = k0 + kk0 + 8 * i; v[i] = (k < Ks && sc >= 0) ? src[(size_t)k * Ns + sc] : 0.f; }
#pragma unroll
    for (int i = 0; i < 16; ++i) T[(kk0 + 8 * i) * 65 + nn] = v[i];
    __syncthreads();
#pragma unroll
    for (int i = 0; i < 2; ++i) { const int e = c.tid + i * 512, row = e >> 4, pc = e & 15; float x[8];
#pragma unroll
        for (int j = 0; j < 8; ++j) x[j] = T[(pc * 8 + j) * 65 + row];
        u32x4 w; w.x = cvt_pk_bf16(x[0], x[1]); w.y = cvt_pk_bf16(x[2], x[3]); w.z = cvt_pk_bf16(x[4], x[5]); w.w = cvt_pk_bf16(x[6], x[7]);
        *(u32x4*)(dst + (size_t)(n0 + row) * Kp + k0 + pc * 8) = w; }
    __syncthreads();
}

__device__ __forceinline__ void modv_job(const Ctx& c, int job) {
    const int l = job / 48, j0 = (job % 48) * 64;
    LAS float* sc = (LAS float*)c.lds;
    LAS float* red = sc + 17 * 1024;
    const float* cv = KIN(I_C); const float* cc = KIN(I_CCTX);
    for (int e = c.tid; e < 17 * 1024; e += 512) { const int r = e >> 10, k = e & 1023; const float v = (r < 16) ? cv[r * 1024 + k] : cc[k]; sc[e] = siluf(v); }
    __syncthreads();
    const int col = c.tid & 63, ks = c.tid >> 6;
    const float* w = KIN(I_WMOD) + (size_t)l * 1024 * 3072 + j0 + col;
    float acc[17];
#pragma unroll
    for (int r = 0; r < 17; ++r) acc[r] = 0.f;
    for (int k = ks * 128; k < ks * 128 + 128; ++k) { const float wv = w[(size_t)k * 3072];
#pragma unroll
        for (int r = 0; r < 17; ++r) acc[r] += sc[r * 1024 + k] * wv; }
#pragma unroll
    for (int r = 0; r < 17; ++r) red[(ks * 17 + r) * 64 + col] = acc[r];
    __syncthreads();
    float* mv = wsp<float>(c, WS_MODV);
    for (int e = c.tid; e < 17 * 64; e += 512) { const int r = e >> 6, cl = e & 63; float s = KIN(I_BMOD)[l * 3072 + j0 + cl];
#pragma unroll
        for (int q = 0; q < 8; ++q) s += red[(q * 17 + r) * 64 + cl];
        mv[((size_t)l * 17 + r) * 3072 + j0 + cl] = s; }
    __syncthreads();
}

__device__ __forceinline__ void rope_job(const Ctx& c) {
    float* rg = wsp<float>(c, WS_ROPEG); float* rm = wsp<float>(c, WS_ROPEM);
    for (int e = c.tid; e < 64 * 16; e += 512) { const int pos = e >> 4, f = e & 15; const float inv = powf(10000.f, -(float)(2 * f) / 32.f); const float a = (float)pos * inv; rg[e * 2] = cosf(a); rg[e * 2 + 1] = sinf(a); }
    for (int e = c.tid; e < 64 * 8; e += 512) { const int pos = e >> 3, f = e & 7; const float inv = powf(10000.f, -(float)(2 * f) / 16.f); const float a = (float)pos * inv; rm[e * 2] = cosf(a); rm[e * 2 + 1] = sinf(a); }
}

typedef float cpx __attribute__((ext_vector_type(2)));
#define CPX(a, b) ((cpx){(a), (b)})
__device__ __forceinline__ cpx cmul(cpx a, cpx b) { return CPX(a.x * b.x - a.y * b.y, a.x * b.y + a.y * b.x); }
__device__ __forceinline__ void ssm_tables_job(const Ctx& c, int job) {
    const int l = job >> 4, g = job & 15;
    LAS cpx* apow = (LAS cpx*)c.lds;
    LAS cpx* bbar = apow + 2 * 17 * 64;
    LAS cpx* cm = bbar + 2 * 64 * 16;
    LAS float* Kc = (LAS float*)(cm + 2 * 16 * 64);
    for (int e = c.tid; e < 2 * 64; e += 512) {
        const int d = e >> 6, p = e & 63; const size_t ix = (((size_t)l * 2 + d) * 16 + g) * 64 + p;
        const float lr = KIN(I_LRE)[ix], li = KIN(I_LIM)[ix], st = expf(KIN(I_LSTEP)[((size_t)l * 2 + d) * 16 + g]);
        for (int k = 0; k <= 16; ++k) { const float m = expf(lr * st * (float)k), an = li * st * (float)k; apow[(d * 17 + k) * 64 + p] = CPX(m * cosf(an), m * sinf(an)); }
    }
    __syncthreads();
    for (int e = c.tid; e < 2 * 64 * 16; e += 512) {
        const int d = e >> 10, p = (e >> 4) & 63, h = e & 15; const size_t ix = (((size_t)l * 2 + d) * 16 + g) * 64 + p;
        const float lr = KIN(I_LRE)[ix], li = KIN(I_LIM)[ix];
        const cpx a = apow[(d * 17 + 1) * 64 + p]; const cpx am1 = CPX(a.x - 1.f, a.y);
        const float den = lr * lr + li * li; const cpx q = CPX((am1.x * lr + am1.y * li) / den, (am1.y * lr - am1.x * li) / den);
        const cpx b = CPX(KIN(I_BRE)[ix * 16 + h], KIN(I_BIM)[ix * 16 + h]);
        bbar[e] = cmul(q, b);
        const size_t cx = ((((size_t)l * 2 + d) * 16 + g) * 16 + h) * 64 + p;
        cm[(d * 16 + h) * 64 + p] = CPX(KIN(I_CRE)[cx], KIN(I_CIM)[cx]);
    }
    __syncthreads();
    for (int e = c.tid; e < 2 * 16 * 256; e += 512) {
        const int d = e >> 12, dd = (e >> 8) & 15, ho = (e >> 4) & 15, hi = e & 15; float s = 0.f;
        for (int p = 0; p < 64; ++p) { const cpx w = cmul(cm[(d * 16 + ho) * 64 + p], apow[(d * 17 + dd) * 64 + p]); const cpx b = bbar[(d * 64 + p) * 16 + hi]; s += w.x * b.x - w.y * b.y; }
        Kc[e] = s;
    }
    __syncthreads();
    bf16_t* wkc = wsp<bf16_t>(c, WS_WKC) + ((size_t)l * 16 + g) * 256 * 512;
    for (int e = c.tid; e < 256 * 512; e += 512) {
        const int r = e >> 9, q = e & 511, i = r >> 4, ho = r & 15; float v;
        if (q < 256) { const int j = q >> 4, hi = q & 15; v = 0.f; if (j <= i) v += Kc[((0 * 16 + (i - j)) * 16 + ho) * 16 + hi]; if (j >= i) v += Kc[((1 * 16 + (j - i)) * 16 + ho) * 16 + hi]; }
        else { const int qq = q - 256, dq = qq >> 7, comp = (qq >> 6) & 1, p = qq & 63, k = dq == 0 ? i + 1 : 16 - i; const cpx w = cmul(cm[(dq * 16 + ho) * 64 + p], apow[(dq * 17 + k) * 64 + p]); v = comp == 0 ? w.x : -w.y; }
        wkc[e] = f2bf(v);
    }
    bf16_t* we = wsp<bf16_t>(c, WS_WE) + ((size_t)l * 16 + g) * 256 * 256;
    for (int e = c.tid; e < 256 * 256; e += 512) {
        const int qq = e >> 8, cidx = e & 255, j = cidx >> 4, hi = cidx & 15, dq = qq >> 7, comp = (qq >> 6) & 1, p = qq & 63, k = dq == 0 ? 15 - j : j;
        const cpx w = cmul(apow[(dq * 17 + k) * 64 + p], bbar[(dq * 64 + p) * 16 + hi]);
        we[e] = f2bf(comp == 0 ? w.x : w.y);
    }
    float* a16 = wsp<float>(c, WS_A16);
    for (int e = c.tid; e < 128; e += 512) { const int d = e >> 6, p = e & 63; const cpx a = apow[(d * 17 + 16) * 64 + p]; const size_t ix = ((((size_t)l * 2 + d) * 16 + g) * 64 + p) * 2; a16[ix] = a.x; a16[ix + 1] = a.y; }
    __syncthreads();
}

__device__ __forceinline__ void hyena_mlp_job(const Ctx& c, int job) {
    const int l = job / 136, tt = job % 136;
    const bool isctx = tt >= 128; const int n = isctx ? CTXL : SEQL; const int t0 = isctx ? (tt - 128) * 32 : tt * 32;
    LAS float* z = (LAS float*)c.lds;
    LAS float* h1 = z + 32 * 36;
    LAS float* h2 = h1 + 32 * 64;
    for (int e = c.tid; e < 32 * 33; e += 512) {
        const int ti = e / 33, f = e % 33, t = t0 + ti; float v;
        if (f == 0) v = (float)t / (float)(n - 1);
        else { const int k = (f - 1) & 15; const float band = 1e-4f + (float)k * ((15.f - 1e-4f) / 15.f); const float om = 6.283185307179586f * (float)t / (float)n; v = (f <= 16) ? cosf(band * om) : -sinf(band * om); }
        z[ti * 36 + f] = v;
    }
    __syncthreads();
    for (int e = c.tid; e < 32 * 64; e += 512) {
        const int ti = e >> 6, j = e & 63; float s = KIN(I_HB1)[l * 64 + j];
        for (int f = 0; f < 33; ++f) s += z[ti * 36 + f] * KIN(I_HW1)[((size_t)l * 33 + f) * 64 + j];
        h1[e] = sinf(KIN(I_HF1)[l * 64 + j] * s);
    }
    __syncthreads();
    for (int e = c.tid; e < 32 * 64; e += 512) {
        const int ti = e >> 6, j = e & 63; float s = KIN(I_HB2)[l * 64 + j];
        for (int f = 0; f < 64; ++f) s += h1[ti * 64 + f] * KIN(I_HW2)[((size_t)l * 64 + f) * 64 + j];
        h2[e] = sinf(KIN(I_HF2)[l * 64 + j] * s);
    }
    __syncthreads();
    float* hT = wsp<float>(c, WS_HT) + (size_t)l * 1024 * NTOK;
    const float mind = -3.070113457325394f, maxd = -15.35056728662697f;
#pragma unroll
    for (int cc = 0; cc < 2; ++cc) {
        const int col = c.tid + cc * 512;
        float acc[32];
#pragma unroll
        for (int ti = 0; ti < 32; ++ti) acc[ti] = 0.f;
        for (int f = 0; f < 64; ++f) { const float w = KIN(I_HW3)[((size_t)l * 64 + f) * 1024 + col];
#pragma unroll
            for (int ti = 0; ti < 32; ++ti) acc[ti] += h2[ti * 64 + f] * w; }
        const int ch = col & 255; const float delta = fabsf(mind + (maxd - mind) * (float)ch / 255.f);
        float* dst = hT + (size_t)col * NTOK + (isctx ? SEQL : 0) + t0;
#pragma unroll
        for (int ti = 0; ti < 32; ++ti) { const float tn = (float)(t0 + ti) / (float)(n - 1); dst[ti] = acc[ti] * expf(-tn * delta); }
    }
    __syncthreads();
}

__device__ __forceinline__ void hyena_pack_job(const Ctx& c, int job) {
    const int l = job >> 9, o = (job >> 8) & 1, ch = job & 255;
    const float* hT = wsp<float>(c, WS_HT) + (size_t)l * 1024 * NTOK;
    const float* fw = hT + (size_t)(o * 512 + ch) * NTOK; const float* bw = hT + (size_t)(o * 512 + 256 + ch) * NTOK;
    LAS float* red = (LAS float*)c.lds;
    float fa[8], ba[8];
#pragma unroll
    for (int k = 0; k < 8; ++k) { fa[k] = fw[c.tid + 512 * k]; ba[k] = bw[c.tid + 512 * k]; }
    const float fc = (c.tid < CTXL) ? fw[SEQL + c.tid] : 0.f, bc = (c.tid < CTXL) ? bw[SEQL + c.tid] : 0.f;
    float s0 = 0.f, s1 = fc * fc + bc * bc;
#pragma unroll
    for (int k = 0; k < 8; ++k) s0 += fa[k] * fa[k] + ba[k] * ba[k];
    s0 = wave_sum(s0); s1 = wave_sum(s1);
    if (c.lane == 0) { red[c.wave] = s0; red[8 + c.wave] = s1; }
    __syncthreads();
    float t0 = 0.f, t1 = 0.f;
#pragma unroll
    for (int w = 0; w < 8; ++w) { t0 += red[w]; t1 += red[8 + w]; }
    const float r0 = rsqrtf(t0 + EPS), r1 = rsqrtf(t1 + EPS);
    bf16_t* gr = wsp<bf16_t>(c, WS_GR) + (((size_t)l * 2 + o) * 256 + ch) * 8192;
#pragma unroll
    for (int k = 0; k < 8; ++k) { const int d = c.tid + 512 * k; gr[4095 - d] = f2bf(fa[k] * r0); if (d >= 1) gr[4095 + d] = f2bf(ba[k] * r0); }
    if (c.tid == 0) gr[8191] = 0;
    bf16_t* grc = wsp<bf16_t>(c, WS_GRC) + (((size_t)l * 2 + o) * 256 + ch) * 512;
    if (c.tid < CTXL) { const int d = c.tid; grc[255 - d] = f2bf(fc * r1); if (d >= 1) grc[255 + d] = f2bf(bc * r1); }
    if (c.tid == 0) grc[511] = 0;
    __syncthreads();
}

__device__ __forceinline__ void norm_rows(const Ctx& c, int l  , int next  , int r0 = -1  , int r1 = 0) {
    const float* mvl = wsp<float>(c, WS_MODV) + (size_t)(l < 0 ? 0 : l) * 17 * 3072;
    const float* mvn = wsp<float>(c, WS_MODV) + (size_t)(next < 0 ? 0 : next) * 17 * 3072;
    const bf16_t* outb = wsp<bf16_t>(c, WS_OUTB);
    bf16_t* hb = wsp<bf16_t>(c, WS_HCAT);
    float* ctxr = wsp<float>(c, WS_CTXR);
    const float* xin0 = KIN(I_X); const float* cin0 = KIN(I_CTX); float* outp = KOUT();
    const float* gpost = KIN(I_GPOST) + (l < 0 ? 0 : l) * DM; const float* gpre = KIN(I_GPRE) + (next < 0 ? 0 : next) * DM;
    const int nw = c.G * 8, lane4 = c.lane * 4;
    const int rb0 = r0 >= 0 ? r0 + c.wave * 2 : (c.bid * 8 + c.wave) * 2, rbe = r0 >= 0 ? r1 : MROWS, rbs = r0 >= 0 ? 16 : nw * 2;
    for (int rowb = rb0; rowb < rbe; rowb += rbs) {
        f32x4 xv[2][4]; u32x2 ow[2][4]; const float* xin[2]; float* xout[2]; int mr[2]; bool live[2], isc[2];
#pragma unroll
        for (int rr = 0; rr < 2; ++rr) {
            const int row = rowb + rr, b = row / NTOK, j = row - b * NTOK; isc[rr] = j >= SEQL; live[rr] = !(next < 0 && isc[rr]); mr[rr] = isc[rr] ? 16 : b;
            if (isc[rr]) { xout[rr] = ctxr + ((size_t)b * CTXL + (j - SEQL)) * DM; xin[rr] = (l < 0) ? cin0 + ((size_t)b * CTXL + (j - SEQL)) * DM : xout[rr]; }
            else { xout[rr] = outp + ((size_t)b * SEQL + j) * DM; xin[rr] = (l <= 0) ? xin0 + ((size_t)b * SEQL + j) * DM : xout[rr]; }
#pragma unroll
            for (int q = 0; q < 4; ++q) { xv[rr][q] = __builtin_nontemporal_load((const f32x4*)(xin[rr] + q * 256 + lane4)); if (l >= 0) ow[rr][q] = *(const u32x2*)(outb + (size_t)row * DM + q * 256 + lane4); }
        }
#pragma unroll
        for (int rr = 0; rr < 2; ++rr) {
            if (!live[rr]) continue;
            const int row = rowb + rr;
            if (l >= 0) {
                float ov[16]; float ss = 0.f;
#pragma unroll
                for (int q = 0; q < 4; ++q) { ov[q * 4] = lo_bf(ow[rr][q].x); ov[q * 4 + 1] = hi_bf(ow[rr][q].x); ov[q * 4 + 2] = lo_bf(ow[rr][q].y); ov[q * 4 + 3] = hi_bf(ow[rr][q].y); }
#pragma unroll
                for (int i = 0; i < 16; ++i) ss += ov[i] * ov[i];
                ss = wave_sum(ss); const float rs = rsqrtf(ss * (1.f / DM) + EPS);
#pragma unroll
                for (int q = 0; q < 4; ++q) { const int col = q * 256 + lane4; const f32x4 gp = *(const f32x4*)(gpost + col); const f32x4 gt = *(const f32x4*)(mvl + mr[rr] * 3072 + 2048 + col);
#pragma unroll
                    for (int i = 0; i < 4; ++i) xv[rr][q][i] += gt[i] * (ov[q * 4 + i] * rs * gp[i]); }
            }
            if ((l >= 0 || isc[rr]) && !c.dry) {
#pragma unroll
                for (int q = 0; q < 4; ++q) __builtin_nontemporal_store(xv[rr][q], (f32x4*)(xout[rr] + q * 256 + lane4));
            }
            if (next >= 0) {
                float ss = 0.f;
#pragma unroll
                for (int q = 0; q < 4; ++q)
#pragma unroll
                    for (int i = 0; i < 4; ++i) ss += xv[rr][q][i] * xv[rr][q][i];
                ss = wave_sum(ss); const float rs = rsqrtf(ss * (1.f / DM) + EPS);
#pragma unroll
                for (int q = 0; q < 4; ++q) { const int col = q * 256 + lane4; const f32x4 gp = *(const f32x4*)(gpre + col);
                    const f32x4 sh = *(const f32x4*)(mvn + mr[rr] * 3072 + col), sc = *(const f32x4*)(mvn + mr[rr] * 3072 + 1024 + col);
                    float hv[4];
#pragma unroll
                    for (int i = 0; i < 4; ++i) hv[i] = xv[rr][q][i] * rs * gp[i] * (1.f + sc[i]) + sh[i];
                    u32x2 w; w.x = cvt_pk_bf16(hv[0], hv[1]); w.y = cvt_pk_bf16(hv[2], hv[3]); *(u32x2*)(hb + (size_t)row * DM + col) = w; }
            }
        }
    }
}

__device__ __forceinline__ void p2_rows(const Ctx& c, int l) {
    bf16_t* pb = wsp<bf16_t>(c, WS_PB);
    bf16_t* B0 = pb; bf16_t* B1 = pb + BLKE; bf16_t* B3 = pb + 3 * BLKE; const bf16_t* B4 = pb + 4 * BLKE;
    bf16_t* kr = wsp<bf16_t>(c, WS_KR); bf16_t* kg = wsp<bf16_t>(c, WS_KG); bf16_t* ug = wsp<bf16_t>(c, WS_UG); bf16_t* us = wsp<bf16_t>(c, WS_US);
    const float* ropeG = wsp<float>(c, WS_ROPEG); const float* ropeM = wsp<float>(c, WS_ROPEM);
    const int lane = c.lane;
    const f32x4 gcq = (lane < 48) ? *(const f32x4*)(KIN(I_GCQ) + l * 192 + lane * 4) : (f32x4){0.f, 0.f, 0.f, 0.f};
    const f32x4 gckv = (lane < 32) ? *(const f32x4*)(KIN(I_GCKV) + l * 128 + lane * 4) : (f32x4){0.f, 0.f, 0.f, 0.f};
    const f32x4 gq = *(const f32x4*)(KIN(I_GQ) + l * 64 + (lane & 15) * 4), gk = *(const f32x4*)(KIN(I_GK) + l * 64 + (lane & 15) * 4);
    for (int rowb = (c.bid * 8 + c.wave) * 4; rowb < MROWS; rowb += c.G * 8 * 4) {
        u32x2 w0[4], w1[4], w3[4], w4[4];
#pragma unroll
        for (int rr = 0; rr < 4; ++rr) { const size_t ro = (size_t)(rowb + rr) * 256 + lane * 4;
            w0[rr] = *(const u32x2*)(B0 + ro); w1[rr] = *(const u32x2*)(B1 + ro); w3[rr] = *(const u32x2*)(B3 + ro); w4[rr] = *(const u32x2*)(B4 + ro); }
#pragma unroll
        for (int rr = 0; rr < 4; ++rr) {
            const int row = rowb + rr;
            const int b = row / NTOK, j = row - b * NTOK; const bool islat = j < SEQL; const int rowpos = (j >> 6) & 63, colpos = j & 63;
            const size_t ro = (size_t)row * 256 + lane * 4;
            {
                const u32x2 w = w0[rr]; float x[4] = {lo_bf(w.x), hi_bf(w.x), lo_bf(w.y), hi_bf(w.y)};
                float ss = (lane < 48) ? (x[0] * x[0] + x[1] * x[1] + x[2] * x[2] + x[3] * x[3]) : 0.f; ss = wave_sum(ss);
                const float rs = rsqrtf(ss * (1.f / 192.f) + EPS);
                float xp[4];
#pragma unroll
                for (int i = 0; i < 4; ++i) xp[i] = swz_xor<2>(x[i]);
                u32x2 o; o.x = 0u; o.y = 0u;
                if (lane < 48) { o.x = cvt_pk_bf16(x[0] * rs * gcq[0], x[1] * rs * gcq[1]); o.y = cvt_pk_bf16(x[2] * rs * gcq[2], x[3] * rs * gcq[3]); }
                else if (lane < 56) {
                    const int t = lane - 48; float y[4];
                    if (islat) { const int pos = (t & 4) ? colpos : rowpos; const bool isx2 = (t & 2) != 0;
#pragma unroll
                        for (int i = 0; i < 4; ++i) { const int f = 4 * (t & 1) + i; const float cs = ropeM[(pos * 8 + f) * 2], sn = ropeM[(pos * 8 + f) * 2 + 1]; y[i] = isx2 ? (xp[i] * sn + x[i] * cs) : (x[i] * cs - xp[i] * sn); } }
                    else {
#pragma unroll
                        for (int i = 0; i < 4; ++i) y[i] = x[i]; }
                    u32x2 kk; kk.x = cvt_pk_bf16(y[0], y[1]); kk.y = cvt_pk_bf16(y[2], y[3]); *(u32x2*)(kr + (size_t)row * 32 + t * 4) = kk;
                }
                if (!c.dry) *(u32x2*)(B0 + ro) = o;
            }
            {
                const u32x2 w = w1[rr]; float x[4] = {lo_bf(w.x), hi_bf(w.x), lo_bf(w.y), hi_bf(w.y)};
                float ss = (lane < 32) ? (x[0] * x[0] + x[1] * x[1] + x[2] * x[2] + x[3] * x[3]) : 0.f; ss = wave_sum(ss);
                const float rs = rsqrtf(ss * (1.f / 128.f) + EPS);
                u32x2 o; o.x = 0u; o.y = 0u;
                if (lane < 32) { o.x = cvt_pk_bf16(x[0] * rs * gckv[0], x[1] * rs * gckv[1]); o.y = cvt_pk_bf16(x[2] * rs * gckv[2], x[3] * rs * gckv[3]); }
                if (!c.dry) *(u32x2*)(B1 + ro) = o;
            }
#pragma unroll
            for (int which = 0; which < 2; ++which) {
                const u32x2 w = which == 0 ? w3[rr] : w4[rr]; float x[4] = {lo_bf(w.x), hi_bf(w.x), lo_bf(w.y), hi_bf(w.y)};
                float ss = x[0] * x[0] + x[1] * x[1] + x[2] * x[2] + x[3] * x[3];
                ss += swz_xor<1>(ss); ss += swz_xor<2>(ss); ss += swz_xor<4>(ss); ss += swz_xor<8>(ss);
                const float rs = rsqrtf(ss * (1.f / 64.f) + EPS);
                const int t = lane & 15; const f32x4 g = which == 0 ? gq : gk;
#pragma unroll
                for (int i = 0; i < 4; ++i) x[i] = x[i] * rs * g[i];
                float xp[4];
#pragma unroll
                for (int i = 0; i < 4; ++i) xp[i] = swz_xor<4>(x[i]);
                if (islat) { const int pos = (t & 8) ? colpos : rowpos; const bool isx2 = (t & 4) != 0;
#pragma unroll
                    for (int i = 0; i < 4; ++i) { const int f = 4 * (t & 3) + i; const float cs = ropeG[(pos * 16 + f) * 2], sn = ropeG[(pos * 16 + f) * 2 + 1]; x[i] = isx2 ? (xp[i] * sn + x[i] * cs) : (x[i] * cs - xp[i] * sn); } }
                if (which == 0) { const float qs = 0.125f * LOG2E; u32x2 o; o.x = cvt_pk_bf16(x[0] * qs, x[1] * qs); o.y = cvt_pk_bf16(x[2] * qs, x[3] * qs); if (!c.dry) *(u32x2*)(B3 + ro) = o; }
                else if (lane < 32) { u32x2 o; o.x = cvt_pk_bf16(x[0], x[1]); o.y = cvt_pk_bf16(x[2], x[3]); *(u32x2*)(kg + ((size_t)(b * 2 + (lane >> 4)) * NTOK + j) * 64 + t * 4) = o; }
            }
        }
    }
}
#ifndef PROBE_ABL
#define PROBE_ABL 0
#endif
#ifndef PROBE_GQAONLY
#define PROBE_GQAONLY 0
#endif
template <int DK, bool SUB, bool NOMAX = false, int ABL = 0>
__device__ __forceinline__ bool attn_unit(float (&rowmax)[2], const Ctx& c, const bf16_t* Qp, int qpitch, const bf16_t* Kp, const bf16_t* Vtp, int kt0, int nkt, int nrows,
                                          const bf16_t* gatep, bf16_t* outp, bool rope, int j0, float qscale, const float* ropeM) {
    constexpr int KS = DK / 16, KPC = DK / 8, KPITCH = DK * 2 + 16, KB = 64 * KPITCH, VPITCH = 136, VB = 64 * VPITCH;
    constexpr int KOFF = 0, VOFF = 3 * KB;
    constexpr float LIM = 60.f;
    static_assert(KB % 16 == 0 && VB % 16 == 0, "attention LDS buffer alignment");
    const int tid = c.tid, lane = c.lane, wave = c.wave;
    const int lq_ = opaque(lane), q = lq_ & 31, h = lq_ >> 5;
    LAS unsigned char* lds = c.lds;
    const int rbase = (wave * 64 < nrows) ? wave * 64 : wave * 64 - 256;
    const bool live = wave * 64 < nrows;
    bf16x8 qf[2][KS];
#pragma unroll
    for (int qt = 0; qt < 2; ++qt) {
        const bf16_t* qrow = Qp + (size_t)(rbase + qt * 32 + q) * qpitch + 8 * h;
#pragma unroll
        for (int ks = 0; ks < KS; ++ks) qf[qt][ks] = *(const bf16x8*)(qrow + 16 * ks);
        if (DK == 96) {
            const int jj = j0 + rbase + qt * 32 + q;
#pragma unroll
            for (int ks = 0; ks < KS; ++ks) {
                float x[8]; unpack8(__builtin_bit_cast(u32x4, qf[qt][ks]), x);
                if (ks >= 4) {
                    const int pos = (ks == 4) ? ((jj >> 6) & 63) : (jj & 63);
#pragma unroll
                    for (int e = 0; e < 8; ++e) { const float xp = half_other(x[e], h); const float cs = ropeM[(pos * 8 + e) * 2], sn = ropeM[(pos * 8 + e) * 2 + 1];
                        const float r = h ? (xp * sn + x[e] * cs) : (x[e] * cs - xp * sn); x[e] = rope ? r : x[e]; }
                }
                u32x4 w; w.x = cvt_pk_bf16(x[0] * qscale, x[1] * qscale); w.y = cvt_pk_bf16(x[2] * qscale, x[3] * qscale); w.z = cvt_pk_bf16(x[4] * qscale, x[5] * qscale); w.w = cvt_pk_bf16(x[6] * qscale, x[7] * qscale);
                qf[qt][ks] = __builtin_bit_cast(bf16x8, w);
            }
        }
    }
    f32x16 o00, o01, o10, o11;
#pragma unroll
    for (int i = 0; i < 16; ++i) { o00[i] = 0.f; o01[i] = 0.f; o10[i] = 0.f; o11[i] = 0.f; }
    const float m0 = SUB ? rowmax[0] : 0.f, m1 = SUB ? rowmax[1] : 0.f; float l0 = 0.f, l1 = 0.f;
    float rmax0 = -1e30f, rmax1 = -1e30f;
    const int tq_ = opaque(tid);
    const int kst0 = (tq_ / KPC) * KPITCH + (tq_ % KPC) * 16, kst1 = ((tq_ + 512) / KPC) * KPITCH + ((tq_ + 512) % KPC) * 16;
    const int kgl0 = ((tq_ / KPC) * DK + (tq_ % KPC) * 8) * 2, kgl1 = (((tq_ + 512) / KPC) * DK + ((tq_ + 512) % KPC) * 8) * 2;
    const int vst = (tq_ >> 3) * VPITCH + (tq_ & 7) * 16, vgl = ((tq_ >> 3) * NTOK + (tq_ & 7) * 8) * 2;
    const bool has2 = (DK == 96) && tq_ < 256;
    const int kfo = q * KPITCH + 16 * h, vfo = q * VPITCH + 8 * h;
    const char* Kc = (const char*)Kp; const char* Vc = (const char*)Vtp;
    u32x4 kreg0, kreg1 = {0u, 0u, 0u, 0u}, vreg;
#define AT_GLOADK(kt) do { if (ABL & 1) break; const char* kb_ = Kc + (size_t)(kt) * (64 * DK * 2); kreg0 = *(const u32x4*)(kb_ + kgl0); if (has2) kreg1 = *(const u32x4*)(kb_ + kgl1); } while (0)
#define AT_GLOADV(kt) do { if (ABL & 1) break; vreg = *(const u32x4*)(Vc + (size_t)(kt) * 128 + vgl); } while (0)
#define AT_WRITEK(bi) do { if (ABL & 1) break; LAS unsigned char* bb = lds + KOFF + (bi) * KB; *(LAS u32x4*)(bb + kst0) = kreg0; if (has2) *(LAS u32x4*)(bb + kst1) = kreg1; } while (0)
#define AT_WRITEV(bi) do { if (ABL & 1) break; LAS u32x2* vd = (LAS u32x2*)(lds + VOFF + (bi) * VB + vst); vd[0] = (u32x2){vreg.x, vreg.y}; vd[1] = (u32x2){vreg.z, vreg.w}; } while (0)
#define AT_KPRE(bi, jh) do { if (KPRE) { const LAS unsigned char* kb_ = lds + KOFF + (bi) * KB + (jh) * 32 * KPITCH + kfo; \
        _Pragma("unroll") for (int ks = 0; ks < KS; ++ks) kf[ks] = *(const LAS bf16x8*)(kb_ + 32 * ks); } } while (0)
#define AT_QK(S0, S1, bi, jh) do { const LAS unsigned char* kb = lds + KOFF + (bi) * KB + (jh) * 32 * KPITCH + kfo; \
        _Pragma("unroll") for (int i = 0; i < 16; ++i) { S0[i] = 0.f; S1[i] = 0.f; } \
        if (!(ABL & 8)) _Pragma("unroll") for (int ks = 0; ks < KS; ++ks) { \
            const bf16x8 a0 = KPRE ? kf[ks] : *(const LAS bf16x8*)(kb + 32 * ks); \
            S0 = __builtin_amdgcn_mfma_f32_32x32x16_bf16(a0, qf[0][ks], S0, 0, 0, 0); \
            S1 = __builtin_amdgcn_mfma_f32_32x32x16_bf16(a0, qf[1][ks], S1, 0, 0, 0); } } while (0)
#define AT_MAX(S, RM) do { if (!SUB && !NOMAX) { _Pragma("unroll") for (int i = 0; i < 16; i += 2) RM = max3_raw(RM, S[i], S[i + 1]); } } while (0)
#define AT_EXP(S, M, L, PK0, PK1) do { float ps = 0.f; \
        _Pragma("unroll") for (int i = 0; i < 16; ++i) { S[i] = (ABL & 2) ? S[i] * 0.001f : __builtin_amdgcn_exp2f(SUB ? S[i] - M : S[i]); ps += S[i]; } \
        L += ps; u32x4 w; \
        w.x = cvt_pk_bf16(S[0], S[1]); w.y = cvt_pk_bf16(S[2], S[3]); w.z = cvt_pk_bf16(S[4], S[5]); w.w = cvt_pk_bf16(S[6], S[7]); PK0 = __builtin_bit_cast(bf16x8, w); \
        w.x = cvt_pk_bf16(S[8], S[9]); w.y = cvt_pk_bf16(S[10], S[11]); w.z = cvt_pk_bf16(S[12], S[13]); w.w = cvt_pk_bf16(S[14], S[15]); PK1 = __builtin_bit_cast(bf16x8, w); } while (0)
#define AT_VLOAD() do { la0 = *(const LAS u32x2*)(vb); ha0 = *(const LAS u32x2*)(vb + 16); lb0 = *(const LAS u32x2*)(vb + 32 * VPITCH); hb0 = *(const LAS u32x2*)(vb + 32 * VPITCH + 16); \
        la1 = *(const LAS u32x2*)(vb + 32); ha1 = *(const LAS u32x2*)(vb + 48); lb1 = *(const LAS u32x2*)(vb + 32 * VPITCH + 32); hb1 = *(const LAS u32x2*)(vb + 32 * VPITCH + 48); } while (0)
#define AT_SUB(SC0, SC1, SN0, SN1, vbi, jh, nbi, njh) do { \
          \
        const LAS unsigned char* vb = lds + VOFF + (vbi) * VB + (jh) * 64 + vfo; \
        u32x2 la0, ha0, lb0, hb0, la1, ha1, lb1, hb1; \
        if (DK == 64) { AT_VLOAD(); }        \
        AT_MAX(SC0, rmax0); AT_MAX(SC1, rmax1); \
        AT_QK(SN0, SN1, nbi, njh); \
        bf16x8 p00, p01, p10, p11; \
        AT_EXP(SC0, m0, l0, p00, p01); AT_EXP(SC1, m1, l1, p10, p11); \
        if (DK != 64) { AT_VLOAD(); } \
        if (!(ABL & 4)) { \
            const bf16x8 va00 = __builtin_bit_cast(bf16x8, (u32x4){la0.x, la0.y, ha0.x, ha0.y}), va10 = __builtin_bit_cast(bf16x8, (u32x4){lb0.x, lb0.y, hb0.x, hb0.y}); \
            const bf16x8 va01 = __builtin_bit_cast(bf16x8, (u32x4){la1.x, la1.y, ha1.x, ha1.y}), va11 = __builtin_bit_cast(bf16x8, (u32x4){lb1.x, lb1.y, hb1.x, hb1.y}); \
            o00 = __builtin_amdgcn_mfma_f32_32x32x16_bf16(va00, p00, o00, 0, 0, 0); \
            o01 = __builtin_amdgcn_mfma_f32_32x32x16_bf16(va10, p00, o01, 0, 0, 0); \
            o10 = __builtin_amdgcn_mfma_f32_32x32x16_bf16(va00, p10, o10, 0, 0, 0); \
            o11 = __builtin_amdgcn_mfma_f32_32x32x16_bf16(va10, p10, o11, 0, 0, 0); \
            o00 = __builtin_amdgcn_mfma_f32_32x32x16_bf16(va01, p01, o00, 0, 0, 0); \
            o01 = __builtin_amdgcn_mfma_f32_32x32x16_bf16(va11, p01, o01, 0, 0, 0); \
            o10 = __builtin_amdgcn_mfma_f32_32x32x16_bf16(va01, p11, o10, 0, 0, 0); \
            o11 = __builtin_amdgcn_mfma_f32_32x32x16_bf16(va11, p11, o11, 0, 0, 0); } \
        if (ABL & 4) { asm volatile("" :: "v"(p00), "v"(p01), "v"(p10), "v"(p11), "v"(la0), "v"(ha0), "v"(lb0), "v"(hb0), "v"(la1), "v"(ha1), "v"(lb1), "v"(hb1)); } \
        } while (0)
    if (!SUB && !NOMAX && tid == 0) *(volatile LAS unsigned*)(lds + LDS_MISC_OFF + 24) = 0u;
    AT_GLOADK(kt0); AT_GLOADV(kt0); AT_WRITEK(0); AT_WRITEV(0);
    AT_GLOADK(kt0 + 1); AT_WRITEK(1);
    __syncthreads();
    f32x16 sa0, sa1, sb0, sb1;
    constexpr bool KPRE = (DK == 64);
    bf16x8 kf[KS];
    AT_KPRE(0, 0);
    AT_QK(sa0, sa1, 0, 0);
    AT_KPRE(0, 1);
    int kb0 = 0, kb1 = 1, kb2 = 2;
    for (int t = 0; t < nkt; ++t) {
        const int tk = (t + 2 < nkt) ? t + 2 : nkt - 1, tv = (t + 1 < nkt) ? t + 1 : nkt - 1;
        AT_GLOADK(kt0 + tk);
        AT_SUB(sa0, sa1, sb0, sb1, t & 1, 0, kb0, 1);
        AT_KPRE(kb1, 0);
        AT_WRITEK(kb2);
        AT_GLOADV(kt0 + tv);
        AT_SUB(sb0, sb1, sa0, sa1, t & 1, 1, kb1, 0);
        AT_KPRE(kb1, 1);
        AT_WRITEV((t + 1) & 1);
        if (!(ABL & 16)) __syncthreads();
        const int tmp = kb0; kb0 = kb1; kb1 = kb2; kb2 = tmp;
    }
#undef AT_GLOADK
#undef AT_GLOADV
#undef AT_WRITEK
#undef AT_WRITEV
#undef AT_QK
#undef AT_KPRE
#undef AT_MAX
#undef AT_EXP
#undef AT_SUB
#undef AT_VLOAD
    bool bad = false;
    if (!SUB && !NOMAX) { const float r0 = half_max(rmax0), r1 = half_max(rmax1); rowmax[0] = r0; rowmax[1] = r1; const bool b_ = live && !(r0 < LIM && r0 > -LIM && r1 < LIM && r1 > -LIM); volatile LAS unsigned* flg = (volatile LAS unsigned*)(lds + LDS_MISC_OFF + 24); if (__any(b_ ? 1 : 0) && opaque(lane) == 0) *flg = 1u; __syncthreads(); bad = *flg != 0u; __syncthreads(); }
    if (live && !bad) {
        const int le_ = opaque(lane), q = le_ & 31, h = le_ >> 5;
#pragma unroll
        for (int qt = 0; qt < 2; ++qt) {
            const float lr = qt ? l1 : l0; const float lt = half_sum(lr), inv = 1.f / lt;
            const size_t row = (size_t)(rbase + qt * 32 + q);
#pragma unroll
            for (int dt = 0; dt < 2; ++dt)
#pragma unroll
                for (int g4 = 0; g4 < 4; ++g4) {
                    const int dv0 = dt * 32 + 8 * g4 + 4 * h;
                    const u32x2 gw = *(const u32x2*)(gatep + row * 256 + dv0);
                    const float g0 = siluf(lo_bf(gw.x)), g1 = siluf(hi_bf(gw.x)), g2 = siluf(lo_bf(gw.y)), g3 = siluf(hi_bf(gw.y));
                    const f32x16& o = qt ? (dt ? o11 : o10) : (dt ? o01 : o00);
                    u32x2 w; w.x = cvt_pk_bf16(o[4 * g4] * inv * g0, o[4 * g4 + 1] * inv * g1); w.y = cvt_pk_bf16(o[4 * g4 + 2] * inv * g2, o[4 * g4 + 3] * inv * g3);
                    *(u32x2*)(outp + row * DM + dv0) = w;
                }
        }
    }
    return bad;
}

template <int N>
__device__ __forceinline__ void hyena_conv(const Ctx& c, LAS unsigned char* ub, LAS unsigned char* gb, int pass, const bf16_t* xmul  , float bias,
                                           bf16_t* zdst  , const bf16_t* gmul, bf16_t* cat  , float cw0, float cw1, float cw2, float cb  ) {
    constexpr int UP = (N + 256) * 2 + 16, NPAIR = N / 256, OFF8 = N - 8;
    const int lane = c.lane, i16 = lane & 15, kq = lane >> 4;
    for (int pr = c.wave; pr < NPAIR; pr += 8) {
        const int t0 = pr * 256;
        u32x4 xq[2][4], gq[2][4]; bf16_t xl[2][4], xr[2][4];
#pragma unroll
        for (int half = 0; half < 2; ++half)
#pragma unroll
            for (int r = 0; r < 4; ++r) { const int t8 = t0 + half * 128 + 32 * kq + 8 * r; const bf16_t* xp_ = xmul + (size_t)i16 * NTOK + t8; xq[half][r] = *(const u32x4*)xp_;
                xl[half][r] = (t8 > 0) ? xp_[-1] : (bf16_t)0; xr[half][r] = (t8 + 8 < N) ? xp_[8] : (bf16_t)0;
                gq[half][r] = (pass == 1) ? *(const u32x4*)(gmul + (size_t)i16 * NTOK + t8) : (u32x4){0u, 0u, 0u, 0u}; }
        f32x4 acc[2][8];
#pragma unroll
        for (int m = 0; m < 8; ++m) { acc[0][m] = (f32x4){0.f, 0.f, 0.f, 0.f}; acc[1][m] = (f32x4){0.f, 0.f, 0.f, 0.f}; }
        const LAS unsigned char* up = ub + i16 * UP + 256 + kq * 16;
        const LAS unsigned char* gp = gb + (OFF8 - t0 - 8 * i16 + 8 * kq) * 2;
        bf16x8 bfa = *(const LAS bf16x8*)(up - 256), bfb = *(const LAS bf16x8*)(up);
        u32x4 wa = *(const LAS u32x4*)(gp - 256), wb = *(const LAS u32x4*)(gp - 256 + 16);
        for (int s0 = -128; s0 < N; s0 += 32) {
            const int sn = (s0 + 32 < N) ? s0 + 32 : s0;
            const bf16x8 bfan = *(const LAS bf16x8*)(up + sn * 2), bfbn = *(const LAS bf16x8*)(up + sn * 2 + 256);
            const u32x4 wan = *(const LAS u32x4*)(gp + sn * 2), wbn = *(const LAS u32x4*)(gp + sn * 2 + 16);
            const unsigned w[8] = {wa.x, wa.y, wa.z, wa.w, wb.x, wb.y, wb.z, wb.w};
            unsigned sh[7];
#pragma unroll
            for (int k = 0; k < 7; ++k) sh[k] = __builtin_amdgcn_alignbit(w[k + 1], w[k], 16);
#pragma unroll
            for (int m = 0; m < 8; ++m) {
                u32x4 a;
                if (m & 1) { const int d0 = (7 - m) >> 1; a = (u32x4){w[d0], w[d0 + 1], w[d0 + 2], w[d0 + 3]}; }
                else { const int d0 = (6 - m) >> 1; a = (u32x4){sh[d0], sh[d0 + 1], sh[d0 + 2], sh[d0 + 3]}; }
                acc[0][m] = __builtin_amdgcn_mfma_f32_16x16x32_bf16(__builtin_bit_cast(bf16x8, a), bfa, acc[0][m], 0, 0, 0);
                acc[1][m] = __builtin_amdgcn_mfma_f32_16x16x32_bf16(__builtin_bit_cast(bf16x8, a), bfb, acc[1][m], 0, 0, 0);
            }
            bfa = bfan; bfb = bfbn; wa = wan; wb = wbn;
        }
#pragma unroll
        for (int half = 0; half < 2; ++half)
#pragma unroll
            for (int r = 0; r < 4; ++r) {
                const int t8 = t0 + half * 128 + 32 * kq + 8 * r;
                float uu[8], xr8[8], xm[8]; unpack8(*(const LAS u32x4*)(ub + i16 * UP + 256 + t8 * 2), uu); unpack8(xq[half][r], xr8);
                {   float pv = bf2f(xl[half][r]);
#pragma unroll
                    for (int m = 0; m < 8; ++m) { const float nx = (m < 7) ? xr8[m + 1] : bf2f(xr[half][r]); xm[m] = bf2f(f2bf(cw0 * pv + cw1 * xr8[m] + cw2 * nx + cb)); pv = xr8[m]; } }
                float y[8];
#pragma unroll
                for (int m = 0; m < 8; ++m) y[m] = xm[m] * (acc[half][m][r] + bias * uu[m]);
                if (pass == 0) { u32x4 o; o.x = cvt_pk_bf16(y[0], y[1]); o.y = cvt_pk_bf16(y[2], y[3]); o.z = cvt_pk_bf16(y[4], y[5]); o.w = cvt_pk_bf16(y[6], y[7]); *(u32x4*)(zdst + (size_t)i16 * NTOK + t8) = o; }
                else { float gg[8]; unpack8(gq[half][r], gg);
#pragma unroll
                    for (int m = 0; m < 8; ++m) gg[m] = bf2f(f2bf(siluf(gg[m])));
                    u32x4 o; o.x = cvt_pk_bf16(y[0] * gg[0], y[1] * gg[1]); o.y = cvt_pk_bf16(y[2] * gg[2], y[3] * gg[3]); o.z = cvt_pk_bf16(y[4] * gg[4], y[5] * gg[5]); o.w = cvt_pk_bf16(y[6] * gg[6], y[7] * gg[7]);
                    *(u32x4*)(cat + (size_t)i16 * NTOK + t8) = o; }
            }
    }
}
template <int N>
__device__ __forceinline__ void hyena_seq(const Ctx& c, int l, int ch, int toff) {
    constexpr int UP = (N + 256) * 2 + 16;
    LAS unsigned char* ub = c.lds; LAS unsigned char* gb = c.lds + 16 * UP;
    const bf16_t* vv = wsp<bf16_t>(c, WS_HYV) + (size_t)ch * 16 * NTOK + toff;
    bf16_t* vz = wsp<bf16_t>(c, WS_HYZ) + (size_t)ch * 16 * NTOK + toff;
    const bf16_t* x1 = wsp<bf16_t>(c, WS_HYX1) + (size_t)ch * 16 * NTOK + toff;
    const bf16_t* x2 = wsp<bf16_t>(c, WS_HYX2) + (size_t)ch * 16 * NTOK + toff;
    const bf16_t* gm = wsp<bf16_t>(c, WS_HYG) + (size_t)ch * 16 * NTOK + toff;
    bf16_t* cat = wsp<bf16_t>(c, WS_HYY) + (size_t)ch * 16 * NTOK + toff;
    { const int e = c.tid, b = e >> 5, side = (e >> 4) & 1, pc = e & 15; unsigned z = 0u; asm volatile("" : "+v"(z)); *(LAS u32x4*)(ub + b * UP + side * (256 + N * 2) + pc * 16) = (u32x4){z, z, z, z}; }
    for (int pass = 0; pass < 2; ++pass) {
        const bf16_t* gr = (N == SEQL) ? wsp<bf16_t>(c, WS_GR) + (((size_t)l * 2 + pass) * 256 + ch) * 8192 : wsp<bf16_t>(c, WS_GRC) + (((size_t)l * 2 + pass) * 256 + ch) * 512;
        const bf16_t* usrc = pass == 0 ? vv : vz;
        constexpr int NG = (2 * N / 8 + 511) / 512;
        {
            u32x4 t[NG];
#pragma unroll
            for (int k = 0; k < NG; ++k) { const int e = c.tid + k * 512; t[k] = (e < 2 * N / 8) ? *(const u32x4*)(gr + e * 8) : (u32x4){0u, 0u, 0u, 0u}; }
#pragma unroll
            for (int k = 0; k < NG; ++k) { const int e = c.tid + k * 512; if (e < 2 * N / 8) *(LAS u32x4*)(gb + e * 16) = t[k]; }
        }
        if constexpr (N == SEQL) {
#pragma unroll
            for (int k0 = 0; k0 < 16; k0 += 8) {
                u32x4 t[8];
#pragma unroll
                for (int k = 0; k < 8; ++k) t[k] = *(const u32x4*)(usrc + (size_t)(k0 + k) * NTOK + c.tid * 8);
#pragma unroll
                for (int k = 0; k < 8; ++k) *(LAS u32x4*)(ub + (k0 + k) * UP + 256 + c.tid * 16) = t[k];
            }
        } else {
            const int b = c.tid >> 5, pc = c.tid & 31;
            *(LAS u32x4*)(ub + b * UP + 256 + pc * 16) = *(const u32x4*)(usrc + (size_t)b * NTOK + pc * 8);
        }
        __syncthreads();
        const float* hcw = KIN(I_HCW) + (size_t)l * 3 * 768; const float* hcb = KIN(I_HCB) + l * 768;
        if (pass == 0) {
            const float w0 = hcw[ch], w1 = hcw[768 + ch], w2 = hcw[1536 + ch], bs = hcb[ch];
            constexpr int PPT = (N == SEQL) ? 16 : 1;
            u32x4 o[PPT];
#pragma unroll
            for (int k = 0; k < PPT; ++k) { const int b = (N == SEQL) ? k : (c.tid >> 5), pc = (N == SEQL) ? c.tid : (c.tid & 31); const LAS unsigned char* p = ub + b * UP + 256 + pc * 16;
                float x[8]; unpack8(*(const LAS u32x4*)p, x); float pv = bf2f(*(const LAS bf16_t*)(p - 2)); const float nx8 = bf2f(*(const LAS bf16_t*)(p + 16)); float y[8];
#pragma unroll
                for (int m = 0; m < 8; ++m) { const float nx = (m < 7) ? x[m + 1] : nx8; y[m] = w0 * pv + w1 * x[m] + w2 * nx + bs; pv = x[m]; }
                o[k].x = cvt_pk_bf16(y[0], y[1]); o[k].y = cvt_pk_bf16(y[2], y[3]); o[k].z = cvt_pk_bf16(y[4], y[5]); o[k].w = cvt_pk_bf16(y[6], y[7]); }
            __syncthreads();
#pragma unroll
            for (int k = 0; k < PPT; ++k) { const int b = (N == SEQL) ? k : (c.tid >> 5), pc = (N == SEQL) ? c.tid : (c.tid & 31); *(LAS u32x4*)(ub + b * UP + 256 + pc * 16) = o[k]; }
            __syncthreads();
        }
        const float bias = KIN(I_HBIAS)[((size_t)l * 2 + pass) * 256 + ch];
        const int cc = (pass + 1) * 256 + ch;
        hyena_conv<N>(c, ub, gb, pass, pass == 0 ? x1 : x2, bias, vz, gm, cat, hcw[cc], hcw[768 + cc], hcw[1536 + cc], hcb[cc]);
        asm volatile("s_waitcnt vmcnt(0)" ::: "memory");
        __syncthreads();
    }
}

__device__ __forceinline__ void hyena_untranspose(const Ctx& c, int tl0, int tl1) {
    const bf16_t* yT = wsp<bf16_t>(c, WS_HYY); bf16_t* cat = wsp<bf16_t>(c, WS_HCAT);
    LAS bf16_t* T = (LAS bf16_t*)c.lds;
    LAS unsigned* T32 = (LAS unsigned*)c.lds;
    for (int tl = tl0; tl < tl1; ++tl) {
        const int b = tl / 68, j0 = (tl - b * 68) * 64;
        u32x4 pre[4];
#pragma unroll
        for (int k = 0; k < 4; ++k) { const int e = c.tid + k * 512, ch = e >> 3, pc = e & 7; pre[k] = *(const u32x4*)(yT + ((size_t)ch * 16 + b) * NTOK + j0 + pc * 8); }
#pragma unroll
        for (int k = 0; k < 4; ++k) { const int e = c.tid + k * 512, ch = e >> 3, pc = e & 7; LAS unsigned* d = T32 + (ch * 132 + pc * 16) / 4; d[0] = pre[k].x; d[1] = pre[k].y; d[2] = pre[k].z; d[3] = pre[k].w; }
        __syncthreads();
#pragma unroll
        for (int k = 0; k < 4; ++k) { const int e = c.tid + k * 512, t = e >> 5, c0 = (e & 31) * 8; float v[8];
#pragma unroll
            for (int i = 0; i < 8; ++i) v[i] = bf2f(T[(c0 + i) * 66 + t]);
            u32x4 w; w.x = cvt_pk_bf16(v[0], v[1]); w.y = cvt_pk_bf16(v[2], v[3]); w.z = cvt_pk_bf16(v[4], v[5]); w.w = cvt_pk_bf16(v[6], v[7]);
            *(u32x4*)(cat + ((size_t)b * NTOK + j0 + t) * DM + 768 + c0) = w; }
        __syncthreads();
    }
}

__device__ __forceinline__ void ssm_scan_item(const Ctx& c, int l, int item) {
    const int b = item >> 2, g = (item & 3) * 4 + (c.tid >> 7), dq = (c.tid >> 6) & 1, p = c.tid & 63;
    const float* a16 = wsp<float>(c, WS_A16) + ((((size_t)l * 2 + dq) * 16 + g) * 64 + p) * 2;
    const float ar = a16[0], ai = a16[1];
    const bf16_t* E = wsp<bf16_t>(c, WS_E); bf16_t* US = wsp<bf16_t>(c, WS_US);
    float sr = 0.f, si = 0.f;
    for (int st0 = 0; st0 < NCHB; st0 += 8) {
        float er[8], ei[8]; size_t ro[8];
#pragma unroll
        for (int k = 0; k < 8; ++k) { const int st = st0 + k; const int cc = dq == 0 ? (st < 16 ? 256 + st : st - 16) : (st < 16 ? 271 - st : 255 - (st - 16));
            ro[k] = (size_t)g * NCHUNK + (size_t)b * NCHB + cc; er[k] = bf2f(E[ro[k] * 256 + dq * 128 + p]); ei[k] = bf2f(E[ro[k] * 256 + dq * 128 + 64 + p]); }
#pragma unroll
        for (int k = 0; k < 8; ++k) {
            US[ro[k] * 512 + 256 + dq * 128 + p] = f2bf(sr); US[ro[k] * 512 + 256 + dq * 128 + 64 + p] = f2bf(si);
            const float nr = ar * sr - ai * si + er[k], ni = ar * si + ai * sr + ei[k]; sr = nr; si = ni;
        }
    }
}

constexpr int LDS_BYTES = 163840;
constexpr int LDS_MISC = LDS_MISC_OFF;
static_assert(LDS_MISC_OFF == LDS_BYTES - 256, "LDS map");
constexpr int NPRO = 1, NPH = 6, NPHASES = NPRO + DEPTH * NPH;
constexpr int QI_HY = 256, QI_SCAN = 64, QI_ATTL = NB * 8 * 8, QI_SSM2 = 16 * 17, QI_UNT = 272, QI_ATTC = NB * 8, QI_GLU = MROWS / 256;
constexpr int QO_SCAN = QI_HY, QO_ATTL = QO_SCAN + QI_SCAN, QO_SSM2 = QO_ATTL + QI_ATTL, QO_UNT = QO_SSM2 + QI_SSM2, QO_ATTC = QO_UNT + QI_UNT, QO_GLU = QO_ATTC + QI_ATTC, QI_TOTAL = QO_GLU + QI_GLU;
#ifndef PROBE_DUP_MASK
#define PROBE_DUP_MASK 0
#endif
#ifndef PROBE_P4KINDS
#define PROBE_P4KINDS 0x7f
#endif
__device__ __forceinline__ void dep_signal(const Ctx& c, unsigned* cnt) {
    asm volatile("s_waitcnt vmcnt(0)" ::: "memory");
    __syncthreads();
    if (c.tid == 0) { __builtin_amdgcn_fence(__ATOMIC_RELEASE, "agent"); asm volatile("s_waitcnt vmcnt(0)" ::: "memory"); (void)xb_add(cnt, 1u); }
}
__device__ __forceinline__ void dep_wait(const Ctx& c, unsigned* cnt, unsigned need, unsigned* tmo) {
    if (c.dry) return;
    if (c.tid == 0) {
        unsigned sp = 0;
        while (xb_ld(cnt) < need) { __builtin_amdgcn_s_sleep(2); if ((++sp & 255u) == 0u) { if (xb_ld(tmo)) break; if (sp > XB_SPIN_CAP) { atomicAdd(tmo, 1u); break; } } }
        __builtin_amdgcn_fence(__ATOMIC_ACQUIRE, "agent");
        asm volatile("s_waitcnt vmcnt(0)" ::: "memory");
    }
    __syncthreads();
}

__global__ void __launch_bounds__(512, 2) mk_fwd(Params prm) {
    extern __shared__ __attribute__((aligned(16))) unsigned char lds_raw[];
    Ctx c; c.lds = (LAS unsigned char*)lds_raw; c.ka = (kargp_t)__builtin_amdgcn_kernarg_segment_ptr(); c.ws = prm.ws; c.tid = threadIdx.x; c.lane = c.tid & 63; c.wave = __builtin_amdgcn_readfirstlane(c.tid >> 6); c.G = gridDim.x; c.bid = blockIdx.x; c.dry = prm.dry;
    const int wave0 = c.wave;
    volatile LAS unsigned* misc = (volatile LAS unsigned*)(c.lds + LDS_MISC);
    if (c.tid < 16) misc[c.tid] = 0u;
    __syncthreads();
    unsigned* ctl = wsp<unsigned>(c, WS_CTL);
    const int lo = prm.ph_lo, hi = prm.ph_hi;
    const bool fused = (hi - lo) > 1;
    XcdBarrier bar; bar.bar = ctl + CW_BAR; bar.x = 0; bar.st = misc;
    if (fused) bar = xcd_barrier_post(ctl + CW_BAR, misc);
#ifndef SITE_MASK
#define SITE_MASK 0x3ff
#endif
#define SITE(n) (((SITE_MASK) >> (n)) & 1)
#define IN(k) (lo <= (k) && (k) < hi)
#define FRESH() do { { kargp_t _k = (kargp_t)__builtin_amdgcn_kernarg_segment_ptr(); asm volatile("" : "+s"(_k)); c.ka = _k; c.ws = (unsigned char*)(GAS unsigned char*)_k[37]; } { int _w = wave0; asm volatile("" : "+s"(_w)); c.wave = _w; c.lane = lane_id_fresh(); c.tid = c.wave * 64 + c.lane; } } while (0)
#define SEAM(k) do { if (IN((k) + 1)) xcd_barrier(bar); } while (0)

    if (SITE(0) && IN(0)) {
        FRESH();
        constexpr int J_MOD = 192, J_HY = 544, J_SSM = 64, J_WIN = 4 * 48 * 8, J_WOUT = 4 * 16 * 8, J_WUQ = 4 * 8 * 2, J_W256 = 4 * 4 * 2, J_NORM = MROWS / 256, J_PACK = 4 * 2 * 256;
        constexpr int J0 = J_MOD, J1 = J0 + J_HY, J2 = J1 + J_SSM, J3 = J2 + J_WIN, J4 = J3 + J_WOUT, J5 = J4 + J_WUQ, J6 = J5 + J_W256, J7 = J6 + J_W256, J8 = J7 + J_W256, J9 = J8 + 1, J10 = J9 + J_NORM, J11 = J10 + J_PACK;
        unsigned* dep = ctl + CW_DEP + DEP_SET * 8;
        unsigned* tmo = ctl + CW_BAR + XB_TMO;
        for (int job = c.bid; job < J11; job += c.G) {
            FRESH();
            if (job < J0) { modv_job(c, job); dep_signal(c, dep); }
            else if (job < J1) { hyena_mlp_job(c, job - J0); dep_signal(c, dep + 64); }
            else if (job < J2) ssm_tables_job(c, job - J1);
            else if (job < J3) { const int r = job - J2, l = r / 384, q = r % 384; wconv_tile(c, KIN(I_WIN) + (size_t)l * DM * INC, DM, INC, INP, wsp<bf16_t>(c, WS_WIN) + (size_t)l * INP * DM, DM, 0, q / 8, q % 8); }
            else if (job < J4) { const int r = job - J3, l = r / 128, q = r % 128; wconv_tile(c, KIN(I_WOUT) + (size_t)l * DM * DM, DM, DM, DM, wsp<bf16_t>(c, WS_WOUT) + (size_t)l * DM * DM, DM, 1, q / 8, q % 8); }
            else if (job < J5) { const int r = job - J4, l = r / 16, q = r % 16; wconv_tile(c, KIN(I_WUQ) + (size_t)l * 192 * 384, 192, 384, 384, wsp<bf16_t>(c, WS_WUQ) + (size_t)l * 512 * 256, 256, 1, q / 2, q % 2); }
            else if (job < J6) { const int r = job - J5, l = r / 8, q = r % 8; wconv_tile(c, KIN(I_WUKV) + (size_t)l * 128 * 512, 128, 512, 256, wsp<bf16_t>(c, WS_WUK) + (size_t)l * 256 * 256, 256, 2, q / 2, q % 2); }
            else if (job < J7) { const int r = job - J6, l = r / 8, q = r % 8; wconv_tile(c, KIN(I_WUKV) + (size_t)l * 128 * 512, 128, 512, 256, wsp<bf16_t>(c, WS_WUV) + (size_t)l * 256 * 256, 256, 3, q / 2, q % 2); }
            else if (job < J8) { const int r = job - J7, l = r / 8, q = r % 8; wconv_tile(c, KIN(I_GLUW) + (size_t)l * 256 * 256, 256, 256, 256, wsp<bf16_t>(c, WS_WGLU) + (size_t)l * 256 * 256, 256, 1, q / 2, q % 2); }
            else if (job < J9) rope_job(c);
            else if (job < J10) { dep_wait(c, dep, J_MOD, tmo); FRESH(); const int t = job - J9; norm_rows(c, -1, 0, t * 256, t * 256 + 256); }
            else { dep_wait(c, dep + 64, J_HY, tmo); FRESH(); hyena_pack_job(c, job - J10); }
        }
        SEAM(0);
    }
    for (int l = 0; l < DEPTH; ++l) {
        const int pbase = NPRO + l * NPH;
        if (SITE(2) && IN(pbase + 0)) {
            FRESH();
            pg8::Gemm g{wsp<bf16_t>(c, WS_HCAT), wsp<bf16_t>(c, WS_WIN) + (size_t)l * INP * DM, MROWS, INP, DM};
            pg8::StaticOrder S; S.init(MROWS, INP, c.G, c.bid);
            EpiInProj E{wsp<bf16_t>(c, WS_PB), wsp<bf16_t>(c, WS_UG), wsp<bf16_t>(c, WS_US), wsp<bf16_t>(c, WS_VTG), wsp<bf16_t>(c, WS_HYV), c.lds + pg8::STAGE_BYTES};
            pg8::gemm_phase(c.lds, g, S, E, c.tid);
            SEAM(pbase + 0);
        }
        if (SITE(3) && IN(pbase + 1)) { FRESH(); p2_rows(c, l); SEAM(pbase + 1); }
        if (SITE(4) && IN(pbase + 2)) {
            FRESH();
            pg8::Gemm g{wsp<bf16_t>(c, WS_PB), wsp<bf16_t>(c, WS_WUQ), MROWS, 512, 256};
            pg8::P3Order S{wsp<bf16_t>(c, WS_PB), wsp<bf16_t>(c, WS_PB) + BLKE, wsp<bf16_t>(c, WS_WUQ) + (size_t)l * 512 * 256, wsp<bf16_t>(c, WS_WUK) + (size_t)l * 256 * 256, wsp<bf16_t>(c, WS_WUV) + (size_t)l * 256 * 256,
                           wsp<bf16_t>(c, WS_UG), wsp<bf16_t>(c, WS_WE) + (size_t)l * 16 * 256 * 256, c.G, c.bid};
            EpiP3 E{{wsp<bf16_t>(c, WS_QM), 384, 384}, {wsp<bf16_t>(c, WS_KM), wsp<bf16_t>(c, WS_KR)}, {wsp<bf16_t>(c, WS_VTM)}, {wsp<bf16_t>(c, WS_E)}};
            pg8::gemm_phase(c.lds, g, S, E, c.tid);
            SEAM(pbase + 2);
        }
        if (SITE(5) && IN(pbase + 3)) {
            FRESH();
            unsigned* qh = ctl + CW_Q + 64 * (l + 4 * (c.dry ? 1 : 0));
            unsigned* dep = ctl + CW_DEP + DEP_SET * (l + 4 * (c.dry ? 1 : 0));
            unsigned* tmo = ctl + CW_BAR + XB_TMO;
            const float* ropeM = wsp<float>(c, WS_ROPEM);
            bool gqa_nomax;
            { float gq_ = fabsf(KIN(I_GQ)[l * 64 + c.lane]), gk_ = fabsf(KIN(I_GK)[l * 64 + c.lane]);
              gq_ = fmaxf(gq_, swz_xor<16>(gq_)); gq_ = fmaxf(gq_, swz_xor<8>(gq_)); gq_ = fmaxf(gq_, swz_xor<4>(gq_)); gq_ = fmaxf(gq_, swz_xor<2>(gq_)); gq_ = fmaxf(gq_, swz_xor<1>(gq_)); gq_ = half_max(gq_);
              gk_ = fmaxf(gk_, swz_xor<16>(gk_)); gk_ = fmaxf(gk_, swz_xor<8>(gk_)); gk_ = fmaxf(gk_, swz_xor<4>(gk_)); gk_ = fmaxf(gk_, swz_xor<2>(gk_)); gk_ = fmaxf(gk_, swz_xor<1>(gk_)); gk_ = half_max(gk_);
              const float bound = 64.f * gq_ * gk_ * 0.125f * LOG2E * 1.01f; gqa_nomax = __builtin_amdgcn_readfirstlane(bound < 50.f ? 1 : 0) != 0; }
#define ATT_CALL(DKV, ...) do { float rowmax_[2] = {0.f, 0.f}; if (attn_unit<DKV, false>(rowmax_, __VA_ARGS__)) { (void)attn_unit<DKV, true>(rowmax_, __VA_ARGS__); } } while (0)
            for (;;) {
                __syncthreads();
                if (c.tid == 0) misc[4] = __hip_atomic_fetch_add(qh, 1u, __ATOMIC_RELAXED, __HIP_MEMORY_SCOPE_AGENT);
                __syncthreads();
                const int it = (int)misc[4];
                if (it >= QI_TOTAL) break;
                FRESH();
                if (c.dry) { const int kd_ = it < QO_SCAN ? 0 : it < QO_ATTL ? 1 : it < QO_SSM2 ? 2 : it < QO_UNT ? 3 : it < QO_ATTC ? 4 : it < QO_GLU ? 5 : 6; if (!((c.dry >> (1 + kd_)) & 1)) continue; }
                if (it < QO_SCAN) { hyena_seq<SEQL>(c, l, it, 0); if (l + 1 < DEPTH) hyena_seq<CTXL>(c, l, it, SEQL); dep_signal(c, dep); }
                else if (it < QO_ATTL) { ssm_scan_item(c, l, it - QO_SCAN); dep_signal(c, dep + 64); }
                else if (it >= QO_ATTC && it < QO_GLU && l + 1 == DEPTH) {   }
                else if (it < QO_SSM2 || (it >= QO_ATTC && it < QO_GLU)) {
                    const bool isctx = it >= QO_ATTC; const int r = isctx ? it - QO_ATTC : (it - QO_ATTL) % (NB * 8), blk = isctx ? 8 : (it - QO_ATTL) / (NB * 8)  ;
                    const int kind = r & 1  , head = (r >> 1) & 3, b = r >> 3;
                    const size_t row0 = (size_t)b * NTOK + (isctx ? SEQL : blk * 512); const int kt0 = isctx ? 64 : 0, nkt = isctx ? 4 : 68, nrows = isctx ? 256 : 512;
                    if (kind == 0) { if (c.dry && PROBE_GQAONLY == 1) continue; ATT_CALL(96, c, wsp<bf16_t>(c, WS_QM) + row0 * 384 + head * 96, 384, wsp<bf16_t>(c, WS_KM) + (size_t)(b * 4 + head) * NTOK * 96, wsp<bf16_t>(c, WS_VTM) + (size_t)(b * 4 + head) * 64 * NTOK,
                                                 kt0, nkt, nrows, wsp<bf16_t>(c, WS_PB) + 2 * BLKE + row0 * 256 + head * 64, wsp<bf16_t>(c, WS_HCAT) + row0 * DM + head * 64, !isctx, blk * 512, 0.10206207261596577f * LOG2E, ropeM); }
                    else if (c.dry && PROBE_GQAONLY == 2) { continue; }
                    else if (c.dry && PROBE_ABL) { float rm_[2] = {0.f, 0.f}; (void)attn_unit<64, false, true, PROBE_ABL>(rm_, c, wsp<bf16_t>(c, WS_PB) + 3 * BLKE + row0 * 256 + head * 64, 256, wsp<bf16_t>(c, WS_KG) + (size_t)(b * 2 + (head >> 1)) * NTOK * 64, wsp<bf16_t>(c, WS_VTG) + (size_t)(b * 2 + (head >> 1)) * 64 * NTOK,
                                       kt0, nkt, nrows, wsp<bf16_t>(c, WS_PB) + 5 * BLKE + row0 * 256 + head * 64, wsp<bf16_t>(c, WS_HCAT) + row0 * DM + 256 + head * 64, false, 0, 1.f, ropeM); }
                    else if (gqa_nomax) { float rm_[2] = {0.f, 0.f}; (void)attn_unit<64, false, true>(rm_, c, wsp<bf16_t>(c, WS_PB) + 3 * BLKE + row0 * 256 + head * 64, 256, wsp<bf16_t>(c, WS_KG) + (size_t)(b * 2 + (head >> 1)) * NTOK * 64, wsp<bf16_t>(c, WS_VTG) + (size_t)(b * 2 + (head >> 1)) * 64 * NTOK,
                                       kt0, nkt, nrows, wsp<bf16_t>(c, WS_PB) + 5 * BLKE + row0 * 256 + head * 64, wsp<bf16_t>(c, WS_HCAT) + row0 * DM + 256 + head * 64, false, 0, 1.f, ropeM); }
                    else { ATT_CALL(64, c, wsp<bf16_t>(c, WS_PB) + 3 * BLKE + row0 * 256 + head * 64, 256, wsp<bf16_t>(c, WS_KG) + (size_t)(b * 2 + (head >> 1)) * NTOK * 64, wsp<bf16_t>(c, WS_VTG) + (size_t)(b * 2 + (head >> 1)) * 64 * NTOK,
                                       kt0, nkt, nrows, wsp<bf16_t>(c, WS_PB) + 5 * BLKE + row0 * 256 + head * 64, wsp<bf16_t>(c, WS_HCAT) + row0 * DM + 256 + head * 64, false, 0, 1.f, ropeM); }
                }
                else if (it < QO_UNT) {
                    const int L = it - QO_SSM2, i = L >> 4, g = L & 15;
                    dep_wait(c, dep + 64, QI_SCAN, tmo);
                    pg8::Gemm gm{wsp<bf16_t>(c, WS_US), wsp<bf16_t>(c, WS_WKC) + (size_t)l * 16 * 256 * 512, 16 * NCHUNK, 16 * 256, 512}; pg8::OneUnit S{g * 17 + i, g};
                    pg8::EpiWalk<PutSsmY> E{{wsp<bf16_t>(c, WS_ZS), wsp<bf16_t>(c, WS_UG), KIN(I_SSMD) + l * 256}}; pg8::gemm_phase(c.lds, gm, S, E, c.tid);
                    dep_signal(c, dep + 64 * (2 + i));
                }
                else if (it < QO_ATTC) {
                    dep_wait(c, dep, QI_HY, tmo);
                    const int j = it - QO_UNT; hyena_untranspose(c, 4 * j, 4 * j + 4);
                }
                else {
                    const int pm = it - QO_GLU;
                    dep_wait(c, dep + 64 * (2 + (pm >> 4)), 16u, tmo);
                    pg8::Gemm gm{wsp<bf16_t>(c, WS_ZS), wsp<bf16_t>(c, WS_WGLU) + (size_t)l * 256 * 256, MROWS, 256, 256}; pg8::OneUnit S{pm, 0};
                    pg8::EpiWalk<PutGlu> E{{wsp<bf16_t>(c, WS_HCAT), wsp<bf16_t>(c, WS_ZS), wsp<bf16_t>(c, WS_PB) + 7 * BLKE, KIN(I_GLUB) + l * 256}}; pg8::gemm_phase(c.lds, gm, S, E, c.tid);
                }
            }
            SEAM(pbase + 3);
        }
        if (SITE(6) && IN(pbase + 4)) {
            FRESH();
            pg8::Gemm g{wsp<bf16_t>(c, WS_HCAT), wsp<bf16_t>(c, WS_WOUT) + (size_t)l * DM * DM, MROWS, DM, DM}; pg8::LiveRowsOrder S; S.init2(DM, c.G, c.bid, l + 1 == DEPTH);
            pg8::EpiWalk<PutPlain> E{{wsp<bf16_t>(c, WS_OUTB), DM, DM}}; pg8::gemm_phase(c.lds, g, S, E, c.tid);
            SEAM(pbase + 4);
        }
        if (SITE(7) && IN(pbase + 5)) { FRESH(); norm_rows(c, l, l + 1 < DEPTH ? l + 1 : -1); if (l + 1 < DEPTH) SEAM(pbase + 5); }
    }
#undef IN
#undef SEAM
}

extern "C" void kernel_launch(void* const* d_in, const int* in_sizes, int n_in, void* d_out, int out_size, void* d_ws, size_t ws_size, hipStream_t stream) {
    static int grid = 0;
    if (grid == 0) {
        if (n_in != 36 || out_size != NB * SEQL * DM || ws_size < WS_END) { fprintf(stderr, "kernel_launch: unexpected shapes: n_in %d out %d ws %zu (need %zu)\n", n_in, out_size, ws_size, (size_t)WS_END); grid = -1; return; }
        int dev = 0, cus = 0, per_cu = 0;
        if (hipGetDevice(&dev) != hipSuccess || hipDeviceGetAttribute(&cus, hipDeviceAttributeMultiprocessorCount, dev) != hipSuccess) { grid = -1; return; }
        if (hipFuncSetAttribute((const void*)mk_fwd, hipFuncAttributeMaxDynamicSharedMemorySize, LDS_BYTES) != hipSuccess) { fprintf(stderr, "kernel_launch: hipFuncSetAttribute failed\n"); grid = -1; return; }
        if (hipOccupancyMaxActiveBlocksPerMultiprocessor(&per_cu, (const void*)mk_fwd, 512, LDS_BYTES) != hipSuccess || per_cu < 1) { fprintf(stderr, "kernel_launch: occupancy query says %d blocks per CU\n", per_cu); per_cu = 1; }
        (void)hipGetLastError();
        grid = cus;
    }
    if (grid < 0) return;
    (void)hipMemsetAsync((char*)d_ws + WS_CTL, 0, CTL_BYTES, stream);
    Params p{};
    for (int i = 0; i < 36; ++i) p.in[i] = (const float*)d_in[i];
    p.out = (float*)d_out; p.ws = (unsigned char*)d_ws;
#if MK_ONE_LAUNCH
    p.ph_lo = 0; p.ph_hi = NPHASES;
    hipLaunchKernelGGL(mk_fwd, dim3(grid), dim3(512), LDS_BYTES, stream, p);
#else
    for (int k = 0; k < NPHASES; ++k) { p.ph_lo = k; p.ph_hi = k + 1; const int site = k < NPRO ? k : NPRO + (k - NPRO) % NPH;
        if ((PROBE_DUP_MASK >> site) & 1) { p.dry = 1 | (PROBE_P4KINDS << 1); hipLaunchKernelGGL(mk_fwd, dim3(grid), dim3(512), LDS_BYTES, stream, p); p.dry = 0; }
        hipLaunchKernelGGL(mk_fwd, dim3(grid), dim3(512), LDS_BYTES, stream, p); }
#endif
}
```

```cpp
#include <hip/hip_runtime.h>
#include <cstdio>
#include <cstdint>

#ifndef MK_ONE_LAUNCH
#define MK_ONE_LAUNCH 1
#endif

#define LAS __attribute__((address_space(3)))
typedef unsigned short bf16_t;
typedef short bf16x8 __attribute__((ext_vector_type(8)));
typedef short bf16x4 __attribute__((ext_vector_type(4)));
typedef float f32x4 __attribute__((ext_vector_type(4)));
typedef float f32x16 __attribute__((ext_vector_type(16)));
typedef unsigned u32x4 __attribute__((ext_vector_type(4)));
typedef unsigned u32x2 __attribute__((ext_vector_type(2)));

constexpr int NB = 16, SEQL = 4096, CTXL = 256, NTOK = SEQL + CTXL  , MROWS = NB * NTOK  ;
constexpr int DM = 1024, DEPTH = 4, INC = 2912, INP = 3072;
constexpr int NCHB = NTOK / 16  , NCHUNK = MROWS / 16  ;
constexpr float EPS = 1e-6f;
constexpr float LOG2E = 1.4426950408889634f;
constexpr int LDS_MISC_OFF = 163840 - 256;

constexpr size_t al256(size_t x) { return (x + 255) & ~(size_t)255; }
constexpr size_t WS_CTL = 0;
constexpr size_t CTL_BYTES = 65536;
constexpr size_t WS_MODV = WS_CTL + CTL_BYTES;
constexpr size_t WS_ROPEG = WS_MODV + al256((size_t)4 * 17 * 3072 * 4);
constexpr size_t WS_ROPEM = WS_ROPEG + 64 * 16 * 2 * 4;
constexpr size_t WS_WIN = WS_ROPEM + 64 * 8 * 2 * 4;
constexpr size_t WS_WOUT = WS_WIN + (size_t)4 * 3072 * 1024 * 2;
constexpr size_t WS_WUQ = WS_WOUT + (size_t)4 * 1024 * 1024 * 2;
constexpr size_t WS_WUK = WS_WUQ + (size_t)4 * 512 * 256 * 2;
constexpr size_t WS_WUV = WS_WUK + (size_t)4 * 256 * 256 * 2;
constexpr size_t WS_WGLU = WS_WUV + (size_t)4 * 256 * 256 * 2;
constexpr size_t WS_WE = WS_WGLU + (size_t)4 * 256 * 256 * 2;
constexpr size_t WS_WKC = WS_WE + (size_t)4 * 16 * 256 * 256 * 2;
constexpr size_t WS_A16 = WS_WKC + (size_t)4 * 16 * 256 * 512 * 2;
constexpr size_t WS_GR = WS_A16 + (size_t)4 * 2 * 16 * 64 * 2 * 4;
constexpr size_t WS_GRC = WS_GR + (size_t)4 * 2 * 256 * 8192 * 2;
constexpr size_t WS_CTXR = WS_GRC + (size_t)4 * 2 * 256 * 512 * 2;
constexpr size_t WS_HCAT = WS_CTXR + (size_t)NB * CTXL * DM * 4;
constexpr size_t BLKE = (size_t)MROWS * 256;
constexpr size_t WS_PB = WS_HCAT + (size_t)MROWS * DM * 2;
constexpr size_t WS_KR = WS_PB + 12 * BLKE * 2;
constexpr size_t WS_KG = WS_KR + (size_t)MROWS * 32 * 2;
constexpr size_t WS_VTG = WS_KG + (size_t)32 * NTOK * 64 * 2;
constexpr size_t WS_UG = WS_VTG + (size_t)32 * NTOK * 64 * 2;
constexpr size_t WS_US = WS_UG + BLKE * 2;
constexpr size_t WS_HYV = WS_US + (size_t)16 * NCHUNK * 512 * 2;
constexpr size_t WS_HYX1 = WS_HYV + BLKE * 2;
constexpr size_t WS_HYX2 = WS_HYX1 + BLKE * 2;
constexpr size_t WS_HYG = WS_HYX2 + BLKE * 2;
constexpr size_t WS_HYZ = WS_HYG + BLKE * 2;
constexpr size_t WS_HYY = WS_HYZ + BLKE * 2;
constexpr size_t WS_END = WS_HYY + BLKE * 2;
static_assert(WS_END <= (size_t)1 << 30, "workspace map exceeds 1 GiB");
constexpr size_t WS_QM = WS_PB + 8 * BLKE * 2;
constexpr size_t WS_KM = WS_QM + (size_t)MROWS * 384 * 2;
constexpr size_t WS_VTM = WS_KM + (size_t)MROWS * 384 * 2;
constexpr size_t WS_E = WS_PB + 4 * BLKE * 2;
constexpr size_t WS_ZS = WS_PB + 6 * BLKE * 2;
constexpr size_t WS_OUTB = WS_PB + 8 * BLKE * 2;
constexpr size_t WS_HT = WS_PB;
static_assert(WS_VTM + BLKE * 2 == WS_PB + 12 * BLKE * 2, "alias map");

constexpr int CW_BAR = 0;
constexpr int CW_Q = 4096;
constexpr int CW_TMO = 4096 + 64 * 8;
constexpr int CW_DEP = 5120;
constexpr int DEP_SET = 20 * 64;

__device__ __forceinline__ float bf2f(bf16_t v) { return __uint_as_float(((unsigned)v) << 16); }
__device__ __forceinline__ bf16_t f2bf(float f) { unsigned u = __float_as_uint(f); u += 0x7FFFu + ((u >> 16) & 1u); return (bf16_t)(u >> 16); }
__device__ __forceinline__ unsigned cvt_pk_bf16(float lo, float hi) { unsigned r; asm volatile("v_cvt_pk_bf16_f32 %0, %1, %2" : "=v"(r) : "v"(lo), "v"(hi)); return r; }
__device__ __forceinline__ float lo_bf(unsigned w) { return __uint_as_float(w << 16); }
__device__ __forceinline__ float hi_bf(unsigned w) { return __uint_as_float(w & 0xFFFF0000u); }
__device__ __forceinline__ float sigmf(float x) { float one = 1.f; asm volatile("" : "+v"(one)); return __builtin_amdgcn_rcpf(one + __builtin_amdgcn_exp2f(-1.4426950408889634f * x)); }
__device__ __forceinline__ float siluf(float x) { return x * sigmf(x); }
__device__ __forceinline__ float gelu_tanh(float x) { const float u = 0.7978845608028654f * (x + 0.044715f * x * x * x); return x * sigmf(2.f * u); }
__device__ __forceinline__ int opaque(int x) { asm volatile("" : "+v"(x)); return x; }
__device__ __forceinline__ int lane_id_fresh() { int x; asm volatile("v_mbcnt_lo_u32_b32 %0, -1, 0\n\tv_mbcnt_hi_u32_b32 %0, -1, %0" : "=v"(x)); return x; }
__device__ __forceinline__ float max3_raw(float a, float b, float c) { float r; asm("v_max3_f32 %0, %1, %2, %3" : "=v"(r) : "v"(a), "v"(b), "v"(c)); return r; }
template <int M> __device__ __forceinline__ float swz_xor(float v) { return __int_as_float(__builtin_amdgcn_ds_swizzle(__float_as_int(v), 0x1F | (M << 10))); }
__device__ __forceinline__ float half_sum(float v) { auto r = __builtin_amdgcn_permlane32_swap(__float_as_uint(v), __float_as_uint(v), false, false); return __uint_as_float(r[0]) + __uint_as_float(r[1]); }
__device__ __forceinline__ float half_max(float v) { auto r = __builtin_amdgcn_permlane32_swap(__float_as_uint(v), __float_as_uint(v), false, false); return fmaxf(__uint_as_float(r[0]), __uint_as_float(r[1])); }
__device__ __forceinline__ float half_other(float v, int h) { auto r = __builtin_amdgcn_permlane32_swap(__float_as_uint(v), __float_as_uint(v), false, false); return __uint_as_float(h ? r[0] : r[1]); }
__device__ __forceinline__ float wave_sum(float v) {
    v += swz_xor<16>(v); v += swz_xor<8>(v); v += swz_xor<4>(v); v += swz_xor<2>(v); v += swz_xor<1>(v);
    return half_sum(v);
}

#define XB_TMO      128
#define XB_XCNT(j)  (256  + 64 * (j))
#define XB_XSUB(j)  (1280 + 64 * (j))
#define XB_XGEN(j)  (2304 + 64 * (j))
#define XB_TOP      3328
#define XB_TOPGEN   3392
#define XCD_BAR_WORDS 3456
#define XB_SPIN_CAP (1u << 22)
__device__ __forceinline__ unsigned xb_ld(unsigned* p)              { return __hip_atomic_load(p, __ATOMIC_RELAXED, __HIP_MEMORY_SCOPE_AGENT); }
__device__ __forceinline__ unsigned xb_add(unsigned* p, unsigned v) { return __hip_atomic_fetch_add(p, v, __ATOMIC_RELAXED, __HIP_MEMORY_SCOPE_AGENT); }
__device__ __forceinline__ unsigned xb_xcc_id() { return (unsigned)__builtin_amdgcn_s_getreg((3 << 11) | 20) & 0xFu; }
#define XB_SPIN(cond, bar) do { unsigned _sp = 0; while (cond) { __builtin_amdgcn_s_sleep(1); \
    if ((++_sp & 255u) == 0u) { if (xb_ld(&(bar)[XB_TMO])) break; if (_sp > XB_SPIN_CAP) { atomicAdd(&(bar)[XB_TMO], 1u); break; } } } } while (0)
struct XcdBarrier { unsigned* bar; unsigned x; volatile LAS unsigned* st; };
__device__ __forceinline__ XcdBarrier xcd_barrier_post(unsigned* bar, volatile LAS unsigned* st) {
    XcdBarrier b; b.bar = bar; b.x = xb_xcc_id(); b.st = st;
    if (threadIdx.x == 0) (void)xb_add(&bar[XB_XCNT(b.x)], 1u);
    return b;
}
__device__ __forceinline__ void xcd_barrier_complete(unsigned* bar, unsigned x, unsigned& nloc, unsigned& nx) {
    const unsigned G = gridDim.x * gridDim.y * gridDim.z;
    unsigned sum, cnt, mine, sp = 0u;
    for (;;) {
        sum = 0u; cnt = 0u; mine = 0u;
#pragma unroll
        for (unsigned j = 0; j < 16; ++j) { const unsigned c = xb_ld(&bar[XB_XCNT(j)]); sum += c; cnt += (c > 0u) ? 1u : 0u; }
        mine = xb_ld(&bar[XB_XCNT(x)]);
        if (sum == G) break;
        __builtin_amdgcn_s_sleep(1);
        if ((++sp & 255u) == 0u) { if (xb_ld(&bar[XB_TMO])) break; if (sp > XB_SPIN_CAP) { atomicAdd(&bar[XB_TMO], 1u); break; } }
    }
    nloc = mine > 0u ? mine : 1u; nx = cnt > 0u ? cnt : 1u;
}
__device__ __forceinline__ void xcd_barrier(const XcdBarrier& b) {
    asm volatile("s_waitcnt vmcnt(0)" ::: "memory");
    __syncthreads();
    if (threadIdx.x == 0) {
        unsigned* bar = b.bar;
        __builtin_amdgcn_s_waitcnt(0);
        unsigned nloc = b.st[0], nx = b.st[1];
        if (nloc == 0u) { xcd_barrier_complete(bar, b.x, nloc, nx); b.st[0] = nloc; b.st[1] = nx; }
        const unsigned old = xb_add(&bar[XB_XSUB(b.x)], 1u);
        const unsigned gen = old / nloc;
        if (old + 1u == (gen + 1u) * nloc) {
            __builtin_amdgcn_fence(__ATOMIC_RELEASE, "agent");
            asm volatile("s_waitcnt vmcnt(0)" ::: "memory");
            const unsigned og = xb_add(&bar[XB_TOP], 1u);
            const unsigned tg = og / nx;
            if (og + 1u == (tg + 1u) * nx) xb_add(&bar[XB_TOPGEN], 1u);
            else XB_SPIN(xb_ld(&bar[XB_TOPGEN]) == tg, bar);
            __builtin_amdgcn_fence(__ATOMIC_ACQUIRE, "agent");
            xb_add(&bar[XB_XGEN(b.x)], 1u);
            asm volatile("s_waitcnt vmcnt(0)" ::: "memory");
        } else {
            XB_SPIN(xb_ld(&bar[XB_XGEN(b.x)]) == gen, bar);
            __builtin_amdgcn_fence(__ATOMIC_ACQUIRE, "agent");
            asm volatile("s_waitcnt vmcnt(0)" ::: "memory");
        }
    }
    __syncthreads();
}

namespace pg8 {
constexpr int BM = 256, BK = 64, HALF = 128, HTB = HALF * BK * 2, STAGE_BYTES = 8 * HTB, NXCD = 8, WGM = 8;
__host__ __device__ __forceinline__ int lds_byte(int r, int c) { const int st = (r >> 4) * 2 + (c >> 5), rr = r & 15, cc = c & 31, ob = rr * 64 + cc * 2; return st * 1024 + (ob ^ (((ob >> 9) & 1) << 5)); }
__host__ __device__ __forceinline__ void stage_rc(int b, int& R, int& C) { const int st = b / 1024, sb = b % 1024, swz = sb ^ (((sb >> 9) & 1) << 5); R = (st >> 1) * 16 + swz / 64; C = (st & 1) * 32 + (swz % 64) / 2; }
__host__ __device__ __forceinline__ int perm32(int rho) { const int n = rho >> 4, i = rho & 15; return 8 * (i >> 2) + 4 * n + (i & 3); }
struct Unit { int pm, pn, kd; };
struct Gemm { const bf16_t* A; const bf16_t* Bt; int M, N, K; };
struct StaticOrder {
    int nM, nN, nwg, G, c;
    __host__ __device__ void init(int M, int N, int G_, int c_) { nM = M / BM; nN = N / BM; nwg = nM * nN; G = G_; c = c_; }
    __host__ __device__ bool next(int i, Unit& u) const {
        const long L = (long)i * G + c; if (L >= nwg) return false;
        int wgid = (int)L; { const int q = nwg / NXCD, r = nwg % NXCD, xcd = wgid % NXCD, off = wgid / NXCD; wgid = (xcd < r ? xcd * (q + 1) : r * (q + 1) + (xcd - r) * q) + off; }
        const int nig = WGM * nN, gid = wgid / nig, fm = gid * WGM, gsz = (nM - fm) < WGM ? (nM - fm) : WGM;
        u.pm = fm + ((wgid % nig) % gsz); u.pn = (wgid % nig) / gsz; u.kd = 0; return true;
    }
    __device__ __forceinline__ void a_ready(const Unit&) const {}
    __device__ __forceinline__ void done(const Unit&) const {}
    __device__ __forceinline__ const char* abase(const Gemm& g, const Unit& u, size_t tstep) const { return (const char*)g.A + (size_t)u.pm * tstep; }
    __device__ __forceinline__ const char* bbase(const Gemm& g, const Unit& u, size_t tstep) const { return (const char*)g.Bt + (size_t)u.pn * tstep; }
};
struct LiveRowsOrder : StaticOrder {
    bool skip;
    __host__ __device__ void init2(int N, int G_, int c_, bool skip_) { skip = skip_; init(skip_ ? NB * SEQL : MROWS, N, G_, c_); }
    __host__ __device__ bool next(int i, Unit& u) const { if (!StaticOrder::next(i, u)) return false; if (skip) u.pm = (u.pm >> 4) * 17 + (u.pm & 15); return true; }
};
struct BatchedOrder {
    int nwg, G, c, tpg;
    __host__ __device__ void init(int ng, int tpg_, int G_, int c_) { nwg = ng * tpg_; tpg = tpg_; G = G_; c = c_; }
    __host__ __device__ bool next(int i, Unit& u) const { const int L = i * G + c; if (L >= nwg) return false; u.pm = L; u.pn = L / tpg; u.kd = 0; return true; }
    __device__ __forceinline__ void a_ready(const Unit&) const {}
    __device__ __forceinline__ void done(const Unit&) const {}
    __device__ __forceinline__ const char* abase(const Gemm& g, const Unit& u, size_t tstep) const { return (const char*)g.A + (size_t)u.pm * tstep; }
    __device__ __forceinline__ const char* bbase(const Gemm& g, const Unit& u, size_t tstep) const { return (const char*)g.Bt + (size_t)u.pn * tstep; }
};
struct P3Order {
    const bf16_t *b0, *b1, *wuq, *wuk, *wuv, *ug, *we; int G, c;
    __host__ __device__ bool next(int i, Unit& u) const {
        const int L = i * G + c; if (L >= 1360) return false;
        if (L < 544) { u.kd = 0; u.pm = L >> 1; u.pn = L & 1; } else if (L < 816) { u.kd = 1; u.pm = L - 544; u.pn = 0; } else if (L < 1088) { u.kd = 2; u.pm = 0; u.pn = L - 816; } else { u.kd = 3; u.pm = L - 1088; u.pn = (L - 1088) / 17; }
        return true;
    }
    __device__ __forceinline__ void a_ready(const Unit&) const {}
    __device__ __forceinline__ void done(const Unit&) const {}
    __device__ __forceinline__ const char* abase(const Gemm&, const Unit& u, size_t tstep) const { const bf16_t* p = u.kd == 0 ? b0 : u.kd == 1 ? b1 : u.kd == 2 ? wuv : ug; return (const char*)p + (size_t)u.pm * tstep; }
    __device__ __forceinline__ const char* bbase(const Gemm&, const Unit& u, size_t tstep) const { const bf16_t* p = u.kd == 0 ? wuq : u.kd == 1 ? wuk : u.kd == 2 ? b1 : we; return (const char*)p + (size_t)u.pn * tstep; }
};

struct OneUnit {
    int pm, pn;
    __host__ __device__ bool next(int i, Unit& u) const { if (i) return false; u.pm = pm; u.pn = pn; u.kd = 0; return true; }
    __device__ __forceinline__ void a_ready(const Unit&) const {}
    __device__ __forceinline__ void done(const Unit&) const {}
    __device__ __forceinline__ const char* abase(const Gemm& g, const Unit& u, size_t tstep) const { return (const char*)g.A + (size_t)u.pm * tstep; }
    __device__ __forceinline__ const char* bbase(const Gemm& g, const Unit& u, size_t tstep) const { return (const char*)g.Bt + (size_t)u.pn * tstep; }
};
template <class Epi, class Sched>
__device__ __forceinline__ void gemm_phase(LAS unsigned char* lds, const Gemm g, const Sched& S, const Epi& E, int tid_in) {
    const int tid = tid_in, wid = __builtin_amdgcn_readfirstlane(tid >> 6), lane = tid & 63, wr = wid >> 2, wc = wid & 3, fr = lane & 15, fq = lane >> 4;
    const int K = g.K, nt = K / BK;
    unsigned voffA[2], voffB[2];
#pragma unroll
    for (int i = 0; i < 2; ++i) { int R, C; stage_rc(tid * 16 + i * 8192, R, C); const int Rb = Epi::PERM ? ((R & ~31) + perm32(R & 31)) : R;
        voffA[i] = (unsigned)(R * K + C) * 2u; voffB[i] = (unsigned)(Rb * K + C) * 2u; }
    const size_t kstep = (size_t)(BK * 2);
    const size_t hstep = (size_t)HALF * K * 2;
    const size_t tstep = 2 * hstep;
    const unsigned ldsw = (unsigned)wid * 1024u;
    const int aoff = lds_byte(wr * 64 + fr, fq * 8), boff = lds_byte(wc * 32 + fr, fq * 8);
#define PG8_SA(b, h) (((b) * 2 + (h)) * HTB)
#define PG8_SB(b, h) ((4 + (b) * 2 + (h)) * HTB)
#define PG8_STAGE(bufoff, gbase, voff) do { _Pragma("unroll") for (int _i = 0; _i < 2; ++_i) \
        __builtin_amdgcn_global_load_lds((const unsigned*)((const char*)(gbase) + (voff)[_i]), (LAS unsigned*)(lds + (bufoff) + ldsw + _i * 8192), 16, 0, 0); } while (0)
#define PG8_LDA(dst, b, h) do { _Pragma("unroll") for (int m = 0; m < 4; ++m) _Pragma("unroll") for (int k = 0; k < 2; ++k) dst[m][k] = *(const LAS bf16x8*)(lds + PG8_SA(b, h) + aoff + m * 2048 + k * 1024); } while (0)
#define PG8_LDB(dst, b, h) do { _Pragma("unroll") for (int n = 0; n < 2; ++n) _Pragma("unroll") for (int k = 0; k < 2; ++k) dst[n][k] = *(const LAS bf16x8*)(lds + PG8_SB(b, h) + boff + n * 2048 + k * 1024); } while (0)
#define PG8_MMA(ai, bj, At, Bt) do { __builtin_amdgcn_s_setprio(1); _Pragma("unroll") for (int m = 0; m < 4; ++m) _Pragma("unroll") for (int n = 0; n < 2; ++n) _Pragma("unroll") for (int k = 0; k < 2; ++k) \
        acc[ai][bj][m][n] = __builtin_amdgcn_mfma_f32_16x16x32_bf16(Bt[n][k], At[m][k], acc[ai][bj][m][n], 0, 0, 0); __builtin_amdgcn_s_setprio(0); } while (0)
#define PG8_WAIT_V(n) asm volatile("s_waitcnt vmcnt(" #n ")" ::: "memory")
#define PG8_WAIT_L(n) asm volatile("s_waitcnt lgkmcnt(" #n ")" ::: "memory")
#define PG8_BAR __builtin_amdgcn_s_barrier()
#define PG8_SCHED __builtin_amdgcn_sched_barrier(0)
    Unit cur, nxt; int ui = 0;
    if (!S.next(0, cur)) return;
    f32x4 acc[2][2][4][2];
#pragma unroll
    for (int a = 0; a < 2; ++a)
#pragma unroll
        for (int b = 0; b < 2; ++b)
#pragma unroll
            for (int m = 0; m < 4; ++m)
#pragma unroll
                for (int n = 0; n < 2; ++n) acc[a][b][m][n] = (f32x4){0.f, 0.f, 0.f, 0.f};
    bf16x8 At[4][2], B0[2][2], B1[2][2];
    const char* cA = S.abase(g, cur, tstep); const char* cB = S.bbase(g, cur, tstep);
    S.a_ready(cur);
    PG8_STAGE(PG8_SB(0, 0), cB, voffB); PG8_STAGE(PG8_SA(0, 0), cA, voffA); PG8_STAGE(PG8_SB(0, 1), cB + hstep, voffB); PG8_STAGE(PG8_SA(0, 1), cA + hstep, voffA);
    if (wr == 1) PG8_BAR;
    PG8_WAIT_V(4); PG8_BAR;
    PG8_STAGE(PG8_SB(1, 0), cB + kstep, voffB); PG8_STAGE(PG8_SA(1, 0), cA + kstep, voffA); PG8_STAGE(PG8_SB(1, 1), cB + hstep + kstep, voffB);
    PG8_WAIT_V(6); PG8_BAR;
    for (;;) {
        const bool has_next = S.next(ui + 1, nxt);
        const char* nA = has_next ? S.abase(g, nxt, tstep) : cA; const char* nB = has_next ? S.bbase(g, nxt, tstep) : cB;
        for (int t = 0; t < nt; t += 2) {
            const bool last = (t == nt - 2);
            const char* a1 = cA + (size_t)(t + 1) * kstep;
            const char* a2 = last ? nA : cA + (size_t)(t + 2) * kstep; const char* b2 = last ? nB : cB + (size_t)(t + 2) * kstep;
            const char* a3 = a2 + kstep; const char* b3 = b2 + kstep;
            if (last && has_next) S.a_ready(nxt);
            PG8_LDB(B0, 0, 0); PG8_SCHED; PG8_LDA(At, 0, 0); PG8_STAGE(PG8_SA(1, 1), a1 + hstep, voffA);
            PG8_WAIT_L(8); PG8_BAR; PG8_WAIT_L(0); PG8_MMA(0, 0, At, B0); PG8_BAR; PG8_SCHED;
            PG8_LDB(B1, 0, 1); PG8_STAGE(PG8_SB(0, 0), b2, voffB);
            PG8_BAR; PG8_WAIT_L(0); PG8_MMA(0, 1, At, B1); PG8_BAR;
            PG8_LDA(At, 0, 1); PG8_STAGE(PG8_SA(0, 0), a2, voffA);
            PG8_BAR; PG8_WAIT_L(0); PG8_MMA(1, 0, At, B0); PG8_BAR; PG8_SCHED;
            PG8_STAGE(PG8_SB(0, 1), b2 + hstep, voffB);
            PG8_WAIT_V(6); PG8_BAR; PG8_MMA(1, 1, At, B1); PG8_BAR;
            PG8_LDB(B0, 1, 0); PG8_SCHED; PG8_LDA(At, 1, 0); PG8_STAGE(PG8_SA(0, 1), a2 + hstep, voffA);
            PG8_WAIT_L(8); PG8_BAR; PG8_WAIT_L(0); PG8_MMA(0, 0, At, B0); PG8_BAR; PG8_SCHED;
            PG8_LDB(B1, 1, 1); PG8_STAGE(PG8_SB(1, 0), b3, voffB);
            PG8_BAR; PG8_WAIT_L(0); PG8_MMA(0, 1, At, B1); PG8_BAR;
            PG8_LDA(At, 1, 1); PG8_STAGE(PG8_SA(1, 0), a3, voffA);
            PG8_BAR; PG8_WAIT_L(0); PG8_MMA(1, 0, At, B0); PG8_BAR; PG8_SCHED;
            PG8_STAGE(PG8_SB(1, 1), b3 + hstep, voffB);
            PG8_WAIT_V(6); PG8_BAR; PG8_MMA(1, 1, At, B1); PG8_BAR;
        }
        { const int l2 = lane_id_fresh(); E(acc, cur, wr, wc, l2 & 15, l2 >> 4); } S.done(cur);
        if (!has_next) break;
#pragma unroll
        for (int a = 0; a < 2; ++a)
#pragma unroll
            for (int b = 0; b < 2; ++b)
#pragma unroll
                for (int m = 0; m < 4; ++m)
#pragma unroll
                    for (int n = 0; n < 2; ++n) acc[a][b][m][n] = (f32x4){0.f, 0.f, 0.f, 0.f};
        cur = nxt; cA = nA; cB = nB; ++ui;
    }
    PG8_WAIT_V(0);
    if (wr == 0) PG8_BAR;
    PG8_BAR;
#undef PG8_SA
#undef PG8_SB
#undef PG8_STAGE
#undef PG8_LDA
#undef PG8_LDB
#undef PG8_MMA
#undef PG8_WAIT_V
#undef PG8_WAIT_L
#undef PG8_BAR
#undef PG8_SCHED
}

template <class F> struct EpiWalk {
    static constexpr bool PERM = true, AFTER_DRAIN = false;
    F f;
    __device__ __forceinline__ void operator()(const f32x4 (&acc)[2][2][4][2], const Unit& u, int wr, int wc, int fr, int fq) const {
#pragma unroll
        for (int ai = 0; ai < 2; ++ai)
#pragma unroll
            for (int m = 0; m < 4; ++m) {
                const int rin = ai * HALF + wr * 64 + m * 16 + fr;
#pragma unroll
                for (int bj = 0; bj < 2; ++bj) { const int cin = bj * HALF + wc * 32 + 8 * fq; f.put(u.pm, u.pn, rin, cin, acc[ai][bj][m][0], acc[ai][bj][m][1]); asm volatile("" ::: "memory"); }
            }
    }
};
}

__device__ __forceinline__ u32x4 pack8(const f32x4& a, const f32x4& b) {
    u32x4 w; w.x = cvt_pk_bf16(a[0], a[1]); w.y = cvt_pk_bf16(a[2], a[3]); w.z = cvt_pk_bf16(b[0], b[1]); w.w = cvt_pk_bf16(b[2], b[3]); return w;
}
__device__ __forceinline__ void unpack8(const u32x4 w, float (&o)[8]) {
    o[0] = lo_bf(w.x); o[1] = hi_bf(w.x); o[2] = lo_bf(w.y); o[3] = hi_bf(w.y); o[4] = lo_bf(w.z); o[5] = hi_bf(w.z); o[6] = lo_bf(w.w); o[7] = hi_bf(w.w);
}

struct PutPlain {
    bf16_t* dst; int ldc, ncols;
    __device__ __forceinline__ void put(int pm, int pn, int rin, int cin, const f32x4& a, const f32x4& b) const { const int col = pn * 256 + cin; if (col < ncols) *(u32x4*)(dst + ((size_t)pm * 256 + rin) * ldc + col) = pack8(a, b); }
};
struct PutKm {
    bf16_t* km; const bf16_t* kr;
    __device__ __forceinline__ void put(int pm, int pn, int rin, int cin, const f32x4& a, const f32x4& b) const {
        const int bb = pm / 17, key = (pm - bb * 17) * 256 + rin, hd = cin >> 6, d = cin & 63;
        bf16_t* dst = km + ((size_t)(bb * 4 + hd) * NTOK + key) * 96;
        *(u32x4*)(dst + d) = pack8(a, b);
        if (d < 32) *(u32x4*)(dst + 64 + d) = *(const u32x4*)(kr + ((size_t)pm * 256 + rin) * 32 + d);
    }
};
struct PutVt {
    bf16_t* vt;
    __device__ __forceinline__ void put(int pm, int pn, int rin, int cin, const f32x4& a, const f32x4& b) const {
        const int bb = pn / 17, key = (pn - bb * 17) * 256 + cin;
        *(u32x4*)(vt + ((size_t)(bb * 4 + (rin >> 6)) * 64 + (rin & 63)) * NTOK + key) = pack8(a, b);
    }
};
struct PutE {
    bf16_t* e;
    __device__ __forceinline__ void put(int pm, int pn, int rin, int cin, const f32x4& a, const f32x4& b) const { *(u32x4*)(e + ((size_t)pm * 256 + rin) * 256 + cin) = pack8(a, b); }
};
struct PutSsmY {
    bf16_t* zs; const bf16_t* ug; const float* dskip;
    __device__ __forceinline__ void put(int pm, int pn, int rin, int cin, const f32x4& a, const f32x4& b) const {
        const int g = pn, n = (pm - g * 17) * 256 + rin, tok = n * 16 + (cin >> 4), ho = cin & 15, ch = g * 16 + ho;
        float u[8]; unpack8(*(const u32x4*)(ug + ((size_t)g * MROWS + tok) * 16 + ho), u);
        const f32x4 d0 = *(const f32x4*)(dskip + ch), d1 = *(const f32x4*)(dskip + ch + 4);
        f32x4 y0, y1;
#pragma unroll
        for (int i = 0; i < 4; ++i) { y0[i] = gelu_tanh(a[i] + d0[i] * u[i]); y1[i] = gelu_tanh(b[i] + d1[i] * u[4 + i]); }
        *(u32x4*)(zs + (size_t)tok * 256 + ch) = pack8(y0, y1);
    }
};
struct PutGlu {
    bf16_t* cat; const bf16_t* zs; const bf16_t* gate; const float* gb;
    __device__ __forceinline__ void put(int pm, int pn, int rin, int cin, const f32x4& a, const f32x4& b) const {
        const size_t row = (size_t)pm * 256 + rin; const int col = cin;
        float z[8], gt[8]; unpack8(*(const u32x4*)(zs + row * 256 + col), z); unpack8(*(const u32x4*)(gate + row * 256 + col), gt);
        const f32x4 b0 = *(const f32x4*)(gb + col), b1 = *(const f32x4*)(gb + col + 4);
        f32x4 y0, y1;
#pragma unroll
        for (int i = 0; i < 4; ++i) { y0[i] = z[i] * sigmf(a[i] + b0[i]) * siluf(gt[i]); y1[i] = z[4 + i] * sigmf(b[i] + b1[i]) * siluf(gt[4 + i]); }
        *(u32x4*)(cat + row * DM + 512 + col) = pack8(y0, y1);
    }
};

struct EpiInProj {
    static constexpr bool PERM = true, AFTER_DRAIN = false;
    bf16_t *pb, *ug, *us, *vtg, *hy0;
    LAS unsigned char* scratch;
    __device__ __forceinline__ void operator()(const f32x4 (&acc)[2][2][4][2], const pg8::Unit& u, int wr, int wc, int fr, int fq) const {
        const int pn = u.pn, pm = u.pm;
        const int bb = pm / 17, jt = (pm - bb * 17) * 256;
        LAS unsigned char* sw = scratch + (wr * 4 + wc) * 1280;
        const int ln = fq * 16 + fr, tch = ln >> 1, thalf = ln & 1;
#pragma unroll
        for (int ai = 0; ai < 2; ++ai)
#pragma unroll
            for (int m = 0; m < 4; ++m) {
                const int rin = ai * pg8::HALF + wr * 64 + m * 16 + fr;
#pragma unroll
                for (int bj = 0; bj < 2; ++bj) {
                    const int cin = bj * pg8::HALF + wc * 32 + 8 * fq;
                    const u32x4 w = pack8(acc[ai][bj][m][0], acc[ai][bj][m][1]);
                    const bool plain = pn < 4 || pn == 5 || pn == 7 || (pn == 4 && bj == 0);
                    if (plain) { *(u32x4*)(pb + (size_t)pn * BLKE + ((size_t)pm * 256 + rin) * 256 + cin) = w; }
                    else if (pn == 6) { const size_t row = (size_t)pm * 256 + rin; const int g = cin >> 4, hi0 = cin & 15;
                        *(u32x4*)(ug + ((size_t)g * MROWS + row) * 16 + hi0) = w;
                        *(u32x4*)(us + ((size_t)g * NCHUNK + (row >> 4)) * 512 + (row & 15) * 16 + hi0) = w; }
                    else {
                        *(LAS u32x4*)(sw + fr * 80 + fq * 16) = w;
                        asm volatile("" ::: "memory");
                        unsigned short e[8];
#pragma unroll
                        for (int i = 0; i < 8; ++i) e[i] = *(const LAS unsigned short*)(sw + (thalf * 8 + i) * 80 + tch * 2);
                        asm volatile("" ::: "memory");
                        u32x4 t; t.x = e[0] | ((unsigned)e[1] << 16); t.y = e[2] | ((unsigned)e[3] << 16); t.z = e[4] | ((unsigned)e[5] << 16); t.w = e[6] | ((unsigned)e[7] << 16);
                        const int chn = bj * pg8::HALF + wc * 32 + tch;
                        const int tok = jt + ai * pg8::HALF + wr * 64 + m * 16 + thalf * 8;
                        bf16_t* dst = (pn == 4) ? vtg + ((size_t)(bb * 2 + ((chn - 128) >> 6)) * 64 + ((chn - 128) & 63)) * NTOK + tok
                                                : hy0 + (size_t)(pn - 8) * BLKE + ((size_t)chn * 16 + bb) * NTOK + tok;
                        *(u32x4*)dst = t;
                    }
                    asm volatile("" ::: "memory");
                }
            }
    }
};

struct EpiP3 {
    static constexpr bool PERM = true, AFTER_DRAIN = false;
    PutPlain q; PutKm k; PutVt v; PutE e;
    __device__ __forceinline__ void operator()(const f32x4 (&acc)[2][2][4][2], const pg8::Unit& u, int wr, int wc, int fr, int fq) const {
#pragma unroll
        for (int ai = 0; ai < 2; ++ai)
#pragma unroll
            for (int m = 0; m < 4; ++m) {
                const int rin = ai * pg8::HALF + wr * 64 + m * 16 + fr;
#pragma unroll
                for (int bj = 0; bj < 2; ++bj) { const int cin = bj * pg8::HALF + wc * 32 + 8 * fq;
                    if (u.kd == 0) q.put(u.pm, u.pn, rin, cin, acc[ai][bj][m][0], acc[ai][bj][m][1]);
                    else if (u.kd == 1) k.put(u.pm, u.pn, rin, cin, acc[ai][bj][m][0], acc[ai][bj][m][1]);
                    else if (u.kd == 2) v.put(u.pm, u.pn, rin, cin, acc[ai][bj][m][0], acc[ai][bj][m][1]);
                    else e.put(u.pm, u.pn, rin, cin, acc[ai][bj][m][0], acc[ai][bj][m][1]);
                    asm volatile("" ::: "memory"); }
            }
    }
};

struct Params {
    const float* in[36];
    float* out;
    unsigned char* ws;
    int ph_lo, ph_hi, dry, pad;
};
enum { I_X = 0, I_C, I_CTX, I_CCTX, I_WMOD, I_BMOD, I_GPRE, I_GPOST, I_WIN, I_WOUT, I_GCQ, I_WUQ, I_GCKV, I_WUKV, I_GQ, I_GK,
       I_LRE, I_LIM, I_LSTEP, I_BRE, I_BIM, I_CRE, I_CIM, I_SSMD, I_GLUW, I_GLUB, I_HCW, I_HCB, I_HW1, I_HB1, I_HF1, I_HW2, I_HB2, I_HF2, I_HW3, I_HBIAS };

typedef __attribute__((address_space(4))) const unsigned long long* kargp_t;
struct Ctx {
    LAS unsigned char* lds;
    kargp_t ka;
    unsigned char* ws;
    int tid, lane, wave, G, bid, dry;
};
#define GAS __attribute__((address_space(1)))
#define KIN(i) ((const float*)(GAS const float*)c.ka[(i)])
#define KOUT() ((float*)(GAS float*)c.ka[36])
template <class T> __device__ __forceinline__ T* wsp(const Ctx& c, size_t off) { return (T*)(c.ws + off); }

__device__ __forceinline__ int wmap(int kind, int n) {
    if (kind == 0) { if (n < 192) return n; if (n < 224) return 320 + (n - 192); if (n < 256) return -1; if (n < 384) return 192 + (n - 256); if (n < 512) return -1; return n - 160; }
    if (kind == 2) return (n >> 6) * 128 + (n & 63);
    if (kind == 3) return (n >> 6) * 128 + 64 + (n & 63);
    return n;
}
__device__ __forceinline__ void wconv_tile(const Ctx& c, const float* src, int Ks, int Ns, int Nlim, bf16_t* dst, int Kp, int kind, int nt, int kt) {
    LAS float* T = (LAS float*)c.lds;
    const int n0 = nt * 64, k0 = kt * 128;
    const int nn = c.tid & 63, kk0 = c.tid >> 6; const int n = n0 + nn; const int sc = (n < Nlim) ? wmap(kind, n) : -1;
    float v[16];
#pragma unroll
    for (int i = 0; i < 16; ++i) { const int k = k0 + kk0 + 8 * i; v[i] = (k < Ks && sc >= 0) ? src[(size_t)k * Ns + sc] : 0.f; }
#pragma unroll
    for (int i = 0; i < 16; ++i) T[(kk0 + 8 * i) * 65 + nn] = v[i];
    __syncthreads();
#pragma unroll
    for (int i = 0; i < 2; ++i) { const int e = c.tid + i * 512, row = e >> 4, pc = e & 15; float x[8];
#pragma unroll
        for (int j = 0; j < 8; ++j) x[j] = T[(pc * 8 + j) * 65 + row];
        u32x4 w; w.x = cvt_pk_bf16(x[0], x[1]); w.y = cvt_pk_bf16(x[2], x[3]); w.z = cvt_pk_bf16(x[4], x[5]); w.w = cvt_pk_bf16(x[6], x[7]);
        *(u32x4*)(dst + (size_t)(n0 + row) * Kp + k0 + pc * 8) = w; }
    __syncthreads();
}

__device__ __forceinline__ void modv_job(const Ctx& c, int job) {
    const int l = job / 48, j0 = (job % 48) * 64;
    LAS float* sc = (LAS float*)c.lds;
    LAS float* red = sc + 17 * 1024;
    const float* cv = KIN(I_C); const float* cc = KIN(I_CCTX);
    for (int e = c.tid; e < 17 * 1024; e += 512) { const int r = e >> 10, k = e & 1023; const float v = (r < 16) ? cv[r * 1024 + k] : cc[k]; sc[e] = siluf(v); }
    __syncthreads();
    const int col = c.tid & 63, ks = c.tid >> 6;
    const float* w = KIN(I_WMOD) + (size_t)l * 1024 * 3072 + j0 + col;
    float acc[17];
#pragma unroll
    for (int r = 0; r < 17; ++r) acc[r] = 0.f;
    for (int k = ks * 128; k < ks * 128 + 128; ++k) { const float wv = w[(size_t)k * 3072];
#pragma unroll
        for (int r = 0; r < 17; ++r) acc[r] += sc[r * 1024 + k] * wv; }
#pragma unroll
    for (int r = 0; r < 17; ++r) red[(ks * 17 + r) * 64 + col] = acc[r];
    __syncthreads();
    float* mv = wsp<float>(c, WS_MODV);
    for (int e = c.tid; e < 17 * 64; e += 512) { const int r = e >> 6, cl = e & 63; float s = KIN(I_BMOD)[l * 3072 + j0 + cl];
#pragma unroll
        for (int q = 0; q < 8; ++q) s += red[(q * 17 + r) * 64 + cl];
        mv[((size_t)l * 17 + r) * 3072 + j0 + cl] = s; }
    __syncthreads();
}

__device__ __forceinline__ void rope_job(const Ctx& c) {
    float* rg = wsp<float>(c, WS_ROPEG); float* rm = wsp<float>(c, WS_ROPEM);
    for (int e = c.tid; e < 64 * 16; e += 512) { const int pos = e >> 4, f = e & 15; const float inv = powf(10000.f, -(float)(2 * f) / 32.f); const float a = (float)pos * inv; rg[e * 2] = cosf(a); rg[e * 2 + 1] = sinf(a); }
    for (int e = c.tid; e < 64 * 8; e += 512) { const int pos = e >> 3, f = e & 7; const float inv = powf(10000.f, -(float)(2 * f) / 16.f); const float a = (float)pos * inv; rm[e * 2] = cosf(a); rm[e * 2 + 1] = sinf(a); }
}

typedef float cpx __attribute__((ext_vector_type(2)));
#define CPX(a, b) ((cpx){(a), (b)})
__device__ __forceinline__ cpx cmul(cpx a, cpx b) { return CPX(a.x * b.x - a.y * b.y, a.x * b.y + a.y * b.x); }
__device__ __forceinline__ void ssm_tables_job(const Ctx& c, int job) {
    const int l = job >> 4, g = job & 15;
    LAS cpx* apow = (LAS cpx*)c.lds;
    LAS cpx* bbar = apow + 2 * 17 * 64;
    LAS cpx* cm = bbar + 2 * 64 * 16;
    LAS float* Kc = (LAS float*)(cm + 2 * 16 * 64);
    for (int e = c.tid; e < 2 * 64; e += 512) {
        const int d = e >> 6, p = e & 63; const size_t ix = (((size_t)l * 2 + d) * 16 + g) * 64 + p;
        const float lr = KIN(I_LRE)[ix], li = KIN(I_LIM)[ix], st = expf(KIN(I_LSTEP)[((size_t)l * 2 + d) * 16 + g]);
        for (int k = 0; k <= 16; ++k) { const float m = expf(lr * st * (float)k), an = li * st * (float)k; apow[(d * 17 + k) * 64 + p] = CPX(m * cosf(an), m * sinf(an)); }
    }
    __syncthreads();
    for (int e = c.tid; e < 2 * 64 * 16; e += 512) {
        const int d = e >> 10, p = (e >> 4) & 63, h = e & 15; const size_t ix = (((size_t)l * 2 + d) * 16 + g) * 64 + p;
        const float lr = KIN(I_LRE)[ix], li = KIN(I_LIM)[ix];
        const cpx a = apow[(d * 17 + 1) * 64 + p]; const cpx am1 = CPX(a.x - 1.f, a.y);
        const float den = lr * lr + li * li; const cpx q = CPX((am1.x * lr + am1.y * li) / den, (am1.y * lr - am1.x * li) / den);
        const cpx b = CPX(KIN(I_BRE)[ix * 16 + h], KIN(I_BIM)[ix * 16 + h]);
        bbar[e] = cmul(q, b);
        const size_t cx = ((((size_t)l * 2 + d) * 16 + g) * 16 + h) * 64 + p;
        cm[(d * 16 + h) * 64 + p] = CPX(KIN(I_CRE)[cx], KIN(I_CIM)[cx]);
    }
    __syncthreads();
    for (int e = c.tid; e < 2 * 16 * 256; e += 512) {
        const int d = e >> 12, dd = (e >> 8) & 15, ho = (e >> 4) & 15, hi = e & 15; float s = 0.f;
        for (int p = 0; p < 64; ++p) { const cpx w = cmul(cm[(d * 16 + ho) * 64 + p], apow[(d * 17 + dd) * 64 + p]); const cpx b = bbar[(d * 64 + p) * 16 + hi]; s += w.x * b.x - w.y * b.y; }
        Kc[e] = s;
    }
    __syncthreads();
    bf16_t* wkc = wsp<bf16_t>(c, WS_WKC) + ((size_t)l * 16 + g) * 256 * 512;
    for (int e = c.tid; e < 256 * 512; e += 512) {
        const int r = e >> 9, q = e & 511, i = r >> 4, ho = r & 15; float v;
        if (q < 256) { const int j = q >> 4, hi = q & 15; v = 0.f; if (j <= i) v += Kc[((0 * 16 + (i - j)) * 16 + ho) * 16 + hi]; if (j >= i) v += Kc[((1 * 16 + (j - i)) * 16 + ho) * 16 + hi]; }
        else { const int qq = q - 256, dq = qq >> 7, comp = (qq >> 6) & 1, p = qq & 63, k = dq == 0 ? i + 1 : 16 - i; const cpx w = cmul(cm[(dq * 16 + ho) * 64 + p], apow[(dq * 17 + k) * 64 + p]); v = comp == 0 ? w.x : -w.y; }
        wkc[e] = f2bf(v);
    }
    bf16_t* we = wsp<bf16_t>(c, WS_WE) + ((size_t)l * 16 + g) * 256 * 256;
    for (int e = c.tid; e < 256 * 256; e += 512) {
        const int qq = e >> 8, cidx = e & 255, j = cidx >> 4, hi = cidx & 15, dq = qq >> 7, comp = (qq >> 6) & 1, p = qq & 63, k = dq == 0 ? 15 - j : j;
        const cpx w = cmul(apow[(dq * 17 + k) * 64 + p], bbar[(dq * 64 + p) * 16 + hi]);
        we[e] = f2bf(comp == 0 ? w.x : w.y);
    }
    float* a16 = wsp<float>(c, WS_A16);
    for (int e = c.tid; e < 128; e += 512) { const int d = e >> 6, p = e & 63; const cpx a = apow[(d * 17 + 16) * 64 + p]; const size_t ix = ((((size_t)l * 2 + d) * 16 + g) * 64 + p) * 2; a16[ix] = a.x; a16[ix + 1] = a.y; }
    __syncthreads();
}

__device__ __forceinline__ void hyena_mlp_job(const Ctx& c, int job) {
    const int l = job / 136, tt = job % 136;
    const bool isctx = tt >= 128; const int n = isctx ? CTXL : SEQL; const int t0 = isctx ? (tt - 128) * 32 : tt * 32;
    LAS float* z = (LAS float*)c.lds;
    LAS float* h1 = z + 32 * 36;
    LAS float* h2 = h1 + 32 * 64;
    for (int e = c.tid; e < 32 * 33; e += 512) {
        const int ti = e / 33, f = e % 33, t = t0 + ti; float v;
        if (f == 0) v = (float)t / (float)(n - 1);
        else { const int k = (f - 1) & 15; const float band = 1e-4f + (float)k * ((15.f - 1e-4f) / 15.f); const float om = 6.283185307179586f * (float)t / (float)n; v = (f <= 16) ? cosf(band * om) : -sinf(band * om); }
        z[ti * 36 + f] = v;
    }
    __syncthreads();
    for (int e = c.tid; e < 32 * 64; e += 512) {
        const int ti = e >> 6, j = e & 63; float s = KIN(I_HB1)[l * 64 + j];
        for (int f = 0; f < 33; ++f) s += z[ti * 36 + f] * KIN(I_HW1)[((size_t)l * 33 + f) * 64 + j];
        h1[e] = sinf(KIN(I_HF1)[l * 64 + j] * s);
    }
    __syncthreads();
    for (int e = c.tid; e < 32 * 64; e += 512) {
        const int ti = e >> 6, j = e & 63; float s = KIN(I_HB2)[l * 64 + j];
        for (int f = 0; f < 64; ++f) s += h1[ti * 64 + f] * KIN(I_HW2)[((size_t)l * 64 + f) * 64 + j];
        h2[e] = sinf(KIN(I_HF2)[l * 64 + j] * s);
    }
    __syncthreads();
    float* hT = wsp<float>(c, WS_HT) + (size_t)l * 1024 * NTOK;
    const float mind = -3.070113457325394f, maxd = -15.35056728662697f;
#pragma unroll
    for (int cc = 0; cc < 2; ++cc) {
        const int col = c.tid + cc * 512;
        float acc[32];
#pragma unroll
        for (int ti = 0; ti < 32; ++ti) acc[ti] = 0.f;
        for (int f = 0; f < 64; ++f) { const float w = KIN(I_HW3)[((size_t)l * 64 + f) * 1024 + col];
#pragma unroll
            for (int ti = 0; ti < 32; ++ti) acc[ti] += h2[ti * 64 + f] * w; }
        const int ch = col & 255; const float delta = fabsf(mind + (maxd - mind) * (float)ch / 255.f);
        float* dst = hT + (size_t)col * NTOK + (isctx ? SEQL : 0) + t0;
#pragma unroll
        for (int ti = 0; ti < 32; ++ti) { const float tn = (float)(t0 + ti) / (float)(n - 1); dst[ti] = acc[ti] * expf(-tn * delta); }
    }
    __syncthreads();
}

__device__ __forceinline__ void hyena_pack_job(const Ctx& c, int job) {
    const int l = job >> 9, o = (job >> 8) & 1, ch = job & 255;
    const float* hT = wsp<float>(c, WS_HT) + (size_t)l * 1024 * NTOK;
    const float* fw = hT + (size_t)(o * 512 + ch) * NTOK; const float* bw = hT + (size_t)(o * 512 + 256 + ch) * NTOK;
    LAS float* red = (LAS float*)c.lds;
    float fa[8], ba[8];
#pragma unroll
    for (int k = 0; k < 8; ++k) { fa[k] = fw[c.tid + 512 * k]; ba[k] = bw[c.tid + 512 * k]; }
    const float fc = (c.tid < CTXL) ? fw[SEQL + c.tid] : 0.f, bc = (c.tid < CTXL) ? bw[SEQL + c.tid] : 0.f;
    float s0 = 0.f, s1 = fc * fc + bc * bc;
#pragma unroll
    for (int k = 0; k < 8; ++k) s0 += fa[k] * fa[k] + ba[k] * ba[k];
    s0 = wave_sum(s0); s1 = wave_sum(s1);
    if (c.lane == 0) { red[c.wave] = s0; red[8 + c.wave] = s1; }
    __syncthreads();
    float t0 = 0.f, t1 = 0.f;
#pragma unroll
    for (int w = 0; w < 8; ++w) { t0 += red[w]; t1 += red[8 + w]; }
    const float r0 = rsqrtf(t0 + EPS), r1 = rsqrtf(t1 + EPS);
    bf16_t* gr = wsp<bf16_t>(c, WS_GR) + (((size_t)l * 2 + o) * 256 + ch) * 8192;
#pragma unroll
    for (int k = 0; k < 8; ++k) { const int d = c.tid + 512 * k; gr[4095 - d] = f2bf(fa[k] * r0); if (d >= 1) gr[4095 + d] = f2bf(ba[k] * r0); }
    if (c.tid == 0) gr[8191] = 0;
    bf16_t* grc = wsp<bf16_t>(c, WS_GRC) + (((size_t)l * 2 + o) * 256 + ch) * 512;
    if (c.tid < CTXL) { const int d = c.tid; grc[255 - d] = f2bf(fc * r1); if (d >= 1) grc[255 + d] = f2bf(bc * r1); }
    if (c.tid == 0) grc[511] = 0;
    __syncthreads();
}

__device__ __forceinline__ void norm_rows(const Ctx& c, int l  , int next  , int r0 = -1  , int r1 = 0) {
    const float* mvl = wsp<float>(c, WS_MODV) + (size_t)(l < 0 ? 0 : l) * 17 * 3072;
    const float* mvn = wsp<float>(c, WS_MODV) + (size_t)(next < 0 ? 0 : next) * 17 * 3072;
    const bf16_t* outb = wsp<bf16_t>(c, WS_OUTB);
    bf16_t* hb = wsp<bf16_t>(c, WS_HCAT);
    float* ctxr = wsp<float>(c, WS_CTXR);
    const float* xin0 = KIN(I_X); const float* cin0 = KIN(I_CTX); float* outp = KOUT();
    const float* gpost = KIN(I_GPOST) + (l < 0 ? 0 : l) * DM; const float* gpre = KIN(I_GPRE) + (next < 0 ? 0 : next) * DM;
    const int nw = c.G * 8, lane4 = c.lane * 4;
    const int rb0 = r0 >= 0 ? r0 + c.wave * 2 : (c.bid * 8 + c.wave) * 2, rbe = r0 >= 0 ? r1 : MROWS, rbs = r0 >= 0 ? 16 : nw * 2;
    for (int rowb = rb0; rowb < rbe; rowb += rbs) {
        f32x4 xv[2][4]; u32x2 ow[2][4]; const float* xin[2]; float* xout[2]; int mr[2]; bool live[2], isc[2];
#pragma unroll
        for (int rr = 0; rr < 2; ++rr) {
            const int row = rowb + rr, b = row / NTOK, j = row - b * NTOK; isc[rr] = j >= SEQL; live[rr] = !(next < 0 && isc[rr]); mr[rr] = isc[rr] ? 16 : b;
            if (isc[rr]) { xout[rr] = ctxr + ((size_t)b * CTXL + (j - SEQL)) * DM; xin[rr] = (l < 0) ? cin0 + ((size_t)b * CTXL + (j - SEQL)) * DM : xout[rr]; }
            else { xout[rr] = outp + ((size_t)b * SEQL + j) * DM; xin[rr] = (l <= 0) ? xin0 + ((size_t)b * SEQL + j) * DM : xout[rr]; }
#pragma unroll
            for (int q = 0; q < 4; ++q) { xv[rr][q] = __builtin_nontemporal_load((const f32x4*)(xin[rr] + q * 256 + lane4)); if (l >= 0) ow[rr][q] = *(const u32x2*)(outb + (size_t)row * DM + q * 256 + lane4); }
        }
#pragma unroll
        for (int rr = 0; rr < 2; ++rr) {
            if (!live[rr]) continue;
            const int row = rowb + rr;
            if (l >= 0) {
                float ov[16]; float ss = 0.f;
#pragma unroll
                for (int q = 0; q < 4; ++q) { ov[q * 4] = lo_bf(ow[rr][q].x); ov[q * 4 + 1] = hi_bf(ow[rr][q].x); ov[q * 4 + 2] = lo_bf(ow[rr][q].y); ov[q * 4 + 3] = hi_bf(ow[rr][q].y); }
#pragma unroll
                for (int i = 0; i < 16; ++i) ss += ov[i] * ov[i];
                ss = wave_sum(ss); const float rs = rsqrtf(ss * (1.f / DM) + EPS);
#pragma unroll
                for (int q = 0; q < 4; ++q) { const int col = q * 256 + lane4; const f32x4 gp = *(const f32x4*)(gpost + col); const f32x4 gt = *(const f32x4*)(mvl + mr[rr] * 3072 + 2048 + col);
#pragma unroll
                    for (int i = 0; i < 4; ++i) xv[rr][q][i] += gt[i] * (ov[q * 4 + i] * rs * gp[i]); }
            }
            if ((l >= 0 || isc[rr]) && !c.dry) {
#pragma unroll
                for (int q = 0; q < 4; ++q) __builtin_nontemporal_store(xv[rr][q], (f32x4*)(xout[rr] + q * 256 + lane4));
            }
            if (next >= 0) {
                float ss = 0.f;
#pragma unroll
                for (int q = 0; q < 4; ++q)
#pragma unroll
                    for (int i = 0; i < 4; ++i) ss += xv[rr][q][i] * xv[rr][q][i];
                ss = wave_sum(ss); const float rs = rsqrtf(ss * (1.f / DM) + EPS);
#pragma unroll
                for (int q = 0; q < 4; ++q) { const int col = q * 256 + lane4; const f32x4 gp = *(const f32x4*)(gpre + col);
                    const f32x4 sh = *(const f32x4*)(mvn + mr[rr] * 3072 + col), sc = *(const f32x4*)(mvn + mr[rr] * 3072 + 1024 + col);
                    float hv[4];
#pragma unroll
                    for (int i = 0; i < 4; ++i) hv[i] = xv[rr][q][i] * rs * gp[i] * (1.f + sc[i]) + sh[i];
                    u32x2 w; w.x = cvt_pk_bf16(hv[0], hv[1]); w.y = cvt_pk_bf16(hv[2], hv[3]); *(u32x2*)(hb + (size_t)row * DM + col) = w; }
            }
        }
    }
}

__device__ __forceinline__ void p2_rows(const Ctx& c, int l) {
    bf16_t* pb = wsp<bf16_t>(c, WS_PB);
    bf16_t* B0 = pb; bf16_t* B1 = pb + BLKE; bf16_t* B3 = pb + 3 * BLKE; const bf16_t* B4 = pb + 4 * BLKE;
    bf16_t* kr = wsp<bf16_t>(c, WS_KR); bf16_t* kg = wsp<bf16_t>(c, WS_KG); bf16_t* ug = wsp<bf16_t>(c, WS_UG); bf16_t* us = wsp<bf16_t>(c, WS_US);
    const float* ropeG = wsp<float>(c, WS_ROPEG); const float* ropeM = wsp<float>(c, WS_ROPEM);
    const int lane = c.lane;
    const f32x4 gcq = (lane < 48) ? *(const f32x4*)(KIN(I_GCQ) + l * 192 + lane * 4) : (f32x4){0.f, 0.f, 0.f, 0.f};
    const f32x4 gckv = (lane < 32) ? *(const f32x4*)(KIN(I_GCKV) + l * 128 + lane * 4) : (f32x4){0.f, 0.f, 0.f, 0.f};
    const f32x4 gq = *(const f32x4*)(KIN(I_GQ) + l * 64 + (lane & 15) * 4), gk = *(const f32x4*)(KIN(I_GK) + l * 64 + (lane & 15) * 4);
    for (int rowb = (c.bid * 8 + c.wave) * 4; rowb < MROWS; rowb += c.G * 8 * 4) {
        u32x2 w0[4], w1[4], w3[4], w4[4];
#pragma unroll
        for (int rr = 0; rr < 4; ++rr) { const size_t ro = (size_t)(rowb + rr) * 256 + lane * 4;
            w0[rr] = *(const u32x2*)(B0 + ro); w1[rr] = *(const u32x2*)(B1 + ro); w3[rr] = *(const u32x2*)(B3 + ro); w4[rr] = *(const u32x2*)(B4 + ro); }
#pragma unroll
        for (int rr = 0; rr < 4; ++rr) {
            const int row = rowb + rr;
            const int b = row / NTOK, j = row - b * NTOK; const bool islat = j < SEQL; const int rowpos = (j >> 6) & 63, colpos = j & 63;
            const size_t ro = (size_t)row * 256 + lane * 4;
            {
                const u32x2 w = w0[rr]; float x[4] = {lo_bf(w.x), hi_bf(w.x), lo_bf(w.y), hi_bf(w.y)};
                float ss = (lane < 48) ? (x[0] * x[0] + x[1] * x[1] + x[2] * x[2] + x[3] * x[3]) : 0.f; ss = wave_sum(ss);
                const float rs = rsqrtf(ss * (1.f / 192.f) + EPS);
                float xp[4];
#pragma unroll
                for (int i = 0; i < 4; ++i) xp[i] = swz_xor<2>(x[i]);
                u32x2 o; o.x = 0u; o.y = 0u;
                if (lane < 48) { o.x = cvt_pk_bf16(x[0] * rs * gcq[0], x[1] * rs * gcq[1]); o.y = cvt_pk_bf16(x[2] * rs * gcq[2], x[3] * rs * gcq[3]); }
                else if (lane < 56) {
                    const int t = lane - 48; float y[4];
                    if (islat) { const int pos = (t & 4) ? colpos : rowpos; const bool isx2 = (t & 2) != 0;
#pragma unroll
                        for (int i = 0; i < 4; ++i) { const int f = 4 * (t & 1) + i; const float cs = ropeM[(pos * 8 + f) * 2], sn = ropeM[(pos * 8 + f) * 2 + 1]; y[i] = isx2 ? (xp[i] * sn + x[i] * cs) : (x[i] * cs - xp[i] * sn); } }
                    else {
#pragma unroll
                        for (int i = 0; i < 4; ++i) y[i] = x[i]; }
                    u32x2 kk; kk.x = cvt_pk_bf16(y[0], y[1]); kk.y = cvt_pk_bf16(y[2], y[3]); *(u32x2*)(kr + (size_t)row * 32 + t * 4) = kk;
                }
                if (!c.dry) *(u32x2*)(B0 + ro) = o;
            }
            {
                const u32x2 w = w1[rr]; float x[4] = {lo_bf(w.x), hi_bf(w.x), lo_bf(w.y), hi_bf(w.y)};
                float ss = (lane < 32) ? (x[0] * x[0] + x[1] * x[1] + x[2] * x[2] + x[3] * x[3]) : 0.f; ss = wave_sum(ss);
                const float rs = rsqrtf(ss * (1.f / 128.f) + EPS);
                u32x2 o; o.x = 0u; o.y = 0u;
                if (lane < 32) { o.x = cvt_pk_bf16(x[0] * rs * gckv[0], x[1] * rs * gckv[1]); o.y = cvt_pk_bf16(x[2] * rs * gckv[2], x[3] * rs * gckv[3]); }
                if (!c.dry) *(u32x2*)(B1 + ro) = o;
            }
#pragma unroll
            for (int which = 0; which < 2; ++which) {
                const u32x2 w = which == 0 ? w3[rr] : w4[rr]; float x[4] = {lo_bf(w.x), hi_bf(w.x), lo_bf(w.y), hi_bf(w.y)};
                float ss = x[0] * x[0] + x[1] * x[1] + x[2] * x[2] + x[3] * x[3];
                ss += swz_xor<1>(ss); ss += swz_xor<2>(ss); ss += swz_xor<4>(ss); ss += swz_xor<8>(ss);
                const float rs = rsqrtf(ss * (1.f / 64.f) + EPS);
                const int t = lane & 15; const f32x4 g = which == 0 ? gq : gk;
#pragma unroll
                for (int i = 0; i < 4; ++i) x[i] = x[i] * rs * g[i];
                float xp[4];
#pragma unroll
                for (int i = 0; i < 4; ++i) xp[i] = swz_xor<4>(x[i]);
                if (islat) { const int pos = (t & 8) ? colpos : rowpos; const bool isx2 = (t & 4) != 0;
#pragma unroll
                    for (int i = 0; i < 4; ++i) { const int f = 4 * (t & 3) + i; const float cs = ropeG[(pos * 16 + f) * 2], sn = ropeG[(pos * 16 + f) * 2 + 1]; x[i] = isx2 ? (xp[i] * sn + x[i] * cs) : (x[i] * cs - xp[i] * sn); } }
                if (which == 0) { const float qs = 0.125f * LOG2E; u32x2 o; o.x = cvt_pk_bf16(x[0] * qs, x[1] * qs); o.y = cvt_pk_bf16(x[2] * qs, x[3] * qs); if (!c.dry) *(u32x2*)(B3 + ro) = o; }
                else if (lane < 32) { u32x2 o; o.x = cvt_pk_bf16(x[0], x[1]); o.y = cvt_pk_bf16(x[2], x[3]); *(u32x2*)(kg + ((size_t)(b * 2 + (lane >> 4)) * NTOK + j) * 64 + t * 4) = o; }
            }
        }
    }
}
#ifndef PROBE_ABL
#define PROBE_ABL 0
#endif
#ifndef PROBE_GQAONLY
#define PROBE_GQAONLY 0
#endif
template <int DK, bool SUB, bool NOMAX = false, int ABL = 0>
__device__ __forceinline__ bool attn_unit(float (&rowmax)[2], const Ctx& c, const bf16_t* Qp, int qpitch, const bf16_t* Kp, const bf16_t* Vtp, int kt0, int nkt, int nrows,
                                          const bf16_t* gatep, bf16_t* outp, bool rope, int j0, float qscale, const float* ropeM) {
    constexpr int KS = DK / 16, KPC = DK / 8, KPITCH = DK * 2 + 16, KB = 64 * KPITCH, VPITCH = 144, VB = 64 * VPITCH;
    constexpr int KOFF = 0, VOFF = 3 * KB;
    constexpr float LIM = 60.f;
    static_assert(KB % 16 == 0 && VB % 16 == 0, "attention LDS buffer alignment");
    const int tid = c.tid, lane = c.lane, wave = c.wave;
    const int lq_ = opaque(lane), q = lq_ & 31, h = lq_ >> 5;
    LAS unsigned char* lds = c.lds;
    const int rbase = (wave * 64 < nrows) ? wave * 64 : wave * 64 - 256;
    const bool live = wave * 64 < nrows;
    bf16x8 qf[2][KS];
#pragma unroll
    for (int qt = 0; qt < 2; ++qt) {
        const bf16_t* qrow = Qp + (size_t)(rbase + qt * 32 + q) * qpitch + 8 * h;
#pragma unroll
        for (int ks = 0; ks < KS; ++ks) qf[qt][ks] = *(const bf16x8*)(qrow + 16 * ks);
        if (DK == 96) {
            const int jj = j0 + rbase + qt * 32 + q;
#pragma unroll
            for (int ks = 0; ks < KS; ++ks) {
                float x[8]; unpack8(__builtin_bit_cast(u32x4, qf[qt][ks]), x);
                if (ks >= 4) {
                    const int pos = (ks == 4) ? ((jj >> 6) & 63) : (jj & 63);
#pragma unroll
                    for (int e = 0; e < 8; ++e) { const float xp = half_other(x[e], h); const float cs = ropeM[(pos * 8 + e) * 2], sn = ropeM[(pos * 8 + e) * 2 + 1];
                        const float r = h ? (xp * sn + x[e] * cs) : (x[e] * cs - xp * sn); x[e] = rope ? r : x[e]; }
                }
                u32x4 w; w.x = cvt_pk_bf16(x[0] * qscale, x[1] * qscale); w.y = cvt_pk_bf16(x[2] * qscale, x[3] * qscale); w.z = cvt_pk_bf16(x[4] * qscale, x[5] * qscale); w.w = cvt_pk_bf16(x[6] * qscale, x[7] * qscale);
                qf[qt][ks] = __builtin_bit_cast(bf16x8, w);
            }
        }
    }
    f32x16 o00, o01, o10, o11;
#pragma unroll
    for (int i = 0; i < 16; ++i) { o00[i] = 0.f; o01[i] = 0.f; o10[i] = 0.f; o11[i] = 0.f; }
    const float m0 = SUB ? rowmax[0] : 0.f, m1 = SUB ? rowmax[1] : 0.f; float l0 = 0.f, l1 = 0.f;
    float rmax0 = -1e30f, rmax1 = -1e30f;
    const int tq_ = opaque(tid);
    const int kst0 = (tq_ / KPC) * KPITCH + (tq_ % KPC) * 16, kst1 = ((tq_ + 512) / KPC) * KPITCH + ((tq_ + 512) % KPC) * 16;
    const int kgl0 = ((tq_ / KPC) * DK + (tq_ % KPC) * 8) * 2, kgl1 = (((tq_ + 512) / KPC) * DK + ((tq_ + 512) % KPC) * 8) * 2;
    const int vst = (tq_ >> 3) * VPITCH + ((tq_ & 7) >> 1) * 32 + ((tq_ & 7) & 1) * 8, vgl = ((tq_ >> 3) * NTOK + (tq_ & 7) * 8) * 2;
    const bool has2 = (DK == 96) && tq_ < 256;
    const int kfo = q * KPITCH + 16 * h, vfo = q * VPITCH + 16 * h;
    const char* Kc = (const char*)Kp; const char* Vc = (const char*)Vtp;
    u32x4 kreg0, kreg1 = {0u, 0u, 0u, 0u}, vreg;
#define AT_GLOADK(kt) do { if (ABL & 1) break; const char* kb_ = Kc + (size_t)(kt) * (64 * DK * 2); kreg0 = *(const u32x4*)(kb_ + kgl0); if (has2) kreg1 = *(const u32x4*)(kb_ + kgl1); } while (0)
#define AT_GLOADV(kt) do { if (ABL & 1) break; vreg = *(const u32x4*)(Vc + (size_t)(kt) * 128 + vgl); } while (0)
#define AT_WRITEK(bi) do { if (ABL & 1) break; LAS unsigned char* bb = lds + KOFF + (bi) * KB; *(LAS u32x4*)(bb + kst0) = kreg0; if (has2) *(LAS u32x4*)(bb + kst1) = kreg1; } while (0)
#define AT_WRITEV(bi) do { if (ABL & 1) break; LAS u32x2* vd = (LAS u32x2*)(lds + VOFF + (bi) * VB + vst); vd[0] = (u32x2){vreg.x, vreg.y}; vd[2] = (u32x2){vreg.z, vreg.w}; } while (0)
#define AT_KPRE(bi, jh) do { if (KPRE) { const LAS unsigned char* kb_ = lds + KOFF + (bi) * KB + (jh) * 32 * KPITCH + kfo; \
        _Pragma("unroll") for (int ks = 0; ks < KS; ++ks) kf[ks] = *(const LAS bf16x8*)(kb_ + 32 * ks); } } while (0)
#define AT_QK(S0, S1, bi, jh) do { const LAS unsigned char* kb = lds + KOFF + (bi) * KB + (jh) * 32 * KPITCH + kfo; \
        _Pragma("unroll") for (int i = 0; i < 16; ++i) { S0[i] = 0.f; S1[i] = 0.f; } \
        if (!(ABL & 8)) _Pragma("unroll") for (int ks = 0; ks < KS; ++ks) { \
            const bf16x8 a0 = KPRE ? kf[ks] : *(const LAS bf16x8*)(kb + 32 * ks); \
            S0 = __builtin_amdgcn_mfma_f32_32x32x16_bf16(a0, qf[0][ks], S0, 0, 0, 0); \
            S1 = __builtin_amdgcn_mfma_f32_32x32x16_bf16(a0, qf[1][ks], S1, 0, 0, 0); } } while (0)
#define AT_MAX(S, RM) do { if (!SUB && !NOMAX) { _Pragma("unroll") for (int i = 0; i < 16; i += 2) RM = max3_raw(RM, S[i], S[i + 1]); } } while (0)
#define AT_EXP(S, M, L, PK0, PK1) do { float ps = 0.f; \
        _Pragma("unroll") for (int i = 0; i < 16; ++i) { S[i] = (ABL & 2) ? S[i] * 0.001f : __builtin_amdgcn_exp2f(SUB ? S[i] - M : S[i]); ps += S[i]; } \
        L += ps; u32x4 w; \
        w.x = cvt_pk_bf16(S[0], S[1]); w.y = cvt_pk_bf16(S[2], S[3]); w.z = cvt_pk_bf16(S[4], S[5]); w.w = cvt_pk_bf16(S[6], S[7]); PK0 = __builtin_bit_cast(bf16x8, w); \
        w.x = cvt_pk_bf16(S[8], S[9]); w.y = cvt_pk_bf16(S[10], S[11]); w.z = cvt_pk_bf16(S[12], S[13]); w.w = cvt_pk_bf16(S[14], S[15]); PK1 = __builtin_bit_cast(bf16x8, w); } while (0)
#define AT_VLOAD() do { va00 = *(const LAS bf16x8*)(vb); va10 = *(const LAS bf16x8*)(vb + 32 * VPITCH); va01 = *(const LAS bf16x8*)(vb + 32); va11 = *(const LAS bf16x8*)(vb + 32 * VPITCH + 32); } while (0)
#define AT_SUB(SC0, SC1, SN0, SN1, vbi, jh, nbi, njh) do { \
          \
        const LAS unsigned char* vb = lds + VOFF + (vbi) * VB + (jh) * 64 + vfo; \
        bf16x8 va00, va10, va01, va11; \
        if (DK == 64) { AT_VLOAD(); }        \
        AT_MAX(SC0, rmax0); AT_MAX(SC1, rmax1); \
        AT_QK(SN0, SN1, nbi, njh); \
        bf16x8 p00, p01, p10, p11; \
        AT_EXP(SC0, m0, l0, p00, p01); AT_EXP(SC1, m1, l1, p10, p11); \
        if (DK != 64) { AT_VLOAD(); } \
        if (!(ABL & 4)) { \
            o00 = __builtin_amdgcn_mfma_f32_32x32x16_bf16(va00, p00, o00, 0, 0, 0); \
            o01 = __builtin_amdgcn_mfma_f32_32x32x16_bf16(va10, p00, o01, 0, 0, 0); \
            o10 = __builtin_amdgcn_mfma_f32_32x32x16_bf16(va00, p10, o10, 0, 0, 0); \
            o11 = __builtin_amdgcn_mfma_f32_32x32x16_bf16(va10, p10, o11, 0, 0, 0); \
            o00 = __builtin_amdgcn_mfma_f32_32x32x16_bf16(va01, p01, o00, 0, 0, 0); \
            o01 = __builtin_amdgcn_mfma_f32_32x32x16_bf16(va11, p01, o01, 0, 0, 0); \
            o10 = __builtin_amdgcn_mfma_f32_32x32x16_bf16(va01, p11, o10, 0, 0, 0); \
            o11 = __builtin_amdgcn_mfma_f32_32x32x16_bf16(va11, p11, o11, 0, 0, 0); } \
        if (ABL & 4) { asm volatile("" :: "v"(p00), "v"(p01), "v"(p10), "v"(p11), "v"(va00), "v"(va10), "v"(va01), "v"(va11)); } \
        } while (0)
    if (!SUB && !NOMAX && tid == 0) *(volatile LAS unsigned*)(lds + LDS_MISC_OFF + 24) = 0u;
    AT_GLOADK(kt0); AT_GLOADV(kt0); AT_WRITEK(0); AT_WRITEV(0);
    AT_GLOADK(kt0 + 1); AT_WRITEK(1);
    __syncthreads();
    f32x16 sa0, sa1, sb0, sb1;
    constexpr bool KPRE = (DK == 64);
    bf16x8 kf[KS];
    AT_KPRE(0, 0);
    AT_QK(sa0, sa1, 0, 0);
    AT_KPRE(0, 1);
    int kb0 = 0, kb1 = 1, kb2 = 2;
    for (int t = 0; t < nkt; ++t) {
        const int tk = (t + 2 < nkt) ? t + 2 : nkt - 1, tv = (t + 1 < nkt) ? t + 1 : nkt - 1;
        AT_GLOADK(kt0 + tk);
        AT_SUB(sa0, sa1, sb0, sb1, t & 1, 0, kb0, 1);
        AT_KPRE(kb1, 0);
        AT_WRITEK(kb2);
        AT_GLOADV(kt0 + tv);
        AT_SUB(sb0, sb1, sa0, sa1, t & 1, 1, kb1, 0);
        AT_KPRE(kb1, 1);
        AT_WRITEV((t + 1) & 1);
        if (!(ABL & 16)) __syncthreads();
        const int tmp = kb0; kb0 = kb1; kb1 = kb2; kb2 = tmp;
    }
#undef AT_GLOADK
#undef AT_GLOADV
#undef AT_WRITEK
#undef AT_WRITEV
#undef AT_QK
#undef AT_KPRE
#undef AT_MAX
#undef AT_EXP
#undef AT_SUB
#undef AT_VLOAD
    bool bad = false;
    if (!SUB && !NOMAX) { const float r0 = half_max(rmax0), r1 = half_max(rmax1); rowmax[0] = r0; rowmax[1] = r1; const bool b_ = live && !(r0 < LIM && r0 > -LIM && r1 < LIM && r1 > -LIM); volatile LAS unsigned* flg = (volatile LAS unsigned*)(lds + LDS_MISC_OFF + 24); if (__any(b_ ? 1 : 0) && opaque(lane) == 0) *flg = 1u; __syncthreads(); bad = *flg != 0u; __syncthreads(); }
    if (live && !bad) {
        const int le_ = opaque(lane), q = le_ & 31, h = le_ >> 5;
#pragma unroll
        for (int qt = 0; qt < 2; ++qt) {
            const float lr = qt ? l1 : l0; const float lt = half_sum(lr), inv = 1.f / lt;
            const size_t row = (size_t)(rbase + qt * 32 + q);
#pragma unroll
            for (int dt = 0; dt < 2; ++dt)
#pragma unroll
                for (int g4 = 0; g4 < 4; ++g4) {
                    const int dv0 = dt * 32 + 8 * g4 + 4 * h;
                    const u32x2 gw = *(const u32x2*)(gatep + row * 256 + dv0);
                    const float g0 = siluf(lo_bf(gw.x)), g1 = siluf(hi_bf(gw.x)), g2 = siluf(lo_bf(gw.y)), g3 = siluf(hi_bf(gw.y));
                    const f32x16& o = qt ? (dt ? o11 : o10) : (dt ? o01 : o00);
                    u32x2 w; w.x = cvt_pk_bf16(o[4 * g4] * inv * g0, o[4 * g4 + 1] * inv * g1); w.y = cvt_pk_bf16(o[4 * g4 + 2] * inv * g2, o[4 * g4 + 3] * inv * g3);
                    *(u32x2*)(outp + row * DM + dv0) = w;
                }
        }
    }
    return bad;
}

template <int N>
__device__ __forceinline__ void hyena_conv(const Ctx& c, LAS unsigned char* ub, LAS unsigned char* gb, int pass, const bf16_t* xmul  , float bias,
                                           bf16_t* zdst  , const bf16_t* gmul, bf16_t* cat  , float cw0, float cw1, float cw2, float cb  ) {
    constexpr int UP = (N + 256) * 2 + 16, NPAIR = N / 256, OFF8 = N - 8;
    const int lane = c.lane, i16 = lane & 15, kq = lane >> 4;
    for (int pr = c.wave; pr < NPAIR; pr += 8) {
        const int t0 = pr * 256;
        u32x4 xq[2][4], gq[2][4]; bf16_t xl[2][4], xr[2][4];
#pragma unroll
        for (int half = 0; half < 2; ++half)
#pragma unroll
            for (int r = 0; r < 4; ++r) { const int t8 = t0 + half * 128 + 32 * kq + 8 * r; const bf16_t* xp_ = xmul + (size_t)i16 * NTOK + t8; xq[half][r] = *(const u32x4*)xp_;
                xl[half][r] = (t8 > 0) ? xp_[-1] : (bf16_t)0; xr[half][r] = (t8 + 8 < N) ? xp_[8] : (bf16_t)0;
                gq[half][r] = (pass == 1) ? *(const u32x4*)(gmul + (size_t)i16 * NTOK + t8) : (u32x4){0u, 0u, 0u, 0u}; }
        f32x4 acc[2][8];
#pragma unroll
        for (int m = 0; m < 8; ++m) { acc[0][m] = (f32x4){0.f, 0.f, 0.f, 0.f}; acc[1][m] = (f32x4){0.f, 0.f, 0.f, 0.f}; }
        const LAS unsigned char* up = ub + i16 * UP + 256 + kq * 16;
        const LAS unsigned char* gp = gb + (OFF8 - t0 - 8 * i16 + 8 * kq) * 2;
        bf16x8 bfa = *(const LAS bf16x8*)(up - 256), bfb = *(const LAS bf16x8*)(up);
        u32x4 wa = *(const LAS u32x4*)(gp - 256), wb = *(const LAS u32x4*)(gp - 256 + 16);
        for (int s0 = -128; s0 < N; s0 += 32) {
            const int sn = (s0 + 32 < N) ? s0 + 32 : s0;
            const bf16x8 bfan = *(const LAS bf16x8*)(up + sn * 2), bfbn = *(const LAS bf16x8*)(up + sn * 2 + 256);
            const u32x4 wan = *(const LAS u32x4*)(gp + sn * 2), wbn = *(const LAS u32x4*)(gp + sn * 2 + 16);
            const unsigned w[8] = {wa.x, wa.y, wa.z, wa.w, wb.x, wb.y, wb.z, wb.w};
            unsigned sh[7];
#pragma unroll
            for (int k = 0; k < 7; ++k) sh[k] = __builtin_amdgcn_alignbit(w[k + 1], w[k], 16);
#pragma unroll
            for (int m = 0; m < 8; ++m) {
                u32x4 a;
                if (m & 1) { const int d0 = (7 - m) >> 1; a = (u32x4){w[d0], w[d0 + 1], w[d0 + 2], w[d0 + 3]}; }
                else { const int d0 = (6 - m) >> 1; a = (u32x4){sh[d0], sh[d0 + 1], sh[d0 + 2], sh[d0 + 3]}; }
                acc[0][m] = __builtin_amdgcn_mfma_f32_16x16x32_bf16(__builtin_bit_cast(bf16x8, a), bfa, acc[0][m], 0, 0, 0);
                acc[1][m] = __builtin_amdgcn_mfma_f32_16x16x32_bf16(__builtin_bit_cast(bf16x8, a), bfb, acc[1][m], 0, 0, 0);
            }
            bfa = bfan; bfb = bfbn; wa = wan; wb = wbn;
        }
#pragma unroll
        for (int half = 0; half < 2; ++half)
#pragma unroll
            for (int r = 0; r < 4; ++r) {
                const int t8 = t0 + half * 128 + 32 * kq + 8 * r;
                float uu[8], xr8[8], xm[8]; unpack8(*(const LAS u32x4*)(ub + i16 * UP + 256 + t8 * 2), uu); unpack8(xq[half][r], xr8);
                {   float pv = bf2f(xl[half][r]);
#pragma unroll
                    for (int m = 0; m < 8; ++m) { const float nx = (m < 7) ? xr8[m + 1] : bf2f(xr[half][r]); xm[m] = bf2f(f2bf(cw0 * pv + cw1 * xr8[m] + cw2 * nx + cb)); pv = xr8[m]; } }
                float y[8];
#pragma unroll
                for (int m = 0; m < 8; ++m) y[m] = xm[m] * (acc[half][m][r] + bias * uu[m]);
                if (pass == 0) { u32x4 o; o.x = cvt_pk_bf16(y[0], y[1]); o.y = cvt_pk_bf16(y[2], y[3]); o.z = cvt_pk_bf16(y[4], y[5]); o.w = cvt_pk_bf16(y[6], y[7]); *(u32x4*)(zdst + (size_t)i16 * NTOK + t8) = o; }
                else { float gg[8]; unpack8(gq[half][r], gg);
#pragma unroll
                    for (int m = 0; m < 8; ++m) gg[m] = bf2f(f2bf(siluf(gg[m])));
                    u32x4 o; o.x = cvt_pk_bf16(y[0] * gg[0], y[1] * gg[1]); o.y = cvt_pk_bf16(y[2] * gg[2], y[3] * gg[3]); o.z = cvt_pk_bf16(y[4] * gg[4], y[5] * gg[5]); o.w = cvt_pk_bf16(y[6] * gg[6], y[7] * gg[7]);
                    *(u32x4*)(cat + (size_t)i16 * NTOK + t8) = o; }
            }
    }
}
template <int N>
__device__ __forceinline__ void hyena_seq(const Ctx& c, int l, int ch, int toff) {
    constexpr int UP = (N + 256) * 2 + 16;
    LAS unsigned char* ub = c.lds; LAS unsigned char* gb = c.lds + 16 * UP;
    const bf16_t* vv = wsp<bf16_t>(c, WS_HYV) + (size_t)ch * 16 * NTOK + toff;
    bf16_t* vz = wsp<bf16_t>(c, WS_HYZ) + (size_t)ch * 16 * NTOK + toff;
    const bf16_t* x1 = wsp<bf16_t>(c, WS_HYX1) + (size_t)ch * 16 * NTOK + toff;
    const bf16_t* x2 = wsp<bf16_t>(c, WS_HYX2) + (size_t)ch * 16 * NTOK + toff;
    const bf16_t* gm = wsp<bf16_t>(c, WS_HYG) + (size_t)ch * 16 * NTOK + toff;
    bf16_t* cat = wsp<bf16_t>(c, WS_HYY) + (size_t)ch * 16 * NTOK + toff;
    { const int e = c.tid, b = e >> 5, side = (e >> 4) & 1, pc = e & 15; unsigned z = 0u; asm volatile("" : "+v"(z)); *(LAS u32x4*)(ub + b * UP + side * (256 + N * 2) + pc * 16) = (u32x4){z, z, z, z}; }
    for (int pass = 0; pass < 2; ++pass) {
        const bf16_t* gr = (N == SEQL) ? wsp<bf16_t>(c, WS_GR) + (((size_t)l * 2 + pass) * 256 + ch) * 8192 : wsp<bf16_t>(c, WS_GRC) + (((size_t)l * 2 + pass) * 256 + ch) * 512;
        const bf16_t* usrc = pass == 0 ? vv : vz;
        constexpr int NG = (2 * N / 8 + 511) / 512;
        {
            u32x4 t[NG];
#pragma unroll
            for (int k = 0; k < NG; ++k) { const int e = c.tid + k * 512; t[k] = (e < 2 * N / 8) ? *(const u32x4*)(gr + e * 8) : (u32x4){0u, 0u, 0u, 0u}; }
#pragma unroll
            for (int k = 0; k < NG; ++k) { const int e = c.tid + k * 512; if (e < 2 * N / 8) *(LAS u32x4*)(gb + e * 16) = t[k]; }
        }
        if constexpr (N == SEQL) {
#pragma unroll
            for (int k0 = 0; k0 < 16; k0 += 8) {
                u32x4 t[8];
#pragma unroll
                for (int k = 0; k < 8; ++k) t[k] = *(const u32x4*)(usrc + (size_t)(k0 + k) * NTOK + c.tid * 8);
#pragma unroll
                for (int k = 0; k < 8; ++k) *(LAS u32x4*)(ub + (k0 + k) * UP + 256 + c.tid * 16) = t[k];
            }
        } else {
            const int b = c.tid >> 5, pc = c.tid & 31;
            *(LAS u32x4*)(ub + b * UP + 256 + pc * 16) = *(const u32x4*)(usrc + (size_t)b * NTOK + pc * 8);
        }
        __syncthreads();
        const float* hcw = KIN(I_HCW) + (size_t)l * 3 * 768; const float* hcb = KIN(I_HCB) + l * 768;
        if (pass == 0) {
            const float w0 = hcw[ch], w1 = hcw[768 + ch], w2 = hcw[1536 + ch], bs = hcb[ch];
            constexpr int PPT = (N == SEQL) ? 16 : 1;
            u32x4 o[PPT];
#pragma unroll
            for (int k = 0; k < PPT; ++k) { const int b = (N == SEQL) ? k : (c.tid >> 5), pc = (N == SEQL) ? c.tid : (c.tid & 31); const LAS unsigned char* p = ub + b * UP + 256 + pc * 16;
                float x[8]; unpack8(*(const LAS u32x4*)p, x); float pv = bf2f(*(const LAS bf16_t*)(p - 2)); const float nx8 = bf2f(*(const LAS bf16_t*)(p + 16)); float y[8];
#pragma unroll
                for (int m = 0; m < 8; ++m) { const float nx = (m < 7) ? x[m + 1] : nx8; y[m] = w0 * pv + w1 * x[m] + w2 * nx + bs; pv = x[m]; }
                o[k].x = cvt_pk_bf16(y[0], y[1]); o[k].y = cvt_pk_bf16(y[2], y[3]); o[k].z = cvt_pk_bf16(y[4], y[5]); o[k].w = cvt_pk_bf16(y[6], y[7]); }
            __syncthreads();
#pragma unroll
            for (int k = 0; k < PPT; ++k) { const int b = (N == SEQL) ? k : (c.tid >> 5), pc = (N == SEQL) ? c.tid : (c.tid & 31); *(LAS u32x4*)(ub + b * UP + 256 + pc * 16) = o[k]; }
            __syncthreads();
        }
        const float bias = KIN(I_HBIAS)[((size_t)l * 2 + pass) * 256 + ch];
        const int cc = (pass + 1) * 256 + ch;
        hyena_conv<N>(c, ub, gb, pass, pass == 0 ? x1 : x2, bias, vz, gm, cat, hcw[cc], hcw[768 + cc], hcw[1536 + cc], hcb[cc]);
        asm volatile("s_waitcnt vmcnt(0)" ::: "memory");
        __syncthreads();
    }
}

__device__ __forceinline__ void hyena_untranspose(const Ctx& c, int tl0, int tl1) {
    const bf16_t* yT = wsp<bf16_t>(c, WS_HYY); bf16_t* cat = wsp<bf16_t>(c, WS_HCAT);
    LAS bf16_t* T = (LAS bf16_t*)c.lds;
    LAS unsigned* T32 = (LAS unsigned*)c.lds;
    for (int tl = tl0; tl < tl1; ++tl) {
        const int b = tl / 68, j0 = (tl - b * 68) * 64;
        u32x4 pre[4];
#pragma unroll
        for (int k = 0; k < 4; ++k) { const int e = c.tid + k * 512, ch = e >> 3, pc = e & 7; pre[k] = *(const u32x4*)(yT + ((size_t)ch * 16 + b) * NTOK + j0 + pc * 8); }
#pragma unroll
        for (int k = 0; k < 4; ++k) { const int e = c.tid + k * 512, ch = e >> 3, pc = e & 7; LAS unsigned* d = T32 + (ch * 132 + pc * 16) / 4; d[0] = pre[k].x; d[1] = pre[k].y; d[2] = pre[k].z; d[3] = pre[k].w; }
        __syncthreads();
#pragma unroll
        for (int k = 0; k < 4; ++k) { const int e = c.tid + k * 512, t = e >> 5, c0 = (e & 31) * 8; float v[8];
#pragma unroll
            for (int i = 0; i < 8; ++i) v[i] = bf2f(T[(c0 + i) * 66 + t]);
            u32x4 w; w.x = cvt_pk_bf16(v[0], v[1]); w.y = cvt_pk_bf16(v[2], v[3]); w.z = cvt_pk_bf16(v[4], v[5]); w.w = cvt_pk_bf16(v[6], v[7]);
            *(u32x4*)(cat + ((size_t)b * NTOK + j0 + t) * DM + 768 + c0) = w; }
        __syncthreads();
    }
}

__device__ __forceinline__ void ssm_scan_item(const Ctx& c, int l, int item) {
    const int b = item >> 2, g = (item & 3) * 4 + (c.tid >> 7), dq = (c.tid >> 6) & 1, p = c.tid & 63;
    const float* a16 = wsp<float>(c, WS_A16) + ((((size_t)l * 2 + dq) * 16 + g) * 64 + p) * 2;
    const float ar = a16[0], ai = a16[1];
    const bf16_t* E = wsp<bf16_t>(c, WS_E); bf16_t* US = wsp<bf16_t>(c, WS_US);
    float sr = 0.f, si = 0.f;
    for (int st0 = 0; st0 < NCHB; st0 += 8) {
        float er[8], ei[8]; size_t ro[8];
#pragma unroll
        for (int k = 0; k < 8; ++k) { const int st = st0 + k; const int cc = dq == 0 ? (st < 16 ? 256 + st : st - 16) : (st < 16 ? 271 - st : 255 - (st - 16));
            ro[k] = (size_t)g * NCHUNK + (size_t)b * NCHB + cc; er[k] = bf2f(E[ro[k] * 256 + dq * 128 + p]); ei[k] = bf2f(E[ro[k] * 256 + dq * 128 + 64 + p]); }
#pragma unroll
        for (int k = 0; k < 8; ++k) {
            US[ro[k] * 512 + 256 + dq * 128 + p] = f2bf(sr); US[ro[k] * 512 + 256 + dq * 128 + 64 + p] = f2bf(si);
            const float nr = ar * sr - ai * si + er[k], ni = ar * si + ai * sr + ei[k]; sr = nr; si = ni;
        }
    }
}

constexpr int LDS_BYTES = 163840;
constexpr int LDS_MISC = LDS_MISC_OFF;
static_assert(LDS_MISC_OFF == LDS_BYTES - 256, "LDS map");
constexpr int NPRO = 1, NPH = 6, NPHASES = NPRO + DEPTH * NPH;
constexpr int QI_HY = 256, QI_SCAN = 64, QI_ATTL = NB * 8 * 8, QI_SSM2 = 16 * 17, QI_UNT = 272, QI_ATTC = NB * 8, QI_GLU = MROWS / 256;
constexpr int QO_SCAN = QI_HY, QO_ATTL = QO_SCAN + QI_SCAN, QO_SSM2 = QO_ATTL + QI_ATTL, QO_UNT = QO_SSM2 + QI_SSM2, QO_ATTC = QO_UNT + QI_UNT, QO_GLU = QO_ATTC + QI_ATTC, QI_TOTAL = QO_GLU + QI_GLU;
#ifndef PROBE_DUP_MASK
#define PROBE_DUP_MASK 0
#endif
#ifndef PROBE_P4KINDS
#define PROBE_P4KINDS 0x7f
#endif
__device__ __forceinline__ void dep_signal(const Ctx& c, unsigned* cnt) {
    asm volatile("s_waitcnt vmcnt(0)" ::: "memory");
    __syncthreads();
    if (c.tid == 0) { __builtin_amdgcn_fence(__ATOMIC_RELEASE, "agent"); asm volatile("s_waitcnt vmcnt(0)" ::: "memory"); (void)xb_add(cnt, 1u); }
}
__device__ __forceinline__ void dep_wait(const Ctx& c, unsigned* cnt, unsigned need, unsigned* tmo) {
    if (c.dry) return;
    if (c.tid == 0) {
        unsigned sp = 0;
        while (xb_ld(cnt) < need) { __builtin_amdgcn_s_sleep(2); if ((++sp & 255u) == 0u) { if (xb_ld(tmo)) break; if (sp > XB_SPIN_CAP) { atomicAdd(tmo, 1u); break; } } }
        __builtin_amdgcn_fence(__ATOMIC_ACQUIRE, "agent");
        asm volatile("s_waitcnt vmcnt(0)" ::: "memory");
    }
    __syncthreads();
}

__global__ void __launch_bounds__(512, 2) mk_fwd(Params prm) {
    extern __shared__ __attribute__((aligned(16))) unsigned char lds_raw[];
    Ctx c; c.lds = (LAS unsigned char*)lds_raw; c.ka = (kargp_t)__builtin_amdgcn_kernarg_segment_ptr(); c.ws = prm.ws; c.tid = threadIdx.x; c.lane = c.tid & 63; c.wave = __builtin_amdgcn_readfirstlane(c.tid >> 6); c.G = gridDim.x; c.bid = blockIdx.x; c.dry = prm.dry;
    const int wave0 = c.wave;
    volatile LAS unsigned* misc = (volatile LAS unsigned*)(c.lds + LDS_MISC);
    if (c.tid < 16) misc[c.tid] = 0u;
    __syncthreads();
    unsigned* ctl = wsp<unsigned>(c, WS_CTL);
    const int lo = prm.ph_lo, hi = prm.ph_hi;
    const bool fused = (hi - lo) > 1;
    XcdBarrier bar; bar.bar = ctl + CW_BAR; bar.x = 0; bar.st = misc;
    if (fused) bar = xcd_barrier_post(ctl + CW_BAR, misc);
#ifndef SITE_MASK
#define SITE_MASK 0x3ff
#endif
#define SITE(n) (((SITE_MASK) >> (n)) & 1)
#define IN(k) (lo <= (k) && (k) < hi)
#define FRESH() do { { kargp_t _k = (kargp_t)__builtin_amdgcn_kernarg_segment_ptr(); asm volatile("" : "+s"(_k)); c.ka = _k; c.ws = (unsigned char*)(GAS unsigned char*)_k[37]; } { int _w = wave0; asm volatile("" : "+s"(_w)); c.wave = _w; c.lane = lane_id_fresh(); c.tid = c.wave * 64 + c.lane; } } while (0)
#define SEAM(k) do { if (IN((k) + 1)) xcd_barrier(bar); } while (0)

    if (SITE(0) && IN(0)) {
        FRESH();
        constexpr int J_MOD = 192, J_HY = 544, J_SSM = 64, J_WIN = 4 * 48 * 8, J_WOUT = 4 * 16 * 8, J_WUQ = 4 * 8 * 2, J_W256 = 4 * 4 * 2, J_NORM = MROWS / 256, J_PACK = 4 * 2 * 256;
        constexpr int J0 = J_MOD, J1 = J0 + J_HY, J2 = J1 + J_SSM, J3 = J2 + J_WIN, J4 = J3 + J_WOUT, J5 = J4 + J_WUQ, J6 = J5 + J_W256, J7 = J6 + J_W256, J8 = J7 + J_W256, J9 = J8 + 1, J10 = J9 + J_NORM, J11 = J10 + J_PACK;
        unsigned* dep = ctl + CW_DEP + DEP_SET * 8;
        unsigned* tmo = ctl + CW_BAR + XB_TMO;
        for (int job = c.bid; job < J11; job += c.G) {
            FRESH();
            if (job < J0) { modv_job(c, job); dep_signal(c, dep); }
            else if (job < J1) { hyena_mlp_job(c, job - J0); dep_signal(c, dep + 64); }
            else if (job < J2) ssm_tables_job(c, job - J1);
            else if (job < J3) { const int r = job - J2, l = r / 384, q = r % 384; wconv_tile(c, KIN(I_WIN) + (size_t)l * DM * INC, DM, INC, INP, wsp<bf16_t>(c, WS_WIN) + (size_t)l * INP * DM, DM, 0, q / 8, q % 8); }
            else if (job < J4) { const int r = job - J3, l = r / 128, q = r % 128; wconv_tile(c, KIN(I_WOUT) + (size_t)l * DM * DM, DM, DM, DM, wsp<bf16_t>(c, WS_WOUT) + (size_t)l * DM * DM, DM, 1, q / 8, q % 8); }
            else if (job < J5) { const int r = job - J4, l = r / 16, q = r % 16; wconv_tile(c, KIN(I_WUQ) + (size_t)l * 192 * 384, 192, 384, 384, wsp<bf16_t>(c, WS_WUQ) + (size_t)l * 512 * 256, 256, 1, q / 2, q % 2); }
            else if (job < J6) { const int r = job - J5, l = r / 8, q = r % 8; wconv_tile(c, KIN(I_WUKV) + (size_t)l * 128 * 512, 128, 512, 256, wsp<bf16_t>(c, WS_WUK) + (size_t)l * 256 * 256, 256, 2, q / 2, q % 2); }
            else if (job < J7) { const int r = job - J6, l = r / 8, q = r % 8; wconv_tile(c, KIN(I_WUKV) + (size_t)l * 128 * 512, 128, 512, 256, wsp<bf16_t>(c, WS_WUV) + (size_t)l * 256 * 256, 256, 3, q / 2, q % 2); }
            else if (job < J8) { const int r = job - J7, l = r / 8, q = r % 8; wconv_tile(c, KIN(I_GLUW) + (size_t)l * 256 * 256, 256, 256, 256, wsp<bf16_t>(c, WS_WGLU) + (size_t)l * 256 * 256, 256, 1, q / 2, q % 2); }
            else if (job < J9) rope_job(c);
            else if (job < J10) { dep_wait(c, dep, J_MOD, tmo); FRESH(); const int t = job - J9; norm_rows(c, -1, 0, t * 256, t * 256 + 256); }
            else { dep_wait(c, dep + 64, J_HY, tmo); FRESH(); hyena_pack_job(c, job - J10); }
        }
        SEAM(0);
    }
    for (int l = 0; l < DEPTH; ++l) {
        const int pbase = NPRO + l * NPH;
        if (SITE(2) && IN(pbase + 0)) {
            FRESH();
            pg8::Gemm g{wsp<bf16_t>(c, WS_HCAT), wsp<bf16_t>(c, WS_WIN) + (size_t)l * INP * DM, MROWS, INP, DM};
            pg8::StaticOrder S; S.init(MROWS, INP, c.G, c.bid);
            EpiInProj E{wsp<bf16_t>(c, WS_PB), wsp<bf16_t>(c, WS_UG), wsp<bf16_t>(c, WS_US), wsp<bf16_t>(c, WS_VTG), wsp<bf16_t>(c, WS_HYV), c.lds + pg8::STAGE_BYTES};
            pg8::gemm_phase(c.lds, g, S, E, c.tid);
            SEAM(pbase + 0);
        }
        if (SITE(3) && IN(pbase + 1)) { FRESH(); p2_rows(c, l); SEAM(pbase + 1); }
        if (SITE(4) && IN(pbase + 2)) {
            FRESH();
            pg8::Gemm g{wsp<bf16_t>(c, WS_PB), wsp<bf16_t>(c, WS_WUQ), MROWS, 512, 256};
            pg8::P3Order S{wsp<bf16_t>(c, WS_PB), wsp<bf16_t>(c, WS_PB) + BLKE, wsp<bf16_t>(c, WS_WUQ) + (size_t)l * 512 * 256, wsp<bf16_t>(c, WS_WUK) + (size_t)l * 256 * 256, wsp<bf16_t>(c, WS_WUV) + (size_t)l * 256 * 256,
                           wsp<bf16_t>(c, WS_UG), wsp<bf16_t>(c, WS_WE) + (size_t)l * 16 * 256 * 256, c.G, c.bid};
            EpiP3 E{{wsp<bf16_t>(c, WS_QM), 384, 384}, {wsp<bf16_t>(c, WS_KM), wsp<bf16_t>(c, WS_KR)}, {wsp<bf16_t>(c, WS_VTM)}, {wsp<bf16_t>(c, WS_E)}};
            pg8::gemm_phase(c.lds, g, S, E, c.tid);
            SEAM(pbase + 2);
        }
        if (SITE(5) && IN(pbase + 3)) {
            FRESH();
            unsigned* qh = ctl + CW_Q + 64 * (l + 4 * (c.dry ? 1 : 0));
            unsigned* dep = ctl + CW_DEP + DEP_SET * (l + 4 * (c.dry ? 1 : 0));
            unsigned* tmo = ctl + CW_BAR + XB_TMO;
            const float* ropeM = wsp<float>(c, WS_ROPEM);
            bool gqa_nomax;
            { float gq_ = fabsf(KIN(I_GQ)[l * 64 + c.lane]), gk_ = fabsf(KIN(I_GK)[l * 64 + c.lane]);
              gq_ = fmaxf(gq_, swz_xor<16>(gq_)); gq_ = fmaxf(gq_, swz_xor<8>(gq_)); gq_ = fmaxf(gq_, swz_xor<4>(gq_)); gq_ = fmaxf(gq_, swz_xor<2>(gq_)); gq_ = fmaxf(gq_, swz_xor<1>(gq_)); gq_ = half_max(gq_);
              gk_ = fmaxf(gk_, swz_xor<16>(gk_)); gk_ = fmaxf(gk_, swz_xor<8>(gk_)); gk_ = fmaxf(gk_, swz_xor<4>(gk_)); gk_ = fmaxf(gk_, swz_xor<2>(gk_)); gk_ = fmaxf(gk_, swz_xor<1>(gk_)); gk_ = half_max(gk_);
              const float bound = 64.f * gq_ * gk_ * 0.125f * LOG2E * 1.01f; gqa_nomax = __builtin_amdgcn_readfirstlane(bound < 50.f ? 1 : 0) != 0; }
#define ATT_CALL(DKV, ...) do { float rowmax_[2] = {0.f, 0.f}; if (attn_unit<DKV, false>(rowmax_, __VA_ARGS__)) { (void)attn_unit<DKV, true>(rowmax_, __VA_ARGS__); } } while (0)
            for (;;) {
                __syncthreads();
                if (c.tid == 0) misc[4] = __hip_atomic_fetch_add(qh, 1u, __ATOMIC_RELAXED, __HIP_MEMORY_SCOPE_AGENT);
                __syncthreads();
                const int it = (int)misc[4];
                if (it >= QI_TOTAL) break;
                FRESH();
                if (c.dry) { const int kd_ = it < QO_SCAN ? 0 : it < QO_ATTL ? 1 : it < QO_SSM2 ? 2 : it < QO_UNT ? 3 : it < QO_ATTC ? 4 : it < QO_GLU ? 5 : 6; if (!((c.dry >> (1 + kd_)) & 1)) continue; }
                if (it < QO_SCAN) { hyena_seq<SEQL>(c, l, it, 0); if (l + 1 < DEPTH) hyena_seq<CTXL>(c, l, it, SEQL); dep_signal(c, dep); }
                else if (it < QO_ATTL) { ssm_scan_item(c, l, it - QO_SCAN); dep_signal(c, dep + 64); }
                else if (it >= QO_ATTC && it < QO_GLU && l + 1 == DEPTH) {   }
                else if (it < QO_SSM2 || (it >= QO_ATTC && it < QO_GLU)) {
                    const bool isctx = it >= QO_ATTC; const int r = isctx ? it - QO_ATTC : (it - QO_ATTL) % (NB * 8), blk = isctx ? 8 : (it - QO_ATTL) / (NB * 8)  ;
                    const int kind = r & 1  , head = (r >> 1) & 3, b = r >> 3;
                    const size_t row0 = (size_t)b * NTOK + (isctx ? SEQL : blk * 512); const int kt0 = isctx ? 64 : 0, nkt = isctx ? 4 : 68, nrows = isctx ? 256 : 512;
                    if (kind == 0) { if (c.dry && PROBE_GQAONLY == 1) continue; ATT_CALL(96, c, wsp<bf16_t>(c, WS_QM) + row0 * 384 + head * 96, 384, wsp<bf16_t>(c, WS_KM) + (size_t)(b * 4 + head) * NTOK * 96, wsp<bf16_t>(c, WS_VTM) + (size_t)(b * 4 + head) * 64 * NTOK,
                                                 kt0, nkt, nrows, wsp<bf16_t>(c, WS_PB) + 2 * BLKE + row0 * 256 + head * 64, wsp<bf16_t>(c, WS_HCAT) + row0 * DM + head * 64, !isctx, blk * 512, 0.10206207261596577f * LOG2E, ropeM); }
                    else if (c.dry && PROBE_GQAONLY == 2) { continue; }
                    else if (c.dry && PROBE_ABL) { float rm_[2] = {0.f, 0.f}; (void)attn_unit<64, false, true, PROBE_ABL>(rm_, c, wsp<bf16_t>(c, WS_PB) + 3 * BLKE + row0 * 256 + head * 64, 256, wsp<bf16_t>(c, WS_KG) + (size_t)(b * 2 + (head >> 1)) * NTOK * 64, wsp<bf16_t>(c, WS_VTG) + (size_t)(b * 2 + (head >> 1)) * 64 * NTOK,
                                       kt0, nkt, nrows, wsp<bf16_t>(c, WS_PB) + 5 * BLKE + row0 * 256 + head * 64, wsp<bf16_t>(c, WS_HCAT) + row0 * DM + 256 + head * 64, false, 0, 1.f, ropeM); }
                    else if (gqa_nomax) { float rm_[2] = {0.f, 0.f}; (void)attn_unit<64, false, true>(rm_, c, wsp<bf16_t>(c, WS_PB) + 3 * BLKE + row0 * 256 + head * 64, 256, wsp<bf16_t>(c, WS_KG) + (size_t)(b * 2 + (head >> 1)) * NTOK * 64, wsp<bf16_t>(c, WS_VTG) + (size_t)(b * 2 + (head >> 1)) * 64 * NTOK,
                                       kt0, nkt, nrows, wsp<bf16_t>(c, WS_PB) + 5 * BLKE + row0 * 256 + head * 64, wsp<bf16_t>(c, WS_HCAT) + row0 * DM + 256 + head * 64, false, 0, 1.f, ropeM); }
                    else { ATT_CALL(64, c, wsp<bf16_t>(c, WS_PB) + 3 * BLKE + row0 * 256 + head * 64, 256, wsp<bf16_t>(c, WS_KG) + (size_t)(b * 2 + (head >> 1)) * NTOK * 64, wsp<bf16_t>(c, WS_VTG) + (size_t)(b * 2 + (head >> 1)) * 64 * NTOK,
                                       kt0, nkt, nrows, wsp<bf16_t>(c, WS_PB) + 5 * BLKE + row0 * 256 + head * 64, wsp<bf16_t>(c, WS_HCAT) + row0 * DM + 256 + head * 64, false, 0, 1.f, ropeM); }
                }
                else if (it < QO_UNT) {
                    const int L = it - QO_SSM2, i = L >> 4, g = L & 15;
                    dep_wait(c, dep + 64, QI_SCAN, tmo);
                    pg8::Gemm gm{wsp<bf16_t>(c, WS_US), wsp<bf16_t>(c, WS_WKC) + (size_t)l * 16 * 256 * 512, 16 * NCHUNK, 16 * 256, 512}; pg8::OneUnit S{g * 17 + i, g};
                    pg8::EpiWalk<PutSsmY> E{{wsp<bf16_t>(c, WS_ZS), wsp<bf16_t>(c, WS_UG), KIN(I_SSMD) + l * 256}}; pg8::gemm_phase(c.lds, gm, S, E, c.tid);
                    dep_signal(c, dep + 64 * (2 + i));
                }
                else if (it < QO_ATTC) {
                    dep_wait(c, dep, QI_HY, tmo);
                    const int j = it - QO_UNT; hyena_untranspose(c, 4 * j, 4 * j + 4);
                }
                else {
                    const int pm = it - QO_GLU;
                    dep_wait(c, dep + 64 * (2 + (pm >> 4)), 16u, tmo);
                    pg8::Gemm gm{wsp<bf16_t>(c, WS_ZS), wsp<bf16_t>(c, WS_WGLU) + (size_t)l * 256 * 256, MROWS, 256, 256}; pg8::OneUnit S{pm, 0};
                    pg8::EpiWalk<PutGlu> E{{wsp<bf16_t>(c, WS_HCAT), wsp<bf16_t>(c, WS_ZS), wsp<bf16_t>(c, WS_PB) + 7 * BLKE, KIN(I_GLUB) + l * 256}}; pg8::gemm_phase(c.lds, gm, S, E, c.tid);
                }
            }
            SEAM(pbase + 3);
        }
        if (SITE(6) && IN(pbase + 4)) {
            FRESH();
            pg8::Gemm g{wsp<bf16_t>(c, WS_HCAT), wsp<bf16_t>(c, WS_WOUT) + (size_t)l * DM * DM, MROWS, DM, DM}; pg8::LiveRowsOrder S; S.init2(DM, c.G, c.bid, l + 1 == DEPTH);
            pg8::EpiWalk<PutPlain> E{{wsp<bf16_t>(c, WS_OUTB), DM, DM}}; pg8::gemm_phase(c.lds, g, S, E, c.tid);
            SEAM(pbase + 4);
        }
        if (SITE(7) && IN(pbase + 5)) { FRESH(); norm_rows(c, l, l + 1 < DEPTH ? l + 1 : -1); if (l + 1 < DEPTH) SEAM(pbase + 5); }
    }
#undef IN
#undef SEAM
}

extern "C" void kernel_launch(void* const* d_in, const int* in_sizes, int n_in, void* d_out, int out_size, void* d_ws, size_t ws_size, hipStream_t stream) {
    static int grid = 0;
    if (grid == 0) {
        if (n_in != 36 || out_size != NB * SEQL * DM || ws_size < WS_END) { fprintf(stderr, "kernel_launch: unexpected shapes: n_in %d out %d ws %zu (need %zu)\n", n_in, out_size, ws_size, (size_t)WS_END); grid = -1; return; }
        int dev = 0, cus = 0, per_cu = 0;
        if (hipGetDevice(&dev) != hipSuccess || hipDeviceGetAttribute(&cus, hipDeviceAttributeMultiprocessorCount, dev) != hipSuccess) { grid = -1; return; }
        if (hipFuncSetAttribute((const void*)mk_fwd, hipFuncAttributeMaxDynamicSharedMemorySize, LDS_BYTES) != hipSuccess) { fprintf(stderr, "kernel_launch: hipFuncSetAttribute failed\n"); grid = -1; return; }
        if (hipOccupancyMaxActiveBlocksPerMultiprocessor(&per_cu, (const void*)mk_fwd, 512, LDS_BYTES) != hipSuccess || per_cu < 1) { fprintf(stderr, "kernel_launch: occupancy query says %d blocks per CU\n", per_cu); per_cu = 1; }
        (void)hipGetLastError();
        grid = cus;
    }
    if (grid < 0) return;
    (void)hipMemsetAsync((char*)d_ws + WS_CTL, 0, CTL_BYTES, stream);
    Params p{};
    for (int i = 0; i < 36; ++i) p.in[i] = (const float*)d_in[i];
    p.out = (float*)d_out; p.ws = (unsigned char*)d_ws;
#if MK_ONE_LAUNCH
    p.ph_lo = 0; p.ph_hi = NPHASES;
    hipLaunchKernelGGL(mk_fwd, dim3(grid), dim3(512), LDS_BYTES, stream, p);
#else
    for (int k = 0; k < NPHASES; ++k) { p.ph_lo = k; p.ph_hi = k + 1; const int site = k < NPRO ? k : NPRO + (k - NPRO) % NPH;
        if ((PROBE_DUP_MASK >> site) & 1) { p.dry = 1 | (PROBE_P4KINDS << 1); hipLaunchKernelGGL(mk_fwd, dim3(grid), dim3(512), LDS_BYTES, stream, p); p.dry = 0; }
        hipLaunchKernelGGL(mk_fwd, dim3(grid), dim3(512), LDS_BYTES, stream, p); }
#endif
}
```

```cpp
#include <hip/hip_runtime.h>
#include <cstdio>
#include <cstdint>

#ifndef MK_ONE_LAUNCH
#define MK_ONE_LAUNCH 1
#endif

#define LAS __attribute__((address_space(3)))
#define GAS __attribute__((address_space(1)))
typedef unsigned short bf16_t;
typedef short bf16x8 __attribute__((ext_vector_type(8)));
typedef short bf16x4 __attribute__((ext_vector_type(4)));
typedef float f32x4 __attribute__((ext_vector_type(4)));
typedef float f32x16 __attribute__((ext_vector_type(16)));
typedef unsigned u32x4 __attribute__((ext_vector_type(4)));
typedef unsigned u32x2 __attribute__((ext_vector_type(2)));

constexpr int NB = 16, SEQL = 4096, CTXL = 256, NTOK = SEQL + CTXL  , MROWS = NB * NTOK  ;
constexpr int DM = 1024, DEPTH = 4, INC = 2912, INP = 3072;
constexpr int NCHB = NTOK / 16  , NCHUNK = MROWS / 16  ;
constexpr float EPS = 1e-6f;
constexpr float LOG2E = 1.4426950408889634f;
constexpr int LDS_MISC_OFF = 163840 - 256;

constexpr size_t al256(size_t x) { return (x + 255) & ~(size_t)255; }
constexpr size_t WS_CTL = 0;
constexpr size_t CTL_BYTES = 131072;
constexpr size_t WS_MODV = WS_CTL + CTL_BYTES;
constexpr size_t WS_ROPEG = WS_MODV + al256((size_t)4 * 17 * 3072 * 4);
constexpr size_t WS_ROPEM = WS_ROPEG + 64 * 16 * 2 * 4;
constexpr size_t WS_WIN = WS_ROPEM + 64 * 8 * 2 * 4;
constexpr size_t WS_WOUT = WS_WIN + (size_t)4 * 3072 * 1024 * 2;
constexpr size_t WS_WUQ = WS_WOUT + (size_t)4 * 1024 * 1024 * 2;
constexpr size_t WS_WUK = WS_WUQ + (size_t)4 * 512 * 256 * 2;
constexpr size_t WS_WUV = WS_WUK + (size_t)4 * 256 * 256 * 2;
constexpr size_t WS_WGLU = WS_WUV + (size_t)4 * 256 * 256 * 2;
constexpr size_t WS_WE = WS_WGLU + (size_t)4 * 256 * 256 * 2;
constexpr size_t WS_WKC = WS_WE + (size_t)4 * 16 * 256 * 256 * 2;
constexpr size_t WS_A16 = WS_WKC + (size_t)4 * 16 * 256 * 512 * 2;
constexpr size_t WS_GR = WS_A16 + (size_t)4 * 2 * 16 * 64 * 2 * 4;
constexpr size_t WS_GRC = WS_GR + (size_t)4 * 2 * 256 * 8192 * 2;
constexpr size_t WS_CTXR = WS_GRC + (size_t)4 * 2 * 256 * 512 * 2;
constexpr size_t WS_HCAT = WS_CTXR + (size_t)NB * CTXL * DM * 4;
constexpr size_t BLKE = (size_t)MROWS * 256;
constexpr size_t WS_PB = WS_HCAT + (size_t)MROWS * DM * 2;
constexpr size_t WS_KR = WS_PB + 12 * BLKE * 2;
constexpr size_t WS_KG = WS_KR + (size_t)MROWS * 32 * 2;
constexpr size_t WS_VTG = WS_KG + (size_t)32 * NTOK * 64 * 2;
constexpr size_t WS_UG = WS_VTG + (size_t)32 * NTOK * 64 * 2;
constexpr size_t WS_US = WS_UG + BLKE * 2;
constexpr size_t WS_HYV = WS_US + (size_t)16 * NCHUNK * 512 * 2;
constexpr size_t WS_HYX1 = WS_HYV + BLKE * 2;
constexpr size_t WS_HYX2 = WS_HYX1 + BLKE * 2;
constexpr size_t WS_HYG = WS_HYX2 + BLKE * 2;
constexpr size_t WS_HYZ = WS_HYG + BLKE * 2;
constexpr size_t WS_HYY = WS_HYZ + BLKE * 2;
constexpr size_t WS_END = WS_HYY + BLKE * 2;
static_assert(WS_END <= (size_t)1 << 30, "workspace map exceeds 1 GiB");
constexpr size_t WS_QM = WS_PB + 8 * BLKE * 2;
constexpr size_t WS_KM = WS_QM + (size_t)MROWS * 384 * 2;
constexpr size_t WS_VTM = WS_KM + (size_t)MROWS * 384 * 2;
constexpr size_t WS_E = WS_PB + 4 * BLKE * 2;
constexpr size_t WS_ZS = WS_PB + 6 * BLKE * 2;
constexpr size_t WS_OUTB = WS_PB + 8 * BLKE * 2;
constexpr size_t WS_HT = WS_PB;
static_assert(WS_VTM + BLKE * 2 == WS_PB + 12 * BLKE * 2, "alias map");

constexpr int CW_BAR = 0;
constexpr int CW_Q = 4096;
constexpr int CW_TMO = 4096 + 64 * 8;
constexpr int CW_DEP = 5120;
constexpr int DEP_SET = 20 * 64;
constexpr int CW_Q2 = 16384;
constexpr int CW_C7 = 20480;

__device__ __forceinline__ float bf2f(bf16_t v) { return __uint_as_float(((unsigned)v) << 16); }
__device__ __forceinline__ bf16_t f2bf(float f) { unsigned u = __float_as_uint(f); u += 0x7FFFu + ((u >> 16) & 1u); return (bf16_t)(u >> 16); }
__device__ __forceinline__ unsigned cvt_pk_bf16(float lo, float hi) { unsigned r; asm volatile("v_cvt_pk_bf16_f32 %0, %1, %2" : "=v"(r) : "v"(lo), "v"(hi)); return r; }
__device__ __forceinline__ float lo_bf(unsigned w) { return __uint_as_float(w << 16); }
__device__ __forceinline__ float hi_bf(unsigned w) { return __uint_as_float(w & 0xFFFF0000u); }
__device__ __forceinline__ float sigmf(float x) { float one = 1.f; asm volatile("" : "+v"(one)); return __builtin_amdgcn_rcpf(one + __builtin_amdgcn_exp2f(-1.4426950408889634f * x)); }
__device__ __forceinline__ float siluf(float x) { return x * sigmf(x); }
__device__ __forceinline__ float gelu_tanh(float x) { const float u = 0.7978845608028654f * (x + 0.044715f * x * x * x); return x * sigmf(2.f * u); }
__device__ __forceinline__ int opaque(int x) { asm volatile("" : "+v"(x)); return x; }
__device__ __forceinline__ int lane_id_fresh() { int x; asm volatile("v_mbcnt_lo_u32_b32 %0, -1, 0\n\tv_mbcnt_hi_u32_b32 %0, -1, %0" : "=v"(x)); return x; }
__device__ __forceinline__ float max3_raw(float a, float b, float c) { float r; asm("v_max3_f32 %0, %1, %2, %3" : "=v"(r) : "v"(a), "v"(b), "v"(c)); return r; }
template <int M> __device__ __forceinline__ float swz_xor(float v) { return __int_as_float(__builtin_amdgcn_ds_swizzle(__float_as_int(v), 0x1F | (M << 10))); }
__device__ __forceinline__ float half_sum(float v) { auto r = __builtin_amdgcn_permlane32_swap(__float_as_uint(v), __float_as_uint(v), false, false); return __uint_as_float(r[0]) + __uint_as_float(r[1]); }
__device__ __forceinline__ float half_max(float v) { auto r = __builtin_amdgcn_permlane32_swap(__float_as_uint(v), __float_as_uint(v), false, false); return fmaxf(__uint_as_float(r[0]), __uint_as_float(r[1])); }
__device__ __forceinline__ float half_other(float v, int h) { auto r = __builtin_amdgcn_permlane32_swap(__float_as_uint(v), __float_as_uint(v), false, false); return __uint_as_float(h ? r[0] : r[1]); }
__device__ __forceinline__ float wave_sum(float v) {
    v += swz_xor<16>(v); v += swz_xor<8>(v); v += swz_xor<4>(v); v += swz_xor<2>(v); v += swz_xor<1>(v);
    return half_sum(v);
}

#define XB_TMO      128
#define XB_XCNT(j)  (256  + 64 * (j))
#define XB_XSUB(j)  (1280 + 64 * (j))
#define XB_XGEN(j)  (2304 + 64 * (j))
#define XB_TOP      3328
#define XB_TOPGEN   3392
#define XCD_BAR_WORDS 3456
#define XB_SPIN_CAP (1u << 22)
__device__ __forceinline__ unsigned xb_ld(unsigned* p)              { return __hip_atomic_load(p, __ATOMIC_RELAXED, __HIP_MEMORY_SCOPE_AGENT); }
__device__ __forceinline__ unsigned xb_add(unsigned* p, unsigned v) { return __hip_atomic_fetch_add(p, v, __ATOMIC_RELAXED, __HIP_MEMORY_SCOPE_AGENT); }
__device__ __forceinline__ unsigned xb_xcc_id() { return (unsigned)__builtin_amdgcn_s_getreg((3 << 11) | 20) & 0xFu; }
#define XB_SPIN(cond, bar) do { unsigned _sp = 0; while (cond) { __builtin_amdgcn_s_sleep(1); \
    if ((++_sp & 255u) == 0u) { if (xb_ld(&(bar)[XB_TMO])) break; if (_sp > XB_SPIN_CAP) { atomicAdd(&(bar)[XB_TMO], 1u); break; } } } } while (0)
struct XcdBarrier { unsigned* bar; unsigned x; volatile LAS unsigned* st; };
__device__ __forceinline__ XcdBarrier xcd_barrier_post(unsigned* bar, volatile LAS unsigned* st) {
    XcdBarrier b; b.bar = bar; b.x = xb_xcc_id(); b.st = st;
    if (threadIdx.x == 0) (void)xb_add(&bar[XB_XCNT(b.x)], 1u);
    return b;
}
__device__ __forceinline__ void xcd_barrier_complete(unsigned* bar, unsigned x, unsigned& nloc, unsigned& nx) {
    const unsigned G = gridDim.x * gridDim.y * gridDim.z;
    unsigned sum, cnt, mine, sp = 0u;
    for (;;) {
        sum = 0u; cnt = 0u; mine = 0u;
#pragma unroll
        for (unsigned j = 0; j < 16; ++j) { const unsigned c = xb_ld(&bar[XB_XCNT(j)]); sum += c; cnt += (c > 0u) ? 1u : 0u; }
        mine = xb_ld(&bar[XB_XCNT(x)]);
        if (sum == G) break;
        __builtin_amdgcn_s_sleep(1);
        if ((++sp & 255u) == 0u) { if (xb_ld(&bar[XB_TMO])) break; if (sp > XB_SPIN_CAP) { atomicAdd(&bar[XB_TMO], 1u); break; } }
    }
    nloc = mine > 0u ? mine : 1u; nx = cnt > 0u ? cnt : 1u;
}
__device__ __forceinline__ void xcd_barrier(const XcdBarrier& b) {
    asm volatile("s_waitcnt vmcnt(0)" ::: "memory");
    __syncthreads();
    if (threadIdx.x == 0) {
        unsigned* bar = b.bar;
        __builtin_amdgcn_s_waitcnt(0);
        unsigned nloc = b.st[0], nx = b.st[1];
        if (nloc == 0u) { xcd_barrier_complete(bar, b.x, nloc, nx); b.st[0] = nloc; b.st[1] = nx; }
        const unsigned old = xb_add(&bar[XB_XSUB(b.x)], 1u);
        const unsigned gen = old / nloc;
        if (old + 1u == (gen + 1u) * nloc) {
            __builtin_amdgcn_fence(__ATOMIC_RELEASE, "agent");
            asm volatile("s_waitcnt vmcnt(0)" ::: "memory");
            const unsigned og = xb_add(&bar[XB_TOP], 1u);
            const unsigned tg = og / nx;
            if (og + 1u == (tg + 1u) * nx) xb_add(&bar[XB_TOPGEN], 1u);
            else XB_SPIN(xb_ld(&bar[XB_TOPGEN]) == tg, bar);
            __builtin_amdgcn_fence(__ATOMIC_ACQUIRE, "agent");
            xb_add(&bar[XB_XGEN(b.x)], 1u);
            asm volatile("s_waitcnt vmcnt(0)" ::: "memory");
        } else {
            XB_SPIN(xb_ld(&bar[XB_XGEN(b.x)]) == gen, bar);
            __builtin_amdgcn_fence(__ATOMIC_ACQUIRE, "agent");
            asm volatile("s_waitcnt vmcnt(0)" ::: "memory");
        }
    }
    __syncthreads();
}

namespace pg8 {
constexpr int BM = 256, BK = 64, HALF = 128, HTB = HALF * BK * 2, STAGE_BYTES = 8 * HTB, NXCD = 8, WGM = 8;
__host__ __device__ __forceinline__ int lds_byte(int r, int c) { const int st = (r >> 4) * 2 + (c >> 5), rr = r & 15, cc = c & 31, ob = rr * 64 + cc * 2; return st * 1024 + (ob ^ (((ob >> 9) & 1) << 5)); }
__host__ __device__ __forceinline__ void stage_rc(int b, int& R, int& C) { const int st = b / 1024, sb = b % 1024, swz = sb ^ (((sb >> 9) & 1) << 5); R = (st >> 1) * 16 + swz / 64; C = (st & 1) * 32 + (swz % 64) / 2; }
__host__ __device__ __forceinline__ int perm32(int rho) { const int n = rho >> 4, i = rho & 15; return 8 * (i >> 2) + 4 * n + (i & 3); }
struct Unit { int pm, pn, kd; };
struct Gemm { const bf16_t* A; const bf16_t* Bt; int M, N, K; };
struct StaticOrder {
    int nM, nN, nwg, G, c;
    __host__ __device__ void init(int M, int N, int G_, int c_) { nM = M / BM; nN = N / BM; nwg = nM * nN; G = G_; c = c_; }
    __host__ __device__ bool next(int i, Unit& u) const {
        const long L = (long)i * G + c; if (L >= nwg) return false;
        int wgid = (int)L; { const int q = nwg / NXCD, r = nwg % NXCD, xcd = wgid % NXCD, off = wgid / NXCD; wgid = (xcd < r ? xcd * (q + 1) : r * (q + 1) + (xcd - r) * q) + off; }
        const int nig = WGM * nN, gid = wgid / nig, fm = gid * WGM, gsz = (nM - fm) < WGM ? (nM - fm) : WGM;
        u.pm = fm + ((wgid % nig) % gsz); u.pn = (wgid % nig) / gsz; u.kd = 0; return true;
    }
    __device__ __forceinline__ void a_ready(const Unit&) const {}
    __device__ __forceinline__ void done(const Unit&) const {}
    __device__ __forceinline__ const char* abase(const Gemm& g, const Unit& u, size_t tstep) const { return (const char*)g.A + (size_t)u.pm * tstep; }
    __device__ __forceinline__ const char* bbase(const Gemm& g, const Unit& u, size_t tstep) const { return (const char*)g.Bt + (size_t)u.pn * tstep; }
};
struct LiveRowsOrder : StaticOrder {
    bool skip;
    __host__ __device__ void init2(int N, int G_, int c_, bool skip_) { skip = skip_; init(skip_ ? NB * SEQL : MROWS, N, G_, c_); }
    __host__ __device__ bool next(int i, Unit& u) const { if (!StaticOrder::next(i, u)) return false; if (skip) u.pm = (u.pm >> 4) * 17 + (u.pm & 15); return true; }
};
struct BatchedOrder {
    int nwg, G, c, tpg;
    __host__ __device__ void init(int ng, int tpg_, int G_, int c_) { nwg = ng * tpg_; tpg = tpg_; G = G_; c = c_; }
    __host__ __device__ bool next(int i, Unit& u) const { const int L = i * G + c; if (L >= nwg) return false; u.pm = L; u.pn = L / tpg; u.kd = 0; return true; }
    __device__ __forceinline__ void a_ready(const Unit&) const {}
    __device__ __forceinline__ void done(const Unit&) const {}
    __device__ __forceinline__ const char* abase(const Gemm& g, const Unit& u, size_t tstep) const { return (const char*)g.A + (size_t)u.pm * tstep; }
    __device__ __forceinline__ const char* bbase(const Gemm& g, const Unit& u, size_t tstep) const { return (const char*)g.Bt + (size_t)u.pn * tstep; }
};
struct P3Order {
    const bf16_t *b0, *b1, *wuq, *wuk, *wuv, *ug, *we; int G, c;
    __host__ __device__ bool next(int i, Unit& u) const {
        const int L = i * G + c; if (L >= 1360) return false;
        if (L < 544) { u.kd = 0; u.pm = L >> 1; u.pn = L & 1; } else if (L < 816) { u.kd = 1; u.pm = L - 544; u.pn = 0; } else if (L < 1088) { u.kd = 2; u.pm = 0; u.pn = L - 816; } else { u.kd = 3; u.pm = L - 1088; u.pn = (L - 1088) / 17; }
        return true;
    }
    __device__ __forceinline__ void a_ready(const Unit&) const {}
    __device__ __forceinline__ void done(const Unit&) const {}
    __device__ __forceinline__ const char* abase(const Gemm&, const Unit& u, size_t tstep) const { const bf16_t* p = u.kd == 0 ? b0 : u.kd == 1 ? b1 : u.kd == 2 ? wuv : ug; return (const char*)p + (size_t)u.pm * tstep; }
    __device__ __forceinline__ const char* bbase(const Gemm&, const Unit& u, size_t tstep) const { const bf16_t* p = u.kd == 0 ? wuq : u.kd == 1 ? wuk : u.kd == 2 ? b1 : we; return (const char*)p + (size_t)u.pn * tstep; }
};

struct OneUnit {
    int pm, pn;
    __host__ __device__ bool next(int i, Unit& u) const { if (i) return false; u.pm = pm; u.pn = pn; u.kd = 0; return true; }
    __device__ __forceinline__ void a_ready(const Unit&) const {}
    __device__ __forceinline__ void done(const Unit&) const {}
    __device__ __forceinline__ const char* abase(const Gemm& g, const Unit& u, size_t tstep) const { return (const char*)g.A + (size_t)u.pm * tstep; }
    __device__ __forceinline__ const char* bbase(const Gemm& g, const Unit& u, size_t tstep) const { return (const char*)g.Bt + (size_t)u.pn * tstep; }
};
template <class Epi, class Sched>
__device__ __forceinline__ void gemm_phase(LAS unsigned char* lds, const Gemm g, const Sched& S, const Epi& E, int tid_in) {
    const int tid = tid_in, wid = __builtin_amdgcn_readfirstlane(tid >> 6), lane = tid & 63, wr = wid >> 2, wc = wid & 3, fr = lane & 15, fq = lane >> 4;
    const int K = g.K, nt = K / BK;
    unsigned voffA[2], voffB[2];
#pragma unroll
    for (int i = 0; i < 2; ++i) { int R, C; stage_rc(tid * 16 + i * 8192, R, C); const int Rb = Epi::PERM ? ((R & ~31) + perm32(R & 31)) : R;
        voffA[i] = (unsigned)(R * K + C) * 2u; voffB[i] = (unsigned)(Rb * K + C) * 2u; }
    const size_t kstep = (size_t)(BK * 2);
    const size_t hstep = (size_t)HALF * K * 2;
    const size_t tstep = 2 * hstep;
    const unsigned ldsw = (unsigned)wid * 1024u;
    const int aoff = lds_byte(wr * 64 + fr, fq * 8), boff = lds_byte(wc * 32 + fr, fq * 8);
#define PG8_SA(b, h) (((b) * 2 + (h)) * HTB)
#define PG8_SB(b, h) ((4 + (b) * 2 + (h)) * HTB)
#define PG8_STAGE(bufoff, gbase, voff) do { _Pragma("unroll") for (int _i = 0; _i < 2; ++_i) \
        __builtin_amdgcn_global_load_lds((const unsigned*)((const char*)(gbase) + (voff)[_i]), (LAS unsigned*)(lds + (bufoff) + ldsw + _i * 8192), 16, 0, 0); } while (0)
#define PG8_LDA(dst, b, h) do { _Pragma("unroll") for (int m = 0; m < 4; ++m) _Pragma("unroll") for (int k = 0; k < 2; ++k) dst[m][k] = *(const LAS bf16x8*)(lds + PG8_SA(b, h) + aoff + m * 2048 + k * 1024); } while (0)
#define PG8_LDB(dst, b, h) do { _Pragma("unroll") for (int n = 0; n < 2; ++n) _Pragma("unroll") for (int k = 0; k < 2; ++k) dst[n][k] = *(const LAS bf16x8*)(lds + PG8_SB(b, h) + boff + n * 2048 + k * 1024); } while (0)
#define PG8_MMA(ai, bj, At, Bt) do { __builtin_amdgcn_s_setprio(1); _Pragma("unroll") for (int m = 0; m < 4; ++m) _Pragma("unroll") for (int n = 0; n < 2; ++n) _Pragma("unroll") for (int k = 0; k < 2; ++k) \
        acc[ai][bj][m][n] = __builtin_amdgcn_mfma_f32_16x16x32_bf16(Bt[n][k], At[m][k], acc[ai][bj][m][n], 0, 0, 0); __builtin_amdgcn_s_setprio(0); } while (0)
#define PG8_WAIT_V(n) asm volatile("s_waitcnt vmcnt(" #n ")" ::: "memory")
#define PG8_WAIT_L(n) asm volatile("s_waitcnt lgkmcnt(" #n ")" ::: "memory")
#define PG8_BAR __builtin_amdgcn_s_barrier()
#define PG8_SCHED __builtin_amdgcn_sched_barrier(0)
    Unit cur, nxt; int ui = 0;
    if (!S.next(0, cur)) return;
    f32x4 acc[2][2][4][2];
#pragma unroll
    for (int a = 0; a < 2; ++a)
#pragma unroll
        for (int b = 0; b < 2; ++b)
#pragma unroll
            for (int m = 0; m < 4; ++m)
#pragma unroll
                for (int n = 0; n < 2; ++n) acc[a][b][m][n] = (f32x4){0.f, 0.f, 0.f, 0.f};
    bf16x8 At[4][2], B0[2][2], B1[2][2];
    const char* cA = S.abase(g, cur, tstep); const char* cB = S.bbase(g, cur, tstep);
    S.a_ready(cur);
    PG8_STAGE(PG8_SB(0, 0), cB, voffB); PG8_STAGE(PG8_SA(0, 0), cA, voffA); PG8_STAGE(PG8_SB(0, 1), cB + hstep, voffB); PG8_STAGE(PG8_SA(0, 1), cA + hstep, voffA);
    if (wr == 1) PG8_BAR;
    PG8_WAIT_V(4); PG8_BAR;
    PG8_STAGE(PG8_SB(1, 0), cB + kstep, voffB); PG8_STAGE(PG8_SA(1, 0), cA + kstep, voffA); PG8_STAGE(PG8_SB(1, 1), cB + hstep + kstep, voffB);
    PG8_WAIT_V(6); PG8_BAR;
    for (;;) {
        const bool has_next = S.next(ui + 1, nxt);
        const char* nA = has_next ? S.abase(g, nxt, tstep) : cA; const char* nB = has_next ? S.bbase(g, nxt, tstep) : cB;
        for (int t = 0; t < nt; t += 2) {
            const bool last = (t == nt - 2);
            const char* a1 = cA + (size_t)(t + 1) * kstep;
            const char* a2 = last ? nA : cA + (size_t)(t + 2) * kstep; const char* b2 = last ? nB : cB + (size_t)(t + 2) * kstep;
            const char* a3 = a2 + kstep; const char* b3 = b2 + kstep;
            if (last && has_next) S.a_ready(nxt);
            PG8_LDB(B0, 0, 0); PG8_SCHED; PG8_LDA(At, 0, 0); PG8_STAGE(PG8_SA(1, 1), a1 + hstep, voffA);
            PG8_WAIT_L(8); PG8_BAR; PG8_WAIT_L(0); PG8_MMA(0, 0, At, B0); PG8_BAR; PG8_SCHED;
            PG8_LDB(B1, 0, 1); PG8_STAGE(PG8_SB(0, 0), b2, voffB);
            PG8_BAR; PG8_WAIT_L(0); PG8_MMA(0, 1, At, B1); PG8_BAR;
            PG8_LDA(At, 0, 1); PG8_STAGE(PG8_SA(0, 0), a2, voffA);
            PG8_BAR; PG8_WAIT_L(0); PG8_MMA(1, 0, At, B0); PG8_BAR; PG8_SCHED;
            PG8_STAGE(PG8_SB(0, 1), b2 + hstep, voffB);
            PG8_WAIT_V(6); PG8_BAR; PG8_MMA(1, 1, At, B1); PG8_BAR;
            PG8_LDB(B0, 1, 0); PG8_SCHED; PG8_LDA(At, 1, 0); PG8_STAGE(PG8_SA(0, 1), a2 + hstep, voffA);
            PG8_WAIT_L(8); PG8_BAR; PG8_WAIT_L(0); PG8_MMA(0, 0, At, B0); PG8_BAR; PG8_SCHED;
            PG8_LDB(B1, 1, 1); PG8_STAGE(PG8_SB(1, 0), b3, voffB);
            PG8_BAR; PG8_WAIT_L(0); PG8_MMA(0, 1, At, B1); PG8_BAR;
            PG8_LDA(At, 1, 1); PG8_STAGE(PG8_SA(1, 0), a3, voffA);
            PG8_BAR; PG8_WAIT_L(0); PG8_MMA(1, 0, At, B0); PG8_BAR; PG8_SCHED;
            PG8_STAGE(PG8_SB(1, 1), b3 + hstep, voffB);
            PG8_WAIT_V(6); PG8_BAR; PG8_MMA(1, 1, At, B1); PG8_BAR;
        }
        { const int l2 = lane_id_fresh(); E(acc, cur, wr, wc, l2 & 15, l2 >> 4); } S.done(cur);
        if (!has_next) break;
#pragma unroll
        for (int a = 0; a < 2; ++a)
#pragma unroll
            for (int b = 0; b < 2; ++b)
#pragma unroll
                for (int m = 0; m < 4; ++m)
#pragma unroll
                    for (int n = 0; n < 2; ++n) acc[a][b][m][n] = (f32x4){0.f, 0.f, 0.f, 0.f};
        cur = nxt; cA = nA; cB = nB; ++ui;
    }
    PG8_WAIT_V(0);
    if (wr == 0) PG8_BAR;
    PG8_BAR;
#undef PG8_SA
#undef PG8_SB
#undef PG8_STAGE
#undef PG8_LDA
#undef PG8_LDB
#undef PG8_MMA
#undef PG8_WAIT_V
#undef PG8_WAIT_L
#undef PG8_BAR
#undef PG8_SCHED
}

template <class F> struct EpiWalk {
    static constexpr bool PERM = true, AFTER_DRAIN = false;
    F f;
    __device__ __forceinline__ void operator()(const f32x4 (&acc)[2][2][4][2], const Unit& u, int wr, int wc, int fr, int fq) const {
#pragma unroll
        for (int ai = 0; ai < 2; ++ai)
#pragma unroll
            for (int m = 0; m < 4; ++m) {
                const int rin = ai * HALF + wr * 64 + m * 16 + fr;
#pragma unroll
                for (int bj = 0; bj < 2; ++bj) { const int cin = bj * HALF + wc * 32 + 8 * fq; f.put(u.pm, u.pn, rin, cin, acc[ai][bj][m][0], acc[ai][bj][m][1]); asm volatile("" ::: "memory"); }
            }
    }
};
}

__device__ __forceinline__ u32x4 pack8(const f32x4& a, const f32x4& b) {
    u32x4 w; w.x = cvt_pk_bf16(a[0], a[1]); w.y = cvt_pk_bf16(a[2], a[3]); w.z = cvt_pk_bf16(b[0], b[1]); w.w = cvt_pk_bf16(b[2], b[3]); return w;
}
__device__ __forceinline__ void unpack8(const u32x4 w, float (&o)[8]) {
    o[0] = lo_bf(w.x); o[1] = hi_bf(w.x); o[2] = lo_bf(w.y); o[3] = hi_bf(w.y); o[4] = lo_bf(w.z); o[5] = hi_bf(w.z); o[6] = lo_bf(w.w); o[7] = hi_bf(w.w);
}

struct PutPlain {
    bf16_t* dst; int ldc, ncols;
    __device__ __forceinline__ void put(int pm, int pn, int rin, int cin, const f32x4& a, const f32x4& b) const { const int col = pn * 256 + cin; if (col < ncols) *(u32x4*)(dst + ((size_t)pm * 256 + rin) * ldc + col) = pack8(a, b); }
};
struct PutPlainWT {
    bf16_t* dst; int ldc, ncols;
    __device__ __forceinline__ void put(int pm, int pn, int rin, int cin, const f32x4& a, const f32x4& b) const {
        const int col = pn * 256 + cin; const u32x4 w = pack8(a, b); GAS bf16_t* p = (GAS bf16_t*)(dst + ((size_t)pm * 256 + rin) * ldc + col);
        asm volatile("global_store_dwordx4 %0, %1, off sc1" :: "v"(p), "v"(w) : "memory"); }
};
struct PutKm {
    bf16_t* km; const bf16_t* kr;
    __device__ __forceinline__ void put(int pm, int pn, int rin, int cin, const f32x4& a, const f32x4& b) const {
        const int bb = pm / 17, key = (pm - bb * 17) * 256 + rin, hd = cin >> 6, d = cin & 63;
        bf16_t* dst = km + ((size_t)(bb * 4 + hd) * NTOK + key) * 96;
        *(u32x4*)(dst + d) = pack8(a, b);
        if (d < 32) *(u32x4*)(dst + 64 + d) = *(const u32x4*)(kr + ((size_t)pm * 256 + rin) * 32 + d);
    }
};
struct PutVt {
    bf16_t* vt;
    __device__ __forceinline__ void put(int pm, int pn, int rin, int cin, const f32x4& a, const f32x4& b) const {
        const int bb = pn / 17, key = (pn - bb * 17) * 256 + cin;
        *(u32x4*)(vt + ((size_t)(bb * 4 + (rin >> 6)) * 64 + (rin & 63)) * NTOK + key) = pack8(a, b);
    }
};
struct PutE {
    bf16_t* e;
    __device__ __forceinline__ void put(int pm, int pn, int rin, int cin, const f32x4& a, const f32x4& b) const { *(u32x4*)(e + ((size_t)pm * 256 + rin) * 256 + cin) = pack8(a, b); }
};
struct PutSsmY {
    bf16_t* zs; const bf16_t* ug; const float* dskip;
    __device__ __forceinline__ void put(int pm, int pn, int rin, int cin, const f32x4& a, const f32x4& b) const {
        const int g = pn, n = (pm - g * 17) * 256 + rin, tok = n * 16 + (cin >> 4), ho = cin & 15, ch = g * 16 + ho;
        float u[8]; unpack8(*(const u32x4*)(ug + ((size_t)g * MROWS + tok) * 16 + ho), u);
        const f32x4 d0 = *(const f32x4*)(dskip + ch), d1 = *(const f32x4*)(dskip + ch + 4);
        f32x4 y0, y1;
#pragma unroll
        for (int i = 0; i < 4; ++i) { y0[i] = gelu_tanh(a[i] + d0[i] * u[i]); y1[i] = gelu_tanh(b[i] + d1[i] * u[4 + i]); }
        *(u32x4*)(zs + (size_t)tok * 256 + ch) = pack8(y0, y1);
    }
};
struct PutGlu {
    bf16_t* cat; const bf16_t* zs; const bf16_t* gate; const float* gb;
    __device__ __forceinline__ void put(int pm, int pn, int rin, int cin, const f32x4& a, const f32x4& b) const {
        const size_t row = (size_t)pm * 256 + rin; const int col = cin;
        float z[8], gt[8]; unpack8(*(const u32x4*)(zs + row * 256 + col), z); unpack8(*(const u32x4*)(gate + row * 256 + col), gt);
        const f32x4 b0 = *(const f32x4*)(gb + col), b1 = *(const f32x4*)(gb + col + 4);
        f32x4 y0, y1;
#pragma unroll
        for (int i = 0; i < 4; ++i) { y0[i] = z[i] * sigmf(a[i] + b0[i]) * siluf(gt[i]); y1[i] = z[4 + i] * sigmf(b[i] + b1[i]) * siluf(gt[4 + i]); }
        *(u32x4*)(cat + row * DM + 512 + col) = pack8(y0, y1);
    }
};

struct EpiInProj {
    static constexpr bool PERM = true, AFTER_DRAIN = false;
    bf16_t *pb, *ug, *us, *vtg, *hy0;
    LAS unsigned char* scratch;
    __device__ __forceinline__ void operator()(const f32x4 (&acc)[2][2][4][2], const pg8::Unit& u, int wr, int wc, int fr, int fq) const {
        const int pn = u.pn, pm = u.pm;
        const int bb = pm / 17, jt = (pm - bb * 17) * 256;
        LAS unsigned char* sw = scratch + (wr * 4 + wc) * 1280;
        const int ln = fq * 16 + fr, tch = ln >> 1, thalf = ln & 1;
#pragma unroll
        for (int ai = 0; ai < 2; ++ai)
#pragma unroll
            for (int m = 0; m < 4; ++m) {
                const int rin = ai * pg8::HALF + wr * 64 + m * 16 + fr;
#pragma unroll
                for (int bj = 0; bj < 2; ++bj) {
                    const int cin = bj * pg8::HALF + wc * 32 + 8 * fq;
                    const u32x4 w = pack8(acc[ai][bj][m][0], acc[ai][bj][m][1]);
                    const bool plain = pn < 4 || pn == 5 || pn == 7 || (pn == 4 && bj == 0);
                    if (plain) { *(u32x4*)(pb + (size_t)pn * BLKE + ((size_t)pm * 256 + rin) * 256 + cin) = w; }
                    else if (pn == 6) { const size_t row = (size_t)pm * 256 + rin; const int g = cin >> 4, hi0 = cin & 15;
                        *(u32x4*)(ug + ((size_t)g * MROWS + row) * 16 + hi0) = w;
                        *(u32x4*)(us + ((size_t)g * NCHUNK + (row >> 4)) * 512 + (row & 15) * 16 + hi0) = w; }
                    else {
                        *(LAS u32x4*)(sw + fr * 80 + fq * 16) = w;
                        asm volatile("" ::: "memory");
                        unsigned short e[8];
#pragma unroll
                        for (int i = 0; i < 8; ++i) e[i] = *(const LAS unsigned short*)(sw + (thalf * 8 + i) * 80 + tch * 2);
                        asm volatile("" ::: "memory");
                        u32x4 t; t.x = e[0] | ((unsigned)e[1] << 16); t.y = e[2] | ((unsigned)e[3] << 16); t.z = e[4] | ((unsigned)e[5] << 16); t.w = e[6] | ((unsigned)e[7] << 16);
                        const int chn = bj * pg8::HALF + wc * 32 + tch;
                        const int tok = jt + ai * pg8::HALF + wr * 64 + m * 16 + thalf * 8;
                        bf16_t* dst = (pn == 4) ? vtg + ((size_t)(bb * 2 + ((chn - 128) >> 6)) * 64 + ((chn - 128) & 63)) * NTOK + tok
                                                : hy0 + (size_t)(pn - 8) * BLKE + ((size_t)chn * 16 + bb) * NTOK + tok;
                        *(u32x4*)dst = t;
                    }
                    asm volatile("" ::: "memory");
                }
            }
    }
};

struct EpiP3 {
    static constexpr bool PERM = true, AFTER_DRAIN = false;
    PutPlain q; PutKm k; PutVt v; PutE e;
    __device__ __forceinline__ void operator()(const f32x4 (&acc)[2][2][4][2], const pg8::Unit& u, int wr, int wc, int fr, int fq) const {
#pragma unroll
        for (int ai = 0; ai < 2; ++ai)
#pragma unroll
            for (int m = 0; m < 4; ++m) {
                const int rin = ai * pg8::HALF + wr * 64 + m * 16 + fr;
#pragma unroll
                for (int bj = 0; bj < 2; ++bj) { const int cin = bj * pg8::HALF + wc * 32 + 8 * fq;
                    if (u.kd == 0) q.put(u.pm, u.pn, rin, cin, acc[ai][bj][m][0], acc[ai][bj][m][1]);
                    else if (u.kd == 1) k.put(u.pm, u.pn, rin, cin, acc[ai][bj][m][0], acc[ai][bj][m][1]);
                    else if (u.kd == 2) v.put(u.pm, u.pn, rin, cin, acc[ai][bj][m][0], acc[ai][bj][m][1]);
                    else e.put(u.pm, u.pn, rin, cin, acc[ai][bj][m][0], acc[ai][bj][m][1]);
                    asm volatile("" ::: "memory"); }
            }
    }
};

struct Params {
    const float* in[36];
    float* out;
    unsigned char* ws;
    int ph_lo, ph_hi, dry, pad;
};
enum { I_X = 0, I_C, I_CTX, I_CCTX, I_WMOD, I_BMOD, I_GPRE, I_GPOST, I_WIN, I_WOUT, I_GCQ, I_WUQ, I_GCKV, I_WUKV, I_GQ, I_GK,
       I_LRE, I_LIM, I_LSTEP, I_BRE, I_BIM, I_CRE, I_CIM, I_SSMD, I_GLUW, I_GLUB, I_HCW, I_HCB, I_HW1, I_HB1, I_HF1, I_HW2, I_HB2, I_HF2, I_HW3, I_HBIAS };

typedef __attribute__((address_space(4))) const unsigned long long* kargp_t;
struct Ctx {
    LAS unsigned char* lds;
    kargp_t ka;
    unsigned char* ws;
    int tid, lane, wave, G, bid, dry;
};
#define KIN(i) ((const float*)(GAS const float*)c.ka[(i)])
#define KOUT() ((float*)(GAS float*)c.ka[36])
template <class T> __device__ __forceinline__ T* wsp(const Ctx& c, size_t off) { return (T*)(c.ws + off); }

__device__ __forceinline__ int wmap(int kind, int n) {
    if (kind == 0) { if (n < 192) return n; if (n < 224) return 320 + (n - 192); if (n < 256) return -1; if (n < 384) return 192 + (n - 256); if (n < 512) return -1; return n - 160; }
    if (kind == 2) return (n >> 6) * 128 + (n & 63);
    if (kind == 3) return (n >> 6) * 128 + 64 + (n & 63);
    return n;
}
__device__ __forceinline__ void wconv_tile(const Ctx& c, const float* src, int Ks, int Ns, int Nlim, bf16_t* dst, int Kp, int kind, int nt, int kt) {
    LAS float* T = (LAS float*)c.lds;
    const int n0 = nt * 64, k0 = kt * 128;
    const int nn = c.tid & 63, kk0 = c.tid >> 6; const int n = n0 + nn; const int sc = (n < Nlim) ? wmap(kind, n) : -1;
    float v[16];
#pragma unroll
    for (int i = 0; i < 16; ++i) { const int k = k0 + kk0 + 8 * i; v[i] = (k < Ks && sc >= 0) ? src[(size_t)k * Ns + sc] : 0.f; }
#pragma unroll
    for (int i = 0; i < 16; ++i) T[(kk0 + 8 * i) * 65 + nn] = v[i];
    __syncthreads();
#pragma unroll
    for (int i = 0; i < 2; ++i) { const int e = c.tid + i * 512, row = e >> 4, pc = e & 15; float x[8];
#pragma unroll
        for (int j = 0; j < 8; ++j) x[j] = T[(pc * 8 + j) * 65 + row];
        u32x4 w; w.x = cvt_pk_bf16(x[0], x[1]); w.y = cvt_pk_bf16(x[2], x[3]); w.z = cvt_pk_bf16(x[4], x[5]); w.w = cvt_pk_bf16(x[6], x[7]);
        *(u32x4*)(dst + (size_t)(n0 + row) * Kp + k0 + pc * 8) = w; }
    __syncthreads();
}

__device__ __forceinline__ void modv_job(const Ctx& c, int job) {
    const int l = job / 48, j0 = (job % 48) * 64;
    LAS float* sc = (LAS float*)c.lds;
    LAS float* red = sc + 17 * 1024;
    const float* cv = KIN(I_C); const float* cc = KIN(I_CCTX);
    for (int e = c.tid; e < 17 * 1024; e += 512) { const int r = e >> 10, k = e & 1023; const float v = (r < 16) ? cv[r * 1024 + k] : cc[k]; sc[e] = siluf(v); }
    __syncthreads();
    const int col = c.tid & 63, ks = c.tid >> 6;
    const float* w = KIN(I_WMOD) + (size_t)l * 1024 * 3072 + j0 + col;
    float acc[17];
#pragma unroll
    for (int r = 0; r < 17; ++r) acc[r] = 0.f;
    for (int k = ks * 128; k < ks * 128 + 128; ++k) { const float wv = w[(size_t)k * 3072];
#pragma unroll
        for (int r = 0; r < 17; ++r) acc[r] += sc[r * 1024 + k] * wv; }
#pragma unroll
    for (int r = 0; r < 17; ++r) red[(ks * 17 + r) * 64 + col] = acc[r];
    __syncthreads();
    float* mv = wsp<float>(c, WS_MODV);
    for (int e = c.tid; e < 17 * 64; e += 512) { const int r = e >> 6, cl = e & 63; float s = KIN(I_BMOD)[l * 3072 + j0 + cl];
#pragma unroll
        for (int q = 0; q < 8; ++q) s += red[(q * 17 + r) * 64 + cl];
        mv[((size_t)l * 17 + r) * 3072 + j0 + cl] = s; }
    __syncthreads();
}

__device__ __forceinline__ void rope_job(const Ctx& c) {
    float* rg = wsp<float>(c, WS_ROPEG); float* rm = wsp<float>(c, WS_ROPEM);
    for (int e = c.tid; e < 64 * 16; e += 512) { const int pos = e >> 4, f = e & 15; const float inv = powf(10000.f, -(float)(2 * f) / 32.f); const float a = (float)pos * inv; rg[e * 2] = cosf(a); rg[e * 2 + 1] = sinf(a); }
    for (int e = c.tid; e < 64 * 8; e += 512) { const int pos = e >> 3, f = e & 7; const float inv = powf(10000.f, -(float)(2 * f) / 16.f); const float a = (float)pos * inv; rm[e * 2] = cosf(a); rm[e * 2 + 1] = sinf(a); }
}

typedef float cpx __attribute__((ext_vector_type(2)));
#define CPX(a, b) ((cpx){(a), (b)})
__device__ __forceinline__ cpx cmul(cpx a, cpx b) { return CPX(a.x * b.x - a.y * b.y, a.x * b.y + a.y * b.x); }
__device__ __forceinline__ void ssm_tables_job(const Ctx& c, int job) {
    const int l = job >> 4, g = job & 15;
    LAS cpx* apow = (LAS cpx*)c.lds;
    LAS cpx* bbar = apow + 2 * 17 * 64;
    LAS cpx* cm = bbar + 2 * 64 * 16;
    LAS float* Kc = (LAS float*)(cm + 2 * 16 * 64);
    for (int e = c.tid; e < 2 * 64; e += 512) {
        const int d = e >> 6, p = e & 63; const size_t ix = (((size_t)l * 2 + d) * 16 + g) * 64 + p;
        const float lr = KIN(I_LRE)[ix], li = KIN(I_LIM)[ix], st = expf(KIN(I_LSTEP)[((size_t)l * 2 + d) * 16 + g]);
        for (int k = 0; k <= 16; ++k) { const float m = expf(lr * st * (float)k), an = li * st * (float)k; apow[(d * 17 + k) * 64 + p] = CPX(m * cosf(an), m * sinf(an)); }
    }
    __syncthreads();
    for (int e = c.tid; e < 2 * 64 * 16; e += 512) {
        const int d = e >> 10, p = (e >> 4) & 63, h = e & 15; const size_t ix = (((size_t)l * 2 + d) * 16 + g) * 64 + p;
        const float lr = KIN(I_LRE)[ix], li = KIN(I_LIM)[ix];
        const cpx a = apow[(d * 17 + 1) * 64 + p]; const cpx am1 = CPX(a.x - 1.f, a.y);
        const float den = lr * lr + li * li; const cpx q = CPX((am1.x * lr + am1.y * li) / den, (am1.y * lr - am1.x * li) / den);
        const cpx b = CPX(KIN(I_BRE)[ix * 16 + h], KIN(I_BIM)[ix * 16 + h]);
        bbar[e] = cmul(q, b);
        const size_t cx = ((((size_t)l * 2 + d) * 16 + g) * 16 + h) * 64 + p;
        cm[(d * 16 + h) * 64 + p] = CPX(KIN(I_CRE)[cx], KIN(I_CIM)[cx]);
    }
    __syncthreads();
    for (int e = c.tid; e < 2 * 16 * 256; e += 512) {
        const int d = e >> 12, dd = (e >> 8) & 15, ho = (e >> 4) & 15, hi = e & 15; float s = 0.f;
        for (int p = 0; p < 64; ++p) { const cpx w = cmul(cm[(d * 16 + ho) * 64 + p], apow[(d * 17 + dd) * 64 + p]); const cpx b = bbar[(d * 64 + p) * 16 + hi]; s += w.x * b.x - w.y * b.y; }
        Kc[e] = s;
    }
    __syncthreads();
    bf16_t* wkc = wsp<bf16_t>(c, WS_WKC) + ((size_t)l * 16 + g) * 256 * 512;
    for (int e = c.tid; e < 256 * 512; e += 512) {
        const int r = e >> 9, q = e & 511, i = r >> 4, ho = r & 15; float v;
        if (q < 256) { const int j = q >> 4, hi = q & 15; v = 0.f; if (j <= i) v += Kc[((0 * 16 + (i - j)) * 16 + ho) * 16 + hi]; if (j >= i) v += Kc[((1 * 16 + (j - i)) * 16 + ho) * 16 + hi]; }
        else { const int qq = q - 256, dq = qq >> 7, comp = (qq >> 6) & 1, p = qq & 63, k = dq == 0 ? i + 1 : 16 - i; const cpx w = cmul(cm[(dq * 16 + ho) * 64 + p], apow[(dq * 17 + k) * 64 + p]); v = comp == 0 ? w.x : -w.y; }
        wkc[e] = f2bf(v);
    }
    bf16_t* we = wsp<bf16_t>(c, WS_WE) + ((size_t)l * 16 + g) * 256 * 256;
    for (int e = c.tid; e < 256 * 256; e += 512) {
        const int qq = e >> 8, cidx = e & 255, j = cidx >> 4, hi = cidx & 15, dq = qq >> 7, comp = (qq >> 6) & 1, p = qq & 63, k = dq == 0 ? 15 - j : j;
        const cpx w = cmul(apow[(dq * 17 + k) * 64 + p], bbar[(dq * 64 + p) * 16 + hi]);
        we[e] = f2bf(comp == 0 ? w.x : w.y);
    }
    float* a16 = wsp<float>(c, WS_A16);
    for (int e = c.tid; e < 128; e += 512) { const int d = e >> 6, p = e & 63; const cpx a = apow[(d * 17 + 16) * 64 + p]; const size_t ix = ((((size_t)l * 2 + d) * 16 + g) * 64 + p) * 2; a16[ix] = a.x; a16[ix + 1] = a.y; }
    __syncthreads();
}

__device__ __forceinline__ void hyena_mlp_job(const Ctx& c, int job) {
    const int l = job / 136, tt = job % 136;
    const bool isctx = tt >= 128; const int n = isctx ? CTXL : SEQL; const int t0 = isctx ? (tt - 128) * 32 : tt * 32;
    LAS float* z = (LAS float*)c.lds;
    LAS float* h1 = z + 32 * 36;
    LAS float* h2 = h1 + 32 * 64;
    for (int e = c.tid; e < 32 * 33; e += 512) {
        const int ti = e / 33, f = e % 33, t = t0 + ti; float v;
        if (f == 0) v = (float)t / (float)(n - 1);
        else { const int k = (f - 1) & 15; const float band = 1e-4f + (float)k * ((15.f - 1e-4f) / 15.f); const float om = 6.283185307179586f * (float)t / (float)n; v = (f <= 16) ? cosf(band * om) : -sinf(band * om); }
        z[ti * 36 + f] = v;
    }
    __syncthreads();
    for (int e = c.tid; e < 32 * 64; e += 512) {
        const int ti = e >> 6, j = e & 63; float s = KIN(I_HB1)[l * 64 + j];
        for (int f = 0; f < 33; ++f) s += z[ti * 36 + f] * KIN(I_HW1)[((size_t)l * 33 + f) * 64 + j];
        h1[e] = sinf(KIN(I_HF1)[l * 64 + j] * s);
    }
    __syncthreads();
    for (int e = c.tid; e < 32 * 64; e += 512) {
        const int ti = e >> 6, j = e & 63; float s = KIN(I_HB2)[l * 64 + j];
        for (int f = 0; f < 64; ++f) s += h1[ti * 64 + f] * KIN(I_HW2)[((size_t)l * 64 + f) * 64 + j];
        h2[e] = sinf(KIN(I_HF2)[l * 64 + j] * s);
    }
    __syncthreads();
    float* hT = wsp<float>(c, WS_HT) + (size_t)l * 1024 * NTOK;
    const float mind = -3.070113457325394f, maxd = -15.35056728662697f;
#pragma unroll
    for (int cc = 0; cc < 2; ++cc) {
        const int col = c.tid + cc * 512;
        float acc[32];
#pragma unroll
        for (int ti = 0; ti < 32; ++ti) acc[ti] = 0.f;
        for (int f = 0; f < 64; ++f) { const float w = KIN(I_HW3)[((size_t)l * 64 + f) * 1024 + col];
#pragma unroll
            for (int ti = 0; ti < 32; ++ti) acc[ti] += h2[ti * 64 + f] * w; }
        const int ch = col & 255; const float delta = fabsf(mind + (maxd - mind) * (float)ch / 255.f);
        float* dst = hT + (size_t)col * NTOK + (isctx ? SEQL : 0) + t0;
#pragma unroll
        for (int ti = 0; ti < 32; ++ti) { const float tn = (float)(t0 + ti) / (float)(n - 1); dst[ti] = acc[ti] * expf(-tn * delta); }
    }
    __syncthreads();
}

__device__ __forceinline__ void hyena_pack_job(const Ctx& c, int job) {
    const int l = job >> 9, o = (job >> 8) & 1, ch = job & 255;
    const float* hT = wsp<float>(c, WS_HT) + (size_t)l * 1024 * NTOK;
    const float* fw = hT + (size_t)(o * 512 + ch) * NTOK; const float* bw = hT + (size_t)(o * 512 + 256 + ch) * NTOK;
    LAS float* red = (LAS float*)c.lds;
    float fa[8], ba[8];
#pragma unroll
    for (int k = 0; k < 8; ++k) { fa[k] = fw[c.tid + 512 * k]; ba[k] = bw[c.tid + 512 * k]; }
    const float fc = (c.tid < CTXL) ? fw[SEQL + c.tid] : 0.f, bc = (c.tid < CTXL) ? bw[SEQL + c.tid] : 0.f;
    float s0 = 0.f, s1 = fc * fc + bc * bc;
#pragma unroll
    for (int k = 0; k < 8; ++k) s0 += fa[k] * fa[k] + ba[k] * ba[k];
    s0 = wave_sum(s0); s1 = wave_sum(s1);
    if (c.lane == 0) { red[c.wave] = s0; red[8 + c.wave] = s1; }
    __syncthreads();
    float t0 = 0.f, t1 = 0.f;
#pragma unroll
    for (int w = 0; w < 8; ++w) { t0 += red[w]; t1 += red[8 + w]; }
    const float r0 = rsqrtf(t0 + EPS), r1 = rsqrtf(t1 + EPS);
    bf16_t* gr = wsp<bf16_t>(c, WS_GR) + (((size_t)l * 2 + o) * 256 + ch) * 8192;
#pragma unroll
    for (int k = 0; k < 8; ++k) { const int d = c.tid + 512 * k; gr[4095 - d] = f2bf(fa[k] * r0); if (d >= 1) gr[4095 + d] = f2bf(ba[k] * r0); }
    if (c.tid == 0) gr[8191] = 0;
    bf16_t* grc = wsp<bf16_t>(c, WS_GRC) + (((size_t)l * 2 + o) * 256 + ch) * 512;
    if (c.tid < CTXL) { const int d = c.tid; grc[255 - d] = f2bf(fc * r1); if (d >= 1) grc[255 + d] = f2bf(bc * r1); }
    if (c.tid == 0) grc[511] = 0;
    __syncthreads();
}

__device__ __forceinline__ void norm_rows(const Ctx& c, int l  , int next  , int r0 = -1  , int r1 = 0) {
    const float* mvl = wsp<float>(c, WS_MODV) + (size_t)(l < 0 ? 0 : l) * 17 * 3072;
    const float* mvn = wsp<float>(c, WS_MODV) + (size_t)(next < 0 ? 0 : next) * 17 * 3072;
    const bf16_t* outb = wsp<bf16_t>(c, WS_OUTB);
    bf16_t* hb = wsp<bf16_t>(c, WS_HCAT);
    float* ctxr = wsp<float>(c, WS_CTXR);
    const float* xin0 = KIN(I_X); const float* cin0 = KIN(I_CTX); float* outp = KOUT();
    const float* gpost = KIN(I_GPOST) + (l < 0 ? 0 : l) * DM; const float* gpre = KIN(I_GPRE) + (next < 0 ? 0 : next) * DM;
    const int nw = c.G * 8, lane4 = c.lane * 4;
    const int rb0 = r0 >= 0 ? r0 + c.wave * 2 : (c.bid * 8 + c.wave) * 2, rbe = r0 >= 0 ? r1 : MROWS, rbs = r0 >= 0 ? 16 : nw * 2;
    for (int rowb = rb0; rowb < rbe; rowb += rbs) {
        f32x4 xv[2][4]; u32x2 ow[2][4]; const float* xin[2]; float* xout[2]; int mr[2]; bool live[2], isc[2];
#pragma unroll
        for (int rr = 0; rr < 2; ++rr) {
            const int row = rowb + rr, b = row / NTOK, j = row - b * NTOK; isc[rr] = j >= SEQL; live[rr] = !(next < 0 && isc[rr]); mr[rr] = isc[rr] ? 16 : b;
            if (isc[rr]) { xout[rr] = ctxr + ((size_t)b * CTXL + (j - SEQL)) * DM; xin[rr] = (l < 0) ? cin0 + ((size_t)b * CTXL + (j - SEQL)) * DM : xout[rr]; }
            else { xout[rr] = outp + ((size_t)b * SEQL + j) * DM; xin[rr] = (l <= 0) ? xin0 + ((size_t)b * SEQL + j) * DM : xout[rr]; }
#pragma unroll
            for (int q = 0; q < 4; ++q) { xv[rr][q] = __builtin_nontemporal_load((const f32x4*)(xin[rr] + q * 256 + lane4)); if (l >= 0) ow[rr][q] = *(const u32x2*)(outb + (size_t)row * DM + q * 256 + lane4); }
        }
#pragma unroll
        for (int rr = 0; rr < 2; ++rr) {
            if (!live[rr]) continue;
            const int row = rowb + rr;
            if (l >= 0) {
                float ov[16]; float ss = 0.f;
#pragma unroll
                for (int q = 0; q < 4; ++q) { ov[q * 4] = lo_bf(ow[rr][q].x); ov[q * 4 + 1] = hi_bf(ow[rr][q].x); ov[q * 4 + 2] = lo_bf(ow[rr][q].y); ov[q * 4 + 3] = hi_bf(ow[rr][q].y); }
#pragma unroll
                for (int i = 0; i < 16; ++i) ss += ov[i] * ov[i];
                ss = wave_sum(ss); const float rs = rsqrtf(ss * (1.f / DM) + EPS);
#pragma unroll
                for (int q = 0; q < 4; ++q) { const int col = q * 256 + lane4; const f32x4 gp = *(const f32x4*)(gpost + col); const f32x4 gt = *(const f32x4*)(mvl + mr[rr] * 3072 + 2048 + col);
#pragma unroll
                    for (int i = 0; i < 4; ++i) xv[rr][q][i] += gt[i] * (ov[q * 4 + i] * rs * gp[i]); }
            }
            if ((l >= 0 || isc[rr]) && !c.dry) {
#pragma unroll
                for (int q = 0; q < 4; ++q) __builtin_nontemporal_store(xv[rr][q], (f32x4*)(xout[rr] + q * 256 + lane4));
            }
            if (next >= 0) {
                float ss = 0.f;
#pragma unroll
                for (int q = 0; q < 4; ++q)
#pragma unroll
                    for (int i = 0; i < 4; ++i) ss += xv[rr][q][i] * xv[rr][q][i];
                ss = wave_sum(ss); const float rs = rsqrtf(ss * (1.f / DM) + EPS);
#pragma unroll
                for (int q = 0; q < 4; ++q) { const int col = q * 256 + lane4; const f32x4 gp = *(const f32x4*)(gpre + col);
                    const f32x4 sh = *(const f32x4*)(mvn + mr[rr] * 3072 + col), sc = *(const f32x4*)(mvn + mr[rr] * 3072 + 1024 + col);
                    float hv[4];
#pragma unroll
                    for (int i = 0; i < 4; ++i) hv[i] = xv[rr][q][i] * rs * gp[i] * (1.f + sc[i]) + sh[i];
                    u32x2 w; w.x = cvt_pk_bf16(hv[0], hv[1]); w.y = cvt_pk_bf16(hv[2], hv[3]); *(u32x2*)(hb + (size_t)row * DM + col) = w; }
            }
        }
    }
}

__device__ __forceinline__ void p2_rows(const Ctx& c, int l) {
    bf16_t* pb = wsp<bf16_t>(c, WS_PB);
    bf16_t* B0 = pb; bf16_t* B1 = pb + BLKE; bf16_t* B3 = pb + 3 * BLKE; const bf16_t* B4 = pb + 4 * BLKE;
    bf16_t* kr = wsp<bf16_t>(c, WS_KR); bf16_t* kg = wsp<bf16_t>(c, WS_KG); bf16_t* ug = wsp<bf16_t>(c, WS_UG); bf16_t* us = wsp<bf16_t>(c, WS_US);
    const float* ropeG = wsp<float>(c, WS_ROPEG); const float* ropeM = wsp<float>(c, WS_ROPEM);
    const int lane = c.lane;
    const f32x4 gcq = (lane < 48) ? *(const f32x4*)(KIN(I_GCQ) + l * 192 + lane * 4) : (f32x4){0.f, 0.f, 0.f, 0.f};
    const f32x4 gckv = (lane < 32) ? *(const f32x4*)(KIN(I_GCKV) + l * 128 + lane * 4) : (f32x4){0.f, 0.f, 0.f, 0.f};
    const f32x4 gq = *(const f32x4*)(KIN(I_GQ) + l * 64 + (lane & 15) * 4), gk = *(const f32x4*)(KIN(I_GK) + l * 64 + (lane & 15) * 4);
    for (int rowb = (c.bid * 8 + c.wave) * 4; rowb < MROWS; rowb += c.G * 8 * 4) {
        u32x2 w0[4], w1[4], w3[4], w4[4];
#pragma unroll
        for (int rr = 0; rr < 4; ++rr) { const size_t ro = (size_t)(rowb + rr) * 256 + lane * 4;
            w0[rr] = *(const u32x2*)(B0 + ro); w1[rr] = *(const u32x2*)(B1 + ro); w3[rr] = *(const u32x2*)(B3 + ro); w4[rr] = *(const u32x2*)(B4 + ro); }
#pragma unroll
        for (int rr = 0; rr < 4; ++rr) {
            const int row = rowb + rr;
            const int b = row / NTOK, j = row - b * NTOK; const bool islat = j < SEQL; const int rowpos = (j >> 6) & 63, colpos = j & 63;
            const size_t ro = (size_t)row * 256 + lane * 4;
            {
                const u32x2 w = w0[rr]; float x[4] = {lo_bf(w.x), hi_bf(w.x), lo_bf(w.y), hi_bf(w.y)};
                float ss = (lane < 48) ? (x[0] * x[0] + x[1] * x[1] + x[2] * x[2] + x[3] * x[3]) : 0.f; ss = wave_sum(ss);
                const float rs = rsqrtf(ss * (1.f / 192.f) + EPS);
                float xp[4];
#pragma unroll
                for (int i = 0; i < 4; ++i) xp[i] = swz_xor<2>(x[i]);
                u32x2 o; o.x = 0u; o.y = 0u;
                if (lane < 48) { o.x = cvt_pk_bf16(x[0] * rs * gcq[0], x[1] * rs * gcq[1]); o.y = cvt_pk_bf16(x[2] * rs * gcq[2], x[3] * rs * gcq[3]); }
                else if (lane < 56) {
                    const int t = lane - 48; float y[4];
                    if (islat) { const int pos = (t & 4) ? colpos : rowpos; const bool isx2 = (t & 2) != 0;
#pragma unroll
                        for (int i = 0; i < 4; ++i) { const int f = 4 * (t & 1) + i; const float cs = ropeM[(pos * 8 + f) * 2], sn = ropeM[(pos * 8 + f) * 2 + 1]; y[i] = isx2 ? (xp[i] * sn + x[i] * cs) : (x[i] * cs - xp[i] * sn); } }
                    else {
#pragma unroll
                        for (int i = 0; i < 4; ++i) y[i] = x[i]; }
                    u32x2 kk; kk.x = cvt_pk_bf16(y[0], y[1]); kk.y = cvt_pk_bf16(y[2], y[3]); *(u32x2*)(kr + (size_t)row * 32 + t * 4) = kk;
                }
                if (!c.dry) *(u32x2*)(B0 + ro) = o;
            }
            {
                const u32x2 w = w1[rr]; float x[4] = {lo_bf(w.x), hi_bf(w.x), lo_bf(w.y), hi_bf(w.y)};
                float ss = (lane < 32) ? (x[0] * x[0] + x[1] * x[1] + x[2] * x[2] + x[3] * x[3]) : 0.f; ss = wave_sum(ss);
                const float rs = rsqrtf(ss * (1.f / 128.f) + EPS);
                u32x2 o; o.x = 0u; o.y = 0u;
                if (lane < 32) { o.x = cvt_pk_bf16(x[0] * rs * gckv[0], x[1] * rs * gckv[1]); o.y = cvt_pk_bf16(x[2] * rs * gckv[2], x[3] * rs * gckv[3]); }
                if (!c.dry) *(u32x2*)(B1 + ro) = o;
            }
#pragma unroll
            for (int which = 0; which < 2; ++which) {
                const u32x2 w = which == 0 ? w3[rr] : w4[rr]; float x[4] = {lo_bf(w.x), hi_bf(w.x), lo_bf(w.y), hi_bf(w.y)};
                float ss = x[0] * x[0] + x[1] * x[1] + x[2] * x[2] + x[3] * x[3];
                ss += swz_xor<1>(ss); ss += swz_xor<2>(ss); ss += swz_xor<4>(ss); ss += swz_xor<8>(ss);
                const float rs = rsqrtf(ss * (1.f / 64.f) + EPS);
                const int t = lane & 15; const f32x4 g = which == 0 ? gq : gk;
#pragma unroll
                for (int i = 0; i < 4; ++i) x[i] = x[i] * rs * g[i];
                float xp[4];
#pragma unroll
                for (int i = 0; i < 4; ++i) xp[i] = swz_xor<4>(x[i]);
                if (islat) { const int pos = (t & 8) ? colpos : rowpos; const bool isx2 = (t & 4) != 0;
#pragma unroll
                    for (int i = 0; i < 4; ++i) { const int f = 4 * (t & 3) + i; const float cs = ropeG[(pos * 16 + f) * 2], sn = ropeG[(pos * 16 + f) * 2 + 1]; x[i] = isx2 ? (xp[i] * sn + x[i] * cs) : (x[i] * cs - xp[i] * sn); } }
                if (which == 0) { const float qs = 0.125f * LOG2E; u32x2 o; o.x = cvt_pk_bf16(x[0] * qs, x[1] * qs); o.y = cvt_pk_bf16(x[2] * qs, x[3] * qs); if (!c.dry) *(u32x2*)(B3 + ro) = o; }
                else if (lane < 32) { u32x2 o; o.x = cvt_pk_bf16(x[0], x[1]); o.y = cvt_pk_bf16(x[2], x[3]); *(u32x2*)(kg + ((size_t)(b * 2 + (lane >> 4)) * NTOK + j) * 64 + t * 4) = o; }
            }
        }
    }
}
#ifndef PROBE_ABL
#define PROBE_ABL 0
#endif
#ifndef PROBE_GQAONLY
#define PROBE_GQAONLY 0
#endif
template <int DK, bool SUB, bool NOMAX = false, int ABL = 0>
__device__ __forceinline__ bool attn_unit(float (&rowmax)[2], const Ctx& c, const bf16_t* Qp, int qpitch, const bf16_t* Kp, const bf16_t* Vtp, int kt0, int nkt, int nrows,
                                          const bf16_t* gatep, bf16_t* outp, bool rope, int j0, float qscale, const float* ropeM) {
    constexpr int KS = DK / 16, KPC = DK / 8, KPITCH = DK * 2 + 16, KB = 64 * KPITCH, VPITCH = 144, VB = 64 * VPITCH;
    constexpr int KOFF = 0, VOFF = 3 * KB;
    constexpr float LIM = 60.f;
    static_assert(KB % 16 == 0 && VB % 16 == 0, "attention LDS buffer alignment");
    const int tid = c.tid, lane = c.lane, wave = c.wave;
    const int lq_ = opaque(lane), q = lq_ & 31, h = lq_ >> 5;
    LAS unsigned char* lds = c.lds;
    const int rbase = (wave * 64 < nrows) ? wave * 64 : wave * 64 - 256;
    const bool live = wave * 64 < nrows;
    bf16x8 qf[2][KS];
#pragma unroll
    for (int qt = 0; qt < 2; ++qt) {
        const bf16_t* qrow = Qp + (size_t)(rbase + qt * 32 + q) * qpitch + 8 * h;
#pragma unroll
        for (int ks = 0; ks < KS; ++ks) qf[qt][ks] = *(const bf16x8*)(qrow + 16 * ks);
        if (DK == 96) {
            const int jj = j0 + rbase + qt * 32 + q;
#pragma unroll
            for (int ks = 0; ks < KS; ++ks) {
                float x[8]; unpack8(__builtin_bit_cast(u32x4, qf[qt][ks]), x);
                if (ks >= 4) {
                    const int pos = (ks == 4) ? ((jj >> 6) & 63) : (jj & 63);
#pragma unroll
                    for (int e = 0; e < 8; ++e) { const float xp = half_other(x[e], h); const float cs = ropeM[(pos * 8 + e) * 2], sn = ropeM[(pos * 8 + e) * 2 + 1];
                        const float r = h ? (xp * sn + x[e] * cs) : (x[e] * cs - xp * sn); x[e] = rope ? r : x[e]; }
                }
                u32x4 w; w.x = cvt_pk_bf16(x[0] * qscale, x[1] * qscale); w.y = cvt_pk_bf16(x[2] * qscale, x[3] * qscale); w.z = cvt_pk_bf16(x[4] * qscale, x[5] * qscale); w.w = cvt_pk_bf16(x[6] * qscale, x[7] * qscale);
                qf[qt][ks] = __builtin_bit_cast(bf16x8, w);
            }
        }
    }
    f32x16 o00, o01, o10, o11;
#pragma unroll
    for (int i = 0; i < 16; ++i) { o00[i] = 0.f; o01[i] = 0.f; o10[i] = 0.f; o11[i] = 0.f; }
    const float m0 = SUB ? rowmax[0] : 0.f, m1 = SUB ? rowmax[1] : 0.f; float l0 = 0.f, l1 = 0.f;
    float rmax0 = -1e30f, rmax1 = -1e30f;
    const int tq_ = opaque(tid);
    const int kst0 = (tq_ / KPC) * KPITCH + (tq_ % KPC) * 16, kst1 = ((tq_ + 512) / KPC) * KPITCH + ((tq_ + 512) % KPC) * 16;
    const int kgl0 = ((tq_ / KPC) * DK + (tq_ % KPC) * 8) * 2, kgl1 = (((tq_ + 512) / KPC) * DK + ((tq_ + 512) % KPC) * 8) * 2;
    const int vst = (tq_ >> 3) * VPITCH + ((tq_ & 7) >> 1) * 32 + ((tq_ & 7) & 1) * 8, vgl = ((tq_ >> 3) * NTOK + (tq_ & 7) * 8) * 2;
    const bool has2 = (DK == 96) && tq_ < 256;
    const int kfo = q * KPITCH + 16 * h, vfo = q * VPITCH + 16 * h;
    const char* Kc = (const char*)Kp; const char* Vc = (const char*)Vtp;
    u32x4 kreg0, kreg1 = {0u, 0u, 0u, 0u}, vreg;
#define AT_GLOADK(kt) do { if (ABL & 1) break; const char* kb_ = Kc + (size_t)(kt) * (64 * DK * 2); kreg0 = *(const u32x4*)(kb_ + kgl0); if (has2) kreg1 = *(const u32x4*)(kb_ + kgl1); } while (0)
#define AT_GLOADV(kt) do { if (ABL & 1) break; vreg = *(const u32x4*)(Vc + (size_t)(kt) * 128 + vgl); } while (0)
#define AT_WRITEK(bi) do { if (ABL & 1) break; LAS unsigned char* bb = lds + KOFF + (bi) * KB; *(LAS u32x4*)(bb + kst0) = kreg0; if (has2) *(LAS u32x4*)(bb + kst1) = kreg1; } while (0)
#define AT_WRITEV(bi) do { if (ABL & 1) break; LAS u32x2* vd = (LAS u32x2*)(lds + VOFF + (bi) * VB + vst); vd[0] = (u32x2){vreg.x, vreg.y}; vd[2] = (u32x2){vreg.z, vreg.w}; } while (0)
#define AT_KPRE(bi, jh) do { if (KPRE) { const LAS unsigned char* kb_ = lds + KOFF + (bi) * KB + (jh) * 32 * KPITCH + kfo; \
        _Pragma("unroll") for (int ks = 0; ks < KS; ++ks) kf[ks] = *(const LAS bf16x8*)(kb_ + 32 * ks); } } while (0)
#define AT_QK(S0, S1, bi, jh) do { const LAS unsigned char* kb = lds + KOFF + (bi) * KB + (jh) * 32 * KPITCH + kfo; \
        _Pragma("unroll") for (int i = 0; i < 16; ++i) { S0[i] = 0.f; S1[i] = 0.f; } \
        if (!(ABL & 8)) _Pragma("unroll") for (int ks = 0; ks < KS; ++ks) { \
            const bf16x8 a0 = KPRE ? kf[ks] : *(const LAS bf16x8*)(kb + 32 * ks); \
            S0 = __builtin_amdgcn_mfma_f32_32x32x16_bf16(a0, qf[0][ks], S0, 0, 0, 0); \
            S1 = __builtin_amdgcn_mfma_f32_32x32x16_bf16(a0, qf[1][ks], S1, 0, 0, 0); } } while (0)
#define AT_MAX(S, RM) do { if (!SUB && !NOMAX) { _Pragma("unroll") for (int i = 0; i < 16; i += 2) RM = max3_raw(RM, S[i], S[i + 1]); } } while (0)
#define AT_EXP(S, M, L, PK0, PK1) do { float ps = 0.f; \
        _Pragma("unroll") for (int i = 0; i < 16; ++i) { S[i] = (ABL & 2) ? S[i] * 0.001f : __builtin_amdgcn_exp2f(SUB ? S[i] - M : S[i]); ps += S[i]; } \
        L += ps; u32x4 w; \
        w.x = cvt_pk_bf16(S[0], S[1]); w.y = cvt_pk_bf16(S[2], S[3]); w.z = cvt_pk_bf16(S[4], S[5]); w.w = cvt_pk_bf16(S[6], S[7]); PK0 = __builtin_bit_cast(bf16x8, w); \
        w.x = cvt_pk_bf16(S[8], S[9]); w.y = cvt_pk_bf16(S[10], S[11]); w.z = cvt_pk_bf16(S[12], S[13]); w.w = cvt_pk_bf16(S[14], S[15]); PK1 = __builtin_bit_cast(bf16x8, w); } while (0)
#define AT_VLOAD() do { va00 = *(const LAS bf16x8*)(vb); va10 = *(const LAS bf16x8*)(vb + 32 * VPITCH); va01 = *(const LAS bf16x8*)(vb + 32); va11 = *(const LAS bf16x8*)(vb + 32 * VPITCH + 32); } while (0)
#define AT_SUB(SC0, SC1, SN0, SN1, vbi, jh, nbi, njh) do { \
          \
        const LAS unsigned char* vb = lds + VOFF + (vbi) * VB + (jh) * 64 + vfo; \
        bf16x8 va00, va10, va01, va11; \
        if (DK == 64) { AT_VLOAD(); }        \
        AT_MAX(SC0, rmax0); AT_MAX(SC1, rmax1); \
        AT_QK(SN0, SN1, nbi, njh); \
        bf16x8 p00, p01, p10, p11; \
        AT_EXP(SC0, m0, l0, p00, p01); AT_EXP(SC1, m1, l1, p10, p11); \
        if (DK != 64) { AT_VLOAD(); } \
        if (!(ABL & 4)) { \
            o00 = __builtin_amdgcn_mfma_f32_32x32x16_bf16(va00, p00, o00, 0, 0, 0); \
            o01 = __builtin_amdgcn_mfma_f32_32x32x16_bf16(va10, p00, o01, 0, 0, 0); \
            o10 = __builtin_amdgcn_mfma_f32_32x32x16_bf16(va00, p10, o10, 0, 0, 0); \
            o11 = __builtin_amdgcn_mfma_f32_32x32x16_bf16(va10, p10, o11, 0, 0, 0); \
            o00 = __builtin_amdgcn_mfma_f32_32x32x16_bf16(va01, p01, o00, 0, 0, 0); \
            o01 = __builtin_amdgcn_mfma_f32_32x32x16_bf16(va11, p01, o01, 0, 0, 0); \
            o10 = __builtin_amdgcn_mfma_f32_32x32x16_bf16(va01, p11, o10, 0, 0, 0); \
            o11 = __builtin_amdgcn_mfma_f32_32x32x16_bf16(va11, p11, o11, 0, 0, 0); } \
        if (ABL & 4) { asm volatile("" :: "v"(p00), "v"(p01), "v"(p10), "v"(p11), "v"(va00), "v"(va10), "v"(va01), "v"(va11)); } \
        } while (0)
    if (!SUB && !NOMAX && tid == 0) *(volatile LAS unsigned*)(lds + LDS_MISC_OFF + 24) = 0u;
    AT_GLOADK(kt0); AT_GLOADV(kt0); AT_WRITEK(0); AT_WRITEV(0);
    AT_GLOADK(kt0 + 1); AT_WRITEK(1);
    __syncthreads();
    f32x16 sa0, sa1, sb0, sb1;
    constexpr bool KPRE = (DK == 64);
    bf16x8 kf[KS];
    AT_KPRE(0, 0);
    AT_QK(sa0, sa1, 0, 0);
    AT_KPRE(0, 1);
    int kb0 = 0, kb1 = 1, kb2 = 2;
    for (int t = 0; t < nkt; ++t) {
        const int tk = (t + 2 < nkt) ? t + 2 : nkt - 1, tv = (t + 1 < nkt) ? t + 1 : nkt - 1;
        AT_GLOADK(kt0 + tk);
        AT_SUB(sa0, sa1, sb0, sb1, t & 1, 0, kb0, 1);
        AT_KPRE(kb1, 0);
        AT_WRITEK(kb2);
        AT_GLOADV(kt0 + tv);
        AT_SUB(sb0, sb1, sa0, sa1, t & 1, 1, kb1, 0);
        AT_KPRE(kb1, 1);
        AT_WRITEV((t + 1) & 1);
        if (!(ABL & 16)) __syncthreads();
        const int tmp = kb0; kb0 = kb1; kb1 = kb2; kb2 = tmp;
    }
#undef AT_GLOADK
#undef AT_GLOADV
#undef AT_WRITEK
#undef AT_WRITEV
#undef AT_QK
#undef AT_KPRE
#undef AT_MAX
#undef AT_EXP
#undef AT_SUB
#undef AT_VLOAD
    bool bad = false;
    if (!SUB && !NOMAX) { const float r0 = half_max(rmax0), r1 = half_max(rmax1); rowmax[0] = r0; rowmax[1] = r1; const bool b_ = live && !(r0 < LIM && r0 > -LIM && r1 < LIM && r1 > -LIM); volatile LAS unsigned* flg = (volatile LAS unsigned*)(lds + LDS_MISC_OFF + 24); if (__any(b_ ? 1 : 0) && opaque(lane) == 0) *flg = 1u; __syncthreads(); bad = *flg != 0u; __syncthreads(); }
    if (live && !bad) {
        const int le_ = opaque(lane), q = le_ & 31, h = le_ >> 5;
#pragma unroll
        for (int qt = 0; qt < 2; ++qt) {
            const float lr = qt ? l1 : l0; const float lt = half_sum(lr), inv = 1.f / lt;
            const size_t row = (size_t)(rbase + qt * 32 + q);
#pragma unroll
            for (int dt = 0; dt < 2; ++dt)
#pragma unroll
                for (int g4 = 0; g4 < 4; ++g4) {
                    const int dv0 = dt * 32 + 8 * g4 + 4 * h;
                    const u32x2 gw = *(const u32x2*)(gatep + row * 256 + dv0);
                    const float g0 = siluf(lo_bf(gw.x)), g1 = siluf(hi_bf(gw.x)), g2 = siluf(lo_bf(gw.y)), g3 = siluf(hi_bf(gw.y));
                    const f32x16& o = qt ? (dt ? o11 : o10) : (dt ? o01 : o00);
                    u32x2 w; w.x = cvt_pk_bf16(o[4 * g4] * inv * g0, o[4 * g4 + 1] * inv * g1); w.y = cvt_pk_bf16(o[4 * g4 + 2] * inv * g2, o[4 * g4 + 3] * inv * g3);
                    *(u32x2*)(outp + row * DM + dv0) = w;
                }
        }
    }
    return bad;
}

template <int N>
__device__ __forceinline__ void hyena_conv(const Ctx& c, LAS unsigned char* ub, LAS unsigned char* gb, int pass, const bf16_t* xmul  , float bias,
                                           bf16_t* zdst  , const bf16_t* gmul, bf16_t* cat  , float cw0, float cw1, float cw2, float cb  ) {
    constexpr int UP = (N + 256) * 2 + 16, NPAIR = N / 256, OFF8 = N - 8;
    const int lane = c.lane, i16 = lane & 15, kq = lane >> 4;
    for (int pr = c.wave; pr < NPAIR; pr += 8) {
        const int t0 = pr * 256;
        u32x4 xq[2][4], gq[2][4]; bf16_t xl[2][4], xr[2][4];
#pragma unroll
        for (int half = 0; half < 2; ++half)
#pragma unroll
            for (int r = 0; r < 4; ++r) { const int t8 = t0 + half * 128 + 32 * kq + 8 * r; const bf16_t* xp_ = xmul + (size_t)i16 * NTOK + t8; xq[half][r] = *(const u32x4*)xp_;
                xl[half][r] = (t8 > 0) ? xp_[-1] : (bf16_t)0; xr[half][r] = (t8 + 8 < N) ? xp_[8] : (bf16_t)0;
                gq[half][r] = (pass == 1) ? *(const u32x4*)(gmul + (size_t)i16 * NTOK + t8) : (u32x4){0u, 0u, 0u, 0u}; }
        f32x4 acc[2][8];
#pragma unroll
        for (int m = 0; m < 8; ++m) { acc[0][m] = (f32x4){0.f, 0.f, 0.f, 0.f}; acc[1][m] = (f32x4){0.f, 0.f, 0.f, 0.f}; }
        const LAS unsigned char* up = ub + i16 * UP + 256 + kq * 16;
        const LAS unsigned char* gp = gb + (OFF8 - t0 - 8 * i16 + 8 * kq) * 2;
        bf16x8 bfa = *(const LAS bf16x8*)(up - 256), bfb = *(const LAS bf16x8*)(up);
        u32x4 wa = *(const LAS u32x4*)(gp - 256), wb = *(const LAS u32x4*)(gp - 256 + 16);
        for (int s0 = -128; s0 < N; s0 += 32) {
            const int sn = (s0 + 32 < N) ? s0 + 32 : s0;
            const bf16x8 bfan = *(const LAS bf16x8*)(up + sn * 2), bfbn = *(const LAS bf16x8*)(up + sn * 2 + 256);
            const u32x4 wan = *(const LAS u32x4*)(gp + sn * 2), wbn = *(const LAS u32x4*)(gp + sn * 2 + 16);
            const unsigned w[8] = {wa.x, wa.y, wa.z, wa.w, wb.x, wb.y, wb.z, wb.w};
            unsigned sh[7];
#pragma unroll
            for (int k = 0; k < 7; ++k) sh[k] = __builtin_amdgcn_alignbit(w[k + 1], w[k], 16);
#pragma unroll
            for (int m = 0; m < 8; ++m) {
                u32x4 a;
                if (m & 1) { const int d0 = (7 - m) >> 1; a = (u32x4){w[d0], w[d0 + 1], w[d0 + 2], w[d0 + 3]}; }
                else { const int d0 = (6 - m) >> 1; a = (u32x4){sh[d0], sh[d0 + 1], sh[d0 + 2], sh[d0 + 3]}; }
                acc[0][m] = __builtin_amdgcn_mfma_f32_16x16x32_bf16(__builtin_bit_cast(bf16x8, a), bfa, acc[0][m], 0, 0, 0);
                acc[1][m] = __builtin_amdgcn_mfma_f32_16x16x32_bf16(__builtin_bit_cast(bf16x8, a), bfb, acc[1][m], 0, 0, 0);
            }
            bfa = bfan; bfb = bfbn; wa = wan; wb = wbn;
        }
#pragma unroll
        for (int half = 0; half < 2; ++half)
#pragma unroll
            for (int r = 0; r < 4; ++r) {
                const int t8 = t0 + half * 128 + 32 * kq + 8 * r;
                float uu[8], xr8[8], xm[8]; unpack8(*(const LAS u32x4*)(ub + i16 * UP + 256 + t8 * 2), uu); unpack8(xq[half][r], xr8);
                {   float pv = bf2f(xl[half][r]);
#pragma unroll
                    for (int m = 0; m < 8; ++m) { const float nx = (m < 7) ? xr8[m + 1] : bf2f(xr[half][r]); xm[m] = bf2f(f2bf(cw0 * pv + cw1 * xr8[m] + cw2 * nx + cb)); pv = xr8[m]; } }
                float y[8];
#pragma unroll
                for (int m = 0; m < 8; ++m) y[m] = xm[m] * (acc[half][m][r] + bias * uu[m]);
                if (pass == 0) { u32x4 o; o.x = cvt_pk_bf16(y[0], y[1]); o.y = cvt_pk_bf16(y[2], y[3]); o.z = cvt_pk_bf16(y[4], y[5]); o.w = cvt_pk_bf16(y[6], y[7]); *(u32x4*)(zdst + (size_t)i16 * NTOK + t8) = o; }
                else { float gg[8]; unpack8(gq[half][r], gg);
#pragma unroll
                    for (int m = 0; m < 8; ++m) gg[m] = bf2f(f2bf(siluf(gg[m])));
                    u32x4 o; o.x = cvt_pk_bf16(y[0] * gg[0], y[1] * gg[1]); o.y = cvt_pk_bf16(y[2] * gg[2], y[3] * gg[3]); o.z = cvt_pk_bf16(y[4] * gg[4], y[5] * gg[5]); o.w = cvt_pk_bf16(y[6] * gg[6], y[7] * gg[7]);
                    *(u32x4*)(cat + (size_t)i16 * NTOK + t8) = o; }
            }
    }
}
template <int N>
__device__ __forceinline__ void hyena_seq(const Ctx& c, int l, int ch, int toff) {
    constexpr int UP = (N + 256) * 2 + 16;
    LAS unsigned char* ub = c.lds; LAS unsigned char* gb = c.lds + 16 * UP;
    const bf16_t* vv = wsp<bf16_t>(c, WS_HYV) + (size_t)ch * 16 * NTOK + toff;
    bf16_t* vz = wsp<bf16_t>(c, WS_HYZ) + (size_t)ch * 16 * NTOK + toff;
    const bf16_t* x1 = wsp<bf16_t>(c, WS_HYX1) + (size_t)ch * 16 * NTOK + toff;
    const bf16_t* x2 = wsp<bf16_t>(c, WS_HYX2) + (size_t)ch * 16 * NTOK + toff;
    const bf16_t* gm = wsp<bf16_t>(c, WS_HYG) + (size_t)ch * 16 * NTOK + toff;
    bf16_t* cat = wsp<bf16_t>(c, WS_HYY) + (size_t)ch * 16 * NTOK + toff;
    { const int e = c.tid, b = e >> 5, side = (e >> 4) & 1, pc = e & 15; unsigned z = 0u; asm volatile("" : "+v"(z)); *(LAS u32x4*)(ub + b * UP + side * (256 + N * 2) + pc * 16) = (u32x4){z, z, z, z}; }
    for (int pass = 0; pass < 2; ++pass) {
        const bf16_t* gr = (N == SEQL) ? wsp<bf16_t>(c, WS_GR) + (((size_t)l * 2 + pass) * 256 + ch) * 8192 : wsp<bf16_t>(c, WS_GRC) + (((size_t)l * 2 + pass) * 256 + ch) * 512;
        const bf16_t* usrc = pass == 0 ? vv : vz;
        constexpr int NG = (2 * N / 8 + 511) / 512;
        {
            u32x4 t[NG];
#pragma unroll
            for (int k = 0; k < NG; ++k) { const int e = c.tid + k * 512; t[k] = (e < 2 * N / 8) ? *(const u32x4*)(gr + e * 8) : (u32x4){0u, 0u, 0u, 0u}; }
#pragma unroll
            for (int k = 0; k < NG; ++k) { const int e = c.tid + k * 512; if (e < 2 * N / 8) *(LAS u32x4*)(gb + e * 16) = t[k]; }
        }
        if constexpr (N == SEQL) {
#pragma unroll
            for (int k0 = 0; k0 < 16; k0 += 8) {
                u32x4 t[8];
#pragma unroll
                for (int k = 0; k < 8; ++k) t[k] = *(const u32x4*)(usrc + (size_t)(k0 + k) * NTOK + c.tid * 8);
#pragma unroll
                for (int k = 0; k < 8; ++k) *(LAS u32x4*)(ub + (k0 + k) * UP + 256 + c.tid * 16) = t[k];
            }
        } else {
            const int b = c.tid >> 5, pc = c.tid & 31;
            *(LAS u32x4*)(ub + b * UP + 256 + pc * 16) = *(const u32x4*)(usrc + (size_t)b * NTOK + pc * 8);
        }
        __syncthreads();
        const float* hcw = KIN(I_HCW) + (size_t)l * 3 * 768; const float* hcb = KIN(I_HCB) + l * 768;
        if (pass == 0) {
            const float w0 = hcw[ch], w1 = hcw[768 + ch], w2 = hcw[1536 + ch], bs = hcb[ch];
            constexpr int PPT = (N == SEQL) ? 16 : 1;
            u32x4 o[PPT];
#pragma unroll
            for (int k = 0; k < PPT; ++k) { const int b = (N == SEQL) ? k : (c.tid >> 5), pc = (N == SEQL) ? c.tid : (c.tid & 31); const LAS unsigned char* p = ub + b * UP + 256 + pc * 16;
                float x[8]; unpack8(*(const LAS u32x4*)p, x); float pv = bf2f(*(const LAS bf16_t*)(p - 2)); const float nx8 = bf2f(*(const LAS bf16_t*)(p + 16)); float y[8];
#pragma unroll
                for (int m = 0; m < 8; ++m) { const float nx = (m < 7) ? x[m + 1] : nx8; y[m] = w0 * pv + w1 * x[m] + w2 * nx + bs; pv = x[m]; }
                o[k].x = cvt_pk_bf16(y[0], y[1]); o[k].y = cvt_pk_bf16(y[2], y[3]); o[k].z = cvt_pk_bf16(y[4], y[5]); o[k].w = cvt_pk_bf16(y[6], y[7]); }
            __syncthreads();
#pragma unroll
            for (int k = 0; k < PPT; ++k) { const int b = (N == SEQL) ? k : (c.tid >> 5), pc = (N == SEQL) ? c.tid : (c.tid & 31); *(LAS u32x4*)(ub + b * UP + 256 + pc * 16) = o[k]; }
            __syncthreads();
        }
        const float bias = KIN(I_HBIAS)[((size_t)l * 2 + pass) * 256 + ch];
        const int cc = (pass + 1) * 256 + ch;
        hyena_conv<N>(c, ub, gb, pass, pass == 0 ? x1 : x2, bias, vz, gm, cat, hcw[cc], hcw[768 + cc], hcw[1536 + cc], hcb[cc]);
        asm volatile("s_waitcnt vmcnt(0)" ::: "memory");
        __syncthreads();
    }
}

__device__ __forceinline__ void hyena_untranspose(const Ctx& c, int tl0, int tl1) {
    const bf16_t* yT = wsp<bf16_t>(c, WS_HYY); bf16_t* cat = wsp<bf16_t>(c, WS_HCAT);
    LAS bf16_t* T = (LAS bf16_t*)c.lds;
    LAS unsigned* T32 = (LAS unsigned*)c.lds;
    for (int tl = tl0; tl < tl1; ++tl) {
        const int b = tl / 68, j0 = (tl - b * 68) * 64;
        u32x4 pre[4];
#pragma unroll
        for (int k = 0; k < 4; ++k) { const int e = c.tid + k * 512, ch = e >> 3, pc = e & 7; pre[k] = *(const u32x4*)(yT + ((size_t)ch * 16 + b) * NTOK + j0 + pc * 8); }
#pragma unroll
        for (int k = 0; k < 4; ++k) { const int e = c.tid + k * 512, ch = e >> 3, pc = e & 7; LAS unsigned* d = T32 + (ch * 132 + pc * 16) / 4; d[0] = pre[k].x; d[1] = pre[k].y; d[2] = pre[k].z; d[3] = pre[k].w; }
        __syncthreads();
#pragma unroll
        for (int k = 0; k < 4; ++k) { const int e = c.tid + k * 512, t = e >> 5, c0 = (e & 31) * 8; float v[8];
#pragma unroll
            for (int i = 0; i < 8; ++i) v[i] = bf2f(T[(c0 + i) * 66 + t]);
            u32x4 w; w.x = cvt_pk_bf16(v[0], v[1]); w.y = cvt_pk_bf16(v[2], v[3]); w.z = cvt_pk_bf16(v[4], v[5]); w.w = cvt_pk_bf16(v[6], v[7]);
            *(u32x4*)(cat + ((size_t)b * NTOK + j0 + t) * DM + 768 + c0) = w; }
        __syncthreads();
    }
}

__device__ __forceinline__ void ssm_scan_item(const Ctx& c, int l, int item) {
    const int b = item >> 2, g = (item & 3) * 4 + (c.tid >> 7), dq = (c.tid >> 6) & 1, p = c.tid & 63;
    const float* a16 = wsp<float>(c, WS_A16) + ((((size_t)l * 2 + dq) * 16 + g) * 64 + p) * 2;
    const float ar = a16[0], ai = a16[1];
    const bf16_t* E = wsp<bf16_t>(c, WS_E); bf16_t* US = wsp<bf16_t>(c, WS_US);
    float sr = 0.f, si = 0.f;
    for (int st0 = 0; st0 < NCHB; st0 += 8) {
        float er[8], ei[8]; size_t ro[8];
#pragma unroll
        for (int k = 0; k < 8; ++k) { const int st = st0 + k; const int cc = dq == 0 ? (st < 16 ? 256 + st : st - 16) : (st < 16 ? 271 - st : 255 - (st - 16));
            ro[k] = (size_t)g * NCHUNK + (size_t)b * NCHB + cc; er[k] = bf2f(E[ro[k] * 256 + dq * 128 + p]); ei[k] = bf2f(E[ro[k] * 256 + dq * 128 + 64 + p]); }
#pragma unroll
        for (int k = 0; k < 8; ++k) {
            US[ro[k] * 512 + 256 + dq * 128 + p] = f2bf(sr); US[ro[k] * 512 + 256 + dq * 128 + 64 + p] = f2bf(si);
            const float nr = ar * sr - ai * si + er[k], ni = ar * si + ai * sr + ei[k]; sr = nr; si = ni;
        }
    }
}

constexpr int LDS_BYTES = 163840;
constexpr int LDS_MISC = LDS_MISC_OFF;
static_assert(LDS_MISC_OFF == LDS_BYTES - 256, "LDS map");
constexpr int NPRO = 1, NPH = 6, NPHASES = NPRO + DEPTH * NPH;
constexpr int QI_HY = 256, QI_SCAN = 64, QI_ATTL = NB * 8 * 8, QI_SSM2 = 16 * 17, QI_UNT = 272, QI_ATTC = NB * 8, QI_GLU = MROWS / 256;
constexpr int QO_SCAN = QI_HY, QO_ATTL = QO_SCAN + QI_SCAN, QO_SSM2 = QO_ATTL + QI_ATTL, QO_UNT = QO_SSM2 + QI_SSM2, QO_ATTC = QO_UNT + QI_UNT, QO_GLU = QO_ATTC + QI_ATTC, QI_TOTAL = QO_GLU + QI_GLU;
#ifndef PROBE_DUP_MASK
#define PROBE_DUP_MASK 0
#endif
#ifndef PROBE_P4KINDS
#define PROBE_P4KINDS 0x7f
#endif
__device__ __forceinline__ void dep_signal(const Ctx& c, unsigned* cnt) {
    asm volatile("s_waitcnt vmcnt(0)" ::: "memory");
    __syncthreads();
    if (c.tid == 0) { __builtin_amdgcn_fence(__ATOMIC_RELEASE, "agent"); asm volatile("s_waitcnt vmcnt(0)" ::: "memory"); (void)xb_add(cnt, 1u); }
}
__device__ __forceinline__ void dep_signal_wt(const Ctx& c, unsigned* cnt) {
    asm volatile("s_waitcnt vmcnt(0)" ::: "memory");
    __syncthreads();
    if (c.tid == 0) (void)xb_add(cnt, 1u);
}
__device__ __forceinline__ void dep_wait(const Ctx& c, unsigned* cnt, unsigned need, unsigned* tmo) {
    if (c.dry) return;
    if (c.tid == 0) {
        unsigned sp = 0;
        while (xb_ld(cnt) < need) { __builtin_amdgcn_s_sleep(2); if ((++sp & 255u) == 0u) { if (xb_ld(tmo)) break; if (sp > XB_SPIN_CAP) { atomicAdd(tmo, 1u); break; } } }
        __builtin_amdgcn_fence(__ATOMIC_ACQUIRE, "agent");
        asm volatile("s_waitcnt vmcnt(0)" ::: "memory");
    }
    __syncthreads();
}

__global__ void __launch_bounds__(512, 2) mk_fwd(Params prm) {
    extern __shared__ __attribute__((aligned(16))) unsigned char lds_raw[];
    Ctx c; c.lds = (LAS unsigned char*)lds_raw; c.ka = (kargp_t)__builtin_amdgcn_kernarg_segment_ptr(); c.ws = prm.ws; c.tid = threadIdx.x; c.lane = c.tid & 63; c.wave = __builtin_amdgcn_readfirstlane(c.tid >> 6); c.G = gridDim.x; c.bid = blockIdx.x; c.dry = prm.dry;
    const int wave0 = c.wave;
    volatile LAS unsigned* misc = (volatile LAS unsigned*)(c.lds + LDS_MISC);
    if (c.tid < 16) misc[c.tid] = 0u;
    __syncthreads();
    unsigned* ctl = wsp<unsigned>(c, WS_CTL);
    const int lo = prm.ph_lo, hi = prm.ph_hi;
    const bool fused = (hi - lo) > 1;
    XcdBarrier bar; bar.bar = ctl + CW_BAR; bar.x = 0; bar.st = misc;
    if (fused) bar = xcd_barrier_post(ctl + CW_BAR, misc);
#ifndef SITE_MASK
#define SITE_MASK 0x3ff
#endif
#define SITE(n) (((SITE_MASK) >> (n)) & 1)
#define IN(k) (lo <= (k) && (k) < hi)
#define FRESH() do { { kargp_t _k = (kargp_t)__builtin_amdgcn_kernarg_segment_ptr(); asm volatile("" : "+s"(_k)); c.ka = _k; c.ws = (unsigned char*)(GAS unsigned char*)_k[37]; } { int _w = wave0; asm volatile("" : "+s"(_w)); c.wave = _w; c.lane = lane_id_fresh(); c.tid = c.wave * 64 + c.lane; } } while (0)
#define SEAM(k) do { if (IN((k) + 1)) xcd_barrier(bar); } while (0)

    if (SITE(0) && IN(0)) {
        FRESH();
        constexpr int J_MOD = 192, J_HY = 544, J_SSM = 64, J_WIN = 4 * 48 * 8, J_WOUT = 4 * 16 * 8, J_WUQ = 4 * 8 * 2, J_W256 = 4 * 4 * 2, J_NORM = MROWS / 256, J_PACK = 4 * 2 * 256;
        constexpr int J0 = J_MOD, J1 = J0 + J_HY, J2 = J1 + J_SSM, J3 = J2 + J_WIN, J4 = J3 + J_WOUT, J5 = J4 + J_WUQ, J6 = J5 + J_W256, J7 = J6 + J_W256, J8 = J7 + J_W256, J9 = J8 + 1, J10 = J9 + J_NORM, J11 = J10 + J_PACK;
        unsigned* dep = ctl + CW_DEP + DEP_SET * 8;
        unsigned* tmo = ctl + CW_BAR + XB_TMO;
        for (int job = c.bid; job < J11; job += c.G) {
            FRESH();
            if (job < J0) { modv_job(c, job); dep_signal(c, dep); }
            else if (job < J1) { hyena_mlp_job(c, job - J0); dep_signal(c, dep + 64); }
            else if (job < J2) ssm_tables_job(c, job - J1);
            else if (job < J3) { const int r = job - J2, l = r / 384, q = r % 384; wconv_tile(c, KIN(I_WIN) + (size_t)l * DM * INC, DM, INC, INP, wsp<bf16_t>(c, WS_WIN) + (size_t)l * INP * DM, DM, 0, q / 8, q % 8); }
            else if (job < J4) { const int r = job - J3, l = r / 128, q = r % 128; wconv_tile(c, KIN(I_WOUT) + (size_t)l * DM * DM, DM, DM, DM, wsp<bf16_t>(c, WS_WOUT) + (size_t)l * DM * DM, DM, 1, q / 8, q % 8); }
            else if (job < J5) { const int r = job - J4, l = r / 16, q = r % 16; wconv_tile(c, KIN(I_WUQ) + (size_t)l * 192 * 384, 192, 384, 384, wsp<bf16_t>(c, WS_WUQ) + (size_t)l * 512 * 256, 256, 1, q / 2, q % 2); }
            else if (job < J6) { const int r = job - J5, l = r / 8, q = r % 8; wconv_tile(c, KIN(I_WUKV) + (size_t)l * 128 * 512, 128, 512, 256, wsp<bf16_t>(c, WS_WUK) + (size_t)l * 256 * 256, 256, 2, q / 2, q % 2); }
            else if (job < J7) { const int r = job - J6, l = r / 8, q = r % 8; wconv_tile(c, KIN(I_WUKV) + (size_t)l * 128 * 512, 128, 512, 256, wsp<bf16_t>(c, WS_WUV) + (size_t)l * 256 * 256, 256, 3, q / 2, q % 2); }
            else if (job < J8) { const int r = job - J7, l = r / 8, q = r % 8; wconv_tile(c, KIN(I_GLUW) + (size_t)l * 256 * 256, 256, 256, 256, wsp<bf16_t>(c, WS_WGLU) + (size_t)l * 256 * 256, 256, 1, q / 2, q % 2); }
            else if (job < J9) rope_job(c);
            else if (job < J10) { dep_wait(c, dep, J_MOD, tmo); FRESH(); const int t = job - J9; norm_rows(c, -1, 0, t * 256, t * 256 + 256); }
            else { dep_wait(c, dep + 64, J_HY, tmo); FRESH(); hyena_pack_job(c, job - J10); }
        }
        SEAM(0);
    }
    for (int l = 0; l < DEPTH; ++l) {
        const int pbase = NPRO + l * NPH;
        if (SITE(2) && IN(pbase + 0)) {
            FRESH();
            pg8::Gemm g{wsp<bf16_t>(c, WS_HCAT), wsp<bf16_t>(c, WS_WIN) + (size_t)l * INP * DM, MROWS, INP, DM};
            pg8::StaticOrder S; S.init(MROWS, INP, c.G, c.bid);
            EpiInProj E{wsp<bf16_t>(c, WS_PB), wsp<bf16_t>(c, WS_UG), wsp<bf16_t>(c, WS_US), wsp<bf16_t>(c, WS_VTG), wsp<bf16_t>(c, WS_HYV), c.lds + pg8::STAGE_BYTES};
            pg8::gemm_phase(c.lds, g, S, E, c.tid);
            SEAM(pbase + 0);
        }
        if (SITE(3) && IN(pbase + 1)) { FRESH(); p2_rows(c, l); SEAM(pbase + 1); }
        if (SITE(4) && IN(pbase + 2)) {
            FRESH();
            pg8::Gemm g{wsp<bf16_t>(c, WS_PB), wsp<bf16_t>(c, WS_WUQ), MROWS, 512, 256};
            pg8::P3Order S{wsp<bf16_t>(c, WS_PB), wsp<bf16_t>(c, WS_PB) + BLKE, wsp<bf16_t>(c, WS_WUQ) + (size_t)l * 512 * 256, wsp<bf16_t>(c, WS_WUK) + (size_t)l * 256 * 256, wsp<bf16_t>(c, WS_WUV) + (size_t)l * 256 * 256,
                           wsp<bf16_t>(c, WS_UG), wsp<bf16_t>(c, WS_WE) + (size_t)l * 16 * 256 * 256, c.G, c.bid};
            EpiP3 E{{wsp<bf16_t>(c, WS_QM), 384, 384}, {wsp<bf16_t>(c, WS_KM), wsp<bf16_t>(c, WS_KR)}, {wsp<bf16_t>(c, WS_VTM)}, {wsp<bf16_t>(c, WS_E)}};
            pg8::gemm_phase(c.lds, g, S, E, c.tid);
            SEAM(pbase + 2);
        }
        if (SITE(5) && IN(pbase + 3)) {
            FRESH();
            unsigned* qh = ctl + CW_Q + 64 * (l + 4 * (c.dry ? 1 : 0));
            unsigned* dep = ctl + CW_DEP + DEP_SET * (l + 4 * (c.dry ? 1 : 0));
            unsigned* tmo = ctl + CW_BAR + XB_TMO;
            const float* ropeM = wsp<float>(c, WS_ROPEM);
            bool gqa_nomax;
            { float gq_ = fabsf(KIN(I_GQ)[l * 64 + c.lane]), gk_ = fabsf(KIN(I_GK)[l * 64 + c.lane]);
              gq_ = fmaxf(gq_, swz_xor<16>(gq_)); gq_ = fmaxf(gq_, swz_xor<8>(gq_)); gq_ = fmaxf(gq_, swz_xor<4>(gq_)); gq_ = fmaxf(gq_, swz_xor<2>(gq_)); gq_ = fmaxf(gq_, swz_xor<1>(gq_)); gq_ = half_max(gq_);
              gk_ = fmaxf(gk_, swz_xor<16>(gk_)); gk_ = fmaxf(gk_, swz_xor<8>(gk_)); gk_ = fmaxf(gk_, swz_xor<4>(gk_)); gk_ = fmaxf(gk_, swz_xor<2>(gk_)); gk_ = fmaxf(gk_, swz_xor<1>(gk_)); gk_ = half_max(gk_);
              const float bound = 64.f * gq_ * gk_ * 0.125f * LOG2E * 1.01f; gqa_nomax = __builtin_amdgcn_readfirstlane(bound < 50.f ? 1 : 0) != 0; }
#define ATT_CALL(DKV, ...) do { float rowmax_[2] = {0.f, 0.f}; if (attn_unit<DKV, false>(rowmax_, __VA_ARGS__)) { (void)attn_unit<DKV, true>(rowmax_, __VA_ARGS__); } } while (0)
            for (;;) {
                __syncthreads();
                if (c.tid == 0) misc[4] = __hip_atomic_fetch_add(qh, 1u, __ATOMIC_RELAXED, __HIP_MEMORY_SCOPE_AGENT);
                __syncthreads();
                const int it = (int)misc[4];
                if (it >= QI_TOTAL) break;
                FRESH();
                if (c.dry) { const int kd_ = it < QO_SCAN ? 0 : it < QO_ATTL ? 1 : it < QO_SSM2 ? 2 : it < QO_UNT ? 3 : it < QO_ATTC ? 4 : it < QO_GLU ? 5 : 6; if (!((c.dry >> (1 + kd_)) & 1)) continue; }
                if (it < QO_SCAN) { hyena_seq<SEQL>(c, l, it, 0); if (l + 1 < DEPTH) hyena_seq<CTXL>(c, l, it, SEQL); dep_signal(c, dep); }
                else if (it < QO_ATTL) { ssm_scan_item(c, l, it - QO_SCAN); dep_signal(c, dep + 64); }
                else if (it >= QO_ATTC && it < QO_GLU && l + 1 == DEPTH) {   }
                else if (it < QO_SSM2 || (it >= QO_ATTC && it < QO_GLU)) {
                    const bool isctx = it >= QO_ATTC; const int r = isctx ? it - QO_ATTC : (it - QO_ATTL) % (NB * 8), blk = isctx ? 8 : (it - QO_ATTL) / (NB * 8)  ;
                    const int kind = r & 1  , head = (r >> 1) & 3, b = r >> 3;
                    const size_t row0 = (size_t)b * NTOK + (isctx ? SEQL : blk * 512); const int kt0 = isctx ? 64 : 0, nkt = isctx ? 4 : 68, nrows = isctx ? 256 : 512;
                    if (kind == 0) { if (c.dry && PROBE_GQAONLY == 1) continue; ATT_CALL(96, c, wsp<bf16_t>(c, WS_QM) + row0 * 384 + head * 96, 384, wsp<bf16_t>(c, WS_KM) + (size_t)(b * 4 + head) * NTOK * 96, wsp<bf16_t>(c, WS_VTM) + (size_t)(b * 4 + head) * 64 * NTOK,
                                                 kt0, nkt, nrows, wsp<bf16_t>(c, WS_PB) + 2 * BLKE + row0 * 256 + head * 64, wsp<bf16_t>(c, WS_HCAT) + row0 * DM + head * 64, !isctx, blk * 512, 0.10206207261596577f * LOG2E, ropeM); }
                    else if (c.dry && PROBE_GQAONLY == 2) { continue; }
                    else if (c.dry && PROBE_ABL) { float rm_[2] = {0.f, 0.f}; (void)attn_unit<64, false, true, PROBE_ABL>(rm_, c, wsp<bf16_t>(c, WS_PB) + 3 * BLKE + row0 * 256 + head * 64, 256, wsp<bf16_t>(c, WS_KG) + (size_t)(b * 2 + (head >> 1)) * NTOK * 64, wsp<bf16_t>(c, WS_VTG) + (size_t)(b * 2 + (head >> 1)) * 64 * NTOK,
                                       kt0, nkt, nrows, wsp<bf16_t>(c, WS_PB) + 5 * BLKE + row0 * 256 + head * 64, wsp<bf16_t>(c, WS_HCAT) + row0 * DM + 256 + head * 64, false, 0, 1.f, ropeM); }
                    else if (gqa_nomax) { float rm_[2] = {0.f, 0.f}; (void)attn_unit<64, false, true>(rm_, c, wsp<bf16_t>(c, WS_PB) + 3 * BLKE + row0 * 256 + head * 64, 256, wsp<bf16_t>(c, WS_KG) + (size_t)(b * 2 + (head >> 1)) * NTOK * 64, wsp<bf16_t>(c, WS_VTG) + (size_t)(b * 2 + (head >> 1)) * 64 * NTOK,
                                       kt0, nkt, nrows, wsp<bf16_t>(c, WS_PB) + 5 * BLKE + row0 * 256 + head * 64, wsp<bf16_t>(c, WS_HCAT) + row0 * DM + 256 + head * 64, false, 0, 1.f, ropeM); }
                    else { ATT_CALL(64, c, wsp<bf16_t>(c, WS_PB) + 3 * BLKE + row0 * 256 + head * 64, 256, wsp<bf16_t>(c, WS_KG) + (size_t)(b * 2 + (head >> 1)) * NTOK * 64, wsp<bf16_t>(c, WS_VTG) + (size_t)(b * 2 + (head >> 1)) * 64 * NTOK,
                                       kt0, nkt, nrows, wsp<bf16_t>(c, WS_PB) + 5 * BLKE + row0 * 256 + head * 64, wsp<bf16_t>(c, WS_HCAT) + row0 * DM + 256 + head * 64, false, 0, 1.f, ropeM); }
                }
                else if (it < QO_UNT) {
                    const int L = it - QO_SSM2, i = L >> 4, g = L & 15;
                    dep_wait(c, dep + 64, QI_SCAN, tmo);
                    pg8::Gemm gm{wsp<bf16_t>(c, WS_US), wsp<bf16_t>(c, WS_WKC) + (size_t)l * 16 * 256 * 512, 16 * NCHUNK, 16 * 256, 512}; pg8::OneUnit S{g * 17 + i, g};
                    pg8::EpiWalk<PutSsmY> E{{wsp<bf16_t>(c, WS_ZS), wsp<bf16_t>(c, WS_UG), KIN(I_SSMD) + l * 256}}; pg8::gemm_phase(c.lds, gm, S, E, c.tid);
                    dep_signal(c, dep + 64 * (2 + i));
                }
                else if (it < QO_ATTC) {
                    dep_wait(c, dep, QI_HY, tmo);
                    const int j = it - QO_UNT; hyena_untranspose(c, 4 * j, 4 * j + 4);
                }
                else {
                    const int pm = it - QO_GLU;
                    dep_wait(c, dep + 64 * (2 + (pm >> 4)), 16u, tmo);
                    pg8::Gemm gm{wsp<bf16_t>(c, WS_ZS), wsp<bf16_t>(c, WS_WGLU) + (size_t)l * 256 * 256, MROWS, 256, 256}; pg8::OneUnit S{pm, 0};
                    pg8::EpiWalk<PutGlu> E{{wsp<bf16_t>(c, WS_HCAT), wsp<bf16_t>(c, WS_ZS), wsp<bf16_t>(c, WS_PB) + 7 * BLKE, KIN(I_GLUB) + l * 256}}; pg8::gemm_phase(c.lds, gm, S, E, c.tid);
                }
            }
            SEAM(pbase + 3);
        }
        if (SITE(6) && IN(pbase + 4)) {
            FRESH();
            const bool lastl = l + 1 == DEPTH;
            constexpr int OPD = 8;
            const int x = c.bid & 7, nsx = (lastl ? NB * 16 : MROWS / 256) / 8;
            const int n1 = 4 * OPD, n2 = n1 + 8 * (nsx - OPD), ntot = n2 + 4 * OPD;
            unsigned* qh = ctl + CW_Q2 + 64 * ((l + 4 * (c.dry ? 1 : 0)) * 8 + x);
            unsigned* c7 = ctl + CW_C7 + 320 * (l + 4 * (c.dry ? 1 : 0));
            unsigned* tmo = ctl + CW_BAR + XB_TMO;
            unsigned pre = 0u;
            if (c.tid == 0) pre = __hip_atomic_fetch_add(qh, 1u, __ATOMIC_RELAXED, __HIP_MEMORY_SCOPE_AGENT);
            for (;;) {
                __syncthreads();
                if (c.tid == 0) { misc[4] = pre; pre = __hip_atomic_fetch_add(qh, 1u, __ATOMIC_RELAXED, __HIP_MEMORY_SCOPE_AGENT); }
                __syncthreads();
                const int it = (int)misc[4];
                if (it >= ntot) break;
                FRESH();
                int i, k;
                if (it < n1) { i = it >> 2; k = it & 3; } else if (it < n2) { const int j = it - n1; i = OPD + (j >> 3); k = j & 7; if (k >= 4) i -= OPD; } else { const int j = it - n2; i = nsx - OPD + (j >> 2); k = 4 + (j & 3); }
                const int s_ = x + 8 * i, pm = lastl ? (s_ >> 4) * 17 + (s_ & 15) : s_;
                if (k < 4) {
                    pg8::Gemm g{wsp<bf16_t>(c, WS_HCAT), wsp<bf16_t>(c, WS_WOUT) + (size_t)l * DM * DM, MROWS, DM, DM}; pg8::OneUnit S{pm, k};
                    pg8::EpiWalk<PutPlainWT> E{{wsp<bf16_t>(c, WS_OUTB), DM, DM}}; pg8::gemm_phase(c.lds, g, S, E, c.tid);
                    dep_signal_wt(c, c7 + s_);
                } else {
                    dep_wait(c, c7 + s_, 4u, tmo);
                    const int r0 = pm * 256 + (k - 4) * 64; norm_rows(c, l, lastl ? -1 : l + 1, r0, r0 + 64);
                }
            }
            if (!lastl) SEAM(pbase + 4);
        }
    }
#undef IN
#undef SEAM
}

extern "C" void kernel_launch(void* const* d_in, const int* in_sizes, int n_in, void* d_out, int out_size, void* d_ws, size_t ws_size, hipStream_t stream) {
    static int grid = 0;
    if (grid == 0) {
        if (n_in != 36 || out_size != NB * SEQL * DM || ws_size < WS_END) { fprintf(stderr, "kernel_launch: unexpected shapes: n_in %d out %d ws %zu (need %zu)\n", n_in, out_size, ws_size, (size_t)WS_END); grid = -1; return; }
        int dev = 0, cus = 0, per_cu = 0;
        if (hipGetDevice(&dev) != hipSuccess || hipDeviceGetAttribute(&cus, hipDeviceAttributeMultiprocessorCount, dev) != hipSuccess) { grid = -1; return; }
        if (hipFuncSetAttribute((const void*)mk_fwd, hipFuncAttributeMaxDynamicSharedMemorySize, LDS_BYTES) != hipSuccess) { fprintf(stderr, "kernel_launch: hipFuncSetAttribute failed\n"); grid = -1; return; }
        if (hipOccupancyMaxActiveBlocksPerMultiprocessor(&per_cu, (const void*)mk_fwd, 512, LDS_BYTES) != hipSuccess || per_cu < 1) { fprintf(stderr, "kernel_launch: occupancy query says %d blocks per CU\n", per_cu); per_cu = 1; }
        (void)hipGetLastError();
        grid = cus;
    }
    if (grid < 0) return;
    (void)hipMemsetAsync((char*)d_ws + WS_CTL, 0, CTL_BYTES, stream);
    Params p{};
    for (int i = 0; i < 36; ++i) p.in[i] = (const float*)d_in[i];
    p.out = (float*)d_out; p.ws = (unsigned char*)d_ws;
#if MK_ONE_LAUNCH
    p.ph_lo = 0; p.ph_hi = NPHASES;
    hipLaunchKernelGGL(mk_fwd, dim3(grid), dim3(512), LDS_BYTES, stream, p);
#else
    for (int k = 0; k < NPHASES; ++k) { p.ph_lo = k; p.ph_hi = k + 1; const int site = k < NPRO ? k : NPRO + (k - NPRO) % NPH;
        if ((PROBE_DUP_MASK >> site) & 1) { p.dry = 1 | (PROBE_P4KINDS << 1); hipLaunchKernelGGL(mk_fwd, dim3(grid), dim3(512), LDS_BYTES, stream, p); p.dry = 0; }
        hipLaunchKernelGGL(mk_fwd, dim3(grid), dim3(512), LDS_BYTES, stream, p); }
#endif
}
```

```cpp
#include <hip/hip_runtime.h>
#include <cstdio>
#include <cstdint>

#ifndef MK_ONE_LAUNCH
#define MK_ONE_LAUNCH 1
#endif

#define LAS __attribute__((address_space(3)))
#define GAS __attribute__((address_space(1)))
typedef unsigned short bf16_t;
typedef short bf16x8 __attribute__((ext_vector_type(8)));
typedef short bf16x4 __attribute__((ext_vector_type(4)));
typedef float f32x4 __attribute__((ext_vector_type(4)));
typedef float f32x16 __attribute__((ext_vector_type(16)));
typedef unsigned u32x4 __attribute__((ext_vector_type(4)));
typedef unsigned u32x2 __attribute__((ext_vector_type(2)));

constexpr int NB = 16, SEQL = 4096, CTXL = 256, NTOK = SEQL + CTXL  , MROWS = NB * NTOK  ;
constexpr int DM = 1024, DEPTH = 4, INC = 2912, INP = 3072;
constexpr int NCHB = NTOK / 16  , NCHUNK = MROWS / 16  ;
constexpr float EPS = 1e-6f;
constexpr float LOG2E = 1.4426950408889634f;
constexpr int LDS_MISC_OFF = 163840 - 256;

constexpr size_t al256(size_t x) { return (x + 255) & ~(size_t)255; }
constexpr size_t WS_CTL = 0;
constexpr size_t CTL_BYTES = 131072;
constexpr size_t WS_MODV = WS_CTL + CTL_BYTES;
constexpr size_t WS_ROPEG = WS_MODV + al256((size_t)4 * 17 * 3072 * 4);
constexpr size_t WS_ROPEM = WS_ROPEG + 64 * 16 * 2 * 4;
constexpr size_t WS_WIN = WS_ROPEM + 64 * 8 * 2 * 4;
constexpr size_t WS_WOUT = WS_WIN + (size_t)4 * 3072 * 1024 * 2;
constexpr size_t WS_WUQ = WS_WOUT + (size_t)4 * 1024 * 1024 * 2;
constexpr size_t WS_WUK = WS_WUQ + (size_t)4 * 512 * 256 * 2;
constexpr size_t WS_WUV = WS_WUK + (size_t)4 * 256 * 256 * 2;
constexpr size_t WS_WGLU = WS_WUV + (size_t)4 * 256 * 256 * 2;
constexpr size_t WS_WE = WS_WGLU + (size_t)4 * 256 * 256 * 2;
constexpr size_t WS_WKC = WS_WE + (size_t)4 * 16 * 256 * 256 * 2;
constexpr size_t WS_A16 = WS_WKC + (size_t)4 * 16 * 256 * 512 * 2;
constexpr size_t WS_GR = WS_A16 + (size_t)4 * 2 * 16 * 64 * 2 * 4;
constexpr size_t WS_GRC = WS_GR + (size_t)4 * 2 * 256 * 8192 * 2;
constexpr size_t WS_CTXR = WS_GRC + (size_t)4 * 2 * 256 * 512 * 2;
constexpr size_t WS_HCAT = WS_CTXR + (size_t)NB * CTXL * DM * 4;
constexpr size_t BLKE = (size_t)MROWS * 256;
constexpr size_t WS_PB = WS_HCAT + (size_t)MROWS * DM * 2;
constexpr size_t WS_KR = WS_PB + 12 * BLKE * 2;
constexpr size_t WS_KG = WS_KR + (size_t)MROWS * 32 * 2;
constexpr size_t WS_VTG = WS_KG + (size_t)32 * NTOK * 64 * 2;
constexpr size_t WS_UG = WS_VTG + (size_t)32 * NTOK * 64 * 2;
constexpr size_t WS_US = WS_UG + BLKE * 2;
constexpr size_t WS_HYV = WS_US + (size_t)16 * NCHUNK * 512 * 2;
constexpr size_t WS_HYX1 = WS_HYV + BLKE * 2;
constexpr size_t WS_HYX2 = WS_HYX1 + BLKE * 2;
constexpr size_t WS_HYG = WS_HYX2 + BLKE * 2;
constexpr size_t WS_HYZ = WS_HYG + BLKE * 2;
constexpr size_t WS_HYY = WS_HYZ + BLKE * 2;
constexpr size_t WS_END = WS_HYY + BLKE * 2;
static_assert(WS_END <= (size_t)1 << 30, "workspace map exceeds 1 GiB");
constexpr size_t WS_QM = WS_PB + 8 * BLKE * 2;
constexpr size_t WS_KM = WS_QM + (size_t)MROWS * 384 * 2;
constexpr size_t WS_VTM = WS_KM + (size_t)MROWS * 384 * 2;
constexpr size_t WS_E = WS_PB + 4 * BLKE * 2;
constexpr size_t WS_ZS = WS_PB + 6 * BLKE * 2;
constexpr size_t WS_OUTB = WS_PB + 8 * BLKE * 2;
constexpr size_t WS_HT = WS_PB;
static_assert(WS_VTM + BLKE * 2 == WS_PB + 12 * BLKE * 2, "alias map");

constexpr int CW_BAR = 0;
constexpr int CW_Q = 4096;
constexpr int CW_TMO = 4096 + 64 * 8;
constexpr int CW_DEP = 5120;
constexpr int DEP_SET = 20 * 64;
constexpr int CW_Q2 = 16384;
constexpr int CW_C7 = 20480;

__device__ __forceinline__ float bf2f(bf16_t v) { return __uint_as_float(((unsigned)v) << 16); }
__device__ __forceinline__ bf16_t f2bf(float f) { unsigned u = __float_as_uint(f); u += 0x7FFFu + ((u >> 16) & 1u); return (bf16_t)(u >> 16); }
__device__ __forceinline__ unsigned cvt_pk_bf16(float lo, float hi) { unsigned r; asm volatile("v_cvt_pk_bf16_f32 %0, %1, %2" : "=v"(r) : "v"(lo), "v"(hi)); return r; }
__device__ __forceinline__ float lo_bf(unsigned w) { return __uint_as_float(w << 16); }
__device__ __forceinline__ float hi_bf(unsigned w) { return __uint_as_float(w & 0xFFFF0000u); }
__device__ __forceinline__ float sigmf(float x) { float one = 1.f; asm volatile("" : "+v"(one)); return __builtin_amdgcn_rcpf(one + __builtin_amdgcn_exp2f(-1.4426950408889634f * x)); }
__device__ __forceinline__ float siluf(float x) { return x * sigmf(x); }
__device__ __forceinline__ float gelu_tanh(float x) { const float u = 0.7978845608028654f * (x + 0.044715f * x * x * x); return x * sigmf(2.f * u); }
__device__ __forceinline__ int opaque(int x) { asm volatile("" : "+v"(x)); return x; }
__device__ __forceinline__ int lane_id_fresh() { int x; asm volatile("v_mbcnt_lo_u32_b32 %0, -1, 0\n\tv_mbcnt_hi_u32_b32 %0, -1, %0" : "=v"(x)); return x; }
__device__ __forceinline__ float max3_raw(float a, float b, float c) { float r; asm("v_max3_f32 %0, %1, %2, %3" : "=v"(r) : "v"(a), "v"(b), "v"(c)); return r; }
template <int M> __device__ __forceinline__ float swz_xor(float v) { return __int_as_float(__builtin_amdgcn_ds_swizzle(__float_as_int(v), 0x1F | (M << 10))); }
__device__ __forceinline__ float half_sum(float v) { auto r = __builtin_amdgcn_permlane32_swap(__float_as_uint(v), __float_as_uint(v), false, false); return __uint_as_float(r[0]) + __uint_as_float(r[1]); }
__device__ __forceinline__ float half_max(float v) { auto r = __builtin_amdgcn_permlane32_swap(__float_as_uint(v), __float_as_uint(v), false, false); return fmaxf(__uint_as_float(r[0]), __uint_as_float(r[1])); }
__device__ __forceinline__ float half_other(float v, int h) { auto r = __builtin_amdgcn_permlane32_swap(__float_as_uint(v), __float_as_uint(v), false, false); return __uint_as_float(h ? r[0] : r[1]); }
__device__ __forceinline__ float wave_sum(float v) {
    v += swz_xor<16>(v); v += swz_xor<8>(v); v += swz_xor<4>(v); v += swz_xor<2>(v); v += swz_xor<1>(v);
    return half_sum(v);
}

#define XB_TMO      128
#define XB_XCNT(j)  (256  + 64 * (j))
#define XB_XSUB(j)  (1280 + 64 * (j))
#define XB_XGEN(j)  (2304 + 64 * (j))
#define XB_TOP      3328
#define XB_TOPGEN   3392
#define XCD_BAR_WORDS 3456
#define XB_SPIN_CAP (1u << 22)
__device__ __forceinline__ unsigned xb_ld(unsigned* p)              { return __hip_atomic_load(p, __ATOMIC_RELAXED, __HIP_MEMORY_SCOPE_AGENT); }
__device__ __forceinline__ unsigned xb_add(unsigned* p, unsigned v) { return __hip_atomic_fetch_add(p, v, __ATOMIC_RELAXED, __HIP_MEMORY_SCOPE_AGENT); }
__device__ __forceinline__ unsigned xb_xcc_id() { return (unsigned)__builtin_amdgcn_s_getreg((3 << 11) | 20) & 0xFu; }
#define XB_SPIN(cond, bar) do { unsigned _sp = 0; while (cond) { __builtin_amdgcn_s_sleep(1); \
    if ((++_sp & 255u) == 0u) { if (xb_ld(&(bar)[XB_TMO])) break; if (_sp > XB_SPIN_CAP) { atomicAdd(&(bar)[XB_TMO], 1u); break; } } } } while (0)
struct XcdBarrier { unsigned* bar; unsigned x; volatile LAS unsigned* st; };
__device__ __forceinline__ XcdBarrier xcd_barrier_post(unsigned* bar, volatile LAS unsigned* st) {
    XcdBarrier b; b.bar = bar; b.x = xb_xcc_id(); b.st = st;
    if (threadIdx.x == 0) (void)xb_add(&bar[XB_XCNT(b.x)], 1u);
    return b;
}
__device__ __forceinline__ void xcd_barrier_complete(unsigned* bar, unsigned x, unsigned& nloc, unsigned& nx) {
    const unsigned G = gridDim.x * gridDim.y * gridDim.z;
    unsigned sum, cnt, mine, sp = 0u;
    for (;;) {
        sum = 0u; cnt = 0u; mine = 0u;
#pragma unroll
        for (unsigned j = 0; j < 16; ++j) { const unsigned c = xb_ld(&bar[XB_XCNT(j)]); sum += c; cnt += (c > 0u) ? 1u : 0u; }
        mine = xb_ld(&bar[XB_XCNT(x)]);
        if (sum == G) break;
        __builtin_amdgcn_s_sleep(1);
        if ((++sp & 255u) == 0u) { if (xb_ld(&bar[XB_TMO])) break; if (sp > XB_SPIN_CAP) { atomicAdd(&bar[XB_TMO], 1u); break; } }
    }
    nloc = mine > 0u ? mine : 1u; nx = cnt > 0u ? cnt : 1u;
}
__device__ __forceinline__ void xcd_barrier(const XcdBarrier& b) {
    asm volatile("s_waitcnt vmcnt(0)" ::: "memory");
    __syncthreads();
    if (threadIdx.x == 0) {
        unsigned* bar = b.bar;
        __builtin_amdgcn_s_waitcnt(0);
        unsigned nloc = b.st[0], nx = b.st[1];
        if (nloc == 0u) { xcd_barrier_complete(bar, b.x, nloc, nx); b.st[0] = nloc; b.st[1] = nx; }
        const unsigned old = xb_add(&bar[XB_XSUB(b.x)], 1u);
        const unsigned gen = old / nloc;
        if (old + 1u == (gen + 1u) * nloc) {
            __builtin_amdgcn_fence(__ATOMIC_RELEASE, "agent");
            asm volatile("s_waitcnt vmcnt(0)" ::: "memory");
            const unsigned og = xb_add(&bar[XB_TOP], 1u);
            const unsigned tg = og / nx;
            if (og + 1u == (tg + 1u) * nx) xb_add(&bar[XB_TOPGEN], 1u);
            else XB_SPIN(xb_ld(&bar[XB_TOPGEN]) == tg, bar);
            __builtin_amdgcn_fence(__ATOMIC_ACQUIRE, "agent");
            xb_add(&bar[XB_XGEN(b.x)], 1u);
            asm volatile("s_waitcnt vmcnt(0)" ::: "memory");
        } else {
            XB_SPIN(xb_ld(&bar[XB_XGEN(b.x)]) == gen, bar);
            __builtin_amdgcn_fence(__ATOMIC_ACQUIRE, "agent");
            asm volatile("s_waitcnt vmcnt(0)" ::: "memory");
        }
    }
    __syncthreads();
}

namespace pg8 {
constexpr int BM = 256, BK = 64, HALF = 128, HTB = HALF * BK * 2, STAGE_BYTES = 8 * HTB, NXCD = 8, WGM = 8;
__host__ __device__ __forceinline__ int lds_byte(int r, int c) { const int st = (r >> 4) * 2 + (c >> 5), rr = r & 15, cc = c & 31, ob = rr * 64 + cc * 2; return st * 1024 + (ob ^ (((ob >> 9) & 1) << 5)); }
__host__ __device__ __forceinline__ void stage_rc(int b, int& R, int& C) { const int st = b / 1024, sb = b % 1024, swz = sb ^ (((sb >> 9) & 1) << 5); R = (st >> 1) * 16 + swz / 64; C = (st & 1) * 32 + (swz % 64) / 2; }
__host__ __device__ __forceinline__ int perm32(int rho) { const int n = rho >> 4, i = rho & 15; return 8 * (i >> 2) + 4 * n + (i & 3); }
struct Unit { int pm, pn, kd; };
struct Gemm { const bf16_t* A; const bf16_t* Bt; int M, N, K; };
struct StaticOrder {
    int nM, nN, nwg, G, c;
    __host__ __device__ void init(int M, int N, int G_, int c_) { nM = M / BM; nN = N / BM; nwg = nM * nN; G = G_; c = c_; }
    __host__ __device__ bool next(int i, Unit& u) const {
        const long L = (long)i * G + c; if (L >= nwg) return false;
        int wgid = (int)L; { const int q = nwg / NXCD, r = nwg % NXCD, xcd = wgid % NXCD, off = wgid / NXCD; wgid = (xcd < r ? xcd * (q + 1) : r * (q + 1) + (xcd - r) * q) + off; }
        const int nig = WGM * nN, gid = wgid / nig, fm = gid * WGM, gsz = (nM - fm) < WGM ? (nM - fm) : WGM;
        u.pm = fm + ((wgid % nig) % gsz); u.pn = (wgid % nig) / gsz; u.kd = 0; return true;
    }
    __device__ __forceinline__ void a_ready(const Unit&) const {}
    __device__ __forceinline__ void done(const Unit&) const {}
    __device__ __forceinline__ const char* abase(const Gemm& g, const Unit& u, size_t tstep) const { return (const char*)g.A + (size_t)u.pm * tstep; }
    __device__ __forceinline__ const char* bbase(const Gemm& g, const Unit& u, size_t tstep) const { return (const char*)g.Bt + (size_t)u.pn * tstep; }
};
struct LiveRowsOrder : StaticOrder {
    bool skip;
    __host__ __device__ void init2(int N, int G_, int c_, bool skip_) { skip = skip_; init(skip_ ? NB * SEQL : MROWS, N, G_, c_); }
    __host__ __device__ bool next(int i, Unit& u) const { if (!StaticOrder::next(i, u)) return false; if (skip) u.pm = (u.pm >> 4) * 17 + (u.pm & 15); return true; }
};
struct BatchedOrder {
    int nwg, G, c, tpg;
    __host__ __device__ void init(int ng, int tpg_, int G_, int c_) { nwg = ng * tpg_; tpg = tpg_; G = G_; c = c_; }
    __host__ __device__ bool next(int i, Unit& u) const { const int L = i * G + c; if (L >= nwg) return false; u.pm = L; u.pn = L / tpg; u.kd = 0; return true; }
    __device__ __forceinline__ void a_ready(const Unit&) const {}
    __device__ __forceinline__ void done(const Unit&) const {}
    __device__ __forceinline__ const char* abase(const Gemm& g, const Unit& u, size_t tstep) const { return (const char*)g.A + (size_t)u.pm * tstep; }
    __device__ __forceinline__ const char* bbase(const Gemm& g, const Unit& u, size_t tstep) const { return (const char*)g.Bt + (size_t)u.pn * tstep; }
};
struct P3Order {
    const bf16_t *b0, *b1, *wuq, *wuk, *wuv, *ug, *we; int G, c;
    __host__ __device__ bool next(int i, Unit& u) const {
        const int L = i * G + c; if (L >= 1360) return false;
        if (L < 544) { u.kd = 0; u.pm = L >> 1; u.pn = L & 1; } else if (L < 816) { u.kd = 1; u.pm = L - 544; u.pn = 0; } else if (L < 1088) { u.kd = 2; u.pm = 0; u.pn = L - 816; } else { u.kd = 3; u.pm = L - 1088; u.pn = (L - 1088) / 17; }
        return true;
    }
    __device__ __forceinline__ void a_ready(const Unit&) const {}
    __device__ __forceinline__ void done(const Unit&) const {}
    __device__ __forceinline__ const char* abase(const Gemm&, const Unit& u, size_t tstep) const { const bf16_t* p = u.kd == 0 ? b0 : u.kd == 1 ? b1 : u.kd == 2 ? wuv : ug; return (const char*)p + (size_t)u.pm * tstep; }
    __device__ __forceinline__ const char* bbase(const Gemm&, const Unit& u, size_t tstep) const { const bf16_t* p = u.kd == 0 ? wuq : u.kd == 1 ? wuk : u.kd == 2 ? b1 : we; return (const char*)p + (size_t)u.pn * tstep; }
};

struct OneUnit {
    int pm, pn;
    __host__ __device__ bool next(int i, Unit& u) const { if (i) return false; u.pm = pm; u.pn = pn; u.kd = 0; return true; }
    __device__ __forceinline__ void a_ready(const Unit&) const {}
    __device__ __forceinline__ void done(const Unit&) const {}
    __device__ __forceinline__ const char* abase(const Gemm& g, const Unit& u, size_t tstep) const { return (const char*)g.A + (size_t)u.pm * tstep; }
    __device__ __forceinline__ const char* bbase(const Gemm& g, const Unit& u, size_t tstep) const { return (const char*)g.Bt + (size_t)u.pn * tstep; }
};
template <class Epi, class Sched>
__device__ __forceinline__ void gemm_phase(LAS unsigned char* lds, const Gemm g, const Sched& S, const Epi& E, int tid_in) {
    const int tid = tid_in, wid = __builtin_amdgcn_readfirstlane(tid >> 6), lane = tid & 63, wr = wid >> 2, wc = wid & 3, fr = lane & 15, fq = lane >> 4;
    const int K = g.K, nt = K / BK;
    unsigned voffA[2], voffB[2];
#pragma unroll
    for (int i = 0; i < 2; ++i) { int R, C; stage_rc(tid * 16 + i * 8192, R, C); const int Rb = Epi::PERM ? ((R & ~31) + perm32(R & 31)) : R;
        voffA[i] = (unsigned)(R * K + C) * 2u; voffB[i] = (unsigned)(Rb * K + C) * 2u; }
    const size_t kstep = (size_t)(BK * 2);
    const size_t hstep = (size_t)HALF * K * 2;
    const size_t tstep = 2 * hstep;
    const unsigned ldsw = (unsigned)wid * 1024u;
    const int aoff = lds_byte(wr * 64 + fr, fq * 8), boff = lds_byte(wc * 32 + fr, fq * 8);
#define PG8_SA(b, h) (((b) * 2 + (h)) * HTB)
#define PG8_SB(b, h) ((4 + (b) * 2 + (h)) * HTB)
#define PG8_STAGE(bufoff, gbase, voff) do { _Pragma("unroll") for (int _i = 0; _i < 2; ++_i) \
        __builtin_amdgcn_global_load_lds((const unsigned*)((const char*)(gbase) + (voff)[_i]), (LAS unsigned*)(lds + (bufoff) + ldsw + _i * 8192), 16, 0, 0); } while (0)
#define PG8_LDA(dst, b, h) do { _Pragma("unroll") for (int m = 0; m < 4; ++m) _Pragma("unroll") for (int k = 0; k < 2; ++k) dst[m][k] = *(const LAS bf16x8*)(lds + PG8_SA(b, h) + aoff + m * 2048 + k * 1024); } while (0)
#define PG8_LDB(dst, b, h) do { _Pragma("unroll") for (int n = 0; n < 2; ++n) _Pragma("unroll") for (int k = 0; k < 2; ++k) dst[n][k] = *(const LAS bf16x8*)(lds + PG8_SB(b, h) + boff + n * 2048 + k * 1024); } while (0)
#define PG8_MMA(ai, bj, At, Bt) do { __builtin_amdgcn_s_setprio(1); _Pragma("unroll") for (int m = 0; m < 4; ++m) _Pragma("unroll") for (int n = 0; n < 2; ++n) _Pragma("unroll") for (int k = 0; k < 2; ++k) \
        acc[ai][bj][m][n] = __builtin_amdgcn_mfma_f32_16x16x32_bf16(Bt[n][k], At[m][k], acc[ai][bj][m][n], 0, 0, 0); __builtin_amdgcn_s_setprio(0); } while (0)
#define PG8_WAIT_V(n) asm volatile("s_waitcnt vmcnt(" #n ")" ::: "memory")
#define PG8_WAIT_L(n) asm volatile("s_waitcnt lgkmcnt(" #n ")" ::: "memory")
#define PG8_BAR __builtin_amdgcn_s_barrier()
#define PG8_SCHED __builtin_amdgcn_sched_barrier(0)
    Unit cur, nxt; int ui = 0;
    if (!S.next(0, cur)) return;
    f32x4 acc[2][2][4][2];
#pragma unroll
    for (int a = 0; a < 2; ++a)
#pragma unroll
        for (int b = 0; b < 2; ++b)
#pragma unroll
            for (int m = 0; m < 4; ++m)
#pragma unroll
                for (int n = 0; n < 2; ++n) acc[a][b][m][n] = (f32x4){0.f, 0.f, 0.f, 0.f};
    bf16x8 At[4][2], B0[2][2], B1[2][2];
    const char* cA = S.abase(g, cur, tstep); const char* cB = S.bbase(g, cur, tstep);
    S.a_ready(cur);
    PG8_STAGE(PG8_SB(0, 0), cB, voffB); PG8_STAGE(PG8_SA(0, 0), cA, voffA); PG8_STAGE(PG8_SB(0, 1), cB + hstep, voffB); PG8_STAGE(PG8_SA(0, 1), cA + hstep, voffA);
    if (wr == 1) PG8_BAR;
    PG8_WAIT_V(4); PG8_BAR;
    PG8_STAGE(PG8_SB(1, 0), cB + kstep, voffB); PG8_STAGE(PG8_SA(1, 0), cA + kstep, voffA); PG8_STAGE(PG8_SB(1, 1), cB + hstep + kstep, voffB);
    PG8_WAIT_V(6); PG8_BAR;
    for (;;) {
        const bool has_next = S.next(ui + 1, nxt);
        const char* nA = has_next ? S.abase(g, nxt, tstep) : cA; const char* nB = has_next ? S.bbase(g, nxt, tstep) : cB;
        for (int t = 0; t < nt; t += 2) {
            const bool last = (t == nt - 2);
            const char* a1 = cA + (size_t)(t + 1) * kstep;
            const char* a2 = last ? nA : cA + (size_t)(t + 2) * kstep; const char* b2 = last ? nB : cB + (size_t)(t + 2) * kstep;
            const char* a3 = a2 + kstep; const char* b3 = b2 + kstep;
            if (last && has_next) S.a_ready(nxt);
            PG8_LDB(B0, 0, 0); PG8_SCHED; PG8_LDA(At, 0, 0); PG8_STAGE(PG8_SA(1, 1), a1 + hstep, voffA);
            PG8_WAIT_L(8); PG8_BAR; PG8_WAIT_L(0); PG8_MMA(0, 0, At, B0); PG8_BAR; PG8_SCHED;
            PG8_LDB(B1, 0, 1); PG8_STAGE(PG8_SB(0, 0), b2, voffB);
            PG8_BAR; PG8_WAIT_L(0); PG8_MMA(0, 1, At, B1); PG8_BAR;
            PG8_LDA(At, 0, 1); PG8_STAGE(PG8_SA(0, 0), a2, voffA);
            PG8_BAR; PG8_WAIT_L(0); PG8_MMA(1, 0, At, B0); PG8_BAR; PG8_SCHED;
            PG8_STAGE(PG8_SB(0, 1), b2 + hstep, voffB);
            PG8_WAIT_V(6); PG8_BAR; PG8_MMA(1, 1, At, B1); PG8_BAR;
            PG8_LDB(B0, 1, 0); PG8_SCHED; PG8_LDA(At, 1, 0); PG8_STAGE(PG8_SA(0, 1), a2 + hstep, voffA);
            PG8_WAIT_L(8); PG8_BAR; PG8_WAIT_L(0); PG8_MMA(0, 0, At, B0); PG8_BAR; PG8_SCHED;
            PG8_LDB(B1, 1, 1); PG8_STAGE(PG8_SB(1, 0), b3, voffB);
            PG8_BAR; PG8_WAIT_L(0); PG8_MMA(0, 1, At, B1); PG8_BAR;
            PG8_LDA(At, 1, 1); PG8_STAGE(PG8_SA(1, 0), a3, voffA);
            PG8_BAR; PG8_WAIT_L(0); PG8_MMA(1, 0, At, B0); PG8_BAR; PG8_SCHED;
            PG8_STAGE(PG8_SB(1, 1), b3 + hstep, voffB);
            PG8_WAIT_V(6); PG8_BAR; PG8_MMA(1, 1, At, B1); PG8_BAR;
        }
        { const int l2 = lane_id_fresh(); E(acc, cur, wr, wc, l2 & 15, l2 >> 4); } S.done(cur);
        if (!has_next) break;
#pragma unroll
        for (int a = 0; a < 2; ++a)
#pragma unroll
            for (int b = 0; b < 2; ++b)
#pragma unroll
                for (int m = 0; m < 4; ++m)
#pragma unroll
                    for (int n = 0; n < 2; ++n) acc[a][b][m][n] = (f32x4){0.f, 0.f, 0.f, 0.f};
        cur = nxt; cA = nA; cB = nB; ++ui;
    }
    PG8_WAIT_V(0);
    if (wr == 0) PG8_BAR;
    PG8_BAR;
#undef PG8_SA
#undef PG8_SB
#undef PG8_STAGE
#undef PG8_LDA
#undef PG8_LDB
#undef PG8_MMA
#undef PG8_WAIT_V
#undef PG8_WAIT_L
#undef PG8_BAR
#undef PG8_SCHED
}

template <class F> struct EpiWalk {
    static constexpr bool PERM = true, AFTER_DRAIN = false;
    F f;
    __device__ __forceinline__ void operator()(const f32x4 (&acc)[2][2][4][2], const Unit& u, int wr, int wc, int fr, int fq) const {
#pragma unroll
        for (int ai = 0; ai < 2; ++ai)
#pragma unroll
            for (int m = 0; m < 4; ++m) {
                const int rin = ai * HALF + wr * 64 + m * 16 + fr;
#pragma unroll
                for (int bj = 0; bj < 2; ++bj) { const int cin = bj * HALF + wc * 32 + 8 * fq; f.put(u.pm, u.pn, rin, cin, acc[ai][bj][m][0], acc[ai][bj][m][1]); asm volatile("" ::: "memory"); }
            }
    }
};
}

__device__ __forceinline__ u32x4 pack8(const f32x4& a, const f32x4& b) {
    u32x4 w; w.x = cvt_pk_bf16(a[0], a[1]); w.y = cvt_pk_bf16(a[2], a[3]); w.z = cvt_pk_bf16(b[0], b[1]); w.w = cvt_pk_bf16(b[2], b[3]); return w;
}
__device__ __forceinline__ void unpack8(const u32x4 w, float (&o)[8]) {
    o[0] = lo_bf(w.x); o[1] = hi_bf(w.x); o[2] = lo_bf(w.y); o[3] = hi_bf(w.y); o[4] = lo_bf(w.z); o[5] = hi_bf(w.z); o[6] = lo_bf(w.w); o[7] = hi_bf(w.w);
}

struct PutPlain {
    bf16_t* dst; int ldc, ncols;
    __device__ __forceinline__ void put(int pm, int pn, int rin, int cin, const f32x4& a, const f32x4& b) const { const int col = pn * 256 + cin; if (col < ncols) *(u32x4*)(dst + ((size_t)pm * 256 + rin) * ldc + col) = pack8(a, b); }
};
struct PutPlainWT {
    bf16_t* dst; int ldc, ncols;
    __device__ __forceinline__ void put(int pm, int pn, int rin, int cin, const f32x4& a, const f32x4& b) const {
        const int col = pn * 256 + cin; const u32x4 w = pack8(a, b); GAS bf16_t* p = (GAS bf16_t*)(dst + ((size_t)pm * 256 + rin) * ldc + col);
        asm volatile("global_store_dwordx4 %0, %1, off sc1" :: "v"(p), "v"(w) : "memory"); }
};
struct PutKm {
    bf16_t* km; const bf16_t* kr;
    __device__ __forceinline__ void put(int pm, int pn, int rin, int cin, const f32x4& a, const f32x4& b) const {
        const int bb = pm / 17, key = (pm - bb * 17) * 256 + rin, hd = cin >> 6, d = cin & 63;
        bf16_t* dst = km + ((size_t)(bb * 4 + hd) * NTOK + key) * 96;
        *(u32x4*)(dst + d) = pack8(a, b);
        if (d < 32) *(u32x4*)(dst + 64 + d) = *(const u32x4*)(kr + ((size_t)pm * 256 + rin) * 32 + d);
    }
};
struct PutVt {
    bf16_t* vt;
    __device__ __forceinline__ void put(int pm, int pn, int rin, int cin, const f32x4& a, const f32x4& b) const {
        const int bb = pn / 17, key = (pn - bb * 17) * 256 + cin;
        *(u32x4*)(vt + ((size_t)(bb * 4 + (rin >> 6)) * 64 + (rin & 63)) * NTOK + key) = pack8(a, b);
    }
};
struct PutE {
    bf16_t* e;
    __device__ __forceinline__ void put(int pm, int pn, int rin, int cin, const f32x4& a, const f32x4& b) const { *(u32x4*)(e + ((size_t)pm * 256 + rin) * 256 + cin) = pack8(a, b); }
};
struct PutSsmY {
    bf16_t* zs; const bf16_t* ug; const float* dskip;
    __device__ __forceinline__ void put(int pm, int pn, int rin, int cin, const f32x4& a, const f32x4& b) const {
        const int g = pn, n = (pm - g * 17) * 256 + rin, tok = n * 16 + (cin >> 4), ho = cin & 15, ch = g * 16 + ho;
        float u[8]; unpack8(*(const u32x4*)(ug + ((size_t)g * MROWS + tok) * 16 + ho), u);
        const f32x4 d0 = *(const f32x4*)(dskip + ch), d1 = *(const f32x4*)(dskip + ch + 4);
        f32x4 y0, y1;
#pragma unroll
        for (int i = 0; i < 4; ++i) { y0[i] = gelu_tanh(a[i] + d0[i] * u[i]); y1[i] = gelu_tanh(b[i] + d1[i] * u[4 + i]); }
        *(u32x4*)(zs + (size_t)tok * 256 + ch) = pack8(y0, y1);
    }
};
struct PutGlu {
    bf16_t* cat; const bf16_t* zs; const bf16_t* gate; const float* gb;
    __device__ __forceinline__ void put(int pm, int pn, int rin, int cin, const f32x4& a, const f32x4& b) const {
        const size_t row = (size_t)pm * 256 + rin; const int col = cin;
        float z[8], gt[8]; unpack8(*(const u32x4*)(zs + row * 256 + col), z); unpack8(*(const u32x4*)(gate + row * 256 + col), gt);
        const f32x4 b0 = *(const f32x4*)(gb + col), b1 = *(const f32x4*)(gb + col + 4);
        f32x4 y0, y1;
#pragma unroll
        for (int i = 0; i < 4; ++i) { y0[i] = z[i] * sigmf(a[i] + b0[i]) * siluf(gt[i]); y1[i] = z[4 + i] * sigmf(b[i] + b1[i]) * siluf(gt[4 + i]); }
        *(u32x4*)(cat + row * DM + 512 + col) = pack8(y0, y1);
    }
};

struct EpiInProj {
    static constexpr bool PERM = true, AFTER_DRAIN = false;
    bf16_t *pb, *ug, *us, *vtg, *hy0;
    LAS unsigned char* scratch;
    __device__ __forceinline__ void operator()(const f32x4 (&acc)[2][2][4][2], const pg8::Unit& u, int wr, int wc, int fr, int fq) const {
        const int pn = u.pn, pm = u.pm;
        const int bb = pm / 17, jt = (pm - bb * 17) * 256;
        LAS unsigned char* sw = scratch + (wr * 4 + wc) * 1280;
        const int ln = fq * 16 + fr, tch = ln >> 1, thalf = ln & 1;
#pragma unroll
        for (int ai = 0; ai < 2; ++ai)
#pragma unroll
            for (int m = 0; m < 4; ++m) {
                const int rin = ai * pg8::HALF + wr * 64 + m * 16 + fr;
#pragma unroll
                for (int bj = 0; bj < 2; ++bj) {
                    const int cin = bj * pg8::HALF + wc * 32 + 8 * fq;
                    const u32x4 w = pack8(acc[ai][bj][m][0], acc[ai][bj][m][1]);
                    const bool plain = pn < 4 || pn == 5 || pn == 7 || (pn == 4 && bj == 0);
                    if (plain) { *(u32x4*)(pb + (size_t)pn * BLKE + ((size_t)pm * 256 + rin) * 256 + cin) = w; }
                    else if (pn == 6) { const size_t row = (size_t)pm * 256 + rin; const int g = cin >> 4, hi0 = cin & 15;
                        *(u32x4*)(ug + ((size_t)g * MROWS + row) * 16 + hi0) = w;
                        *(u32x4*)(us + ((size_t)g * NCHUNK + (row >> 4)) * 512 + (row & 15) * 16 + hi0) = w; }
                    else {
                        *(LAS u32x4*)(sw + fr * 80 + fq * 16) = w;
                        asm volatile("" ::: "memory");
                        unsigned short e[8];
#pragma unroll
                        for (int i = 0; i < 8; ++i) e[i] = *(const LAS unsigned short*)(sw + (thalf * 8 + i) * 80 + tch * 2);
                        asm volatile("" ::: "memory");
                        u32x4 t; t.x = e[0] | ((unsigned)e[1] << 16); t.y = e[2] | ((unsigned)e[3] << 16); t.z = e[4] | ((unsigned)e[5] << 16); t.w = e[6] | ((unsigned)e[7] << 16);
                        const int chn = bj * pg8::HALF + wc * 32 + tch;
                        const int tok = jt + ai * pg8::HALF + wr * 64 + m * 16 + thalf * 8;
                        bf16_t* dst = (pn == 4) ? vtg + ((size_t)(bb * 2 + ((chn - 128) >> 6)) * 64 + ((chn - 128) & 63)) * NTOK + tok
                                                : hy0 + (size_t)(pn - 8) * BLKE + ((size_t)chn * 16 + bb) * NTOK + tok;
                        *(u32x4*)dst = t;
                    }
                    asm volatile("" ::: "memory");
                }
            }
    }
};

struct EpiP3 {
    static constexpr bool PERM = true, AFTER_DRAIN = false;
    PutPlain q; PutKm k; PutVt v; PutE e;
    __device__ __forceinline__ void operator()(const f32x4 (&acc)[2][2][4][2], const pg8::Unit& u, int wr, int wc, int fr, int fq) const {
#pragma unroll
        for (int ai = 0; ai < 2; ++ai)
#pragma unroll
            for (int m = 0; m < 4; ++m) {
                const int rin = ai * pg8::HALF + wr * 64 + m * 16 + fr;
#pragma unroll
                for (int bj = 0; bj < 2; ++bj) { const int cin = bj * pg8::HALF + wc * 32 + 8 * fq;
                    if (u.kd == 0) q.put(u.pm, u.pn, rin, cin, acc[ai][bj][m][0], acc[ai][bj][m][1]);
                    else if (u.kd == 1) k.put(u.pm, u.pn, rin, cin, acc[ai][bj][m][0], acc[ai][bj][m][1]);
                    else if (u.kd == 2) v.put(u.pm, u.pn, rin, cin, acc[ai][bj][m][0], acc[ai][bj][m][1]);
                    else e.put(u.pm, u.pn, rin, cin, acc[ai][bj][m][0], acc[ai][bj][m][1]);
                    asm volatile("" ::: "memory"); }
            }
    }
};

struct Params {
    const float* in[36];
    float* out;
    unsigned char* ws;
    int ph_lo, ph_hi, dry, pad;
};
enum { I_X = 0, I_C, I_CTX, I_CCTX, I_WMOD, I_BMOD, I_GPRE, I_GPOST, I_WIN, I_WOUT, I_GCQ, I_WUQ, I_GCKV, I_WUKV, I_GQ, I_GK,
       I_LRE, I_LIM, I_LSTEP, I_BRE, I_BIM, I_CRE, I_CIM, I_SSMD, I_GLUW, I_GLUB, I_HCW, I_HCB, I_HW1, I_HB1, I_HF1, I_HW2, I_HB2, I_HF2, I_HW3, I_HBIAS };

typedef __attribute__((address_space(4))) const unsigned long long* kargp_t;
struct Ctx {
    LAS unsigned char* lds;
    kargp_t ka;
    unsigned char* ws;
    int tid, lane, wave, G, bid, dry;
};
#define KIN(i) ((const float*)(GAS const float*)c.ka[(i)])
#define KOUT() ((float*)(GAS float*)c.ka[36])
template <class T> __device__ __forceinline__ T* wsp(const Ctx& c, size_t off) { return (T*)(c.ws + off); }

__device__ __forceinline__ int wmap(int kind, int n) {
    if (kind == 0) { if (n < 192) return n; if (n < 224) return 320 + (n - 192); if (n < 256) return -1; if (n < 384) return 192 + (n - 256); if (n < 512) return -1; return n - 160; }
    if (kind == 2) return (n >> 6) * 128 + (n & 63);
    if (kind == 3) return (n >> 6) * 128 + 64 + (n & 63);
    return n;
}
__device__ __forceinline__ void wconv_tile(const Ctx& c, const float* src, int Ks, int Ns, int Nlim, bf16_t* dst, int Kp, int kind, int nt, int kt) {
    LAS float* T = (LAS float*)c.lds;
    const int n0 = nt * 64, k0 = kt * 128;
    const int nn = c.tid & 63, kk0 = c.tid >> 6; const int n = n0 + nn; const int sc = (n < Nlim) ? wmap(kind, n) : -1;
    float v[16];
#pragma unroll
    for (int i = 0; i < 16; ++i) { const int k = k0 + kk0 + 8 * i; v[i] = (k < Ks && sc >= 0) ? src[(size_t)k * Ns + sc] : 0.f; }
#pragma unroll
    for (int i = 0; i < 16; ++i) T[(kk0 + 8 * i) * 65 + nn] = v[i];
    __syncthreads();
#pragma unroll
    for (int i = 0; i < 2; ++i) { const int e = c.tid + i * 512, row = e >> 4, pc = e & 15; float x[8];
#pragma unroll
        for (int j = 0; j < 8; ++j) x[j] = T[(pc * 8 + j) * 65 + row];
        u32x4 w; w.x = cvt_pk_bf16(x[0], x[1]); w.y = cvt_pk_bf16(x[2], x[3]); w.z = cvt_pk_bf16(x[4], x[5]); w.w = cvt_pk_bf16(x[6], x[7]);
        *(u32x4*)(dst + (size_t)(n0 + row) * Kp + k0 + pc * 8) = w; }
    __syncthreads();
}

__device__ __forceinline__ void modv_job(const Ctx& c, int job) {
    const int l = job / 48, j0 = (job % 48) * 64;
    LAS float* sc = (LAS float*)c.lds;
    LAS float* red = sc + 17 * 1024;
    const float* cv = KIN(I_C); const float* cc = KIN(I_CCTX);
    for (int e = c.tid; e < 17 * 1024; e += 512) { const int r = e >> 10, k = e & 1023; const float v = (r < 16) ? cv[r * 1024 + k] : cc[k]; sc[e] = siluf(v); }
    __syncthreads();
    const int col = c.tid & 63, ks = c.tid >> 6;
    const float* w = KIN(I_WMOD) + (size_t)l * 1024 * 3072 + j0 + col;
    float acc[17];
#pragma unroll
    for (int r = 0; r < 17; ++r) acc[r] = 0.f;
    for (int k = ks * 128; k < ks * 128 + 128; ++k) { const float wv = w[(size_t)k * 3072];
#pragma unroll
        for (int r = 0; r < 17; ++r) acc[r] += sc[r * 1024 + k] * wv; }
#pragma unroll
    for (int r = 0; r < 17; ++r) red[(ks * 17 + r) * 64 + col] = acc[r];
    __syncthreads();
    float* mv = wsp<float>(c, WS_MODV);
    for (int e = c.tid; e < 17 * 64; e += 512) { const int r = e >> 6, cl = e & 63; float s = KIN(I_BMOD)[l * 3072 + j0 + cl];
#pragma unroll
        for (int q = 0; q < 8; ++q) s += red[(q * 17 + r) * 64 + cl];
        mv[((size_t)l * 17 + r) * 3072 + j0 + cl] = s; }
    __syncthreads();
}

__device__ __forceinline__ void rope_job(const Ctx& c) {
    float* rg = wsp<float>(c, WS_ROPEG); float* rm = wsp<float>(c, WS_ROPEM);
    for (int e = c.tid; e < 64 * 16; e += 512) { const int pos = e >> 4, f = e & 15; const float inv = powf(10000.f, -(float)(2 * f) / 32.f); const float a = (float)pos * inv; rg[e * 2] = cosf(a); rg[e * 2 + 1] = sinf(a); }
    for (int e = c.tid; e < 64 * 8; e += 512) { const int pos = e >> 3, f = e & 7; const float inv = powf(10000.f, -(float)(2 * f) / 16.f); const float a = (float)pos * inv; rm[e * 2] = cosf(a); rm[e * 2 + 1] = sinf(a); }
}

typedef float cpx __attribute__((ext_vector_type(2)));
#define CPX(a, b) ((cpx){(a), (b)})
__device__ __forceinline__ cpx cmul(cpx a, cpx b) { return CPX(a.x * b.x - a.y * b.y, a.x * b.y + a.y * b.x); }
__device__ __forceinline__ void ssm_tables_job(const Ctx& c, int job) {
    const int l = job >> 4, g = job & 15;
    LAS cpx* apow = (LAS cpx*)c.lds;
    LAS cpx* bbar = apow + 2 * 17 * 64;
    LAS cpx* cm = bbar + 2 * 64 * 16;
    LAS float* Kc = (LAS float*)(cm + 2 * 16 * 64);
    for (int e = c.tid; e < 2 * 64; e += 512) {
        const int d = e >> 6, p = e & 63; const size_t ix = (((size_t)l * 2 + d) * 16 + g) * 64 + p;
        const float lr = KIN(I_LRE)[ix], li = KIN(I_LIM)[ix], st = expf(KIN(I_LSTEP)[((size_t)l * 2 + d) * 16 + g]);
        for (int k = 0; k <= 16; ++k) { const float m = expf(lr * st * (float)k), an = li * st * (float)k; apow[(d * 17 + k) * 64 + p] = CPX(m * cosf(an), m * sinf(an)); }
    }
    __syncthreads();
    for (int e = c.tid; e < 2 * 64 * 16; e += 512) {
        const int d = e >> 10, p = (e >> 4) & 63, h = e & 15; const size_t ix = (((size_t)l * 2 + d) * 16 + g) * 64 + p;
        const float lr = KIN(I_LRE)[ix], li = KIN(I_LIM)[ix];
        const cpx a = apow[(d * 17 + 1) * 64 + p]; const cpx am1 = CPX(a.x - 1.f, a.y);
        const float den = lr * lr + li * li; const cpx q = CPX((am1.x * lr + am1.y * li) / den, (am1.y * lr - am1.x * li) / den);
        const cpx b = CPX(KIN(I_BRE)[ix * 16 + h], KIN(I_BIM)[ix * 16 + h]);
        bbar[e] = cmul(q, b);
        const size_t cx = ((((size_t)l * 2 + d) * 16 + g) * 16 + h) * 64 + p;
        cm[(d * 16 + h) * 64 + p] = CPX(KIN(I_CRE)[cx], KIN(I_CIM)[cx]);
    }
    __syncthreads();
    for (int e = c.tid; e < 2 * 16 * 256; e += 512) {
        const int d = e >> 12, dd = (e >> 8) & 15, ho = (e >> 4) & 15, hi = e & 15; float s = 0.f;
        for (int p = 0; p < 64; ++p) { const cpx w = cmul(cm[(d * 16 + ho) * 64 + p], apow[(d * 17 + dd) * 64 + p]); const cpx b = bbar[(d * 64 + p) * 16 + hi]; s += w.x * b.x - w.y * b.y; }
        Kc[e] = s;
    }
    __syncthreads();
    bf16_t* wkc = wsp<bf16_t>(c, WS_WKC) + ((size_t)l * 16 + g) * 256 * 512;
    for (int e = c.tid; e < 256 * 512; e += 512) {
        const int r = e >> 9, q = e & 511, i = r >> 4, ho = r & 15; float v;
        if (q < 256) { const int j = q >> 4, hi = q & 15; v = 0.f; if (j <= i) v += Kc[((0 * 16 + (i - j)) * 16 + ho) * 16 + hi]; if (j >= i) v += Kc[((1 * 16 + (j - i)) * 16 + ho) * 16 + hi]; }
        else { const int qq = q - 256, dq = qq >> 7, comp = (qq >> 6) & 1, p = qq & 63, k = dq == 0 ? i + 1 : 16 - i; const cpx w = cmul(cm[(dq * 16 + ho) * 64 + p], apow[(dq * 17 + k) * 64 + p]); v = comp == 0 ? w.x : -w.y; }
        wkc[e] = f2bf(v);
    }
    bf16_t* we = wsp<bf16_t>(c, WS_WE) + ((size_t)l * 16 + g) * 256 * 256;
    for (int e = c.tid; e < 256 * 256; e += 512) {
        const int qq = e >> 8, cidx = e & 255, j = cidx >> 4, hi = cidx & 15, dq = qq >> 7, comp = (qq >> 6) & 1, p = qq & 63, k = dq == 0 ? 15 - j : j;
        const cpx w = cmul(apow[(dq * 17 + k) * 64 + p], bbar[(dq * 64 + p) * 16 + hi]);
        we[e] = f2bf(comp == 0 ? w.x : w.y);
    }
    float* a16 = wsp<float>(c, WS_A16);
    for (int e = c.tid; e < 128; e += 512) { const int d = e >> 6, p = e & 63; const cpx a = apow[(d * 17 + 16) * 64 + p]; const size_t ix = ((((size_t)l * 2 + d) * 16 + g) * 64 + p) * 2; a16[ix] = a.x; a16[ix + 1] = a.y; }
    __syncthreads();
}

__device__ __forceinline__ void hyena_mlp_job(const Ctx& c, int job) {
    const int l = job / 136, tt = job % 136;
    const bool isctx = tt >= 128; const int n = isctx ? CTXL : SEQL; const int t0 = isctx ? (tt - 128) * 32 : tt * 32;
    LAS float* z = (LAS float*)c.lds;
    LAS float* h1 = z + 32 * 36;
    LAS float* h2 = h1 + 32 * 64;
    for (int e = c.tid; e < 32 * 33; e += 512) {
        const int ti = e / 33, f = e % 33, t = t0 + ti; float v;
        if (f == 0) v = (float)t / (float)(n - 1);
        else { const int k = (f - 1) & 15; const float band = 1e-4f + (float)k * ((15.f - 1e-4f) / 15.f); const float om = 6.283185307179586f * (float)t / (float)n; v = (f <= 16) ? cosf(band * om) : -sinf(band * om); }
        z[ti * 36 + f] = v;
    }
    __syncthreads();
    for (int e = c.tid; e < 32 * 64; e += 512) {
        const int ti = e >> 6, j = e & 63; float s = KIN(I_HB1)[l * 64 + j];
        for (int f = 0; f < 33; ++f) s += z[ti * 36 + f] * KIN(I_HW1)[((size_t)l * 33 + f) * 64 + j];
        h1[e] = sinf(KIN(I_HF1)[l * 64 + j] * s);
    }
    __syncthreads();
    for (int e = c.tid; e < 32 * 64; e += 512) {
        const int ti = e >> 6, j = e & 63; float s = KIN(I_HB2)[l * 64 + j];
        for (int f = 0; f < 64; ++f) s += h1[ti * 64 + f] * KIN(I_HW2)[((size_t)l * 64 + f) * 64 + j];
        h2[e] = sinf(KIN(I_HF2)[l * 64 + j] * s);
    }
    __syncthreads();
    float* hT = wsp<float>(c, WS_HT) + (size_t)l * 1024 * NTOK;
    const float mind = -3.070113457325394f, maxd = -15.35056728662697f;
#pragma unroll
    for (int cc = 0; cc < 2; ++cc) {
        const int col = c.tid + cc * 512;
        float acc[32];
#pragma unroll
        for (int ti = 0; ti < 32; ++ti) acc[ti] = 0.f;
        for (int f = 0; f < 64; ++f) { const float w = KIN(I_HW3)[((size_t)l * 64 + f) * 1024 + col];
#pragma unroll
            for (int ti = 0; ti < 32; ++ti) acc[ti] += h2[ti * 64 + f] * w; }
        const int ch = col & 255; const float delta = fabsf(mind + (maxd - mind) * (float)ch / 255.f);
        float* dst = hT + (size_t)col * NTOK + (isctx ? SEQL : 0) + t0;
#pragma unroll
        for (int ti = 0; ti < 32; ++ti) { const float tn = (float)(t0 + ti) / (float)(n - 1); dst[ti] = acc[ti] * expf(-tn * delta); }
    }
    __syncthreads();
}

__device__ __forceinline__ void hyena_pack_job(const Ctx& c, int job) {
    const int l = job >> 9, o = (job >> 8) & 1, ch = job & 255;
    const float* hT = wsp<float>(c, WS_HT) + (size_t)l * 1024 * NTOK;
    const float* fw = hT + (size_t)(o * 512 + ch) * NTOK; const float* bw = hT + (size_t)(o * 512 + 256 + ch) * NTOK;
    LAS float* red = (LAS float*)c.lds;
    float fa[8], ba[8];
#pragma unroll
    for (int k = 0; k < 8; ++k) { fa[k] = fw[c.tid + 512 * k]; ba[k] = bw[c.tid + 512 * k]; }
    const float fc = (c.tid < CTXL) ? fw[SEQL + c.tid] : 0.f, bc = (c.tid < CTXL) ? bw[SEQL + c.tid] : 0.f;
    float s0 = 0.f, s1 = fc * fc + bc * bc;
#pragma unroll
    for (int k = 0; k < 8; ++k) s0 += fa[k] * fa[k] + ba[k] * ba[k];
    s0 = wave_sum(s0); s1 = wave_sum(s1);
    if (c.lane == 0) { red[c.wave] = s0; red[8 + c.wave] = s1; }
    __syncthreads();
    float t0 = 0.f, t1 = 0.f;
#pragma unroll
    for (int w = 0; w < 8; ++w) { t0 += red[w]; t1 += red[8 + w]; }
    const float r0 = rsqrtf(t0 + EPS), r1 = rsqrtf(t1 + EPS);
    bf16_t* gr = wsp<bf16_t>(c, WS_GR) + (((size_t)l * 2 + o) * 256 + ch) * 8192;
#pragma unroll
    for (int k = 0; k < 8; ++k) { const int d = c.tid + 512 * k; gr[4095 - d] = f2bf(fa[k] * r0); if (d >= 1) gr[4095 + d] = f2bf(ba[k] * r0); }
    if (c.tid == 0) gr[8191] = 0;
    bf16_t* grc = wsp<bf16_t>(c, WS_GRC) + (((size_t)l * 2 + o) * 256 + ch) * 512;
    if (c.tid < CTXL) { const int d = c.tid; grc[255 - d] = f2bf(fc * r1); if (d >= 1) grc[255 + d] = f2bf(bc * r1); }
    if (c.tid == 0) grc[511] = 0;
    __syncthreads();
}

struct NormItem {
    const float* xin; float* xout; const bf16_t* outb; bf16_t* hb; int b, l, next, lane4; bool isc, dry;
    f32x4 gtp[4], gqs[4], sh[4];
};
__device__ __forceinline__ void norm_load(const NormItem& n, int rowb, f32x4 (&xv)[2][4], u32x2 (&ow)[2][4]) {
#pragma unroll
    for (int rr = 0; rr < 2; ++rr) { const int row = rowb + rr; const size_t j = (size_t)(row - n.b * NTOK);
#pragma unroll
        for (int q = 0; q < 4; ++q) { xv[rr][q] = __builtin_nontemporal_load((const f32x4*)(n.xin + j * DM + q * 256 + n.lane4)); if (n.l >= 0) ow[rr][q] = *(const u32x2*)(n.outb + (size_t)row * DM + q * 256 + n.lane4); } }
}
__device__ __forceinline__ void norm_proc(const NormItem& n, int rowb, f32x4 (&xv)[2][4], const u32x2 (&ow)[2][4]) {
#pragma unroll
    for (int rr = 0; rr < 2; ++rr) {
        const int row = rowb + rr; const size_t j = (size_t)(row - n.b * NTOK);
        if (n.l >= 0) {
            float ov[16]; float ss = 0.f;
#pragma unroll
            for (int q = 0; q < 4; ++q) { ov[q * 4] = lo_bf(ow[rr][q].x); ov[q * 4 + 1] = hi_bf(ow[rr][q].x); ov[q * 4 + 2] = lo_bf(ow[rr][q].y); ov[q * 4 + 3] = hi_bf(ow[rr][q].y); }
#pragma unroll
            for (int i = 0; i < 16; ++i) ss += ov[i] * ov[i];
            ss = wave_sum(ss); const float rs = rsqrtf(ss * (1.f / DM) + EPS);
#pragma unroll
            for (int q = 0; q < 4; ++q)
#pragma unroll
                for (int i = 0; i < 4; ++i) xv[rr][q][i] += n.gtp[q][i] * (ov[q * 4 + i] * rs);
        }
        if ((n.l >= 0 || n.isc) && !n.dry) {
#pragma unroll
            for (int q = 0; q < 4; ++q) __builtin_nontemporal_store(xv[rr][q], (f32x4*)(n.xout + j * DM + q * 256 + n.lane4));
        }
        if (n.next >= 0) {
            float ss = 0.f;
#pragma unroll
            for (int q = 0; q < 4; ++q)
#pragma unroll
                for (int i = 0; i < 4; ++i) ss += xv[rr][q][i] * xv[rr][q][i];
            ss = wave_sum(ss); const float rs = rsqrtf(ss * (1.f / DM) + EPS);
#pragma unroll
            for (int q = 0; q < 4; ++q) { float hv[4];
#pragma unroll
                for (int i = 0; i < 4; ++i) hv[i] = xv[rr][q][i] * rs * n.gqs[q][i] + n.sh[q][i];
                u32x2 w; w.x = cvt_pk_bf16(hv[0], hv[1]); w.y = cvt_pk_bf16(hv[2], hv[3]); *(u32x2*)(n.hb + (size_t)row * DM + q * 256 + n.lane4) = w; }
        }
    }
}
__device__ __forceinline__ void norm_rows(const Ctx& c, int l  , int next  , int r0, int r1  ) {
    NormItem n; n.b = r0 / NTOK; n.isc = (r0 - n.b * NTOK) >= SEQL; n.l = l; n.next = next; n.lane4 = c.lane * 4; n.dry = c.dry != 0;
    if (next < 0 && n.isc) return;
    const int mr = n.isc ? 16 : n.b;
    const float* mvl = wsp<float>(c, WS_MODV) + ((size_t)(l < 0 ? 0 : l) * 17 + mr) * 3072;
    const float* mvn = wsp<float>(c, WS_MODV) + ((size_t)(next < 0 ? 0 : next) * 17 + mr) * 3072;
    const float* gpost = KIN(I_GPOST) + (l < 0 ? 0 : l) * DM; const float* gpre = KIN(I_GPRE) + (next < 0 ? 0 : next) * DM;
    n.outb = wsp<bf16_t>(c, WS_OUTB); n.hb = wsp<bf16_t>(c, WS_HCAT);
    if (n.isc) { float* base = wsp<float>(c, WS_CTXR) + ((ptrdiff_t)n.b * CTXL - SEQL) * DM; n.xout = base; n.xin = (l < 0) ? KIN(I_CTX) + ((ptrdiff_t)n.b * CTXL - SEQL) * DM : base; }
    else { float* base = KOUT() + (size_t)n.b * SEQL * DM; n.xout = base; n.xin = (l <= 0) ? KIN(I_X) + (size_t)n.b * SEQL * DM : base; }
#pragma unroll
    for (int q = 0; q < 4; ++q) { const int col = q * 256 + n.lane4;
        if (l >= 0) { const f32x4 gp = *(const f32x4*)(gpost + col), gt = *(const f32x4*)(mvl + 2048 + col); n.gtp[q] = gp * gt; } else n.gtp[q] = (f32x4){0.f, 0.f, 0.f, 0.f};
        if (next >= 0) { const f32x4 g = *(const f32x4*)(gpre + col), s1 = *(const f32x4*)(mvn + 1024 + col); n.gqs[q] = g * (s1 + 1.f); n.sh[q] = *(const f32x4*)(mvn + col); }
        else { n.gqs[q] = (f32x4){0.f, 0.f, 0.f, 0.f}; n.sh[q] = (f32x4){0.f, 0.f, 0.f, 0.f}; } }
    f32x4 xa[2][4], xb[2][4]; u32x2 oa[2][4], ob[2][4];
#pragma unroll
    for (int rr = 0; rr < 2; ++rr)
#pragma unroll
        for (int q = 0; q < 4; ++q) { oa[rr][q] = (u32x2){0u, 0u}; ob[rr][q] = (u32x2){0u, 0u}; }
    int rowb = r0 + c.wave * 2;
    norm_load(n, rowb, xa, oa);
    for (; rowb < r1; rowb += 32) {
        norm_load(n, rowb + 16, xb, ob);
        norm_proc(n, rowb, xa, oa);
        if (rowb + 32 < r1) norm_load(n, rowb + 32, xa, oa);
        norm_proc(n, rowb + 16, xb, ob);
    }
}

__device__ __forceinline__ void p2_rows(const Ctx& c, int l) {
    bf16_t* pb = wsp<bf16_t>(c, WS_PB);
    bf16_t* B0 = pb; bf16_t* B1 = pb + BLKE; bf16_t* B3 = pb + 3 * BLKE; const bf16_t* B4 = pb + 4 * BLKE;
    bf16_t* kr = wsp<bf16_t>(c, WS_KR); bf16_t* kg = wsp<bf16_t>(c, WS_KG); bf16_t* ug = wsp<bf16_t>(c, WS_UG); bf16_t* us = wsp<bf16_t>(c, WS_US);
    const float* ropeG = wsp<float>(c, WS_ROPEG); const float* ropeM = wsp<float>(c, WS_ROPEM);
    const int lane = c.lane;
    const f32x4 gcq = (lane < 48) ? *(const f32x4*)(KIN(I_GCQ) + l * 192 + lane * 4) : (f32x4){0.f, 0.f, 0.f, 0.f};
    const f32x4 gckv = (lane < 32) ? *(const f32x4*)(KIN(I_GCKV) + l * 128 + lane * 4) : (f32x4){0.f, 0.f, 0.f, 0.f};
    const f32x4 gq = *(const f32x4*)(KIN(I_GQ) + l * 64 + (lane & 15) * 4), gk = *(const f32x4*)(KIN(I_GK) + l * 64 + (lane & 15) * 4);
    for (int rowb = (c.bid * 8 + c.wave) * 4; rowb < MROWS; rowb += c.G * 8 * 4) {
        u32x2 w0[4], w1[4], w3[4], w4[4];
#pragma unroll
        for (int rr = 0; rr < 4; ++rr) { const size_t ro = (size_t)(rowb + rr) * 256 + lane * 4;
            w0[rr] = *(const u32x2*)(B0 + ro); w1[rr] = *(const u32x2*)(B1 + ro); w3[rr] = *(const u32x2*)(B3 + ro); w4[rr] = *(const u32x2*)(B4 + ro); }
#pragma unroll
        for (int rr = 0; rr < 4; ++rr) {
            const int row = rowb + rr;
            const int b = row / NTOK, j = row - b * NTOK; const bool islat = j < SEQL; const int rowpos = (j >> 6) & 63, colpos = j & 63;
            const size_t ro = (size_t)row * 256 + lane * 4;
            {
                const u32x2 w = w0[rr]; float x[4] = {lo_bf(w.x), hi_bf(w.x), lo_bf(w.y), hi_bf(w.y)};
                float ss = (lane < 48) ? (x[0] * x[0] + x[1] * x[1] + x[2] * x[2] + x[3] * x[3]) : 0.f; ss = wave_sum(ss);
                const float rs = rsqrtf(ss * (1.f / 192.f) + EPS);
                float xp[4];
#pragma unroll
                for (int i = 0; i < 4; ++i) xp[i] = swz_xor<2>(x[i]);
                u32x2 o; o.x = 0u; o.y = 0u;
                if (lane < 48) { o.x = cvt_pk_bf16(x[0] * rs * gcq[0], x[1] * rs * gcq[1]); o.y = cvt_pk_bf16(x[2] * rs * gcq[2], x[3] * rs * gcq[3]); }
                else if (lane < 56) {
                    const int t = lane - 48; float y[4];
                    if (islat) { const int pos = (t & 4) ? colpos : rowpos; const bool isx2 = (t & 2) != 0;
#pragma unroll
                        for (int i = 0; i < 4; ++i) { const int f = 4 * (t & 1) + i; const float cs = ropeM[(pos * 8 + f) * 2], sn = ropeM[(pos * 8 + f) * 2 + 1]; y[i] = isx2 ? (xp[i] * sn + x[i] * cs) : (x[i] * cs - xp[i] * sn); } }
                    else {
#pragma unroll
                        for (int i = 0; i < 4; ++i) y[i] = x[i]; }
                    u32x2 kk; kk.x = cvt_pk_bf16(y[0], y[1]); kk.y = cvt_pk_bf16(y[2], y[3]); *(u32x2*)(kr + (size_t)row * 32 + t * 4) = kk;
                }
                if (!c.dry) *(u32x2*)(B0 + ro) = o;
            }
            {
                const u32x2 w = w1[rr]; float x[4] = {lo_bf(w.x), hi_bf(w.x), lo_bf(w.y), hi_bf(w.y)};
                float ss = (lane < 32) ? (x[0] * x[0] + x[1] * x[1] + x[2] * x[2] + x[3] * x[3]) : 0.f; ss = wave_sum(ss);
                const float rs = rsqrtf(ss * (1.f / 128.f) + EPS);
                u32x2 o; o.x = 0u; o.y = 0u;
                if (lane < 32) { o.x = cvt_pk_bf16(x[0] * rs * gckv[0], x[1] * rs * gckv[1]); o.y = cvt_pk_bf16(x[2] * rs * gckv[2], x[3] * rs * gckv[3]); }
                if (!c.dry) *(u32x2*)(B1 + ro) = o;
            }
#pragma unroll
            for (int which = 0; which < 2; ++which) {
                const u32x2 w = which == 0 ? w3[rr] : w4[rr]; float x[4] = {lo_bf(w.x), hi_bf(w.x), lo_bf(w.y), hi_bf(w.y)};
                float ss = x[0] * x[0] + x[1] * x[1] + x[2] * x[2] + x[3] * x[3];
                ss += swz_xor<1>(ss); ss += swz_xor<2>(ss); ss += swz_xor<4>(ss); ss += swz_xor<8>(ss);
                const float rs = rsqrtf(ss * (1.f / 64.f) + EPS);
                const int t = lane & 15; const f32x4 g = which == 0 ? gq : gk;
#pragma unroll
                for (int i = 0; i < 4; ++i) x[i] = x[i] * rs * g[i];
                float xp[4];
#pragma unroll
                for (int i = 0; i < 4; ++i) xp[i] = swz_xor<4>(x[i]);
                if (islat) { const int pos = (t & 8) ? colpos : rowpos; const bool isx2 = (t & 4) != 0;
#pragma unroll
                    for (int i = 0; i < 4; ++i) { const int f = 4 * (t & 3) + i; const float cs = ropeG[(pos * 16 + f) * 2], sn = ropeG[(pos * 16 + f) * 2 + 1]; x[i] = isx2 ? (xp[i] * sn + x[i] * cs) : (x[i] * cs - xp[i] * sn); } }
                if (which == 0) { const float qs = 0.125f * LOG2E; u32x2 o; o.x = cvt_pk_bf16(x[0] * qs, x[1] * qs); o.y = cvt_pk_bf16(x[2] * qs, x[3] * qs); if (!c.dry) *(u32x2*)(B3 + ro) = o; }
                else if (lane < 32) { u32x2 o; o.x = cvt_pk_bf16(x[0], x[1]); o.y = cvt_pk_bf16(x[2], x[3]); *(u32x2*)(kg + ((size_t)(b * 2 + (lane >> 4)) * NTOK + j) * 64 + t * 4) = o; }
            }
        }
    }
}
#ifndef PROBE_ABL
#define PROBE_ABL 0
#endif
#ifndef PROBE_GQAONLY
#define PROBE_GQAONLY 0
#endif
template <int DK, bool SUB, bool NOMAX = false, int ABL = 0>
__device__ __forceinline__ bool attn_unit(float (&rowmax)[2], const Ctx& c, const bf16_t* Qp, int qpitch, const bf16_t* Kp, const bf16_t* Vtp, int kt0, int nkt, int nrows,
                                          const bf16_t* gatep, bf16_t* outp, bool rope, int j0, float qscale, const float* ropeM) {
    constexpr int KS = DK / 16, KPC = DK / 8, KPITCH = DK * 2 + 16, KB = 64 * KPITCH, VPITCH = 144, VB = 64 * VPITCH;
    constexpr int KOFF = 0, VOFF = 3 * KB;
    constexpr float LIM = 60.f;
    static_assert(KB % 16 == 0 && VB % 16 == 0, "attention LDS buffer alignment");
    const int tid = c.tid, lane = c.lane, wave = c.wave;
    const int lq_ = opaque(lane), q = lq_ & 31, h = lq_ >> 5;
    LAS unsigned char* lds = c.lds;
    const int rbase = (wave * 64 < nrows) ? wave * 64 : wave * 64 - 256;
    const bool live = wave * 64 < nrows;
    bf16x8 qf[2][KS];
#pragma unroll
    for (int qt = 0; qt < 2; ++qt) {
        const bf16_t* qrow = Qp + (size_t)(rbase + qt * 32 + q) * qpitch + 8 * h;
#pragma unroll
        for (int ks = 0; ks < KS; ++ks) qf[qt][ks] = *(const bf16x8*)(qrow + 16 * ks);
        if (DK == 96) {
            const int jj = j0 + rbase + qt * 32 + q;
#pragma unroll
            for (int ks = 0; ks < KS; ++ks) {
                float x[8]; unpack8(__builtin_bit_cast(u32x4, qf[qt][ks]), x);
                if (ks >= 4) {
                    const int pos = (ks == 4) ? ((jj >> 6) & 63) : (jj & 63);
#pragma unroll
                    for (int e = 0; e < 8; ++e) { const float xp = half_other(x[e], h); const float cs = ropeM[(pos * 8 + e) * 2], sn = ropeM[(pos * 8 + e) * 2 + 1];
                        const float r = h ? (xp * sn + x[e] * cs) : (x[e] * cs - xp * sn); x[e] = rope ? r : x[e]; }
                }
                u32x4 w; w.x = cvt_pk_bf16(x[0] * qscale, x[1] * qscale); w.y = cvt_pk_bf16(x[2] * qscale, x[3] * qscale); w.z = cvt_pk_bf16(x[4] * qscale, x[5] * qscale); w.w = cvt_pk_bf16(x[6] * qscale, x[7] * qscale);
                qf[qt][ks] = __builtin_bit_cast(bf16x8, w);
            }
        }
    }
    f32x16 o00, o01, o10, o11;
#pragma unroll
    for (int i = 0; i < 16; ++i) { o00[i] = 0.f; o01[i] = 0.f; o10[i] = 0.f; o11[i] = 0.f; }
    const float m0 = SUB ? rowmax[0] : 0.f, m1 = SUB ? rowmax[1] : 0.f; float l0 = 0.f, l1 = 0.f;
    float rmax0 = -1e30f, rmax1 = -1e30f;
    const int tq_ = opaque(tid);
    const int kst0 = (tq_ / KPC) * KPITCH + (tq_ % KPC) * 16, kst1 = ((tq_ + 512) / KPC) * KPITCH + ((tq_ + 512) % KPC) * 16;
    const int kgl0 = ((tq_ / KPC) * DK + (tq_ % KPC) * 8) * 2, kgl1 = (((tq_ + 512) / KPC) * DK + ((tq_ + 512) % KPC) * 8) * 2;
    const int vst = (tq_ >> 3) * VPITCH + ((tq_ & 7) >> 1) * 32 + ((tq_ & 7) & 1) * 8, vgl = ((tq_ >> 3) * NTOK + (tq_ & 7) * 8) * 2;
    const bool has2 = (DK == 96) && tq_ < 256;
    const int kfo = q * KPITCH + 16 * h, vfo = q * VPITCH + 16 * h;
    const char* Kc = (const char*)Kp; const char* Vc = (const char*)Vtp;
    u32x4 kreg0, kreg1 = {0u, 0u, 0u, 0u}, vreg;
#define AT_GLOADK(kt) do { if (ABL & 1) break; const char* kb_ = Kc + (size_t)(kt) * (64 * DK * 2); kreg0 = *(const u32x4*)(kb_ + kgl0); if (has2) kreg1 = *(const u32x4*)(kb_ + kgl1); } while (0)
#define AT_GLOADV(kt) do { if (ABL & 1) break; vreg = *(const u32x4*)(Vc + (size_t)(kt) * 128 + vgl); } while (0)
#define AT_WRITEK(bi) do { if (ABL & 1) break; LAS unsigned char* bb = lds + KOFF + (bi) * KB; *(LAS u32x4*)(bb + kst0) = kreg0; if (has2) *(LAS u32x4*)(bb + kst1) = kreg1; } while (0)
#define AT_WRITEV(bi) do { if (ABL & 1) break; LAS u32x2* vd = (LAS u32x2*)(lds + VOFF + (bi) * VB + vst); vd[0] = (u32x2){vreg.x, vreg.y}; vd[2] = (u32x2){vreg.z, vreg.w}; } while (0)
#define AT_KPRE(bi, jh) do { if (KPRE) { const LAS unsigned char* kb_ = lds + KOFF + (bi) * KB + (jh) * 32 * KPITCH + kfo; \
        _Pragma("unroll") for (int ks = 0; ks < KS; ++ks) kf[ks] = *(const LAS bf16x8*)(kb_ + 32 * ks); } } while (0)
#define AT_QK(S0, S1, bi, jh) do { const LAS unsigned char* kb = lds + KOFF + (bi) * KB + (jh) * 32 * KPITCH + kfo; \
        _Pragma("unroll") for (int i = 0; i < 16; ++i) { S0[i] = 0.f; S1[i] = 0.f; } \
        if (!(ABL & 8)) _Pragma("unroll") for (int ks = 0; ks < KS; ++ks) { \
            const bf16x8 a0 = KPRE ? kf[ks] : *(const LAS bf16x8*)(kb + 32 * ks); \
            S0 = __builtin_amdgcn_mfma_f32_32x32x16_bf16(a0, qf[0][ks], S0, 0, 0, 0); \
            S1 = __builtin_amdgcn_mfma_f32_32x32x16_bf16(a0, qf[1][ks], S1, 0, 0, 0); } } while (0)
#define AT_MAX(S, RM) do { if (!SUB && !NOMAX) { _Pragma("unroll") for (int i = 0; i < 16; i += 2) RM = max3_raw(RM, S[i], S[i + 1]); } } while (0)
#define AT_EXP(S, M, L, PK0, PK1) do { float ps = 0.f; \
        _Pragma("unroll") for (int i = 0; i < 16; ++i) { S[i] = (ABL & 2) ? S[i] * 0.001f : __builtin_amdgcn_exp2f(SUB ? S[i] - M : S[i]); ps += S[i]; } \
        L += ps; u32x4 w; \
        w.x = cvt_pk_bf16(S[0], S[1]); w.y = cvt_pk_bf16(S[2], S[3]); w.z = cvt_pk_bf16(S[4], S[5]); w.w = cvt_pk_bf16(S[6], S[7]); PK0 = __builtin_bit_cast(bf16x8, w); \
        w.x = cvt_pk_bf16(S[8], S[9]); w.y = cvt_pk_bf16(S[10], S[11]); w.z = cvt_pk_bf16(S[12], S[13]); w.w = cvt_pk_bf16(S[14], S[15]); PK1 = __builtin_bit_cast(bf16x8, w); } while (0)
#define AT_VLOAD() do { va00 = *(const LAS bf16x8*)(vb); va10 = *(const LAS bf16x8*)(vb + 32 * VPITCH); va01 = *(const LAS bf16x8*)(vb + 32); va11 = *(const LAS bf16x8*)(vb + 32 * VPITCH + 32); } while (0)
#define AT_SUB(SC0, SC1, SN0, SN1, vbi, jh, nbi, njh) do { \
          \
        const LAS unsigned char* vb = lds + VOFF + (vbi) * VB + (jh) * 64 + vfo; \
        bf16x8 va00, va10, va01, va11; \
        if (DK == 64) { AT_VLOAD(); }        \
        AT_MAX(SC0, rmax0); AT_MAX(SC1, rmax1); \
        AT_QK(SN0, SN1, nbi, njh); \
        bf16x8 p00, p01, p10, p11; \
        AT_EXP(SC0, m0, l0, p00, p01); AT_EXP(SC1, m1, l1, p10, p11); \
        if (DK != 64) { AT_VLOAD(); } \
        if (!(ABL & 4)) { \
            o00 = __builtin_amdgcn_mfma_f32_32x32x16_bf16(va00, p00, o00, 0, 0, 0); \
            o01 = __builtin_amdgcn_mfma_f32_32x32x16_bf16(va10, p00, o01, 0, 0, 0); \
            o10 = __builtin_amdgcn_mfma_f32_32x32x16_bf16(va00, p10, o10, 0, 0, 0); \
            o11 = __builtin_amdgcn_mfma_f32_32x32x16_bf16(va10, p10, o11, 0, 0, 0); \
            o00 = __builtin_amdgcn_mfma_f32_32x32x16_bf16(va01, p01, o00, 0, 0, 0); \
            o01 = __builtin_amdgcn_mfma_f32_32x32x16_bf16(va11, p01, o01, 0, 0, 0); \
            o10 = __builtin_amdgcn_mfma_f32_32x32x16_bf16(va01, p11, o10, 0, 0, 0); \
            o11 = __builtin_amdgcn_mfma_f32_32x32x16_bf16(va11, p11, o11, 0, 0, 0); } \
        if (ABL & 4) { asm volatile("" :: "v"(p00), "v"(p01), "v"(p10), "v"(p11), "v"(va00), "v"(va10), "v"(va01), "v"(va11)); } \
        } while (0)
    if (!SUB && !NOMAX && tid == 0) *(volatile LAS unsigned*)(lds + LDS_MISC_OFF + 24) = 0u;
    AT_GLOADK(kt0); AT_GLOADV(kt0); AT_WRITEK(0); AT_WRITEV(0);
    AT_GLOADK(kt0 + 1); AT_WRITEK(1);
    __syncthreads();
    f32x16 sa0, sa1, sb0, sb1;
    constexpr bool KPRE = (DK == 64);
    bf16x8 kf[KS];
    AT_KPRE(0, 0);
    AT_QK(sa0, sa1, 0, 0);
    AT_KPRE(0, 1);
    int kb0 = 0, kb1 = 1, kb2 = 2;
    for (int t = 0; t < nkt; ++t) {
        const int tk = (t + 2 < nkt) ? t + 2 : nkt - 1, tv = (t + 1 < nkt) ? t + 1 : nkt - 1;
        AT_GLOADK(kt0 + tk);
        AT_SUB(sa0, sa1, sb0, sb1, t & 1, 0, kb0, 1);
        AT_KPRE(kb1, 0);
        AT_WRITEK(kb2);
        AT_GLOADV(kt0 + tv);
        AT_SUB(sb0, sb1, sa0, sa1, t & 1, 1, kb1, 0);
        AT_KPRE(kb1, 1);
        AT_WRITEV((t + 1) & 1);
        if (!(ABL & 16)) __syncthreads();
        const int tmp = kb0; kb0 = kb1; kb1 = kb2; kb2 = tmp;
    }
#undef AT_GLOADK
#undef AT_GLOADV
#undef AT_WRITEK
#undef AT_WRITEV
#undef AT_QK
#undef AT_KPRE
#undef AT_MAX
#undef AT_EXP
#undef AT_SUB
#undef AT_VLOAD
    bool bad = false;
    if (!SUB && !NOMAX) { const float r0 = half_max(rmax0), r1 = half_max(rmax1); rowmax[0] = r0; rowmax[1] = r1; const bool b_ = live && !(r0 < LIM && r0 > -LIM && r1 < LIM && r1 > -LIM); volatile LAS unsigned* flg = (volatile LAS unsigned*)(lds + LDS_MISC_OFF + 24); if (__any(b_ ? 1 : 0) && opaque(lane) == 0) *flg = 1u; __syncthreads(); bad = *flg != 0u; __syncthreads(); }
    if (live && !bad) {
        const int le_ = opaque(lane), q = le_ & 31, h = le_ >> 5;
#pragma unroll
        for (int qt = 0; qt < 2; ++qt) {
            const float lr = qt ? l1 : l0; const float lt = half_sum(lr), inv = 1.f / lt;
            const size_t row = (size_t)(rbase + qt * 32 + q);
#pragma unroll
            for (int dt = 0; dt < 2; ++dt)
#pragma unroll
                for (int g4 = 0; g4 < 4; ++g4) {
                    const int dv0 = dt * 32 + 8 * g4 + 4 * h;
                    const u32x2 gw = *(const u32x2*)(gatep + row * 256 + dv0);
                    const float g0 = siluf(lo_bf(gw.x)), g1 = siluf(hi_bf(gw.x)), g2 = siluf(lo_bf(gw.y)), g3 = siluf(hi_bf(gw.y));
                    const f32x16& o = qt ? (dt ? o11 : o10) : (dt ? o01 : o00);
                    u32x2 w; w.x = cvt_pk_bf16(o[4 * g4] * inv * g0, o[4 * g4 + 1] * inv * g1); w.y = cvt_pk_bf16(o[4 * g4 + 2] * inv * g2, o[4 * g4 + 3] * inv * g3);
                    *(u32x2*)(outp + row * DM + dv0) = w;
                }
        }
    }
    return bad;
}

template <int N>
__device__ __forceinline__ void hyena_conv(const Ctx& c, LAS unsigned char* ub, LAS unsigned char* gb, int pass, const bf16_t* xmul  , float bias,
                                           bf16_t* zdst  , const bf16_t* gmul, bf16_t* cat  , float cw0, float cw1, float cw2, float cb  ) {
    constexpr int UP = (N + 256) * 2 + 16, NPAIR = N / 256, OFF8 = N - 8;
    const int lane = c.lane, i16 = lane & 15, kq = lane >> 4;
    for (int pr = c.wave; pr < NPAIR; pr += 8) {
        const int t0 = pr * 256;
        u32x4 xq[2][4], gq[2][4]; bf16_t xl[2][4], xr[2][4];
#pragma unroll
        for (int half = 0; half < 2; ++half)
#pragma unroll
            for (int r = 0; r < 4; ++r) { const int t8 = t0 + half * 128 + 32 * kq + 8 * r; const bf16_t* xp_ = xmul + (size_t)i16 * NTOK + t8; xq[half][r] = *(const u32x4*)xp_;
                xl[half][r] = (t8 > 0) ? xp_[-1] : (bf16_t)0; xr[half][r] = (t8 + 8 < N) ? xp_[8] : (bf16_t)0;
                gq[half][r] = (pass == 1) ? *(const u32x4*)(gmul + (size_t)i16 * NTOK + t8) : (u32x4){0u, 0u, 0u, 0u}; }
        f32x4 acc[2][8];
#pragma unroll
        for (int m = 0; m < 8; ++m) { acc[0][m] = (f32x4){0.f, 0.f, 0.f, 0.f}; acc[1][m] = (f32x4){0.f, 0.f, 0.f, 0.f}; }
        const LAS unsigned char* up = ub + i16 * UP + 256 + kq * 16;
        const LAS unsigned char* gp = gb + (OFF8 - t0 - 8 * i16 + 8 * kq) * 2;
        bf16x8 bfa = *(const LAS bf16x8*)(up - 256), bfb = *(const LAS bf16x8*)(up);
        u32x4 wa = *(const LAS u32x4*)(gp - 256), wb = *(const LAS u32x4*)(gp - 256 + 16);
        for (int s0 = -128; s0 < N; s0 += 32) {
            const int sn = (s0 + 32 < N) ? s0 + 32 : s0;
            const bf16x8 bfan = *(const LAS bf16x8*)(up + sn * 2), bfbn = *(const LAS bf16x8*)(up + sn * 2 + 256);
            const u32x4 wan = *(const LAS u32x4*)(gp + sn * 2), wbn = *(const LAS u32x4*)(gp + sn * 2 + 16);
            const unsigned w[8] = {wa.x, wa.y, wa.z, wa.w, wb.x, wb.y, wb.z, wb.w};
            unsigned sh[7];
#pragma unroll
            for (int k = 0; k < 7; ++k) sh[k] = __builtin_amdgcn_alignbit(w[k + 1], w[k], 16);
#pragma unroll
            for (int m = 0; m < 8; ++m) {
                u32x4 a;
                if (m & 1) { const int d0 = (7 - m) >> 1; a = (u32x4){w[d0], w[d0 + 1], w[d0 + 2], w[d0 + 3]}; }
                else { const int d0 = (6 - m) >> 1; a = (u32x4){sh[d0], sh[d0 + 1], sh[d0 + 2], sh[d0 + 3]}; }
                acc[0][m] = __builtin_amdgcn_mfma_f32_16x16x32_bf16(__builtin_bit_cast(bf16x8, a), bfa, acc[0][m], 0, 0, 0);
                acc[1][m] = __builtin_amdgcn_mfma_f32_16x16x32_bf16(__builtin_bit_cast(bf16x8, a), bfb, acc[1][m], 0, 0, 0);
            }
            bfa = bfan; bfb = bfbn; wa = wan; wb = wbn;
        }
#pragma unroll
        for (int half = 0; half < 2; ++half)
#pragma unroll
            for (int r = 0; r < 4; ++r) {
                const int t8 = t0 + half * 128 + 32 * kq + 8 * r;
                float uu[8], xr8[8], xm[8]; unpack8(*(const LAS u32x4*)(ub + i16 * UP + 256 + t8 * 2), uu); unpack8(xq[half][r], xr8);
                {   float pv = bf2f(xl[half][r]);
#pragma unroll
                    for (int m = 0; m < 8; ++m) { const float nx = (m < 7) ? xr8[m + 1] : bf2f(xr[half][r]); xm[m] = bf2f(f2bf(cw0 * pv + cw1 * xr8[m] + cw2 * nx + cb)); pv = xr8[m]; } }
                float y[8];
#pragma unroll
                for (int m = 0; m < 8; ++m) y[m] = xm[m] * (acc[half][m][r] + bias * uu[m]);
                if (pass == 0) { u32x4 o; o.x = cvt_pk_bf16(y[0], y[1]); o.y = cvt_pk_bf16(y[2], y[3]); o.z = cvt_pk_bf16(y[4], y[5]); o.w = cvt_pk_bf16(y[6], y[7]); *(u32x4*)(zdst + (size_t)i16 * NTOK + t8) = o; }
                else { float gg[8]; unpack8(gq[half][r], gg);
#pragma unroll
                    for (int m = 0; m < 8; ++m) gg[m] = bf2f(f2bf(siluf(gg[m])));
                    u32x4 o; o.x = cvt_pk_bf16(y[0] * gg[0], y[1] * gg[1]); o.y = cvt_pk_bf16(y[2] * gg[2], y[3] * gg[3]); o.z = cvt_pk_bf16(y[4] * gg[4], y[5] * gg[5]); o.w = cvt_pk_bf16(y[6] * gg[6], y[7] * gg[7]);
                    *(u32x4*)(cat + (size_t)i16 * NTOK + t8) = o; }
            }
    }
}
template <int N>
__device__ __forceinline__ void hyena_seq(const Ctx& c, int l, int ch, int toff) {
    constexpr int UP = (N + 256) * 2 + 16;
    LAS unsigned char* ub = c.lds; LAS unsigned char* gb = c.lds + 16 * UP;
    const bf16_t* vv = wsp<bf16_t>(c, WS_HYV) + (size_t)ch * 16 * NTOK + toff;
    bf16_t* vz = wsp<bf16_t>(c, WS_HYZ) + (size_t)ch * 16 * NTOK + toff;
    const bf16_t* x1 = wsp<bf16_t>(c, WS_HYX1) + (size_t)ch * 16 * NTOK + toff;
    const bf16_t* x2 = wsp<bf16_t>(c, WS_HYX2) + (size_t)ch * 16 * NTOK + toff;
    const bf16_t* gm = wsp<bf16_t>(c, WS_HYG) + (size_t)ch * 16 * NTOK + toff;
    bf16_t* cat = wsp<bf16_t>(c, WS_HYY) + (size_t)ch * 16 * NTOK + toff;
    { const int e = c.tid, b = e >> 5, side = (e >> 4) & 1, pc = e & 15; unsigned z = 0u; asm volatile("" : "+v"(z)); *(LAS u32x4*)(ub + b * UP + side * (256 + N * 2) + pc * 16) = (u32x4){z, z, z, z}; }
    for (int pass = 0; pass < 2; ++pass) {
        const bf16_t* gr = (N == SEQL) ? wsp<bf16_t>(c, WS_GR) + (((size_t)l * 2 + pass) * 256 + ch) * 8192 : wsp<bf16_t>(c, WS_GRC) + (((size_t)l * 2 + pass) * 256 + ch) * 512;
        const bf16_t* usrc = pass == 0 ? vv : vz;
        constexpr int NG = (2 * N / 8 + 511) / 512;
        {
            u32x4 t[NG];
#pragma unroll
            for (int k = 0; k < NG; ++k) { const int e = c.tid + k * 512; t[k] = (e < 2 * N / 8) ? *(const u32x4*)(gr + e * 8) : (u32x4){0u, 0u, 0u, 0u}; }
#pragma unroll
            for (int k = 0; k < NG; ++k) { const int e = c.tid + k * 512; if (e < 2 * N / 8) *(LAS u32x4*)(gb + e * 16) = t[k]; }
        }
        if constexpr (N == SEQL) {
#pragma unroll
            for (int k0 = 0; k0 < 16; k0 += 8) {
                u32x4 t[8];
#pragma unroll
                for (int k = 0; k < 8; ++k) t[k] = *(const u32x4*)(usrc + (size_t)(k0 + k) * NTOK + c.tid * 8);
#pragma unroll
                for (int k = 0; k < 8; ++k) *(LAS u32x4*)(ub + (k0 + k) * UP + 256 + c.tid * 16) = t[k];
            }
        } else {
            const int b = c.tid >> 5, pc = c.tid & 31;
            *(LAS u32x4*)(ub + b * UP + 256 + pc * 16) = *(const u32x4*)(usrc + (size_t)b * NTOK + pc * 8);
        }
        __syncthreads();
        const float* hcw = KIN(I_HCW) + (size_t)l * 3 * 768; const float* hcb = KIN(I_HCB) + l * 768;
        if (pass == 0) {
            const float w0 = hcw[ch], w1 = hcw[768 + ch], w2 = hcw[1536 + ch], bs = hcb[ch];
            constexpr int PPT = (N == SEQL) ? 16 : 1;
            u32x4 o[PPT];
#pragma unroll
            for (int k = 0; k < PPT; ++k) { const int b = (N == SEQL) ? k : (c.tid >> 5), pc = (N == SEQL) ? c.tid : (c.tid & 31); const LAS unsigned char* p = ub + b * UP + 256 + pc * 16;
                float x[8]; unpack8(*(const LAS u32x4*)p, x); float pv = bf2f(*(const LAS bf16_t*)(p - 2)); const float nx8 = bf2f(*(const LAS bf16_t*)(p + 16)); float y[8];
#pragma unroll
                for (int m = 0; m < 8; ++m) { const float nx = (m < 7) ? x[m + 1] : nx8; y[m] = w0 * pv + w1 * x[m] + w2 * nx + bs; pv = x[m]; }
                o[k].x = cvt_pk_bf16(y[0], y[1]); o[k].y = cvt_pk_bf16(y[2], y[3]); o[k].z = cvt_pk_bf16(y[4], y[5]); o[k].w = cvt_pk_bf16(y[6], y[7]); }
            __syncthreads();
#pragma unroll
            for (int k = 0; k < PPT; ++k) { const int b = (N == SEQL) ? k : (c.tid >> 5), pc = (N == SEQL) ? c.tid : (c.tid & 31); *(LAS u32x4*)(ub + b * UP + 256 + pc * 16) = o[k]; }
            __syncthreads();
        }
        const float bias = KIN(I_HBIAS)[((size_t)l * 2 + pass) * 256 + ch];
        const int cc = (pass + 1) * 256 + ch;
        hyena_conv<N>(c, ub, gb, pass, pass == 0 ? x1 : x2, bias, vz, gm, cat, hcw[cc], hcw[768 + cc], hcw[1536 + cc], hcb[cc]);
        asm volatile("s_waitcnt vmcnt(0)" ::: "memory");
        __syncthreads();
    }
}

__device__ __forceinline__ void hyena_untranspose(const Ctx& c, int tl0, int tl1) {
    const bf16_t* yT = wsp<bf16_t>(c, WS_HYY); bf16_t* cat = wsp<bf16_t>(c, WS_HCAT);
    LAS bf16_t* T = (LAS bf16_t*)c.lds;
    LAS unsigned* T32 = (LAS unsigned*)c.lds;
    for (int tl = tl0; tl < tl1; ++tl) {
        const int b = tl / 68, j0 = (tl - b * 68) * 64;
        u32x4 pre[4];
#pragma unroll
        for (int k = 0; k < 4; ++k) { const int e = c.tid + k * 512, ch = e >> 3, pc = e & 7; pre[k] = *(const u32x4*)(yT + ((size_t)ch * 16 + b) * NTOK + j0 + pc * 8); }
#pragma unroll
        for (int k = 0; k < 4; ++k) { const int e = c.tid + k * 512, ch = e >> 3, pc = e & 7; LAS unsigned* d = T32 + (ch * 132 + pc * 16) / 4; d[0] = pre[k].x; d[1] = pre[k].y; d[2] = pre[k].z; d[3] = pre[k].w; }
        __syncthreads();
#pragma unroll
        for (int k = 0; k < 4; ++k) { const int e = c.tid + k * 512, t = e >> 5, c0 = (e & 31) * 8; float v[8];
#pragma unroll
            for (int i = 0; i < 8; ++i) v[i] = bf2f(T[(c0 + i) * 66 + t]);
            u32x4 w; w.x = cvt_pk_bf16(v[0], v[1]); w.y = cvt_pk_bf16(v[2], v[3]); w.z = cvt_pk_bf16(v[4], v[5]); w.w = cvt_pk_bf16(v[6], v[7]);
            *(u32x4*)(cat + ((size_t)b * NTOK + j0 + t) * DM + 768 + c0) = w; }
        __syncthreads();
    }
}

__device__ __forceinline__ void ssm_scan_item(const Ctx& c, int l, int item) {
    const int b = item >> 2, g = (item & 3) * 4 + (c.tid >> 7), dq = (c.tid >> 6) & 1, p = c.tid & 63;
    const float* a16 = wsp<float>(c, WS_A16) + ((((size_t)l * 2 + dq) * 16 + g) * 64 + p) * 2;
    const float ar = a16[0], ai = a16[1];
    const bf16_t* E = wsp<bf16_t>(c, WS_E); bf16_t* US = wsp<bf16_t>(c, WS_US);
    float sr = 0.f, si = 0.f;
    for (int st0 = 0; st0 < NCHB; st0 += 8) {
        float er[8], ei[8]; size_t ro[8];
#pragma unroll
        for (int k = 0; k < 8; ++k) { const int st = st0 + k; const int cc = dq == 0 ? (st < 16 ? 256 + st : st - 16) : (st < 16 ? 271 - st : 255 - (st - 16));
            ro[k] = (size_t)g * NCHUNK + (size_t)b * NCHB + cc; er[k] = bf2f(E[ro[k] * 256 + dq * 128 + p]); ei[k] = bf2f(E[ro[k] * 256 + dq * 128 + 64 + p]); }
#pragma unroll
        for (int k = 0; k < 8; ++k) {
            US[ro[k] * 512 + 256 + dq * 128 + p] = f2bf(sr); US[ro[k] * 512 + 256 + dq * 128 + 64 + p] = f2bf(si);
            const float nr = ar * sr - ai * si + er[k], ni = ar * si + ai * sr + ei[k]; sr = nr; si = ni;
        }
    }
}

constexpr int LDS_BYTES = 163840;
constexpr int LDS_MISC = LDS_MISC_OFF;
static_assert(LDS_MISC_OFF == LDS_BYTES - 256, "LDS map");
constexpr int NPRO = 1, NPH = 6, NPHASES = NPRO + DEPTH * NPH;
constexpr int QI_HY = 256, QI_SCAN = 64, QI_ATTL = NB * 8 * 8, QI_SSM2 = 16 * 17, QI_UNT = 272, QI_ATTC = NB * 8, QI_GLU = MROWS / 256;
constexpr int QO_SCAN = QI_HY, QO_ATTL = QO_SCAN + QI_SCAN, QO_SSM2 = QO_ATTL + QI_ATTL, QO_UNT = QO_SSM2 + QI_SSM2, QO_ATTC = QO_UNT + QI_UNT, QO_GLU = QO_ATTC + QI_ATTC, QI_TOTAL = QO_GLU + QI_GLU;
#ifndef PROBE_DUP_MASK
#define PROBE_DUP_MASK 0
#endif
#ifndef PROBE_P4KINDS
#define PROBE_P4KINDS 0x7f
#endif
__device__ __forceinline__ void dep_signal(const Ctx& c, unsigned* cnt) {
    asm volatile("s_waitcnt vmcnt(0)" ::: "memory");
    __syncthreads();
    if (c.tid == 0) { __builtin_amdgcn_fence(__ATOMIC_RELEASE, "agent"); asm volatile("s_waitcnt vmcnt(0)" ::: "memory"); (void)xb_add(cnt, 1u); }
}
__device__ __forceinline__ void dep_signal_wt(const Ctx& c, unsigned* cnt) {
    asm volatile("s_waitcnt vmcnt(0)" ::: "memory");
    __syncthreads();
    if (c.tid == 0) (void)xb_add(cnt, 1u);
}
__device__ __forceinline__ void dep_wait(const Ctx& c, unsigned* cnt, unsigned need, unsigned* tmo) {
    if (c.dry) return;
    if (c.tid == 0) {
        unsigned sp = 0;
        while (xb_ld(cnt) < need) { __builtin_amdgcn_s_sleep(2); if ((++sp & 255u) == 0u) { if (xb_ld(tmo)) break; if (sp > XB_SPIN_CAP) { atomicAdd(tmo, 1u); break; } } }
        __builtin_amdgcn_fence(__ATOMIC_ACQUIRE, "agent");
        asm volatile("s_waitcnt vmcnt(0)" ::: "memory");
    }
    __syncthreads();
}

__global__ void __launch_bounds__(512, 2) mk_fwd(Params prm) {
    extern __shared__ __attribute__((aligned(16))) unsigned char lds_raw[];
    Ctx c; c.lds = (LAS unsigned char*)lds_raw; c.ka = (kargp_t)__builtin_amdgcn_kernarg_segment_ptr(); c.ws = prm.ws; c.tid = threadIdx.x; c.lane = c.tid & 63; c.wave = __builtin_amdgcn_readfirstlane(c.tid >> 6); c.G = gridDim.x; c.bid = blockIdx.x; c.dry = prm.dry;
    const int wave0 = c.wave;
    volatile LAS unsigned* misc = (volatile LAS unsigned*)(c.lds + LDS_MISC);
    if (c.tid < 16) misc[c.tid] = 0u;
    __syncthreads();
    unsigned* ctl = wsp<unsigned>(c, WS_CTL);
    const int lo = prm.ph_lo, hi = prm.ph_hi;
    const bool fused = (hi - lo) > 1;
    XcdBarrier bar; bar.bar = ctl + CW_BAR; bar.x = 0; bar.st = misc;
    if (fused) bar = xcd_barrier_post(ctl + CW_BAR, misc);
#ifndef SITE_MASK
#define SITE_MASK 0x3ff
#endif
#define SITE(n) (((SITE_MASK) >> (n)) & 1)
#define IN(k) (lo <= (k) && (k) < hi)
#define FRESH() do { { kargp_t _k = (kargp_t)__builtin_amdgcn_kernarg_segment_ptr(); asm volatile("" : "+s"(_k)); c.ka = _k; c.ws = (unsigned char*)(GAS unsigned char*)_k[37]; } { int _w = wave0; asm volatile("" : "+s"(_w)); c.wave = _w; c.lane = lane_id_fresh(); c.tid = c.wave * 64 + c.lane; } } while (0)
#define SEAM(k) do { if (IN((k) + 1)) xcd_barrier(bar); } while (0)

    if (SITE(0) && IN(0)) {
        FRESH();
        constexpr int J_MOD = 192, J_HY = 544, J_SSM = 64, J_WIN = 4 * 48 * 8, J_WOUT = 4 * 16 * 8, J_WUQ = 4 * 8 * 2, J_W256 = 4 * 4 * 2, J_NORM = MROWS / 256, J_PACK = 4 * 2 * 256;
        constexpr int J0 = J_MOD, J1 = J0 + J_HY, J2 = J1 + J_SSM, J3 = J2 + J_WIN, J4 = J3 + J_WOUT, J5 = J4 + J_WUQ, J6 = J5 + J_W256, J7 = J6 + J_W256, J8 = J7 + J_W256, J9 = J8 + 1, J10 = J9 + J_NORM, J11 = J10 + J_PACK;
        unsigned* dep = ctl + CW_DEP + DEP_SET * 8;
        unsigned* tmo = ctl + CW_BAR + XB_TMO;
        for (int job = c.bid; job < J11; job += c.G) {
            FRESH();
            if (job < J0) { modv_job(c, job); dep_signal(c, dep); }
            else if (job < J1) { hyena_mlp_job(c, job - J0); dep_signal(c, dep + 64); }
            else if (job < J2) ssm_tables_job(c, job - J1);
            else if (job < J3) { const int r = job - J2, l = r / 384, q = r % 384; wconv_tile(c, KIN(I_WIN) + (size_t)l * DM * INC, DM, INC, INP, wsp<bf16_t>(c, WS_WIN) + (size_t)l * INP * DM, DM, 0, q / 8, q % 8); }
            else if (job < J4) { const int r = job - J3, l = r / 128, q = r % 128; wconv_tile(c, KIN(I_WOUT) + (size_t)l * DM * DM, DM, DM, DM, wsp<bf16_t>(c, WS_WOUT) + (size_t)l * DM * DM, DM, 1, q / 8, q % 8); }
            else if (job < J5) { const int r = job - J4, l = r / 16, q = r % 16; wconv_tile(c, KIN(I_WUQ) + (size_t)l * 192 * 384, 192, 384, 384, wsp<bf16_t>(c, WS_WUQ) + (size_t)l * 512 * 256, 256, 1, q / 2, q % 2); }
            else if (job < J6) { const int r = job - J5, l = r / 8, q = r % 8; wconv_tile(c, KIN(I_WUKV) + (size_t)l * 128 * 512, 128, 512, 256, wsp<bf16_t>(c, WS_WUK) + (size_t)l * 256 * 256, 256, 2, q / 2, q % 2); }
            else if (job < J7) { const int r = job - J6, l = r / 8, q = r % 8; wconv_tile(c, KIN(I_WUKV) + (size_t)l * 128 * 512, 128, 512, 256, wsp<bf16_t>(c, WS_WUV) + (size_t)l * 256 * 256, 256, 3, q / 2, q % 2); }
            else if (job < J8) { const int r = job - J7, l = r / 8, q = r % 8; wconv_tile(c, KIN(I_GLUW) + (size_t)l * 256 * 256, 256, 256, 256, wsp<bf16_t>(c, WS_WGLU) + (size_t)l * 256 * 256, 256, 1, q / 2, q % 2); }
            else if (job < J9) rope_job(c);
            else if (job < J10) { dep_wait(c, dep, J_MOD, tmo); FRESH(); const int t = job - J9; norm_rows(c, -1, 0, t * 256, t * 256 + 256); }
            else { dep_wait(c, dep + 64, J_HY, tmo); FRESH(); hyena_pack_job(c, job - J10); }
        }
        SEAM(0);
    }
    for (int l = 0; l < DEPTH; ++l) {
        const int pbase = NPRO + l * NPH;
        if (SITE(2) && IN(pbase + 0)) {
            FRESH();
            pg8::Gemm g{wsp<bf16_t>(c, WS_HCAT), wsp<bf16_t>(c, WS_WIN) + (size_t)l * INP * DM, MROWS, INP, DM};
            pg8::StaticOrder S; S.init(MROWS, INP, c.G, c.bid);
            EpiInProj E{wsp<bf16_t>(c, WS_PB), wsp<bf16_t>(c, WS_UG), wsp<bf16_t>(c, WS_US), wsp<bf16_t>(c, WS_VTG), wsp<bf16_t>(c, WS_HYV), c.lds + pg8::STAGE_BYTES};
            pg8::gemm_phase(c.lds, g, S, E, c.tid);
            SEAM(pbase + 0);
        }
        if (SITE(3) && IN(pbase + 1)) { FRESH(); p2_rows(c, l); SEAM(pbase + 1); }
        if (SITE(4) && IN(pbase + 2)) {
            FRESH();
            pg8::Gemm g{wsp<bf16_t>(c, WS_PB), wsp<bf16_t>(c, WS_WUQ), MROWS, 512, 256};
            pg8::P3Order S{wsp<bf16_t>(c, WS_PB), wsp<bf16_t>(c, WS_PB) + BLKE, wsp<bf16_t>(c, WS_WUQ) + (size_t)l * 512 * 256, wsp<bf16_t>(c, WS_WUK) + (size_t)l * 256 * 256, wsp<bf16_t>(c, WS_WUV) + (size_t)l * 256 * 256,
                           wsp<bf16_t>(c, WS_UG), wsp<bf16_t>(c, WS_WE) + (size_t)l * 16 * 256 * 256, c.G, c.bid};
            EpiP3 E{{wsp<bf16_t>(c, WS_QM), 384, 384}, {wsp<bf16_t>(c, WS_KM), wsp<bf16_t>(c, WS_KR)}, {wsp<bf16_t>(c, WS_VTM)}, {wsp<bf16_t>(c, WS_E)}};
            pg8::gemm_phase(c.lds, g, S, E, c.tid);
            SEAM(pbase + 2);
        }
        if (SITE(5) && IN(pbase + 3)) {
            FRESH();
            unsigned* qh = ctl + CW_Q + 64 * (l + 4 * (c.dry ? 1 : 0));
            unsigned* dep = ctl + CW_DEP + DEP_SET * (l + 4 * (c.dry ? 1 : 0));
            unsigned* tmo = ctl + CW_BAR + XB_TMO;
            const float* ropeM = wsp<float>(c, WS_ROPEM);
            bool gqa_nomax;
            { float gq_ = fabsf(KIN(I_GQ)[l * 64 + c.lane]), gk_ = fabsf(KIN(I_GK)[l * 64 + c.lane]);
              gq_ = fmaxf(gq_, swz_xor<16>(gq_)); gq_ = fmaxf(gq_, swz_xor<8>(gq_)); gq_ = fmaxf(gq_, swz_xor<4>(gq_)); gq_ = fmaxf(gq_, swz_xor<2>(gq_)); gq_ = fmaxf(gq_, swz_xor<1>(gq_)); gq_ = half_max(gq_);
              gk_ = fmaxf(gk_, swz_xor<16>(gk_)); gk_ = fmaxf(gk_, swz_xor<8>(gk_)); gk_ = fmaxf(gk_, swz_xor<4>(gk_)); gk_ = fmaxf(gk_, swz_xor<2>(gk_)); gk_ = fmaxf(gk_, swz_xor<1>(gk_)); gk_ = half_max(gk_);
              const float bound = 64.f * gq_ * gk_ * 0.125f * LOG2E * 1.01f; gqa_nomax = __builtin_amdgcn_readfirstlane(bound < 50.f ? 1 : 0) != 0; }
#define ATT_CALL(DKV, ...) do { float rowmax_[2] = {0.f, 0.f}; if (attn_unit<DKV, false>(rowmax_, __VA_ARGS__)) { (void)attn_unit<DKV, true>(rowmax_, __VA_ARGS__); } } while (0)
            for (;;) {
                __syncthreads();
                if (c.tid == 0) misc[4] = __hip_atomic_fetch_add(qh, 1u, __ATOMIC_RELAXED, __HIP_MEMORY_SCOPE_AGENT);
                __syncthreads();
                const int it = (int)misc[4];
                if (it >= QI_TOTAL) break;
                FRESH();
                if (c.dry) { const int kd_ = it < QO_SCAN ? 0 : it < QO_ATTL ? 1 : it < QO_SSM2 ? 2 : it < QO_UNT ? 3 : it < QO_ATTC ? 4 : it < QO_GLU ? 5 : 6; if (!((c.dry >> (1 + kd_)) & 1)) continue; }
                if (it < QO_SCAN) { hyena_seq<SEQL>(c, l, it, 0); if (l + 1 < DEPTH) hyena_seq<CTXL>(c, l, it, SEQL); dep_signal(c, dep); }
                else if (it < QO_ATTL) { ssm_scan_item(c, l, it - QO_SCAN); dep_signal(c, dep + 64); }
                else if (it >= QO_ATTC && it < QO_GLU && l + 1 == DEPTH) {   }
                else if (it < QO_SSM2 || (it >= QO_ATTC && it < QO_GLU)) {
                    const bool isctx = it >= QO_ATTC; const int r = isctx ? it - QO_ATTC : (it - QO_ATTL) % (NB * 8), blk = isctx ? 8 : (it - QO_ATTL) / (NB * 8)  ;
                    const int kind = r & 1  , head = (r >> 1) & 3, b = r >> 3;
                    const size_t row0 = (size_t)b * NTOK + (isctx ? SEQL : blk * 512); const int kt0 = isctx ? 64 : 0, nkt = isctx ? 4 : 68, nrows = isctx ? 256 : 512;
                    if (kind == 0) { if (c.dry && PROBE_GQAONLY == 1) continue; ATT_CALL(96, c, wsp<bf16_t>(c, WS_QM) + row0 * 384 + head * 96, 384, wsp<bf16_t>(c, WS_KM) + (size_t)(b * 4 + head) * NTOK * 96, wsp<bf16_t>(c, WS_VTM) + (size_t)(b * 4 + head) * 64 * NTOK,
                                                 kt0, nkt, nrows, wsp<bf16_t>(c, WS_PB) + 2 * BLKE + row0 * 256 + head * 64, wsp<bf16_t>(c, WS_HCAT) + row0 * DM + head * 64, !isctx, blk * 512, 0.10206207261596577f * LOG2E, ropeM); }
                    else if (c.dry && PROBE_GQAONLY == 2) { continue; }
                    else if (c.dry && PROBE_ABL) { float rm_[2] = {0.f, 0.f}; (void)attn_unit<64, false, true, PROBE_ABL>(rm_, c, wsp<bf16_t>(c, WS_PB) + 3 * BLKE + row0 * 256 + head * 64, 256, wsp<bf16_t>(c, WS_KG) + (size_t)(b * 2 + (head >> 1)) * NTOK * 64, wsp<bf16_t>(c, WS_VTG) + (size_t)(b * 2 + (head >> 1)) * 64 * NTOK,
                                       kt0, nkt, nrows, wsp<bf16_t>(c, WS_PB) + 5 * BLKE + row0 * 256 + head * 64, wsp<bf16_t>(c, WS_HCAT) + row0 * DM + 256 + head * 64, false, 0, 1.f, ropeM); }
                    else if (gqa_nomax) { float rm_[2] = {0.f, 0.f}; (void)attn_unit<64, false, true>(rm_, c, wsp<bf16_t>(c, WS_PB) + 3 * BLKE + row0 * 256 + head * 64, 256, wsp<bf16_t>(c, WS_KG) + (size_t)(b * 2 + (head >> 1)) * NTOK * 64, wsp<bf16_t>(c, WS_VTG) + (size_t)(b * 2 + (head >> 1)) * 64 * NTOK,
                                       kt0, nkt, nrows, wsp<bf16_t>(c, WS_PB) + 5 * BLKE + row0 * 256 + head * 64, wsp<bf16_t>(c, WS_HCAT) + row0 * DM + 256 + head * 64, false, 0, 1.f, ropeM); }
                    else { ATT_CALL(64, c, wsp<bf16_t>(c, WS_PB) + 3 * BLKE + row0 * 256 + head * 64, 256, wsp<bf16_t>(c, WS_KG) + (size_t)(b * 2 + (head >> 1)) * NTOK * 64, wsp<bf16_t>(c, WS_VTG) + (size_t)(b * 2 + (head >> 1)) * 64 * NTOK,
                                       kt0, nkt, nrows, wsp<bf16_t>(c, WS_PB) + 5 * BLKE + row0 * 256 + head * 64, wsp<bf16_t>(c, WS_HCAT) + row0 * DM + 256 + head * 64, false, 0, 1.f, ropeM); }
                }
                else if (it < QO_UNT) {
                    const int L = it - QO_SSM2, i = L >> 4, g = L & 15;
                    dep_wait(c, dep + 64, QI_SCAN, tmo);
                    pg8::Gemm gm{wsp<bf16_t>(c, WS_US), wsp<bf16_t>(c, WS_WKC) + (size_t)l * 16 * 256 * 512, 16 * NCHUNK, 16 * 256, 512}; pg8::OneUnit S{g * 17 + i, g};
                    pg8::EpiWalk<PutSsmY> E{{wsp<bf16_t>(c, WS_ZS), wsp<bf16_t>(c, WS_UG), KIN(I_SSMD) + l * 256}}; pg8::gemm_phase(c.lds, gm, S, E, c.tid);
                    dep_signal(c, dep + 64 * (2 + i));
                }
                else if (it < QO_ATTC) {
                    dep_wait(c, dep, QI_HY, tmo);
                    const int j = it - QO_UNT; hyena_untranspose(c, 4 * j, 4 * j + 4);
                }
                else {
                    const int pm = it - QO_GLU;
                    dep_wait(c, dep + 64 * (2 + (pm >> 4)), 16u, tmo);
                    pg8::Gemm gm{wsp<bf16_t>(c, WS_ZS), wsp<bf16_t>(c, WS_WGLU) + (size_t)l * 256 * 256, MROWS, 256, 256}; pg8::OneUnit S{pm, 0};
                    pg8::EpiWalk<PutGlu> E{{wsp<bf16_t>(c, WS_HCAT), wsp<bf16_t>(c, WS_ZS), wsp<bf16_t>(c, WS_PB) + 7 * BLKE, KIN(I_GLUB) + l * 256}}; pg8::gemm_phase(c.lds, gm, S, E, c.tid);
                }
            }
            SEAM(pbase + 3);
        }
        if (SITE(6) && IN(pbase + 4)) {
            FRESH();
            const bool lastl = l + 1 == DEPTH;
            constexpr int OPD = 8;
            const int x = c.bid & 7, nsx = (lastl ? NB * 16 : MROWS / 256) / 8;
            const int n1 = 4 * OPD, n2 = n1 + 8 * (nsx - OPD), ntot = n2 + 4 * OPD;
            unsigned* qh = ctl + CW_Q2 + 64 * ((l + 4 * (c.dry ? 1 : 0)) * 8 + x);
            unsigned* c7 = ctl + CW_C7 + 320 * (l + 4 * (c.dry ? 1 : 0));
            unsigned* tmo = ctl + CW_BAR + XB_TMO;
            unsigned pre = 0u;
            if (c.tid == 0) pre = __hip_atomic_fetch_add(qh, 1u, __ATOMIC_RELAXED, __HIP_MEMORY_SCOPE_AGENT);
            for (;;) {
                __syncthreads();
                if (c.tid == 0) { misc[4] = pre; pre = __hip_atomic_fetch_add(qh, 1u, __ATOMIC_RELAXED, __HIP_MEMORY_SCOPE_AGENT); }
                __syncthreads();
                const int it = (int)misc[4];
                if (it >= ntot) break;
                FRESH();
                int i, k;
                if (it < n1) { i = it >> 2; k = it & 3; } else if (it < n2) { const int j = it - n1; i = OPD + (j >> 3); k = j & 7; if (k >= 4) i -= OPD; } else { const int j = it - n2; i = nsx - OPD + (j >> 2); k = 4 + (j & 3); }
                const int s_ = x + 8 * i, pm = lastl ? (s_ >> 4) * 17 + (s_ & 15) : s_;
                if (k < 4) {
                    pg8::Gemm g{wsp<bf16_t>(c, WS_HCAT), wsp<bf16_t>(c, WS_WOUT) + (size_t)l * DM * DM, MROWS, DM, DM}; pg8::OneUnit S{pm, k};
                    pg8::EpiWalk<PutPlainWT> E{{wsp<bf16_t>(c, WS_OUTB), DM, DM}}; pg8::gemm_phase(c.lds, g, S, E, c.tid);
                    dep_signal_wt(c, c7 + s_);
                } else {
                    dep_wait(c, c7 + s_, 4u, tmo);
                    const int r0 = pm * 256 + (k - 4) * 64; norm_rows(c, l, lastl ? -1 : l + 1, r0, r0 + 64);
                }
            }
            if (!lastl) SEAM(pbase + 4);
        }
    }
#undef IN
#undef SEAM
}

extern "C" void kernel_launch(void* const* d_in, const int* in_sizes, int n_in, void* d_out, int out_size, void* d_ws, size_t ws_size, hipStream_t stream) {
    static int grid = 0;
    if (grid == 0) {
        if (n_in != 36 || out_size != NB * SEQL * DM || ws_size < WS_END) { fprintf(stderr, "kernel_launch: unexpected shapes: n_in %d out %d ws %zu (need %zu)\n", n_in, out_size, ws_size, (size_t)WS_END); grid = -1; return; }
        int dev = 0, cus = 0, per_cu = 0;
        if (hipGetDevice(&dev) != hipSuccess || hipDeviceGetAttribute(&cus, hipDeviceAttributeMultiprocessorCount, dev) != hipSuccess) { grid = -1; return; }
        if (hipFuncSetAttribute((const void*)mk_fwd, hipFuncAttributeMaxDynamicSharedMemorySize, LDS_BYTES) != hipSuccess) { fprintf(stderr, "kernel_launch: hipFuncSetAttribute failed\n"); grid = -1; return; }
        if (hipOccupancyMaxActiveBlocksPerMultiprocessor(&per_cu, (const void*)mk_fwd, 512, LDS_BYTES) != hipSuccess || per_cu < 1) { fprintf(stderr, "kernel_launch: occupancy query says %d blocks per CU\n", per_cu); per_cu = 1; }
        (void)hipGetLastError();
        grid = cus;
    }
    if (grid < 0) return;
    (void)hipMemsetAsync((char*)d_ws + WS_CTL, 0, CTL_BYTES, stream);
    Params p{};
    for (int i = 0; i < 36; ++i) p.in[i] = (const float*)d_in[i];
    p.out = (float*)d_out; p.ws = (unsigned char*)d_ws;
#if MK_ONE_LAUNCH
    p.ph_lo = 0; p.ph_hi = NPHASES;
    hipLaunchKernelGGL(mk_fwd, dim3(grid), dim3(512), LDS_BYTES, stream, p);
#else
    for (int k = 0; k < NPHASES; ++k) { p.ph_lo = k; p.ph_hi = k + 1; const int site = k < NPRO ? k : NPRO + (k - NPRO) % NPH;
        if ((PROBE_DUP_MASK >> site) & 1) { p.dry = 1 | (PROBE_P4KINDS << 1); hipLaunchKernelGGL(mk_fwd, dim3(grid), dim3(512), LDS_BYTES, stream, p); p.dry = 0; }
        hipLaunchKernelGGL(mk_fwd, dim3(grid), dim3(512), LDS_BYTES, stream, p); }
#endif
}
```

```cpp
#include <hip/hip_runtime.h>
#include <cstdio>
#include <cstdint>

#ifndef MK_ONE_LAUNCH
#define MK_ONE_LAUNCH 1
#endif

#define LAS __attribute__((address_space(3)))
#define GAS __attribute__((address_space(1)))
typedef unsigned short bf16_t;
typedef short bf16x8 __attribute__((ext_vector_type(8)));
typedef short bf16x4 __attribute__((ext_vector_type(4)));
typedef float f32x4 __attribute__((ext_vector_type(4)));
typedef float f32x16 __attribute__((ext_vector_type(16)));
typedef unsigned u32x4 __attribute__((ext_vector_type(4)));
typedef unsigned u32x2 __attribute__((ext_vector_type(2)));

constexpr int NB = 16, SEQL = 4096, CTXL = 256, NTOK = SEQL + CTXL  , MROWS = NB * NTOK  ;
constexpr int DM = 1024, DEPTH = 4, INC = 2912, INP = 3072;
constexpr int NCHB = NTOK / 16  , NCHUNK = MROWS / 16  ;
constexpr float EPS = 1e-6f;
constexpr float LOG2E = 1.4426950408889634f;
constexpr int LDS_MISC_OFF = 163840 - 256;

constexpr size_t al256(size_t x) { return (x + 255) & ~(size_t)255; }
constexpr size_t WS_CTL = 0;
constexpr size_t CTL_BYTES = 131072;
constexpr size_t WS_MODV = WS_CTL + CTL_BYTES;
constexpr size_t WS_ROPEG = WS_MODV + al256((size_t)4 * 17 * 3072 * 4);
constexpr size_t WS_ROPEM = WS_ROPEG + 64 * 16 * 2 * 4;
constexpr size_t WS_WIN = WS_ROPEM + 64 * 8 * 2 * 4;
constexpr size_t WS_WOUT = WS_WIN + (size_t)4 * 3072 * 1024 * 2;
constexpr size_t WS_WUQ = WS_WOUT + (size_t)4 * 1024 * 1024 * 2;
constexpr size_t WS_WUK = WS_WUQ + (size_t)4 * 512 * 256 * 2;
constexpr size_t WS_WUV = WS_WUK + (size_t)4 * 256 * 256 * 2;
constexpr size_t WS_WGLU = WS_WUV + (size_t)4 * 256 * 256 * 2;
constexpr size_t WS_WE = WS_WGLU + (size_t)4 * 256 * 256 * 2;
constexpr size_t WS_WKC = WS_WE + (size_t)4 * 16 * 256 * 256 * 2;
constexpr size_t WS_A16 = WS_WKC + (size_t)4 * 16 * 256 * 512 * 2;
constexpr size_t WS_GR = WS_A16 + (size_t)4 * 2 * 16 * 64 * 2 * 4;
constexpr size_t WS_GRC = WS_GR + (size_t)4 * 2 * 256 * 8192 * 2;
constexpr size_t WS_CTXR = WS_GRC + (size_t)4 * 2 * 256 * 512 * 2;
constexpr size_t WS_HCAT = WS_CTXR + (size_t)NB * CTXL * DM * 4;
constexpr size_t BLKE = (size_t)MROWS * 256;
constexpr size_t WS_PB = WS_HCAT + (size_t)MROWS * DM * 2;
constexpr size_t WS_KR = WS_PB + 12 * BLKE * 2;
constexpr size_t WS_KG = WS_KR + (size_t)MROWS * 32 * 2;
constexpr size_t WS_VTG = WS_KG + (size_t)32 * NTOK * 64 * 2;
constexpr size_t WS_UG = WS_VTG + (size_t)32 * NTOK * 64 * 2;
constexpr size_t WS_US = WS_UG + BLKE * 2;
constexpr size_t WS_HYV = WS_US + (size_t)16 * NCHUNK * 512 * 2;
constexpr size_t WS_HYX1 = WS_HYV + BLKE * 2;
constexpr size_t WS_HYX2 = WS_HYX1 + BLKE * 2;
constexpr size_t WS_HYG = WS_HYX2 + BLKE * 2;
constexpr size_t WS_HYZ = WS_HYG + BLKE * 2;
constexpr size_t WS_HYY = WS_HYZ + BLKE * 2;
constexpr size_t WS_END = WS_HYY + BLKE * 2;
static_assert(WS_END <= (size_t)1 << 30, "workspace map exceeds 1 GiB");
constexpr size_t WS_QM = WS_PB + 8 * BLKE * 2;
constexpr size_t WS_KM = WS_QM + (size_t)MROWS * 384 * 2;
constexpr size_t WS_VTM = WS_KM + (size_t)MROWS * 384 * 2;
constexpr size_t WS_E = WS_PB + 4 * BLKE * 2;
constexpr size_t WS_ZS = WS_PB + 6 * BLKE * 2;
constexpr size_t WS_OUTB = WS_PB + 8 * BLKE * 2;
constexpr size_t WS_HT = WS_PB;
static_assert(WS_VTM + BLKE * 2 == WS_PB + 12 * BLKE * 2, "alias map");

constexpr int CW_BAR = 0;
constexpr int CW_Q = 4096;
constexpr int CW_TMO = 4096 + 64 * 8;
constexpr int CW_DEP = 5120;
constexpr int DEP_SET = 20 * 64;
constexpr int CW_Q2 = 16384;
constexpr int CW_C7 = 20480;

__device__ __forceinline__ float bf2f(bf16_t v) { return __uint_as_float(((unsigned)v) << 16); }
__device__ __forceinline__ bf16_t f2bf(float f) { unsigned u = __float_as_uint(f); u += 0x7FFFu + ((u >> 16) & 1u); return (bf16_t)(u >> 16); }
__device__ __forceinline__ unsigned cvt_pk_bf16(float lo, float hi) { unsigned r; asm volatile("v_cvt_pk_bf16_f32 %0, %1, %2" : "=v"(r) : "v"(lo), "v"(hi)); return r; }
__device__ __forceinline__ float lo_bf(unsigned w) { return __uint_as_float(w << 16); }
__device__ __forceinline__ float hi_bf(unsigned w) { return __uint_as_float(w & 0xFFFF0000u); }
__device__ __forceinline__ float sigmf(float x) { float one = 1.f; asm volatile("" : "+v"(one)); return __builtin_amdgcn_rcpf(one + __builtin_amdgcn_exp2f(-1.4426950408889634f * x)); }
__device__ __forceinline__ float siluf(float x) { return x * sigmf(x); }
__device__ __forceinline__ float gelu_tanh(float x) { const float u = 0.7978845608028654f * (x + 0.044715f * x * x * x); return x * sigmf(2.f * u); }
__device__ __forceinline__ int opaque(int x) { asm volatile("" : "+v"(x)); return x; }
__device__ __forceinline__ int lane_id_fresh() { int x; asm volatile("v_mbcnt_lo_u32_b32 %0, -1, 0\n\tv_mbcnt_hi_u32_b32 %0, -1, %0" : "=v"(x)); return x; }
__device__ __forceinline__ float max3_raw(float a, float b, float c) { float r; asm("v_max3_f32 %0, %1, %2, %3" : "=v"(r) : "v"(a), "v"(b), "v"(c)); return r; }
template <int M> __device__ __forceinline__ float swz_xor(float v) { return __int_as_float(__builtin_amdgcn_ds_swizzle(__float_as_int(v), 0x1F | (M << 10))); }
__device__ __forceinline__ float half_sum(float v) { auto r = __builtin_amdgcn_permlane32_swap(__float_as_uint(v), __float_as_uint(v), false, false); return __uint_as_float(r[0]) + __uint_as_float(r[1]); }
__device__ __forceinline__ float half_max(float v) { auto r = __builtin_amdgcn_permlane32_swap(__float_as_uint(v), __float_as_uint(v), false, false); return fmaxf(__uint_as_float(r[0]), __uint_as_float(r[1])); }
__device__ __forceinline__ float half_other(float v, int h) { auto r = __builtin_amdgcn_permlane32_swap(__float_as_uint(v), __float_as_uint(v), false, false); return __uint_as_float(h ? r[0] : r[1]); }
__device__ __forceinline__ float wave_sum(float v) {
    v += swz_xor<16>(v); v += swz_xor<8>(v); v += swz_xor<4>(v); v += swz_xor<2>(v); v += swz_xor<1>(v);
    return half_sum(v);
}

#define XB_TMO      128
#define XB_XCNT(j)  (256  + 64 * (j))
#define XB_XSUB(j)  (1280 + 64 * (j))
#define XB_XGEN(j)  (2304 + 64 * (j))
#define XB_TOP      3328
#define XB_TOPGEN   3392
#define XCD_BAR_WORDS 3456
#define XB_SPIN_CAP (1u << 22)
__device__ __forceinline__ unsigned xb_ld(unsigned* p)              { return __hip_atomic_load(p, __ATOMIC_RELAXED, __HIP_MEMORY_SCOPE_AGENT); }
__device__ __forceinline__ unsigned xb_add(unsigned* p, unsigned v) { return __hip_atomic_fetch_add(p, v, __ATOMIC_RELAXED, __HIP_MEMORY_SCOPE_AGENT); }
__device__ __forceinline__ unsigned xb_xcc_id() { return (unsigned)__builtin_amdgcn_s_getreg((3 << 11) | 20) & 0xFu; }
#define XB_SPIN(cond, bar) do { unsigned _sp = 0; while (cond) { __builtin_amdgcn_s_sleep(1); \
    if ((++_sp & 255u) == 0u) { if (xb_ld(&(bar)[XB_TMO])) break; if (_sp > XB_SPIN_CAP) { atomicAdd(&(bar)[XB_TMO], 1u); break; } } } } while (0)
struct XcdBarrier { unsigned* bar; unsigned x; volatile LAS unsigned* st; };
__device__ __forceinline__ XcdBarrier xcd_barrier_post(unsigned* bar, volatile LAS unsigned* st) {
    XcdBarrier b; b.bar = bar; b.x = xb_xcc_id(); b.st = st;
    if (threadIdx.x == 0) (void)xb_add(&bar[XB_XCNT(b.x)], 1u);
    return b;
}
__device__ __forceinline__ void xcd_barrier_complete(unsigned* bar, unsigned x, unsigned& nloc, unsigned& nx) {
    const unsigned G = gridDim.x * gridDim.y * gridDim.z;
    unsigned sum, cnt, mine, sp = 0u;
    for (;;) {
        sum = 0u; cnt = 0u; mine = 0u;
#pragma unroll
        for (unsigned j = 0; j < 16; ++j) { const unsigned c = xb_ld(&bar[XB_XCNT(j)]); sum += c; cnt += (c > 0u) ? 1u : 0u; }
        mine = xb_ld(&bar[XB_XCNT(x)]);
        if (sum == G) break;
        __builtin_amdgcn_s_sleep(1);
        if ((++sp & 255u) == 0u) { if (xb_ld(&bar[XB_TMO])) break; if (sp > XB_SPIN_CAP) { atomicAdd(&bar[XB_TMO], 1u); break; } }
    }
    nloc = mine > 0u ? mine : 1u; nx = cnt > 0u ? cnt : 1u;
}
__device__ __forceinline__ void xcd_barrier(const XcdBarrier& b) {
    asm volatile("s_waitcnt vmcnt(0)" ::: "memory");
    __syncthreads();
    if (threadIdx.x == 0) {
        unsigned* bar = b.bar;
        __builtin_amdgcn_s_waitcnt(0);
        unsigned nloc = b.st[0], nx = b.st[1];
        if (nloc == 0u) { xcd_barrier_complete(bar, b.x, nloc, nx); b.st[0] = nloc; b.st[1] = nx; }
        const unsigned old = xb_add(&bar[XB_XSUB(b.x)], 1u);
        const unsigned gen = old / nloc;
        if (old + 1u == (gen + 1u) * nloc) {
            __builtin_amdgcn_fence(__ATOMIC_RELEASE, "agent");
            asm volatile("s_waitcnt vmcnt(0)" ::: "memory");
            const unsigned og = xb_add(&bar[XB_TOP], 1u);
            const unsigned tg = og / nx;
            if (og + 1u == (tg + 1u) * nx) xb_add(&bar[XB_TOPGEN], 1u);
            else XB_SPIN(xb_ld(&bar[XB_TOPGEN]) == tg, bar);
            __builtin_amdgcn_fence(__ATOMIC_ACQUIRE, "agent");
            xb_add(&bar[XB_XGEN(b.x)], 1u);
            asm volatile("s_waitcnt vmcnt(0)" ::: "memory");
        } else {
            XB_SPIN(xb_ld(&bar[XB_XGEN(b.x)]) == gen, bar);
            __builtin_amdgcn_fence(__ATOMIC_ACQUIRE, "agent");
            asm volatile("s_waitcnt vmcnt(0)" ::: "memory");
        }
    }
    __syncthreads();
}

namespace pg8 {
constexpr int BM = 256, BK = 64, HALF = 128, HTB = HALF * BK * 2, STAGE_BYTES = 8 * HTB, NXCD = 8, WGM = 8;
__host__ __device__ __forceinline__ int lds_byte(int r, int c) { const int st = (r >> 4) * 2 + (c >> 5), rr = r & 15, cc = c & 31, ob = rr * 64 + cc * 2; return st * 1024 + (ob ^ (((ob >> 9) & 1) << 5)); }
__host__ __device__ __forceinline__ void stage_rc(int b, int& R, int& C) { const int st = b / 1024, sb = b % 1024, swz = sb ^ (((sb >> 9) & 1) << 5); R = (st >> 1) * 16 + swz / 64; C = (st & 1) * 32 + (swz % 64) / 2; }
__host__ __device__ __forceinline__ int perm32(int rho) { const int n = rho >> 4, i = rho & 15; return 8 * (i >> 2) + 4 * n + (i & 3); }
struct Unit { int pm, pn, kd; };
struct Gemm { const bf16_t* A; const bf16_t* Bt; int M, N, K; };
struct StaticOrder {
    int nM, nN, nwg, G, c;
    __host__ __device__ void init(int M, int N, int G_, int c_) { nM = M / BM; nN = N / BM; nwg = nM * nN; G = G_; c = c_; }
    __host__ __device__ bool next(int i, Unit& u) const {
        const long L = (long)i * G + c; if (L >= nwg) return false;
        int wgid = (int)L; { const int q = nwg / NXCD, r = nwg % NXCD, xcd = wgid % NXCD, off = wgid / NXCD; wgid = (xcd < r ? xcd * (q + 1) : r * (q + 1) + (xcd - r) * q) + off; }
        const int nig = WGM * nN, gid = wgid / nig, fm = gid * WGM, gsz = (nM - fm) < WGM ? (nM - fm) : WGM;
        u.pm = fm + ((wgid % nig) % gsz); u.pn = (wgid % nig) / gsz; u.kd = 0; return true;
    }
    __device__ __forceinline__ void a_ready(const Unit&) const {}
    __device__ __forceinline__ void done(const Unit&) const {}
    __device__ __forceinline__ const char* abase(const Gemm& g, const Unit& u, size_t tstep) const { return (const char*)g.A + (size_t)u.pm * tstep; }
    __device__ __forceinline__ const char* bbase(const Gemm& g, const Unit& u, size_t tstep) const { return (const char*)g.Bt + (size_t)u.pn * tstep; }
};
struct LiveRowsOrder : StaticOrder {
    bool skip;
    __host__ __device__ void init2(int N, int G_, int c_, bool skip_) { skip = skip_; init(skip_ ? NB * SEQL : MROWS, N, G_, c_); }
    __host__ __device__ bool next(int i, Unit& u) const { if (!StaticOrder::next(i, u)) return false; if (skip) u.pm = (u.pm >> 4) * 17 + (u.pm & 15); return true; }
};
struct BatchedOrder {
    int nwg, G, c, tpg;
    __host__ __device__ void init(int ng, int tpg_, int G_, int c_) { nwg = ng * tpg_; tpg = tpg_; G = G_; c = c_; }
    __host__ __device__ bool next(int i, Unit& u) const { const int L = i * G + c; if (L >= nwg) return false; u.pm = L; u.pn = L / tpg; u.kd = 0; return true; }
    __device__ __forceinline__ void a_ready(const Unit&) const {}
    __device__ __forceinline__ void done(const Unit&) const {}
    __device__ __forceinline__ const char* abase(const Gemm& g, const Unit& u, size_t tstep) const { return (const char*)g.A + (size_t)u.pm * tstep; }
    __device__ __forceinline__ const char* bbase(const Gemm& g, const Unit& u, size_t tstep) const { return (const char*)g.Bt + (size_t)u.pn * tstep; }
};
struct P3Order {
    const bf16_t *b0, *b1, *wuq, *wuk, *wuv, *ug, *we; int G, c;
    __host__ __device__ bool next(int i, Unit& u) const {
        const int L = i * G + c; if (L >= 1360) return false;
        if (L < 544) { u.kd = 0; u.pm = L >> 1; u.pn = L & 1; } else if (L < 816) { u.kd = 1; u.pm = L - 544; u.pn = 0; } else if (L < 1088) { u.kd = 2; u.pm = 0; u.pn = L - 816; } else { u.kd = 3; u.pm = L - 1088; u.pn = (L - 1088) / 17; }
        return true;
    }
    __device__ __forceinline__ void a_ready(const Unit&) const {}
    __device__ __forceinline__ void done(const Unit&) const {}
    __device__ __forceinline__ const char* abase(const Gemm&, const Unit& u, size_t tstep) const { const bf16_t* p = u.kd == 0 ? b0 : u.kd == 1 ? b1 : u.kd == 2 ? wuv : ug; return (const char*)p + (size_t)u.pm * tstep; }
    __device__ __forceinline__ const char* bbase(const Gemm&, const Unit& u, size_t tstep) const { const bf16_t* p = u.kd == 0 ? wuq : u.kd == 1 ? wuk : u.kd == 2 ? b1 : we; return (const char*)p + (size_t)u.pn * tstep; }
};

struct OneUnit {
    int pm, pn;
    __host__ __device__ bool next(int i, Unit& u) const { if (i) return false; u.pm = pm; u.pn = pn; u.kd = 0; return true; }
    __device__ __forceinline__ void a_ready(const Unit&) const {}
    __device__ __forceinline__ void done(const Unit&) const {}
    __device__ __forceinline__ const char* abase(const Gemm& g, const Unit& u, size_t tstep) const { return (const char*)g.A + (size_t)u.pm * tstep; }
    __device__ __forceinline__ const char* bbase(const Gemm& g, const Unit& u, size_t tstep) const { return (const char*)g.Bt + (size_t)u.pn * tstep; }
};
template <class Epi, class Sched>
__device__ __forceinline__ void gemm_phase(LAS unsigned char* lds, const Gemm g, const Sched& S, const Epi& E, int tid_in) {
    const int tid = tid_in, wid = __builtin_amdgcn_readfirstlane(tid >> 6), lane = tid & 63, wr = wid >> 2, wc = wid & 3, fr = lane & 15, fq = lane >> 4;
    const int K = g.K, nt = K / BK;
    unsigned voffA[2], voffB[2];
#pragma unroll
    for (int i = 0; i < 2; ++i) { int R, C; stage_rc(tid * 16 + i * 8192, R, C); const int Rb = Epi::PERM ? ((R & ~31) + perm32(R & 31)) : R;
        voffA[i] = (unsigned)(R * K + C) * 2u; voffB[i] = (unsigned)(Rb * K + C) * 2u; }
    const size_t kstep = (size_t)(BK * 2);
    const size_t hstep = (size_t)HALF * K * 2;
    const size_t tstep = 2 * hstep;
    const unsigned ldsw = (unsigned)wid * 1024u;
    const int aoff = lds_byte(wr * 64 + fr, fq * 8), boff = lds_byte(wc * 32 + fr, fq * 8);
#define PG8_SA(b, h) (((b) * 2 + (h)) * HTB)
#define PG8_SB(b, h) ((4 + (b) * 2 + (h)) * HTB)
#define PG8_STAGE(bufoff, gbase, voff) do { _Pragma("unroll") for (int _i = 0; _i < 2; ++_i) \
        __builtin_amdgcn_global_load_lds((const unsigned*)((const char*)(gbase) + (voff)[_i]), (LAS unsigned*)(lds + (bufoff) + ldsw + _i * 8192), 16, 0, 0); } while (0)
#define PG8_LDA(dst, b, h) do { _Pragma("unroll") for (int m = 0; m < 4; ++m) _Pragma("unroll") for (int k = 0; k < 2; ++k) dst[m][k] = *(const LAS bf16x8*)(lds + PG8_SA(b, h) + aoff + m * 2048 + k * 1024); } while (0)
#define PG8_LDB(dst, b, h) do { _Pragma("unroll") for (int n = 0; n < 2; ++n) _Pragma("unroll") for (int k = 0; k < 2; ++k) dst[n][k] = *(const LAS bf16x8*)(lds + PG8_SB(b, h) + boff + n * 2048 + k * 1024); } while (0)
#define PG8_MMA(ai, bj, At, Bt) do { __builtin_amdgcn_s_setprio(1); _Pragma("unroll") for (int m = 0; m < 4; ++m) _Pragma("unroll") for (int n = 0; n < 2; ++n) _Pragma("unroll") for (int k = 0; k < 2; ++k) \
        acc[ai][bj][m][n] = __builtin_amdgcn_mfma_f32_16x16x32_bf16(Bt[n][k], At[m][k], acc[ai][bj][m][n], 0, 0, 0); __builtin_amdgcn_s_setprio(0); } while (0)
#define PG8_WAIT_V(n) asm volatile("s_waitcnt vmcnt(" #n ")" ::: "memory")
#define PG8_WAIT_L(n) asm volatile("s_waitcnt lgkmcnt(" #n ")" ::: "memory")
#define PG8_BAR __builtin_amdgcn_s_barrier()
#define PG8_SCHED __builtin_amdgcn_sched_barrier(0)
    Unit cur, nxt; int ui = 0;
    if (!S.next(0, cur)) return;
    f32x4 acc[2][2][4][2];
#pragma unroll
    for (int a = 0; a < 2; ++a)
#pragma unroll
        for (int b = 0; b < 2; ++b)
#pragma unroll
            for (int m = 0; m < 4; ++m)
#pragma unroll
                for (int n = 0; n < 2; ++n) acc[a][b][m][n] = (f32x4){0.f, 0.f, 0.f, 0.f};
    bf16x8 At[4][2], B0[2][2], B1[2][2];
    const char* cA = S.abase(g, cur, tstep); const char* cB = S.bbase(g, cur, tstep);
    S.a_ready(cur);
    PG8_STAGE(PG8_SB(0, 0), cB, voffB); PG8_STAGE(PG8_SA(0, 0), cA, voffA); PG8_STAGE(PG8_SB(0, 1), cB + hstep, voffB); PG8_STAGE(PG8_SA(0, 1), cA + hstep, voffA);
    if (wr == 1) PG8_BAR;
    PG8_WAIT_V(4); PG8_BAR;
    PG8_STAGE(PG8_SB(1, 0), cB + kstep, voffB); PG8_STAGE(PG8_SA(1, 0), cA + kstep, voffA); PG8_STAGE(PG8_SB(1, 1), cB + hstep + kstep, voffB);
    PG8_WAIT_V(6); PG8_BAR;
    for (;;) {
        const bool has_next = S.next(ui + 1, nxt);
        const char* nA = has_next ? S.abase(g, nxt, tstep) : cA; const char* nB = has_next ? S.bbase(g, nxt, tstep) : cB;
        for (int t = 0; t < nt; t += 2) {
            const bool last = (t == nt - 2);
            const char* a1 = cA + (size_t)(t + 1) * kstep;
            const char* a2 = last ? nA : cA + (size_t)(t + 2) * kstep; const char* b2 = last ? nB : cB + (size_t)(t + 2) * kstep;
            const char* a3 = a2 + kstep; const char* b3 = b2 + kstep;
            if (last && has_next) S.a_ready(nxt);
            PG8_LDB(B0, 0, 0); PG8_SCHED; PG8_LDA(At, 0, 0); PG8_STAGE(PG8_SA(1, 1), a1 + hstep, voffA);
            PG8_WAIT_L(8); PG8_BAR; PG8_WAIT_L(0); PG8_MMA(0, 0, At, B0); PG8_BAR; PG8_SCHED;
            PG8_LDB(B1, 0, 1); PG8_STAGE(PG8_SB(0, 0), b2, voffB);
            PG8_BAR; PG8_WAIT_L(0); PG8_MMA(0, 1, At, B1); PG8_BAR;
            PG8_LDA(At, 0, 1); PG8_STAGE(PG8_SA(0, 0), a2, voffA);
            PG8_BAR; PG8_WAIT_L(0); PG8_MMA(1, 0, At, B0); PG8_BAR; PG8_SCHED;
            PG8_STAGE(PG8_SB(0, 1), b2 + hstep, voffB);
            PG8_WAIT_V(6); PG8_BAR; PG8_MMA(1, 1, At, B1); PG8_BAR;
            PG8_LDB(B0, 1, 0); PG8_SCHED; PG8_LDA(At, 1, 0); PG8_STAGE(PG8_SA(0, 1), a2 + hstep, voffA);
            PG8_WAIT_L(8); PG8_BAR; PG8_WAIT_L(0); PG8_MMA(0, 0, At, B0); PG8_BAR; PG8_SCHED;
            PG8_LDB(B1, 1, 1); PG8_STAGE(PG8_SB(1, 0), b3, voffB);
            PG8_BAR; PG8_WAIT_L(0); PG8_MMA(0, 1, At, B1); PG8_BAR;
            PG8_LDA(At, 1, 1); PG8_STAGE(PG8_SA(1, 0), a3, voffA);
            PG8_BAR; PG8_WAIT_L(0); PG8_MMA(1, 0, At, B0); PG8_BAR; PG8_SCHED;
            PG8_STAGE(PG8_SB(1, 1), b3 + hstep, voffB);
            PG8_WAIT_V(6); PG8_BAR; PG8_MMA(1, 1, At, B1); PG8_BAR;
        }
        { const int l2 = lane_id_fresh(); E(acc, cur, wr, wc, l2 & 15, l2 >> 4); } S.done(cur);
        if (!has_next) break;
#pragma unroll
        for (int a = 0; a < 2; ++a)
#pragma unroll
            for (int b = 0; b < 2; ++b)
#pragma unroll
                for (int m = 0; m < 4; ++m)
#pragma unroll
                    for (int n = 0; n < 2; ++n) acc[a][b][m][n] = (f32x4){0.f, 0.f, 0.f, 0.f};
        cur = nxt; cA = nA; cB = nB; ++ui;
    }
    PG8_WAIT_V(0);
    if (wr == 0) PG8_BAR;
    PG8_BAR;
#undef PG8_SA
#undef PG8_SB
#undef PG8_STAGE
#undef PG8_LDA
#undef PG8_LDB
#undef PG8_MMA
#undef PG8_WAIT_V
#undef PG8_WAIT_L
#undef PG8_BAR
#undef PG8_SCHED
}

template <class F> struct EpiWalk {
    static constexpr bool PERM = true, AFTER_DRAIN = false;
    F f;
    __device__ __forceinline__ void operator()(const f32x4 (&acc)[2][2][4][2], const Unit& u, int wr, int wc, int fr, int fq) const {
#pragma unroll
        for (int ai = 0; ai < 2; ++ai)
#pragma unroll
            for (int m = 0; m < 4; ++m) {
                const int rin = ai * HALF + wr * 64 + m * 16 + fr;
#pragma unroll
                for (int bj = 0; bj < 2; ++bj) { const int cin = bj * HALF + wc * 32 + 8 * fq; f.put(u.pm, u.pn, rin, cin, acc[ai][bj][m][0], acc[ai][bj][m][1]); asm volatile("" ::: "memory"); }
            }
    }
};
}

__device__ __forceinline__ u32x4 pack8(const f32x4& a, const f32x4& b) {
    u32x4 w; w.x = cvt_pk_bf16(a[0], a[1]); w.y = cvt_pk_bf16(a[2], a[3]); w.z = cvt_pk_bf16(b[0], b[1]); w.w = cvt_pk_bf16(b[2], b[3]); return w;
}
__device__ __forceinline__ void unpack8(const u32x4 w, float (&o)[8]) {
    o[0] = lo_bf(w.x); o[1] = hi_bf(w.x); o[2] = lo_bf(w.y); o[3] = hi_bf(w.y); o[4] = lo_bf(w.z); o[5] = hi_bf(w.z); o[6] = lo_bf(w.w); o[7] = hi_bf(w.w);
}

struct PutPlain {
    bf16_t* dst; int ldc, ncols;
    __device__ __forceinline__ void put(int pm, int pn, int rin, int cin, const f32x4& a, const f32x4& b) const { const int col = pn * 256 + cin; if (col < ncols) *(u32x4*)(dst + ((size_t)pm * 256 + rin) * ldc + col) = pack8(a, b); }
};
struct PutPlainWT {
    bf16_t* dst; int ldc, ncols;
    __device__ __forceinline__ void put(int pm, int pn, int rin, int cin, const f32x4& a, const f32x4& b) const {
        const int col = pn * 256 + cin; const u32x4 w = pack8(a, b); GAS bf16_t* p = (GAS bf16_t*)(dst + ((size_t)pm * 256 + rin) * ldc + col);
        asm volatile("global_store_dwordx4 %0, %1, off sc1" :: "v"(p), "v"(w) : "memory"); }
};
struct PutKm {
    bf16_t* km; const bf16_t* kr;
    __device__ __forceinline__ void put(int pm, int pn, int rin, int cin, const f32x4& a, const f32x4& b) const {
        const int bb = pm / 17, key = (pm - bb * 17) * 256 + rin, hd = cin >> 6, d = cin & 63;
        bf16_t* dst = km + ((size_t)(bb * 4 + hd) * NTOK + key) * 96;
        *(u32x4*)(dst + d) = pack8(a, b);
        if (d < 32) *(u32x4*)(dst + 64 + d) = *(const u32x4*)(kr + ((size_t)pm * 256 + rin) * 32 + d);
    }
};
struct PutVt {
    bf16_t* vt;
    __device__ __forceinline__ void put(int pm, int pn, int rin, int cin, const f32x4& a, const f32x4& b) const {
        const int bb = pn / 17, key = (pn - bb * 17) * 256 + cin;
        *(u32x4*)(vt + ((size_t)(bb * 4 + (rin >> 6)) * 64 + (rin & 63)) * NTOK + key) = pack8(a, b);
    }
};
struct PutE {
    bf16_t* e;
    __device__ __forceinline__ void put(int pm, int pn, int rin, int cin, const f32x4& a, const f32x4& b) const { *(u32x4*)(e + ((size_t)pm * 256 + rin) * 256 + cin) = pack8(a, b); }
};
struct PutSsmY {
    bf16_t* zs; const bf16_t* ug; const float* dskip;
    __device__ __forceinline__ void put(int pm, int pn, int rin, int cin, const f32x4& a, const f32x4& b) const {
        const int g = pn, n = (pm - g * 17) * 256 + rin, tok = n * 16 + (cin >> 4), ho = cin & 15, ch = g * 16 + ho;
        float u[8]; unpack8(*(const u32x4*)(ug + ((size_t)g * MROWS + tok) * 16 + ho), u);
        const f32x4 d0 = *(const f32x4*)(dskip + ch), d1 = *(const f32x4*)(dskip + ch + 4);
        f32x4 y0, y1;
#pragma unroll
        for (int i = 0; i < 4; ++i) { y0[i] = gelu_tanh(a[i] + d0[i] * u[i]); y1[i] = gelu_tanh(b[i] + d1[i] * u[4 + i]); }
        *(u32x4*)(zs + (size_t)tok * 256 + ch) = pack8(y0, y1);
    }
};
struct PutGlu {
    bf16_t* cat; const bf16_t* zs; const bf16_t* gate; const float* gb;
    __device__ __forceinline__ void put(int pm, int pn, int rin, int cin, const f32x4& a, const f32x4& b) const {
        const size_t row = (size_t)pm * 256 + rin; const int col = cin;
        float z[8], gt[8]; unpack8(*(const u32x4*)(zs + row * 256 + col), z); unpack8(*(const u32x4*)(gate + row * 256 + col), gt);
        const f32x4 b0 = *(const f32x4*)(gb + col), b1 = *(const f32x4*)(gb + col + 4);
        f32x4 y0, y1;
#pragma unroll
        for (int i = 0; i < 4; ++i) { y0[i] = z[i] * sigmf(a[i] + b0[i]) * siluf(gt[i]); y1[i] = z[4 + i] * sigmf(b[i] + b1[i]) * siluf(gt[4 + i]); }
        *(u32x4*)(cat + row * DM + 512 + col) = pack8(y0, y1);
    }
};

struct EpiInProj {
    static constexpr bool PERM = true, AFTER_DRAIN = false;
    bf16_t *pb, *ug, *us, *vtg, *hy0;
    LAS unsigned char* scratch;
    __device__ __forceinline__ void operator()(const f32x4 (&acc)[2][2][4][2], const pg8::Unit& u, int wr, int wc, int fr, int fq) const {
        const int pn = u.pn, pm = u.pm;
        const int bb = pm / 17, jt = (pm - bb * 17) * 256;
        LAS unsigned char* sw = scratch + (wr * 4 + wc) * 1280;
        const int ln = fq * 16 + fr, tch = ln >> 1, thalf = ln & 1;
#pragma unroll
        for (int ai = 0; ai < 2; ++ai)
#pragma unroll
            for (int m = 0; m < 4; ++m) {
                const int rin = ai * pg8::HALF + wr * 64 + m * 16 + fr;
#pragma unroll
                for (int bj = 0; bj < 2; ++bj) {
                    const int cin = bj * pg8::HALF + wc * 32 + 8 * fq;
                    const u32x4 w = pack8(acc[ai][bj][m][0], acc[ai][bj][m][1]);
                    const bool plain = pn < 4 || pn == 5 || pn == 7 || (pn == 4 && bj == 0);
                    if (plain) { *(u32x4*)(pb + (size_t)pn * BLKE + ((size_t)pm * 256 + rin) * 256 + cin) = w; }
                    else if (pn == 6) { const size_t row = (size_t)pm * 256 + rin; const int g = cin >> 4, hi0 = cin & 15;
                        *(u32x4*)(ug + ((size_t)g * MROWS + row) * 16 + hi0) = w;
                        *(u32x4*)(us + ((size_t)g * NCHUNK + (row >> 4)) * 512 + (row & 15) * 16 + hi0) = w; }
                    else {
                        *(LAS u32x4*)(sw + fr * 80 + fq * 16) = w;
                        asm volatile("" ::: "memory");
                        unsigned short e[8];
#pragma unroll
                        for (int i = 0; i < 8; ++i) e[i] = *(const LAS unsigned short*)(sw + (thalf * 8 + i) * 80 + tch * 2);
                        asm volatile("" ::: "memory");
                        u32x4 t; t.x = e[0] | ((unsigned)e[1] << 16); t.y = e[2] | ((unsigned)e[3] << 16); t.z = e[4] | ((unsigned)e[5] << 16); t.w = e[6] | ((unsigned)e[7] << 16);
                        const int chn = bj * pg8::HALF + wc * 32 + tch;
                        const int tok = jt + ai * pg8::HALF + wr * 64 + m * 16 + thalf * 8;
                        bf16_t* dst = (pn == 4) ? vtg + ((size_t)(bb * 2 + ((chn - 128) >> 6)) * 64 + ((chn - 128) & 63)) * NTOK + tok
                                                : hy0 + (size_t)(pn - 8) * BLKE + ((size_t)chn * 16 + bb) * NTOK + tok;
                        *(u32x4*)dst = t;
                    }
                    asm volatile("" ::: "memory");
                }
            }
    }
};

struct EpiP3 {
    static constexpr bool PERM = true, AFTER_DRAIN = false;
    PutPlain q; PutKm k; PutVt v; PutE e;
    __device__ __forceinline__ void operator()(const f32x4 (&acc)[2][2][4][2], const pg8::Unit& u, int wr, int wc, int fr, int fq) const {
#pragma unroll
        for (int ai = 0; ai < 2; ++ai)
#pragma unroll
            for (int m = 0; m < 4; ++m) {
                const int rin = ai * pg8::HALF + wr * 64 + m * 16 + fr;
#pragma unroll
                for (int bj = 0; bj < 2; ++bj) { const int cin = bj * pg8::HALF + wc * 32 + 8 * fq;
                    if (u.kd == 0) q.put(u.pm, u.pn, rin, cin, acc[ai][bj][m][0], acc[ai][bj][m][1]);
                    else if (u.kd == 1) k.put(u.pm, u.pn, rin, cin, acc[ai][bj][m][0], acc[ai][bj][m][1]);
                    else if (u.kd == 2) v.put(u.pm, u.pn, rin, cin, acc[ai][bj][m][0], acc[ai][bj][m][1]);
                    else e.put(u.pm, u.pn, rin, cin, acc[ai][bj][m][0], acc[ai][bj][m][1]);
                    asm volatile("" ::: "memory"); }
            }
    }
};

struct Params {
    const float* in[36];
    float* out;
    unsigned char* ws;
    int ph_lo, ph_hi, dry, pad;
};
enum { I_X = 0, I_C, I_CTX, I_CCTX, I_WMOD, I_BMOD, I_GPRE, I_GPOST, I_WIN, I_WOUT, I_GCQ, I_WUQ, I_GCKV, I_WUKV, I_GQ, I_GK,
       I_LRE, I_LIM, I_LSTEP, I_BRE, I_BIM, I_CRE, I_CIM, I_SSMD, I_GLUW, I_GLUB, I_HCW, I_HCB, I_HW1, I_HB1, I_HF1, I_HW2, I_HB2, I_HF2, I_HW3, I_HBIAS };

typedef __attribute__((address_space(4))) const unsigned long long* kargp_t;
struct Ctx {
    LAS unsigned char* lds;
    kargp_t ka;
    unsigned char* ws;
    int tid, lane, wave, G, bid, dry;
};
#define KIN(i) ((const float*)(GAS const float*)c.ka[(i)])
#define KOUT() ((float*)(GAS float*)c.ka[36])
template <class T> __device__ __forceinline__ T* wsp(const Ctx& c, size_t off) { return (T*)(c.ws + off); }

__device__ __forceinline__ int wmap(int kind, int n) {
    if (kind == 0) { if (n < 192) return n; if (n < 224) return 320 + (n - 192); if (n < 256) return -1; if (n < 384) return 192 + (n - 256); if (n < 512) return -1; return n - 160; }
    if (kind == 2) return (n >> 6) * 128 + (n & 63);
    if (kind == 3) return (n >> 6) * 128 + 64 + (n & 63);
    return n;
}
__device__ __forceinline__ void wconv_tile(const Ctx& c, const float* src, int Ks, int Ns, int Nlim, bf16_t* dst, int Kp, int kind, int nt, int kt) {
    LAS float* T = (LAS float*)c.lds;
    const int n0 = nt * 64, k0 = kt * 128;
    const int nn = c.tid & 63, kk0 = c.tid >> 6; const int n = n0 + nn; const int sc = (n < Nlim) ? wmap(kind, n) : -1;
    float v[16];
#pragma unroll
    for (int i = 0; i < 16; ++i) { const int k = k0 + kk0 + 8 * i; v[i] = (k < Ks && sc >= 0) ? src[(size_t)k * Ns + sc] : 0.f; }
#pragma unroll
    for (int i = 0; i < 16; ++i) T[(kk0 + 8 * i) * 65 + nn] = v[i];
    __syncthreads();
#pragma unroll
    for (int i = 0; i < 2; ++i) { const int e = c.tid + i * 512, row = e >> 4, pc = e & 15; float x[8];
#pragma unroll
        for (int j = 0; j < 8; ++j) x[j] = T[(pc * 8 + j) * 65 + row];
        u32x4 w; w.x = cvt_pk_bf16(x[0], x[1]); w.y = cvt_pk_bf16(x[2], x[3]); w.z = cvt_pk_bf16(x[4], x[5]); w.w = cvt_pk_bf16(x[6], x[7]);
        *(u32x4*)(dst + (size_t)(n0 + row) * Kp + k0 + pc * 8) = w; }
    __syncthreads();
}

__device__ __forceinline__ void modv_job(const Ctx& c, int job) {
    const int l = job / 48, j0 = (job % 48) * 64;
    LAS float* sc = (LAS float*)c.lds;
    LAS float* red = sc + 17 * 1024;
    const float* cv = KIN(I_C); const float* cc = KIN(I_CCTX);
    for (int e = c.tid; e < 17 * 1024; e += 512) { const int r = e >> 10, k = e & 1023; const float v = (r < 16) ? cv[r * 1024 + k] : cc[k]; sc[e] = siluf(v); }
    __syncthreads();
    const int col = c.tid & 63, ks = c.tid >> 6;
    const float* w = KIN(I_WMOD) + (size_t)l * 1024 * 3072 + j0 + col;
    float acc[17];
#pragma unroll
    for (int r = 0; r < 17; ++r) acc[r] = 0.f;
    for (int k = ks * 128; k < ks * 128 + 128; ++k) { const float wv = w[(size_t)k * 3072];
#pragma unroll
        for (int r = 0; r < 17; ++r) acc[r] += sc[r * 1024 + k] * wv; }
#pragma unroll
    for (int r = 0; r < 17; ++r) red[(ks * 17 + r) * 64 + col] = acc[r];
    __syncthreads();
    float* mv = wsp<float>(c, WS_MODV);
    for (int e = c.tid; e < 17 * 64; e += 512) { const int r = e >> 6, cl = e & 63; float s = KIN(I_BMOD)[l * 3072 + j0 + cl];
#pragma unroll
        for (int q = 0; q < 8; ++q) s += red[(q * 17 + r) * 64 + cl];
        mv[((size_t)l * 17 + r) * 3072 + j0 + cl] = s; }
    __syncthreads();
}

__device__ __forceinline__ void rope_job(const Ctx& c) {
    float* rg = wsp<float>(c, WS_ROPEG); float* rm = wsp<float>(c, WS_ROPEM);
    for (int e = c.tid; e < 64 * 16; e += 512) { const int pos = e >> 4, f = e & 15; const float inv = powf(10000.f, -(float)(2 * f) / 32.f); const float a = (float)pos * inv; rg[e * 2] = cosf(a); rg[e * 2 + 1] = sinf(a); }
    for (int e = c.tid; e < 64 * 8; e += 512) { const int pos = e >> 3, f = e & 7; const float inv = powf(10000.f, -(float)(2 * f) / 16.f); const float a = (float)pos * inv; rm[e * 2] = cosf(a); rm[e * 2 + 1] = sinf(a); }
}

typedef float cpx __attribute__((ext_vector_type(2)));
#define CPX(a, b) ((cpx){(a), (b)})
__device__ __forceinline__ cpx cmul(cpx a, cpx b) { return CPX(a.x * b.x - a.y * b.y, a.x * b.y + a.y * b.x); }
__device__ __forceinline__ void ssm_tables_job(const Ctx& c, int job) {
    const int l = job >> 4, g = job & 15;
    LAS cpx* apow = (LAS cpx*)c.lds;
    LAS cpx* bbar = apow + 2 * 17 * 64;
    LAS cpx* cm = bbar + 2 * 64 * 16;
    LAS float* Kc = (LAS float*)(cm + 2 * 16 * 64);
    for (int e = c.tid; e < 2 * 64; e += 512) {
        const int d = e >> 6, p = e & 63; const size_t ix = (((size_t)l * 2 + d) * 16 + g) * 64 + p;
        const float lr = KIN(I_LRE)[ix], li = KIN(I_LIM)[ix], st = expf(KIN(I_LSTEP)[((size_t)l * 2 + d) * 16 + g]);
        for (int k = 0; k <= 16; ++k) { const float m = expf(lr * st * (float)k), an = li * st * (float)k; apow[(d * 17 + k) * 64 + p] = CPX(m * cosf(an), m * sinf(an)); }
    }
    __syncthreads();
    for (int e = c.tid; e < 2 * 64 * 16; e += 512) {
        const int d = e >> 10, p = (e >> 4) & 63, h = e & 15; const size_t ix = (((size_t)l * 2 + d) * 16 + g) * 64 + p;
        const float lr = KIN(I_LRE)[ix], li = KIN(I_LIM)[ix];
        const cpx a = apow[(d * 17 + 1) * 64 + p]; const cpx am1 = CPX(a.x - 1.f, a.y);
        const float den = lr * lr + li * li; const cpx q = CPX((am1.x * lr + am1.y * li) / den, (am1.y * lr - am1.x * li) / den);
        const cpx b = CPX(KIN(I_BRE)[ix * 16 + h], KIN(I_BIM)[ix * 16 + h]);
        bbar[e] = cmul(q, b);
        const size_t cx = ((((size_t)l * 2 + d) * 16 + g) * 16 + h) * 64 + p;
        cm[(d * 16 + h) * 64 + p] = CPX(KIN(I_CRE)[cx], KIN(I_CIM)[cx]);
    }
    __syncthreads();
    for (int e = c.tid; e < 2 * 16 * 256; e += 512) {
        const int d = e >> 12, dd = (e >> 8) & 15, ho = (e >> 4) & 15, hi = e & 15; float s = 0.f;
        for (int p = 0; p < 64; ++p) { const cpx w = cmul(cm[(d * 16 + ho) * 64 + p], apow[(d * 17 + dd) * 64 + p]); const cpx b = bbar[(d * 64 + p) * 16 + hi]; s += w.x * b.x - w.y * b.y; }
        Kc[e] = s;
    }
    __syncthreads();
    bf16_t* wkc = wsp<bf16_t>(c, WS_WKC) + ((size_t)l * 16 + g) * 256 * 512;
    for (int e = c.tid; e < 256 * 512; e += 512) {
        const int r = e >> 9, q = e & 511, i = r >> 4, ho = r & 15; float v;
        if (q < 256) { const int j = q >> 4, hi = q & 15; v = 0.f; if (j <= i) v += Kc[((0 * 16 + (i - j)) * 16 + ho) * 16 + hi]; if (j >= i) v += Kc[((1 * 16 + (j - i)) * 16 + ho) * 16 + hi]; }
        else { const int qq = q - 256, dq = qq >> 7, comp = (qq >> 6) & 1, p = qq & 63, k = dq == 0 ? i + 1 : 16 - i; const cpx w = cmul(cm[(dq * 16 + ho) * 64 + p], apow[(dq * 17 + k) * 64 + p]); v = comp == 0 ? w.x : -w.y; }
        wkc[e] = f2bf(v);
    }
    bf16_t* we = wsp<bf16_t>(c, WS_WE) + ((size_t)l * 16 + g) * 256 * 256;
    for (int e = c.tid; e < 256 * 256; e += 512) {
        const int qq = e >> 8, cidx = e & 255, j = cidx >> 4, hi = cidx & 15, dq = qq >> 7, comp = (qq >> 6) & 1, p = qq & 63, k = dq == 0 ? 15 - j : j;
        const cpx w = cmul(apow[(dq * 17 + k) * 64 + p], bbar[(dq * 64 + p) * 16 + hi]);
        we[e] = f2bf(comp == 0 ? w.x : w.y);
    }
    float* a16 = wsp<float>(c, WS_A16);
    for (int e = c.tid; e < 128; e += 512) { const int d = e >> 6, p = e & 63; const cpx a = apow[(d * 17 + 16) * 64 + p]; const size_t ix = ((((size_t)l * 2 + d) * 16 + g) * 64 + p) * 2; a16[ix] = a.x; a16[ix + 1] = a.y; }
    __syncthreads();
}

__device__ __forceinline__ void hyena_mlp_job(const Ctx& c, int job) {
    const int l = job / 136, tt = job % 136;
    const bool isctx = tt >= 128; const int n = isctx ? CTXL : SEQL; const int t0 = isctx ? (tt - 128) * 32 : tt * 32;
    LAS float* z = (LAS float*)c.lds;
    LAS float* h1 = z + 32 * 36;
    LAS float* h2 = h1 + 32 * 64;
    for (int e = c.tid; e < 32 * 33; e += 512) {
        const int ti = e / 33, f = e % 33, t = t0 + ti; float v;
        if (f == 0) v = (float)t / (float)(n - 1);
        else { const int k = (f - 1) & 15; const float band = 1e-4f + (float)k * ((15.f - 1e-4f) / 15.f); const float om = 6.283185307179586f * (float)t / (float)n; v = (f <= 16) ? cosf(band * om) : -sinf(band * om); }
        z[ti * 36 + f] = v;
    }
    __syncthreads();
    for (int e = c.tid; e < 32 * 64; e += 512) {
        const int ti = e >> 6, j = e & 63; float s = KIN(I_HB1)[l * 64 + j];
        for (int f = 0; f < 33; ++f) s += z[ti * 36 + f] * KIN(I_HW1)[((size_t)l * 33 + f) * 64 + j];
        h1[e] = sinf(KIN(I_HF1)[l * 64 + j] * s);
    }
    __syncthreads();
    for (int e = c.tid; e < 32 * 64; e += 512) {
        const int ti = e >> 6, j = e & 63; float s = KIN(I_HB2)[l * 64 + j];
        for (int f = 0; f < 64; ++f) s += h1[ti * 64 + f] * KIN(I_HW2)[((size_t)l * 64 + f) * 64 + j];
        h2[e] = sinf(KIN(I_HF2)[l * 64 + j] * s);
    }
    __syncthreads();
    float* hT = wsp<float>(c, WS_HT) + (size_t)l * 1024 * NTOK;
    const float mind = -3.070113457325394f, maxd = -15.35056728662697f;
#pragma unroll
    for (int cc = 0; cc < 2; ++cc) {
        const int col = c.tid + cc * 512;
        float acc[32];
#pragma unroll
        for (int ti = 0; ti < 32; ++ti) acc[ti] = 0.f;
        for (int f = 0; f < 64; ++f) { const float w = KIN(I_HW3)[((size_t)l * 64 + f) * 1024 + col];
#pragma unroll
            for (int ti = 0; ti < 32; ++ti) acc[ti] += h2[ti * 64 + f] * w; }
        const int ch = col & 255; const float delta = fabsf(mind + (maxd - mind) * (float)ch / 255.f);
        float* dst = hT + (size_t)col * NTOK + (isctx ? SEQL : 0) + t0;
#pragma unroll
        for (int ti = 0; ti < 32; ++ti) { const float tn = (float)(t0 + ti) / (float)(n - 1); dst[ti] = acc[ti] * expf(-tn * delta); }
    }
    __syncthreads();
}

__device__ __forceinline__ void hyena_pack_job(const Ctx& c, int job) {
    const int l = job >> 9, o = (job >> 8) & 1, ch = job & 255;
    const float* hT = wsp<float>(c, WS_HT) + (size_t)l * 1024 * NTOK;
    const float* fw = hT + (size_t)(o * 512 + ch) * NTOK; const float* bw = hT + (size_t)(o * 512 + 256 + ch) * NTOK;
    LAS float* red = (LAS float*)c.lds;
    float fa[8], ba[8];
#pragma unroll
    for (int k = 0; k < 8; ++k) { fa[k] = fw[c.tid + 512 * k]; ba[k] = bw[c.tid + 512 * k]; }
    const float fc = (c.tid < CTXL) ? fw[SEQL + c.tid] : 0.f, bc = (c.tid < CTXL) ? bw[SEQL + c.tid] : 0.f;
    float s0 = 0.f, s1 = fc * fc + bc * bc;
#pragma unroll
    for (int k = 0; k < 8; ++k) s0 += fa[k] * fa[k] + ba[k] * ba[k];
    s0 = wave_sum(s0); s1 = wave_sum(s1);
    if (c.lane == 0) { red[c.wave] = s0; red[8 + c.wave] = s1; }
    __syncthreads();
    float t0 = 0.f, t1 = 0.f;
#pragma unroll
    for (int w = 0; w < 8; ++w) { t0 += red[w]; t1 += red[8 + w]; }
    const float r0 = rsqrtf(t0 + EPS), r1 = rsqrtf(t1 + EPS);
    bf16_t* gr = wsp<bf16_t>(c, WS_GR) + (((size_t)l * 2 + o) * 256 + ch) * 8192;
#pragma unroll
    for (int k = 0; k < 8; ++k) { const int d = c.tid + 512 * k; gr[4095 - d] = f2bf(fa[k] * r0); if (d >= 1) gr[4095 + d] = f2bf(ba[k] * r0); }
    if (c.tid == 0) gr[8191] = 0;
    bf16_t* grc = wsp<bf16_t>(c, WS_GRC) + (((size_t)l * 2 + o) * 256 + ch) * 512;
    if (c.tid < CTXL) { const int d = c.tid; grc[255 - d] = f2bf(fc * r1); if (d >= 1) grc[255 + d] = f2bf(bc * r1); }
    if (c.tid == 0) grc[511] = 0;
    __syncthreads();
}

struct NormItem {
    const float* xin; float* xout; const bf16_t* outb; bf16_t* hb; int b, l, next, lane4; bool isc, dry;
    f32x4 gtp[4], gqs[4], sh[4];
};
__device__ __forceinline__ void norm_load(const NormItem& n, int rowb, f32x4 (&xv)[2][4], u32x2 (&ow)[2][4]) {
#pragma unroll
    for (int rr = 0; rr < 2; ++rr) { const int row = rowb + rr; const size_t j = (size_t)(row - n.b * NTOK);
#pragma unroll
        for (int q = 0; q < 4; ++q) { xv[rr][q] = __builtin_nontemporal_load((const f32x4*)(n.xin + j * DM + q * 256 + n.lane4)); if (n.l >= 0) ow[rr][q] = *(const u32x2*)(n.outb + (size_t)row * DM + q * 256 + n.lane4); } }
}
__device__ __forceinline__ void norm_proc(const NormItem& n, int rowb, f32x4 (&xv)[2][4], const u32x2 (&ow)[2][4]) {
#pragma unroll
    for (int rr = 0; rr < 2; ++rr) {
        const int row = rowb + rr; const size_t j = (size_t)(row - n.b * NTOK);
        if (n.l >= 0) {
            float ov[16]; float ss = 0.f;
#pragma unroll
            for (int q = 0; q < 4; ++q) { ov[q * 4] = lo_bf(ow[rr][q].x); ov[q * 4 + 1] = hi_bf(ow[rr][q].x); ov[q * 4 + 2] = lo_bf(ow[rr][q].y); ov[q * 4 + 3] = hi_bf(ow[rr][q].y); }
#pragma unroll
            for (int i = 0; i < 16; ++i) ss += ov[i] * ov[i];
            ss = wave_sum(ss); const float rs = rsqrtf(ss * (1.f / DM) + EPS);
#pragma unroll
            for (int q = 0; q < 4; ++q)
#pragma unroll
                for (int i = 0; i < 4; ++i) xv[rr][q][i] += n.gtp[q][i] * (ov[q * 4 + i] * rs);
        }
        if ((n.l >= 0 || n.isc) && !n.dry) {
#pragma unroll
            for (int q = 0; q < 4; ++q) __builtin_nontemporal_store(xv[rr][q], (f32x4*)(n.xout + j * DM + q * 256 + n.lane4));
        }
        if (n.next >= 0) {
            float ss = 0.f;
#pragma unroll
            for (int q = 0; q < 4; ++q)
#pragma unroll
                for (int i = 0; i < 4; ++i) ss += xv[rr][q][i] * xv[rr][q][i];
            ss = wave_sum(ss); const float rs = rsqrtf(ss * (1.f / DM) + EPS);
#pragma unroll
            for (int q = 0; q < 4; ++q) { float hv[4];
#pragma unroll
                for (int i = 0; i < 4; ++i) hv[i] = xv[rr][q][i] * rs * n.gqs[q][i] + n.sh[q][i];
                u32x2 w; w.x = cvt_pk_bf16(hv[0], hv[1]); w.y = cvt_pk_bf16(hv[2], hv[3]); *(u32x2*)(n.hb + (size_t)row * DM + q * 256 + n.lane4) = w; }
        }
    }
}
__device__ __forceinline__ void norm_rows(const Ctx& c, int l  , int next  , int r0, int r1  ) {
    NormItem n; n.b = r0 / NTOK; n.isc = (r0 - n.b * NTOK) >= SEQL; n.l = l; n.next = next; n.lane4 = c.lane * 4; n.dry = c.dry != 0;
    if (next < 0 && n.isc) return;
    const int mr = n.isc ? 16 : n.b;
    const float* mvl = wsp<float>(c, WS_MODV) + ((size_t)(l < 0 ? 0 : l) * 17 + mr) * 3072;
    const float* mvn = wsp<float>(c, WS_MODV) + ((size_t)(next < 0 ? 0 : next) * 17 + mr) * 3072;
    const float* gpost = KIN(I_GPOST) + (l < 0 ? 0 : l) * DM; const float* gpre = KIN(I_GPRE) + (next < 0 ? 0 : next) * DM;
    n.outb = wsp<bf16_t>(c, WS_OUTB); n.hb = wsp<bf16_t>(c, WS_HCAT);
    if (n.isc) { float* base = wsp<float>(c, WS_CTXR) + ((ptrdiff_t)n.b * CTXL - SEQL) * DM; n.xout = base; n.xin = (l < 0) ? KIN(I_CTX) + ((ptrdiff_t)n.b * CTXL - SEQL) * DM : base; }
    else { float* base = KOUT() + (size_t)n.b * SEQL * DM; n.xout = base; n.xin = (l <= 0) ? KIN(I_X) + (size_t)n.b * SEQL * DM : base; }
#pragma unroll
    for (int q = 0; q < 4; ++q) { const int col = q * 256 + n.lane4;
        if (l >= 0) { const f32x4 gp = *(const f32x4*)(gpost + col), gt = *(const f32x4*)(mvl + 2048 + col); n.gtp[q] = gp * gt; } else n.gtp[q] = (f32x4){0.f, 0.f, 0.f, 0.f};
        if (next >= 0) { const f32x4 g = *(const f32x4*)(gpre + col), s1 = *(const f32x4*)(mvn + 1024 + col); n.gqs[q] = g * (s1 + 1.f); n.sh[q] = *(const f32x4*)(mvn + col); }
        else { n.gqs[q] = (f32x4){0.f, 0.f, 0.f, 0.f}; n.sh[q] = (f32x4){0.f, 0.f, 0.f, 0.f}; } }
    f32x4 xa[2][4], xb[2][4]; u32x2 oa[2][4], ob[2][4];
#pragma unroll
    for (int rr = 0; rr < 2; ++rr)
#pragma unroll
        for (int q = 0; q < 4; ++q) { oa[rr][q] = (u32x2){0u, 0u}; ob[rr][q] = (u32x2){0u, 0u}; }
    int rowb = r0 + c.wave * 2;
    norm_load(n, rowb, xa, oa);
    for (; rowb < r1; rowb += 32) {
        norm_load(n, rowb + 16, xb, ob);
        norm_proc(n, rowb, xa, oa);
        if (rowb + 32 < r1) norm_load(n, rowb + 32, xa, oa);
        norm_proc(n, rowb + 16, xb, ob);
    }
}

struct P2Env {
    bf16_t *B0, *B1, *B3; const bf16_t* B4; bf16_t *kr, *kg; const LAS float *ropeM, *ropeG; f32x4 gcq, gckv, gq, gk; int lane; bool dry;
};
__device__ __forceinline__ void p2_load(const P2Env& e, int rowb, u32x2 (&w0)[4], u32x2 (&w1)[4], u32x2 (&w3)[4], u32x2 (&w4)[4]) {
#pragma unroll
    for (int rr = 0; rr < 4; ++rr) { const size_t ro = (size_t)(rowb + rr) * 256 + e.lane * 4;
        w0[rr] = *(const u32x2*)(e.B0 + ro); w1[rr] = *(const u32x2*)(e.B1 + ro); w3[rr] = *(const u32x2*)(e.B3 + ro); w4[rr] = *(const u32x2*)(e.B4 + ro); }
}
__device__ __forceinline__ void p2_proc(const P2Env& e, int rowb, const u32x2 (&w0)[4], const u32x2 (&w1)[4], const u32x2 (&w3)[4], const u32x2 (&w4)[4]) {
    const int lane = e.lane;
#pragma unroll
    for (int rr = 0; rr < 4; ++rr) {
        const int row = rowb + rr;
        const int b = row / NTOK, j = row - b * NTOK; const bool islat = j < SEQL; const int rowpos = (j >> 6) & 63, colpos = j & 63;
        const size_t ro = (size_t)row * 256 + lane * 4;
        const int tm_ = lane & 7, tg_ = lane & 15;
        const LAS float* am = e.ropeM + (((tm_ & 4) ? colpos : rowpos) * 8 + 4 * (tm_ & 1)) * 2; const LAS float* ag = e.ropeG + (((tg_ & 8) ? colpos : rowpos) * 16 + 4 * (tg_ & 3)) * 2;
        const f32x4 rm0 = *(const LAS f32x4*)am, rm1 = *(const LAS f32x4*)(am + 4), rg0 = *(const LAS f32x4*)ag, rg1 = *(const LAS f32x4*)(ag + 4);
        const float rmv[8] = {rm0[0], rm0[1], rm0[2], rm0[3], rm1[0], rm1[1], rm1[2], rm1[3]}, rgv[8] = {rg0[0], rg0[1], rg0[2], rg0[3], rg1[0], rg1[1], rg1[2], rg1[3]};
        {
            const u32x2 w = w0[rr]; float x[4] = {lo_bf(w.x), hi_bf(w.x), lo_bf(w.y), hi_bf(w.y)};
            float ss = (lane < 48) ? (x[0] * x[0] + x[1] * x[1] + x[2] * x[2] + x[3] * x[3]) : 0.f; ss = wave_sum(ss);
            const float rs = rsqrtf(ss * (1.f / 192.f) + EPS);
            float xp[4];
#pragma unroll
            for (int i = 0; i < 4; ++i) xp[i] = swz_xor<2>(x[i]);
            u32x2 o; o.x = 0u; o.y = 0u;
            if (lane < 48) { o.x = cvt_pk_bf16(x[0] * rs * e.gcq[0], x[1] * rs * e.gcq[1]); o.y = cvt_pk_bf16(x[2] * rs * e.gcq[2], x[3] * rs * e.gcq[3]); }
            else if (lane < 56) {
                const int t = lane - 48; float y[4];
                if (islat) { const bool isx2 = (t & 2) != 0;
#pragma unroll
                    for (int i = 0; i < 4; ++i) { const float cs = rmv[2 * i], sn = rmv[2 * i + 1]; y[i] = isx2 ? (xp[i] * sn + x[i] * cs) : (x[i] * cs - xp[i] * sn); } }
                else {
#pragma unroll
                    for (int i = 0; i < 4; ++i) y[i] = x[i]; }
                u32x2 kk; kk.x = cvt_pk_bf16(y[0], y[1]); kk.y = cvt_pk_bf16(y[2], y[3]); *(u32x2*)(e.kr + (size_t)row * 32 + t * 4) = kk;
            }
            if (!e.dry) *(u32x2*)(e.B0 + ro) = o;
        }
        {
            const u32x2 w = w1[rr]; float x[4] = {lo_bf(w.x), hi_bf(w.x), lo_bf(w.y), hi_bf(w.y)};
            float ss = (lane < 32) ? (x[0] * x[0] + x[1] * x[1] + x[2] * x[2] + x[3] * x[3]) : 0.f; ss = wave_sum(ss);
            const float rs = rsqrtf(ss * (1.f / 128.f) + EPS);
            u32x2 o; o.x = 0u; o.y = 0u;
            if (lane < 32) { o.x = cvt_pk_bf16(x[0] * rs * e.gckv[0], x[1] * rs * e.gckv[1]); o.y = cvt_pk_bf16(x[2] * rs * e.gckv[2], x[3] * rs * e.gckv[3]); }
            if (!e.dry) *(u32x2*)(e.B1 + ro) = o;
        }
#pragma unroll
        for (int which = 0; which < 2; ++which) {
            const u32x2 w = which == 0 ? w3[rr] : w4[rr]; float x[4] = {lo_bf(w.x), hi_bf(w.x), lo_bf(w.y), hi_bf(w.y)};
            float ss = x[0] * x[0] + x[1] * x[1] + x[2] * x[2] + x[3] * x[3];
            ss += swz_xor<1>(ss); ss += swz_xor<2>(ss); ss += swz_xor<4>(ss); ss += swz_xor<8>(ss);
            const float rs = rsqrtf(ss * (1.f / 64.f) + EPS);
            const int t = lane & 15; const f32x4 g = which == 0 ? e.gq : e.gk;
#pragma unroll
            for (int i = 0; i < 4; ++i) x[i] = x[i] * rs * g[i];
            float xp[4];
#pragma unroll
            for (int i = 0; i < 4; ++i) xp[i] = swz_xor<4>(x[i]);
            if (islat) { const bool isx2 = (t & 4) != 0;
#pragma unroll
                for (int i = 0; i < 4; ++i) { const float cs = rgv[2 * i], sn = rgv[2 * i + 1]; x[i] = isx2 ? (xp[i] * sn + x[i] * cs) : (x[i] * cs - xp[i] * sn); } }
            if (which == 0) { const float qs = 0.125f * LOG2E; u32x2 o; o.x = cvt_pk_bf16(x[0] * qs, x[1] * qs); o.y = cvt_pk_bf16(x[2] * qs, x[3] * qs); if (!e.dry) *(u32x2*)(e.B3 + ro) = o; }
            else if (lane < 32) { u32x2 o; o.x = cvt_pk_bf16(x[0], x[1]); o.y = cvt_pk_bf16(x[2], x[3]); *(u32x2*)(e.kg + ((size_t)(b * 2 + (lane >> 4)) * NTOK + j) * 64 + t * 4) = o; }
        }
    }
}
__device__ __forceinline__ void p2_rows(const Ctx& c, int l) {
    bf16_t* pb = wsp<bf16_t>(c, WS_PB);
    P2Env e; e.B0 = pb; e.B1 = pb + BLKE; e.B3 = pb + 3 * BLKE; e.B4 = pb + 4 * BLKE; e.kr = wsp<bf16_t>(c, WS_KR); e.kg = wsp<bf16_t>(c, WS_KG); e.lane = c.lane; e.dry = c.dry != 0;
    LAS float* tab = (LAS float*)c.lds; e.ropeM = tab; e.ropeG = tab + 1024;
    { const float* srcM = wsp<float>(c, WS_ROPEM); const float* srcG = wsp<float>(c, WS_ROPEG);
      for (int i = c.tid; i < 256; i += 512) ((LAS f32x4*)tab)[i] = *(const f32x4*)(srcM + i * 4);
      for (int i = c.tid; i < 512; i += 512) ((LAS f32x4*)(tab + 1024))[i] = *(const f32x4*)(srcG + i * 4); }
    const int lane = c.lane;
    e.gcq = (lane < 48) ? *(const f32x4*)(KIN(I_GCQ) + l * 192 + lane * 4) : (f32x4){0.f, 0.f, 0.f, 0.f};
    e.gckv = (lane < 32) ? *(const f32x4*)(KIN(I_GCKV) + l * 128 + lane * 4) : (f32x4){0.f, 0.f, 0.f, 0.f};
    e.gq = *(const f32x4*)(KIN(I_GQ) + l * 64 + (lane & 15) * 4); e.gk = *(const f32x4*)(KIN(I_GK) + l * 64 + (lane & 15) * 4);
    __syncthreads();
    const int step = c.G * 8 * 4;
    u32x2 a0[4], a1[4], a3[4], a4[4], b0[4], b1[4], b3[4], b4[4];
    int rowb = (c.bid * 8 + c.wave) * 4;
    if (rowb < MROWS) p2_load(e, rowb, a0, a1, a3, a4);
    for (; rowb < MROWS; rowb += 2 * step) {
        const bool hb = rowb + step < MROWS;
        if (hb) p2_load(e, rowb + step, b0, b1, b3, b4);
        p2_proc(e, rowb, a0, a1, a3, a4);
        if (rowb + 2 * step < MROWS) p2_load(e, rowb + 2 * step, a0, a1, a3, a4);
        if (hb) p2_proc(e, rowb + step, b0, b1, b3, b4);
    }
    __syncthreads();
}
#ifndef PROBE_ABL
#define PROBE_ABL 0
#endif
#ifndef PROBE_GQAONLY
#define PROBE_GQAONLY 0
#endif
template <int DK, bool SUB, bool NOMAX = false, int ABL = 0>
__device__ __forceinline__ bool attn_unit(float (&rowmax)[2], const Ctx& c, const bf16_t* Qp, int qpitch, const bf16_t* Kp, const bf16_t* Vtp, int kt0, int nkt, int nrows,
                                          const bf16_t* gatep, bf16_t* outp, bool rope, int j0, float qscale, const float* ropeM) {
    constexpr int KS = DK / 16, KPC = DK / 8, KPITCH = DK * 2 + 16, KB = 64 * KPITCH, VPITCH = 144, VB = 64 * VPITCH;
    constexpr int KOFF = 0, VOFF = 3 * KB;
    constexpr float LIM = 60.f;
    static_assert(KB % 16 == 0 && VB % 16 == 0, "attention LDS buffer alignment");
    const int tid = c.tid, lane = c.lane, wave = c.wave;
    const int lq_ = opaque(lane), q = lq_ & 31, h = lq_ >> 5;
    LAS unsigned char* lds = c.lds;
    const int rbase = (wave * 64 < nrows) ? wave * 64 : wave * 64 - 256;
    const bool live = wave * 64 < nrows;
    bf16x8 qf[2][KS];
#pragma unroll
    for (int qt = 0; qt < 2; ++qt) {
        const bf16_t* qrow = Qp + (size_t)(rbase + qt * 32 + q) * qpitch + 8 * h;
#pragma unroll
        for (int ks = 0; ks < KS; ++ks) qf[qt][ks] = *(const bf16x8*)(qrow + 16 * ks);
        if (DK == 96) {
            const int jj = j0 + rbase + qt * 32 + q;
#pragma unroll
            for (int ks = 0; ks < KS; ++ks) {
                float x[8]; unpack8(__builtin_bit_cast(u32x4, qf[qt][ks]), x);
                if (ks >= 4) {
                    const int pos = (ks == 4) ? ((jj >> 6) & 63) : (jj & 63);
#pragma unroll
                    for (int e = 0; e < 8; ++e) { const float xp = half_other(x[e], h); const float cs = ropeM[(pos * 8 + e) * 2], sn = ropeM[(pos * 8 + e) * 2 + 1];
                        const float r = h ? (xp * sn + x[e] * cs) : (x[e] * cs - xp * sn); x[e] = rope ? r : x[e]; }
                }
                u32x4 w; w.x = cvt_pk_bf16(x[0] * qscale, x[1] * qscale); w.y = cvt_pk_bf16(x[2] * qscale, x[3] * qscale); w.z = cvt_pk_bf16(x[4] * qscale, x[5] * qscale); w.w = cvt_pk_bf16(x[6] * qscale, x[7] * qscale);
                qf[qt][ks] = __builtin_bit_cast(bf16x8, w);
            }
        }
    }
    f32x16 o00, o01, o10, o11;
#pragma unroll
    for (int i = 0; i < 16; ++i) { o00[i] = 0.f; o01[i] = 0.f; o10[i] = 0.f; o11[i] = 0.f; }
    const float m0 = SUB ? rowmax[0] : 0.f, m1 = SUB ? rowmax[1] : 0.f; float l0 = 0.f, l1 = 0.f;
    float rmax0 = -1e30f, rmax1 = -1e30f;
    const int tq_ = opaque(tid);
    const int kst0 = (tq_ / KPC) * KPITCH + (tq_ % KPC) * 16, kst1 = ((tq_ + 512) / KPC) * KPITCH + ((tq_ + 512) % KPC) * 16;
    const int kgl0 = ((tq_ / KPC) * DK + (tq_ % KPC) * 8) * 2, kgl1 = (((tq_ + 512) / KPC) * DK + ((tq_ + 512) % KPC) * 8) * 2;
    const int vst = (tq_ >> 3) * VPITCH + ((tq_ & 7) >> 1) * 32 + ((tq_ & 7) & 1) * 8, vgl = ((tq_ >> 3) * NTOK + (tq_ & 7) * 8) * 2;
    const bool has2 = (DK == 96) && tq_ < 256;
    const int kfo = q * KPITCH + 16 * h, vfo = q * VPITCH + 16 * h;
    const char* Kc = (const char*)Kp; const char* Vc = (const char*)Vtp;
    u32x4 kreg0, kreg1 = {0u, 0u, 0u, 0u}, vreg;
#define AT_GLOADK(kt) do { if (ABL & 1) break; const char* kb_ = Kc + (size_t)(kt) * (64 * DK * 2); kreg0 = *(const u32x4*)(kb_ + kgl0); if (has2) kreg1 = *(const u32x4*)(kb_ + kgl1); } while (0)
#define AT_GLOADV(kt) do { if (ABL & 1) break; vreg = *(const u32x4*)(Vc + (size_t)(kt) * 128 + vgl); } while (0)
#define AT_WRITEK(bi) do { if (ABL & 1) break; LAS unsigned char* bb = lds + KOFF + (bi) * KB; *(LAS u32x4*)(bb + kst0) = kreg0; if (has2) *(LAS u32x4*)(bb + kst1) = kreg1; } while (0)
#define AT_WRITEV(bi) do { if (ABL & 1) break; LAS u32x2* vd = (LAS u32x2*)(lds + VOFF + (bi) * VB + vst); vd[0] = (u32x2){vreg.x, vreg.y}; vd[2] = (u32x2){vreg.z, vreg.w}; } while (0)
#define AT_KPRE(bi, jh) do { if (KPRE) { const LAS unsigned char* kb_ = lds + KOFF + (bi) * KB + (jh) * 32 * KPITCH + kfo; \
        _Pragma("unroll") for (int ks = 0; ks < KS; ++ks) kf[ks] = *(const LAS bf16x8*)(kb_ + 32 * ks); } } while (0)
#define AT_QK(S0, S1, bi, jh) do { const LAS unsigned char* kb = lds + KOFF + (bi) * KB + (jh) * 32 * KPITCH + kfo; \
        _Pragma("unroll") for (int i = 0; i < 16; ++i) { S0[i] = 0.f; S1[i] = 0.f; } \
        if (!(ABL & 8)) _Pragma("unroll") for (int ks = 0; ks < KS; ++ks) { \
            const bf16x8 a0 = KPRE ? kf[ks] : *(const LAS bf16x8*)(kb + 32 * ks); \
            S0 = __builtin_amdgcn_mfma_f32_32x32x16_bf16(a0, qf[0][ks], S0, 0, 0, 0); \
            S1 = __builtin_amdgcn_mfma_f32_32x32x16_bf16(a0, qf[1][ks], S1, 0, 0, 0); } } while (0)
#define AT_MAX(S, RM) do { if (!SUB && !NOMAX) { _Pragma("unroll") for (int i = 0; i < 16; i += 2) RM = max3_raw(RM, S[i], S[i + 1]); } } while (0)
#define AT_EXP(S, M, L, PK0, PK1) do { float ps = 0.f; \
        _Pragma("unroll") for (int i = 0; i < 16; ++i) { S[i] = (ABL & 2) ? S[i] * 0.001f : __builtin_amdgcn_exp2f(SUB ? S[i] - M : S[i]); ps += S[i]; } \
        L += ps; u32x4 w; \
        w.x = cvt_pk_bf16(S[0], S[1]); w.y = cvt_pk_bf16(S[2], S[3]); w.z = cvt_pk_bf16(S[4], S[5]); w.w = cvt_pk_bf16(S[6], S[7]); PK0 = __builtin_bit_cast(bf16x8, w); \
        w.x = cvt_pk_bf16(S[8], S[9]); w.y = cvt_pk_bf16(S[10], S[11]); w.z = cvt_pk_bf16(S[12], S[13]); w.w = cvt_pk_bf16(S[14], S[15]); PK1 = __builtin_bit_cast(bf16x8, w); } while (0)
#define AT_VLOAD() do { va00 = *(const LAS bf16x8*)(vb); va10 = *(const LAS bf16x8*)(vb + 32 * VPITCH); va01 = *(const LAS bf16x8*)(vb + 32); va11 = *(const LAS bf16x8*)(vb + 32 * VPITCH + 32); } while (0)
#define AT_SUB(SC0, SC1, SN0, SN1, vbi, jh, nbi, njh) do { \
          \
        const LAS unsigned char* vb = lds + VOFF + (vbi) * VB + (jh) * 64 + vfo; \
        bf16x8 va00, va10, va01, va11; \
        if (DK == 64) { AT_VLOAD(); }        \
        AT_MAX(SC0, rmax0); AT_MAX(SC1, rmax1); \
        AT_QK(SN0, SN1, nbi, njh); \
        bf16x8 p00, p01, p10, p11; \
        AT_EXP(SC0, m0, l0, p00, p01); AT_EXP(SC1, m1, l1, p10, p11); \
        if (DK != 64) { AT_VLOAD(); } \
        if (!(ABL & 4)) { \
            o00 = __builtin_amdgcn_mfma_f32_32x32x16_bf16(va00, p00, o00, 0, 0, 0); \
            o01 = __builtin_amdgcn_mfma_f32_32x32x16_bf16(va10, p00, o01, 0, 0, 0); \
            o10 = __builtin_amdgcn_mfma_f32_32x32x16_bf16(va00, p10, o10, 0, 0, 0); \
            o11 = __builtin_amdgcn_mfma_f32_32x32x16_bf16(va10, p10, o11, 0, 0, 0); \
            o00 = __builtin_amdgcn_mfma_f32_32x32x16_bf16(va01, p01, o00, 0, 0, 0); \
            o01 = __builtin_amdgcn_mfma_f32_32x32x16_bf16(va11, p01, o01, 0, 0, 0); \
            o10 = __builtin_amdgcn_mfma_f32_32x32x16_bf16(va01, p11, o10, 0, 0, 0); \
            o11 = __builtin_amdgcn_mfma_f32_32x32x16_bf16(va11, p11, o11, 0, 0, 0); } \
        if (ABL & 4) { asm volatile("" :: "v"(p00), "v"(p01), "v"(p10), "v"(p11), "v"(va00), "v"(va10), "v"(va01), "v"(va11)); } \
        } while (0)
    if (!SUB && !NOMAX && tid == 0) *(volatile LAS unsigned*)(lds + LDS_MISC_OFF + 24) = 0u;
    AT_GLOADK(kt0); AT_GLOADV(kt0); AT_WRITEK(0); AT_WRITEV(0);
    AT_GLOADK(kt0 + 1); AT_WRITEK(1);
    __syncthreads();
    f32x16 sa0, sa1, sb0, sb1;
    constexpr bool KPRE = (DK == 64);
    bf16x8 kf[KS];
    AT_KPRE(0, 0);
    AT_QK(sa0, sa1, 0, 0);
    AT_KPRE(0, 1);
    int kb0 = 0, kb1 = 1, kb2 = 2;
    for (int t = 0; t < nkt; ++t) {
        const int tk = (t + 2 < nkt) ? t + 2 : nkt - 1, tv = (t + 1 < nkt) ? t + 1 : nkt - 1;
        AT_GLOADK(kt0 + tk);
        AT_SUB(sa0, sa1, sb0, sb1, t & 1, 0, kb0, 1);
        AT_KPRE(kb1, 0);
        AT_WRITEK(kb2);
        AT_GLOADV(kt0 + tv);
        AT_SUB(sb0, sb1, sa0, sa1, t & 1, 1, kb1, 0);
        AT_KPRE(kb1, 1);
        AT_WRITEV((t + 1) & 1);
        if (!(ABL & 16)) __syncthreads();
        const int tmp = kb0; kb0 = kb1; kb1 = kb2; kb2 = tmp;
    }
#undef AT_GLOADK
#undef AT_GLOADV
#undef AT_WRITEK
#undef AT_WRITEV
#undef AT_QK
#undef AT_KPRE
#undef AT_MAX
#undef AT_EXP
#undef AT_SUB
#undef AT_VLOAD
    bool bad = false;
    if (!SUB && !NOMAX) { const float r0 = half_max(rmax0), r1 = half_max(rmax1); rowmax[0] = r0; rowmax[1] = r1; const bool b_ = live && !(r0 < LIM && r0 > -LIM && r1 < LIM && r1 > -LIM); volatile LAS unsigned* flg = (volatile LAS unsigned*)(lds + LDS_MISC_OFF + 24); if (__any(b_ ? 1 : 0) && opaque(lane) == 0) *flg = 1u; __syncthreads(); bad = *flg != 0u; __syncthreads(); }
    if (live && !bad) {
        const int le_ = opaque(lane), q = le_ & 31, h = le_ >> 5;
#pragma unroll
        for (int qt = 0; qt < 2; ++qt) {
            const float lr = qt ? l1 : l0; const float lt = half_sum(lr), inv = 1.f / lt;
            const size_t row = (size_t)(rbase + qt * 32 + q);
#pragma unroll
            for (int dt = 0; dt < 2; ++dt)
#pragma unroll
                for (int g4 = 0; g4 < 4; ++g4) {
                    const int dv0 = dt * 32 + 8 * g4 + 4 * h;
                    const u32x2 gw = *(const u32x2*)(gatep + row * 256 + dv0);
                    const float g0 = siluf(lo_bf(gw.x)), g1 = siluf(hi_bf(gw.x)), g2 = siluf(lo_bf(gw.y)), g3 = siluf(hi_bf(gw.y));
                    const f32x16& o = qt ? (dt ? o11 : o10) : (dt ? o01 : o00);
                    u32x2 w; w.x = cvt_pk_bf16(o[4 * g4] * inv * g0, o[4 * g4 + 1] * inv * g1); w.y = cvt_pk_bf16(o[4 * g4 + 2] * inv * g2, o[4 * g4 + 3] * inv * g3);
                    *(u32x2*)(outp + row * DM + dv0) = w;
                }
        }
    }
    return bad;
}

template <int N>
__device__ __forceinline__ void hyena_conv(const Ctx& c, LAS unsigned char* ub, LAS unsigned char* gb, int pass, const bf16_t* xmul  , float bias,
                                           bf16_t* zdst  , const bf16_t* gmul, bf16_t* cat  , float cw0, float cw1, float cw2, float cb  ) {
    constexpr int UP = (N + 256) * 2 + 16, NPAIR = N / 256, OFF8 = N - 8;
    const int lane = c.lane, i16 = lane & 15, kq = lane >> 4;
    for (int pr = c.wave; pr < NPAIR; pr += 8) {
        const int t0 = pr * 256;
        u32x4 xq[2][4], gq[2][4]; bf16_t xl[2][4], xr[2][4];
#pragma unroll
        for (int half = 0; half < 2; ++half)
#pragma unroll
            for (int r = 0; r < 4; ++r) { const int t8 = t0 + half * 128 + 32 * kq + 8 * r; const bf16_t* xp_ = xmul + (size_t)i16 * NTOK + t8; xq[half][r] = *(const u32x4*)xp_;
                xl[half][r] = (t8 > 0) ? xp_[-1] : (bf16_t)0; xr[half][r] = (t8 + 8 < N) ? xp_[8] : (bf16_t)0;
                gq[half][r] = (pass == 1) ? *(const u32x4*)(gmul + (size_t)i16 * NTOK + t8) : (u32x4){0u, 0u, 0u, 0u}; }
        f32x4 acc[2][8];
#pragma unroll
        for (int m = 0; m < 8; ++m) { acc[0][m] = (f32x4){0.f, 0.f, 0.f, 0.f}; acc[1][m] = (f32x4){0.f, 0.f, 0.f, 0.f}; }
        const LAS unsigned char* up = ub + i16 * UP + 256 + kq * 16;
        const LAS unsigned char* gp = gb + (OFF8 - t0 - 8 * i16 + 8 * kq) * 2;
        bf16x8 bfa = *(const LAS bf16x8*)(up - 256), bfb = *(const LAS bf16x8*)(up);
        u32x4 wa = *(const LAS u32x4*)(gp - 256), wb = *(const LAS u32x4*)(gp - 256 + 16);
        for (int s0 = -128; s0 < N; s0 += 32) {
            const int sn = (s0 + 32 < N) ? s0 + 32 : s0;
            const bf16x8 bfan = *(const LAS bf16x8*)(up + sn * 2), bfbn = *(const LAS bf16x8*)(up + sn * 2 + 256);
            const u32x4 wan = *(const LAS u32x4*)(gp + sn * 2), wbn = *(const LAS u32x4*)(gp + sn * 2 + 16);
            const unsigned w[8] = {wa.x, wa.y, wa.z, wa.w, wb.x, wb.y, wb.z, wb.w};
            unsigned sh[7];
#pragma unroll
            for (int k = 0; k < 7; ++k) sh[k] = __builtin_amdgcn_alignbit(w[k + 1], w[k], 16);
#pragma unroll
            for (int m = 0; m < 8; ++m) {
                u32x4 a;
                if (m & 1) { const int d0 = (7 - m) >> 1; a = (u32x4){w[d0], w[d0 + 1], w[d0 + 2], w[d0 + 3]}; }
                else { const int d0 = (6 - m) >> 1; a = (u32x4){sh[d0], sh[d0 + 1], sh[d0 + 2], sh[d0 + 3]}; }
                acc[0][m] = __builtin_amdgcn_mfma_f32_16x16x32_bf16(__builtin_bit_cast(bf16x8, a), bfa, acc[0][m], 0, 0, 0);
                acc[1][m] = __builtin_amdgcn_mfma_f32_16x16x32_bf16(__builtin_bit_cast(bf16x8, a), bfb, acc[1][m], 0, 0, 0);
            }
            bfa = bfan; bfb = bfbn; wa = wan; wb = wbn;
        }
#pragma unroll
        for (int half = 0; half < 2; ++half)
#pragma unroll
            for (int r = 0; r < 4; ++r) {
                const int t8 = t0 + half * 128 + 32 * kq + 8 * r;
                float uu[8], xr8[8], xm[8]; unpack8(*(const LAS u32x4*)(ub + i16 * UP + 256 + t8 * 2), uu); unpack8(xq[half][r], xr8);
                {   float pv = bf2f(xl[half][r]);
#pragma unroll
                    for (int m = 0; m < 8; ++m) { const float nx = (m < 7) ? xr8[m + 1] : bf2f(xr[half][r]); xm[m] = bf2f(f2bf(cw0 * pv + cw1 * xr8[m] + cw2 * nx + cb)); pv = xr8[m]; } }
                float y[8];
#pragma unroll
                for (int m = 0; m < 8; ++m) y[m] = xm[m] * (acc[half][m][r] + bias * uu[m]);
                if (pass == 0) { u32x4 o; o.x = cvt_pk_bf16(y[0], y[1]); o.y = cvt_pk_bf16(y[2], y[3]); o.z = cvt_pk_bf16(y[4], y[5]); o.w = cvt_pk_bf16(y[6], y[7]); *(u32x4*)(zdst + (size_t)i16 * NTOK + t8) = o; }
                else { float gg[8]; unpack8(gq[half][r], gg);
#pragma unroll
                    for (int m = 0; m < 8; ++m) gg[m] = bf2f(f2bf(siluf(gg[m])));
                    u32x4 o; o.x = cvt_pk_bf16(y[0] * gg[0], y[1] * gg[1]); o.y = cvt_pk_bf16(y[2] * gg[2], y[3] * gg[3]); o.z = cvt_pk_bf16(y[4] * gg[4], y[5] * gg[5]); o.w = cvt_pk_bf16(y[6] * gg[6], y[7] * gg[7]);
                    *(u32x4*)(cat + (size_t)i16 * NTOK + t8) = o; }
            }
    }
}
template <int N>
__device__ __forceinline__ void hyena_seq(const Ctx& c, int l, int ch, int toff) {
    constexpr int UP = (N + 256) * 2 + 16;
    LAS unsigned char* ub = c.lds; LAS unsigned char* gb = c.lds + 16 * UP;
    const bf16_t* vv = wsp<bf16_t>(c, WS_HYV) + (size_t)ch * 16 * NTOK + toff;
    bf16_t* vz = wsp<bf16_t>(c, WS_HYZ) + (size_t)ch * 16 * NTOK + toff;
    const bf16_t* x1 = wsp<bf16_t>(c, WS_HYX1) + (size_t)ch * 16 * NTOK + toff;
    const bf16_t* x2 = wsp<bf16_t>(c, WS_HYX2) + (size_t)ch * 16 * NTOK + toff;
    const bf16_t* gm = wsp<bf16_t>(c, WS_HYG) + (size_t)ch * 16 * NTOK + toff;
    bf16_t* cat = wsp<bf16_t>(c, WS_HYY) + (size_t)ch * 16 * NTOK + toff;
    { const int e = c.tid, b = e >> 5, side = (e >> 4) & 1, pc = e & 15; unsigned z = 0u; asm volatile("" : "+v"(z)); *(LAS u32x4*)(ub + b * UP + side * (256 + N * 2) + pc * 16) = (u32x4){z, z, z, z}; }
    for (int pass = 0; pass < 2; ++pass) {
        const bf16_t* gr = (N == SEQL) ? wsp<bf16_t>(c, WS_GR) + (((size_t)l * 2 + pass) * 256 + ch) * 8192 : wsp<bf16_t>(c, WS_GRC) + (((size_t)l * 2 + pass) * 256 + ch) * 512;
        const bf16_t* usrc = pass == 0 ? vv : vz;
        constexpr int NG = (2 * N / 8 + 511) / 512;
        {
            u32x4 t[NG];
#pragma unroll
            for (int k = 0; k < NG; ++k) { const int e = c.tid + k * 512; t[k] = (e < 2 * N / 8) ? *(const u32x4*)(gr + e * 8) : (u32x4){0u, 0u, 0u, 0u}; }
#pragma unroll
            for (int k = 0; k < NG; ++k) { const int e = c.tid + k * 512; if (e < 2 * N / 8) *(LAS u32x4*)(gb + e * 16) = t[k]; }
        }
        if constexpr (N == SEQL) {
#pragma unroll
            for (int k0 = 0; k0 < 16; k0 += 8) {
                u32x4 t[8];
#pragma unroll
                for (int k = 0; k < 8; ++k) t[k] = *(const u32x4*)(usrc + (size_t)(k0 + k) * NTOK + c.tid * 8);
#pragma unroll
                for (int k = 0; k < 8; ++k) *(LAS u32x4*)(ub + (k0 + k) * UP + 256 + c.tid * 16) = t[k];
            }
        } else {
            const int b = c.tid >> 5, pc = c.tid & 31;
            *(LAS u32x4*)(ub + b * UP + 256 + pc * 16) = *(const u32x4*)(usrc + (size_t)b * NTOK + pc * 8);
        }
        __syncthreads();
        const float* hcw = KIN(I_HCW) + (size_t)l * 3 * 768; const float* hcb = KIN(I_HCB) + l * 768;
        if (pass == 0) {
            const float w0 = hcw[ch], w1 = hcw[768 + ch], w2 = hcw[1536 + ch], bs = hcb[ch];
            constexpr int PPT = (N == SEQL) ? 16 : 1;
            u32x4 o[PPT];
#pragma unroll
            for (int k = 0; k < PPT; ++k) { const int b = (N == SEQL) ? k : (c.tid >> 5), pc = (N == SEQL) ? c.tid : (c.tid & 31); const LAS unsigned char* p = ub + b * UP + 256 + pc * 16;
                float x[8]; unpack8(*(const LAS u32x4*)p, x); float pv = bf2f(*(const LAS bf16_t*)(p - 2)); const float nx8 = bf2f(*(const LAS bf16_t*)(p + 16)); float y[8];
#pragma unroll
                for (int m = 0; m < 8; ++m) { const float nx = (m < 7) ? x[m + 1] : nx8; y[m] = w0 * pv + w1 * x[m] + w2 * nx + bs; pv = x[m]; }
                o[k].x = cvt_pk_bf16(y[0], y[1]); o[k].y = cvt_pk_bf16(y[2], y[3]); o[k].z = cvt_pk_bf16(y[4], y[5]); o[k].w = cvt_pk_bf16(y[6], y[7]); }
            __syncthreads();
#pragma unroll
            for (int k = 0; k < PPT; ++k) { const int b = (N == SEQL) ? k : (c.tid >> 5), pc = (N == SEQL) ? c.tid : (c.tid & 31); *(LAS u32x4*)(ub + b * UP + 256 + pc * 16) = o[k]; }
            __syncthreads();
        }
        const float bias = KIN(I_HBIAS)[((size_t)l * 2 + pass) * 256 + ch];
        const int cc = (pass + 1) * 256 + ch;
        hyena_conv<N>(c, ub, gb, pass, pass == 0 ? x1 : x2, bias, vz, gm, cat, hcw[cc], hcw[768 + cc], hcw[1536 + cc], hcb[cc]);
        asm volatile("s_waitcnt vmcnt(0)" ::: "memory");
        __syncthreads();
    }
}

__device__ __forceinline__ void hyena_untranspose(const Ctx& c, int tl0, int tl1) {
    const bf16_t* yT = wsp<bf16_t>(c, WS_HYY); bf16_t* cat = wsp<bf16_t>(c, WS_HCAT);
    LAS bf16_t* T = (LAS bf16_t*)c.lds;
    LAS unsigned* T32 = (LAS unsigned*)c.lds;
    for (int tl = tl0; tl < tl1; ++tl) {
        const int b = tl / 68, j0 = (tl - b * 68) * 64;
        u32x4 pre[4];
#pragma unroll
        for (int k = 0; k < 4; ++k) { const int e = c.tid + k * 512, ch = e >> 3, pc = e & 7; pre[k] = *(const u32x4*)(yT + ((size_t)ch * 16 + b) * NTOK + j0 + pc * 8); }
#pragma unroll
        for (int k = 0; k < 4; ++k) { const int e = c.tid + k * 512, ch = e >> 3, pc = e & 7; LAS unsigned* d = T32 + (ch * 132 + pc * 16) / 4; d[0] = pre[k].x; d[1] = pre[k].y; d[2] = pre[k].z; d[3] = pre[k].w; }
        __syncthreads();
#pragma unroll
        for (int k = 0; k < 4; ++k) { const int e = c.tid + k * 512, t = e >> 5, c0 = (e & 31) * 8; float v[8];
#pragma unroll
            for (int i = 0; i < 8; ++i) v[i] = bf2f(T[(c0 + i) * 66 + t]);
            u32x4 w; w.x = cvt_pk_bf16(v[0], v[1]); w.y = cvt_pk_bf16(v[2], v[3]); w.z = cvt_pk_bf16(v[4], v[5]); w.w = cvt_pk_bf16(v[6], v[7]);
            *(u32x4*)(cat + ((size_t)b * NTOK + j0 + t) * DM + 768 + c0) = w; }
        __syncthreads();
    }
}

__device__ __forceinline__ void ssm_scan_item(const Ctx& c, int l, int item) {
    const int b = item >> 2, g = (item & 3) * 4 + (c.tid >> 7), dq = (c.tid >> 6) & 1, p = c.tid & 63;
    const float* a16 = wsp<float>(c, WS_A16) + ((((size_t)l * 2 + dq) * 16 + g) * 64 + p) * 2;
    const float ar = a16[0], ai = a16[1];
    const bf16_t* E = wsp<bf16_t>(c, WS_E); bf16_t* US = wsp<bf16_t>(c, WS_US);
    float sr = 0.f, si = 0.f;
    for (int st0 = 0; st0 < NCHB; st0 += 8) {
        float er[8], ei[8]; size_t ro[8];
#pragma unroll
        for (int k = 0; k < 8; ++k) { const int st = st0 + k; const int cc = dq == 0 ? (st < 16 ? 256 + st : st - 16) : (st < 16 ? 271 - st : 255 - (st - 16));
            ro[k] = (size_t)g * NCHUNK + (size_t)b * NCHB + cc; er[k] = bf2f(E[ro[k] * 256 + dq * 128 + p]); ei[k] = bf2f(E[ro[k] * 256 + dq * 128 + 64 + p]); }
#pragma unroll
        for (int k = 0; k < 8; ++k) {
            US[ro[k] * 512 + 256 + dq * 128 + p] = f2bf(sr); US[ro[k] * 512 + 256 + dq * 128 + 64 + p] = f2bf(si);
            const float nr = ar * sr - ai * si + er[k], ni = ar * si + ai * sr + ei[k]; sr = nr; si = ni;
        }
    }
}

constexpr int LDS_BYTES = 163840;
constexpr int LDS_MISC = LDS_MISC_OFF;
static_assert(LDS_MISC_OFF == LDS_BYTES - 256, "LDS map");
constexpr int NPRO = 1, NPH = 6, NPHASES = NPRO + DEPTH * NPH;
constexpr int QI_HY = 256, QI_SCAN = 64, QI_ATTL = NB * 8 * 8, QI_SSM2 = 16 * 17, QI_UNT = 272, QI_ATTC = NB * 8, QI_GLU = MROWS / 256;
constexpr int QO_SCAN = QI_HY, QO_ATTL = QO_SCAN + QI_SCAN, QO_SSM2 = QO_ATTL + QI_ATTL, QO_UNT = QO_SSM2 + QI_SSM2, QO_ATTC = QO_UNT + QI_UNT, QO_GLU = QO_ATTC + QI_ATTC, QI_TOTAL = QO_GLU + QI_GLU;
#ifndef PROBE_DUP_MASK
#define PROBE_DUP_MASK 0
#endif
#ifndef PROBE_P4KINDS
#define PROBE_P4KINDS 0x7f
#endif
__device__ __forceinline__ void dep_signal(const Ctx& c, unsigned* cnt) {
    asm volatile("s_waitcnt vmcnt(0)" ::: "memory");
    __syncthreads();
    if (c.tid == 0) { __builtin_amdgcn_fence(__ATOMIC_RELEASE, "agent"); asm volatile("s_waitcnt vmcnt(0)" ::: "memory"); (void)xb_add(cnt, 1u); }
}
__device__ __forceinline__ void dep_signal_wt(const Ctx& c, unsigned* cnt) {
    asm volatile("s_waitcnt vmcnt(0)" ::: "memory");
    __syncthreads();
    if (c.tid == 0) (void)xb_add(cnt, 1u);
}
__device__ __forceinline__ void dep_wait(const Ctx& c, unsigned* cnt, unsigned need, unsigned* tmo) {
    if (c.dry) return;
    if (c.tid == 0) {
        unsigned sp = 0;
        while (xb_ld(cnt) < need) { __builtin_amdgcn_s_sleep(2); if ((++sp & 255u) == 0u) { if (xb_ld(tmo)) break; if (sp > XB_SPIN_CAP) { atomicAdd(tmo, 1u); break; } } }
        __builtin_amdgcn_fence(__ATOMIC_ACQUIRE, "agent");
        asm volatile("s_waitcnt vmcnt(0)" ::: "memory");
    }
    __syncthreads();
}

__global__ void __launch_bounds__(512, 2) mk_fwd(Params prm) {
    extern __shared__ __attribute__((aligned(16))) unsigned char lds_raw[];
    Ctx c; c.lds = (LAS unsigned char*)lds_raw; c.ka = (kargp_t)__builtin_amdgcn_kernarg_segment_ptr(); c.ws = prm.ws; c.tid = threadIdx.x; c.lane = c.tid & 63; c.wave = __builtin_amdgcn_readfirstlane(c.tid >> 6); c.G = gridDim.x; c.bid = blockIdx.x; c.dry = prm.dry;
    const int wave0 = c.wave;
    volatile LAS unsigned* misc = (volatile LAS unsigned*)(c.lds + LDS_MISC);
    if (c.tid < 16) misc[c.tid] = 0u;
    __syncthreads();
    unsigned* ctl = wsp<unsigned>(c, WS_CTL);
    const int lo = prm.ph_lo, hi = prm.ph_hi;
    const bool fused = (hi - lo) > 1;
    XcdBarrier bar; bar.bar = ctl + CW_BAR; bar.x = 0; bar.st = misc;
    if (fused) bar = xcd_barrier_post(ctl + CW_BAR, misc);
#ifndef SITE_MASK
#define SITE_MASK 0x3ff
#endif
#define SITE(n) (((SITE_MASK) >> (n)) & 1)
#define IN(k) (lo <= (k) && (k) < hi)
#define FRESH() do { { kargp_t _k = (kargp_t)__builtin_amdgcn_kernarg_segment_ptr(); asm volatile("" : "+s"(_k)); c.ka = _k; c.ws = (unsigned char*)(GAS unsigned char*)_k[37]; } { int _w = wave0; asm volatile("" : "+s"(_w)); c.wave = _w; c.lane = lane_id_fresh(); c.tid = c.wave * 64 + c.lane; } } while (0)
#define SEAM(k) do { if (IN((k) + 1)) xcd_barrier(bar); } while (0)

    if (SITE(0) && IN(0)) {
        FRESH();
        constexpr int J_MOD = 192, J_HY = 544, J_SSM = 64, J_WIN = 4 * 48 * 8, J_WOUT = 4 * 16 * 8, J_WUQ = 4 * 8 * 2, J_W256 = 4 * 4 * 2, J_NORM = MROWS / 256, J_PACK = 4 * 2 * 256;
        constexpr int J0 = J_MOD, J1 = J0 + J_HY, J2 = J1 + J_SSM, J3 = J2 + J_WIN, J4 = J3 + J_WOUT, J5 = J4 + J_WUQ, J6 = J5 + J_W256, J7 = J6 + J_W256, J8 = J7 + J_W256, J9 = J8 + 1, J10 = J9 + J_NORM, J11 = J10 + J_PACK;
        unsigned* dep = ctl + CW_DEP + DEP_SET * 8;
        unsigned* tmo = ctl + CW_BAR + XB_TMO;
        for (int job = c.bid; job < J11; job += c.G) {
            FRESH();
            if (job < J0) { modv_job(c, job); dep_signal(c, dep); }
            else if (job < J1) { hyena_mlp_job(c, job - J0); dep_signal(c, dep + 64); }
            else if (job < J2) ssm_tables_job(c, job - J1);
            else if (job < J3) { const int r = job - J2, l = r / 384, q = r % 384; wconv_tile(c, KIN(I_WIN) + (size_t)l * DM * INC, DM, INC, INP, wsp<bf16_t>(c, WS_WIN) + (size_t)l * INP * DM, DM, 0, q / 8, q % 8); }
            else if (job < J4) { const int r = job - J3, l = r / 128, q = r % 128; wconv_tile(c, KIN(I_WOUT) + (size_t)l * DM * DM, DM, DM, DM, wsp<bf16_t>(c, WS_WOUT) + (size_t)l * DM * DM, DM, 1, q / 8, q % 8); }
            else if (job < J5) { const int r = job - J4, l = r / 16, q = r % 16; wconv_tile(c, KIN(I_WUQ) + (size_t)l * 192 * 384, 192, 384, 384, wsp<bf16_t>(c, WS_WUQ) + (size_t)l * 512 * 256, 256, 1, q / 2, q % 2); }
            else if (job < J6) { const int r = job - J5, l = r / 8, q = r % 8; wconv_tile(c, KIN(I_WUKV) + (size_t)l * 128 * 512, 128, 512, 256, wsp<bf16_t>(c, WS_WUK) + (size_t)l * 256 * 256, 256, 2, q / 2, q % 2); }
            else if (job < J7) { const int r = job - J6, l = r / 8, q = r % 8; wconv_tile(c, KIN(I_WUKV) + (size_t)l * 128 * 512, 128, 512, 256, wsp<bf16_t>(c, WS_WUV) + (size_t)l * 256 * 256, 256, 3, q / 2, q % 2); }
            else if (job < J8) { const int r = job - J7, l = r / 8, q = r % 8; wconv_tile(c, KIN(I_GLUW) + (size_t)l * 256 * 256, 256, 256, 256, wsp<bf16_t>(c, WS_WGLU) + (size_t)l * 256 * 256, 256, 1, q / 2, q % 2); }
            else if (job < J9) rope_job(c);
            else if (job < J10) { dep_wait(c, dep, J_MOD, tmo); FRESH(); const int t = job - J9; norm_rows(c, -1, 0, t * 256, t * 256 + 256); }
            else { dep_wait(c, dep + 64, J_HY, tmo); FRESH(); hyena_pack_job(c, job - J10); }
        }
        SEAM(0);
    }
    for (int l = 0; l < DEPTH; ++l) {
        const int pbase = NPRO + l * NPH;
        if (SITE(2) && IN(pbase + 0)) {
            FRESH();
            pg8::Gemm g{wsp<bf16_t>(c, WS_HCAT), wsp<bf16_t>(c, WS_WIN) + (size_t)l * INP * DM, MROWS, INP, DM};
            pg8::StaticOrder S; S.init(MROWS, INP, c.G, c.bid);
            EpiInProj E{wsp<bf16_t>(c, WS_PB), wsp<bf16_t>(c, WS_UG), wsp<bf16_t>(c, WS_US), wsp<bf16_t>(c, WS_VTG), wsp<bf16_t>(c, WS_HYV), c.lds + pg8::STAGE_BYTES};
            pg8::gemm_phase(c.lds, g, S, E, c.tid);
            SEAM(pbase + 0);
        }
        if (SITE(3) && IN(pbase + 1)) { FRESH(); p2_rows(c, l); SEAM(pbase + 1); }
        if (SITE(4) && IN(pbase + 2)) {
            FRESH();
            pg8::Gemm g{wsp<bf16_t>(c, WS_PB), wsp<bf16_t>(c, WS_WUQ), MROWS, 512, 256};
            pg8::P3Order S{wsp<bf16_t>(c, WS_PB), wsp<bf16_t>(c, WS_PB) + BLKE, wsp<bf16_t>(c, WS_WUQ) + (size_t)l * 512 * 256, wsp<bf16_t>(c, WS_WUK) + (size_t)l * 256 * 256, wsp<bf16_t>(c, WS_WUV) + (size_t)l * 256 * 256,
                           wsp<bf16_t>(c, WS_UG), wsp<bf16_t>(c, WS_WE) + (size_t)l * 16 * 256 * 256, c.G, c.bid};
            EpiP3 E{{wsp<bf16_t>(c, WS_QM), 384, 384}, {wsp<bf16_t>(c, WS_KM), wsp<bf16_t>(c, WS_KR)}, {wsp<bf16_t>(c, WS_VTM)}, {wsp<bf16_t>(c, WS_E)}};
            pg8::gemm_phase(c.lds, g, S, E, c.tid);
            SEAM(pbase + 2);
        }
        if (SITE(5) && IN(pbase + 3)) {
            FRESH();
            unsigned* qh = ctl + CW_Q + 64 * (l + 4 * (c.dry ? 1 : 0));
            unsigned* dep = ctl + CW_DEP + DEP_SET * (l + 4 * (c.dry ? 1 : 0));
            unsigned* tmo = ctl + CW_BAR + XB_TMO;
            const float* ropeM = wsp<float>(c, WS_ROPEM);
            bool gqa_nomax;
            { float gq_ = fabsf(KIN(I_GQ)[l * 64 + c.lane]), gk_ = fabsf(KIN(I_GK)[l * 64 + c.lane]);
              gq_ = fmaxf(gq_, swz_xor<16>(gq_)); gq_ = fmaxf(gq_, swz_xor<8>(gq_)); gq_ = fmaxf(gq_, swz_xor<4>(gq_)); gq_ = fmaxf(gq_, swz_xor<2>(gq_)); gq_ = fmaxf(gq_, swz_xor<1>(gq_)); gq_ = half_max(gq_);
              gk_ = fmaxf(gk_, swz_xor<16>(gk_)); gk_ = fmaxf(gk_, swz_xor<8>(gk_)); gk_ = fmaxf(gk_, swz_xor<4>(gk_)); gk_ = fmaxf(gk_, swz_xor<2>(gk_)); gk_ = fmaxf(gk_, swz_xor<1>(gk_)); gk_ = half_max(gk_);
              const float bound = 64.f * gq_ * gk_ * 0.125f * LOG2E * 1.01f; gqa_nomax = __builtin_amdgcn_readfirstlane(bound < 50.f ? 1 : 0) != 0; }
#define ATT_CALL(DKV, ...) do { float rowmax_[2] = {0.f, 0.f}; if (attn_unit<DKV, false>(rowmax_, __VA_ARGS__)) { (void)attn_unit<DKV, true>(rowmax_, __VA_ARGS__); } } while (0)
            for (;;) {
                __syncthreads();
                if (c.tid == 0) misc[4] = __hip_atomic_fetch_add(qh, 1u, __ATOMIC_RELAXED, __HIP_MEMORY_SCOPE_AGENT);
                __syncthreads();
                const int it = (int)misc[4];
                if (it >= QI_TOTAL) break;
                FRESH();
                if (c.dry) { const int kd_ = it < QO_SCAN ? 0 : it < QO_ATTL ? 1 : it < QO_SSM2 ? 2 : it < QO_UNT ? 3 : it < QO_ATTC ? 4 : it < QO_GLU ? 5 : 6; if (!((c.dry >> (1 + kd_)) & 1)) continue; }
                if (it < QO_SCAN) { hyena_seq<SEQL>(c, l, it, 0); if (l + 1 < DEPTH) hyena_seq<CTXL>(c, l, it, SEQL); dep_signal(c, dep); }
                else if (it < QO_ATTL) { ssm_scan_item(c, l, it - QO_SCAN); dep_signal(c, dep + 64); }
                else if (it >= QO_ATTC && it < QO_GLU && l + 1 == DEPTH) {   }
                else if (it < QO_SSM2 || (it >= QO_ATTC && it < QO_GLU)) {
                    const bool isctx = it >= QO_ATTC; const int r = isctx ? it - QO_ATTC : (it - QO_ATTL) % (NB * 8), blk = isctx ? 8 : (it - QO_ATTL) / (NB * 8)  ;
                    const int kind = r & 1  , head = (r >> 1) & 3, b = r >> 3;
                    const size_t row0 = (size_t)b * NTOK + (isctx ? SEQL : blk * 512); const int kt0 = isctx ? 64 : 0, nkt = isctx ? 4 : 68, nrows = isctx ? 256 : 512;
                    if (kind == 0) { if (c.dry && PROBE_GQAONLY == 1) continue; ATT_CALL(96, c, wsp<bf16_t>(c, WS_QM) + row0 * 384 + head * 96, 384, wsp<bf16_t>(c, WS_KM) + (size_t)(b * 4 + head) * NTOK * 96, wsp<bf16_t>(c, WS_VTM) + (size_t)(b * 4 + head) * 64 * NTOK,
                                                 kt0, nkt, nrows, wsp<bf16_t>(c, WS_PB) + 2 * BLKE + row0 * 256 + head * 64, wsp<bf16_t>(c, WS_HCAT) + row0 * DM + head * 64, !isctx, blk * 512, 0.10206207261596577f * LOG2E, ropeM); }
                    else if (c.dry && PROBE_GQAONLY == 2) { continue; }
                    else if (c.dry && PROBE_ABL) { float rm_[2] = {0.f, 0.f}; (void)attn_unit<64, false, true, PROBE_ABL>(rm_, c, wsp<bf16_t>(c, WS_PB) + 3 * BLKE + row0 * 256 + head * 64, 256, wsp<bf16_t>(c, WS_KG) + (size_t)(b * 2 + (head >> 1)) * NTOK * 64, wsp<bf16_t>(c, WS_VTG) + (size_t)(b * 2 + (head >> 1)) * 64 * NTOK,
                                       kt0, nkt, nrows, wsp<bf16_t>(c, WS_PB) + 5 * BLKE + row0 * 256 + head * 64, wsp<bf16_t>(c, WS_HCAT) + row0 * DM + 256 + head * 64, false, 0, 1.f, ropeM); }
                    else if (gqa_nomax) { float rm_[2] = {0.f, 0.f}; (void)attn_unit<64, false, true>(rm_, c, wsp<bf16_t>(c, WS_PB) + 3 * BLKE + row0 * 256 + head * 64, 256, wsp<bf16_t>(c, WS_KG) + (size_t)(b * 2 + (head >> 1)) * NTOK * 64, wsp<bf16_t>(c, WS_VTG) + (size_t)(b * 2 + (head >> 1)) * 64 * NTOK,
                                       kt0, nkt, nrows, wsp<bf16_t>(c, WS_PB) + 5 * BLKE + row0 * 256 + head * 64, wsp<bf16_t>(c, WS_HCAT) + row0 * DM + 256 + head * 64, false, 0, 1.f, ropeM); }
                    else { ATT_CALL(64, c, wsp<bf16_t>(c, WS_PB) + 3 * BLKE + row0 * 256 + head * 64, 256, wsp<bf16_t>(c, WS_KG) + (size_t)(b * 2 + (head >> 1)) * NTOK * 64, wsp<bf16_t>(c, WS_VTG) + (size_t)(b * 2 + (head >> 1)) * 64 * NTOK,
                                       kt0, nkt, nrows, wsp<bf16_t>(c, WS_PB) + 5 * BLKE + row0 * 256 + head * 64, wsp<bf16_t>(c, WS_HCAT) + row0 * DM + 256 + head * 64, false, 0, 1.f, ropeM); }
                }
                else if (it < QO_UNT) {
                    const int L = it - QO_SSM2, i = L >> 4, g = L & 15;
                    dep_wait(c, dep + 64, QI_SCAN, tmo);
                    pg8::Gemm gm{wsp<bf16_t>(c, WS_US), wsp<bf16_t>(c, WS_WKC) + (size_t)l * 16 * 256 * 512, 16 * NCHUNK, 16 * 256, 512}; pg8::OneUnit S{g * 17 + i, g};
                    pg8::EpiWalk<PutSsmY> E{{wsp<bf16_t>(c, WS_ZS), wsp<bf16_t>(c, WS_UG), KIN(I_SSMD) + l * 256}}; pg8::gemm_phase(c.lds, gm, S, E, c.tid);
                    dep_signal(c, dep + 64 * (2 + i));
                }
                else if (it < QO_ATTC) {
                    dep_wait(c, dep, QI_HY, tmo);
                    const int j = it - QO_UNT; hyena_untranspose(c, 4 * j, 4 * j + 4);
                }
                else {
                    const int pm = it - QO_GLU;
                    dep_wait(c, dep + 64 * (2 + (pm >> 4)), 16u, tmo);
                    pg8::Gemm gm{wsp<bf16_t>(c, WS_ZS), wsp<bf16_t>(c, WS_WGLU) + (size_t)l * 256 * 256, MROWS, 256, 256}; pg8::OneUnit S{pm, 0};
                    pg8::EpiWalk<PutGlu> E{{wsp<bf16_t>(c, WS_HCAT), wsp<bf16_t>(c, WS_ZS), wsp<bf16_t>(c, WS_PB) + 7 * BLKE, KIN(I_GLUB) + l * 256}}; pg8::gemm_phase(c.lds, gm, S, E, c.tid);
                }
            }
            SEAM(pbase + 3);
        }
        if (SITE(6) && IN(pbase + 4)) {
            FRESH();
            const bool lastl = l + 1 == DEPTH;
            constexpr int OPD = 8;
            const int x = c.bid & 7, nsx = (lastl ? NB * 16 : MROWS / 256) / 8;
            const int n1 = 4 * OPD, n2 = n1 + 8 * (nsx - OPD), ntot = n2 + 4 * OPD;
            unsigned* qh = ctl + CW_Q2 + 64 * ((l + 4 * (c.dry ? 1 : 0)) * 8 + x);
            unsigned* c7 = ctl + CW_C7 + 320 * (l + 4 * (c.dry ? 1 : 0));
            unsigned* tmo = ctl + CW_BAR + XB_TMO;
            unsigned pre = 0u;
            if (c.tid == 0) pre = __hip_atomic_fetch_add(qh, 1u, __ATOMIC_RELAXED, __HIP_MEMORY_SCOPE_AGENT);
            for (;;) {
                __syncthreads();
                if (c.tid == 0) { misc[4] = pre; pre = __hip_atomic_fetch_add(qh, 1u, __ATOMIC_RELAXED, __HIP_MEMORY_SCOPE_AGENT); }
                __syncthreads();
                const int it = (int)misc[4];
                if (it >= ntot) break;
                FRESH();
                int i, k;
                if (it < n1) { i = it >> 2; k = it & 3; } else if (it < n2) { const int j = it - n1; i = OPD + (j >> 3); k = j & 7; if (k >= 4) i -= OPD; } else { const int j = it - n2; i = nsx - OPD + (j >> 2); k = 4 + (j & 3); }
                const int s_ = x + 8 * i, pm = lastl ? (s_ >> 4) * 17 + (s_ & 15) : s_;
                if (k < 4) {
                    pg8::Gemm g{wsp<bf16_t>(c, WS_HCAT), wsp<bf16_t>(c, WS_WOUT) + (size_t)l * DM * DM, MROWS, DM, DM}; pg8::OneUnit S{pm, k};
                    pg8::EpiWalk<PutPlainWT> E{{wsp<bf16_t>(c, WS_OUTB), DM, DM}}; pg8::gemm_phase(c.lds, g, S, E, c.tid);
                    dep_signal_wt(c, c7 + s_);
                } else {
                    dep_wait(c, c7 + s_, 4u, tmo);
                    const int r0 = pm * 256 + (k - 4) * 64; norm_rows(c, l, lastl ? -1 : l + 1, r0, r0 + 64);
                }
            }
            if (!lastl) SEAM(pbase + 4);
        }
    }
#undef IN
#undef SEAM
}

extern "C" void kernel_launch(void* const* d_in, const int* in_sizes, int n_in, void* d_out, int out_size, void* d_ws, size_t ws_size, hipStream_t stream) {
    static int grid = 0;
    if (grid == 0) {
        if (n_in != 36 || out_size != NB * SEQL * DM || ws_size < WS_END) { fprintf(stderr, "kernel_launch: unexpected shapes: n_in %d out %d ws %zu (need %zu)\n", n_in, out_size, ws_size, (size_t)WS_END); grid = -1; return; }
        int dev = 0, cus = 0, per_cu = 0;
        if (hipGetDevice(&dev) != hipSuccess || hipDeviceGetAttribute(&cus, hipDeviceAttributeMultiprocessorCount, dev) != hipSuccess) { grid = -1; return; }
        if (hipFuncSetAttribute((const void*)mk_fwd, hipFuncAttributeMaxDynamicSharedMemorySize, LDS_BYTES) != hipSuccess) { fprintf(stderr, "kernel_launch: hipFuncSetAttribute failed\n"); grid = -1; return; }
        if (hipOccupancyMaxActiveBlocksPerMultiprocessor(&per_cu, (const void*)mk_fwd, 512, LDS_BYTES) != hipSuccess || per_cu < 1) { fprintf(stderr, "kernel_launch: occupancy query says %d blocks per CU\n", per_cu); per_cu = 1; }
        (void)hipGetLastError();
        grid = cus;
    }
    if (grid < 0) return;
    (void)hipMemsetAsync((char*)d_ws + WS_CTL, 0, CTL_BYTES, stream);
    Params p{};
    for (int i = 0; i < 36; ++i) p.in[i] = (const float*)d_in[i];
    p.out = (float*)d_out; p.ws = (unsigned char*)d_ws;
#if MK_ONE_LAUNCH
    p.ph_lo = 0; p.ph_hi = NPHASES;
    hipLaunchKernelGGL(mk_fwd, dim3(grid), dim3(512), LDS_BYTES, stream, p);
#else
    for (int k = 0; k < NPHASES; ++k) { p.ph_lo = k; p.ph_hi = k + 1; const int site = k < NPRO ? k : NPRO + (k - NPRO) % NPH;
        if ((PROBE_DUP_MASK >> site) & 1) { p.dry = 1 | (PROBE_P4KINDS << 1); hipLaunchKernelGGL(mk_fwd, dim3(grid), dim3(512), LDS_BYTES, stream, p); p.dry = 0; }
        hipLaunchKernelGGL(mk_fwd, dim3(grid), dim3(512), LDS_BYTES, stream, p); }
#endif
}
```

```cpp
#include <hip/hip_runtime.h>
#include <cstdio>
#include <cstdint>

#ifndef MK_ONE_LAUNCH
#define MK_ONE_LAUNCH 1
#endif

#define LAS __attribute__((address_space(3)))
#define GAS __attribute__((address_space(1)))
typedef unsigned short bf16_t;
typedef short bf16x8 __attribute__((ext_vector_type(8)));
typedef short bf16x4 __attribute__((ext_vector_type(4)));
typedef float f32x4 __attribute__((ext_vector_type(4)));
typedef float f32x16 __attribute__((ext_vector_type(16)));
typedef unsigned u32x4 __attribute__((ext_vector_type(4)));
typedef unsigned u32x2 __attribute__((ext_vector_type(2)));

constexpr int NB = 16, SEQL = 4096, CTXL = 256, NTOK = SEQL + CTXL  , MROWS = NB * NTOK  ;
constexpr int DM = 1024, DEPTH = 4, INC = 2912, INP = 3072;
constexpr int NCHB = NTOK / 16  , NCHUNK = MROWS / 16  ;
constexpr float EPS = 1e-6f;
constexpr float LOG2E = 1.4426950408889634f;
constexpr int LDS_MISC_OFF = 163840 - 256;

constexpr size_t al256(size_t x) { return (x + 255) & ~(size_t)255; }
constexpr size_t WS_CTL = 0;
constexpr size_t CTL_BYTES = 131072;
constexpr size_t WS_MODV = WS_CTL + CTL_BYTES;
constexpr size_t WS_ROPEG = WS_MODV + al256((size_t)4 * 17 * 3072 * 4);
constexpr size_t WS_ROPEM = WS_ROPEG + 64 * 16 * 2 * 4;
constexpr size_t WS_WIN = WS_ROPEM + 64 * 8 * 2 * 4;
constexpr size_t WS_WOUT = WS_WIN + (size_t)4 * 3072 * 1024 * 2;
constexpr size_t WS_WUQ = WS_WOUT + (size_t)4 * 1024 * 1024 * 2;
constexpr size_t WS_WUK = WS_WUQ + (size_t)4 * 512 * 256 * 2;
constexpr size_t WS_WUV = WS_WUK + (size_t)4 * 256 * 256 * 2;
constexpr size_t WS_WGLU = WS_WUV + (size_t)4 * 256 * 256 * 2;
constexpr size_t WS_WE = WS_WGLU + (size_t)4 * 256 * 256 * 2;
constexpr size_t WS_WKC = WS_WE + (size_t)4 * 16 * 256 * 256 * 2;
constexpr size_t WS_A16 = WS_WKC + (size_t)4 * 16 * 256 * 512 * 2;
constexpr size_t WS_GR = WS_A16 + (size_t)4 * 2 * 16 * 64 * 2 * 4;
constexpr size_t WS_GRC = WS_GR + (size_t)4 * 2 * 256 * 8192 * 2;
constexpr size_t WS_CTXR = WS_GRC + (size_t)4 * 2 * 256 * 512 * 2;
constexpr size_t WS_HCAT = WS_CTXR + (size_t)NB * CTXL * DM * 4;
constexpr size_t BLKE = (size_t)MROWS * 256;
constexpr size_t WS_PB = WS_HCAT + (size_t)MROWS * DM * 2;
constexpr size_t WS_KR = WS_PB + 12 * BLKE * 2;
constexpr size_t WS_KG = WS_KR + (size_t)MROWS * 32 * 2;
constexpr size_t WS_VTG = WS_KG + (size_t)32 * NTOK * 64 * 2;
constexpr size_t WS_UG = WS_VTG + (size_t)32 * NTOK * 64 * 2;
constexpr size_t WS_US = WS_UG + BLKE * 2;
constexpr size_t WS_HYV = WS_US + (size_t)16 * NCHUNK * 512 * 2;
constexpr size_t WS_HYX1 = WS_HYV + BLKE * 2;
constexpr size_t WS_HYX2 = WS_HYX1 + BLKE * 2;
constexpr size_t WS_HYG = WS_HYX2 + BLKE * 2;
constexpr size_t WS_HYZ = WS_HYG + BLKE * 2;
constexpr size_t WS_HYY = WS_HYZ + BLKE * 2;
constexpr size_t WS_END = WS_HYY + BLKE * 2;
static_assert(WS_END <= (size_t)1 << 30, "workspace map exceeds 1 GiB");
constexpr size_t WS_QM = WS_PB + 8 * BLKE * 2;
constexpr size_t WS_KM = WS_QM + (size_t)MROWS * 384 * 2;
constexpr size_t WS_VTM = WS_KM + (size_t)MROWS * 384 * 2;
constexpr size_t WS_E = WS_PB + 4 * BLKE * 2;
constexpr size_t WS_ZS = WS_PB + 6 * BLKE * 2;
constexpr size_t WS_OUTB = WS_PB + 8 * BLKE * 2;
constexpr size_t WS_HT = WS_PB;
static_assert(WS_VTM + BLKE * 2 == WS_PB + 12 * BLKE * 2, "alias map");

constexpr int CW_BAR = 0;
constexpr int CW_Q = 4096;
constexpr int CW_TMO = 4096 + 64 * 8;
constexpr int CW_DEP = 5120;
constexpr int DEP_SET = 20 * 64;
constexpr int CW_Q2 = 16384;
constexpr int CW_C7 = 20480;

__device__ __forceinline__ float bf2f(bf16_t v) { return __uint_as_float(((unsigned)v) << 16); }
__device__ __forceinline__ bf16_t f2bf(float f) { unsigned u = __float_as_uint(f); u += 0x7FFFu + ((u >> 16) & 1u); return (bf16_t)(u >> 16); }
__device__ __forceinline__ unsigned cvt_pk_bf16(float lo, float hi) { unsigned r; asm volatile("v_cvt_pk_bf16_f32 %0, %1, %2" : "=v"(r) : "v"(lo), "v"(hi)); return r; }
__device__ __forceinline__ float lo_bf(unsigned w) { return __uint_as_float(w << 16); }
__device__ __forceinline__ float hi_bf(unsigned w) { return __uint_as_float(w & 0xFFFF0000u); }
__device__ __forceinline__ float sigmf(float x) { float one = 1.f; asm volatile("" : "+v"(one)); return __builtin_amdgcn_rcpf(one + __builtin_amdgcn_exp2f(-1.4426950408889634f * x)); }
__device__ __forceinline__ float siluf(float x) { return x * sigmf(x); }
__device__ __forceinline__ float gelu_tanh(float x) { const float u = 0.7978845608028654f * (x + 0.044715f * x * x * x); return x * sigmf(2.f * u); }
__device__ __forceinline__ int opaque(int x) { asm volatile("" : "+v"(x)); return x; }
__device__ __forceinline__ int lane_id_fresh() { int x; asm volatile("v_mbcnt_lo_u32_b32 %0, -1, 0\n\tv_mbcnt_hi_u32_b32 %0, -1, %0" : "=v"(x)); return x; }
__device__ __forceinline__ float max3_raw(float a, float b, float c) { float r; asm("v_max3_f32 %0, %1, %2, %3" : "=v"(r) : "v"(a), "v"(b), "v"(c)); return r; }
template <int M> __device__ __forceinline__ float swz_xor(float v) { return __int_as_float(__builtin_amdgcn_ds_swizzle(__float_as_int(v), 0x1F | (M << 10))); }
__device__ __forceinline__ float half_sum(float v) { auto r = __builtin_amdgcn_permlane32_swap(__float_as_uint(v), __float_as_uint(v), false, false); return __uint_as_float(r[0]) + __uint_as_float(r[1]); }
__device__ __forceinline__ float half_max(float v) { auto r = __builtin_amdgcn_permlane32_swap(__float_as_uint(v), __float_as_uint(v), false, false); return fmaxf(__uint_as_float(r[0]), __uint_as_float(r[1])); }
__device__ __forceinline__ float half_other(float v, int h) { auto r = __builtin_amdgcn_permlane32_swap(__float_as_uint(v), __float_as_uint(v), false, false); return __uint_as_float(h ? r[0] : r[1]); }
__device__ __forceinline__ float wave_sum(float v) {
    v += swz_xor<16>(v); v += swz_xor<8>(v); v += swz_xor<4>(v); v += swz_xor<2>(v); v += swz_xor<1>(v);
    return half_sum(v);
}

#define XB_TMO      128
#define XB_XCNT(j)  (256  + 64 * (j))
#define XB_XSUB(j)  (1280 + 64 * (j))
#define XB_XGEN(j)  (2304 + 64 * (j))
#define XB_TOP      3328
#define XB_TOPGEN   3392
#define XCD_BAR_WORDS 3456
#define XB_SPIN_CAP (1u << 22)
__device__ __forceinline__ unsigned xb_ld(unsigned* p)              { return __hip_atomic_load(p, __ATOMIC_RELAXED, __HIP_MEMORY_SCOPE_AGENT); }
__device__ __forceinline__ unsigned xb_add(unsigned* p, unsigned v) { return __hip_atomic_fetch_add(p, v, __ATOMIC_RELAXED, __HIP_MEMORY_SCOPE_AGENT); }
__device__ __forceinline__ unsigned xb_xcc_id() { return (unsigned)__builtin_amdgcn_s_getreg((3 << 11) | 20) & 0xFu; }
#define XB_SPIN(cond, bar) do { unsigned _sp = 0; while (cond) { __builtin_amdgcn_s_sleep(1); \
    if ((++_sp & 255u) == 0u) { if (xb_ld(&(bar)[XB_TMO])) break; if (_sp > XB_SPIN_CAP) { atomicAdd(&(bar)[XB_TMO], 1u); break; } } } } while (0)
struct XcdBarrier { unsigned* bar; unsigned x; volatile LAS unsigned* st; };
__device__ __forceinline__ XcdBarrier xcd_barrier_post(unsigned* bar, volatile LAS unsigned* st) {
    XcdBarrier b; b.bar = bar; b.x = xb_xcc_id(); b.st = st;
    if (threadIdx.x == 0) (void)xb_add(&bar[XB_XCNT(b.x)], 1u);
    return b;
}
__device__ __forceinline__ void xcd_barrier_complete(unsigned* bar, unsigned x, unsigned& nloc, unsigned& nx) {
    const unsigned G = gridDim.x * gridDim.y * gridDim.z;
    unsigned sum, cnt, mine, sp = 0u;
    for (;;) {
        sum = 0u; cnt = 0u; mine = 0u;
#pragma unroll
        for (unsigned j = 0; j < 16; ++j) { const unsigned c = xb_ld(&bar[XB_XCNT(j)]); sum += c; cnt += (c > 0u) ? 1u : 0u; }
        mine = xb_ld(&bar[XB_XCNT(x)]);
        if (sum == G) break;
        __builtin_amdgcn_s_sleep(1);
        if ((++sp & 255u) == 0u) { if (xb_ld(&bar[XB_TMO])) break; if (sp > XB_SPIN_CAP) { atomicAdd(&bar[XB_TMO], 1u); break; } }
    }
    nloc = mine > 0u ? mine : 1u; nx = cnt > 0u ? cnt : 1u;
}
__device__ __forceinline__ void xcd_barrier(const XcdBarrier& b) {
    asm volatile("s_waitcnt vmcnt(0)" ::: "memory");
    __syncthreads();
    if (threadIdx.x == 0) {
        unsigned* bar = b.bar;
        __builtin_amdgcn_s_waitcnt(0);
        unsigned nloc = b.st[0], nx = b.st[1];
        if (nloc == 0u) { xcd_barrier_complete(bar, b.x, nloc, nx); b.st[0] = nloc; b.st[1] = nx; }
        const unsigned old = xb_add(&bar[XB_XSUB(b.x)], 1u);
        const unsigned gen = old / nloc;
        if (old + 1u == (gen + 1u) * nloc) {
            __builtin_amdgcn_fence(__ATOMIC_RELEASE, "agent");
            asm volatile("s_waitcnt vmcnt(0)" ::: "memory");
            const unsigned og = xb_add(&bar[XB_TOP], 1u);
            const unsigned tg = og / nx;
            if (og + 1u == (tg + 1u) * nx) xb_add(&bar[XB_TOPGEN], 1u);
            else XB_SPIN(xb_ld(&bar[XB_TOPGEN]) == tg, bar);
            __builtin_amdgcn_fence(__ATOMIC_ACQUIRE, "agent");
            xb_add(&bar[XB_XGEN(b.x)], 1u);
            asm volatile("s_waitcnt vmcnt(0)" ::: "memory");
        } else {
            XB_SPIN(xb_ld(&bar[XB_XGEN(b.x)]) == gen, bar);
            __builtin_amdgcn_fence(__ATOMIC_ACQUIRE, "agent");
            asm volatile("s_waitcnt vmcnt(0)" ::: "memory");
        }
    }
    __syncthreads();
}

namespace pg8 {
constexpr int BM = 256, BK = 64, HALF = 128, HTB = HALF * BK * 2, STAGE_BYTES = 8 * HTB, NXCD = 8, WGM = 8;
__host__ __device__ __forceinline__ int lds_byte(int r, int c) { const int st = (r >> 4) * 2 + (c >> 5), rr = r & 15, cc = c & 31, ob = rr * 64 + cc * 2; return st * 1024 + (ob ^ (((ob >> 9) & 1) << 5)); }
__host__ __device__ __forceinline__ void stage_rc(int b, int& R, int& C) { const int st = b / 1024, sb = b % 1024, swz = sb ^ (((sb >> 9) & 1) << 5); R = (st >> 1) * 16 + swz / 64; C = (st & 1) * 32 + (swz % 64) / 2; }
__host__ __device__ __forceinline__ int perm32(int rho) { const int n = rho >> 4, i = rho & 15; return 8 * (i >> 2) + 4 * n + (i & 3); }
struct Unit { int pm, pn, kd; };
struct Gemm { const bf16_t* A; const bf16_t* Bt; int M, N, K; };
struct StaticOrder {
    int nM, nN, nwg, G, c;
    __host__ __device__ void init(int M, int N, int G_, int c_) { nM = M / BM; nN = N / BM; nwg = nM * nN; G = G_; c = c_; }
    __host__ __device__ bool next(int i, Unit& u) const {
        const long L = (long)i * G + c; if (L >= nwg) return false;
        int wgid = (int)L; { const int q = nwg / NXCD, r = nwg % NXCD, xcd = wgid % NXCD, off = wgid / NXCD; wgid = (xcd < r ? xcd * (q + 1) : r * (q + 1) + (xcd - r) * q) + off; }
        const int nig = WGM * nN, gid = wgid / nig, fm = gid * WGM, gsz = (nM - fm) < WGM ? (nM - fm) : WGM;
        u.pm = fm + ((wgid % nig) % gsz); u.pn = (wgid % nig) / gsz; u.kd = 0; return true;
    }
    __device__ __forceinline__ void a_ready(const Unit&) const {}
    __device__ __forceinline__ void done(const Unit&) const {}
    __device__ __forceinline__ const char* abase(const Gemm& g, const Unit& u, size_t tstep) const { return (const char*)g.A + (size_t)u.pm * tstep; }
    __device__ __forceinline__ const char* bbase(const Gemm& g, const Unit& u, size_t tstep) const { return (const char*)g.Bt + (size_t)u.pn * tstep; }
};
struct LiveRowsOrder : StaticOrder {
    bool skip;
    __host__ __device__ void init2(int N, int G_, int c_, bool skip_) { skip = skip_; init(skip_ ? NB * SEQL : MROWS, N, G_, c_); }
    __host__ __device__ bool next(int i, Unit& u) const { if (!StaticOrder::next(i, u)) return false; if (skip) u.pm = (u.pm >> 4) * 17 + (u.pm & 15); return true; }
};
struct BatchedOrder {
    int nwg, G, c, tpg;
    __host__ __device__ void init(int ng, int tpg_, int G_, int c_) { nwg = ng * tpg_; tpg = tpg_; G = G_; c = c_; }
    __host__ __device__ bool next(int i, Unit& u) const { const int L = i * G + c; if (L >= nwg) return false; u.pm = L; u.pn = L / tpg; u.kd = 0; return true; }
    __device__ __forceinline__ void a_ready(const Unit&) const {}
    __device__ __forceinline__ void done(const Unit&) const {}
    __device__ __forceinline__ const char* abase(const Gemm& g, const Unit& u, size_t tstep) const { return (const char*)g.A + (size_t)u.pm * tstep; }
    __device__ __forceinline__ const char* bbase(const Gemm& g, const Unit& u, size_t tstep) const { return (const char*)g.Bt + (size_t)u.pn * tstep; }
};
struct P3Order {
    const bf16_t *b0, *b1, *wuq, *wuk, *wuv, *ug, *we; int G, c;
    __host__ __device__ bool next(int i, Unit& u) const {
        const int L = i * G + c; if (L >= 1360) return false;
        if (L < 544) { u.kd = 0; u.pm = L >> 1; u.pn = L & 1; } else if (L < 816) { u.kd = 1; u.pm = L - 544; u.pn = 0; } else if (L < 1088) { u.kd = 2; u.pm = 0; u.pn = L - 816; } else { u.kd = 3; u.pm = L - 1088; u.pn = (L - 1088) / 17; }
        return true;
    }
    __device__ __forceinline__ void a_ready(const Unit&) const {}
    __device__ __forceinline__ void done(const Unit&) const {}
    __device__ __forceinline__ const char* abase(const Gemm&, const Unit& u, size_t tstep) const { const bf16_t* p = u.kd == 0 ? b0 : u.kd == 1 ? b1 : u.kd == 2 ? wuv : ug; return (const char*)p + (size_t)u.pm * tstep; }
    __device__ __forceinline__ const char* bbase(const Gemm&, const Unit& u, size_t tstep) const { const bf16_t* p = u.kd == 0 ? wuq : u.kd == 1 ? wuk : u.kd == 2 ? b1 : we; return (const char*)p + (size_t)u.pn * tstep; }
};

struct OneUnit {
    int pm, pn;
    __host__ __device__ bool next(int i, Unit& u) const { if (i) return false; u.pm = pm; u.pn = pn; u.kd = 0; return true; }
    __device__ __forceinline__ void a_ready(const Unit&) const {}
    __device__ __forceinline__ void done(const Unit&) const {}
    __device__ __forceinline__ const char* abase(const Gemm& g, const Unit& u, size_t tstep) const { return (const char*)g.A + (size_t)u.pm * tstep; }
    __device__ __forceinline__ const char* bbase(const Gemm& g, const Unit& u, size_t tstep) const { return (const char*)g.Bt + (size_t)u.pn * tstep; }
};
template <class Epi, class Sched>
__device__ __forceinline__ void gemm_phase(LAS unsigned char* lds, const Gemm g, const Sched& S, const Epi& E, int tid_in) {
    const int tid = tid_in, wid = __builtin_amdgcn_readfirstlane(tid >> 6), lane = tid & 63, wr = wid >> 2, wc = wid & 3, fr = lane & 15, fq = lane >> 4;
    const int K = g.K, nt = K / BK;
    unsigned voffA[2], voffB[2];
#pragma unroll
    for (int i = 0; i < 2; ++i) { int R, C; stage_rc(tid * 16 + i * 8192, R, C); const int Rb = Epi::PERM ? ((R & ~31) + perm32(R & 31)) : R;
        voffA[i] = (unsigned)(R * K + C) * 2u; voffB[i] = (unsigned)(Rb * K + C) * 2u; }
    const size_t kstep = (size_t)(BK * 2);
    const size_t hstep = (size_t)HALF * K * 2;
    const size_t tstep = 2 * hstep;
    const unsigned ldsw = (unsigned)wid * 1024u;
    const int aoff = lds_byte(wr * 64 + fr, fq * 8), boff = lds_byte(wc * 32 + fr, fq * 8);
#define PG8_SA(b, h) (((b) * 2 + (h)) * HTB)
#define PG8_SB(b, h) ((4 + (b) * 2 + (h)) * HTB)
#define PG8_STAGE(bufoff, gbase, voff) do { _Pragma("unroll") for (int _i = 0; _i < 2; ++_i) \
        __builtin_amdgcn_global_load_lds((const unsigned*)((const char*)(gbase) + (voff)[_i]), (LAS unsigned*)(lds + (bufoff) + ldsw + _i * 8192), 16, 0, 0); } while (0)
#define PG8_LDA(dst, b, h) do { _Pragma("unroll") for (int m = 0; m < 4; ++m) _Pragma("unroll") for (int k = 0; k < 2; ++k) dst[m][k] = *(const LAS bf16x8*)(lds + PG8_SA(b, h) + aoff + m * 2048 + k * 1024); } while (0)
#define PG8_LDB(dst, b, h) do { _Pragma("unroll") for (int n = 0; n < 2; ++n) _Pragma("unroll") for (int k = 0; k < 2; ++k) dst[n][k] = *(const LAS bf16x8*)(lds + PG8_SB(b, h) + boff + n * 2048 + k * 1024); } while (0)
#define PG8_MMA(ai, bj, At, Bt) do { __builtin_amdgcn_s_setprio(1); _Pragma("unroll") for (int m = 0; m < 4; ++m) _Pragma("unroll") for (int n = 0; n < 2; ++n) _Pragma("unroll") for (int k = 0; k < 2; ++k) \
        acc[ai][bj][m][n] = __builtin_amdgcn_mfma_f32_16x16x32_bf16(Bt[n][k], At[m][k], acc[ai][bj][m][n], 0, 0, 0); __builtin_amdgcn_s_setprio(0); } while (0)
#define PG8_WAIT_V(n) asm volatile("s_waitcnt vmcnt(" #n ")" ::: "memory")
#define PG8_WAIT_L(n) asm volatile("s_waitcnt lgkmcnt(" #n ")" ::: "memory")
#define PG8_BAR __builtin_amdgcn_s_barrier()
#define PG8_SCHED __builtin_amdgcn_sched_barrier(0)
    Unit cur, nxt; int ui = 0;
    if (!S.next(0, cur)) return;
    f32x4 acc[2][2][4][2];
#pragma unroll
    for (int a = 0; a < 2; ++a)
#pragma unroll
        for (int b = 0; b < 2; ++b)
#pragma unroll
            for (int m = 0; m < 4; ++m)
#pragma unroll
                for (int n = 0; n < 2; ++n) acc[a][b][m][n] = (f32x4){0.f, 0.f, 0.f, 0.f};
    bf16x8 At[4][2], B0[2][2], B1[2][2];
    const char* cA = S.abase(g, cur, tstep); const char* cB = S.bbase(g, cur, tstep);
    S.a_ready(cur);
    PG8_STAGE(PG8_SB(0, 0), cB, voffB); PG8_STAGE(PG8_SA(0, 0), cA, voffA); PG8_STAGE(PG8_SB(0, 1), cB + hstep, voffB); PG8_STAGE(PG8_SA(0, 1), cA + hstep, voffA);
    if (wr == 1) PG8_BAR;
    PG8_WAIT_V(4); PG8_BAR;
    PG8_STAGE(PG8_SB(1, 0), cB + kstep, voffB); PG8_STAGE(PG8_SA(1, 0), cA + kstep, voffA); PG8_STAGE(PG8_SB(1, 1), cB + hstep + kstep, voffB);
    PG8_WAIT_V(6); PG8_BAR;
    for (;;) {
        const bool has_next = S.next(ui + 1, nxt);
        const char* nA = has_next ? S.abase(g, nxt, tstep) : cA; const char* nB = has_next ? S.bbase(g, nxt, tstep) : cB;
        for (int t = 0; t < nt; t += 2) {
            const bool last = (t == nt - 2);
            const char* a1 = cA + (size_t)(t + 1) * kstep;
            const char* a2 = last ? nA : cA + (size_t)(t + 2) * kstep; const char* b2 = last ? nB : cB + (size_t)(t + 2) * kstep;
            const char* a3 = a2 + kstep; const char* b3 = b2 + kstep;
            if (last && has_next) S.a_ready(nxt);
            PG8_LDB(B0, 0, 0); PG8_SCHED; PG8_LDA(At, 0, 0); PG8_STAGE(PG8_SA(1, 1), a1 + hstep, voffA);
            PG8_WAIT_L(8); PG8_BAR; PG8_WAIT_L(0); PG8_MMA(0, 0, At, B0); PG8_BAR; PG8_SCHED;
            PG8_LDB(B1, 0, 1); PG8_STAGE(PG8_SB(0, 0), b2, voffB);
            PG8_BAR; PG8_WAIT_L(0); PG8_MMA(0, 1, At, B1); PG8_BAR;
            PG8_LDA(At, 0, 1); PG8_STAGE(PG8_SA(0, 0), a2, voffA);
            PG8_BAR; PG8_WAIT_L(0); PG8_MMA(1, 0, At, B0); PG8_BAR; PG8_SCHED;
            PG8_STAGE(PG8_SB(0, 1), b2 + hstep, voffB);
            PG8_WAIT_V(6); PG8_BAR; PG8_MMA(1, 1, At, B1); PG8_BAR;
            PG8_LDB(B0, 1, 0); PG8_SCHED; PG8_LDA(At, 1, 0); PG8_STAGE(PG8_SA(0, 1), a2 + hstep, voffA);
            PG8_WAIT_L(8); PG8_BAR; PG8_WAIT_L(0); PG8_MMA(0, 0, At, B0); PG8_BAR; PG8_SCHED;
            PG8_LDB(B1, 1, 1); PG8_STAGE(PG8_SB(1, 0), b3, voffB);
            PG8_BAR; PG8_WAIT_L(0); PG8_MMA(0, 1, At, B1); PG8_BAR;
            PG8_LDA(At, 1, 1); PG8_STAGE(PG8_SA(1, 0), a3, voffA);
            PG8_BAR; PG8_WAIT_L(0); PG8_MMA(1, 0, At, B0); PG8_BAR; PG8_SCHED;
            PG8_STAGE(PG8_SB(1, 1), b3 + hstep, voffB);
            PG8_WAIT_V(6); PG8_BAR; PG8_MMA(1, 1, At, B1); PG8_BAR;
        }
        { const int l2 = lane_id_fresh(); E(acc, cur, wr, wc, l2 & 15, l2 >> 4); } S.done(cur);
        if (!has_next) break;
#pragma unroll
        for (int a = 0; a < 2; ++a)
#pragma unroll
            for (int b = 0; b < 2; ++b)
#pragma unroll
                for (int m = 0; m < 4; ++m)
#pragma unroll
                    for (int n = 0; n < 2; ++n) acc[a][b][m][n] = (f32x4){0.f, 0.f, 0.f, 0.f};
        cur = nxt; cA = nA; cB = nB; ++ui;
    }
    PG8_WAIT_V(0);
    if (wr == 0) PG8_BAR;
    PG8_BAR;
#undef PG8_SA
#undef PG8_SB
#undef PG8_STAGE
#undef PG8_LDA
#undef PG8_LDB
#undef PG8_MMA
#undef PG8_WAIT_V
#undef PG8_WAIT_L
#undef PG8_BAR
#undef PG8_SCHED
}

template <class F> struct EpiWalk {
    static constexpr bool PERM = true, AFTER_DRAIN = false;
    F f;
    __device__ __forceinline__ void operator()(const f32x4 (&acc)[2][2][4][2], const Unit& u, int wr, int wc, int fr, int fq) const {
#pragma unroll
        for (int ai = 0; ai < 2; ++ai)
#pragma unroll
            for (int m = 0; m < 4; ++m) {
                const int rin = ai * HALF + wr * 64 + m * 16 + fr;
#pragma unroll
                for (int bj = 0; bj < 2; ++bj) { const int cin = bj * HALF + wc * 32 + 8 * fq; f.put(u.pm, u.pn, rin, cin, acc[ai][bj][m][0], acc[ai][bj][m][1]); asm volatile("" ::: "memory"); }
            }
    }
};
template <class F> struct EpiWalkPF {
    static constexpr bool PERM = true, AFTER_DRAIN = false;
    F f;
    __device__ __forceinline__ void operator()(const f32x4 (&acc)[2][2][4][2], const Unit& u, int wr, int wc, int fr, int fq) const {
        typename F::Inv iv[2];
#pragma unroll
        for (int bj = 0; bj < 2; ++bj) iv[bj] = f.inv(u.pm, u.pn, bj * HALF + wc * 32 + 8 * fq);
#pragma unroll
        for (int ai = 0; ai < 2; ++ai) {
            typename F::Pre pre[4][2];
#pragma unroll
            for (int m = 0; m < 4; ++m)
#pragma unroll
                for (int bj = 0; bj < 2; ++bj) pre[m][bj] = f.pre(u.pm, u.pn, ai * HALF + wr * 64 + m * 16 + fr, bj * HALF + wc * 32 + 8 * fq);
            asm volatile("" ::: "memory");
#pragma unroll
            for (int m = 0; m < 4; ++m) {
                const int rin = ai * HALF + wr * 64 + m * 16 + fr;
#pragma unroll
                for (int bj = 0; bj < 2; ++bj) { const int cin = bj * HALF + wc * 32 + 8 * fq; f.put(u.pm, u.pn, rin, cin, acc[ai][bj][m][0], acc[ai][bj][m][1], pre[m][bj], iv[bj]); asm volatile("" ::: "memory"); }
            }
        }
    }
};
}

__device__ __forceinline__ u32x4 pack8(const f32x4& a, const f32x4& b) {
    u32x4 w; w.x = cvt_pk_bf16(a[0], a[1]); w.y = cvt_pk_bf16(a[2], a[3]); w.z = cvt_pk_bf16(b[0], b[1]); w.w = cvt_pk_bf16(b[2], b[3]); return w;
}
__device__ __forceinline__ void unpack8(const u32x4 w, float (&o)[8]) {
    o[0] = lo_bf(w.x); o[1] = hi_bf(w.x); o[2] = lo_bf(w.y); o[3] = hi_bf(w.y); o[4] = lo_bf(w.z); o[5] = hi_bf(w.z); o[6] = lo_bf(w.w); o[7] = hi_bf(w.w);
}

struct PutPlain {
    bf16_t* dst; int ldc, ncols;
    __device__ __forceinline__ void put(int pm, int pn, int rin, int cin, const f32x4& a, const f32x4& b) const { const int col = pn * 256 + cin; if (col < ncols) *(u32x4*)(dst + ((size_t)pm * 256 + rin) * ldc + col) = pack8(a, b); }
};
struct PutPlainWT {
    bf16_t* dst; int ldc, ncols;
    __device__ __forceinline__ void put(int pm, int pn, int rin, int cin, const f32x4& a, const f32x4& b) const {
        const int col = pn * 256 + cin; const u32x4 w = pack8(a, b); GAS bf16_t* p = (GAS bf16_t*)(dst + ((size_t)pm * 256 + rin) * ldc + col);
        asm volatile("global_store_dwordx4 %0, %1, off sc1" :: "v"(p), "v"(w) : "memory"); }
};
struct PutKm {
    bf16_t* km; const bf16_t* kr;
    __device__ __forceinline__ void put(int pm, int pn, int rin, int cin, const f32x4& a, const f32x4& b) const {
        const int bb = pm / 17, key = (pm - bb * 17) * 256 + rin, hd = cin >> 6, d = cin & 63;
        bf16_t* dst = km + ((size_t)(bb * 4 + hd) * NTOK + key) * 96;
        *(u32x4*)(dst + d) = pack8(a, b);
        if (d < 32) *(u32x4*)(dst + 64 + d) = *(const u32x4*)(kr + ((size_t)pm * 256 + rin) * 32 + d);
    }
};
struct PutVt {
    bf16_t* vt;
    __device__ __forceinline__ void put(int pm, int pn, int rin, int cin, const f32x4& a, const f32x4& b) const {
        const int bb = pn / 17, key = (pn - bb * 17) * 256 + cin;
        *(u32x4*)(vt + ((size_t)(bb * 4 + (rin >> 6)) * 64 + (rin & 63)) * NTOK + key) = pack8(a, b);
    }
};
struct PutE {
    bf16_t* e;
    __device__ __forceinline__ void put(int pm, int pn, int rin, int cin, const f32x4& a, const f32x4& b) const { *(u32x4*)(e + ((size_t)pm * 256 + rin) * 256 + cin) = pack8(a, b); }
};
struct PutSsmY {
    bf16_t* zs; const bf16_t* ug; const float* dskip;
    struct Inv { f32x4 d0, d1; }; typedef u32x4 Pre;
    __device__ __forceinline__ Inv inv(int pm, int pn, int cin) const { const int ch = pn * 16 + (cin & 15); Inv v; v.d0 = *(const f32x4*)(dskip + ch); v.d1 = *(const f32x4*)(dskip + ch + 4); return v; }
    __device__ __forceinline__ Pre pre(int pm, int pn, int rin, int cin) const { const int g = pn, n = (pm - g * 17) * 256 + rin, tok = n * 16 + (cin >> 4), ho = cin & 15; return *(const u32x4*)(ug + ((size_t)g * MROWS + tok) * 16 + ho); }
    __device__ __forceinline__ void put(int pm, int pn, int rin, int cin, const f32x4& a, const f32x4& b, const Pre& pw, const Inv& iv) const {
        const int g = pn, n = (pm - g * 17) * 256 + rin, tok = n * 16 + (cin >> 4), ho = cin & 15, ch = g * 16 + ho;
        float u[8]; unpack8(pw, u);
        f32x4 y0, y1;
#pragma unroll
        for (int i = 0; i < 4; ++i) { y0[i] = gelu_tanh(a[i] + iv.d0[i] * u[i]); y1[i] = gelu_tanh(b[i] + iv.d1[i] * u[4 + i]); }
        *(u32x4*)(zs + (size_t)tok * 256 + ch) = pack8(y0, y1);
    }
};
struct PutGlu {
    bf16_t* cat; const bf16_t* zs; const bf16_t* gate; const float* gb;
    struct Inv { f32x4 b0, b1; }; struct Pre { u32x4 z, g; };
    __device__ __forceinline__ Inv inv(int pm, int pn, int cin) const { Inv v; v.b0 = *(const f32x4*)(gb + cin); v.b1 = *(const f32x4*)(gb + cin + 4); return v; }
    __device__ __forceinline__ Pre pre(int pm, int pn, int rin, int cin) const { const size_t row = (size_t)pm * 256 + rin; Pre r; r.z = *(const u32x4*)(zs + row * 256 + cin); r.g = *(const u32x4*)(gate + row * 256 + cin); return r; }
    __device__ __forceinline__ void put(int pm, int pn, int rin, int cin, const f32x4& a, const f32x4& b, const Pre& pw, const Inv& iv) const {
        const size_t row = (size_t)pm * 256 + rin; const int col = cin;
        float z[8], gt[8]; unpack8(pw.z, z); unpack8(pw.g, gt);
        f32x4 y0, y1;
#pragma unroll
        for (int i = 0; i < 4; ++i) { y0[i] = z[i] * sigmf(a[i] + iv.b0[i]) * siluf(gt[i]); y1[i] = z[4 + i] * sigmf(b[i] + iv.b1[i]) * siluf(gt[4 + i]); }
        *(u32x4*)(cat + row * DM + 512 + col) = pack8(y0, y1);
    }
};

struct EpiInProj {
    static constexpr bool PERM = true, AFTER_DRAIN = false;
    bf16_t *pb, *ug, *us, *vtg, *hy0;
    LAS unsigned char* scratch;
    __device__ __forceinline__ void operator()(const f32x4 (&acc)[2][2][4][2], const pg8::Unit& u, int wr, int wc, int fr, int fq) const {
        const int pn = u.pn, pm = u.pm;
        const int bb = pm / 17, jt = (pm - bb * 17) * 256;
        LAS unsigned char* sw = scratch + (wr * 4 + wc) * 1280;
        const int ln = fq * 16 + fr, tch = ln >> 1, thalf = ln & 1;
#pragma unroll
        for (int ai = 0; ai < 2; ++ai)
#pragma unroll
            for (int m = 0; m < 4; ++m) {
                const int rin = ai * pg8::HALF + wr * 64 + m * 16 + fr;
#pragma unroll
                for (int bj = 0; bj < 2; ++bj) {
                    const int cin = bj * pg8::HALF + wc * 32 + 8 * fq;
                    const u32x4 w = pack8(acc[ai][bj][m][0], acc[ai][bj][m][1]);
                    const bool plain = pn < 4 || pn == 5 || pn == 7 || (pn == 4 && bj == 0);
                    if (plain) { *(u32x4*)(pb + (size_t)pn * BLKE + ((size_t)pm * 256 + rin) * 256 + cin) = w; }
                    else if (pn == 6) { const size_t row = (size_t)pm * 256 + rin; const int g = cin >> 4, hi0 = cin & 15;
                        *(u32x4*)(ug + ((size_t)g * MROWS + row) * 16 + hi0) = w;
                        *(u32x4*)(us + ((size_t)g * NCHUNK + (row >> 4)) * 512 + (row & 15) * 16 + hi0) = w; }
                    else {
                        *(LAS u32x4*)(sw + fr * 80 + fq * 16) = w;
                        asm volatile("" ::: "memory");
                        unsigned short e[8];
#pragma unroll
                        for (int i = 0; i < 8; ++i) e[i] = *(const LAS unsigned short*)(sw + (thalf * 8 + i) * 80 + tch * 2);
                        asm volatile("" ::: "memory");
                        u32x4 t; t.x = e[0] | ((unsigned)e[1] << 16); t.y = e[2] | ((unsigned)e[3] << 16); t.z = e[4] | ((unsigned)e[5] << 16); t.w = e[6] | ((unsigned)e[7] << 16);
                        const int chn = bj * pg8::HALF + wc * 32 + tch;
                        const int tok = jt + ai * pg8::HALF + wr * 64 + m * 16 + thalf * 8;
                        bf16_t* dst = (pn == 4) ? vtg + ((size_t)(bb * 2 + ((chn - 128) >> 6)) * 64 + ((chn - 128) & 63)) * NTOK + tok
                                                : hy0 + (size_t)(pn - 8) * BLKE + ((size_t)chn * 16 + bb) * NTOK + tok;
                        *(u32x4*)dst = t;
                    }
                    asm volatile("" ::: "memory");
                }
            }
    }
};

struct EpiP3 {
    static constexpr bool PERM = true, AFTER_DRAIN = false;
    PutPlain q; PutKm k; PutVt v; PutE e;
    __device__ __forceinline__ void operator()(const f32x4 (&acc)[2][2][4][2], const pg8::Unit& u, int wr, int wc, int fr, int fq) const {
#pragma unroll
        for (int ai = 0; ai < 2; ++ai)
#pragma unroll
            for (int m = 0; m < 4; ++m) {
                const int rin = ai * pg8::HALF + wr * 64 + m * 16 + fr;
#pragma unroll
                for (int bj = 0; bj < 2; ++bj) { const int cin = bj * pg8::HALF + wc * 32 + 8 * fq;
                    if (u.kd == 0) q.put(u.pm, u.pn, rin, cin, acc[ai][bj][m][0], acc[ai][bj][m][1]);
                    else if (u.kd == 1) k.put(u.pm, u.pn, rin, cin, acc[ai][bj][m][0], acc[ai][bj][m][1]);
                    else if (u.kd == 2) v.put(u.pm, u.pn, rin, cin, acc[ai][bj][m][0], acc[ai][bj][m][1]);
                    else e.put(u.pm, u.pn, rin, cin, acc[ai][bj][m][0], acc[ai][bj][m][1]);
                    asm volatile("" ::: "memory"); }
            }
    }
};

struct Params {
    const float* in[36];
    float* out;
    unsigned char* ws;
    int ph_lo, ph_hi, dry, pad;
};
enum { I_X = 0, I_C, I_CTX, I_CCTX, I_WMOD, I_BMOD, I_GPRE, I_GPOST, I_WIN, I_WOUT, I_GCQ, I_WUQ, I_GCKV, I_WUKV, I_GQ, I_GK,
       I_LRE, I_LIM, I_LSTEP, I_BRE, I_BIM, I_CRE, I_CIM, I_SSMD, I_GLUW, I_GLUB, I_HCW, I_HCB, I_HW1, I_HB1, I_HF1, I_HW2, I_HB2, I_HF2, I_HW3, I_HBIAS };

typedef __attribute__((address_space(4))) const unsigned long long* kargp_t;
struct Ctx {
    LAS unsigned char* lds;
    kargp_t ka;
    unsigned char* ws;
    int tid, lane, wave, G, bid, dry;
};
#define KIN(i) ((const float*)(GAS const float*)c.ka[(i)])
#define KOUT() ((float*)(GAS float*)c.ka[36])
template <class T> __device__ __forceinline__ T* wsp(const Ctx& c, size_t off) { return (T*)(c.ws + off); }

__device__ __forceinline__ int wmap(int kind, int n) {
    if (kind == 0) { if (n < 192) return n; if (n < 224) return 320 + (n - 192); if (n < 256) return -1; if (n < 384) return 192 + (n - 256); if (n < 512) return -1; return n - 160; }
    if (kind == 2) return (n >> 6) * 128 + (n & 63);
    if (kind == 3) return (n >> 6) * 128 + 64 + (n & 63);
    return n;
}
__device__ __forceinline__ void wconv_tile(const Ctx& c, const float* src, int Ks, int Ns, int Nlim, bf16_t* dst, int Kp, int kind, int nt, int kt) {
    LAS float* T = (LAS float*)c.lds;
    const int n0 = nt * 64, k0 = kt * 128;
    const int nn = c.tid & 63, kk0 = c.tid >> 6; const int n = n0 + nn; const int sc = (n < Nlim) ? wmap(kind, n) : -1;
    float v[16];
#pragma unroll
    for (int i = 0; i < 16; ++i) { const int k = k0 + kk0 + 8 * i; v[i] = (k < Ks && sc >= 0) ? src[(size_t)k * Ns + sc] : 0.f; }
#pragma unroll
    for (int i = 0; i < 16; ++i) T[(kk0 + 8 * i) * 65 + nn] = v[i];
    __syncthreads();
#pragma unroll
    for (int i = 0; i < 2; ++i) { const int e = c.tid + i * 512, row = e >> 4, pc = e & 15; float x[8];
#pragma unroll
        for (int j = 0; j < 8; ++j) x[j] = T[(pc * 8 + j) * 65 + row];
        u32x4 w; w.x = cvt_pk_bf16(x[0], x[1]); w.y = cvt_pk_bf16(x[2], x[3]); w.z = cvt_pk_bf16(x[4], x[5]); w.w = cvt_pk_bf16(x[6], x[7]);
        *(u32x4*)(dst + (size_t)(n0 + row) * Kp + k0 + pc * 8) = w; }
    __syncthreads();
}

__device__ __forceinline__ void modv_job(const Ctx& c, int job) {
    const int l = job / 48, j0 = (job % 48) * 64;
    LAS float* sc = (LAS float*)c.lds;
    LAS float* red = sc + 17 * 1024;
    const float* cv = KIN(I_C); const float* cc = KIN(I_CCTX);
    for (int e = c.tid; e < 17 * 1024; e += 512) { const int r = e >> 10, k = e & 1023; const float v = (r < 16) ? cv[r * 1024 + k] : cc[k]; sc[e] = siluf(v); }
    __syncthreads();
    const int col = c.tid & 63, ks = c.tid >> 6;
    const float* w = KIN(I_WMOD) + (size_t)l * 1024 * 3072 + j0 + col;
    float acc[17];
#pragma unroll
    for (int r = 0; r < 17; ++r) acc[r] = 0.f;
    for (int k = ks * 128; k < ks * 128 + 128; ++k) { const float wv = w[(size_t)k * 3072];
#pragma unroll
        for (int r = 0; r < 17; ++r) acc[r] += sc[r * 1024 + k] * wv; }
#pragma unroll
    for (int r = 0; r < 17; ++r) red[(ks * 17 + r) * 64 + col] = acc[r];
    __syncthreads();
    float* mv = wsp<float>(c, WS_MODV);
    for (int e = c.tid; e < 17 * 64; e += 512) { const int r = e >> 6, cl = e & 63; float s = KIN(I_BMOD)[l * 3072 + j0 + cl];
#pragma unroll
        for (int q = 0; q < 8; ++q) s += red[(q * 17 + r) * 64 + cl];
        mv[((size_t)l * 17 + r) * 3072 + j0 + cl] = s; }
    __syncthreads();
}

__device__ __forceinline__ void rope_job(const Ctx& c) {
    float* rg = wsp<float>(c, WS_ROPEG); float* rm = wsp<float>(c, WS_ROPEM);
    for (int e = c.tid; e < 64 * 16; e += 512) { const int pos = e >> 4, f = e & 15; const float inv = powf(10000.f, -(float)(2 * f) / 32.f); const float a = (float)pos * inv; rg[e * 2] = cosf(a); rg[e * 2 + 1] = sinf(a); }
    for (int e = c.tid; e < 64 * 8; e += 512) { const int pos = e >> 3, f = e & 7; const float inv = powf(10000.f, -(float)(2 * f) / 16.f); const float a = (float)pos * inv; rm[e * 2] = cosf(a); rm[e * 2 + 1] = sinf(a); }
}

typedef float cpx __attribute__((ext_vector_type(2)));
#define CPX(a, b) ((cpx){(a), (b)})
__device__ __forceinline__ cpx cmul(cpx a, cpx b) { return CPX(a.x * b.x - a.y * b.y, a.x * b.y + a.y * b.x); }
__device__ __forceinline__ void ssm_tables_job(const Ctx& c, int job) {
    const int l = job >> 4, g = job & 15;
    LAS cpx* apow = (LAS cpx*)c.lds;
    LAS cpx* bbar = apow + 2 * 17 * 64;
    LAS cpx* cm = bbar + 2 * 64 * 16;
    LAS float* Kc = (LAS float*)(cm + 2 * 16 * 64);
    for (int e = c.tid; e < 2 * 64; e += 512) {
        const int d = e >> 6, p = e & 63; const size_t ix = (((size_t)l * 2 + d) * 16 + g) * 64 + p;
        const float lr = KIN(I_LRE)[ix], li = KIN(I_LIM)[ix], st = expf(KIN(I_LSTEP)[((size_t)l * 2 + d) * 16 + g]);
        for (int k = 0; k <= 16; ++k) { const float m = expf(lr * st * (float)k), an = li * st * (float)k; apow[(d * 17 + k) * 64 + p] = CPX(m * cosf(an), m * sinf(an)); }
    }
    __syncthreads();
    for (int e = c.tid; e < 2 * 64 * 16; e += 512) {
        const int d = e >> 10, p = (e >> 4) & 63, h = e & 15; const size_t ix = (((size_t)l * 2 + d) * 16 + g) * 64 + p;
        const float lr = KIN(I_LRE)[ix], li = KIN(I_LIM)[ix];
        const cpx a = apow[(d * 17 + 1) * 64 + p]; const cpx am1 = CPX(a.x - 1.f, a.y);
        const float den = lr * lr + li * li; const cpx q = CPX((am1.x * lr + am1.y * li) / den, (am1.y * lr - am1.x * li) / den);
        const cpx b = CPX(KIN(I_BRE)[ix * 16 + h], KIN(I_BIM)[ix * 16 + h]);
        bbar[e] = cmul(q, b);
        const size_t cx = ((((size_t)l * 2 + d) * 16 + g) * 16 + h) * 64 + p;
        cm[(d * 16 + h) * 64 + p] = CPX(KIN(I_CRE)[cx], KIN(I_CIM)[cx]);
    }
    __syncthreads();
    for (int e = c.tid; e < 2 * 16 * 256; e += 512) {
        const int d = e >> 12, dd = (e >> 8) & 15, ho = (e >> 4) & 15, hi = e & 15; float s = 0.f;
        for (int p = 0; p < 64; ++p) { const cpx w = cmul(cm[(d * 16 + ho) * 64 + p], apow[(d * 17 + dd) * 64 + p]); const cpx b = bbar[(d * 64 + p) * 16 + hi]; s += w.x * b.x - w.y * b.y; }
        Kc[e] = s;
    }
    __syncthreads();
    bf16_t* wkc = wsp<bf16_t>(c, WS_WKC) + ((size_t)l * 16 + g) * 256 * 512;
    for (int e = c.tid; e < 256 * 512; e += 512) {
        const int r = e >> 9, q = e & 511, i = r >> 4, ho = r & 15; float v;
        if (q < 256) { const int j = q >> 4, hi = q & 15; v = 0.f; if (j <= i) v += Kc[((0 * 16 + (i - j)) * 16 + ho) * 16 + hi]; if (j >= i) v += Kc[((1 * 16 + (j - i)) * 16 + ho) * 16 + hi]; }
        else { const int qq = q - 256, dq = qq >> 7, comp = (qq >> 6) & 1, p = qq & 63, k = dq == 0 ? i + 1 : 16 - i; const cpx w = cmul(cm[(dq * 16 + ho) * 64 + p], apow[(dq * 17 + k) * 64 + p]); v = comp == 0 ? w.x : -w.y; }
        wkc[e] = f2bf(v);
    }
    bf16_t* we = wsp<bf16_t>(c, WS_WE) + ((size_t)l * 16 + g) * 256 * 256;
    for (int e = c.tid; e < 256 * 256; e += 512) {
        const int qq = e >> 8, cidx = e & 255, j = cidx >> 4, hi = cidx & 15, dq = qq >> 7, comp = (qq >> 6) & 1, p = qq & 63, k = dq == 0 ? 15 - j : j;
        const cpx w = cmul(apow[(dq * 17 + k) * 64 + p], bbar[(dq * 64 + p) * 16 + hi]);
        we[e] = f2bf(comp == 0 ? w.x : w.y);
    }
    float* a16 = wsp<float>(c, WS_A16);
    for (int e = c.tid; e < 128; e += 512) { const int d = e >> 6, p = e & 63; const cpx a = apow[(d * 17 + 16) * 64 + p]; const size_t ix = ((((size_t)l * 2 + d) * 16 + g) * 64 + p) * 2; a16[ix] = a.x; a16[ix + 1] = a.y; }
    __syncthreads();
}

__device__ __forceinline__ void hyena_mlp_job(const Ctx& c, int job) {
    const int l = job / 136, tt = job % 136;
    const bool isctx = tt >= 128; const int n = isctx ? CTXL : SEQL; const int t0 = isctx ? (tt - 128) * 32 : tt * 32;
    LAS float* z = (LAS float*)c.lds;
    LAS float* h1 = z + 32 * 36;
    LAS float* h2 = h1 + 32 * 64;
    for (int e = c.tid; e < 32 * 33; e += 512) {
        const int ti = e / 33, f = e % 33, t = t0 + ti; float v;
        if (f == 0) v = (float)t / (float)(n - 1);
        else { const int k = (f - 1) & 15; const float band = 1e-4f + (float)k * ((15.f - 1e-4f) / 15.f); const float om = 6.283185307179586f * (float)t / (float)n; v = (f <= 16) ? cosf(band * om) : -sinf(band * om); }
        z[ti * 36 + f] = v;
    }
    __syncthreads();
    for (int e = c.tid; e < 32 * 64; e += 512) {
        const int ti = e >> 6, j = e & 63; float s = KIN(I_HB1)[l * 64 + j];
        for (int f = 0; f < 33; ++f) s += z[ti * 36 + f] * KIN(I_HW1)[((size_t)l * 33 + f) * 64 + j];
        h1[e] = sinf(KIN(I_HF1)[l * 64 + j] * s);
    }
    __syncthreads();
    for (int e = c.tid; e < 32 * 64; e += 512) {
        const int ti = e >> 6, j = e & 63; float s = KIN(I_HB2)[l * 64 + j];
        for (int f = 0; f < 64; ++f) s += h1[ti * 64 + f] * KIN(I_HW2)[((size_t)l * 64 + f) * 64 + j];
        h2[e] = sinf(KIN(I_HF2)[l * 64 + j] * s);
    }
    __syncthreads();
    float* hT = wsp<float>(c, WS_HT) + (size_t)l * 1024 * NTOK;
    const float mind = -3.070113457325394f, maxd = -15.35056728662697f;
#pragma unroll
    for (int cc = 0; cc < 2; ++cc) {
        const int col = c.tid + cc * 512;
        float acc[32];
#pragma unroll
        for (int ti = 0; ti < 32; ++ti) acc[ti] = 0.f;
        for (int f = 0; f < 64; ++f) { const float w = KIN(I_HW3)[((size_t)l * 64 + f) * 1024 + col];
#pragma unroll
            for (int ti = 0; ti < 32; ++ti) acc[ti] += h2[ti * 64 + f] * w; }
        const int ch = col & 255; const float delta = fabsf(mind + (maxd - mind) * (float)ch / 255.f);
        float* dst = hT + (size_t)col * NTOK + (isctx ? SEQL : 0) + t0;
#pragma unroll
        for (int ti = 0; ti < 32; ++ti) { const float tn = (float)(t0 + ti) / (float)(n - 1); dst[ti] = acc[ti] * expf(-tn * delta); }
    }
    __syncthreads();
}

__device__ __forceinline__ void hyena_pack_job(const Ctx& c, int job) {
    const int l = job >> 9, o = (job >> 8) & 1, ch = job & 255;
    const float* hT = wsp<float>(c, WS_HT) + (size_t)l * 1024 * NTOK;
    const float* fw = hT + (size_t)(o * 512 + ch) * NTOK; const float* bw = hT + (size_t)(o * 512 + 256 + ch) * NTOK;
    LAS float* red = (LAS float*)c.lds;
    float fa[8], ba[8];
#pragma unroll
    for (int k = 0; k < 8; ++k) { fa[k] = fw[c.tid + 512 * k]; ba[k] = bw[c.tid + 512 * k]; }
    const float fc = (c.tid < CTXL) ? fw[SEQL + c.tid] : 0.f, bc = (c.tid < CTXL) ? bw[SEQL + c.tid] : 0.f;
    float s0 = 0.f, s1 = fc * fc + bc * bc;
#pragma unroll
    for (int k = 0; k < 8; ++k) s0 += fa[k] * fa[k] + ba[k] * ba[k];
    s0 = wave_sum(s0); s1 = wave_sum(s1);
    if (c.lane == 0) { red[c.wave] = s0; red[8 + c.wave] = s1; }
    __syncthreads();
    float t0 = 0.f, t1 = 0.f;
#pragma unroll
    for (int w = 0; w < 8; ++w) { t0 += red[w]; t1 += red[8 + w]; }
    const float r0 = rsqrtf(t0 + EPS), r1 = rsqrtf(t1 + EPS);
    bf16_t* gr = wsp<bf16_t>(c, WS_GR) + (((size_t)l * 2 + o) * 256 + ch) * 8192;
#pragma unroll
    for (int k = 0; k < 8; ++k) { const int d = c.tid + 512 * k; gr[4095 - d] = f2bf(fa[k] * r0); if (d >= 1) gr[4095 + d] = f2bf(ba[k] * r0); }
    if (c.tid == 0) gr[8191] = 0;
    bf16_t* grc = wsp<bf16_t>(c, WS_GRC) + (((size_t)l * 2 + o) * 256 + ch) * 512;
    if (c.tid < CTXL) { const int d = c.tid; grc[255 - d] = f2bf(fc * r1); if (d >= 1) grc[255 + d] = f2bf(bc * r1); }
    if (c.tid == 0) grc[511] = 0;
    __syncthreads();
}

struct NormItem {
    const float* xin; float* xout; const bf16_t* outb; bf16_t* hb; int b, l, next, lane4; bool isc, dry;
    f32x4 gtp[4], gqs[4], sh[4];
};
__device__ __forceinline__ void norm_load(const NormItem& n, int rowb, f32x4 (&xv)[2][4], u32x2 (&ow)[2][4]) {
#pragma unroll
    for (int rr = 0; rr < 2; ++rr) { const int row = rowb + rr; const size_t j = (size_t)(row - n.b * NTOK);
#pragma unroll
        for (int q = 0; q < 4; ++q) { xv[rr][q] = __builtin_nontemporal_load((const f32x4*)(n.xin + j * DM + q * 256 + n.lane4)); if (n.l >= 0) ow[rr][q] = *(const u32x2*)(n.outb + (size_t)row * DM + q * 256 + n.lane4); } }
}
__device__ __forceinline__ void norm_proc(const NormItem& n, int rowb, f32x4 (&xv)[2][4], const u32x2 (&ow)[2][4]) {
#pragma unroll
    for (int rr = 0; rr < 2; ++rr) {
        const int row = rowb + rr; const size_t j = (size_t)(row - n.b * NTOK);
        if (n.l >= 0) {
            float ov[16]; float ss = 0.f;
#pragma unroll
            for (int q = 0; q < 4; ++q) { ov[q * 4] = lo_bf(ow[rr][q].x); ov[q * 4 + 1] = hi_bf(ow[rr][q].x); ov[q * 4 + 2] = lo_bf(ow[rr][q].y); ov[q * 4 + 3] = hi_bf(ow[rr][q].y); }
#pragma unroll
            for (int i = 0; i < 16; ++i) ss += ov[i] * ov[i];
            ss = wave_sum(ss); const float rs = rsqrtf(ss * (1.f / DM) + EPS);
#pragma unroll
            for (int q = 0; q < 4; ++q)
#pragma unroll
                for (int i = 0; i < 4; ++i) xv[rr][q][i] += n.gtp[q][i] * (ov[q * 4 + i] * rs);
        }
        if ((n.l >= 0 || n.isc) && !n.dry) {
#pragma unroll
            for (int q = 0; q < 4; ++q) __builtin_nontemporal_store(xv[rr][q], (f32x4*)(n.xout + j * DM + q * 256 + n.lane4));
        }
        if (n.next >= 0) {
            float ss = 0.f;
#pragma unroll
            for (int q = 0; q < 4; ++q)
#pragma unroll
                for (int i = 0; i < 4; ++i) ss += xv[rr][q][i] * xv[rr][q][i];
            ss = wave_sum(ss); const float rs = rsqrtf(ss * (1.f / DM) + EPS);
#pragma unroll
            for (int q = 0; q < 4; ++q) { float hv[4];
#pragma unroll
                for (int i = 0; i < 4; ++i) hv[i] = xv[rr][q][i] * rs * n.gqs[q][i] + n.sh[q][i];
                u32x2 w; w.x = cvt_pk_bf16(hv[0], hv[1]); w.y = cvt_pk_bf16(hv[2], hv[3]); *(u32x2*)(n.hb + (size_t)row * DM + q * 256 + n.lane4) = w; }
        }
    }
}
__device__ __forceinline__ void norm_rows(const Ctx& c, int l  , int next  , int r0, int r1  ) {
    NormItem n; n.b = r0 / NTOK; n.isc = (r0 - n.b * NTOK) >= SEQL; n.l = l; n.next = next; n.lane4 = c.lane * 4; n.dry = c.dry != 0;
    if (next < 0 && n.isc) return;
    const int mr = n.isc ? 16 : n.b;
    const float* mvl = wsp<float>(c, WS_MODV) + ((size_t)(l < 0 ? 0 : l) * 17 + mr) * 3072;
    const float* mvn = wsp<float>(c, WS_MODV) + ((size_t)(next < 0 ? 0 : next) * 17 + mr) * 3072;
    const float* gpost = KIN(I_GPOST) + (l < 0 ? 0 : l) * DM; const float* gpre = KIN(I_GPRE) + (next < 0 ? 0 : next) * DM;
    n.outb = wsp<bf16_t>(c, WS_OUTB); n.hb = wsp<bf16_t>(c, WS_HCAT);
    if (n.isc) { float* base = wsp<float>(c, WS_CTXR) + ((ptrdiff_t)n.b * CTXL - SEQL) * DM; n.xout = base; n.xin = (l < 0) ? KIN(I_CTX) + ((ptrdiff_t)n.b * CTXL - SEQL) * DM : base; }
    else { float* base = KOUT() + (size_t)n.b * SEQL * DM; n.xout = base; n.xin = (l <= 0) ? KIN(I_X) + (size_t)n.b * SEQL * DM : base; }
#pragma unroll
    for (int q = 0; q < 4; ++q) { const int col = q * 256 + n.lane4;
        if (l >= 0) { const f32x4 gp = *(const f32x4*)(gpost + col), gt = *(const f32x4*)(mvl + 2048 + col); n.gtp[q] = gp * gt; } else n.gtp[q] = (f32x4){0.f, 0.f, 0.f, 0.f};
        if (next >= 0) { const f32x4 g = *(const f32x4*)(gpre + col), s1 = *(const f32x4*)(mvn + 1024 + col); n.gqs[q] = g * (s1 + 1.f); n.sh[q] = *(const f32x4*)(mvn + col); }
        else { n.gqs[q] = (f32x4){0.f, 0.f, 0.f, 0.f}; n.sh[q] = (f32x4){0.f, 0.f, 0.f, 0.f}; } }
    f32x4 xa[2][4], xb[2][4]; u32x2 oa[2][4], ob[2][4];
#pragma unroll
    for (int rr = 0; rr < 2; ++rr)
#pragma unroll
        for (int q = 0; q < 4; ++q) { oa[rr][q] = (u32x2){0u, 0u}; ob[rr][q] = (u32x2){0u, 0u}; }
    int rowb = r0 + c.wave * 2;
    norm_load(n, rowb, xa, oa);
    for (; rowb < r1; rowb += 32) {
        norm_load(n, rowb + 16, xb, ob);
        norm_proc(n, rowb, xa, oa);
        if (rowb + 32 < r1) norm_load(n, rowb + 32, xa, oa);
        norm_proc(n, rowb + 16, xb, ob);
    }
}

struct P2Env {
    bf16_t *B0, *B1, *B3; const bf16_t* B4; bf16_t *kr, *kg; const LAS float *ropeM, *ropeG; f32x4 gcq, gckv, gq, gk; int lane; bool dry;
};
__device__ __forceinline__ void p2_load(const P2Env& e, int rowb, u32x2 (&w0)[4], u32x2 (&w1)[4], u32x2 (&w3)[4], u32x2 (&w4)[4]) {
#pragma unroll
    for (int rr = 0; rr < 4; ++rr) { const size_t ro = (size_t)(rowb + rr) * 256 + e.lane * 4;
        w0[rr] = *(const u32x2*)(e.B0 + ro); w1[rr] = *(const u32x2*)(e.B1 + ro); w3[rr] = *(const u32x2*)(e.B3 + ro); w4[rr] = *(const u32x2*)(e.B4 + ro); }
}
__device__ __forceinline__ void p2_proc(const P2Env& e, int rowb, const u32x2 (&w0)[4], const u32x2 (&w1)[4], const u32x2 (&w3)[4], const u32x2 (&w4)[4]) {
    const int lane = e.lane;
#pragma unroll
    for (int rr = 0; rr < 4; ++rr) {
        const int row = rowb + rr;
        const int b = row / NTOK, j = row - b * NTOK; const bool islat = j < SEQL; const int rowpos = (j >> 6) & 63, colpos = j & 63;
        const size_t ro = (size_t)row * 256 + lane * 4;
        const int tm_ = lane & 7, tg_ = lane & 15;
        const LAS float* am = e.ropeM + (((tm_ & 4) ? colpos : rowpos) * 8 + 4 * (tm_ & 1)) * 2; const LAS float* ag = e.ropeG + (((tg_ & 8) ? colpos : rowpos) * 16 + 4 * (tg_ & 3)) * 2;
        const f32x4 rm0 = *(const LAS f32x4*)am, rm1 = *(const LAS f32x4*)(am + 4), rg0 = *(const LAS f32x4*)ag, rg1 = *(const LAS f32x4*)(ag + 4);
        const float rmv[8] = {rm0[0], rm0[1], rm0[2], rm0[3], rm1[0], rm1[1], rm1[2], rm1[3]}, rgv[8] = {rg0[0], rg0[1], rg0[2], rg0[3], rg1[0], rg1[1], rg1[2], rg1[3]};
        {
            const u32x2 w = w0[rr]; float x[4] = {lo_bf(w.x), hi_bf(w.x), lo_bf(w.y), hi_bf(w.y)};
            float ss = (lane < 48) ? (x[0] * x[0] + x[1] * x[1] + x[2] * x[2] + x[3] * x[3]) : 0.f; ss = wave_sum(ss);
            const float rs = rsqrtf(ss * (1.f / 192.f) + EPS);
            float xp[4];
#pragma unroll
            for (int i = 0; i < 4; ++i) xp[i] = swz_xor<2>(x[i]);
            u32x2 o; o.x = 0u; o.y = 0u;
            if (lane < 48) { o.x = cvt_pk_bf16(x[0] * rs * e.gcq[0], x[1] * rs * e.gcq[1]); o.y = cvt_pk_bf16(x[2] * rs * e.gcq[2], x[3] * rs * e.gcq[3]); }
            else if (lane < 56) {
                const int t = lane - 48; float y[4];
                if (islat) { const bool isx2 = (t & 2) != 0;
#pragma unroll
                    for (int i = 0; i < 4; ++i) { const float cs = rmv[2 * i], sn = rmv[2 * i + 1]; y[i] = isx2 ? (xp[i] * sn + x[i] * cs) : (x[i] * cs - xp[i] * sn); } }
                else {
#pragma unroll
                    for (int i = 0; i < 4; ++i) y[i] = x[i]; }
                u32x2 kk; kk.x = cvt_pk_bf16(y[0], y[1]); kk.y = cvt_pk_bf16(y[2], y[3]); *(u32x2*)(e.kr + (size_t)row * 32 + t * 4) = kk;
            }
            if (!e.dry) *(u32x2*)(e.B0 + ro) = o;
        }
        {
            const u32x2 w = w1[rr]; float x[4] = {lo_bf(w.x), hi_bf(w.x), lo_bf(w.y), hi_bf(w.y)};
            float ss = (lane < 32) ? (x[0] * x[0] + x[1] * x[1] + x[2] * x[2] + x[3] * x[3]) : 0.f; ss = wave_sum(ss);
            const float rs = rsqrtf(ss * (1.f / 128.f) + EPS);
            u32x2 o; o.x = 0u; o.y = 0u;
            if (lane < 32) { o.x = cvt_pk_bf16(x[0] * rs * e.gckv[0], x[1] * rs * e.gckv[1]); o.y = cvt_pk_bf16(x[2] * rs * e.gckv[2], x[3] * rs * e.gckv[3]); }
            if (!e.dry) *(u32x2*)(e.B1 + ro) = o;
        }
#pragma unroll
        for (int which = 0; which < 2; ++which) {
            const u32x2 w = which == 0 ? w3[rr] : w4[rr]; float x[4] = {lo_bf(w.x), hi_bf(w.x), lo_bf(w.y), hi_bf(w.y)};
            float ss = x[0] * x[0] + x[1] * x[1] + x[2] * x[2] + x[3] * x[3];
            ss += swz_xor<1>(ss); ss += swz_xor<2>(ss); ss += swz_xor<4>(ss); ss += swz_xor<8>(ss);
            const float rs = rsqrtf(ss * (1.f / 64.f) + EPS);
            const int t = lane & 15; const f32x4 g = which == 0 ? e.gq : e.gk;
#pragma unroll
            for (int i = 0; i < 4; ++i) x[i] = x[i] * rs * g[i];
            float xp[4];
#pragma unroll
            for (int i = 0; i < 4; ++i) xp[i] = swz_xor<4>(x[i]);
            if (islat) { const bool isx2 = (t & 4) != 0;
#pragma unroll
                for (int i = 0; i < 4; ++i) { const float cs = rgv[2 * i], sn = rgv[2 * i + 1]; x[i] = isx2 ? (xp[i] * sn + x[i] * cs) : (x[i] * cs - xp[i] * sn); } }
            if (which == 0) { const float qs = 0.125f * LOG2E; u32x2 o; o.x = cvt_pk_bf16(x[0] * qs, x[1] * qs); o.y = cvt_pk_bf16(x[2] * qs, x[3] * qs); if (!e.dry) *(u32x2*)(e.B3 + ro) = o; }
            else if (lane < 32) { u32x2 o; o.x = cvt_pk_bf16(x[0], x[1]); o.y = cvt_pk_bf16(x[2], x[3]); *(u32x2*)(e.kg + ((size_t)(b * 2 + (lane >> 4)) * NTOK + j) * 64 + t * 4) = o; }
        }
    }
}
__device__ __forceinline__ void p2_rows(const Ctx& c, int l) {
    bf16_t* pb = wsp<bf16_t>(c, WS_PB);
    P2Env e; e.B0 = pb; e.B1 = pb + BLKE; e.B3 = pb + 3 * BLKE; e.B4 = pb + 4 * BLKE; e.kr = wsp<bf16_t>(c, WS_KR); e.kg = wsp<bf16_t>(c, WS_KG); e.lane = c.lane; e.dry = c.dry != 0;
    LAS float* tab = (LAS float*)c.lds; e.ropeM = tab; e.ropeG = tab + 1024;
    { const float* srcM = wsp<float>(c, WS_ROPEM); const float* srcG = wsp<float>(c, WS_ROPEG);
      for (int i = c.tid; i < 256; i += 512) ((LAS f32x4*)tab)[i] = *(const f32x4*)(srcM + i * 4);
      for (int i = c.tid; i < 512; i += 512) ((LAS f32x4*)(tab + 1024))[i] = *(const f32x4*)(srcG + i * 4); }
    const int lane = c.lane;
    e.gcq = (lane < 48) ? *(const f32x4*)(KIN(I_GCQ) + l * 192 + lane * 4) : (f32x4){0.f, 0.f, 0.f, 0.f};
    e.gckv = (lane < 32) ? *(const f32x4*)(KIN(I_GCKV) + l * 128 + lane * 4) : (f32x4){0.f, 0.f, 0.f, 0.f};
    e.gq = *(const f32x4*)(KIN(I_GQ) + l * 64 + (lane & 15) * 4); e.gk = *(const f32x4*)(KIN(I_GK) + l * 64 + (lane & 15) * 4);
    __syncthreads();
    const int step = c.G * 8 * 4;
    u32x2 a0[4], a1[4], a3[4], a4[4], b0[4], b1[4], b3[4], b4[4];
    int rowb = (c.bid * 8 + c.wave) * 4;
    if (rowb < MROWS) p2_load(e, rowb, a0, a1, a3, a4);
    for (; rowb < MROWS; rowb += 2 * step) {
        const bool hb = rowb + step < MROWS;
        if (hb) p2_load(e, rowb + step, b0, b1, b3, b4);
        p2_proc(e, rowb, a0, a1, a3, a4);
        if (rowb + 2 * step < MROWS) p2_load(e, rowb + 2 * step, a0, a1, a3, a4);
        if (hb) p2_proc(e, rowb + step, b0, b1, b3, b4);
    }
    __syncthreads();
}
#ifndef PROBE_ABL
#define PROBE_ABL 0
#endif
#ifndef PROBE_GQAONLY
#define PROBE_GQAONLY 0
#endif
template <int DK, bool SUB, bool NOMAX = false, int ABL = 0>
__device__ __forceinline__ bool attn_unit(float (&rowmax)[2], const Ctx& c, const bf16_t* Qp, int qpitch, const bf16_t* Kp, const bf16_t* Vtp, int kt0, int nkt, int nrows,
                                          const bf16_t* gatep, bf16_t* outp, bool rope, int j0, float qscale, const float* ropeM) {
    constexpr int KS = DK / 16, KPC = DK / 8, KPITCH = DK * 2 + 16, KB = 64 * KPITCH, VPITCH = 144, VB = 64 * VPITCH;
    constexpr int KOFF = 0, VOFF = 3 * KB;
    constexpr float LIM = 60.f;
    static_assert(KB % 16 == 0 && VB % 16 == 0, "attention LDS buffer alignment");
    const int tid = c.tid, lane = c.lane, wave = c.wave;
    const int lq_ = opaque(lane), q = lq_ & 31, h = lq_ >> 5;
    LAS unsigned char* lds = c.lds;
    const int rbase = (wave * 64 < nrows) ? wave * 64 : wave * 64 - 256;
    const bool live = wave * 64 < nrows;
    bf16x8 qf[2][KS];
#pragma unroll
    for (int qt = 0; qt < 2; ++qt) {
        const bf16_t* qrow = Qp + (size_t)(rbase + qt * 32 + q) * qpitch + 8 * h;
#pragma unroll
        for (int ks = 0; ks < KS; ++ks) qf[qt][ks] = *(const bf16x8*)(qrow + 16 * ks);
        if (DK == 96) {
            const int jj = j0 + rbase + qt * 32 + q;
#pragma unroll
            for (int ks = 0; ks < KS; ++ks) {
                float x[8]; unpack8(__builtin_bit_cast(u32x4, qf[qt][ks]), x);
                if (ks >= 4) {
                    const int pos = (ks == 4) ? ((jj >> 6) & 63) : (jj & 63);
#pragma unroll
                    for (int e = 0; e < 8; ++e) { const float xp = half_other(x[e], h); const float cs = ropeM[(pos * 8 + e) * 2], sn = ropeM[(pos * 8 + e) * 2 + 1];
                        const float r = h ? (xp * sn + x[e] * cs) : (x[e] * cs - xp * sn); x[e] = rope ? r : x[e]; }
                }
                u32x4 w; w.x = cvt_pk_bf16(x[0] * qscale, x[1] * qscale); w.y = cvt_pk_bf16(x[2] * qscale, x[3] * qscale); w.z = cvt_pk_bf16(x[4] * qscale, x[5] * qscale); w.w = cvt_pk_bf16(x[6] * qscale, x[7] * qscale);
                qf[qt][ks] = __builtin_bit_cast(bf16x8, w);
            }
        }
    }
    f32x16 o00, o01, o10, o11;
#pragma unroll
    for (int i = 0; i < 16; ++i) { o00[i] = 0.f; o01[i] = 0.f; o10[i] = 0.f; o11[i] = 0.f; }
    const float m0 = SUB ? rowmax[0] : 0.f, m1 = SUB ? rowmax[1] : 0.f; float l0 = 0.f, l1 = 0.f;
    float rmax0 = -1e30f, rmax1 = -1e30f;
    const int tq_ = opaque(tid);
    const int kst0 = (tq_ / KPC) * KPITCH + (tq_ % KPC) * 16, kst1 = ((tq_ + 512) / KPC) * KPITCH + ((tq_ + 512) % KPC) * 16;
    const int kgl0 = ((tq_ / KPC) * DK + (tq_ % KPC) * 8) * 2, kgl1 = (((tq_ + 512) / KPC) * DK + ((tq_ + 512) % KPC) * 8) * 2;
    const int vst = (tq_ >> 3) * VPITCH + ((tq_ & 7) >> 1) * 32 + ((tq_ & 7) & 1) * 8, vgl = ((tq_ >> 3) * NTOK + (tq_ & 7) * 8) * 2;
    const bool has2 = (DK == 96) && tq_ < 256;
    const int kfo = q * KPITCH + 16 * h, vfo = q * VPITCH + 16 * h;
    const char* Kc = (const char*)Kp; const char* Vc = (const char*)Vtp;
    u32x4 kreg0, kreg1 = {0u, 0u, 0u, 0u}, vreg;
#define AT_GLOADK(kt) do { if (ABL & 1) break; const char* kb_ = Kc + (size_t)(kt) * (64 * DK * 2); kreg0 = *(const u32x4*)(kb_ + kgl0); if (has2) kreg1 = *(const u32x4*)(kb_ + kgl1); } while (0)
#define AT_GLOADV(kt) do { if (ABL & 1) break; vreg = *(const u32x4*)(Vc + (size_t)(kt) * 128 + vgl); } while (0)
#define AT_WRITEK(bi) do { if (ABL & 1) break; LAS unsigned char* bb = lds + KOFF + (bi) * KB; *(LAS u32x4*)(bb + kst0) = kreg0; if (has2) *(LAS u32x4*)(bb + kst1) = kreg1; } while (0)
#define AT_WRITEV(bi) do { if (ABL & 1) break; LAS u32x2* vd = (LAS u32x2*)(lds + VOFF + (bi) * VB + vst); vd[0] = (u32x2){vreg.x, vreg.y}; vd[2] = (u32x2){vreg.z, vreg.w}; } while (0)
#define AT_KPRE(bi, jh) do { if (KPRE) { const LAS unsigned char* kb_ = lds + KOFF + (bi) * KB + (jh) * 32 * KPITCH + kfo; \
        _Pragma("unroll") for (int ks = 0; ks < KS; ++ks) kf[ks] = *(const LAS bf16x8*)(kb_ + 32 * ks); } } while (0)
#define AT_QK(S0, S1, bi, jh) do { const LAS unsigned char* kb = lds + KOFF + (bi) * KB + (jh) * 32 * KPITCH + kfo; \
        _Pragma("unroll") for (int i = 0; i < 16; ++i) { S0[i] = 0.f; S1[i] = 0.f; } \
        if (!(ABL & 8)) _Pragma("unroll") for (int ks = 0; ks < KS; ++ks) { \
            const bf16x8 a0 = KPRE ? kf[ks] : *(const LAS bf16x8*)(kb + 32 * ks); \
            S0 = __builtin_amdgcn_mfma_f32_32x32x16_bf16(a0, qf[0][ks], S0, 0, 0, 0); \
            S1 = __builtin_amdgcn_mfma_f32_32x32x16_bf16(a0, qf[1][ks], S1, 0, 0, 0); } } while (0)
#define AT_MAX(S, RM) do { if (!SUB && !NOMAX) { _Pragma("unroll") for (int i = 0; i < 16; i += 2) RM = max3_raw(RM, S[i], S[i + 1]); } } while (0)
#define AT_EXP(S, M, L, PK0, PK1) do { float ps = 0.f; \
        _Pragma("unroll") for (int i = 0; i < 16; ++i) { S[i] = (ABL & 2) ? S[i] * 0.001f : __builtin_amdgcn_exp2f(SUB ? S[i] - M : S[i]); ps += S[i]; } \
        L += ps; u32x4 w; \
        w.x = cvt_pk_bf16(S[0], S[1]); w.y = cvt_pk_bf16(S[2], S[3]); w.z = cvt_pk_bf16(S[4], S[5]); w.w = cvt_pk_bf16(S[6], S[7]); PK0 = __builtin_bit_cast(bf16x8, w); \
        w.x = cvt_pk_bf16(S[8], S[9]); w.y = cvt_pk_bf16(S[10], S[11]); w.z = cvt_pk_bf16(S[12], S[13]); w.w = cvt_pk_bf16(S[14], S[15]); PK1 = __builtin_bit_cast(bf16x8, w); } while (0)
#define AT_VLOAD() do { va00 = *(const LAS bf16x8*)(vb); va10 = *(const LAS bf16x8*)(vb + 32 * VPITCH); va01 = *(const LAS bf16x8*)(vb + 32); va11 = *(const LAS bf16x8*)(vb + 32 * VPITCH + 32); } while (0)
#define AT_SUB(SC0, SC1, SN0, SN1, vbi, jh, nbi, njh) do { \
          \
        const LAS unsigned char* vb = lds + VOFF + (vbi) * VB + (jh) * 64 + vfo; \
        bf16x8 va00, va10, va01, va11; \
        if (DK == 64) { AT_VLOAD(); }        \
        AT_MAX(SC0, rmax0); AT_MAX(SC1, rmax1); \
        AT_QK(SN0, SN1, nbi, njh); \
        bf16x8 p00, p01, p10, p11; \
        AT_EXP(SC0, m0, l0, p00, p01); AT_EXP(SC1, m1, l1, p10, p11); \
        if (DK != 64) { AT_VLOAD(); } \
        if (!(ABL & 4)) { \
            o00 = __builtin_amdgcn_mfma_f32_32x32x16_bf16(va00, p00, o00, 0, 0, 0); \
            o01 = __builtin_amdgcn_mfma_f32_32x32x16_bf16(va10, p00, o01, 0, 0, 0); \
            o10 = __builtin_amdgcn_mfma_f32_32x32x16_bf16(va00, p10, o10, 0, 0, 0); \
            o11 = __builtin_amdgcn_mfma_f32_32x32x16_bf16(va10, p10, o11, 0, 0, 0); \
            o00 = __builtin_amdgcn_mfma_f32_32x32x16_bf16(va01, p01, o00, 0, 0, 0); \
            o01 = __builtin_amdgcn_mfma_f32_32x32x16_bf16(va11, p01, o01, 0, 0, 0); \
            o10 = __builtin_amdgcn_mfma_f32_32x32x16_bf16(va01, p11, o10, 0, 0, 0); \
            o11 = __builtin_amdgcn_mfma_f32_32x32x16_bf16(va11, p11, o11, 0, 0, 0); } \
        if (ABL & 4) { asm volatile("" :: "v"(p00), "v"(p01), "v"(p10), "v"(p11), "v"(va00), "v"(va10), "v"(va01), "v"(va11)); } \
        } while (0)
    if (!SUB && !NOMAX && tid == 0) *(volatile LAS unsigned*)(lds + LDS_MISC_OFF + 24) = 0u;
    AT_GLOADK(kt0); AT_GLOADV(kt0); AT_WRITEK(0); AT_WRITEV(0);
    AT_GLOADK(kt0 + 1); AT_WRITEK(1);
    __syncthreads();
    f32x16 sa0, sa1, sb0, sb1;
    constexpr bool KPRE = (DK == 64);
    bf16x8 kf[KS];
    AT_KPRE(0, 0);
    AT_QK(sa0, sa1, 0, 0);
    AT_KPRE(0, 1);
    int kb0 = 0, kb1 = 1, kb2 = 2;
    for (int t = 0; t < nkt; ++t) {
        const int tk = (t + 2 < nkt) ? t + 2 : nkt - 1, tv = (t + 1 < nkt) ? t + 1 : nkt - 1;
        AT_GLOADK(kt0 + tk);
        AT_SUB(sa0, sa1, sb0, sb1, t & 1, 0, kb0, 1);
        AT_KPRE(kb1, 0);
        AT_WRITEK(kb2);
        AT_GLOADV(kt0 + tv);
        AT_SUB(sb0, sb1, sa0, sa1, t & 1, 1, kb1, 0);
        AT_KPRE(kb1, 1);
        AT_WRITEV((t + 1) & 1);
        if (!(ABL & 16)) __syncthreads();
        const int tmp = kb0; kb0 = kb1; kb1 = kb2; kb2 = tmp;
    }
#undef AT_GLOADK
#undef AT_GLOADV
#undef AT_WRITEK
#undef AT_WRITEV
#undef AT_QK
#undef AT_KPRE
#undef AT_MAX
#undef AT_EXP
#undef AT_SUB
#undef AT_VLOAD
    bool bad = false;
    if (!SUB && !NOMAX) { const float r0 = half_max(rmax0), r1 = half_max(rmax1); rowmax[0] = r0; rowmax[1] = r1; const bool b_ = live && !(r0 < LIM && r0 > -LIM && r1 < LIM && r1 > -LIM); volatile LAS unsigned* flg = (volatile LAS unsigned*)(lds + LDS_MISC_OFF + 24); if (__any(b_ ? 1 : 0) && opaque(lane) == 0) *flg = 1u; __syncthreads(); bad = *flg != 0u; __syncthreads(); }
    if (live && !bad) {
        const int le_ = opaque(lane), q = le_ & 31, h = le_ >> 5;
#pragma unroll
        for (int qt = 0; qt < 2; ++qt) {
            const float lr = qt ? l1 : l0; const float lt = half_sum(lr), inv = 1.f / lt;
            const size_t row = (size_t)(rbase + qt * 32 + q);
#pragma unroll
            for (int dt = 0; dt < 2; ++dt)
#pragma unroll
                for (int g4 = 0; g4 < 4; ++g4) {
                    const int dv0 = dt * 32 + 8 * g4 + 4 * h;
                    const u32x2 gw = *(const u32x2*)(gatep + row * 256 + dv0);
                    const float g0 = siluf(lo_bf(gw.x)), g1 = siluf(hi_bf(gw.x)), g2 = siluf(lo_bf(gw.y)), g3 = siluf(hi_bf(gw.y));
                    const f32x16& o = qt ? (dt ? o11 : o10) : (dt ? o01 : o00);
                    u32x2 w; w.x = cvt_pk_bf16(o[4 * g4] * inv * g0, o[4 * g4 + 1] * inv * g1); w.y = cvt_pk_bf16(o[4 * g4 + 2] * inv * g2, o[4 * g4 + 3] * inv * g3);
                    *(u32x2*)(outp + row * DM + dv0) = w;
                }
        }
    }
    return bad;
}

template <int N>
__device__ __forceinline__ void hyena_conv(const Ctx& c, LAS unsigned char* ub, LAS unsigned char* gb, int pass, const bf16_t* xmul  , float bias,
                                           bf16_t* zdst  , const bf16_t* gmul, bf16_t* cat  , float cw0, float cw1, float cw2, float cb  ) {
    constexpr int UP = (N + 256) * 2 + 16, NPAIR = N / 256, OFF8 = N - 8;
    const int lane = c.lane, i16 = lane & 15, kq = lane >> 4;
    for (int pr = c.wave; pr < NPAIR; pr += 8) {
        const int t0 = pr * 256;
        u32x4 xq[2][4], gq[2][4]; bf16_t xl[2][4], xr[2][4];
#pragma unroll
        for (int half = 0; half < 2; ++half)
#pragma unroll
            for (int r = 0; r < 4; ++r) { const int t8 = t0 + half * 128 + 32 * kq + 8 * r; const bf16_t* xp_ = xmul + (size_t)i16 * NTOK + t8; xq[half][r] = *(const u32x4*)xp_;
                xl[half][r] = (t8 > 0) ? xp_[-1] : (bf16_t)0; xr[half][r] = (t8 + 8 < N) ? xp_[8] : (bf16_t)0;
                gq[half][r] = (pass == 1) ? *(const u32x4*)(gmul + (size_t)i16 * NTOK + t8) : (u32x4){0u, 0u, 0u, 0u}; }
        f32x4 acc[2][8];
#pragma unroll
        for (int m = 0; m < 8; ++m) { acc[0][m] = (f32x4){0.f, 0.f, 0.f, 0.f}; acc[1][m] = (f32x4){0.f, 0.f, 0.f, 0.f}; }
        const LAS unsigned char* up = ub + i16 * UP + 256 + kq * 16;
        const LAS unsigned char* gp = gb + (OFF8 - t0 - 8 * i16 + 8 * kq) * 2;
        bf16x8 bfa = *(const LAS bf16x8*)(up - 256), bfb = *(const LAS bf16x8*)(up);
        u32x4 wa = *(const LAS u32x4*)(gp - 256), wb = *(const LAS u32x4*)(gp - 256 + 16);
        for (int s0 = -128; s0 < N; s0 += 32) {
            const int sn = (s0 + 32 < N) ? s0 + 32 : s0;
            const bf16x8 bfan = *(const LAS bf16x8*)(up + sn * 2), bfbn = *(const LAS bf16x8*)(up + sn * 2 + 256);
            const u32x4 wan = *(const LAS u32x4*)(gp + sn * 2), wbn = *(const LAS u32x4*)(gp + sn * 2 + 16);
            const unsigned w[8] = {wa.x, wa.y, wa.z, wa.w, wb.x, wb.y, wb.z, wb.w};
            unsigned sh[7];
#pragma unroll
            for (int k = 0; k < 7; ++k) sh[k] = __builtin_amdgcn_alignbit(w[k + 1], w[k], 16);
#pragma unroll
            for (int m = 0; m < 8; ++m) {
                u32x4 a;
                if (m & 1) { const int d0 = (7 - m) >> 1; a = (u32x4){w[d0], w[d0 + 1], w[d0 + 2], w[d0 + 3]}; }
                else { const int d0 = (6 - m) >> 1; a = (u32x4){sh[d0], sh[d0 + 1], sh[d0 + 2], sh[d0 + 3]}; }
                acc[0][m] = __builtin_amdgcn_mfma_f32_16x16x32_bf16(__builtin_bit_cast(bf16x8, a), bfa, acc[0][m], 0, 0, 0);
                acc[1][m] = __builtin_amdgcn_mfma_f32_16x16x32_bf16(__builtin_bit_cast(bf16x8, a), bfb, acc[1][m], 0, 0, 0);
            }
            bfa = bfan; bfb = bfbn; wa = wan; wb = wbn;
        }
#pragma unroll
        for (int half = 0; half < 2; ++half)
#pragma unroll
            for (int r = 0; r < 4; ++r) {
                const int t8 = t0 + half * 128 + 32 * kq + 8 * r;
                float uu[8], xr8[8], xm[8]; unpack8(*(const LAS u32x4*)(ub + i16 * UP + 256 + t8 * 2), uu); unpack8(xq[half][r], xr8);
                {   float pv = bf2f(xl[half][r]);
#pragma unroll
                    for (int m = 0; m < 8; ++m) { const float nx = (m < 7) ? xr8[m + 1] : bf2f(xr[half][r]); xm[m] = bf2f(f2bf(cw0 * pv + cw1 * xr8[m] + cw2 * nx + cb)); pv = xr8[m]; } }
                float y[8];
#pragma unroll
                for (int m = 0; m < 8; ++m) y[m] = xm[m] * (acc[half][m][r] + bias * uu[m]);
                if (pass == 0) { u32x4 o; o.x = cvt_pk_bf16(y[0], y[1]); o.y = cvt_pk_bf16(y[2], y[3]); o.z = cvt_pk_bf16(y[4], y[5]); o.w = cvt_pk_bf16(y[6], y[7]); *(u32x4*)(zdst + (size_t)i16 * NTOK + t8) = o; }
                else { float gg[8]; unpack8(gq[half][r], gg);
#pragma unroll
                    for (int m = 0; m < 8; ++m) gg[m] = bf2f(f2bf(siluf(gg[m])));
                    u32x4 o; o.x = cvt_pk_bf16(y[0] * gg[0], y[1] * gg[1]); o.y = cvt_pk_bf16(y[2] * gg[2], y[3] * gg[3]); o.z = cvt_pk_bf16(y[4] * gg[4], y[5] * gg[5]); o.w = cvt_pk_bf16(y[6] * gg[6], y[7] * gg[7]);
                    *(u32x4*)(cat + (size_t)i16 * NTOK + t8) = o; }
            }
    }
}
template <int N>
__device__ __forceinline__ void hyena_seq(const Ctx& c, int l, int ch, int toff) {
    constexpr int UP = (N + 256) * 2 + 16;
    LAS unsigned char* ub = c.lds; LAS unsigned char* gb = c.lds + 16 * UP;
    const bf16_t* vv = wsp<bf16_t>(c, WS_HYV) + (size_t)ch * 16 * NTOK + toff;
    bf16_t* vz = wsp<bf16_t>(c, WS_HYZ) + (size_t)ch * 16 * NTOK + toff;
    const bf16_t* x1 = wsp<bf16_t>(c, WS_HYX1) + (size_t)ch * 16 * NTOK + toff;
    const bf16_t* x2 = wsp<bf16_t>(c, WS_HYX2) + (size_t)ch * 16 * NTOK + toff;
    const bf16_t* gm = wsp<bf16_t>(c, WS_HYG) + (size_t)ch * 16 * NTOK + toff;
    bf16_t* cat = wsp<bf16_t>(c, WS_HYY) + (size_t)ch * 16 * NTOK + toff;
    { const int e = c.tid, b = e >> 5, side = (e >> 4) & 1, pc = e & 15; unsigned z = 0u; asm volatile("" : "+v"(z)); *(LAS u32x4*)(ub + b * UP + side * (256 + N * 2) + pc * 16) = (u32x4){z, z, z, z}; }
    for (int pass = 0; pass < 2; ++pass) {
        const bf16_t* gr = (N == SEQL) ? wsp<bf16_t>(c, WS_GR) + (((size_t)l * 2 + pass) * 256 + ch) * 8192 : wsp<bf16_t>(c, WS_GRC) + (((size_t)l * 2 + pass) * 256 + ch) * 512;
        const bf16_t* usrc = pass == 0 ? vv : vz;
        constexpr int NG = (2 * N / 8 + 511) / 512;
        {
            u32x4 t[NG];
#pragma unroll
            for (int k = 0; k < NG; ++k) { const int e = c.tid + k * 512; t[k] = (e < 2 * N / 8) ? *(const u32x4*)(gr + e * 8) : (u32x4){0u, 0u, 0u, 0u}; }
#pragma unroll
            for (int k = 0; k < NG; ++k) { const int e = c.tid + k * 512; if (e < 2 * N / 8) *(LAS u32x4*)(gb + e * 16) = t[k]; }
        }
        if constexpr (N == SEQL) {
#pragma unroll
            for (int k0 = 0; k0 < 16; k0 += 8) {
                u32x4 t[8];
#pragma unroll
                for (int k = 0; k < 8; ++k) t[k] = *(const u32x4*)(usrc + (size_t)(k0 + k) * NTOK + c.tid * 8);
#pragma unroll
                for (int k = 0; k < 8; ++k) *(LAS u32x4*)(ub + (k0 + k) * UP + 256 + c.tid * 16) = t[k];
            }
        } else {
            const int b = c.tid >> 5, pc = c.tid & 31;
            *(LAS u32x4*)(ub + b * UP + 256 + pc * 16) = *(const u32x4*)(usrc + (size_t)b * NTOK + pc * 8);
        }
        __syncthreads();
        const float* hcw = KIN(I_HCW) + (size_t)l * 3 * 768; const float* hcb = KIN(I_HCB) + l * 768;
        if (pass == 0) {
            const float w0 = hcw[ch], w1 = hcw[768 + ch], w2 = hcw[1536 + ch], bs = hcb[ch];
            constexpr int PPT = (N == SEQL) ? 16 : 1;
            u32x4 o[PPT];
#pragma unroll
            for (int k = 0; k < PPT; ++k) { const int b = (N == SEQL) ? k : (c.tid >> 5), pc = (N == SEQL) ? c.tid : (c.tid & 31); const LAS unsigned char* p = ub + b * UP + 256 + pc * 16;
                float x[8]; unpack8(*(const LAS u32x4*)p, x); float pv = bf2f(*(const LAS bf16_t*)(p - 2)); const float nx8 = bf2f(*(const LAS bf16_t*)(p + 16)); float y[8];
#pragma unroll
                for (int m = 0; m < 8; ++m) { const float nx = (m < 7) ? x[m + 1] : nx8; y[m] = w0 * pv + w1 * x[m] + w2 * nx + bs; pv = x[m]; }
                o[k].x = cvt_pk_bf16(y[0], y[1]); o[k].y = cvt_pk_bf16(y[2], y[3]); o[k].z = cvt_pk_bf16(y[4], y[5]); o[k].w = cvt_pk_bf16(y[6], y[7]); }
            __syncthreads();
#pragma unroll
            for (int k = 0; k < PPT; ++k) { const int b = (N == SEQL) ? k : (c.tid >> 5), pc = (N == SEQL) ? c.tid : (c.tid & 31); *(LAS u32x4*)(ub + b * UP + 256 + pc * 16) = o[k]; }
            __syncthreads();
        }
        const float bias = KIN(I_HBIAS)[((size_t)l * 2 + pass) * 256 + ch];
        const int cc = (pass + 1) * 256 + ch;
        hyena_conv<N>(c, ub, gb, pass, pass == 0 ? x1 : x2, bias, vz, gm, cat, hcw[cc], hcw[768 + cc], hcw[1536 + cc], hcb[cc]);
        asm volatile("s_waitcnt vmcnt(0)" ::: "memory");
        __syncthreads();
    }
}

__device__ __forceinline__ void hyena_untranspose(const Ctx& c, int tl0, int tl1) {
    const bf16_t* yT = wsp<bf16_t>(c, WS_HYY); bf16_t* cat = wsp<bf16_t>(c, WS_HCAT);
    LAS bf16_t* T = (LAS bf16_t*)c.lds;
    LAS unsigned* T32 = (LAS unsigned*)c.lds;
    for (int tl = tl0; tl < tl1; ++tl) {
        const int b = tl / 68, j0 = (tl - b * 68) * 64;
        u32x4 pre[4];
#pragma unroll
        for (int k = 0; k < 4; ++k) { const int e = c.tid + k * 512, ch = e >> 3, pc = e & 7; pre[k] = *(const u32x4*)(yT + ((size_t)ch * 16 + b) * NTOK + j0 + pc * 8); }
#pragma unroll
        for (int k = 0; k < 4; ++k) { const int e = c.tid + k * 512, ch = e >> 3, pc = e & 7; LAS unsigned* d = T32 + (ch * 132 + pc * 16) / 4; d[0] = pre[k].x; d[1] = pre[k].y; d[2] = pre[k].z; d[3] = pre[k].w; }
        __syncthreads();
#pragma unroll
        for (int k = 0; k < 4; ++k) { const int e = c.tid + k * 512, t = e >> 5, c0 = (e & 31) * 8; float v[8];
#pragma unroll
            for (int i = 0; i < 8; ++i) v[i] = bf2f(T[(c0 + i) * 66 + t]);
            u32x4 w; w.x = cvt_pk_bf16(v[0], v[1]); w.y = cvt_pk_bf16(v[2], v[3]); w.z = cvt_pk_bf16(v[4], v[5]); w.w = cvt_pk_bf16(v[6], v[7]);
            *(u32x4*)(cat + ((size_t)b * NTOK + j0 + t) * DM + 768 + c0) = w; }
        __syncthreads();
    }
}

__device__ __forceinline__ void ssm_scan_item(const Ctx& c, int l, int item) {
    const int b = item >> 2, g = (item & 3) * 4 + (c.tid >> 7), dq = (c.tid >> 6) & 1, p = c.tid & 63;
    const float* a16 = wsp<float>(c, WS_A16) + ((((size_t)l * 2 + dq) * 16 + g) * 64 + p) * 2;
    const float ar = a16[0], ai = a16[1];
    const bf16_t* E = wsp<bf16_t>(c, WS_E); bf16_t* US = wsp<bf16_t>(c, WS_US);
    float sr = 0.f, si = 0.f;
    for (int st0 = 0; st0 < NCHB; st0 += 8) {
        float er[8], ei[8]; size_t ro[8];
#pragma unroll
        for (int k = 0; k < 8; ++k) { const int st = st0 + k; const int cc = dq == 0 ? (st < 16 ? 256 + st : st - 16) : (st < 16 ? 271 - st : 255 - (st - 16));
            ro[k] = (size_t)g * NCHUNK + (size_t)b * NCHB + cc; er[k] = bf2f(E[ro[k] * 256 + dq * 128 + p]); ei[k] = bf2f(E[ro[k] * 256 + dq * 128 + 64 + p]); }
#pragma unroll
        for (int k = 0; k < 8; ++k) {
            US[ro[k] * 512 + 256 + dq * 128 + p] = f2bf(sr); US[ro[k] * 512 + 256 + dq * 128 + 64 + p] = f2bf(si);
            const float nr = ar * sr - ai * si + er[k], ni = ar * si + ai * sr + ei[k]; sr = nr; si = ni;
        }
    }
}

constexpr int LDS_BYTES = 163840;
constexpr int LDS_MISC = LDS_MISC_OFF;
static_assert(LDS_MISC_OFF == LDS_BYTES - 256, "LDS map");
constexpr int NPRO = 1, NPH = 6, NPHASES = NPRO + DEPTH * NPH;
constexpr int QI_HY = 256, QI_SCAN = 64, QI_ATTL = NB * 8 * 8, QI_SSM2 = 16 * 17, QI_UNT = 272, QI_ATTC = NB * 8, QI_GLU = MROWS / 256;
constexpr int QO_SCAN = QI_HY, QO_ATTL = QO_SCAN + QI_SCAN, QO_SSM2 = QO_ATTL + QI_ATTL, QO_UNT = QO_SSM2 + QI_SSM2, QO_ATTC = QO_UNT + QI_UNT, QO_GLU = QO_ATTC + QI_ATTC, QI_TOTAL = QO_GLU + QI_GLU;
#ifndef PROBE_DUP_MASK
#define PROBE_DUP_MASK 0
#endif
#ifndef PROBE_P4KINDS
#define PROBE_P4KINDS 0x7f
#endif
__device__ __forceinline__ void dep_signal(const Ctx& c, unsigned* cnt) {
    asm volatile("s_waitcnt vmcnt(0)" ::: "memory");
    __syncthreads();
    if (c.tid == 0) { __builtin_amdgcn_fence(__ATOMIC_RELEASE, "agent"); asm volatile("s_waitcnt vmcnt(0)" ::: "memory"); (void)xb_add(cnt, 1u); }
}
__device__ __forceinline__ void dep_signal_wt(const Ctx& c, unsigned* cnt) {
    asm volatile("s_waitcnt vmcnt(0)" ::: "memory");
    __syncthreads();
    if (c.tid == 0) (void)xb_add(cnt, 1u);
}
__device__ __forceinline__ void dep_wait(const Ctx& c, unsigned* cnt, unsigned need, unsigned* tmo) {
    if (c.dry) return;
    if (c.tid == 0) {
        unsigned sp = 0;
        while (xb_ld(cnt) < need) { __builtin_amdgcn_s_sleep(2); if ((++sp & 255u) == 0u) { if (xb_ld(tmo)) break; if (sp > XB_SPIN_CAP) { atomicAdd(tmo, 1u); break; } } }
        __builtin_amdgcn_fence(__ATOMIC_ACQUIRE, "agent");
        asm volatile("s_waitcnt vmcnt(0)" ::: "memory");
    }
    __syncthreads();
}

__global__ void __launch_bounds__(512, 2) mk_fwd(Params prm) {
    extern __shared__ __attribute__((aligned(16))) unsigned char lds_raw[];
    Ctx c; c.lds = (LAS unsigned char*)lds_raw; c.ka = (kargp_t)__builtin_amdgcn_kernarg_segment_ptr(); c.ws = prm.ws; c.tid = threadIdx.x; c.lane = c.tid & 63; c.wave = __builtin_amdgcn_readfirstlane(c.tid >> 6); c.G = gridDim.x; c.bid = blockIdx.x; c.dry = prm.dry;
    const int wave0 = c.wave;
    volatile LAS unsigned* misc = (volatile LAS unsigned*)(c.lds + LDS_MISC);
    if (c.tid < 16) misc[c.tid] = 0u;
    __syncthreads();
    unsigned* ctl = wsp<unsigned>(c, WS_CTL);
    const int lo = prm.ph_lo, hi = prm.ph_hi;
    const bool fused = (hi - lo) > 1;
    XcdBarrier bar; bar.bar = ctl + CW_BAR; bar.x = 0; bar.st = misc;
    if (fused) bar = xcd_barrier_post(ctl + CW_BAR, misc);
#ifndef SITE_MASK
#define SITE_MASK 0x3ff
#endif
#define SITE(n) (((SITE_MASK) >> (n)) & 1)
#define IN(k) (lo <= (k) && (k) < hi)
#define FRESH() do { { kargp_t _k = (kargp_t)__builtin_amdgcn_kernarg_segment_ptr(); asm volatile("" : "+s"(_k)); c.ka = _k; c.ws = (unsigned char*)(GAS unsigned char*)_k[37]; } { int _w = wave0; asm volatile("" : "+s"(_w)); c.wave = _w; c.lane = lane_id_fresh(); c.tid = c.wave * 64 + c.lane; } } while (0)
#define SEAM(k) do { if (IN((k) + 1)) xcd_barrier(bar); } while (0)

    if (SITE(0) && IN(0)) {
        FRESH();
        constexpr int J_MOD = 192, J_HY = 544, J_SSM = 64, J_WIN = 4 * 48 * 8, J_WOUT = 4 * 16 * 8, J_WUQ = 4 * 8 * 2, J_W256 = 4 * 4 * 2, J_NORM = MROWS / 256, J_PACK = 4 * 2 * 256;
        constexpr int J0 = J_MOD, J1 = J0 + J_HY, J2 = J1 + J_SSM, J3 = J2 + J_WIN, J4 = J3 + J_WOUT, J5 = J4 + J_WUQ, J6 = J5 + J_W256, J7 = J6 + J_W256, J8 = J7 + J_W256, J9 = J8 + 1, J10 = J9 + J_NORM, J11 = J10 + J_PACK;
        unsigned* dep = ctl + CW_DEP + DEP_SET * 8;
        unsigned* tmo = ctl + CW_BAR + XB_TMO;
        for (int job = c.bid; job < J11; job += c.G) {
            FRESH();
            if (job < J0) { modv_job(c, job); dep_signal(c, dep); }
            else if (job < J1) { hyena_mlp_job(c, job - J0); dep_signal(c, dep + 64); }
            else if (job < J2) ssm_tables_job(c, job - J1);
            else if (job < J3) { const int r = job - J2, l = r / 384, q = r % 384; wconv_tile(c, KIN(I_WIN) + (size_t)l * DM * INC, DM, INC, INP, wsp<bf16_t>(c, WS_WIN) + (size_t)l * INP * DM, DM, 0, q / 8, q % 8); }
            else if (job < J4) { const int r = job - J3, l = r / 128, q = r % 128; wconv_tile(c, KIN(I_WOUT) + (size_t)l * DM * DM, DM, DM, DM, wsp<bf16_t>(c, WS_WOUT) + (size_t)l * DM * DM, DM, 1, q / 8, q % 8); }
            else if (job < J5) { const int r = job - J4, l = r / 16, q = r % 16; wconv_tile(c, KIN(I_WUQ) + (size_t)l * 192 * 384, 192, 384, 384, wsp<bf16_t>(c, WS_WUQ) + (size_t)l * 512 * 256, 256, 1, q / 2, q % 2); }
            else if (job < J6) { const int r = job - J5, l = r / 8, q = r % 8; wconv_tile(c, KIN(I_WUKV) + (size_t)l * 128 * 512, 128, 512, 256, wsp<bf16_t>(c, WS_WUK) + (size_t)l * 256 * 256, 256, 2, q / 2, q % 2); }
            else if (job < J7) { const int r = job - J6, l = r / 8, q = r % 8; wconv_tile(c, KIN(I_WUKV) + (size_t)l * 128 * 512, 128, 512, 256, wsp<bf16_t>(c, WS_WUV) + (size_t)l * 256 * 256, 256, 3, q / 2, q % 2); }
            else if (job < J8) { const int r = job - J7, l = r / 8, q = r % 8; wconv_tile(c, KIN(I_GLUW) + (size_t)l * 256 * 256, 256, 256, 256, wsp<bf16_t>(c, WS_WGLU) + (size_t)l * 256 * 256, 256, 1, q / 2, q % 2); }
            else if (job < J9) rope_job(c);
            else if (job < J10) { dep_wait(c, dep, J_MOD, tmo); FRESH(); const int t = job - J9; norm_rows(c, -1, 0, t * 256, t * 256 + 256); }
            else { dep_wait(c, dep + 64, J_HY, tmo); FRESH(); hyena_pack_job(c, job - J10); }
        }
        SEAM(0);
    }
    for (int l = 0; l < DEPTH; ++l) {
        const int pbase = NPRO + l * NPH;
        if (SITE(2) && IN(pbase + 0)) {
            FRESH();
            pg8::Gemm g{wsp<bf16_t>(c, WS_HCAT), wsp<bf16_t>(c, WS_WIN) + (size_t)l * INP * DM, MROWS, INP, DM};
            pg8::StaticOrder S; S.init(MROWS, INP, c.G, c.bid);
            EpiInProj E{wsp<bf16_t>(c, WS_PB), wsp<bf16_t>(c, WS_UG), wsp<bf16_t>(c, WS_US), wsp<bf16_t>(c, WS_VTG), wsp<bf16_t>(c, WS_HYV), c.lds + pg8::STAGE_BYTES};
            pg8::gemm_phase(c.lds, g, S, E, c.tid);
            SEAM(pbase + 0);
        }
        if (SITE(3) && IN(pbase + 1)) { FRESH(); p2_rows(c, l); SEAM(pbase + 1); }
        if (SITE(4) && IN(pbase + 2)) {
            FRESH();
            pg8::Gemm g{wsp<bf16_t>(c, WS_PB), wsp<bf16_t>(c, WS_WUQ), MROWS, 512, 256};
            pg8::P3Order S{wsp<bf16_t>(c, WS_PB), wsp<bf16_t>(c, WS_PB) + BLKE, wsp<bf16_t>(c, WS_WUQ) + (size_t)l * 512 * 256, wsp<bf16_t>(c, WS_WUK) + (size_t)l * 256 * 256, wsp<bf16_t>(c, WS_WUV) + (size_t)l * 256 * 256,
                           wsp<bf16_t>(c, WS_UG), wsp<bf16_t>(c, WS_WE) + (size_t)l * 16 * 256 * 256, c.G, c.bid};
            EpiP3 E{{wsp<bf16_t>(c, WS_QM), 384, 384}, {wsp<bf16_t>(c, WS_KM), wsp<bf16_t>(c, WS_KR)}, {wsp<bf16_t>(c, WS_VTM)}, {wsp<bf16_t>(c, WS_E)}};
            pg8::gemm_phase(c.lds, g, S, E, c.tid);
            SEAM(pbase + 2);
        }
        if (SITE(5) && IN(pbase + 3)) {
            FRESH();
            unsigned* qh = ctl + CW_Q + 64 * (l + 4 * (c.dry ? 1 : 0));
            unsigned* dep = ctl + CW_DEP + DEP_SET * (l + 4 * (c.dry ? 1 : 0));
            unsigned* tmo = ctl + CW_BAR + XB_TMO;
            const float* ropeM = wsp<float>(c, WS_ROPEM);
            bool gqa_nomax;
            { float gq_ = fabsf(KIN(I_GQ)[l * 64 + c.lane]), gk_ = fabsf(KIN(I_GK)[l * 64 + c.lane]);
              gq_ = fmaxf(gq_, swz_xor<16>(gq_)); gq_ = fmaxf(gq_, swz_xor<8>(gq_)); gq_ = fmaxf(gq_, swz_xor<4>(gq_)); gq_ = fmaxf(gq_, swz_xor<2>(gq_)); gq_ = fmaxf(gq_, swz_xor<1>(gq_)); gq_ = half_max(gq_);
              gk_ = fmaxf(gk_, swz_xor<16>(gk_)); gk_ = fmaxf(gk_, swz_xor<8>(gk_)); gk_ = fmaxf(gk_, swz_xor<4>(gk_)); gk_ = fmaxf(gk_, swz_xor<2>(gk_)); gk_ = fmaxf(gk_, swz_xor<1>(gk_)); gk_ = half_max(gk_);
              const float bound = 64.f * gq_ * gk_ * 0.125f * LOG2E * 1.01f; gqa_nomax = __builtin_amdgcn_readfirstlane(bound < 50.f ? 1 : 0) != 0; }
#define ATT_CALL(DKV, ...) do { float rowmax_[2] = {0.f, 0.f}; if (attn_unit<DKV, false>(rowmax_, __VA_ARGS__)) { (void)attn_unit<DKV, true>(rowmax_, __VA_ARGS__); } } while (0)
            for (;;) {
                __syncthreads();
                if (c.tid == 0) misc[4] = __hip_atomic_fetch_add(qh, 1u, __ATOMIC_RELAXED, __HIP_MEMORY_SCOPE_AGENT);
                __syncthreads();
                const int it = (int)misc[4];
                if (it >= QI_TOTAL) break;
                FRESH();
                if (c.dry) { const int kd_ = it < QO_SCAN ? 0 : it < QO_ATTL ? 1 : it < QO_SSM2 ? 2 : it < QO_UNT ? 3 : it < QO_ATTC ? 4 : it < QO_GLU ? 5 : 6; if (!((c.dry >> (1 + kd_)) & 1)) continue; }
                if (it < QO_SCAN) { hyena_seq<SEQL>(c, l, it, 0); if (l + 1 < DEPTH) hyena_seq<CTXL>(c, l, it, SEQL); dep_signal(c, dep); }
                else if (it < QO_ATTL) { ssm_scan_item(c, l, it - QO_SCAN); dep_signal(c, dep + 64); }
                else if (it >= QO_ATTC && it < QO_GLU && l + 1 == DEPTH) {   }
                else if (it < QO_SSM2 || (it >= QO_ATTC && it < QO_GLU)) {
                    const bool isctx = it >= QO_ATTC; const int r = isctx ? it - QO_ATTC : (it - QO_ATTL) % (NB * 8), blk = isctx ? 8 : (it - QO_ATTL) / (NB * 8)  ;
                    const int kind = r & 1  , head = (r >> 1) & 3, b = r >> 3;
                    const size_t row0 = (size_t)b * NTOK + (isctx ? SEQL : blk * 512); const int kt0 = isctx ? 64 : 0, nkt = isctx ? 4 : 68, nrows = isctx ? 256 : 512;
                    if (kind == 0) { if (c.dry && PROBE_GQAONLY == 1) continue; ATT_CALL(96, c, wsp<bf16_t>(c, WS_QM) + row0 * 384 + head * 96, 384, wsp<bf16_t>(c, WS_KM) + (size_t)(b * 4 + head) * NTOK * 96, wsp<bf16_t>(c, WS_VTM) + (size_t)(b * 4 + head) * 64 * NTOK,
                                                 kt0, nkt, nrows, wsp<bf16_t>(c, WS_PB) + 2 * BLKE + row0 * 256 + head * 64, wsp<bf16_t>(c, WS_HCAT) + row0 * DM + head * 64, !isctx, blk * 512, 0.10206207261596577f * LOG2E, ropeM); }
                    else if (c.dry && PROBE_GQAONLY == 2) { continue; }
                    else if (c.dry && PROBE_ABL) { float rm_[2] = {0.f, 0.f}; (void)attn_unit<64, false, true, PROBE_ABL>(rm_, c, wsp<bf16_t>(c, WS_PB) + 3 * BLKE + row0 * 256 + head * 64, 256, wsp<bf16_t>(c, WS_KG) + (size_t)(b * 2 + (head >> 1)) * NTOK * 64, wsp<bf16_t>(c, WS_VTG) + (size_t)(b * 2 + (head >> 1)) * 64 * NTOK,
                                       kt0, nkt, nrows, wsp<bf16_t>(c, WS_PB) + 5 * BLKE + row0 * 256 + head * 64, wsp<bf16_t>(c, WS_HCAT) + row0 * DM + 256 + head * 64, false, 0, 1.f, ropeM); }
                    else if (gqa_nomax) { float rm_[2] = {0.f, 0.f}; (void)attn_unit<64, false, true>(rm_, c, wsp<bf16_t>(c, WS_PB) + 3 * BLKE + row0 * 256 + head * 64, 256, wsp<bf16_t>(c, WS_KG) + (size_t)(b * 2 + (head >> 1)) * NTOK * 64, wsp<bf16_t>(c, WS_VTG) + (size_t)(b * 2 + (head >> 1)) * 64 * NTOK,
                                       kt0, nkt, nrows, wsp<bf16_t>(c, WS_PB) + 5 * BLKE + row0 * 256 + head * 64, wsp<bf16_t>(c, WS_HCAT) + row0 * DM + 256 + head * 64, false, 0, 1.f, ropeM); }
                    else { ATT_CALL(64, c, wsp<bf16_t>(c, WS_PB) + 3 * BLKE + row0 * 256 + head * 64, 256, wsp<bf16_t>(c, WS_KG) + (size_t)(b * 2 + (head >> 1)) * NTOK * 64, wsp<bf16_t>(c, WS_VTG) + (size_t)(b * 2 + (head >> 1)) * 64 * NTOK,
                                       kt0, nkt, nrows, wsp<bf16_t>(c, WS_PB) + 5 * BLKE + row0 * 256 + head * 64, wsp<bf16_t>(c, WS_HCAT) + row0 * DM + 256 + head * 64, false, 0, 1.f, ropeM); }
                }
                else if (it < QO_UNT) {
                    const int L = it - QO_SSM2, i = L >> 4, g = L & 15;
                    dep_wait(c, dep + 64, QI_SCAN, tmo);
                    pg8::Gemm gm{wsp<bf16_t>(c, WS_US), wsp<bf16_t>(c, WS_WKC) + (size_t)l * 16 * 256 * 512, 16 * NCHUNK, 16 * 256, 512}; pg8::OneUnit S{g * 17 + i, g};
                    pg8::EpiWalkPF<PutSsmY> E{{wsp<bf16_t>(c, WS_ZS), wsp<bf16_t>(c, WS_UG), KIN(I_SSMD) + l * 256}}; pg8::gemm_phase(c.lds, gm, S, E, c.tid);
                    dep_signal(c, dep + 64 * (2 + i));
                }
                else if (it < QO_ATTC) {
                    dep_wait(c, dep, QI_HY, tmo);
                    const int j = it - QO_UNT; hyena_untranspose(c, 4 * j, 4 * j + 4);
                }
                else {
                    const int pm = it - QO_GLU;
                    dep_wait(c, dep + 64 * (2 + (pm >> 4)), 16u, tmo);
                    pg8::Gemm gm{wsp<bf16_t>(c, WS_ZS), wsp<bf16_t>(c, WS_WGLU) + (size_t)l * 256 * 256, MROWS, 256, 256}; pg8::OneUnit S{pm, 0};
                    pg8::EpiWalkPF<PutGlu> E{{wsp<bf16_t>(c, WS_HCAT), wsp<bf16_t>(c, WS_ZS), wsp<bf16_t>(c, WS_PB) + 7 * BLKE, KIN(I_GLUB) + l * 256}}; pg8::gemm_phase(c.lds, gm, S, E, c.tid);
                }
            }
            SEAM(pbase + 3);
        }
        if (SITE(6) && IN(pbase + 4)) {
            FRESH();
            const bool lastl = l + 1 == DEPTH;
            constexpr int OPD = 8;
            const int x = c.bid & 7, nsx = (lastl ? NB * 16 : MROWS / 256) / 8;
            const int n1 = 4 * OPD, n2 = n1 + 8 * (nsx - OPD), ntot = n2 + 4 * OPD;
            unsigned* qh = ctl + CW_Q2 + 64 * ((l + 4 * (c.dry ? 1 : 0)) * 8 + x);
            unsigned* c7 = ctl + CW_C7 + 320 * (l + 4 * (c.dry ? 1 : 0));
            unsigned* tmo = ctl + CW_BAR + XB_TMO;
            unsigned pre = 0u;
            if (c.tid == 0) pre = __hip_atomic_fetch_add(qh, 1u, __ATOMIC_RELAXED, __HIP_MEMORY_SCOPE_AGENT);
            for (;;) {
                __syncthreads();
                if (c.tid == 0) { misc[4] = pre; pre = __hip_atomic_fetch_add(qh, 1u, __ATOMIC_RELAXED, __HIP_MEMORY_SCOPE_AGENT); }
                __syncthreads();
                const int it = (int)misc[4];
                if (it >= ntot) break;
                FRESH();
                int i, k;
                if (it < n1) { i = it >> 2; k = it & 3; } else if (it < n2) { const int j = it - n1; i = OPD + (j >> 3); k = j & 7; if (k >= 4) i -= OPD; } else { const int j = it - n2; i = nsx - OPD + (j >> 2); k = 4 + (j & 3); }
                const int s_ = x + 8 * i, pm = lastl ? (s_ >> 4) * 17 + (s_ & 15) : s_;
                if (k < 4) {
                    pg8::Gemm g{wsp<bf16_t>(c, WS_HCAT), wsp<bf16_t>(c, WS_WOUT) + (size_t)l * DM * DM, MROWS, DM, DM}; pg8::OneUnit S{pm, k};
                    pg8::EpiWalk<PutPlainWT> E{{wsp<bf16_t>(c, WS_OUTB), DM, DM}}; pg8::gemm_phase(c.lds, g, S, E, c.tid);
                    dep_signal_wt(c, c7 + s_);
                } else {
                    dep_wait(c, c7 + s_, 4u, tmo);
                    const int r0 = pm * 256 + (k - 4) * 64; norm_rows(c, l, lastl ? -1 : l + 1, r0, r0 + 64);
                }
            }
            if (!lastl) SEAM(pbase + 4);
        }
    }
#undef IN
#undef SEAM
}

extern "C" void kernel_launch(void* const* d_in, const int* in_sizes, int n_in, void* d_out, int out_size, void* d_ws, size_t ws_size, hipStream_t stream) {
    static int grid = 0;
    if (grid == 0) {
        if (n_in != 36 || out_size != NB * SEQL * DM || ws_size < WS_END) { fprintf(stderr, "kernel_launch: unexpected shapes: n_in %d out %d ws %zu (need %zu)\n", n_in, out_size, ws_size, (size_t)WS_END); grid = -1; return; }
        int dev = 0, cus = 0, per_cu = 0;
        if (hipGetDevice(&dev) != hipSuccess || hipDeviceGetAttribute(&cus, hipDeviceAttributeMultiprocessorCount, dev) != hipSuccess) { grid = -1; return; }
        if (hipFuncSetAttribute((const void*)mk_fwd, hipFuncAttributeMaxDynamicSharedMemorySize, LDS_BYTES) != hipSuccess) { fprintf(stderr, "kernel_launch: hipFuncSetAttribute failed\n"); grid = -1; return; }
        if (hipOccupancyMaxActiveBlocksPerMultiprocessor(&per_cu, (const void*)mk_fwd, 512, LDS_BYTES) != hipSuccess || per_cu < 1) { fprintf(stderr, "kernel_launch: occupancy query says %d blocks per CU\n", per_cu); per_cu = 1; }
        (void)hipGetLastError();
        grid = cus;
    }
    if (grid < 0) return;
    (void)hipMemsetAsync((char*)d_ws + WS_CTL, 0, CTL_BYTES, stream);
    Params p{};
    for (int i = 0; i < 36; ++i) p.in[i] = (const float*)d_in[i];
    p.out = (float*)d_out; p.ws = (unsigned char*)d_ws;
#if MK_ONE_LAUNCH
    p.ph_lo = 0; p.ph_hi = NPHASES;
    hipLaunchKernelGGL(mk_fwd, dim3(grid), dim3(512), LDS_BYTES, stream, p);
#else
    for (int k = 0; k < NPHASES; ++k) { p.ph_lo = k; p.ph_hi = k + 1; const int site = k < NPRO ? k : NPRO + (k - NPRO) % NPH;
        if ((PROBE_DUP_MASK >> site) & 1) { p.dry = 1 | (PROBE_P4KINDS << 1); hipLaunchKernelGGL(mk_fwd, dim3(grid), dim3(512), LDS_BYTES, stream, p); p.dry = 0; }
        hipLaunchKernelGGL(mk_fwd, dim3(grid), dim3(512), LDS_BYTES, stream, p); }
#endif
}
```

```cpp
#include <hip/hip_runtime.h>
#include <cstdio>
#include <cstdint>

#ifndef MK_ONE_LAUNCH
#define MK_ONE_LAUNCH 1
#endif

#define LAS __attribute__((address_space(3)))
#define GAS __attribute__((address_space(1)))
typedef unsigned short bf16_t;
typedef short bf16x8 __attribute__((ext_vector_type(8)));
typedef short bf16x4 __attribute__((ext_vector_type(4)));
typedef float f32x4 __attribute__((ext_vector_type(4)));
typedef float f32x16 __attribute__((ext_vector_type(16)));
typedef unsigned u32x4 __attribute__((ext_vector_type(4)));
typedef unsigned u32x2 __attribute__((ext_vector_type(2)));

constexpr int NB = 16, SEQL = 4096, CTXL = 256, NTOK = SEQL + CTXL  , MROWS = NB * NTOK  ;
constexpr int DM = 1024, DEPTH = 4, INC = 2912, INP = 3072;
constexpr int NCHB = NTOK / 16  , NCHUNK = MROWS / 16  ;
constexpr float EPS = 1e-6f;
constexpr float LOG2E = 1.4426950408889634f;
constexpr int LDS_MISC_OFF = 163840 - 256;

constexpr size_t al256(size_t x) { return (x + 255) & ~(size_t)255; }
constexpr size_t WS_CTL = 0;
constexpr size_t CTL_BYTES = 131072;
constexpr size_t WS_MODV = WS_CTL + CTL_BYTES;
constexpr size_t WS_ROPEG = WS_MODV + al256((size_t)4 * 17 * 3072 * 4);
constexpr size_t WS_ROPEM = WS_ROPEG + 64 * 16 * 2 * 4;
constexpr size_t WS_WIN = WS_ROPEM + 64 * 8 * 2 * 4;
constexpr size_t WS_WOUT = WS_WIN + (size_t)4 * 3072 * 1024 * 2;
constexpr size_t WS_WUQ = WS_WOUT + (size_t)4 * 1024 * 1024 * 2;
constexpr size_t WS_WUK = WS_WUQ + (size_t)4 * 512 * 256 * 2;
constexpr size_t WS_WUV = WS_WUK + (size_t)4 * 256 * 256 * 2;
constexpr size_t WS_WGLU = WS_WUV + (size_t)4 * 256 * 256 * 2;
constexpr size_t WS_WE = WS_WGLU + (size_t)4 * 256 * 256 * 2;
constexpr size_t WS_WKC = WS_WE + (size_t)4 * 16 * 256 * 256 * 2;
constexpr size_t WS_A16 = WS_WKC + (size_t)4 * 16 * 256 * 512 * 2;
constexpr size_t WS_GR = WS_A16 + (size_t)4 * 2 * 16 * 64 * 2 * 4;
constexpr size_t WS_GRC = WS_GR + (size_t)4 * 2 * 256 * 8192 * 2;
constexpr size_t WS_CTXR = WS_GRC + (size_t)4 * 2 * 256 * 512 * 2;
constexpr size_t WS_HCAT = WS_CTXR + (size_t)NB * CTXL * DM * 4;
constexpr size_t BLKE = (size_t)MROWS * 256;
constexpr size_t WS_PB = WS_HCAT + (size_t)MROWS * DM * 2;
constexpr size_t WS_KR = WS_PB + 12 * BLKE * 2;
constexpr size_t WS_KG = WS_KR + (size_t)MROWS * 32 * 2;
constexpr size_t WS_VTG = WS_KG + (size_t)32 * NTOK * 64 * 2;
constexpr size_t WS_UG = WS_VTG + (size_t)32 * NTOK * 64 * 2;
constexpr size_t WS_US = WS_UG + BLKE * 2;
constexpr size_t WS_HYV = WS_US + (size_t)16 * NCHUNK * 512 * 2;
constexpr size_t WS_HYX1 = WS_HYV + BLKE * 2;
constexpr size_t WS_HYX2 = WS_HYX1 + BLKE * 2;
constexpr size_t WS_HYG = WS_HYX2 + BLKE * 2;
constexpr size_t WS_HYZ = WS_HYG + BLKE * 2;
constexpr size_t WS_HYY = WS_HYZ + BLKE * 2;
constexpr size_t WS_END = WS_HYY + BLKE * 2;
static_assert(WS_END <= (size_t)1 << 30, "workspace map exceeds 1 GiB");
constexpr size_t WS_QM = WS_PB + 8 * BLKE * 2;
constexpr size_t WS_KM = WS_QM + (size_t)MROWS * 384 * 2;
constexpr size_t WS_VTM = WS_KM + (size_t)MROWS * 384 * 2;
constexpr size_t WS_E = WS_PB + 4 * BLKE * 2;
constexpr size_t WS_ZS = WS_PB + 6 * BLKE * 2;
constexpr size_t WS_OUTB = WS_PB + 8 * BLKE * 2;
constexpr size_t WS_HT = WS_PB;
static_assert(WS_VTM + BLKE * 2 == WS_PB + 12 * BLKE * 2, "alias map");

constexpr int CW_BAR = 0;
constexpr int CW_Q = 4096;
constexpr int CW_TMO = 4096 + 64 * 8;
constexpr int CW_DEP = 5120;
constexpr int DEP_SET = 20 * 64;
constexpr int CW_Q2 = 16384;
constexpr int CW_C7 = 20480;

__device__ __forceinline__ float bf2f(bf16_t v) { return __uint_as_float(((unsigned)v) << 16); }
__device__ __forceinline__ bf16_t f2bf(float f) { unsigned u = __float_as_uint(f); u += 0x7FFFu + ((u >> 16) & 1u); return (bf16_t)(u >> 16); }
__device__ __forceinline__ unsigned cvt_pk_bf16(float lo, float hi) { unsigned r; asm volatile("v_cvt_pk_bf16_f32 %0, %1, %2" : "=v"(r) : "v"(lo), "v"(hi)); return r; }
__device__ __forceinline__ float lo_bf(unsigned w) { return __uint_as_float(w << 16); }
__device__ __forceinline__ float hi_bf(unsigned w) { return __uint_as_float(w & 0xFFFF0000u); }
__device__ __forceinline__ float sigmf(float x) { float one = 1.f; asm volatile("" : "+v"(one)); return __builtin_amdgcn_rcpf(one + __builtin_amdgcn_exp2f(-1.4426950408889634f * x)); }
__device__ __forceinline__ float siluf(float x) { return x * sigmf(x); }
__device__ __forceinline__ float gelu_tanh(float x) { const float u = 0.7978845608028654f * (x + 0.044715f * x * x * x); return x * sigmf(2.f * u); }
__device__ __forceinline__ int opaque(int x) { asm volatile("" : "+v"(x)); return x; }
__device__ __forceinline__ int lane_id_fresh() { int x; asm volatile("v_mbcnt_lo_u32_b32 %0, -1, 0\n\tv_mbcnt_hi_u32_b32 %0, -1, %0" : "=v"(x)); return x; }
__device__ __forceinline__ float max3_raw(float a, float b, float c) { float r; asm("v_max3_f32 %0, %1, %2, %3" : "=v"(r) : "v"(a), "v"(b), "v"(c)); return r; }
template <int M> __device__ __forceinline__ float swz_xor(float v) { return __int_as_float(__builtin_amdgcn_ds_swizzle(__float_as_int(v), 0x1F | (M << 10))); }
__device__ __forceinline__ float half_sum(float v) { auto r = __builtin_amdgcn_permlane32_swap(__float_as_uint(v), __float_as_uint(v), false, false); return __uint_as_float(r[0]) + __uint_as_float(r[1]); }
__device__ __forceinline__ float half_max(float v) { auto r = __builtin_amdgcn_permlane32_swap(__float_as_uint(v), __float_as_uint(v), false, false); return fmaxf(__uint_as_float(r[0]), __uint_as_float(r[1])); }
__device__ __forceinline__ float half_other(float v, int h) { auto r = __builtin_amdgcn_permlane32_swap(__float_as_uint(v), __float_as_uint(v), false, false); return __uint_as_float(h ? r[0] : r[1]); }
__device__ __forceinline__ float wave_sum(float v) {
    v += swz_xor<16>(v); v += swz_xor<8>(v); v += swz_xor<4>(v); v += swz_xor<2>(v); v += swz_xor<1>(v);
    return half_sum(v);
}

#define XB_TMO      128
#define XB_XCNT(j)  (256  + 64 * (j))
#define XB_XSUB(j)  (1280 + 64 * (j))
#define XB_XGEN(j)  (2304 + 64 * (j))
#define XB_TOP      3328
#define XB_TOPGEN   3392
#define XCD_BAR_WORDS 3456
#define XB_SPIN_CAP (1u << 22)
__device__ __forceinline__ unsigned xb_ld(unsigned* p)              { return __hip_atomic_load(p, __ATOMIC_RELAXED, __HIP_MEMORY_SCOPE_AGENT); }
__device__ __forceinline__ unsigned xb_add(unsigned* p, unsigned v) { return __hip_atomic_fetch_add(p, v, __ATOMIC_RELAXED, __HIP_MEMORY_SCOPE_AGENT); }
__device__ __forceinline__ unsigned xb_xcc_id() { return (unsigned)__builtin_amdgcn_s_getreg((3 << 11) | 20) & 0xFu; }
#define XB_SPIN(cond, bar) do { unsigned _sp = 0; while (cond) { __builtin_amdgcn_s_sleep(1); \
    if ((++_sp & 255u) == 0u) { if (xb_ld(&(bar)[XB_TMO])) break; if (_sp > XB_SPIN_CAP) { atomicAdd(&(bar)[XB_TMO], 1u); break; } } } } while (0)
struct XcdBarrier { unsigned* bar; unsigned x; volatile LAS unsigned* st; };
__device__ __forceinline__ XcdBarrier xcd_barrier_post(unsigned* bar, volatile LAS unsigned* st) {
    XcdBarrier b; b.bar = bar; b.x = xb_xcc_id(); b.st = st;
    if (threadIdx.x == 0) (void)xb_add(&bar[XB_XCNT(b.x)], 1u);
    return b;
}
__device__ __forceinline__ void xcd_barrier_complete(unsigned* bar, unsigned x, unsigned& nloc, unsigned& nx) {
    const unsigned G = gridDim.x * gridDim.y * gridDim.z;
    unsigned sum, cnt, mine, sp = 0u;
    for (;;) {
        sum = 0u; cnt = 0u; mine = 0u;
#pragma unroll
        for (unsigned j = 0; j < 16; ++j) { const unsigned c = xb_ld(&bar[XB_XCNT(j)]); sum += c; cnt += (c > 0u) ? 1u : 0u; }
        mine = xb_ld(&bar[XB_XCNT(x)]);
        if (sum == G) break;
        __builtin_amdgcn_s_sleep(1);
        if ((++sp & 255u) == 0u) { if (xb_ld(&bar[XB_TMO])) break; if (sp > XB_SPIN_CAP) { atomicAdd(&bar[XB_TMO], 1u); break; } }
    }
    nloc = mine > 0u ? mine : 1u; nx = cnt > 0u ? cnt : 1u;
}
__device__ __forceinline__ void xcd_barrier(const XcdBarrier& b) {
    asm volatile("s_waitcnt vmcnt(0)" ::: "memory");
    __syncthreads();
    if (threadIdx.x == 0) {
        unsigned* bar = b.bar;
        __builtin_amdgcn_s_waitcnt(0);
        unsigned nloc = b.st[0], nx = b.st[1];
        if (nloc == 0u) { xcd_barrier_complete(bar, b.x, nloc, nx); b.st[0] = nloc; b.st[1] = nx; }
        const unsigned old = xb_add(&bar[XB_XSUB(b.x)], 1u);
        const unsigned gen = old / nloc;
        if (old + 1u == (gen + 1u) * nloc) {
            __builtin_amdgcn_fence(__ATOMIC_RELEASE, "agent");
            asm volatile("s_waitcnt vmcnt(0)" ::: "memory");
            const unsigned og = xb_add(&bar[XB_TOP], 1u);
            const unsigned tg = og / nx;
            if (og + 1u == (tg + 1u) * nx) xb_add(&bar[XB_TOPGEN], 1u);
            else XB_SPIN(xb_ld(&bar[XB_TOPGEN]) == tg, bar);
            __builtin_amdgcn_fence(__ATOMIC_ACQUIRE, "agent");
            xb_add(&bar[XB_XGEN(b.x)], 1u);
            asm volatile("s_waitcnt vmcnt(0)" ::: "memory");
        } else {
            XB_SPIN(xb_ld(&bar[XB_XGEN(b.x)]) == gen, bar);
            __builtin_amdgcn_fence(__ATOMIC_ACQUIRE, "agent");
            asm volatile("s_waitcnt vmcnt(0)" ::: "memory");
        }
    }
    __syncthreads();
}

namespace pg8 {
constexpr int BM = 256, BK = 64, HALF = 128, HTB = HALF * BK * 2, STAGE_BYTES = 8 * HTB, NXCD = 8, WGM = 8;
__host__ __device__ __forceinline__ int lds_byte(int r, int c) { const int st = (r >> 4) * 2 + (c >> 5), rr = r & 15, cc = c & 31, ob = rr * 64 + cc * 2; return st * 1024 + (ob ^ (((ob >> 9) & 1) << 5)); }
__host__ __device__ __forceinline__ void stage_rc(int b, int& R, int& C) { const int st = b / 1024, sb = b % 1024, swz = sb ^ (((sb >> 9) & 1) << 5); R = (st >> 1) * 16 + swz / 64; C = (st & 1) * 32 + (swz % 64) / 2; }
__host__ __device__ __forceinline__ int perm32(int rho) { const int n = rho >> 4, i = rho & 15; return 8 * (i >> 2) + 4 * n + (i & 3); }
struct Unit { int pm, pn, kd; };
struct Gemm { const bf16_t* A; const bf16_t* Bt; int M, N, K; };
struct StaticOrder {
    int nM, nN, nwg, G, c;
    __host__ __device__ void init(int M, int N, int G_, int c_) { nM = M / BM; nN = N / BM; nwg = nM * nN; G = G_; c = c_; }
    __host__ __device__ bool next(int i, Unit& u) const {
        const long L = (long)i * G + c; if (L >= nwg) return false;
        int wgid = (int)L; { const int q = nwg / NXCD, r = nwg % NXCD, xcd = wgid % NXCD, off = wgid / NXCD; wgid = (xcd < r ? xcd * (q + 1) : r * (q + 1) + (xcd - r) * q) + off; }
        const int nig = WGM * nN, gid = wgid / nig, fm = gid * WGM, gsz = (nM - fm) < WGM ? (nM - fm) : WGM;
        u.pm = fm + ((wgid % nig) % gsz); u.pn = (wgid % nig) / gsz; u.kd = 0; return true;
    }
    __device__ __forceinline__ void a_ready(const Unit&) const {}
    __device__ __forceinline__ void done(const Unit&) const {}
    __device__ __forceinline__ const char* abase(const Gemm& g, const Unit& u, size_t tstep) const { return (const char*)g.A + (size_t)u.pm * tstep; }
    __device__ __forceinline__ const char* bbase(const Gemm& g, const Unit& u, size_t tstep) const { return (const char*)g.Bt + (size_t)u.pn * tstep; }
};
struct LiveRowsOrder : StaticOrder {
    bool skip;
    __host__ __device__ void init2(int N, int G_, int c_, bool skip_) { skip = skip_; init(skip_ ? NB * SEQL : MROWS, N, G_, c_); }
    __host__ __device__ bool next(int i, Unit& u) const { if (!StaticOrder::next(i, u)) return false; if (skip) u.pm = (u.pm >> 4) * 17 + (u.pm & 15); return true; }
};
struct BatchedOrder {
    int nwg, G, c, tpg;
    __host__ __device__ void init(int ng, int tpg_, int G_, int c_) { nwg = ng * tpg_; tpg = tpg_; G = G_; c = c_; }
    __host__ __device__ bool next(int i, Unit& u) const { const int L = i * G + c; if (L >= nwg) return false; u.pm = L; u.pn = L / tpg; u.kd = 0; return true; }
    __device__ __forceinline__ void a_ready(const Unit&) const {}
    __device__ __forceinline__ void done(const Unit&) const {}
    __device__ __forceinline__ const char* abase(const Gemm& g, const Unit& u, size_t tstep) const { return (const char*)g.A + (size_t)u.pm * tstep; }
    __device__ __forceinline__ const char* bbase(const Gemm& g, const Unit& u, size_t tstep) const { return (const char*)g.Bt + (size_t)u.pn * tstep; }
};
struct P3Order {
    const bf16_t *b0, *b1, *wuq, *wuk, *wuv, *ug, *we; int G, c;
    __host__ __device__ bool next(int i, Unit& u) const {
        const int L = i * G + c; if (L >= 1360) return false;
        if (L < 544) { u.kd = 0; u.pm = L >> 1; u.pn = L & 1; } else if (L < 816) { u.kd = 1; u.pm = L - 544; u.pn = 0; } else if (L < 1088) { u.kd = 2; u.pm = 0; u.pn = L - 816; } else { u.kd = 3; u.pm = L - 1088; u.pn = (L - 1088) / 17; }
        return true;
    }
    __device__ __forceinline__ void a_ready(const Unit&) const {}
    __device__ __forceinline__ void done(const Unit&) const {}
    __device__ __forceinline__ const char* abase(const Gemm&, const Unit& u, size_t tstep) const { const bf16_t* p = u.kd == 0 ? b0 : u.kd == 1 ? b1 : u.kd == 2 ? wuv : ug; return (const char*)p + (size_t)u.pm * tstep; }
    __device__ __forceinline__ const char* bbase(const Gemm&, const Unit& u, size_t tstep) const { const bf16_t* p = u.kd == 0 ? wuq : u.kd == 1 ? wuk : u.kd == 2 ? b1 : we; return (const char*)p + (size_t)u.pn * tstep; }
};

struct OneUnit {
    int pm, pn;
    __host__ __device__ bool next(int i, Unit& u) const { if (i) return false; u.pm = pm; u.pn = pn; u.kd = 0; return true; }
    __device__ __forceinline__ void a_ready(const Unit&) const {}
    __device__ __forceinline__ void done(const Unit&) const {}
    __device__ __forceinline__ const char* abase(const Gemm& g, const Unit& u, size_t tstep) const { return (const char*)g.A + (size_t)u.pm * tstep; }
    __device__ __forceinline__ const char* bbase(const Gemm& g, const Unit& u, size_t tstep) const { return (const char*)g.Bt + (size_t)u.pn * tstep; }
};
template <class Epi, class Sched>
__device__ __forceinline__ void gemm_phase(LAS unsigned char* lds, const Gemm g, const Sched& S, const Epi& E, int tid_in) {
    const int tid = tid_in, wid = __builtin_amdgcn_readfirstlane(tid >> 6), lane = tid & 63, wr = wid >> 2, wc = wid & 3, fr = lane & 15, fq = lane >> 4;
    const int K = g.K, nt = K / BK;
    unsigned voffA[2], voffB[2];
#pragma unroll
    for (int i = 0; i < 2; ++i) { int R, C; stage_rc(tid * 16 + i * 8192, R, C); const int Rb = Epi::PERM ? ((R & ~31) + perm32(R & 31)) : R;
        voffA[i] = (unsigned)(R * K + C) * 2u; voffB[i] = (unsigned)(Rb * K + C) * 2u; }
    const size_t kstep = (size_t)(BK * 2);
    const size_t hstep = (size_t)HALF * K * 2;
    const size_t tstep = 2 * hstep;
    const unsigned ldsw = (unsigned)wid * 1024u;
    const int aoff = lds_byte(wr * 64 + fr, fq * 8), boff = lds_byte(wc * 32 + fr, fq * 8);
#define PG8_SA(b, h) (((b) * 2 + (h)) * HTB)
#define PG8_SB(b, h) ((4 + (b) * 2 + (h)) * HTB)
#define PG8_STAGE(bufoff, gbase, voff) do { _Pragma("unroll") for (int _i = 0; _i < 2; ++_i) \
        __builtin_amdgcn_global_load_lds((const unsigned*)((const char*)(gbase) + (voff)[_i]), (LAS unsigned*)(lds + (bufoff) + ldsw + _i * 8192), 16, 0, 0); } while (0)
#define PG8_LDA(dst, b, h) do { _Pragma("unroll") for (int m = 0; m < 4; ++m) _Pragma("unroll") for (int k = 0; k < 2; ++k) dst[m][k] = *(const LAS bf16x8*)(lds + PG8_SA(b, h) + aoff + m * 2048 + k * 1024); } while (0)
#define PG8_LDB(dst, b, h) do { _Pragma("unroll") for (int n = 0; n < 2; ++n) _Pragma("unroll") for (int k = 0; k < 2; ++k) dst[n][k] = *(const LAS bf16x8*)(lds + PG8_SB(b, h) + boff + n * 2048 + k * 1024); } while (0)
#define PG8_MMA(ai, bj, At, Bt) do { __builtin_amdgcn_s_setprio(1); _Pragma("unroll") for (int m = 0; m < 4; ++m) _Pragma("unroll") for (int n = 0; n < 2; ++n) _Pragma("unroll") for (int k = 0; k < 2; ++k) \
        acc[ai][bj][m][n] = __builtin_amdgcn_mfma_f32_16x16x32_bf16(Bt[n][k], At[m][k], acc[ai][bj][m][n], 0, 0, 0); __builtin_amdgcn_s_setprio(0); } while (0)
#define PG8_WAIT_V(n) asm volatile("s_waitcnt vmcnt(" #n ")" ::: "memory")
#define PG8_WAIT_L(n) asm volatile("s_waitcnt lgkmcnt(" #n ")" ::: "memory")
#define PG8_BAR __builtin_amdgcn_s_barrier()
#define PG8_SCHED __builtin_amdgcn_sched_barrier(0)
    Unit cur, nxt; int ui = 0;
    if (!S.next(0, cur)) return;
    f32x4 acc[2][2][4][2];
#pragma unroll
    for (int a = 0; a < 2; ++a)
#pragma unroll
        for (int b = 0; b < 2; ++b)
#pragma unroll
            for (int m = 0; m < 4; ++m)
#pragma unroll
                for (int n = 0; n < 2; ++n) acc[a][b][m][n] = (f32x4){0.f, 0.f, 0.f, 0.f};
    bf16x8 At[4][2], B0[2][2], B1[2][2];
    const char* cA = S.abase(g, cur, tstep); const char* cB = S.bbase(g, cur, tstep);
    S.a_ready(cur);
    PG8_STAGE(PG8_SB(0, 0), cB, voffB); PG8_STAGE(PG8_SA(0, 0), cA, voffA); PG8_STAGE(PG8_SB(0, 1), cB + hstep, voffB); PG8_STAGE(PG8_SA(0, 1), cA + hstep, voffA);
    if (wr == 1) PG8_BAR;
    PG8_WAIT_V(4); PG8_BAR;
    PG8_STAGE(PG8_SB(1, 0), cB + kstep, voffB); PG8_STAGE(PG8_SA(1, 0), cA + kstep, voffA); PG8_STAGE(PG8_SB(1, 1), cB + hstep + kstep, voffB);
    PG8_WAIT_V(6); PG8_BAR;
    for (;;) {
        const bool has_next = S.next(ui + 1, nxt);
        const char* nA = has_next ? S.abase(g, nxt, tstep) : cA; const char* nB = has_next ? S.bbase(g, nxt, tstep) : cB;
        for (int t = 0; t < nt; t += 2) {
            const bool last = (t == nt - 2);
            const char* a1 = cA + (size_t)(t + 1) * kstep;
            const char* a2 = last ? nA : cA + (size_t)(t + 2) * kstep; const char* b2 = last ? nB : cB + (size_t)(t + 2) * kstep;
            const char* a3 = a2 + kstep; const char* b3 = b2 + kstep;
            if (last && has_next) S.a_ready(nxt);
            PG8_LDB(B0, 0, 0); PG8_SCHED; PG8_LDA(At, 0, 0); PG8_STAGE(PG8_SA(1, 1), a1 + hstep, voffA);
            PG8_WAIT_L(8); PG8_BAR; PG8_WAIT_L(0); PG8_MMA(0, 0, At, B0); PG8_BAR; PG8_SCHED;
            PG8_LDB(B1, 0, 1); PG8_STAGE(PG8_SB(0, 0), b2, voffB);
            PG8_BAR; PG8_WAIT_L(0); PG8_MMA(0, 1, At, B1); PG8_BAR;
            PG8_LDA(At, 0, 1); PG8_STAGE(PG8_SA(0, 0), a2, voffA);
            PG8_BAR; PG8_WAIT_L(0); PG8_MMA(1, 0, At, B0); PG8_BAR; PG8_SCHED;
            PG8_STAGE(PG8_SB(0, 1), b2 + hstep, voffB);
            PG8_WAIT_V(6); PG8_BAR; PG8_MMA(1, 1, At, B1); PG8_BAR;
            PG8_LDB(B0, 1, 0); PG8_SCHED; PG8_LDA(At, 1, 0); PG8_STAGE(PG8_SA(0, 1), a2 + hstep, voffA);
            PG8_WAIT_L(8); PG8_BAR; PG8_WAIT_L(0); PG8_MMA(0, 0, At, B0); PG8_BAR; PG8_SCHED;
            PG8_LDB(B1, 1, 1); PG8_STAGE(PG8_SB(1, 0), b3, voffB);
            PG8_BAR; PG8_WAIT_L(0); PG8_MMA(0, 1, At, B1); PG8_BAR;
            PG8_LDA(At, 1, 1); PG8_STAGE(PG8_SA(1, 0), a3, voffA);
            PG8_BAR; PG8_WAIT_L(0); PG8_MMA(1, 0, At, B0); PG8_BAR; PG8_SCHED;
            PG8_STAGE(PG8_SB(1, 1), b3 + hstep, voffB);
            PG8_WAIT_V(6); PG8_BAR; PG8_MMA(1, 1, At, B1); PG8_BAR;
        }
        { const int l2 = lane_id_fresh(); E(acc, cur, wr, wc, l2 & 15, l2 >> 4); } S.done(cur);
        if (!has_next) break;
#pragma unroll
        for (int a = 0; a < 2; ++a)
#pragma unroll
            for (int b = 0; b < 2; ++b)
#pragma unroll
                for (int m = 0; m < 4; ++m)
#pragma unroll
                    for (int n = 0; n < 2; ++n) acc[a][b][m][n] = (f32x4){0.f, 0.f, 0.f, 0.f};
        cur = nxt; cA = nA; cB = nB; ++ui;
    }
    PG8_WAIT_V(0);
    if (wr == 0) PG8_BAR;
    PG8_BAR;
#undef PG8_SA
#undef PG8_SB
#undef PG8_STAGE
#undef PG8_LDA
#undef PG8_LDB
#undef PG8_MMA
#undef PG8_WAIT_V
#undef PG8_WAIT_L
#undef PG8_BAR
#undef PG8_SCHED
}

template <class F> struct EpiWalk {
    static constexpr bool PERM = true, AFTER_DRAIN = false;
    F f;
    __device__ __forceinline__ void operator()(const f32x4 (&acc)[2][2][4][2], const Unit& u, int wr, int wc, int fr, int fq) const {
#pragma unroll
        for (int ai = 0; ai < 2; ++ai)
#pragma unroll
            for (int m = 0; m < 4; ++m) {
                const int rin = ai * HALF + wr * 64 + m * 16 + fr;
#pragma unroll
                for (int bj = 0; bj < 2; ++bj) { const int cin = bj * HALF + wc * 32 + 8 * fq; f.put(u.pm, u.pn, rin, cin, acc[ai][bj][m][0], acc[ai][bj][m][1]); asm volatile("" ::: "memory"); }
            }
    }
};
template <class F> struct EpiWalkPF {
    static constexpr bool PERM = true, AFTER_DRAIN = false;
    F f;
    __device__ __forceinline__ void operator()(const f32x4 (&acc)[2][2][4][2], const Unit& u, int wr, int wc, int fr, int fq) const {
        typename F::Inv iv[2];
#pragma unroll
        for (int bj = 0; bj < 2; ++bj) iv[bj] = f.inv(u.pm, u.pn, bj * HALF + wc * 32 + 8 * fq);
#pragma unroll
        for (int ai = 0; ai < 2; ++ai) {
            typename F::Pre pre[4][2];
#pragma unroll
            for (int m = 0; m < 4; ++m)
#pragma unroll
                for (int bj = 0; bj < 2; ++bj) pre[m][bj] = f.pre(u.pm, u.pn, ai * HALF + wr * 64 + m * 16 + fr, bj * HALF + wc * 32 + 8 * fq);
            asm volatile("" ::: "memory");
#pragma unroll
            for (int m = 0; m < 4; ++m) {
                const int rin = ai * HALF + wr * 64 + m * 16 + fr;
#pragma unroll
                for (int bj = 0; bj < 2; ++bj) { const int cin = bj * HALF + wc * 32 + 8 * fq; f.put(u.pm, u.pn, rin, cin, acc[ai][bj][m][0], acc[ai][bj][m][1], pre[m][bj], iv[bj]); asm volatile("" ::: "memory"); }
            }
        }
    }
};
}

__device__ __forceinline__ u32x4 pack8(const f32x4& a, const f32x4& b) {
    u32x4 w; w.x = cvt_pk_bf16(a[0], a[1]); w.y = cvt_pk_bf16(a[2], a[3]); w.z = cvt_pk_bf16(b[0], b[1]); w.w = cvt_pk_bf16(b[2], b[3]); return w;
}
__device__ __forceinline__ void unpack8(const u32x4 w, float (&o)[8]) {
    o[0] = lo_bf(w.x); o[1] = hi_bf(w.x); o[2] = lo_bf(w.y); o[3] = hi_bf(w.y); o[4] = lo_bf(w.z); o[5] = hi_bf(w.z); o[6] = lo_bf(w.w); o[7] = hi_bf(w.w);
}

struct PutPlain {
    bf16_t* dst; int ldc, ncols;
    __device__ __forceinline__ void put(int pm, int pn, int rin, int cin, const f32x4& a, const f32x4& b) const { const int col = pn * 256 + cin; if (col < ncols) *(u32x4*)(dst + ((size_t)pm * 256 + rin) * ldc + col) = pack8(a, b); }
};
struct PutPlainWT {
    bf16_t* dst; int ldc, ncols;
    __device__ __forceinline__ void put(int pm, int pn, int rin, int cin, const f32x4& a, const f32x4& b) const {
        const int col = pn * 256 + cin; const u32x4 w = pack8(a, b); GAS bf16_t* p = (GAS bf16_t*)(dst + ((size_t)pm * 256 + rin) * ldc + col);
        asm volatile("global_store_dwordx4 %0, %1, off sc1" :: "v"(p), "v"(w) : "memory"); }
};
struct PutKm {
    bf16_t* km; const bf16_t* kr;
    __device__ __forceinline__ void put(int pm, int pn, int rin, int cin, const f32x4& a, const f32x4& b) const {
        const int bb = pm / 17, key = (pm - bb * 17) * 256 + rin, hd = cin >> 6, d = cin & 63;
        bf16_t* dst = km + ((size_t)(bb * 4 + hd) * NTOK + key) * 96;
        *(u32x4*)(dst + d) = pack8(a, b);
        if (d < 32) *(u32x4*)(dst + 64 + d) = *(const u32x4*)(kr + ((size_t)pm * 256 + rin) * 32 + d);
    }
    __device__ __forceinline__ u32x4 pre(int pm, int rin, int cin) const { const int d = cin & 63; return (d < 32) ? *(const u32x4*)(kr + ((size_t)pm * 256 + rin) * 32 + d) : (u32x4){0u, 0u, 0u, 0u}; }
    __device__ __forceinline__ void put2(int pm, int pn, int rin, int cin, const f32x4& a, const f32x4& b, const u32x4& kw) const {
        const int bb = pm / 17, key = (pm - bb * 17) * 256 + rin, hd = cin >> 6, d = cin & 63;
        bf16_t* dst = km + ((size_t)(bb * 4 + hd) * NTOK + key) * 96;
        *(u32x4*)(dst + d) = pack8(a, b);
        if (d < 32) *(u32x4*)(dst + 64 + d) = kw;
    }
};
struct PutVt {
    bf16_t* vt;
    __device__ __forceinline__ void put(int pm, int pn, int rin, int cin, const f32x4& a, const f32x4& b) const {
        const int bb = pn / 17, key = (pn - bb * 17) * 256 + cin;
        *(u32x4*)(vt + ((size_t)(bb * 4 + (rin >> 6)) * 64 + (rin & 63)) * NTOK + key) = pack8(a, b);
    }
};
struct PutE {
    bf16_t* e;
    __device__ __forceinline__ void put(int pm, int pn, int rin, int cin, const f32x4& a, const f32x4& b) const { *(u32x4*)(e + ((size_t)pm * 256 + rin) * 256 + cin) = pack8(a, b); }
};
struct PutSsmY {
    bf16_t* zs; const bf16_t* ug; const float* dskip;
    struct Inv { f32x4 d0, d1; }; typedef u32x4 Pre;
    __device__ __forceinline__ Inv inv(int pm, int pn, int cin) const { const int ch = pn * 16 + (cin & 15); Inv v; v.d0 = *(const f32x4*)(dskip + ch); v.d1 = *(const f32x4*)(dskip + ch + 4); return v; }
    __device__ __forceinline__ Pre pre(int pm, int pn, int rin, int cin) const { const int g = pn, n = (pm - g * 17) * 256 + rin, tok = n * 16 + (cin >> 4), ho = cin & 15; return *(const u32x4*)(ug + ((size_t)g * MROWS + tok) * 16 + ho); }
    __device__ __forceinline__ void put(int pm, int pn, int rin, int cin, const f32x4& a, const f32x4& b, const Pre& pw, const Inv& iv) const {
        const int g = pn, n = (pm - g * 17) * 256 + rin, tok = n * 16 + (cin >> 4), ho = cin & 15, ch = g * 16 + ho;
        float u[8]; unpack8(pw, u);
        f32x4 y0, y1;
#pragma unroll
        for (int i = 0; i < 4; ++i) { y0[i] = gelu_tanh(a[i] + iv.d0[i] * u[i]); y1[i] = gelu_tanh(b[i] + iv.d1[i] * u[4 + i]); }
        *(u32x4*)(zs + (size_t)tok * 256 + ch) = pack8(y0, y1);
    }
};
struct PutGlu {
    bf16_t* cat; const bf16_t* zs; const bf16_t* gate; const float* gb;
    struct Inv { f32x4 b0, b1; }; struct Pre { u32x4 z, g; };
    __device__ __forceinline__ Inv inv(int pm, int pn, int cin) const { Inv v; v.b0 = *(const f32x4*)(gb + cin); v.b1 = *(const f32x4*)(gb + cin + 4); return v; }
    __device__ __forceinline__ Pre pre(int pm, int pn, int rin, int cin) const { const size_t row = (size_t)pm * 256 + rin; Pre r; r.z = *(const u32x4*)(zs + row * 256 + cin); r.g = *(const u32x4*)(gate + row * 256 + cin); return r; }
    __device__ __forceinline__ void put(int pm, int pn, int rin, int cin, const f32x4& a, const f32x4& b, const Pre& pw, const Inv& iv) const {
        const size_t row = (size_t)pm * 256 + rin; const int col = cin;
        float z[8], gt[8]; unpack8(pw.z, z); unpack8(pw.g, gt);
        f32x4 y0, y1;
#pragma unroll
        for (int i = 0; i < 4; ++i) { y0[i] = z[i] * sigmf(a[i] + iv.b0[i]) * siluf(gt[i]); y1[i] = z[4 + i] * sigmf(b[i] + iv.b1[i]) * siluf(gt[4 + i]); }
        *(u32x4*)(cat + row * DM + 512 + col) = pack8(y0, y1);
    }
};

struct EpiInProj {
    static constexpr bool PERM = true, AFTER_DRAIN = false;
    bf16_t *pb, *ug, *us, *vtg, *hy0;
    LAS unsigned char* scratch;
    __device__ __forceinline__ void operator()(const f32x4 (&acc)[2][2][4][2], const pg8::Unit& u, int wr, int wc, int fr, int fq) const {
        const int pn = u.pn, pm = u.pm;
        const int bb = pm / 17, jt = (pm - bb * 17) * 256;
        LAS unsigned char* sw = scratch + (wr * 4 + wc) * 1280;
        const int ln = fq * 16 + fr, tch = ln >> 1, thalf = ln & 1;
#pragma unroll
        for (int ai = 0; ai < 2; ++ai)
#pragma unroll
            for (int m = 0; m < 4; ++m) {
                const int rin = ai * pg8::HALF + wr * 64 + m * 16 + fr;
#pragma unroll
                for (int bj = 0; bj < 2; ++bj) {
                    const int cin = bj * pg8::HALF + wc * 32 + 8 * fq;
                    const u32x4 w = pack8(acc[ai][bj][m][0], acc[ai][bj][m][1]);
                    const bool plain = pn < 4 || pn == 5 || pn == 7 || (pn == 4 && bj == 0);
                    if (plain) { *(u32x4*)(pb + (size_t)pn * BLKE + ((size_t)pm * 256 + rin) * 256 + cin) = w; }
                    else if (pn == 6) { const size_t row = (size_t)pm * 256 + rin; const int g = cin >> 4, hi0 = cin & 15;
                        *(u32x4*)(ug + ((size_t)g * MROWS + row) * 16 + hi0) = w;
                        *(u32x4*)(us + ((size_t)g * NCHUNK + (row >> 4)) * 512 + (row & 15) * 16 + hi0) = w; }
                    else {
                        *(LAS u32x4*)(sw + fr * 80 + fq * 16) = w;
                        asm volatile("" ::: "memory");
                        unsigned short e[8];
#pragma unroll
                        for (int i = 0; i < 8; ++i) e[i] = *(const LAS unsigned short*)(sw + (thalf * 8 + i) * 80 + tch * 2);
                        asm volatile("" ::: "memory");
                        u32x4 t; t.x = e[0] | ((unsigned)e[1] << 16); t.y = e[2] | ((unsigned)e[3] << 16); t.z = e[4] | ((unsigned)e[5] << 16); t.w = e[6] | ((unsigned)e[7] << 16);
                        const int chn = bj * pg8::HALF + wc * 32 + tch;
                        const int tok = jt + ai * pg8::HALF + wr * 64 + m * 16 + thalf * 8;
                        bf16_t* dst = (pn == 4) ? vtg + ((size_t)(bb * 2 + ((chn - 128) >> 6)) * 64 + ((chn - 128) & 63)) * NTOK + tok
                                                : hy0 + (size_t)(pn - 8) * BLKE + ((size_t)chn * 16 + bb) * NTOK + tok;
                        *(u32x4*)dst = t;
                    }
                    asm volatile("" ::: "memory");
                }
            }
    }
};

struct EpiP3 {
    static constexpr bool PERM = true, AFTER_DRAIN = false;
    PutPlain q; PutKm k; PutVt v; PutE e;
    __device__ __forceinline__ void operator()(const f32x4 (&acc)[2][2][4][2], const pg8::Unit& u, int wr, int wc, int fr, int fq) const {
        if (u.kd == 1) {
#pragma unroll
            for (int ai = 0; ai < 2; ++ai) {
                u32x4 pre[4][2];
#pragma unroll
                for (int m = 0; m < 4; ++m)
#pragma unroll
                    for (int bj = 0; bj < 2; ++bj) pre[m][bj] = k.pre(u.pm, ai * pg8::HALF + wr * 64 + m * 16 + fr, bj * pg8::HALF + wc * 32 + 8 * fq);
                asm volatile("" ::: "memory");
#pragma unroll
                for (int m = 0; m < 4; ++m)
#pragma unroll
                    for (int bj = 0; bj < 2; ++bj) { k.put2(u.pm, u.pn, ai * pg8::HALF + wr * 64 + m * 16 + fr, bj * pg8::HALF + wc * 32 + 8 * fq, acc[ai][bj][m][0], acc[ai][bj][m][1], pre[m][bj]); asm volatile("" ::: "memory"); }
            }
            return;
        }
#pragma unroll
        for (int ai = 0; ai < 2; ++ai)
#pragma unroll
            for (int m = 0; m < 4; ++m) {
                const int rin = ai * pg8::HALF + wr * 64 + m * 16 + fr;
#pragma unroll
                for (int bj = 0; bj < 2; ++bj) { const int cin = bj * pg8::HALF + wc * 32 + 8 * fq;
                    if (u.kd == 0) q.put(u.pm, u.pn, rin, cin, acc[ai][bj][m][0], acc[ai][bj][m][1]);
                    else if (u.kd == 1) k.put(u.pm, u.pn, rin, cin, acc[ai][bj][m][0], acc[ai][bj][m][1]);
                    else if (u.kd == 2) v.put(u.pm, u.pn, rin, cin, acc[ai][bj][m][0], acc[ai][bj][m][1]);
                    else e.put(u.pm, u.pn, rin, cin, acc[ai][bj][m][0], acc[ai][bj][m][1]);
                    asm volatile("" ::: "memory"); }
            }
    }
};

struct Params {
    const float* in[36];
    float* out;
    unsigned char* ws;
    int ph_lo, ph_hi, dry, pad;
};
enum { I_X = 0, I_C, I_CTX, I_CCTX, I_WMOD, I_BMOD, I_GPRE, I_GPOST, I_WIN, I_WOUT, I_GCQ, I_WUQ, I_GCKV, I_WUKV, I_GQ, I_GK,
       I_LRE, I_LIM, I_LSTEP, I_BRE, I_BIM, I_CRE, I_CIM, I_SSMD, I_GLUW, I_GLUB, I_HCW, I_HCB, I_HW1, I_HB1, I_HF1, I_HW2, I_HB2, I_HF2, I_HW3, I_HBIAS };

typedef __attribute__((address_space(4))) const unsigned long long* kargp_t;
struct Ctx {
    LAS unsigned char* lds;
    kargp_t ka;
    unsigned char* ws;
    int tid, lane, wave, G, bid, dry;
};
#define KIN(i) ((const float*)(GAS const float*)c.ka[(i)])
#define KOUT() ((float*)(GAS float*)c.ka[36])
template <class T> __device__ __forceinline__ T* wsp(const Ctx& c, size_t off) { return (T*)(c.ws + off); }

__device__ __forceinline__ int wmap(int kind, int n) {
    if (kind == 0) { if (n < 192) return n; if (n < 224) return 320 + (n - 192); if (n < 256) return -1; if (n < 384) return 192 + (n - 256); if (n < 512) return -1; return n - 160; }
    if (kind == 2) return (n >> 6) * 128 + (n & 63);
    if (kind == 3) return (n >> 6) * 128 + 64 + (n & 63);
    return n;
}
__device__ __forceinline__ void wconv_tile(const Ctx& c, const float* src, int Ks, int Ns, int Nlim, bf16_t* dst, int Kp, int kind, int nt, int kt) {
    LAS float* T = (LAS float*)c.lds;
    const int n0 = nt * 64, k0 = kt * 128;
    const int nn = c.tid & 63, kk0 = c.tid >> 6; const int n = n0 + nn; const int sc = (n < Nlim) ? wmap(kind, n) : -1;
    float v[16];
#pragma unroll
    for (int i = 0; i < 16; ++i) { const int k = k0 + kk0 + 8 * i; v[i] = (k < Ks && sc >= 0) ? src[(size_t)k * Ns + sc] : 0.f; }
#pragma unroll
    for (int i = 0; i < 16; ++i) T[(kk0 + 8 * i) * 65 + nn] = v[i];
    __syncthreads();
#pragma unroll
    for (int i = 0; i < 2; ++i) { const int e = c.tid + i * 512, row = e >> 4, pc = e & 15; float x[8];
#pragma unroll
        for (int j = 0; j < 8; ++j) x[j] = T[(pc * 8 + j) * 65 + row];
        u32x4 w; w.x = cvt_pk_bf16(x[0], x[1]); w.y = cvt_pk_bf16(x[2], x[3]); w.z = cvt_pk_bf16(x[4], x[5]); w.w = cvt_pk_bf16(x[6], x[7]);
        *(u32x4*)(dst + (size_t)(n0 + row) * Kp + k0 + pc * 8) = w; }
    __syncthreads();
}

__device__ __forceinline__ void modv_job(const Ctx& c, int job) {
    const int l = job / 48, j0 = (job % 48) * 64;
    LAS float* sc = (LAS float*)c.lds;
    LAS float* red = sc + 17 * 1024;
    const float* cv = KIN(I_C); const float* cc = KIN(I_CCTX);
    for (int e = c.tid; e < 17 * 1024; e += 512) { const int r = e >> 10, k = e & 1023; const float v = (r < 16) ? cv[r * 1024 + k] : cc[k]; sc[e] = siluf(v); }
    __syncthreads();
    const int col = c.tid & 63, ks = c.tid >> 6;
    const float* w = KIN(I_WMOD) + (size_t)l * 1024 * 3072 + j0 + col;
    float acc[17];
#pragma unroll
    for (int r = 0; r < 17; ++r) acc[r] = 0.f;
    for (int k = ks * 128; k < ks * 128 + 128; ++k) { const float wv = w[(size_t)k * 3072];
#pragma unroll
        for (int r = 0; r < 17; ++r) acc[r] += sc[r * 1024 + k] * wv; }
#pragma unroll
    for (int r = 0; r < 17; ++r) red[(ks * 17 + r) * 64 + col] = acc[r];
    __syncthreads();
    float* mv = wsp<float>(c, WS_MODV);
    for (int e = c.tid; e < 17 * 64; e += 512) { const int r = e >> 6, cl = e & 63; float s = KIN(I_BMOD)[l * 3072 + j0 + cl];
#pragma unroll
        for (int q = 0; q < 8; ++q) s += red[(q * 17 + r) * 64 + cl];
        mv[((size_t)l * 17 + r) * 3072 + j0 + cl] = s; }
    __syncthreads();
}

__device__ __forceinline__ void rope_job(const Ctx& c) {
    float* rg = wsp<float>(c, WS_ROPEG); float* rm = wsp<float>(c, WS_ROPEM);
    for (int e = c.tid; e < 64 * 16; e += 512) { const int pos = e >> 4, f = e & 15; const float inv = powf(10000.f, -(float)(2 * f) / 32.f); const float a = (float)pos * inv; rg[e * 2] = cosf(a); rg[e * 2 + 1] = sinf(a); }
    for (int e = c.tid; e < 64 * 8; e += 512) { const int pos = e >> 3, f = e & 7; const float inv = powf(10000.f, -(float)(2 * f) / 16.f); const float a = (float)pos * inv; rm[e * 2] = cosf(a); rm[e * 2 + 1] = sinf(a); }
}

typedef float cpx __attribute__((ext_vector_type(2)));
#define CPX(a, b) ((cpx){(a), (b)})
__device__ __forceinline__ cpx cmul(cpx a, cpx b) { return CPX(a.x * b.x - a.y * b.y, a.x * b.y + a.y * b.x); }
__device__ __forceinline__ void ssm_tables_job(const Ctx& c, int job) {
    const int l = job >> 4, g = job & 15;
    LAS cpx* apow = (LAS cpx*)c.lds;
    LAS cpx* bbar = apow + 2 * 17 * 64;
    LAS cpx* cm = bbar + 2 * 64 * 16;
    LAS float* Kc = (LAS float*)(cm + 2 * 16 * 64);
    for (int e = c.tid; e < 2 * 64; e += 512) {
        const int d = e >> 6, p = e & 63; const size_t ix = (((size_t)l * 2 + d) * 16 + g) * 64 + p;
        const float lr = KIN(I_LRE)[ix], li = KIN(I_LIM)[ix], st = expf(KIN(I_LSTEP)[((size_t)l * 2 + d) * 16 + g]);
        for (int k = 0; k <= 16; ++k) { const float m = expf(lr * st * (float)k), an = li * st * (float)k; apow[(d * 17 + k) * 64 + p] = CPX(m * cosf(an), m * sinf(an)); }
    }
    __syncthreads();
    for (int e = c.tid; e < 2 * 64 * 16; e += 512) {
        const int d = e >> 10, p = (e >> 4) & 63, h = e & 15; const size_t ix = (((size_t)l * 2 + d) * 16 + g) * 64 + p;
        const float lr = KIN(I_LRE)[ix], li = KIN(I_LIM)[ix];
        const cpx a = apow[(d * 17 + 1) * 64 + p]; const cpx am1 = CPX(a.x - 1.f, a.y);
        const float den = lr * lr + li * li; const cpx q = CPX((am1.x * lr + am1.y * li) / den, (am1.y * lr - am1.x * li) / den);
        const cpx b = CPX(KIN(I_BRE)[ix * 16 + h], KIN(I_BIM)[ix * 16 + h]);
        bbar[e] = cmul(q, b);
        const size_t cx = ((((size_t)l * 2 + d) * 16 + g) * 16 + h) * 64 + p;
        cm[(d * 16 + h) * 64 + p] = CPX(KIN(I_CRE)[cx], KIN(I_CIM)[cx]);
    }
    __syncthreads();
    for (int e = c.tid; e < 2 * 16 * 256; e += 512) {
        const int d = e >> 12, dd = (e >> 8) & 15, ho = (e >> 4) & 15, hi = e & 15; float s = 0.f;
        for (int p = 0; p < 64; ++p) { const cpx w = cmul(cm[(d * 16 + ho) * 64 + p], apow[(d * 17 + dd) * 64 + p]); const cpx b = bbar[(d * 64 + p) * 16 + hi]; s += w.x * b.x - w.y * b.y; }
        Kc[e] = s;
    }
    __syncthreads();
    bf16_t* wkc = wsp<bf16_t>(c, WS_WKC) + ((size_t)l * 16 + g) * 256 * 512;
    for (int e = c.tid; e < 256 * 512; e += 512) {
        const int r = e >> 9, q = e & 511, i = r >> 4, ho = r & 15; float v;
        if (q < 256) { const int j = q >> 4, hi = q & 15; v = 0.f; if (j <= i) v += Kc[((0 * 16 + (i - j)) * 16 + ho) * 16 + hi]; if (j >= i) v += Kc[((1 * 16 + (j - i)) * 16 + ho) * 16 + hi]; }
        else { const int qq = q - 256, dq = qq >> 7, comp = (qq >> 6) & 1, p = qq & 63, k = dq == 0 ? i + 1 : 16 - i; const cpx w = cmul(cm[(dq * 16 + ho) * 64 + p], apow[(dq * 17 + k) * 64 + p]); v = comp == 0 ? w.x : -w.y; }
        wkc[e] = f2bf(v);
    }
    bf16_t* we = wsp<bf16_t>(c, WS_WE) + ((size_t)l * 16 + g) * 256 * 256;
    for (int e = c.tid; e < 256 * 256; e += 512) {
        const int qq = e >> 8, cidx = e & 255, j = cidx >> 4, hi = cidx & 15, dq = qq >> 7, comp = (qq >> 6) & 1, p = qq & 63, k = dq == 0 ? 15 - j : j;
        const cpx w = cmul(apow[(dq * 17 + k) * 64 + p], bbar[(dq * 64 + p) * 16 + hi]);
        we[e] = f2bf(comp == 0 ? w.x : w.y);
    }
    float* a16 = wsp<float>(c, WS_A16);
    for (int e = c.tid; e < 128; e += 512) { const int d = e >> 6, p = e & 63; const cpx a = apow[(d * 17 + 16) * 64 + p]; const size_t ix = ((((size_t)l * 2 + d) * 16 + g) * 64 + p) * 2; a16[ix] = a.x; a16[ix + 1] = a.y; }
    __syncthreads();
}

__device__ __forceinline__ void hyena_mlp_job(const Ctx& c, int job) {
    const int l = job / 136, tt = job % 136;
    const bool isctx = tt >= 128; const int n = isctx ? CTXL : SEQL; const int t0 = isctx ? (tt - 128) * 32 : tt * 32;
    LAS float* z = (LAS float*)c.lds;
    LAS float* h1 = z + 32 * 36;
    LAS float* h2 = h1 + 32 * 64;
    for (int e = c.tid; e < 32 * 33; e += 512) {
        const int ti = e / 33, f = e % 33, t = t0 + ti; float v;
        if (f == 0) v = (float)t / (float)(n - 1);
        else { const int k = (f - 1) & 15; const float band = 1e-4f + (float)k * ((15.f - 1e-4f) / 15.f); const float om = 6.283185307179586f * (float)t / (float)n; v = (f <= 16) ? cosf(band * om) : -sinf(band * om); }
        z[ti * 36 + f] = v;
    }
    __syncthreads();
    for (int e = c.tid; e < 32 * 64; e += 512) {
        const int ti = e >> 6, j = e & 63; float s = KIN(I_HB1)[l * 64 + j];
        for (int f = 0; f < 33; ++f) s += z[ti * 36 + f] * KIN(I_HW1)[((size_t)l * 33 + f) * 64 + j];
        h1[e] = sinf(KIN(I_HF1)[l * 64 + j] * s);
    }
    __syncthreads();
    for (int e = c.tid; e < 32 * 64; e += 512) {
        const int ti = e >> 6, j = e & 63; float s = KIN(I_HB2)[l * 64 + j];
        for (int f = 0; f < 64; ++f) s += h1[ti * 64 + f] * KIN(I_HW2)[((size_t)l * 64 + f) * 64 + j];
        h2[e] = sinf(KIN(I_HF2)[l * 64 + j] * s);
    }
    __syncthreads();
    float* hT = wsp<float>(c, WS_HT) + (size_t)l * 1024 * NTOK;
    const float mind = -3.070113457325394f, maxd = -15.35056728662697f;
#pragma unroll
    for (int cc = 0; cc < 2; ++cc) {
        const int col = c.tid + cc * 512;
        float acc[32];
#pragma unroll
        for (int ti = 0; ti < 32; ++ti) acc[ti] = 0.f;
        for (int f = 0; f < 64; ++f) { const float w = KIN(I_HW3)[((size_t)l * 64 + f) * 1024 + col];
#pragma unroll
            for (int ti = 0; ti < 32; ++ti) acc[ti] += h2[ti * 64 + f] * w; }
        const int ch = col & 255; const float delta = fabsf(mind + (maxd - mind) * (float)ch / 255.f);
        float* dst = hT + (size_t)col * NTOK + (isctx ? SEQL : 0) + t0;
#pragma unroll
        for (int ti = 0; ti < 32; ++ti) { const float tn = (float)(t0 + ti) / (float)(n - 1); dst[ti] = acc[ti] * expf(-tn * delta); }
    }
    __syncthreads();
}

__device__ __forceinline__ void hyena_pack_job(const Ctx& c, int job) {
    const int l = job >> 9, o = (job >> 8) & 1, ch = job & 255;
    const float* hT = wsp<float>(c, WS_HT) + (size_t)l * 1024 * NTOK;
    const float* fw = hT + (size_t)(o * 512 + ch) * NTOK; const float* bw = hT + (size_t)(o * 512 + 256 + ch) * NTOK;
    LAS float* red = (LAS float*)c.lds;
    float fa[8], ba[8];
#pragma unroll
    for (int k = 0; k < 8; ++k) { fa[k] = fw[c.tid + 512 * k]; ba[k] = bw[c.tid + 512 * k]; }
    const float fc = (c.tid < CTXL) ? fw[SEQL + c.tid] : 0.f, bc = (c.tid < CTXL) ? bw[SEQL + c.tid] : 0.f;
    float s0 = 0.f, s1 = fc * fc + bc * bc;
#pragma unroll
    for (int k = 0; k < 8; ++k) s0 += fa[k] * fa[k] + ba[k] * ba[k];
    s0 = wave_sum(s0); s1 = wave_sum(s1);
    if (c.lane == 0) { red[c.wave] = s0; red[8 + c.wave] = s1; }
    __syncthreads();
    float t0 = 0.f, t1 = 0.f;
#pragma unroll
    for (int w = 0; w < 8; ++w) { t0 += red[w]; t1 += red[8 + w]; }
    const float r0 = rsqrtf(t0 + EPS), r1 = rsqrtf(t1 + EPS);
    bf16_t* gr = wsp<bf16_t>(c, WS_GR) + (((size_t)l * 2 + o) * 256 + ch) * 8192;
#pragma unroll
    for (int k = 0; k < 8; ++k) { const int d = c.tid + 512 * k; gr[4095 - d] = f2bf(fa[k] * r0); if (d >= 1) gr[4095 + d] = f2bf(ba[k] * r0); }
    if (c.tid == 0) gr[8191] = 0;
    bf16_t* grc = wsp<bf16_t>(c, WS_GRC) + (((size_t)l * 2 + o) * 256 + ch) * 512;
    if (c.tid < CTXL) { const int d = c.tid; grc[255 - d] = f2bf(fc * r1); if (d >= 1) grc[255 + d] = f2bf(bc * r1); }
    if (c.tid == 0) grc[511] = 0;
    __syncthreads();
}

struct NormItem {
    const float* xin; float* xout; const bf16_t* outb; bf16_t* hb; int b, l, next, lane4; bool isc, dry;
    f32x4 gtp[4], gqs[4], sh[4];
};
__device__ __forceinline__ void norm_load(const NormItem& n, int rowb, f32x4 (&xv)[2][4], u32x2 (&ow)[2][4]) {
#pragma unroll
    for (int rr = 0; rr < 2; ++rr) { const int row = rowb + rr; const size_t j = (size_t)(row - n.b * NTOK);
#pragma unroll
        for (int q = 0; q < 4; ++q) { xv[rr][q] = __builtin_nontemporal_load((const f32x4*)(n.xin + j * DM + q * 256 + n.lane4)); if (n.l >= 0) ow[rr][q] = *(const u32x2*)(n.outb + (size_t)row * DM + q * 256 + n.lane4); } }
}
__device__ __forceinline__ void norm_proc(const NormItem& n, int rowb, f32x4 (&xv)[2][4], const u32x2 (&ow)[2][4]) {
#pragma unroll
    for (int rr = 0; rr < 2; ++rr) {
        const int row = rowb + rr; const size_t j = (size_t)(row - n.b * NTOK);
        if (n.l >= 0) {
            float ov[16]; float ss = 0.f;
#pragma unroll
            for (int q = 0; q < 4; ++q) { ov[q * 4] = lo_bf(ow[rr][q].x); ov[q * 4 + 1] = hi_bf(ow[rr][q].x); ov[q * 4 + 2] = lo_bf(ow[rr][q].y); ov[q * 4 + 3] = hi_bf(ow[rr][q].y); }
#pragma unroll
            for (int i = 0; i < 16; ++i) ss += ov[i] * ov[i];
            ss = wave_sum(ss); const float rs = rsqrtf(ss * (1.f / DM) + EPS);
#pragma unroll
            for (int q = 0; q < 4; ++q)
#pragma unroll
                for (int i = 0; i < 4; ++i) xv[rr][q][i] += n.gtp[q][i] * (ov[q * 4 + i] * rs);
        }
        if ((n.l >= 0 || n.isc) && !n.dry) {
#pragma unroll
            for (int q = 0; q < 4; ++q) __builtin_nontemporal_store(xv[rr][q], (f32x4*)(n.xout + j * DM + q * 256 + n.lane4));
        }
        if (n.next >= 0) {
            float ss = 0.f;
#pragma unroll
            for (int q = 0; q < 4; ++q)
#pragma unroll
                for (int i = 0; i < 4; ++i) ss += xv[rr][q][i] * xv[rr][q][i];
            ss = wave_sum(ss); const float rs = rsqrtf(ss * (1.f / DM) + EPS);
#pragma unroll
            for (int q = 0; q < 4; ++q) { float hv[4];
#pragma unroll
                for (int i = 0; i < 4; ++i) hv[i] = xv[rr][q][i] * rs * n.gqs[q][i] + n.sh[q][i];
                u32x2 w; w.x = cvt_pk_bf16(hv[0], hv[1]); w.y = cvt_pk_bf16(hv[2], hv[3]); *(u32x2*)(n.hb + (size_t)row * DM + q * 256 + n.lane4) = w; }
        }
    }
}
__device__ __forceinline__ void norm_rows(const Ctx& c, int l  , int next  , int r0, int r1  ) {
    NormItem n; n.b = r0 / NTOK; n.isc = (r0 - n.b * NTOK) >= SEQL; n.l = l; n.next = next; n.lane4 = c.lane * 4; n.dry = c.dry != 0;
    if (next < 0 && n.isc) return;
    const int mr = n.isc ? 16 : n.b;
    const float* mvl = wsp<float>(c, WS_MODV) + ((size_t)(l < 0 ? 0 : l) * 17 + mr) * 3072;
    const float* mvn = wsp<float>(c, WS_MODV) + ((size_t)(next < 0 ? 0 : next) * 17 + mr) * 3072;
    const float* gpost = KIN(I_GPOST) + (l < 0 ? 0 : l) * DM; const float* gpre = KIN(I_GPRE) + (next < 0 ? 0 : next) * DM;
    n.outb = wsp<bf16_t>(c, WS_OUTB); n.hb = wsp<bf16_t>(c, WS_HCAT);
    if (n.isc) { float* base = wsp<float>(c, WS_CTXR) + ((ptrdiff_t)n.b * CTXL - SEQL) * DM; n.xout = base; n.xin = (l < 0) ? KIN(I_CTX) + ((ptrdiff_t)n.b * CTXL - SEQL) * DM : base; }
    else { float* base = KOUT() + (size_t)n.b * SEQL * DM; n.xout = base; n.xin = (l <= 0) ? KIN(I_X) + (size_t)n.b * SEQL * DM : base; }
#pragma unroll
    for (int q = 0; q < 4; ++q) { const int col = q * 256 + n.lane4;
        if (l >= 0) { const f32x4 gp = *(const f32x4*)(gpost + col), gt = *(const f32x4*)(mvl + 2048 + col); n.gtp[q] = gp * gt; } else n.gtp[q] = (f32x4){0.f, 0.f, 0.f, 0.f};
        if (next >= 0) { const f32x4 g = *(const f32x4*)(gpre + col), s1 = *(const f32x4*)(mvn + 1024 + col); n.gqs[q] = g * (s1 + 1.f); n.sh[q] = *(const f32x4*)(mvn + col); }
        else { n.gqs[q] = (f32x4){0.f, 0.f, 0.f, 0.f}; n.sh[q] = (f32x4){0.f, 0.f, 0.f, 0.f}; } }
    f32x4 xa[2][4], xb[2][4]; u32x2 oa[2][4], ob[2][4];
#pragma unroll
    for (int rr = 0; rr < 2; ++rr)
#pragma unroll
        for (int q = 0; q < 4; ++q) { oa[rr][q] = (u32x2){0u, 0u}; ob[rr][q] = (u32x2){0u, 0u}; }
    int rowb = r0 + c.wave * 2;
    norm_load(n, rowb, xa, oa);
    for (; rowb < r1; rowb += 32) {
        norm_load(n, rowb + 16, xb, ob);
        norm_proc(n, rowb, xa, oa);
        if (rowb + 32 < r1) norm_load(n, rowb + 32, xa, oa);
        norm_proc(n, rowb + 16, xb, ob);
    }
}

struct P2Env {
    bf16_t *B0, *B1, *B3; const bf16_t* B4; bf16_t *kr, *kg; const LAS float *ropeM, *ropeG; f32x4 gcq, gckv, gq, gk; int lane; bool dry;
};
__device__ __forceinline__ void p2_load(const P2Env& e, int rowb, u32x2 (&w0)[4], u32x2 (&w1)[4], u32x2 (&w3)[4], u32x2 (&w4)[4]) {
#pragma unroll
    for (int rr = 0; rr < 4; ++rr) { const size_t ro = (size_t)(rowb + rr) * 256 + e.lane * 4;
        w0[rr] = *(const u32x2*)(e.B0 + ro); w1[rr] = *(const u32x2*)(e.B1 + ro); w3[rr] = *(const u32x2*)(e.B3 + ro); w4[rr] = *(const u32x2*)(e.B4 + ro); }
}
__device__ __forceinline__ void p2_proc(const P2Env& e, int rowb, const u32x2 (&w0)[4], const u32x2 (&w1)[4], const u32x2 (&w3)[4], const u32x2 (&w4)[4]) {
    const int lane = e.lane;
#pragma unroll
    for (int rr = 0; rr < 4; ++rr) {
        const int row = rowb + rr;
        const int b = row / NTOK, j = row - b * NTOK; const bool islat = j < SEQL; const int rowpos = (j >> 6) & 63, colpos = j & 63;
        const size_t ro = (size_t)row * 256 + lane * 4;
        const int tm_ = lane & 7, tg_ = lane & 15;
        const LAS float* am = e.ropeM + (((tm_ & 4) ? colpos : rowpos) * 8 + 4 * (tm_ & 1)) * 2; const LAS float* ag = e.ropeG + (((tg_ & 8) ? colpos : rowpos) * 16 + 4 * (tg_ & 3)) * 2;
        const f32x4 rm0 = *(const LAS f32x4*)am, rm1 = *(const LAS f32x4*)(am + 4), rg0 = *(const LAS f32x4*)ag, rg1 = *(const LAS f32x4*)(ag + 4);
        const float rmv[8] = {rm0[0], rm0[1], rm0[2], rm0[3], rm1[0], rm1[1], rm1[2], rm1[3]}, rgv[8] = {rg0[0], rg0[1], rg0[2], rg0[3], rg1[0], rg1[1], rg1[2], rg1[3]};
        {
            const u32x2 w = w0[rr]; float x[4] = {lo_bf(w.x), hi_bf(w.x), lo_bf(w.y), hi_bf(w.y)};
            float ss = (lane < 48) ? (x[0] * x[0] + x[1] * x[1] + x[2] * x[2] + x[3] * x[3]) : 0.f; ss = wave_sum(ss);
            const float rs = rsqrtf(ss * (1.f / 192.f) + EPS);
            float xp[4];
#pragma unroll
            for (int i = 0; i < 4; ++i) xp[i] = swz_xor<2>(x[i]);
            u32x2 o; o.x = 0u; o.y = 0u;
            if (lane < 48) { o.x = cvt_pk_bf16(x[0] * rs * e.gcq[0], x[1] * rs * e.gcq[1]); o.y = cvt_pk_bf16(x[2] * rs * e.gcq[2], x[3] * rs * e.gcq[3]); }
            else if (lane < 56) {
                const int t = lane - 48; float y[4];
                if (islat) { const bool isx2 = (t & 2) != 0;
#pragma unroll
                    for (int i = 0; i < 4; ++i) { const float cs = rmv[2 * i], sn = rmv[2 * i + 1]; y[i] = isx2 ? (xp[i] * sn + x[i] * cs) : (x[i] * cs - xp[i] * sn); } }
                else {
#pragma unroll
                    for (int i = 0; i < 4; ++i) y[i] = x[i]; }
                u32x2 kk; kk.x = cvt_pk_bf16(y[0], y[1]); kk.y = cvt_pk_bf16(y[2], y[3]); *(u32x2*)(e.kr + (size_t)row * 32 + t * 4) = kk;
            }
            if (!e.dry) *(u32x2*)(e.B0 + ro) = o;
        }
        {
            const u32x2 w = w1[rr]; float x[4] = {lo_bf(w.x), hi_bf(w.x), lo_bf(w.y), hi_bf(w.y)};
            float ss = (lane < 32) ? (x[0] * x[0] + x[1] * x[1] + x[2] * x[2] + x[3] * x[3]) : 0.f; ss = wave_sum(ss);
            const float rs = rsqrtf(ss * (1.f / 128.f) + EPS);
            u32x2 o; o.x = 0u; o.y = 0u;
            if (lane < 32) { o.x = cvt_pk_bf16(x[0] * rs * e.gckv[0], x[1] * rs * e.gckv[1]); o.y = cvt_pk_bf16(x[2] * rs * e.gckv[2], x[3] * rs * e.gckv[3]); }
            if (!e.dry) *(u32x2*)(e.B1 + ro) = o;
        }
#pragma unroll
        for (int which = 0; which < 2; ++which) {
            const u32x2 w = which == 0 ? w3[rr] : w4[rr]; float x[4] = {lo_bf(w.x), hi_bf(w.x), lo_bf(w.y), hi_bf(w.y)};
            float ss = x[0] * x[0] + x[1] * x[1] + x[2] * x[2] + x[3] * x[3];
            ss += swz_xor<1>(ss); ss += swz_xor<2>(ss); ss += swz_xor<4>(ss); ss += swz_xor<8>(ss);
            const float rs = rsqrtf(ss * (1.f / 64.f) + EPS);
            const int t = lane & 15; const f32x4 g = which == 0 ? e.gq : e.gk;
#pragma unroll
            for (int i = 0; i < 4; ++i) x[i] = x[i] * rs * g[i];
            float xp[4];
#pragma unroll
            for (int i = 0; i < 4; ++i) xp[i] = swz_xor<4>(x[i]);
            if (islat) { const bool isx2 = (t & 4) != 0;
#pragma unroll
                for (int i = 0; i < 4; ++i) { const float cs = rgv[2 * i], sn = rgv[2 * i + 1]; x[i] = isx2 ? (xp[i] * sn + x[i] * cs) : (x[i] * cs - xp[i] * sn); } }
            if (which == 0) { const float qs = 0.125f * LOG2E; u32x2 o; o.x = cvt_pk_bf16(x[0] * qs, x[1] * qs); o.y = cvt_pk_bf16(x[2] * qs, x[3] * qs); if (!e.dry) *(u32x2*)(e.B3 + ro) = o; }
            else if (lane < 32) { u32x2 o; o.x = cvt_pk_bf16(x[0], x[1]); o.y = cvt_pk_bf16(x[2], x[3]); *(u32x2*)(e.kg + ((size_t)(b * 2 + (lane >> 4)) * NTOK + j) * 64 + t * 4) = o; }
        }
    }
}
__device__ __forceinline__ void p2_rows(const Ctx& c, int l) {
    bf16_t* pb = wsp<bf16_t>(c, WS_PB);
    P2Env e; e.B0 = pb; e.B1 = pb + BLKE; e.B3 = pb + 3 * BLKE; e.B4 = pb + 4 * BLKE; e.kr = wsp<bf16_t>(c, WS_KR); e.kg = wsp<bf16_t>(c, WS_KG); e.lane = c.lane; e.dry = c.dry != 0;
    LAS float* tab = (LAS float*)c.lds; e.ropeM = tab; e.ropeG = tab + 1024;
    { const float* srcM = wsp<float>(c, WS_ROPEM); const float* srcG = wsp<float>(c, WS_ROPEG);
      for (int i = c.tid; i < 256; i += 512) ((LAS f32x4*)tab)[i] = *(const f32x4*)(srcM + i * 4);
      for (int i = c.tid; i < 512; i += 512) ((LAS f32x4*)(tab + 1024))[i] = *(const f32x4*)(srcG + i * 4); }
    const int lane = c.lane;
    e.gcq = (lane < 48) ? *(const f32x4*)(KIN(I_GCQ) + l * 192 + lane * 4) : (f32x4){0.f, 0.f, 0.f, 0.f};
    e.gckv = (lane < 32) ? *(const f32x4*)(KIN(I_GCKV) + l * 128 + lane * 4) : (f32x4){0.f, 0.f, 0.f, 0.f};
    e.gq = *(const f32x4*)(KIN(I_GQ) + l * 64 + (lane & 15) * 4); e.gk = *(const f32x4*)(KIN(I_GK) + l * 64 + (lane & 15) * 4);
    __syncthreads();
    const int step = c.G * 8 * 4;
    u32x2 a0[4], a1[4], a3[4], a4[4], b0[4], b1[4], b3[4], b4[4];
    int rowb = (c.bid * 8 + c.wave) * 4;
    if (rowb < MROWS) p2_load(e, rowb, a0, a1, a3, a4);
    for (; rowb < MROWS; rowb += 2 * step) {
        const bool hb = rowb + step < MROWS;
        if (hb) p2_load(e, rowb + step, b0, b1, b3, b4);
        p2_proc(e, rowb, a0, a1, a3, a4);
        if (rowb + 2 * step < MROWS) p2_load(e, rowb + 2 * step, a0, a1, a3, a4);
        if (hb) p2_proc(e, rowb + step, b0, b1, b3, b4);
    }
    __syncthreads();
}
#ifndef PROBE_ABL
#define PROBE_ABL 0
#endif
#ifndef PROBE_GQAONLY
#define PROBE_GQAONLY 0
#endif
template <int DK, bool SUB, bool NOMAX = false, int ABL = 0>
__device__ __forceinline__ bool attn_unit(float (&rowmax)[2], const Ctx& c, const bf16_t* Qp, int qpitch, const bf16_t* Kp, const bf16_t* Vtp, int kt0, int nkt, int nrows,
                                          const bf16_t* gatep, bf16_t* outp, bool rope, int j0, float qscale, const float* ropeM) {
    constexpr int KS = DK / 16, KPC = DK / 8, KPITCH = DK * 2 + 16, KB = 64 * KPITCH, VPITCH = 144, VB = 64 * VPITCH;
    constexpr int KOFF = 0, VOFF = 3 * KB;
    constexpr float LIM = 60.f;
    static_assert(KB % 16 == 0 && VB % 16 == 0, "attention LDS buffer alignment");
    const int tid = c.tid, lane = c.lane, wave = c.wave;
    const int lq_ = opaque(lane), q = lq_ & 31, h = lq_ >> 5;
    LAS unsigned char* lds = c.lds;
    const int rbase = (wave * 64 < nrows) ? wave * 64 : wave * 64 - 256;
    const bool live = wave * 64 < nrows;
    bf16x8 qf[2][KS];
#pragma unroll
    for (int qt = 0; qt < 2; ++qt) {
        const bf16_t* qrow = Qp + (size_t)(rbase + qt * 32 + q) * qpitch + 8 * h;
#pragma unroll
        for (int ks = 0; ks < KS; ++ks) qf[qt][ks] = *(const bf16x8*)(qrow + 16 * ks);
        if (DK == 96) {
            const int jj = j0 + rbase + qt * 32 + q;
#pragma unroll
            for (int ks = 0; ks < KS; ++ks) {
                float x[8]; unpack8(__builtin_bit_cast(u32x4, qf[qt][ks]), x);
                if (ks >= 4) {
                    const int pos = (ks == 4) ? ((jj >> 6) & 63) : (jj & 63);
#pragma unroll
                    for (int e = 0; e < 8; ++e) { const float xp = half_other(x[e], h); const float cs = ropeM[(pos * 8 + e) * 2], sn = ropeM[(pos * 8 + e) * 2 + 1];
                        const float r = h ? (xp * sn + x[e] * cs) : (x[e] * cs - xp * sn); x[e] = rope ? r : x[e]; }
                }
                u32x4 w; w.x = cvt_pk_bf16(x[0] * qscale, x[1] * qscale); w.y = cvt_pk_bf16(x[2] * qscale, x[3] * qscale); w.z = cvt_pk_bf16(x[4] * qscale, x[5] * qscale); w.w = cvt_pk_bf16(x[6] * qscale, x[7] * qscale);
                qf[qt][ks] = __builtin_bit_cast(bf16x8, w);
            }
        }
    }
    f32x16 o00, o01, o10, o11;
#pragma unroll
    for (int i = 0; i < 16; ++i) { o00[i] = 0.f; o01[i] = 0.f; o10[i] = 0.f; o11[i] = 0.f; }
    const float m0 = SUB ? rowmax[0] : 0.f, m1 = SUB ? rowmax[1] : 0.f; float l0 = 0.f, l1 = 0.f;
    float rmax0 = -1e30f, rmax1 = -1e30f;
    const int tq_ = opaque(tid);
    const int kst0 = (tq_ / KPC) * KPITCH + (tq_ % KPC) * 16, kst1 = ((tq_ + 512) / KPC) * KPITCH + ((tq_ + 512) % KPC) * 16;
    const int kgl0 = ((tq_ / KPC) * DK + (tq_ % KPC) * 8) * 2, kgl1 = (((tq_ + 512) / KPC) * DK + ((tq_ + 512) % KPC) * 8) * 2;
    const int vst = (tq_ >> 3) * VPITCH + ((tq_ & 7) >> 1) * 32 + ((tq_ & 7) & 1) * 8, vgl = ((tq_ >> 3) * NTOK + (tq_ & 7) * 8) * 2;
    const bool has2 = (DK == 96) && tq_ < 256;
    const int kfo = q * KPITCH + 16 * h, vfo = q * VPITCH + 16 * h;
    const char* Kc = (const char*)Kp; const char* Vc = (const char*)Vtp;
    u32x4 kreg0, kreg1 = {0u, 0u, 0u, 0u}, vreg;
#define AT_GLOADK(kt) do { if (ABL & 1) break; const char* kb_ = Kc + (size_t)(kt) * (64 * DK * 2); kreg0 = *(const u32x4*)(kb_ + kgl0); if (has2) kreg1 = *(const u32x4*)(kb_ + kgl1); } while (0)
#define AT_GLOADV(kt) do { if (ABL & 1) break; vreg = *(const u32x4*)(Vc + (size_t)(kt) * 128 + vgl); } while (0)
#define AT_WRITEK(bi) do { if (ABL & 1) break; LAS unsigned char* bb = lds + KOFF + (bi) * KB; *(LAS u32x4*)(bb + kst0) = kreg0; if (has2) *(LAS u32x4*)(bb + kst1) = kreg1; } while (0)
#define AT_WRITEV(bi) do { if (ABL & 1) break; LAS u32x2* vd = (LAS u32x2*)(lds + VOFF + (bi) * VB + vst); vd[0] = (u32x2){vreg.x, vreg.y}; vd[2] = (u32x2){vreg.z, vreg.w}; } while (0)
#define AT_KPRE(bi, jh) do { if (KPRE) { const LAS unsigned char* kb_ = lds + KOFF + (bi) * KB + (jh) * 32 * KPITCH + kfo; \
        _Pragma("unroll") for (int ks = 0; ks < KS; ++ks) kf[ks] = *(const LAS bf16x8*)(kb_ + 32 * ks); } } while (0)
#define AT_QK(S0, S1, bi, jh) do { const LAS unsigned char* kb = lds + KOFF + (bi) * KB + (jh) * 32 * KPITCH + kfo; \
        _Pragma("unroll") for (int i = 0; i < 16; ++i) { S0[i] = 0.f; S1[i] = 0.f; } \
        if (!(ABL & 8)) _Pragma("unroll") for (int ks = 0; ks < KS; ++ks) { \
            const bf16x8 a0 = KPRE ? kf[ks] : *(const LAS bf16x8*)(kb + 32 * ks); \
            S0 = __builtin_amdgcn_mfma_f32_32x32x16_bf16(a0, qf[0][ks], S0, 0, 0, 0); \
            S1 = __builtin_amdgcn_mfma_f32_32x32x16_bf16(a0, qf[1][ks], S1, 0, 0, 0); } } while (0)
#define AT_MAX(S, RM) do { if (!SUB && !NOMAX) { _Pragma("unroll") for (int i = 0; i < 16; i += 2) RM = max3_raw(RM, S[i], S[i + 1]); } } while (0)
#define AT_EXP(S, M, L, PK0, PK1) do { float ps = 0.f; \
        _Pragma("unroll") for (int i = 0; i < 16; ++i) { S[i] = (ABL & 2) ? S[i] * 0.001f : __builtin_amdgcn_exp2f(SUB ? S[i] - M : S[i]); ps += S[i]; } \
        L += ps; u32x4 w; \
        w.x = cvt_pk_bf16(S[0], S[1]); w.y = cvt_pk_bf16(S[2], S[3]); w.z = cvt_pk_bf16(S[4], S[5]); w.w = cvt_pk_bf16(S[6], S[7]); PK0 = __builtin_bit_cast(bf16x8, w); \
        w.x = cvt_pk_bf16(S[8], S[9]); w.y = cvt_pk_bf16(S[10], S[11]); w.z = cvt_pk_bf16(S[12], S[13]); w.w = cvt_pk_bf16(S[14], S[15]); PK1 = __builtin_bit_cast(bf16x8, w); } while (0)
#define AT_VLOAD() do { va00 = *(const LAS bf16x8*)(vb); va10 = *(const LAS bf16x8*)(vb + 32 * VPITCH); va01 = *(const LAS bf16x8*)(vb + 32); va11 = *(const LAS bf16x8*)(vb + 32 * VPITCH + 32); } while (0)
#define AT_SUB(SC0, SC1, SN0, SN1, vbi, jh, nbi, njh) do { \
          \
        const LAS unsigned char* vb = lds + VOFF + (vbi) * VB + (jh) * 64 + vfo; \
        bf16x8 va00, va10, va01, va11; \
        if (DK == 64) { AT_VLOAD(); }        \
        AT_MAX(SC0, rmax0); AT_MAX(SC1, rmax1); \
        AT_QK(SN0, SN1, nbi, njh); \
        bf16x8 p00, p01, p10, p11; \
        AT_EXP(SC0, m0, l0, p00, p01); AT_EXP(SC1, m1, l1, p10, p11); \
        if (DK != 64) { AT_VLOAD(); } \
        if (!(ABL & 4)) { \
            o00 = __builtin_amdgcn_mfma_f32_32x32x16_bf16(va00, p00, o00, 0, 0, 0); \
            o01 = __builtin_amdgcn_mfma_f32_32x32x16_bf16(va10, p00, o01, 0, 0, 0); \
            o10 = __builtin_amdgcn_mfma_f32_32x32x16_bf16(va00, p10, o10, 0, 0, 0); \
            o11 = __builtin_amdgcn_mfma_f32_32x32x16_bf16(va10, p10, o11, 0, 0, 0); \
            o00 = __builtin_amdgcn_mfma_f32_32x32x16_bf16(va01, p01, o00, 0, 0, 0); \
            o01 = __builtin_amdgcn_mfma_f32_32x32x16_bf16(va11, p01, o01, 0, 0, 0); \
            o10 = __builtin_amdgcn_mfma_f32_32x32x16_bf16(va01, p11, o10, 0, 0, 0); \
            o11 = __builtin_amdgcn_mfma_f32_32x32x16_bf16(va11, p11, o11, 0, 0, 0); } \
        if (ABL & 4) { asm volatile("" :: "v"(p00), "v"(p01), "v"(p10), "v"(p11), "v"(va00), "v"(va10), "v"(va01), "v"(va11)); } \
        } while (0)
    if (!SUB && !NOMAX && tid == 0) *(volatile LAS unsigned*)(lds + LDS_MISC_OFF + 24) = 0u;
    AT_GLOADK(kt0); AT_GLOADV(kt0); AT_WRITEK(0); AT_WRITEV(0);
    AT_GLOADK(kt0 + 1); AT_WRITEK(1);
    __syncthreads();
    f32x16 sa0, sa1, sb0, sb1;
    constexpr bool KPRE = (DK == 64);
    bf16x8 kf[KS];
    AT_KPRE(0, 0);
    AT_QK(sa0, sa1, 0, 0);
    AT_KPRE(0, 1);
    int kb0 = 0, kb1 = 1, kb2 = 2;
    for (int t = 0; t < nkt; ++t) {
        const int tk = (t + 2 < nkt) ? t + 2 : nkt - 1, tv = (t + 1 < nkt) ? t + 1 : nkt - 1;
        AT_GLOADK(kt0 + tk);
        AT_SUB(sa0, sa1, sb0, sb1, t & 1, 0, kb0, 1);
        AT_KPRE(kb1, 0);
        AT_WRITEK(kb2);
        AT_GLOADV(kt0 + tv);
        AT_SUB(sb0, sb1, sa0, sa1, t & 1, 1, kb1, 0);
        AT_KPRE(kb1, 1);
        AT_WRITEV((t + 1) & 1);
        if (!(ABL & 16)) __syncthreads();
        const int tmp = kb0; kb0 = kb1; kb1 = kb2; kb2 = tmp;
    }
#undef AT_GLOADK
#undef AT_GLOADV
#undef AT_WRITEK
#undef AT_WRITEV
#undef AT_QK
#undef AT_KPRE
#undef AT_MAX
#undef AT_EXP
#undef AT_SUB
#undef AT_VLOAD
    bool bad = false;
    if (!SUB && !NOMAX) { const float r0 = half_max(rmax0), r1 = half_max(rmax1); rowmax[0] = r0; rowmax[1] = r1; const bool b_ = live && !(r0 < LIM && r0 > -LIM && r1 < LIM && r1 > -LIM); volatile LAS unsigned* flg = (volatile LAS unsigned*)(lds + LDS_MISC_OFF + 24); if (__any(b_ ? 1 : 0) && opaque(lane) == 0) *flg = 1u; __syncthreads(); bad = *flg != 0u; __syncthreads(); }
    if (live && !bad) {
        const int le_ = opaque(lane), q = le_ & 31, h = le_ >> 5;
        u32x2 gws[2][2][4];
#pragma unroll
        for (int qt = 0; qt < 2; ++qt)
#pragma unroll
            for (int dt = 0; dt < 2; ++dt)
#pragma unroll
                for (int g4 = 0; g4 < 4; ++g4) gws[qt][dt][g4] = *(const u32x2*)(gatep + (size_t)(rbase + qt * 32 + q) * 256 + dt * 32 + 8 * g4 + 4 * h);
#pragma unroll
        for (int qt = 0; qt < 2; ++qt) {
            const float lr = qt ? l1 : l0; const float lt = half_sum(lr), inv = 1.f / lt;
            const size_t row = (size_t)(rbase + qt * 32 + q);
#pragma unroll
            for (int dt = 0; dt < 2; ++dt)
#pragma unroll
                for (int g4 = 0; g4 < 4; ++g4) {
                    const int dv0 = dt * 32 + 8 * g4 + 4 * h;
                    const u32x2 gw = gws[qt][dt][g4];
                    const float g0 = siluf(lo_bf(gw.x)), g1 = siluf(hi_bf(gw.x)), g2 = siluf(lo_bf(gw.y)), g3 = siluf(hi_bf(gw.y));
                    const f32x16& o = qt ? (dt ? o11 : o10) : (dt ? o01 : o00);
                    u32x2 w; w.x = cvt_pk_bf16(o[4 * g4] * inv * g0, o[4 * g4 + 1] * inv * g1); w.y = cvt_pk_bf16(o[4 * g4 + 2] * inv * g2, o[4 * g4 + 3] * inv * g3);
                    *(u32x2*)(outp + row * DM + dv0) = w;
                }
        }
    }
    return bad;
}

template <int N>
__device__ __forceinline__ void hyena_conv(const Ctx& c, LAS unsigned char* ub, LAS unsigned char* gb, int pass, const bf16_t* xmul  , float bias,
                                           bf16_t* zdst  , const bf16_t* gmul, bf16_t* cat  , float cw0, float cw1, float cw2, float cb  ) {
    constexpr int UP = (N + 256) * 2 + 16, NPAIR = N / 256, OFF8 = N - 8;
    const int lane = c.lane, i16 = lane & 15, kq = lane >> 4;
    for (int pr = c.wave; pr < NPAIR; pr += 8) {
        const int t0 = pr * 256;
        u32x4 xq[2][4], gq[2][4]; bf16_t xl[2][4], xr[2][4];
#pragma unroll
        for (int half = 0; half < 2; ++half)
#pragma unroll
            for (int r = 0; r < 4; ++r) { const int t8 = t0 + half * 128 + 32 * kq + 8 * r; const bf16_t* xp_ = xmul + (size_t)i16 * NTOK + t8; xq[half][r] = *(const u32x4*)xp_;
                xl[half][r] = (t8 > 0) ? xp_[-1] : (bf16_t)0; xr[half][r] = (t8 + 8 < N) ? xp_[8] : (bf16_t)0;
                gq[half][r] = (pass == 1) ? *(const u32x4*)(gmul + (size_t)i16 * NTOK + t8) : (u32x4){0u, 0u, 0u, 0u}; }
        f32x4 acc[2][8];
#pragma unroll
        for (int m = 0; m < 8; ++m) { acc[0][m] = (f32x4){0.f, 0.f, 0.f, 0.f}; acc[1][m] = (f32x4){0.f, 0.f, 0.f, 0.f}; }
        const LAS unsigned char* up = ub + i16 * UP + 256 + kq * 16;
        const LAS unsigned char* gp = gb + (OFF8 - t0 - 8 * i16 + 8 * kq) * 2;
        bf16x8 bfa = *(const LAS bf16x8*)(up - 256), bfb = *(const LAS bf16x8*)(up);
        u32x4 wa = *(const LAS u32x4*)(gp - 256), wb = *(const LAS u32x4*)(gp - 256 + 16);
        for (int s0 = -128; s0 < N; s0 += 32) {
            const int sn = (s0 + 32 < N) ? s0 + 32 : s0;
            const bf16x8 bfan = *(const LAS bf16x8*)(up + sn * 2), bfbn = *(const LAS bf16x8*)(up + sn * 2 + 256);
            const u32x4 wan = *(const LAS u32x4*)(gp + sn * 2), wbn = *(const LAS u32x4*)(gp + sn * 2 + 16);
            const unsigned w[8] = {wa.x, wa.y, wa.z, wa.w, wb.x, wb.y, wb.z, wb.w};
            unsigned sh[7];
#pragma unroll
            for (int k = 0; k < 7; ++k) sh[k] = __builtin_amdgcn_alignbit(w[k + 1], w[k], 16);
#pragma unroll
            for (int m = 0; m < 8; ++m) {
                u32x4 a;
                if (m & 1) { const int d0 = (7 - m) >> 1; a = (u32x4){w[d0], w[d0 + 1], w[d0 + 2], w[d0 + 3]}; }
                else { const int d0 = (6 - m) >> 1; a = (u32x4){sh[d0], sh[d0 + 1], sh[d0 + 2], sh[d0 + 3]}; }
                acc[0][m] = __builtin_amdgcn_mfma_f32_16x16x32_bf16(__builtin_bit_cast(bf16x8, a), bfa, acc[0][m], 0, 0, 0);
                acc[1][m] = __builtin_amdgcn_mfma_f32_16x16x32_bf16(__builtin_bit_cast(bf16x8, a), bfb, acc[1][m], 0, 0, 0);
            }
            bfa = bfan; bfb = bfbn; wa = wan; wb = wbn;
        }
#pragma unroll
        for (int half = 0; half < 2; ++half)
#pragma unroll
            for (int r = 0; r < 4; ++r) {
                const int t8 = t0 + half * 128 + 32 * kq + 8 * r;
                float uu[8], xr8[8], xm[8]; unpack8(*(const LAS u32x4*)(ub + i16 * UP + 256 + t8 * 2), uu); unpack8(xq[half][r], xr8);
                {   float pv = bf2f(xl[half][r]);
#pragma unroll
                    for (int m = 0; m < 8; ++m) { const float nx = (m < 7) ? xr8[m + 1] : bf2f(xr[half][r]); xm[m] = bf2f(f2bf(cw0 * pv + cw1 * xr8[m] + cw2 * nx + cb)); pv = xr8[m]; } }
                float y[8];
#pragma unroll
                for (int m = 0; m < 8; ++m) y[m] = xm[m] * (acc[half][m][r] + bias * uu[m]);
                if (pass == 0) { u32x4 o; o.x = cvt_pk_bf16(y[0], y[1]); o.y = cvt_pk_bf16(y[2], y[3]); o.z = cvt_pk_bf16(y[4], y[5]); o.w = cvt_pk_bf16(y[6], y[7]); *(u32x4*)(zdst + (size_t)i16 * NTOK + t8) = o; }
                else { float gg[8]; unpack8(gq[half][r], gg);
#pragma unroll
                    for (int m = 0; m < 8; ++m) gg[m] = bf2f(f2bf(siluf(gg[m])));
                    u32x4 o; o.x = cvt_pk_bf16(y[0] * gg[0], y[1] * gg[1]); o.y = cvt_pk_bf16(y[2] * gg[2], y[3] * gg[3]); o.z = cvt_pk_bf16(y[4] * gg[4], y[5] * gg[5]); o.w = cvt_pk_bf16(y[6] * gg[6], y[7] * gg[7]);
                    *(u32x4*)(cat + (size_t)i16 * NTOK + t8) = o; }
            }
    }
}
template <int N>
__device__ __forceinline__ void hyena_seq(const Ctx& c, int l, int ch, int toff) {
    constexpr int UP = (N + 256) * 2 + 16;
    LAS unsigned char* ub = c.lds; LAS unsigned char* gb = c.lds + 16 * UP;
    const bf16_t* vv = wsp<bf16_t>(c, WS_HYV) + (size_t)ch * 16 * NTOK + toff;
    bf16_t* vz = wsp<bf16_t>(c, WS_HYZ) + (size_t)ch * 16 * NTOK + toff;
    const bf16_t* x1 = wsp<bf16_t>(c, WS_HYX1) + (size_t)ch * 16 * NTOK + toff;
    const bf16_t* x2 = wsp<bf16_t>(c, WS_HYX2) + (size_t)ch * 16 * NTOK + toff;
    const bf16_t* gm = wsp<bf16_t>(c, WS_HYG) + (size_t)ch * 16 * NTOK + toff;
    bf16_t* cat = wsp<bf16_t>(c, WS_HYY) + (size_t)ch * 16 * NTOK + toff;
    { const int e = c.tid, b = e >> 5, side = (e >> 4) & 1, pc = e & 15; unsigned z = 0u; asm volatile("" : "+v"(z)); *(LAS u32x4*)(ub + b * UP + side * (256 + N * 2) + pc * 16) = (u32x4){z, z, z, z}; }
    for (int pass = 0; pass < 2; ++pass) {
        const bf16_t* gr = (N == SEQL) ? wsp<bf16_t>(c, WS_GR) + (((size_t)l * 2 + pass) * 256 + ch) * 8192 : wsp<bf16_t>(c, WS_GRC) + (((size_t)l * 2 + pass) * 256 + ch) * 512;
        const bf16_t* usrc = pass == 0 ? vv : vz;
        constexpr int NG = (2 * N / 8 + 511) / 512;
        {
            u32x4 t[NG];
#pragma unroll
            for (int k = 0; k < NG; ++k) { const int e = c.tid + k * 512; t[k] = (e < 2 * N / 8) ? *(const u32x4*)(gr + e * 8) : (u32x4){0u, 0u, 0u, 0u}; }
#pragma unroll
            for (int k = 0; k < NG; ++k) { const int e = c.tid + k * 512; if (e < 2 * N / 8) *(LAS u32x4*)(gb + e * 16) = t[k]; }
        }
        if constexpr (N == SEQL) {
#pragma unroll
            for (int k0 = 0; k0 < 16; k0 += 8) {
                u32x4 t[8];
#pragma unroll
                for (int k = 0; k < 8; ++k) t[k] = *(const u32x4*)(usrc + (size_t)(k0 + k) * NTOK + c.tid * 8);
#pragma unroll
                for (int k = 0; k < 8; ++k) *(LAS u32x4*)(ub + (k0 + k) * UP + 256 + c.tid * 16) = t[k];
            }
        } else {
            const int b = c.tid >> 5, pc = c.tid & 31;
            *(LAS u32x4*)(ub + b * UP + 256 + pc * 16) = *(const u32x4*)(usrc + (size_t)b * NTOK + pc * 8);
        }
        __syncthreads();
        const float* hcw = KIN(I_HCW) + (size_t)l * 3 * 768; const float* hcb = KIN(I_HCB) + l * 768;
        if (pass == 0) {
            const float w0 = hcw[ch], w1 = hcw[768 + ch], w2 = hcw[1536 + ch], bs = hcb[ch];
            constexpr int PPT = (N == SEQL) ? 16 : 1;
            u32x4 o[PPT];
#pragma unroll
            for (int k = 0; k < PPT; ++k) { const int b = (N == SEQL) ? k : (c.tid >> 5), pc = (N == SEQL) ? c.tid : (c.tid & 31); const LAS unsigned char* p = ub + b * UP + 256 + pc * 16;
                float x[8]; unpack8(*(const LAS u32x4*)p, x); float pv = bf2f(*(const LAS bf16_t*)(p - 2)); const float nx8 = bf2f(*(const LAS bf16_t*)(p + 16)); float y[8];
#pragma unroll
                for (int m = 0; m < 8; ++m) { const float nx = (m < 7) ? x[m + 1] : nx8; y[m] = w0 * pv + w1 * x[m] + w2 * nx + bs; pv = x[m]; }
                o[k].x = cvt_pk_bf16(y[0], y[1]); o[k].y = cvt_pk_bf16(y[2], y[3]); o[k].z = cvt_pk_bf16(y[4], y[5]); o[k].w = cvt_pk_bf16(y[6], y[7]); }
            __syncthreads();
#pragma unroll
            for (int k = 0; k < PPT; ++k) { const int b = (N == SEQL) ? k : (c.tid >> 5), pc = (N == SEQL) ? c.tid : (c.tid & 31); *(LAS u32x4*)(ub + b * UP + 256 + pc * 16) = o[k]; }
            __syncthreads();
        }
        const float bias = KIN(I_HBIAS)[((size_t)l * 2 + pass) * 256 + ch];
        const int cc = (pass + 1) * 256 + ch;
        hyena_conv<N>(c, ub, gb, pass, pass == 0 ? x1 : x2, bias, vz, gm, cat, hcw[cc], hcw[768 + cc], hcw[1536 + cc], hcb[cc]);
        asm volatile("s_waitcnt vmcnt(0)" ::: "memory");
        __syncthreads();
    }
}

__device__ __forceinline__ void hyena_untranspose(const Ctx& c, int tl0, int tl1) {
    const bf16_t* yT = wsp<bf16_t>(c, WS_HYY); bf16_t* cat = wsp<bf16_t>(c, WS_HCAT);
    LAS bf16_t* T = (LAS bf16_t*)c.lds;
    LAS unsigned* T32 = (LAS unsigned*)c.lds;
    for (int tl = tl0; tl < tl1; ++tl) {
        const int b = tl / 68, j0 = (tl - b * 68) * 64;
        u32x4 pre[4];
#pragma unroll
        for (int k = 0; k < 4; ++k) { const int e = c.tid + k * 512, ch = e >> 3, pc = e & 7; pre[k] = *(const u32x4*)(yT + ((size_t)ch * 16 + b) * NTOK + j0 + pc * 8); }
#pragma unroll
        for (int k = 0; k < 4; ++k) { const int e = c.tid + k * 512, ch = e >> 3, pc = e & 7; LAS unsigned* d = T32 + (ch * 132 + pc * 16) / 4; d[0] = pre[k].x; d[1] = pre[k].y; d[2] = pre[k].z; d[3] = pre[k].w; }
        __syncthreads();
#pragma unroll
        for (int k = 0; k < 4; ++k) { const int e = c.tid + k * 512, t = e >> 5, c0 = (e & 31) * 8; float v[8];
#pragma unroll
            for (int i = 0; i < 8; ++i) v[i] = bf2f(T[(c0 + i) * 66 + t]);
            u32x4 w; w.x = cvt_pk_bf16(v[0], v[1]); w.y = cvt_pk_bf16(v[2], v[3]); w.z = cvt_pk_bf16(v[4], v[5]); w.w = cvt_pk_bf16(v[6], v[7]);
            *(u32x4*)(cat + ((size_t)b * NTOK + j0 + t) * DM + 768 + c0) = w; }
        __syncthreads();
    }
}

__device__ __forceinline__ void ssm_scan_item(const Ctx& c, int l, int item) {
    const int b = item >> 2, g = (item & 3) * 4 + (c.tid >> 7), dq = (c.tid >> 6) & 1, p = c.tid & 63;
    const float* a16 = wsp<float>(c, WS_A16) + ((((size_t)l * 2 + dq) * 16 + g) * 64 + p) * 2;
    const float ar = a16[0], ai = a16[1];
    const bf16_t* E = wsp<bf16_t>(c, WS_E); bf16_t* US = wsp<bf16_t>(c, WS_US);
    float sr = 0.f, si = 0.f;
    for (int st0 = 0; st0 < NCHB; st0 += 8) {
        float er[8], ei[8]; size_t ro[8];
#pragma unroll
        for (int k = 0; k < 8; ++k) { const int st = st0 + k; const int cc = dq == 0 ? (st < 16 ? 256 + st : st - 16) : (st < 16 ? 271 - st : 255 - (st - 16));
            ro[k] = (size_t)g * NCHUNK + (size_t)b * NCHB + cc; er[k] = bf2f(E[ro[k] * 256 + dq * 128 + p]); ei[k] = bf2f(E[ro[k] * 256 + dq * 128 + 64 + p]); }
#pragma unroll
        for (int k = 0; k < 8; ++k) {
            US[ro[k] * 512 + 256 + dq * 128 + p] = f2bf(sr); US[ro[k] * 512 + 256 + dq * 128 + 64 + p] = f2bf(si);
            const float nr = ar * sr - ai * si + er[k], ni = ar * si + ai * sr + ei[k]; sr = nr; si = ni;
        }
    }
}

constexpr int LDS_BYTES = 163840;
constexpr int LDS_MISC = LDS_MISC_OFF;
static_assert(LDS_MISC_OFF == LDS_BYTES - 256, "LDS map");
constexpr int NPRO = 1, NPH = 6, NPHASES = NPRO + DEPTH * NPH;
constexpr int QI_HY = 256, QI_SCAN = 64, QI_ATTL = NB * 8 * 8, QI_SSM2 = 16 * 17, QI_UNT = 272, QI_ATTC = NB * 8, QI_GLU = MROWS / 256;
constexpr int QO_SCAN = QI_HY, QO_ATTL = QO_SCAN + QI_SCAN, QO_SSM2 = QO_ATTL + QI_ATTL, QO_UNT = QO_SSM2 + QI_SSM2, QO_ATTC = QO_UNT + QI_UNT, QO_GLU = QO_ATTC + QI_ATTC, QI_TOTAL = QO_GLU + QI_GLU;
#ifndef PROBE_DUP_MASK
#define PROBE_DUP_MASK 0
#endif
#ifndef PROBE_P4KINDS
#define PROBE_P4KINDS 0x7f
#endif
__device__ __forceinline__ void dep_signal(const Ctx& c, unsigned* cnt) {
    asm volatile("s_waitcnt vmcnt(0)" ::: "memory");
    __syncthreads();
    if (c.tid == 0) { __builtin_amdgcn_fence(__ATOMIC_RELEASE, "agent"); asm volatile("s_waitcnt vmcnt(0)" ::: "memory"); (void)xb_add(cnt, 1u); }
}
__device__ __forceinline__ void dep_signal_wt(const Ctx& c, unsigned* cnt) {
    asm volatile("s_waitcnt vmcnt(0)" ::: "memory");
    __syncthreads();
    if (c.tid == 0) (void)xb_add(cnt, 1u);
}
__device__ __forceinline__ void dep_wait(const Ctx& c, unsigned* cnt, unsigned need, unsigned* tmo) {
    if (c.dry) return;
    if (c.tid == 0) {
        unsigned sp = 0;
        while (xb_ld(cnt) < need) { __builtin_amdgcn_s_sleep(2); if ((++sp & 255u) == 0u) { if (xb_ld(tmo)) break; if (sp > XB_SPIN_CAP) { atomicAdd(tmo, 1u); break; } } }
        __builtin_amdgcn_fence(__ATOMIC_ACQUIRE, "agent");
        asm volatile("s_waitcnt vmcnt(0)" ::: "memory");
    }
    __syncthreads();
}

__global__ void __launch_bounds__(512, 2) mk_fwd(Params prm) {
    extern __shared__ __attribute__((aligned(16))) unsigned char lds_raw[];
    Ctx c; c.lds = (LAS unsigned char*)lds_raw; c.ka = (kargp_t)__builtin_amdgcn_kernarg_segment_ptr(); c.ws = prm.ws; c.tid = threadIdx.x; c.lane = c.tid & 63; c.wave = __builtin_amdgcn_readfirstlane(c.tid >> 6); c.G = gridDim.x; c.bid = blockIdx.x; c.dry = prm.dry;
    const int wave0 = c.wave;
    volatile LAS unsigned* misc = (volatile LAS unsigned*)(c.lds + LDS_MISC);
    if (c.tid < 16) misc[c.tid] = 0u;
    __syncthreads();
    unsigned* ctl = wsp<unsigned>(c, WS_CTL);
    const int lo = prm.ph_lo, hi = prm.ph_hi;
    const bool fused = (hi - lo) > 1;
    XcdBarrier bar; bar.bar = ctl + CW_BAR; bar.x = 0; bar.st = misc;
    if (fused) bar = xcd_barrier_post(ctl + CW_BAR, misc);
#ifndef SITE_MASK
#define SITE_MASK 0x3ff
#endif
#define SITE(n) (((SITE_MASK) >> (n)) & 1)
#define IN(k) (lo <= (k) && (k) < hi)
#define FRESH() do { { kargp_t _k = (kargp_t)__builtin_amdgcn_kernarg_segment_ptr(); asm volatile("" : "+s"(_k)); c.ka = _k; c.ws = (unsigned char*)(GAS unsigned char*)_k[37]; } { int _w = wave0; asm volatile("" : "+s"(_w)); c.wave = _w; c.lane = lane_id_fresh(); c.tid = c.wave * 64 + c.lane; } } while (0)
#define SEAM(k) do { if (IN((k) + 1)) xcd_barrier(bar); } while (0)

    if (SITE(0) && IN(0)) {
        FRESH();
        constexpr int J_MOD = 192, J_HY = 544, J_SSM = 64, J_WIN = 4 * 48 * 8, J_WOUT = 4 * 16 * 8, J_WUQ = 4 * 8 * 2, J_W256 = 4 * 4 * 2, J_NORM = MROWS / 256, J_PACK = 4 * 2 * 256;
        constexpr int J0 = J_MOD, J1 = J0 + J_HY, J2 = J1 + J_SSM, J3 = J2 + J_WIN, J4 = J3 + J_WOUT, J5 = J4 + J_WUQ, J6 = J5 + J_W256, J7 = J6 + J_W256, J8 = J7 + J_W256, J9 = J8 + 1, J10 = J9 + J_NORM, J11 = J10 + J_PACK;
        unsigned* dep = ctl + CW_DEP + DEP_SET * 8;
        unsigned* tmo = ctl + CW_BAR + XB_TMO;
        for (int job = c.bid; job < J11; job += c.G) {
            FRESH();
            if (job < J0) { modv_job(c, job); dep_signal(c, dep); }
            else if (job < J1) { hyena_mlp_job(c, job - J0); dep_signal(c, dep + 64); }
            else if (job < J2) ssm_tables_job(c, job - J1);
            else if (job < J3) { const int r = job - J2, l = r / 384, q = r % 384; wconv_tile(c, KIN(I_WIN) + (size_t)l * DM * INC, DM, INC, INP, wsp<bf16_t>(c, WS_WIN) + (size_t)l * INP * DM, DM, 0, q / 8, q % 8); }
            else if (job < J4) { const int r = job - J3, l = r / 128, q = r % 128; wconv_tile(c, KIN(I_WOUT) + (size_t)l * DM * DM, DM, DM, DM, wsp<bf16_t>(c, WS_WOUT) + (size_t)l * DM * DM, DM, 1, q / 8, q % 8); }
            else if (job < J5) { const int r = job - J4, l = r / 16, q = r % 16; wconv_tile(c, KIN(I_WUQ) + (size_t)l * 192 * 384, 192, 384, 384, wsp<bf16_t>(c, WS_WUQ) + (size_t)l * 512 * 256, 256, 1, q / 2, q % 2); }
            else if (job < J6) { const int r = job - J5, l = r / 8, q = r % 8; wconv_tile(c, KIN(I_WUKV) + (size_t)l * 128 * 512, 128, 512, 256, wsp<bf16_t>(c, WS_WUK) + (size_t)l * 256 * 256, 256, 2, q / 2, q % 2); }
            else if (job < J7) { const int r = job - J6, l = r / 8, q = r % 8; wconv_tile(c, KIN(I_WUKV) + (size_t)l * 128 * 512, 128, 512, 256, wsp<bf16_t>(c, WS_WUV) + (size_t)l * 256 * 256, 256, 3, q / 2, q % 2); }
            else if (job < J8) { const int r = job - J7, l = r / 8, q = r % 8; wconv_tile(c, KIN(I_GLUW) + (size_t)l * 256 * 256, 256, 256, 256, wsp<bf16_t>(c, WS_WGLU) + (size_t)l * 256 * 256, 256, 1, q / 2, q % 2); }
            else if (job < J9) rope_job(c);
            else if (job < J10) { dep_wait(c, dep, J_MOD, tmo); FRESH(); const int t = job - J9; norm_rows(c, -1, 0, t * 256, t * 256 + 256); }
            else { dep_wait(c, dep + 64, J_HY, tmo); FRESH(); hyena_pack_job(c, job - J10); }
        }
        SEAM(0);
    }
    for (int l = 0; l < DEPTH; ++l) {
        const int pbase = NPRO + l * NPH;
        if (SITE(2) && IN(pbase + 0)) {
            FRESH();
            pg8::Gemm g{wsp<bf16_t>(c, WS_HCAT), wsp<bf16_t>(c, WS_WIN) + (size_t)l * INP * DM, MROWS, INP, DM};
            pg8::StaticOrder S; S.init(MROWS, INP, c.G, c.bid);
            EpiInProj E{wsp<bf16_t>(c, WS_PB), wsp<bf16_t>(c, WS_UG), wsp<bf16_t>(c, WS_US), wsp<bf16_t>(c, WS_VTG), wsp<bf16_t>(c, WS_HYV), c.lds + pg8::STAGE_BYTES};
            pg8::gemm_phase(c.lds, g, S, E, c.tid);
            SEAM(pbase + 0);
        }
        if (SITE(3) && IN(pbase + 1)) { FRESH(); p2_rows(c, l); SEAM(pbase + 1); }
        if (SITE(4) && IN(pbase + 2)) {
            FRESH();
            pg8::Gemm g{wsp<bf16_t>(c, WS_PB), wsp<bf16_t>(c, WS_WUQ), MROWS, 512, 256};
            pg8::P3Order S{wsp<bf16_t>(c, WS_PB), wsp<bf16_t>(c, WS_PB) + BLKE, wsp<bf16_t>(c, WS_WUQ) + (size_t)l * 512 * 256, wsp<bf16_t>(c, WS_WUK) + (size_t)l * 256 * 256, wsp<bf16_t>(c, WS_WUV) + (size_t)l * 256 * 256,
                           wsp<bf16_t>(c, WS_UG), wsp<bf16_t>(c, WS_WE) + (size_t)l * 16 * 256 * 256, c.G, c.bid};
            EpiP3 E{{wsp<bf16_t>(c, WS_QM), 384, 384}, {wsp<bf16_t>(c, WS_KM), wsp<bf16_t>(c, WS_KR)}, {wsp<bf16_t>(c, WS_VTM)}, {wsp<bf16_t>(c, WS_E)}};
            pg8::gemm_phase(c.lds, g, S, E, c.tid);
            SEAM(pbase + 2);
        }
        if (SITE(5) && IN(pbase + 3)) {
            FRESH();
            unsigned* qh = ctl + CW_Q + 64 * (l + 4 * (c.dry ? 1 : 0));
            unsigned* dep = ctl + CW_DEP + DEP_SET * (l + 4 * (c.dry ? 1 : 0));
            unsigned* tmo = ctl + CW_BAR + XB_TMO;
            const float* ropeM = wsp<float>(c, WS_ROPEM);
            bool gqa_nomax;
            { float gq_ = fabsf(KIN(I_GQ)[l * 64 + c.lane]), gk_ = fabsf(KIN(I_GK)[l * 64 + c.lane]);
              gq_ = fmaxf(gq_, swz_xor<16>(gq_)); gq_ = fmaxf(gq_, swz_xor<8>(gq_)); gq_ = fmaxf(gq_, swz_xor<4>(gq_)); gq_ = fmaxf(gq_, swz_xor<2>(gq_)); gq_ = fmaxf(gq_, swz_xor<1>(gq_)); gq_ = half_max(gq_);
              gk_ = fmaxf(gk_, swz_xor<16>(gk_)); gk_ = fmaxf(gk_, swz_xor<8>(gk_)); gk_ = fmaxf(gk_, swz_xor<4>(gk_)); gk_ = fmaxf(gk_, swz_xor<2>(gk_)); gk_ = fmaxf(gk_, swz_xor<1>(gk_)); gk_ = half_max(gk_);
              const float bound = 64.f * gq_ * gk_ * 0.125f * LOG2E * 1.01f; gqa_nomax = __builtin_amdgcn_readfirstlane(bound < 50.f ? 1 : 0) != 0; }
#define ATT_CALL(DKV, ...) do { float rowmax_[2] = {0.f, 0.f}; if (attn_unit<DKV, false>(rowmax_, __VA_ARGS__)) { (void)attn_unit<DKV, true>(rowmax_, __VA_ARGS__); } } while (0)
            for (;;) {
                __syncthreads();
                if (c.tid == 0) misc[4] = __hip_atomic_fetch_add(qh, 1u, __ATOMIC_RELAXED, __HIP_MEMORY_SCOPE_AGENT);
                __syncthreads();
                const int it = (int)misc[4];
                if (it >= QI_TOTAL) break;
                FRESH();
                if (c.dry) { const int kd_ = it < QO_SCAN ? 0 : it < QO_ATTL ? 1 : it < QO_SSM2 ? 2 : it < QO_UNT ? 3 : it < QO_ATTC ? 4 : it < QO_GLU ? 5 : 6; if (!((c.dry >> (1 + kd_)) & 1)) continue; }
                if (it < QO_SCAN) { hyena_seq<SEQL>(c, l, it, 0); if (l + 1 < DEPTH) hyena_seq<CTXL>(c, l, it, SEQL); dep_signal(c, dep); }
                else if (it < QO_ATTL) { ssm_scan_item(c, l, it - QO_SCAN); dep_signal(c, dep + 64); }
                else if (it >= QO_ATTC && it < QO_GLU && l + 1 == DEPTH) {   }
                else if (it < QO_SSM2 || (it >= QO_ATTC && it < QO_GLU)) {
                    const bool isctx = it >= QO_ATTC; const int r = isctx ? it - QO_ATTC : (it - QO_ATTL) % (NB * 8), blk = isctx ? 8 : (it - QO_ATTL) / (NB * 8)  ;
                    const int kind = r & 1  , head = (r >> 1) & 3, b = r >> 3;
                    const size_t row0 = (size_t)b * NTOK + (isctx ? SEQL : blk * 512); const int kt0 = isctx ? 64 : 0, nkt = isctx ? 4 : 68, nrows = isctx ? 256 : 512;
                    if (kind == 0) { if (c.dry && PROBE_GQAONLY == 1) continue; ATT_CALL(96, c, wsp<bf16_t>(c, WS_QM) + row0 * 384 + head * 96, 384, wsp<bf16_t>(c, WS_KM) + (size_t)(b * 4 + head) * NTOK * 96, wsp<bf16_t>(c, WS_VTM) + (size_t)(b * 4 + head) * 64 * NTOK,
                                                 kt0, nkt, nrows, wsp<bf16_t>(c, WS_PB) + 2 * BLKE + row0 * 256 + head * 64, wsp<bf16_t>(c, WS_HCAT) + row0 * DM + head * 64, !isctx, blk * 512, 0.10206207261596577f * LOG2E, ropeM); }
                    else if (c.dry && PROBE_GQAONLY == 2) { continue; }
                    else if (c.dry && PROBE_ABL) { float rm_[2] = {0.f, 0.f}; (void)attn_unit<64, false, true, PROBE_ABL>(rm_, c, wsp<bf16_t>(c, WS_PB) + 3 * BLKE + row0 * 256 + head * 64, 256, wsp<bf16_t>(c, WS_KG) + (size_t)(b * 2 + (head >> 1)) * NTOK * 64, wsp<bf16_t>(c, WS_VTG) + (size_t)(b * 2 + (head >> 1)) * 64 * NTOK,
                                       kt0, nkt, nrows, wsp<bf16_t>(c, WS_PB) + 5 * BLKE + row0 * 256 + head * 64, wsp<bf16_t>(c, WS_HCAT) + row0 * DM + 256 + head * 64, false, 0, 1.f, ropeM); }
                    else if (gqa_nomax) { float rm_[2] = {0.f, 0.f}; (void)attn_unit<64, false, true>(rm_, c, wsp<bf16_t>(c, WS_PB) + 3 * BLKE + row0 * 256 + head * 64, 256, wsp<bf16_t>(c, WS_KG) + (size_t)(b * 2 + (head >> 1)) * NTOK * 64, wsp<bf16_t>(c, WS_VTG) + (size_t)(b * 2 + (head >> 1)) * 64 * NTOK,
                                       kt0, nkt, nrows, wsp<bf16_t>(c, WS_PB) + 5 * BLKE + row0 * 256 + head * 64, wsp<bf16_t>(c, WS_HCAT) + row0 * DM + 256 + head * 64, false, 0, 1.f, ropeM); }
                    else { ATT_CALL(64, c, wsp<bf16_t>(c, WS_PB) + 3 * BLKE + row0 * 256 + head * 64, 256, wsp<bf16_t>(c, WS_KG) + (size_t)(b * 2 + (head >> 1)) * NTOK * 64, wsp<bf16_t>(c, WS_VTG) + (size_t)(b * 2 + (head >> 1)) * 64 * NTOK,
                                       kt0, nkt, nrows, wsp<bf16_t>(c, WS_PB) + 5 * BLKE + row0 * 256 + head * 64, wsp<bf16_t>(c, WS_HCAT) + row0 * DM + 256 + head * 64, false, 0, 1.f, ropeM); }
                }
                else if (it < QO_UNT) {
                    const int L = it - QO_SSM2, i = L >> 4, g = L & 15;
                    dep_wait(c, dep + 64, QI_SCAN, tmo);
                    pg8::Gemm gm{wsp<bf16_t>(c, WS_US), wsp<bf16_t>(c, WS_WKC) + (size_t)l * 16 * 256 * 512, 16 * NCHUNK, 16 * 256, 512}; pg8::OneUnit S{g * 17 + i, g};
                    pg8::EpiWalkPF<PutSsmY> E{{wsp<bf16_t>(c, WS_ZS), wsp<bf16_t>(c, WS_UG), KIN(I_SSMD) + l * 256}}; pg8::gemm_phase(c.lds, gm, S, E, c.tid);
                    dep_signal(c, dep + 64 * (2 + i));
                }
                else if (it < QO_ATTC) {
                    dep_wait(c, dep, QI_HY, tmo);
                    const int j = it - QO_UNT; hyena_untranspose(c, 4 * j, 4 * j + 4);
                }
                else {
                    const int pm = it - QO_GLU;
                    dep_wait(c, dep + 64 * (2 + (pm >> 4)), 16u, tmo);
                    pg8::Gemm gm{wsp<bf16_t>(c, WS_ZS), wsp<bf16_t>(c, WS_WGLU) + (size_t)l * 256 * 256, MROWS, 256, 256}; pg8::OneUnit S{pm, 0};
                    pg8::EpiWalkPF<PutGlu> E{{wsp<bf16_t>(c, WS_HCAT), wsp<bf16_t>(c, WS_ZS), wsp<bf16_t>(c, WS_PB) + 7 * BLKE, KIN(I_GLUB) + l * 256}}; pg8::gemm_phase(c.lds, gm, S, E, c.tid);
                }
            }
            SEAM(pbase + 3);
        }
        if (SITE(6) && IN(pbase + 4)) {
            FRESH();
            const bool lastl = l + 1 == DEPTH;
            constexpr int OPD = 8;
            const int x = c.bid & 7, nsx = (lastl ? NB * 16 : MROWS / 256) / 8;
            const int n1 = 4 * OPD, n2 = n1 + 8 * (nsx - OPD), ntot = n2 + 4 * OPD;
            unsigned* qh = ctl + CW_Q2 + 64 * ((l + 4 * (c.dry ? 1 : 0)) * 8 + x);
            unsigned* c7 = ctl + CW_C7 + 320 * (l + 4 * (c.dry ? 1 : 0));
            unsigned* tmo = ctl + CW_BAR + XB_TMO;
            unsigned pre = 0u;
            if (c.tid == 0) pre = __hip_atomic_fetch_add(qh, 1u, __ATOMIC_RELAXED, __HIP_MEMORY_SCOPE_AGENT);
            for (;;) {
                __syncthreads();
                if (c.tid == 0) { misc[4] = pre; pre = __hip_atomic_fetch_add(qh, 1u, __ATOMIC_RELAXED, __HIP_MEMORY_SCOPE_AGENT); }
                __syncthreads();
                const int it = (int)misc[4];
                if (it >= ntot) break;
                FRESH();
                int i, k;
                if (it < n1) { i = it >> 2; k = it & 3; } else if (it < n2) { const int j = it - n1; i = OPD + (j >> 3); k = j & 7; if (k >= 4) i -= OPD; } else { const int j = it - n2; i = nsx - OPD + (j >> 2); k = 4 + (j & 3); }
                const int s_ = x + 8 * i, pm = lastl ? (s_ >> 4) * 17 + (s_ & 15) : s_;
                if (k < 4) {
                    pg8::Gemm g{wsp<bf16_t>(c, WS_HCAT), wsp<bf16_t>(c, WS_WOUT) + (size_t)l * DM * DM, MROWS, DM, DM}; pg8::OneUnit S{pm, k};
                    pg8::EpiWalk<PutPlainWT> E{{wsp<bf16_t>(c, WS_OUTB), DM, DM}}; pg8::gemm_phase(c.lds, g, S, E, c.tid);
                    dep_signal_wt(c, c7 + s_);
                } else {
                    dep_wait(c, c7 + s_, 4u, tmo);
                    const int r0 = pm * 256 + (k - 4) * 64; norm_rows(c, l, lastl ? -1 : l + 1, r0, r0 + 64);
                }
            }
            if (!lastl) SEAM(pbase + 4);
        }
    }
#undef IN
#undef SEAM
}

extern "C" void kernel_launch(void* const* d_in, const int* in_sizes, int n_in, void* d_out, int out_size, void* d_ws, size_t ws_size, hipStream_t stream) {
    static int grid = 0;
    if (grid == 0) {
        if (n_in != 36 || out_size != NB * SEQL * DM || ws_size < WS_END) { fprintf(stderr, "kernel_launch: unexpected shapes: n_in %d out %d ws %zu (need %zu)\n", n_in, out_size, ws_size, (size_t)WS_END); grid = -1; return; }
        int dev = 0, cus = 0, per_cu = 0;
        if (hipGetDevice(&dev) != hipSuccess || hipDeviceGetAttribute(&cus, hipDeviceAttributeMultiprocessorCount, dev) != hipSuccess) { grid = -1; return; }
        if (hipFuncSetAttribute((const void*)mk_fwd, hipFuncAttributeMaxDynamicSharedMemorySize, LDS_BYTES) != hipSuccess) { fprintf(stderr, "kernel_launch: hipFuncSetAttribute failed\n"); grid = -1; return; }
        if (hipOccupancyMaxActiveBlocksPerMultiprocessor(&per_cu, (const void*)mk_fwd, 512, LDS_BYTES) != hipSuccess || per_cu < 1) { fprintf(stderr, "kernel_launch: occupancy query says %d blocks per CU\n", per_cu); per_cu = 1; }
        (void)hipGetLastError();
        grid = cus;
    }
    if (grid < 0) return;
    (void)hipMemsetAsync((char*)d_ws + WS_CTL, 0, CTL_BYTES, stream);
    Params p{};
    for (int i = 0; i < 36; ++i) p.in[i] = (const float*)d_in[i];
    p.out = (float*)d_out; p.ws = (unsigned char*)d_ws;
#if MK_ONE_LAUNCH
    p.ph_lo = 0; p.ph_hi = NPHASES;
    hipLaunchKernelGGL(mk_fwd, dim3(grid), dim3(512), LDS_BYTES, stream, p);
#else
    for (int k = 0; k < NPHASES; ++k) { p.ph_lo = k; p.ph_hi = k + 1; const int site = k < NPRO ? k : NPRO + (k - NPRO) % NPH;
        if ((PROBE_DUP_MASK >> site) & 1) { p.dry = 1 | (PROBE_P4KINDS << 1); hipLaunchKernelGGL(mk_fwd, dim3(grid), dim3(512), LDS_BYTES, stream, p); p.dry = 0; }
        hipLaunchKernelGGL(mk_fwd, dim3(grid), dim3(512), LDS_BYTES, stream, p); }
#endif
}
```
